# Optimizing an MI355X kernel written in HIP

```python
import math
import jax, jax.numpy as jnp
from jax import lax
import numpy as np

D_MODEL = 1024
BATCH = 4
SEQ = 8192
DEPTH = 2

N_MIXERS = 2
DA_HEADS = 8
DA_HEAD_DIM = 64
ATTN_QBLOCK = 128
MB_HEADS = 8
MB_HEAD_DIM = 128
MB_BLOCK = 256
MB_TOPK = 3
MB_QCHUNK = 32
ROPE_THETA = 500000.0
ROPE_FRACTION = 4
D_FF_DENSE = 2816
N_EXPERTS = 8
MOE_TOPK = 2
D_FF_EXPERT = 3584
NORM_EPS = 1e-6
SUBLN_EPS = 1e-5

kernel_name = "hybrid_diffattn_moba_moe_trunk"


def rmsnorm(x, g, eps):
    xf = x.astype(jnp.float32)
    y = xf * lax.rsqrt(jnp.mean(xf * xf, axis=-1, keepdims=True) + eps)
    return (y * g.astype(jnp.float32)).astype(x.dtype)


def rope_tables(seq, head_dim):
    rot = head_dim // ROPE_FRACTION
    inv_freq = ROPE_THETA ** (-jnp.arange(0, rot, 2, dtype=jnp.float32) / rot)
    ang = jnp.arange(seq, dtype=jnp.float32)[:, None] * inv_freq[None, :]
    return jnp.cos(ang), jnp.sin(ang)


def apply_partial_rope(x, cos, sin):
    r = cos.shape[-1]
    c = cos[None, :, None, :].astype(x.dtype)
    s = sin[None, :, None, :].astype(x.dtype)
    x1, x2, rest = x[..., :r], x[..., r:2 * r], x[..., 2 * r:]
    return jnp.concatenate([x1 * c - x2 * s, x2 * c + x1 * s, rest], axis=-1)


def diff_attention(h, w_qkv, w_o, lq1, lk1, lq2, lk2, subln_g, lambda_init):
    B, S, _ = h.shape
    H, dh = DA_HEADS, DA_HEAD_DIM
    qkv = jnp.einsum('bsd,de->bse', h, w_qkv)
    q, k, v = jnp.split(qkv, [2 * H * dh, 4 * H * dh], axis=-1)
    cos, sin = rope_tables(S, dh)
    q = apply_partial_rope(q.reshape(B, S, 2 * H, dh), cos, sin) * dh ** -0.5
    k = apply_partial_rope(k.reshape(B, S, 2 * H, dh), cos, sin)
    v = v.reshape(B, S, H, 2 * dh)
    q, k, v = q.transpose(0, 2, 1, 3), k.transpose(0, 2, 1, 3), v.transpose(0, 2, 1, 3)
    f32 = jnp.float32
    lam = (jnp.exp(jnp.sum(lq1.astype(f32) * lk1.astype(f32)))
           - jnp.exp(jnp.sum(lq2.astype(f32) * lk2.astype(f32))) + lambda_init)
    nq = S // ATTN_QBLOCK
    q_blocks = jnp.moveaxis(q.reshape(B, 2 * H, nq, ATTN_QBLOCK, dh), 2, 0)
    k_pos = jnp.arange(S)

    def block(args):
        qb, bi = args
        q_pos = bi * ATTN_QBLOCK + jnp.arange(ATTN_QBLOCK)
        s = jnp.einsum('bhqd,bhkd->bhqk', qb, k, preferred_element_type=f32)
        s = jnp.where(k_pos[None, :] <= q_pos[:, None], s, -jnp.inf)
        p = jax.nn.softmax(s, axis=-1).reshape(B, H, 2, ATTN_QBLOCK, S)
        a = (p[:, :, 0] - lam * p[:, :, 1]).astype(v.dtype)
        return jnp.einsum('bhqk,bhkd->bhqd', a, v)

    o = lax.map(block, (q_blocks, jnp.arange(nq)))
    o = o.transpose(1, 0, 3, 2, 4).reshape(B, S, H, 2 * dh)
    o = rmsnorm(o, subln_g, SUBLN_EPS) * (1.0 - lambda_init)
    return jnp.einsum('bse,ed->bsd', o.reshape(B, S, 2 * H * dh), w_o)


def moba_attention(h, w_qkv, w_o):
    B, S, _ = h.shape
    H, dh, L = MB_HEADS, MB_HEAD_DIM, MB_BLOCK
    f32 = jnp.float32
    qkv = jnp.einsum('bsd,de->bse', h, w_qkv)
    q, k, v = jnp.split(qkv, 3, axis=-1)
    cos, sin = rope_tables(S, dh)
    q = apply_partial_rope(q.reshape(B, S, H, dh), cos, sin) * dh ** -0.5
    k = apply_partial_rope(k.reshape(B, S, H, dh), cos, sin)
    v = v.reshape(B, S, H, dh)
    q, k, v = q.transpose(0, 2, 1, 3), k.transpose(0, 2, 1, 3), v.transpose(0, 2, 1, 3)
    nb = -(-S // L)
    pad = nb * L - S
    kb = jnp.pad(k, ((0, 0), (0, 0), (0, pad), (0, 0))).reshape(B, H, nb, L, dh)
    vb = jnp.pad(v, ((0, 0), (0, 0), (0, pad), (0, 0))).reshape(B, H, nb, L, dh)
    k_mean = jnp.mean(kb.astype(f32), axis=3)
    gate_pad = max(nb, MB_TOPK) - nb
    nq = S // MB_QCHUNK
    q_chunks = jnp.moveaxis(q.reshape(B, H, nq, MB_QCHUNK, dh), 2, 0)
    b_idx = jnp.arange(B)[:, None, None, None]
    h_idx = jnp.arange(H)[None, :, None, None]
    block_ids = jnp.arange(nb)
    slot_ids = jnp.arange(MB_TOPK)
    in_block = jnp.arange(L)

    def chunk(args):
        qc, ci = args
        q_pos = ci * MB_QCHUNK + jnp.arange(MB_QCHUNK)
        own = (ci * MB_QCHUNK) // L
        gate = jnp.einsum('bhqd,bhnd->bhqn', qc.astype(f32), k_mean)
        gate = jnp.where(block_ids < own, gate, -jnp.inf)
        gate = jnp.pad(gate, ((0, 0), (0, 0), (0, 0), (0, gate_pad)), constant_values=-jnp.inf)
        _, sel = lax.top_k(gate, MB_TOPK)
        sel = jnp.minimum(sel, nb - 1)
        k_sel = kb[b_idx, h_idx, sel]
        v_sel = vb[b_idx, h_idx, sel]
        s_sel = jnp.einsum('bhqd,bhqnld->bhqnl', qc, k_sel, preferred_element_type=f32)
        s_sel = jnp.where((slot_ids < own)[:, None], s_sel, -jnp.inf)
        k_own = lax.dynamic_index_in_dim(kb, own, axis=2, keepdims=False)
        v_own = lax.dynamic_index_in_dim(vb, own, axis=2, keepdims=False)
        s_own = jnp.einsum('bhqd,bhld->bhql', qc, k_own, preferred_element_type=f32)
        s_own = jnp.where(own * L + in_block[None, :] <= q_pos[:, None], s_own, -jnp.inf)
        scores = jnp.concatenate([s_sel.reshape(B, H, MB_QCHUNK, MB_TOPK * L), s_own], axis=-1)
        p = jax.nn.softmax(scores, axis=-1).astype(v.dtype)
        p_sel = p[..., :MB_TOPK * L].reshape(B, H, MB_QCHUNK, MB_TOPK, L)
        p_own = p[..., MB_TOPK * L:]
        return (jnp.einsum('bhqnl,bhqnld->bhqd', p_sel, v_sel)
                + jnp.einsum('bhql,bhld->bhqd', p_own, v_own))

    o = lax.map(chunk, (q_chunks, jnp.arange(nq)))
    o = o.transpose(1, 0, 3, 2, 4).reshape(B, S, H * dh)
    return jnp.einsum('bse,ed->bsd', o, w_o)


def dense_swiglu(h, w1, w3, w2):
    return jnp.einsum('bsf,fd->bsd', jax.nn.silu(h @ w1) * (h @ w3), w2)


def moe_swiglu(h, w_router, w1, w3, w2):
    B, S, D = h.shape
    t = h.reshape(B * S, D)
    logits = jnp.einsum('td,de->te', t, w_router, preferred_element_type=jnp.float32)
    top_vals, top_idx = lax.top_k(logits, MOE_TOPK)
    gates = jax.nn.softmax(top_vals, axis=-1)
    combine = jnp.sum(jax.nn.one_hot(top_idx, N_EXPERTS, dtype=jnp.float32) * gates[..., None], axis=1)
    y = jnp.zeros_like(t)
    for e in range(N_EXPERTS):
        hid = jax.nn.silu(t @ w1[e]) * (t @ w3[e])
        y = y + (combine[:, e:e + 1].astype(t.dtype) * hid) @ w2[e]
    return y.reshape(B, S, D)


def setup_inputs(seed: int = 0) -> dict:
    key = jax.random.key(seed)
    ks = jax.random.split(key, 20)
    D = D_MODEL
    n_even = (DEPTH + 1) // 2
    n_odd = DEPTH // 2
    f32 = jnp.float32

    def w(k, shape, fan_in):
        return jax.random.normal(k, shape, f32) * fan_in ** -0.5

    def gain(k, shape):
        return 1.0 + 0.02 * jax.random.normal(k, shape, f32)

    da_qkv = 6 * DA_HEADS * DA_HEAD_DIM
    da_out = 2 * DA_HEADS * DA_HEAD_DIM
    mb_qkv = 3 * MB_HEADS * MB_HEAD_DIM
    mb_out = MB_HEADS * MB_HEAD_DIM
    return {
        'x': jax.random.normal(ks[0], (BATCH, SEQ, D), f32),
        'norm_mix': gain(ks[1], (DEPTH, D)),
        'norm_ffn': gain(ks[2], (DEPTH, D)),
        'final_norm': gain(ks[3], (D,)),
        'da_wqkv': w(ks[4], (n_even, D, da_qkv), D),
        'da_wo': w(ks[5], (n_even, da_out, D), da_out),
        'da_lq1': 0.1 * jax.random.normal(ks[6], (n_even, DA_HEAD_DIM), f32),
        'da_lk1': 0.1 * jax.random.normal(ks[7], (n_even, DA_HEAD_DIM), f32),
        'da_lq2': 0.1 * jax.random.normal(ks[8], (n_even, DA_HEAD_DIM), f32),
        'da_lk2': 0.1 * jax.random.normal(ks[9], (n_even, DA_HEAD_DIM), f32),
        'da_subln': gain(ks[10], (n_even, 2 * DA_HEAD_DIM)),
        'mb_wqkv': w(ks[11], (n_odd, D, mb_qkv), D),
        'mb_wo': w(ks[12], (n_odd, mb_out, D), mb_out),
        'ffn_w1': w(ks[13], (n_even, D, D_FF_DENSE), D),
        'ffn_w3': w(ks[14], (n_even, D, D_FF_DENSE), D),
        'ffn_w2': w(ks[15], (n_even, D_FF_DENSE, D), D_FF_DENSE),
        'moe_router': w(ks[16], (n_odd, D, N_EXPERTS), D),
        'moe_w1': w(ks[17], (n_odd, N_EXPERTS, D, D_FF_EXPERT), D),
        'moe_w3': w(ks[18], (n_odd, N_EXPERTS, D, D_FF_EXPERT), D),
        'moe_w2': w(ks[19], (n_odd, N_EXPERTS, D_FF_EXPERT, D), D_FF_EXPERT),
    }


def reference(x, norm_mix, norm_ffn, final_norm, da_wqkv, da_wo, da_lq1, da_lk1, da_lq2,
              da_lk2, da_subln, mb_wqkv, mb_wo, ffn_w1, ffn_w3, ffn_w2, moe_router,
              moe_w1, moe_w3, moe_w2):
    for i in range(DEPTH):
        j = i // N_MIXERS
        h = rmsnorm(x, norm_mix[i], NORM_EPS)
        if i % N_MIXERS == 0:
            lambda_init = 0.8 - 0.6 * math.exp(-0.3 * i)
            x = x + diff_attention(h, da_wqkv[j], da_wo[j], da_lq1[j], da_lk1[j], da_lq2[j],
                                   da_lk2[j], da_subln[j], lambda_init)
        else:
            x = x + moba_attention(h, mb_wqkv[j], mb_wo[j])
        h = rmsnorm(x, norm_ffn[i], NORM_EPS)
        k = i // 2
        if i % 2 == 0:
            x = x + dense_swiglu(h, ffn_w1[k], ffn_w3[k], ffn_w2[k])
        else:
            x = x + moe_swiglu(h, moe_router[k], moe_w1[k], moe_w3[k], moe_w2[k])
    return rmsnorm(x, final_norm, NORM_EPS)
```

```cpp
#include <hip/hip_runtime.h>
#include <hip/hip_bf16.h>
#include <cstdio>
#include <cstdint>
#include <cmath>
namespace pg8 {
#define PG8_LAS __attribute__((address_space(3)))
typedef unsigned short bf16_t;
typedef short bf16x8 __attribute__((ext_vector_type(8)));
typedef float f32x4 __attribute__((ext_vector_type(4)));
typedef unsigned u32x4 __attribute__((ext_vector_type(4)));
constexpr int BM = 256, BK = 64, HALF = 128, HTB = HALF * BK * 2  , STAGE_BYTES = 8 * HTB, NXCD = 8, WGM = 8;

__host__ __device__ __forceinline__ int lds_byte(int r, int c) { const int st = (r >> 4) * 2 + (c >> 5), rr = r & 15, cc = c & 31, ob = rr * 64 + cc * 2; return st * 1024 + (ob ^ (((ob >> 9) & 1) << 5)); }
__host__ __device__ __forceinline__ void stage_rc(int b, int& R, int& C) { const int st = b / 1024, sb = b % 1024, swz = sb ^ (((sb >> 9) & 1) << 5); R = (st >> 1) * 16 + swz / 64; C = (st & 1) * 32 + (swz % 64) / 2; }
__host__ __device__ __forceinline__ int perm32(int rho) { const int n = rho >> 4, i = rho & 15; return 8 * (i >> 2) + 4 * n + (i & 3); }

struct Unit { int pm, pn; };

struct TileOrder {
    int nM, nN, nwg, G, c;
    __device__ __forceinline__ void init(int nM_, int nN_, int G_, int c_) { nM = nM_; nN = nN_; nwg = nM * nN; G = G_; c = c_; }
    __device__ __forceinline__ bool next(int i, Unit& u) const {
        const long L = (long)i * G + c; if (L >= nwg) return false;
        int wgid = (int)L; { const int q = nwg / NXCD, r = nwg % NXCD, xcd = wgid % NXCD, off = wgid / NXCD; wgid = (xcd < r ? xcd * (q + 1) : r * (q + 1) + (xcd - r) * q) + off; }
        const int nig = WGM * nN, gid = wgid / nig, fm = gid * WGM, gsz = (nM - fm) < WGM ? (nM - fm) : WGM;
        u.pm = fm + ((wgid % nig) % gsz); u.pn = (wgid % nig) / gsz; return true;
    }
};

struct ABDense {
    static constexpr bool GATHER = false;
    const bf16_t* A; const bf16_t* Bt; int K;
    __device__ __forceinline__ const char* abase(const Unit& u) const { return (const char*)A + (size_t)u.pm * BM * K * 2; }
    __device__ __forceinline__ const char* bbase(const Unit& u) const { return (const char*)Bt + (size_t)u.pn * BM * K * 2; }
    __device__ __forceinline__ const int* tokp(const Unit&) const { return nullptr; }
};
struct ABMoeUp {
    static constexpr bool GATHER = true;
    const bf16_t* A; const bf16_t* Bt; int K; const int* slot_tok; const PG8_LAS int* cum; size_t estride;
    __device__ __forceinline__ int expert(int pm) const { int e = 0;
#pragma unroll
        for (int k = 1; k < 8; ++k) e += (pm >= cum[k]) ? 1 : 0; return e; }
    __device__ __forceinline__ const char* abase(const Unit&) const { return (const char*)A; }
    __device__ __forceinline__ const char* bbase(const Unit& u) const { return (const char*)(Bt + (size_t)expert(u.pm) * estride) + (size_t)u.pn * BM * K * 2; }
    __device__ __forceinline__ const int* tokp(const Unit& u) const { return slot_tok + u.pm * BM; }
};
struct ABMoeDown {
    static constexpr bool GATHER = false;
    const bf16_t* A; const bf16_t* Bt; int K; const PG8_LAS int* cum; size_t estride;
    __device__ __forceinline__ int expert(int pm) const { int e = 0;
#pragma unroll
        for (int k = 1; k < 8; ++k) e += (pm >= cum[k]) ? 1 : 0; return e; }
    __device__ __forceinline__ const char* abase(const Unit& u) const { return (const char*)A + (size_t)u.pm * BM * K * 2; }
    __device__ __forceinline__ const char* bbase(const Unit& u) const { return (const char*)(Bt + (size_t)expert(u.pm) * estride) + (size_t)u.pn * BM * K * 2; }
    __device__ __forceinline__ const int* tokp(const Unit&) const { return nullptr; }
};

__device__ __forceinline__ unsigned cvt_pk_bf16(float lo, float hi) { unsigned r; asm volatile("v_cvt_pk_bf16_f32 %0, %1, %2" : "=v"(r) : "v"(lo), "v"(hi)); return r; }

template <int DH> struct EpiQKV {
    static constexpr bool PERM = true;
    bf16_t* O; int ldc; const float* ct; const float* st; float qscale;
    __device__ __forceinline__ void operator()(const f32x4 (&acc)[2][2][4][2], const Unit& u, int wr, int wc, int fr, int fq) const {
        constexpr int NF = DH / 8;
        const int row0 = u.pm * BM + wr * 64 + fr, col0 = u.pn * BM + wc * 32 + 8 * fq;
        const int sect = u.pn >> 2;
        const float sc = (sect == 0) ? qscale : 1.f;
        const bool rot = (sect < 2) && (DH == 64 ? (((wc & 1) == 0) && (fq < 2)) : (wc == 0));
#pragma unroll
        for (int ai = 0; ai < 2; ++ai)
#pragma unroll
            for (int m = 0; m < 4; ++m) {
                const int row = row0 + ai * HALF + m * 16; const int pos = row & 8191;
                f32x4 c4 = (f32x4){1.f, 1.f, 1.f, 1.f}, s4 = (f32x4){0.f, 0.f, 0.f, 0.f};
                if (rot) { c4 = *(const f32x4*)(ct + pos * NF + 4 * fq); s4 = *(const f32x4*)(st + pos * NF + 4 * fq); }
                bf16_t* rowp = O + (size_t)row * ldc + col0;
#pragma unroll
                for (int bj = 0; bj < 2; ++bj) {
                    const f32x4 x1 = acc[ai][bj][m][0], x2 = acc[ai][bj][m][1];
                    f32x4 v0 = (x1 * c4 - x2 * s4) * sc, v1 = (x2 * c4 + x1 * s4) * sc;
                    u32x4 w; w.x = cvt_pk_bf16(v0[0], v0[1]); w.y = cvt_pk_bf16(v0[2], v0[3]); w.z = cvt_pk_bf16(v1[0], v1[1]); w.w = cvt_pk_bf16(v1[2], v1[3]);
                    *(u32x4*)(rowp + bj * HALF) = w; }
            }
    }
};

__device__ __forceinline__ float silu_mul(float a, float b) { return a * b * __builtin_amdgcn_rcpf(1.0f + __builtin_amdgcn_exp2f(-1.4426950408889634f * a)); }
struct EpiSwiGLU {
    static constexpr bool PERM = true;
    bf16_t* O; int ldc; const float* gate;
    __device__ __forceinline__ void operator()(const f32x4 (&acc)[2][2][4][2], const Unit& u, int wr, int wc, int fr, int fq) const {
        const int row0 = u.pm * BM + wr * 64 + fr, col0 = u.pn * HALF + wc * 32 + 8 * fq;
#pragma unroll
        for (int ai = 0; ai < 2; ++ai)
#pragma unroll
            for (int m = 0; m < 4; ++m) {
                const int row = row0 + ai * HALF + m * 16; const float g = gate ? gate[row] : 1.f;
                const f32x4 a0 = acc[ai][0][m][0], a1 = acc[ai][0][m][1], b0 = acc[ai][1][m][0], b1 = acc[ai][1][m][1];
                float v[8];
#pragma unroll
                for (int k = 0; k < 4; ++k) { v[k] = g * silu_mul(a0[k], b0[k]); v[4 + k] = g * silu_mul(a1[k], b1[k]); }
                u32x4 w; w.x = cvt_pk_bf16(v[0], v[1]); w.y = cvt_pk_bf16(v[2], v[3]); w.z = cvt_pk_bf16(v[4], v[5]); w.w = cvt_pk_bf16(v[6], v[7]);
                *(u32x4*)(O + (size_t)row * ldc + col0) = w; }
    }
};
struct EpiRes {
    static constexpr bool PERM = false;
    const float* base; float* out; int ldc; const int* rowmap;
    __device__ __forceinline__ void operator()(const f32x4 (&acc)[2][2][4][2], const Unit& u, int wr, int wc, int fr, int fq) const {
        const int row0 = u.pm * BM + wr * 64 + fr, col0 = u.pn * BM + wc * 32 + 4 * fq;
#pragma unroll
        for (int ai = 0; ai < 2; ++ai)
#pragma unroll
            for (int m = 0; m < 4; ++m) {
                const int row = row0 + ai * HALF + m * 16; const int orow = rowmap ? rowmap[row] : row;
                if (orow >= 0) { const size_t off = (size_t)orow * ldc + col0;
#pragma unroll
                    for (int bj = 0; bj < 2; ++bj)
#pragma unroll
                        for (int n = 0; n < 2; ++n) *(f32x4*)(out + off + bj * HALF + n * 16) = *(const f32x4*)(base + off + bj * HALF + n * 16) + acc[ai][bj][m][n]; }
                if (m & 1) asm volatile("" ::: "memory"); }
    }
};

template <class Epi, class AB>
__device__ __forceinline__ void gemm_phase(PG8_LAS unsigned char* lds, const AB ab, const TileOrder& S, const Epi& E) {
    const int tid = threadIdx.x, wid = __builtin_amdgcn_readfirstlane(tid >> 6), lane = tid & 63, wr = wid >> 2, wc = wid & 3, fr = lane & 15, fq = lane >> 4;
    const int K = ab.K, nt = K / BK;
    int Rr[2], Cc[2]; unsigned voffB[2];
#pragma unroll
    for (int i = 0; i < 2; ++i) { int R, C; stage_rc(tid * 16 + i * 8192, R, C); const int Rb = Epi::PERM ? ((R & ~31) + perm32(R & 31)) : R;
        Rr[i] = R; Cc[i] = C; voffB[i] = (unsigned)(Rb * K + C) * 2u; }
    const size_t kstep = (size_t)(BK * 2);
    const size_t hstep = (size_t)HALF * K * 2;
    const unsigned ldsw = (unsigned)wid * 1024u;
    const int aoff = lds_byte(wr * 64 + fr, fq * 8), boff = lds_byte(wc * 32 + fr, fq * 8);
#define PG8_SA(b, h) (((b) * 2 + (h)) * HTB)
#define PG8_SB(b, h) ((4 + (b) * 2 + (h)) * HTB)
#define PG8_STAGE(bufoff, gbase, voff) do { _Pragma("unroll") for (int _i = 0; _i < 2; ++_i) \
        __builtin_amdgcn_global_load_lds((const unsigned*)((const char*)(gbase) + (voff)[_i]), (PG8_LAS unsigned*)(lds + (bufoff) + ldsw + _i * 8192), 16, 0, 0); } while (0)
#define PG8_LDA(dst, b, h) do { _Pragma("unroll") for (int m = 0; m < 4; ++m) _Pragma("unroll") for (int k = 0; k < 2; ++k) dst[m][k] = *(const PG8_LAS bf16x8*)(lds + PG8_SA(b, h) + aoff + m * 2048 + k * 1024); } while (0)
#define PG8_LDB(dst, b, h) do { _Pragma("unroll") for (int n = 0; n < 2; ++n) _Pragma("unroll") for (int k = 0; k < 2; ++k) dst[n][k] = *(const PG8_LAS bf16x8*)(lds + PG8_SB(b, h) + boff + n * 2048 + k * 1024); } while (0)
#define PG8_MMA(ai, bj, At, Bt) do { __builtin_amdgcn_s_setprio(1); _Pragma("unroll") for (int m = 0; m < 4; ++m) _Pragma("unroll") for (int n = 0; n < 2; ++n) _Pragma("unroll") for (int k = 0; k < 2; ++k) \
        acc[ai][bj][m][n] = __builtin_amdgcn_mfma_f32_16x16x32_bf16(Bt[n][k], At[m][k], acc[ai][bj][m][n], 0, 0, 0); __builtin_amdgcn_s_setprio(0); } while (0)
#define PG8_WAIT_V(n) asm volatile("s_waitcnt vmcnt(" #n ")" ::: "memory")
#define PG8_WAIT_L(n) asm volatile("s_waitcnt lgkmcnt(" #n ")" ::: "memory")
#define PG8_BAR __builtin_amdgcn_s_barrier()
#define PG8_SCHED __builtin_amdgcn_sched_barrier(0)
    Unit cur, nxt; int ui = 0;
    if (!S.next(0, cur)) return;
    f32x4 acc[2][2][4][2];
#pragma unroll
    for (int a = 0; a < 2; ++a)
#pragma unroll
        for (int b = 0; b < 2; ++b)
#pragma unroll
            for (int m = 0; m < 4; ++m)
#pragma unroll
                for (int n = 0; n < 2; ++n) acc[a][b][m][n] = (f32x4){0.f, 0.f, 0.f, 0.f};
    bf16x8 At[4][2], B0[2][2], B1[2][2];
    unsigned cv0[2], cv1[2], nv0[2], nv1[2]; int ntok[4] = {0, 0, 0, 0};
    if constexpr (AB::GATHER) { const int* tp = ab.tokp(cur);
#pragma unroll
        for (int i = 0; i < 2; ++i) { int t0 = tp[Rr[i]], t1 = tp[HALF + Rr[i]]; t0 = t0 < 0 ? 0 : t0; t1 = t1 < 0 ? 0 : t1;
            cv0[i] = (unsigned)(t0 * K + Cc[i]) * 2u; cv1[i] = (unsigned)(t1 * K + Cc[i]) * 2u; }
    } else {
#pragma unroll
        for (int i = 0; i < 2; ++i) { cv0[i] = (unsigned)(Rr[i] * K + Cc[i]) * 2u; cv1[i] = cv0[i] + (unsigned)hstep; }
    }
#pragma unroll
    for (int i = 0; i < 2; ++i) { nv0[i] = cv0[i]; nv1[i] = cv1[i]; }
    const char* cA = ab.abase(cur); const char* cB = ab.bbase(cur);
    PG8_STAGE(PG8_SB(0, 0), cB, voffB); PG8_STAGE(PG8_SB(0, 1), cB + hstep, voffB); PG8_STAGE(PG8_SA(0, 0), cA, cv0); PG8_STAGE(PG8_SA(0, 1), cA, cv1);
    if (wr == 1) PG8_BAR;
    PG8_WAIT_V(2); PG8_BAR;
    PG8_STAGE(PG8_SB(1, 0), cB + kstep, voffB); PG8_STAGE(PG8_SA(1, 0), cA + kstep, cv0); PG8_STAGE(PG8_SB(1, 1), cB + hstep + kstep, voffB);
    PG8_WAIT_V(6); PG8_BAR;
    for (;;) {
        const bool has_next = S.next(ui + 1, nxt);
        const char* nA = has_next ? ab.abase(nxt) : cA; const char* nB = has_next ? ab.bbase(nxt) : cB;
        if constexpr (AB::GATHER) {
            if (has_next) { const int* tp = ab.tokp(nxt);
                asm volatile("global_load_dword %0, %1, off" : "=v"(ntok[0]) : "v"(tp + Rr[0]) : "memory");
                asm volatile("global_load_dword %0, %1, off" : "=v"(ntok[1]) : "v"(tp + Rr[1]) : "memory");
                asm volatile("global_load_dword %0, %1, off" : "=v"(ntok[2]) : "v"(tp + HALF + Rr[0]) : "memory");
                asm volatile("global_load_dword %0, %1, off" : "=v"(ntok[3]) : "v"(tp + HALF + Rr[1]) : "memory"); }
        }
        for (int t = 0; t < nt; t += 2) {
            const bool last = (t == nt - 2);
            const char* a1 = cA + (size_t)(t + 1) * kstep;
            const char* a2 = last ? nA : cA + (size_t)(t + 2) * kstep; const char* b2 = last ? nB : cB + (size_t)(t + 2) * kstep;
            const char* a3 = a2 + kstep; const char* b3 = b2 + kstep;
            unsigned x0[2], x1[2];
            if constexpr (AB::GATHER) {
                if (last && has_next) {
                    asm volatile("s_waitcnt vmcnt(6)" : "+v"(ntok[0]), "+v"(ntok[1]), "+v"(ntok[2]), "+v"(ntok[3]) :: "memory");
#pragma unroll
                    for (int i = 0; i < 2; ++i) { int t0 = ntok[i], t1 = ntok[2 + i]; t0 = t0 < 0 ? 0 : t0; t1 = t1 < 0 ? 0 : t1;
                        nv0[i] = (unsigned)(t0 * K + Cc[i]) * 2u; nv1[i] = (unsigned)(t1 * K + Cc[i]) * 2u; }
                }
#pragma unroll
                for (int i = 0; i < 2; ++i) { x0[i] = last ? nv0[i] : cv0[i]; x1[i] = last ? nv1[i] : cv1[i]; }
            } else {
#pragma unroll
                for (int i = 0; i < 2; ++i) { x0[i] = cv0[i]; x1[i] = cv1[i]; }
            }
            PG8_LDB(B0, 0, 0); PG8_LDB(B1, 0, 1); PG8_SCHED; PG8_LDA(At, 0, 0); PG8_STAGE(PG8_SA(1, 1), a1, cv1);
            PG8_WAIT_V(8); PG8_WAIT_L(0); PG8_BAR; PG8_MMA(0, 0, At, B0); PG8_MMA(0, 1, At, B1); PG8_BAR; PG8_SCHED;
            PG8_LDA(At, 0, 1); PG8_STAGE(PG8_SB(0, 0), b2, voffB); PG8_STAGE(PG8_SB(0, 1), b2 + hstep, voffB); PG8_STAGE(PG8_SA(0, 0), a2, x0);
            PG8_WAIT_V(8); PG8_WAIT_L(0); PG8_BAR; PG8_MMA(1, 0, At, B0); PG8_MMA(1, 1, At, B1); PG8_BAR; PG8_SCHED;
            PG8_LDB(B0, 1, 0); PG8_LDB(B1, 1, 1); PG8_SCHED; PG8_LDA(At, 1, 0); PG8_STAGE(PG8_SA(0, 1), a2, x1);
            PG8_WAIT_V(8); PG8_WAIT_L(0); PG8_BAR; PG8_MMA(0, 0, At, B0); PG8_MMA(0, 1, At, B1); PG8_BAR; PG8_SCHED;
            PG8_LDA(At, 1, 1); PG8_STAGE(PG8_SB(1, 0), b3, voffB); PG8_STAGE(PG8_SB(1, 1), b3 + hstep, voffB); PG8_STAGE(PG8_SA(1, 0), a3, x0);
            PG8_WAIT_V(8); PG8_WAIT_L(0); PG8_BAR; PG8_MMA(1, 0, At, B0); PG8_MMA(1, 1, At, B1); PG8_BAR; PG8_SCHED;
        }
        if (wr == 0) PG8_BAR;
        E(acc, cur, wr, wc, fr, fq);
        if (!has_next) break;
#pragma unroll
        for (int a = 0; a < 2; ++a)
#pragma unroll
            for (int b = 0; b < 2; ++b)
#pragma unroll
                for (int m = 0; m < 4; ++m)
#pragma unroll
                    for (int n = 0; n < 2; ++n) acc[a][b][m][n] = (f32x4){0.f, 0.f, 0.f, 0.f};
        cur = nxt; cA = nA; cB = nB; ++ui;
#pragma unroll
        for (int i = 0; i < 2; ++i) { cv0[i] = nv0[i]; cv1[i] = nv1[i]; }
        if (wr == 1) PG8_BAR;
    }
    PG8_WAIT_V(0);
    PG8_BAR;
#undef PG8_SA
#undef PG8_SB
#undef PG8_STAGE
#undef PG8_LDA
#undef PG8_LDB
#undef PG8_MMA
#undef PG8_WAIT_V
#undef PG8_WAIT_L
#undef PG8_BAR
#undef PG8_SCHED
}
}
namespace attn_body {
using bf16=__hip_bfloat16;
using bf16x8=__attribute__((ext_vector_type(8)))short;
using s16x4=__attribute__((ext_vector_type(4)))short;
using f32x16=__attribute__((ext_vector_type(16)))float;
using u32x4=__attribute__((ext_vector_type(4)))unsigned;
constexpr int BATCH=4,NVH=32,SEQ=8192,D=64,PQ=3072,PO=2048;
constexpr int NW=8,QBLK=32,QB=QBLK*NW,KVBLK=64,NQB=SEQ/QB;
constexpr int ATTN_UNIT_ROWS=QB;
__device__ __forceinline__ int crow(int r,int hi){return (r&3)+8*(r>>2)+4*hi;}
#define SBAR() __builtin_amdgcn_sched_barrier(0)
__device__ __forceinline__ void cmask(f32x16&p0,f32x16&p1,int jb,int qrel,int hi){
  const float NEG=-INFINITY; int kb=64*jb+4*hi;
  #pragma unroll
  for(int r=0;r<16;++r){int kv=kb+(r&3)+8*(r>>2); if(kv>qrel)p0[r]=NEG; if(kv+32>qrel)p1[r]=NEG;}
}

constexpr int NSLOT=3, SLOTB=8192;
constexpr int LDS_K=0, LDS_V=NSLOT*SLOTB, LDS_WS=2*NSLOT*SLOTB, LDS_OST=LDS_WS+NW*64*4, LDS_BYTES=LDS_OST+NW*4096;
constexpr float C2=0.125f*1.4426950408889634f;
__device__ __forceinline__ void glds16(const void*gsrc,unsigned lds_dst){unsigned keep;
  asm volatile("s_mov_b32 %0, m0\n\ts_mov_b32 m0, %2\n\ts_nop 0\n\tglobal_load_lds_dwordx4 %1, off\n\ts_mov_b32 m0, %0":"=&s"(keep):"v"(gsrc),"s"(lds_dst):"memory");}
__device__ __forceinline__ float max3f(float a,float b,float c){float r;asm("v_max3_f32 %0, %1, %2, %3":"=v"(r):"v"(a),"v"(b),"v"(c));return r;}
__device__ __forceinline__ float max2f(float a,float b){float r;asm("v_max_f32_e32 %0, %1, %2":"=v"(r):"v"(a),"v"(b));return r;}
__device__ __forceinline__ float fadd_s(float a,float b){float r;asm("v_add_f32_e32 %0, %1, %2":"=v"(r):"v"(a),"v"(b));return r;}
__device__ __forceinline__ float fsub_s(float a,float b){float r;asm("v_sub_f32_e32 %0, %1, %2":"=v"(r):"v"(a),"v"(b));return r;}
typedef float f32x2_t __attribute__((ext_vector_type(2))); typedef __bf16 bf16x2_t __attribute__((ext_vector_type(2)));
__device__ __forceinline__ unsigned cvtpk_s(float lo,float hi){f32x2_t v={lo,hi};bf16x2_t b=__builtin_convertvector(v,bf16x2_t);return __builtin_bit_cast(unsigned,b);}
#define WAIT_BAR(N) asm volatile("s_waitcnt vmcnt(" #N ") lgkmcnt(0)\n\ts_barrier":::"memory")

__device__ __forceinline__ void qkt(f32x16&p0,f32x16&p1,const char*Kslot,const bf16x8*qr,const f32x16&negm,int r32,int hi){
  const char*kb=Kslot+hi*1024+r32*16;
  #pragma unroll
  for(int d0=0;d0<4;++d0){
    const bf16x8 b0=*reinterpret_cast<const bf16x8*>(kb+d0*2048);
    const bf16x8 b1=*reinterpret_cast<const bf16x8*>(kb+d0*2048+512);
    if(d0==0){p0=__builtin_amdgcn_mfma_f32_32x32x16_bf16(b0,qr[0],negm,0,0,0);p1=__builtin_amdgcn_mfma_f32_32x32x16_bf16(b1,qr[0],negm,0,0,0);}
    else{p0=__builtin_amdgcn_mfma_f32_32x32x16_bf16(b0,qr[d0],p0,0,0,0);p1=__builtin_amdgcn_mfma_f32_32x32x16_bf16(b1,qr[d0],p1,0,0,0);}}
}
typedef __attribute__((address_space(3))) const char* lds_cptr;
typedef short v4i16_t __attribute__((ext_vector_type(4)));
__device__ __forceinline__ void kload8(bf16x8*kf,lds_cptr kp){
  kf[0]=*(const __attribute__((address_space(3))) bf16x8*)(kp);      kf[1]=*(const __attribute__((address_space(3))) bf16x8*)(kp+512);
  kf[2]=*(const __attribute__((address_space(3))) bf16x8*)(kp+2048); kf[3]=*(const __attribute__((address_space(3))) bf16x8*)(kp+2560);
  kf[4]=*(const __attribute__((address_space(3))) bf16x8*)(kp+4096); kf[5]=*(const __attribute__((address_space(3))) bf16x8*)(kp+4608);
  kf[6]=*(const __attribute__((address_space(3))) bf16x8*)(kp+6144); kf[7]=*(const __attribute__((address_space(3))) bf16x8*)(kp+6656);
}
__device__ __forceinline__ void kload2(bf16x8*kf,lds_cptr kp,int j){ kf[2*j]=*(const __attribute__((address_space(3))) bf16x8*)(kp+j*2048); kf[2*j+1]=*(const __attribute__((address_space(3))) bf16x8*)(kp+j*2048+512); }
__device__ __forceinline__ s16x4 vtr(lds_cptr p){ return __builtin_bit_cast(s16x4,__builtin_amdgcn_ds_read_tr16_b64_v4i16((__attribute__((address_space(3))) v4i16_t*)p)); }
__device__ __forceinline__ float rowmax(const f32x16&p0,const f32x16&p1){
  float a=max3f(p0[0],p0[1],p1[0]),b=max3f(p0[2],p0[3],p1[1]);a=max3f(a,p1[2],p1[3]);
  #pragma unroll
  for(int r=4;r<16;r+=4){a=max3f(a,p0[r],p0[r+1]);b=max3f(b,p0[r+2],p0[r+3]);a=max3f(a,p1[r],p1[r+1]);b=max3f(b,p1[r+2],p1[r+3]);}
  const float m=max2f(a,b);
  auto rr=__builtin_amdgcn_permlane32_swap(__float_as_uint(m),__float_as_uint(m),false,false);
  return max2f(__uint_as_float(rr[0]),__uint_as_float(rr[1]));
}
__device__ __forceinline__ void pv(f32x16*o,int vb,bf16x8 pa0,bf16x8 pa1,bf16x8 pa2,bf16x8 pa3){
  #pragma unroll
  for(int d0=0;d0<2;++d0){s16x4 lo[4],hi[4];
    #pragma unroll
    for(int ks=0;ks<4;++ks){
      asm volatile("ds_read_b64_tr_b16 %0,%1 offset:%c2":"=&v"(lo[ks]):"v"(vb),"i"(d0*4096+ks*1024):"memory");
      asm volatile("ds_read_b64_tr_b16 %0,%1 offset:%c2":"=&v"(hi[ks]):"v"(vb),"i"(d0*4096+ks*1024+512):"memory");}
    asm volatile("s_waitcnt lgkmcnt(0)":::"memory");SBAR();
    #define PK(k) (bf16x8){lo[k][0],lo[k][1],lo[k][2],lo[k][3],hi[k][0],hi[k][1],hi[k][2],hi[k][3]}
    o[d0]=__builtin_amdgcn_mfma_f32_32x32x16_bf16(pa0,PK(0),o[d0],0,0,0);
    o[d0]=__builtin_amdgcn_mfma_f32_32x32x16_bf16(pa1,PK(1),o[d0],0,0,0);
    o[d0]=__builtin_amdgcn_mfma_f32_32x32x16_bf16(pa2,PK(2),o[d0],0,0,0);
    o[d0]=__builtin_amdgcn_mfma_f32_32x32x16_bf16(pa3,PK(3),o[d0],0,0,0);
    #undef PK
  }
}

#ifndef ATTN_STORE16
#define ATTN_STORE16(p,v) (*(u32x4*)(p)=(v))
#endif
template<int THRL> __device__ __forceinline__ void attn_unit(int b,int vh,int qb,const bf16*__restrict__ QKV,bf16*O,char*shm){
  const int tid=threadIdx.x,lane=tid&63,r32=lane&31,hi=lane>>5; const int wid=__builtin_amdgcn_readfirstlane(tid>>6);
  const long rowbase=(long)b*SEQ; const int q0=qb*QB;
  const int qh=vh>>1; const bf16*Qw=QKV+(rowbase+q0+wid*QBLK)*PQ+qh*D;
  const bf16*Kh=QKV+rowbase*PQ+1024+qh*D,*Vh=QKV+rowbase*PQ+2048+(qh>>1)*128+(vh&1)*D;
  const unsigned lds0=(unsigned)(uintptr_t)shm;
  float*wsf=(float*)(shm+LDS_WS)+wid*64;
  const bf16*ksrc=Kh+(long)lane*PQ+wid*8;
  const bf16*vsrc=Vh+(long)(16*(wid&3)+(lane>>2))*PQ+(wid>>2)*32+(lane&3)*8;
  const unsigned kdst=lds0+LDS_K+wid*1024, vdst=lds0+LDS_V+wid*1024;
  #define DMA_K(t,slot) glds16(ksrc+(long)(t)*KVBLK*PQ,(unsigned)__builtin_amdgcn_readfirstlane(kdst+(slot)))
  #define DMA_V(t,slot) glds16(vsrc+(long)(t)*KVBLK*PQ,(unsigned)__builtin_amdgcn_readfirstlane(vdst+(slot)))
  const int vb0=(int)(lds0+LDS_V)+((lane>>4)&1)*32+(lane&3)*8+(4*hi+((lane&15)>>2))*64;
  const char*Kbase=shm+LDS_K; bf16x8 kf[8];
  const lds_cptr shm3=(lds_cptr)shm; const lds_cptr kp0=shm3+LDS_K+hi*1024+r32*16; const lds_cptr vp0=shm3+LDS_V+((lane>>4)&1)*32+(lane&3)*8+(4*hi+((lane&15)>>2))*64;
  const int NT=(q0+QB)/KVBLK;
  DMA_K(0,0);DMA_V(0,0);DMA_K(1,SLOTB);
  bf16x8 qr[4];
  #pragma unroll
  for(int d0=0;d0<4;++d0)qr[d0]=*reinterpret_cast<const bf16x8*>(&Qw[(long)r32*PQ+d0*16+hi*8]);
  float mhat=0.f,l_reg=0.f;f32x16 o[2];o[0]=f32x16{};o[1]=f32x16{};f32x16 negm=f32x16{};asm volatile("":"+v"(negm));
  const int qrel=wid*QBLK+r32;
  #define CMASK(P0,P1,t) do{int jb_=(t)-(NT-4); if(jb_>=0)cmask(P0,P1,jb_,qrel,hi);}while(0)
  bool resc=false;
  #define START(P0,P1) do{ const float rm=rowmax(P0,P1); resc=false; \
    { const float dl=rm; mhat=fadd_s(mhat,dl); \
      _Pragma("unroll") for(int r=0;r<16;++r){P0[r]=fsub_s(P0[r],dl);P1[r]=fsub_s(P1[r],dl);} \
      _Pragma("unroll") for(int r=0;r<16;++r)negm[r]=-mhat; asm volatile("":"+v"(negm)); } \
    _Pragma("unroll") for(int r=0;r<16;++r)P0[r]=__builtin_amdgcn_exp2f(P0[r]); }while(0)
  #define RESC() do{ if(resc){ asm volatile("s_waitcnt lgkmcnt(0)":::"memory"); \
      _Pragma("unroll") for(int d_=0;d_<2;++d_) _Pragma("unroll") for(int r=0;r<16;++r)o[d_][r]*=wsf[crow(r,hi)]; } }while(0)
  f32x16 pA0,pA1,pB0,pB1;
  int sl_prev=0,sl_cur=0,sl_next=SLOTB;
  #define ROT() do{sl_prev=sl_cur;sl_cur=sl_next;sl_next=(sl_next==(NSLOT-1)*SLOTB)?0:sl_next+SLOTB;}while(0)
  DMA_K(2,2*SLOTB);
  WAIT_BAR(3);
  qkt(pA0,pA1,Kbase,qr,negm,r32,hi);asm volatile("s_nop 15\n\ts_nop 7":"+v"(pA0),"+v"(pA1));CMASK(pA0,pA1,0);
  START(pA0,pA1);
  _Pragma("unroll") for(int r=0;r<16;++r)pA1[r]=__builtin_amdgcn_exp2f(pA1[r]);
  WAIT_BAR(0);
  DMA_K(3,0);DMA_V(1,SLOTB);
  ROT();
  kload8(kf,kp0+sl_cur);
  WAIT_BAR(2);
  s16x4 vlo[8],vhi[8]; u32x4 pw0,pw1,pw2,pw3;
  #define PKW(P,B) cvtpk_s(P[B],P[B+1])
  #define PAF(k) __builtin_bit_cast(bf16x8,pw##k)
  #define VFR(i) (bf16x8){vlo[i][0],vlo[i][1],vlo[i][2],vlo[i][3],vhi[i][0],vhi[i][1],vhi[i][2],vhi[i][3]}
  #define PIN(x) asm volatile("":"+v"(x))
  #define MX3(a,b,c) __builtin_fmaxf(__builtin_fmaxf((a),(b)),(c))
  #define GAPA(MF,A0,A1,A2,A3,W0,W1,PW) do{ MF; sacc+=A0; sacc+=A1; sacc+=A2; sacc+=A3; PIN(sacc); W0; W1; PIN(PW); SBAR(); }while(0)
  #define EX(v) __builtin_amdgcn_exp2f(v)
  #define GAPB(MF,X,B) do{ MF; X[B]=EX(X[B]); X[B+1]=EX(X[B+1]); X[B+2]=EX(X[B+2]); X[B+3]=EX(X[B+3]); PIN(X); SBAR(); }while(0)
  #define VRD(i) do{ vlo[i]=vtr(vp_+(((i)>>2)*4096+((i)&3)*1024)); vhi[i]=vtr(vp_+(((i)>>2)*4096+((i)&3)*1024+512)); }while(0)
  #define KRD(G,j) do{ if(G){ kload2(kf,kp0+sl_next,j); SBAR(); } }while(0)
  #define STEP(C0,C1,P0,P1,t,GK,GV,GL) do{ SBAR(); \
    const lds_cptr vp_=vp0+sl_prev; \
    VRD(0); SBAR(); float sacc=(P0[0]+P0[1]); \
    GAPA(C0=__builtin_amdgcn_mfma_f32_32x32x16_bf16(kf[0],qr[0],negm,0,0,0), P0[2],P0[3],P0[4],P0[5],     pw0[0]=PKW(P0,0), pw0[1]=PKW(P0,2), pw0); \
    VRD(4); SBAR(); GAPA(C1=__builtin_amdgcn_mfma_f32_32x32x16_bf16(kf[1],qr[0],negm,0,0,0), P0[6],P0[7],P0[8],P0[9],     pw0[2]=PKW(P0,4), pw0[3]=PKW(P0,6), pw0); \
    VRD(1); SBAR(); GAPA(C0=__builtin_amdgcn_mfma_f32_32x32x16_bf16(kf[2],qr[1],C0,0,0,0),   P0[10],P0[11],P0[12],P0[13], pw1[0]=PKW(P0,8), pw1[1]=PKW(P0,10), pw1); \
    VRD(5); SBAR(); GAPA(C1=__builtin_amdgcn_mfma_f32_32x32x16_bf16(kf[3],qr[1],C1,0,0,0),   P0[14],P0[15],P1[0],P1[1],   pw1[2]=PKW(P0,12),pw1[3]=PKW(P0,14), pw1); \
    VRD(2); SBAR(); GAPA(C0=__builtin_amdgcn_mfma_f32_32x32x16_bf16(kf[4],qr[2],C0,0,0,0),   P1[2],P1[3],P1[4],P1[5],     pw2[0]=PKW(P1,0), pw2[1]=PKW(P1,2), pw2); \
    VRD(6); SBAR(); GAPA(C1=__builtin_amdgcn_mfma_f32_32x32x16_bf16(kf[5],qr[2],C1,0,0,0),   P1[6],P1[7],P1[8],P1[9],     pw2[2]=PKW(P1,4), pw2[3]=PKW(P1,6), pw2); \
    VRD(3); SBAR(); GAPA(C0=__builtin_amdgcn_mfma_f32_32x32x16_bf16(kf[6],qr[3],C0,0,0,0),   P1[10],P1[11],P1[12],P1[13], pw3[0]=PKW(P1,8), pw3[1]=PKW(P1,10), pw3); \
    VRD(7); SBAR(); GAPA(C1=__builtin_amdgcn_mfma_f32_32x32x16_bf16(kf[7],qr[3],C1,0,0,0),   P1[14],P1[15],0.f,0.f,       pw3[2]=PKW(P1,12),pw3[3]=PKW(P1,14), pw3); \
    l_reg+=sacc; \
    if(GK){DMA_K((t)+3,sl_cur);} if(GV){DMA_V((t)+1,sl_next);} \
    CMASK(C0,C1,t); \
    { float a=MX3(C0[0],C0[1],C1[0]),b=MX3(C0[2],C0[3],C1[1]); a=MX3(a,C1[2],C1[3]); \
      _Pragma("unroll") for(int r=4;r<16;r+=4){a=MX3(a,C0[r],C0[r+1]);b=MX3(b,C0[r+2],C0[r+3]);a=MX3(a,C1[r],C1[r+1]);b=MX3(b,C1[r+2],C1[r+3]);} \
      float rm=__builtin_fmaxf(a,b); { auto rr=__builtin_amdgcn_permlane32_swap(__float_as_uint(rm),__float_as_uint(rm),false,false); rm=__builtin_fmaxf(__uint_as_float(rr[0]),__uint_as_float(rr[1])); } \
      resc=false; \
      if(__builtin_expect(__any(rm>(float)THRL),0)){ const float dl=__builtin_fmaxf(rm,0.f); mhat+=dl; \
        _Pragma("unroll") for(int r=0;r<16;++r){C0[r]-=dl;C1[r]-=dl;} \
        _Pragma("unroll") for(int r=0;r<16;++r)negm[r]=-mhat; asm volatile("":"+v"(negm)); \
        const float f=__builtin_amdgcn_exp2f(-dl); l_reg*=f; if(hi==0)wsf[r32]=f; resc=true; } } \
    SBAR(); \
    GAPB(o[0]=__builtin_amdgcn_mfma_f32_32x32x16_bf16(PAF(0),VFR(0),o[0],0,0,0), C0,0); \
    GAPB(o[1]=__builtin_amdgcn_mfma_f32_32x32x16_bf16(PAF(0),VFR(4),o[1],0,0,0), C0,4); \
    KRD(GL,0); GAPB(o[0]=__builtin_amdgcn_mfma_f32_32x32x16_bf16(PAF(1),VFR(1),o[0],0,0,0), C0,8); \
    KRD(GL,1); GAPB(o[1]=__builtin_amdgcn_mfma_f32_32x32x16_bf16(PAF(1),VFR(5),o[1],0,0,0), C0,12); \
    KRD(GL,2); GAPB(o[0]=__builtin_amdgcn_mfma_f32_32x32x16_bf16(PAF(2),VFR(2),o[0],0,0,0), C1,0); \
    KRD(GL,3); GAPB(o[1]=__builtin_amdgcn_mfma_f32_32x32x16_bf16(PAF(2),VFR(6),o[1],0,0,0), C1,4); \
    GAPB(o[0]=__builtin_amdgcn_mfma_f32_32x32x16_bf16(PAF(3),VFR(3),o[0],0,0,0), C1,8); \
    GAPB(o[1]=__builtin_amdgcn_mfma_f32_32x32x16_bf16(PAF(3),VFR(7),o[1],0,0,0), C1,12); \
    }while(0)
  int t=1;
  #undef CMASK
  #define CMASK(P0,P1,t) do{}while(0)
  for(;t+5<NT;t+=2){
    STEP(pB0,pB1,pA0,pA1,t,true,true,true);     WAIT_BAR(2); RESC(); ROT();
    STEP(pA0,pA1,pB0,pB1,t+1,true,true,true);   WAIT_BAR(2); RESC(); ROT();
  }
  #undef CMASK
  #define CMASK(P0,P1,t) do{int jb_=(t)-(NT-4); if(jb_>=0)cmask(P0,P1,jb_,qrel,hi);}while(0)
  #define ENDW(tt) do{ if((tt)+3<NT){WAIT_BAR(2);} else if((tt)+2<NT){WAIT_BAR(1);} else {WAIT_BAR(0);} }while(0)
  for(;t+1<NT;t+=2){
    STEP(pB0,pB1,pA0,pA1,t,(t+3<NT),(t+1<NT),(t+1<NT));       ENDW(t);   RESC(); ROT();
    STEP(pA0,pA1,pB0,pB1,t+1,(t+4<NT),(t+2<NT),(t+2<NT));     ENDW(t+1); RESC(); ROT();
  }
  STEP(pB0,pB1,pA0,pA1,NT-1,false,false,false); RESC();
  { float sacc=pB0[0]+pB0[1]; _Pragma("unroll") for(int r=2;r<16;++r)sacc+=pB0[r]; _Pragma("unroll") for(int r=0;r<16;++r)sacc+=pB1[r]; l_reg+=sacc;
    pw0=(u32x4){PKW(pB0,0),PKW(pB0,2),PKW(pB0,4),PKW(pB0,6)};pw1=(u32x4){PKW(pB0,8),PKW(pB0,10),PKW(pB0,12),PKW(pB0,14)};pw2=(u32x4){PKW(pB1,0),PKW(pB1,2),PKW(pB1,4),PKW(pB1,6)};pw3=(u32x4){PKW(pB1,8),PKW(pB1,10),PKW(pB1,12),PKW(pB1,14)};
    SBAR(); pv(o,vb0+sl_cur,PAF(0),PAF(1),PAF(2),PAF(3)); }
  #undef PKW
  #undef PAF
  #undef VFR
  #undef PIN
  #undef MX3
  #undef GAPA
  #undef GAPB
  #undef EX
  #undef VRD
  #undef KRD
  #undef STEP
  #undef ENDW
  {auto rr=__builtin_amdgcn_permlane32_swap(__float_as_uint(l_reg),__float_as_uint(l_reg),false,false);l_reg=__uint_as_float(rr[0])+__uint_as_float(rr[1]);}
  if(hi==0)wsf[32+r32]=l_reg;asm volatile("s_waitcnt lgkmcnt(0)":::"memory");
  float rli[16];
  #pragma unroll
  for(int r=0;r<16;++r)rli[r]=__builtin_amdgcn_rcpf(wsf[32+crow(r,hi)]);
  bf16*Ow=O+(rowbase+q0+wid*QBLK)*PO+qh*128+(vh&1)*D;
  { bf16*stg=(bf16*)(shm+LDS_OST)+wid*2048;
    #pragma unroll
    for(int r=0;r<16;++r){const int orow=crow(r,hi);
      #pragma unroll
      for(int d0=0;d0<2;++d0)stg[orow*64+d0*32+r32]=__float2bfloat16(o[d0][r]*rli[r]);}
    asm volatile("s_waitcnt lgkmcnt(0)":::"memory");
    #pragma unroll
    for(int i=0;i<4;++i){const int row=i*8+(lane>>3),ch=lane&7; const u32x4 v=*(const u32x4*)(stg+row*64+ch*8); ATTN_STORE16(Ow+(long)row*PO+ch*8,v);} }
  asm volatile("s_waitcnt lgkmcnt(0)\n\ts_barrier":::"memory");
  #undef DMA_K
  #undef DMA_V
  #undef CMASK
  #undef START
  #undef RESC
  #undef ROT
}
constexpr int ATTN_LDS_BYTES=LDS_BYTES;
struct AttnUnit { int bh; int qb; };
struct StaticOrder {
  int vcu, G;
  __device__ __forceinline__ StaticOrder(int vcu_,int G_):vcu(vcu_),G(G_){}
  __device__ __forceinline__ bool next(int i,AttnUnit&u)const{
    if(G==256){ if(i>=16)return false; const int s=vcu&7,ii=i&3; u.bh=(i>>2)*32+(vcu>>3); u.qb=(ii==0)?s:(ii==1)?15-s:(ii==2)?16+s:31-s; return true; }
    const int uu=vcu+i*G; if(uu>=4096)return false; u.bh=uu>>5; u.qb=uu&31; return true; }
};
template<class Sched,int THRL=8> __device__ __forceinline__ void attn_phase(char*lds,const bf16*QKV,bf16*O,const Sched&S){
  AttnUnit u;
  for(int i=0;S.next(i,u);++i){ attn_unit<THRL>(u.bh>>5,u.bh&31,u.qb,QKV,O,lds); }
}
#undef SBAR
#undef WAIT_BAR
}

namespace moba {
using bf16 = __hip_bfloat16;
using bf16x8 = __attribute__((ext_vector_type(8))) short;
using s16x4  = __attribute__((ext_vector_type(4))) short;
using f32x16 = __attribute__((ext_vector_type(16))) float;
using u32x4  = __attribute__((ext_vector_type(4))) unsigned;
constexpr int D = 128, NW = 8, QBLK = 32, KVBLK = 64, LDK = 3072, NT = 4;
constexpr float THR = 8.f;
constexpr size_t SHM_V = KVBLK * D * 2, SHM_K = KVBLK * D * 2, SHM_ATTN = 2 * SHM_V + 2 * SHM_K + NW * 64 * 4;
#define KSWZ(row, colB) ((row) * 256 + ((colB) ^ (((row) & 7) << 4)))
#define SBAR() __builtin_amdgcn_sched_barrier(0)
__device__ __forceinline__ int crow(int r, int hi) { return (r & 3) + 8 * (r >> 2) + 4 * hi; }
__device__ __forceinline__ unsigned cvtpk(float lo, float hi) { unsigned r; asm volatile("v_cvt_pk_bf16_f32 %0, %1, %2" : "=v"(r) : "v"(lo), "v"(hi)); return r; }
__device__ __forceinline__ void partialSM(f32x16& p0, f32x16& p1, float& m_reg, float& mn, float& alpha) {
  float pmax = p0[0];
#pragma unroll
  for (int r = 1; r < 16; ++r) pmax = fmaxf(pmax, p0[r]);
#pragma unroll
  for (int r = 0; r < 16; ++r) pmax = fmaxf(pmax, p1[r]);
  { auto rr = __builtin_amdgcn_permlane32_swap(__float_as_uint(pmax), __float_as_uint(pmax), false, false);
    pmax = fmaxf(__uint_as_float(rr[0]), __uint_as_float(rr[1])); }
  if (__builtin_expect(__all(pmax - m_reg <= THR), 1)) { mn = m_reg; alpha = 1.f; }
  else { mn = fmaxf(m_reg, pmax); alpha = __builtin_amdgcn_exp2f(m_reg - mn); m_reg = mn; }
#pragma unroll
  for (int r = 0; r < 16; ++r) p0[r] = p0[r] - mn;
#pragma unroll
  for (int r = 0; r < 16; ++r) p1[r] = p1[r] - mn;
#pragma unroll
  for (int r = 0; r < 16; ++r) p0[r] = __builtin_amdgcn_exp2f(p0[r]);
}
__device__ __forceinline__ void finishSM(f32x16& p0, f32x16& p1, float alpha, float& l_reg, bf16x8& pa0, bf16x8& pa1, bf16x8& pa2, bf16x8& pa3) {
#pragma unroll
  for (int r = 0; r < 16; ++r) p1[r] = __builtin_amdgcn_exp2f(p1[r]);
  float ps = 0;
#pragma unroll
  for (int r = 0; r < 16; ++r) ps += p0[r];
#pragma unroll
  for (int r = 0; r < 16; ++r) ps += p1[r];
  { auto rr = __builtin_amdgcn_permlane32_swap(__float_as_uint(ps), __float_as_uint(ps), false, false);
    ps = __uint_as_float(rr[0]) + __uint_as_float(rr[1]); }
  l_reg = l_reg * alpha + ps;
#define PK4(P, BASE, OUT) do { unsigned a0 = cvtpk(P[BASE + 0], P[BASE + 1]), a1 = cvtpk(P[BASE + 2], P[BASE + 3]);   \
    unsigned b0 = cvtpk(P[BASE + 4], P[BASE + 5]), b1 = cvtpk(P[BASE + 6], P[BASE + 7]);                              \
    auto r0 = __builtin_amdgcn_permlane32_swap(a0, b0, false, false); auto r1 = __builtin_amdgcn_permlane32_swap(a1, b1, false, false); \
    u32x4 w = {r0[0], r1[0], r0[1], r1[1]}; OUT = *reinterpret_cast<bf16x8*>(&w); } while (0)
  PK4(p0, 0, pa0); PK4(p0, 8, pa1); PK4(p1, 0, pa2); PK4(p1, 8, pa3);
#undef PK4
}
__device__ __forceinline__ void qkt(f32x16& p0, f32x16& p1, const bf16* Ks, const bf16x8* qr, int r32, int hi) {
  p0 = f32x16{}; p1 = f32x16{};
#pragma unroll
  for (int d0 = 0; d0 < 8; ++d0) { int cb = (d0 * 16 + hi * 8) * 2;
    bf16x8 b0 = *reinterpret_cast<const bf16x8*>((const char*)Ks + KSWZ(r32, cb));
    bf16x8 b1 = *reinterpret_cast<const bf16x8*>((const char*)Ks + KSWZ(32 + r32, cb));
    p0 = __builtin_amdgcn_mfma_f32_32x32x16_bf16(b0, qr[d0], p0, 0, 0, 0);
    p1 = __builtin_amdgcn_mfma_f32_32x32x16_bf16(b1, qr[d0], p1, 0, 0, 0); }
}
__device__ __forceinline__ int v_st(int k, int c) { const int kk = (k & ~0xC) | ((k & 4) << 1) | ((k & 8) >> 1); return ((kk >> 3) * 4 + (c >> 5)) * 512 + ((kk & 7) * 32 + (c & 31)) * 2; }
__device__ __forceinline__ int v_rd_base(int lane) { return ((lane & 3) << 3) | (((lane >> 2) & 3) << 6) | (((lane >> 4) & 1) << 5) | (((lane >> 5) & 1) << 8); }
constexpr int v_rd_off(int d0, int ks, int half) { return d0 * 512 + ks * 4096 + half * 2048; }
template <int OFF> __device__ __forceinline__ s16x4 tr_read(int vb) {
  s16x4 r; asm volatile("ds_read_b64_tr_b16 %0, %1 offset:%2" : "=&v"(r) : "v"(vb), "i"(OFF) : "memory"); return r;
}
template <int D0> __device__ __forceinline__ void pv_one(f32x16& od, int vb, bf16x8 pa0, bf16x8 pa1, bf16x8 pa2, bf16x8 pa3) {
  const s16x4 l0 = tr_read<v_rd_off(D0, 0, 0)>(vb), h0 = tr_read<v_rd_off(D0, 0, 1)>(vb), l1 = tr_read<v_rd_off(D0, 1, 0)>(vb), h1 = tr_read<v_rd_off(D0, 1, 1)>(vb);
  const s16x4 l2 = tr_read<v_rd_off(D0, 2, 0)>(vb), h2 = tr_read<v_rd_off(D0, 2, 1)>(vb), l3 = tr_read<v_rd_off(D0, 3, 0)>(vb), h3 = tr_read<v_rd_off(D0, 3, 1)>(vb);
  asm volatile("s_waitcnt lgkmcnt(0)" ::: "memory"); SBAR();
#define PK(L, H) (bf16x8){L[0], L[1], L[2], L[3], H[0], H[1], H[2], H[3]}
  od = __builtin_amdgcn_mfma_f32_32x32x16_bf16(pa0, PK(l0, h0), od, 0, 0, 0);
  od = __builtin_amdgcn_mfma_f32_32x32x16_bf16(pa1, PK(l1, h1), od, 0, 0, 0);
  od = __builtin_amdgcn_mfma_f32_32x32x16_bf16(pa2, PK(l2, h2), od, 0, 0, 0);
  od = __builtin_amdgcn_mfma_f32_32x32x16_bf16(pa3, PK(l3, h3), od, 0, 0, 0);
#undef PK
}
__device__ __forceinline__ void pv_d0(f32x16* o, int vb, bf16x8 pa0, bf16x8 pa1, bf16x8 pa2, bf16x8 pa3) {
  pv_one<0>(o[0], vb, pa0, pa1, pa2, pa3); pv_one<1>(o[1], vb, pa0, pa1, pa2, pa3); pv_one<2>(o[2], vb, pa0, pa1, pa2, pa3); pv_one<3>(o[3], vb, pa0, pa1, pa2, pa3);
}
__device__ __forceinline__ void cmask(f32x16& p0, f32x16& p1, int tile, int ql, int hi) {
  asm volatile("" : "+v"(ql));
#pragma unroll
  for (int r = 0; r < 16; ++r) { const int kv = 64 * tile + (r & 3) + 8 * (r >> 2) + 4 * hi; if (kv > ql) p0[r] = -1e30f; if (kv + 32 > ql) p1[r] = -1e30f; }
}
__device__ __forceinline__ void moba_unit(const bool OWN, const bf16* qrow, const bf16* __restrict__ Kh, const bf16* __restrict__ Vh, bf16* obase, int ostride, int dst, float* ml, int mli, int ql, char* lds) {
  const int tid = threadIdx.x, wid = tid >> 6, lane = tid & 63, r32 = lane & 31, hi = lane >> 5;
  bf16* V_lds = (bf16*)lds; bf16* K_lds = (bf16*)(lds + 2 * SHM_V);
  float* ws = (float*)(lds + 2 * SHM_V + 2 * SHM_K) + wid * 64; float* li_l = ws; float* al_l = ws + 32;
  float m_reg = -1e30f, l_reg = 0; f32x16 o[4] = {}; bf16x8 qr[8];
  const bf16* Qw = qrow + hi * 8;
#pragma unroll
  for (int d0 = 0; d0 < 8; ++d0) qr[d0] = *reinterpret_cast<const bf16x8*>(Qw + d0 * 16);
  const int sr = tid >> 4, sc = (tid & 15) * 8, vst0 = v_st(sr, sc), vst1 = v_st(32 + sr, sc);
  const int vb0 = (int)(uintptr_t)V_lds + v_rd_base(lane);
  struct { bf16x8 vs0, vs1, ks0, ks1; } sr_[2];
#define SLOAD(i, k0) do { sr_[i].vs0 = *reinterpret_cast<const bf16x8*>(&Vh[(long)((k0) + sr) * LDK + sc]); sr_[i].vs1 = *reinterpret_cast<const bf16x8*>(&Vh[(long)((k0) + 32 + sr) * LDK + sc]); \
    sr_[i].ks0 = *reinterpret_cast<const bf16x8*>(&Kh[(long)((k0) + sr) * LDK + sc]); sr_[i].ks1 = *reinterpret_cast<const bf16x8*>(&Kh[(long)((k0) + 32 + sr) * LDK + sc]); } while (0)
#define SWRITE(b, i) do { *(bf16x8*)((char*)V_lds + (b) * SHM_V + vst0) = sr_[i].vs0;          \
    *(bf16x8*)((char*)V_lds + (b) * SHM_V + vst1) = sr_[i].vs1; int kc = sc * 2;               \
    *(bf16x8*)((char*)K_lds + (b) * SHM_K + KSWZ(sr, kc)) = sr_[i].ks0;                       \
    *(bf16x8*)((char*)K_lds + (b) * SHM_K + KSWZ(32 + sr, kc)) = sr_[i].ks1; } while (0)
#define SWAIT() asm volatile("s_waitcnt vmcnt(4)" ::: "memory")
#define RESC(a) do { if (__any((a) < 1.f)) { if (hi == 0) al_l[r32] = (a); asm volatile("s_waitcnt lgkmcnt(0)" ::: "memory"); \
    _Pragma("unroll") for (int d = 0; d < 4; ++d) _Pragma("unroll") for (int r = 0; r < 16; ++r) o[d][r] *= al_l[crow(r, hi)]; } } while (0)
  f32x16 pA0, pA1, pB0, pB1; float mnA, mnB, alA, alB; bf16x8 pa0, pa1, pa2, pa3;
  constexpr int SE = 0, SO = 1;
  SLOAD(SE, 0); asm volatile("s_waitcnt vmcnt(0)" ::: "memory"); SWRITE(0, SE); __syncthreads();
  qkt(pA0, pA1, K_lds, qr, r32, hi); if (OWN) cmask(pA0, pA1, 0, ql, hi); partialSM(pA0, pA1, m_reg, mnA, alA);
  SLOAD(SO, KVBLK); SLOAD(SE, 2 * KVBLK);
  SWAIT(); SWRITE(1, SO); __syncthreads();
  {
    SBAR(); qkt(pB0, pB1, (bf16*)((char*)K_lds + SHM_K), qr, r32, hi);
    finishSM(pA0, pA1, alA, l_reg, pa0, pa1, pa2, pa3); SBAR();
    SLOAD(SO, 3 * KVBLK); SBAR();
    pv_d0(o, vb0, pa0, pa1, pa2, pa3); if (OWN) cmask(pB0, pB1, 1, ql, hi); partialSM(pB0, pB1, m_reg, mnB, alB);
    __syncthreads(); SWAIT(); SWRITE(0, SE);
    RESC(alB); __syncthreads();
    SBAR(); qkt(pA0, pA1, K_lds, qr, r32, hi);
    finishSM(pB0, pB1, alB, l_reg, pa0, pa1, pa2, pa3); SBAR();
    pv_d0(o, vb0 + (int)SHM_V, pa0, pa1, pa2, pa3); if (OWN) cmask(pA0, pA1, 2, ql, hi); partialSM(pA0, pA1, m_reg, mnA, alA);
    __syncthreads(); asm volatile("s_waitcnt vmcnt(0)" ::: "memory"); SWRITE(1, SO);
    RESC(alA); __syncthreads();
  }
  SBAR(); qkt(pB0, pB1, (bf16*)((char*)K_lds + SHM_K), qr, r32, hi);
  finishSM(pA0, pA1, alA, l_reg, pa0, pa1, pa2, pa3); SBAR();
  pv_d0(o, vb0, pa0, pa1, pa2, pa3); if (OWN) cmask(pB0, pB1, 3, ql, hi); partialSM(pB0, pB1, m_reg, mnB, alB);
  __syncthreads(); RESC(alB);
  finishSM(pB0, pB1, alB, l_reg, pa0, pa1, pa2, pa3); SBAR();
  pv_d0(o, vb0 + (int)SHM_V, pa0, pa1, pa2, pa3);
  if (hi == 0) li_l[r32] = l_reg; asm volatile("s_waitcnt lgkmcnt(0)" ::: "memory");
  float rli[16];
#pragma unroll
  for (int r = 0; r < 16; ++r) rli[r] = __builtin_amdgcn_rcpf(li_l[crow(r, hi)]);
  __syncthreads();
  bf16* stg = (bf16*)lds + wid * 4096;
#pragma unroll
  for (int r = 0; r < 16; ++r) { const int orow = crow(r, hi);
#pragma unroll
    for (int d0 = 0; d0 < 4; ++d0) stg[orow * 128 + d0 * 32 + r32] = __float2bfloat16(o[d0][r] * rli[r]); }
  int* dsto = (int*)al_l;
  if (hi == 0) dsto[r32] = dst;
  asm volatile("s_waitcnt lgkmcnt(0)" ::: "memory");
#pragma unroll
  for (int i = 0; i < 8; ++i) { const int row = i * 4 + (lane >> 4), ch = lane & 15; const int di = dsto[row]; const u32x4 v = *(const u32x4*)(stg + row * 128 + ch * 8);
    if (di >= 0) *(u32x4*)(obase + (size_t)di * ostride + ch * 8) = v; }
  if (hi == 0 && dst >= 0) { ml[2 * (size_t)mli] = m_reg; ml[2 * (size_t)mli + 1] = l_reg; }
  asm volatile("s_waitcnt lgkmcnt(0)" ::: "memory");
  __syncthreads();
#undef SLOAD
#undef SWRITE
#undef SWAIT
#undef RESC
}
#undef KSWZ
#undef SBAR
}
#define GAS __attribute__((address_space(1)))
#define LAS __attribute__((address_space(3)))
typedef unsigned short bf16;
typedef unsigned v4u __attribute__((ext_vector_type(4)));
typedef float f32x4 __attribute__((ext_vector_type(4)));
typedef short bf16x8 __attribute__((ext_vector_type(8)));
typedef GAS unsigned gu32;
typedef GAS unsigned long long gu64;
#define RLX_AGENT __ATOMIC_RELAXED, __HIP_MEMORY_SCOPE_AGENT
#define LDS_WAIT() asm volatile("s_waitcnt lgkmcnt(0)" ::: "memory")
#define VM_WAIT() asm volatile("s_waitcnt vmcnt(0)" ::: "memory")
__device__ __forceinline__ unsigned long long rt() { return __builtin_amdgcn_s_memrealtime(); }
__device__ __forceinline__ unsigned f2bf(float f) { unsigned u = __builtin_bit_cast(unsigned, f); return (u + 0x7fffu + ((u >> 16) & 1u)) >> 16; }
__device__ __forceinline__ unsigned pk2(float lo, float hi) { return f2bf(lo) | (f2bf(hi) << 16); }
#define XB_TMO      128
#define XB_XCNT(j)  (256  + 64 * (j))
#define XB_XSUB(j)  (1280 + 64 * (j))
#define XB_XGEN(j)  (2304 + 64 * (j))
#define XB_TOP      3328
#define XB_TOPGEN   3392
#define XCD_BAR_WORDS 3456
#define XB_SPIN_CAP (1u << 18)

__device__ __forceinline__ unsigned xb_ld(unsigned* p)              { return __hip_atomic_load(p, __ATOMIC_RELAXED, __HIP_MEMORY_SCOPE_AGENT); }
__device__ __forceinline__ unsigned xb_add(unsigned* p, unsigned v) { return __hip_atomic_fetch_add(p, v, __ATOMIC_RELAXED, __HIP_MEMORY_SCOPE_AGENT); }
__device__ __forceinline__ unsigned xb_xcc_id() { return (unsigned)__builtin_amdgcn_s_getreg((3 << 11) | 20) & 0xFu; }
#define XB_SPIN(cond, bar) do { unsigned _sp = 0; while (cond) { __builtin_amdgcn_s_sleep(1); \
    if ((++_sp & 255u) == 0u) { if (xb_ld(&(bar)[XB_TMO])) break; if (_sp > XB_SPIN_CAP) { atomicAdd(&(bar)[XB_TMO], 1u); break; } } } } while (0)

struct XcdBarrier {
    unsigned* bar; unsigned x;
    volatile LAS unsigned* st;
};

__device__ __forceinline__ XcdBarrier xcd_barrier_post(unsigned* bar, volatile LAS unsigned* st) {
    XcdBarrier b; b.bar = bar; b.x = xb_xcc_id(); b.st = st;
    if (threadIdx.x == 0) (void)xb_add(&bar[XB_XCNT(b.x)], 1u);
    return b;
}
__device__ __forceinline__ void xcd_barrier_complete(unsigned* bar, unsigned x, unsigned& nloc, unsigned& nx) {
    const unsigned G = gridDim.x * gridDim.y * gridDim.z;
    unsigned sum, cnt, mine, sp = 0u;
    for (;;) {
        sum = 0u; cnt = 0u; mine = 0u;
#pragma unroll
        for (unsigned j = 0; j < 16; ++j) { const unsigned c = xb_ld(&bar[XB_XCNT(j)]); sum += c; cnt += (c > 0u) ? 1u : 0u; mine = (j == x) ? c : mine; }
        if (sum == G) break;
        __builtin_amdgcn_s_sleep(1);
        if ((++sp & 255u) == 0u) { if (xb_ld(&bar[XB_TMO])) break; if (sp > XB_SPIN_CAP) { atomicAdd(&bar[XB_TMO], 1u); break; } }
    }
    nloc = mine > 0u ? mine : 1u; nx = cnt > 0u ? cnt : 1u;
}

__device__ __forceinline__ void xcd_barrier(const XcdBarrier& b) {
    asm volatile("s_waitcnt vmcnt(0)" ::: "memory");
    __syncthreads();
    if (threadIdx.x == 0) {
        unsigned* bar = b.bar;
        __builtin_amdgcn_s_waitcnt(0);
        unsigned nloc = b.st[0], nx = b.st[1];
        if (nloc == 0u) { xcd_barrier_complete(bar, b.x, nloc, nx); b.st[0] = nloc; b.st[1] = nx; }
        const unsigned old = xb_add(&bar[XB_XSUB(b.x)], 1u);
        const unsigned gen = old / nloc;
        if (old + 1u == (gen + 1u) * nloc) {
            __builtin_amdgcn_fence(__ATOMIC_RELEASE, "agent");
            asm volatile("s_waitcnt vmcnt(0)" ::: "memory");
            const unsigned og = xb_add(&bar[XB_TOP], 1u);
            const unsigned tg = og / nx;
            if (og + 1u == (tg + 1u) * nx) xb_add(&bar[XB_TOPGEN], 1u);
            else XB_SPIN(xb_ld(&bar[XB_TOPGEN]) == tg, bar);
            __builtin_amdgcn_fence(__ATOMIC_ACQUIRE, "agent");
            xb_add(&bar[XB_XGEN(b.x)], 1u);
            asm volatile("s_waitcnt vmcnt(0)" ::: "memory");
        } else {
            XB_SPIN(xb_ld(&bar[XB_XGEN(b.x)]) == gen, bar);
            __builtin_amdgcn_fence(__ATOMIC_ACQUIRE, "agent");
            asm volatile("s_waitcnt vmcnt(0)" ::: "memory");
        }
    }
    __syncthreads();
}

constexpr int NWAVES = 8;
#ifndef MK_PER_PHASE
#define MK_PER_PHASE 0
#endif
constexpr int BATCH = 4, SEQ = 8192, DM = 1024, TOK = BATCH * SEQ;
constexpr int FF0 = 2816, NEXP = 8, FF1 = 3584;
constexpr int NQKV = 3072;
constexpr int MB_H = 8, MB_NB = 32, MB_L = 256;
constexpr int SLOTS = TOK + NEXP * 256;
constexpr float NORM_EPS = 1e-6f, SUBLN_EPS = 1e-5f;
constexpr float LAMBDA_INIT0 = 0.2f;
constexpr float LOG2E = 1.4426950408889634f;
constexpr int LIST_PER_BH = 256 * 496;
__host__ __device__ constexpr int list_off(int j) { return 256 * (31 * j - (j * (j - 1)) / 2); }

constexpr size_t MiB = 1u << 20;
constexpr size_t WS_CTL = 0, CTL_ZERO_BYTES = 1 * MiB;
constexpr size_t WS_ROPE64 = 1 * MiB;
constexpr size_t WS_ROPE128 = WS_ROPE64 + 512 * 1024;
constexpr size_t WS_KMEAN = WS_ROPE128 + 1 * MiB;
constexpr size_t WS_TOK = 3 * MiB;
constexpr size_t WS_SLOT = 4 * MiB;
constexpr size_t WS_OWNML = 6 * MiB;
constexpr size_t WS_W0QKV = 8 * MiB, WS_W0O = 14 * MiB, WS_W013 = 16 * MiB, WS_W02 = 27 * MiB, WS_W1QKV = 33 * MiB, WS_W1O = 39 * MiB;
constexpr size_t B0 = 42 * MiB;
constexpr size_t WS_H = B0;
constexpr size_t WS_QKV = B0 + 64 * MiB;
constexpr size_t WS_OATT = B0 + 256 * MiB;
constexpr size_t WS_UD = B0 + 128 * MiB;
constexpr size_t WS_LIST = B0 + 256 * MiB;
constexpr size_t WS_PML = B0 + 272 * MiB;
constexpr size_t WS_PO = B0 + 280 * MiB;
constexpr size_t WS_WM13 = B0 + 64 * MiB;
constexpr size_t WS_WM2 = WS_WM13 + 112 * MiB;
constexpr size_t WS_UM = B0 + 232 * MiB;
constexpr size_t WS_END = WS_UM + (size_t)SLOTS * FF1 * 2;
static_assert(WS_PO + (size_t)TOK * MB_H * 3 * 128 * 2 <= WS_END + 8 * MiB && WS_END <= 528 * MiB, "d_ws map");
constexpr int CW_TMO = 0, CW_CODE = 1, CW_DBG = 2;
constexpr int CW_MOECNT = 64;
constexpr int CW_MOBACNT = 256;
constexpr int CW_BAR = 4096;
constexpr int RING_OFF = 0, RING_BYTES = 131072;
constexpr int LDSCTL_OFF = RING_BYTES, MISC_OFF = LDSCTL_OFF + 320;
constexpr int LDS_BYTES = 147456;

struct Args { const float* in[20]; float* out; unsigned char* ws; float inv64[8]; float inv128[16]; int ph_lo, ph_hi; };

__device__ __forceinline__ float wave_sum(float v) {
#pragma unroll
    for (int o = 1; o < 64; o <<= 1) v += __shfl_xor(v, o);
    return v;
}
template <int MAP> __device__ __forceinline__ int maprow(int n) {
    if (MAP == 1) { if (n >= 2048) return n; const int d = n & 63; if (d >= 16) return n; const int b = d >> 3, a = (d >> 2) & 1, c = d & 3; return (n & ~63) + 8 * a + 4 * b + c; }
    if (MAP == 2) { if (n >= 2048) return n; const int d = n & 127; if (d >= 32) return n; const int b = d >> 4, a = (d >> 2) & 3, c = d & 3; return (n & ~127) + 8 * a + 4 * b + c; }
    if (MAP == 3) return 256 * (n >> 7) + (n & 127);
    if (MAP == 4) return 256 * (n >> 7) + 128 + (n & 127);
    return n;
}
template <int MAP> __device__ __forceinline__ void transpose_item(const float* W, int K, int N, bf16* WT, LAS float* scr, int item, int lane) {
    const int nblk = N / 32, kb = item / nblk, nb = item % nblk, k0 = 64 * kb, n0 = 32 * nb;
#pragma unroll 8
    for (int i = 0; i < 32; ++i) { const int kk = 2 * i + (lane >> 5); scr[kk * 33 + (lane & 31)] = W[(size_t)(k0 + kk) * N + n0 + (lane & 31)]; }
    LDS_WAIT(); asm volatile("" ::: "memory");
    const int c = lane & 7;
#pragma unroll
    for (int j = 0; j < 4; ++j) { const int n = (lane >> 3) + 8 * j; const LAS float* s = scr + (8 * c) * 33 + n;
        v4u o; o.x = pk2(s[0 * 33], s[1 * 33]); o.y = pk2(s[2 * 33], s[3 * 33]); o.z = pk2(s[4 * 33], s[5 * 33]); o.w = pk2(s[6 * 33], s[7 * 33]);
        *(GAS v4u*)(WT + (size_t)maprow<MAP>(n0 + n) * K + k0 + 8 * c) = o; }
    LDS_WAIT(); asm volatile("" ::: "memory");
}
__device__ __forceinline__ void rms_row(const float* xrow, const f32x4 (&g)[4], f32x4 (&v)[4], int lane) {
    const GAS f32x4* xr = (const GAS f32x4*)xrow + lane; float s = 0.f;
#pragma unroll
    for (int j = 0; j < 4; ++j) { v[j] = xr[64 * j]; s += (v[j].x * v[j].x + v[j].y * v[j].y) + (v[j].z * v[j].z + v[j].w * v[j].w); }
    const float rstd = 1.f / sqrtf(wave_sum(s) * (1.f / DM) + NORM_EPS);
#pragma unroll
    for (int j = 0; j < 4; ++j) v[j] = v[j] * rstd * g[j];
}
__device__ __forceinline__ void store_row_bf16(bf16* orow, const f32x4 (&v)[4], int lane) {
    GAS unsigned long long* o8 = (GAS unsigned long long*)orow + lane;
#pragma unroll
    for (int j = 0; j < 4; ++j) o8[64 * j] = (unsigned long long)pk2(v[j].x, v[j].y) | ((unsigned long long)pk2(v[j].z, v[j].w) << 32);
}
__device__ __forceinline__ void load_gain(const float* g, f32x4 (&gv)[4], int lane) {
#pragma unroll
    for (int j = 0; j < 4; ++j) gv[j] = *((const f32x4*)g + lane + 64 * j);
}
__device__ __forceinline__ void rmsnorm_phase(const float* src, const float* gain, bf16* dst, int gw, int ngw, int lane) {
    f32x4 gv[4]; load_gain(gain, gv, lane);
    for (int m = gw; m < TOK; m += ngw) { f32x4 v[4]; rms_row(src + (size_t)m * DM, gv, v, lane); store_row_bf16(dst + (size_t)m * DM, v, lane); }
}
__device__ __forceinline__ float bf2f(unsigned short b) { return __uint_as_float((unsigned)b << 16); }

__global__ void __launch_bounds__(NWAVES * 64, 2) mk_fwd(Args args) {
    extern __shared__ __attribute__((aligned(16))) unsigned char lds[];
    LAS unsigned char* L = (LAS unsigned char*)lds;
    volatile LAS unsigned* MISC = (volatile LAS unsigned*)(L + MISC_OFF);
    const int tid = threadIdx.x, lane = tid & 63, wave = __builtin_amdgcn_readfirstlane(tid >> 6);
    const int G = gridDim.x; const int bx = blockIdx.x; const int vcu = (G % 8 == 0) ? (bx % 8) * (G / 8) + bx / 8 : bx;
    const int gw = vcu * NWAVES + wave, NGW = G * NWAVES;
    unsigned char* ws = args.ws;
    gu32* ctl = (gu32*)(ws + WS_CTL);
    float* out = args.out;
    const float* x = args.in[0]; const float* norm_mix = args.in[1]; const float* norm_ffn = args.in[2]; const float* final_norm = args.in[3];
    const float* da_wqkv = args.in[4]; const float* da_wo = args.in[5]; const float* da_lq1 = args.in[6]; const float* da_lk1 = args.in[7]; const float* da_lq2 = args.in[8]; const float* da_lk2 = args.in[9];
    const float* da_subln = args.in[10]; const float* mb_wqkv = args.in[11]; const float* mb_wo = args.in[12]; const float* ffn_w1 = args.in[13]; const float* ffn_w3 = args.in[14]; const float* ffn_w2 = args.in[15];
    const float* moe_router = args.in[16]; const float* moe_w1 = args.in[17]; const float* moe_w3 = args.in[18]; const float* moe_w2 = args.in[19];
    float* rope64 = (float*)(ws + WS_ROPE64); float* rope128 = (float*)(ws + WS_ROPE128); float* kmean = (float*)(ws + WS_KMEAN);
    int* tok_e = (int*)(ws + WS_TOK); int* tok_pos = tok_e + 2 * TOK; float* tok_gate = (float*)(tok_pos + 2 * TOK);
    int* slot_tok = (int*)(ws + WS_SLOT); float* slot_gate = (float*)(slot_tok + 2 * SLOTS);
    float* ownml = (float*)(ws + WS_OWNML);
    bf16* W0qkv = (bf16*)(ws + WS_W0QKV); bf16* W0o = (bf16*)(ws + WS_W0O); bf16* W013 = (bf16*)(ws + WS_W013); bf16* W02 = (bf16*)(ws + WS_W02); bf16* W1qkv = (bf16*)(ws + WS_W1QKV); bf16* W1o = (bf16*)(ws + WS_W1O);
    bf16* Hb = (bf16*)(ws + WS_H); bf16* QKV = (bf16*)(ws + WS_QKV); bf16* OATT = (bf16*)(ws + WS_OATT); bf16* UD = (bf16*)(ws + WS_UD);
    int* lists = (int*)(ws + WS_LIST); float* pml = (float*)(ws + WS_PML); bf16* PO = (bf16*)(ws + WS_PO);
    bf16* WM13 = (bf16*)(ws + WS_WM13); bf16* WM2 = (bf16*)(ws + WS_WM2); bf16* UM = (bf16*)(ws + WS_UM);

    for (int u = tid; u < (LDS_BYTES - LDSCTL_OFF) / 4; u += NWAVES * 64) ((LAS unsigned*)(L + LDSCTL_OFF))[u] = 0u;
    __syncthreads();
    XcdBarrier bar; bar.bar = (unsigned*)(ctl + CW_BAR); bar.x = 0; bar.st = nullptr;
    if (!MK_PER_PHASE) bar = xcd_barrier_post((unsigned*)(ctl + CW_BAR), MISC + 8);
#define GRID_BAR() do { if (!MK_PER_PHASE) xcd_barrier(bar); } while (0)
    const int lo = args.ph_lo, hi_ph = args.ph_hi;
#ifndef PH_MASK
#define PH_MASK 0xFFFFFFFFu
#endif
#define IN(k) (((PH_MASK >> (k)) & 1u) && lo <= (k) && (k) < hi_ph)
#define SEAM(k) do { if (IN((k) + 1)) GRID_BAR(); } while (0)

    if (IN(0)) {
        LAS float* scr = (LAS float*)(L + RING_OFF + wave * 16384);
        constexpr int I_QKV = (DM / 64) * (NQKV / 32), I_O = (DM / 64) * (DM / 32), I_13 = (DM / 64) * (FF0 / 32), I_2 = (FF0 / 64) * (DM / 32);
        constexpr int NITEMS = 2 * I_QKV + 2 * I_O + 2 * I_13 + I_2;
        for (int it = gw; it < NITEMS; it += NGW) {
            int r = it;
            if (r < I_QKV) { transpose_item<1>(da_wqkv, DM, NQKV, W0qkv, scr, r, lane); continue; } r -= I_QKV;
            if (r < I_QKV) { transpose_item<2>(mb_wqkv, DM, NQKV, W1qkv, scr, r, lane); continue; } r -= I_QKV;
            if (r < I_O) { transpose_item<0>(da_wo, DM, DM, W0o, scr, r, lane); continue; } r -= I_O;
            if (r < I_O) { transpose_item<0>(mb_wo, DM, DM, W1o, scr, r, lane); continue; } r -= I_O;
            if (r < I_13) { transpose_item<3>(ffn_w1, DM, FF0, W013, scr, r, lane); continue; } r -= I_13;
            if (r < I_13) { transpose_item<4>(ffn_w3, DM, FF0, W013, scr, r, lane); continue; } r -= I_13;
            transpose_item<0>(ffn_w2, FF0, DM, W02, scr, r, lane);
        }
        {
            const int gt = (vcu * NWAVES + wave) * 64 + lane, NT_ = G * NWAVES * 64;
            for (int e = gt; e < SEQ * 8; e += NT_) { const int pos = e >> 3, i = e & 7; const float ang = (float)pos * args.inv64[i]; rope64[e] = cosf(ang); rope64[SEQ * 8 + e] = sinf(ang); }
            for (int e = gt; e < SEQ * 16; e += NT_) { const int pos = e >> 4, i = e & 15; const float ang = (float)pos * args.inv128[i]; rope128[e] = cosf(ang); rope128[SEQ * 16 + e] = sinf(ang); }
        }
        rmsnorm_phase(x, norm_mix, Hb, gw, NGW, lane);
        SEAM(0);
    }
    if (IN(1)) {
        pg8::ABDense ab{Hb, W0qkv, DM}; pg8::TileOrder S; S.init(TOK / 256, NQKV / 256, G, bx);
        pg8::EpiQKV<64> E{QKV, NQKV, rope64, rope64 + SEQ * 8, 0.125f * LOG2E};
        pg8::gemm_phase<pg8::EpiQKV<64>, pg8::ABDense>(L + RING_OFF, ab, S, E);
        SEAM(1);
    }
    if (IN(2)) {
        const attn_body::StaticOrder AS(vcu, G);
        attn_body::attn_phase<attn_body::StaticOrder>((char*)lds + RING_OFF, (const attn_body::bf16*)QKV, (attn_body::bf16*)OATT, AS);
        SEAM(2);
    }
    if (IN(3)) {
        float lam;
        { const float a = wave_sum(da_lq1[lane] * da_lk1[lane]), b = wave_sum(da_lq2[lane] * da_lk2[lane]); lam = expf(a) - expf(b) + LAMBDA_INIT0; }
        const int hh = lane >> 3, dd = (lane & 7) * 16;
        float gsub[16];
#pragma unroll
        for (int k = 0; k < 16; ++k) gsub[k] = da_subln[dd + k] * (1.f - LAMBDA_INIT0);
        for (int m = gw; m < TOK; m += NGW) {
            const bf16* o1 = OATT + (size_t)m * 2048 + (2 * hh) * 128 + dd; const bf16* o2 = o1 + 128;
            const v4u a0 = *(const GAS v4u*)o1, a1 = *(const GAS v4u*)(o1 + 8), b0 = *(const GAS v4u*)o2, b1 = *(const GAS v4u*)(o2 + 8);
            float d[16]; float ss = 0.f;
#pragma unroll
            for (int k = 0; k < 4; ++k) {
                const unsigned ua = a0[k], ub = b0[k], uc = a1[k], ud = b1[k];
                d[2 * k] = __uint_as_float(ua << 16) - lam * __uint_as_float(ub << 16); d[2 * k + 1] = __uint_as_float(ua & 0xffff0000u) - lam * __uint_as_float(ub & 0xffff0000u);
                d[8 + 2 * k] = __uint_as_float(uc << 16) - lam * __uint_as_float(ud << 16); d[8 + 2 * k + 1] = __uint_as_float(uc & 0xffff0000u) - lam * __uint_as_float(ud & 0xffff0000u); }
#pragma unroll
            for (int k = 0; k < 16; ++k) ss += d[k] * d[k];
            ss += __shfl_xor(ss, 1); ss += __shfl_xor(ss, 2); ss += __shfl_xor(ss, 4);
            const float rstd = 1.f / sqrtf(ss * (1.f / 128.f) + SUBLN_EPS);
            v4u w0, w1;
#pragma unroll
            for (int k = 0; k < 4; ++k) { w0[k] = pk2(d[2 * k] * rstd * gsub[2 * k], d[2 * k + 1] * rstd * gsub[2 * k + 1]); w1[k] = pk2(d[8 + 2 * k] * rstd * gsub[8 + 2 * k], d[8 + 2 * k + 1] * rstd * gsub[8 + 2 * k + 1]); }
            bf16* od = Hb + (size_t)m * DM + hh * 128 + dd;
            *(GAS v4u*)od = w0; *(GAS v4u*)(od + 8) = w1;
        }
        SEAM(3);
    }
    if (IN(4)) {
        pg8::ABDense ab{Hb, W0o, DM}; pg8::TileOrder S; S.init(TOK / 256, DM / 256, G, bx);
        pg8::EpiRes E{x, out, DM, nullptr};
        pg8::gemm_phase<pg8::EpiRes, pg8::ABDense>(L + RING_OFF, ab, S, E);
        SEAM(4);
    }
    if (IN(5)) { rmsnorm_phase(out, norm_ffn, QKV, gw, NGW, lane); SEAM(5); }
    if (IN(6)) {
        pg8::ABDense ab{QKV, W013, DM}; pg8::TileOrder S; S.init(TOK / 256, (2 * FF0) / 256, G, bx);
        pg8::EpiSwiGLU E{UD, FF0, nullptr};
        pg8::gemm_phase<pg8::EpiSwiGLU, pg8::ABDense>(L + RING_OFF, ab, S, E);
        SEAM(6);
    }
    if (IN(7)) {
        pg8::ABDense ab{UD, W02, FF0}; pg8::TileOrder S; S.init(TOK / 256, DM / 256, G, bx);
        pg8::EpiRes E{out, out, DM, nullptr};
        pg8::gemm_phase<pg8::EpiRes, pg8::ABDense>(L + RING_OFF, ab, S, E);
        SEAM(7);
    }
    if (IN(8)) { rmsnorm_phase(out, norm_mix + DM, Hb, gw, NGW, lane); SEAM(8); }
    if (IN(9)) {
        pg8::ABDense ab{Hb, W1qkv, DM}; pg8::TileOrder S; S.init(TOK / 256, NQKV / 256, G, bx);
        pg8::EpiQKV<128> E{QKV, NQKV, rope128, rope128 + SEQ * 16, 0.08838834764831845f * LOG2E};
        pg8::gemm_phase<pg8::EpiQKV<128>, pg8::ABDense>(L + RING_OFF, ab, S, E);
        SEAM(9);
    }
    if (IN(10)) {
        LAS float* red = (LAS float*)(L + RING_OFF);
        for (int u = vcu; u < BATCH * MB_H * MB_NB; u += G) {
            const int b = u >> 8, h = (u >> 5) & 7, j = u & 31;
            const int dch = tid & 15, kg = tid >> 4;
            const bf16* kp = QKV + (size_t)(b * SEQ + j * MB_L + kg * 8) * NQKV + 1024 + h * 128 + dch * 8;
            float s[8] = {0.f, 0.f, 0.f, 0.f, 0.f, 0.f, 0.f, 0.f};
#pragma unroll
            for (int k = 0; k < 8; ++k) { const v4u v = *(const GAS v4u*)(kp + (size_t)k * NQKV);
#pragma unroll
                for (int q = 0; q < 4; ++q) { s[2 * q] += __uint_as_float(v[q] << 16); s[2 * q + 1] += __uint_as_float(v[q] & 0xffff0000u); } }
#pragma unroll
            for (int q = 0; q < 8; ++q) red[kg * 128 + dch * 8 + q] = s[q];
            __syncthreads();
            if (tid < 128) { float a = 0.f;
#pragma unroll 8
                for (int k = 0; k < 32; ++k) a += red[k * 128 + tid];
                kmean[(size_t)u * 128 + tid] = a * (1.f / 256.f); }
            __syncthreads();
        }
        SEAM(10);
    }
    if (IN(11)) {
        LAS float* km = (LAS float*)(L + RING_OFF);
        LAS float* mv = (LAS float*)(L + RING_OFF + 16384);
        LAS int* mi = (LAS int*)(L + RING_OFF + 16384 + 3072);
        LAS int* lcnt = (LAS int*)(L + RING_OFF + 24576);
        for (int u = vcu; u < BATCH * MB_H * (MB_NB - 1); u += G) {
            const int bh = u / 31, o = 1 + u % 31, b = bh >> 3, h = bh & 7;
            for (int e = tid; e < 32 * 128; e += 512) km[e] = kmean[(size_t)bh * 4096 + e];
            if (tid < 32) lcnt[tid] = 0;
            __syncthreads();
            const int ql = tid & 255, half = tid >> 8; const int s = o * 256 + ql;
            const bf16* qp = QKV + (size_t)(b * SEQ + s) * NQKV + h * 128;
            float qf[128];
#pragma unroll
            for (int c = 0; c < 16; ++c) { const v4u v = *(const GAS v4u*)(qp + c * 8);
#pragma unroll
                for (int q = 0; q < 4; ++q) { qf[c * 8 + 2 * q] = __uint_as_float(v[q] << 16); qf[c * 8 + 2 * q + 1] = __uint_as_float(v[q] & 0xffff0000u); } }
            float v0 = -INFINITY, v1 = -INFINITY, v2 = -INFINITY; int i0 = -1, i1 = -1, i2 = -1;
            for (int jj = 0; jj < 16; ++jj) { const int j = half * 16 + jj;
                if (j < o) { float g = 0.f; const LAS f32x4* kr = (const LAS f32x4*)(km + j * 128);
#pragma unroll
                    for (int c = 0; c < 32; ++c) { const f32x4 kv = kr[c]; g += qf[4 * c] * kv.x + qf[4 * c + 1] * kv.y + qf[4 * c + 2] * kv.z + qf[4 * c + 3] * kv.w; }
                    if (g > v0) { v2 = v1; i2 = i1; v1 = v0; i1 = i0; v0 = g; i0 = j; } else if (g > v1) { v2 = v1; i2 = i1; v1 = g; i1 = j; } else if (g > v2) { v2 = g; i2 = j; } } }
            if (half == 1) { mv[ql * 3] = v0; mv[ql * 3 + 1] = v1; mv[ql * 3 + 2] = v2; mi[ql * 3] = i0; mi[ql * 3 + 1] = i1; mi[ql * 3 + 2] = i2; }
            __syncthreads();
            int lp0 = 0, lp1 = 0, lp2 = 0;
            if (half == 0) {
#pragma unroll
                for (int k = 0; k < 3; ++k) { const float g = mv[ql * 3 + k]; const int j = mi[ql * 3 + k];
                    if (j >= 0) { if (g > v0) { v2 = v1; i2 = i1; v1 = v0; i1 = i0; v0 = g; i0 = j; } else if (g > v1) { v2 = v1; i2 = i1; v1 = g; i1 = j; } else if (g > v2) { v2 = g; i2 = j; } } }
                if (i0 >= 0) lp0 = __hip_atomic_fetch_add(&lcnt[i0], 1, __ATOMIC_RELAXED, __HIP_MEMORY_SCOPE_WORKGROUP);
                if (i1 >= 0) lp1 = __hip_atomic_fetch_add(&lcnt[i1], 1, __ATOMIC_RELAXED, __HIP_MEMORY_SCOPE_WORKGROUP);
                if (i2 >= 0) lp2 = __hip_atomic_fetch_add(&lcnt[i2], 1, __ATOMIC_RELAXED, __HIP_MEMORY_SCOPE_WORKGROUP);
            }
            __syncthreads();
            if (tid < 32) { const int n = lcnt[tid]; lcnt[32 + tid] = n ? (int)__hip_atomic_fetch_add(ctl + CW_MOBACNT + bh * 32 + tid, (unsigned)n, RLX_AGENT) : 0; }
            __syncthreads();
            if (half == 0) { int* lb = lists + (size_t)bh * LIST_PER_BH;
                if (i0 >= 0) lb[list_off(i0) + lcnt[32 + i0] + lp0] = s;
                if (i1 >= 0) lb[list_off(i1) + lcnt[32 + i1] + lp1] = s | (1 << 16);
                if (i2 >= 0) lb[list_off(i2) + lcnt[32 + i2] + lp2] = s | (2 << 16); }
            __syncthreads();
        }
        SEAM(11);
    }
    if (IN(12)) {
        LAS int* pre = (LAS int*)(L + 102400);
        { const unsigned c0 = __hip_atomic_load(ctl + CW_MOBACNT + tid, RLX_AGENT), c1 = __hip_atomic_load(ctl + CW_MOBACNT + 512 + tid, RLX_AGENT);
          pre[tid] = (int)((c0 + 255u) >> 8); pre[512 + tid] = (int)((c1 + 255u) >> 8); }
        __syncthreads();
        if (tid == 0) { int a = 0; for (int k = 0; k < 1024; ++k) { const int n = pre[k]; pre[k] = a; a += n; } pre[1024] = a; }
        __syncthreads();
        const int nlist = pre[1024], ntot = 1024 + nlist;
        const int wl = wave * 32 + (lane & 31);
        for (int u = vcu; u < ntot; u += G) {
            const bool own = u < 1024;
            int b, h, kb, s, dst, mli, ostride; moba::bf16* obase; float* mlp;
            if (own) {
                b = u >> 8; h = (u >> 5) & 7; kb = u & 31; s = kb * 256 + wl; dst = b * SEQ + s; mli = (b * 8 + h) * SEQ + s; ostride = DM; obase = (moba::bf16*)Hb + h * 128; mlp = ownml;
            } else {
                const int lu = u - 1024; int loI = 0, hiI = 1024;
                while (hiI - loI > 1) { const int mid = (loI + hiI) >> 1; if (pre[mid] <= lu) loI = mid; else hiI = mid; }
                const int bhj = loI, chunk = lu - pre[bhj], bh = bhj >> 5; kb = bhj & 31; b = bh >> 3; h = bh & 7;
                const int cnt = (int)__hip_atomic_load(ctl + CW_MOBACNT + bhj, RLX_AGENT);
                const int ei = chunk * 256 + wl; const bool valid = ei < cnt;
                const int ent = valid ? lists[(size_t)bh * LIST_PER_BH + list_off(kb) + ei] : 0;
                s = ent & 0xffff; mli = (bh * SEQ + s) * 3 + (ent >> 16); dst = valid ? mli : -1; ostride = 128; obase = (moba::bf16*)PO; mlp = pml;
            }
            const moba::bf16* qrow = (const moba::bf16*)QKV + ((size_t)b * SEQ + s) * NQKV + h * 128;
            const moba::bf16* Kh = (const moba::bf16*)QKV + ((size_t)b * SEQ + kb * 256) * NQKV + 1024 + h * 128;
            moba::moba_unit(own, qrow, Kh, Kh + 1024, obase, ostride, dst, mlp, mli, wl, (char*)lds);
        }
        SEAM(12);
    }
    if (IN(13)) {
        const int hh = lane >> 3, dd = (lane & 7) * 16;
        for (int m = gw; m < TOK; m += NGW) {
            const int b = m >> 13, s = m & 8191, nv = (s >> 8) < 3 ? (s >> 8) : 3; const int qi = (b * 8 + hh) * SEQ + s;
            float mm[4], ll[4]; mm[0] = ownml[2 * (size_t)qi]; ll[0] = ownml[2 * (size_t)qi + 1]; float M = mm[0];
#pragma unroll
            for (int r = 0; r < 3; ++r) { if (r < nv) { mm[1 + r] = pml[2 * ((size_t)qi * 3 + r)]; ll[1 + r] = pml[2 * ((size_t)qi * 3 + r) + 1]; M = fmaxf(M, mm[1 + r]); } else { mm[1 + r] = -1e30f; ll[1 + r] = 0.f; } }
            float w[4], wsum = 0.f;
#pragma unroll
            for (int r = 0; r < 4; ++r) { w[r] = ll[r] * __builtin_amdgcn_exp2f(mm[r] - M); wsum += w[r]; }
            const float inv = 1.f / wsum;
            float acc16[16];
            bf16* op = Hb + (size_t)m * DM + hh * 128 + dd;
            { const v4u a0 = *(const GAS v4u*)op, a1 = *(const GAS v4u*)(op + 8); const float ww = w[0] * inv;
#pragma unroll
              for (int k = 0; k < 4; ++k) { acc16[2 * k] = ww * __uint_as_float(a0[k] << 16); acc16[2 * k + 1] = ww * __uint_as_float(a0[k] & 0xffff0000u); acc16[8 + 2 * k] = ww * __uint_as_float(a1[k] << 16); acc16[8 + 2 * k + 1] = ww * __uint_as_float(a1[k] & 0xffff0000u); } }
#pragma unroll
            for (int r = 0; r < 3; ++r) if (r < nv) { const bf16* pp = PO + ((size_t)qi * 3 + r) * 128 + dd; const v4u a0 = *(const GAS v4u*)pp, a1 = *(const GAS v4u*)(pp + 8); const float ww = w[1 + r] * inv;
#pragma unroll
                for (int k = 0; k < 4; ++k) { acc16[2 * k] += ww * __uint_as_float(a0[k] << 16); acc16[2 * k + 1] += ww * __uint_as_float(a0[k] & 0xffff0000u); acc16[8 + 2 * k] += ww * __uint_as_float(a1[k] << 16); acc16[8 + 2 * k + 1] += ww * __uint_as_float(a1[k] & 0xffff0000u); } }
            v4u w0, w1;
#pragma unroll
            for (int k = 0; k < 4; ++k) { w0[k] = pk2(acc16[2 * k], acc16[2 * k + 1]); w1[k] = pk2(acc16[8 + 2 * k], acc16[8 + 2 * k + 1]); }
            *(GAS v4u*)op = w0; *(GAS v4u*)(op + 8) = w1;
        }
        SEAM(13);
    }
    if (IN(14)) {
        pg8::ABDense ab{Hb, W1o, DM}; pg8::TileOrder S; S.init(TOK / 256, DM / 256, G, bx);
        pg8::EpiRes E{out, out, DM, nullptr};
        pg8::gemm_phase<pg8::EpiRes, pg8::ABDense>(L + RING_OFF, ab, S, E);
        SEAM(14);
    }
    if (IN(15)) {
        {
            const int gt = (vcu * NWAVES + wave) * 64 + lane, NT_ = G * NWAVES * 64;
            for (int e = gt; e < 2 * SLOTS; e += NT_) { slot_tok[e] = -1; slot_gate[e] = 0.f; }
        }
        {
            f32x4 gv[4]; load_gain(norm_ffn + DM, gv, lane);
            float wr_[16][8];
#pragma unroll
            for (int j = 0; j < 4; ++j)
#pragma unroll
                for (int q = 0; q < 4; ++q) { const int k = 4 * lane + 256 * j + q; const f32x4 a = *(const GAS f32x4*)(moe_router + (size_t)k * 8), c = *(const GAS f32x4*)(moe_router + (size_t)k * 8 + 4);
                    wr_[4 * j + q][0] = a.x; wr_[4 * j + q][1] = a.y; wr_[4 * j + q][2] = a.z; wr_[4 * j + q][3] = a.w; wr_[4 * j + q][4] = c.x; wr_[4 * j + q][5] = c.y; wr_[4 * j + q][6] = c.z; wr_[4 * j + q][7] = c.w; }
            for (int m = gw; m < TOK; m += NGW) {
                f32x4 v[4]; rms_row(out + (size_t)m * DM, gv, v, lane); store_row_bf16(Hb + (size_t)m * DM, v, lane);
                float lg[8];
#pragma unroll
                for (int e = 0; e < 8; ++e) { float a = 0.f;
#pragma unroll
                    for (int j = 0; j < 4; ++j) a += v[j].x * wr_[4 * j][e] + v[j].y * wr_[4 * j + 1][e] + v[j].z * wr_[4 * j + 2][e] + v[j].w * wr_[4 * j + 3][e];
                    lg[e] = wave_sum(a); }
                int e0 = 0; float l0 = lg[0];
#pragma unroll
                for (int e = 1; e < 8; ++e) if (lg[e] > l0) { l0 = lg[e]; e0 = e; }
                int e1 = -1; float l1 = -INFINITY;
#pragma unroll
                for (int e = 0; e < 8; ++e) if (e != e0 && lg[e] > l1) { l1 = lg[e]; e1 = e; }
                if (lane == 0) {
                    const float g0 = 1.f / (1.f + expf(l1 - l0)), g1 = 1.f - g0;
                    const int p0 = (int)__hip_atomic_fetch_add(ctl + CW_MOECNT + e0, 1u, RLX_AGENT), p1 = (int)__hip_atomic_fetch_add(ctl + CW_MOECNT + 8 + e1, 1u, RLX_AGENT);
                    tok_e[m] = e0; tok_e[TOK + m] = e1; tok_pos[m] = p0; tok_pos[TOK + m] = p1; tok_gate[m] = g0; tok_gate[TOK + m] = g1;
                }
            }
        }
        {
            LAS float* scr = (LAS float*)(L + RING_OFF + wave * 16384);
            constexpr int I_1 = (DM / 64) * (FF1 / 32), I_2 = (FF1 / 64) * (DM / 32), PER_E = 2 * I_1 + I_2;
            for (int it = gw; it < NEXP * PER_E; it += NGW) {
                const int e = it / PER_E; int r = it % PER_E;
                if (r < I_1) { transpose_item<3>(moe_w1 + (size_t)e * DM * FF1, DM, FF1, WM13 + (size_t)e * 2 * FF1 * DM, scr, r, lane); continue; } r -= I_1;
                if (r < I_1) { transpose_item<4>(moe_w3 + (size_t)e * DM * FF1, DM, FF1, WM13 + (size_t)e * 2 * FF1 * DM, scr, r, lane); continue; } r -= I_1;
                transpose_item<0>(moe_w2 + (size_t)e * FF1 * DM, FF1, DM, WM2 + (size_t)e * DM * FF1, scr, r, lane);
            }
        }
        SEAM(15);
    }
#define MOE_CUM() do { if (tid < 2) { int a = 0; for (int e = 0; e < 8; ++e) { MISC[16 + 9 * tid + e] = (unsigned)a; a += (int)((__hip_atomic_load(ctl + CW_MOECNT + 8 * tid + e, RLX_AGENT) + 255u) >> 8); } MISC[16 + 9 * tid + 8] = (unsigned)a; } __syncthreads(); } while (0)
    if (IN(16)) {
        MOE_CUM();
        const int gt = (vcu * NWAVES + wave) * 64 + lane, NT_ = G * NWAVES * 64;
        for (int e = gt; e < 2 * TOK; e += NT_) { const int r = e >= TOK ? 1 : 0; const int ex = tok_e[e]; const int slot = (int)MISC[16 + 9 * r + ex] * 256 + tok_pos[e];
            slot_tok[r * SLOTS + slot] = e - r * TOK; slot_gate[r * SLOTS + slot] = tok_gate[e]; }
        SEAM(16);
    }
#define MOE_UP(r) do { MOE_CUM(); \
        pg8::ABMoeUp ab{Hb, WM13, DM, slot_tok + (r) * SLOTS, (const LAS int*)(L + MISC_OFF + 4 * (16 + 9 * (r))), (size_t)2 * FF1 * DM}; \
        pg8::TileOrder S; S.init((int)MISC[16 + 9 * (r) + 8], (2 * FF1) / 256, G, bx); \
        pg8::EpiSwiGLU E{UM, FF1, slot_gate + (r) * SLOTS}; \
        pg8::gemm_phase<pg8::EpiSwiGLU, pg8::ABMoeUp>(L + RING_OFF, ab, S, E); } while (0)
#define MOE_DOWN(r) do { MOE_CUM(); \
        pg8::ABMoeDown ab{UM, WM2, FF1, (const LAS int*)(L + MISC_OFF + 4 * (16 + 9 * (r))), (size_t)DM * FF1}; \
        pg8::TileOrder S; S.init((int)MISC[16 + 9 * (r) + 8], DM / 256, G, bx); \
        pg8::EpiRes E{out, out, DM, slot_tok + (r) * SLOTS}; \
        pg8::gemm_phase<pg8::EpiRes, pg8::ABMoeDown>(L + RING_OFF, ab, S, E); } while (0)
    if (IN(17)) { MOE_UP(0); SEAM(17); }
    if (IN(18)) { MOE_DOWN(0); SEAM(18); }
    if (IN(19)) { MOE_UP(1); SEAM(19); }
    if (IN(20)) { MOE_DOWN(1); SEAM(20); }
    if (IN(21)) {
        f32x4 gv[4]; load_gain(final_norm, gv, lane);
        for (int m = gw; m < TOK; m += NGW) { f32x4 v[4]; rms_row(out + (size_t)m * DM, gv, v, lane);
            GAS f32x4* o = (GAS f32x4*)(out + (size_t)m * DM) + lane;
#pragma unroll
            for (int j = 0; j < 4; ++j) o[64 * j] = v[j]; }
    }
#undef IN
#undef SEAM
#undef GRID_BAR
}
constexpr int N_PHASES = 22;

extern "C" void kernel_launch(void* const* d_in, const int* in_sizes, int n_in, void* d_out, int out_size, void* d_ws, size_t ws_size, hipStream_t stream) {
    static int grid = 0;
    if (grid == 0) {
        if (n_in != 20 || in_sizes[0] != TOK * DM || out_size != TOK * DM || ws_size < WS_END) { fprintf(stderr, "kernel_launch: shape / workspace mismatch (n_in %d, in0 %d, out %d, ws %zu, need %zu); nothing launched\n", n_in, n_in > 0 ? in_sizes[0] : -1, out_size, ws_size, (size_t)WS_END); grid = -1; return; }
        int dev = 0, cus = 0, per_cu = 0;
        if (hipGetDevice(&dev) != hipSuccess || hipDeviceGetAttribute(&cus, hipDeviceAttributeMultiprocessorCount, dev) != hipSuccess) { grid = -1; return; }
        if (hipFuncSetAttribute((const void*)mk_fwd, hipFuncAttributeMaxDynamicSharedMemorySize, LDS_BYTES) != hipSuccess) { fprintf(stderr, "kernel_launch: hipFuncSetAttribute failed\n"); grid = -1; return; }
        if (hipOccupancyMaxActiveBlocksPerMultiprocessor(&per_cu, (const void*)mk_fwd, NWAVES * 64, LDS_BYTES) != hipSuccess || per_cu < 1) fprintf(stderr, "kernel_launch: occupancy query reports %d workgroups per CU\n", per_cu);
        (void)hipGetLastError();
        grid = cus;
    }
    if (grid < 0) return;
    if (hipMemsetAsync((char*)d_ws + WS_CTL, 0, CTL_ZERO_BYTES, stream) != hipSuccess) return;
    Args a{};
    for (int i = 0; i < 20; ++i) a.in[i] = (const float*)d_in[i];
    a.out = (float*)d_out; a.ws = (unsigned char*)d_ws;
    for (int i = 0; i < 8; ++i) a.inv64[i] = (float)pow(500000.0, -(double)(2 * i) / 16.0);
    for (int i = 0; i < 16; ++i) a.inv128[i] = (float)pow(500000.0, -(double)(2 * i) / 32.0);
#if MK_PER_PHASE
    for (int p = 0; p < N_PHASES; ++p) { a.ph_lo = p; a.ph_hi = p + 1; hipLaunchKernelGGL(mk_fwd, dim3(grid), dim3(NWAVES * 64), LDS_BYTES, stream, a); }
#else
    a.ph_lo = 0; a.ph_hi = N_PHASES;
    hipLaunchKernelGGL(mk_fwd, dim3(grid), dim3(NWAVES * 64), LDS_BYTES, stream, a);
#endif
    const hipError_t le = hipPeekAtLastError();
    if (le != hipSuccess) fprintf(stderr, "kernel_launch: launch failed: %s\n", hipGetErrorName(le));
}
```

```cpp
#include <hip/hip_runtime.h>
#include <hip/hip_bf16.h>
#include <cstdio>
#include <cstdint>
#include <cmath>
namespace pg8 {
#define PG8_LAS __attribute__((address_space(3)))
typedef unsigned short bf16_t;
typedef short bf16x8 __attribute__((ext_vector_type(8)));
typedef float f32x4 __attribute__((ext_vector_type(4)));
typedef unsigned u32x4 __attribute__((ext_vector_type(4)));
constexpr int BM = 256, BK = 64, HALF = 128, HTB = HALF * BK * 2  , STAGE_BYTES = 8 * HTB, NXCD = 8, WGM = 8;

__host__ __device__ __forceinline__ int lds_byte(int r, int c) { const int st = (r >> 4) * 2 + (c >> 5), rr = r & 15, cc = c & 31, ob = rr * 64 + cc * 2; return st * 1024 + (ob ^ (((ob >> 9) & 1) << 5)); }
__host__ __device__ __forceinline__ void stage_rc(int b, int& R, int& C) { const int st = b / 1024, sb = b % 1024, swz = sb ^ (((sb >> 9) & 1) << 5); R = (st >> 1) * 16 + swz / 64; C = (st & 1) * 32 + (swz % 64) / 2; }
__host__ __device__ __forceinline__ int perm32(int rho) { const int n = rho >> 4, i = rho & 15; return 8 * (i >> 2) + 4 * n + (i & 3); }

struct Unit { int pm, pn; };

struct TileOrder {
    int nM, nN, nwg, G, c;
    __device__ __forceinline__ void init(int nM_, int nN_, int G_, int c_) { nM = nM_; nN = nN_; nwg = nM * nN; G = G_; c = c_; }
    __device__ __forceinline__ bool next(int i, Unit& u) const {
        const long L = (long)i * G + c; if (L >= nwg) return false;
        int wgid = (int)L; { const int q = nwg / NXCD, r = nwg % NXCD, xcd = wgid % NXCD, off = wgid / NXCD; wgid = (xcd < r ? xcd * (q + 1) : r * (q + 1) + (xcd - r) * q) + off; }
        const int nig = WGM * nN, gid = wgid / nig, fm = gid * WGM, gsz = (nM - fm) < WGM ? (nM - fm) : WGM;
        u.pm = fm + ((wgid % nig) % gsz); u.pn = (wgid % nig) / gsz; return true;
    }
};

struct ABDense {
    static constexpr bool GATHER = false;
    const bf16_t* A; const bf16_t* Bt; int K;
    __device__ __forceinline__ const char* abase(const Unit& u) const { return (const char*)A + (size_t)u.pm * BM * K * 2; }
    __device__ __forceinline__ const char* bbase(const Unit& u) const { return (const char*)Bt + (size_t)u.pn * BM * K * 2; }
    __device__ __forceinline__ const int* tokp(const Unit&) const { return nullptr; }
};
struct ABMoeUp {
    static constexpr bool GATHER = true;
    const bf16_t* A; const bf16_t* Bt; int K; const int* slot_tok; const PG8_LAS int* cum; size_t estride;
    __device__ __forceinline__ int expert(int pm) const { int e = 0;
#pragma unroll
        for (int k = 1; k < 8; ++k) e += (pm >= cum[k]) ? 1 : 0; return e; }
    __device__ __forceinline__ const char* abase(const Unit&) const { return (const char*)A; }
    __device__ __forceinline__ const char* bbase(const Unit& u) const { return (const char*)(Bt + (size_t)expert(u.pm) * estride) + (size_t)u.pn * BM * K * 2; }
    __device__ __forceinline__ const int* tokp(const Unit& u) const { return slot_tok + u.pm * BM; }
};
struct ABMoeDown {
    static constexpr bool GATHER = false;
    const bf16_t* A; const bf16_t* Bt; int K; const PG8_LAS int* cum; size_t estride;
    __device__ __forceinline__ int expert(int pm) const { int e = 0;
#pragma unroll
        for (int k = 1; k < 8; ++k) e += (pm >= cum[k]) ? 1 : 0; return e; }
    __device__ __forceinline__ const char* abase(const Unit& u) const { return (const char*)A + (size_t)u.pm * BM * K * 2; }
    __device__ __forceinline__ const char* bbase(const Unit& u) const { return (const char*)(Bt + (size_t)expert(u.pm) * estride) + (size_t)u.pn * BM * K * 2; }
    __device__ __forceinline__ const int* tokp(const Unit&) const { return nullptr; }
};

__device__ __forceinline__ unsigned cvt_pk_bf16(float lo, float hi) { unsigned r; asm volatile("v_cvt_pk_bf16_f32 %0, %1, %2" : "=v"(r) : "v"(lo), "v"(hi)); return r; }

template <int DH> struct EpiQKV {
    static constexpr bool PERM = true;
    bf16_t* O; int ldc; const float* ct; const float* st; float qscale;
    __device__ __forceinline__ void operator()(const f32x4 (&acc)[2][2][4][2], const Unit& u, int wr, int wc, int fr, int fq) const {
        constexpr int NF = DH / 8;
        const int row0 = u.pm * BM + wr * 64 + fr, col0 = u.pn * BM + wc * 32 + 8 * fq;
        const int sect = u.pn >> 2;
        const float sc = (sect == 0) ? qscale : 1.f;
        const bool rot = (sect < 2) && (DH == 64 ? (((wc & 1) == 0) && (fq < 2)) : (wc == 0));
#pragma unroll
        for (int ai = 0; ai < 2; ++ai)
#pragma unroll
            for (int m = 0; m < 4; ++m) {
                const int row = row0 + ai * HALF + m * 16; const int pos = row & 8191;
                f32x4 c4 = (f32x4){1.f, 1.f, 1.f, 1.f}, s4 = (f32x4){0.f, 0.f, 0.f, 0.f};
                if (rot) { c4 = *(const f32x4*)(ct + pos * NF + 4 * fq); s4 = *(const f32x4*)(st + pos * NF + 4 * fq); }
                bf16_t* rowp = O + (size_t)row * ldc + col0;
#pragma unroll
                for (int bj = 0; bj < 2; ++bj) {
                    const f32x4 x1 = acc[ai][bj][m][0], x2 = acc[ai][bj][m][1];
                    f32x4 v0 = (x1 * c4 - x2 * s4) * sc, v1 = (x2 * c4 + x1 * s4) * sc;
                    u32x4 w; w.x = cvt_pk_bf16(v0[0], v0[1]); w.y = cvt_pk_bf16(v0[2], v0[3]); w.z = cvt_pk_bf16(v1[0], v1[1]); w.w = cvt_pk_bf16(v1[2], v1[3]);
                    *(u32x4*)(rowp + bj * HALF) = w; }
            }
    }
};

__device__ __forceinline__ float silu_mul(float a, float b) { return a * b * __builtin_amdgcn_rcpf(1.0f + __builtin_amdgcn_exp2f(-1.4426950408889634f * a)); }
struct EpiSwiGLU {
    static constexpr bool PERM = true;
    bf16_t* O; int ldc; const float* gate;
    __device__ __forceinline__ void operator()(const f32x4 (&acc)[2][2][4][2], const Unit& u, int wr, int wc, int fr, int fq) const {
        const int row0 = u.pm * BM + wr * 64 + fr, col0 = u.pn * HALF + wc * 32 + 8 * fq;
#pragma unroll
        for (int ai = 0; ai < 2; ++ai)
#pragma unroll
            for (int m = 0; m < 4; ++m) {
                const int row = row0 + ai * HALF + m * 16; const float g = gate ? gate[row] : 1.f;
                const f32x4 a0 = acc[ai][0][m][0], a1 = acc[ai][0][m][1], b0 = acc[ai][1][m][0], b1 = acc[ai][1][m][1];
                float v[8];
#pragma unroll
                for (int k = 0; k < 4; ++k) { v[k] = g * silu_mul(a0[k], b0[k]); v[4 + k] = g * silu_mul(a1[k], b1[k]); }
                u32x4 w; w.x = cvt_pk_bf16(v[0], v[1]); w.y = cvt_pk_bf16(v[2], v[3]); w.z = cvt_pk_bf16(v[4], v[5]); w.w = cvt_pk_bf16(v[6], v[7]);
                *(u32x4*)(O + (size_t)row * ldc + col0) = w; }
    }
};
struct EpiRes {
    static constexpr bool PERM = false;
    const float* base; float* out; int ldc; const int* rowmap;
    __device__ __forceinline__ void operator()(const f32x4 (&acc)[2][2][4][2], const Unit& u, int wr, int wc, int fr, int fq) const {
        const int row0 = u.pm * BM + wr * 64 + fr, col0 = u.pn * BM + wc * 32 + 4 * fq;
#pragma unroll
        for (int ai = 0; ai < 2; ++ai)
#pragma unroll
            for (int m = 0; m < 4; ++m) {
                const int row = row0 + ai * HALF + m * 16; const int orow = rowmap ? rowmap[row] : row;
                if (orow >= 0) { const size_t off = (size_t)orow * ldc + col0;
#pragma unroll
                    for (int bj = 0; bj < 2; ++bj)
#pragma unroll
                        for (int n = 0; n < 2; ++n) *(f32x4*)(out + off + bj * HALF + n * 16) = *(const f32x4*)(base + off + bj * HALF + n * 16) + acc[ai][bj][m][n]; }
                if (m & 1) asm volatile("" ::: "memory"); }
    }
};

template <class Epi, class AB>
__device__ __forceinline__ void gemm_phase(PG8_LAS unsigned char* lds, const AB ab, const TileOrder& S, const Epi& E) {
    const int tid = threadIdx.x, wid = __builtin_amdgcn_readfirstlane(tid >> 6), lane = tid & 63, wr = wid >> 2, wc = wid & 3, fr = lane & 15, fq = lane >> 4;
    const int K = ab.K, nt = K / BK;
    int Rr[2], Cc[2]; unsigned voffB[2];
#pragma unroll
    for (int i = 0; i < 2; ++i) { int R, C; stage_rc(tid * 16 + i * 8192, R, C); const int Rb = Epi::PERM ? ((R & ~31) + perm32(R & 31)) : R;
        Rr[i] = R; Cc[i] = C; voffB[i] = (unsigned)(Rb * K + C) * 2u; }
    const size_t kstep = (size_t)(BK * 2);
    const size_t hstep = (size_t)HALF * K * 2;
    const unsigned ldsw = (unsigned)wid * 1024u;
    const int aoff = lds_byte(wr * 64 + fr, fq * 8), boff = lds_byte(wc * 32 + fr, fq * 8);
#define PG8_SA(b, h) (((b) * 2 + (h)) * HTB)
#define PG8_SB(b, h) ((4 + (b) * 2 + (h)) * HTB)
#define PG8_STAGE(bufoff, gbase, voff) do { _Pragma("unroll") for (int _i = 0; _i < 2; ++_i) \
        __builtin_amdgcn_global_load_lds((const unsigned*)((const char*)(gbase) + (voff)[_i]), (PG8_LAS unsigned*)(lds + (bufoff) + ldsw + _i * 8192), 16, 0, 0); } while (0)
#define PG8_LDA(dst, b, h) do { _Pragma("unroll") for (int m = 0; m < 4; ++m) _Pragma("unroll") for (int k = 0; k < 2; ++k) dst[m][k] = *(const PG8_LAS bf16x8*)(lds + PG8_SA(b, h) + aoff + m * 2048 + k * 1024); } while (0)
#define PG8_LDB(dst, b, h) do { _Pragma("unroll") for (int n = 0; n < 2; ++n) _Pragma("unroll") for (int k = 0; k < 2; ++k) dst[n][k] = *(const PG8_LAS bf16x8*)(lds + PG8_SB(b, h) + boff + n * 2048 + k * 1024); } while (0)
#define PG8_MMA(ai, bj, At, Bt) do { __builtin_amdgcn_s_setprio(1); _Pragma("unroll") for (int m = 0; m < 4; ++m) _Pragma("unroll") for (int n = 0; n < 2; ++n) _Pragma("unroll") for (int k = 0; k < 2; ++k) \
        acc[ai][bj][m][n] = __builtin_amdgcn_mfma_f32_16x16x32_bf16(Bt[n][k], At[m][k], acc[ai][bj][m][n], 0, 0, 0); __builtin_amdgcn_s_setprio(0); } while (0)
#define PG8_WAIT_V(n) asm volatile("s_waitcnt vmcnt(" #n ")" ::: "memory")
#define PG8_WAIT_L(n) asm volatile("s_waitcnt lgkmcnt(" #n ")" ::: "memory")
#define PG8_BAR __builtin_amdgcn_s_barrier()
#define PG8_SCHED __builtin_amdgcn_sched_barrier(0)
    Unit cur, nxt; int ui = 0;
    if (!S.next(0, cur)) return;
    f32x4 acc[2][2][4][2];
#pragma unroll
    for (int a = 0; a < 2; ++a)
#pragma unroll
        for (int b = 0; b < 2; ++b)
#pragma unroll
            for (int m = 0; m < 4; ++m)
#pragma unroll
                for (int n = 0; n < 2; ++n) acc[a][b][m][n] = (f32x4){0.f, 0.f, 0.f, 0.f};
    bf16x8 At[4][2], B0[2][2], B1[2][2];
    unsigned cv0[2], cv1[2], nv0[2], nv1[2]; int ntok[4] = {0, 0, 0, 0};
    if constexpr (AB::GATHER) { const int* tp = ab.tokp(cur);
#pragma unroll
        for (int i = 0; i < 2; ++i) { int t0 = tp[Rr[i]], t1 = tp[HALF + Rr[i]]; t0 = t0 < 0 ? 0 : t0; t1 = t1 < 0 ? 0 : t1;
            cv0[i] = (unsigned)(t0 * K + Cc[i]) * 2u; cv1[i] = (unsigned)(t1 * K + Cc[i]) * 2u; }
    } else {
#pragma unroll
        for (int i = 0; i < 2; ++i) { cv0[i] = (unsigned)(Rr[i] * K + Cc[i]) * 2u; cv1[i] = cv0[i] + (unsigned)hstep; }
    }
#pragma unroll
    for (int i = 0; i < 2; ++i) { nv0[i] = cv0[i]; nv1[i] = cv1[i]; }
    const char* cA = ab.abase(cur); const char* cB = ab.bbase(cur);
    PG8_STAGE(PG8_SB(0, 0), cB, voffB); PG8_STAGE(PG8_SB(0, 1), cB + hstep, voffB); PG8_STAGE(PG8_SA(0, 0), cA, cv0); PG8_STAGE(PG8_SA(0, 1), cA, cv1);
    if (wr == 1) PG8_BAR;
    PG8_WAIT_V(2); PG8_BAR;
    PG8_STAGE(PG8_SB(1, 0), cB + kstep, voffB); PG8_STAGE(PG8_SA(1, 0), cA + kstep, cv0); PG8_STAGE(PG8_SB(1, 1), cB + hstep + kstep, voffB);
    PG8_WAIT_V(6); PG8_BAR;
    for (;;) {
        const bool has_next = S.next(ui + 1, nxt);
        const char* nA = has_next ? ab.abase(nxt) : cA; const char* nB = has_next ? ab.bbase(nxt) : cB;
        if constexpr (AB::GATHER) {
            if (has_next) { const int* tp = ab.tokp(nxt);
                asm volatile("global_load_dword %0, %1, off" : "=v"(ntok[0]) : "v"(tp + Rr[0]) : "memory");
                asm volatile("global_load_dword %0, %1, off" : "=v"(ntok[1]) : "v"(tp + Rr[1]) : "memory");
                asm volatile("global_load_dword %0, %1, off" : "=v"(ntok[2]) : "v"(tp + HALF + Rr[0]) : "memory");
                asm volatile("global_load_dword %0, %1, off" : "=v"(ntok[3]) : "v"(tp + HALF + Rr[1]) : "memory"); }
        }
        for (int t = 0; t < nt; t += 2) {
            const bool last = (t == nt - 2);
            const char* a1 = cA + (size_t)(t + 1) * kstep;
            const char* a2 = last ? nA : cA + (size_t)(t + 2) * kstep; const char* b2 = last ? nB : cB + (size_t)(t + 2) * kstep;
            const char* a3 = a2 + kstep; const char* b3 = b2 + kstep;
            unsigned x0[2], x1[2];
            if constexpr (AB::GATHER) {
                if (last && has_next) {
                    asm volatile("s_waitcnt vmcnt(6)" : "+v"(ntok[0]), "+v"(ntok[1]), "+v"(ntok[2]), "+v"(ntok[3]) :: "memory");
#pragma unroll
                    for (int i = 0; i < 2; ++i) { int t0 = ntok[i], t1 = ntok[2 + i]; t0 = t0 < 0 ? 0 : t0; t1 = t1 < 0 ? 0 : t1;
                        nv0[i] = (unsigned)(t0 * K + Cc[i]) * 2u; nv1[i] = (unsigned)(t1 * K + Cc[i]) * 2u; }
                }
#pragma unroll
                for (int i = 0; i < 2; ++i) { x0[i] = last ? nv0[i] : cv0[i]; x1[i] = last ? nv1[i] : cv1[i]; }
            } else {
#pragma unroll
                for (int i = 0; i < 2; ++i) { x0[i] = cv0[i]; x1[i] = cv1[i]; }
            }
            PG8_LDB(B0, 0, 0); PG8_LDB(B1, 0, 1); PG8_SCHED; PG8_LDA(At, 0, 0); PG8_STAGE(PG8_SA(1, 1), a1, cv1);
            PG8_WAIT_V(8); PG8_WAIT_L(0); PG8_BAR; PG8_MMA(0, 0, At, B0); PG8_MMA(0, 1, At, B1); PG8_BAR; PG8_SCHED;
            PG8_LDA(At, 0, 1); PG8_STAGE(PG8_SB(0, 0), b2, voffB); PG8_STAGE(PG8_SB(0, 1), b2 + hstep, voffB); PG8_STAGE(PG8_SA(0, 0), a2, x0);
            PG8_WAIT_V(8); PG8_WAIT_L(0); PG8_BAR; PG8_MMA(1, 0, At, B0); PG8_MMA(1, 1, At, B1); PG8_BAR; PG8_SCHED;
            PG8_LDB(B0, 1, 0); PG8_LDB(B1, 1, 1); PG8_SCHED; PG8_LDA(At, 1, 0); PG8_STAGE(PG8_SA(0, 1), a2, x1);
            PG8_WAIT_V(8); PG8_WAIT_L(0); PG8_BAR; PG8_MMA(0, 0, At, B0); PG8_MMA(0, 1, At, B1); PG8_BAR; PG8_SCHED;
            PG8_LDA(At, 1, 1); PG8_STAGE(PG8_SB(1, 0), b3, voffB); PG8_STAGE(PG8_SB(1, 1), b3 + hstep, voffB); PG8_STAGE(PG8_SA(1, 0), a3, x0);
            PG8_WAIT_V(8); PG8_WAIT_L(0); PG8_BAR; PG8_MMA(1, 0, At, B0); PG8_MMA(1, 1, At, B1); PG8_BAR; PG8_SCHED;
        }
        if (wr == 0) PG8_BAR;
        E(acc, cur, wr, wc, fr, fq);
        if (!has_next) break;
#pragma unroll
        for (int a = 0; a < 2; ++a)
#pragma unroll
            for (int b = 0; b < 2; ++b)
#pragma unroll
                for (int m = 0; m < 4; ++m)
#pragma unroll
                    for (int n = 0; n < 2; ++n) acc[a][b][m][n] = (f32x4){0.f, 0.f, 0.f, 0.f};
        cur = nxt; cA = nA; cB = nB; ++ui;
#pragma unroll
        for (int i = 0; i < 2; ++i) { cv0[i] = nv0[i]; cv1[i] = nv1[i]; }
        if (wr == 1) PG8_BAR;
    }
    PG8_WAIT_V(0);
    PG8_BAR;
#undef PG8_SA
#undef PG8_SB
#undef PG8_STAGE
#undef PG8_LDA
#undef PG8_LDB
#undef PG8_MMA
#undef PG8_WAIT_V
#undef PG8_WAIT_L
#undef PG8_BAR
#undef PG8_SCHED
}
}

namespace moba {
using bf16 = __hip_bfloat16;
using bf16x8 = __attribute__((ext_vector_type(8))) short;
using s16x4  = __attribute__((ext_vector_type(4))) short;
using f32x16 = __attribute__((ext_vector_type(16))) float;
using u32x4  = __attribute__((ext_vector_type(4))) unsigned;
constexpr int D = 128, NW = 8, QBLK = 32, KVBLK = 64, LDK = 3072, NT = 4;
constexpr float THR = 8.f;
constexpr size_t SHM_V = KVBLK * D * 2, SHM_K = KVBLK * D * 2, SHM_ATTN = 2 * SHM_V + 2 * SHM_K + NW * 64 * 4;
#define KSWZ(row, colB) ((row) * 256 + ((colB) ^ (((row) & 7) << 4)))
#define SBAR() __builtin_amdgcn_sched_barrier(0)
__device__ __forceinline__ int crow(int r, int hi) { return (r & 3) + 8 * (r >> 2) + 4 * hi; }
__device__ __forceinline__ unsigned cvtpk(float lo, float hi) { unsigned r; asm volatile("v_cvt_pk_bf16_f32 %0, %1, %2" : "=v"(r) : "v"(lo), "v"(hi)); return r; }
__device__ __forceinline__ void partialSM(f32x16& p0, f32x16& p1, float& m_reg, float& mn, float& alpha) {
  float pmax = p0[0];
#pragma unroll
  for (int r = 1; r < 16; ++r) pmax = fmaxf(pmax, p0[r]);
#pragma unroll
  for (int r = 0; r < 16; ++r) pmax = fmaxf(pmax, p1[r]);
  { auto rr = __builtin_amdgcn_permlane32_swap(__float_as_uint(pmax), __float_as_uint(pmax), false, false);
    pmax = fmaxf(__uint_as_float(rr[0]), __uint_as_float(rr[1])); }
  if (__builtin_expect(__all(pmax - m_reg <= THR), 1)) { mn = m_reg; alpha = 1.f; }
  else { mn = fmaxf(m_reg, pmax); alpha = __builtin_amdgcn_exp2f(m_reg - mn); m_reg = mn; }
#pragma unroll
  for (int r = 0; r < 16; ++r) p0[r] = p0[r] - mn;
#pragma unroll
  for (int r = 0; r < 16; ++r) p1[r] = p1[r] - mn;
#pragma unroll
  for (int r = 0; r < 16; ++r) p0[r] = __builtin_amdgcn_exp2f(p0[r]);
}
__device__ __forceinline__ void finishSM(f32x16& p0, f32x16& p1, float alpha, float& l_reg, bf16x8& pa0, bf16x8& pa1, bf16x8& pa2, bf16x8& pa3) {
#pragma unroll
  for (int r = 0; r < 16; ++r) p1[r] = __builtin_amdgcn_exp2f(p1[r]);
  float ps = 0;
#pragma unroll
  for (int r = 0; r < 16; ++r) ps += p0[r];
#pragma unroll
  for (int r = 0; r < 16; ++r) ps += p1[r];
  { auto rr = __builtin_amdgcn_permlane32_swap(__float_as_uint(ps), __float_as_uint(ps), false, false);
    ps = __uint_as_float(rr[0]) + __uint_as_float(rr[1]); }
  l_reg = l_reg * alpha + ps;
#define PK4(P, BASE, OUT) do { unsigned a0 = cvtpk(P[BASE + 0], P[BASE + 1]), a1 = cvtpk(P[BASE + 2], P[BASE + 3]);   \
    unsigned b0 = cvtpk(P[BASE + 4], P[BASE + 5]), b1 = cvtpk(P[BASE + 6], P[BASE + 7]);                              \
    auto r0 = __builtin_amdgcn_permlane32_swap(a0, b0, false, false); auto r1 = __builtin_amdgcn_permlane32_swap(a1, b1, false, false); \
    u32x4 w = {r0[0], r1[0], r0[1], r1[1]}; OUT = *reinterpret_cast<bf16x8*>(&w); } while (0)
  PK4(p0, 0, pa0); PK4(p0, 8, pa1); PK4(p1, 0, pa2); PK4(p1, 8, pa3);
#undef PK4
}
__device__ __forceinline__ void qkt(f32x16& p0, f32x16& p1, const bf16* Ks, const bf16x8* qr, int r32, int hi) {
  p0 = f32x16{}; p1 = f32x16{};
#pragma unroll
  for (int d0 = 0; d0 < 8; ++d0) { int cb = (d0 * 16 + hi * 8) * 2;
    bf16x8 b0 = *reinterpret_cast<const bf16x8*>((const char*)Ks + KSWZ(r32, cb));
    bf16x8 b1 = *reinterpret_cast<const bf16x8*>((const char*)Ks + KSWZ(32 + r32, cb));
    p0 = __builtin_amdgcn_mfma_f32_32x32x16_bf16(b0, qr[d0], p0, 0, 0, 0);
    p1 = __builtin_amdgcn_mfma_f32_32x32x16_bf16(b1, qr[d0], p1, 0, 0, 0); }
}
__device__ __forceinline__ int v_st(int k, int c) { const int kk = (k & ~0xC) | ((k & 4) << 1) | ((k & 8) >> 1); return ((kk >> 3) * 4 + (c >> 5)) * 512 + ((kk & 7) * 32 + (c & 31)) * 2; }
__device__ __forceinline__ int v_rd_base(int lane) { return ((lane & 3) << 3) | (((lane >> 2) & 3) << 6) | (((lane >> 4) & 1) << 5) | (((lane >> 5) & 1) << 8); }
constexpr int v_rd_off(int d0, int ks, int half) { return d0 * 512 + ks * 4096 + half * 2048; }
template <int OFF> __device__ __forceinline__ s16x4 tr_read(int vb) {
  s16x4 r; asm volatile("ds_read_b64_tr_b16 %0, %1 offset:%2" : "=&v"(r) : "v"(vb), "i"(OFF) : "memory"); return r;
}
template <int D0> __device__ __forceinline__ void pv_one(f32x16& od, int vb, bf16x8 pa0, bf16x8 pa1, bf16x8 pa2, bf16x8 pa3) {
  const s16x4 l0 = tr_read<v_rd_off(D0, 0, 0)>(vb), h0 = tr_read<v_rd_off(D0, 0, 1)>(vb), l1 = tr_read<v_rd_off(D0, 1, 0)>(vb), h1 = tr_read<v_rd_off(D0, 1, 1)>(vb);
  const s16x4 l2 = tr_read<v_rd_off(D0, 2, 0)>(vb), h2 = tr_read<v_rd_off(D0, 2, 1)>(vb), l3 = tr_read<v_rd_off(D0, 3, 0)>(vb), h3 = tr_read<v_rd_off(D0, 3, 1)>(vb);
  asm volatile("s_waitcnt lgkmcnt(0)" ::: "memory"); SBAR();
#define PK(L, H) (bf16x8){L[0], L[1], L[2], L[3], H[0], H[1], H[2], H[3]}
  od = __builtin_amdgcn_mfma_f32_32x32x16_bf16(pa0, PK(l0, h0), od, 0, 0, 0);
  od = __builtin_amdgcn_mfma_f32_32x32x16_bf16(pa1, PK(l1, h1), od, 0, 0, 0);
  od = __builtin_amdgcn_mfma_f32_32x32x16_bf16(pa2, PK(l2, h2), od, 0, 0, 0);
  od = __builtin_amdgcn_mfma_f32_32x32x16_bf16(pa3, PK(l3, h3), od, 0, 0, 0);
#undef PK
}
__device__ __forceinline__ void pv_d0(f32x16* o, int vb, bf16x8 pa0, bf16x8 pa1, bf16x8 pa2, bf16x8 pa3) {
  pv_one<0>(o[0], vb, pa0, pa1, pa2, pa3); pv_one<1>(o[1], vb, pa0, pa1, pa2, pa3); pv_one<2>(o[2], vb, pa0, pa1, pa2, pa3); pv_one<3>(o[3], vb, pa0, pa1, pa2, pa3);
}
__device__ __forceinline__ void cmask(f32x16& p0, f32x16& p1, int tile, int ql, int hi) {
  asm volatile("" : "+v"(ql));
#pragma unroll
  for (int r = 0; r < 16; ++r) { const int kv = 64 * tile + (r & 3) + 8 * (r >> 2) + 4 * hi; if (kv > ql) p0[r] = -1e30f; if (kv + 32 > ql) p1[r] = -1e30f; }
}
__device__ __forceinline__ void moba_unit(const bool OWN, const bf16* qrow, const bf16* __restrict__ Kh, const bf16* __restrict__ Vh, bf16* obase, int ostride, int dst, float* ml, int mli, int ql, char* lds) {
  const int tid = threadIdx.x, wid = tid >> 6, lane = tid & 63, r32 = lane & 31, hi = lane >> 5;
  bf16* V_lds = (bf16*)lds; bf16* K_lds = (bf16*)(lds + 2 * SHM_V);
  float* ws = (float*)(lds + 2 * SHM_V + 2 * SHM_K) + wid * 64; float* li_l = ws; float* al_l = ws + 32;
  float m_reg = -1e30f, l_reg = 0; f32x16 o[4] = {}; bf16x8 qr[8];
  const bf16* Qw = qrow + hi * 8;
#pragma unroll
  for (int d0 = 0; d0 < 8; ++d0) qr[d0] = *reinterpret_cast<const bf16x8*>(Qw + d0 * 16);
  const int sr = tid >> 4, sc = (tid & 15) * 8, vst0 = v_st(sr, sc), vst1 = v_st(32 + sr, sc);
  const int vb0 = (int)(uintptr_t)V_lds + v_rd_base(lane);
  struct { bf16x8 vs0, vs1, ks0, ks1; } sr_[2];
#define SLOAD(i, k0) do { sr_[i].vs0 = *reinterpret_cast<const bf16x8*>(&Vh[(long)((k0) + sr) * LDK + sc]); sr_[i].vs1 = *reinterpret_cast<const bf16x8*>(&Vh[(long)((k0) + 32 + sr) * LDK + sc]); \
    sr_[i].ks0 = *reinterpret_cast<const bf16x8*>(&Kh[(long)((k0) + sr) * LDK + sc]); sr_[i].ks1 = *reinterpret_cast<const bf16x8*>(&Kh[(long)((k0) + 32 + sr) * LDK + sc]); } while (0)
#define SWRITE(b, i) do { *(bf16x8*)((char*)V_lds + (b) * SHM_V + vst0) = sr_[i].vs0;          \
    *(bf16x8*)((char*)V_lds + (b) * SHM_V + vst1) = sr_[i].vs1; int kc = sc * 2;               \
    *(bf16x8*)((char*)K_lds + (b) * SHM_K + KSWZ(sr, kc)) = sr_[i].ks0;                       \
    *(bf16x8*)((char*)K_lds + (b) * SHM_K + KSWZ(32 + sr, kc)) = sr_[i].ks1; } while (0)
#define SWAIT() asm volatile("s_waitcnt vmcnt(4)" ::: "memory")
#define RESC(a) do { if (__any((a) < 1.f)) { if (hi == 0) al_l[r32] = (a); asm volatile("s_waitcnt lgkmcnt(0)" ::: "memory"); \
    _Pragma("unroll") for (int d = 0; d < 4; ++d) _Pragma("unroll") for (int r = 0; r < 16; ++r) o[d][r] *= al_l[crow(r, hi)]; } } while (0)
  f32x16 pA0, pA1, pB0, pB1; float mnA, mnB, alA, alB; bf16x8 pa0, pa1, pa2, pa3;
  constexpr int SE = 0, SO = 1;
  SLOAD(SE, 0); asm volatile("s_waitcnt vmcnt(0)" ::: "memory"); SWRITE(0, SE); __syncthreads();
  qkt(pA0, pA1, K_lds, qr, r32, hi); if (OWN) cmask(pA0, pA1, 0, ql, hi); partialSM(pA0, pA1, m_reg, mnA, alA);
  SLOAD(SO, KVBLK); SLOAD(SE, 2 * KVBLK);
  SWAIT(); SWRITE(1, SO); __syncthreads();
  {
    SBAR(); qkt(pB0, pB1, (bf16*)((char*)K_lds + SHM_K), qr, r32, hi);
    finishSM(pA0, pA1, alA, l_reg, pa0, pa1, pa2, pa3); SBAR();
    SLOAD(SO, 3 * KVBLK); SBAR();
    pv_d0(o, vb0, pa0, pa1, pa2, pa3); if (OWN) cmask(pB0, pB1, 1, ql, hi); partialSM(pB0, pB1, m_reg, mnB, alB);
    __syncthreads(); SWAIT(); SWRITE(0, SE);
    RESC(alB); __syncthreads();
    SBAR(); qkt(pA0, pA1, K_lds, qr, r32, hi);
    finishSM(pB0, pB1, alB, l_reg, pa0, pa1, pa2, pa3); SBAR();
    pv_d0(o, vb0 + (int)SHM_V, pa0, pa1, pa2, pa3); if (OWN) cmask(pA0, pA1, 2, ql, hi); partialSM(pA0, pA1, m_reg, mnA, alA);
    __syncthreads(); asm volatile("s_waitcnt vmcnt(0)" ::: "memory"); SWRITE(1, SO);
    RESC(alA); __syncthreads();
  }
  SBAR(); qkt(pB0, pB1, (bf16*)((char*)K_lds + SHM_K), qr, r32, hi);
  finishSM(pA0, pA1, alA, l_reg, pa0, pa1, pa2, pa3); SBAR();
  pv_d0(o, vb0, pa0, pa1, pa2, pa3); if (OWN) cmask(pB0, pB1, 3, ql, hi); partialSM(pB0, pB1, m_reg, mnB, alB);
  __syncthreads(); RESC(alB);
  finishSM(pB0, pB1, alB, l_reg, pa0, pa1, pa2, pa3); SBAR();
  pv_d0(o, vb0 + (int)SHM_V, pa0, pa1, pa2, pa3);
  if (hi == 0) li_l[r32] = l_reg; asm volatile("s_waitcnt lgkmcnt(0)" ::: "memory");
  float rli[16];
#pragma unroll
  for (int r = 0; r < 16; ++r) rli[r] = __builtin_amdgcn_rcpf(li_l[crow(r, hi)]);
  __syncthreads();
  bf16* stg = (bf16*)lds + wid * 4096;
#pragma unroll
  for (int r = 0; r < 16; ++r) { const int orow = crow(r, hi);
#pragma unroll
    for (int d0 = 0; d0 < 4; ++d0) stg[orow * 128 + d0 * 32 + r32] = __float2bfloat16(o[d0][r] * rli[r]); }
  int* dsto = (int*)al_l;
  if (hi == 0) dsto[r32] = dst;
  asm volatile("s_waitcnt lgkmcnt(0)" ::: "memory");
#pragma unroll
  for (int i = 0; i < 8; ++i) { const int row = i * 4 + (lane >> 4), ch = lane & 15; const int di = dsto[row]; const u32x4 v = *(const u32x4*)(stg + row * 128 + ch * 8);
    if (di >= 0) *(u32x4*)(obase + (size_t)di * ostride + ch * 8) = v; }
  if (hi == 0 && dst >= 0) { ml[2 * (size_t)mli] = m_reg; ml[2 * (size_t)mli + 1] = l_reg; }
  asm volatile("s_waitcnt lgkmcnt(0)" ::: "memory");
  __syncthreads();
#undef SLOAD
#undef SWRITE
#undef SWAIT
#undef RESC
}

#define KSWZ64(row, colB) ((row) * 128 + ((colB) ^ ((((row) >> 1) & 7) << 4)))
constexpr size_t DA_SHM_K = 64 * 64 * 2;
constexpr size_t DA_SHM = 2 * SHM_V + 2 * DA_SHM_K + NW * 64 * 4;
__device__ __forceinline__ void qkt64(f32x16& p0, f32x16& p1, const bf16* Ks, const bf16x8* qr, int r32, int hi) {
  p0 = f32x16{}; p1 = f32x16{};
#pragma unroll
  for (int d0 = 0; d0 < 4; ++d0) { int cb = (d0 * 16 + hi * 8) * 2;
    bf16x8 b0 = *reinterpret_cast<const bf16x8*>((const char*)Ks + KSWZ64(r32, cb));
    bf16x8 b1 = *reinterpret_cast<const bf16x8*>((const char*)Ks + KSWZ64(32 + r32, cb));
    p0 = __builtin_amdgcn_mfma_f32_32x32x16_bf16(b0, qr[d0], p0, 0, 0, 0);
    p1 = __builtin_amdgcn_mfma_f32_32x32x16_bf16(b1, qr[d0], p1, 0, 0, 0); }
}
__device__ __forceinline__ void dattn_unit(const bf16* Qb, const bf16* __restrict__ Kh, const bf16* __restrict__ Vh, bf16* Ob, const int NT, char* lds) {
  const int tid = threadIdx.x, wid = tid >> 6, lane = tid & 63, r32 = lane & 31, hi = lane >> 5;
  bf16* V_lds = (bf16*)lds; bf16* K_lds = (bf16*)(lds + 2 * SHM_V);
  float* ws = (float*)(lds + 2 * SHM_V + 2 * DA_SHM_K) + wid * 64; float* li_l = ws; float* al_l = ws + 32;
  float m_reg = -1e30f, l_reg = 0; f32x16 o[4] = {}; bf16x8 qr[4];
  const bf16* Qw = Qb + (long)(wid * QBLK + r32) * LDK + hi * 8;
#pragma unroll
  for (int d0 = 0; d0 < 4; ++d0) qr[d0] = *reinterpret_cast<const bf16x8*>(Qw + d0 * 16);
  const int sr = tid >> 4, sc = (tid & 15) * 8, vst0 = v_st(sr, sc), vst1 = v_st(32 + sr, sc);
  const int kr = tid >> 3, kc = (tid & 7) * 8, kst = KSWZ64(kr, kc * 2);
  const int vb0 = (int)(uintptr_t)V_lds + v_rd_base(lane);
  const int ql = wid * QBLK + r32;
  struct { bf16x8 vs0, vs1, ks; } sr_[2];
#define SLOAD(i, k0) do { sr_[i].vs0 = *reinterpret_cast<const bf16x8*>(&Vh[(long)((k0) + sr) * LDK + sc]); sr_[i].vs1 = *reinterpret_cast<const bf16x8*>(&Vh[(long)((k0) + 32 + sr) * LDK + sc]); \
    sr_[i].ks = *reinterpret_cast<const bf16x8*>(&Kh[(long)((k0) + kr) * LDK + kc]); } while (0)
#define SWRITE(b, i) do { *(bf16x8*)((char*)V_lds + (b) * SHM_V + vst0) = sr_[i].vs0; *(bf16x8*)((char*)V_lds + (b) * SHM_V + vst1) = sr_[i].vs1; \
    *(bf16x8*)((char*)K_lds + (b) * DA_SHM_K + kst) = sr_[i].ks; } while (0)
#define SWAIT() asm volatile("s_waitcnt vmcnt(3)" ::: "memory")
#define RESC(a) do { if (__any((a) < 1.f)) { if (hi == 0) al_l[r32] = (a); asm volatile("s_waitcnt lgkmcnt(0)" ::: "memory"); \
    _Pragma("unroll") for (int d = 0; d < 4; ++d) _Pragma("unroll") for (int r = 0; r < 16; ++r) o[d][r] *= al_l[crow(r, hi)]; } } while (0)
#define MASK(P0, P1, t) do { if ((t) >= NT - 4) cmask(P0, P1, (t) - (NT - 4), ql, hi); } while (0)
  f32x16 pA0, pA1, pB0, pB1; float mnA, mnB, alA, alB; bf16x8 pa0, pa1, pa2, pa3;
  constexpr int SE = 0, SO = 1;
  SLOAD(SE, 0); asm volatile("s_waitcnt vmcnt(0)" ::: "memory"); SWRITE(0, SE); __syncthreads();
  qkt64(pA0, pA1, K_lds, qr, r32, hi); MASK(pA0, pA1, 0); partialSM(pA0, pA1, m_reg, mnA, alA);
  SLOAD(SO, KVBLK); SLOAD(SE, 2 * KVBLK);
  SWAIT(); SWRITE(1, SO); __syncthreads();
  for (int j = 1; j + 1 < NT; j += 2) {
    SBAR(); qkt64(pB0, pB1, (bf16*)((char*)K_lds + DA_SHM_K), qr, r32, hi);
    finishSM(pA0, pA1, alA, l_reg, pa0, pa1, pa2, pa3); SBAR();
    SLOAD(SO, (j + 2) * KVBLK); SBAR();
    pv_d0(o, vb0, pa0, pa1, pa2, pa3); MASK(pB0, pB1, j); partialSM(pB0, pB1, m_reg, mnB, alB);
    __syncthreads(); SWAIT(); SWRITE(0, SE);
    RESC(alB); __syncthreads();
    SBAR(); qkt64(pA0, pA1, K_lds, qr, r32, hi);
    finishSM(pB0, pB1, alB, l_reg, pa0, pa1, pa2, pa3); SBAR();
    if (j + 3 < NT) SLOAD(SE, (j + 3) * KVBLK); SBAR();
    pv_d0(o, vb0 + (int)SHM_V, pa0, pa1, pa2, pa3); MASK(pA0, pA1, j + 1); partialSM(pA0, pA1, m_reg, mnA, alA);
    __syncthreads(); SWAIT(); SWRITE(1, SO);
    RESC(alA); __syncthreads();
  }
  SBAR(); qkt64(pB0, pB1, (bf16*)((char*)K_lds + DA_SHM_K), qr, r32, hi);
  finishSM(pA0, pA1, alA, l_reg, pa0, pa1, pa2, pa3); SBAR();
  pv_d0(o, vb0, pa0, pa1, pa2, pa3); MASK(pB0, pB1, NT - 1); partialSM(pB0, pB1, m_reg, mnB, alB);
  __syncthreads(); RESC(alB);
  finishSM(pB0, pB1, alB, l_reg, pa0, pa1, pa2, pa3); SBAR();
  pv_d0(o, vb0 + (int)SHM_V, pa0, pa1, pa2, pa3);
  if (hi == 0) li_l[r32] = l_reg; asm volatile("s_waitcnt lgkmcnt(0)" ::: "memory");
  float rli[16];
#pragma unroll
  for (int r = 0; r < 16; ++r) rli[r] = __builtin_amdgcn_rcpf(li_l[crow(r, hi)]);
  __syncthreads();
  bf16* stg = (bf16*)lds + wid * 4096;
#pragma unroll
  for (int r = 0; r < 16; ++r) { const int orow = crow(r, hi);
#pragma unroll
    for (int d0 = 0; d0 < 4; ++d0) stg[orow * 128 + d0 * 32 + r32] = __float2bfloat16(o[d0][r] * rli[r]); }
  asm volatile("s_waitcnt lgkmcnt(0)" ::: "memory");
#pragma unroll
  for (int i = 0; i < 8; ++i) { const int row = i * 4 + (lane >> 4), ch = lane & 15; const u32x4 v = *(const u32x4*)(stg + row * 128 + ch * 8);
    *(u32x4*)(Ob + (size_t)(wid * QBLK + row) * 2048 + ch * 8) = v; }
  asm volatile("s_waitcnt lgkmcnt(0)" ::: "memory");
  __syncthreads();
#undef SLOAD
#undef SWRITE
#undef SWAIT
#undef RESC
#undef MASK
}
struct DaUnit { int bqh; int qb; };
struct DaOrder {
  int vcu, G;
  __device__ __forceinline__ DaOrder(int vcu_, int G_) : vcu(vcu_), G(G_) {}
  __device__ __forceinline__ bool next(int i, DaUnit& u) const {
    if (G == 256) { if (i >= 8) return false; const int s = vcu & 7, ii = i & 3; u.bqh = (i >> 2) * 32 + (vcu >> 3); u.qb = (ii == 0) ? s : (ii == 1) ? 15 - s : (ii == 2) ? 16 + s : 31 - s; return true; }
    const int uu = vcu + i * G; if (uu >= 2048) return false; u.bqh = uu >> 5; u.qb = uu & 31; return true; }
};
template <class Sched> __device__ __forceinline__ void dattn_phase(char* lds, const bf16* QKV, bf16* O, const Sched& S) {
  DaUnit u;
  for (int i = 0; S.next(i, u); ++i) { const int b = u.bqh >> 4, qh = u.bqh & 15; const size_t rb = (size_t)b * 8192;
    dattn_unit(QKV + (rb + u.qb * 256) * LDK + qh * 64, QKV + rb * LDK + 1024 + qh * 64, QKV + rb * LDK + 2048 + (qh >> 1) * 128, O + (rb + u.qb * 256) * 2048 + qh * 128, 4 * (u.qb + 1), lds); }
}
#undef KSWZ64
#undef KSWZ
#undef SBAR
}
#define GAS __attribute__((address_space(1)))
#define LAS __attribute__((address_space(3)))
typedef unsigned short bf16;
typedef unsigned v4u __attribute__((ext_vector_type(4)));
typedef float f32x4 __attribute__((ext_vector_type(4)));
typedef short bf16x8 __attribute__((ext_vector_type(8)));
typedef GAS unsigned gu32;
typedef GAS unsigned long long gu64;
#define RLX_AGENT __ATOMIC_RELAXED, __HIP_MEMORY_SCOPE_AGENT
#define LDS_WAIT() asm volatile("s_waitcnt lgkmcnt(0)" ::: "memory")
#define VM_WAIT() asm volatile("s_waitcnt vmcnt(0)" ::: "memory")
__device__ __forceinline__ unsigned long long rt() { return __builtin_amdgcn_s_memrealtime(); }
__device__ __forceinline__ unsigned f2bf(float f) { unsigned u = __builtin_bit_cast(unsigned, f); return (u + 0x7fffu + ((u >> 16) & 1u)) >> 16; }
__device__ __forceinline__ unsigned pk2(float lo, float hi) { return f2bf(lo) | (f2bf(hi) << 16); }
#define XB_TMO      128
#define XB_XCNT(j)  (256  + 64 * (j))
#define XB_XSUB(j)  (1280 + 64 * (j))
#define XB_XGEN(j)  (2304 + 64 * (j))
#define XB_TOP      3328
#define XB_TOPGEN   3392
#define XCD_BAR_WORDS 3456
#define XB_SPIN_CAP (1u << 18)

__device__ __forceinline__ unsigned xb_ld(unsigned* p)              { return __hip_atomic_load(p, __ATOMIC_RELAXED, __HIP_MEMORY_SCOPE_AGENT); }
__device__ __forceinline__ unsigned xb_add(unsigned* p, unsigned v) { return __hip_atomic_fetch_add(p, v, __ATOMIC_RELAXED, __HIP_MEMORY_SCOPE_AGENT); }
__device__ __forceinline__ unsigned xb_xcc_id() { return (unsigned)__builtin_amdgcn_s_getreg((3 << 11) | 20) & 0xFu; }
#define XB_SPIN(cond, bar) do { unsigned _sp = 0; while (cond) { __builtin_amdgcn_s_sleep(1); \
    if ((++_sp & 255u) == 0u) { if (xb_ld(&(bar)[XB_TMO])) break; if (_sp > XB_SPIN_CAP) { atomicAdd(&(bar)[XB_TMO], 1u); break; } } } } while (0)

struct XcdBarrier {
    unsigned* bar; unsigned x;
    volatile LAS unsigned* st;
};

__device__ __forceinline__ XcdBarrier xcd_barrier_post(unsigned* bar, volatile LAS unsigned* st) {
    XcdBarrier b; b.bar = bar; b.x = xb_xcc_id(); b.st = st;
    if (threadIdx.x == 0) (void)xb_add(&bar[XB_XCNT(b.x)], 1u);
    return b;
}
__device__ __forceinline__ void xcd_barrier_complete(unsigned* bar, unsigned x, unsigned& nloc, unsigned& nx) {
    const unsigned G = gridDim.x * gridDim.y * gridDim.z;
    unsigned sum, cnt, mine, sp = 0u;
    for (;;) {
        sum = 0u; cnt = 0u; mine = 0u;
#pragma unroll
        for (unsigned j = 0; j < 16; ++j) { const unsigned c = xb_ld(&bar[XB_XCNT(j)]); sum += c; cnt += (c > 0u) ? 1u : 0u; mine = (j == x) ? c : mine; }
        if (sum == G) break;
        __builtin_amdgcn_s_sleep(1);
        if ((++sp & 255u) == 0u) { if (xb_ld(&bar[XB_TMO])) break; if (sp > XB_SPIN_CAP) { atomicAdd(&bar[XB_TMO], 1u); break; } }
    }
    nloc = mine > 0u ? mine : 1u; nx = cnt > 0u ? cnt : 1u;
}

__device__ __forceinline__ void xcd_barrier(const XcdBarrier& b) {
    asm volatile("s_waitcnt vmcnt(0)" ::: "memory");
    __syncthreads();
    if (threadIdx.x == 0) {
        unsigned* bar = b.bar;
        __builtin_amdgcn_s_waitcnt(0);
        unsigned nloc = b.st[0], nx = b.st[1];
        if (nloc == 0u) { xcd_barrier_complete(bar, b.x, nloc, nx); b.st[0] = nloc; b.st[1] = nx; }
        const unsigned old = xb_add(&bar[XB_XSUB(b.x)], 1u);
        const unsigned gen = old / nloc;
        if (old + 1u == (gen + 1u) * nloc) {
            __builtin_amdgcn_fence(__ATOMIC_RELEASE, "agent");
            asm volatile("s_waitcnt vmcnt(0)" ::: "memory");
            const unsigned og = xb_add(&bar[XB_TOP], 1u);
            const unsigned tg = og / nx;
            if (og + 1u == (tg + 1u) * nx) xb_add(&bar[XB_TOPGEN], 1u);
            else XB_SPIN(xb_ld(&bar[XB_TOPGEN]) == tg, bar);
            __builtin_amdgcn_fence(__ATOMIC_ACQUIRE, "agent");
            xb_add(&bar[XB_XGEN(b.x)], 1u);
            asm volatile("s_waitcnt vmcnt(0)" ::: "memory");
        } else {
            XB_SPIN(xb_ld(&bar[XB_XGEN(b.x)]) == gen, bar);
            __builtin_amdgcn_fence(__ATOMIC_ACQUIRE, "agent");
            asm volatile("s_waitcnt vmcnt(0)" ::: "memory");
        }
    }
    __syncthreads();
}

constexpr int NWAVES = 8;
#ifndef MK_PER_PHASE
#define MK_PER_PHASE 0
#endif
constexpr int BATCH = 4, SEQ = 8192, DM = 1024, TOK = BATCH * SEQ;
constexpr int FF0 = 2816, NEXP = 8, FF1 = 3584;
constexpr int NQKV = 3072;
constexpr int MB_H = 8, MB_NB = 32, MB_L = 256;
constexpr int SLOTS = TOK + NEXP * 256;
constexpr float NORM_EPS = 1e-6f, SUBLN_EPS = 1e-5f;
constexpr float LAMBDA_INIT0 = 0.2f;
constexpr float LOG2E = 1.4426950408889634f;
constexpr int LIST_PER_BH = 256 * 496;
__host__ __device__ constexpr int list_off(int j) { return 256 * (31 * j - (j * (j - 1)) / 2); }

constexpr size_t MiB = 1u << 20;
constexpr size_t WS_CTL = 0, CTL_ZERO_BYTES = 1 * MiB;
constexpr size_t WS_ROPE64 = 1 * MiB;
constexpr size_t WS_ROPE128 = WS_ROPE64 + 512 * 1024;
constexpr size_t WS_KMEAN = WS_ROPE128 + 1 * MiB;
constexpr size_t WS_TOK = 3 * MiB;
constexpr size_t WS_SLOT = 4 * MiB;
constexpr size_t WS_OWNML = 6 * MiB;
constexpr size_t WS_W0QKV = 8 * MiB, WS_W0O = 14 * MiB, WS_W013 = 16 * MiB, WS_W02 = 27 * MiB, WS_W1QKV = 33 * MiB, WS_W1O = 39 * MiB;
constexpr size_t B0 = 42 * MiB;
constexpr size_t WS_H = B0;
constexpr size_t WS_QKV = B0 + 64 * MiB;
constexpr size_t WS_OATT = B0 + 256 * MiB;
constexpr size_t WS_UD = B0 + 128 * MiB;
constexpr size_t WS_LIST = B0 + 256 * MiB;
constexpr size_t WS_PML = B0 + 272 * MiB;
constexpr size_t WS_PO = B0 + 280 * MiB;
constexpr size_t WS_WM13 = B0 + 64 * MiB;
constexpr size_t WS_WM2 = WS_WM13 + 112 * MiB;
constexpr size_t WS_UM = B0 + 232 * MiB;
constexpr size_t WS_END = WS_UM + (size_t)SLOTS * FF1 * 2;
static_assert(WS_PO + (size_t)TOK * MB_H * 3 * 128 * 2 <= WS_END + 8 * MiB && WS_END <= 528 * MiB, "d_ws map");
constexpr int CW_TMO = 0, CW_CODE = 1, CW_DBG = 2;
constexpr int CW_MOECNT = 64;
constexpr int CW_MOBACNT = 256;
constexpr int CW_BAR = 4096;
constexpr int RING_OFF = 0, RING_BYTES = 131072;
constexpr int LDSCTL_OFF = RING_BYTES, MISC_OFF = LDSCTL_OFF + 320;
constexpr int LDS_BYTES = 147456;

struct Args { const float* in[20]; float* out; unsigned char* ws; float inv64[8]; float inv128[16]; int ph_lo, ph_hi; };

__device__ __forceinline__ float wave_sum(float v) {
#pragma unroll
    for (int o = 1; o < 64; o <<= 1) v += __shfl_xor(v, o);
    return v;
}
template <int MAP> __device__ __forceinline__ int maprow(int n) {
    if (MAP == 1) { if (n >= 2048) return n; const int d = n & 63; if (d >= 16) return n; const int b = d >> 3, a = (d >> 2) & 1, c = d & 3; return (n & ~63) + 8 * a + 4 * b + c; }
    if (MAP == 2) { if (n >= 2048) return n; const int d = n & 127; if (d >= 32) return n; const int b = d >> 4, a = (d >> 2) & 3, c = d & 3; return (n & ~127) + 8 * a + 4 * b + c; }
    if (MAP == 3) return 256 * (n >> 7) + (n & 127);
    if (MAP == 4) return 256 * (n >> 7) + 128 + (n & 127);
    return n;
}
template <int MAP> __device__ __forceinline__ void transpose_item(const float* W, int K, int N, bf16* WT, LAS float* scr, int item, int lane) {
    const int nblk = N / 32, kb = item / nblk, nb = item % nblk, k0 = 64 * kb, n0 = 32 * nb;
    const int kr = lane >> 3, nc = (lane & 7) * 4;
    f32x4 v[8];
#pragma unroll
    for (int i = 0; i < 8; ++i) v[i] = *(const GAS f32x4*)(W + (size_t)(k0 + i * 8 + kr) * N + n0 + nc);
#pragma unroll
    for (int i = 0; i < 8; ++i) { LAS float* d = scr + (i * 8 + kr) * 33 + nc; d[0] = v[i].x; d[1] = v[i].y; d[2] = v[i].z; d[3] = v[i].w; }
    LDS_WAIT(); asm volatile("" ::: "memory");
    const int c = lane & 7;
#pragma unroll
    for (int j = 0; j < 4; ++j) { const int n = (lane >> 3) + 8 * j; const LAS float* s = scr + (8 * c) * 33 + n;
        v4u o; o.x = pk2(s[0 * 33], s[1 * 33]); o.y = pk2(s[2 * 33], s[3 * 33]); o.z = pk2(s[4 * 33], s[5 * 33]); o.w = pk2(s[6 * 33], s[7 * 33]);
        *(GAS v4u*)(WT + (size_t)maprow<MAP>(n0 + n) * K + k0 + 8 * c) = o; }
    LDS_WAIT(); asm volatile("" ::: "memory");
}
__device__ __forceinline__ void rms_row(const float* xrow, const f32x4 (&g)[4], f32x4 (&v)[4], int lane) {
    const GAS f32x4* xr = (const GAS f32x4*)xrow + lane; float s = 0.f;
#pragma unroll
    for (int j = 0; j < 4; ++j) { v[j] = xr[64 * j]; s += (v[j].x * v[j].x + v[j].y * v[j].y) + (v[j].z * v[j].z + v[j].w * v[j].w); }
    const float rstd = 1.f / sqrtf(wave_sum(s) * (1.f / DM) + NORM_EPS);
#pragma unroll
    for (int j = 0; j < 4; ++j) v[j] = v[j] * rstd * g[j];
}
__device__ __forceinline__ void store_row_bf16(bf16* orow, const f32x4 (&v)[4], int lane) {
    GAS unsigned long long* o8 = (GAS unsigned long long*)orow + lane;
#pragma unroll
    for (int j = 0; j < 4; ++j) o8[64 * j] = (unsigned long long)pk2(v[j].x, v[j].y) | ((unsigned long long)pk2(v[j].z, v[j].w) << 32);
}
__device__ __forceinline__ void load_gain(const float* g, f32x4 (&gv)[4], int lane) {
#pragma unroll
    for (int j = 0; j < 4; ++j) gv[j] = *((const f32x4*)g + lane + 64 * j);
}
__device__ __forceinline__ void rmsnorm_phase(const float* src, const float* gain, bf16* dst, int gw, int ngw, int lane) {
    f32x4 gv[4]; load_gain(gain, gv, lane);
    for (int m = gw; m < TOK; m += ngw) { f32x4 v[4]; rms_row(src + (size_t)m * DM, gv, v, lane); store_row_bf16(dst + (size_t)m * DM, v, lane); }
}
__device__ __forceinline__ float bf2f(unsigned short b) { return __uint_as_float((unsigned)b << 16); }


typedef __attribute__((address_space(4))) const unsigned char* kaptr_t;
__device__ __forceinline__ kaptr_t ka_get() { kaptr_t p = (kaptr_t)__builtin_amdgcn_kernarg_segment_ptr(); asm volatile("" : "+s"(p)); return p; }
#define KA_IN(k) (*(const float* const __attribute__((address_space(4)))*)(ka + 8 * (k)))
#define PH_PTRS kaptr_t ka = ka_get(); unsigned char* const ws = *(unsigned char* const __attribute__((address_space(4)))*)(ka + 168); float* const out = *(float* const __attribute__((address_space(4)))*)(ka + 160); gu32* const ctl = (gu32*)(ws + WS_CTL); (void)out; (void)ctl
#define IN_X KA_IN(0)
#define norm_mix KA_IN(1)
#define norm_ffn KA_IN(2)
#define final_norm KA_IN(3)
#define da_wqkv KA_IN(4)
#define da_wo KA_IN(5)
#define da_lq1 KA_IN(6)
#define da_lk1 KA_IN(7)
#define da_lq2 KA_IN(8)
#define da_lk2 KA_IN(9)
#define da_subln KA_IN(10)
#define mb_wqkv KA_IN(11)
#define mb_wo KA_IN(12)
#define ffn_w1 KA_IN(13)
#define ffn_w3 KA_IN(14)
#define ffn_w2 KA_IN(15)
#define moe_router KA_IN(16)
#define moe_w1 KA_IN(17)
#define moe_w3 KA_IN(18)
#define moe_w2 KA_IN(19)
#define rope64 ((float*)(ws + WS_ROPE64))
#define rope128 ((float*)(ws + WS_ROPE128))
#define kmean ((float*)(ws + WS_KMEAN))
#define tok_e ((int*)(ws + WS_TOK))
#define tok_pos (tok_e + 2 * TOK)
#define tok_gate ((float*)(tok_pos + 2 * TOK))
#define slot_tok ((int*)(ws + WS_SLOT))
#define slot_gate ((float*)(slot_tok + 2 * SLOTS))
#define ownml ((float*)(ws + WS_OWNML))
#define W0qkv ((bf16*)(ws + WS_W0QKV))
#define W0o ((bf16*)(ws + WS_W0O))
#define W013 ((bf16*)(ws + WS_W013))
#define W02 ((bf16*)(ws + WS_W02))
#define W1qkv ((bf16*)(ws + WS_W1QKV))
#define W1o ((bf16*)(ws + WS_W1O))
#define Hb ((bf16*)(ws + WS_H))
#define QKV ((bf16*)(ws + WS_QKV))
#define OATT ((bf16*)(ws + WS_OATT))
#define UD ((bf16*)(ws + WS_UD))
#define lists ((int*)(ws + WS_LIST))
#define pml ((float*)(ws + WS_PML))
#define PO ((bf16*)(ws + WS_PO))
#define WM13 ((bf16*)(ws + WS_WM13))
#define WM2 ((bf16*)(ws + WS_WM2))
#define UM ((bf16*)(ws + WS_UM))
__global__ void __launch_bounds__(NWAVES * 64, 2) mk_fwd(Args args) {
    extern __shared__ __attribute__((aligned(16))) unsigned char lds[];
    LAS unsigned char* L = (LAS unsigned char*)lds;
    volatile LAS unsigned* MISC = (volatile LAS unsigned*)(L + MISC_OFF);
    const int tid = threadIdx.x, lane = tid & 63, wave = __builtin_amdgcn_readfirstlane(tid >> 6);
    const int G = gridDim.x; const int bx = blockIdx.x; const int vcu = (G % 8 == 0) ? (bx % 8) * (G / 8) + bx / 8 : bx;
    const int gw = vcu * NWAVES + wave, NGW = G * NWAVES;
    gu32* ctl0 = (gu32*)(args.ws + WS_CTL);
    for (int u = tid; u < (LDS_BYTES - LDSCTL_OFF) / 4; u += NWAVES * 64) ((LAS unsigned*)(L + LDSCTL_OFF))[u] = 0u;
    __syncthreads();
    XcdBarrier bar; bar.bar = (unsigned*)(ctl0 + CW_BAR); bar.x = 0; bar.st = nullptr;
    if (!MK_PER_PHASE) bar = xcd_barrier_post((unsigned*)(ctl0 + CW_BAR), MISC + 8);
#define GRID_BAR() do { if (!MK_PER_PHASE) xcd_barrier(bar); } while (0)
    const int lo = args.ph_lo, hi_ph = args.ph_hi;
#ifndef PH_MASK
#define PH_MASK 0xFFFFFFFFu
#endif
#define IN(k) (((PH_MASK >> (k)) & 1u) && lo <= (k) && (k) < hi_ph)
#define SEAM(k) do { if (IN((k) + 1)) GRID_BAR(); } while (0)
#ifndef DUP_MASK
#define DUP_MASK 0u
#endif
#define NREP(k) ((((DUP_MASK) >> (k)) & 1u) ? 2 : 1)

    if (IN(0)) { PH_PTRS; for (int rep_ = 0; rep_ < NREP(0); ++rep_) {
        LAS float* scr = (LAS float*)(L + RING_OFF + wave * 16384);
        constexpr int I_QKV = (DM / 64) * (NQKV / 32), I_O = (DM / 64) * (DM / 32), I_13 = (DM / 64) * (FF0 / 32), I_2 = (FF0 / 64) * (DM / 32);
        constexpr int NITEMS = 2 * I_QKV + 2 * I_O + 2 * I_13 + I_2;
        for (int it = gw; it < NITEMS; it += NGW) {
            int r = it;
            if (r < I_QKV) { transpose_item<1>(da_wqkv, DM, NQKV, W0qkv, scr, r, lane); continue; } r -= I_QKV;
            if (r < I_QKV) { transpose_item<2>(mb_wqkv, DM, NQKV, W1qkv, scr, r, lane); continue; } r -= I_QKV;
            if (r < I_O) { transpose_item<0>(da_wo, DM, DM, W0o, scr, r, lane); continue; } r -= I_O;
            if (r < I_O) { transpose_item<0>(mb_wo, DM, DM, W1o, scr, r, lane); continue; } r -= I_O;
            if (r < I_13) { transpose_item<3>(ffn_w1, DM, FF0, W013, scr, r, lane); continue; } r -= I_13;
            if (r < I_13) { transpose_item<4>(ffn_w3, DM, FF0, W013, scr, r, lane); continue; } r -= I_13;
            transpose_item<0>(ffn_w2, FF0, DM, W02, scr, r, lane);
        }
        {
            const int gt = (vcu * NWAVES + wave) * 64 + lane, NT_ = G * NWAVES * 64;
            for (int e = gt; e < SEQ * 8; e += NT_) { const int pos = e >> 3, i = e & 7; const float ang = (float)pos * (*(const float __attribute__((address_space(4)))*)(ka + 176 + 4 * i)); rope64[e] = cosf(ang); rope64[SEQ * 8 + e] = sinf(ang); }
            for (int e = gt; e < SEQ * 16; e += NT_) { const int pos = e >> 4, i = e & 15; const float ang = (float)pos * (*(const float __attribute__((address_space(4)))*)(ka + 208 + 4 * i)); rope128[e] = cosf(ang); rope128[SEQ * 16 + e] = sinf(ang); }
        }
        rmsnorm_phase(IN_X, norm_mix, Hb, gw, NGW, lane);
        } SEAM(0);
    }
    if (IN(1)) { PH_PTRS; for (int rep_ = 0; rep_ < NREP(1); ++rep_) {
        pg8::ABDense ab{Hb, W0qkv, DM}; pg8::TileOrder S; S.init(TOK / 256, NQKV / 256, G, bx);
        pg8::EpiQKV<64> E{QKV, NQKV, rope64, rope64 + SEQ * 8, 0.125f * LOG2E};
        pg8::gemm_phase<pg8::EpiQKV<64>, pg8::ABDense>(L + RING_OFF, ab, S, E);
        } SEAM(1);
    }
    if (IN(2)) { PH_PTRS; for (int rep_ = 0; rep_ < NREP(2); ++rep_) {
        const moba::DaOrder AS(vcu, G);
        moba::dattn_phase<moba::DaOrder>((char*)lds + RING_OFF, (const moba::bf16*)QKV, (moba::bf16*)OATT, AS);
        } SEAM(2);
    }
    if (IN(3)) { PH_PTRS; for (int rep_ = 0; rep_ < NREP(3); ++rep_) {
        float lam;
        { const float a = wave_sum(da_lq1[lane] * da_lk1[lane]), b = wave_sum(da_lq2[lane] * da_lk2[lane]); lam = expf(a) - expf(b) + LAMBDA_INIT0; }
        const int hh = lane >> 3, dd = (lane & 7) * 16;
        float gsub[16];
#pragma unroll
        for (int k = 0; k < 16; ++k) gsub[k] = da_subln[dd + k] * (1.f - LAMBDA_INIT0);
        for (int m = gw; m < TOK; m += NGW) {
            const bf16* o1 = OATT + (size_t)m * 2048 + (2 * hh) * 128 + dd; const bf16* o2 = o1 + 128;
            const v4u a0 = *(const GAS v4u*)o1, a1 = *(const GAS v4u*)(o1 + 8), b0 = *(const GAS v4u*)o2, b1 = *(const GAS v4u*)(o2 + 8);
            float d[16]; float ss = 0.f;
#pragma unroll
            for (int k = 0; k < 4; ++k) {
                const unsigned ua = a0[k], ub = b0[k], uc = a1[k], ud = b1[k];
                d[2 * k] = __uint_as_float(ua << 16) - lam * __uint_as_float(ub << 16); d[2 * k + 1] = __uint_as_float(ua & 0xffff0000u) - lam * __uint_as_float(ub & 0xffff0000u);
                d[8 + 2 * k] = __uint_as_float(uc << 16) - lam * __uint_as_float(ud << 16); d[8 + 2 * k + 1] = __uint_as_float(uc & 0xffff0000u) - lam * __uint_as_float(ud & 0xffff0000u); }
#pragma unroll
            for (int k = 0; k < 16; ++k) ss += d[k] * d[k];
            ss += __shfl_xor(ss, 1); ss += __shfl_xor(ss, 2); ss += __shfl_xor(ss, 4);
            const float rstd = 1.f / sqrtf(ss * (1.f / 128.f) + SUBLN_EPS);
            v4u w0, w1;
#pragma unroll
            for (int k = 0; k < 4; ++k) { w0[k] = pk2(d[2 * k] * rstd * gsub[2 * k], d[2 * k + 1] * rstd * gsub[2 * k + 1]); w1[k] = pk2(d[8 + 2 * k] * rstd * gsub[8 + 2 * k], d[8 + 2 * k + 1] * rstd * gsub[8 + 2 * k + 1]); }
            bf16* od = Hb + (size_t)m * DM + hh * 128 + dd;
            *(GAS v4u*)od = w0; *(GAS v4u*)(od + 8) = w1;
        }
        } SEAM(3);
    }
    if (IN(4)) { PH_PTRS; for (int rep_ = 0; rep_ < NREP(4); ++rep_) {
        pg8::ABDense ab{Hb, W0o, DM}; pg8::TileOrder S; S.init(TOK / 256, DM / 256, G, bx);
        pg8::EpiRes E{IN_X, out, DM, nullptr};
        pg8::gemm_phase<pg8::EpiRes, pg8::ABDense>(L + RING_OFF, ab, S, E);
        } SEAM(4);
    }
    if (IN(5)) { PH_PTRS; for (int rep_ = 0; rep_ < NREP(5); ++rep_) rmsnorm_phase(out, norm_ffn, QKV, gw, NGW, lane); SEAM(5); }
    if (IN(6)) { PH_PTRS; for (int rep_ = 0; rep_ < NREP(6); ++rep_) {
        pg8::ABDense ab{QKV, W013, DM}; pg8::TileOrder S; S.init(TOK / 256, (2 * FF0) / 256, G, bx);
        pg8::EpiSwiGLU E{UD, FF0, nullptr};
        pg8::gemm_phase<pg8::EpiSwiGLU, pg8::ABDense>(L + RING_OFF, ab, S, E);
        } SEAM(6);
    }
    if (IN(7)) { PH_PTRS; for (int rep_ = 0; rep_ < NREP(7); ++rep_) {
        pg8::ABDense ab{UD, W02, FF0}; pg8::TileOrder S; S.init(TOK / 256, DM / 256, G, bx);
        pg8::EpiRes E{out, out, DM, nullptr};
        pg8::gemm_phase<pg8::EpiRes, pg8::ABDense>(L + RING_OFF, ab, S, E);
        } SEAM(7);
    }
    if (IN(8)) { PH_PTRS; for (int rep_ = 0; rep_ < NREP(8); ++rep_) rmsnorm_phase(out, norm_mix + DM, Hb, gw, NGW, lane); SEAM(8); }
    if (IN(9)) { PH_PTRS; for (int rep_ = 0; rep_ < NREP(9); ++rep_) {
        pg8::ABDense ab{Hb, W1qkv, DM}; pg8::TileOrder S; S.init(TOK / 256, NQKV / 256, G, bx);
        pg8::EpiQKV<128> E{QKV, NQKV, rope128, rope128 + SEQ * 16, 0.08838834764831845f * LOG2E};
        pg8::gemm_phase<pg8::EpiQKV<128>, pg8::ABDense>(L + RING_OFF, ab, S, E);
        } SEAM(9);
    }
    if (IN(10)) { PH_PTRS; for (int rep_ = 0; rep_ < NREP(10); ++rep_) {
        LAS float* red = (LAS float*)(L + RING_OFF);
        for (int u = vcu; u < BATCH * MB_H * MB_NB; u += G) {
            const int b = u >> 8, h = (u >> 5) & 7, j = u & 31;
            const int dch = tid & 15, kg = tid >> 4;
            const bf16* kp = QKV + (size_t)(b * SEQ + j * MB_L + kg * 8) * NQKV + 1024 + h * 128 + dch * 8;
            float s[8] = {0.f, 0.f, 0.f, 0.f, 0.f, 0.f, 0.f, 0.f};
#pragma unroll
            for (int k = 0; k < 8; ++k) { const v4u v = *(const GAS v4u*)(kp + (size_t)k * NQKV);
#pragma unroll
                for (int q = 0; q < 4; ++q) { s[2 * q] += __uint_as_float(v[q] << 16); s[2 * q + 1] += __uint_as_float(v[q] & 0xffff0000u); } }
#pragma unroll
            for (int q = 0; q < 8; ++q) red[kg * 128 + dch * 8 + q] = s[q];
            __syncthreads();
            if (tid < 128) { float a = 0.f;
#pragma unroll 8
                for (int k = 0; k < 32; ++k) a += red[k * 128 + tid];
                kmean[(size_t)u * 128 + tid] = a * (1.f / 256.f); }
            __syncthreads();
        }
        } SEAM(10);
    }
    if (IN(11)) { PH_PTRS; for (int rep_ = 0; rep_ < NREP(11); ++rep_) {
        LAS float* km = (LAS float*)(L + RING_OFF);
        LAS float* mv = (LAS float*)(L + RING_OFF + 16384);
        LAS int* mi = (LAS int*)(L + RING_OFF + 16384 + 3072);
        LAS int* lcnt = (LAS int*)(L + RING_OFF + 24576);
        for (int u = vcu; u < BATCH * MB_H * (MB_NB - 1); u += G) {
            const int bh = u / 31, o = 1 + u % 31, b = bh >> 3, h = bh & 7;
            for (int e = tid; e < 32 * 128; e += 512) km[e] = kmean[(size_t)bh * 4096 + e];
            if (tid < 32) lcnt[tid] = 0;
            __syncthreads();
            const int ql = tid & 255, half = tid >> 8; const int s = o * 256 + ql;
            const bf16* qp = QKV + (size_t)(b * SEQ + s) * NQKV + h * 128;
            float qf[128];
#pragma unroll
            for (int c = 0; c < 16; ++c) { const v4u v = *(const GAS v4u*)(qp + c * 8);
#pragma unroll
                for (int q = 0; q < 4; ++q) { qf[c * 8 + 2 * q] = __uint_as_float(v[q] << 16); qf[c * 8 + 2 * q + 1] = __uint_as_float(v[q] & 0xffff0000u); } }
            float v0 = -INFINITY, v1 = -INFINITY, v2 = -INFINITY; int i0 = -1, i1 = -1, i2 = -1;
            for (int jj = 0; jj < 16; ++jj) { const int j = half * 16 + jj;
                if (j < o) { float g = 0.f; const LAS f32x4* kr = (const LAS f32x4*)(km + j * 128);
#pragma unroll
                    for (int c = 0; c < 32; ++c) { const f32x4 kv = kr[c]; g += qf[4 * c] * kv.x + qf[4 * c + 1] * kv.y + qf[4 * c + 2] * kv.z + qf[4 * c + 3] * kv.w; }
                    if (g > v0) { v2 = v1; i2 = i1; v1 = v0; i1 = i0; v0 = g; i0 = j; } else if (g > v1) { v2 = v1; i2 = i1; v1 = g; i1 = j; } else if (g > v2) { v2 = g; i2 = j; } } }
            if (half == 1) { mv[ql * 3] = v0; mv[ql * 3 + 1] = v1; mv[ql * 3 + 2] = v2; mi[ql * 3] = i0; mi[ql * 3 + 1] = i1; mi[ql * 3 + 2] = i2; }
            __syncthreads();
            int lp0 = 0, lp1 = 0, lp2 = 0;
            if (half == 0) {
#pragma unroll
                for (int k = 0; k < 3; ++k) { const float g = mv[ql * 3 + k]; const int j = mi[ql * 3 + k];
                    if (j >= 0) { if (g > v0) { v2 = v1; i2 = i1; v1 = v0; i1 = i0; v0 = g; i0 = j; } else if (g > v1) { v2 = v1; i2 = i1; v1 = g; i1 = j; } else if (g > v2) { v2 = g; i2 = j; } } }
                if (i0 >= 0) lp0 = __hip_atomic_fetch_add(&lcnt[i0], 1, __ATOMIC_RELAXED, __HIP_MEMORY_SCOPE_WORKGROUP);
                if (i1 >= 0) lp1 = __hip_atomic_fetch_add(&lcnt[i1], 1, __ATOMIC_RELAXED, __HIP_MEMORY_SCOPE_WORKGROUP);
                if (i2 >= 0) lp2 = __hip_atomic_fetch_add(&lcnt[i2], 1, __ATOMIC_RELAXED, __HIP_MEMORY_SCOPE_WORKGROUP);
            }
            __syncthreads();
            if (tid < 32 && rep_ == 0) { const int n = lcnt[tid]; lcnt[32 + tid] = n ? (int)__hip_atomic_fetch_add(ctl + CW_MOBACNT + bh * 32 + tid, (unsigned)n, RLX_AGENT) : 0; }
            __syncthreads();
            if (half == 0 && rep_ == 0) { int* lb = lists + (size_t)bh * LIST_PER_BH;
                if (i0 >= 0) lb[list_off(i0) + lcnt[32 + i0] + lp0] = s;
                if (i1 >= 0) lb[list_off(i1) + lcnt[32 + i1] + lp1] = s | (1 << 16);
                if (i2 >= 0) lb[list_off(i2) + lcnt[32 + i2] + lp2] = s | (2 << 16); }
            __syncthreads();
        }
        } SEAM(11);
    }
    if (IN(12)) { PH_PTRS; for (int rep_ = 0; rep_ < NREP(12); ++rep_) {
        LAS int* pre = (LAS int*)(L + 102400);
        { const unsigned c0 = __hip_atomic_load(ctl + CW_MOBACNT + tid, RLX_AGENT), c1 = __hip_atomic_load(ctl + CW_MOBACNT + 512 + tid, RLX_AGENT);
          pre[tid] = (int)((c0 + 255u) >> 8); pre[512 + tid] = (int)((c1 + 255u) >> 8); }
        __syncthreads();
        if (tid == 0) { int a = 0; for (int k = 0; k < 1024; ++k) { const int n = pre[k]; pre[k] = a; a += n; } pre[1024] = a; }
        __syncthreads();
        const int nlist = pre[1024], ntot = 1024 + nlist;
        const int wl = wave * 32 + (lane & 31);
        for (int u = vcu; u < ntot; u += G) {
            const bool own = u < 1024;
            int b, h, kb, s, dst, mli, ostride; moba::bf16* obase; float* mlp;
            if (own) {
                b = u >> 8; h = (u >> 5) & 7; kb = u & 31; s = kb * 256 + wl; dst = b * SEQ + s; mli = (b * 8 + h) * SEQ + s; ostride = DM; obase = (moba::bf16*)Hb + h * 128; mlp = ownml;
            } else {
                const int lu = u - 1024; int loI = 0, hiI = 1024;
                while (hiI - loI > 1) { const int mid = (loI + hiI) >> 1; if (pre[mid] <= lu) loI = mid; else hiI = mid; }
                const int bhj = loI, chunk = lu - pre[bhj], bh = bhj >> 5; kb = bhj & 31; b = bh >> 3; h = bh & 7;
                const int cnt = (int)__hip_atomic_load(ctl + CW_MOBACNT + bhj, RLX_AGENT);
                const int ei = chunk * 256 + wl; const bool valid = ei < cnt;
                const int ent = valid ? lists[(size_t)bh * LIST_PER_BH + list_off(kb) + ei] : 0;
                s = ent & 0xffff; mli = (bh * SEQ + s) * 3 + (ent >> 16); dst = valid ? mli : -1; ostride = 128; obase = (moba::bf16*)PO; mlp = pml;
            }
            const moba::bf16* qrow = (const moba::bf16*)QKV + ((size_t)b * SEQ + s) * NQKV + h * 128;
            const moba::bf16* Kh = (const moba::bf16*)QKV + ((size_t)b * SEQ + kb * 256) * NQKV + 1024 + h * 128;
            moba::moba_unit(own, qrow, Kh, Kh + 1024, obase, ostride, dst, mlp, mli, wl, (char*)lds);
        }
        } SEAM(12);
    }
    if (IN(13)) { PH_PTRS; for (int rep_ = 0; rep_ < NREP(13); ++rep_) {
        const int hh = lane >> 3, dd = (lane & 7) * 16;
        for (int m = gw; m < TOK; m += NGW) {
            const int b = m >> 13, s = m & 8191, nv = (s >> 8) < 3 ? (s >> 8) : 3; const int qi = (b * 8 + hh) * SEQ + s;
            float mm[4], ll[4]; mm[0] = ownml[2 * (size_t)qi]; ll[0] = ownml[2 * (size_t)qi + 1]; float M = mm[0];
#pragma unroll
            for (int r = 0; r < 3; ++r) { if (r < nv) { mm[1 + r] = pml[2 * ((size_t)qi * 3 + r)]; ll[1 + r] = pml[2 * ((size_t)qi * 3 + r) + 1]; M = fmaxf(M, mm[1 + r]); } else { mm[1 + r] = -1e30f; ll[1 + r] = 0.f; } }
            float w[4], wsum = 0.f;
#pragma unroll
            for (int r = 0; r < 4; ++r) { w[r] = ll[r] * __builtin_amdgcn_exp2f(mm[r] - M); wsum += w[r]; }
            const float inv = 1.f / wsum;
            float acc16[16];
            bf16* op = Hb + (size_t)m * DM + hh * 128 + dd;
            { const v4u a0 = *(const GAS v4u*)op, a1 = *(const GAS v4u*)(op + 8); const float ww = w[0] * inv;
#pragma unroll
              for (int k = 0; k < 4; ++k) { acc16[2 * k] = ww * __uint_as_float(a0[k] << 16); acc16[2 * k + 1] = ww * __uint_as_float(a0[k] & 0xffff0000u); acc16[8 + 2 * k] = ww * __uint_as_float(a1[k] << 16); acc16[8 + 2 * k + 1] = ww * __uint_as_float(a1[k] & 0xffff0000u); } }
#pragma unroll
            for (int r = 0; r < 3; ++r) if (r < nv) { const bf16* pp = PO + ((size_t)qi * 3 + r) * 128 + dd; const v4u a0 = *(const GAS v4u*)pp, a1 = *(const GAS v4u*)(pp + 8); const float ww = w[1 + r] * inv;
#pragma unroll
                for (int k = 0; k < 4; ++k) { acc16[2 * k] += ww * __uint_as_float(a0[k] << 16); acc16[2 * k + 1] += ww * __uint_as_float(a0[k] & 0xffff0000u); acc16[8 + 2 * k] += ww * __uint_as_float(a1[k] << 16); acc16[8 + 2 * k + 1] += ww * __uint_as_float(a1[k] & 0xffff0000u); } }
            v4u w0, w1;
#pragma unroll
            for (int k = 0; k < 4; ++k) { w0[k] = pk2(acc16[2 * k], acc16[2 * k + 1]); w1[k] = pk2(acc16[8 + 2 * k], acc16[8 + 2 * k + 1]); }
            *(GAS v4u*)op = w0; *(GAS v4u*)(op + 8) = w1;
        }
        } SEAM(13);
    }
    if (IN(14)) { PH_PTRS; for (int rep_ = 0; rep_ < NREP(14); ++rep_) {
        pg8::ABDense ab{Hb, W1o, DM}; pg8::TileOrder S; S.init(TOK / 256, DM / 256, G, bx);
        pg8::EpiRes E{out, out, DM, nullptr};
        pg8::gemm_phase<pg8::EpiRes, pg8::ABDense>(L + RING_OFF, ab, S, E);
        } SEAM(14);
    }
    if (IN(15)) { PH_PTRS; for (int rep_ = 0; rep_ < NREP(15); ++rep_) {
        {
            const int gt = (vcu * NWAVES + wave) * 64 + lane, NT_ = G * NWAVES * 64;
            for (int e = gt; e < 2 * SLOTS; e += NT_) { slot_tok[e] = -1; slot_gate[e] = 0.f; }
        }
        if (rep_ == 0) {
            f32x4 gv[4]; load_gain(norm_ffn + DM, gv, lane);
            float wr_[16][8];
#pragma unroll
            for (int j = 0; j < 4; ++j)
#pragma unroll
                for (int q = 0; q < 4; ++q) { const int k = 4 * lane + 256 * j + q; const f32x4 a = *(const GAS f32x4*)(moe_router + (size_t)k * 8), c = *(const GAS f32x4*)(moe_router + (size_t)k * 8 + 4);
                    wr_[4 * j + q][0] = a.x; wr_[4 * j + q][1] = a.y; wr_[4 * j + q][2] = a.z; wr_[4 * j + q][3] = a.w; wr_[4 * j + q][4] = c.x; wr_[4 * j + q][5] = c.y; wr_[4 * j + q][6] = c.z; wr_[4 * j + q][7] = c.w; }
            for (int m = gw; m < TOK; m += NGW) {
                f32x4 v[4]; rms_row(out + (size_t)m * DM, gv, v, lane); store_row_bf16(Hb + (size_t)m * DM, v, lane);
                float lg[8];
#pragma unroll
                for (int e = 0; e < 8; ++e) { float a = 0.f;
#pragma unroll
                    for (int j = 0; j < 4; ++j) a += v[j].x * wr_[4 * j][e] + v[j].y * wr_[4 * j + 1][e] + v[j].z * wr_[4 * j + 2][e] + v[j].w * wr_[4 * j + 3][e];
                    lg[e] = wave_sum(a); }
                int e0 = 0; float l0 = lg[0];
#pragma unroll
                for (int e = 1; e < 8; ++e) if (lg[e] > l0) { l0 = lg[e]; e0 = e; }
                int e1 = -1; float l1 = -INFINITY;
#pragma unroll
                for (int e = 0; e < 8; ++e) if (e != e0 && lg[e] > l1) { l1 = lg[e]; e1 = e; }
                if (lane == 0) {
                    const float g0 = 1.f / (1.f + expf(l1 - l0)), g1 = 1.f - g0;
                    const int p0 = (int)__hip_atomic_fetch_add(ctl + CW_MOECNT + e0, 1u, RLX_AGENT), p1 = (int)__hip_atomic_fetch_add(ctl + CW_MOECNT + 8 + e1, 1u, RLX_AGENT);
                    tok_e[m] = e0; tok_e[TOK + m] = e1; tok_pos[m] = p0; tok_pos[TOK + m] = p1; tok_gate[m] = g0; tok_gate[TOK + m] = g1;
                }
            }
        }
        {
            LAS float* scr = (LAS float*)(L + RING_OFF + wave * 16384);
            constexpr int I_1 = (DM / 64) * (FF1 / 32), I_2 = (FF1 / 64) * (DM / 32), PER_E = 2 * I_1 + I_2;
            for (int it = gw; it < NEXP * PER_E; it += NGW) {
                const int e = it / PER_E; int r = it % PER_E;
                if (r < I_1) { transpose_item<3>(moe_w1 + (size_t)e * DM * FF1, DM, FF1, WM13 + (size_t)e * 2 * FF1 * DM, scr, r, lane); continue; } r -= I_1;
                if (r < I_1) { transpose_item<4>(moe_w3 + (size_t)e * DM * FF1, DM, FF1, WM13 + (size_t)e * 2 * FF1 * DM, scr, r, lane); continue; } r -= I_1;
                transpose_item<0>(moe_w2 + (size_t)e * FF1 * DM, FF1, DM, WM2 + (size_t)e * DM * FF1, scr, r, lane);
            }
        }
        } SEAM(15);
    }
#define MOE_CUM() do { if (tid < 2) { int a = 0; for (int e = 0; e < 8; ++e) { MISC[16 + 9 * tid + e] = (unsigned)a; a += (int)((__hip_atomic_load(ctl + CW_MOECNT + 8 * tid + e, RLX_AGENT) + 255u) >> 8); } MISC[16 + 9 * tid + 8] = (unsigned)a; } __syncthreads(); } while (0)
    if (IN(16)) { PH_PTRS; for (int rep_ = 0; rep_ < NREP(16); ++rep_) {
        MOE_CUM();
        const int gt = (vcu * NWAVES + wave) * 64 + lane, NT_ = G * NWAVES * 64;
        for (int e = gt; e < 2 * TOK; e += NT_) { const int r = e >= TOK ? 1 : 0; const int ex = tok_e[e]; const int slot = (int)MISC[16 + 9 * r + ex] * 256 + tok_pos[e];
            slot_tok[r * SLOTS + slot] = e - r * TOK; slot_gate[r * SLOTS + slot] = tok_gate[e]; }
        } SEAM(16);
    }
#define MOE_UP(r) do { MOE_CUM(); \
        pg8::ABMoeUp ab{Hb, WM13, DM, slot_tok + (r) * SLOTS, (const LAS int*)(L + MISC_OFF + 4 * (16 + 9 * (r))), (size_t)2 * FF1 * DM}; \
        pg8::TileOrder S; S.init((int)MISC[16 + 9 * (r) + 8], (2 * FF1) / 256, G, bx); \
        pg8::EpiSwiGLU E{UM, FF1, slot_gate + (r) * SLOTS}; \
        pg8::gemm_phase<pg8::EpiSwiGLU, pg8::ABMoeUp>(L + RING_OFF, ab, S, E); } while (0)
#define MOE_DOWN(r) do { MOE_CUM(); \
        pg8::ABMoeDown ab{UM, WM2, FF1, (const LAS int*)(L + MISC_OFF + 4 * (16 + 9 * (r))), (size_t)DM * FF1}; \
        pg8::TileOrder S; S.init((int)MISC[16 + 9 * (r) + 8], DM / 256, G, bx); \
        pg8::EpiRes E{out, out, DM, slot_tok + (r) * SLOTS}; \
        pg8::gemm_phase<pg8::EpiRes, pg8::ABMoeDown>(L + RING_OFF, ab, S, E); } while (0)
    if (IN(17)) { PH_PTRS; for (int rep_ = 0; rep_ < NREP(17); ++rep_) MOE_UP(0); SEAM(17); }
    if (IN(18)) { PH_PTRS; MOE_DOWN(0); SEAM(18); }
    if (IN(19)) { PH_PTRS; for (int rep_ = 0; rep_ < NREP(19); ++rep_) MOE_UP(1); SEAM(19); }
    if (IN(20)) { PH_PTRS; MOE_DOWN(1); SEAM(20); }
    if (IN(21)) { PH_PTRS;
        f32x4 gv[4]; load_gain(final_norm, gv, lane);
        for (int m = gw; m < TOK; m += NGW) { f32x4 v[4]; rms_row(out + (size_t)m * DM, gv, v, lane);
            GAS f32x4* o = (GAS f32x4*)(out + (size_t)m * DM) + lane;
#pragma unroll
            for (int j = 0; j < 4; ++j) o[64 * j] = v[j]; }
    }
#undef IN
#undef SEAM
#undef GRID_BAR
}
constexpr int N_PHASES = 22;

extern "C" void kernel_launch(void* const* d_in, const int* in_sizes, int n_in, void* d_out, int out_size, void* d_ws, size_t ws_size, hipStream_t stream) {
    static int grid = 0;
    if (grid == 0) {
        if (n_in != 20 || in_sizes[0] != TOK * DM || out_size != TOK * DM || ws_size < WS_END) { fprintf(stderr, "kernel_launch: shape / workspace mismatch (n_in %d, in0 %d, out %d, ws %zu, need %zu); nothing launched\n", n_in, n_in > 0 ? in_sizes[0] : -1, out_size, ws_size, (size_t)WS_END); grid = -1; return; }
        int dev = 0, cus = 0, per_cu = 0;
        if (hipGetDevice(&dev) != hipSuccess || hipDeviceGetAttribute(&cus, hipDeviceAttributeMultiprocessorCount, dev) != hipSuccess) { grid = -1; return; }
        if (hipFuncSetAttribute((const void*)mk_fwd, hipFuncAttributeMaxDynamicSharedMemorySize, LDS_BYTES) != hipSuccess) { fprintf(stderr, "kernel_launch: hipFuncSetAttribute failed\n"); grid = -1; return; }
        if (hipOccupancyMaxActiveBlocksPerMultiprocessor(&per_cu, (const void*)mk_fwd, NWAVES * 64, LDS_BYTES) != hipSuccess || per_cu < 1) fprintf(stderr, "kernel_launch: occupancy query reports %d workgroups per CU\n", per_cu);
        (void)hipGetLastError();
        grid = cus;
    }
    if (grid < 0) return;
    if (hipMemsetAsync((char*)d_ws + WS_CTL, 0, CTL_ZERO_BYTES, stream) != hipSuccess) return;
    Args a{};
    for (int i = 0; i < 20; ++i) a.in[i] = (const float*)d_in[i];
    a.out = (float*)d_out; a.ws = (unsigned char*)d_ws;
    for (int i = 0; i < 8; ++i) a.inv64[i] = (float)pow(500000.0, -(double)(2 * i) / 16.0);
    for (int i = 0; i < 16; ++i) a.inv128[i] = (float)pow(500000.0, -(double)(2 * i) / 32.0);
#if MK_PER_PHASE
    for (int p = 0; p < N_PHASES; ++p) { a.ph_lo = p; a.ph_hi = p + 1; hipLaunchKernelGGL(mk_fwd, dim3(grid), dim3(NWAVES * 64), LDS_BYTES, stream, a); }
#else
    a.ph_lo = 0; a.ph_hi = N_PHASES;
    hipLaunchKernelGGL(mk_fwd, dim3(grid), dim3(NWAVES * 64), LDS_BYTES, stream, a);
#endif
    const hipError_t le = hipPeekAtLastError();
    if (le != hipSuccess) fprintf(stderr, "kernel_launch: launch failed: %s\n", hipGetErrorName(le));
}
```

```cpp
#include <hip/hip_runtime.h>
#include <hip/hip_bf16.h>
#include <cstdio>
#include <cstdint>
#include <cmath>
namespace pg8 {
#define PG8_LAS __attribute__((address_space(3)))
typedef unsigned short bf16_t;
typedef short bf16x8 __attribute__((ext_vector_type(8)));
typedef float f32x4 __attribute__((ext_vector_type(4)));
typedef unsigned u32x4 __attribute__((ext_vector_type(4)));
constexpr int BM = 256, BK = 64, HALF = 128, HTB = HALF * BK * 2  , STAGE_BYTES = 8 * HTB, NXCD = 8, WGM = 8;

__host__ __device__ __forceinline__ int lds_byte(int r, int c) { const int st = (r >> 4) * 2 + (c >> 5), rr = r & 15, cc = c & 31, ob = rr * 64 + cc * 2; return st * 1024 + (ob ^ (((ob >> 9) & 1) << 5)); }
__host__ __device__ __forceinline__ void stage_rc(int b, int& R, int& C) { const int st = b / 1024, sb = b % 1024, swz = sb ^ (((sb >> 9) & 1) << 5); R = (st >> 1) * 16 + swz / 64; C = (st & 1) * 32 + (swz % 64) / 2; }
__host__ __device__ __forceinline__ int perm32(int rho) { const int n = rho >> 4, i = rho & 15; return 8 * (i >> 2) + 4 * n + (i & 3); }

struct Unit { int pm, pn; };

struct TileOrder {
    int nM, nN, nwg, G, c;
    __device__ __forceinline__ void init(int nM_, int nN_, int G_, int c_) { nM = nM_; nN = nN_; nwg = nM * nN; G = G_; c = c_; }
    __device__ __forceinline__ bool next(int i, Unit& u) const {
        const long L = (long)i * G + c; if (L >= nwg) return false;
        int wgid = (int)L; { const int q = nwg / NXCD, r = nwg % NXCD, xcd = wgid % NXCD, off = wgid / NXCD; wgid = (xcd < r ? xcd * (q + 1) : r * (q + 1) + (xcd - r) * q) + off; }
        const int nig = WGM * nN, gid = wgid / nig, fm = gid * WGM, gsz = (nM - fm) < WGM ? (nM - fm) : WGM;
        u.pm = fm + ((wgid % nig) % gsz); u.pn = (wgid % nig) / gsz; return true;
    }
};

struct ABDense {
    static constexpr bool GATHER = false;
    const bf16_t* A; const bf16_t* Bt; int K;
    __device__ __forceinline__ const char* abase(const Unit& u) const { return (const char*)A + (size_t)u.pm * BM * K * 2; }
    __device__ __forceinline__ const char* bbase(const Unit& u) const { return (const char*)Bt + (size_t)u.pn * BM * K * 2; }
    __device__ __forceinline__ const int* tokp(const Unit&) const { return nullptr; }
};
struct ABMoeUp {
    static constexpr bool GATHER = true;
    const bf16_t* A; const bf16_t* Bt; int K; const int* slot_tok; const PG8_LAS int* cum; size_t estride;
    __device__ __forceinline__ int expert(int pm) const { int e = 0;
#pragma unroll
        for (int k = 1; k < 8; ++k) e += (pm >= cum[k]) ? 1 : 0; return e; }
    __device__ __forceinline__ const char* abase(const Unit&) const { return (const char*)A; }
    __device__ __forceinline__ const char* bbase(const Unit& u) const { return (const char*)(Bt + (size_t)expert(u.pm) * estride) + (size_t)u.pn * BM * K * 2; }
    __device__ __forceinline__ const int* tokp(const Unit& u) const { return slot_tok + u.pm * BM; }
};
struct ABMoeDown {
    static constexpr bool GATHER = false;
    const bf16_t* A; const bf16_t* Bt; int K; const PG8_LAS int* cum; size_t estride;
    __device__ __forceinline__ int expert(int pm) const { int e = 0;
#pragma unroll
        for (int k = 1; k < 8; ++k) e += (pm >= cum[k]) ? 1 : 0; return e; }
    __device__ __forceinline__ const char* abase(const Unit& u) const { return (const char*)A + (size_t)u.pm * BM * K * 2; }
    __device__ __forceinline__ const char* bbase(const Unit& u) const { return (const char*)(Bt + (size_t)expert(u.pm) * estride) + (size_t)u.pn * BM * K * 2; }
    __device__ __forceinline__ const int* tokp(const Unit&) const { return nullptr; }
};

__device__ __forceinline__ unsigned cvt_pk_bf16(float lo, float hi) { unsigned r; asm volatile("v_cvt_pk_bf16_f32 %0, %1, %2" : "=v"(r) : "v"(lo), "v"(hi)); return r; }

template <int DH> struct EpiQKV {
    static constexpr bool PERM = true;
    bf16_t* O; int ldc; const float* ct; const float* st; float qscale;
    __device__ __forceinline__ void operator()(const f32x4 (&acc)[2][2][4][2], const Unit& u, int wr, int wc, int fr, int fq) const {
        constexpr int NF = DH / 8;
        const int row0 = u.pm * BM + wr * 64 + fr, col0 = u.pn * BM + wc * 32 + 8 * fq;
        const int sect = u.pn >> 2;
        const float sc = (sect == 0) ? qscale : 1.f;
        const bool rot = (sect < 2) && (DH == 64 ? (((wc & 1) == 0) && (fq < 2)) : (wc == 0));
#pragma unroll
        for (int ai = 0; ai < 2; ++ai)
#pragma unroll
            for (int m = 0; m < 4; ++m) {
                const int row = row0 + ai * HALF + m * 16; const int pos = row & 8191;
                f32x4 c4 = (f32x4){1.f, 1.f, 1.f, 1.f}, s4 = (f32x4){0.f, 0.f, 0.f, 0.f};
                if (rot) { c4 = *(const f32x4*)(ct + pos * NF + 4 * fq); s4 = *(const f32x4*)(st + pos * NF + 4 * fq); }
                bf16_t* rowp = O + (size_t)row * ldc + col0;
#pragma unroll
                for (int bj = 0; bj < 2; ++bj) {
                    const f32x4 x1 = acc[ai][bj][m][0], x2 = acc[ai][bj][m][1];
                    f32x4 v0 = (x1 * c4 - x2 * s4) * sc, v1 = (x2 * c4 + x1 * s4) * sc;
                    u32x4 w; w.x = cvt_pk_bf16(v0[0], v0[1]); w.y = cvt_pk_bf16(v0[2], v0[3]); w.z = cvt_pk_bf16(v1[0], v1[1]); w.w = cvt_pk_bf16(v1[2], v1[3]);
                    *(u32x4*)(rowp + bj * HALF) = w; }
            }
    }
};

__device__ __forceinline__ float silu_mul(float a, float b) { return a * b * __builtin_amdgcn_rcpf(1.0f + __builtin_amdgcn_exp2f(-1.4426950408889634f * a)); }
struct EpiSwiGLU {
    static constexpr bool PERM = true;
    bf16_t* O; int ldc; const float* gate;
    __device__ __forceinline__ void operator()(const f32x4 (&acc)[2][2][4][2], const Unit& u, int wr, int wc, int fr, int fq) const {
        const int row0 = u.pm * BM + wr * 64 + fr, col0 = u.pn * HALF + wc * 32 + 8 * fq;
#pragma unroll
        for (int ai = 0; ai < 2; ++ai)
#pragma unroll
            for (int m = 0; m < 4; ++m) {
                const int row = row0 + ai * HALF + m * 16; const float g = gate ? gate[row] : 1.f;
                const f32x4 a0 = acc[ai][0][m][0], a1 = acc[ai][0][m][1], b0 = acc[ai][1][m][0], b1 = acc[ai][1][m][1];
                float v[8];
#pragma unroll
                for (int k = 0; k < 4; ++k) { v[k] = g * silu_mul(a0[k], b0[k]); v[4 + k] = g * silu_mul(a1[k], b1[k]); }
                u32x4 w; w.x = cvt_pk_bf16(v[0], v[1]); w.y = cvt_pk_bf16(v[2], v[3]); w.z = cvt_pk_bf16(v[4], v[5]); w.w = cvt_pk_bf16(v[6], v[7]);
                *(u32x4*)(O + (size_t)row * ldc + col0) = w; }
    }
};
struct EpiRes {
    static constexpr bool PERM = false;
    const float* base; float* out; int ldc; const int* rowmap;
    __device__ __forceinline__ void operator()(const f32x4 (&acc)[2][2][4][2], const Unit& u, int wr, int wc, int fr, int fq) const {
        const int row0 = u.pm * BM + wr * 64 + fr, col0 = u.pn * BM + wc * 32 + 4 * fq;
#pragma unroll
        for (int ai = 0; ai < 2; ++ai)
#pragma unroll
            for (int m = 0; m < 4; ++m) {
                const int row = row0 + ai * HALF + m * 16; const int orow = rowmap ? rowmap[row] : row;
                if (orow >= 0) { const size_t off = (size_t)orow * ldc + col0;
#pragma unroll
                    for (int bj = 0; bj < 2; ++bj)
#pragma unroll
                        for (int n = 0; n < 2; ++n) *(f32x4*)(out + off + bj * HALF + n * 16) = *(const f32x4*)(base + off + bj * HALF + n * 16) + acc[ai][bj][m][n]; }
                if (m & 1) asm volatile("" ::: "memory"); }
    }
};

template <class Epi, class AB>
__device__ __forceinline__ void gemm_phase(PG8_LAS unsigned char* lds, const AB ab, const TileOrder& S, const Epi& E) {
    const int tid = threadIdx.x, wid = __builtin_amdgcn_readfirstlane(tid >> 6), lane = tid & 63, wr = wid >> 2, wc = wid & 3, fr = lane & 15, fq = lane >> 4;
    const int K = ab.K, nt = K / BK;
    int Rr[2], Cc[2]; unsigned voffB[2];
#pragma unroll
    for (int i = 0; i < 2; ++i) { int R, C; stage_rc(tid * 16 + i * 8192, R, C); const int Rb = Epi::PERM ? ((R & ~31) + perm32(R & 31)) : R;
        Rr[i] = R; Cc[i] = C; voffB[i] = (unsigned)(Rb * K + C) * 2u; }
    const size_t kstep = (size_t)(BK * 2);
    const size_t hstep = (size_t)HALF * K * 2;
    const unsigned ldsw = (unsigned)wid * 1024u;
    const int aoff = lds_byte(wr * 64 + fr, fq * 8), boff = lds_byte(wc * 32 + fr, fq * 8);
#define PG8_SA(b, h) (((b) * 2 + (h)) * HTB)
#define PG8_SB(b, h) ((4 + (b) * 2 + (h)) * HTB)
#define PG8_STAGE(bufoff, gbase, voff) do { _Pragma("unroll") for (int _i = 0; _i < 2; ++_i) \
        __builtin_amdgcn_global_load_lds((const unsigned*)((const char*)(gbase) + (voff)[_i]), (PG8_LAS unsigned*)(lds + (bufoff) + ldsw + _i * 8192), 16, 0, 0); } while (0)
#define PG8_LDA(dst, b, h) do { _Pragma("unroll") for (int m = 0; m < 4; ++m) _Pragma("unroll") for (int k = 0; k < 2; ++k) dst[m][k] = *(const PG8_LAS bf16x8*)(lds + PG8_SA(b, h) + aoff + m * 2048 + k * 1024); } while (0)
#define PG8_LDB(dst, b, h) do { _Pragma("unroll") for (int n = 0; n < 2; ++n) _Pragma("unroll") for (int k = 0; k < 2; ++k) dst[n][k] = *(const PG8_LAS bf16x8*)(lds + PG8_SB(b, h) + boff + n * 2048 + k * 1024); } while (0)
#define PG8_MMA(ai, bj, At, Bt) do { __builtin_amdgcn_s_setprio(1); _Pragma("unroll") for (int m = 0; m < 4; ++m) _Pragma("unroll") for (int n = 0; n < 2; ++n) _Pragma("unroll") for (int k = 0; k < 2; ++k) \
        acc[ai][bj][m][n] = __builtin_amdgcn_mfma_f32_16x16x32_bf16(Bt[n][k], At[m][k], acc[ai][bj][m][n], 0, 0, 0); __builtin_amdgcn_s_setprio(0); } while (0)
#define PG8_WAIT_V(n) asm volatile("s_waitcnt vmcnt(" #n ")" ::: "memory")
#define PG8_WAIT_L(n) asm volatile("s_waitcnt lgkmcnt(" #n ")" ::: "memory")
#define PG8_BAR __builtin_amdgcn_s_barrier()
#define PG8_SCHED __builtin_amdgcn_sched_barrier(0)
    Unit cur, nxt; int ui = 0;
    if (!S.next(0, cur)) return;
    f32x4 acc[2][2][4][2];
#pragma unroll
    for (int a = 0; a < 2; ++a)
#pragma unroll
        for (int b = 0; b < 2; ++b)
#pragma unroll
            for (int m = 0; m < 4; ++m)
#pragma unroll
                for (int n = 0; n < 2; ++n) acc[a][b][m][n] = (f32x4){0.f, 0.f, 0.f, 0.f};
    bf16x8 At[4][2], B0[2][2], B1[2][2];
    unsigned cv0[2], cv1[2], nv0[2], nv1[2]; int ntok[4] = {0, 0, 0, 0};
    if constexpr (AB::GATHER) { const int* tp = ab.tokp(cur);
#pragma unroll
        for (int i = 0; i < 2; ++i) { int t0 = tp[Rr[i]], t1 = tp[HALF + Rr[i]]; t0 = t0 < 0 ? 0 : t0; t1 = t1 < 0 ? 0 : t1;
            cv0[i] = (unsigned)(t0 * K + Cc[i]) * 2u; cv1[i] = (unsigned)(t1 * K + Cc[i]) * 2u; }
    } else {
#pragma unroll
        for (int i = 0; i < 2; ++i) { cv0[i] = (unsigned)(Rr[i] * K + Cc[i]) * 2u; cv1[i] = cv0[i] + (unsigned)hstep; }
    }
#pragma unroll
    for (int i = 0; i < 2; ++i) { nv0[i] = cv0[i]; nv1[i] = cv1[i]; }
    const char* cA = ab.abase(cur); const char* cB = ab.bbase(cur);
    PG8_STAGE(PG8_SB(0, 0), cB, voffB); PG8_STAGE(PG8_SB(0, 1), cB + hstep, voffB); PG8_STAGE(PG8_SA(0, 0), cA, cv0); PG8_STAGE(PG8_SA(0, 1), cA, cv1);
    if (wr == 1) PG8_BAR;
    PG8_WAIT_V(2); PG8_BAR;
    PG8_STAGE(PG8_SB(1, 0), cB + kstep, voffB); PG8_STAGE(PG8_SA(1, 0), cA + kstep, cv0); PG8_STAGE(PG8_SB(1, 1), cB + hstep + kstep, voffB);
    PG8_WAIT_V(6); PG8_BAR;
    for (;;) {
        const bool has_next = S.next(ui + 1, nxt);
        const char* nA = has_next ? ab.abase(nxt) : cA; const char* nB = has_next ? ab.bbase(nxt) : cB;
        if constexpr (AB::GATHER) {
            if (has_next) { const int* tp = ab.tokp(nxt);
                asm volatile("global_load_dword %0, %1, off" : "=v"(ntok[0]) : "v"(tp + Rr[0]) : "memory");
                asm volatile("global_load_dword %0, %1, off" : "=v"(ntok[1]) : "v"(tp + Rr[1]) : "memory");
                asm volatile("global_load_dword %0, %1, off" : "=v"(ntok[2]) : "v"(tp + HALF + Rr[0]) : "memory");
                asm volatile("global_load_dword %0, %1, off" : "=v"(ntok[3]) : "v"(tp + HALF + Rr[1]) : "memory"); }
        }
        for (int t = 0; t < nt; t += 2) {
            const bool last = (t == nt - 2);
            const char* a1 = cA + (size_t)(t + 1) * kstep;
            const char* a2 = last ? nA : cA + (size_t)(t + 2) * kstep; const char* b2 = last ? nB : cB + (size_t)(t + 2) * kstep;
            const char* a3 = a2 + kstep; const char* b3 = b2 + kstep;
            unsigned x0[2], x1[2];
            if constexpr (AB::GATHER) {
                if (last && has_next) {
                    asm volatile("s_waitcnt vmcnt(6)" : "+v"(ntok[0]), "+v"(ntok[1]), "+v"(ntok[2]), "+v"(ntok[3]) :: "memory");
#pragma unroll
                    for (int i = 0; i < 2; ++i) { int t0 = ntok[i], t1 = ntok[2 + i]; t0 = t0 < 0 ? 0 : t0; t1 = t1 < 0 ? 0 : t1;
                        nv0[i] = (unsigned)(t0 * K + Cc[i]) * 2u; nv1[i] = (unsigned)(t1 * K + Cc[i]) * 2u; }
                }
#pragma unroll
                for (int i = 0; i < 2; ++i) { x0[i] = last ? nv0[i] : cv0[i]; x1[i] = last ? nv1[i] : cv1[i]; }
            } else {
#pragma unroll
                for (int i = 0; i < 2; ++i) { x0[i] = cv0[i]; x1[i] = cv1[i]; }
            }
            PG8_LDB(B0, 0, 0); PG8_LDB(B1, 0, 1); PG8_SCHED; PG8_LDA(At, 0, 0); PG8_STAGE(PG8_SA(1, 1), a1, cv1);
            PG8_WAIT_V(8); PG8_WAIT_L(0); PG8_BAR; PG8_MMA(0, 0, At, B0); PG8_MMA(0, 1, At, B1); PG8_BAR; PG8_SCHED;
            PG8_LDA(At, 0, 1); PG8_STAGE(PG8_SB(0, 0), b2, voffB); PG8_STAGE(PG8_SB(0, 1), b2 + hstep, voffB); PG8_STAGE(PG8_SA(0, 0), a2, x0);
            PG8_WAIT_V(8); PG8_WAIT_L(0); PG8_BAR; PG8_MMA(1, 0, At, B0); PG8_MMA(1, 1, At, B1); PG8_BAR; PG8_SCHED;
            PG8_LDB(B0, 1, 0); PG8_LDB(B1, 1, 1); PG8_SCHED; PG8_LDA(At, 1, 0); PG8_STAGE(PG8_SA(0, 1), a2, x1);
            PG8_WAIT_V(8); PG8_WAIT_L(0); PG8_BAR; PG8_MMA(0, 0, At, B0); PG8_MMA(0, 1, At, B1); PG8_BAR; PG8_SCHED;
            PG8_LDA(At, 1, 1); PG8_STAGE(PG8_SB(1, 0), b3, voffB); PG8_STAGE(PG8_SB(1, 1), b3 + hstep, voffB); PG8_STAGE(PG8_SA(1, 0), a3, x0);
            PG8_WAIT_V(8); PG8_WAIT_L(0); PG8_BAR; PG8_MMA(1, 0, At, B0); PG8_MMA(1, 1, At, B1); PG8_BAR; PG8_SCHED;
        }
        if (wr == 0) PG8_BAR;
        E(acc, cur, wr, wc, fr, fq);
        if (!has_next) break;
#pragma unroll
        for (int a = 0; a < 2; ++a)
#pragma unroll
            for (int b = 0; b < 2; ++b)
#pragma unroll
                for (int m = 0; m < 4; ++m)
#pragma unroll
                    for (int n = 0; n < 2; ++n) acc[a][b][m][n] = (f32x4){0.f, 0.f, 0.f, 0.f};
        cur = nxt; cA = nA; cB = nB; ++ui;
#pragma unroll
        for (int i = 0; i < 2; ++i) { cv0[i] = nv0[i]; cv1[i] = nv1[i]; }
        if (wr == 1) PG8_BAR;
    }
    PG8_WAIT_V(0);
    PG8_BAR;
#undef PG8_SA
#undef PG8_SB
#undef PG8_STAGE
#undef PG8_LDA
#undef PG8_LDB
#undef PG8_MMA
#undef PG8_WAIT_V
#undef PG8_WAIT_L
#undef PG8_BAR
#undef PG8_SCHED
}
}

namespace moba {
using bf16 = __hip_bfloat16;
using bf16x8 = __attribute__((ext_vector_type(8))) short;
using s16x4  = __attribute__((ext_vector_type(4))) short;
using f32x16 = __attribute__((ext_vector_type(16))) float;
using u32x4  = __attribute__((ext_vector_type(4))) unsigned;
constexpr int D = 128, NW = 8, QBLK = 32, KVBLK = 64, LDK = 3072, NT = 4;
constexpr float THR = 8.f;
constexpr size_t SHM_V = KVBLK * D * 2, SHM_K = KVBLK * D * 2, SHM_ATTN = 2 * SHM_V + 2 * SHM_K + NW * 64 * 4;
#define KSWZ(row, colB) ((row) * 256 + ((colB) ^ (((row) & 7) << 4)))
#define SBAR() __builtin_amdgcn_sched_barrier(0)
__device__ __forceinline__ int crow(int r, int hi) { return (r & 3) + 8 * (r >> 2) + 4 * hi; }
__device__ __forceinline__ unsigned cvtpk(float lo, float hi) { unsigned r; asm volatile("v_cvt_pk_bf16_f32 %0, %1, %2" : "=v"(r) : "v"(lo), "v"(hi)); return r; }
__device__ __forceinline__ void partialSM(f32x16& p0, f32x16& p1, float& m_reg, float& mn, float& alpha) {
  float pmax = p0[0];
#pragma unroll
  for (int r = 1; r < 16; ++r) pmax = fmaxf(pmax, p0[r]);
#pragma unroll
  for (int r = 0; r < 16; ++r) pmax = fmaxf(pmax, p1[r]);
  { auto rr = __builtin_amdgcn_permlane32_swap(__float_as_uint(pmax), __float_as_uint(pmax), false, false);
    pmax = fmaxf(__uint_as_float(rr[0]), __uint_as_float(rr[1])); }
  if (__builtin_expect(__all(pmax - m_reg <= THR), 1)) { mn = m_reg; alpha = 1.f; }
  else { mn = fmaxf(m_reg, pmax); alpha = __builtin_amdgcn_exp2f(m_reg - mn); m_reg = mn; }
#pragma unroll
  for (int r = 0; r < 16; ++r) p0[r] = p0[r] - mn;
#pragma unroll
  for (int r = 0; r < 16; ++r) p1[r] = p1[r] - mn;
#pragma unroll
  for (int r = 0; r < 16; ++r) p0[r] = __builtin_amdgcn_exp2f(p0[r]);
}
__device__ __forceinline__ void finishSM(f32x16& p0, f32x16& p1, float alpha, float& l_reg, bf16x8& pa0, bf16x8& pa1, bf16x8& pa2, bf16x8& pa3) {
#pragma unroll
  for (int r = 0; r < 16; ++r) p1[r] = __builtin_amdgcn_exp2f(p1[r]);
  float ps = 0;
#pragma unroll
  for (int r = 0; r < 16; ++r) ps += p0[r];
#pragma unroll
  for (int r = 0; r < 16; ++r) ps += p1[r];
  { auto rr = __builtin_amdgcn_permlane32_swap(__float_as_uint(ps), __float_as_uint(ps), false, false);
    ps = __uint_as_float(rr[0]) + __uint_as_float(rr[1]); }
  l_reg = l_reg * alpha + ps;
#define PK4(P, BASE, OUT) do { unsigned a0 = cvtpk(P[BASE + 0], P[BASE + 1]), a1 = cvtpk(P[BASE + 2], P[BASE + 3]);   \
    unsigned b0 = cvtpk(P[BASE + 4], P[BASE + 5]), b1 = cvtpk(P[BASE + 6], P[BASE + 7]);                              \
    auto r0 = __builtin_amdgcn_permlane32_swap(a0, b0, false, false); auto r1 = __builtin_amdgcn_permlane32_swap(a1, b1, false, false); \
    u32x4 w = {r0[0], r1[0], r0[1], r1[1]}; OUT = *reinterpret_cast<bf16x8*>(&w); } while (0)
  PK4(p0, 0, pa0); PK4(p0, 8, pa1); PK4(p1, 0, pa2); PK4(p1, 8, pa3);
#undef PK4
}
__device__ __forceinline__ void qkt(f32x16& p0, f32x16& p1, const bf16* Ks, const bf16x8* qr, int r32, int hi) {
  p0 = f32x16{}; p1 = f32x16{};
#pragma unroll
  for (int d0 = 0; d0 < 8; ++d0) { int cb = (d0 * 16 + hi * 8) * 2;
    bf16x8 b0 = *reinterpret_cast<const bf16x8*>((const char*)Ks + KSWZ(r32, cb));
    bf16x8 b1 = *reinterpret_cast<const bf16x8*>((const char*)Ks + KSWZ(32 + r32, cb));
    p0 = __builtin_amdgcn_mfma_f32_32x32x16_bf16(b0, qr[d0], p0, 0, 0, 0);
    p1 = __builtin_amdgcn_mfma_f32_32x32x16_bf16(b1, qr[d0], p1, 0, 0, 0); }
}
__device__ __forceinline__ int v_st(int k, int c) { const int kk = (k & ~0xC) | ((k & 4) << 1) | ((k & 8) >> 1); return ((kk >> 3) * 4 + (c >> 5)) * 512 + ((kk & 7) * 32 + (c & 31)) * 2; }
__device__ __forceinline__ int v_rd_base(int lane) { return ((lane & 3) << 3) | (((lane >> 2) & 3) << 6) | (((lane >> 4) & 1) << 5) | (((lane >> 5) & 1) << 8); }
constexpr int v_rd_off(int d0, int ks, int half) { return d0 * 512 + ks * 4096 + half * 2048; }
template <int OFF> __device__ __forceinline__ s16x4 tr_read(int vb) {
  s16x4 r; asm volatile("ds_read_b64_tr_b16 %0, %1 offset:%2" : "=&v"(r) : "v"(vb), "i"(OFF) : "memory"); return r;
}
template <int D0> __device__ __forceinline__ void pv_one(f32x16& od, int vb, bf16x8 pa0, bf16x8 pa1, bf16x8 pa2, bf16x8 pa3) {
  const s16x4 l0 = tr_read<v_rd_off(D0, 0, 0)>(vb), h0 = tr_read<v_rd_off(D0, 0, 1)>(vb), l1 = tr_read<v_rd_off(D0, 1, 0)>(vb), h1 = tr_read<v_rd_off(D0, 1, 1)>(vb);
  const s16x4 l2 = tr_read<v_rd_off(D0, 2, 0)>(vb), h2 = tr_read<v_rd_off(D0, 2, 1)>(vb), l3 = tr_read<v_rd_off(D0, 3, 0)>(vb), h3 = tr_read<v_rd_off(D0, 3, 1)>(vb);
  asm volatile("s_waitcnt lgkmcnt(0)" ::: "memory"); SBAR();
#define PK(L, H) (bf16x8){L[0], L[1], L[2], L[3], H[0], H[1], H[2], H[3]}
  od = __builtin_amdgcn_mfma_f32_32x32x16_bf16(pa0, PK(l0, h0), od, 0, 0, 0);
  od = __builtin_amdgcn_mfma_f32_32x32x16_bf16(pa1, PK(l1, h1), od, 0, 0, 0);
  od = __builtin_amdgcn_mfma_f32_32x32x16_bf16(pa2, PK(l2, h2), od, 0, 0, 0);
  od = __builtin_amdgcn_mfma_f32_32x32x16_bf16(pa3, PK(l3, h3), od, 0, 0, 0);
#undef PK
}
__device__ __forceinline__ void pv_d0(f32x16* o, int vb, bf16x8 pa0, bf16x8 pa1, bf16x8 pa2, bf16x8 pa3) {
  pv_one<0>(o[0], vb, pa0, pa1, pa2, pa3); pv_one<1>(o[1], vb, pa0, pa1, pa2, pa3); pv_one<2>(o[2], vb, pa0, pa1, pa2, pa3); pv_one<3>(o[3], vb, pa0, pa1, pa2, pa3);
}
__device__ __forceinline__ void cmask(f32x16& p0, f32x16& p1, int tile, int ql, int hi) {
  asm volatile("" : "+v"(ql));
#pragma unroll
  for (int r = 0; r < 16; ++r) { const int kv = 64 * tile + (r & 3) + 8 * (r >> 2) + 4 * hi; if (kv > ql) p0[r] = -1e30f; if (kv + 32 > ql) p1[r] = -1e30f; }
}
__device__ __forceinline__ void moba_unit(const bool OWN, const bf16* qrow, const bf16* __restrict__ Kh, const bf16* __restrict__ Vh, bf16* obase, int ostride, int dst, float* ml, int mli, int ql, char* lds) {
  const int tid = threadIdx.x, wid = tid >> 6, lane = tid & 63, r32 = lane & 31, hi = lane >> 5;
  bf16* V_lds = (bf16*)lds; bf16* K_lds = (bf16*)(lds + 2 * SHM_V);
  float* ws = (float*)(lds + 2 * SHM_V + 2 * SHM_K) + wid * 64; float* li_l = ws; float* al_l = ws + 32;
  float m_reg = -1e30f, l_reg = 0; f32x16 o[4] = {}; bf16x8 qr[8];
  const bf16* Qw = qrow + hi * 8;
#pragma unroll
  for (int d0 = 0; d0 < 8; ++d0) qr[d0] = *reinterpret_cast<const bf16x8*>(Qw + d0 * 16);
  const int sr = tid >> 4, sc = (tid & 15) * 8, vst0 = v_st(sr, sc), vst1 = v_st(32 + sr, sc);
  const int vb0 = (int)(uintptr_t)V_lds + v_rd_base(lane);
  struct { bf16x8 vs0, vs1, ks0, ks1; } sr_[2];
#define SLOAD(i, k0) do { sr_[i].vs0 = *reinterpret_cast<const bf16x8*>(&Vh[(long)((k0) + sr) * LDK + sc]); sr_[i].vs1 = *reinterpret_cast<const bf16x8*>(&Vh[(long)((k0) + 32 + sr) * LDK + sc]); \
    sr_[i].ks0 = *reinterpret_cast<const bf16x8*>(&Kh[(long)((k0) + sr) * LDK + sc]); sr_[i].ks1 = *reinterpret_cast<const bf16x8*>(&Kh[(long)((k0) + 32 + sr) * LDK + sc]); } while (0)
#define SWRITE(b, i) do { *(bf16x8*)((char*)V_lds + (b) * SHM_V + vst0) = sr_[i].vs0;          \
    *(bf16x8*)((char*)V_lds + (b) * SHM_V + vst1) = sr_[i].vs1; int kc = sc * 2;               \
    *(bf16x8*)((char*)K_lds + (b) * SHM_K + KSWZ(sr, kc)) = sr_[i].ks0;                       \
    *(bf16x8*)((char*)K_lds + (b) * SHM_K + KSWZ(32 + sr, kc)) = sr_[i].ks1; } while (0)
#define SWAIT() asm volatile("s_waitcnt vmcnt(4)" ::: "memory")
#define RESC(a) do { if (__any((a) < 1.f)) { if (hi == 0) al_l[r32] = (a); asm volatile("s_waitcnt lgkmcnt(0)" ::: "memory"); \
    _Pragma("unroll") for (int d = 0; d < 4; ++d) _Pragma("unroll") for (int r = 0; r < 16; ++r) o[d][r] *= al_l[crow(r, hi)]; } } while (0)
  f32x16 pA0, pA1, pB0, pB1; float mnA, mnB, alA, alB; bf16x8 pa0, pa1, pa2, pa3;
  constexpr int SE = 0, SO = 1;
  SLOAD(SE, 0); asm volatile("s_waitcnt vmcnt(0)" ::: "memory"); SWRITE(0, SE); __syncthreads();
  qkt(pA0, pA1, K_lds, qr, r32, hi); if (OWN) cmask(pA0, pA1, 0, ql, hi); partialSM(pA0, pA1, m_reg, mnA, alA);
  SLOAD(SO, KVBLK); SLOAD(SE, 2 * KVBLK);
  SWAIT(); SWRITE(1, SO); __syncthreads();
  {
    SBAR(); qkt(pB0, pB1, (bf16*)((char*)K_lds + SHM_K), qr, r32, hi);
    finishSM(pA0, pA1, alA, l_reg, pa0, pa1, pa2, pa3); SBAR();
    SLOAD(SO, 3 * KVBLK); SBAR();
    pv_d0(o, vb0, pa0, pa1, pa2, pa3); if (OWN) cmask(pB0, pB1, 1, ql, hi); partialSM(pB0, pB1, m_reg, mnB, alB);
    __syncthreads(); SWAIT(); SWRITE(0, SE);
    RESC(alB); __syncthreads();
    SBAR(); qkt(pA0, pA1, K_lds, qr, r32, hi);
    finishSM(pB0, pB1, alB, l_reg, pa0, pa1, pa2, pa3); SBAR();
    pv_d0(o, vb0 + (int)SHM_V, pa0, pa1, pa2, pa3); if (OWN) cmask(pA0, pA1, 2, ql, hi); partialSM(pA0, pA1, m_reg, mnA, alA);
    __syncthreads(); asm volatile("s_waitcnt vmcnt(0)" ::: "memory"); SWRITE(1, SO);
    RESC(alA); __syncthreads();
  }
  SBAR(); qkt(pB0, pB1, (bf16*)((char*)K_lds + SHM_K), qr, r32, hi);
  finishSM(pA0, pA1, alA, l_reg, pa0, pa1, pa2, pa3); SBAR();
  pv_d0(o, vb0, pa0, pa1, pa2, pa3); if (OWN) cmask(pB0, pB1, 3, ql, hi); partialSM(pB0, pB1, m_reg, mnB, alB);
  __syncthreads(); RESC(alB);
  finishSM(pB0, pB1, alB, l_reg, pa0, pa1, pa2, pa3); SBAR();
  pv_d0(o, vb0 + (int)SHM_V, pa0, pa1, pa2, pa3);
  if (hi == 0) li_l[r32] = l_reg; asm volatile("s_waitcnt lgkmcnt(0)" ::: "memory");
  float rli[16];
#pragma unroll
  for (int r = 0; r < 16; ++r) rli[r] = __builtin_amdgcn_rcpf(li_l[crow(r, hi)]);
  __syncthreads();
  bf16* stg = (bf16*)lds + wid * 4096;
#pragma unroll
  for (int r = 0; r < 16; ++r) { const int orow = crow(r, hi);
#pragma unroll
    for (int d0 = 0; d0 < 4; ++d0) stg[orow * 128 + d0 * 32 + r32] = __float2bfloat16(o[d0][r] * rli[r]); }
  int* dsto = (int*)al_l;
  if (hi == 0) dsto[r32] = dst;
  asm volatile("s_waitcnt lgkmcnt(0)" ::: "memory");
#pragma unroll
  for (int i = 0; i < 8; ++i) { const int row = i * 4 + (lane >> 4), ch = lane & 15; const int di = dsto[row]; const u32x4 v = *(const u32x4*)(stg + row * 128 + ch * 8);
    if (di >= 0) *(u32x4*)(obase + (size_t)di * ostride + ch * 8) = v; }
  if (hi == 0 && dst >= 0) { ml[2 * (size_t)mli] = m_reg; ml[2 * (size_t)mli + 1] = l_reg; }
  asm volatile("s_waitcnt lgkmcnt(0)" ::: "memory");
  __syncthreads();
#undef SLOAD
#undef SWRITE
#undef SWAIT
#undef RESC
}

#define KSWZ64(row, colB) ((row) * 128 + ((colB) ^ ((((row) >> 1) & 7) << 4)))
constexpr size_t DA_SHM_K = 64 * 64 * 2;
constexpr size_t DA_SHM = 2 * SHM_V + 2 * DA_SHM_K + NW * 64 * 4;
__device__ __forceinline__ void qkt64(f32x16& p0, f32x16& p1, const bf16* Ks, const bf16x8* qr, int r32, int hi) {
  p0 = f32x16{}; p1 = f32x16{};
#pragma unroll
  for (int d0 = 0; d0 < 4; ++d0) { int cb = (d0 * 16 + hi * 8) * 2;
    bf16x8 b0 = *reinterpret_cast<const bf16x8*>((const char*)Ks + KSWZ64(r32, cb));
    bf16x8 b1 = *reinterpret_cast<const bf16x8*>((const char*)Ks + KSWZ64(32 + r32, cb));
    p0 = __builtin_amdgcn_mfma_f32_32x32x16_bf16(b0, qr[d0], p0, 0, 0, 0);
    p1 = __builtin_amdgcn_mfma_f32_32x32x16_bf16(b1, qr[d0], p1, 0, 0, 0); }
}
__device__ __forceinline__ void dattn_unit(const bf16* Qb, const bf16* __restrict__ Kh, const bf16* __restrict__ Vh, bf16* Ob, const int NT, char* lds) {
  const int tid = threadIdx.x, wid = tid >> 6, lane = tid & 63, r32 = lane & 31, hi = lane >> 5;
  bf16* V_lds = (bf16*)lds; bf16* K_lds = (bf16*)(lds + 2 * SHM_V);
  float* ws = (float*)(lds + 2 * SHM_V + 2 * DA_SHM_K) + wid * 64; float* li_l = ws; float* al_l = ws + 32;
  float m_reg = -1e30f, l_reg = 0; f32x16 o[4] = {}; bf16x8 qr[4];
  const bf16* Qw = Qb + (long)(wid * QBLK + r32) * LDK + hi * 8;
#pragma unroll
  for (int d0 = 0; d0 < 4; ++d0) qr[d0] = *reinterpret_cast<const bf16x8*>(Qw + d0 * 16);
  const int sr = tid >> 4, sc = (tid & 15) * 8, vst0 = v_st(sr, sc), vst1 = v_st(32 + sr, sc);
  const int kr = tid >> 3, kc = (tid & 7) * 8, kst = KSWZ64(kr, kc * 2);
  const int vb0 = (int)(uintptr_t)V_lds + v_rd_base(lane);
  const int ql = wid * QBLK + r32;
  struct { bf16x8 vs0, vs1, ks; } sr_[2];
#define SLOAD(i, k0) do { sr_[i].vs0 = *reinterpret_cast<const bf16x8*>(&Vh[(long)((k0) + sr) * LDK + sc]); sr_[i].vs1 = *reinterpret_cast<const bf16x8*>(&Vh[(long)((k0) + 32 + sr) * LDK + sc]); \
    sr_[i].ks = *reinterpret_cast<const bf16x8*>(&Kh[(long)((k0) + kr) * LDK + kc]); } while (0)
#define SWRITE(b, i) do { *(bf16x8*)((char*)V_lds + (b) * SHM_V + vst0) = sr_[i].vs0; *(bf16x8*)((char*)V_lds + (b) * SHM_V + vst1) = sr_[i].vs1; \
    *(bf16x8*)((char*)K_lds + (b) * DA_SHM_K + kst) = sr_[i].ks; } while (0)
#define SWAIT() asm volatile("s_waitcnt vmcnt(3)" ::: "memory")
#define RESC(a) do { if (__any((a) < 1.f)) { if (hi == 0) al_l[r32] = (a); asm volatile("s_waitcnt lgkmcnt(0)" ::: "memory"); \
    _Pragma("unroll") for (int d = 0; d < 4; ++d) _Pragma("unroll") for (int r = 0; r < 16; ++r) o[d][r] *= al_l[crow(r, hi)]; } } while (0)
#define MASK(P0, P1, t) do { if ((t) >= NT - 4) cmask(P0, P1, (t) - (NT - 4), ql, hi); } while (0)
  f32x16 pA0, pA1, pB0, pB1; float mnA, mnB, alA, alB; bf16x8 pa0, pa1, pa2, pa3;
  constexpr int SE = 0, SO = 1;
  SLOAD(SE, 0); asm volatile("s_waitcnt vmcnt(0)" ::: "memory"); SWRITE(0, SE); __syncthreads();
  qkt64(pA0, pA1, K_lds, qr, r32, hi); MASK(pA0, pA1, 0); partialSM(pA0, pA1, m_reg, mnA, alA);
  SLOAD(SO, KVBLK); SLOAD(SE, 2 * KVBLK);
  SWAIT(); SWRITE(1, SO); __syncthreads();
  for (int j = 1; j + 1 < NT; j += 2) {
    SBAR(); qkt64(pB0, pB1, (bf16*)((char*)K_lds + DA_SHM_K), qr, r32, hi);
    finishSM(pA0, pA1, alA, l_reg, pa0, pa1, pa2, pa3); SBAR();
    SLOAD(SO, (j + 2) * KVBLK); SBAR();
    pv_d0(o, vb0, pa0, pa1, pa2, pa3); MASK(pB0, pB1, j); partialSM(pB0, pB1, m_reg, mnB, alB);
    __syncthreads(); SWAIT(); SWRITE(0, SE);
    RESC(alB); __syncthreads();
    SBAR(); qkt64(pA0, pA1, K_lds, qr, r32, hi);
    finishSM(pB0, pB1, alB, l_reg, pa0, pa1, pa2, pa3); SBAR();
    if (j + 3 < NT) SLOAD(SE, (j + 3) * KVBLK); SBAR();
    pv_d0(o, vb0 + (int)SHM_V, pa0, pa1, pa2, pa3); MASK(pA0, pA1, j + 1); partialSM(pA0, pA1, m_reg, mnA, alA);
    __syncthreads(); SWAIT(); SWRITE(1, SO);
    RESC(alA); __syncthreads();
  }
  SBAR(); qkt64(pB0, pB1, (bf16*)((char*)K_lds + DA_SHM_K), qr, r32, hi);
  finishSM(pA0, pA1, alA, l_reg, pa0, pa1, pa2, pa3); SBAR();
  pv_d0(o, vb0, pa0, pa1, pa2, pa3); MASK(pB0, pB1, NT - 1); partialSM(pB0, pB1, m_reg, mnB, alB);
  __syncthreads(); RESC(alB);
  finishSM(pB0, pB1, alB, l_reg, pa0, pa1, pa2, pa3); SBAR();
  pv_d0(o, vb0 + (int)SHM_V, pa0, pa1, pa2, pa3);
  if (hi == 0) li_l[r32] = l_reg; asm volatile("s_waitcnt lgkmcnt(0)" ::: "memory");
  float rli[16];
#pragma unroll
  for (int r = 0; r < 16; ++r) rli[r] = __builtin_amdgcn_rcpf(li_l[crow(r, hi)]);
  __syncthreads();
  bf16* stg = (bf16*)lds + wid * 4096;
#pragma unroll
  for (int r = 0; r < 16; ++r) { const int orow = crow(r, hi);
#pragma unroll
    for (int d0 = 0; d0 < 4; ++d0) stg[orow * 128 + d0 * 32 + r32] = __float2bfloat16(o[d0][r] * rli[r]); }
  asm volatile("s_waitcnt lgkmcnt(0)" ::: "memory");
#pragma unroll
  for (int i = 0; i < 8; ++i) { const int row = i * 4 + (lane >> 4), ch = lane & 15; const u32x4 v = *(const u32x4*)(stg + row * 128 + ch * 8);
    *(u32x4*)(Ob + (size_t)(wid * QBLK + row) * 2048 + ch * 8) = v; }
  asm volatile("s_waitcnt lgkmcnt(0)" ::: "memory");
  __syncthreads();
#undef SLOAD
#undef SWRITE
#undef SWAIT
#undef RESC
#undef MASK
}
struct DaUnit { int bqh; int qb; };
struct DaOrder {
  int vcu, G;
  __device__ __forceinline__ DaOrder(int vcu_, int G_) : vcu(vcu_), G(G_) {}
  __device__ __forceinline__ bool next(int i, DaUnit& u) const {
    if (G == 256) { if (i >= 8) return false; const int s = vcu & 7, ii = i & 3; u.bqh = (i >> 2) * 32 + (vcu >> 3); u.qb = (ii == 0) ? s : (ii == 1) ? 15 - s : (ii == 2) ? 16 + s : 31 - s; return true; }
    const int uu = vcu + i * G; if (uu >= 2048) return false; u.bqh = uu >> 5; u.qb = uu & 31; return true; }
};
template <class Sched> __device__ __forceinline__ void dattn_phase(char* lds, const bf16* QKV, bf16* O, const Sched& S) {
  DaUnit u;
  for (int i = 0; S.next(i, u); ++i) { const int b = u.bqh >> 4, qh = u.bqh & 15; const size_t rb = (size_t)b * 8192;
    dattn_unit(QKV + (rb + u.qb * 256) * LDK + qh * 64, QKV + rb * LDK + 1024 + qh * 64, QKV + rb * LDK + 2048 + (qh >> 1) * 128, O + (rb + u.qb * 256) * 2048 + qh * 128, 4 * (u.qb + 1), lds); }
}
#undef KSWZ64
#undef KSWZ
#undef SBAR
}
#define GAS __attribute__((address_space(1)))
#define LAS __attribute__((address_space(3)))
typedef unsigned short bf16;
typedef unsigned v4u __attribute__((ext_vector_type(4)));
typedef float f32x4 __attribute__((ext_vector_type(4)));
typedef short bf16x8 __attribute__((ext_vector_type(8)));
typedef GAS unsigned gu32;
typedef GAS unsigned long long gu64;
#define RLX_AGENT __ATOMIC_RELAXED, __HIP_MEMORY_SCOPE_AGENT
#define LDS_WAIT() asm volatile("s_waitcnt lgkmcnt(0)" ::: "memory")
#define VM_WAIT() asm volatile("s_waitcnt vmcnt(0)" ::: "memory")
__device__ __forceinline__ unsigned long long rt() { return __builtin_amdgcn_s_memrealtime(); }
__device__ __forceinline__ unsigned f2bf(float f) { unsigned u = __builtin_bit_cast(unsigned, f); return (u + 0x7fffu + ((u >> 16) & 1u)) >> 16; }
__device__ __forceinline__ unsigned pk2(float lo, float hi) { return f2bf(lo) | (f2bf(hi) << 16); }
#define XB_TMO      128
#define XB_XCNT(j)  (256  + 64 * (j))
#define XB_XSUB(j)  (1280 + 64 * (j))
#define XB_XGEN(j)  (2304 + 64 * (j))
#define XB_TOP      3328
#define XB_TOPGEN   3392
#define XCD_BAR_WORDS 3456
#define XB_SPIN_CAP (1u << 18)

__device__ __forceinline__ unsigned xb_ld(unsigned* p)              { return __hip_atomic_load(p, __ATOMIC_RELAXED, __HIP_MEMORY_SCOPE_AGENT); }
__device__ __forceinline__ unsigned xb_add(unsigned* p, unsigned v) { return __hip_atomic_fetch_add(p, v, __ATOMIC_RELAXED, __HIP_MEMORY_SCOPE_AGENT); }
__device__ __forceinline__ unsigned xb_xcc_id() { return (unsigned)__builtin_amdgcn_s_getreg((3 << 11) | 20) & 0xFu; }
#define XB_SPIN(cond, bar) do { unsigned _sp = 0; while (cond) { __builtin_amdgcn_s_sleep(1); \
    if ((++_sp & 255u) == 0u) { if (xb_ld(&(bar)[XB_TMO])) break; if (_sp > XB_SPIN_CAP) { atomicAdd(&(bar)[XB_TMO], 1u); break; } } } } while (0)

struct XcdBarrier {
    unsigned* bar; unsigned x;
    volatile LAS unsigned* st;
};

__device__ __forceinline__ XcdBarrier xcd_barrier_post(unsigned* bar, volatile LAS unsigned* st) {
    XcdBarrier b; b.bar = bar; b.x = xb_xcc_id(); b.st = st;
    if (threadIdx.x == 0) (void)xb_add(&bar[XB_XCNT(b.x)], 1u);
    return b;
}
__device__ __forceinline__ void xcd_barrier_complete(unsigned* bar, unsigned x, unsigned& nloc, unsigned& nx) {
    const unsigned G = gridDim.x * gridDim.y * gridDim.z;
    unsigned sum, cnt, mine, sp = 0u;
    for (;;) {
        sum = 0u; cnt = 0u; mine = 0u;
#pragma unroll
        for (unsigned j = 0; j < 16; ++j) { const unsigned c = xb_ld(&bar[XB_XCNT(j)]); sum += c; cnt += (c > 0u) ? 1u : 0u; mine = (j == x) ? c : mine; }
        if (sum == G) break;
        __builtin_amdgcn_s_sleep(1);
        if ((++sp & 255u) == 0u) { if (xb_ld(&bar[XB_TMO])) break; if (sp > XB_SPIN_CAP) { atomicAdd(&bar[XB_TMO], 1u); break; } }
    }
    nloc = mine > 0u ? mine : 1u; nx = cnt > 0u ? cnt : 1u;
}

__device__ __forceinline__ void xcd_barrier(const XcdBarrier& b) {
    asm volatile("s_waitcnt vmcnt(0)" ::: "memory");
    __syncthreads();
    if (threadIdx.x == 0) {
        unsigned* bar = b.bar;
        __builtin_amdgcn_s_waitcnt(0);
        unsigned nloc = b.st[0], nx = b.st[1];
        if (nloc == 0u) { xcd_barrier_complete(bar, b.x, nloc, nx); b.st[0] = nloc; b.st[1] = nx; }
        const unsigned old = xb_add(&bar[XB_XSUB(b.x)], 1u);
        const unsigned gen = old / nloc;
        if (old + 1u == (gen + 1u) * nloc) {
            __builtin_amdgcn_fence(__ATOMIC_RELEASE, "agent");
            asm volatile("s_waitcnt vmcnt(0)" ::: "memory");
            const unsigned og = xb_add(&bar[XB_TOP], 1u);
            const unsigned tg = og / nx;
            if (og + 1u == (tg + 1u) * nx) xb_add(&bar[XB_TOPGEN], 1u);
            else XB_SPIN(xb_ld(&bar[XB_TOPGEN]) == tg, bar);
            __builtin_amdgcn_fence(__ATOMIC_ACQUIRE, "agent");
            xb_add(&bar[XB_XGEN(b.x)], 1u);
            asm volatile("s_waitcnt vmcnt(0)" ::: "memory");
        } else {
            XB_SPIN(xb_ld(&bar[XB_XGEN(b.x)]) == gen, bar);
            __builtin_amdgcn_fence(__ATOMIC_ACQUIRE, "agent");
            asm volatile("s_waitcnt vmcnt(0)" ::: "memory");
        }
    }
    __syncthreads();
}

constexpr int NWAVES = 8;
#ifndef MK_PER_PHASE
#define MK_PER_PHASE 0
#endif
constexpr int BATCH = 4, SEQ = 8192, DM = 1024, TOK = BATCH * SEQ;
constexpr int FF0 = 2816, NEXP = 8, FF1 = 3584;
constexpr int NQKV = 3072;
constexpr int MB_H = 8, MB_NB = 32, MB_L = 256;
constexpr int SLOTS = TOK + NEXP * 256;
constexpr float NORM_EPS = 1e-6f, SUBLN_EPS = 1e-5f;
constexpr float LAMBDA_INIT0 = 0.2f;
constexpr float LOG2E = 1.4426950408889634f;
constexpr int LIST_PER_BH = 256 * 496;
__host__ __device__ constexpr int list_off(int j) { return 256 * (31 * j - (j * (j - 1)) / 2); }

constexpr size_t MiB = 1u << 20;
constexpr size_t WS_CTL = 0, CTL_ZERO_BYTES = 1 * MiB;
constexpr size_t WS_ROPE64 = 1 * MiB;
constexpr size_t WS_ROPE128 = WS_ROPE64 + 512 * 1024;
constexpr size_t WS_KMEAN = WS_ROPE128 + 1 * MiB;
constexpr size_t WS_TOK = 3 * MiB;
constexpr size_t WS_SLOT = 4 * MiB;
constexpr size_t WS_OWNML = 6 * MiB;
constexpr size_t WS_W0QKV = 8 * MiB, WS_W0O = 14 * MiB, WS_W013 = 16 * MiB, WS_W02 = 27 * MiB, WS_W1QKV = 33 * MiB, WS_W1O = 39 * MiB;
constexpr size_t B0 = 42 * MiB;
constexpr size_t WS_H = B0;
constexpr size_t WS_QKV = B0 + 64 * MiB;
constexpr size_t WS_OATT = B0 + 256 * MiB;
constexpr size_t WS_UD = B0 + 128 * MiB;
constexpr size_t WS_LIST = B0 + 256 * MiB;
constexpr size_t WS_PML = B0 + 272 * MiB;
constexpr size_t WS_PO = B0 + 280 * MiB;
constexpr size_t WS_WM13 = B0 + 64 * MiB;
constexpr size_t WS_WM2 = WS_WM13 + 112 * MiB;
constexpr size_t WS_UM = B0 + 232 * MiB;
constexpr size_t WS_END = WS_UM + (size_t)SLOTS * FF1 * 2;
static_assert(WS_PO + (size_t)TOK * MB_H * 3 * 128 * 2 <= WS_END + 8 * MiB && WS_END <= 528 * MiB, "d_ws map");
constexpr int CW_TMO = 0, CW_CODE = 1, CW_DBG = 2;
constexpr int CW_MOECNT = 64;
constexpr int CW_MOBACNT = 256;
constexpr int CW_BAR = 4096;
constexpr int RING_OFF = 0, RING_BYTES = 131072;
constexpr int LDSCTL_OFF = RING_BYTES, MISC_OFF = LDSCTL_OFF + 320;
constexpr int LDS_BYTES = 147456;

struct Args { const float* in[20]; float* out; unsigned char* ws; float inv64[8]; float inv128[16]; int ph_lo, ph_hi; };

__device__ __forceinline__ float wave_sum(float v) {
#pragma unroll
    for (int o = 1; o < 64; o <<= 1) v += __shfl_xor(v, o);
    return v;
}
template <int MAP> __device__ __forceinline__ int maprow(int n) {
    if (MAP == 1) { if (n >= 2048) return n; const int d = n & 63; if (d >= 16) return n; const int b = d >> 3, a = (d >> 2) & 1, c = d & 3; return (n & ~63) + 8 * a + 4 * b + c; }
    if (MAP == 2) { if (n >= 2048) return n; const int d = n & 127; if (d >= 32) return n; const int b = d >> 4, a = (d >> 2) & 3, c = d & 3; return (n & ~127) + 8 * a + 4 * b + c; }
    if (MAP == 3) return 256 * (n >> 7) + (n & 127);
    if (MAP == 4) return 256 * (n >> 7) + 128 + (n & 127);
    return n;
}
template <int MAP> __device__ __forceinline__ void transpose_item(const float* W, int K, int N, bf16* WT, LAS float* scr, int item, int lane) {
    const int nblk = N / 32, kb = item / nblk, nb = item % nblk, k0 = 64 * kb, n0 = 32 * nb;
    const int kr = lane >> 3, nc = (lane & 7) * 4;
    f32x4 v[8];
#pragma unroll
    for (int i = 0; i < 8; ++i) v[i] = *(const GAS f32x4*)(W + (size_t)(k0 + i * 8 + kr) * N + n0 + nc);
#pragma unroll
    for (int i = 0; i < 8; ++i) { LAS float* d = scr + (i * 8 + kr) * 33 + nc; d[0] = v[i].x; d[1] = v[i].y; d[2] = v[i].z; d[3] = v[i].w; }
    LDS_WAIT(); asm volatile("" ::: "memory");
    const int c = lane & 7;
#pragma unroll
    for (int j = 0; j < 4; ++j) { const int n = (lane >> 3) + 8 * j; const LAS float* s = scr + (8 * c) * 33 + n;
        v4u o; o.x = pk2(s[0 * 33], s[1 * 33]); o.y = pk2(s[2 * 33], s[3 * 33]); o.z = pk2(s[4 * 33], s[5 * 33]); o.w = pk2(s[6 * 33], s[7 * 33]);
        *(GAS v4u*)(WT + (size_t)maprow<MAP>(n0 + n) * K + k0 + 8 * c) = o; }
    LDS_WAIT(); asm volatile("" ::: "memory");
}
__device__ __forceinline__ void rms_row(const float* xrow, const f32x4 (&g)[4], f32x4 (&v)[4], int lane) {
    const GAS f32x4* xr = (const GAS f32x4*)xrow + lane; float s = 0.f;
#pragma unroll
    for (int j = 0; j < 4; ++j) { v[j] = xr[64 * j]; s += (v[j].x * v[j].x + v[j].y * v[j].y) + (v[j].z * v[j].z + v[j].w * v[j].w); }
    const float rstd = 1.f / sqrtf(wave_sum(s) * (1.f / DM) + NORM_EPS);
#pragma unroll
    for (int j = 0; j < 4; ++j) v[j] = v[j] * rstd * g[j];
}
__device__ __forceinline__ void store_row_bf16(bf16* orow, const f32x4 (&v)[4], int lane) {
    GAS unsigned long long* o8 = (GAS unsigned long long*)orow + lane;
#pragma unroll
    for (int j = 0; j < 4; ++j) o8[64 * j] = (unsigned long long)pk2(v[j].x, v[j].y) | ((unsigned long long)pk2(v[j].z, v[j].w) << 32);
}
__device__ __forceinline__ void load_gain(const float* g, f32x4 (&gv)[4], int lane) {
#pragma unroll
    for (int j = 0; j < 4; ++j) gv[j] = *((const f32x4*)g + lane + 64 * j);
}
__device__ __forceinline__ void rmsnorm_phase(const float* src, const float* gain, bf16* dst, int gw, int ngw, int lane) {
    f32x4 gv[4]; load_gain(gain, gv, lane);
    for (int m = gw; m < TOK; m += ngw) { f32x4 v[4]; rms_row(src + (size_t)m * DM, gv, v, lane); store_row_bf16(dst + (size_t)m * DM, v, lane); }
}
__device__ __forceinline__ float bf2f(unsigned short b) { return __uint_as_float((unsigned)b << 16); }


typedef __attribute__((address_space(4))) const unsigned char* kaptr_t;
__device__ __forceinline__ kaptr_t ka_get() { kaptr_t p = (kaptr_t)__builtin_amdgcn_kernarg_segment_ptr(); asm volatile("" : "+s"(p)); return p; }
#define KA_IN(k) (*(const float* const __attribute__((address_space(4)))*)(ka + 8 * (k)))
#define PH_PTRS kaptr_t ka = ka_get(); unsigned char* const ws = *(unsigned char* const __attribute__((address_space(4)))*)(ka + 168); float* const out = *(float* const __attribute__((address_space(4)))*)(ka + 160); gu32* const ctl = (gu32*)(ws + WS_CTL); (void)out; (void)ctl
#define IN_X KA_IN(0)
#define norm_mix KA_IN(1)
#define norm_ffn KA_IN(2)
#define final_norm KA_IN(3)
#define da_wqkv KA_IN(4)
#define da_wo KA_IN(5)
#define da_lq1 KA_IN(6)
#define da_lk1 KA_IN(7)
#define da_lq2 KA_IN(8)
#define da_lk2 KA_IN(9)
#define da_subln KA_IN(10)
#define mb_wqkv KA_IN(11)
#define mb_wo KA_IN(12)
#define ffn_w1 KA_IN(13)
#define ffn_w3 KA_IN(14)
#define ffn_w2 KA_IN(15)
#define moe_router KA_IN(16)
#define moe_w1 KA_IN(17)
#define moe_w3 KA_IN(18)
#define moe_w2 KA_IN(19)
#define rope64 ((float*)(ws + WS_ROPE64))
#define rope128 ((float*)(ws + WS_ROPE128))
#define kmean ((float*)(ws + WS_KMEAN))
#define tok_e ((int*)(ws + WS_TOK))
#define tok_pos (tok_e + 2 * TOK)
#define tok_gate ((float*)(tok_pos + 2 * TOK))
#define wg_base ((int*)(ws + WS_TOK + 800 * 1024))
#define slot_tok ((int*)(ws + WS_SLOT))
#define slot_gate ((float*)(slot_tok + 2 * SLOTS))
#define ownml ((float*)(ws + WS_OWNML))
#define W0qkv ((bf16*)(ws + WS_W0QKV))
#define W0o ((bf16*)(ws + WS_W0O))
#define W013 ((bf16*)(ws + WS_W013))
#define W02 ((bf16*)(ws + WS_W02))
#define W1qkv ((bf16*)(ws + WS_W1QKV))
#define W1o ((bf16*)(ws + WS_W1O))
#define Hb ((bf16*)(ws + WS_H))
#define QKV ((bf16*)(ws + WS_QKV))
#define OATT ((bf16*)(ws + WS_OATT))
#define UD ((bf16*)(ws + WS_UD))
#define lists ((int*)(ws + WS_LIST))
#define pml ((float*)(ws + WS_PML))
#define PO ((bf16*)(ws + WS_PO))
#define WM13 ((bf16*)(ws + WS_WM13))
#define WM2 ((bf16*)(ws + WS_WM2))
#define UM ((bf16*)(ws + WS_UM))
__global__ void __launch_bounds__(NWAVES * 64, 2) mk_fwd(Args args) {
    extern __shared__ __attribute__((aligned(16))) unsigned char lds[];
    LAS unsigned char* L = (LAS unsigned char*)lds;
    volatile LAS unsigned* MISC = (volatile LAS unsigned*)(L + MISC_OFF);
    const int tid = threadIdx.x, lane = tid & 63, wave = __builtin_amdgcn_readfirstlane(tid >> 6);
    const int G = gridDim.x; const int bx = blockIdx.x; const int vcu = (G % 8 == 0) ? (bx % 8) * (G / 8) + bx / 8 : bx;
    const int gw = vcu * NWAVES + wave, NGW = G * NWAVES;
    gu32* ctl0 = (gu32*)(args.ws + WS_CTL);
    for (int u = tid; u < (LDS_BYTES - LDSCTL_OFF) / 4; u += NWAVES * 64) ((LAS unsigned*)(L + LDSCTL_OFF))[u] = 0u;
    __syncthreads();
    XcdBarrier bar; bar.bar = (unsigned*)(ctl0 + CW_BAR); bar.x = 0; bar.st = nullptr;
    if (!MK_PER_PHASE) bar = xcd_barrier_post((unsigned*)(ctl0 + CW_BAR), MISC + 8);
#define GRID_BAR() do { if (!MK_PER_PHASE) xcd_barrier(bar); } while (0)
    const int lo = args.ph_lo, hi_ph = args.ph_hi;
#ifndef PH_MASK
#define PH_MASK 0xFFFFFFFFu
#endif
#define IN(k) (((PH_MASK >> (k)) & 1u) && lo <= (k) && (k) < hi_ph)
#define SEAM(k) do { if (IN((k) + 1)) GRID_BAR(); } while (0)
#ifndef DUP_MASK
#define DUP_MASK 0u
#endif
#define NREP(k) ((((DUP_MASK) >> (k)) & 1u) ? 2 : 1)

    if (IN(0)) { PH_PTRS; for (int rep_ = 0; rep_ < NREP(0); ++rep_) {
        LAS float* scr = (LAS float*)(L + RING_OFF + wave * 16384);
        constexpr int I_QKV = (DM / 64) * (NQKV / 32), I_O = (DM / 64) * (DM / 32), I_13 = (DM / 64) * (FF0 / 32), I_2 = (FF0 / 64) * (DM / 32);
        constexpr int NITEMS = 2 * I_QKV + 2 * I_O + 2 * I_13 + I_2;
        for (int it = gw; it < NITEMS; it += NGW) {
            int r = it;
            if (r < I_QKV) { transpose_item<1>(da_wqkv, DM, NQKV, W0qkv, scr, r, lane); continue; } r -= I_QKV;
            if (r < I_QKV) { transpose_item<2>(mb_wqkv, DM, NQKV, W1qkv, scr, r, lane); continue; } r -= I_QKV;
            if (r < I_O) { transpose_item<0>(da_wo, DM, DM, W0o, scr, r, lane); continue; } r -= I_O;
            if (r < I_O) { transpose_item<0>(mb_wo, DM, DM, W1o, scr, r, lane); continue; } r -= I_O;
            if (r < I_13) { transpose_item<3>(ffn_w1, DM, FF0, W013, scr, r, lane); continue; } r -= I_13;
            if (r < I_13) { transpose_item<4>(ffn_w3, DM, FF0, W013, scr, r, lane); continue; } r -= I_13;
            transpose_item<0>(ffn_w2, FF0, DM, W02, scr, r, lane);
        }
        {
            const int gt = (vcu * NWAVES + wave) * 64 + lane, NT_ = G * NWAVES * 64;
            for (int e = gt; e < SEQ * 8; e += NT_) { const int pos = e >> 3, i = e & 7; const float ang = (float)pos * (*(const float __attribute__((address_space(4)))*)(ka + 176 + 4 * i)); rope64[e] = cosf(ang); rope64[SEQ * 8 + e] = sinf(ang); }
            for (int e = gt; e < SEQ * 16; e += NT_) { const int pos = e >> 4, i = e & 15; const float ang = (float)pos * (*(const float __attribute__((address_space(4)))*)(ka + 208 + 4 * i)); rope128[e] = cosf(ang); rope128[SEQ * 16 + e] = sinf(ang); }
        }
        rmsnorm_phase(IN_X, norm_mix, Hb, gw, NGW, lane);
        } SEAM(0);
    }
    if (IN(1)) { PH_PTRS; for (int rep_ = 0; rep_ < NREP(1); ++rep_) {
        pg8::ABDense ab{Hb, W0qkv, DM}; pg8::TileOrder S; S.init(TOK / 256, NQKV / 256, G, bx);
        pg8::EpiQKV<64> E{QKV, NQKV, rope64, rope64 + SEQ * 8, 0.125f * LOG2E};
        pg8::gemm_phase<pg8::EpiQKV<64>, pg8::ABDense>(L + RING_OFF, ab, S, E);
        } SEAM(1);
    }
    if (IN(2)) { PH_PTRS; for (int rep_ = 0; rep_ < NREP(2); ++rep_) {
        const moba::DaOrder AS(vcu, G);
        moba::dattn_phase<moba::DaOrder>((char*)lds + RING_OFF, (const moba::bf16*)QKV, (moba::bf16*)OATT, AS);
        } SEAM(2);
    }
    if (IN(3)) { PH_PTRS; for (int rep_ = 0; rep_ < NREP(3); ++rep_) {
        float lam;
        { const float a = wave_sum(da_lq1[lane] * da_lk1[lane]), b = wave_sum(da_lq2[lane] * da_lk2[lane]); lam = expf(a) - expf(b) + LAMBDA_INIT0; }
        const int hh = lane >> 3, dd = (lane & 7) * 16;
        float gsub[16];
#pragma unroll
        for (int k = 0; k < 16; ++k) gsub[k] = da_subln[dd + k] * (1.f - LAMBDA_INIT0);
        for (int m = gw; m < TOK; m += NGW) {
            const bf16* o1 = OATT + (size_t)m * 2048 + (2 * hh) * 128 + dd; const bf16* o2 = o1 + 128;
            const v4u a0 = *(const GAS v4u*)o1, a1 = *(const GAS v4u*)(o1 + 8), b0 = *(const GAS v4u*)o2, b1 = *(const GAS v4u*)(o2 + 8);
            float d[16]; float ss = 0.f;
#pragma unroll
            for (int k = 0; k < 4; ++k) {
                const unsigned ua = a0[k], ub = b0[k], uc = a1[k], ud = b1[k];
                d[2 * k] = __uint_as_float(ua << 16) - lam * __uint_as_float(ub << 16); d[2 * k + 1] = __uint_as_float(ua & 0xffff0000u) - lam * __uint_as_float(ub & 0xffff0000u);
                d[8 + 2 * k] = __uint_as_float(uc << 16) - lam * __uint_as_float(ud << 16); d[8 + 2 * k + 1] = __uint_as_float(uc & 0xffff0000u) - lam * __uint_as_float(ud & 0xffff0000u); }
#pragma unroll
            for (int k = 0; k < 16; ++k) ss += d[k] * d[k];
            ss += __shfl_xor(ss, 1); ss += __shfl_xor(ss, 2); ss += __shfl_xor(ss, 4);
            const float rstd = 1.f / sqrtf(ss * (1.f / 128.f) + SUBLN_EPS);
            v4u w0, w1;
#pragma unroll
            for (int k = 0; k < 4; ++k) { w0[k] = pk2(d[2 * k] * rstd * gsub[2 * k], d[2 * k + 1] * rstd * gsub[2 * k + 1]); w1[k] = pk2(d[8 + 2 * k] * rstd * gsub[8 + 2 * k], d[8 + 2 * k + 1] * rstd * gsub[8 + 2 * k + 1]); }
            bf16* od = Hb + (size_t)m * DM + hh * 128 + dd;
            *(GAS v4u*)od = w0; *(GAS v4u*)(od + 8) = w1;
        }
        } SEAM(3);
    }
    if (IN(4)) { PH_PTRS; for (int rep_ = 0; rep_ < NREP(4); ++rep_) {
        pg8::ABDense ab{Hb, W0o, DM}; pg8::TileOrder S; S.init(TOK / 256, DM / 256, G, bx);
        pg8::EpiRes E{IN_X, out, DM, nullptr};
        pg8::gemm_phase<pg8::EpiRes, pg8::ABDense>(L + RING_OFF, ab, S, E);
        } SEAM(4);
    }
    if (IN(5)) { PH_PTRS; for (int rep_ = 0; rep_ < NREP(5); ++rep_) rmsnorm_phase(out, norm_ffn, QKV, gw, NGW, lane); SEAM(5); }
    if (IN(6)) { PH_PTRS; for (int rep_ = 0; rep_ < NREP(6); ++rep_) {
        pg8::ABDense ab{QKV, W013, DM}; pg8::TileOrder S; S.init(TOK / 256, (2 * FF0) / 256, G, bx);
        pg8::EpiSwiGLU E{UD, FF0, nullptr};
        pg8::gemm_phase<pg8::EpiSwiGLU, pg8::ABDense>(L + RING_OFF, ab, S, E);
        } SEAM(6);
    }
    if (IN(7)) { PH_PTRS; for (int rep_ = 0; rep_ < NREP(7); ++rep_) {
        pg8::ABDense ab{UD, W02, FF0}; pg8::TileOrder S; S.init(TOK / 256, DM / 256, G, bx);
        pg8::EpiRes E{out, out, DM, nullptr};
        pg8::gemm_phase<pg8::EpiRes, pg8::ABDense>(L + RING_OFF, ab, S, E);
        } SEAM(7);
    }
    if (IN(8)) { PH_PTRS; for (int rep_ = 0; rep_ < NREP(8); ++rep_) rmsnorm_phase(out, norm_mix + DM, Hb, gw, NGW, lane); SEAM(8); }
    if (IN(9)) { PH_PTRS; for (int rep_ = 0; rep_ < NREP(9); ++rep_) {
        pg8::ABDense ab{Hb, W1qkv, DM}; pg8::TileOrder S; S.init(TOK / 256, NQKV / 256, G, bx);
        pg8::EpiQKV<128> E{QKV, NQKV, rope128, rope128 + SEQ * 16, 0.08838834764831845f * LOG2E};
        pg8::gemm_phase<pg8::EpiQKV<128>, pg8::ABDense>(L + RING_OFF, ab, S, E);
        } SEAM(9);
    }
    if (IN(10)) { PH_PTRS; for (int rep_ = 0; rep_ < NREP(10); ++rep_) {
        LAS float* red = (LAS float*)(L + RING_OFF);
        for (int u = vcu; u < BATCH * MB_H * MB_NB; u += G) {
            const int b = u >> 8, h = (u >> 5) & 7, j = u & 31;
            const int dch = tid & 15, kg = tid >> 4;
            const bf16* kp = QKV + (size_t)(b * SEQ + j * MB_L + kg * 8) * NQKV + 1024 + h * 128 + dch * 8;
            float s[8] = {0.f, 0.f, 0.f, 0.f, 0.f, 0.f, 0.f, 0.f};
#pragma unroll
            for (int k = 0; k < 8; ++k) { const v4u v = *(const GAS v4u*)(kp + (size_t)k * NQKV);
#pragma unroll
                for (int q = 0; q < 4; ++q) { s[2 * q] += __uint_as_float(v[q] << 16); s[2 * q + 1] += __uint_as_float(v[q] & 0xffff0000u); } }
#pragma unroll
            for (int q = 0; q < 8; ++q) red[kg * 128 + dch * 8 + q] = s[q];
            __syncthreads();
            if (tid < 128) { float a = 0.f;
#pragma unroll 8
                for (int k = 0; k < 32; ++k) a += red[k * 128 + tid];
                kmean[(size_t)u * 128 + tid] = a * (1.f / 256.f); }
            __syncthreads();
        }
        } SEAM(10);
    }
    if (IN(11)) { PH_PTRS; for (int rep_ = 0; rep_ < NREP(11); ++rep_) {
        LAS float* km = (LAS float*)(L + RING_OFF);
        LAS float* mv = (LAS float*)(L + RING_OFF + 16384);
        LAS int* mi = (LAS int*)(L + RING_OFF + 16384 + 3072);
        LAS int* lcnt = (LAS int*)(L + RING_OFF + 24576);
        for (int u = vcu; u < BATCH * MB_H * (MB_NB - 1); u += G) {
            const int bh = u / 31, o = 1 + u % 31, b = bh >> 3, h = bh & 7;
            for (int e = tid; e < 32 * 128; e += 512) km[e] = kmean[(size_t)bh * 4096 + e];
            if (tid < 32) lcnt[tid] = 0;
            __syncthreads();
            const int ql = tid & 255, half = tid >> 8; const int s = o * 256 + ql;
            const bf16* qp = QKV + (size_t)(b * SEQ + s) * NQKV + h * 128;
            float qf[128];
#pragma unroll
            for (int c = 0; c < 16; ++c) { const v4u v = *(const GAS v4u*)(qp + c * 8);
#pragma unroll
                for (int q = 0; q < 4; ++q) { qf[c * 8 + 2 * q] = __uint_as_float(v[q] << 16); qf[c * 8 + 2 * q + 1] = __uint_as_float(v[q] & 0xffff0000u); } }
            float v0 = -INFINITY, v1 = -INFINITY, v2 = -INFINITY; int i0 = -1, i1 = -1, i2 = -1;
            for (int jj = 0; jj < 16; ++jj) { const int j = half * 16 + jj;
                if (j < o) { float g = 0.f; const LAS f32x4* kr = (const LAS f32x4*)(km + j * 128);
#pragma unroll
                    for (int c = 0; c < 32; ++c) { const f32x4 kv = kr[c]; g += qf[4 * c] * kv.x + qf[4 * c + 1] * kv.y + qf[4 * c + 2] * kv.z + qf[4 * c + 3] * kv.w; }
                    if (g > v0) { v2 = v1; i2 = i1; v1 = v0; i1 = i0; v0 = g; i0 = j; } else if (g > v1) { v2 = v1; i2 = i1; v1 = g; i1 = j; } else if (g > v2) { v2 = g; i2 = j; } } }
            if (half == 1) { mv[ql * 3] = v0; mv[ql * 3 + 1] = v1; mv[ql * 3 + 2] = v2; mi[ql * 3] = i0; mi[ql * 3 + 1] = i1; mi[ql * 3 + 2] = i2; }
            __syncthreads();
            int lp0 = 0, lp1 = 0, lp2 = 0;
            if (half == 0) {
#pragma unroll
                for (int k = 0; k < 3; ++k) { const float g = mv[ql * 3 + k]; const int j = mi[ql * 3 + k];
                    if (j >= 0) { if (g > v0) { v2 = v1; i2 = i1; v1 = v0; i1 = i0; v0 = g; i0 = j; } else if (g > v1) { v2 = v1; i2 = i1; v1 = g; i1 = j; } else if (g > v2) { v2 = g; i2 = j; } } }
                if (i0 >= 0) lp0 = __hip_atomic_fetch_add(&lcnt[i0], 1, __ATOMIC_RELAXED, __HIP_MEMORY_SCOPE_WORKGROUP);
                if (i1 >= 0) lp1 = __hip_atomic_fetch_add(&lcnt[i1], 1, __ATOMIC_RELAXED, __HIP_MEMORY_SCOPE_WORKGROUP);
                if (i2 >= 0) lp2 = __hip_atomic_fetch_add(&lcnt[i2], 1, __ATOMIC_RELAXED, __HIP_MEMORY_SCOPE_WORKGROUP);
            }
            __syncthreads();
            if (tid < 32 && rep_ == 0) { const int n = lcnt[tid]; lcnt[32 + tid] = n ? (int)__hip_atomic_fetch_add(ctl + CW_MOBACNT + bh * 32 + tid, (unsigned)n, RLX_AGENT) : 0; }
            __syncthreads();
            if (half == 0 && rep_ == 0) { int* lb = lists + (size_t)bh * LIST_PER_BH;
                if (i0 >= 0) lb[list_off(i0) + lcnt[32 + i0] + lp0] = s;
                if (i1 >= 0) lb[list_off(i1) + lcnt[32 + i1] + lp1] = s | (1 << 16);
                if (i2 >= 0) lb[list_off(i2) + lcnt[32 + i2] + lp2] = s | (2 << 16); }
            __syncthreads();
        }
        } SEAM(11);
    }
    if (IN(12)) { PH_PTRS; for (int rep_ = 0; rep_ < NREP(12); ++rep_) {
        LAS int* pre = (LAS int*)(L + 102400);
        { const unsigned c0 = __hip_atomic_load(ctl + CW_MOBACNT + tid, RLX_AGENT), c1 = __hip_atomic_load(ctl + CW_MOBACNT + 512 + tid, RLX_AGENT);
          pre[tid] = (int)((c0 + 255u) >> 8); pre[512 + tid] = (int)((c1 + 255u) >> 8); }
        __syncthreads();
        if (tid == 0) { int a = 0; for (int k = 0; k < 1024; ++k) { const int n = pre[k]; pre[k] = a; a += n; } pre[1024] = a; }
        __syncthreads();
        const int nlist = pre[1024], ntot = 1024 + nlist;
        const int wl = wave * 32 + (lane & 31);
        for (int u = vcu; u < ntot; u += G) {
            const bool own = u < 1024;
            int b, h, kb, s, dst, mli, ostride; moba::bf16* obase; float* mlp;
            if (own) {
                b = u >> 8; h = (u >> 5) & 7; kb = u & 31; s = kb * 256 + wl; dst = b * SEQ + s; mli = (b * 8 + h) * SEQ + s; ostride = DM; obase = (moba::bf16*)Hb + h * 128; mlp = ownml;
            } else {
                const int lu = u - 1024; int loI = 0, hiI = 1024;
                while (hiI - loI > 1) { const int mid = (loI + hiI) >> 1; if (pre[mid] <= lu) loI = mid; else hiI = mid; }
                const int bhj = loI, chunk = lu - pre[bhj], bh = bhj >> 5; kb = bhj & 31; b = bh >> 3; h = bh & 7;
                const int cnt = (int)__hip_atomic_load(ctl + CW_MOBACNT + bhj, RLX_AGENT);
                const int ei = chunk * 256 + wl; const bool valid = ei < cnt;
                const int ent = valid ? lists[(size_t)bh * LIST_PER_BH + list_off(kb) + ei] : 0;
                s = ent & 0xffff; mli = (bh * SEQ + s) * 3 + (ent >> 16); dst = valid ? mli : -1; ostride = 128; obase = (moba::bf16*)PO; mlp = pml;
            }
            const moba::bf16* qrow = (const moba::bf16*)QKV + ((size_t)b * SEQ + s) * NQKV + h * 128;
            const moba::bf16* Kh = (const moba::bf16*)QKV + ((size_t)b * SEQ + kb * 256) * NQKV + 1024 + h * 128;
            moba::moba_unit(own, qrow, Kh, Kh + 1024, obase, ostride, dst, mlp, mli, wl, (char*)lds);
        }
        } SEAM(12);
    }
    if (IN(13)) { PH_PTRS; for (int rep_ = 0; rep_ < NREP(13); ++rep_) {
        const int hh = lane >> 3, dd = (lane & 7) * 16;
        for (int m = gw; m < TOK; m += NGW) {
            const int b = m >> 13, s = m & 8191, nv = (s >> 8) < 3 ? (s >> 8) : 3; const int qi = (b * 8 + hh) * SEQ + s;
            float mm[4], ll[4]; mm[0] = ownml[2 * (size_t)qi]; ll[0] = ownml[2 * (size_t)qi + 1]; float M = mm[0];
#pragma unroll
            for (int r = 0; r < 3; ++r) { if (r < nv) { mm[1 + r] = pml[2 * ((size_t)qi * 3 + r)]; ll[1 + r] = pml[2 * ((size_t)qi * 3 + r) + 1]; M = fmaxf(M, mm[1 + r]); } else { mm[1 + r] = -1e30f; ll[1 + r] = 0.f; } }
            float w[4], wsum = 0.f;
#pragma unroll
            for (int r = 0; r < 4; ++r) { w[r] = ll[r] * __builtin_amdgcn_exp2f(mm[r] - M); wsum += w[r]; }
            const float inv = 1.f / wsum;
            float acc16[16];
            bf16* op = Hb + (size_t)m * DM + hh * 128 + dd;
            { const v4u a0 = *(const GAS v4u*)op, a1 = *(const GAS v4u*)(op + 8); const float ww = w[0] * inv;
#pragma unroll
              for (int k = 0; k < 4; ++k) { acc16[2 * k] = ww * __uint_as_float(a0[k] << 16); acc16[2 * k + 1] = ww * __uint_as_float(a0[k] & 0xffff0000u); acc16[8 + 2 * k] = ww * __uint_as_float(a1[k] << 16); acc16[8 + 2 * k + 1] = ww * __uint_as_float(a1[k] & 0xffff0000u); } }
#pragma unroll
            for (int r = 0; r < 3; ++r) if (r < nv) { const bf16* pp = PO + ((size_t)qi * 3 + r) * 128 + dd; const v4u a0 = *(const GAS v4u*)pp, a1 = *(const GAS v4u*)(pp + 8); const float ww = w[1 + r] * inv;
#pragma unroll
                for (int k = 0; k < 4; ++k) { acc16[2 * k] += ww * __uint_as_float(a0[k] << 16); acc16[2 * k + 1] += ww * __uint_as_float(a0[k] & 0xffff0000u); acc16[8 + 2 * k] += ww * __uint_as_float(a1[k] << 16); acc16[8 + 2 * k + 1] += ww * __uint_as_float(a1[k] & 0xffff0000u); } }
            v4u w0, w1;
#pragma unroll
            for (int k = 0; k < 4; ++k) { w0[k] = pk2(acc16[2 * k], acc16[2 * k + 1]); w1[k] = pk2(acc16[8 + 2 * k], acc16[8 + 2 * k + 1]); }
            *(GAS v4u*)op = w0; *(GAS v4u*)(op + 8) = w1;
        }
        } SEAM(13);
    }
    if (IN(14)) { PH_PTRS; for (int rep_ = 0; rep_ < NREP(14); ++rep_) {
        pg8::ABDense ab{Hb, W1o, DM}; pg8::TileOrder S; S.init(TOK / 256, DM / 256, G, bx);
        pg8::EpiRes E{out, out, DM, nullptr};
        pg8::gemm_phase<pg8::EpiRes, pg8::ABDense>(L + RING_OFF, ab, S, E);
        } SEAM(14);
    }
    if (IN(15)) { PH_PTRS; for (int rep_ = 0; rep_ < NREP(15); ++rep_) {
        {
            const int gt = (vcu * NWAVES + wave) * 64 + lane, NT_ = G * NWAVES * 64;
            for (int e = gt; e < 2 * SLOTS; e += NT_) { slot_tok[e] = -1; slot_gate[e] = 0.f; }
        }
        if (rep_ == 0) {
            f32x4 gv[4]; load_gain(norm_ffn + DM, gv, lane);
            float wr_[16][8];
#pragma unroll
            for (int j = 0; j < 4; ++j)
#pragma unroll
                for (int q = 0; q < 4; ++q) { const int k = 4 * lane + 256 * j + q; const f32x4 a = *(const GAS f32x4*)(moe_router + (size_t)k * 8), c = *(const GAS f32x4*)(moe_router + (size_t)k * 8 + 4);
                    wr_[4 * j + q][0] = a.x; wr_[4 * j + q][1] = a.y; wr_[4 * j + q][2] = a.z; wr_[4 * j + q][3] = a.w; wr_[4 * j + q][4] = c.x; wr_[4 * j + q][5] = c.y; wr_[4 * j + q][6] = c.z; wr_[4 * j + q][7] = c.w; }
            for (int m = gw; m < TOK; m += NGW) {
                f32x4 v[4]; rms_row(out + (size_t)m * DM, gv, v, lane); store_row_bf16(Hb + (size_t)m * DM, v, lane);
                float lg[8];
#pragma unroll
                for (int e = 0; e < 8; ++e) { float a = 0.f;
#pragma unroll
                    for (int j = 0; j < 4; ++j) a += v[j].x * wr_[4 * j][e] + v[j].y * wr_[4 * j + 1][e] + v[j].z * wr_[4 * j + 2][e] + v[j].w * wr_[4 * j + 3][e];
                    lg[e] = wave_sum(a); }
                int e0 = 0; float l0 = lg[0];
#pragma unroll
                for (int e = 1; e < 8; ++e) if (lg[e] > l0) { l0 = lg[e]; e0 = e; }
                int e1 = -1; float l1 = -INFINITY;
#pragma unroll
                for (int e = 0; e < 8; ++e) if (e != e0 && lg[e] > l1) { l1 = lg[e]; e1 = e; }
                if (lane == 0) {
                    const float g0 = 1.f / (1.f + expf(l1 - l0)), g1 = 1.f - g0;
                    const int p0 = (int)__hip_atomic_fetch_add((LAS unsigned*)(L + MISC_OFF) + 40 + e0, 1u, __ATOMIC_RELAXED, __HIP_MEMORY_SCOPE_WORKGROUP), p1 = (int)__hip_atomic_fetch_add((LAS unsigned*)(L + MISC_OFF) + 48 + e1, 1u, __ATOMIC_RELAXED, __HIP_MEMORY_SCOPE_WORKGROUP);
                    tok_e[m] = e0; tok_e[TOK + m] = e1; tok_pos[m] = p0; tok_pos[TOK + m] = p1; tok_gate[m] = g0; tok_gate[TOK + m] = g1;
                }
            }
            LDS_WAIT(); __syncthreads();
            if (tid < 16) { const unsigned n = MISC[40 + tid]; wg_base[vcu * 16 + tid] = n ? (int)__hip_atomic_fetch_add(ctl + CW_MOECNT + tid, n, RLX_AGENT) : 0; }
        }
        {
            LAS float* scr = (LAS float*)(L + RING_OFF + wave * 16384);
            constexpr int I_1 = (DM / 64) * (FF1 / 32), I_2 = (FF1 / 64) * (DM / 32), PER_E = 2 * I_1 + I_2;
            for (int it = gw; it < NEXP * PER_E; it += NGW) {
                const int e = it / PER_E; int r = it % PER_E;
                if (r < I_1) { transpose_item<3>(moe_w1 + (size_t)e * DM * FF1, DM, FF1, WM13 + (size_t)e * 2 * FF1 * DM, scr, r, lane); continue; } r -= I_1;
                if (r < I_1) { transpose_item<4>(moe_w3 + (size_t)e * DM * FF1, DM, FF1, WM13 + (size_t)e * 2 * FF1 * DM, scr, r, lane); continue; } r -= I_1;
                transpose_item<0>(moe_w2 + (size_t)e * FF1 * DM, FF1, DM, WM2 + (size_t)e * DM * FF1, scr, r, lane);
            }
        }
        } SEAM(15);
    }
#define MOE_CUM() do { if (tid < 2) { int a = 0; for (int e = 0; e < 8; ++e) { MISC[16 + 9 * tid + e] = (unsigned)a; a += (int)((__hip_atomic_load(ctl + CW_MOECNT + 8 * tid + e, RLX_AGENT) + 255u) >> 8); } MISC[16 + 9 * tid + 8] = (unsigned)a; } __syncthreads(); } while (0)
    if (IN(16)) { PH_PTRS; for (int rep_ = 0; rep_ < NREP(16); ++rep_) {
        MOE_CUM();
        const int gt = (vcu * NWAVES + wave) * 64 + lane, NT_ = G * NWAVES * 64;
        for (int e = gt; e < 2 * TOK; e += NT_) { const int r = e >= TOK ? 1 : 0; const int ex = tok_e[e]; const int t_ = e - r * TOK; const int slot = (int)MISC[16 + 9 * r + ex] * 256 + wg_base[((t_ % NGW) >> 3) * 16 + r * 8 + ex] + tok_pos[e];
            slot_tok[r * SLOTS + slot] = e - r * TOK; slot_gate[r * SLOTS + slot] = tok_gate[e]; }
        } SEAM(16);
    }
#define MOE_UP(r) do { MOE_CUM(); \
        pg8::ABMoeUp ab{Hb, WM13, DM, slot_tok + (r) * SLOTS, (const LAS int*)(L + MISC_OFF + 4 * (16 + 9 * (r))), (size_t)2 * FF1 * DM}; \
        pg8::TileOrder S; S.init((int)MISC[16 + 9 * (r) + 8], (2 * FF1) / 256, G, bx); \
        pg8::EpiSwiGLU E{UM, FF1, slot_gate + (r) * SLOTS}; \
        pg8::gemm_phase<pg8::EpiSwiGLU, pg8::ABMoeUp>(L + RING_OFF, ab, S, E); } while (0)
#define MOE_DOWN(r) do { MOE_CUM(); \
        pg8::ABMoeDown ab{UM, WM2, FF1, (const LAS int*)(L + MISC_OFF + 4 * (16 + 9 * (r))), (size_t)DM * FF1}; \
        pg8::TileOrder S; S.init((int)MISC[16 + 9 * (r) + 8], DM / 256, G, bx); \
        pg8::EpiRes E{out, out, DM, slot_tok + (r) * SLOTS}; \
        pg8::gemm_phase<pg8::EpiRes, pg8::ABMoeDown>(L + RING_OFF, ab, S, E); } while (0)
    if (IN(17)) { PH_PTRS; for (int rep_ = 0; rep_ < NREP(17); ++rep_) MOE_UP(0); SEAM(17); }
    if (IN(18)) { PH_PTRS; MOE_DOWN(0); SEAM(18); }
    if (IN(19)) { PH_PTRS; for (int rep_ = 0; rep_ < NREP(19); ++rep_) MOE_UP(1); SEAM(19); }
    if (IN(20)) { PH_PTRS; MOE_DOWN(1); SEAM(20); }
    if (IN(21)) { PH_PTRS;
        f32x4 gv[4]; load_gain(final_norm, gv, lane);
        for (int m = gw; m < TOK; m += NGW) { f32x4 v[4]; rms_row(out + (size_t)m * DM, gv, v, lane);
            GAS f32x4* o = (GAS f32x4*)(out + (size_t)m * DM) + lane;
#pragma unroll
            for (int j = 0; j < 4; ++j) o[64 * j] = v[j]; }
    }
#undef IN
#undef SEAM
#undef GRID_BAR
}
constexpr int N_PHASES = 22;

extern "C" void kernel_launch(void* const* d_in, const int* in_sizes, int n_in, void* d_out, int out_size, void* d_ws, size_t ws_size, hipStream_t stream) {
    static int grid = 0;
    if (grid == 0) {
        if (n_in != 20 || in_sizes[0] != TOK * DM || out_size != TOK * DM || ws_size < WS_END) { fprintf(stderr, "kernel_launch: shape / workspace mismatch (n_in %d, in0 %d, out %d, ws %zu, need %zu); nothing launched\n", n_in, n_in > 0 ? in_sizes[0] : -1, out_size, ws_size, (size_t)WS_END); grid = -1; return; }
        int dev = 0, cus = 0, per_cu = 0;
        if (hipGetDevice(&dev) != hipSuccess || hipDeviceGetAttribute(&cus, hipDeviceAttributeMultiprocessorCount, dev) != hipSuccess) { grid = -1; return; }
        if (hipFuncSetAttribute((const void*)mk_fwd, hipFuncAttributeMaxDynamicSharedMemorySize, LDS_BYTES) != hipSuccess) { fprintf(stderr, "kernel_launch: hipFuncSetAttribute failed\n"); grid = -1; return; }
        if (hipOccupancyMaxActiveBlocksPerMultiprocessor(&per_cu, (const void*)mk_fwd, NWAVES * 64, LDS_BYTES) != hipSuccess || per_cu < 1) fprintf(stderr, "kernel_launch: occupancy query reports %d workgroups per CU\n", per_cu);
        (void)hipGetLastError();
        grid = cus;
    }
    if (grid < 0) return;
    if (hipMemsetAsync((char*)d_ws + WS_CTL, 0, CTL_ZERO_BYTES, stream) != hipSuccess) return;
    Args a{};
    for (int i = 0; i < 20; ++i) a.in[i] = (const float*)d_in[i];
    a.out = (float*)d_out; a.ws = (unsigned char*)d_ws;
    for (int i = 0; i < 8; ++i) a.inv64[i] = (float)pow(500000.0, -(double)(2 * i) / 16.0);
    for (int i = 0; i < 16; ++i) a.inv128[i] = (float)pow(500000.0, -(double)(2 * i) / 32.0);
#if MK_PER_PHASE
    for (int p = 0; p < N_PHASES; ++p) { a.ph_lo = p; a.ph_hi = p + 1; hipLaunchKernelGGL(mk_fwd, dim3(grid), dim3(NWAVES * 64), LDS_BYTES, stream, a); }
#else
    a.ph_lo = 0; a.ph_hi = N_PHASES;
    hipLaunchKernelGGL(mk_fwd, dim3(grid), dim3(NWAVES * 64), LDS_BYTES, stream, a);
#ifdef PROBE_LIST
    {
        static const int probe[] = {PROBE_LIST};
        for (int k : probe) { a.ph_lo = k; a.ph_hi = k + 1;
            a.out = (k == 4 || k == 14) ? (float*)((char*)d_ws + WS_QKV) : (k == 7 || k == 18 || k == 20 || k == 21) ? (float*)((char*)d_ws + WS_H) : (float*)d_out;
            hipLaunchKernelGGL(mk_fwd, dim3(grid), dim3(NWAVES * 64), LDS_BYTES, stream, a); }
    }
#endif
#endif
    const hipError_t le = hipPeekAtLastError();
    if (le != hipSuccess) fprintf(stderr, "kernel_launch: launch failed: %s\n", hipGetErrorName(le));
}
```

```cpp
#include <hip/hip_runtime.h>
#include <hip/hip_bf16.h>
#include <cstdio>
#include <cstdint>
#include <cmath>
namespace pg8 {
#define PG8_LAS __attribute__((address_space(3)))
typedef unsigned short bf16_t;
typedef short bf16x8 __attribute__((ext_vector_type(8)));
typedef float f32x4 __attribute__((ext_vector_type(4)));
typedef unsigned u32x4 __attribute__((ext_vector_type(4)));
constexpr int BM = 256, BK = 64, HALF = 128, HTB = HALF * BK * 2  , STAGE_BYTES = 8 * HTB, NXCD = 8, WGM = 8;

__host__ __device__ __forceinline__ int lds_byte(int r, int c) { const int st = (r >> 4) * 2 + (c >> 5), rr = r & 15, cc = c & 31, ob = rr * 64 + cc * 2; return st * 1024 + (ob ^ (((ob >> 9) & 1) << 5)); }
__host__ __device__ __forceinline__ void stage_rc(int b, int& R, int& C) { const int st = b / 1024, sb = b % 1024, swz = sb ^ (((sb >> 9) & 1) << 5); R = (st >> 1) * 16 + swz / 64; C = (st & 1) * 32 + (swz % 64) / 2; }
__host__ __device__ __forceinline__ int perm32(int rho) { const int n = rho >> 4, i = rho & 15; return 8 * (i >> 2) + 4 * n + (i & 3); }

struct Unit { int pm, pn; };

struct TileOrder {
    int nM, nN, nwg, G, c;
    __device__ __forceinline__ void init(int nM_, int nN_, int G_, int c_) { nM = nM_; nN = nN_; nwg = nM * nN; G = G_; c = c_; }
    __device__ __forceinline__ bool next(int i, Unit& u) const {
        const long L = (long)i * G + c; if (L >= nwg) return false;
        int wgid = (int)L; { const int q = nwg / NXCD, r = nwg % NXCD, xcd = wgid % NXCD, off = wgid / NXCD; wgid = (xcd < r ? xcd * (q + 1) : r * (q + 1) + (xcd - r) * q) + off; }
        const int nig = WGM * nN, gid = wgid / nig, fm = gid * WGM, gsz = (nM - fm) < WGM ? (nM - fm) : WGM;
        u.pm = fm + ((wgid % nig) % gsz); u.pn = (wgid % nig) / gsz; return true;
    }
};

struct ABDense {
    static constexpr bool GATHER = false;
    const bf16_t* A; const bf16_t* Bt; int K;
    __device__ __forceinline__ const char* abase(const Unit& u) const { return (const char*)A + (size_t)u.pm * BM * K * 2; }
    __device__ __forceinline__ const char* bbase(const Unit& u) const { return (const char*)Bt + (size_t)u.pn * BM * K * 2; }
    __device__ __forceinline__ const int* tokp(const Unit&) const { return nullptr; }
};
struct ABMoeUp {
    static constexpr bool GATHER = true;
    const bf16_t* A; const bf16_t* Bt; int K; const int* slot_tok; const PG8_LAS int* cum; size_t estride;
    __device__ __forceinline__ int expert(int pm) const { int e = 0;
#pragma unroll
        for (int k = 1; k < 8; ++k) e += (pm >= cum[k]) ? 1 : 0; return e; }
    __device__ __forceinline__ const char* abase(const Unit&) const { return (const char*)A; }
    __device__ __forceinline__ const char* bbase(const Unit& u) const { return (const char*)(Bt + (size_t)expert(u.pm) * estride) + (size_t)u.pn * BM * K * 2; }
    __device__ __forceinline__ const int* tokp(const Unit& u) const { return slot_tok + u.pm * BM; }
};
struct ABMoeDown {
    static constexpr bool GATHER = false;
    const bf16_t* A; const bf16_t* Bt; int K; const PG8_LAS int* cum; size_t estride;
    __device__ __forceinline__ int expert(int pm) const { int e = 0;
#pragma unroll
        for (int k = 1; k < 8; ++k) e += (pm >= cum[k]) ? 1 : 0; return e; }
    __device__ __forceinline__ const char* abase(const Unit& u) const { return (const char*)A + (size_t)u.pm * BM * K * 2; }
    __device__ __forceinline__ const char* bbase(const Unit& u) const { return (const char*)(Bt + (size_t)expert(u.pm) * estride) + (size_t)u.pn * BM * K * 2; }
    __device__ __forceinline__ const int* tokp(const Unit&) const { return nullptr; }
};

__device__ __forceinline__ unsigned cvt_pk_bf16(float lo, float hi) { unsigned r; asm volatile("v_cvt_pk_bf16_f32 %0, %1, %2" : "=v"(r) : "v"(lo), "v"(hi)); return r; }

template <int DH> struct EpiQKV {
    static constexpr bool PERM = true;
    bf16_t* O; int ldc; const float* ct; const float* st; float qscale; const unsigned long long* rss;
    __device__ __forceinline__ void operator()(const f32x4 (&acc)[2][2][4][2], const Unit& u, int wr, int wc, int fr, int fq) const {
        constexpr int NF = DH / 8;
        const int row0 = u.pm * BM + wr * 64 + fr, col0 = u.pn * BM + wc * 32 + 8 * fq;
        const int sect = u.pn >> 2;
        const float sc = (sect == 0) ? qscale : 1.f;
        const bool rot = (sect < 2) && (DH == 64 ? (((wc & 1) == 0) && (fq < 2)) : (wc == 0));
#pragma unroll
        for (int ai = 0; ai < 2; ++ai)
#pragma unroll
            for (int m = 0; m < 4; ++m) {
                const int row = row0 + ai * HALF + m * 16; const int pos = row & 8191; const float rs = sc * __builtin_amdgcn_rsqf((float)rss[row] * (5.9604644775390625e-8f / 1024.0f) + 1e-6f);
                f32x4 c4 = (f32x4){1.f, 1.f, 1.f, 1.f}, s4 = (f32x4){0.f, 0.f, 0.f, 0.f};
                if (rot) { c4 = *(const f32x4*)(ct + pos * NF + 4 * fq); s4 = *(const f32x4*)(st + pos * NF + 4 * fq); }
                bf16_t* rowp = O + (size_t)row * ldc + col0;
#pragma unroll
                for (int bj = 0; bj < 2; ++bj) {
                    const f32x4 x1 = acc[ai][bj][m][0], x2 = acc[ai][bj][m][1];
                    f32x4 v0 = (x1 * c4 - x2 * s4) * rs, v1 = (x2 * c4 + x1 * s4) * rs;
                    u32x4 w; w.x = cvt_pk_bf16(v0[0], v0[1]); w.y = cvt_pk_bf16(v0[2], v0[3]); w.z = cvt_pk_bf16(v1[0], v1[1]); w.w = cvt_pk_bf16(v1[2], v1[3]);
                    *(u32x4*)(rowp + bj * HALF) = w; }
            }
    }
};

__device__ __forceinline__ float silu_mul(float a, float b) { return a * b * __builtin_amdgcn_rcpf(1.0f + __builtin_amdgcn_exp2f(-1.4426950408889634f * a)); }
struct EpiSwiGLU {
    static constexpr bool PERM = true;
    bf16_t* O; int ldc; const float* gate; const unsigned long long* rss; const int* rowmap;
    __device__ __forceinline__ void operator()(const f32x4 (&acc)[2][2][4][2], const Unit& u, int wr, int wc, int fr, int fq) const {
        const int row0 = u.pm * BM + wr * 64 + fr, col0 = u.pn * HALF + wc * 32 + 8 * fq;
#pragma unroll
        for (int ai = 0; ai < 2; ++ai)
#pragma unroll
            for (int m = 0; m < 4; ++m) {
                const int row = row0 + ai * HALF + m * 16; const float g = gate ? gate[row] : 1.f; const int trow = rowmap ? rowmap[row] : row;
                const float rs = trow >= 0 ? __builtin_amdgcn_rsqf((float)rss[trow] * (5.9604644775390625e-8f / 1024.0f) + 1e-6f) : 0.f;
                const f32x4 a0 = acc[ai][0][m][0] * rs, a1 = acc[ai][0][m][1] * rs, b0 = acc[ai][1][m][0] * rs, b1 = acc[ai][1][m][1] * rs;
                float v[8];
#pragma unroll
                for (int k = 0; k < 4; ++k) { v[k] = g * silu_mul(a0[k], b0[k]); v[4 + k] = g * silu_mul(a1[k], b1[k]); }
                u32x4 w; w.x = cvt_pk_bf16(v[0], v[1]); w.y = cvt_pk_bf16(v[2], v[3]); w.z = cvt_pk_bf16(v[4], v[5]); w.w = cvt_pk_bf16(v[6], v[7]);
                *(u32x4*)(O + (size_t)row * ldc + col0) = w; }
    }
};
struct EpiResB {
    static constexpr bool PERM = true;
    const bf16_t* Rin; bf16_t* Rout; int ldc; const int* rowmap; unsigned long long* rss_out;
    __device__ __forceinline__ void operator()(const f32x4 (&acc)[2][2][4][2], const Unit& u, int wr, int wc, int fr, int fq) const {
        const int row0 = u.pm * BM + wr * 64 + fr, col0 = u.pn * BM + wc * 32 + 8 * fq;
#pragma unroll
        for (int ai = 0; ai < 2; ++ai)
#pragma unroll
            for (int m = 0; m < 4; ++m) {
                const int row = row0 + ai * HALF + m * 16; const int orow = rowmap ? rowmap[row] : row; float ss = 0.f;
                if (orow >= 0) { const bf16_t* rp = Rin + (size_t)orow * ldc + col0; bf16_t* wp = Rout + (size_t)orow * ldc + col0;
#pragma unroll
                    for (int bj = 0; bj < 2; ++bj) { const u32x4 w = *(const u32x4*)(rp + bj * HALF); const f32x4 a0 = acc[ai][bj][m][0], a1 = acc[ai][bj][m][1];
                        float v[8];
                        v[0] = __uint_as_float(w.x << 16) + a0[0]; v[1] = __uint_as_float(w.x & 0xffff0000u) + a0[1]; v[2] = __uint_as_float(w.y << 16) + a0[2]; v[3] = __uint_as_float(w.y & 0xffff0000u) + a0[3];
                        v[4] = __uint_as_float(w.z << 16) + a1[0]; v[5] = __uint_as_float(w.z & 0xffff0000u) + a1[1]; v[6] = __uint_as_float(w.w << 16) + a1[2]; v[7] = __uint_as_float(w.w & 0xffff0000u) + a1[3];
#pragma unroll
                        for (int k = 0; k < 8; ++k) ss += v[k] * v[k];
                        u32x4 o; o.x = cvt_pk_bf16(v[0], v[1]); o.y = cvt_pk_bf16(v[2], v[3]); o.z = cvt_pk_bf16(v[4], v[5]); o.w = cvt_pk_bf16(v[6], v[7]);
                        *(u32x4*)(wp + bj * HALF) = o; } }
                if (rss_out) { ss += __shfl_xor(ss, 16); ss += __shfl_xor(ss, 32);
                    if (fq == 0) __hip_atomic_fetch_add(rss_out + orow, (unsigned long long)(ss * 16777216.0f), __ATOMIC_RELAXED, __HIP_MEMORY_SCOPE_AGENT); }
                if (m & 1) asm volatile("" ::: "memory"); }
    }
};

template <class Epi, class AB>
__device__ __forceinline__ void gemm_phase(PG8_LAS unsigned char* lds, const AB ab, const TileOrder& S, const Epi& E) {
    const int tid = threadIdx.x, wid = __builtin_amdgcn_readfirstlane(tid >> 6), lane = tid & 63, wr = wid >> 2, wc = wid & 3, fr = lane & 15, fq = lane >> 4;
    const int K = ab.K, nt = K / BK;
    int Rr[2], Cc[2]; unsigned voffB[2];
#pragma unroll
    for (int i = 0; i < 2; ++i) { int R, C; stage_rc(tid * 16 + i * 8192, R, C); const int Rb = Epi::PERM ? ((R & ~31) + perm32(R & 31)) : R;
        Rr[i] = R; Cc[i] = C; voffB[i] = (unsigned)(Rb * K + C) * 2u; }
    const size_t kstep = (size_t)(BK * 2);
    const size_t hstep = (size_t)HALF * K * 2;
    const unsigned ldsw = (unsigned)wid * 1024u;
    const int aoff = lds_byte(wr * 64 + fr, fq * 8), boff = lds_byte(wc * 32 + fr, fq * 8);
#define PG8_SA(b, h) (((b) * 2 + (h)) * HTB)
#define PG8_SB(b, h) ((4 + (b) * 2 + (h)) * HTB)
#define PG8_STAGE(bufoff, gbase, voff) do { _Pragma("unroll") for (int _i = 0; _i < 2; ++_i) \
        __builtin_amdgcn_global_load_lds((const unsigned*)((const char*)(gbase) + (voff)[_i]), (PG8_LAS unsigned*)(lds + (bufoff) + ldsw + _i * 8192), 16, 0, 0); } while (0)
#define PG8_LDA(dst, b, h) do { _Pragma("unroll") for (int m = 0; m < 4; ++m) _Pragma("unroll") for (int k = 0; k < 2; ++k) dst[m][k] = *(const PG8_LAS bf16x8*)(lds + PG8_SA(b, h) + aoff + m * 2048 + k * 1024); } while (0)
#define PG8_LDB(dst, b, h) do { _Pragma("unroll") for (int n = 0; n < 2; ++n) _Pragma("unroll") for (int k = 0; k < 2; ++k) dst[n][k] = *(const PG8_LAS bf16x8*)(lds + PG8_SB(b, h) + boff + n * 2048 + k * 1024); } while (0)
#define PG8_MMA(ai, bj, At, Bt) do { __builtin_amdgcn_s_setprio(1); _Pragma("unroll") for (int m = 0; m < 4; ++m) _Pragma("unroll") for (int n = 0; n < 2; ++n) _Pragma("unroll") for (int k = 0; k < 2; ++k) \
        acc[ai][bj][m][n] = __builtin_amdgcn_mfma_f32_16x16x32_bf16(Bt[n][k], At[m][k], acc[ai][bj][m][n], 0, 0, 0); __builtin_amdgcn_s_setprio(0); } while (0)
#define PG8_WAIT_V(n) asm volatile("s_waitcnt vmcnt(" #n ")" ::: "memory")
#define PG8_WAIT_L(n) asm volatile("s_waitcnt lgkmcnt(" #n ")" ::: "memory")
#define PG8_BAR __builtin_amdgcn_s_barrier()
#define PG8_SCHED __builtin_amdgcn_sched_barrier(0)
    Unit cur, nxt; int ui = 0;
    if (!S.next(0, cur)) return;
    f32x4 acc[2][2][4][2];
#pragma unroll
    for (int a = 0; a < 2; ++a)
#pragma unroll
        for (int b = 0; b < 2; ++b)
#pragma unroll
            for (int m = 0; m < 4; ++m)
#pragma unroll
                for (int n = 0; n < 2; ++n) acc[a][b][m][n] = (f32x4){0.f, 0.f, 0.f, 0.f};
    bf16x8 At[4][2], B0[2][2], B1[2][2];
    unsigned cv0[2], cv1[2], nv0[2], nv1[2]; int ntok[4] = {0, 0, 0, 0};
    if constexpr (AB::GATHER) { const int* tp = ab.tokp(cur);
#pragma unroll
        for (int i = 0; i < 2; ++i) { int t0 = tp[Rr[i]], t1 = tp[HALF + Rr[i]]; t0 = t0 < 0 ? 0 : t0; t1 = t1 < 0 ? 0 : t1;
            cv0[i] = (unsigned)(t0 * K + Cc[i]) * 2u; cv1[i] = (unsigned)(t1 * K + Cc[i]) * 2u; }
    } else {
#pragma unroll
        for (int i = 0; i < 2; ++i) { cv0[i] = (unsigned)(Rr[i] * K + Cc[i]) * 2u; cv1[i] = cv0[i] + (unsigned)hstep; }
    }
#pragma unroll
    for (int i = 0; i < 2; ++i) { nv0[i] = cv0[i]; nv1[i] = cv1[i]; }
    const char* cA = ab.abase(cur); const char* cB = ab.bbase(cur);
    PG8_STAGE(PG8_SB(0, 0), cB, voffB); PG8_STAGE(PG8_SB(0, 1), cB + hstep, voffB); PG8_STAGE(PG8_SA(0, 0), cA, cv0); PG8_STAGE(PG8_SA(0, 1), cA, cv1);
    if (wr == 1) PG8_BAR;
    PG8_WAIT_V(2); PG8_BAR;
    PG8_STAGE(PG8_SB(1, 0), cB + kstep, voffB); PG8_STAGE(PG8_SA(1, 0), cA + kstep, cv0); PG8_STAGE(PG8_SB(1, 1), cB + hstep + kstep, voffB);
    PG8_WAIT_V(6); PG8_BAR;
    for (;;) {
        const bool has_next = S.next(ui + 1, nxt);
        const char* nA = has_next ? ab.abase(nxt) : cA; const char* nB = has_next ? ab.bbase(nxt) : cB;
        if constexpr (AB::GATHER) {
            if (has_next) { const int* tp = ab.tokp(nxt);
                asm volatile("global_load_dword %0, %1, off" : "=v"(ntok[0]) : "v"(tp + Rr[0]) : "memory");
                asm volatile("global_load_dword %0, %1, off" : "=v"(ntok[1]) : "v"(tp + Rr[1]) : "memory");
                asm volatile("global_load_dword %0, %1, off" : "=v"(ntok[2]) : "v"(tp + HALF + Rr[0]) : "memory");
                asm volatile("global_load_dword %0, %1, off" : "=v"(ntok[3]) : "v"(tp + HALF + Rr[1]) : "memory"); }
        }
        for (int t = 0; t < nt; t += 2) {
            const bool last = (t == nt - 2);
            const char* a1 = cA + (size_t)(t + 1) * kstep;
            const char* a2 = last ? nA : cA + (size_t)(t + 2) * kstep; const char* b2 = last ? nB : cB + (size_t)(t + 2) * kstep;
            const char* a3 = a2 + kstep; const char* b3 = b2 + kstep;
            unsigned x0[2], x1[2];
            if constexpr (AB::GATHER) {
                if (last && has_next) {
                    asm volatile("s_waitcnt vmcnt(6)" : "+v"(ntok[0]), "+v"(ntok[1]), "+v"(ntok[2]), "+v"(ntok[3]) :: "memory");
#pragma unroll
                    for (int i = 0; i < 2; ++i) { int t0 = ntok[i], t1 = ntok[2 + i]; t0 = t0 < 0 ? 0 : t0; t1 = t1 < 0 ? 0 : t1;
                        nv0[i] = (unsigned)(t0 * K + Cc[i]) * 2u; nv1[i] = (unsigned)(t1 * K + Cc[i]) * 2u; }
                }
#pragma unroll
                for (int i = 0; i < 2; ++i) { x0[i] = last ? nv0[i] : cv0[i]; x1[i] = last ? nv1[i] : cv1[i]; }
            } else {
#pragma unroll
                for (int i = 0; i < 2; ++i) { x0[i] = cv0[i]; x1[i] = cv1[i]; }
            }
            PG8_LDB(B0, 0, 0); PG8_LDB(B1, 0, 1); PG8_SCHED; PG8_LDA(At, 0, 0); PG8_STAGE(PG8_SA(1, 1), a1, cv1);
            PG8_WAIT_V(8); PG8_WAIT_L(0); PG8_BAR; PG8_MMA(0, 0, At, B0); PG8_MMA(0, 1, At, B1); PG8_BAR; PG8_SCHED;
            PG8_LDA(At, 0, 1); PG8_STAGE(PG8_SB(0, 0), b2, voffB); PG8_STAGE(PG8_SB(0, 1), b2 + hstep, voffB); PG8_STAGE(PG8_SA(0, 0), a2, x0);
            PG8_WAIT_V(8); PG8_WAIT_L(0); PG8_BAR; PG8_MMA(1, 0, At, B0); PG8_MMA(1, 1, At, B1); PG8_BAR; PG8_SCHED;
            PG8_LDB(B0, 1, 0); PG8_LDB(B1, 1, 1); PG8_SCHED; PG8_LDA(At, 1, 0); PG8_STAGE(PG8_SA(0, 1), a2, x1);
            PG8_WAIT_V(8); PG8_WAIT_L(0); PG8_BAR; PG8_MMA(0, 0, At, B0); PG8_MMA(0, 1, At, B1); PG8_BAR; PG8_SCHED;
            PG8_LDA(At, 1, 1); PG8_STAGE(PG8_SB(1, 0), b3, voffB); PG8_STAGE(PG8_SB(1, 1), b3 + hstep, voffB); PG8_STAGE(PG8_SA(1, 0), a3, x0);
            PG8_WAIT_V(8); PG8_WAIT_L(0); PG8_BAR; PG8_MMA(1, 0, At, B0); PG8_MMA(1, 1, At, B1); PG8_BAR; PG8_SCHED;
        }
        if (wr == 0) PG8_BAR;
        E(acc, cur, wr, wc, fr, fq);
        if (!has_next) break;
#pragma unroll
        for (int a = 0; a < 2; ++a)
#pragma unroll
            for (int b = 0; b < 2; ++b)
#pragma unroll
                for (int m = 0; m < 4; ++m)
#pragma unroll
                    for (int n = 0; n < 2; ++n) acc[a][b][m][n] = (f32x4){0.f, 0.f, 0.f, 0.f};
        cur = nxt; cA = nA; cB = nB; ++ui;
#pragma unroll
        for (int i = 0; i < 2; ++i) { cv0[i] = nv0[i]; cv1[i] = nv1[i]; }
        if (wr == 1) PG8_BAR;
    }
    PG8_WAIT_V(0);
    PG8_BAR;
#undef PG8_SA
#undef PG8_SB
#undef PG8_STAGE
#undef PG8_LDA
#undef PG8_LDB
#undef PG8_MMA
#undef PG8_WAIT_V
#undef PG8_WAIT_L
#undef PG8_BAR
#undef PG8_SCHED
}
}

namespace moba {
using bf16 = __hip_bfloat16;
using bf16x8 = __attribute__((ext_vector_type(8))) short;
using s16x4  = __attribute__((ext_vector_type(4))) short;
using f32x16 = __attribute__((ext_vector_type(16))) float;
using u32x4  = __attribute__((ext_vector_type(4))) unsigned;
constexpr int D = 128, NW = 8, QBLK = 32, KVBLK = 64, LDK = 3072, NT = 4;
constexpr float THR = 8.f;
constexpr size_t SHM_V = KVBLK * D * 2, SHM_K = KVBLK * D * 2, SHM_ATTN = 2 * SHM_V + 2 * SHM_K + NW * 64 * 4;
#define KSWZ(row, colB) ((row) * 256 + ((colB) ^ (((row) & 7) << 4)))
#define SBAR() __builtin_amdgcn_sched_barrier(0)
__device__ __forceinline__ int crow(int r, int hi) { return (r & 3) + 8 * (r >> 2) + 4 * hi; }
__device__ __forceinline__ unsigned cvtpk(float lo, float hi) { unsigned r; asm volatile("v_cvt_pk_bf16_f32 %0, %1, %2" : "=v"(r) : "v"(lo), "v"(hi)); return r; }
__device__ __forceinline__ void partialSM(f32x16& p0, f32x16& p1, float& m_reg, float& mn, float& alpha) {
  float pmax = p0[0];
#pragma unroll
  for (int r = 1; r < 16; ++r) pmax = fmaxf(pmax, p0[r]);
#pragma unroll
  for (int r = 0; r < 16; ++r) pmax = fmaxf(pmax, p1[r]);
  { auto rr = __builtin_amdgcn_permlane32_swap(__float_as_uint(pmax), __float_as_uint(pmax), false, false);
    pmax = fmaxf(__uint_as_float(rr[0]), __uint_as_float(rr[1])); }
  if (__builtin_expect(__all(pmax - m_reg <= THR), 1)) { mn = m_reg; alpha = 1.f; }
  else { mn = fmaxf(m_reg, pmax); alpha = __builtin_amdgcn_exp2f(m_reg - mn); m_reg = mn; }
#pragma unroll
  for (int r = 0; r < 16; ++r) p0[r] = p0[r] - mn;
#pragma unroll
  for (int r = 0; r < 16; ++r) p1[r] = p1[r] - mn;
#pragma unroll
  for (int r = 0; r < 16; ++r) p0[r] = __builtin_amdgcn_exp2f(p0[r]);
}
__device__ __forceinline__ void finishSM(f32x16& p0, f32x16& p1, float alpha, float& l_reg, bf16x8& pa0, bf16x8& pa1, bf16x8& pa2, bf16x8& pa3) {
#pragma unroll
  for (int r = 0; r < 16; ++r) p1[r] = __builtin_amdgcn_exp2f(p1[r]);
  float ps = 0;
#pragma unroll
  for (int r = 0; r < 16; ++r) ps += p0[r];
#pragma unroll
  for (int r = 0; r < 16; ++r) ps += p1[r];
  { auto rr = __builtin_amdgcn_permlane32_swap(__float_as_uint(ps), __float_as_uint(ps), false, false);
    ps = __uint_as_float(rr[0]) + __uint_as_float(rr[1]); }
  l_reg = l_reg * alpha + ps;
#define PK4(P, BASE, OUT) do { unsigned a0 = cvtpk(P[BASE + 0], P[BASE + 1]), a1 = cvtpk(P[BASE + 2], P[BASE + 3]);   \
    unsigned b0 = cvtpk(P[BASE + 4], P[BASE + 5]), b1 = cvtpk(P[BASE + 6], P[BASE + 7]);                              \
    auto r0 = __builtin_amdgcn_permlane32_swap(a0, b0, false, false); auto r1 = __builtin_amdgcn_permlane32_swap(a1, b1, false, false); \
    u32x4 w = {r0[0], r1[0], r0[1], r1[1]}; OUT = *reinterpret_cast<bf16x8*>(&w); } while (0)
  PK4(p0, 0, pa0); PK4(p0, 8, pa1); PK4(p1, 0, pa2); PK4(p1, 8, pa3);
#undef PK4
}
__device__ __forceinline__ void qkt(f32x16& p0, f32x16& p1, const bf16* Ks, const bf16x8* qr, int r32, int hi) {
  p0 = f32x16{}; p1 = f32x16{};
#pragma unroll
  for (int d0 = 0; d0 < 8; ++d0) { int cb = (d0 * 16 + hi * 8) * 2;
    bf16x8 b0 = *reinterpret_cast<const bf16x8*>((const char*)Ks + KSWZ(r32, cb));
    bf16x8 b1 = *reinterpret_cast<const bf16x8*>((const char*)Ks + KSWZ(32 + r32, cb));
    p0 = __builtin_amdgcn_mfma_f32_32x32x16_bf16(b0, qr[d0], p0, 0, 0, 0);
    p1 = __builtin_amdgcn_mfma_f32_32x32x16_bf16(b1, qr[d0], p1, 0, 0, 0); }
}
__device__ __forceinline__ int v_st(int k, int c) { const int kk = (k & ~0xC) | ((k & 4) << 1) | ((k & 8) >> 1); return ((kk >> 3) * 4 + (c >> 5)) * 512 + ((kk & 7) * 32 + (c & 31)) * 2; }
__device__ __forceinline__ int v_rd_base(int lane) { return ((lane & 3) << 3) | (((lane >> 2) & 3) << 6) | (((lane >> 4) & 1) << 5) | (((lane >> 5) & 1) << 8); }
constexpr int v_rd_off(int d0, int ks, int half) { return d0 * 512 + ks * 4096 + half * 2048; }
template <int OFF> __device__ __forceinline__ s16x4 tr_read(int vb) {
  s16x4 r; asm volatile("ds_read_b64_tr_b16 %0, %1 offset:%2" : "=&v"(r) : "v"(vb), "i"(OFF) : "memory"); return r;
}
template <int D0> __device__ __forceinline__ void pv_one(f32x16& od, int vb, bf16x8 pa0, bf16x8 pa1, bf16x8 pa2, bf16x8 pa3) {
  const s16x4 l0 = tr_read<v_rd_off(D0, 0, 0)>(vb), h0 = tr_read<v_rd_off(D0, 0, 1)>(vb), l1 = tr_read<v_rd_off(D0, 1, 0)>(vb), h1 = tr_read<v_rd_off(D0, 1, 1)>(vb);
  const s16x4 l2 = tr_read<v_rd_off(D0, 2, 0)>(vb), h2 = tr_read<v_rd_off(D0, 2, 1)>(vb), l3 = tr_read<v_rd_off(D0, 3, 0)>(vb), h3 = tr_read<v_rd_off(D0, 3, 1)>(vb);
  asm volatile("s_waitcnt lgkmcnt(0)" ::: "memory"); SBAR();
#define PK(L, H) (bf16x8){L[0], L[1], L[2], L[3], H[0], H[1], H[2], H[3]}
  od = __builtin_amdgcn_mfma_f32_32x32x16_bf16(pa0, PK(l0, h0), od, 0, 0, 0);
  od = __builtin_amdgcn_mfma_f32_32x32x16_bf16(pa1, PK(l1, h1), od, 0, 0, 0);
  od = __builtin_amdgcn_mfma_f32_32x32x16_bf16(pa2, PK(l2, h2), od, 0, 0, 0);
  od = __builtin_amdgcn_mfma_f32_32x32x16_bf16(pa3, PK(l3, h3), od, 0, 0, 0);
#undef PK
}
__device__ __forceinline__ void pv_d0(f32x16* o, int vb, bf16x8 pa0, bf16x8 pa1, bf16x8 pa2, bf16x8 pa3) {
  pv_one<0>(o[0], vb, pa0, pa1, pa2, pa3); pv_one<1>(o[1], vb, pa0, pa1, pa2, pa3); pv_one<2>(o[2], vb, pa0, pa1, pa2, pa3); pv_one<3>(o[3], vb, pa0, pa1, pa2, pa3);
}
__device__ __forceinline__ void cmask(f32x16& p0, f32x16& p1, int tile, int ql, int hi) {
  asm volatile("" : "+v"(ql));
#pragma unroll
  for (int r = 0; r < 16; ++r) { const int kv = 64 * tile + (r & 3) + 8 * (r >> 2) + 4 * hi; if (kv > ql) p0[r] = -1e30f; if (kv + 32 > ql) p1[r] = -1e30f; }
}
__device__ __forceinline__ void moba_unit(const bool OWN, const bf16* qrow, const bf16* __restrict__ Kh, const bf16* __restrict__ Vh, bf16* obase, int ostride, int dst, float* ml, int mli, int ql, char* lds) {
  const int tid = threadIdx.x, wid = tid >> 6, lane = tid & 63, r32 = lane & 31, hi = lane >> 5;
  bf16* V_lds = (bf16*)lds; bf16* K_lds = (bf16*)(lds + 2 * SHM_V);
  float* ws = (float*)(lds + 2 * SHM_V + 2 * SHM_K) + wid * 64; float* li_l = ws; float* al_l = ws + 32;
  float m_reg = -1e30f, l_reg = 0; f32x16 o[4] = {}; bf16x8 qr[8];
  const bf16* Qw = qrow + hi * 8;
#pragma unroll
  for (int d0 = 0; d0 < 8; ++d0) qr[d0] = *reinterpret_cast<const bf16x8*>(Qw + d0 * 16);
  const int sr = tid >> 4, sc = (tid & 15) * 8, vst0 = v_st(sr, sc), vst1 = v_st(32 + sr, sc);
  const int vb0 = (int)(uintptr_t)V_lds + v_rd_base(lane);
  struct { bf16x8 vs0, vs1, ks0, ks1; } sr_[2];
#define SLOAD(i, k0) do { sr_[i].vs0 = *reinterpret_cast<const bf16x8*>(&Vh[(long)((k0) + sr) * LDK + sc]); sr_[i].vs1 = *reinterpret_cast<const bf16x8*>(&Vh[(long)((k0) + 32 + sr) * LDK + sc]); \
    sr_[i].ks0 = *reinterpret_cast<const bf16x8*>(&Kh[(long)((k0) + sr) * LDK + sc]); sr_[i].ks1 = *reinterpret_cast<const bf16x8*>(&Kh[(long)((k0) + 32 + sr) * LDK + sc]); } while (0)
#define SWRITE(b, i) do { *(bf16x8*)((char*)V_lds + (b) * SHM_V + vst0) = sr_[i].vs0;          \
    *(bf16x8*)((char*)V_lds + (b) * SHM_V + vst1) = sr_[i].vs1; int kc = sc * 2;               \
    *(bf16x8*)((char*)K_lds + (b) * SHM_K + KSWZ(sr, kc)) = sr_[i].ks0;                       \
    *(bf16x8*)((char*)K_lds + (b) * SHM_K + KSWZ(32 + sr, kc)) = sr_[i].ks1; } while (0)
#define SWAIT() asm volatile("s_waitcnt vmcnt(4)" ::: "memory")
#define RESC(a) do { if (__any((a) < 1.f)) { if (hi == 0) al_l[r32] = (a); asm volatile("s_waitcnt lgkmcnt(0)" ::: "memory"); \
    _Pragma("unroll") for (int d = 0; d < 4; ++d) _Pragma("unroll") for (int r = 0; r < 16; ++r) o[d][r] *= al_l[crow(r, hi)]; } } while (0)
  f32x16 pA0, pA1, pB0, pB1; float mnA, mnB, alA, alB; bf16x8 pa0, pa1, pa2, pa3;
  constexpr int SE = 0, SO = 1;
  SLOAD(SE, 0); asm volatile("s_waitcnt vmcnt(0)" ::: "memory"); SWRITE(0, SE); __syncthreads();
  qkt(pA0, pA1, K_lds, qr, r32, hi); if (OWN) cmask(pA0, pA1, 0, ql, hi); partialSM(pA0, pA1, m_reg, mnA, alA);
  SLOAD(SO, KVBLK); SLOAD(SE, 2 * KVBLK);
  SWAIT(); SWRITE(1, SO); __syncthreads();
  {
    SBAR(); qkt(pB0, pB1, (bf16*)((char*)K_lds + SHM_K), qr, r32, hi);
    finishSM(pA0, pA1, alA, l_reg, pa0, pa1, pa2, pa3); SBAR();
    SLOAD(SO, 3 * KVBLK); SBAR();
    pv_d0(o, vb0, pa0, pa1, pa2, pa3); if (OWN) cmask(pB0, pB1, 1, ql, hi); partialSM(pB0, pB1, m_reg, mnB, alB);
    __syncthreads(); SWAIT(); SWRITE(0, SE);
    RESC(alB); __syncthreads();
    SBAR(); qkt(pA0, pA1, K_lds, qr, r32, hi);
    finishSM(pB0, pB1, alB, l_reg, pa0, pa1, pa2, pa3); SBAR();
    pv_d0(o, vb0 + (int)SHM_V, pa0, pa1, pa2, pa3); if (OWN) cmask(pA0, pA1, 2, ql, hi); partialSM(pA0, pA1, m_reg, mnA, alA);
    __syncthreads(); asm volatile("s_waitcnt vmcnt(0)" ::: "memory"); SWRITE(1, SO);
    RESC(alA); __syncthreads();
  }
  SBAR(); qkt(pB0, pB1, (bf16*)((char*)K_lds + SHM_K), qr, r32, hi);
  finishSM(pA0, pA1, alA, l_reg, pa0, pa1, pa2, pa3); SBAR();
  pv_d0(o, vb0, pa0, pa1, pa2, pa3); if (OWN) cmask(pB0, pB1, 3, ql, hi); partialSM(pB0, pB1, m_reg, mnB, alB);
  __syncthreads(); RESC(alB);
  finishSM(pB0, pB1, alB, l_reg, pa0, pa1, pa2, pa3); SBAR();
  pv_d0(o, vb0 + (int)SHM_V, pa0, pa1, pa2, pa3);
  if (hi == 0) li_l[r32] = l_reg; asm volatile("s_waitcnt lgkmcnt(0)" ::: "memory");
  float rli[16];
#pragma unroll
  for (int r = 0; r < 16; ++r) rli[r] = __builtin_amdgcn_rcpf(li_l[crow(r, hi)]);
  __syncthreads();
  bf16* stg = (bf16*)lds + wid * 4096;
#pragma unroll
  for (int r = 0; r < 16; ++r) { const int orow = crow(r, hi);
#pragma unroll
    for (int d0 = 0; d0 < 4; ++d0) stg[orow * 128 + d0 * 32 + r32] = __float2bfloat16(o[d0][r] * rli[r]); }
  int* dsto = (int*)al_l;
  if (hi == 0) dsto[r32] = dst;
  asm volatile("s_waitcnt lgkmcnt(0)" ::: "memory");
#pragma unroll
  for (int i = 0; i < 8; ++i) { const int row = i * 4 + (lane >> 4), ch = lane & 15; const int di = dsto[row]; const u32x4 v = *(const u32x4*)(stg + row * 128 + ch * 8);
    if (di >= 0) *(u32x4*)(obase + (size_t)di * ostride + ch * 8) = v; }
  if (hi == 0 && dst >= 0) { ml[2 * (size_t)mli] = m_reg; ml[2 * (size_t)mli + 1] = l_reg; }
  asm volatile("s_waitcnt lgkmcnt(0)" ::: "memory");
  __syncthreads();
#undef SLOAD
#undef SWRITE
#undef SWAIT
#undef RESC
}

#define KSWZ64(row, colB) ((row) * 128 + ((colB) ^ ((((row) >> 1) & 7) << 4)))
constexpr size_t DA_SHM_K = 64 * 64 * 2;
constexpr size_t DA_SHM = 2 * SHM_V + 2 * DA_SHM_K + NW * 64 * 4;
__device__ __forceinline__ void qkt64(f32x16& p0, f32x16& p1, const bf16* Ks, const bf16x8* qr, int r32, int hi) {
  p0 = f32x16{}; p1 = f32x16{};
#pragma unroll
  for (int d0 = 0; d0 < 4; ++d0) { int cb = (d0 * 16 + hi * 8) * 2;
    bf16x8 b0 = *reinterpret_cast<const bf16x8*>((const char*)Ks + KSWZ64(r32, cb));
    bf16x8 b1 = *reinterpret_cast<const bf16x8*>((const char*)Ks + KSWZ64(32 + r32, cb));
    p0 = __builtin_amdgcn_mfma_f32_32x32x16_bf16(b0, qr[d0], p0, 0, 0, 0);
    p1 = __builtin_amdgcn_mfma_f32_32x32x16_bf16(b1, qr[d0], p1, 0, 0, 0); }
}
__device__ __forceinline__ void dattn_unit(const bf16* Qb, const bf16* __restrict__ Kh, const bf16* __restrict__ Vh, bf16* Ob, const int NT, char* lds) {
  const int tid = threadIdx.x, wid = tid >> 6, lane = tid & 63, r32 = lane & 31, hi = lane >> 5;
  bf16* V_lds = (bf16*)lds; bf16* K_lds = (bf16*)(lds + 2 * SHM_V);
  float* ws = (float*)(lds + 2 * SHM_V + 2 * DA_SHM_K) + wid * 64; float* li_l = ws; float* al_l = ws + 32;
  float m_reg = -1e30f, l_reg = 0; f32x16 o[4] = {}; bf16x8 qr[4];
  const bf16* Qw = Qb + (long)(wid * QBLK + r32) * LDK + hi * 8;
#pragma unroll
  for (int d0 = 0; d0 < 4; ++d0) qr[d0] = *reinterpret_cast<const bf16x8*>(Qw + d0 * 16);
  const int sr = tid >> 4, sc = (tid & 15) * 8, vst0 = v_st(sr, sc), vst1 = v_st(32 + sr, sc);
  const int kr = tid >> 3, kc = (tid & 7) * 8, kst = KSWZ64(kr, kc * 2);
  const int vb0 = (int)(uintptr_t)V_lds + v_rd_base(lane);
  const int ql = wid * QBLK + r32;
  struct { bf16x8 vs0, vs1, ks; } sr_[2];
#define SLOAD(i, k0) do { sr_[i].vs0 = *reinterpret_cast<const bf16x8*>(&Vh[(long)((k0) + sr) * LDK + sc]); sr_[i].vs1 = *reinterpret_cast<const bf16x8*>(&Vh[(long)((k0) + 32 + sr) * LDK + sc]); \
    sr_[i].ks = *reinterpret_cast<const bf16x8*>(&Kh[(long)((k0) + kr) * LDK + kc]); } while (0)
#define SWRITE(b, i) do { *(bf16x8*)((char*)V_lds + (b) * SHM_V + vst0) = sr_[i].vs0; *(bf16x8*)((char*)V_lds + (b) * SHM_V + vst1) = sr_[i].vs1; \
    *(bf16x8*)((char*)K_lds + (b) * DA_SHM_K + kst) = sr_[i].ks; } while (0)
#define SWAIT() asm volatile("s_waitcnt vmcnt(3)" ::: "memory")
#define RESC(a) do { if (__any((a) < 1.f)) { if (hi == 0) al_l[r32] = (a); asm volatile("s_waitcnt lgkmcnt(0)" ::: "memory"); \
    _Pragma("unroll") for (int d = 0; d < 4; ++d) _Pragma("unroll") for (int r = 0; r < 16; ++r) o[d][r] *= al_l[crow(r, hi)]; } } while (0)
#define MASK(P0, P1, t) do { if ((t) >= NT - 4) cmask(P0, P1, (t) - (NT - 4), ql, hi); } while (0)
  f32x16 pA0, pA1, pB0, pB1; float mnA, mnB, alA, alB; bf16x8 pa0, pa1, pa2, pa3;
  constexpr int SE = 0, SO = 1;
  SLOAD(SE, 0); asm volatile("s_waitcnt vmcnt(0)" ::: "memory"); SWRITE(0, SE); __syncthreads();
  qkt64(pA0, pA1, K_lds, qr, r32, hi); MASK(pA0, pA1, 0); partialSM(pA0, pA1, m_reg, mnA, alA);
  SLOAD(SO, KVBLK); SLOAD(SE, 2 * KVBLK);
  SWAIT(); SWRITE(1, SO); __syncthreads();
  for (int j = 1; j + 1 < NT; j += 2) {
    SBAR(); qkt64(pB0, pB1, (bf16*)((char*)K_lds + DA_SHM_K), qr, r32, hi);
    finishSM(pA0, pA1, alA, l_reg, pa0, pa1, pa2, pa3); SBAR();
    SLOAD(SO, (j + 2) * KVBLK); SBAR();
    pv_d0(o, vb0, pa0, pa1, pa2, pa3); MASK(pB0, pB1, j); partialSM(pB0, pB1, m_reg, mnB, alB);
    __syncthreads(); SWAIT(); SWRITE(0, SE);
    RESC(alB); __syncthreads();
    SBAR(); qkt64(pA0, pA1, K_lds, qr, r32, hi);
    finishSM(pB0, pB1, alB, l_reg, pa0, pa1, pa2, pa3); SBAR();
    if (j + 3 < NT) SLOAD(SE, (j + 3) * KVBLK); SBAR();
    pv_d0(o, vb0 + (int)SHM_V, pa0, pa1, pa2, pa3); MASK(pA0, pA1, j + 1); partialSM(pA0, pA1, m_reg, mnA, alA);
    __syncthreads(); SWAIT(); SWRITE(1, SO);
    RESC(alA); __syncthreads();
  }
  SBAR(); qkt64(pB0, pB1, (bf16*)((char*)K_lds + DA_SHM_K), qr, r32, hi);
  finishSM(pA0, pA1, alA, l_reg, pa0, pa1, pa2, pa3); SBAR();
  pv_d0(o, vb0, pa0, pa1, pa2, pa3); MASK(pB0, pB1, NT - 1); partialSM(pB0, pB1, m_reg, mnB, alB);
  __syncthreads(); RESC(alB);
  finishSM(pB0, pB1, alB, l_reg, pa0, pa1, pa2, pa3); SBAR();
  pv_d0(o, vb0 + (int)SHM_V, pa0, pa1, pa2, pa3);
  if (hi == 0) li_l[r32] = l_reg; asm volatile("s_waitcnt lgkmcnt(0)" ::: "memory");
  float rli[16];
#pragma unroll
  for (int r = 0; r < 16; ++r) rli[r] = __builtin_amdgcn_rcpf(li_l[crow(r, hi)]);
  __syncthreads();
  bf16* stg = (bf16*)lds + wid * 4096;
#pragma unroll
  for (int r = 0; r < 16; ++r) { const int orow = crow(r, hi);
#pragma unroll
    for (int d0 = 0; d0 < 4; ++d0) stg[orow * 128 + d0 * 32 + r32] = __float2bfloat16(o[d0][r] * rli[r]); }
  asm volatile("s_waitcnt lgkmcnt(0)" ::: "memory");
#pragma unroll
  for (int i = 0; i < 8; ++i) { const int row = i * 4 + (lane >> 4), ch = lane & 15; const u32x4 v = *(const u32x4*)(stg + row * 128 + ch * 8);
    *(u32x4*)(Ob + (size_t)(wid * QBLK + row) * 2048 + ch * 8) = v; }
  asm volatile("s_waitcnt lgkmcnt(0)" ::: "memory");
  __syncthreads();
#undef SLOAD
#undef SWRITE
#undef SWAIT
#undef RESC
#undef MASK
}
struct DaUnit { int bqh; int qb; };
struct DaOrder {
  int vcu, G;
  __device__ __forceinline__ DaOrder(int vcu_, int G_) : vcu(vcu_), G(G_) {}
  __device__ __forceinline__ bool next(int i, DaUnit& u) const {
    if (G == 256) { if (i >= 8) return false; const int s = vcu & 7, ii = i & 3; u.bqh = (i >> 2) * 32 + (vcu >> 3); u.qb = (ii == 0) ? s : (ii == 1) ? 15 - s : (ii == 2) ? 16 + s : 31 - s; return true; }
    const int uu = vcu + i * G; if (uu >= 2048) return false; u.bqh = uu >> 5; u.qb = uu & 31; return true; }
};
template <class Sched> __device__ __forceinline__ void dattn_phase(char* lds, const bf16* QKV, bf16* O, const Sched& S) {
  DaUnit u;
  for (int i = 0; S.next(i, u); ++i) { const int b = u.bqh >> 4, qh = u.bqh & 15; const size_t rb = (size_t)b * 8192;
    dattn_unit(QKV + (rb + u.qb * 256) * LDK + qh * 64, QKV + rb * LDK + 1024 + qh * 64, QKV + rb * LDK + 2048 + (qh >> 1) * 128, O + (rb + u.qb * 256) * 2048 + qh * 128, 4 * (u.qb + 1), lds); }
}
#undef KSWZ64
#undef KSWZ
#undef SBAR
}
#define GAS __attribute__((address_space(1)))
#define LAS __attribute__((address_space(3)))
typedef unsigned short bf16;
typedef unsigned v4u __attribute__((ext_vector_type(4)));
typedef float f32x4 __attribute__((ext_vector_type(4)));
typedef short bf16x8 __attribute__((ext_vector_type(8)));
typedef GAS unsigned gu32;
typedef GAS unsigned long long gu64;
#define RLX_AGENT __ATOMIC_RELAXED, __HIP_MEMORY_SCOPE_AGENT
#define LDS_WAIT() asm volatile("s_waitcnt lgkmcnt(0)" ::: "memory")
#define VM_WAIT() asm volatile("s_waitcnt vmcnt(0)" ::: "memory")
__device__ __forceinline__ unsigned long long rt() { return __builtin_amdgcn_s_memrealtime(); }
__device__ __forceinline__ unsigned f2bf(float f) { unsigned u = __builtin_bit_cast(unsigned, f); return (u + 0x7fffu + ((u >> 16) & 1u)) >> 16; }
__device__ __forceinline__ unsigned pk2(float lo, float hi) { return f2bf(lo) | (f2bf(hi) << 16); }
#define XB_TMO      128
#define XB_XCNT(j)  (256  + 64 * (j))
#define XB_XSUB(j)  (1280 + 64 * (j))
#define XB_XGEN(j)  (2304 + 64 * (j))
#define XB_TOP      3328
#define XB_TOPGEN   3392
#define XCD_BAR_WORDS 3456
#define XB_SPIN_CAP (1u << 18)

__device__ __forceinline__ unsigned xb_ld(unsigned* p)              { return __hip_atomic_load(p, __ATOMIC_RELAXED, __HIP_MEMORY_SCOPE_AGENT); }
__device__ __forceinline__ unsigned xb_add(unsigned* p, unsigned v) { return __hip_atomic_fetch_add(p, v, __ATOMIC_RELAXED, __HIP_MEMORY_SCOPE_AGENT); }
__device__ __forceinline__ unsigned xb_xcc_id() { return (unsigned)__builtin_amdgcn_s_getreg((3 << 11) | 20) & 0xFu; }
#define XB_SPIN(cond, bar) do { unsigned _sp = 0; while (cond) { __builtin_amdgcn_s_sleep(1); \
    if ((++_sp & 255u) == 0u) { if (xb_ld(&(bar)[XB_TMO])) break; if (_sp > XB_SPIN_CAP) { atomicAdd(&(bar)[XB_TMO], 1u); break; } } } } while (0)

struct XcdBarrier {
    unsigned* bar; unsigned x;
    volatile LAS unsigned* st;
};

__device__ __forceinline__ XcdBarrier xcd_barrier_post(unsigned* bar, volatile LAS unsigned* st) {
    XcdBarrier b; b.bar = bar; b.x = xb_xcc_id(); b.st = st;
    if (threadIdx.x == 0) (void)xb_add(&bar[XB_XCNT(b.x)], 1u);
    return b;
}
__device__ __forceinline__ void xcd_barrier_complete(unsigned* bar, unsigned x, unsigned& nloc, unsigned& nx) {
    const unsigned G = gridDim.x * gridDim.y * gridDim.z;
    unsigned sum, cnt, mine, sp = 0u;
    for (;;) {
        sum = 0u; cnt = 0u; mine = 0u;
#pragma unroll
        for (unsigned j = 0; j < 16; ++j) { const unsigned c = xb_ld(&bar[XB_XCNT(j)]); sum += c; cnt += (c > 0u) ? 1u : 0u; mine = (j == x) ? c : mine; }
        if (sum == G) break;
        __builtin_amdgcn_s_sleep(1);
        if ((++sp & 255u) == 0u) { if (xb_ld(&bar[XB_TMO])) break; if (sp > XB_SPIN_CAP) { atomicAdd(&bar[XB_TMO], 1u); break; } }
    }
    nloc = mine > 0u ? mine : 1u; nx = cnt > 0u ? cnt : 1u;
}

__device__ __forceinline__ void xcd_barrier(const XcdBarrier& b) {
    asm volatile("s_waitcnt vmcnt(0)" ::: "memory");
    __syncthreads();
    if (threadIdx.x == 0) {
        unsigned* bar = b.bar;
        __builtin_amdgcn_s_waitcnt(0);
        unsigned nloc = b.st[0], nx = b.st[1];
        if (nloc == 0u) { xcd_barrier_complete(bar, b.x, nloc, nx); b.st[0] = nloc; b.st[1] = nx; }
        const unsigned old = xb_add(&bar[XB_XSUB(b.x)], 1u);
        const unsigned gen = old / nloc;
        if (old + 1u == (gen + 1u) * nloc) {
            __builtin_amdgcn_fence(__ATOMIC_RELEASE, "agent");
            asm volatile("s_waitcnt vmcnt(0)" ::: "memory");
            const unsigned og = xb_add(&bar[XB_TOP], 1u);
            const unsigned tg = og / nx;
            if (og + 1u == (tg + 1u) * nx) xb_add(&bar[XB_TOPGEN], 1u);
            else XB_SPIN(xb_ld(&bar[XB_TOPGEN]) == tg, bar);
            __builtin_amdgcn_fence(__ATOMIC_ACQUIRE, "agent");
            xb_add(&bar[XB_XGEN(b.x)], 1u);
            asm volatile("s_waitcnt vmcnt(0)" ::: "memory");
        } else {
            XB_SPIN(xb_ld(&bar[XB_XGEN(b.x)]) == gen, bar);
            __builtin_amdgcn_fence(__ATOMIC_ACQUIRE, "agent");
            asm volatile("s_waitcnt vmcnt(0)" ::: "memory");
        }
    }
    __syncthreads();
}

constexpr int NWAVES = 8;
#ifndef MK_PER_PHASE
#define MK_PER_PHASE 0
#endif
constexpr int BATCH = 4, SEQ = 8192, DM = 1024, TOK = BATCH * SEQ;
constexpr int FF0 = 2816, NEXP = 8, FF1 = 3584;
constexpr int NQKV = 3072;
constexpr int MB_H = 8, MB_NB = 32, MB_L = 256;
constexpr int SLOTS = TOK + NEXP * 256;
constexpr float NORM_EPS = 1e-6f, SUBLN_EPS = 1e-5f;
constexpr float LAMBDA_INIT0 = 0.2f;
constexpr float LOG2E = 1.4426950408889634f;
constexpr int LIST_PER_BH = 256 * 496;
__host__ __device__ constexpr int list_off(int j) { return 256 * (31 * j - (j * (j - 1)) / 2); }

constexpr size_t MiB = 1u << 20;
constexpr size_t WS_CTL = 0, CTL_ZERO_BYTES = 2 * MiB;
constexpr size_t WS_ROPE64 = 2 * MiB;
constexpr size_t WS_ROPE128 = WS_ROPE64 + 512 * 1024;
constexpr size_t WS_KMEAN = WS_ROPE128 + 1 * MiB;
constexpr size_t WS_TOK = 4 * MiB;
constexpr size_t WS_SLOT = 5 * MiB;
constexpr size_t WS_OWNML = 6 * MiB;
constexpr size_t WS_W0QKV = 8 * MiB, WS_W0O = 14 * MiB, WS_W013 = 16 * MiB, WS_W02 = 27 * MiB, WS_W1QKV = 33 * MiB, WS_W1O = 39 * MiB;
constexpr size_t B0 = 42 * MiB;
constexpr size_t WS_H = B0;
constexpr size_t WS_QKV = B0 + 64 * MiB;
constexpr size_t WS_OATT = B0 + 256 * MiB;
constexpr size_t WS_UD = B0 + 128 * MiB;
constexpr size_t WS_LIST = B0 + 256 * MiB;
constexpr size_t WS_PML = B0 + 272 * MiB;
constexpr size_t WS_PO = B0 + 280 * MiB;
constexpr size_t WS_WM13 = B0 + 64 * MiB;
constexpr size_t WS_WM2 = WS_WM13 + 112 * MiB;
constexpr size_t WS_UM = B0 + 232 * MiB;
constexpr size_t WS_END = WS_UM + (size_t)SLOTS * FF1 * 2;
static_assert(WS_PO + (size_t)TOK * MB_H * 3 * 128 * 2 <= WS_END + 8 * MiB && WS_END <= 528 * MiB, "d_ws map");
constexpr int CW_TMO = 0, CW_CODE = 1, CW_DBG = 2;
constexpr int CW_MOECNT = 64;
constexpr int CW_MOBACNT = 256;
constexpr int CW_BAR = 4096;
constexpr size_t WS_RSS = 1 * MiB;
constexpr int RING_OFF = 0, RING_BYTES = 131072;
constexpr int LDSCTL_OFF = RING_BYTES, MISC_OFF = LDSCTL_OFF + 320;
constexpr int LDS_BYTES = 147456;

struct Args { const float* in[20]; float* out; unsigned char* ws; float inv64[8]; float inv128[16]; int ph_lo, ph_hi; };

__device__ __forceinline__ float wave_sum(float v) {
#pragma unroll
    for (int o = 1; o < 64; o <<= 1) v += __shfl_xor(v, o);
    return v;
}
template <int MAP> __device__ __forceinline__ int maprow(int n) {
    if (MAP == 1) { if (n >= 2048) return n; const int d = n & 63; if (d >= 16) return n; const int b = d >> 3, a = (d >> 2) & 1, c = d & 3; return (n & ~63) + 8 * a + 4 * b + c; }
    if (MAP == 2) { if (n >= 2048) return n; const int d = n & 127; if (d >= 32) return n; const int b = d >> 4, a = (d >> 2) & 3, c = d & 3; return (n & ~127) + 8 * a + 4 * b + c; }
    if (MAP == 3) return 256 * (n >> 7) + (n & 127);
    if (MAP == 4) return 256 * (n >> 7) + 128 + (n & 127);
    return n;
}
template <int MAP> __device__ __forceinline__ void transpose_item(const float* W, int K, int N, bf16* WT, LAS float* scr, int item, int lane, const float* gk = nullptr) {
    const int nblk = N / 32, kb = item / nblk, nb = item % nblk, k0 = 64 * kb, n0 = 32 * nb;
    const int kr = lane >> 3, nc = (lane & 7) * 4;
    f32x4 v[8];
#pragma unroll
    for (int i = 0; i < 8; ++i) v[i] = *(const GAS f32x4*)(W + (size_t)(k0 + i * 8 + kr) * N + n0 + nc);
    if (gk) {
#pragma unroll
        for (int i = 0; i < 8; ++i) v[i] = v[i] * gk[k0 + i * 8 + kr]; }
#pragma unroll
    for (int i = 0; i < 8; ++i) { LAS float* d = scr + (i * 8 + kr) * 33 + nc; d[0] = v[i].x; d[1] = v[i].y; d[2] = v[i].z; d[3] = v[i].w; }
    LDS_WAIT(); asm volatile("" ::: "memory");
    const int c = lane & 7;
#pragma unroll
    for (int j = 0; j < 4; ++j) { const int n = (lane >> 3) + 8 * j; const LAS float* s = scr + (8 * c) * 33 + n;
        v4u o; o.x = pk2(s[0 * 33], s[1 * 33]); o.y = pk2(s[2 * 33], s[3 * 33]); o.z = pk2(s[4 * 33], s[5 * 33]); o.w = pk2(s[6 * 33], s[7 * 33]);
        *(GAS v4u*)(WT + (size_t)maprow<MAP>(n0 + n) * K + k0 + 8 * c) = o; }
    LDS_WAIT(); asm volatile("" ::: "memory");
}
__device__ __forceinline__ void rms_row(const float* xrow, const f32x4 (&g)[4], f32x4 (&v)[4], int lane) {
    const GAS f32x4* xr = (const GAS f32x4*)xrow + lane; float s = 0.f;
#pragma unroll
    for (int j = 0; j < 4; ++j) { v[j] = xr[64 * j]; s += (v[j].x * v[j].x + v[j].y * v[j].y) + (v[j].z * v[j].z + v[j].w * v[j].w); }
    const float rstd = 1.f / sqrtf(wave_sum(s) * (1.f / DM) + NORM_EPS);
#pragma unroll
    for (int j = 0; j < 4; ++j) v[j] = v[j] * rstd * g[j];
}
__device__ __forceinline__ void store_row_bf16(bf16* orow, const f32x4 (&v)[4], int lane) {
    GAS unsigned long long* o8 = (GAS unsigned long long*)orow + lane;
#pragma unroll
    for (int j = 0; j < 4; ++j) o8[64 * j] = (unsigned long long)pk2(v[j].x, v[j].y) | ((unsigned long long)pk2(v[j].z, v[j].w) << 32);
}
__device__ __forceinline__ void load_gain(const float* g, f32x4 (&gv)[4], int lane) {
#pragma unroll
    for (int j = 0; j < 4; ++j) gv[j] = *((const f32x4*)g + lane + 64 * j);
}
__device__ __forceinline__ void rmsnorm_phase(const float* src, const float* gain, bf16* dst, int gw, int ngw, int lane) {
    f32x4 gv[4]; load_gain(gain, gv, lane);
    for (int m = gw; m < TOK; m += ngw) { f32x4 v[4]; rms_row(src + (size_t)m * DM, gv, v, lane); store_row_bf16(dst + (size_t)m * DM, v, lane); }
}
__device__ __forceinline__ float bf2f(unsigned short b) { return __uint_as_float((unsigned)b << 16); }


typedef __attribute__((address_space(4))) const unsigned char* kaptr_t;
__device__ __forceinline__ kaptr_t ka_get() { kaptr_t p = (kaptr_t)__builtin_amdgcn_kernarg_segment_ptr(); asm volatile("" : "+s"(p)); return p; }
#define KA_IN(k) (*(const float* const __attribute__((address_space(4)))*)(ka + 8 * (k)))
#define PH_PTRS kaptr_t ka = ka_get(); unsigned char* const ws = *(unsigned char* const __attribute__((address_space(4)))*)(ka + 168); float* const out = *(float* const __attribute__((address_space(4)))*)(ka + 160); gu32* const ctl = (gu32*)(ws + WS_CTL); (void)out; (void)ctl
#define IN_X KA_IN(0)
#define norm_mix KA_IN(1)
#define norm_ffn KA_IN(2)
#define final_norm KA_IN(3)
#define da_wqkv KA_IN(4)
#define da_wo KA_IN(5)
#define da_lq1 KA_IN(6)
#define da_lk1 KA_IN(7)
#define da_lq2 KA_IN(8)
#define da_lk2 KA_IN(9)
#define da_subln KA_IN(10)
#define mb_wqkv KA_IN(11)
#define mb_wo KA_IN(12)
#define ffn_w1 KA_IN(13)
#define ffn_w3 KA_IN(14)
#define ffn_w2 KA_IN(15)
#define moe_router KA_IN(16)
#define moe_w1 KA_IN(17)
#define moe_w3 KA_IN(18)
#define moe_w2 KA_IN(19)
#define rope64 ((float*)(ws + WS_ROPE64))
#define rope128 ((float*)(ws + WS_ROPE128))
#define kmean ((float*)(ws + WS_KMEAN))
#define tok_e ((int*)(ws + WS_TOK))
#define tok_pos (tok_e + 2 * TOK)
#define tok_gate ((float*)(tok_pos + 2 * TOK))
#define wg_base ((int*)(ws + WS_TOK + 800 * 1024))
#define slot_tok ((int*)(ws + WS_SLOT))
#define slot_gate ((float*)(slot_tok + 2 * SLOTS))
#define ownml ((float*)(ws + WS_OWNML))
#define W0qkv ((bf16*)(ws + WS_W0QKV))
#define W0o ((bf16*)(ws + WS_W0O))
#define W013 ((bf16*)(ws + WS_W013))
#define W02 ((bf16*)(ws + WS_W02))
#define W1qkv ((bf16*)(ws + WS_W1QKV))
#define W1o ((bf16*)(ws + WS_W1O))
#define Rb ((bf16*)(ws + WS_H))
#define OB ((bf16*)out)
#define RSS(j) ((unsigned long long*)(ws + WS_RSS) + (size_t)(j) * TOK)
#define QKV ((bf16*)(ws + WS_QKV))
#define OATT ((bf16*)(ws + WS_OATT))
#define UD ((bf16*)(ws + WS_UD))
#define lists ((int*)(ws + WS_LIST))
#define pml ((float*)(ws + WS_PML))
#define PO ((bf16*)(ws + WS_PO))
#define WM13 ((bf16*)(ws + WS_WM13))
#define WM2 ((bf16*)(ws + WS_WM2))
#define UM ((bf16*)(ws + WS_UM))
__global__ void __launch_bounds__(NWAVES * 64, 2) mk_fwd(Args args) {
    extern __shared__ __attribute__((aligned(16))) unsigned char lds[];
    LAS unsigned char* L = (LAS unsigned char*)lds;
    volatile LAS unsigned* MISC = (volatile LAS unsigned*)(L + MISC_OFF);
    const int tid = threadIdx.x, lane = tid & 63, wave = __builtin_amdgcn_readfirstlane(tid >> 6);
    const int G = gridDim.x; const int bx = blockIdx.x; const int vcu = (G % 8 == 0) ? (bx % 8) * (G / 8) + bx / 8 : bx;
    const int gw = vcu * NWAVES + wave, NGW = G * NWAVES;
    gu32* ctl0 = (gu32*)(args.ws + WS_CTL);
    for (int u = tid; u < (LDS_BYTES - LDSCTL_OFF) / 4; u += NWAVES * 64) ((LAS unsigned*)(L + LDSCTL_OFF))[u] = 0u;
    __syncthreads();
    XcdBarrier bar; bar.bar = (unsigned*)(ctl0 + CW_BAR); bar.x = 0; bar.st = nullptr;
    if (!MK_PER_PHASE) bar = xcd_barrier_post((unsigned*)(ctl0 + CW_BAR), MISC + 8);
#define GRID_BAR() do { if (!MK_PER_PHASE) xcd_barrier(bar); } while (0)
    const int lo = args.ph_lo, hi_ph = args.ph_hi;
#ifndef PH_MASK
#define PH_MASK 0xFFFFFFFFu
#endif
#define IN(k) (((PH_MASK >> (k)) & 1u) && lo <= (k) && (k) < hi_ph)
#define SEAM(k) do { if (IN((k) + 1)) GRID_BAR(); } while (0)
#ifndef DUP_MASK
#define DUP_MASK 0u
#endif
#define NREP(k) ((((DUP_MASK) >> (k)) & 1u) ? 2 : 1)

    if (IN(0)) { PH_PTRS; for (int rep_ = 0; rep_ < NREP(0); ++rep_) {
        LAS float* scr = (LAS float*)(L + RING_OFF + wave * 16384);
        constexpr int I_QKV = (DM / 64) * (NQKV / 32), I_O = (DM / 64) * (DM / 32), I_13 = (DM / 64) * (FF0 / 32), I_2 = (FF0 / 64) * (DM / 32);
        constexpr int NITEMS = 2 * I_QKV + 2 * I_O + 2 * I_13 + I_2;
        for (int it = gw; it < NITEMS; it += NGW) {
            int r = it;
            if (r < I_QKV) { transpose_item<1>(da_wqkv, DM, NQKV, W0qkv, scr, r, lane, norm_mix); continue; } r -= I_QKV;
            if (r < I_QKV) { transpose_item<2>(mb_wqkv, DM, NQKV, W1qkv, scr, r, lane, norm_mix + DM); continue; } r -= I_QKV;
            if (r < I_O) { transpose_item<0>(da_wo, DM, DM, W0o, scr, r, lane); continue; } r -= I_O;
            if (r < I_O) { transpose_item<0>(mb_wo, DM, DM, W1o, scr, r, lane); continue; } r -= I_O;
            if (r < I_13) { transpose_item<3>(ffn_w1, DM, FF0, W013, scr, r, lane, norm_ffn); continue; } r -= I_13;
            if (r < I_13) { transpose_item<4>(ffn_w3, DM, FF0, W013, scr, r, lane, norm_ffn); continue; } r -= I_13;
            transpose_item<0>(ffn_w2, FF0, DM, W02, scr, r, lane);
        }
        {
            const int gt = (vcu * NWAVES + wave) * 64 + lane, NT_ = G * NWAVES * 64;
            for (int e = gt; e < SEQ * 8; e += NT_) { const int pos = e >> 3, i = e & 7; const float ang = (float)pos * (*(const float __attribute__((address_space(4)))*)(ka + 176 + 4 * i)); rope64[e] = cosf(ang); rope64[SEQ * 8 + e] = sinf(ang); }
            for (int e = gt; e < SEQ * 16; e += NT_) { const int pos = e >> 4, i = e & 15; const float ang = (float)pos * (*(const float __attribute__((address_space(4)))*)(ka + 208 + 4 * i)); rope128[e] = cosf(ang); rope128[SEQ * 16 + e] = sinf(ang); }
        }
        for (int m = gw; m < TOK; m += NGW) {
            const GAS f32x4* xr = (const GAS f32x4*)(IN_X + (size_t)m * DM) + lane; f32x4 v[4]; float s = 0.f;
#pragma unroll
            for (int j = 0; j < 4; ++j) { v[j] = xr[64 * j]; s += (v[j].x * v[j].x + v[j].y * v[j].y) + (v[j].z * v[j].z + v[j].w * v[j].w); }
            store_row_bf16(Rb + (size_t)m * DM, v, lane); s = wave_sum(s); if (lane == 0) RSS(0)[m] = (unsigned long long)(s * 16777216.0f); }
        } SEAM(0);
    }
    if (IN(1)) { PH_PTRS; for (int rep_ = 0; rep_ < NREP(1); ++rep_) {
        pg8::ABDense ab{Rb, W0qkv, DM}; pg8::TileOrder S; S.init(TOK / 256, NQKV / 256, G, bx);
        pg8::EpiQKV<64> E{QKV, NQKV, rope64, rope64 + SEQ * 8, 0.125f * LOG2E, RSS(0)};
        pg8::gemm_phase<pg8::EpiQKV<64>, pg8::ABDense>(L + RING_OFF, ab, S, E);
        } SEAM(1);
    }
    if (IN(2)) { PH_PTRS; for (int rep_ = 0; rep_ < NREP(2); ++rep_) {
        const moba::DaOrder AS(vcu, G);
        moba::dattn_phase<moba::DaOrder>((char*)lds + RING_OFF, (const moba::bf16*)QKV, (moba::bf16*)OATT, AS);
        } SEAM(2);
    }
    if (IN(3)) { PH_PTRS; for (int rep_ = 0; rep_ < NREP(3); ++rep_) {
        float lam;
        { const float a = wave_sum(da_lq1[lane] * da_lk1[lane]), b = wave_sum(da_lq2[lane] * da_lk2[lane]); lam = expf(a) - expf(b) + LAMBDA_INIT0; }
        const int hh = lane >> 3, dd = (lane & 7) * 16;
        float gsub[16];
#pragma unroll
        for (int k = 0; k < 16; ++k) gsub[k] = da_subln[dd + k] * (1.f - LAMBDA_INIT0);
        for (int m = gw; m < TOK; m += NGW) {
            const bf16* o1 = OATT + (size_t)m * 2048 + (2 * hh) * 128 + dd; const bf16* o2 = o1 + 128;
            const v4u a0 = *(const GAS v4u*)o1, a1 = *(const GAS v4u*)(o1 + 8), b0 = *(const GAS v4u*)o2, b1 = *(const GAS v4u*)(o2 + 8);
            float d[16]; float ss = 0.f;
#pragma unroll
            for (int k = 0; k < 4; ++k) {
                const unsigned ua = a0[k], ub = b0[k], uc = a1[k], ud = b1[k];
                d[2 * k] = __uint_as_float(ua << 16) - lam * __uint_as_float(ub << 16); d[2 * k + 1] = __uint_as_float(ua & 0xffff0000u) - lam * __uint_as_float(ub & 0xffff0000u);
                d[8 + 2 * k] = __uint_as_float(uc << 16) - lam * __uint_as_float(ud << 16); d[8 + 2 * k + 1] = __uint_as_float(uc & 0xffff0000u) - lam * __uint_as_float(ud & 0xffff0000u); }
#pragma unroll
            for (int k = 0; k < 16; ++k) ss += d[k] * d[k];
            ss += __shfl_xor(ss, 1); ss += __shfl_xor(ss, 2); ss += __shfl_xor(ss, 4);
            const float rstd = 1.f / sqrtf(ss * (1.f / 128.f) + SUBLN_EPS);
            v4u w0, w1;
#pragma unroll
            for (int k = 0; k < 4; ++k) { w0[k] = pk2(d[2 * k] * rstd * gsub[2 * k], d[2 * k + 1] * rstd * gsub[2 * k + 1]); w1[k] = pk2(d[8 + 2 * k] * rstd * gsub[8 + 2 * k], d[8 + 2 * k + 1] * rstd * gsub[8 + 2 * k + 1]); }
            bf16* od = OB + (size_t)m * DM + hh * 128 + dd;
            *(GAS v4u*)od = w0; *(GAS v4u*)(od + 8) = w1;
        }
        } SEAM(3);
    }
    if (IN(4)) { PH_PTRS; for (int rep_ = 0; rep_ < NREP(4); ++rep_) {
        pg8::ABDense ab{OB, W0o, DM}; pg8::TileOrder S; S.init(TOK / 256, DM / 256, G, bx);
        pg8::EpiResB E{Rb, Rb, DM, nullptr, RSS(1)};
        pg8::gemm_phase<pg8::EpiResB, pg8::ABDense>(L + RING_OFF, ab, S, E);
        } SEAM(4);
    }
    if (IN(6)) { PH_PTRS; for (int rep_ = 0; rep_ < NREP(6); ++rep_) {
        pg8::ABDense ab{Rb, W013, DM}; pg8::TileOrder S; S.init(TOK / 256, (2 * FF0) / 256, G, bx);
        pg8::EpiSwiGLU E{UD, FF0, nullptr, RSS(1), nullptr};
        pg8::gemm_phase<pg8::EpiSwiGLU, pg8::ABDense>(L + RING_OFF, ab, S, E);
        } SEAM(6);
    }
    if (IN(7)) { PH_PTRS; for (int rep_ = 0; rep_ < NREP(7); ++rep_) {
        pg8::ABDense ab{UD, W02, FF0}; pg8::TileOrder S; S.init(TOK / 256, DM / 256, G, bx);
        pg8::EpiResB E{Rb, Rb, DM, nullptr, RSS(2)};
        pg8::gemm_phase<pg8::EpiResB, pg8::ABDense>(L + RING_OFF, ab, S, E);
        } SEAM(7);
    }
    if (IN(9)) { PH_PTRS; for (int rep_ = 0; rep_ < NREP(9); ++rep_) {
        pg8::ABDense ab{Rb, W1qkv, DM}; pg8::TileOrder S; S.init(TOK / 256, NQKV / 256, G, bx);
        pg8::EpiQKV<128> E{QKV, NQKV, rope128, rope128 + SEQ * 16, 0.08838834764831845f * LOG2E, RSS(2)};
        pg8::gemm_phase<pg8::EpiQKV<128>, pg8::ABDense>(L + RING_OFF, ab, S, E);
        } SEAM(9);
    }
    if (IN(10)) { PH_PTRS; for (int rep_ = 0; rep_ < NREP(10); ++rep_) {
        LAS float* red = (LAS float*)(L + RING_OFF);
        for (int u = vcu; u < BATCH * MB_H * MB_NB; u += G) {
            const int b = u >> 8, h = (u >> 5) & 7, j = u & 31;
            const int dch = tid & 15, kg = tid >> 4;
            const bf16* kp = QKV + (size_t)(b * SEQ + j * MB_L + kg * 8) * NQKV + 1024 + h * 128 + dch * 8;
            float s[8] = {0.f, 0.f, 0.f, 0.f, 0.f, 0.f, 0.f, 0.f};
#pragma unroll
            for (int k = 0; k < 8; ++k) { const v4u v = *(const GAS v4u*)(kp + (size_t)k * NQKV);
#pragma unroll
                for (int q = 0; q < 4; ++q) { s[2 * q] += __uint_as_float(v[q] << 16); s[2 * q + 1] += __uint_as_float(v[q] & 0xffff0000u); } }
#pragma unroll
            for (int q = 0; q < 8; ++q) red[kg * 128 + dch * 8 + q] = s[q];
            __syncthreads();
            if (tid < 128) { float a = 0.f;
#pragma unroll 8
                for (int k = 0; k < 32; ++k) a += red[k * 128 + tid];
                kmean[(size_t)u * 128 + tid] = a * (1.f / 256.f); }
            __syncthreads();
        }
        } SEAM(10);
    }
    if (IN(11)) { PH_PTRS; for (int rep_ = 0; rep_ < NREP(11); ++rep_) {
        LAS float* km = (LAS float*)(L + RING_OFF);
        LAS float* mv = (LAS float*)(L + RING_OFF + 16384);
        LAS int* mi = (LAS int*)(L + RING_OFF + 16384 + 3072);
        LAS int* lcnt = (LAS int*)(L + RING_OFF + 24576);
        for (int u = vcu; u < BATCH * MB_H * (MB_NB - 1); u += G) {
            const int bh = u / 31, o = 1 + u % 31, b = bh >> 3, h = bh & 7;
            for (int e = tid; e < 32 * 128; e += 512) km[e] = kmean[(size_t)bh * 4096 + e];
            if (tid < 32) lcnt[tid] = 0;
            __syncthreads();
            const int ql = tid & 255, half = tid >> 8; const int s = o * 256 + ql;
            const bf16* qp = QKV + (size_t)(b * SEQ + s) * NQKV + h * 128;
            float qf[128];
#pragma unroll
            for (int c = 0; c < 16; ++c) { const v4u v = *(const GAS v4u*)(qp + c * 8);
#pragma unroll
                for (int q = 0; q < 4; ++q) { qf[c * 8 + 2 * q] = __uint_as_float(v[q] << 16); qf[c * 8 + 2 * q + 1] = __uint_as_float(v[q] & 0xffff0000u); } }
            float v0 = -INFINITY, v1 = -INFINITY, v2 = -INFINITY; int i0 = -1, i1 = -1, i2 = -1;
            for (int jj = 0; jj < 16; ++jj) { const int j = half * 16 + jj;
                if (j < o) { float g = 0.f; const LAS f32x4* kr = (const LAS f32x4*)(km + j * 128);
#pragma unroll
                    for (int c = 0; c < 32; ++c) { const f32x4 kv = kr[c]; g += qf[4 * c] * kv.x + qf[4 * c + 1] * kv.y + qf[4 * c + 2] * kv.z + qf[4 * c + 3] * kv.w; }
                    if (g > v0) { v2 = v1; i2 = i1; v1 = v0; i1 = i0; v0 = g; i0 = j; } else if (g > v1) { v2 = v1; i2 = i1; v1 = g; i1 = j; } else if (g > v2) { v2 = g; i2 = j; } } }
            if (half == 1) { mv[ql * 3] = v0; mv[ql * 3 + 1] = v1; mv[ql * 3 + 2] = v2; mi[ql * 3] = i0; mi[ql * 3 + 1] = i1; mi[ql * 3 + 2] = i2; }
            __syncthreads();
            int lp0 = 0, lp1 = 0, lp2 = 0;
            if (half == 0) {
#pragma unroll
                for (int k = 0; k < 3; ++k) { const float g = mv[ql * 3 + k]; const int j = mi[ql * 3 + k];
                    if (j >= 0) { if (g > v0) { v2 = v1; i2 = i1; v1 = v0; i1 = i0; v0 = g; i0 = j; } else if (g > v1) { v2 = v1; i2 = i1; v1 = g; i1 = j; } else if (g > v2) { v2 = g; i2 = j; } } }
                if (i0 >= 0) lp0 = __hip_atomic_fetch_add(&lcnt[i0], 1, __ATOMIC_RELAXED, __HIP_MEMORY_SCOPE_WORKGROUP);
                if (i1 >= 0) lp1 = __hip_atomic_fetch_add(&lcnt[i1], 1, __ATOMIC_RELAXED, __HIP_MEMORY_SCOPE_WORKGROUP);
                if (i2 >= 0) lp2 = __hip_atomic_fetch_add(&lcnt[i2], 1, __ATOMIC_RELAXED, __HIP_MEMORY_SCOPE_WORKGROUP);
            }
            __syncthreads();
            if (tid < 32 && rep_ == 0) { const int n = lcnt[tid]; lcnt[32 + tid] = n ? (int)__hip_atomic_fetch_add(ctl + CW_MOBACNT + bh * 32 + tid, (unsigned)n, RLX_AGENT) : 0; }
            __syncthreads();
            if (half == 0 && rep_ == 0) { int* lb = lists + (size_t)bh * LIST_PER_BH;
                if (i0 >= 0) lb[list_off(i0) + lcnt[32 + i0] + lp0] = s;
                if (i1 >= 0) lb[list_off(i1) + lcnt[32 + i1] + lp1] = s | (1 << 16);
                if (i2 >= 0) lb[list_off(i2) + lcnt[32 + i2] + lp2] = s | (2 << 16); }
            __syncthreads();
        }
        } SEAM(11);
    }
    if (IN(12)) { PH_PTRS; for (int rep_ = 0; rep_ < NREP(12); ++rep_) {
        LAS int* pre = (LAS int*)(L + 102400);
        { const unsigned c0 = __hip_atomic_load(ctl + CW_MOBACNT + tid, RLX_AGENT), c1 = __hip_atomic_load(ctl + CW_MOBACNT + 512 + tid, RLX_AGENT);
          pre[tid] = (int)((c0 + 255u) >> 8); pre[512 + tid] = (int)((c1 + 255u) >> 8); }
        __syncthreads();
        if (tid == 0) { int a = 0; for (int k = 0; k < 1024; ++k) { const int n = pre[k]; pre[k] = a; a += n; } pre[1024] = a; }
        __syncthreads();
        const int nlist = pre[1024], ntot = 1024 + nlist;
        const int wl = wave * 32 + (lane & 31);
        for (int u = vcu; u < ntot; u += G) {
            const bool own = u < 1024;
            int b, h, kb, s, dst, mli, ostride; moba::bf16* obase; float* mlp;
            if (own) {
                b = u >> 8; h = (u >> 5) & 7; kb = u & 31; s = kb * 256 + wl; dst = b * SEQ + s; mli = (b * 8 + h) * SEQ + s; ostride = DM; obase = (moba::bf16*)OB + h * 128; mlp = ownml;
            } else {
                const int lu = u - 1024; int loI = 0, hiI = 1024;
                while (hiI - loI > 1) { const int mid = (loI + hiI) >> 1; if (pre[mid] <= lu) loI = mid; else hiI = mid; }
                const int bhj = loI, chunk = lu - pre[bhj], bh = bhj >> 5; kb = bhj & 31; b = bh >> 3; h = bh & 7;
                const int cnt = (int)__hip_atomic_load(ctl + CW_MOBACNT + bhj, RLX_AGENT);
                const int ei = chunk * 256 + wl; const bool valid = ei < cnt;
                const int ent = valid ? lists[(size_t)bh * LIST_PER_BH + list_off(kb) + ei] : 0;
                s = ent & 0xffff; mli = (bh * SEQ + s) * 3 + (ent >> 16); dst = valid ? mli : -1; ostride = 128; obase = (moba::bf16*)PO; mlp = pml;
            }
            const moba::bf16* qrow = (const moba::bf16*)QKV + ((size_t)b * SEQ + s) * NQKV + h * 128;
            const moba::bf16* Kh = (const moba::bf16*)QKV + ((size_t)b * SEQ + kb * 256) * NQKV + 1024 + h * 128;
            moba::moba_unit(own, qrow, Kh, Kh + 1024, obase, ostride, dst, mlp, mli, wl, (char*)lds);
        }
        } SEAM(12);
    }
    if (IN(13)) { PH_PTRS; for (int rep_ = 0; rep_ < NREP(13); ++rep_) {
        const int hh = lane >> 3, dd = (lane & 7) * 16;
        for (int m = gw; m < TOK; m += NGW) {
            const int b = m >> 13, s = m & 8191, nv = (s >> 8) < 3 ? (s >> 8) : 3; const int qi = (b * 8 + hh) * SEQ + s;
            float mm[4], ll[4]; mm[0] = ownml[2 * (size_t)qi]; ll[0] = ownml[2 * (size_t)qi + 1]; float M = mm[0];
#pragma unroll
            for (int r = 0; r < 3; ++r) { if (r < nv) { mm[1 + r] = pml[2 * ((size_t)qi * 3 + r)]; ll[1 + r] = pml[2 * ((size_t)qi * 3 + r) + 1]; M = fmaxf(M, mm[1 + r]); } else { mm[1 + r] = -1e30f; ll[1 + r] = 0.f; } }
            float w[4], wsum = 0.f;
#pragma unroll
            for (int r = 0; r < 4; ++r) { w[r] = ll[r] * __builtin_amdgcn_exp2f(mm[r] - M); wsum += w[r]; }
            const float inv = 1.f / wsum;
            float acc16[16];
            bf16* op = OB + (size_t)m * DM + hh * 128 + dd;
            { const v4u a0 = *(const GAS v4u*)op, a1 = *(const GAS v4u*)(op + 8); const float ww = w[0] * inv;
#pragma unroll
              for (int k = 0; k < 4; ++k) { acc16[2 * k] = ww * __uint_as_float(a0[k] << 16); acc16[2 * k + 1] = ww * __uint_as_float(a0[k] & 0xffff0000u); acc16[8 + 2 * k] = ww * __uint_as_float(a1[k] << 16); acc16[8 + 2 * k + 1] = ww * __uint_as_float(a1[k] & 0xffff0000u); } }
#pragma unroll
            for (int r = 0; r < 3; ++r) if (r < nv) { const bf16* pp = PO + ((size_t)qi * 3 + r) * 128 + dd; const v4u a0 = *(const GAS v4u*)pp, a1 = *(const GAS v4u*)(pp + 8); const float ww = w[1 + r] * inv;
#pragma unroll
                for (int k = 0; k < 4; ++k) { acc16[2 * k] += ww * __uint_as_float(a0[k] << 16); acc16[2 * k + 1] += ww * __uint_as_float(a0[k] & 0xffff0000u); acc16[8 + 2 * k] += ww * __uint_as_float(a1[k] << 16); acc16[8 + 2 * k + 1] += ww * __uint_as_float(a1[k] & 0xffff0000u); } }
            v4u w0, w1;
#pragma unroll
            for (int k = 0; k < 4; ++k) { w0[k] = pk2(acc16[2 * k], acc16[2 * k + 1]); w1[k] = pk2(acc16[8 + 2 * k], acc16[8 + 2 * k + 1]); }
            *(GAS v4u*)op = w0; *(GAS v4u*)(op + 8) = w1;
        }
        } SEAM(13);
    }
    if (IN(14)) { PH_PTRS; for (int rep_ = 0; rep_ < NREP(14); ++rep_) {
        pg8::ABDense ab{OB, W1o, DM}; pg8::TileOrder S; S.init(TOK / 256, DM / 256, G, bx);
        pg8::EpiResB E{Rb, Rb, DM, nullptr, RSS(3)};
        pg8::gemm_phase<pg8::EpiResB, pg8::ABDense>(L + RING_OFF, ab, S, E);
        } SEAM(14);
    }
    if (IN(15)) { PH_PTRS; for (int rep_ = 0; rep_ < NREP(15); ++rep_) {
        {
            const int gt = (vcu * NWAVES + wave) * 64 + lane, NT_ = G * NWAVES * 64;
            for (int e = gt; e < 2 * SLOTS; e += NT_) { slot_tok[e] = -1; slot_gate[e] = 0.f; }
        }
        if (rep_ == 0) {
            f32x4 gv[4]; load_gain(norm_ffn + DM, gv, lane);
            float wr_[16][8];
#pragma unroll
            for (int j = 0; j < 4; ++j)
#pragma unroll
                for (int q = 0; q < 4; ++q) { const int k = 4 * lane + 256 * j + q; const f32x4 a = *(const GAS f32x4*)(moe_router + (size_t)k * 8) * gv[j][q], c = *(const GAS f32x4*)(moe_router + (size_t)k * 8 + 4) * gv[j][q];
                    wr_[4 * j + q][0] = a.x; wr_[4 * j + q][1] = a.y; wr_[4 * j + q][2] = a.z; wr_[4 * j + q][3] = a.w; wr_[4 * j + q][4] = c.x; wr_[4 * j + q][5] = c.y; wr_[4 * j + q][6] = c.z; wr_[4 * j + q][7] = c.w; }
            for (int m = gw; m < TOK; m += NGW) {
                f32x4 v[4];
                { const GAS unsigned long long* r8 = (const GAS unsigned long long*)(Rb + (size_t)m * DM) + lane;
#pragma unroll
                  for (int j = 0; j < 4; ++j) { const unsigned long long w = r8[64 * j]; const unsigned lo32 = (unsigned)w, hi32 = (unsigned)(w >> 32);
                      v[j].x = __uint_as_float(lo32 << 16); v[j].y = __uint_as_float(lo32 & 0xffff0000u); v[j].z = __uint_as_float(hi32 << 16); v[j].w = __uint_as_float(hi32 & 0xffff0000u); } }
                float lg[8];
#pragma unroll
                for (int e = 0; e < 8; ++e) { float a = 0.f;
#pragma unroll
                    for (int j = 0; j < 4; ++j) a += v[j].x * wr_[4 * j][e] + v[j].y * wr_[4 * j + 1][e] + v[j].z * wr_[4 * j + 2][e] + v[j].w * wr_[4 * j + 3][e];
                    lg[e] = wave_sum(a); }
                { const float rs = 1.f / sqrtf((float)RSS(3)[m] * (5.9604644775390625e-8f / DM) + NORM_EPS);
#pragma unroll
                  for (int e = 0; e < 8; ++e) lg[e] *= rs; }
                int e0 = 0; float l0 = lg[0];
#pragma unroll
                for (int e = 1; e < 8; ++e) if (lg[e] > l0) { l0 = lg[e]; e0 = e; }
                int e1 = -1; float l1 = -INFINITY;
#pragma unroll
                for (int e = 0; e < 8; ++e) if (e != e0 && lg[e] > l1) { l1 = lg[e]; e1 = e; }
                if (lane == 0) {
                    const float g0 = 1.f / (1.f + expf(l1 - l0)), g1 = 1.f - g0;
                    const int p0 = (int)__hip_atomic_fetch_add((LAS unsigned*)(L + MISC_OFF) + 40 + e0, 1u, __ATOMIC_RELAXED, __HIP_MEMORY_SCOPE_WORKGROUP), p1 = (int)__hip_atomic_fetch_add((LAS unsigned*)(L + MISC_OFF) + 48 + e1, 1u, __ATOMIC_RELAXED, __HIP_MEMORY_SCOPE_WORKGROUP);
                    tok_e[m] = e0; tok_e[TOK + m] = e1; tok_pos[m] = p0; tok_pos[TOK + m] = p1; tok_gate[m] = g0; tok_gate[TOK + m] = g1;
                }
            }
            LDS_WAIT(); __syncthreads();
            if (tid < 16) { const unsigned n = MISC[40 + tid]; wg_base[vcu * 16 + tid] = n ? (int)__hip_atomic_fetch_add(ctl + CW_MOECNT + tid, n, RLX_AGENT) : 0; }
        }
        {
            LAS float* scr = (LAS float*)(L + RING_OFF + wave * 16384);
            constexpr int I_1 = (DM / 64) * (FF1 / 32), I_2 = (FF1 / 64) * (DM / 32), PER_E = 2 * I_1 + I_2;
            for (int it = gw; it < NEXP * PER_E; it += NGW) {
                const int e = it / PER_E; int r = it % PER_E;
                if (r < I_1) { transpose_item<3>(moe_w1 + (size_t)e * DM * FF1, DM, FF1, WM13 + (size_t)e * 2 * FF1 * DM, scr, r, lane, norm_ffn + DM); continue; } r -= I_1;
                if (r < I_1) { transpose_item<4>(moe_w3 + (size_t)e * DM * FF1, DM, FF1, WM13 + (size_t)e * 2 * FF1 * DM, scr, r, lane, norm_ffn + DM); continue; } r -= I_1;
                transpose_item<0>(moe_w2 + (size_t)e * FF1 * DM, FF1, DM, WM2 + (size_t)e * DM * FF1, scr, r, lane);
            }
        }
        } SEAM(15);
    }
#define MOE_CUM() do { if (tid < 2) { int a = 0; for (int e = 0; e < 8; ++e) { MISC[16 + 9 * tid + e] = (unsigned)a; a += (int)((__hip_atomic_load(ctl + CW_MOECNT + 8 * tid + e, RLX_AGENT) + 255u) >> 8); } MISC[16 + 9 * tid + 8] = (unsigned)a; } __syncthreads(); } while (0)
    if (IN(16)) { PH_PTRS; for (int rep_ = 0; rep_ < NREP(16); ++rep_) {
        MOE_CUM();
        const int gt = (vcu * NWAVES + wave) * 64 + lane, NT_ = G * NWAVES * 64;
        for (int e = gt; e < 2 * TOK; e += NT_) { const int r = e >= TOK ? 1 : 0; const int ex = tok_e[e]; const int t_ = e - r * TOK; const int slot = (int)MISC[16 + 9 * r + ex] * 256 + wg_base[((t_ % NGW) >> 3) * 16 + r * 8 + ex] + tok_pos[e];
            slot_tok[r * SLOTS + slot] = e - r * TOK; slot_gate[r * SLOTS + slot] = tok_gate[e]; }
        } SEAM(16);
    }
#define MOE_UP(r) do { MOE_CUM(); \
        pg8::ABMoeUp ab{Rb, WM13, DM, slot_tok + (r) * SLOTS, (const LAS int*)(L + MISC_OFF + 4 * (16 + 9 * (r))), (size_t)2 * FF1 * DM}; \
        pg8::TileOrder S; S.init((int)MISC[16 + 9 * (r) + 8], (2 * FF1) / 256, G, bx); \
        pg8::EpiSwiGLU E{UM, FF1, slot_gate + (r) * SLOTS, RSS(3), slot_tok + (r) * SLOTS}; \
        pg8::gemm_phase<pg8::EpiSwiGLU, pg8::ABMoeUp>(L + RING_OFF, ab, S, E); } while (0)
#define MOE_DOWN(r) do { MOE_CUM(); \
        pg8::ABMoeDown ab{UM, WM2, FF1, (const LAS int*)(L + MISC_OFF + 4 * (16 + 9 * (r))), (size_t)DM * FF1}; \
        pg8::TileOrder S; S.init((int)MISC[16 + 9 * (r) + 8], DM / 256, G, bx); \
        pg8::EpiResB E{(r) == 0 ? Rb : OB, (r) == 0 ? OB : Rb, DM, slot_tok + (r) * SLOTS, nullptr};     \
        pg8::gemm_phase<pg8::EpiResB, pg8::ABMoeDown>(L + RING_OFF, ab, S, E); } while (0)
    if (IN(17)) { PH_PTRS; for (int rep_ = 0; rep_ < NREP(17); ++rep_) MOE_UP(0); SEAM(17); }
    if (IN(18)) { PH_PTRS; MOE_DOWN(0); SEAM(18); }
    if (IN(19)) { PH_PTRS; for (int rep_ = 0; rep_ < NREP(19); ++rep_) MOE_UP(1); SEAM(19); }
    if (IN(20)) { PH_PTRS; MOE_DOWN(1); SEAM(20); }
    if (IN(21)) { PH_PTRS;
        f32x4 gv[4]; load_gain(final_norm, gv, lane);
        for (int m = gw; m < TOK; m += NGW) {
            f32x4 v[4]; float s = 0.f;
            const GAS unsigned long long* r8 = (const GAS unsigned long long*)(Rb + (size_t)m * DM) + lane;
#pragma unroll
            for (int j = 0; j < 4; ++j) { const unsigned long long w = r8[64 * j]; const unsigned lo32 = (unsigned)w, hi32 = (unsigned)(w >> 32);
                v[j].x = __uint_as_float(lo32 << 16); v[j].y = __uint_as_float(lo32 & 0xffff0000u); v[j].z = __uint_as_float(hi32 << 16); v[j].w = __uint_as_float(hi32 & 0xffff0000u);
                s += (v[j].x * v[j].x + v[j].y * v[j].y) + (v[j].z * v[j].z + v[j].w * v[j].w); }
            const float rstd = 1.f / sqrtf(wave_sum(s) * (1.f / DM) + NORM_EPS);
            GAS f32x4* o = (GAS f32x4*)(out + (size_t)m * DM) + lane;
#pragma unroll
            for (int j = 0; j < 4; ++j) o[64 * j] = v[j] * rstd * gv[j]; }
    }
#undef IN
#undef SEAM
#undef GRID_BAR
}
constexpr int N_PHASES = 22;

extern "C" void kernel_launch(void* const* d_in, const int* in_sizes, int n_in, void* d_out, int out_size, void* d_ws, size_t ws_size, hipStream_t stream) {
    static int grid = 0;
    if (grid == 0) {
        if (n_in != 20 || in_sizes[0] != TOK * DM || out_size != TOK * DM || ws_size < WS_END) { fprintf(stderr, "kernel_launch: shape / workspace mismatch (n_in %d, in0 %d, out %d, ws %zu, need %zu); nothing launched\n", n_in, n_in > 0 ? in_sizes[0] : -1, out_size, ws_size, (size_t)WS_END); grid = -1; return; }
        int dev = 0, cus = 0, per_cu = 0;
        if (hipGetDevice(&dev) != hipSuccess || hipDeviceGetAttribute(&cus, hipDeviceAttributeMultiprocessorCount, dev) != hipSuccess) { grid = -1; return; }
        if (hipFuncSetAttribute((const void*)mk_fwd, hipFuncAttributeMaxDynamicSharedMemorySize, LDS_BYTES) != hipSuccess) { fprintf(stderr, "kernel_launch: hipFuncSetAttribute failed\n"); grid = -1; return; }
        if (hipOccupancyMaxActiveBlocksPerMultiprocessor(&per_cu, (const void*)mk_fwd, NWAVES * 64, LDS_BYTES) != hipSuccess || per_cu < 1) fprintf(stderr, "kernel_launch: occupancy query reports %d workgroups per CU\n", per_cu);
        (void)hipGetLastError();
        grid = cus;
    }
    if (grid < 0) return;
    if (hipMemsetAsync((char*)d_ws + WS_CTL, 0, CTL_ZERO_BYTES, stream) != hipSuccess) return;
    Args a{};
    for (int i = 0; i < 20; ++i) a.in[i] = (const float*)d_in[i];
    a.out = (float*)d_out; a.ws = (unsigned char*)d_ws;
    for (int i = 0; i < 8; ++i) a.inv64[i] = (float)pow(500000.0, -(double)(2 * i) / 16.0);
    for (int i = 0; i < 16; ++i) a.inv128[i] = (float)pow(500000.0, -(double)(2 * i) / 32.0);
#if MK_PER_PHASE
    for (int p = 0; p < N_PHASES; ++p) { a.ph_lo = p; a.ph_hi = p + 1; hipLaunchKernelGGL(mk_fwd, dim3(grid), dim3(NWAVES * 64), LDS_BYTES, stream, a); }
#else
    a.ph_lo = 0; a.ph_hi = N_PHASES;
    hipLaunchKernelGGL(mk_fwd, dim3(grid), dim3(NWAVES * 64), LDS_BYTES, stream, a);
#ifdef PROBE_LIST
    {
        static const int probe[] = {PROBE_LIST};
        for (int k : probe) { a.ph_lo = k; a.ph_hi = k + 1;
            a.out = (k == 3 || k == 12 || k == 13 || k == 18 || k == 21) ? (float*)((char*)d_ws + WS_QKV) : (float*)d_out;
            hipLaunchKernelGGL(mk_fwd, dim3(grid), dim3(NWAVES * 64), LDS_BYTES, stream, a); }
    }
#endif
#endif
    const hipError_t le = hipPeekAtLastError();
    if (le != hipSuccess) fprintf(stderr, "kernel_launch: launch failed: %s\n", hipGetErrorName(le));
}
```

```cpp
#include <hip/hip_runtime.h>
#include <hip/hip_bf16.h>
#include <cstdio>
#include <cstdint>
#include <cmath>
namespace pg8 {
#define PG8_LAS __attribute__((address_space(3)))
typedef unsigned short bf16_t;
typedef short bf16x8 __attribute__((ext_vector_type(8)));
typedef float f32x4 __attribute__((ext_vector_type(4)));
typedef unsigned u32x4 __attribute__((ext_vector_type(4)));
constexpr int BM = 256, BK = 64, HALF = 128, HTB = HALF * BK * 2  , STAGE_BYTES = 8 * HTB, NXCD = 8, WGM = 8;

__host__ __device__ __forceinline__ int lds_byte(int r, int c) { const int st = (r >> 4) * 2 + (c >> 5), rr = r & 15, cc = c & 31, ob = rr * 64 + cc * 2; return st * 1024 + (ob ^ (((ob >> 9) & 1) << 5)); }
__host__ __device__ __forceinline__ void stage_rc(int b, int& R, int& C) { const int st = b / 1024, sb = b % 1024, swz = sb ^ (((sb >> 9) & 1) << 5); R = (st >> 1) * 16 + swz / 64; C = (st & 1) * 32 + (swz % 64) / 2; }
__host__ __device__ __forceinline__ int perm32(int rho) { const int n = rho >> 4, i = rho & 15; return 8 * (i >> 2) + 4 * n + (i & 3); }

struct Unit { int pm, pn; };

struct TileOrder {
    int nM, nN, nwg, G, c;
    __device__ __forceinline__ void init(int nM_, int nN_, int G_, int c_) { nM = nM_; nN = nN_; nwg = nM * nN; G = G_; c = c_; }
    __device__ __forceinline__ bool next(int i, Unit& u) const {
        const long L = (long)i * G + c; if (L >= nwg) return false;
        int wgid = (int)L; { const int q = nwg / NXCD, r = nwg % NXCD, xcd = wgid % NXCD, off = wgid / NXCD; wgid = (xcd < r ? xcd * (q + 1) : r * (q + 1) + (xcd - r) * q) + off; }
        const int nig = WGM * nN, gid = wgid / nig, fm = gid * WGM, gsz = (nM - fm) < WGM ? (nM - fm) : WGM;
        u.pm = fm + ((wgid % nig) % gsz); u.pn = (wgid % nig) / gsz; return true;
    }
};

struct ABDense {
    static constexpr bool GATHER = false;
    const bf16_t* A; const bf16_t* Bt; int K;
    __device__ __forceinline__ const char* abase(const Unit& u) const { return (const char*)A + (size_t)u.pm * BM * K * 2; }
    __device__ __forceinline__ const char* bbase(const Unit& u) const { return (const char*)Bt + (size_t)u.pn * BM * K * 2; }
    __device__ __forceinline__ const int* tokp(const Unit&) const { return nullptr; }
};
struct ABMoeUp {
    static constexpr bool GATHER = true;
    const bf16_t* A; const bf16_t* Bt; int K; const int* slot_tok; const PG8_LAS int* cum; size_t estride;
    __device__ __forceinline__ int expert(int pm) const { int e = 0;
#pragma unroll
        for (int k = 1; k < 8; ++k) e += (pm >= cum[k]) ? 1 : 0; return e; }
    __device__ __forceinline__ const char* abase(const Unit&) const { return (const char*)A; }
    __device__ __forceinline__ const char* bbase(const Unit& u) const { return (const char*)(Bt + (size_t)expert(u.pm) * estride) + (size_t)u.pn * BM * K * 2; }
    __device__ __forceinline__ const int* tokp(const Unit& u) const { return slot_tok + u.pm * BM; }
};
struct ABMoeDown {
    static constexpr bool GATHER = false;
    const bf16_t* A; const bf16_t* Bt; int K; const PG8_LAS int* cum; size_t estride;
    __device__ __forceinline__ int expert(int pm) const { int e = 0;
#pragma unroll
        for (int k = 1; k < 8; ++k) e += (pm >= cum[k]) ? 1 : 0; return e; }
    __device__ __forceinline__ const char* abase(const Unit& u) const { return (const char*)A + (size_t)u.pm * BM * K * 2; }
    __device__ __forceinline__ const char* bbase(const Unit& u) const { return (const char*)(Bt + (size_t)expert(u.pm) * estride) + (size_t)u.pn * BM * K * 2; }
    __device__ __forceinline__ const int* tokp(const Unit&) const { return nullptr; }
};

__device__ __forceinline__ unsigned cvt_pk_bf16(float lo, float hi) { unsigned r; asm volatile("v_cvt_pk_bf16_f32 %0, %1, %2" : "=v"(r) : "v"(lo), "v"(hi)); return r; }

template <int DH> struct EpiQKV {
    static constexpr bool PERM = true; typedef f32x4 acc_t;
    bf16_t* O; int ldc; const float* ct; const float* st; float qscale; const unsigned long long* rss;
    __device__ __forceinline__ void operator()(const f32x4 (&acc)[2][2][4][2], const Unit& u, int wr, int wc, int fr, int fq) const {
        constexpr int NF = DH / 8;
        const int row0 = u.pm * BM + wr * 64 + fr, col0 = u.pn * BM + wc * 32 + 8 * fq;
        const int sect = u.pn >> 2;
        const float sc = (sect == 0) ? qscale : 1.f;
        const bool rot = (sect < 2) && (DH == 64 ? (((wc & 1) == 0) && (fq < 2)) : (wc == 0));
#pragma unroll
        for (int ai = 0; ai < 2; ++ai)
#pragma unroll
            for (int m = 0; m < 4; ++m) {
                const int row = row0 + ai * HALF + m * 16; const int pos = row & 8191; const float rs = sc * __builtin_amdgcn_rsqf((float)rss[row] * (5.9604644775390625e-8f / 1024.0f) + 1e-6f);
                f32x4 c4 = (f32x4){1.f, 1.f, 1.f, 1.f}, s4 = (f32x4){0.f, 0.f, 0.f, 0.f};
                if (rot) { c4 = *(const f32x4*)(ct + pos * NF + 4 * fq); s4 = *(const f32x4*)(st + pos * NF + 4 * fq); }
                bf16_t* rowp = O + (size_t)row * ldc + col0;
#pragma unroll
                for (int bj = 0; bj < 2; ++bj) {
                    const f32x4 x1 = acc[ai][bj][m][0], x2 = acc[ai][bj][m][1];
                    f32x4 v0 = (x1 * c4 - x2 * s4) * rs, v1 = (x2 * c4 + x1 * s4) * rs;
                    u32x4 w; w.x = cvt_pk_bf16(v0[0], v0[1]); w.y = cvt_pk_bf16(v0[2], v0[3]); w.z = cvt_pk_bf16(v1[0], v1[1]); w.w = cvt_pk_bf16(v1[2], v1[3]);
                    *(u32x4*)(rowp + bj * HALF) = w; }
            }
    }
};

__device__ __forceinline__ float silu_mul(float a, float b) { return a * b * __builtin_amdgcn_rcpf(1.0f + __builtin_amdgcn_exp2f(-1.4426950408889634f * a)); }
struct EpiSwiGLU {
    static constexpr bool PERM = true; typedef f32x4 acc_t;
    bf16_t* O; int ldc; const float* gate; const unsigned long long* rss; const int* rowmap;
    __device__ __forceinline__ void operator()(const f32x4 (&acc)[2][2][4][2], const Unit& u, int wr, int wc, int fr, int fq) const {
        const int row0 = u.pm * BM + wr * 64 + fr, col0 = u.pn * HALF + wc * 32 + 8 * fq;
#pragma unroll
        for (int ai = 0; ai < 2; ++ai)
#pragma unroll
            for (int m = 0; m < 4; ++m) {
                const int row = row0 + ai * HALF + m * 16; const float g = gate ? gate[row] : 1.f; const int trow = rowmap ? rowmap[row] : row;
                const float rs = trow >= 0 ? __builtin_amdgcn_rsqf((float)rss[trow] * (5.9604644775390625e-8f / 1024.0f) + 1e-6f) : 0.f;
                const f32x4 a0 = acc[ai][0][m][0] * rs, a1 = acc[ai][0][m][1] * rs, b0 = acc[ai][1][m][0] * rs, b1 = acc[ai][1][m][1] * rs;
                float v[8];
#pragma unroll
                for (int k = 0; k < 4; ++k) { v[k] = g * silu_mul(a0[k], b0[k]); v[4 + k] = g * silu_mul(a1[k], b1[k]); }
                u32x4 w; w.x = cvt_pk_bf16(v[0], v[1]); w.y = cvt_pk_bf16(v[2], v[3]); w.z = cvt_pk_bf16(v[4], v[5]); w.w = cvt_pk_bf16(v[6], v[7]);
                *(u32x4*)(O + (size_t)row * ldc + col0) = w; }
    }
};
struct EpiResB {
    static constexpr bool PERM = true; typedef f32x4 acc_t;
    const bf16_t* Rin; bf16_t* Rout; int ldc; const int* rowmap; unsigned long long* rss_out;
    __device__ __forceinline__ void operator()(const f32x4 (&acc)[2][2][4][2], const Unit& u, int wr, int wc, int fr, int fq) const {
        const int row0 = u.pm * BM + wr * 64 + fr, col0 = u.pn * BM + wc * 32 + 8 * fq;
#pragma unroll
        for (int ai = 0; ai < 2; ++ai)
#pragma unroll
            for (int m = 0; m < 4; ++m) {
                const int row = row0 + ai * HALF + m * 16; const int orow = rowmap ? rowmap[row] : row; float ss = 0.f;
                if (orow >= 0) { const bf16_t* rp = Rin + (size_t)orow * ldc + col0; bf16_t* wp = Rout + (size_t)orow * ldc + col0;
#pragma unroll
                    for (int bj = 0; bj < 2; ++bj) { const u32x4 w = *(const u32x4*)(rp + bj * HALF); const f32x4 a0 = acc[ai][bj][m][0], a1 = acc[ai][bj][m][1];
                        float v[8];
                        v[0] = __uint_as_float(w.x << 16) + a0[0]; v[1] = __uint_as_float(w.x & 0xffff0000u) + a0[1]; v[2] = __uint_as_float(w.y << 16) + a0[2]; v[3] = __uint_as_float(w.y & 0xffff0000u) + a0[3];
                        v[4] = __uint_as_float(w.z << 16) + a1[0]; v[5] = __uint_as_float(w.z & 0xffff0000u) + a1[1]; v[6] = __uint_as_float(w.w << 16) + a1[2]; v[7] = __uint_as_float(w.w & 0xffff0000u) + a1[3];
#pragma unroll
                        for (int k = 0; k < 8; ++k) ss += v[k] * v[k];
                        u32x4 o; o.x = cvt_pk_bf16(v[0], v[1]); o.y = cvt_pk_bf16(v[2], v[3]); o.z = cvt_pk_bf16(v[4], v[5]); o.w = cvt_pk_bf16(v[6], v[7]);
                        *(u32x4*)(wp + bj * HALF) = o; } }
                if (rss_out) { ss += __shfl_xor(ss, 16); ss += __shfl_xor(ss, 32);
                    if (fq == 0) __hip_atomic_fetch_add(rss_out + orow, (unsigned long long)(ss * 16777216.0f), __ATOMIC_RELAXED, __HIP_MEMORY_SCOPE_AGENT); }
                if (m & 1) asm volatile("" ::: "memory"); }
    }
};

typedef int i32x4_e __attribute__((ext_vector_type(4)));
struct EpiSwiGLUQ {
    static constexpr bool PERM = true; typedef i32x4_e acc_t;
    signed char* O; int ldc; const float* sa; const unsigned* cm; const int* rowmap; const PG8_LAS int* cum; float qmul;
    __device__ __forceinline__ void operator()(const i32x4_e (&acc)[2][2][4][2], const Unit& u, int wr, int wc, int fr, int fq) const {
        int e = 0;
#pragma unroll
        for (int k = 1; k < 8; ++k) e += (u.pm >= cum[k]) ? 1 : 0;
        const unsigned* cme = cm + (size_t)e * 7168 + u.pn * BM + wc * 32 + 8 * fq;
        float sbA[8], sbB[8];
#pragma unroll
        for (int k = 0; k < 8; ++k) { sbA[k] = __uint_as_float(cme[k]) * (1.0f / 127.0f); sbB[k] = __uint_as_float(cme[HALF + k]) * (1.0f / 127.0f); }
        const int row0 = u.pm * BM + wr * 64 + fr, col0 = u.pn * HALF + wc * 32 + 8 * fq;
#pragma unroll
        for (int ai = 0; ai < 2; ++ai)
#pragma unroll
            for (int m = 0; m < 4; ++m) {
                const int row = row0 + ai * HALF + m * 16; const int trow = rowmap[row]; const float s = trow >= 0 ? sa[trow] : 0.f;
                const i32x4_e a0 = acc[ai][0][m][0], a1 = acc[ai][0][m][1], b0 = acc[ai][1][m][0], b1 = acc[ai][1][m][1];
                int q[8];
#pragma unroll
                for (int k = 0; k < 4; ++k) {
                    const float va = (float)a0[k] * s * sbA[k], vb = (float)b0[k] * s * sbB[k], vc = (float)a1[k] * s * sbA[4 + k], vd = (float)b1[k] * s * sbB[4 + k];
                    float u0 = silu_mul(va, vb) * qmul, u1 = silu_mul(vc, vd) * qmul;
                    u0 = fminf(fmaxf(u0, -127.f), 127.f); u1 = fminf(fmaxf(u1, -127.f), 127.f);
                    q[k] = (int)__builtin_rintf(u0); q[4 + k] = (int)__builtin_rintf(u1); }
                unsigned lo = (unsigned)(q[0] & 255) | ((unsigned)(q[1] & 255) << 8) | ((unsigned)(q[2] & 255) << 16) | ((unsigned)(q[3] & 255) << 24);
                unsigned hi = (unsigned)(q[4] & 255) | ((unsigned)(q[5] & 255) << 8) | ((unsigned)(q[6] & 255) << 16) | ((unsigned)(q[7] & 255) << 24);
                *(unsigned long long*)(O + (size_t)row * ldc + col0) = (unsigned long long)lo | ((unsigned long long)hi << 32); }
    }
};
struct EpiResBQ {
    static constexpr bool PERM = true; typedef i32x4_e acc_t;
    const bf16_t* Rin; bf16_t* Rout; int ldc; const int* rowmap; const float* gate; const unsigned* cm; const PG8_LAS int* cum; float dq;
    __device__ __forceinline__ void operator()(const i32x4_e (&acc)[2][2][4][2], const Unit& u, int wr, int wc, int fr, int fq) const {
        int e = 0;
#pragma unroll
        for (int k = 1; k < 8; ++k) e += (u.pm >= cum[k]) ? 1 : 0;
        const int row0 = u.pm * BM + wr * 64 + fr, col0 = u.pn * BM + wc * 32 + 8 * fq;
        const unsigned* cme = cm + (size_t)e * 1024 + col0;
        float sb[2][8];
#pragma unroll
        for (int bj = 0; bj < 2; ++bj)
#pragma unroll
            for (int k = 0; k < 8; ++k) sb[bj][k] = __uint_as_float(cme[bj * HALF + k]) * (dq / 127.0f);
#pragma unroll
        for (int ai = 0; ai < 2; ++ai)
#pragma unroll
            for (int m = 0; m < 4; ++m) {
                const int row = row0 + ai * HALF + m * 16; const int orow = rowmap[row];
                if (orow >= 0) { const float gt = gate[row]; const bf16_t* rp = Rin + (size_t)orow * ldc + col0; bf16_t* wp = Rout + (size_t)orow * ldc + col0;
#pragma unroll
                    for (int bj = 0; bj < 2; ++bj) { const u32x4 w = *(const u32x4*)(rp + bj * HALF); const i32x4_e a0 = acc[ai][bj][m][0], a1 = acc[ai][bj][m][1];
                        float v[8];
                        v[0] = __uint_as_float(w.x << 16) + (float)a0[0] * gt * sb[bj][0]; v[1] = __uint_as_float(w.x & 0xffff0000u) + (float)a0[1] * gt * sb[bj][1];
                        v[2] = __uint_as_float(w.y << 16) + (float)a0[2] * gt * sb[bj][2]; v[3] = __uint_as_float(w.y & 0xffff0000u) + (float)a0[3] * gt * sb[bj][3];
                        v[4] = __uint_as_float(w.z << 16) + (float)a1[0] * gt * sb[bj][4]; v[5] = __uint_as_float(w.z & 0xffff0000u) + (float)a1[1] * gt * sb[bj][5];
                        v[6] = __uint_as_float(w.w << 16) + (float)a1[2] * gt * sb[bj][6]; v[7] = __uint_as_float(w.w & 0xffff0000u) + (float)a1[3] * gt * sb[bj][7];
                        u32x4 o; o.x = cvt_pk_bf16(v[0], v[1]); o.y = cvt_pk_bf16(v[2], v[3]); o.z = cvt_pk_bf16(v[4], v[5]); o.w = cvt_pk_bf16(v[6], v[7]);
                        *(u32x4*)(wp + bj * HALF) = o; } }
                if (m & 1) asm volatile("" ::: "memory"); }
    }
};
typedef int i32x4 __attribute__((ext_vector_type(4)));
__device__ __forceinline__ f32x4 mma16(bf16x8 a, bf16x8 b, f32x4 c) { return __builtin_amdgcn_mfma_f32_16x16x32_bf16(a, b, c, 0, 0, 0); }
__device__ __forceinline__ i32x4 mma16(bf16x8 a, bf16x8 b, i32x4 c) { return __builtin_amdgcn_mfma_i32_16x16x64_i8(__builtin_bit_cast(i32x4, a), __builtin_bit_cast(i32x4, b), c, 0, 0, 0); }
template <class Epi, class AB>
__device__ __forceinline__ void gemm_phase(PG8_LAS unsigned char* lds, const AB ab, const TileOrder& S, const Epi& E) {
    const int tid = threadIdx.x, wid = __builtin_amdgcn_readfirstlane(tid >> 6), lane = tid & 63, wr = wid >> 2, wc = wid & 3, fr = lane & 15, fq = lane >> 4;
    const int K = ab.K, nt = K / BK;
    int Rr[2], Cc[2]; unsigned voffB[2];
#pragma unroll
    for (int i = 0; i < 2; ++i) { int R, C; stage_rc(tid * 16 + i * 8192, R, C); const int Rb = Epi::PERM ? ((R & ~31) + perm32(R & 31)) : R;
        Rr[i] = R; Cc[i] = C; voffB[i] = (unsigned)(Rb * K + C) * 2u; }
    const size_t kstep = (size_t)(BK * 2);
    const size_t hstep = (size_t)HALF * K * 2;
    const unsigned ldsw = (unsigned)wid * 1024u;
    const int aoff = lds_byte(wr * 64 + fr, fq * 8), boff = lds_byte(wc * 32 + fr, fq * 8);
#define PG8_SA(b, h) (((b) * 2 + (h)) * HTB)
#define PG8_SB(b, h) ((4 + (b) * 2 + (h)) * HTB)
#define PG8_STAGE(bufoff, gbase, voff) do { _Pragma("unroll") for (int _i = 0; _i < 2; ++_i) \
        __builtin_amdgcn_global_load_lds((const unsigned*)((const char*)(gbase) + (voff)[_i]), (PG8_LAS unsigned*)(lds + (bufoff) + ldsw + _i * 8192), 16, 0, 0); } while (0)
#define PG8_LDA(dst, b, h) do { _Pragma("unroll") for (int m = 0; m < 4; ++m) _Pragma("unroll") for (int k = 0; k < 2; ++k) dst[m][k] = *(const PG8_LAS bf16x8*)(lds + PG8_SA(b, h) + aoff + m * 2048 + k * 1024); } while (0)
#define PG8_LDB(dst, b, h) do { _Pragma("unroll") for (int n = 0; n < 2; ++n) _Pragma("unroll") for (int k = 0; k < 2; ++k) dst[n][k] = *(const PG8_LAS bf16x8*)(lds + PG8_SB(b, h) + boff + n * 2048 + k * 1024); } while (0)
#define PG8_MMA(ai, bj, At, Bt) do { __builtin_amdgcn_s_setprio(1); _Pragma("unroll") for (int m = 0; m < 4; ++m) _Pragma("unroll") for (int n = 0; n < 2; ++n) _Pragma("unroll") for (int k = 0; k < 2; ++k) \
        acc[ai][bj][m][n] = mma16(Bt[n][k], At[m][k], acc[ai][bj][m][n]); __builtin_amdgcn_s_setprio(0); } while (0)
#define PG8_WAIT_V(n) asm volatile("s_waitcnt vmcnt(" #n ")" ::: "memory")
#define PG8_WAIT_L(n) asm volatile("s_waitcnt lgkmcnt(" #n ")" ::: "memory")
#define PG8_BAR __builtin_amdgcn_s_barrier()
#define PG8_SCHED __builtin_amdgcn_sched_barrier(0)
    Unit cur, nxt; int ui = 0;
    if (!S.next(0, cur)) return;
    typedef typename Epi::acc_t acc_t;
    acc_t acc[2][2][4][2];
#pragma unroll
    for (int a = 0; a < 2; ++a)
#pragma unroll
        for (int b = 0; b < 2; ++b)
#pragma unroll
            for (int m = 0; m < 4; ++m)
#pragma unroll
                for (int n = 0; n < 2; ++n) acc[a][b][m][n] = (acc_t){0, 0, 0, 0};
    bf16x8 At[4][2], B0[2][2], B1[2][2];
    unsigned cv0[2], cv1[2], nv0[2], nv1[2]; int ntok[4] = {0, 0, 0, 0};
    if constexpr (AB::GATHER) { const int* tp = ab.tokp(cur);
#pragma unroll
        for (int i = 0; i < 2; ++i) { int t0 = tp[Rr[i]], t1 = tp[HALF + Rr[i]]; t0 = t0 < 0 ? 0 : t0; t1 = t1 < 0 ? 0 : t1;
            cv0[i] = (unsigned)(t0 * K + Cc[i]) * 2u; cv1[i] = (unsigned)(t1 * K + Cc[i]) * 2u; }
    } else {
#pragma unroll
        for (int i = 0; i < 2; ++i) { cv0[i] = (unsigned)(Rr[i] * K + Cc[i]) * 2u; cv1[i] = cv0[i] + (unsigned)hstep; }
    }
#pragma unroll
    for (int i = 0; i < 2; ++i) { nv0[i] = cv0[i]; nv1[i] = cv1[i]; }
    const char* cA = ab.abase(cur); const char* cB = ab.bbase(cur);
    PG8_STAGE(PG8_SB(0, 0), cB, voffB); PG8_STAGE(PG8_SB(0, 1), cB + hstep, voffB); PG8_STAGE(PG8_SA(0, 0), cA, cv0); PG8_STAGE(PG8_SA(0, 1), cA, cv1);
    if (wr == 1) PG8_BAR;
    PG8_WAIT_V(2); PG8_BAR;
    PG8_STAGE(PG8_SB(1, 0), cB + kstep, voffB); PG8_STAGE(PG8_SA(1, 0), cA + kstep, cv0); PG8_STAGE(PG8_SB(1, 1), cB + hstep + kstep, voffB);
    PG8_WAIT_V(6); PG8_BAR;
    for (;;) {
        const bool has_next = S.next(ui + 1, nxt);
        const char* nA = has_next ? ab.abase(nxt) : cA; const char* nB = has_next ? ab.bbase(nxt) : cB;
        if constexpr (AB::GATHER) {
            if (has_next) { const int* tp = ab.tokp(nxt);
                asm volatile("global_load_dword %0, %1, off" : "=v"(ntok[0]) : "v"(tp + Rr[0]) : "memory");
                asm volatile("global_load_dword %0, %1, off" : "=v"(ntok[1]) : "v"(tp + Rr[1]) : "memory");
                asm volatile("global_load_dword %0, %1, off" : "=v"(ntok[2]) : "v"(tp + HALF + Rr[0]) : "memory");
                asm volatile("global_load_dword %0, %1, off" : "=v"(ntok[3]) : "v"(tp + HALF + Rr[1]) : "memory"); }
        }
        for (int t = 0; t < nt; t += 2) {
            const bool last = (t == nt - 2);
            const char* a1 = cA + (size_t)(t + 1) * kstep;
            const char* a2 = last ? nA : cA + (size_t)(t + 2) * kstep; const char* b2 = last ? nB : cB + (size_t)(t + 2) * kstep;
            const char* a3 = a2 + kstep; const char* b3 = b2 + kstep;
            unsigned x0[2], x1[2];
            if constexpr (AB::GATHER) {
                if (last && has_next) {
                    asm volatile("s_waitcnt vmcnt(6)" : "+v"(ntok[0]), "+v"(ntok[1]), "+v"(ntok[2]), "+v"(ntok[3]) :: "memory");
#pragma unroll
                    for (int i = 0; i < 2; ++i) { int t0 = ntok[i], t1 = ntok[2 + i]; t0 = t0 < 0 ? 0 : t0; t1 = t1 < 0 ? 0 : t1;
                        nv0[i] = (unsigned)(t0 * K + Cc[i]) * 2u; nv1[i] = (unsigned)(t1 * K + Cc[i]) * 2u; }
                }
#pragma unroll
                for (int i = 0; i < 2; ++i) { x0[i] = last ? nv0[i] : cv0[i]; x1[i] = last ? nv1[i] : cv1[i]; }
            } else {
#pragma unroll
                for (int i = 0; i < 2; ++i) { x0[i] = cv0[i]; x1[i] = cv1[i]; }
            }
            PG8_LDB(B0, 0, 0); PG8_LDB(B1, 0, 1); PG8_SCHED; PG8_LDA(At, 0, 0); PG8_STAGE(PG8_SA(1, 1), a1, cv1);
            PG8_WAIT_V(8); PG8_WAIT_L(0); PG8_BAR; PG8_MMA(0, 0, At, B0); PG8_MMA(0, 1, At, B1); PG8_BAR; PG8_SCHED;
            PG8_LDA(At, 0, 1); PG8_STAGE(PG8_SB(0, 0), b2, voffB); PG8_STAGE(PG8_SB(0, 1), b2 + hstep, voffB); PG8_STAGE(PG8_SA(0, 0), a2, x0);
            PG8_WAIT_V(8); PG8_WAIT_L(0); PG8_BAR; PG8_MMA(1, 0, At, B0); PG8_MMA(1, 1, At, B1); PG8_BAR; PG8_SCHED;
            PG8_LDB(B0, 1, 0); PG8_LDB(B1, 1, 1); PG8_SCHED; PG8_LDA(At, 1, 0); PG8_STAGE(PG8_SA(0, 1), a2, x1);
            PG8_WAIT_V(8); PG8_WAIT_L(0); PG8_BAR; PG8_MMA(0, 0, At, B0); PG8_MMA(0, 1, At, B1); PG8_BAR; PG8_SCHED;
            PG8_LDA(At, 1, 1); PG8_STAGE(PG8_SB(1, 0), b3, voffB); PG8_STAGE(PG8_SB(1, 1), b3 + hstep, voffB); PG8_STAGE(PG8_SA(1, 0), a3, x0);
            PG8_WAIT_V(8); PG8_WAIT_L(0); PG8_BAR; PG8_MMA(1, 0, At, B0); PG8_MMA(1, 1, At, B1); PG8_BAR; PG8_SCHED;
        }
        if (wr == 0) PG8_BAR;
        E(acc, cur, wr, wc, fr, fq);
        if (!has_next) break;
#pragma unroll
        for (int a = 0; a < 2; ++a)
#pragma unroll
            for (int b = 0; b < 2; ++b)
#pragma unroll
                for (int m = 0; m < 4; ++m)
#pragma unroll
                    for (int n = 0; n < 2; ++n) acc[a][b][m][n] = (acc_t){0, 0, 0, 0};
        cur = nxt; cA = nA; cB = nB; ++ui;
#pragma unroll
        for (int i = 0; i < 2; ++i) { cv0[i] = nv0[i]; cv1[i] = nv1[i]; }
        if (wr == 1) PG8_BAR;
    }
    PG8_WAIT_V(0);
    PG8_BAR;
#undef PG8_SA
#undef PG8_SB
#undef PG8_STAGE
#undef PG8_LDA
#undef PG8_LDB
#undef PG8_MMA
#undef PG8_WAIT_V
#undef PG8_WAIT_L
#undef PG8_BAR
#undef PG8_SCHED
}
}

namespace moba {
using bf16 = __hip_bfloat16;
using bf16x8 = __attribute__((ext_vector_type(8))) short;
using s16x4  = __attribute__((ext_vector_type(4))) short;
using f32x16 = __attribute__((ext_vector_type(16))) float;
using u32x4  = __attribute__((ext_vector_type(4))) unsigned;
constexpr int D = 128, NW = 8, QBLK = 32, KVBLK = 64, LDK = 3072, NT = 4;
constexpr float THR = 8.f;
constexpr size_t SHM_V = KVBLK * D * 2, SHM_K = KVBLK * D * 2, SHM_ATTN = 2 * SHM_V + 2 * SHM_K + NW * 64 * 4;
#define KSWZ(row, colB) ((row) * 256 + ((colB) ^ (((row) & 7) << 4)))
#define SBAR() __builtin_amdgcn_sched_barrier(0)
__device__ __forceinline__ int crow(int r, int hi) { return (r & 3) + 8 * (r >> 2) + 4 * hi; }
__device__ __forceinline__ unsigned cvtpk(float lo, float hi) { unsigned r; asm volatile("v_cvt_pk_bf16_f32 %0, %1, %2" : "=v"(r) : "v"(lo), "v"(hi)); return r; }
__device__ __forceinline__ void partialSM(f32x16& p0, f32x16& p1, float& m_reg, float& mn, float& alpha) {
  float pmax = p0[0];
#pragma unroll
  for (int r = 1; r < 16; ++r) pmax = fmaxf(pmax, p0[r]);
#pragma unroll
  for (int r = 0; r < 16; ++r) pmax = fmaxf(pmax, p1[r]);
  { auto rr = __builtin_amdgcn_permlane32_swap(__float_as_uint(pmax), __float_as_uint(pmax), false, false);
    pmax = fmaxf(__uint_as_float(rr[0]), __uint_as_float(rr[1])); }
  if (__builtin_expect(__all(pmax - m_reg <= THR), 1)) { mn = m_reg; alpha = 1.f; }
  else { mn = fmaxf(m_reg, pmax); alpha = __builtin_amdgcn_exp2f(m_reg - mn); m_reg = mn; }
#pragma unroll
  for (int r = 0; r < 16; ++r) p0[r] = p0[r] - mn;
#pragma unroll
  for (int r = 0; r < 16; ++r) p1[r] = p1[r] - mn;
#pragma unroll
  for (int r = 0; r < 16; ++r) p0[r] = __builtin_amdgcn_exp2f(p0[r]);
}
__device__ __forceinline__ void finishSM(f32x16& p0, f32x16& p1, float alpha, float& l_reg, bf16x8& pa0, bf16x8& pa1, bf16x8& pa2, bf16x8& pa3) {
#pragma unroll
  for (int r = 0; r < 16; ++r) p1[r] = __builtin_amdgcn_exp2f(p1[r]);
  float ps = 0;
#pragma unroll
  for (int r = 0; r < 16; ++r) ps += p0[r];
#pragma unroll
  for (int r = 0; r < 16; ++r) ps += p1[r];
  { auto rr = __builtin_amdgcn_permlane32_swap(__float_as_uint(ps), __float_as_uint(ps), false, false);
    ps = __uint_as_float(rr[0]) + __uint_as_float(rr[1]); }
  l_reg = l_reg * alpha + ps;
#define PK4(P, BASE, OUT) do { unsigned a0 = cvtpk(P[BASE + 0], P[BASE + 1]), a1 = cvtpk(P[BASE + 2], P[BASE + 3]);   \
    unsigned b0 = cvtpk(P[BASE + 4], P[BASE + 5]), b1 = cvtpk(P[BASE + 6], P[BASE + 7]);                              \
    auto r0 = __builtin_amdgcn_permlane32_swap(a0, b0, false, false); auto r1 = __builtin_amdgcn_permlane32_swap(a1, b1, false, false); \
    u32x4 w = {r0[0], r1[0], r0[1], r1[1]}; OUT = *reinterpret_cast<bf16x8*>(&w); } while (0)
  PK4(p0, 0, pa0); PK4(p0, 8, pa1); PK4(p1, 0, pa2); PK4(p1, 8, pa3);
#undef PK4
}
__device__ __forceinline__ void qkt(f32x16& p0, f32x16& p1, const bf16* Ks, const bf16x8* qr, int r32, int hi) {
  p0 = f32x16{}; p1 = f32x16{};
#pragma unroll
  for (int d0 = 0; d0 < 8; ++d0) { int cb = (d0 * 16 + hi * 8) * 2;
    bf16x8 b0 = *reinterpret_cast<const bf16x8*>((const char*)Ks + KSWZ(r32, cb));
    bf16x8 b1 = *reinterpret_cast<const bf16x8*>((const char*)Ks + KSWZ(32 + r32, cb));
    p0 = __builtin_amdgcn_mfma_f32_32x32x16_bf16(b0, qr[d0], p0, 0, 0, 0);
    p1 = __builtin_amdgcn_mfma_f32_32x32x16_bf16(b1, qr[d0], p1, 0, 0, 0); }
}
__device__ __forceinline__ int v_st(int k, int c) { const int kk = (k & ~0xC) | ((k & 4) << 1) | ((k & 8) >> 1); return ((kk >> 3) * 4 + (c >> 5)) * 512 + ((kk & 7) * 32 + (c & 31)) * 2; }
__device__ __forceinline__ int v_rd_base(int lane) { return ((lane & 3) << 3) | (((lane >> 2) & 3) << 6) | (((lane >> 4) & 1) << 5) | (((lane >> 5) & 1) << 8); }
constexpr int v_rd_off(int d0, int ks, int half) { return d0 * 512 + ks * 4096 + half * 2048; }
template <int OFF> __device__ __forceinline__ s16x4 tr_read(int vb) {
  s16x4 r; asm volatile("ds_read_b64_tr_b16 %0, %1 offset:%2" : "=&v"(r) : "v"(vb), "i"(OFF) : "memory"); return r;
}
template <int D0> __device__ __forceinline__ void pv_one(f32x16& od, int vb, bf16x8 pa0, bf16x8 pa1, bf16x8 pa2, bf16x8 pa3) {
  const s16x4 l0 = tr_read<v_rd_off(D0, 0, 0)>(vb), h0 = tr_read<v_rd_off(D0, 0, 1)>(vb), l1 = tr_read<v_rd_off(D0, 1, 0)>(vb), h1 = tr_read<v_rd_off(D0, 1, 1)>(vb);
  const s16x4 l2 = tr_read<v_rd_off(D0, 2, 0)>(vb), h2 = tr_read<v_rd_off(D0, 2, 1)>(vb), l3 = tr_read<v_rd_off(D0, 3, 0)>(vb), h3 = tr_read<v_rd_off(D0, 3, 1)>(vb);
  asm volatile("s_waitcnt lgkmcnt(0)" ::: "memory"); SBAR();
#define PK(L, H) (bf16x8){L[0], L[1], L[2], L[3], H[0], H[1], H[2], H[3]}
  od = __builtin_amdgcn_mfma_f32_32x32x16_bf16(pa0, PK(l0, h0), od, 0, 0, 0);
  od = __builtin_amdgcn_mfma_f32_32x32x16_bf16(pa1, PK(l1, h1), od, 0, 0, 0);
  od = __builtin_amdgcn_mfma_f32_32x32x16_bf16(pa2, PK(l2, h2), od, 0, 0, 0);
  od = __builtin_amdgcn_mfma_f32_32x32x16_bf16(pa3, PK(l3, h3), od, 0, 0, 0);
#undef PK
}
__device__ __forceinline__ void pv_d0(f32x16* o, int vb, bf16x8 pa0, bf16x8 pa1, bf16x8 pa2, bf16x8 pa3) {
  pv_one<0>(o[0], vb, pa0, pa1, pa2, pa3); pv_one<1>(o[1], vb, pa0, pa1, pa2, pa3); pv_one<2>(o[2], vb, pa0, pa1, pa2, pa3); pv_one<3>(o[3], vb, pa0, pa1, pa2, pa3);
}
__device__ __forceinline__ void cmask(f32x16& p0, f32x16& p1, int tile, int ql, int hi) {
  asm volatile("" : "+v"(ql));
#pragma unroll
  for (int r = 0; r < 16; ++r) { const int kv = 64 * tile + (r & 3) + 8 * (r >> 2) + 4 * hi; if (kv > ql) p0[r] = -1e30f; if (kv + 32 > ql) p1[r] = -1e30f; }
}
__device__ __forceinline__ void moba_unit(const bool OWN, const bf16* qrow, const bf16* __restrict__ Kh, const bf16* __restrict__ Vh, bf16* obase, int ostride, int dst, float* ml, int mli, int ql, char* lds) {
  const int tid = threadIdx.x, wid = tid >> 6, lane = tid & 63, r32 = lane & 31, hi = lane >> 5;
  bf16* V_lds = (bf16*)lds; bf16* K_lds = (bf16*)(lds + 2 * SHM_V);
  float* ws = (float*)(lds + 2 * SHM_V + 2 * SHM_K) + wid * 64; float* li_l = ws; float* al_l = ws + 32;
  float m_reg = -1e30f, l_reg = 0; f32x16 o[4] = {}; bf16x8 qr[8];
  const bf16* Qw = qrow + hi * 8;
#pragma unroll
  for (int d0 = 0; d0 < 8; ++d0) qr[d0] = *reinterpret_cast<const bf16x8*>(Qw + d0 * 16);
  const int sr = tid >> 4, sc = (tid & 15) * 8, vst0 = v_st(sr, sc), vst1 = v_st(32 + sr, sc);
  const int vb0 = (int)(uintptr_t)V_lds + v_rd_base(lane);
  struct { bf16x8 vs0, vs1, ks0, ks1; } sr_[2];
#define SLOAD(i, k0) do { sr_[i].vs0 = *reinterpret_cast<const bf16x8*>(&Vh[(long)((k0) + sr) * LDK + sc]); sr_[i].vs1 = *reinterpret_cast<const bf16x8*>(&Vh[(long)((k0) + 32 + sr) * LDK + sc]); \
    sr_[i].ks0 = *reinterpret_cast<const bf16x8*>(&Kh[(long)((k0) + sr) * LDK + sc]); sr_[i].ks1 = *reinterpret_cast<const bf16x8*>(&Kh[(long)((k0) + 32 + sr) * LDK + sc]); } while (0)
#define SWRITE(b, i) do { *(bf16x8*)((char*)V_lds + (b) * SHM_V + vst0) = sr_[i].vs0;          \
    *(bf16x8*)((char*)V_lds + (b) * SHM_V + vst1) = sr_[i].vs1; int kc = sc * 2;               \
    *(bf16x8*)((char*)K_lds + (b) * SHM_K + KSWZ(sr, kc)) = sr_[i].ks0;                       \
    *(bf16x8*)((char*)K_lds + (b) * SHM_K + KSWZ(32 + sr, kc)) = sr_[i].ks1; } while (0)
#define SWAIT() asm volatile("s_waitcnt vmcnt(4)" ::: "memory")
#define RESC(a) do { if (__any((a) < 1.f)) { if (hi == 0) al_l[r32] = (a); asm volatile("s_waitcnt lgkmcnt(0)" ::: "memory"); \
    _Pragma("unroll") for (int d = 0; d < 4; ++d) _Pragma("unroll") for (int r = 0; r < 16; ++r) o[d][r] *= al_l[crow(r, hi)]; } } while (0)
  f32x16 pA0, pA1, pB0, pB1; float mnA, mnB, alA, alB; bf16x8 pa0, pa1, pa2, pa3;
  constexpr int SE = 0, SO = 1;
  SLOAD(SE, 0); asm volatile("s_waitcnt vmcnt(0)" ::: "memory"); SWRITE(0, SE); __syncthreads();
  qkt(pA0, pA1, K_lds, qr, r32, hi); if (OWN) cmask(pA0, pA1, 0, ql, hi); partialSM(pA0, pA1, m_reg, mnA, alA);
  SLOAD(SO, KVBLK); SLOAD(SE, 2 * KVBLK);
  SWAIT(); SWRITE(1, SO); __syncthreads();
  {
    SBAR(); qkt(pB0, pB1, (bf16*)((char*)K_lds + SHM_K), qr, r32, hi);
    finishSM(pA0, pA1, alA, l_reg, pa0, pa1, pa2, pa3); SBAR();
    SLOAD(SO, 3 * KVBLK); SBAR();
    pv_d0(o, vb0, pa0, pa1, pa2, pa3); if (OWN) cmask(pB0, pB1, 1, ql, hi); partialSM(pB0, pB1, m_reg, mnB, alB);
    __syncthreads(); SWAIT(); SWRITE(0, SE);
    RESC(alB); __syncthreads();
    SBAR(); qkt(pA0, pA1, K_lds, qr, r32, hi);
    finishSM(pB0, pB1, alB, l_reg, pa0, pa1, pa2, pa3); SBAR();
    pv_d0(o, vb0 + (int)SHM_V, pa0, pa1, pa2, pa3); if (OWN) cmask(pA0, pA1, 2, ql, hi); partialSM(pA0, pA1, m_reg, mnA, alA);
    __syncthreads(); asm volatile("s_waitcnt vmcnt(0)" ::: "memory"); SWRITE(1, SO);
    RESC(alA); __syncthreads();
  }
  SBAR(); qkt(pB0, pB1, (bf16*)((char*)K_lds + SHM_K), qr, r32, hi);
  finishSM(pA0, pA1, alA, l_reg, pa0, pa1, pa2, pa3); SBAR();
  pv_d0(o, vb0, pa0, pa1, pa2, pa3); if (OWN) cmask(pB0, pB1, 3, ql, hi); partialSM(pB0, pB1, m_reg, mnB, alB);
  __syncthreads(); RESC(alB);
  finishSM(pB0, pB1, alB, l_reg, pa0, pa1, pa2, pa3); SBAR();
  pv_d0(o, vb0 + (int)SHM_V, pa0, pa1, pa2, pa3);
  if (hi == 0) li_l[r32] = l_reg; asm volatile("s_waitcnt lgkmcnt(0)" ::: "memory");
  float rli[16];
#pragma unroll
  for (int r = 0; r < 16; ++r) rli[r] = __builtin_amdgcn_rcpf(li_l[crow(r, hi)]);
  __syncthreads();
  bf16* stg = (bf16*)lds + wid * 4096;
#pragma unroll
  for (int r = 0; r < 16; ++r) { const int orow = crow(r, hi);
#pragma unroll
    for (int d0 = 0; d0 < 4; ++d0) stg[orow * 128 + d0 * 32 + r32] = __float2bfloat16(o[d0][r] * rli[r]); }
  int* dsto = (int*)al_l;
  if (hi == 0) dsto[r32] = dst;
  asm volatile("s_waitcnt lgkmcnt(0)" ::: "memory");
#pragma unroll
  for (int i = 0; i < 8; ++i) { const int row = i * 4 + (lane >> 4), ch = lane & 15; const int di = dsto[row]; const u32x4 v = *(const u32x4*)(stg + row * 128 + ch * 8);
    if (di >= 0) *(u32x4*)(obase + (size_t)di * ostride + ch * 8) = v; }
  if (hi == 0 && dst >= 0) { ml[2 * (size_t)mli] = m_reg; ml[2 * (size_t)mli + 1] = l_reg; }
  asm volatile("s_waitcnt lgkmcnt(0)" ::: "memory");
  __syncthreads();
#undef SLOAD
#undef SWRITE
#undef SWAIT
#undef RESC
}

#define KSWZ64(row, colB) ((row) * 128 + ((colB) ^ ((((row) >> 1) & 7) << 4)))
constexpr size_t DA_SHM_K = 64 * 64 * 2;
constexpr size_t DA_SHM = 2 * SHM_V + 2 * DA_SHM_K + NW * 64 * 4;
__device__ __forceinline__ void qkt64(f32x16& p0, f32x16& p1, const bf16* Ks, const bf16x8* qr, int r32, int hi) {
  p0 = f32x16{}; p1 = f32x16{};
#pragma unroll
  for (int d0 = 0; d0 < 4; ++d0) { int cb = (d0 * 16 + hi * 8) * 2;
    bf16x8 b0 = *reinterpret_cast<const bf16x8*>((const char*)Ks + KSWZ64(r32, cb));
    bf16x8 b1 = *reinterpret_cast<const bf16x8*>((const char*)Ks + KSWZ64(32 + r32, cb));
    p0 = __builtin_amdgcn_mfma_f32_32x32x16_bf16(b0, qr[d0], p0, 0, 0, 0);
    p1 = __builtin_amdgcn_mfma_f32_32x32x16_bf16(b1, qr[d0], p1, 0, 0, 0); }
}
__device__ __forceinline__ void dattn_unit(const bf16* Qb, const bf16* __restrict__ Kh, const bf16* __restrict__ Vh, bf16* Ob, const int NT, char* lds) {
  const int tid = threadIdx.x, wid = tid >> 6, lane = tid & 63, r32 = lane & 31, hi = lane >> 5;
  bf16* V_lds = (bf16*)lds; bf16* K_lds = (bf16*)(lds + 2 * SHM_V);
  float* ws = (float*)(lds + 2 * SHM_V + 2 * DA_SHM_K) + wid * 64; float* li_l = ws; float* al_l = ws + 32;
  float m_reg = -1e30f, l_reg = 0; f32x16 o[4] = {}; bf16x8 qr[4];
  const bf16* Qw = Qb + (long)(wid * QBLK + r32) * LDK + hi * 8;
#pragma unroll
  for (int d0 = 0; d0 < 4; ++d0) qr[d0] = *reinterpret_cast<const bf16x8*>(Qw + d0 * 16);
  const int sr = tid >> 4, sc = (tid & 15) * 8, vst0 = v_st(sr, sc), vst1 = v_st(32 + sr, sc);
  const int kr = tid >> 3, kc = (tid & 7) * 8, kst = KSWZ64(kr, kc * 2);
  const int vb0 = (int)(uintptr_t)V_lds + v_rd_base(lane);
  const int ql = wid * QBLK + r32;
  struct { bf16x8 vs0, vs1, ks; } sr_[2];
#define SLOAD(i, k0) do { sr_[i].vs0 = *reinterpret_cast<const bf16x8*>(&Vh[(long)((k0) + sr) * LDK + sc]); sr_[i].vs1 = *reinterpret_cast<const bf16x8*>(&Vh[(long)((k0) + 32 + sr) * LDK + sc]); \
    sr_[i].ks = *reinterpret_cast<const bf16x8*>(&Kh[(long)((k0) + kr) * LDK + kc]); } while (0)
#define SWRITE(b, i) do { *(bf16x8*)((char*)V_lds + (b) * SHM_V + vst0) = sr_[i].vs0; *(bf16x8*)((char*)V_lds + (b) * SHM_V + vst1) = sr_[i].vs1; \
    *(bf16x8*)((char*)K_lds + (b) * DA_SHM_K + kst) = sr_[i].ks; } while (0)
#define SWAIT() asm volatile("s_waitcnt vmcnt(3)" ::: "memory")
#define RESC(a) do { if (__any((a) < 1.f)) { if (hi == 0) al_l[r32] = (a); asm volatile("s_waitcnt lgkmcnt(0)" ::: "memory"); \
    _Pragma("unroll") for (int d = 0; d < 4; ++d) _Pragma("unroll") for (int r = 0; r < 16; ++r) o[d][r] *= al_l[crow(r, hi)]; } } while (0)
#define MASK(P0, P1, t) do { if ((t) >= NT - 4) cmask(P0, P1, (t) - (NT - 4), ql, hi); } while (0)
  f32x16 pA0, pA1, pB0, pB1; float mnA, mnB, alA, alB; bf16x8 pa0, pa1, pa2, pa3;
  constexpr int SE = 0, SO = 1;
  SLOAD(SE, 0); asm volatile("s_waitcnt vmcnt(0)" ::: "memory"); SWRITE(0, SE); __syncthreads();
  qkt64(pA0, pA1, K_lds, qr, r32, hi); MASK(pA0, pA1, 0); partialSM(pA0, pA1, m_reg, mnA, alA);
  SLOAD(SO, KVBLK); SLOAD(SE, 2 * KVBLK);
  SWAIT(); SWRITE(1, SO); __syncthreads();
  for (int j = 1; j + 1 < NT; j += 2) {
    SBAR(); qkt64(pB0, pB1, (bf16*)((char*)K_lds + DA_SHM_K), qr, r32, hi);
    finishSM(pA0, pA1, alA, l_reg, pa0, pa1, pa2, pa3); SBAR();
    SLOAD(SO, (j + 2) * KVBLK); SBAR();
    pv_d0(o, vb0, pa0, pa1, pa2, pa3); MASK(pB0, pB1, j); partialSM(pB0, pB1, m_reg, mnB, alB);
    __syncthreads(); SWAIT(); SWRITE(0, SE);
    RESC(alB); __syncthreads();
    SBAR(); qkt64(pA0, pA1, K_lds, qr, r32, hi);
    finishSM(pB0, pB1, alB, l_reg, pa0, pa1, pa2, pa3); SBAR();
    if (j + 3 < NT) SLOAD(SE, (j + 3) * KVBLK); SBAR();
    pv_d0(o, vb0 + (int)SHM_V, pa0, pa1, pa2, pa3); MASK(pA0, pA1, j + 1); partialSM(pA0, pA1, m_reg, mnA, alA);
    __syncthreads(); SWAIT(); SWRITE(1, SO);
    RESC(alA); __syncthreads();
  }
  SBAR(); qkt64(pB0, pB1, (bf16*)((char*)K_lds + DA_SHM_K), qr, r32, hi);
  finishSM(pA0, pA1, alA, l_reg, pa0, pa1, pa2, pa3); SBAR();
  pv_d0(o, vb0, pa0, pa1, pa2, pa3); MASK(pB0, pB1, NT - 1); partialSM(pB0, pB1, m_reg, mnB, alB);
  __syncthreads(); RESC(alB);
  finishSM(pB0, pB1, alB, l_reg, pa0, pa1, pa2, pa3); SBAR();
  pv_d0(o, vb0 + (int)SHM_V, pa0, pa1, pa2, pa3);
  if (hi == 0) li_l[r32] = l_reg; asm volatile("s_waitcnt lgkmcnt(0)" ::: "memory");
  float rli[16];
#pragma unroll
  for (int r = 0; r < 16; ++r) rli[r] = __builtin_amdgcn_rcpf(li_l[crow(r, hi)]);
  __syncthreads();
  bf16* stg = (bf16*)lds + wid * 4096;
#pragma unroll
  for (int r = 0; r < 16; ++r) { const int orow = crow(r, hi);
#pragma unroll
    for (int d0 = 0; d0 < 4; ++d0) stg[orow * 128 + d0 * 32 + r32] = __float2bfloat16(o[d0][r] * rli[r]); }
  asm volatile("s_waitcnt lgkmcnt(0)" ::: "memory");
#pragma unroll
  for (int i = 0; i < 8; ++i) { const int row = i * 4 + (lane >> 4), ch = lane & 15; const u32x4 v = *(const u32x4*)(stg + row * 128 + ch * 8);
    *(u32x4*)(Ob + (size_t)(wid * QBLK + row) * 2048 + ch * 8) = v; }
  asm volatile("s_waitcnt lgkmcnt(0)" ::: "memory");
  __syncthreads();
#undef SLOAD
#undef SWRITE
#undef SWAIT
#undef RESC
#undef MASK
}
struct DaUnit { int bqh; int qb; };
struct DaOrder {
  int vcu, G;
  __device__ __forceinline__ DaOrder(int vcu_, int G_) : vcu(vcu_), G(G_) {}
  __device__ __forceinline__ bool next(int i, DaUnit& u) const {
    if (G == 256) { if (i >= 8) return false; const int s = vcu & 7, ii = i & 3; u.bqh = (i >> 2) * 32 + (vcu >> 3); u.qb = (ii == 0) ? s : (ii == 1) ? 15 - s : (ii == 2) ? 16 + s : 31 - s; return true; }
    const int uu = vcu + i * G; if (uu >= 2048) return false; u.bqh = uu >> 5; u.qb = uu & 31; return true; }
};
template <class Sched> __device__ __forceinline__ void dattn_phase(char* lds, const bf16* QKV, bf16* O, const Sched& S) {
  DaUnit u;
  for (int i = 0; S.next(i, u); ++i) { const int b = u.bqh >> 4, qh = u.bqh & 15; const size_t rb = (size_t)b * 8192;
    dattn_unit(QKV + (rb + u.qb * 256) * LDK + qh * 64, QKV + rb * LDK + 1024 + qh * 64, QKV + rb * LDK + 2048 + (qh >> 1) * 128, O + (rb + u.qb * 256) * 2048 + qh * 128, 4 * (u.qb + 1), lds); }
}
#undef KSWZ64
#undef KSWZ
#undef SBAR
}
#define GAS __attribute__((address_space(1)))
#define LAS __attribute__((address_space(3)))
typedef unsigned short bf16;
typedef unsigned v4u __attribute__((ext_vector_type(4)));
typedef float f32x4 __attribute__((ext_vector_type(4)));
typedef short bf16x8 __attribute__((ext_vector_type(8)));
typedef GAS unsigned gu32;
typedef GAS unsigned long long gu64;
#define RLX_AGENT __ATOMIC_RELAXED, __HIP_MEMORY_SCOPE_AGENT
#define LDS_WAIT() asm volatile("s_waitcnt lgkmcnt(0)" ::: "memory")
#define VM_WAIT() asm volatile("s_waitcnt vmcnt(0)" ::: "memory")
__device__ __forceinline__ unsigned long long rt() { return __builtin_amdgcn_s_memrealtime(); }
__device__ __forceinline__ unsigned f2bf(float f) { unsigned u = __builtin_bit_cast(unsigned, f); return (u + 0x7fffu + ((u >> 16) & 1u)) >> 16; }
__device__ __forceinline__ unsigned pk2(float lo, float hi) { return f2bf(lo) | (f2bf(hi) << 16); }
#define XB_TMO      128
#define XB_XCNT(j)  (256  + 64 * (j))
#define XB_XSUB(j)  (1280 + 64 * (j))
#define XB_XGEN(j)  (2304 + 64 * (j))
#define XB_TOP      3328
#define XB_TOPGEN   3392
#define XCD_BAR_WORDS 3456
#define XB_SPIN_CAP (1u << 18)

__device__ __forceinline__ unsigned xb_ld(unsigned* p)              { return __hip_atomic_load(p, __ATOMIC_RELAXED, __HIP_MEMORY_SCOPE_AGENT); }
__device__ __forceinline__ unsigned xb_add(unsigned* p, unsigned v) { return __hip_atomic_fetch_add(p, v, __ATOMIC_RELAXED, __HIP_MEMORY_SCOPE_AGENT); }
__device__ __forceinline__ unsigned xb_xcc_id() { return (unsigned)__builtin_amdgcn_s_getreg((3 << 11) | 20) & 0xFu; }
#define XB_SPIN(cond, bar) do { unsigned _sp = 0; while (cond) { __builtin_amdgcn_s_sleep(1); \
    if ((++_sp & 255u) == 0u) { if (xb_ld(&(bar)[XB_TMO])) break; if (_sp > XB_SPIN_CAP) { atomicAdd(&(bar)[XB_TMO], 1u); break; } } } } while (0)

struct XcdBarrier {
    unsigned* bar; unsigned x;
    volatile LAS unsigned* st;
};

__device__ __forceinline__ XcdBarrier xcd_barrier_post(unsigned* bar, volatile LAS unsigned* st) {
    XcdBarrier b; b.bar = bar; b.x = xb_xcc_id(); b.st = st;
    if (threadIdx.x == 0) (void)xb_add(&bar[XB_XCNT(b.x)], 1u);
    return b;
}
__device__ __forceinline__ void xcd_barrier_complete(unsigned* bar, unsigned x, unsigned& nloc, unsigned& nx) {
    const unsigned G = gridDim.x * gridDim.y * gridDim.z;
    unsigned sum, cnt, mine, sp = 0u;
    for (;;) {
        sum = 0u; cnt = 0u; mine = 0u;
#pragma unroll
        for (unsigned j = 0; j < 16; ++j) { const unsigned c = xb_ld(&bar[XB_XCNT(j)]); sum += c; cnt += (c > 0u) ? 1u : 0u; mine = (j == x) ? c : mine; }
        if (sum == G) break;
        __builtin_amdgcn_s_sleep(1);
        if ((++sp & 255u) == 0u) { if (xb_ld(&bar[XB_TMO])) break; if (sp > XB_SPIN_CAP) { atomicAdd(&bar[XB_TMO], 1u); break; } }
    }
    nloc = mine > 0u ? mine : 1u; nx = cnt > 0u ? cnt : 1u;
}

__device__ __forceinline__ void xcd_barrier(const XcdBarrier& b) {
    asm volatile("s_waitcnt vmcnt(0)" ::: "memory");
    __syncthreads();
    if (threadIdx.x == 0) {
        unsigned* bar = b.bar;
        __builtin_amdgcn_s_waitcnt(0);
        unsigned nloc = b.st[0], nx = b.st[1];
        if (nloc == 0u) { xcd_barrier_complete(bar, b.x, nloc, nx); b.st[0] = nloc; b.st[1] = nx; }
        const unsigned old = xb_add(&bar[XB_XSUB(b.x)], 1u);
        const unsigned gen = old / nloc;
        if (old + 1u == (gen + 1u) * nloc) {
            __builtin_amdgcn_fence(__ATOMIC_RELEASE, "agent");
            asm volatile("s_waitcnt vmcnt(0)" ::: "memory");
            const unsigned og = xb_add(&bar[XB_TOP], 1u);
            const unsigned tg = og / nx;
            if (og + 1u == (tg + 1u) * nx) xb_add(&bar[XB_TOPGEN], 1u);
            else XB_SPIN(xb_ld(&bar[XB_TOPGEN]) == tg, bar);
            __builtin_amdgcn_fence(__ATOMIC_ACQUIRE, "agent");
            xb_add(&bar[XB_XGEN(b.x)], 1u);
            asm volatile("s_waitcnt vmcnt(0)" ::: "memory");
        } else {
            XB_SPIN(xb_ld(&bar[XB_XGEN(b.x)]) == gen, bar);
            __builtin_amdgcn_fence(__ATOMIC_ACQUIRE, "agent");
            asm volatile("s_waitcnt vmcnt(0)" ::: "memory");
        }
    }
    __syncthreads();
}

constexpr int NWAVES = 8;
#ifndef MK_PER_PHASE
#define MK_PER_PHASE 0
#endif
constexpr int BATCH = 4, SEQ = 8192, DM = 1024, TOK = BATCH * SEQ;
constexpr int FF0 = 2816, NEXP = 8, FF1 = 3584;
constexpr int NQKV = 3072;
constexpr int MB_H = 8, MB_NB = 32, MB_L = 256;
constexpr int SLOTS = TOK + NEXP * 256;
constexpr float NORM_EPS = 1e-6f, SUBLN_EPS = 1e-5f;
constexpr float LAMBDA_INIT0 = 0.2f;
constexpr float LOG2E = 1.4426950408889634f;
constexpr int LIST_PER_BH = 256 * 496;
__host__ __device__ constexpr int list_off(int j) { return 256 * (31 * j - (j * (j - 1)) / 2); }

constexpr size_t MiB = 1u << 20;
constexpr size_t WS_CTL = 0, CTL_ZERO_BYTES = 3 * MiB;
constexpr size_t WS_CMAX13 = 2 * MiB;
constexpr size_t WS_CMAX2 = WS_CMAX13 + 256 * 1024;
constexpr size_t WS_SSTOT = WS_CMAX2 + 64 * 1024;
constexpr size_t WS_ROPE64 = 3 * MiB;
constexpr size_t WS_ROPE128 = WS_ROPE64 + 512 * 1024;
constexpr size_t WS_KMEAN = WS_ROPE128 + 1 * MiB;
constexpr size_t WS_TOK = 5 * MiB;
constexpr size_t WS_SLOT = 6 * MiB;
constexpr size_t WS_SA = 7 * MiB;
constexpr size_t WS_OWNML = 41 * MiB;
constexpr size_t WS_W0QKV = 8 * MiB, WS_W0O = 14 * MiB, WS_W013 = 16 * MiB, WS_W02 = 27 * MiB, WS_W1QKV = 33 * MiB, WS_W1O = 39 * MiB;
constexpr size_t B0 = 43 * MiB;
constexpr size_t WS_H = B0;
constexpr size_t WS_QKV = B0 + 64 * MiB;
constexpr size_t WS_OATT = B0 + 256 * MiB;
constexpr size_t WS_UD = B0 + 128 * MiB;
constexpr size_t WS_LIST = B0 + 256 * MiB;
constexpr size_t WS_PML = B0 + 272 * MiB;
constexpr size_t WS_PO = B0 + 280 * MiB;
constexpr size_t WS_WM13 = B0 + 64 * MiB;
constexpr size_t WS_WM2 = WS_WM13 + 56 * MiB;
constexpr size_t WS_AQ = WS_WM2 + 28 * MiB;
constexpr size_t WS_UM = B0 + 232 * MiB;
constexpr size_t WS_END = WS_PO + (size_t)TOK * MB_H * 3 * 128 * 2;
static_assert(WS_UM + (size_t)SLOTS * FF1 <= WS_END && WS_AQ + (size_t)TOK * DM <= WS_UM && WS_END <= 528 * MiB, "d_ws map");
constexpr int CW_TMO = 0, CW_CODE = 1, CW_DBG = 2;
constexpr int CW_MOECNT = 64;
constexpr int CW_MOBACNT = 256;
constexpr int CW_BAR = 4096;
constexpr size_t WS_RSS = 1 * MiB;
constexpr int RING_OFF = 0, RING_BYTES = 131072;
constexpr int LDSCTL_OFF = RING_BYTES, MISC_OFF = LDSCTL_OFF + 320;
constexpr int LDS_BYTES = 147456;

struct Args { const float* in[20]; float* out; unsigned char* ws; float inv64[8]; float inv128[16]; int ph_lo, ph_hi; };

__device__ __forceinline__ float wave_sum(float v) {
#pragma unroll
    for (int o = 1; o < 64; o <<= 1) v += __shfl_xor(v, o);
    return v;
}
template <int MAP> __device__ __forceinline__ int maprow(int n) {
    if (MAP == 1) { if (n >= 2048) return n; const int d = n & 63; if (d >= 16) return n; const int b = d >> 3, a = (d >> 2) & 1, c = d & 3; return (n & ~63) + 8 * a + 4 * b + c; }
    if (MAP == 2) { if (n >= 2048) return n; const int d = n & 127; if (d >= 32) return n; const int b = d >> 4, a = (d >> 2) & 3, c = d & 3; return (n & ~127) + 8 * a + 4 * b + c; }
    if (MAP == 3) return 256 * (n >> 7) + (n & 127);
    if (MAP == 4) return 256 * (n >> 7) + 128 + (n & 127);
    return n;
}
template <int MAP> __device__ __forceinline__ void transpose_item(const float* W, int K, int N, bf16* WT, LAS float* scr, int item, int lane, const float* gk = nullptr) {
    const int nblk = N / 32, kb = item / nblk, nb = item % nblk, k0 = 64 * kb, n0 = 32 * nb;
    const int kr = lane >> 3, nc = (lane & 7) * 4;
    f32x4 v[8];
#pragma unroll
    for (int i = 0; i < 8; ++i) v[i] = *(const GAS f32x4*)(W + (size_t)(k0 + i * 8 + kr) * N + n0 + nc);
    if (gk) {
#pragma unroll
        for (int i = 0; i < 8; ++i) v[i] = v[i] * gk[k0 + i * 8 + kr]; }
#pragma unroll
    for (int i = 0; i < 8; ++i) { LAS float* d = scr + (i * 8 + kr) * 33 + nc; d[0] = v[i].x; d[1] = v[i].y; d[2] = v[i].z; d[3] = v[i].w; }
    LDS_WAIT(); asm volatile("" ::: "memory");
    const int c = lane & 7;
#pragma unroll
    for (int j = 0; j < 4; ++j) { const int n = (lane >> 3) + 8 * j; const LAS float* s = scr + (8 * c) * 33 + n;
        v4u o; o.x = pk2(s[0 * 33], s[1 * 33]); o.y = pk2(s[2 * 33], s[3 * 33]); o.z = pk2(s[4 * 33], s[5 * 33]); o.w = pk2(s[6 * 33], s[7 * 33]);
        *(GAS v4u*)(WT + (size_t)maprow<MAP>(n0 + n) * K + k0 + 8 * c) = o; }
    LDS_WAIT(); asm volatile("" ::: "memory");
}

template <int MAP> __device__ __forceinline__ void wmax_item(const float* W, int K, int N, unsigned* cmax, unsigned long long* sstot, int item, int lane, const float* gk) {
    const int nblk = N / 32, kb = item / nblk, nb = item % nblk, k0 = 64 * kb, n0 = 32 * nb;
    const int kr = lane >> 3, nc = (lane & 7) * 4;
    f32x4 v[8];
#pragma unroll
    for (int i = 0; i < 8; ++i) v[i] = *(const GAS f32x4*)(W + (size_t)(k0 + i * 8 + kr) * N + n0 + nc);
    if (gk) {
#pragma unroll
        for (int i = 0; i < 8; ++i) v[i] = v[i] * gk[k0 + i * 8 + kr]; }
    f32x4 mx = (f32x4){0.f, 0.f, 0.f, 0.f}; float ss = 0.f;
#pragma unroll
    for (int i = 0; i < 8; ++i) { mx.x = fmaxf(mx.x, fabsf(v[i].x)); mx.y = fmaxf(mx.y, fabsf(v[i].y)); mx.z = fmaxf(mx.z, fabsf(v[i].z)); mx.w = fmaxf(mx.w, fabsf(v[i].w));
        ss += (v[i].x * v[i].x + v[i].y * v[i].y) + (v[i].z * v[i].z + v[i].w * v[i].w); }
#pragma unroll
    for (int o = 8; o < 64; o <<= 1) { mx.x = fmaxf(mx.x, __shfl_xor(mx.x, o)); mx.y = fmaxf(mx.y, __shfl_xor(mx.y, o)); mx.z = fmaxf(mx.z, __shfl_xor(mx.z, o)); mx.w = fmaxf(mx.w, __shfl_xor(mx.w, o)); }
    if (lane < 8) {
        __hip_atomic_fetch_max(cmax + maprow<MAP>(n0 + nc + 0), __float_as_uint(mx.x), __ATOMIC_RELAXED, __HIP_MEMORY_SCOPE_AGENT);
        __hip_atomic_fetch_max(cmax + maprow<MAP>(n0 + nc + 1), __float_as_uint(mx.y), __ATOMIC_RELAXED, __HIP_MEMORY_SCOPE_AGENT);
        __hip_atomic_fetch_max(cmax + maprow<MAP>(n0 + nc + 2), __float_as_uint(mx.z), __ATOMIC_RELAXED, __HIP_MEMORY_SCOPE_AGENT);
        __hip_atomic_fetch_max(cmax + maprow<MAP>(n0 + nc + 3), __float_as_uint(mx.w), __ATOMIC_RELAXED, __HIP_MEMORY_SCOPE_AGENT); }
    if (sstot) { ss = wave_sum(ss); if (lane == 0) __hip_atomic_fetch_add(sstot, (unsigned long long)(ss * 16777216.0f), __ATOMIC_RELAXED, __HIP_MEMORY_SCOPE_AGENT); }
}
template <int MAP> __device__ __forceinline__ void transpose_item_q(const float* W, int K, int N, signed char* WT, const unsigned* cmax, LAS float* scr, int item, int lane, const float* gk) {
    const int nblk = N / 32, kb = item / nblk, nb = item % nblk, k0 = 64 * kb, n0 = 32 * nb;
    const int kr = lane >> 3, nc = (lane & 7) * 4;
    f32x4 v[8];
#pragma unroll
    for (int i = 0; i < 8; ++i) v[i] = *(const GAS f32x4*)(W + (size_t)(k0 + i * 8 + kr) * N + n0 + nc);
    if (gk) {
#pragma unroll
        for (int i = 0; i < 8; ++i) v[i] = v[i] * gk[k0 + i * 8 + kr]; }
#pragma unroll
    for (int i = 0; i < 8; ++i) { LAS float* d = scr + (i * 8 + kr) * 33 + nc; d[0] = v[i].x; d[1] = v[i].y; d[2] = v[i].z; d[3] = v[i].w; }
    LDS_WAIT(); asm volatile("" ::: "memory");
    const int half = lane >> 5, n = lane & 31, row = maprow<MAP>(n0 + n);
    const float cm = __uint_as_float(cmax[row]); const float inv = cm > 0.f ? 127.0f / cm : 0.f;
    const LAS float* s = scr + (32 * half) * 33 + n;
    unsigned w[8];
#pragma unroll
    for (int q4 = 0; q4 < 8; ++q4) { unsigned pk = 0;
#pragma unroll
        for (int b = 0; b < 4; ++b) { const int q = (int)__builtin_rintf(s[(4 * q4 + b) * 33] * inv); pk |= (unsigned)(q & 255) << (8 * b); }
        w[q4] = pk; }
    GAS v4u* dst = (GAS v4u*)(WT + (size_t)row * K + k0 + 32 * half);
    dst[0] = (v4u){w[0], w[1], w[2], w[3]}; dst[1] = (v4u){w[4], w[5], w[6], w[7]};
    LDS_WAIT(); asm volatile("" ::: "memory");
}
__device__ __forceinline__ void rms_row(const float* xrow, const f32x4 (&g)[4], f32x4 (&v)[4], int lane) {
    const GAS f32x4* xr = (const GAS f32x4*)xrow + lane; float s = 0.f;
#pragma unroll
    for (int j = 0; j < 4; ++j) { v[j] = xr[64 * j]; s += (v[j].x * v[j].x + v[j].y * v[j].y) + (v[j].z * v[j].z + v[j].w * v[j].w); }
    const float rstd = 1.f / sqrtf(wave_sum(s) * (1.f / DM) + NORM_EPS);
#pragma unroll
    for (int j = 0; j < 4; ++j) v[j] = v[j] * rstd * g[j];
}
__device__ __forceinline__ void store_row_bf16(bf16* orow, const f32x4 (&v)[4], int lane) {
    GAS unsigned long long* o8 = (GAS unsigned long long*)orow + lane;
#pragma unroll
    for (int j = 0; j < 4; ++j) o8[64 * j] = (unsigned long long)pk2(v[j].x, v[j].y) | ((unsigned long long)pk2(v[j].z, v[j].w) << 32);
}
__device__ __forceinline__ void load_gain(const float* g, f32x4 (&gv)[4], int lane) {
#pragma unroll
    for (int j = 0; j < 4; ++j) gv[j] = *((const f32x4*)g + lane + 64 * j);
}
__device__ __forceinline__ void rmsnorm_phase(const float* src, const float* gain, bf16* dst, int gw, int ngw, int lane) {
    f32x4 gv[4]; load_gain(gain, gv, lane);
    for (int m = gw; m < TOK; m += ngw) { f32x4 v[4]; rms_row(src + (size_t)m * DM, gv, v, lane); store_row_bf16(dst + (size_t)m * DM, v, lane); }
}
__device__ __forceinline__ float bf2f(unsigned short b) { return __uint_as_float((unsigned)b << 16); }


typedef __attribute__((address_space(4))) const unsigned char* kaptr_t;
__device__ __forceinline__ kaptr_t ka_get() { kaptr_t p = (kaptr_t)__builtin_amdgcn_kernarg_segment_ptr(); asm volatile("" : "+s"(p)); return p; }
#define KA_IN(k) (*(const float* const __attribute__((address_space(4)))*)(ka + 8 * (k)))
#define PH_PTRS kaptr_t ka = ka_get(); unsigned char* const ws = *(unsigned char* const __attribute__((address_space(4)))*)(ka + 168); float* const out = *(float* const __attribute__((address_space(4)))*)(ka + 160); gu32* const ctl = (gu32*)(ws + WS_CTL); (void)out; (void)ctl
#define IN_X KA_IN(0)
#define norm_mix KA_IN(1)
#define norm_ffn KA_IN(2)
#define final_norm KA_IN(3)
#define da_wqkv KA_IN(4)
#define da_wo KA_IN(5)
#define da_lq1 KA_IN(6)
#define da_lk1 KA_IN(7)
#define da_lq2 KA_IN(8)
#define da_lk2 KA_IN(9)
#define da_subln KA_IN(10)
#define mb_wqkv KA_IN(11)
#define mb_wo KA_IN(12)
#define ffn_w1 KA_IN(13)
#define ffn_w3 KA_IN(14)
#define ffn_w2 KA_IN(15)
#define moe_router KA_IN(16)
#define moe_w1 KA_IN(17)
#define moe_w3 KA_IN(18)
#define moe_w2 KA_IN(19)
#define rope64 ((float*)(ws + WS_ROPE64))
#define rope128 ((float*)(ws + WS_ROPE128))
#define kmean ((float*)(ws + WS_KMEAN))
#define tok_e ((int*)(ws + WS_TOK))
#define tok_pos (tok_e + 2 * TOK)
#define tok_gate ((float*)(tok_pos + 2 * TOK))
#define wg_base ((int*)(ws + WS_TOK + 800 * 1024))
#define slot_tok ((int*)(ws + WS_SLOT))
#define slot_gate ((float*)(slot_tok + 2 * SLOTS))
#define ownml ((float*)(ws + WS_OWNML))
#define W0qkv ((bf16*)(ws + WS_W0QKV))
#define W0o ((bf16*)(ws + WS_W0O))
#define W013 ((bf16*)(ws + WS_W013))
#define W02 ((bf16*)(ws + WS_W02))
#define W1qkv ((bf16*)(ws + WS_W1QKV))
#define W1o ((bf16*)(ws + WS_W1O))
#define Rb ((bf16*)(ws + WS_H))
#define OB ((bf16*)out)
#define RSS(j) ((unsigned long long*)(ws + WS_RSS) + (size_t)(j) * TOK)
#define QKV ((bf16*)(ws + WS_QKV))
#define OATT ((bf16*)(ws + WS_OATT))
#define UD ((bf16*)(ws + WS_UD))
#define lists ((int*)(ws + WS_LIST))
#define pml ((float*)(ws + WS_PML))
#define PO ((bf16*)(ws + WS_PO))
#define WM13 ((signed char*)(ws + WS_WM13))
#define WM2 ((signed char*)(ws + WS_WM2))
#define AQ ((signed char*)(ws + WS_AQ))
#define UM ((signed char*)(ws + WS_UM))
#define CMAX13 ((unsigned*)(ws + WS_CMAX13))
#define CMAX2 ((unsigned*)(ws + WS_CMAX2))
#define SSTOT ((unsigned long long*)(ws + WS_SSTOT))
#define SA ((float*)(ws + WS_SA))
__global__ void __launch_bounds__(NWAVES * 64, 2) mk_fwd(Args args) {
    extern __shared__ __attribute__((aligned(16))) unsigned char lds[];
    LAS unsigned char* L = (LAS unsigned char*)lds;
    volatile LAS unsigned* MISC = (volatile LAS unsigned*)(L + MISC_OFF);
    const int wave = __builtin_amdgcn_readfirstlane((int)threadIdx.x >> 6);
#define tid ((int)threadIdx.x)
#define lane ((int)(threadIdx.x & 63u))
    const int G = gridDim.x; const int bx = blockIdx.x; const int vcu = (G % 8 == 0) ? (bx % 8) * (G / 8) + bx / 8 : bx;
    const int gw = vcu * NWAVES + wave, NGW = G * NWAVES;
    gu32* ctl0 = (gu32*)(args.ws + WS_CTL);
    for (int u = tid; u < (LDS_BYTES - LDSCTL_OFF) / 4; u += NWAVES * 64) ((LAS unsigned*)(L + LDSCTL_OFF))[u] = 0u;
    __syncthreads();
    XcdBarrier bar; bar.bar = (unsigned*)(ctl0 + CW_BAR); bar.x = 0; bar.st = nullptr;
    if (!MK_PER_PHASE) bar = xcd_barrier_post((unsigned*)(ctl0 + CW_BAR), MISC + 8);
#define GRID_BAR() do { if (!MK_PER_PHASE) xcd_barrier(bar); } while (0)
    const int lo = args.ph_lo, hi_ph = args.ph_hi;
#ifndef PH_MASK
#define PH_MASK 0xFFFFFFFFu
#endif
#define IN(k) (((PH_MASK >> (k)) & 1u) && lo <= (k) && (k) < hi_ph)
#define SEAM(k) do { if (IN((k) + 1)) GRID_BAR(); } while (0)
#ifndef DUP_MASK
#define DUP_MASK 0u
#endif
#define NREP(k) ((((DUP_MASK) >> (k)) & 1u) ? 2 : 1)

    if (IN(0)) { PH_PTRS; for (int rep_ = 0; rep_ < NREP(0); ++rep_) {
        LAS float* scr = (LAS float*)(L + RING_OFF + wave * 16384);
        constexpr int I_QKV = (DM / 64) * (NQKV / 32), I_O = (DM / 64) * (DM / 32), I_13 = (DM / 64) * (FF0 / 32), I_2 = (FF0 / 64) * (DM / 32);
        constexpr int NITEMS = 2 * I_QKV + 2 * I_O + 2 * I_13 + I_2;
        for (int it = gw; it < NITEMS; it += NGW) {
            int r = it;
            if (r < I_QKV) { transpose_item<1>(da_wqkv, DM, NQKV, W0qkv, scr, r, lane, norm_mix); continue; } r -= I_QKV;
            if (r < I_QKV) { transpose_item<2>(mb_wqkv, DM, NQKV, W1qkv, scr, r, lane, norm_mix + DM); continue; } r -= I_QKV;
            if (r < I_O) { transpose_item<0>(da_wo, DM, DM, W0o, scr, r, lane); continue; } r -= I_O;
            if (r < I_O) { transpose_item<0>(mb_wo, DM, DM, W1o, scr, r, lane); continue; } r -= I_O;
            if (r < I_13) { transpose_item<3>(ffn_w1, DM, FF0, W013, scr, r, lane, norm_ffn); continue; } r -= I_13;
            if (r < I_13) { transpose_item<4>(ffn_w3, DM, FF0, W013, scr, r, lane, norm_ffn); continue; } r -= I_13;
            transpose_item<0>(ffn_w2, FF0, DM, W02, scr, r, lane);
        }
        {
            const int gt = (vcu * NWAVES + wave) * 64 + lane, NT_ = G * NWAVES * 64;
            for (int e = gt; e < SEQ * 8; e += NT_) { const int pos = e >> 3, i = e & 7; const float ang = (float)pos * (*(const float __attribute__((address_space(4)))*)(ka + 176 + 4 * i)); rope64[e] = cosf(ang); rope64[SEQ * 8 + e] = sinf(ang); }
            for (int e = gt; e < SEQ * 16; e += NT_) { const int pos = e >> 4, i = e & 15; const float ang = (float)pos * (*(const float __attribute__((address_space(4)))*)(ka + 208 + 4 * i)); rope128[e] = cosf(ang); rope128[SEQ * 16 + e] = sinf(ang); }
        }
        for (int m = gw; m < TOK; m += NGW) {
            const GAS f32x4* xr = (const GAS f32x4*)(IN_X + (size_t)m * DM) + lane; f32x4 v[4]; float s = 0.f;
#pragma unroll
            for (int j = 0; j < 4; ++j) { v[j] = xr[64 * j]; s += (v[j].x * v[j].x + v[j].y * v[j].y) + (v[j].z * v[j].z + v[j].w * v[j].w); }
            store_row_bf16(Rb + (size_t)m * DM, v, lane); s = wave_sum(s); if (lane == 0) RSS(0)[m] = (unsigned long long)(s * 16777216.0f); }
        } SEAM(0);
    }
    if (IN(1)) { PH_PTRS; for (int rep_ = 0; rep_ < NREP(1); ++rep_) {
        pg8::ABDense ab{Rb, W0qkv, DM}; pg8::TileOrder S; S.init(TOK / 256, NQKV / 256, G, bx);
        pg8::EpiQKV<64> E{QKV, NQKV, rope64, rope64 + SEQ * 8, 0.125f * LOG2E, RSS(0)};
        pg8::gemm_phase<pg8::EpiQKV<64>, pg8::ABDense>(L + RING_OFF, ab, S, E);
        } SEAM(1);
    }
    if (IN(2)) { PH_PTRS; for (int rep_ = 0; rep_ < NREP(2); ++rep_) {
        const moba::DaOrder AS(vcu, G);
        moba::dattn_phase<moba::DaOrder>((char*)lds + RING_OFF, (const moba::bf16*)QKV, (moba::bf16*)OATT, AS);
        } SEAM(2);
    }
    if (IN(3)) { PH_PTRS; for (int rep_ = 0; rep_ < NREP(3); ++rep_) {
        float lam;
        { const float a = wave_sum(da_lq1[lane] * da_lk1[lane]), b = wave_sum(da_lq2[lane] * da_lk2[lane]); lam = expf(a) - expf(b) + LAMBDA_INIT0; }
        const int hh = lane >> 3, dd = (lane & 7) * 16;
        float gsub[16];
#pragma unroll
        for (int k = 0; k < 16; ++k) gsub[k] = da_subln[dd + k] * (1.f - LAMBDA_INIT0);
        for (int m = gw; m < TOK; m += NGW) {
            const bf16* o1 = OATT + (size_t)m * 2048 + (2 * hh) * 128 + dd; const bf16* o2 = o1 + 128;
            const v4u a0 = *(const GAS v4u*)o1, a1 = *(const GAS v4u*)(o1 + 8), b0 = *(const GAS v4u*)o2, b1 = *(const GAS v4u*)(o2 + 8);
            float d[16]; float ss = 0.f;
#pragma unroll
            for (int k = 0; k < 4; ++k) {
                const unsigned ua = a0[k], ub = b0[k], uc = a1[k], ud = b1[k];
                d[2 * k] = __uint_as_float(ua << 16) - lam * __uint_as_float(ub << 16); d[2 * k + 1] = __uint_as_float(ua & 0xffff0000u) - lam * __uint_as_float(ub & 0xffff0000u);
                d[8 + 2 * k] = __uint_as_float(uc << 16) - lam * __uint_as_float(ud << 16); d[8 + 2 * k + 1] = __uint_as_float(uc & 0xffff0000u) - lam * __uint_as_float(ud & 0xffff0000u); }
#pragma unroll
            for (int k = 0; k < 16; ++k) ss += d[k] * d[k];
            ss += __shfl_xor(ss, 1); ss += __shfl_xor(ss, 2); ss += __shfl_xor(ss, 4);
            const float rstd = 1.f / sqrtf(ss * (1.f / 128.f) + SUBLN_EPS);
            v4u w0, w1;
#pragma unroll
            for (int k = 0; k < 4; ++k) { w0[k] = pk2(d[2 * k] * rstd * gsub[2 * k], d[2 * k + 1] * rstd * gsub[2 * k + 1]); w1[k] = pk2(d[8 + 2 * k] * rstd * gsub[8 + 2 * k], d[8 + 2 * k + 1] * rstd * gsub[8 + 2 * k + 1]); }
            bf16* od = OB + (size_t)m * DM + hh * 128 + dd;
            *(GAS v4u*)od = w0; *(GAS v4u*)(od + 8) = w1;
        }
        } SEAM(3);
    }
    if (IN(4)) { PH_PTRS; for (int rep_ = 0; rep_ < NREP(4); ++rep_) {
        pg8::ABDense ab{OB, W0o, DM}; pg8::TileOrder S; S.init(TOK / 256, DM / 256, G, bx);
        pg8::EpiResB E{Rb, Rb, DM, nullptr, RSS(1)};
        pg8::gemm_phase<pg8::EpiResB, pg8::ABDense>(L + RING_OFF, ab, S, E);
        } SEAM(4);
    }
    if (IN(6)) { PH_PTRS; for (int rep_ = 0; rep_ < NREP(6); ++rep_) {
        pg8::ABDense ab{Rb, W013, DM}; pg8::TileOrder S; S.init(TOK / 256, (2 * FF0) / 256, G, bx);
        pg8::EpiSwiGLU E{UD, FF0, nullptr, RSS(1), nullptr};
        pg8::gemm_phase<pg8::EpiSwiGLU, pg8::ABDense>(L + RING_OFF, ab, S, E);
        } SEAM(6);
    }
    if (IN(7)) { PH_PTRS; for (int rep_ = 0; rep_ < NREP(7); ++rep_) {
        pg8::ABDense ab{UD, W02, FF0}; pg8::TileOrder S; S.init(TOK / 256, DM / 256, G, bx);
        pg8::EpiResB E{Rb, Rb, DM, nullptr, RSS(2)};
        pg8::gemm_phase<pg8::EpiResB, pg8::ABDense>(L + RING_OFF, ab, S, E);
        } SEAM(7);
    }
    if (IN(9)) { PH_PTRS; for (int rep_ = 0; rep_ < NREP(9); ++rep_) {
        pg8::ABDense ab{Rb, W1qkv, DM}; pg8::TileOrder S; S.init(TOK / 256, NQKV / 256, G, bx);
        pg8::EpiQKV<128> E{QKV, NQKV, rope128, rope128 + SEQ * 16, 0.08838834764831845f * LOG2E, RSS(2)};
        pg8::gemm_phase<pg8::EpiQKV<128>, pg8::ABDense>(L + RING_OFF, ab, S, E);
        } SEAM(9);
    }
    if (IN(10)) { PH_PTRS; for (int rep_ = 0; rep_ < NREP(10); ++rep_) {
        LAS float* red = (LAS float*)(L + RING_OFF);
        for (int u = vcu; u < BATCH * MB_H * MB_NB; u += G) {
            const int b = u >> 8, h = (u >> 5) & 7, j = u & 31;
            const int dch = tid & 15, kg = tid >> 4;
            const bf16* kp = QKV + (size_t)(b * SEQ + j * MB_L + kg * 8) * NQKV + 1024 + h * 128 + dch * 8;
            float s[8] = {0.f, 0.f, 0.f, 0.f, 0.f, 0.f, 0.f, 0.f};
#pragma unroll
            for (int k = 0; k < 8; ++k) { const v4u v = *(const GAS v4u*)(kp + (size_t)k * NQKV);
#pragma unroll
                for (int q = 0; q < 4; ++q) { s[2 * q] += __uint_as_float(v[q] << 16); s[2 * q + 1] += __uint_as_float(v[q] & 0xffff0000u); } }
#pragma unroll
            for (int q = 0; q < 8; ++q) red[kg * 128 + dch * 8 + q] = s[q];
            __syncthreads();
            if (tid < 128) { float a = 0.f;
#pragma unroll 8
                for (int k = 0; k < 32; ++k) a += red[k * 128 + tid];
                kmean[(size_t)u * 128 + tid] = a * (1.f / 256.f); }
            __syncthreads();
        }
        } SEAM(10);
    }
    if (IN(11)) { PH_PTRS; for (int rep_ = 0; rep_ < NREP(11); ++rep_) {
        LAS float* km = (LAS float*)(L + RING_OFF);
        LAS float* mv = (LAS float*)(L + RING_OFF + 16384);
        LAS int* mi = (LAS int*)(L + RING_OFF + 16384 + 3072);
        LAS int* lcnt = (LAS int*)(L + RING_OFF + 24576);
        for (int u = vcu; u < BATCH * MB_H * (MB_NB - 1); u += G) {
            const int bh = u / 31, o = 1 + u % 31, b = bh >> 3, h = bh & 7;
            for (int e = tid; e < 32 * 128; e += 512) km[e] = kmean[(size_t)bh * 4096 + e];
            if (tid < 32) lcnt[tid] = 0;
            __syncthreads();
            const int ql = tid & 255, half = tid >> 8; const int s = o * 256 + ql;
            const bf16* qp = QKV + (size_t)(b * SEQ + s) * NQKV + h * 128;
            float qf[128];
#pragma unroll
            for (int c = 0; c < 16; ++c) { const v4u v = *(const GAS v4u*)(qp + c * 8);
#pragma unroll
                for (int q = 0; q < 4; ++q) { qf[c * 8 + 2 * q] = __uint_as_float(v[q] << 16); qf[c * 8 + 2 * q + 1] = __uint_as_float(v[q] & 0xffff0000u); } }
            float v0 = -INFINITY, v1 = -INFINITY, v2 = -INFINITY; int i0 = -1, i1 = -1, i2 = -1;
            for (int jj = 0; jj < 16; ++jj) { const int j = half * 16 + jj;
                if (j < o) { float g = 0.f; const LAS f32x4* kr = (const LAS f32x4*)(km + j * 128);
#pragma unroll
                    for (int c = 0; c < 32; ++c) { const f32x4 kv = kr[c]; g += qf[4 * c] * kv.x + qf[4 * c + 1] * kv.y + qf[4 * c + 2] * kv.z + qf[4 * c + 3] * kv.w; }
                    if (g > v0) { v2 = v1; i2 = i1; v1 = v0; i1 = i0; v0 = g; i0 = j; } else if (g > v1) { v2 = v1; i2 = i1; v1 = g; i1 = j; } else if (g > v2) { v2 = g; i2 = j; } } }
            if (half == 1) { mv[ql * 3] = v0; mv[ql * 3 + 1] = v1; mv[ql * 3 + 2] = v2; mi[ql * 3] = i0; mi[ql * 3 + 1] = i1; mi[ql * 3 + 2] = i2; }
            __syncthreads();
            int lp0 = 0, lp1 = 0, lp2 = 0;
            if (half == 0) {
#pragma unroll
                for (int k = 0; k < 3; ++k) { const float g = mv[ql * 3 + k]; const int j = mi[ql * 3 + k];
                    if (j >= 0) { if (g > v0) { v2 = v1; i2 = i1; v1 = v0; i1 = i0; v0 = g; i0 = j; } else if (g > v1) { v2 = v1; i2 = i1; v1 = g; i1 = j; } else if (g > v2) { v2 = g; i2 = j; } } }
                if (i0 >= 0) lp0 = __hip_atomic_fetch_add(&lcnt[i0], 1, __ATOMIC_RELAXED, __HIP_MEMORY_SCOPE_WORKGROUP);
                if (i1 >= 0) lp1 = __hip_atomic_fetch_add(&lcnt[i1], 1, __ATOMIC_RELAXED, __HIP_MEMORY_SCOPE_WORKGROUP);
                if (i2 >= 0) lp2 = __hip_atomic_fetch_add(&lcnt[i2], 1, __ATOMIC_RELAXED, __HIP_MEMORY_SCOPE_WORKGROUP);
            }
            __syncthreads();
            if (tid < 32 && rep_ == 0) { const int n = lcnt[tid]; lcnt[32 + tid] = n ? (int)__hip_atomic_fetch_add(ctl + CW_MOBACNT + bh * 32 + tid, (unsigned)n, RLX_AGENT) : 0; }
            __syncthreads();
            if (half == 0 && rep_ == 0) { int* lb = lists + (size_t)bh * LIST_PER_BH;
                if (i0 >= 0) lb[list_off(i0) + lcnt[32 + i0] + lp0] = s;
                if (i1 >= 0) lb[list_off(i1) + lcnt[32 + i1] + lp1] = s | (1 << 16);
                if (i2 >= 0) lb[list_off(i2) + lcnt[32 + i2] + lp2] = s | (2 << 16); }
            __syncthreads();
        }
        } SEAM(11);
    }
    if (IN(12)) { PH_PTRS; for (int rep_ = 0; rep_ < NREP(12); ++rep_) {
        LAS int* pre = (LAS int*)(L + 102400);
        { const unsigned c0 = __hip_atomic_load(ctl + CW_MOBACNT + tid, RLX_AGENT), c1 = __hip_atomic_load(ctl + CW_MOBACNT + 512 + tid, RLX_AGENT);
          pre[tid] = (int)((c0 + 255u) >> 8); pre[512 + tid] = (int)((c1 + 255u) >> 8); }
        __syncthreads();
        if (tid == 0) { int a = 0; for (int k = 0; k < 1024; ++k) { const int n = pre[k]; pre[k] = a; a += n; } pre[1024] = a; }
        __syncthreads();
        const int nlist = pre[1024], ntot = 1024 + nlist;
        const int wl = wave * 32 + (lane & 31);
        for (int u = vcu; u < ntot; u += G) {
            const bool own = u < 1024;
            int b, h, kb, s, dst, mli, ostride; moba::bf16* obase; float* mlp;
            if (own) {
                b = u >> 8; h = (u >> 5) & 7; kb = u & 31; s = kb * 256 + wl; dst = b * SEQ + s; mli = (b * 8 + h) * SEQ + s; ostride = DM; obase = (moba::bf16*)OB + h * 128; mlp = ownml;
            } else {
                const int lu = u - 1024; int loI = 0, hiI = 1024;
                while (hiI - loI > 1) { const int mid = (loI + hiI) >> 1; if (pre[mid] <= lu) loI = mid; else hiI = mid; }
                const int bhj = loI, chunk = lu - pre[bhj], bh = bhj >> 5; kb = bhj & 31; b = bh >> 3; h = bh & 7;
                const int cnt = (int)__hip_atomic_load(ctl + CW_MOBACNT + bhj, RLX_AGENT);
                const int ei = chunk * 256 + wl; const bool valid = ei < cnt;
                const int ent = valid ? lists[(size_t)bh * LIST_PER_BH + list_off(kb) + ei] : 0;
                s = ent & 0xffff; mli = (bh * SEQ + s) * 3 + (ent >> 16); dst = valid ? mli : -1; ostride = 128; obase = (moba::bf16*)PO; mlp = pml;
            }
            const moba::bf16* qrow = (const moba::bf16*)QKV + ((size_t)b * SEQ + s) * NQKV + h * 128;
            const moba::bf16* Kh = (const moba::bf16*)QKV + ((size_t)b * SEQ + kb * 256) * NQKV + 1024 + h * 128;
            moba::moba_unit(own, qrow, Kh, Kh + 1024, obase, ostride, dst, mlp, mli, wl, (char*)lds);
        }
        } SEAM(12);
    }
    if (IN(13)) { PH_PTRS; for (int rep_ = 0; rep_ < NREP(13); ++rep_) {
        const int hh = lane >> 3, dd = (lane & 7) * 16;
        for (int m = gw; m < TOK; m += NGW) {
            const int b = m >> 13, s = m & 8191, nv = (s >> 8) < 3 ? (s >> 8) : 3; const int qi = (b * 8 + hh) * SEQ + s;
            float mm[4], ll[4]; mm[0] = ownml[2 * (size_t)qi]; ll[0] = ownml[2 * (size_t)qi + 1]; float M = mm[0];
#pragma unroll
            for (int r = 0; r < 3; ++r) { if (r < nv) { mm[1 + r] = pml[2 * ((size_t)qi * 3 + r)]; ll[1 + r] = pml[2 * ((size_t)qi * 3 + r) + 1]; M = fmaxf(M, mm[1 + r]); } else { mm[1 + r] = -1e30f; ll[1 + r] = 0.f; } }
            float w[4], wsum = 0.f;
#pragma unroll
            for (int r = 0; r < 4; ++r) { w[r] = ll[r] * __builtin_amdgcn_exp2f(mm[r] - M); wsum += w[r]; }
            const float inv = 1.f / wsum;
            float acc16[16];
            bf16* op = OB + (size_t)m * DM + hh * 128 + dd;
            { const v4u a0 = *(const GAS v4u*)op, a1 = *(const GAS v4u*)(op + 8); const float ww = w[0] * inv;
#pragma unroll
              for (int k = 0; k < 4; ++k) { acc16[2 * k] = ww * __uint_as_float(a0[k] << 16); acc16[2 * k + 1] = ww * __uint_as_float(a0[k] & 0xffff0000u); acc16[8 + 2 * k] = ww * __uint_as_float(a1[k] << 16); acc16[8 + 2 * k + 1] = ww * __uint_as_float(a1[k] & 0xffff0000u); } }
#pragma unroll
            for (int r = 0; r < 3; ++r) if (r < nv) { const bf16* pp = PO + ((size_t)qi * 3 + r) * 128 + dd; const v4u a0 = *(const GAS v4u*)pp, a1 = *(const GAS v4u*)(pp + 8); const float ww = w[1 + r] * inv;
#pragma unroll
                for (int k = 0; k < 4; ++k) { acc16[2 * k] += ww * __uint_as_float(a0[k] << 16); acc16[2 * k + 1] += ww * __uint_as_float(a0[k] & 0xffff0000u); acc16[8 + 2 * k] += ww * __uint_as_float(a1[k] << 16); acc16[8 + 2 * k + 1] += ww * __uint_as_float(a1[k] & 0xffff0000u); } }
            v4u w0, w1;
#pragma unroll
            for (int k = 0; k < 4; ++k) { w0[k] = pk2(acc16[2 * k], acc16[2 * k + 1]); w1[k] = pk2(acc16[8 + 2 * k], acc16[8 + 2 * k + 1]); }
            *(GAS v4u*)op = w0; *(GAS v4u*)(op + 8) = w1;
        }
        } SEAM(13);
    }
    if (IN(14)) { PH_PTRS; for (int rep_ = 0; rep_ < NREP(14); ++rep_) {
        pg8::ABDense ab{OB, W1o, DM}; pg8::TileOrder S; S.init(TOK / 256, DM / 256, G, bx);
        pg8::EpiResB E{Rb, Rb, DM, nullptr, RSS(3)};
        pg8::gemm_phase<pg8::EpiResB, pg8::ABDense>(L + RING_OFF, ab, S, E);
        } SEAM(14);
    }
    if (IN(15)) { PH_PTRS; for (int rep_ = 0; rep_ < NREP(15); ++rep_) {
        {
            const int gt = (vcu * NWAVES + wave) * 64 + lane, NT_ = G * NWAVES * 64;
            for (int e = gt; e < 2 * SLOTS; e += NT_) { slot_tok[e] = -1; slot_gate[e] = 0.f; }
        }
        if (rep_ == 0) {
            f32x4 gv[4]; load_gain(norm_ffn + DM, gv, lane);
            float wr_[16][8];
#pragma unroll
            for (int j = 0; j < 4; ++j)
#pragma unroll
                for (int q = 0; q < 4; ++q) { const int k = 4 * lane + 256 * j + q; const f32x4 a = *(const GAS f32x4*)(moe_router + (size_t)k * 8) * gv[j][q], c = *(const GAS f32x4*)(moe_router + (size_t)k * 8 + 4) * gv[j][q];
                    wr_[4 * j + q][0] = a.x; wr_[4 * j + q][1] = a.y; wr_[4 * j + q][2] = a.z; wr_[4 * j + q][3] = a.w; wr_[4 * j + q][4] = c.x; wr_[4 * j + q][5] = c.y; wr_[4 * j + q][6] = c.z; wr_[4 * j + q][7] = c.w; }
            for (int m = gw; m < TOK; m += NGW) {
                f32x4 v[4];
                { const GAS unsigned long long* r8 = (const GAS unsigned long long*)(Rb + (size_t)m * DM) + lane;
#pragma unroll
                  for (int j = 0; j < 4; ++j) { const unsigned long long w = r8[64 * j]; const unsigned lo32 = (unsigned)w, hi32 = (unsigned)(w >> 32);
                      v[j].x = __uint_as_float(lo32 << 16); v[j].y = __uint_as_float(lo32 & 0xffff0000u); v[j].z = __uint_as_float(hi32 << 16); v[j].w = __uint_as_float(hi32 & 0xffff0000u); } }
                float lg[8];
#pragma unroll
                for (int e = 0; e < 8; ++e) { float a = 0.f;
#pragma unroll
                    for (int j = 0; j < 4; ++j) a += v[j].x * wr_[4 * j][e] + v[j].y * wr_[4 * j + 1][e] + v[j].z * wr_[4 * j + 2][e] + v[j].w * wr_[4 * j + 3][e];
                    lg[e] = wave_sum(a); }
                const float rs = 1.f / sqrtf((float)RSS(3)[m] * (5.9604644775390625e-8f / DM) + NORM_EPS);
#pragma unroll
                for (int e = 0; e < 8; ++e) lg[e] *= rs;
                {
                    float mx = 0.f;
#pragma unroll
                    for (int j = 0; j < 4; ++j) mx = fmaxf(fmaxf(mx, fmaxf(fabsf(v[j].x), fabsf(v[j].y))), fmaxf(fabsf(v[j].z), fabsf(v[j].w)));
#pragma unroll
                    for (int o = 1; o < 64; o <<= 1) mx = fmaxf(mx, __shfl_xor(mx, o));
                    const float inv = mx > 0.f ? 127.0f / mx : 0.f;
                    GAS unsigned* aq = (GAS unsigned*)(AQ + (size_t)m * DM) + lane;
#pragma unroll
                    for (int j = 0; j < 4; ++j) { const int q0 = (int)__builtin_rintf(v[j].x * inv), q1 = (int)__builtin_rintf(v[j].y * inv), q2 = (int)__builtin_rintf(v[j].z * inv), q3 = (int)__builtin_rintf(v[j].w * inv);
                        aq[64 * j] = (unsigned)(q0 & 255) | ((unsigned)(q1 & 255) << 8) | ((unsigned)(q2 & 255) << 16) | ((unsigned)(q3 & 255) << 24); }
                    if (lane == 0) SA[m] = mx * rs * (1.0f / 127.0f);
                }
                int e0 = 0; float l0 = lg[0];
#pragma unroll
                for (int e = 1; e < 8; ++e) if (lg[e] > l0) { l0 = lg[e]; e0 = e; }
                int e1 = -1; float l1 = -INFINITY;
#pragma unroll
                for (int e = 0; e < 8; ++e) if (e != e0 && lg[e] > l1) { l1 = lg[e]; e1 = e; }
                if (lane == 0) {
                    const float g0 = 1.f / (1.f + expf(l1 - l0)), g1 = 1.f - g0;
                    const int p0 = (int)__hip_atomic_fetch_add((LAS unsigned*)(L + MISC_OFF) + 40 + e0, 1u, __ATOMIC_RELAXED, __HIP_MEMORY_SCOPE_WORKGROUP), p1 = (int)__hip_atomic_fetch_add((LAS unsigned*)(L + MISC_OFF) + 48 + e1, 1u, __ATOMIC_RELAXED, __HIP_MEMORY_SCOPE_WORKGROUP);
                    tok_e[m] = e0; tok_e[TOK + m] = e1; tok_pos[m] = p0; tok_pos[TOK + m] = p1; tok_gate[m] = g0; tok_gate[TOK + m] = g1;
                }
            }
            LDS_WAIT(); __syncthreads();
            if (tid < 16) { const unsigned n = MISC[40 + tid]; wg_base[vcu * 16 + tid] = n ? (int)__hip_atomic_fetch_add(ctl + CW_MOECNT + tid, n, RLX_AGENT) : 0; }
        }
        {
            constexpr int I_1 = (DM / 64) * (FF1 / 32), I_2 = (FF1 / 64) * (DM / 32), PER_E = 2 * I_1 + I_2;
            for (int it = gw; it < NEXP * PER_E; it += NGW) {
                const int e = it / PER_E; int r = it % PER_E;
                if (r < I_1) { wmax_item<3>(moe_w1 + (size_t)e * DM * FF1, DM, FF1, CMAX13 + e * 2 * FF1, SSTOT, r, lane, norm_ffn + DM); continue; } r -= I_1;
                if (r < I_1) { wmax_item<4>(moe_w3 + (size_t)e * DM * FF1, DM, FF1, CMAX13 + e * 2 * FF1, SSTOT + 1, r, lane, norm_ffn + DM); continue; } r -= I_1;
                wmax_item<0>(moe_w2 + (size_t)e * FF1 * DM, FF1, DM, CMAX2 + e * DM, nullptr, r, lane, nullptr);
            }
        }
        } SEAM(15);
    }
#define MOE_CUM() do { if (tid < 2) { int a = 0; for (int e = 0; e < 8; ++e) { MISC[16 + 9 * tid + e] = (unsigned)a; a += (int)((__hip_atomic_load(ctl + CW_MOECNT + 8 * tid + e, RLX_AGENT) + 255u) >> 8); } MISC[16 + 9 * tid + 8] = (unsigned)a; } __syncthreads(); } while (0)
    if (IN(16)) { PH_PTRS; for (int rep_ = 0; rep_ < NREP(16); ++rep_) {
        MOE_CUM();
        const int gt = (vcu * NWAVES + wave) * 64 + lane, NT_ = G * NWAVES * 64;
        for (int e = gt; e < 2 * TOK; e += NT_) { const int r = e >= TOK ? 1 : 0; const int ex = tok_e[e]; const int t_ = e - r * TOK; const int slot = (int)MISC[16 + 9 * r + ex] * 256 + wg_base[((t_ % NGW) >> 3) * 16 + r * 8 + ex] + tok_pos[e];
            slot_tok[r * SLOTS + slot] = e - r * TOK; slot_gate[r * SLOTS + slot] = tok_gate[e]; }
        {
            LAS float* scr = (LAS float*)(L + RING_OFF + wave * 16384);
            constexpr int I_1 = (DM / 64) * (FF1 / 32), I_2 = (FF1 / 64) * (DM / 32), PER_E = 2 * I_1 + I_2;
            for (int it = gw; it < NEXP * PER_E; it += NGW) {
                const int e = it / PER_E; int r = it % PER_E;
                if (r < I_1) { transpose_item_q<3>(moe_w1 + (size_t)e * DM * FF1, DM, FF1, WM13 + (size_t)e * 2 * FF1 * DM, CMAX13 + e * 2 * FF1, scr, r, lane, norm_ffn + DM); continue; } r -= I_1;
                if (r < I_1) { transpose_item_q<4>(moe_w3 + (size_t)e * DM * FF1, DM, FF1, WM13 + (size_t)e * 2 * FF1 * DM, CMAX13 + e * 2 * FF1, scr, r, lane, norm_ffn + DM); continue; } r -= I_1;
                transpose_item_q<0>(moe_w2 + (size_t)e * FF1 * DM, FF1, DM, WM2 + (size_t)e * DM * FF1, CMAX2 + e * DM, scr, r, lane, nullptr);
            }
        }
        } SEAM(16);
    }
#define MOE_SU() (8.0f * sqrtf(((float)SSTOT[0] * (5.9604644775390625e-8f / (NEXP * FF1))) * ((float)SSTOT[1] * (5.9604644775390625e-8f / (NEXP * FF1)))))
#define MOE_UP(r) do { MOE_CUM(); \
        pg8::ABMoeUp ab{(const pg8::bf16_t*)AQ, (const pg8::bf16_t*)WM13, DM / 2, slot_tok + (r) * SLOTS, (const LAS int*)(L + MISC_OFF + 4 * (16 + 9 * (r))), (size_t)2 * FF1 * (DM / 2)}; \
        pg8::TileOrder S; S.init((int)MISC[16 + 9 * (r) + 8], (2 * FF1) / 256, G, bx); \
        pg8::EpiSwiGLUQ E{UM, FF1, SA, CMAX13, slot_tok + (r) * SLOTS, (const LAS int*)(L + MISC_OFF + 4 * (16 + 9 * (r))), 127.0f / MOE_SU()}; \
        pg8::gemm_phase<pg8::EpiSwiGLUQ, pg8::ABMoeUp>(L + RING_OFF, ab, S, E); } while (0)
#define MOE_DOWN(r) do { MOE_CUM(); \
        pg8::ABMoeDown ab{(const pg8::bf16_t*)UM, (const pg8::bf16_t*)WM2, FF1 / 2, (const LAS int*)(L + MISC_OFF + 4 * (16 + 9 * (r))), (size_t)DM * (FF1 / 2)}; \
        pg8::TileOrder S; S.init((int)MISC[16 + 9 * (r) + 8], DM / 256, G, bx); \
        pg8::EpiResBQ E{(r) == 0 ? Rb : OB, (r) == 0 ? OB : Rb, DM, slot_tok + (r) * SLOTS, slot_gate + (r) * SLOTS, CMAX2, (const LAS int*)(L + MISC_OFF + 4 * (16 + 9 * (r))), MOE_SU() * (1.0f / 127.0f)}; \
        pg8::gemm_phase<pg8::EpiResBQ, pg8::ABMoeDown>(L + RING_OFF, ab, S, E); } while (0)
    if (IN(17)) { PH_PTRS; for (int rep_ = 0; rep_ < NREP(17); ++rep_) MOE_UP(0); SEAM(17); }
    if (IN(18)) { PH_PTRS; MOE_DOWN(0); SEAM(18); }
    if (IN(19)) { PH_PTRS; for (int rep_ = 0; rep_ < NREP(19); ++rep_) MOE_UP(1); SEAM(19); }
    if (IN(20)) { PH_PTRS; MOE_DOWN(1); SEAM(20); }
    if (IN(21)) { PH_PTRS;
        f32x4 gv[4]; load_gain(final_norm, gv, lane);
        for (int m = gw; m < TOK; m += NGW) {
            f32x4 v[4]; float s = 0.f;
            const GAS unsigned long long* r8 = (const GAS unsigned long long*)(Rb + (size_t)m * DM) + lane;
#pragma unroll
            for (int j = 0; j < 4; ++j) { const unsigned long long w = r8[64 * j]; const unsigned lo32 = (unsigned)w, hi32 = (unsigned)(w >> 32);
                v[j].x = __uint_as_float(lo32 << 16); v[j].y = __uint_as_float(lo32 & 0xffff0000u); v[j].z = __uint_as_float(hi32 << 16); v[j].w = __uint_as_float(hi32 & 0xffff0000u);
                s += (v[j].x * v[j].x + v[j].y * v[j].y) + (v[j].z * v[j].z + v[j].w * v[j].w); }
            const float rstd = 1.f / sqrtf(wave_sum(s) * (1.f / DM) + NORM_EPS);
            GAS f32x4* o = (GAS f32x4*)(out + (size_t)m * DM) + lane;
#pragma unroll
            for (int j = 0; j < 4; ++j) o[64 * j] = v[j] * rstd * gv[j]; }
    }
#undef IN
#undef SEAM
#undef GRID_BAR
#undef tid
#undef lane
}
constexpr int N_PHASES = 22;

extern "C" void kernel_launch(void* const* d_in, const int* in_sizes, int n_in, void* d_out, int out_size, void* d_ws, size_t ws_size, hipStream_t stream) {
    static int grid = 0;
    if (grid == 0) {
        if (n_in != 20 || in_sizes[0] != TOK * DM || out_size != TOK * DM || ws_size < WS_END) { fprintf(stderr, "kernel_launch: shape / workspace mismatch (n_in %d, in0 %d, out %d, ws %zu, need %zu); nothing launched\n", n_in, n_in > 0 ? in_sizes[0] : -1, out_size, ws_size, (size_t)WS_END); grid = -1; return; }
        int dev = 0, cus = 0, per_cu = 0;
        if (hipGetDevice(&dev) != hipSuccess || hipDeviceGetAttribute(&cus, hipDeviceAttributeMultiprocessorCount, dev) != hipSuccess) { grid = -1; return; }
        if (hipFuncSetAttribute((const void*)mk_fwd, hipFuncAttributeMaxDynamicSharedMemorySize, LDS_BYTES) != hipSuccess) { fprintf(stderr, "kernel_launch: hipFuncSetAttribute failed\n"); grid = -1; return; }
        if (hipOccupancyMaxActiveBlocksPerMultiprocessor(&per_cu, (const void*)mk_fwd, NWAVES * 64, LDS_BYTES) != hipSuccess || per_cu < 1) fprintf(stderr, "kernel_launch: occupancy query reports %d workgroups per CU\n", per_cu);
        (void)hipGetLastError();
        grid = cus;
    }
    if (grid < 0) return;
    if (hipMemsetAsync((char*)d_ws + WS_CTL, 0, CTL_ZERO_BYTES, stream) != hipSuccess) return;
    Args a{};
    for (int i = 0; i < 20; ++i) a.in[i] = (const float*)d_in[i];
    a.out = (float*)d_out; a.ws = (unsigned char*)d_ws;
    for (int i = 0; i < 8; ++i) a.inv64[i] = (float)pow(500000.0, -(double)(2 * i) / 16.0);
    for (int i = 0; i < 16; ++i) a.inv128[i] = (float)pow(500000.0, -(double)(2 * i) / 32.0);
#if MK_PER_PHASE
    for (int p = 0; p < N_PHASES; ++p) { a.ph_lo = p; a.ph_hi = p + 1; hipLaunchKernelGGL(mk_fwd, dim3(grid), dim3(NWAVES * 64), LDS_BYTES, stream, a); }
#else
    a.ph_lo = 0; a.ph_hi = N_PHASES;
    hipLaunchKernelGGL(mk_fwd, dim3(grid), dim3(NWAVES * 64), LDS_BYTES, stream, a);
#ifdef PROBE_LIST
    {
        static const int probe[] = {PROBE_LIST};
        for (int k : probe) { a.ph_lo = k; a.ph_hi = k + 1;
            a.out = (k == 3 || k == 12 || k == 13 || k == 18 || k == 21) ? (float*)((char*)d_ws + WS_QKV) : (float*)d_out;
            hipLaunchKernelGGL(mk_fwd, dim3(grid), dim3(NWAVES * 64), LDS_BYTES, stream, a); }
    }
#endif
#endif
    const hipError_t le = hipPeekAtLastError();
    if (le != hipSuccess) fprintf(stderr, "kernel_launch: launch failed: %s\n", hipGetErrorName(le));
}
```

```cpp
#include <hip/hip_runtime.h>
#include <hip/hip_bf16.h>
#include <cstdio>
#include <cstdint>
#include <cmath>
namespace pg8 {
#define PG8_LAS __attribute__((address_space(3)))
typedef unsigned short bf16_t;
typedef short bf16x8 __attribute__((ext_vector_type(8)));
typedef float f32x4 __attribute__((ext_vector_type(4)));
typedef unsigned u32x4 __attribute__((ext_vector_type(4)));
constexpr int BM = 256, BK = 64, HALF = 128, HTB = HALF * BK * 2  , STAGE_BYTES = 8 * HTB, NXCD = 8, WGM = 8;

__host__ __device__ __forceinline__ int lds_byte(int r, int c) { const int st = (r >> 4) * 2 + (c >> 5), rr = r & 15, cc = c & 31, ob = rr * 64 + cc * 2; return st * 1024 + (ob ^ (((ob >> 9) & 1) << 5)); }
__host__ __device__ __forceinline__ void stage_rc(int b, int& R, int& C) { const int st = b / 1024, sb = b % 1024, swz = sb ^ (((sb >> 9) & 1) << 5); R = (st >> 1) * 16 + swz / 64; C = (st & 1) * 32 + (swz % 64) / 2; }
__host__ __device__ __forceinline__ int perm32(int rho) { const int n = rho >> 4, i = rho & 15; return 8 * (i >> 2) + 4 * n + (i & 3); }

struct Unit { int pm, pn; };

struct TileOrder {
    int nM, nN, nwg, G, c;
    __device__ __forceinline__ void init(int nM_, int nN_, int G_, int c_) { nM = nM_; nN = nN_; nwg = nM * nN; G = G_; c = c_; }
    __device__ __forceinline__ bool next(int i, Unit& u) const {
        const long L = (long)i * G + c; if (L >= nwg) return false;
        int wgid = (int)L; { const int q = nwg / NXCD, r = nwg % NXCD, xcd = wgid % NXCD, off = wgid / NXCD; wgid = (xcd < r ? xcd * (q + 1) : r * (q + 1) + (xcd - r) * q) + off; }
        const int nig = WGM * nN, gid = wgid / nig, fm = gid * WGM, gsz = (nM - fm) < WGM ? (nM - fm) : WGM;
        u.pm = fm + ((wgid % nig) % gsz); u.pn = (wgid % nig) / gsz; return true;
    }
};

struct ABDense {
    static constexpr bool GATHER = false;
    const bf16_t* A; const bf16_t* Bt; int K;
    __device__ __forceinline__ const char* abase(const Unit& u) const { return (const char*)A + (size_t)u.pm * BM * K * 2; }
    __device__ __forceinline__ const char* bbase(const Unit& u) const { return (const char*)Bt + (size_t)u.pn * BM * K * 2; }
    __device__ __forceinline__ const int* tokp(const Unit&) const { return nullptr; }
};
struct ABMoeUp {
    static constexpr bool GATHER = true;
    const bf16_t* A; const bf16_t* Bt; int K; const int* slot_tok; const PG8_LAS int* cum; size_t estride;
    __device__ __forceinline__ int expert(int pm) const { int e = 0;
#pragma unroll
        for (int k = 1; k < 8; ++k) e += (pm >= cum[k]) ? 1 : 0; return e; }
    __device__ __forceinline__ const char* abase(const Unit&) const { return (const char*)A; }
    __device__ __forceinline__ const char* bbase(const Unit& u) const { return (const char*)(Bt + (size_t)expert(u.pm) * estride) + (size_t)u.pn * BM * K * 2; }
    __device__ __forceinline__ const int* tokp(const Unit& u) const { return slot_tok + u.pm * BM; }
};
struct ABMoeDown {
    static constexpr bool GATHER = false;
    const bf16_t* A; const bf16_t* Bt; int K; const PG8_LAS int* cum; size_t estride;
    __device__ __forceinline__ int expert(int pm) const { int e = 0;
#pragma unroll
        for (int k = 1; k < 8; ++k) e += (pm >= cum[k]) ? 1 : 0; return e; }
    __device__ __forceinline__ const char* abase(const Unit& u) const { return (const char*)A + (size_t)u.pm * BM * K * 2; }
    __device__ __forceinline__ const char* bbase(const Unit& u) const { return (const char*)(Bt + (size_t)expert(u.pm) * estride) + (size_t)u.pn * BM * K * 2; }
    __device__ __forceinline__ const int* tokp(const Unit&) const { return nullptr; }
};

__device__ __forceinline__ unsigned cvt_pk_bf16(float lo, float hi) { unsigned r; asm volatile("v_cvt_pk_bf16_f32 %0, %1, %2" : "=v"(r) : "v"(lo), "v"(hi)); return r; }

template <int DH> struct EpiQKV {
    static constexpr bool PERM = true; typedef f32x4 acc_t;
    bf16_t* O; int ldc; const float* ct; const float* st; float qscale; const unsigned long long* rss;
    __device__ __forceinline__ void operator()(const f32x4 (&acc)[2][2][4][2], const Unit& u, int wr, int wc, int fr, int fq) const {
        constexpr int NF = DH / 8;
        const int row0 = u.pm * BM + wr * 64 + fr, col0 = u.pn * BM + wc * 32 + 8 * fq;
        const int sect = u.pn >> 2;
        const float sc = (sect == 0) ? qscale : 1.f;
        const bool rot = (sect < 2) && (DH == 64 ? (((wc & 1) == 0) && (fq < 2)) : (wc == 0));
#pragma unroll
        for (int ai = 0; ai < 2; ++ai)
#pragma unroll
            for (int m = 0; m < 4; ++m) {
                const int row = row0 + ai * HALF + m * 16; const int pos = row & 8191; const float rs = sc * __builtin_amdgcn_rsqf((float)rss[row] * (5.9604644775390625e-8f / 1024.0f) + 1e-6f);
                f32x4 c4 = (f32x4){1.f, 1.f, 1.f, 1.f}, s4 = (f32x4){0.f, 0.f, 0.f, 0.f};
                if (rot) { c4 = *(const f32x4*)(ct + pos * NF + 4 * fq); s4 = *(const f32x4*)(st + pos * NF + 4 * fq); }
                bf16_t* rowp = O + (size_t)row * ldc + col0;
#pragma unroll
                for (int bj = 0; bj < 2; ++bj) {
                    const f32x4 x1 = acc[ai][bj][m][0], x2 = acc[ai][bj][m][1];
                    f32x4 v0 = (x1 * c4 - x2 * s4) * rs, v1 = (x2 * c4 + x1 * s4) * rs;
                    u32x4 w; w.x = cvt_pk_bf16(v0[0], v0[1]); w.y = cvt_pk_bf16(v0[2], v0[3]); w.z = cvt_pk_bf16(v1[0], v1[1]); w.w = cvt_pk_bf16(v1[2], v1[3]);
                    *(u32x4*)(rowp + bj * HALF) = w; }
            }
    }
};

__device__ __forceinline__ float silu_mul(float a, float b) { return a * b * __builtin_amdgcn_rcpf(1.0f + __builtin_amdgcn_exp2f(-1.4426950408889634f * a)); }
struct EpiSwiGLU {
    static constexpr bool PERM = true; typedef f32x4 acc_t;
    bf16_t* O; int ldc; const float* gate; const unsigned long long* rss; const int* rowmap;
    __device__ __forceinline__ void operator()(const f32x4 (&acc)[2][2][4][2], const Unit& u, int wr, int wc, int fr, int fq) const {
        const int row0 = u.pm * BM + wr * 64 + fr, col0 = u.pn * HALF + wc * 32 + 8 * fq;
#pragma unroll
        for (int ai = 0; ai < 2; ++ai)
#pragma unroll
            for (int m = 0; m < 4; ++m) {
                const int row = row0 + ai * HALF + m * 16; const float g = gate ? gate[row] : 1.f; const int trow = rowmap ? rowmap[row] : row;
                const float rs = trow >= 0 ? __builtin_amdgcn_rsqf((float)rss[trow] * (5.9604644775390625e-8f / 1024.0f) + 1e-6f) : 0.f;
                const f32x4 a0 = acc[ai][0][m][0] * rs, a1 = acc[ai][0][m][1] * rs, b0 = acc[ai][1][m][0] * rs, b1 = acc[ai][1][m][1] * rs;
                float v[8];
#pragma unroll
                for (int k = 0; k < 4; ++k) { v[k] = g * silu_mul(a0[k], b0[k]); v[4 + k] = g * silu_mul(a1[k], b1[k]); }
                u32x4 w; w.x = cvt_pk_bf16(v[0], v[1]); w.y = cvt_pk_bf16(v[2], v[3]); w.z = cvt_pk_bf16(v[4], v[5]); w.w = cvt_pk_bf16(v[6], v[7]);
                *(u32x4*)(O + (size_t)row * ldc + col0) = w; }
    }
};
struct EpiResB {
    static constexpr bool PERM = true; typedef f32x4 acc_t;
    const bf16_t* Rin; bf16_t* Rout; int ldc; const int* rowmap; unsigned long long* rss_out;
    __device__ __forceinline__ void operator()(const f32x4 (&acc)[2][2][4][2], const Unit& u, int wr, int wc, int fr, int fq) const {
        const int row0 = u.pm * BM + wr * 64 + fr, col0 = u.pn * BM + wc * 32 + 8 * fq;
#pragma unroll
        for (int ai = 0; ai < 2; ++ai)
#pragma unroll
            for (int m = 0; m < 4; ++m) {
                const int row = row0 + ai * HALF + m * 16; const int orow = rowmap ? rowmap[row] : row; float ss = 0.f;
                if (orow >= 0) { const bf16_t* rp = Rin + (size_t)orow * ldc + col0; bf16_t* wp = Rout + (size_t)orow * ldc + col0;
#pragma unroll
                    for (int bj = 0; bj < 2; ++bj) { const u32x4 w = *(const u32x4*)(rp + bj * HALF); const f32x4 a0 = acc[ai][bj][m][0], a1 = acc[ai][bj][m][1];
                        float v[8];
                        v[0] = __uint_as_float(w.x << 16) + a0[0]; v[1] = __uint_as_float(w.x & 0xffff0000u) + a0[1]; v[2] = __uint_as_float(w.y << 16) + a0[2]; v[3] = __uint_as_float(w.y & 0xffff0000u) + a0[3];
                        v[4] = __uint_as_float(w.z << 16) + a1[0]; v[5] = __uint_as_float(w.z & 0xffff0000u) + a1[1]; v[6] = __uint_as_float(w.w << 16) + a1[2]; v[7] = __uint_as_float(w.w & 0xffff0000u) + a1[3];
#pragma unroll
                        for (int k = 0; k < 8; ++k) ss += v[k] * v[k];
                        u32x4 o; o.x = cvt_pk_bf16(v[0], v[1]); o.y = cvt_pk_bf16(v[2], v[3]); o.z = cvt_pk_bf16(v[4], v[5]); o.w = cvt_pk_bf16(v[6], v[7]);
                        *(u32x4*)(wp + bj * HALF) = o; } }
                if (rss_out) { ss += __shfl_xor(ss, 16); ss += __shfl_xor(ss, 32);
                    if (fq == 0) __hip_atomic_fetch_add(rss_out + orow, (unsigned long long)(ss * 16777216.0f), __ATOMIC_RELAXED, __HIP_MEMORY_SCOPE_AGENT); }
                if (m & 1) asm volatile("" ::: "memory"); }
    }
};

typedef int i32x4_e __attribute__((ext_vector_type(4)));
struct EpiSwiGLUQ {
    static constexpr bool PERM = true; typedef i32x4_e acc_t;
    signed char* O; int ldc; const float* sa; const unsigned* cm; const int* rowmap; const PG8_LAS int* cum; float qmul;
    __device__ __forceinline__ void operator()(const i32x4_e (&acc)[2][2][4][2], const Unit& u, int wr, int wc, int fr, int fq) const {
        int e = 0;
#pragma unroll
        for (int k = 1; k < 8; ++k) e += (u.pm >= cum[k]) ? 1 : 0;
        const unsigned* cme = cm + (size_t)e * 7168 + u.pn * BM + wc * 32 + 8 * fq;
        float sbA[8], sbB[8];
#pragma unroll
        for (int k = 0; k < 8; ++k) { sbA[k] = __uint_as_float(cme[k]) * (1.0f / 127.0f); sbB[k] = __uint_as_float(cme[HALF + k]) * (1.0f / 127.0f); }
        const int row0 = u.pm * BM + wr * 64 + fr, col0 = u.pn * HALF + wc * 32 + 8 * fq;
#pragma unroll
        for (int ai = 0; ai < 2; ++ai)
#pragma unroll
            for (int m = 0; m < 4; ++m) {
                const int row = row0 + ai * HALF + m * 16; const int trow = rowmap[row]; const float s = trow >= 0 ? sa[trow] : 0.f;
                const i32x4_e a0 = acc[ai][0][m][0], a1 = acc[ai][0][m][1], b0 = acc[ai][1][m][0], b1 = acc[ai][1][m][1];
                int q[8];
#pragma unroll
                for (int k = 0; k < 4; ++k) {
                    const float va = (float)a0[k] * s * sbA[k], vb = (float)b0[k] * s * sbB[k], vc = (float)a1[k] * s * sbA[4 + k], vd = (float)b1[k] * s * sbB[4 + k];
                    float u0 = silu_mul(va, vb) * qmul, u1 = silu_mul(vc, vd) * qmul;
                    u0 = fminf(fmaxf(u0, -127.f), 127.f); u1 = fminf(fmaxf(u1, -127.f), 127.f);
                    q[k] = (int)__builtin_rintf(u0); q[4 + k] = (int)__builtin_rintf(u1); }
                unsigned lo = (unsigned)(q[0] & 255) | ((unsigned)(q[1] & 255) << 8) | ((unsigned)(q[2] & 255) << 16) | ((unsigned)(q[3] & 255) << 24);
                unsigned hi = (unsigned)(q[4] & 255) | ((unsigned)(q[5] & 255) << 8) | ((unsigned)(q[6] & 255) << 16) | ((unsigned)(q[7] & 255) << 24);
                *(unsigned long long*)(O + (size_t)row * ldc + col0) = (unsigned long long)lo | ((unsigned long long)hi << 32); }
    }
};
struct EpiResBQ {
    static constexpr bool PERM = true; typedef i32x4_e acc_t;
    const bf16_t* Rin; bf16_t* Rout; int ldc; const int* rowmap; const float* gate; const unsigned* cm; const PG8_LAS int* cum; float dq;
    __device__ __forceinline__ void operator()(const i32x4_e (&acc)[2][2][4][2], const Unit& u, int wr, int wc, int fr, int fq) const {
        int e = 0;
#pragma unroll
        for (int k = 1; k < 8; ++k) e += (u.pm >= cum[k]) ? 1 : 0;
        const int row0 = u.pm * BM + wr * 64 + fr, col0 = u.pn * BM + wc * 32 + 8 * fq;
        const unsigned* cme = cm + (size_t)e * 1024 + col0;
        float sb[2][8];
#pragma unroll
        for (int bj = 0; bj < 2; ++bj)
#pragma unroll
            for (int k = 0; k < 8; ++k) sb[bj][k] = __uint_as_float(cme[bj * HALF + k]) * (dq / 127.0f);
#pragma unroll
        for (int ai = 0; ai < 2; ++ai)
#pragma unroll
            for (int m = 0; m < 4; ++m) {
                const int row = row0 + ai * HALF + m * 16; const int orow = rowmap[row];
                if (orow >= 0) { const float gt = gate[row]; const bf16_t* rp = Rin + (size_t)orow * ldc + col0; bf16_t* wp = Rout + (size_t)orow * ldc + col0;
#pragma unroll
                    for (int bj = 0; bj < 2; ++bj) { const u32x4 w = *(const u32x4*)(rp + bj * HALF); const i32x4_e a0 = acc[ai][bj][m][0], a1 = acc[ai][bj][m][1];
                        float v[8];
                        v[0] = __uint_as_float(w.x << 16) + (float)a0[0] * gt * sb[bj][0]; v[1] = __uint_as_float(w.x & 0xffff0000u) + (float)a0[1] * gt * sb[bj][1];
                        v[2] = __uint_as_float(w.y << 16) + (float)a0[2] * gt * sb[bj][2]; v[3] = __uint_as_float(w.y & 0xffff0000u) + (float)a0[3] * gt * sb[bj][3];
                        v[4] = __uint_as_float(w.z << 16) + (float)a1[0] * gt * sb[bj][4]; v[5] = __uint_as_float(w.z & 0xffff0000u) + (float)a1[1] * gt * sb[bj][5];
                        v[6] = __uint_as_float(w.w << 16) + (float)a1[2] * gt * sb[bj][6]; v[7] = __uint_as_float(w.w & 0xffff0000u) + (float)a1[3] * gt * sb[bj][7];
                        u32x4 o; o.x = cvt_pk_bf16(v[0], v[1]); o.y = cvt_pk_bf16(v[2], v[3]); o.z = cvt_pk_bf16(v[4], v[5]); o.w = cvt_pk_bf16(v[6], v[7]);
                        *(u32x4*)(wp + bj * HALF) = o; } }
                if (m & 1) asm volatile("" ::: "memory"); }
    }
};
typedef int i32x4 __attribute__((ext_vector_type(4)));
__device__ __forceinline__ f32x4 mma16(bf16x8 a, bf16x8 b, f32x4 c) { return __builtin_amdgcn_mfma_f32_16x16x32_bf16(a, b, c, 0, 0, 0); }
__device__ __forceinline__ i32x4 mma16(bf16x8 a, bf16x8 b, i32x4 c) { return __builtin_amdgcn_mfma_i32_16x16x64_i8(__builtin_bit_cast(i32x4, a), __builtin_bit_cast(i32x4, b), c, 0, 0, 0); }
template <class Epi, class AB>
__device__ __forceinline__ void gemm_phase(PG8_LAS unsigned char* lds, const AB ab, const TileOrder& S, const Epi& E) {
    const int tid = threadIdx.x, wid = __builtin_amdgcn_readfirstlane(tid >> 6), lane = tid & 63, wr = wid >> 2, wc = wid & 3, fr = lane & 15, fq = lane >> 4;
    const int K = ab.K, nt = K / BK;
    int Rr[2], Cc[2]; unsigned voffB[2];
#pragma unroll
    for (int i = 0; i < 2; ++i) { int R, C; stage_rc(tid * 16 + i * 8192, R, C); const int Rb = Epi::PERM ? ((R & ~31) + perm32(R & 31)) : R;
        Rr[i] = R; Cc[i] = C; voffB[i] = (unsigned)(Rb * K + C) * 2u; }
    const size_t kstep = (size_t)(BK * 2);
    const size_t hstep = (size_t)HALF * K * 2;
    const unsigned ldsw = (unsigned)wid * 1024u;
    const int aoff = lds_byte(wr * 64 + fr, fq * 8), boff = lds_byte(wc * 32 + fr, fq * 8);
#define PG8_SA(b, h) (((b) * 2 + (h)) * HTB)
#define PG8_SB(b, h) ((4 + (b) * 2 + (h)) * HTB)
#define PG8_STAGE(bufoff, gbase, voff) do { _Pragma("unroll") for (int _i = 0; _i < 2; ++_i) \
        __builtin_amdgcn_global_load_lds((const unsigned*)((const char*)(gbase) + (voff)[_i]), (PG8_LAS unsigned*)(lds + (bufoff) + ldsw + _i * 8192), 16, 0, 0); } while (0)
#define PG8_LDA(dst, b, h) do { _Pragma("unroll") for (int m = 0; m < 4; ++m) _Pragma("unroll") for (int k = 0; k < 2; ++k) dst[m][k] = *(const PG8_LAS bf16x8*)(lds + PG8_SA(b, h) + aoff + m * 2048 + k * 1024); } while (0)
#define PG8_LDB(dst, b, h) do { _Pragma("unroll") for (int n = 0; n < 2; ++n) _Pragma("unroll") for (int k = 0; k < 2; ++k) dst[n][k] = *(const PG8_LAS bf16x8*)(lds + PG8_SB(b, h) + boff + n * 2048 + k * 1024); } while (0)
#define PG8_MMA(ai, bj, At, Bt) do { __builtin_amdgcn_s_setprio(1); _Pragma("unroll") for (int m = 0; m < 4; ++m) _Pragma("unroll") for (int n = 0; n < 2; ++n) _Pragma("unroll") for (int k = 0; k < 2; ++k) \
        acc[ai][bj][m][n] = mma16(Bt[n][k], At[m][k], acc[ai][bj][m][n]); __builtin_amdgcn_s_setprio(0); } while (0)
#define PG8_WAIT_V(n) asm volatile("s_waitcnt vmcnt(" #n ")" ::: "memory")
#define PG8_WAIT_L(n) asm volatile("s_waitcnt lgkmcnt(" #n ")" ::: "memory")
#define PG8_BAR __builtin_amdgcn_s_barrier()
#define PG8_SCHED __builtin_amdgcn_sched_barrier(0)
    Unit cur, nxt; int ui = 0;
    if (!S.next(0, cur)) return;
    typedef typename Epi::acc_t acc_t;
    acc_t acc[2][2][4][2];
#pragma unroll
    for (int a = 0; a < 2; ++a)
#pragma unroll
        for (int b = 0; b < 2; ++b)
#pragma unroll
            for (int m = 0; m < 4; ++m)
#pragma unroll
                for (int n = 0; n < 2; ++n) acc[a][b][m][n] = (acc_t){0, 0, 0, 0};
    bf16x8 At[4][2], B0[2][2], B1[2][2];
    unsigned cv0[2], cv1[2], nv0[2], nv1[2]; int ntok[4] = {0, 0, 0, 0};
    if constexpr (AB::GATHER) { const int* tp = ab.tokp(cur);
#pragma unroll
        for (int i = 0; i < 2; ++i) { int t0 = tp[Rr[i]], t1 = tp[HALF + Rr[i]]; t0 = t0 < 0 ? 0 : t0; t1 = t1 < 0 ? 0 : t1;
            cv0[i] = (unsigned)(t0 * K + Cc[i]) * 2u; cv1[i] = (unsigned)(t1 * K + Cc[i]) * 2u; }
    } else {
#pragma unroll
        for (int i = 0; i < 2; ++i) { cv0[i] = (unsigned)(Rr[i] * K + Cc[i]) * 2u; cv1[i] = cv0[i] + (unsigned)hstep; }
    }
#pragma unroll
    for (int i = 0; i < 2; ++i) { nv0[i] = cv0[i]; nv1[i] = cv1[i]; }
    const char* cA = ab.abase(cur); const char* cB = ab.bbase(cur);
    PG8_STAGE(PG8_SB(0, 0), cB, voffB); PG8_STAGE(PG8_SB(0, 1), cB + hstep, voffB); PG8_STAGE(PG8_SA(0, 0), cA, cv0); PG8_STAGE(PG8_SA(0, 1), cA, cv1);
    if (wr == 1) PG8_BAR;
    PG8_WAIT_V(2); PG8_BAR;
    PG8_STAGE(PG8_SB(1, 0), cB + kstep, voffB); PG8_STAGE(PG8_SA(1, 0), cA + kstep, cv0); PG8_STAGE(PG8_SB(1, 1), cB + hstep + kstep, voffB);
    PG8_WAIT_V(6); PG8_BAR;
    for (;;) {
        const bool has_next = S.next(ui + 1, nxt);
        const char* nA = has_next ? ab.abase(nxt) : cA; const char* nB = has_next ? ab.bbase(nxt) : cB;
        if constexpr (AB::GATHER) {
            if (has_next) { const int* tp = ab.tokp(nxt);
                asm volatile("global_load_dword %0, %1, off" : "=v"(ntok[0]) : "v"(tp + Rr[0]) : "memory");
                asm volatile("global_load_dword %0, %1, off" : "=v"(ntok[1]) : "v"(tp + Rr[1]) : "memory");
                asm volatile("global_load_dword %0, %1, off" : "=v"(ntok[2]) : "v"(tp + HALF + Rr[0]) : "memory");
                asm volatile("global_load_dword %0, %1, off" : "=v"(ntok[3]) : "v"(tp + HALF + Rr[1]) : "memory"); }
        }
        for (int t = 0; t < nt; t += 2) {
            const bool last = (t == nt - 2);
            const char* a1 = cA + (size_t)(t + 1) * kstep;
            const char* a2 = last ? nA : cA + (size_t)(t + 2) * kstep; const char* b2 = last ? nB : cB + (size_t)(t + 2) * kstep;
            const char* a3 = a2 + kstep; const char* b3 = b2 + kstep;
            unsigned x0[2], x1[2];
            if constexpr (AB::GATHER) {
                if (last && has_next) {
                    asm volatile("s_waitcnt vmcnt(6)" : "+v"(ntok[0]), "+v"(ntok[1]), "+v"(ntok[2]), "+v"(ntok[3]) :: "memory");
#pragma unroll
                    for (int i = 0; i < 2; ++i) { int t0 = ntok[i], t1 = ntok[2 + i]; t0 = t0 < 0 ? 0 : t0; t1 = t1 < 0 ? 0 : t1;
                        nv0[i] = (unsigned)(t0 * K + Cc[i]) * 2u; nv1[i] = (unsigned)(t1 * K + Cc[i]) * 2u; }
                }
#pragma unroll
                for (int i = 0; i < 2; ++i) { x0[i] = last ? nv0[i] : cv0[i]; x1[i] = last ? nv1[i] : cv1[i]; }
            } else {
#pragma unroll
                for (int i = 0; i < 2; ++i) { x0[i] = cv0[i]; x1[i] = cv1[i]; }
            }
            PG8_LDB(B0, 0, 0); PG8_LDB(B1, 0, 1); PG8_SCHED; PG8_LDA(At, 0, 0); PG8_STAGE(PG8_SA(1, 1), a1, cv1);
            PG8_WAIT_V(8); PG8_WAIT_L(0); PG8_BAR; PG8_MMA(0, 0, At, B0); PG8_MMA(0, 1, At, B1); PG8_BAR; PG8_SCHED;
            PG8_LDA(At, 0, 1); PG8_STAGE(PG8_SB(0, 0), b2, voffB); PG8_STAGE(PG8_SB(0, 1), b2 + hstep, voffB); PG8_STAGE(PG8_SA(0, 0), a2, x0);
            PG8_WAIT_V(8); PG8_WAIT_L(0); PG8_BAR; PG8_MMA(1, 0, At, B0); PG8_MMA(1, 1, At, B1); PG8_BAR; PG8_SCHED;
            PG8_LDB(B0, 1, 0); PG8_LDB(B1, 1, 1); PG8_SCHED; PG8_LDA(At, 1, 0); PG8_STAGE(PG8_SA(0, 1), a2, x1);
            PG8_WAIT_V(8); PG8_WAIT_L(0); PG8_BAR; PG8_MMA(0, 0, At, B0); PG8_MMA(0, 1, At, B1); PG8_BAR; PG8_SCHED;
            PG8_LDA(At, 1, 1); PG8_STAGE(PG8_SB(1, 0), b3, voffB); PG8_STAGE(PG8_SB(1, 1), b3 + hstep, voffB); PG8_STAGE(PG8_SA(1, 0), a3, x0);
            PG8_WAIT_V(8); PG8_WAIT_L(0); PG8_BAR; PG8_MMA(1, 0, At, B0); PG8_MMA(1, 1, At, B1); PG8_BAR; PG8_SCHED;
        }
        if (wr == 0) PG8_BAR;
        E(acc, cur, wr, wc, fr, fq);
        if (!has_next) break;
#pragma unroll
        for (int a = 0; a < 2; ++a)
#pragma unroll
            for (int b = 0; b < 2; ++b)
#pragma unroll
                for (int m = 0; m < 4; ++m)
#pragma unroll
                    for (int n = 0; n < 2; ++n) acc[a][b][m][n] = (acc_t){0, 0, 0, 0};
        cur = nxt; cA = nA; cB = nB; ++ui;
#pragma unroll
        for (int i = 0; i < 2; ++i) { cv0[i] = nv0[i]; cv1[i] = nv1[i]; }
        if (wr == 1) PG8_BAR;
    }
    PG8_WAIT_V(0);
    PG8_BAR;
#undef PG8_SA
#undef PG8_SB
#undef PG8_STAGE
#undef PG8_LDA
#undef PG8_LDB
#undef PG8_MMA
#undef PG8_WAIT_V
#undef PG8_WAIT_L
#undef PG8_BAR
#undef PG8_SCHED
}
}

namespace moba {
using bf16 = __hip_bfloat16;
using bf16x8 = __attribute__((ext_vector_type(8))) short;
using s16x4  = __attribute__((ext_vector_type(4))) short;
using f32x16 = __attribute__((ext_vector_type(16))) float;
using u32x4  = __attribute__((ext_vector_type(4))) unsigned;
constexpr int D = 128, NW = 8, QBLK = 32, KVBLK = 64, LDK = 3072, NT = 4;
constexpr float THR = 8.f;
constexpr size_t SHM_V = KVBLK * D * 2, SHM_K = KVBLK * D * 2, SHM_ATTN = 2 * SHM_V + 2 * SHM_K + NW * 64 * 4;
#define KSWZ(row, colB) ((row) * 256 + ((colB) ^ (((row) & 7) << 4)))
#define SBAR() __builtin_amdgcn_sched_barrier(0)
__device__ __forceinline__ int crow(int r, int hi) { return (r & 3) + 8 * (r >> 2) + 4 * hi; }
__device__ __forceinline__ unsigned cvtpk(float lo, float hi) { unsigned r; asm volatile("v_cvt_pk_bf16_f32 %0, %1, %2" : "=v"(r) : "v"(lo), "v"(hi)); return r; }
__device__ __forceinline__ void partialSM(f32x16& p0, f32x16& p1, float& m_reg, float& mn, float& alpha) {
  float pmax = p0[0];
#pragma unroll
  for (int r = 1; r < 16; ++r) pmax = fmaxf(pmax, p0[r]);
#pragma unroll
  for (int r = 0; r < 16; ++r) pmax = fmaxf(pmax, p1[r]);
  { auto rr = __builtin_amdgcn_permlane32_swap(__float_as_uint(pmax), __float_as_uint(pmax), false, false);
    pmax = fmaxf(__uint_as_float(rr[0]), __uint_as_float(rr[1])); }
  if (__builtin_expect(__all(pmax - m_reg <= THR), 1)) { mn = m_reg; alpha = 1.f; }
  else { mn = fmaxf(m_reg, pmax); alpha = __builtin_amdgcn_exp2f(m_reg - mn); m_reg = mn; }
#pragma unroll
  for (int r = 0; r < 16; ++r) p0[r] = p0[r] - mn;
#pragma unroll
  for (int r = 0; r < 16; ++r) p1[r] = p1[r] - mn;
#pragma unroll
  for (int r = 0; r < 16; ++r) p0[r] = __builtin_amdgcn_exp2f(p0[r]);
}
__device__ __forceinline__ void finishSM(f32x16& p0, f32x16& p1, float alpha, float& l_reg, bf16x8& pa0, bf16x8& pa1, bf16x8& pa2, bf16x8& pa3) {
#pragma unroll
  for (int r = 0; r < 16; ++r) p1[r] = __builtin_amdgcn_exp2f(p1[r]);
  float ps = 0;
#pragma unroll
  for (int r = 0; r < 16; ++r) ps += p0[r];
#pragma unroll
  for (int r = 0; r < 16; ++r) ps += p1[r];
  { auto rr = __builtin_amdgcn_permlane32_swap(__float_as_uint(ps), __float_as_uint(ps), false, false);
    ps = __uint_as_float(rr[0]) + __uint_as_float(rr[1]); }
  l_reg = l_reg * alpha + ps;
#define PK4(P, BASE, OUT) do { unsigned a0 = cvtpk(P[BASE + 0], P[BASE + 1]), a1 = cvtpk(P[BASE + 2], P[BASE + 3]);   \
    unsigned b0 = cvtpk(P[BASE + 4], P[BASE + 5]), b1 = cvtpk(P[BASE + 6], P[BASE + 7]);                              \
    auto r0 = __builtin_amdgcn_permlane32_swap(a0, b0, false, false); auto r1 = __builtin_amdgcn_permlane32_swap(a1, b1, false, false); \
    u32x4 w = {r0[0], r1[0], r0[1], r1[1]}; OUT = *reinterpret_cast<bf16x8*>(&w); } while (0)
  PK4(p0, 0, pa0); PK4(p0, 8, pa1); PK4(p1, 0, pa2); PK4(p1, 8, pa3);
#undef PK4
}
__device__ __forceinline__ void qkt(f32x16& p0, f32x16& p1, const bf16* Ks, const bf16x8* qr, int r32, int hi) {
  p0 = f32x16{}; p1 = f32x16{};
#pragma unroll
  for (int d0 = 0; d0 < 8; ++d0) { int cb = (d0 * 16 + hi * 8) * 2;
    bf16x8 b0 = *reinterpret_cast<const bf16x8*>((const char*)Ks + KSWZ(r32, cb));
    bf16x8 b1 = *reinterpret_cast<const bf16x8*>((const char*)Ks + KSWZ(32 + r32, cb));
    p0 = __builtin_amdgcn_mfma_f32_32x32x16_bf16(b0, qr[d0], p0, 0, 0, 0);
    p1 = __builtin_amdgcn_mfma_f32_32x32x16_bf16(b1, qr[d0], p1, 0, 0, 0); }
}
__device__ __forceinline__ int v_st(int k, int c) { const int kk = (k & ~0xC) | ((k & 4) << 1) | ((k & 8) >> 1); return ((kk >> 3) * 4 + (c >> 5)) * 512 + ((kk & 7) * 32 + (c & 31)) * 2; }
__device__ __forceinline__ int v_rd_base(int lane) { return ((lane & 3) << 3) | (((lane >> 2) & 3) << 6) | (((lane >> 4) & 1) << 5) | (((lane >> 5) & 1) << 8); }
constexpr int v_rd_off(int d0, int ks, int half) { return d0 * 512 + ks * 4096 + half * 2048; }
template <int OFF> __device__ __forceinline__ s16x4 tr_read(int vb) {
  s16x4 r; asm volatile("ds_read_b64_tr_b16 %0, %1 offset:%2" : "=&v"(r) : "v"(vb), "i"(OFF) : "memory"); return r;
}
template <int D0> __device__ __forceinline__ void pv_one(f32x16& od, int vb, bf16x8 pa0, bf16x8 pa1, bf16x8 pa2, bf16x8 pa3) {
  const s16x4 l0 = tr_read<v_rd_off(D0, 0, 0)>(vb), h0 = tr_read<v_rd_off(D0, 0, 1)>(vb), l1 = tr_read<v_rd_off(D0, 1, 0)>(vb), h1 = tr_read<v_rd_off(D0, 1, 1)>(vb);
  const s16x4 l2 = tr_read<v_rd_off(D0, 2, 0)>(vb), h2 = tr_read<v_rd_off(D0, 2, 1)>(vb), l3 = tr_read<v_rd_off(D0, 3, 0)>(vb), h3 = tr_read<v_rd_off(D0, 3, 1)>(vb);
  asm volatile("s_waitcnt lgkmcnt(0)" ::: "memory"); SBAR();
#define PK(L, H) (bf16x8){L[0], L[1], L[2], L[3], H[0], H[1], H[2], H[3]}
  od = __builtin_amdgcn_mfma_f32_32x32x16_bf16(pa0, PK(l0, h0), od, 0, 0, 0);
  od = __builtin_amdgcn_mfma_f32_32x32x16_bf16(pa1, PK(l1, h1), od, 0, 0, 0);
  od = __builtin_amdgcn_mfma_f32_32x32x16_bf16(pa2, PK(l2, h2), od, 0, 0, 0);
  od = __builtin_amdgcn_mfma_f32_32x32x16_bf16(pa3, PK(l3, h3), od, 0, 0, 0);
#undef PK
}
__device__ __forceinline__ void pv_d0(f32x16* o, int vb, bf16x8 pa0, bf16x8 pa1, bf16x8 pa2, bf16x8 pa3) {
  pv_one<0>(o[0], vb, pa0, pa1, pa2, pa3); pv_one<1>(o[1], vb, pa0, pa1, pa2, pa3); pv_one<2>(o[2], vb, pa0, pa1, pa2, pa3); pv_one<3>(o[3], vb, pa0, pa1, pa2, pa3);
}
__device__ __forceinline__ void cmask(f32x16& p0, f32x16& p1, int tile, int ql, int hi) {
  asm volatile("" : "+v"(ql));
#pragma unroll
  for (int r = 0; r < 16; ++r) { const int kv = 64 * tile + (r & 3) + 8 * (r >> 2) + 4 * hi; if (kv > ql) p0[r] = -1e30f; if (kv + 32 > ql) p1[r] = -1e30f; }
}
__device__ __forceinline__ void moba_unit(const bool OWN, const bf16* qrow, const bf16* __restrict__ Kh, const bf16* __restrict__ Vh, bf16* obase, int ostride, int dst, float* ml, int mli, int ql, char* lds) {
  const int tid = threadIdx.x, wid = tid >> 6, lane = tid & 63, r32 = lane & 31, hi = lane >> 5;
  bf16* V_lds = (bf16*)lds; bf16* K_lds = (bf16*)(lds + 2 * SHM_V);
  float* ws = (float*)(lds + 2 * SHM_V + 2 * SHM_K) + wid * 64; float* li_l = ws; float* al_l = ws + 32;
  float m_reg = -1e30f, l_reg = 0; f32x16 o[4] = {}; bf16x8 qr[8];
  const bf16* Qw = qrow + hi * 8;
#pragma unroll
  for (int d0 = 0; d0 < 8; ++d0) qr[d0] = *reinterpret_cast<const bf16x8*>(Qw + d0 * 16);
  const int sr = tid >> 4, sc = (tid & 15) * 8, vst0 = v_st(sr, sc), vst1 = v_st(32 + sr, sc);
  const int vb0 = (int)(uintptr_t)V_lds + v_rd_base(lane);
  struct { bf16x8 vs0, vs1, ks0, ks1; } sr_[2];
#define SLOAD(i, k0) do { sr_[i].vs0 = *reinterpret_cast<const bf16x8*>(&Vh[(long)((k0) + sr) * LDK + sc]); sr_[i].vs1 = *reinterpret_cast<const bf16x8*>(&Vh[(long)((k0) + 32 + sr) * LDK + sc]); \
    sr_[i].ks0 = *reinterpret_cast<const bf16x8*>(&Kh[(long)((k0) + sr) * LDK + sc]); sr_[i].ks1 = *reinterpret_cast<const bf16x8*>(&Kh[(long)((k0) + 32 + sr) * LDK + sc]); } while (0)
#define SWRITE(b, i) do { *(bf16x8*)((char*)V_lds + (b) * SHM_V + vst0) = sr_[i].vs0;          \
    *(bf16x8*)((char*)V_lds + (b) * SHM_V + vst1) = sr_[i].vs1; int kc = sc * 2;               \
    *(bf16x8*)((char*)K_lds + (b) * SHM_K + KSWZ(sr, kc)) = sr_[i].ks0;                       \
    *(bf16x8*)((char*)K_lds + (b) * SHM_K + KSWZ(32 + sr, kc)) = sr_[i].ks1; } while (0)
#define SWAIT() asm volatile("s_waitcnt vmcnt(4)" ::: "memory")
#define RESC(a) do { if (__any((a) < 1.f)) { if (hi == 0) al_l[r32] = (a); asm volatile("s_waitcnt lgkmcnt(0)" ::: "memory"); \
    _Pragma("unroll") for (int d = 0; d < 4; ++d) _Pragma("unroll") for (int r = 0; r < 16; ++r) o[d][r] *= al_l[crow(r, hi)]; } } while (0)
  f32x16 pA0, pA1, pB0, pB1; float mnA, mnB, alA, alB; bf16x8 pa0, pa1, pa2, pa3;
  constexpr int SE = 0, SO = 1;
  SLOAD(SE, 0); asm volatile("s_waitcnt vmcnt(0)" ::: "memory"); SWRITE(0, SE); __syncthreads();
  qkt(pA0, pA1, K_lds, qr, r32, hi); if (OWN) cmask(pA0, pA1, 0, ql, hi); partialSM(pA0, pA1, m_reg, mnA, alA);
  SLOAD(SO, KVBLK); SLOAD(SE, 2 * KVBLK);
  SWAIT(); SWRITE(1, SO); __syncthreads();
  {
    SBAR(); qkt(pB0, pB1, (bf16*)((char*)K_lds + SHM_K), qr, r32, hi);
    finishSM(pA0, pA1, alA, l_reg, pa0, pa1, pa2, pa3); SBAR();
    SLOAD(SO, 3 * KVBLK); SBAR();
    pv_d0(o, vb0, pa0, pa1, pa2, pa3); if (OWN) cmask(pB0, pB1, 1, ql, hi); partialSM(pB0, pB1, m_reg, mnB, alB);
    __syncthreads(); SWAIT(); SWRITE(0, SE);
    RESC(alB); __syncthreads();
    SBAR(); qkt(pA0, pA1, K_lds, qr, r32, hi);
    finishSM(pB0, pB1, alB, l_reg, pa0, pa1, pa2, pa3); SBAR();
    pv_d0(o, vb0 + (int)SHM_V, pa0, pa1, pa2, pa3); if (OWN) cmask(pA0, pA1, 2, ql, hi); partialSM(pA0, pA1, m_reg, mnA, alA);
    __syncthreads(); asm volatile("s_waitcnt vmcnt(0)" ::: "memory"); SWRITE(1, SO);
    RESC(alA); __syncthreads();
  }
  SBAR(); qkt(pB0, pB1, (bf16*)((char*)K_lds + SHM_K), qr, r32, hi);
  finishSM(pA0, pA1, alA, l_reg, pa0, pa1, pa2, pa3); SBAR();
  pv_d0(o, vb0, pa0, pa1, pa2, pa3); if (OWN) cmask(pB0, pB1, 3, ql, hi); partialSM(pB0, pB1, m_reg, mnB, alB);
  __syncthreads(); RESC(alB);
  finishSM(pB0, pB1, alB, l_reg, pa0, pa1, pa2, pa3); SBAR();
  pv_d0(o, vb0 + (int)SHM_V, pa0, pa1, pa2, pa3);
  if (hi == 0) li_l[r32] = l_reg; asm volatile("s_waitcnt lgkmcnt(0)" ::: "memory");
  float rli[16];
#pragma unroll
  for (int r = 0; r < 16; ++r) rli[r] = __builtin_amdgcn_rcpf(li_l[crow(r, hi)]);
  __syncthreads();
  bf16* stg = (bf16*)lds + wid * 4096;
#pragma unroll
  for (int r = 0; r < 16; ++r) { const int orow = crow(r, hi);
#pragma unroll
    for (int d0 = 0; d0 < 4; ++d0) stg[orow * 128 + d0 * 32 + r32] = __float2bfloat16(o[d0][r] * rli[r]); }
  int* dsto = (int*)al_l;
  if (hi == 0) dsto[r32] = dst;
  asm volatile("s_waitcnt lgkmcnt(0)" ::: "memory");
#pragma unroll
  for (int i = 0; i < 8; ++i) { const int row = i * 4 + (lane >> 4), ch = lane & 15; const int di = dsto[row]; const u32x4 v = *(const u32x4*)(stg + row * 128 + ch * 8);
    if (di >= 0) *(u32x4*)(obase + (size_t)di * ostride + ch * 8) = v; }
  if (hi == 0 && dst >= 0) { ml[2 * (size_t)mli] = m_reg; ml[2 * (size_t)mli + 1] = l_reg; }
  asm volatile("s_waitcnt lgkmcnt(0)" ::: "memory");
  __syncthreads();
#undef SLOAD
#undef SWRITE
#undef SWAIT
#undef RESC
}

#define KSWZ64(row, colB) ((row) * 128 + ((colB) ^ ((((row) >> 1) & 7) << 4)))
constexpr size_t DA_SHM_K = 64 * 64 * 2;
constexpr size_t DA_SHM = 2 * SHM_V + 2 * DA_SHM_K + NW * 64 * 4;
__device__ __forceinline__ void qkt64(f32x16& p0, f32x16& p1, const bf16* Ks, const bf16x8* qr, int r32, int hi) {
  p0 = f32x16{}; p1 = f32x16{};
#pragma unroll
  for (int d0 = 0; d0 < 4; ++d0) { int cb = (d0 * 16 + hi * 8) * 2;
    bf16x8 b0 = *reinterpret_cast<const bf16x8*>((const char*)Ks + KSWZ64(r32, cb));
    bf16x8 b1 = *reinterpret_cast<const bf16x8*>((const char*)Ks + KSWZ64(32 + r32, cb));
    p0 = __builtin_amdgcn_mfma_f32_32x32x16_bf16(b0, qr[d0], p0, 0, 0, 0);
    p1 = __builtin_amdgcn_mfma_f32_32x32x16_bf16(b1, qr[d0], p1, 0, 0, 0); }
}
__device__ __forceinline__ void dattn_unit(const bf16* Qb, const bf16* __restrict__ Kh, const bf16* __restrict__ Vh, bf16* Ob, const int NT, char* lds) {
  const int tid = threadIdx.x, wid = tid >> 6, lane = tid & 63, r32 = lane & 31, hi = lane >> 5;
  bf16* V_lds = (bf16*)lds; bf16* K_lds = (bf16*)(lds + 2 * SHM_V);
  float* ws = (float*)(lds + 2 * SHM_V + 2 * DA_SHM_K) + wid * 64; float* li_l = ws; float* al_l = ws + 32;
  float m_reg = -1e30f, l_reg = 0; f32x16 o[4] = {}; bf16x8 qr[4];
  const bf16* Qw = Qb + (long)(wid * QBLK + r32) * LDK + hi * 8;
#pragma unroll
  for (int d0 = 0; d0 < 4; ++d0) qr[d0] = *reinterpret_cast<const bf16x8*>(Qw + d0 * 16);
  const int sr = tid >> 4, sc = (tid & 15) * 8, vst0 = v_st(sr, sc), vst1 = v_st(32 + sr, sc);
  const int kr = tid >> 3, kc = (tid & 7) * 8, kst = KSWZ64(kr, kc * 2);
  const int vb0 = (int)(uintptr_t)V_lds + v_rd_base(lane);
  const int ql = wid * QBLK + r32;
  struct { bf16x8 vs0, vs1, ks; } sr_[2];
#define SLOAD(i, k0) do { sr_[i].vs0 = *reinterpret_cast<const bf16x8*>(&Vh[(long)((k0) + sr) * LDK + sc]); sr_[i].vs1 = *reinterpret_cast<const bf16x8*>(&Vh[(long)((k0) + 32 + sr) * LDK + sc]); \
    sr_[i].ks = *reinterpret_cast<const bf16x8*>(&Kh[(long)((k0) + kr) * LDK + kc]); } while (0)
#define SWRITE(b, i) do { *(bf16x8*)((char*)V_lds + (b) * SHM_V + vst0) = sr_[i].vs0; *(bf16x8*)((char*)V_lds + (b) * SHM_V + vst1) = sr_[i].vs1; \
    *(bf16x8*)((char*)K_lds + (b) * DA_SHM_K + kst) = sr_[i].ks; } while (0)
#define SWAIT() asm volatile("s_waitcnt vmcnt(3)" ::: "memory")
#define RESC(a) do { if (__any((a) < 1.f)) { if (hi == 0) al_l[r32] = (a); asm volatile("s_waitcnt lgkmcnt(0)" ::: "memory"); \
    _Pragma("unroll") for (int d = 0; d < 4; ++d) _Pragma("unroll") for (int r = 0; r < 16; ++r) o[d][r] *= al_l[crow(r, hi)]; } } while (0)
#define MASK(P0, P1, t) do { if ((t) >= NT - 4) cmask(P0, P1, (t) - (NT - 4), ql, hi); } while (0)
  f32x16 pA0, pA1, pB0, pB1; float mnA, mnB, alA, alB; bf16x8 pa0, pa1, pa2, pa3;
  constexpr int SE = 0, SO = 1;
  SLOAD(SE, 0); asm volatile("s_waitcnt vmcnt(0)" ::: "memory"); SWRITE(0, SE); __syncthreads();
  qkt64(pA0, pA1, K_lds, qr, r32, hi); MASK(pA0, pA1, 0); partialSM(pA0, pA1, m_reg, mnA, alA);
  SLOAD(SO, KVBLK); SLOAD(SE, 2 * KVBLK);
  SWAIT(); SWRITE(1, SO); __syncthreads();
  for (int j = 1; j + 1 < NT; j += 2) {
    SBAR(); qkt64(pB0, pB1, (bf16*)((char*)K_lds + DA_SHM_K), qr, r32, hi);
    finishSM(pA0, pA1, alA, l_reg, pa0, pa1, pa2, pa3); SBAR();
    SLOAD(SO, (j + 2) * KVBLK); SBAR();
    pv_d0(o, vb0, pa0, pa1, pa2, pa3); MASK(pB0, pB1, j); partialSM(pB0, pB1, m_reg, mnB, alB);
    __syncthreads(); SWAIT(); SWRITE(0, SE);
    RESC(alB); __syncthreads();
    SBAR(); qkt64(pA0, pA1, K_lds, qr, r32, hi);
    finishSM(pB0, pB1, alB, l_reg, pa0, pa1, pa2, pa3); SBAR();
    if (j + 3 < NT) SLOAD(SE, (j + 3) * KVBLK); SBAR();
    pv_d0(o, vb0 + (int)SHM_V, pa0, pa1, pa2, pa3); MASK(pA0, pA1, j + 1); partialSM(pA0, pA1, m_reg, mnA, alA);
    __syncthreads(); SWAIT(); SWRITE(1, SO);
    RESC(alA); __syncthreads();
  }
  SBAR(); qkt64(pB0, pB1, (bf16*)((char*)K_lds + DA_SHM_K), qr, r32, hi);
  finishSM(pA0, pA1, alA, l_reg, pa0, pa1, pa2, pa3); SBAR();
  pv_d0(o, vb0, pa0, pa1, pa2, pa3); MASK(pB0, pB1, NT - 1); partialSM(pB0, pB1, m_reg, mnB, alB);
  __syncthreads(); RESC(alB);
  finishSM(pB0, pB1, alB, l_reg, pa0, pa1, pa2, pa3); SBAR();
  pv_d0(o, vb0 + (int)SHM_V, pa0, pa1, pa2, pa3);
  if (hi == 0) li_l[r32] = l_reg; asm volatile("s_waitcnt lgkmcnt(0)" ::: "memory");
  float rli[16];
#pragma unroll
  for (int r = 0; r < 16; ++r) rli[r] = __builtin_amdgcn_rcpf(li_l[crow(r, hi)]);
  __syncthreads();
  bf16* stg = (bf16*)lds + wid * 4096;
#pragma unroll
  for (int r = 0; r < 16; ++r) { const int orow = crow(r, hi);
#pragma unroll
    for (int d0 = 0; d0 < 4; ++d0) stg[orow * 128 + d0 * 32 + r32] = __float2bfloat16(o[d0][r] * rli[r]); }
  asm volatile("s_waitcnt lgkmcnt(0)" ::: "memory");
#pragma unroll
  for (int i = 0; i < 8; ++i) { const int row = i * 4 + (lane >> 4), ch = lane & 15; const u32x4 v = *(const u32x4*)(stg + row * 128 + ch * 8);
    *(u32x4*)(Ob + (size_t)(wid * QBLK + row) * 2048 + ch * 8) = v; }
  asm volatile("s_waitcnt lgkmcnt(0)" ::: "memory");
  __syncthreads();
#undef SLOAD
#undef SWRITE
#undef SWAIT
#undef RESC
#undef MASK
}
struct DaUnit { int bqh; int qb; };
struct DaOrder {
  int vcu, G;
  __device__ __forceinline__ DaOrder(int vcu_, int G_) : vcu(vcu_), G(G_) {}
  __device__ __forceinline__ bool next(int i, DaUnit& u) const {
    if (G == 256) { if (i >= 8) return false; const int s = vcu & 7, ii = i & 3; u.bqh = (i >> 2) * 32 + (vcu >> 3); u.qb = (ii == 0) ? s : (ii == 1) ? 15 - s : (ii == 2) ? 16 + s : 31 - s; return true; }
    const int uu = vcu + i * G; if (uu >= 2048) return false; u.bqh = uu >> 5; u.qb = uu & 31; return true; }
};
template <class Sched> __device__ __forceinline__ void dattn_phase(char* lds, const bf16* QKV, bf16* O, const Sched& S) {
  DaUnit u;
  for (int i = 0; S.next(i, u); ++i) { const int b = u.bqh >> 4, qh = u.bqh & 15; const size_t rb = (size_t)b * 8192;
    dattn_unit(QKV + (rb + u.qb * 256) * LDK + qh * 64, QKV + rb * LDK + 1024 + qh * 64, QKV + rb * LDK + 2048 + (qh >> 1) * 128, O + (rb + u.qb * 256) * 2048 + qh * 128, 4 * (u.qb + 1), lds); }
}
#undef KSWZ64
#undef KSWZ
#undef SBAR
}
#define GAS __attribute__((address_space(1)))
#define LAS __attribute__((address_space(3)))
typedef unsigned short bf16;
typedef unsigned v4u __attribute__((ext_vector_type(4)));
typedef float f32x4 __attribute__((ext_vector_type(4)));
typedef short bf16x8 __attribute__((ext_vector_type(8)));
typedef GAS unsigned gu32;
typedef GAS unsigned long long gu64;
#define RLX_AGENT __ATOMIC_RELAXED, __HIP_MEMORY_SCOPE_AGENT
#define LDS_WAIT() asm volatile("s_waitcnt lgkmcnt(0)" ::: "memory")
#define VM_WAIT() asm volatile("s_waitcnt vmcnt(0)" ::: "memory")
__device__ __forceinline__ unsigned long long rt() { return __builtin_amdgcn_s_memrealtime(); }
__device__ __forceinline__ unsigned f2bf(float f) { unsigned u = __builtin_bit_cast(unsigned, f); return (u + 0x7fffu + ((u >> 16) & 1u)) >> 16; }
__device__ __forceinline__ unsigned pk2(float lo, float hi) { return f2bf(lo) | (f2bf(hi) << 16); }
#define XB_TMO      128
#define XB_XCNT(j)  (256  + 64 * (j))
#define XB_XSUB(j)  (1280 + 64 * (j))
#define XB_XGEN(j)  (2304 + 64 * (j))
#define XB_TOP      3328
#define XB_TOPGEN   3392
#define XCD_BAR_WORDS 3456
#define XB_SPIN_CAP (1u << 18)

__device__ __forceinline__ unsigned xb_ld(unsigned* p)              { return __hip_atomic_load(p, __ATOMIC_RELAXED, __HIP_MEMORY_SCOPE_AGENT); }
__device__ __forceinline__ unsigned xb_add(unsigned* p, unsigned v) { return __hip_atomic_fetch_add(p, v, __ATOMIC_RELAXED, __HIP_MEMORY_SCOPE_AGENT); }
__device__ __forceinline__ unsigned xb_xcc_id() { return (unsigned)__builtin_amdgcn_s_getreg((3 << 11) | 20) & 0xFu; }
#define XB_SPIN(cond, bar) do { unsigned _sp = 0; while (cond) { __builtin_amdgcn_s_sleep(1); \
    if ((++_sp & 255u) == 0u) { if (xb_ld(&(bar)[XB_TMO])) break; if (_sp > XB_SPIN_CAP) { atomicAdd(&(bar)[XB_TMO], 1u); break; } } } } while (0)

struct XcdBarrier {
    unsigned* bar; unsigned x;
    volatile LAS unsigned* st;
};

__device__ __forceinline__ XcdBarrier xcd_barrier_post(unsigned* bar, volatile LAS unsigned* st) {
    XcdBarrier b; b.bar = bar; b.x = xb_xcc_id(); b.st = st;
    if (threadIdx.x == 0) (void)xb_add(&bar[XB_XCNT(b.x)], 1u);
    return b;
}
__device__ __forceinline__ void xcd_barrier_complete(unsigned* bar, unsigned x, unsigned& nloc, unsigned& nx) {
    const unsigned G = gridDim.x * gridDim.y * gridDim.z;
    unsigned sum, cnt, mine, sp = 0u;
    for (;;) {
        sum = 0u; cnt = 0u; mine = 0u;
#pragma unroll
        for (unsigned j = 0; j < 16; ++j) { const unsigned c = xb_ld(&bar[XB_XCNT(j)]); sum += c; cnt += (c > 0u) ? 1u : 0u; mine = (j == x) ? c : mine; }
        if (sum == G) break;
        __builtin_amdgcn_s_sleep(1);
        if ((++sp & 255u) == 0u) { if (xb_ld(&bar[XB_TMO])) break; if (sp > XB_SPIN_CAP) { atomicAdd(&bar[XB_TMO], 1u); break; } }
    }
    nloc = mine > 0u ? mine : 1u; nx = cnt > 0u ? cnt : 1u;
}

__device__ __forceinline__ void xcd_barrier(const XcdBarrier& b) {
    asm volatile("s_waitcnt vmcnt(0)" ::: "memory");
    __syncthreads();
    if (threadIdx.x == 0) {
        unsigned* bar = b.bar;
        __builtin_amdgcn_s_waitcnt(0);
        unsigned nloc = b.st[0], nx = b.st[1];
        if (nloc == 0u) { xcd_barrier_complete(bar, b.x, nloc, nx); b.st[0] = nloc; b.st[1] = nx; }
        const unsigned old = xb_add(&bar[XB_XSUB(b.x)], 1u);
        const unsigned gen = old / nloc;
        if (old + 1u == (gen + 1u) * nloc) {
            __builtin_amdgcn_fence(__ATOMIC_RELEASE, "agent");
            asm volatile("s_waitcnt vmcnt(0)" ::: "memory");
            const unsigned og = xb_add(&bar[XB_TOP], 1u);
            const unsigned tg = og / nx;
            if (og + 1u == (tg + 1u) * nx) xb_add(&bar[XB_TOPGEN], 1u);
            else XB_SPIN(xb_ld(&bar[XB_TOPGEN]) == tg, bar);
            __builtin_amdgcn_fence(__ATOMIC_ACQUIRE, "agent");
            xb_add(&bar[XB_XGEN(b.x)], 1u);
            asm volatile("s_waitcnt vmcnt(0)" ::: "memory");
        } else {
            XB_SPIN(xb_ld(&bar[XB_XGEN(b.x)]) == gen, bar);
            __builtin_amdgcn_fence(__ATOMIC_ACQUIRE, "agent");
            asm volatile("s_waitcnt vmcnt(0)" ::: "memory");
        }
    }
    __syncthreads();
}

constexpr int NWAVES = 8;
#ifndef MK_PER_PHASE
#define MK_PER_PHASE 0
#endif
constexpr int BATCH = 4, SEQ = 8192, DM = 1024, TOK = BATCH * SEQ;
constexpr int FF0 = 2816, NEXP = 8, FF1 = 3584;
constexpr int NQKV = 3072;
constexpr int MB_H = 8, MB_NB = 32, MB_L = 256;
constexpr int SLOTS = TOK + NEXP * 256;
constexpr float NORM_EPS = 1e-6f, SUBLN_EPS = 1e-5f;
constexpr float LAMBDA_INIT0 = 0.2f;
constexpr float LOG2E = 1.4426950408889634f;
constexpr int LIST_PER_BH = 256 * 496;
__host__ __device__ constexpr int list_off(int j) { return 256 * (31 * j - (j * (j - 1)) / 2); }

constexpr size_t MiB = 1u << 20;
constexpr size_t WS_CTL = 0, CTL_ZERO_BYTES = 3 * MiB;
constexpr size_t WS_CMAX13 = 2 * MiB;
constexpr size_t WS_CMAX2 = WS_CMAX13 + 256 * 1024;
constexpr size_t WS_SSTOT = WS_CMAX2 + 64 * 1024;
constexpr size_t WS_ROPE64 = 3 * MiB;
constexpr size_t WS_ROPE128 = WS_ROPE64 + 512 * 1024;
constexpr size_t WS_KMEAN = WS_ROPE128 + 1 * MiB;
constexpr size_t WS_TOK = 5 * MiB;
constexpr size_t WS_SLOT = 6 * MiB;
constexpr size_t WS_SA = 7 * MiB;
constexpr size_t WS_OWNML = 41 * MiB;
constexpr size_t WS_W0QKV = 8 * MiB, WS_W0O = 14 * MiB, WS_W013 = 16 * MiB, WS_W02 = 27 * MiB, WS_W1QKV = 33 * MiB, WS_W1O = 39 * MiB;
constexpr size_t B0 = 43 * MiB;
constexpr size_t WS_H = B0;
constexpr size_t WS_QKV = B0 + 64 * MiB;
constexpr size_t WS_OATT = B0 + 256 * MiB;
constexpr size_t WS_UD = B0 + 128 * MiB;
constexpr size_t WS_LIST = B0 + 256 * MiB;
constexpr size_t WS_PML = B0 + 272 * MiB;
constexpr size_t WS_PO = B0 + 280 * MiB;
constexpr size_t WS_WM13 = B0 + 64 * MiB;
constexpr size_t WS_WM2 = WS_WM13 + 56 * MiB;
constexpr size_t WS_AQ = WS_WM2 + 28 * MiB;
constexpr size_t WS_UM = B0 + 232 * MiB;
constexpr size_t WS_END = WS_PO + (size_t)TOK * MB_H * 3 * 128 * 2;
static_assert(WS_UM + (size_t)SLOTS * FF1 <= WS_END && WS_AQ + (size_t)TOK * DM <= WS_UM && WS_END <= 528 * MiB, "d_ws map");
constexpr int CW_TMO = 0, CW_CODE = 1, CW_DBG = 2;
constexpr int CW_MOECNT = 64;
constexpr int CW_MOBACNT = 256;
constexpr int CW_BAR = 4096;
constexpr size_t WS_RSS = 1 * MiB;
constexpr int RING_OFF = 0, RING_BYTES = 131072;
constexpr int LDSCTL_OFF = RING_BYTES, MISC_OFF = LDSCTL_OFF + 320;
constexpr int LDS_BYTES = 147456;

struct Args { const float* in[20]; float* out; unsigned char* ws; float inv64[8]; float inv128[16]; int ph_lo, ph_hi; };

__device__ __forceinline__ float wave_sum(float v) {
#pragma unroll
    for (int o = 1; o < 64; o <<= 1) v += __shfl_xor(v, o);
    return v;
}
template <int MAP> __device__ __forceinline__ int maprow(int n) {
    if (MAP == 1) { if (n >= 2048) return n; const int d = n & 63; if (d >= 16) return n; const int b = d >> 3, a = (d >> 2) & 1, c = d & 3; return (n & ~63) + 8 * a + 4 * b + c; }
    if (MAP == 2) { if (n >= 2048) return n; const int d = n & 127; if (d >= 32) return n; const int b = d >> 4, a = (d >> 2) & 3, c = d & 3; return (n & ~127) + 8 * a + 4 * b + c; }
    if (MAP == 3) return 256 * (n >> 7) + (n & 127);
    if (MAP == 4) return 256 * (n >> 7) + 128 + (n & 127);
    return n;
}
template <int MAP> __device__ __forceinline__ void transpose_item(const float* W, int K, int N, bf16* WT, LAS float* scr, int item, int lane, const float* gk = nullptr) {
    const int nblk = N / 32, kb = item / nblk, nb = item % nblk, k0 = 64 * kb, n0 = 32 * nb;
    const int kr = lane >> 3, nc = (lane & 7) * 4;
    f32x4 v[8];
#pragma unroll
    for (int i = 0; i < 8; ++i) v[i] = *(const GAS f32x4*)(W + (size_t)(k0 + i * 8 + kr) * N + n0 + nc);
    if (gk) {
#pragma unroll
        for (int i = 0; i < 8; ++i) v[i] = v[i] * gk[k0 + i * 8 + kr]; }
#pragma unroll
    for (int i = 0; i < 8; ++i) { LAS float* d = scr + (i * 8 + kr) * 33 + nc; d[0] = v[i].x; d[1] = v[i].y; d[2] = v[i].z; d[3] = v[i].w; }
    LDS_WAIT(); asm volatile("" ::: "memory");
    const int c = lane & 7;
#pragma unroll
    for (int j = 0; j < 4; ++j) { const int n = (lane >> 3) + 8 * j; const LAS float* s = scr + (8 * c) * 33 + n;
        v4u o; o.x = pk2(s[0 * 33], s[1 * 33]); o.y = pk2(s[2 * 33], s[3 * 33]); o.z = pk2(s[4 * 33], s[5 * 33]); o.w = pk2(s[6 * 33], s[7 * 33]);
        *(GAS v4u*)(WT + (size_t)maprow<MAP>(n0 + n) * K + k0 + 8 * c) = o; }
    LDS_WAIT(); asm volatile("" ::: "memory");
}

template <int MAP> __device__ __forceinline__ float wmax_strip(const float* W, int N, unsigned* cmax, int kb0, int nkb, int nb, int lane, const float* gk) {
    const int n0 = 32 * nb, kr = lane >> 3, nc = (lane & 7) * 4;
    f32x4 mx = (f32x4){0.f, 0.f, 0.f, 0.f}; float ss = 0.f;
    for (int kb = kb0; kb < kb0 + nkb; ++kb) { const int k0 = 64 * kb;
        f32x4 v[8];
#pragma unroll
        for (int i = 0; i < 8; ++i) v[i] = *(const GAS f32x4*)(W + (size_t)(k0 + i * 8 + kr) * N + n0 + nc);
        if (gk) {
#pragma unroll
            for (int i = 0; i < 8; ++i) v[i] = v[i] * gk[k0 + i * 8 + kr]; }
#pragma unroll
        for (int i = 0; i < 8; ++i) { mx.x = fmaxf(mx.x, fabsf(v[i].x)); mx.y = fmaxf(mx.y, fabsf(v[i].y)); mx.z = fmaxf(mx.z, fabsf(v[i].z)); mx.w = fmaxf(mx.w, fabsf(v[i].w));
            ss += (v[i].x * v[i].x + v[i].y * v[i].y) + (v[i].z * v[i].z + v[i].w * v[i].w); } }
#pragma unroll
    for (int o = 8; o < 64; o <<= 1) { mx.x = fmaxf(mx.x, __shfl_xor(mx.x, o)); mx.y = fmaxf(mx.y, __shfl_xor(mx.y, o)); mx.z = fmaxf(mx.z, __shfl_xor(mx.z, o)); mx.w = fmaxf(mx.w, __shfl_xor(mx.w, o)); }
    if (lane < 8) {
        __hip_atomic_fetch_max(cmax + maprow<MAP>(n0 + nc + 0), __float_as_uint(mx.x), __ATOMIC_RELAXED, __HIP_MEMORY_SCOPE_AGENT);
        __hip_atomic_fetch_max(cmax + maprow<MAP>(n0 + nc + 1), __float_as_uint(mx.y), __ATOMIC_RELAXED, __HIP_MEMORY_SCOPE_AGENT);
        __hip_atomic_fetch_max(cmax + maprow<MAP>(n0 + nc + 2), __float_as_uint(mx.z), __ATOMIC_RELAXED, __HIP_MEMORY_SCOPE_AGENT);
        __hip_atomic_fetch_max(cmax + maprow<MAP>(n0 + nc + 3), __float_as_uint(mx.w), __ATOMIC_RELAXED, __HIP_MEMORY_SCOPE_AGENT); }
    return ss;
}
template <int MAP> __device__ __forceinline__ void transpose_item_q(const float* W, int K, int N, signed char* WT, const unsigned* cmax, LAS float* scr, int item, int lane, const float* gk) {
    const int nblk = N / 32, kb = item / nblk, nb = item % nblk, k0 = 64 * kb, n0 = 32 * nb;
    const int kr = lane >> 3, nc = (lane & 7) * 4;
    f32x4 v[8];
#pragma unroll
    for (int i = 0; i < 8; ++i) v[i] = *(const GAS f32x4*)(W + (size_t)(k0 + i * 8 + kr) * N + n0 + nc);
    if (gk) {
#pragma unroll
        for (int i = 0; i < 8; ++i) v[i] = v[i] * gk[k0 + i * 8 + kr]; }
#pragma unroll
    for (int i = 0; i < 8; ++i) { LAS float* d = scr + (i * 8 + kr) * 33 + nc; d[0] = v[i].x; d[1] = v[i].y; d[2] = v[i].z; d[3] = v[i].w; }
    LDS_WAIT(); asm volatile("" ::: "memory");
    const int half = lane >> 5, n = lane & 31, row = maprow<MAP>(n0 + n);
    const float cm = __uint_as_float(cmax[row]); const float inv = cm > 0.f ? 127.0f / cm : 0.f;
    const LAS float* s = scr + (32 * half) * 33 + n;
    unsigned w[8];
#pragma unroll
    for (int q4 = 0; q4 < 8; ++q4) { unsigned pk = 0;
#pragma unroll
        for (int b = 0; b < 4; ++b) { const int q = (int)__builtin_rintf(s[(4 * q4 + b) * 33] * inv); pk |= (unsigned)(q & 255) << (8 * b); }
        w[q4] = pk; }
    GAS v4u* dst = (GAS v4u*)(WT + (size_t)row * K + k0 + 32 * half);
    dst[0] = (v4u){w[0], w[1], w[2], w[3]}; dst[1] = (v4u){w[4], w[5], w[6], w[7]};
    LDS_WAIT(); asm volatile("" ::: "memory");
}
__device__ __forceinline__ void rms_row(const float* xrow, const f32x4 (&g)[4], f32x4 (&v)[4], int lane) {
    const GAS f32x4* xr = (const GAS f32x4*)xrow + lane; float s = 0.f;
#pragma unroll
    for (int j = 0; j < 4; ++j) { v[j] = xr[64 * j]; s += (v[j].x * v[j].x + v[j].y * v[j].y) + (v[j].z * v[j].z + v[j].w * v[j].w); }
    const float rstd = 1.f / sqrtf(wave_sum(s) * (1.f / DM) + NORM_EPS);
#pragma unroll
    for (int j = 0; j < 4; ++j) v[j] = v[j] * rstd * g[j];
}
__device__ __forceinline__ void store_row_bf16(bf16* orow, const f32x4 (&v)[4], int lane) {
    GAS unsigned long long* o8 = (GAS unsigned long long*)orow + lane;
#pragma unroll
    for (int j = 0; j < 4; ++j) o8[64 * j] = (unsigned long long)pk2(v[j].x, v[j].y) | ((unsigned long long)pk2(v[j].z, v[j].w) << 32);
}
__device__ __forceinline__ void load_gain(const float* g, f32x4 (&gv)[4], int lane) {
#pragma unroll
    for (int j = 0; j < 4; ++j) gv[j] = *((const f32x4*)g + lane + 64 * j);
}
__device__ __forceinline__ void rmsnorm_phase(const float* src, const float* gain, bf16* dst, int gw, int ngw, int lane) {
    f32x4 gv[4]; load_gain(gain, gv, lane);
    for (int m = gw; m < TOK; m += ngw) { f32x4 v[4]; rms_row(src + (size_t)m * DM, gv, v, lane); store_row_bf16(dst + (size_t)m * DM, v, lane); }
}
__device__ __forceinline__ float bf2f(unsigned short b) { return __uint_as_float((unsigned)b << 16); }


typedef __attribute__((address_space(4))) const unsigned char* kaptr_t;
__device__ __forceinline__ kaptr_t ka_get() { kaptr_t p = (kaptr_t)__builtin_amdgcn_kernarg_segment_ptr(); asm volatile("" : "+s"(p)); return p; }
#define KA_IN(k) (*(const float* const __attribute__((address_space(4)))*)(ka + 8 * (k)))
#define PH_PTRS kaptr_t ka = ka_get(); unsigned char* const ws = *(unsigned char* const __attribute__((address_space(4)))*)(ka + 168); float* const out = *(float* const __attribute__((address_space(4)))*)(ka + 160); gu32* const ctl = (gu32*)(ws + WS_CTL); (void)out; (void)ctl
#define IN_X KA_IN(0)
#define norm_mix KA_IN(1)
#define norm_ffn KA_IN(2)
#define final_norm KA_IN(3)
#define da_wqkv KA_IN(4)
#define da_wo KA_IN(5)
#define da_lq1 KA_IN(6)
#define da_lk1 KA_IN(7)
#define da_lq2 KA_IN(8)
#define da_lk2 KA_IN(9)
#define da_subln KA_IN(10)
#define mb_wqkv KA_IN(11)
#define mb_wo KA_IN(12)
#define ffn_w1 KA_IN(13)
#define ffn_w3 KA_IN(14)
#define ffn_w2 KA_IN(15)
#define moe_router KA_IN(16)
#define moe_w1 KA_IN(17)
#define moe_w3 KA_IN(18)
#define moe_w2 KA_IN(19)
#define rope64 ((float*)(ws + WS_ROPE64))
#define rope128 ((float*)(ws + WS_ROPE128))
#define kmean ((float*)(ws + WS_KMEAN))
#define tok_e ((int*)(ws + WS_TOK))
#define tok_pos (tok_e + 2 * TOK)
#define tok_gate ((float*)(tok_pos + 2 * TOK))
#define wg_base ((int*)(ws + WS_TOK + 800 * 1024))
#define slot_tok ((int*)(ws + WS_SLOT))
#define slot_gate ((float*)(slot_tok + 2 * SLOTS))
#define ownml ((float*)(ws + WS_OWNML))
#define W0qkv ((bf16*)(ws + WS_W0QKV))
#define W0o ((bf16*)(ws + WS_W0O))
#define W013 ((bf16*)(ws + WS_W013))
#define W02 ((bf16*)(ws + WS_W02))
#define W1qkv ((bf16*)(ws + WS_W1QKV))
#define W1o ((bf16*)(ws + WS_W1O))
#define Rb ((bf16*)(ws + WS_H))
#define OB ((bf16*)out)
#define RSS(j) ((unsigned long long*)(ws + WS_RSS) + (size_t)(j) * TOK)
#define QKV ((bf16*)(ws + WS_QKV))
#define OATT ((bf16*)(ws + WS_OATT))
#define UD ((bf16*)(ws + WS_UD))
#define lists ((int*)(ws + WS_LIST))
#define pml ((float*)(ws + WS_PML))
#define PO ((bf16*)(ws + WS_PO))
#define WM13 ((signed char*)(ws + WS_WM13))
#define WM2 ((signed char*)(ws + WS_WM2))
#define AQ ((signed char*)(ws + WS_AQ))
#define UM ((signed char*)(ws + WS_UM))
#define CMAX13 ((unsigned*)(ws + WS_CMAX13))
#define CMAX2 ((unsigned*)(ws + WS_CMAX2))
#define SSTOT ((unsigned long long*)(ws + WS_SSTOT))
#define SA ((float*)(ws + WS_SA))
__global__ void __launch_bounds__(NWAVES * 64, 2) mk_fwd(Args args) {
    extern __shared__ __attribute__((aligned(16))) unsigned char lds[];
    LAS unsigned char* L = (LAS unsigned char*)lds;
    volatile LAS unsigned* MISC = (volatile LAS unsigned*)(L + MISC_OFF);
    const int wave = __builtin_amdgcn_readfirstlane((int)threadIdx.x >> 6);
#define tid ((int)threadIdx.x)
#define lane ((int)(threadIdx.x & 63u))
    const int G = gridDim.x; const int bx = blockIdx.x; const int vcu = (G % 8 == 0) ? (bx % 8) * (G / 8) + bx / 8 : bx;
    const int gw = vcu * NWAVES + wave, NGW = G * NWAVES;
    gu32* ctl0 = (gu32*)(args.ws + WS_CTL);
    for (int u = tid; u < (LDS_BYTES - LDSCTL_OFF) / 4; u += NWAVES * 64) ((LAS unsigned*)(L + LDSCTL_OFF))[u] = 0u;
    __syncthreads();
    XcdBarrier bar; bar.bar = (unsigned*)(ctl0 + CW_BAR); bar.x = 0; bar.st = nullptr;
    if (!MK_PER_PHASE) bar = xcd_barrier_post((unsigned*)(ctl0 + CW_BAR), MISC + 8);
#define GRID_BAR() do { if (!MK_PER_PHASE) xcd_barrier(bar); } while (0)
    const int lo = args.ph_lo, hi_ph = args.ph_hi;
#ifndef PH_MASK
#define PH_MASK 0xFFFFFFFFu
#endif
#define IN(k) (((PH_MASK >> (k)) & 1u) && lo <= (k) && (k) < hi_ph)
#define SEAM(k) do { if (IN((k) + 1)) GRID_BAR(); } while (0)
#ifndef DUP_MASK
#define DUP_MASK 0u
#endif
#define NREP(k) ((((DUP_MASK) >> (k)) & 1u) ? 2 : 1)

    if (IN(0)) { PH_PTRS; for (int rep_ = 0; rep_ < NREP(0); ++rep_) {
        LAS float* scr = (LAS float*)(L + RING_OFF + wave * 16384);
        constexpr int I_QKV = (DM / 64) * (NQKV / 32), I_O = (DM / 64) * (DM / 32), I_13 = (DM / 64) * (FF0 / 32), I_2 = (FF0 / 64) * (DM / 32);
        constexpr int NITEMS = 2 * I_QKV + 2 * I_O + 2 * I_13 + I_2;
        for (int it = gw; it < NITEMS; it += NGW) {
            int r = it;
            if (r < I_QKV) { transpose_item<1>(da_wqkv, DM, NQKV, W0qkv, scr, r, lane, norm_mix); continue; } r -= I_QKV;
            if (r < I_QKV) { transpose_item<2>(mb_wqkv, DM, NQKV, W1qkv, scr, r, lane, norm_mix + DM); continue; } r -= I_QKV;
            if (r < I_O) { transpose_item<0>(da_wo, DM, DM, W0o, scr, r, lane); continue; } r -= I_O;
            if (r < I_O) { transpose_item<0>(mb_wo, DM, DM, W1o, scr, r, lane); continue; } r -= I_O;
            if (r < I_13) { transpose_item<3>(ffn_w1, DM, FF0, W013, scr, r, lane, norm_ffn); continue; } r -= I_13;
            if (r < I_13) { transpose_item<4>(ffn_w3, DM, FF0, W013, scr, r, lane, norm_ffn); continue; } r -= I_13;
            transpose_item<0>(ffn_w2, FF0, DM, W02, scr, r, lane);
        }
        {
            const int gt = (vcu * NWAVES + wave) * 64 + lane, NT_ = G * NWAVES * 64;
            for (int e = gt; e < SEQ * 8; e += NT_) { const int pos = e >> 3, i = e & 7; const float ang = (float)pos * (*(const float __attribute__((address_space(4)))*)(ka + 176 + 4 * i)); rope64[e] = cosf(ang); rope64[SEQ * 8 + e] = sinf(ang); }
            for (int e = gt; e < SEQ * 16; e += NT_) { const int pos = e >> 4, i = e & 15; const float ang = (float)pos * (*(const float __attribute__((address_space(4)))*)(ka + 208 + 4 * i)); rope128[e] = cosf(ang); rope128[SEQ * 16 + e] = sinf(ang); }
        }
        for (int m = gw; m < TOK; m += NGW) {
            const GAS f32x4* xr = (const GAS f32x4*)(IN_X + (size_t)m * DM) + lane; f32x4 v[4]; float s = 0.f;
#pragma unroll
            for (int j = 0; j < 4; ++j) { v[j] = xr[64 * j]; s += (v[j].x * v[j].x + v[j].y * v[j].y) + (v[j].z * v[j].z + v[j].w * v[j].w); }
            store_row_bf16(Rb + (size_t)m * DM, v, lane); s = wave_sum(s); if (lane == 0) RSS(0)[m] = (unsigned long long)(s * 16777216.0f); }
        } SEAM(0);
    }
    if (IN(1)) { PH_PTRS; for (int rep_ = 0; rep_ < NREP(1); ++rep_) {
        pg8::ABDense ab{Rb, W0qkv, DM}; pg8::TileOrder S; S.init(TOK / 256, NQKV / 256, G, bx);
        pg8::EpiQKV<64> E{QKV, NQKV, rope64, rope64 + SEQ * 8, 0.125f * LOG2E, RSS(0)};
        pg8::gemm_phase<pg8::EpiQKV<64>, pg8::ABDense>(L + RING_OFF, ab, S, E);
        } SEAM(1);
    }
    if (IN(2)) { PH_PTRS; for (int rep_ = 0; rep_ < NREP(2); ++rep_) {
        const moba::DaOrder AS(vcu, G);
        moba::dattn_phase<moba::DaOrder>((char*)lds + RING_OFF, (const moba::bf16*)QKV, (moba::bf16*)OATT, AS);
        } SEAM(2);
    }
    if (IN(3)) { PH_PTRS; for (int rep_ = 0; rep_ < NREP(3); ++rep_) {
        float lam;
        { const float a = wave_sum(da_lq1[lane] * da_lk1[lane]), b = wave_sum(da_lq2[lane] * da_lk2[lane]); lam = expf(a) - expf(b) + LAMBDA_INIT0; }
        const int hh = lane >> 3, dd = (lane & 7) * 16;
        float gsub[16];
#pragma unroll
        for (int k = 0; k < 16; ++k) gsub[k] = da_subln[dd + k] * (1.f - LAMBDA_INIT0);
        for (int m = gw; m < TOK; m += NGW) {
            const bf16* o1 = OATT + (size_t)m * 2048 + (2 * hh) * 128 + dd; const bf16* o2 = o1 + 128;
            const v4u a0 = *(const GAS v4u*)o1, a1 = *(const GAS v4u*)(o1 + 8), b0 = *(const GAS v4u*)o2, b1 = *(const GAS v4u*)(o2 + 8);
            float d[16]; float ss = 0.f;
#pragma unroll
            for (int k = 0; k < 4; ++k) {
                const unsigned ua = a0[k], ub = b0[k], uc = a1[k], ud = b1[k];
                d[2 * k] = __uint_as_float(ua << 16) - lam * __uint_as_float(ub << 16); d[2 * k + 1] = __uint_as_float(ua & 0xffff0000u) - lam * __uint_as_float(ub & 0xffff0000u);
                d[8 + 2 * k] = __uint_as_float(uc << 16) - lam * __uint_as_float(ud << 16); d[8 + 2 * k + 1] = __uint_as_float(uc & 0xffff0000u) - lam * __uint_as_float(ud & 0xffff0000u); }
#pragma unroll
            for (int k = 0; k < 16; ++k) ss += d[k] * d[k];
            ss += __shfl_xor(ss, 1); ss += __shfl_xor(ss, 2); ss += __shfl_xor(ss, 4);
            const float rstd = 1.f / sqrtf(ss * (1.f / 128.f) + SUBLN_EPS);
            v4u w0, w1;
#pragma unroll
            for (int k = 0; k < 4; ++k) { w0[k] = pk2(d[2 * k] * rstd * gsub[2 * k], d[2 * k + 1] * rstd * gsub[2 * k + 1]); w1[k] = pk2(d[8 + 2 * k] * rstd * gsub[8 + 2 * k], d[8 + 2 * k + 1] * rstd * gsub[8 + 2 * k + 1]); }
            bf16* od = OB + (size_t)m * DM + hh * 128 + dd;
            *(GAS v4u*)od = w0; *(GAS v4u*)(od + 8) = w1;
        }
        } SEAM(3);
    }
    if (IN(4)) { PH_PTRS; for (int rep_ = 0; rep_ < NREP(4); ++rep_) {
        pg8::ABDense ab{OB, W0o, DM}; pg8::TileOrder S; S.init(TOK / 256, DM / 256, G, bx);
        pg8::EpiResB E{Rb, Rb, DM, nullptr, RSS(1)};
        pg8::gemm_phase<pg8::EpiResB, pg8::ABDense>(L + RING_OFF, ab, S, E);
        } SEAM(4);
    }
    if (IN(6)) { PH_PTRS; for (int rep_ = 0; rep_ < NREP(6); ++rep_) {
        pg8::ABDense ab{Rb, W013, DM}; pg8::TileOrder S; S.init(TOK / 256, (2 * FF0) / 256, G, bx);
        pg8::EpiSwiGLU E{UD, FF0, nullptr, RSS(1), nullptr};
        pg8::gemm_phase<pg8::EpiSwiGLU, pg8::ABDense>(L + RING_OFF, ab, S, E);
        } SEAM(6);
    }
    if (IN(7)) { PH_PTRS; for (int rep_ = 0; rep_ < NREP(7); ++rep_) {
        pg8::ABDense ab{UD, W02, FF0}; pg8::TileOrder S; S.init(TOK / 256, DM / 256, G, bx);
        pg8::EpiResB E{Rb, Rb, DM, nullptr, RSS(2)};
        pg8::gemm_phase<pg8::EpiResB, pg8::ABDense>(L + RING_OFF, ab, S, E);
        } SEAM(7);
    }
    if (IN(9)) { PH_PTRS; for (int rep_ = 0; rep_ < NREP(9); ++rep_) {
        pg8::ABDense ab{Rb, W1qkv, DM}; pg8::TileOrder S; S.init(TOK / 256, NQKV / 256, G, bx);
        pg8::EpiQKV<128> E{QKV, NQKV, rope128, rope128 + SEQ * 16, 0.08838834764831845f * LOG2E, RSS(2)};
        pg8::gemm_phase<pg8::EpiQKV<128>, pg8::ABDense>(L + RING_OFF, ab, S, E);
        } SEAM(9);
    }
    if (IN(10)) { PH_PTRS; for (int rep_ = 0; rep_ < NREP(10); ++rep_) {
        LAS float* red = (LAS float*)(L + RING_OFF);
        for (int u = vcu; u < BATCH * MB_H * MB_NB; u += G) {
            const int b = u >> 8, h = (u >> 5) & 7, j = u & 31;
            const int dch = tid & 15, kg = tid >> 4;
            const bf16* kp = QKV + (size_t)(b * SEQ + j * MB_L + kg * 8) * NQKV + 1024 + h * 128 + dch * 8;
            float s[8] = {0.f, 0.f, 0.f, 0.f, 0.f, 0.f, 0.f, 0.f};
#pragma unroll
            for (int k = 0; k < 8; ++k) { const v4u v = *(const GAS v4u*)(kp + (size_t)k * NQKV);
#pragma unroll
                for (int q = 0; q < 4; ++q) { s[2 * q] += __uint_as_float(v[q] << 16); s[2 * q + 1] += __uint_as_float(v[q] & 0xffff0000u); } }
#pragma unroll
            for (int q = 0; q < 8; ++q) red[kg * 128 + dch * 8 + q] = s[q];
            __syncthreads();
            if (tid < 128) { float a = 0.f;
#pragma unroll 8
                for (int k = 0; k < 32; ++k) a += red[k * 128 + tid];
                kmean[(size_t)u * 128 + tid] = a * (1.f / 256.f); }
            __syncthreads();
        }
        } SEAM(10);
    }
    if (IN(11)) { PH_PTRS; for (int rep_ = 0; rep_ < NREP(11); ++rep_) {
        LAS float* km = (LAS float*)(L + RING_OFF);
        LAS float* mv = (LAS float*)(L + RING_OFF + 16384);
        LAS int* mi = (LAS int*)(L + RING_OFF + 16384 + 3072);
        LAS int* lcnt = (LAS int*)(L + RING_OFF + 24576);
        for (int u = vcu; u < BATCH * MB_H * (MB_NB - 1); u += G) {
            const int bh = u / 31, o = 1 + u % 31, b = bh >> 3, h = bh & 7;
            for (int e = tid; e < 32 * 128; e += 512) km[e] = kmean[(size_t)bh * 4096 + e];
            if (tid < 32) lcnt[tid] = 0;
            __syncthreads();
            const int ql = tid & 255, half = tid >> 8; const int s = o * 256 + ql;
            const bf16* qp = QKV + (size_t)(b * SEQ + s) * NQKV + h * 128;
            float qf[128];
#pragma unroll
            for (int c = 0; c < 16; ++c) { const v4u v = *(const GAS v4u*)(qp + c * 8);
#pragma unroll
                for (int q = 0; q < 4; ++q) { qf[c * 8 + 2 * q] = __uint_as_float(v[q] << 16); qf[c * 8 + 2 * q + 1] = __uint_as_float(v[q] & 0xffff0000u); } }
            float v0 = -INFINITY, v1 = -INFINITY, v2 = -INFINITY; int i0 = -1, i1 = -1, i2 = -1;
            for (int jj = 0; jj < 16; ++jj) { const int j = half * 16 + jj;
                if (j < o) { float g = 0.f; const LAS f32x4* kr = (const LAS f32x4*)(km + j * 128);
#pragma unroll
                    for (int c = 0; c < 32; ++c) { const f32x4 kv = kr[c]; g += qf[4 * c] * kv.x + qf[4 * c + 1] * kv.y + qf[4 * c + 2] * kv.z + qf[4 * c + 3] * kv.w; }
                    if (g > v0) { v2 = v1; i2 = i1; v1 = v0; i1 = i0; v0 = g; i0 = j; } else if (g > v1) { v2 = v1; i2 = i1; v1 = g; i1 = j; } else if (g > v2) { v2 = g; i2 = j; } } }
            if (half == 1) { mv[ql * 3] = v0; mv[ql * 3 + 1] = v1; mv[ql * 3 + 2] = v2; mi[ql * 3] = i0; mi[ql * 3 + 1] = i1; mi[ql * 3 + 2] = i2; }
            __syncthreads();
            int lp0 = 0, lp1 = 0, lp2 = 0;
            if (half == 0) {
#pragma unroll
                for (int k = 0; k < 3; ++k) { const float g = mv[ql * 3 + k]; const int j = mi[ql * 3 + k];
                    if (j >= 0) { if (g > v0) { v2 = v1; i2 = i1; v1 = v0; i1 = i0; v0 = g; i0 = j; } else if (g > v1) { v2 = v1; i2 = i1; v1 = g; i1 = j; } else if (g > v2) { v2 = g; i2 = j; } } }
                if (i0 >= 0) lp0 = __hip_atomic_fetch_add(&lcnt[i0], 1, __ATOMIC_RELAXED, __HIP_MEMORY_SCOPE_WORKGROUP);
                if (i1 >= 0) lp1 = __hip_atomic_fetch_add(&lcnt[i1], 1, __ATOMIC_RELAXED, __HIP_MEMORY_SCOPE_WORKGROUP);
                if (i2 >= 0) lp2 = __hip_atomic_fetch_add(&lcnt[i2], 1, __ATOMIC_RELAXED, __HIP_MEMORY_SCOPE_WORKGROUP);
            }
            __syncthreads();
            if (tid < 32 && rep_ == 0) { const int n = lcnt[tid]; lcnt[32 + tid] = n ? (int)__hip_atomic_fetch_add(ctl + CW_MOBACNT + bh * 32 + tid, (unsigned)n, RLX_AGENT) : 0; }
            __syncthreads();
            if (half == 0 && rep_ == 0) { int* lb = lists + (size_t)bh * LIST_PER_BH;
                if (i0 >= 0) lb[list_off(i0) + lcnt[32 + i0] + lp0] = s;
                if (i1 >= 0) lb[list_off(i1) + lcnt[32 + i1] + lp1] = s | (1 << 16);
                if (i2 >= 0) lb[list_off(i2) + lcnt[32 + i2] + lp2] = s | (2 << 16); }
            __syncthreads();
        }
        } SEAM(11);
    }
    if (IN(12)) { PH_PTRS; for (int rep_ = 0; rep_ < NREP(12); ++rep_) {
        LAS int* pre = (LAS int*)(L + 102400);
        { const unsigned c0 = __hip_atomic_load(ctl + CW_MOBACNT + tid, RLX_AGENT), c1 = __hip_atomic_load(ctl + CW_MOBACNT + 512 + tid, RLX_AGENT);
          pre[tid] = (int)((c0 + 255u) >> 8); pre[512 + tid] = (int)((c1 + 255u) >> 8); }
        __syncthreads();
        if (tid == 0) { int a = 0; for (int k = 0; k < 1024; ++k) { const int n = pre[k]; pre[k] = a; a += n; } pre[1024] = a; }
        __syncthreads();
        const int nlist = pre[1024], ntot = 1024 + nlist;
        const int wl = wave * 32 + (lane & 31);
        for (int u = vcu; u < ntot; u += G) {
            const bool own = u < 1024;
            int b, h, kb, s, dst, mli, ostride; moba::bf16* obase; float* mlp;
            if (own) {
                b = u >> 8; h = (u >> 5) & 7; kb = u & 31; s = kb * 256 + wl; dst = b * SEQ + s; mli = (b * 8 + h) * SEQ + s; ostride = DM; obase = (moba::bf16*)OB + h * 128; mlp = ownml;
            } else {
                const int lu = u - 1024; int loI = 0, hiI = 1024;
                while (hiI - loI > 1) { const int mid = (loI + hiI) >> 1; if (pre[mid] <= lu) loI = mid; else hiI = mid; }
                const int bhj = loI, chunk = lu - pre[bhj], bh = bhj >> 5; kb = bhj & 31; b = bh >> 3; h = bh & 7;
                const int cnt = (int)__hip_atomic_load(ctl + CW_MOBACNT + bhj, RLX_AGENT);
                const int ei = chunk * 256 + wl; const bool valid = ei < cnt;
                const int ent = valid ? lists[(size_t)bh * LIST_PER_BH + list_off(kb) + ei] : 0;
                s = ent & 0xffff; mli = (bh * SEQ + s) * 3 + (ent >> 16); dst = valid ? mli : -1; ostride = 128; obase = (moba::bf16*)PO; mlp = pml;
            }
            const moba::bf16* qrow = (const moba::bf16*)QKV + ((size_t)b * SEQ + s) * NQKV + h * 128;
            const moba::bf16* Kh = (const moba::bf16*)QKV + ((size_t)b * SEQ + kb * 256) * NQKV + 1024 + h * 128;
            moba::moba_unit(own, qrow, Kh, Kh + 1024, obase, ostride, dst, mlp, mli, wl, (char*)lds);
        }
        } SEAM(12);
    }
    if (IN(13)) { PH_PTRS; for (int rep_ = 0; rep_ < NREP(13); ++rep_) {
        const int hh = lane >> 3, dd = (lane & 7) * 16;
        for (int m = gw; m < TOK; m += NGW) {
            const int b = m >> 13, s = m & 8191, nv = (s >> 8) < 3 ? (s >> 8) : 3; const int qi = (b * 8 + hh) * SEQ + s;
            float mm[4], ll[4]; mm[0] = ownml[2 * (size_t)qi]; ll[0] = ownml[2 * (size_t)qi + 1]; float M = mm[0];
#pragma unroll
            for (int r = 0; r < 3; ++r) { if (r < nv) { mm[1 + r] = pml[2 * ((size_t)qi * 3 + r)]; ll[1 + r] = pml[2 * ((size_t)qi * 3 + r) + 1]; M = fmaxf(M, mm[1 + r]); } else { mm[1 + r] = -1e30f; ll[1 + r] = 0.f; } }
            float w[4], wsum = 0.f;
#pragma unroll
            for (int r = 0; r < 4; ++r) { w[r] = ll[r] * __builtin_amdgcn_exp2f(mm[r] - M); wsum += w[r]; }
            const float inv = 1.f / wsum;
            float acc16[16];
            bf16* op = OB + (size_t)m * DM + hh * 128 + dd;
            { const v4u a0 = *(const GAS v4u*)op, a1 = *(const GAS v4u*)(op + 8); const float ww = w[0] * inv;
#pragma unroll
              for (int k = 0; k < 4; ++k) { acc16[2 * k] = ww * __uint_as_float(a0[k] << 16); acc16[2 * k + 1] = ww * __uint_as_float(a0[k] & 0xffff0000u); acc16[8 + 2 * k] = ww * __uint_as_float(a1[k] << 16); acc16[8 + 2 * k + 1] = ww * __uint_as_float(a1[k] & 0xffff0000u); } }
#pragma unroll
            for (int r = 0; r < 3; ++r) if (r < nv) { const bf16* pp = PO + ((size_t)qi * 3 + r) * 128 + dd; const v4u a0 = *(const GAS v4u*)pp, a1 = *(const GAS v4u*)(pp + 8); const float ww = w[1 + r] * inv;
#pragma unroll
                for (int k = 0; k < 4; ++k) { acc16[2 * k] += ww * __uint_as_float(a0[k] << 16); acc16[2 * k + 1] += ww * __uint_as_float(a0[k] & 0xffff0000u); acc16[8 + 2 * k] += ww * __uint_as_float(a1[k] << 16); acc16[8 + 2 * k + 1] += ww * __uint_as_float(a1[k] & 0xffff0000u); } }
            v4u w0, w1;
#pragma unroll
            for (int k = 0; k < 4; ++k) { w0[k] = pk2(acc16[2 * k], acc16[2 * k + 1]); w1[k] = pk2(acc16[8 + 2 * k], acc16[8 + 2 * k + 1]); }
            *(GAS v4u*)op = w0; *(GAS v4u*)(op + 8) = w1;
        }
        } SEAM(13);
    }
    if (IN(14)) { PH_PTRS; for (int rep_ = 0; rep_ < NREP(14); ++rep_) {
        pg8::ABDense ab{OB, W1o, DM}; pg8::TileOrder S; S.init(TOK / 256, DM / 256, G, bx);
        pg8::EpiResB E{Rb, Rb, DM, nullptr, RSS(3)};
        pg8::gemm_phase<pg8::EpiResB, pg8::ABDense>(L + RING_OFF, ab, S, E);
        } SEAM(14);
    }
    if (IN(15)) { PH_PTRS; for (int rep_ = 0; rep_ < NREP(15); ++rep_) {
        {
            const int gt = (vcu * NWAVES + wave) * 64 + lane, NT_ = G * NWAVES * 64;
            for (int e = gt; e < 2 * SLOTS; e += NT_) { slot_tok[e] = -1; slot_gate[e] = 0.f; }
        }
        if (rep_ == 0) {
            f32x4 gv[4]; load_gain(norm_ffn + DM, gv, lane);
            float wr_[16][8];
#pragma unroll
            for (int j = 0; j < 4; ++j)
#pragma unroll
                for (int q = 0; q < 4; ++q) { const int k = 4 * lane + 256 * j + q; const f32x4 a = *(const GAS f32x4*)(moe_router + (size_t)k * 8) * gv[j][q], c = *(const GAS f32x4*)(moe_router + (size_t)k * 8 + 4) * gv[j][q];
                    wr_[4 * j + q][0] = a.x; wr_[4 * j + q][1] = a.y; wr_[4 * j + q][2] = a.z; wr_[4 * j + q][3] = a.w; wr_[4 * j + q][4] = c.x; wr_[4 * j + q][5] = c.y; wr_[4 * j + q][6] = c.z; wr_[4 * j + q][7] = c.w; }
            for (int m = gw; m < TOK; m += NGW) {
                f32x4 v[4];
                { const GAS unsigned long long* r8 = (const GAS unsigned long long*)(Rb + (size_t)m * DM) + lane;
#pragma unroll
                  for (int j = 0; j < 4; ++j) { const unsigned long long w = r8[64 * j]; const unsigned lo32 = (unsigned)w, hi32 = (unsigned)(w >> 32);
                      v[j].x = __uint_as_float(lo32 << 16); v[j].y = __uint_as_float(lo32 & 0xffff0000u); v[j].z = __uint_as_float(hi32 << 16); v[j].w = __uint_as_float(hi32 & 0xffff0000u); } }
                float lg[8];
#pragma unroll
                for (int e = 0; e < 8; ++e) { float a = 0.f;
#pragma unroll
                    for (int j = 0; j < 4; ++j) a += v[j].x * wr_[4 * j][e] + v[j].y * wr_[4 * j + 1][e] + v[j].z * wr_[4 * j + 2][e] + v[j].w * wr_[4 * j + 3][e];
                    lg[e] = wave_sum(a); }
                const float rs = 1.f / sqrtf((float)RSS(3)[m] * (5.9604644775390625e-8f / DM) + NORM_EPS);
#pragma unroll
                for (int e = 0; e < 8; ++e) lg[e] *= rs;
                {
                    float mx = 0.f;
#pragma unroll
                    for (int j = 0; j < 4; ++j) mx = fmaxf(fmaxf(mx, fmaxf(fabsf(v[j].x), fabsf(v[j].y))), fmaxf(fabsf(v[j].z), fabsf(v[j].w)));
#pragma unroll
                    for (int o = 1; o < 64; o <<= 1) mx = fmaxf(mx, __shfl_xor(mx, o));
                    const float inv = mx > 0.f ? 127.0f / mx : 0.f;
                    GAS unsigned* aq = (GAS unsigned*)(AQ + (size_t)m * DM) + lane;
#pragma unroll
                    for (int j = 0; j < 4; ++j) { const int q0 = (int)__builtin_rintf(v[j].x * inv), q1 = (int)__builtin_rintf(v[j].y * inv), q2 = (int)__builtin_rintf(v[j].z * inv), q3 = (int)__builtin_rintf(v[j].w * inv);
                        aq[64 * j] = (unsigned)(q0 & 255) | ((unsigned)(q1 & 255) << 8) | ((unsigned)(q2 & 255) << 16) | ((unsigned)(q3 & 255) << 24); }
                    if (lane == 0) SA[m] = mx * rs * (1.0f / 127.0f);
                }
                int e0 = 0; float l0 = lg[0];
#pragma unroll
                for (int e = 1; e < 8; ++e) if (lg[e] > l0) { l0 = lg[e]; e0 = e; }
                int e1 = -1; float l1 = -INFINITY;
#pragma unroll
                for (int e = 0; e < 8; ++e) if (e != e0 && lg[e] > l1) { l1 = lg[e]; e1 = e; }
                if (lane == 0) {
                    const float g0 = 1.f / (1.f + expf(l1 - l0)), g1 = 1.f - g0;
                    const int p0 = (int)__hip_atomic_fetch_add((LAS unsigned*)(L + MISC_OFF) + 40 + e0, 1u, __ATOMIC_RELAXED, __HIP_MEMORY_SCOPE_WORKGROUP), p1 = (int)__hip_atomic_fetch_add((LAS unsigned*)(L + MISC_OFF) + 48 + e1, 1u, __ATOMIC_RELAXED, __HIP_MEMORY_SCOPE_WORKGROUP);
                    tok_e[m] = e0; tok_e[TOK + m] = e1; tok_pos[m] = p0; tok_pos[TOK + m] = p1; tok_gate[m] = g0; tok_gate[TOK + m] = g1;
                }
            }
            LDS_WAIT(); __syncthreads();
            if (tid < 16) { const unsigned n = MISC[40 + tid]; wg_base[vcu * 16 + tid] = n ? (int)__hip_atomic_fetch_add(ctl + CW_MOECNT + tid, n, RLX_AGENT) : 0; }
        }
        {
            constexpr int S_1 = (DM / 512) * (FF1 / 32), S_2 = (FF1 / 512) * (DM / 32), PER_E = 2 * S_1 + S_2;
            float ssA = 0.f, ssB = 0.f;
            for (int it = gw; it < NEXP * PER_E; it += NGW) {
                const int e = it / PER_E; int r = it % PER_E;
                if (r < S_1) { ssA += wmax_strip<3>(moe_w1 + (size_t)e * DM * FF1, FF1, CMAX13 + e * 2 * FF1, 8 * (r / (FF1 / 32)), 8, r % (FF1 / 32), lane, norm_ffn + DM); continue; } r -= S_1;
                if (r < S_1) { ssB += wmax_strip<4>(moe_w3 + (size_t)e * DM * FF1, FF1, CMAX13 + e * 2 * FF1, 8 * (r / (FF1 / 32)), 8, r % (FF1 / 32), lane, norm_ffn + DM); continue; } r -= S_1;
                (void)wmax_strip<0>(moe_w2 + (size_t)e * FF1 * DM, DM, CMAX2 + e * DM, 8 * (r / (DM / 32)), 8, r % (DM / 32), lane, nullptr);
            }
            ssA = wave_sum(ssA); ssB = wave_sum(ssB);
            if (lane == 0) { __hip_atomic_fetch_add(SSTOT, (unsigned long long)(ssA * 16777216.0f), __ATOMIC_RELAXED, __HIP_MEMORY_SCOPE_AGENT); __hip_atomic_fetch_add(SSTOT + 1, (unsigned long long)(ssB * 16777216.0f), __ATOMIC_RELAXED, __HIP_MEMORY_SCOPE_AGENT); }
        }
        } SEAM(15);
    }
#define MOE_CUM() do { if (tid < 2) { int a = 0; for (int e = 0; e < 8; ++e) { MISC[16 + 9 * tid + e] = (unsigned)a; a += (int)((__hip_atomic_load(ctl + CW_MOECNT + 8 * tid + e, RLX_AGENT) + 255u) >> 8); } MISC[16 + 9 * tid + 8] = (unsigned)a; } __syncthreads(); } while (0)
    if (IN(16)) { PH_PTRS; for (int rep_ = 0; rep_ < NREP(16); ++rep_) {
        MOE_CUM();
        const int gt = (vcu * NWAVES + wave) * 64 + lane, NT_ = G * NWAVES * 64;
        for (int e = gt; e < 2 * TOK; e += NT_) { const int r = e >= TOK ? 1 : 0; const int ex = tok_e[e]; const int t_ = e - r * TOK; const int slot = (int)MISC[16 + 9 * r + ex] * 256 + wg_base[((t_ % NGW) >> 3) * 16 + r * 8 + ex] + tok_pos[e];
            slot_tok[r * SLOTS + slot] = e - r * TOK; slot_gate[r * SLOTS + slot] = tok_gate[e]; }
        {
            LAS float* scr = (LAS float*)(L + RING_OFF + wave * 16384);
            constexpr int I_1 = (DM / 64) * (FF1 / 32), I_2 = (FF1 / 64) * (DM / 32), PER_E = 2 * I_1 + I_2;
            for (int it = gw; it < NEXP * PER_E; it += NGW) {
                const int e = it / PER_E; int r = it % PER_E;
                if (r < I_1) { transpose_item_q<3>(moe_w1 + (size_t)e * DM * FF1, DM, FF1, WM13 + (size_t)e * 2 * FF1 * DM, CMAX13 + e * 2 * FF1, scr, r, lane, norm_ffn + DM); continue; } r -= I_1;
                if (r < I_1) { transpose_item_q<4>(moe_w3 + (size_t)e * DM * FF1, DM, FF1, WM13 + (size_t)e * 2 * FF1 * DM, CMAX13 + e * 2 * FF1, scr, r, lane, norm_ffn + DM); continue; } r -= I_1;
                transpose_item_q<0>(moe_w2 + (size_t)e * FF1 * DM, FF1, DM, WM2 + (size_t)e * DM * FF1, CMAX2 + e * DM, scr, r, lane, nullptr);
            }
        }
        } SEAM(16);
    }
#define MOE_SU() (8.0f * sqrtf(((float)SSTOT[0] * (5.9604644775390625e-8f / (NEXP * FF1))) * ((float)SSTOT[1] * (5.9604644775390625e-8f / (NEXP * FF1)))))
#define MOE_UP(r) do { MOE_CUM(); \
        pg8::ABMoeUp ab{(const pg8::bf16_t*)AQ, (const pg8::bf16_t*)WM13, DM / 2, slot_tok + (r) * SLOTS, (const LAS int*)(L + MISC_OFF + 4 * (16 + 9 * (r))), (size_t)2 * FF1 * (DM / 2)}; \
        pg8::TileOrder S; S.init((int)MISC[16 + 9 * (r) + 8], (2 * FF1) / 256, G, bx); \
        pg8::EpiSwiGLUQ E{UM, FF1, SA, CMAX13, slot_tok + (r) * SLOTS, (const LAS int*)(L + MISC_OFF + 4 * (16 + 9 * (r))), 127.0f / MOE_SU()}; \
        pg8::gemm_phase<pg8::EpiSwiGLUQ, pg8::ABMoeUp>(L + RING_OFF, ab, S, E); } while (0)
#define MOE_DOWN(r) do { MOE_CUM(); \
        pg8::ABMoeDown ab{(const pg8::bf16_t*)UM, (const pg8::bf16_t*)WM2, FF1 / 2, (const LAS int*)(L + MISC_OFF + 4 * (16 + 9 * (r))), (size_t)DM * (FF1 / 2)}; \
        pg8::TileOrder S; S.init((int)MISC[16 + 9 * (r) + 8], DM / 256, G, bx); \
        pg8::EpiResBQ E{(r) == 0 ? Rb : OB, (r) == 0 ? OB : Rb, DM, slot_tok + (r) * SLOTS, slot_gate + (r) * SLOTS, CMAX2, (const LAS int*)(L + MISC_OFF + 4 * (16 + 9 * (r))), MOE_SU() * (1.0f / 127.0f)}; \
        pg8::gemm_phase<pg8::EpiResBQ, pg8::ABMoeDown>(L + RING_OFF, ab, S, E); } while (0)
    if (IN(17)) { PH_PTRS; for (int rep_ = 0; rep_ < NREP(17); ++rep_) MOE_UP(0); SEAM(17); }
    if (IN(18)) { PH_PTRS; MOE_DOWN(0); SEAM(18); }
    if (IN(19)) { PH_PTRS; for (int rep_ = 0; rep_ < NREP(19); ++rep_) MOE_UP(1); SEAM(19); }
    if (IN(20)) { PH_PTRS; MOE_DOWN(1); SEAM(20); }
    if (IN(21)) { PH_PTRS;
        f32x4 gv[4]; load_gain(final_norm, gv, lane);
        for (int m = gw; m < TOK; m += NGW) {
            f32x4 v[4]; float s = 0.f;
            const GAS unsigned long long* r8 = (const GAS unsigned long long*)(Rb + (size_t)m * DM) + lane;
#pragma unroll
            for (int j = 0; j < 4; ++j) { const unsigned long long w = r8[64 * j]; const unsigned lo32 = (unsigned)w, hi32 = (unsigned)(w >> 32);
                v[j].x = __uint_as_float(lo32 << 16); v[j].y = __uint_as_float(lo32 & 0xffff0000u); v[j].z = __uint_as_float(hi32 << 16); v[j].w = __uint_as_float(hi32 & 0xffff0000u);
                s += (v[j].x * v[j].x + v[j].y * v[j].y) + (v[j].z * v[j].z + v[j].w * v[j].w); }
            const float rstd = 1.f / sqrtf(wave_sum(s) * (1.f / DM) + NORM_EPS);
            GAS f32x4* o = (GAS f32x4*)(out + (size_t)m * DM) + lane;
#pragma unroll
            for (int j = 0; j < 4; ++j) o[64 * j] = v[j] * rstd * gv[j]; }
    }
#undef IN
#undef SEAM
#undef GRID_BAR
#undef tid
#undef lane
}
constexpr int N_PHASES = 22;

extern "C" void kernel_launch(void* const* d_in, const int* in_sizes, int n_in, void* d_out, int out_size, void* d_ws, size_t ws_size, hipStream_t stream) {
    static int grid = 0;
    if (grid == 0) {
        if (n_in != 20 || in_sizes[0] != TOK * DM || out_size != TOK * DM || ws_size < WS_END) { fprintf(stderr, "kernel_launch: shape / workspace mismatch (n_in %d, in0 %d, out %d, ws %zu, need %zu); nothing launched\n", n_in, n_in > 0 ? in_sizes[0] : -1, out_size, ws_size, (size_t)WS_END); grid = -1; return; }
        int dev = 0, cus = 0, per_cu = 0;
        if (hipGetDevice(&dev) != hipSuccess || hipDeviceGetAttribute(&cus, hipDeviceAttributeMultiprocessorCount, dev) != hipSuccess) { grid = -1; return; }
        if (hipFuncSetAttribute((const void*)mk_fwd, hipFuncAttributeMaxDynamicSharedMemorySize, LDS_BYTES) != hipSuccess) { fprintf(stderr, "kernel_launch: hipFuncSetAttribute failed\n"); grid = -1; return; }
        if (hipOccupancyMaxActiveBlocksPerMultiprocessor(&per_cu, (const void*)mk_fwd, NWAVES * 64, LDS_BYTES) != hipSuccess || per_cu < 1) fprintf(stderr, "kernel_launch: occupancy query reports %d workgroups per CU\n", per_cu);
        (void)hipGetLastError();
        grid = cus;
    }
    if (grid < 0) return;
    if (hipMemsetAsync((char*)d_ws + WS_CTL, 0, CTL_ZERO_BYTES, stream) != hipSuccess) return;
    Args a{};
    for (int i = 0; i < 20; ++i) a.in[i] = (const float*)d_in[i];
    a.out = (float*)d_out; a.ws = (unsigned char*)d_ws;
    for (int i = 0; i < 8; ++i) a.inv64[i] = (float)pow(500000.0, -(double)(2 * i) / 16.0);
    for (int i = 0; i < 16; ++i) a.inv128[i] = (float)pow(500000.0, -(double)(2 * i) / 32.0);
#if MK_PER_PHASE
    for (int p = 0; p < N_PHASES; ++p) { a.ph_lo = p; a.ph_hi = p + 1; hipLaunchKernelGGL(mk_fwd, dim3(grid), dim3(NWAVES * 64), LDS_BYTES, stream, a); }
#else
    a.ph_lo = 0; a.ph_hi = N_PHASES;
    hipLaunchKernelGGL(mk_fwd, dim3(grid), dim3(NWAVES * 64), LDS_BYTES, stream, a);
#ifdef PROBE_LIST
    {
        static const int probe[] = {PROBE_LIST};
        for (int k : probe) { a.ph_lo = k; a.ph_hi = k + 1;
            a.out = (k == 3 || k == 12 || k == 13 || k == 18 || k == 21) ? (float*)((char*)d_ws + WS_QKV) : (float*)d_out;
            hipLaunchKernelGGL(mk_fwd, dim3(grid), dim3(NWAVES * 64), LDS_BYTES, stream, a); }
    }
#endif
#endif
    const hipError_t le = hipPeekAtLastError();
    if (le != hipSuccess) fprintf(stderr, "kernel_launch: launch failed: %s\n", hipGetErrorName(le));
}
```

```cpp
#include <hip/hip_runtime.h>
#include <hip/hip_bf16.h>
#include <cstdio>
#include <cstdint>
#include <cmath>
namespace pg8 {
#define PG8_LAS __attribute__((address_space(3)))
typedef unsigned short bf16_t;
typedef short bf16x8 __attribute__((ext_vector_type(8)));
typedef float f32x4 __attribute__((ext_vector_type(4)));
typedef unsigned u32x4 __attribute__((ext_vector_type(4)));
constexpr int BM = 256, BK = 64, HALF = 128, HTB = HALF * BK * 2  , STAGE_BYTES = 8 * HTB, NXCD = 8, WGM = 8;

__host__ __device__ __forceinline__ int lds_byte(int r, int c) { const int st = (r >> 4) * 2 + (c >> 5), rr = r & 15, cc = c & 31, ob = rr * 64 + cc * 2; return st * 1024 + (ob ^ (((ob >> 9) & 1) << 5)); }
__host__ __device__ __forceinline__ void stage_rc(int b, int& R, int& C) { const int st = b / 1024, sb = b % 1024, swz = sb ^ (((sb >> 9) & 1) << 5); R = (st >> 1) * 16 + swz / 64; C = (st & 1) * 32 + (swz % 64) / 2; }
__host__ __device__ __forceinline__ int perm32(int rho) { const int n = rho >> 4, i = rho & 15; return 8 * (i >> 2) + 4 * n + (i & 3); }

struct Unit { int pm, pn; };

struct TileOrder {
    int nM, nN, nwg, G, c;
    __device__ __forceinline__ void init(int nM_, int nN_, int G_, int c_) { nM = nM_; nN = nN_; nwg = nM * nN; G = G_; c = c_; }
    __device__ __forceinline__ bool next(int i, Unit& u) const {
        const long L = (long)i * G + c; if (L >= nwg) return false;
        int wgid = (int)L; { const int q = nwg / NXCD, r = nwg % NXCD, xcd = wgid % NXCD, off = wgid / NXCD; wgid = (xcd < r ? xcd * (q + 1) : r * (q + 1) + (xcd - r) * q) + off; }
        const int nig = WGM * nN, gid = wgid / nig, fm = gid * WGM, gsz = (nM - fm) < WGM ? (nM - fm) : WGM;
        u.pm = fm + ((wgid % nig) % gsz); u.pn = (wgid % nig) / gsz; return true;
    }
};

struct ABDense {
    static constexpr bool GATHER = false;
    const bf16_t* A; const bf16_t* Bt; int K;
    __device__ __forceinline__ const char* abase(const Unit& u) const { return (const char*)A + (size_t)u.pm * BM * K * 2; }
    __device__ __forceinline__ const char* bbase(const Unit& u) const { return (const char*)Bt + (size_t)u.pn * BM * K * 2; }
    __device__ __forceinline__ const int* tokp(const Unit&) const { return nullptr; }
};
struct ABMoeUp {
    static constexpr bool GATHER = true;
    const bf16_t* A; const bf16_t* Bt; int K; const int* slot_tok; const PG8_LAS int* cum; size_t estride;
    __device__ __forceinline__ int expert(int pm) const { int e = 0;
#pragma unroll
        for (int k = 1; k < 8; ++k) e += (pm >= cum[k]) ? 1 : 0; return e; }
    __device__ __forceinline__ const char* abase(const Unit&) const { return (const char*)A; }
    __device__ __forceinline__ const char* bbase(const Unit& u) const { return (const char*)(Bt + (size_t)expert(u.pm) * estride) + (size_t)u.pn * BM * K * 2; }
    __device__ __forceinline__ const int* tokp(const Unit& u) const { return slot_tok + u.pm * BM; }
};
struct ABMoeDown {
    static constexpr bool GATHER = false;
    const bf16_t* A; const bf16_t* Bt; int K; const PG8_LAS int* cum; size_t estride;
    __device__ __forceinline__ int expert(int pm) const { int e = 0;
#pragma unroll
        for (int k = 1; k < 8; ++k) e += (pm >= cum[k]) ? 1 : 0; return e; }
    __device__ __forceinline__ const char* abase(const Unit& u) const { return (const char*)A + (size_t)u.pm * BM * K * 2; }
    __device__ __forceinline__ const char* bbase(const Unit& u) const { return (const char*)(Bt + (size_t)expert(u.pm) * estride) + (size_t)u.pn * BM * K * 2; }
    __device__ __forceinline__ const int* tokp(const Unit&) const { return nullptr; }
};

__device__ __forceinline__ unsigned cvt_pk_bf16(float lo, float hi) { unsigned r; asm volatile("v_cvt_pk_bf16_f32 %0, %1, %2" : "=v"(r) : "v"(lo), "v"(hi)); return r; }

template <int DH> struct EpiQKV {
    static constexpr bool PERM = true; typedef f32x4 acc_t;
    bf16_t* O; int ldc; const float* ct; const float* st; float qscale; const unsigned long long* rss;
    __device__ __forceinline__ void operator()(const f32x4 (&acc)[2][2][4][2], const Unit& u, int wr, int wc, int fr, int fq) const {
        constexpr int NF = DH / 8;
        const int row0 = u.pm * BM + wr * 64 + fr, col0 = u.pn * BM + wc * 32 + 8 * fq;
        const int sect = u.pn >> 2;
        const float sc = (sect == 0) ? qscale : 1.f;
        const bool rot = (sect < 2) && (DH == 64 ? (((wc & 1) == 0) && (fq < 2)) : (wc == 0));
#pragma unroll
        for (int ai = 0; ai < 2; ++ai)
#pragma unroll
            for (int m = 0; m < 4; ++m) {
                const int row = row0 + ai * HALF + m * 16; const int pos = row & 8191; const float rs = sc * __builtin_amdgcn_rsqf((float)rss[row] * (5.9604644775390625e-8f / 1024.0f) + 1e-6f);
                f32x4 c4 = (f32x4){1.f, 1.f, 1.f, 1.f}, s4 = (f32x4){0.f, 0.f, 0.f, 0.f};
                if (rot) { c4 = *(const f32x4*)(ct + pos * NF + 4 * fq); s4 = *(const f32x4*)(st + pos * NF + 4 * fq); }
                bf16_t* rowp = O + (size_t)row * ldc + col0;
#pragma unroll
                for (int bj = 0; bj < 2; ++bj) {
                    const f32x4 x1 = acc[ai][bj][m][0], x2 = acc[ai][bj][m][1];
                    f32x4 v0 = (x1 * c4 - x2 * s4) * rs, v1 = (x2 * c4 + x1 * s4) * rs;
                    u32x4 w; w.x = cvt_pk_bf16(v0[0], v0[1]); w.y = cvt_pk_bf16(v0[2], v0[3]); w.z = cvt_pk_bf16(v1[0], v1[1]); w.w = cvt_pk_bf16(v1[2], v1[3]);
                    *(u32x4*)(rowp + bj * HALF) = w; }
            }
    }
};

__device__ __forceinline__ float silu_mul(float a, float b) { return a * b * __builtin_amdgcn_rcpf(1.0f + __builtin_amdgcn_exp2f(-1.4426950408889634f * a)); }
struct EpiSwiGLU {
    static constexpr bool PERM = true; typedef f32x4 acc_t;
    bf16_t* O; int ldc; const float* gate; const unsigned long long* rss; const int* rowmap;
    __device__ __forceinline__ void operator()(const f32x4 (&acc)[2][2][4][2], const Unit& u, int wr, int wc, int fr, int fq) const {
        const int row0 = u.pm * BM + wr * 64 + fr, col0 = u.pn * HALF + wc * 32 + 8 * fq;
#pragma unroll
        for (int ai = 0; ai < 2; ++ai)
#pragma unroll
            for (int m = 0; m < 4; ++m) {
                const int row = row0 + ai * HALF + m * 16; const float g = gate ? gate[row] : 1.f; const int trow = rowmap ? rowmap[row] : row;
                const float rs = trow >= 0 ? __builtin_amdgcn_rsqf((float)rss[trow] * (5.9604644775390625e-8f / 1024.0f) + 1e-6f) : 0.f;
                const f32x4 a0 = acc[ai][0][m][0] * rs, a1 = acc[ai][0][m][1] * rs, b0 = acc[ai][1][m][0] * rs, b1 = acc[ai][1][m][1] * rs;
                float v[8];
#pragma unroll
                for (int k = 0; k < 4; ++k) { v[k] = g * silu_mul(a0[k], b0[k]); v[4 + k] = g * silu_mul(a1[k], b1[k]); }
                u32x4 w; w.x = cvt_pk_bf16(v[0], v[1]); w.y = cvt_pk_bf16(v[2], v[3]); w.z = cvt_pk_bf16(v[4], v[5]); w.w = cvt_pk_bf16(v[6], v[7]);
                *(u32x4*)(O + (size_t)row * ldc + col0) = w; }
    }
};
struct EpiResB {
    static constexpr bool PERM = true; typedef f32x4 acc_t;
    const bf16_t* Rin; bf16_t* Rout; int ldc; const int* rowmap; unsigned long long* rss_out;
    __device__ __forceinline__ void operator()(const f32x4 (&acc)[2][2][4][2], const Unit& u, int wr, int wc, int fr, int fq) const {
        const int row0 = u.pm * BM + wr * 64 + fr, col0 = u.pn * BM + wc * 32 + 8 * fq;
#pragma unroll
        for (int ai = 0; ai < 2; ++ai)
#pragma unroll
            for (int m = 0; m < 4; ++m) {
                const int row = row0 + ai * HALF + m * 16; const int orow = rowmap ? rowmap[row] : row; float ss = 0.f;
                if (orow >= 0) { const bf16_t* rp = Rin + (size_t)orow * ldc + col0; bf16_t* wp = Rout + (size_t)orow * ldc + col0;
#pragma unroll
                    for (int bj = 0; bj < 2; ++bj) { const u32x4 w = *(const u32x4*)(rp + bj * HALF); const f32x4 a0 = acc[ai][bj][m][0], a1 = acc[ai][bj][m][1];
                        float v[8];
                        v[0] = __uint_as_float(w.x << 16) + a0[0]; v[1] = __uint_as_float(w.x & 0xffff0000u) + a0[1]; v[2] = __uint_as_float(w.y << 16) + a0[2]; v[3] = __uint_as_float(w.y & 0xffff0000u) + a0[3];
                        v[4] = __uint_as_float(w.z << 16) + a1[0]; v[5] = __uint_as_float(w.z & 0xffff0000u) + a1[1]; v[6] = __uint_as_float(w.w << 16) + a1[2]; v[7] = __uint_as_float(w.w & 0xffff0000u) + a1[3];
#pragma unroll
                        for (int k = 0; k < 8; ++k) ss += v[k] * v[k];
                        u32x4 o; o.x = cvt_pk_bf16(v[0], v[1]); o.y = cvt_pk_bf16(v[2], v[3]); o.z = cvt_pk_bf16(v[4], v[5]); o.w = cvt_pk_bf16(v[6], v[7]);
                        *(u32x4*)(wp + bj * HALF) = o; } }
                if (rss_out) { ss += __shfl_xor(ss, 16); ss += __shfl_xor(ss, 32);
                    if (fq == 0) __hip_atomic_fetch_add(rss_out + orow, (unsigned long long)(ss * 16777216.0f), __ATOMIC_RELAXED, __HIP_MEMORY_SCOPE_AGENT); }
                if (m & 1) asm volatile("" ::: "memory"); }
    }
};

typedef int i32x4_e __attribute__((ext_vector_type(4)));
struct EpiSwiGLUQ {
    static constexpr bool PERM = true; typedef i32x4_e acc_t;
    signed char* O; int ldc; const float* sa; const unsigned* cm; const int* rowmap; const PG8_LAS int* cum; float qmul;
    __device__ __forceinline__ void operator()(const i32x4_e (&acc)[2][2][4][2], const Unit& u, int wr, int wc, int fr, int fq) const {
        int e = 0;
#pragma unroll
        for (int k = 1; k < 8; ++k) e += (u.pm >= cum[k]) ? 1 : 0;
        const unsigned* cme = cm + (size_t)e * 7168 + u.pn * BM + wc * 32 + 8 * fq;
        float cA[8], cAB[8];
#pragma unroll
        for (int k = 0; k < 8; ++k) { cA[k] = __uint_as_float(cme[k]) * (1.0f / 127.0f); cAB[k] = cA[k] * (__uint_as_float(cme[HALF + k]) * (1.0f / 127.0f)); }
        const int row0 = u.pm * BM + wr * 64 + fr, col0 = u.pn * HALF + wc * 32 + 8 * fq;
#pragma unroll
        for (int ai = 0; ai < 2; ++ai)
#pragma unroll
            for (int m = 0; m < 4; ++m) {
                const int row = row0 + ai * HALF + m * 16; const int trow = rowmap[row]; const float s = trow >= 0 ? sa[trow] : 0.f;
                const float sneg = -1.4426950408889634f * s, s2q = s * s * qmul;
                const i32x4_e a0 = acc[ai][0][m][0], a1 = acc[ai][0][m][1], b0 = acc[ai][1][m][0], b1 = acc[ai][1][m][1];
                unsigned lo = 0u, hi = 0u;
#pragma unroll
                for (int k = 0; k < 4; ++k) {
                    const float fa = (float)a0[k], fb = (float)b0[k], fc = (float)a1[k], fd = (float)b1[k];
                    const float sg0 = __builtin_amdgcn_rcpf(1.0f + __builtin_amdgcn_exp2f((fa * cA[k]) * sneg)), sg1 = __builtin_amdgcn_rcpf(1.0f + __builtin_amdgcn_exp2f((fc * cA[4 + k]) * sneg));
                    const float u0 = ((fa * fb) * cAB[k]) * s2q * sg0 + 128.0f, u1 = ((fc * fd) * cAB[4 + k]) * s2q * sg1 + 128.0f;
                    lo = __builtin_amdgcn_cvt_pk_u8_f32(__builtin_rintf(u0), k, lo); hi = __builtin_amdgcn_cvt_pk_u8_f32(__builtin_rintf(u1), k, hi); }
                lo ^= 0x80808080u; hi ^= 0x80808080u;
                *(unsigned long long*)(O + (size_t)row * ldc + col0) = (unsigned long long)lo | ((unsigned long long)hi << 32); }
    }
};
struct EpiResBQ {
    static constexpr bool PERM = true; typedef i32x4_e acc_t;
    const bf16_t* Rin; bf16_t* Rout; int ldc; const int* rowmap; const float* gate; const unsigned* cm; const PG8_LAS int* cum; float dq;
    __device__ __forceinline__ void operator()(const i32x4_e (&acc)[2][2][4][2], const Unit& u, int wr, int wc, int fr, int fq) const {
        int e = 0;
#pragma unroll
        for (int k = 1; k < 8; ++k) e += (u.pm >= cum[k]) ? 1 : 0;
        const int row0 = u.pm * BM + wr * 64 + fr, col0 = u.pn * BM + wc * 32 + 8 * fq;
        const unsigned* cme = cm + (size_t)e * 1024 + col0;
        float sb[2][8];
#pragma unroll
        for (int bj = 0; bj < 2; ++bj)
#pragma unroll
            for (int k = 0; k < 8; ++k) sb[bj][k] = __uint_as_float(cme[bj * HALF + k]) * (dq / 127.0f);
#pragma unroll
        for (int ai = 0; ai < 2; ++ai)
#pragma unroll
            for (int m = 0; m < 4; ++m) {
                const int row = row0 + ai * HALF + m * 16; const int orow = rowmap[row];
                if (orow >= 0) { const float gt = gate[row]; const bf16_t* rp = Rin + (size_t)orow * ldc + col0; bf16_t* wp = Rout + (size_t)orow * ldc + col0;
#pragma unroll
                    for (int bj = 0; bj < 2; ++bj) { const u32x4 w = *(const u32x4*)(rp + bj * HALF); const i32x4_e a0 = acc[ai][bj][m][0], a1 = acc[ai][bj][m][1];
                        float v[8];
                        v[0] = __uint_as_float(w.x << 16) + (float)a0[0] * gt * sb[bj][0]; v[1] = __uint_as_float(w.x & 0xffff0000u) + (float)a0[1] * gt * sb[bj][1];
                        v[2] = __uint_as_float(w.y << 16) + (float)a0[2] * gt * sb[bj][2]; v[3] = __uint_as_float(w.y & 0xffff0000u) + (float)a0[3] * gt * sb[bj][3];
                        v[4] = __uint_as_float(w.z << 16) + (float)a1[0] * gt * sb[bj][4]; v[5] = __uint_as_float(w.z & 0xffff0000u) + (float)a1[1] * gt * sb[bj][5];
                        v[6] = __uint_as_float(w.w << 16) + (float)a1[2] * gt * sb[bj][6]; v[7] = __uint_as_float(w.w & 0xffff0000u) + (float)a1[3] * gt * sb[bj][7];
                        u32x4 o; o.x = cvt_pk_bf16(v[0], v[1]); o.y = cvt_pk_bf16(v[2], v[3]); o.z = cvt_pk_bf16(v[4], v[5]); o.w = cvt_pk_bf16(v[6], v[7]);
                        *(u32x4*)(wp + bj * HALF) = o; } }
                if (m & 1) asm volatile("" ::: "memory"); }
    }
};
typedef int i32x4 __attribute__((ext_vector_type(4)));
__device__ __forceinline__ f32x4 mma16(bf16x8 a, bf16x8 b, f32x4 c) { return __builtin_amdgcn_mfma_f32_16x16x32_bf16(a, b, c, 0, 0, 0); }
__device__ __forceinline__ i32x4 mma16(bf16x8 a, bf16x8 b, i32x4 c) { return __builtin_amdgcn_mfma_i32_16x16x64_i8(__builtin_bit_cast(i32x4, a), __builtin_bit_cast(i32x4, b), c, 0, 0, 0); }
template <class Epi, class AB, bool ALIGN_EPI = true>
__device__ __forceinline__ void gemm_phase(PG8_LAS unsigned char* lds, const AB ab, const TileOrder& S, const Epi& E) {
    const int tid = threadIdx.x, wid = __builtin_amdgcn_readfirstlane(tid >> 6), lane = tid & 63, wr = wid >> 2, wc = wid & 3, fr = lane & 15, fq = lane >> 4;
    const int K = ab.K, nt = K / BK;
    int Rr[2], Cc[2]; unsigned voffB[2];
#pragma unroll
    for (int i = 0; i < 2; ++i) { int R, C; stage_rc(tid * 16 + i * 8192, R, C); const int Rb = Epi::PERM ? ((R & ~31) + perm32(R & 31)) : R;
        Rr[i] = R; Cc[i] = C; voffB[i] = (unsigned)(Rb * K + C) * 2u; }
    const size_t kstep = (size_t)(BK * 2);
    const size_t hstep = (size_t)HALF * K * 2;
    const unsigned ldsw = (unsigned)wid * 1024u;
    const int aoff = lds_byte(wr * 64 + fr, fq * 8), boff = lds_byte(wc * 32 + fr, fq * 8);
#define PG8_SA(b, h) (((b) * 2 + (h)) * HTB)
#define PG8_SB(b, h) ((4 + (b) * 2 + (h)) * HTB)
#define PG8_STAGE(bufoff, gbase, voff) do { _Pragma("unroll") for (int _i = 0; _i < 2; ++_i) \
        __builtin_amdgcn_global_load_lds((const unsigned*)((const char*)(gbase) + (voff)[_i]), (PG8_LAS unsigned*)(lds + (bufoff) + ldsw + _i * 8192), 16, 0, 0); } while (0)
#define PG8_LDA(dst, b, h) do { _Pragma("unroll") for (int m = 0; m < 4; ++m) _Pragma("unroll") for (int k = 0; k < 2; ++k) dst[m][k] = *(const PG8_LAS bf16x8*)(lds + PG8_SA(b, h) + aoff + m * 2048 + k * 1024); } while (0)
#define PG8_LDB(dst, b, h) do { _Pragma("unroll") for (int n = 0; n < 2; ++n) _Pragma("unroll") for (int k = 0; k < 2; ++k) dst[n][k] = *(const PG8_LAS bf16x8*)(lds + PG8_SB(b, h) + boff + n * 2048 + k * 1024); } while (0)
#define PG8_MMA(ai, bj, At, Bt) do { __builtin_amdgcn_s_setprio(1); _Pragma("unroll") for (int m = 0; m < 4; ++m) _Pragma("unroll") for (int n = 0; n < 2; ++n) _Pragma("unroll") for (int k = 0; k < 2; ++k) \
        acc[ai][bj][m][n] = mma16(Bt[n][k], At[m][k], acc[ai][bj][m][n]); __builtin_amdgcn_s_setprio(0); } while (0)
#define PG8_WAIT_V(n) asm volatile("s_waitcnt vmcnt(" #n ")" ::: "memory")
#define PG8_WAIT_L(n) asm volatile("s_waitcnt lgkmcnt(" #n ")" ::: "memory")
#define PG8_BAR __builtin_amdgcn_s_barrier()
#define PG8_SCHED __builtin_amdgcn_sched_barrier(0)
    Unit cur, nxt; int ui = 0;
    if (!S.next(0, cur)) return;
    typedef typename Epi::acc_t acc_t;
    acc_t acc[2][2][4][2];
#pragma unroll
    for (int a = 0; a < 2; ++a)
#pragma unroll
        for (int b = 0; b < 2; ++b)
#pragma unroll
            for (int m = 0; m < 4; ++m)
#pragma unroll
                for (int n = 0; n < 2; ++n) acc[a][b][m][n] = (acc_t){0, 0, 0, 0};
    bf16x8 At[4][2], B0[2][2], B1[2][2];
    unsigned cv0[2], cv1[2], nv0[2], nv1[2]; int ntok[4] = {0, 0, 0, 0};
    if constexpr (AB::GATHER) { const int* tp = ab.tokp(cur);
#pragma unroll
        for (int i = 0; i < 2; ++i) { int t0 = tp[Rr[i]], t1 = tp[HALF + Rr[i]]; t0 = t0 < 0 ? 0 : t0; t1 = t1 < 0 ? 0 : t1;
            cv0[i] = (unsigned)(t0 * K + Cc[i]) * 2u; cv1[i] = (unsigned)(t1 * K + Cc[i]) * 2u; }
    } else {
#pragma unroll
        for (int i = 0; i < 2; ++i) { cv0[i] = (unsigned)(Rr[i] * K + Cc[i]) * 2u; cv1[i] = cv0[i] + (unsigned)hstep; }
    }
#pragma unroll
    for (int i = 0; i < 2; ++i) { nv0[i] = cv0[i]; nv1[i] = cv1[i]; }
    const char* cA = ab.abase(cur); const char* cB = ab.bbase(cur);
    PG8_STAGE(PG8_SB(0, 0), cB, voffB); PG8_STAGE(PG8_SB(0, 1), cB + hstep, voffB); PG8_STAGE(PG8_SA(0, 0), cA, cv0); PG8_STAGE(PG8_SA(0, 1), cA, cv1);
    if (wr == 1) PG8_BAR;
    PG8_WAIT_V(2); PG8_BAR;
    PG8_STAGE(PG8_SB(1, 0), cB + kstep, voffB); PG8_STAGE(PG8_SA(1, 0), cA + kstep, cv0); PG8_STAGE(PG8_SB(1, 1), cB + hstep + kstep, voffB);
    PG8_WAIT_V(6); PG8_BAR;
    for (;;) {
        const bool has_next = S.next(ui + 1, nxt);
        const char* nA = has_next ? ab.abase(nxt) : cA; const char* nB = has_next ? ab.bbase(nxt) : cB;
        if constexpr (AB::GATHER) {
            if (has_next) { const int* tp = ab.tokp(nxt);
                asm volatile("global_load_dword %0, %1, off" : "=v"(ntok[0]) : "v"(tp + Rr[0]) : "memory");
                asm volatile("global_load_dword %0, %1, off" : "=v"(ntok[1]) : "v"(tp + Rr[1]) : "memory");
                asm volatile("global_load_dword %0, %1, off" : "=v"(ntok[2]) : "v"(tp + HALF + Rr[0]) : "memory");
                asm volatile("global_load_dword %0, %1, off" : "=v"(ntok[3]) : "v"(tp + HALF + Rr[1]) : "memory"); }
        }
        for (int t = 0; t < nt; t += 2) {
            const bool last = (t == nt - 2);
            const char* a1 = cA + (size_t)(t + 1) * kstep;
            const char* a2 = last ? nA : cA + (size_t)(t + 2) * kstep; const char* b2 = last ? nB : cB + (size_t)(t + 2) * kstep;
            const char* a3 = a2 + kstep; const char* b3 = b2 + kstep;
            unsigned x0[2], x1[2];
            if constexpr (AB::GATHER) {
                if (last && has_next) {
                    asm volatile("s_waitcnt vmcnt(6)" : "+v"(ntok[0]), "+v"(ntok[1]), "+v"(ntok[2]), "+v"(ntok[3]) :: "memory");
#pragma unroll
                    for (int i = 0; i < 2; ++i) { int t0 = ntok[i], t1 = ntok[2 + i]; t0 = t0 < 0 ? 0 : t0; t1 = t1 < 0 ? 0 : t1;
                        nv0[i] = (unsigned)(t0 * K + Cc[i]) * 2u; nv1[i] = (unsigned)(t1 * K + Cc[i]) * 2u; }
                }
#pragma unroll
                for (int i = 0; i < 2; ++i) { x0[i] = last ? nv0[i] : cv0[i]; x1[i] = last ? nv1[i] : cv1[i]; }
            } else {
#pragma unroll
                for (int i = 0; i < 2; ++i) { x0[i] = cv0[i]; x1[i] = cv1[i]; }
            }
            PG8_LDB(B0, 0, 0); PG8_LDB(B1, 0, 1); PG8_SCHED; PG8_LDA(At, 0, 0); PG8_STAGE(PG8_SA(1, 1), a1, cv1);
            PG8_WAIT_V(8); PG8_WAIT_L(0); PG8_BAR; PG8_MMA(0, 0, At, B0); PG8_MMA(0, 1, At, B1); PG8_BAR; PG8_SCHED;
            PG8_LDA(At, 0, 1); PG8_STAGE(PG8_SB(0, 0), b2, voffB); PG8_STAGE(PG8_SB(0, 1), b2 + hstep, voffB); PG8_STAGE(PG8_SA(0, 0), a2, x0);
            PG8_WAIT_V(8); PG8_WAIT_L(0); PG8_BAR; PG8_MMA(1, 0, At, B0); PG8_MMA(1, 1, At, B1); PG8_BAR; PG8_SCHED;
            PG8_LDB(B0, 1, 0); PG8_LDB(B1, 1, 1); PG8_SCHED; PG8_LDA(At, 1, 0); PG8_STAGE(PG8_SA(0, 1), a2, x1);
            PG8_WAIT_V(8); PG8_WAIT_L(0); PG8_BAR; PG8_MMA(0, 0, At, B0); PG8_MMA(0, 1, At, B1); PG8_BAR; PG8_SCHED;
            PG8_LDA(At, 1, 1); PG8_STAGE(PG8_SB(1, 0), b3, voffB); PG8_STAGE(PG8_SB(1, 1), b3 + hstep, voffB); PG8_STAGE(PG8_SA(1, 0), a3, x0);
            PG8_WAIT_V(8); PG8_WAIT_L(0); PG8_BAR; PG8_MMA(1, 0, At, B0); PG8_MMA(1, 1, At, B1); PG8_BAR; PG8_SCHED;
        }
        if constexpr (ALIGN_EPI) { if (wr == 0) PG8_BAR; }
        E(acc, cur, wr, wc, fr, fq);
        if (!has_next) break;
#pragma unroll
        for (int a = 0; a < 2; ++a)
#pragma unroll
            for (int b = 0; b < 2; ++b)
#pragma unroll
                for (int m = 0; m < 4; ++m)
#pragma unroll
                    for (int n = 0; n < 2; ++n) acc[a][b][m][n] = (acc_t){0, 0, 0, 0};
        cur = nxt; cA = nA; cB = nB; ++ui;
#pragma unroll
        for (int i = 0; i < 2; ++i) { cv0[i] = nv0[i]; cv1[i] = nv1[i]; }
        if constexpr (ALIGN_EPI) { if (wr == 1) PG8_BAR; }
    }
    PG8_WAIT_V(0);
    if constexpr (!ALIGN_EPI) { if (wr == 0) PG8_BAR; }
    PG8_BAR;
#undef PG8_SA
#undef PG8_SB
#undef PG8_STAGE
#undef PG8_LDA
#undef PG8_LDB
#undef PG8_MMA
#undef PG8_WAIT_V
#undef PG8_WAIT_L
#undef PG8_BAR
#undef PG8_SCHED
}
}

namespace moba {
using bf16 = __hip_bfloat16;
using bf16x8 = __attribute__((ext_vector_type(8))) short;
using s16x4  = __attribute__((ext_vector_type(4))) short;
using f32x16 = __attribute__((ext_vector_type(16))) float;
using u32x4  = __attribute__((ext_vector_type(4))) unsigned;
constexpr int D = 128, NW = 8, QBLK = 32, KVBLK = 64, LDK = 3072, NT = 4;
constexpr float THR = 8.f;
constexpr size_t SHM_V = KVBLK * D * 2, SHM_K = KVBLK * D * 2, SHM_ATTN = 2 * SHM_V + 2 * SHM_K + NW * 64 * 4;
#define KSWZ(row, colB) ((row) * 256 + ((colB) ^ (((row) & 7) << 4)))
#define SBAR() __builtin_amdgcn_sched_barrier(0)
__device__ __forceinline__ int crow(int r, int hi) { return (r & 3) + 8 * (r >> 2) + 4 * hi; }
__device__ __forceinline__ unsigned cvtpk(float lo, float hi) { unsigned r; asm volatile("v_cvt_pk_bf16_f32 %0, %1, %2" : "=v"(r) : "v"(lo), "v"(hi)); return r; }
__device__ __forceinline__ void partialSM(f32x16& p0, f32x16& p1, float& m_reg, float& mn, float& alpha) {
  float pmax = p0[0];
#pragma unroll
  for (int r = 1; r < 16; ++r) pmax = fmaxf(pmax, p0[r]);
#pragma unroll
  for (int r = 0; r < 16; ++r) pmax = fmaxf(pmax, p1[r]);
  { auto rr = __builtin_amdgcn_permlane32_swap(__float_as_uint(pmax), __float_as_uint(pmax), false, false);
    pmax = fmaxf(__uint_as_float(rr[0]), __uint_as_float(rr[1])); }
  if (__builtin_expect(__all(pmax - m_reg <= THR), 1)) { mn = m_reg; alpha = 1.f; }
  else { mn = fmaxf(m_reg, pmax); alpha = __builtin_amdgcn_exp2f(m_reg - mn); m_reg = mn; }
#pragma unroll
  for (int r = 0; r < 16; ++r) p0[r] = p0[r] - mn;
#pragma unroll
  for (int r = 0; r < 16; ++r) p1[r] = p1[r] - mn;
#pragma unroll
  for (int r = 0; r < 16; ++r) p0[r] = __builtin_amdgcn_exp2f(p0[r]);
}
__device__ __forceinline__ void finishSM(f32x16& p0, f32x16& p1, float alpha, float& l_reg, bf16x8& pa0, bf16x8& pa1, bf16x8& pa2, bf16x8& pa3) {
#pragma unroll
  for (int r = 0; r < 16; ++r) p1[r] = __builtin_amdgcn_exp2f(p1[r]);
  float ps = 0;
#pragma unroll
  for (int r = 0; r < 16; ++r) ps += p0[r];
#pragma unroll
  for (int r = 0; r < 16; ++r) ps += p1[r];
  { auto rr = __builtin_amdgcn_permlane32_swap(__float_as_uint(ps), __float_as_uint(ps), false, false);
    ps = __uint_as_float(rr[0]) + __uint_as_float(rr[1]); }
  l_reg = l_reg * alpha + ps;
#define PK4(P, BASE, OUT) do { unsigned a0 = cvtpk(P[BASE + 0], P[BASE + 1]), a1 = cvtpk(P[BASE + 2], P[BASE + 3]);   \
    unsigned b0 = cvtpk(P[BASE + 4], P[BASE + 5]), b1 = cvtpk(P[BASE + 6], P[BASE + 7]);                              \
    auto r0 = __builtin_amdgcn_permlane32_swap(a0, b0, false, false); auto r1 = __builtin_amdgcn_permlane32_swap(a1, b1, false, false); \
    u32x4 w = {r0[0], r1[0], r0[1], r1[1]}; OUT = *reinterpret_cast<bf16x8*>(&w); } while (0)
  PK4(p0, 0, pa0); PK4(p0, 8, pa1); PK4(p1, 0, pa2); PK4(p1, 8, pa3);
#undef PK4
}
__device__ __forceinline__ void qkt(f32x16& p0, f32x16& p1, const bf16* Ks, const bf16x8* qr, int r32, int hi) {
  p0 = f32x16{}; p1 = f32x16{};
#pragma unroll
  for (int d0 = 0; d0 < 8; ++d0) { int cb = (d0 * 16 + hi * 8) * 2;
    bf16x8 b0 = *reinterpret_cast<const bf16x8*>((const char*)Ks + KSWZ(r32, cb));
    bf16x8 b1 = *reinterpret_cast<const bf16x8*>((const char*)Ks + KSWZ(32 + r32, cb));
    p0 = __builtin_amdgcn_mfma_f32_32x32x16_bf16(b0, qr[d0], p0, 0, 0, 0);
    p1 = __builtin_amdgcn_mfma_f32_32x32x16_bf16(b1, qr[d0], p1, 0, 0, 0); }
}
__device__ __forceinline__ int v_st(int k, int c) { const int kk = (k & ~0xC) | ((k & 4) << 1) | ((k & 8) >> 1); return ((kk >> 3) * 4 + (c >> 5)) * 512 + ((kk & 7) * 32 + (c & 31)) * 2; }
__device__ __forceinline__ int v_rd_base(int lane) { return ((lane & 3) << 3) | (((lane >> 2) & 3) << 6) | (((lane >> 4) & 1) << 5) | (((lane >> 5) & 1) << 8); }
constexpr int v_rd_off(int d0, int ks, int half) { return d0 * 512 + ks * 4096 + half * 2048; }
template <int OFF> __device__ __forceinline__ s16x4 tr_read(int vb) {
  s16x4 r; asm volatile("ds_read_b64_tr_b16 %0, %1 offset:%2" : "=&v"(r) : "v"(vb), "i"(OFF) : "memory"); return r;
}
template <int D0> __device__ __forceinline__ void pv_one(f32x16& od, int vb, bf16x8 pa0, bf16x8 pa1, bf16x8 pa2, bf16x8 pa3) {
  const s16x4 l0 = tr_read<v_rd_off(D0, 0, 0)>(vb), h0 = tr_read<v_rd_off(D0, 0, 1)>(vb), l1 = tr_read<v_rd_off(D0, 1, 0)>(vb), h1 = tr_read<v_rd_off(D0, 1, 1)>(vb);
  const s16x4 l2 = tr_read<v_rd_off(D0, 2, 0)>(vb), h2 = tr_read<v_rd_off(D0, 2, 1)>(vb), l3 = tr_read<v_rd_off(D0, 3, 0)>(vb), h3 = tr_read<v_rd_off(D0, 3, 1)>(vb);
  asm volatile("s_waitcnt lgkmcnt(0)" ::: "memory"); SBAR();
#define PK(L, H) (bf16x8){L[0], L[1], L[2], L[3], H[0], H[1], H[2], H[3]}
  od = __builtin_amdgcn_mfma_f32_32x32x16_bf16(pa0, PK(l0, h0), od, 0, 0, 0);
  od = __builtin_amdgcn_mfma_f32_32x32x16_bf16(pa1, PK(l1, h1), od, 0, 0, 0);
  od = __builtin_amdgcn_mfma_f32_32x32x16_bf16(pa2, PK(l2, h2), od, 0, 0, 0);
  od = __builtin_amdgcn_mfma_f32_32x32x16_bf16(pa3, PK(l3, h3), od, 0, 0, 0);
#undef PK
}
__device__ __forceinline__ void pv_d0(f32x16* o, int vb, bf16x8 pa0, bf16x8 pa1, bf16x8 pa2, bf16x8 pa3) {
  pv_one<0>(o[0], vb, pa0, pa1, pa2, pa3); pv_one<1>(o[1], vb, pa0, pa1, pa2, pa3); pv_one<2>(o[2], vb, pa0, pa1, pa2, pa3); pv_one<3>(o[3], vb, pa0, pa1, pa2, pa3);
}
__device__ __forceinline__ void cmask(f32x16& p0, f32x16& p1, int tile, int ql, int hi) {
  asm volatile("" : "+v"(ql));
#pragma unroll
  for (int r = 0; r < 16; ++r) { const int kv = 64 * tile + (r & 3) + 8 * (r >> 2) + 4 * hi; if (kv > ql) p0[r] = -1e30f; if (kv + 32 > ql) p1[r] = -1e30f; }
}
__device__ __forceinline__ void moba_unit(const bool OWN, const bf16* qrow, const bf16* __restrict__ Kh, const bf16* __restrict__ Vh, bf16* obase, int ostride, int dst, float* ml, int mli, int ql, char* lds) {
  const int tid = threadIdx.x, wid = tid >> 6, lane = tid & 63, r32 = lane & 31, hi = lane >> 5;
  bf16* V_lds = (bf16*)lds; bf16* K_lds = (bf16*)(lds + 2 * SHM_V);
  float* ws = (float*)(lds + 2 * SHM_V + 2 * SHM_K) + wid * 64; float* li_l = ws; float* al_l = ws + 32;
  float m_reg = -1e30f, l_reg = 0; f32x16 o[4] = {}; bf16x8 qr[8];
  const bf16* Qw = qrow + hi * 8;
#pragma unroll
  for (int d0 = 0; d0 < 8; ++d0) qr[d0] = *reinterpret_cast<const bf16x8*>(Qw + d0 * 16);
  const int sr = tid >> 4, sc = (tid & 15) * 8, vst0 = v_st(sr, sc), vst1 = v_st(32 + sr, sc);
  const int vb0 = (int)(uintptr_t)V_lds + v_rd_base(lane);
  struct { bf16x8 vs0, vs1, ks0, ks1; } sr_[2];
#define SLOAD(i, k0) do { sr_[i].vs0 = *reinterpret_cast<const bf16x8*>(&Vh[(long)((k0) + sr) * LDK + sc]); sr_[i].vs1 = *reinterpret_cast<const bf16x8*>(&Vh[(long)((k0) + 32 + sr) * LDK + sc]); \
    sr_[i].ks0 = *reinterpret_cast<const bf16x8*>(&Kh[(long)((k0) + sr) * LDK + sc]); sr_[i].ks1 = *reinterpret_cast<const bf16x8*>(&Kh[(long)((k0) + 32 + sr) * LDK + sc]); } while (0)
#define SWRITE(b, i) do { *(bf16x8*)((char*)V_lds + (b) * SHM_V + vst0) = sr_[i].vs0;          \
    *(bf16x8*)((char*)V_lds + (b) * SHM_V + vst1) = sr_[i].vs1; int kc = sc * 2;               \
    *(bf16x8*)((char*)K_lds + (b) * SHM_K + KSWZ(sr, kc)) = sr_[i].ks0;                       \
    *(bf16x8*)((char*)K_lds + (b) * SHM_K + KSWZ(32 + sr, kc)) = sr_[i].ks1; } while (0)
#define SWAIT() asm volatile("s_waitcnt vmcnt(4)" ::: "memory")
#define RESC(a) do { if (__any((a) < 1.f)) { if (hi == 0) al_l[r32] = (a); asm volatile("s_waitcnt lgkmcnt(0)" ::: "memory"); \
    _Pragma("unroll") for (int d = 0; d < 4; ++d) _Pragma("unroll") for (int r = 0; r < 16; ++r) o[d][r] *= al_l[crow(r, hi)]; } } while (0)
  f32x16 pA0, pA1, pB0, pB1; float mnA, mnB, alA, alB; bf16x8 pa0, pa1, pa2, pa3;
  constexpr int SE = 0, SO = 1;
  SLOAD(SE, 0); asm volatile("s_waitcnt vmcnt(0)" ::: "memory"); SWRITE(0, SE); __syncthreads();
  qkt(pA0, pA1, K_lds, qr, r32, hi); if (OWN) cmask(pA0, pA1, 0, ql, hi); partialSM(pA0, pA1, m_reg, mnA, alA);
  SLOAD(SO, KVBLK); SLOAD(SE, 2 * KVBLK);
  SWAIT(); SWRITE(1, SO); __syncthreads();
  {
    SBAR(); qkt(pB0, pB1, (bf16*)((char*)K_lds + SHM_K), qr, r32, hi);
    finishSM(pA0, pA1, alA, l_reg, pa0, pa1, pa2, pa3); SBAR();
    SLOAD(SO, 3 * KVBLK); SBAR();
    pv_d0(o, vb0, pa0, pa1, pa2, pa3); if (OWN) cmask(pB0, pB1, 1, ql, hi); partialSM(pB0, pB1, m_reg, mnB, alB);
    __syncthreads(); SWAIT(); SWRITE(0, SE);
    RESC(alB); __syncthreads();
    SBAR(); qkt(pA0, pA1, K_lds, qr, r32, hi);
    finishSM(pB0, pB1, alB, l_reg, pa0, pa1, pa2, pa3); SBAR();
    pv_d0(o, vb0 + (int)SHM_V, pa0, pa1, pa2, pa3); if (OWN) cmask(pA0, pA1, 2, ql, hi); partialSM(pA0, pA1, m_reg, mnA, alA);
    __syncthreads(); asm volatile("s_waitcnt vmcnt(0)" ::: "memory"); SWRITE(1, SO);
    RESC(alA); __syncthreads();
  }
  SBAR(); qkt(pB0, pB1, (bf16*)((char*)K_lds + SHM_K), qr, r32, hi);
  finishSM(pA0, pA1, alA, l_reg, pa0, pa1, pa2, pa3); SBAR();
  pv_d0(o, vb0, pa0, pa1, pa2, pa3); if (OWN) cmask(pB0, pB1, 3, ql, hi); partialSM(pB0, pB1, m_reg, mnB, alB);
  __syncthreads(); RESC(alB);
  finishSM(pB0, pB1, alB, l_reg, pa0, pa1, pa2, pa3); SBAR();
  pv_d0(o, vb0 + (int)SHM_V, pa0, pa1, pa2, pa3);
  if (hi == 0) li_l[r32] = l_reg; asm volatile("s_waitcnt lgkmcnt(0)" ::: "memory");
  float rli[16];
#pragma unroll
  for (int r = 0; r < 16; ++r) rli[r] = __builtin_amdgcn_rcpf(li_l[crow(r, hi)]);
  __syncthreads();
  bf16* stg = (bf16*)lds + wid * 4096;
#pragma unroll
  for (int r = 0; r < 16; ++r) { const int orow = crow(r, hi);
#pragma unroll
    for (int d0 = 0; d0 < 4; ++d0) stg[orow * 128 + d0 * 32 + r32] = __float2bfloat16(o[d0][r] * rli[r]); }
  int* dsto = (int*)al_l;
  if (hi == 0) dsto[r32] = dst;
  asm volatile("s_waitcnt lgkmcnt(0)" ::: "memory");
#pragma unroll
  for (int i = 0; i < 8; ++i) { const int row = i * 4 + (lane >> 4), ch = lane & 15; const int di = dsto[row]; const u32x4 v = *(const u32x4*)(stg + row * 128 + ch * 8);
    if (di >= 0) *(u32x4*)(obase + (size_t)di * ostride + ch * 8) = v; }
  if (hi == 0 && dst >= 0) { ml[2 * (size_t)mli] = m_reg; ml[2 * (size_t)mli + 1] = l_reg; }
  asm volatile("s_waitcnt lgkmcnt(0)" ::: "memory");
  __syncthreads();
#undef SLOAD
#undef SWRITE
#undef SWAIT
#undef RESC
}

#define KSWZ64(row, colB) ((row) * 128 + ((colB) ^ ((((row) >> 1) & 7) << 4)))
constexpr size_t DA_SHM_K = 64 * 64 * 2;
constexpr size_t DA_SHM = 2 * SHM_V + 2 * DA_SHM_K + NW * 64 * 4;
__device__ __forceinline__ void qkt64(f32x16& p0, f32x16& p1, const bf16* Ks, const bf16x8* qr, int r32, int hi) {
  p0 = f32x16{}; p1 = f32x16{};
#pragma unroll
  for (int d0 = 0; d0 < 4; ++d0) { int cb = (d0 * 16 + hi * 8) * 2;
    bf16x8 b0 = *reinterpret_cast<const bf16x8*>((const char*)Ks + KSWZ64(r32, cb));
    bf16x8 b1 = *reinterpret_cast<const bf16x8*>((const char*)Ks + KSWZ64(32 + r32, cb));
    p0 = __builtin_amdgcn_mfma_f32_32x32x16_bf16(b0, qr[d0], p0, 0, 0, 0);
    p1 = __builtin_amdgcn_mfma_f32_32x32x16_bf16(b1, qr[d0], p1, 0, 0, 0); }
}
__device__ __forceinline__ void dattn_unit(const bf16* Qb, const bf16* __restrict__ Kh, const bf16* __restrict__ Vh, bf16* Ob, const int NT, char* lds) {
  const int tid = threadIdx.x, wid = tid >> 6, lane = tid & 63, r32 = lane & 31, hi = lane >> 5;
  bf16* V_lds = (bf16*)lds; bf16* K_lds = (bf16*)(lds + 2 * SHM_V);
  float* ws = (float*)(lds + 2 * SHM_V + 2 * DA_SHM_K) + wid * 64; float* li_l = ws; float* al_l = ws + 32;
  float m_reg = -1e30f, l_reg = 0; f32x16 o[4] = {}; bf16x8 qr[4];
  const bf16* Qw = Qb + (long)(wid * QBLK + r32) * LDK + hi * 8;
#pragma unroll
  for (int d0 = 0; d0 < 4; ++d0) qr[d0] = *reinterpret_cast<const bf16x8*>(Qw + d0 * 16);
  const int sr = tid >> 4, sc = (tid & 15) * 8, vst0 = v_st(sr, sc), vst1 = v_st(32 + sr, sc);
  const int kr = tid >> 3, kc = (tid & 7) * 8, kst = KSWZ64(kr, kc * 2);
  const int vb0 = (int)(uintptr_t)V_lds + v_rd_base(lane);
  const int ql = wid * QBLK + r32;
  struct { bf16x8 vs0, vs1, ks; } sr_[2];
#define SLOAD(i, k0) do { sr_[i].vs0 = *reinterpret_cast<const bf16x8*>(&Vh[(long)((k0) + sr) * LDK + sc]); sr_[i].vs1 = *reinterpret_cast<const bf16x8*>(&Vh[(long)((k0) + 32 + sr) * LDK + sc]); \
    sr_[i].ks = *reinterpret_cast<const bf16x8*>(&Kh[(long)((k0) + kr) * LDK + kc]); } while (0)
#define SWRITE(b, i) do { *(bf16x8*)((char*)V_lds + (b) * SHM_V + vst0) = sr_[i].vs0; *(bf16x8*)((char*)V_lds + (b) * SHM_V + vst1) = sr_[i].vs1; \
    *(bf16x8*)((char*)K_lds + (b) * DA_SHM_K + kst) = sr_[i].ks; } while (0)
#define SWAIT() asm volatile("s_waitcnt vmcnt(3)" ::: "memory")
#define RESC(a) do { if (__any((a) < 1.f)) { if (hi == 0) al_l[r32] = (a); asm volatile("s_waitcnt lgkmcnt(0)" ::: "memory"); \
    _Pragma("unroll") for (int d = 0; d < 4; ++d) _Pragma("unroll") for (int r = 0; r < 16; ++r) o[d][r] *= al_l[crow(r, hi)]; } } while (0)
#define MASK(P0, P1, t) do { if ((t) >= NT - 4) cmask(P0, P1, (t) - (NT - 4), ql, hi); } while (0)
  f32x16 pA0, pA1, pB0, pB1; float mnA, mnB, alA, alB; bf16x8 pa0, pa1, pa2, pa3;
  constexpr int SE = 0, SO = 1;
  SLOAD(SE, 0); asm volatile("s_waitcnt vmcnt(0)" ::: "memory"); SWRITE(0, SE); __syncthreads();
  qkt64(pA0, pA1, K_lds, qr, r32, hi); MASK(pA0, pA1, 0); partialSM(pA0, pA1, m_reg, mnA, alA);
  SLOAD(SO, KVBLK); SLOAD(SE, 2 * KVBLK);
  SWAIT(); SWRITE(1, SO); __syncthreads();
  for (int j = 1; j + 1 < NT; j += 2) {
    SBAR(); qkt64(pB0, pB1, (bf16*)((char*)K_lds + DA_SHM_K), qr, r32, hi);
    finishSM(pA0, pA1, alA, l_reg, pa0, pa1, pa2, pa3); SBAR();
    SLOAD(SO, (j + 2) * KVBLK); SBAR();
    pv_d0(o, vb0, pa0, pa1, pa2, pa3); MASK(pB0, pB1, j); partialSM(pB0, pB1, m_reg, mnB, alB);
    __syncthreads(); SWAIT(); SWRITE(0, SE);
    RESC(alB); __syncthreads();
    SBAR(); qkt64(pA0, pA1, K_lds, qr, r32, hi);
    finishSM(pB0, pB1, alB, l_reg, pa0, pa1, pa2, pa3); SBAR();
    if (j + 3 < NT) SLOAD(SE, (j + 3) * KVBLK); SBAR();
    pv_d0(o, vb0 + (int)SHM_V, pa0, pa1, pa2, pa3); MASK(pA0, pA1, j + 1); partialSM(pA0, pA1, m_reg, mnA, alA);
    __syncthreads(); SWAIT(); SWRITE(1, SO);
    RESC(alA); __syncthreads();
  }
  SBAR(); qkt64(pB0, pB1, (bf16*)((char*)K_lds + DA_SHM_K), qr, r32, hi);
  finishSM(pA0, pA1, alA, l_reg, pa0, pa1, pa2, pa3); SBAR();
  pv_d0(o, vb0, pa0, pa1, pa2, pa3); MASK(pB0, pB1, NT - 1); partialSM(pB0, pB1, m_reg, mnB, alB);
  __syncthreads(); RESC(alB);
  finishSM(pB0, pB1, alB, l_reg, pa0, pa1, pa2, pa3); SBAR();
  pv_d0(o, vb0 + (int)SHM_V, pa0, pa1, pa2, pa3);
  if (hi == 0) li_l[r32] = l_reg; asm volatile("s_waitcnt lgkmcnt(0)" ::: "memory");
  float rli[16];
#pragma unroll
  for (int r = 0; r < 16; ++r) rli[r] = __builtin_amdgcn_rcpf(li_l[crow(r, hi)]);
  __syncthreads();
  bf16* stg = (bf16*)lds + wid * 4096;
#pragma unroll
  for (int r = 0; r < 16; ++r) { const int orow = crow(r, hi);
#pragma unroll
    for (int d0 = 0; d0 < 4; ++d0) stg[orow * 128 + d0 * 32 + r32] = __float2bfloat16(o[d0][r] * rli[r]); }
  asm volatile("s_waitcnt lgkmcnt(0)" ::: "memory");
#pragma unroll
  for (int i = 0; i < 8; ++i) { const int row = i * 4 + (lane >> 4), ch = lane & 15; const u32x4 v = *(const u32x4*)(stg + row * 128 + ch * 8);
    *(u32x4*)(Ob + (size_t)(wid * QBLK + row) * 2048 + ch * 8) = v; }
  asm volatile("s_waitcnt lgkmcnt(0)" ::: "memory");
  __syncthreads();
#undef SLOAD
#undef SWRITE
#undef SWAIT
#undef RESC
#undef MASK
}
struct DaUnit { int bqh; int qb; };
struct DaOrder {
  int vcu, G;
  __device__ __forceinline__ DaOrder(int vcu_, int G_) : vcu(vcu_), G(G_) {}
  __device__ __forceinline__ bool next(int i, DaUnit& u) const {
    if (G == 256) { if (i >= 8) return false; const int s = vcu & 7, ii = i & 3; u.bqh = (i >> 2) * 32 + (vcu >> 3); u.qb = (ii == 0) ? s : (ii == 1) ? 15 - s : (ii == 2) ? 16 + s : 31 - s; return true; }
    const int uu = vcu + i * G; if (uu >= 2048) return false; u.bqh = uu >> 5; u.qb = uu & 31; return true; }
};
template <class Sched> __device__ __forceinline__ void dattn_phase(char* lds, const bf16* QKV, bf16* O, const Sched& S) {
  DaUnit u;
  for (int i = 0; S.next(i, u); ++i) { const int b = u.bqh >> 4, qh = u.bqh & 15; const size_t rb = (size_t)b * 8192;
    dattn_unit(QKV + (rb + u.qb * 256) * LDK + qh * 64, QKV + rb * LDK + 1024 + qh * 64, QKV + rb * LDK + 2048 + (qh >> 1) * 128, O + (rb + u.qb * 256) * 2048 + qh * 128, 4 * (u.qb + 1), lds); }
}
#undef KSWZ64
#undef KSWZ
#undef SBAR
}
#define GAS __attribute__((address_space(1)))
#define LAS __attribute__((address_space(3)))
typedef unsigned short bf16;
typedef unsigned v4u __attribute__((ext_vector_type(4)));
typedef float f32x4 __attribute__((ext_vector_type(4)));
typedef short bf16x8 __attribute__((ext_vector_type(8)));
typedef GAS unsigned gu32;
typedef GAS unsigned long long gu64;
#define RLX_AGENT __ATOMIC_RELAXED, __HIP_MEMORY_SCOPE_AGENT
#define LDS_WAIT() asm volatile("s_waitcnt lgkmcnt(0)" ::: "memory")
#define VM_WAIT() asm volatile("s_waitcnt vmcnt(0)" ::: "memory")
__device__ __forceinline__ unsigned long long rt() { return __builtin_amdgcn_s_memrealtime(); }
__device__ __forceinline__ unsigned f2bf(float f) { unsigned u = __builtin_bit_cast(unsigned, f); return (u + 0x7fffu + ((u >> 16) & 1u)) >> 16; }
__device__ __forceinline__ unsigned pk2(float lo, float hi) { return f2bf(lo) | (f2bf(hi) << 16); }
#define XB_TMO      128
#define XB_XCNT(j)  (256  + 64 * (j))
#define XB_XSUB(j)  (1280 + 64 * (j))
#define XB_XGEN(j)  (2304 + 64 * (j))
#define XB_TOP      3328
#define XB_TOPGEN   3392
#define XCD_BAR_WORDS 3456
#define XB_SPIN_CAP (1u << 18)

__device__ __forceinline__ unsigned xb_ld(unsigned* p)              { return __hip_atomic_load(p, __ATOMIC_RELAXED, __HIP_MEMORY_SCOPE_AGENT); }
__device__ __forceinline__ unsigned xb_add(unsigned* p, unsigned v) { return __hip_atomic_fetch_add(p, v, __ATOMIC_RELAXED, __HIP_MEMORY_SCOPE_AGENT); }
__device__ __forceinline__ unsigned xb_xcc_id() { return (unsigned)__builtin_amdgcn_s_getreg((3 << 11) | 20) & 0xFu; }
#define XB_SPIN(cond, bar) do { unsigned _sp = 0; while (cond) { __builtin_amdgcn_s_sleep(1); \
    if ((++_sp & 255u) == 0u) { if (xb_ld(&(bar)[XB_TMO])) break; if (_sp > XB_SPIN_CAP) { atomicAdd(&(bar)[XB_TMO], 1u); break; } } } } while (0)

struct XcdBarrier {
    unsigned* bar; unsigned x;
    volatile LAS unsigned* st;
};

__device__ __forceinline__ XcdBarrier xcd_barrier_post(unsigned* bar, volatile LAS unsigned* st) {
    XcdBarrier b; b.bar = bar; b.x = xb_xcc_id(); b.st = st;
    if (threadIdx.x == 0) (void)xb_add(&bar[XB_XCNT(b.x)], 1u);
    return b;
}
__device__ __forceinline__ void xcd_barrier_complete(unsigned* bar, unsigned x, unsigned& nloc, unsigned& nx) {
    const unsigned G = gridDim.x * gridDim.y * gridDim.z;
    unsigned sum, cnt, mine, sp = 0u;
    for (;;) {
        sum = 0u; cnt = 0u; mine = 0u;
#pragma unroll
        for (unsigned j = 0; j < 16; ++j) { const unsigned c = xb_ld(&bar[XB_XCNT(j)]); sum += c; cnt += (c > 0u) ? 1u : 0u; mine = (j == x) ? c : mine; }
        if (sum == G) break;
        __builtin_amdgcn_s_sleep(1);
        if ((++sp & 255u) == 0u) { if (xb_ld(&bar[XB_TMO])) break; if (sp > XB_SPIN_CAP) { atomicAdd(&bar[XB_TMO], 1u); break; } }
    }
    nloc = mine > 0u ? mine : 1u; nx = cnt > 0u ? cnt : 1u;
}

__device__ __forceinline__ void xcd_barrier(const XcdBarrier& b) {
    asm volatile("s_waitcnt vmcnt(0)" ::: "memory");
    __syncthreads();
    if (threadIdx.x == 0) {
        unsigned* bar = b.bar;
        __builtin_amdgcn_s_waitcnt(0);
        unsigned nloc = b.st[0], nx = b.st[1];
        if (nloc == 0u) { xcd_barrier_complete(bar, b.x, nloc, nx); b.st[0] = nloc; b.st[1] = nx; }
        const unsigned old = xb_add(&bar[XB_XSUB(b.x)], 1u);
        const unsigned gen = old / nloc;
        if (old + 1u == (gen + 1u) * nloc) {
            __builtin_amdgcn_fence(__ATOMIC_RELEASE, "agent");
            asm volatile("s_waitcnt vmcnt(0)" ::: "memory");
            const unsigned og = xb_add(&bar[XB_TOP], 1u);
            const unsigned tg = og / nx;
            if (og + 1u == (tg + 1u) * nx) xb_add(&bar[XB_TOPGEN], 1u);
            else XB_SPIN(xb_ld(&bar[XB_TOPGEN]) == tg, bar);
            __builtin_amdgcn_fence(__ATOMIC_ACQUIRE, "agent");
            xb_add(&bar[XB_XGEN(b.x)], 1u);
            asm volatile("s_waitcnt vmcnt(0)" ::: "memory");
        } else {
            XB_SPIN(xb_ld(&bar[XB_XGEN(b.x)]) == gen, bar);
            __builtin_amdgcn_fence(__ATOMIC_ACQUIRE, "agent");
            asm volatile("s_waitcnt vmcnt(0)" ::: "memory");
        }
    }
    __syncthreads();
}

constexpr int NWAVES = 8;
#ifndef GEMM_ALIGN
#define GEMM_ALIGN true
#endif
#ifndef MK_PER_PHASE
#define MK_PER_PHASE 0
#endif
constexpr int BATCH = 4, SEQ = 8192, DM = 1024, TOK = BATCH * SEQ;
constexpr int FF0 = 2816, NEXP = 8, FF1 = 3584;
constexpr int NQKV = 3072;
constexpr int MB_H = 8, MB_NB = 32, MB_L = 256;
constexpr int SLOTS = TOK + NEXP * 256;
constexpr float NORM_EPS = 1e-6f, SUBLN_EPS = 1e-5f;
constexpr float LAMBDA_INIT0 = 0.2f;
constexpr float LOG2E = 1.4426950408889634f;
constexpr int LIST_PER_BH = 256 * 496;
__host__ __device__ constexpr int list_off(int j) { return 256 * (31 * j - (j * (j - 1)) / 2); }

constexpr size_t MiB = 1u << 20;
constexpr size_t WS_CTL = 0, CTL_ZERO_BYTES = 3 * MiB;
constexpr size_t WS_CMAX13 = 2 * MiB;
constexpr size_t WS_CMAX2 = WS_CMAX13 + 256 * 1024;
constexpr size_t WS_SSTOT = WS_CMAX2 + 64 * 1024;
constexpr size_t WS_ROPE64 = 3 * MiB;
constexpr size_t WS_ROPE128 = WS_ROPE64 + 512 * 1024;
constexpr size_t WS_KMEAN = WS_ROPE128 + 1 * MiB;
constexpr size_t WS_TOK = 5 * MiB;
constexpr size_t WS_SLOT = 6 * MiB;
constexpr size_t WS_SA = 7 * MiB;
constexpr size_t WS_OWNML = 41 * MiB;
constexpr size_t WS_W0QKV = 8 * MiB, WS_W0O = 14 * MiB, WS_W013 = 16 * MiB, WS_W02 = 27 * MiB, WS_W1QKV = 33 * MiB, WS_W1O = 39 * MiB;
constexpr size_t B0 = 43 * MiB;
constexpr size_t WS_H = B0;
constexpr size_t WS_QKV = B0 + 64 * MiB;
constexpr size_t WS_OATT = B0 + 256 * MiB;
constexpr size_t WS_UD = B0 + 128 * MiB;
constexpr size_t WS_LIST = B0 + 256 * MiB;
constexpr size_t WS_PML = B0 + 272 * MiB;
constexpr size_t WS_PO = B0 + 280 * MiB;
constexpr size_t WS_WM13 = B0 + 64 * MiB;
constexpr size_t WS_WM2 = WS_WM13 + 56 * MiB;
constexpr size_t WS_AQ = WS_WM2 + 28 * MiB;
constexpr size_t WS_UM = B0 + 232 * MiB;
constexpr size_t WS_END = WS_PO + (size_t)TOK * MB_H * 3 * 128 * 2;
static_assert(WS_UM + (size_t)SLOTS * FF1 <= WS_END && WS_AQ + (size_t)TOK * DM <= WS_UM && WS_END <= 528 * MiB, "d_ws map");
constexpr int CW_TMO = 0, CW_CODE = 1, CW_DBG = 2;
constexpr int CW_MOECNT = 64;
constexpr int CW_MOBACNT = 256;
constexpr int CW_BAR = 4096;
constexpr size_t WS_RSS = 1 * MiB;
constexpr int RING_OFF = 0, RING_BYTES = 131072;
constexpr int LDSCTL_OFF = RING_BYTES, MISC_OFF = LDSCTL_OFF + 320;
constexpr int LDS_BYTES = 147456;

struct Args { const float* in[20]; float* out; unsigned char* ws; float inv64[8]; float inv128[16]; int ph_lo, ph_hi; };

__device__ __forceinline__ float wave_sum(float v) {
#pragma unroll
    for (int o = 1; o < 64; o <<= 1) v += __shfl_xor(v, o);
    return v;
}
template <int MAP> __device__ __forceinline__ int maprow(int n) {
    if (MAP == 1) { if (n >= 2048) return n; const int d = n & 63; if (d >= 16) return n; const int b = d >> 3, a = (d >> 2) & 1, c = d & 3; return (n & ~63) + 8 * a + 4 * b + c; }
    if (MAP == 2) { if (n >= 2048) return n; const int d = n & 127; if (d >= 32) return n; const int b = d >> 4, a = (d >> 2) & 3, c = d & 3; return (n & ~127) + 8 * a + 4 * b + c; }
    if (MAP == 3) return 256 * (n >> 7) + (n & 127);
    if (MAP == 4) return 256 * (n >> 7) + 128 + (n & 127);
    return n;
}
template <int MAP> __device__ __forceinline__ void transpose_item(const float* W, int K, int N, bf16* WT, LAS float* scr, int item, int lane, const float* gk = nullptr) {
    const int nblk = N / 32, kb = item / nblk, nb = item % nblk, k0 = 64 * kb, n0 = 32 * nb;
    const int kr = lane >> 3, nc = (lane & 7) * 4;
    f32x4 v[8];
#pragma unroll
    for (int i = 0; i < 8; ++i) v[i] = *(const GAS f32x4*)(W + (size_t)(k0 + i * 8 + kr) * N + n0 + nc);
    if (gk) {
#pragma unroll
        for (int i = 0; i < 8; ++i) v[i] = v[i] * gk[k0 + i * 8 + kr]; }
#pragma unroll
    for (int i = 0; i < 8; ++i) { LAS float* d = scr + (i * 8 + kr) * 33 + nc; d[0] = v[i].x; d[1] = v[i].y; d[2] = v[i].z; d[3] = v[i].w; }
    LDS_WAIT(); asm volatile("" ::: "memory");
    const int c = lane & 7;
#pragma unroll
    for (int j = 0; j < 4; ++j) { const int n = (lane >> 3) + 8 * j; const LAS float* s = scr + (8 * c) * 33 + n;
        v4u o; o.x = pk2(s[0 * 33], s[1 * 33]); o.y = pk2(s[2 * 33], s[3 * 33]); o.z = pk2(s[4 * 33], s[5 * 33]); o.w = pk2(s[6 * 33], s[7 * 33]);
        *(GAS v4u*)(WT + (size_t)maprow<MAP>(n0 + n) * K + k0 + 8 * c) = o; }
    LDS_WAIT(); asm volatile("" ::: "memory");
}

template <int MAP> __device__ __forceinline__ float wmax_strip(const float* W, int N, unsigned* cmax, int kb0, int nkb, int nb, int lane, const float* gk) {
    const int n0 = 32 * nb, kr = lane >> 3, nc = (lane & 7) * 4;
    f32x4 mx = (f32x4){0.f, 0.f, 0.f, 0.f}; float ss = 0.f;
    for (int kb = kb0; kb < kb0 + nkb; ++kb) { const int k0 = 64 * kb;
        f32x4 v[8];
#pragma unroll
        for (int i = 0; i < 8; ++i) v[i] = *(const GAS f32x4*)(W + (size_t)(k0 + i * 8 + kr) * N + n0 + nc);
        if (gk) {
#pragma unroll
            for (int i = 0; i < 8; ++i) v[i] = v[i] * gk[k0 + i * 8 + kr]; }
#pragma unroll
        for (int i = 0; i < 8; ++i) { mx.x = fmaxf(mx.x, fabsf(v[i].x)); mx.y = fmaxf(mx.y, fabsf(v[i].y)); mx.z = fmaxf(mx.z, fabsf(v[i].z)); mx.w = fmaxf(mx.w, fabsf(v[i].w));
            ss += (v[i].x * v[i].x + v[i].y * v[i].y) + (v[i].z * v[i].z + v[i].w * v[i].w); } }
#pragma unroll
    for (int o = 8; o < 64; o <<= 1) { mx.x = fmaxf(mx.x, __shfl_xor(mx.x, o)); mx.y = fmaxf(mx.y, __shfl_xor(mx.y, o)); mx.z = fmaxf(mx.z, __shfl_xor(mx.z, o)); mx.w = fmaxf(mx.w, __shfl_xor(mx.w, o)); }
    if (lane < 8) {
        __hip_atomic_fetch_max(cmax + maprow<MAP>(n0 + nc + 0), __float_as_uint(mx.x), __ATOMIC_RELAXED, __HIP_MEMORY_SCOPE_AGENT);
        __hip_atomic_fetch_max(cmax + maprow<MAP>(n0 + nc + 1), __float_as_uint(mx.y), __ATOMIC_RELAXED, __HIP_MEMORY_SCOPE_AGENT);
        __hip_atomic_fetch_max(cmax + maprow<MAP>(n0 + nc + 2), __float_as_uint(mx.z), __ATOMIC_RELAXED, __HIP_MEMORY_SCOPE_AGENT);
        __hip_atomic_fetch_max(cmax + maprow<MAP>(n0 + nc + 3), __float_as_uint(mx.w), __ATOMIC_RELAXED, __HIP_MEMORY_SCOPE_AGENT); }
    return ss;
}
template <int MAP> __device__ __forceinline__ void transpose_item_q(const float* W, int K, int N, signed char* WT, const unsigned* cmax, LAS float* scr, int item, int lane, const float* gk) {
    const int nblk = N / 32, kb = item / nblk, nb = item % nblk, k0 = 64 * kb, n0 = 32 * nb;
    const int kr = lane >> 3, nc = (lane & 7) * 4;
    f32x4 v[8];
#pragma unroll
    for (int i = 0; i < 8; ++i) v[i] = *(const GAS f32x4*)(W + (size_t)(k0 + i * 8 + kr) * N + n0 + nc);
    if (gk) {
#pragma unroll
        for (int i = 0; i < 8; ++i) v[i] = v[i] * gk[k0 + i * 8 + kr]; }
#pragma unroll
    for (int i = 0; i < 8; ++i) { LAS float* d = scr + (i * 8 + kr) * 33 + nc; d[0] = v[i].x; d[1] = v[i].y; d[2] = v[i].z; d[3] = v[i].w; }
    LDS_WAIT(); asm volatile("" ::: "memory");
    const int half = lane >> 5, n = lane & 31, row = maprow<MAP>(n0 + n);
    const float cm = __uint_as_float(cmax[row]); const float inv = cm > 0.f ? 127.0f / cm : 0.f;
    const LAS float* s = scr + (32 * half) * 33 + n;
    unsigned w[8];
#pragma unroll
    for (int q4 = 0; q4 < 8; ++q4) { unsigned pk = 0;
#pragma unroll
        for (int b = 0; b < 4; ++b) { const int q = (int)__builtin_rintf(s[(4 * q4 + b) * 33] * inv); pk |= (unsigned)(q & 255) << (8 * b); }
        w[q4] = pk; }
    GAS v4u* dst = (GAS v4u*)(WT + (size_t)row * K + k0 + 32 * half);
    dst[0] = (v4u){w[0], w[1], w[2], w[3]}; dst[1] = (v4u){w[4], w[5], w[6], w[7]};
    LDS_WAIT(); asm volatile("" ::: "memory");
}
__device__ __forceinline__ void rms_row(const float* xrow, const f32x4 (&g)[4], f32x4 (&v)[4], int lane) {
    const GAS f32x4* xr = (const GAS f32x4*)xrow + lane; float s = 0.f;
#pragma unroll
    for (int j = 0; j < 4; ++j) { v[j] = xr[64 * j]; s += (v[j].x * v[j].x + v[j].y * v[j].y) + (v[j].z * v[j].z + v[j].w * v[j].w); }
    const float rstd = 1.f / sqrtf(wave_sum(s) * (1.f / DM) + NORM_EPS);
#pragma unroll
    for (int j = 0; j < 4; ++j) v[j] = v[j] * rstd * g[j];
}
__device__ __forceinline__ void store_row_bf16(bf16* orow, const f32x4 (&v)[4], int lane) {
    GAS unsigned long long* o8 = (GAS unsigned long long*)orow + lane;
#pragma unroll
    for (int j = 0; j < 4; ++j) o8[64 * j] = (unsigned long long)pk2(v[j].x, v[j].y) | ((unsigned long long)pk2(v[j].z, v[j].w) << 32);
}
__device__ __forceinline__ void load_gain(const float* g, f32x4 (&gv)[4], int lane) {
#pragma unroll
    for (int j = 0; j < 4; ++j) gv[j] = *((const f32x4*)g + lane + 64 * j);
}
__device__ __forceinline__ void rmsnorm_phase(const float* src, const float* gain, bf16* dst, int gw, int ngw, int lane) {
    f32x4 gv[4]; load_gain(gain, gv, lane);
    for (int m = gw; m < TOK; m += ngw) { f32x4 v[4]; rms_row(src + (size_t)m * DM, gv, v, lane); store_row_bf16(dst + (size_t)m * DM, v, lane); }
}
__device__ __forceinline__ float bf2f(unsigned short b) { return __uint_as_float((unsigned)b << 16); }


typedef __attribute__((address_space(4))) const unsigned char* kaptr_t;
__device__ __forceinline__ kaptr_t ka_get() { kaptr_t p = (kaptr_t)__builtin_amdgcn_kernarg_segment_ptr(); asm volatile("" : "+s"(p)); return p; }
#define KA_IN(k) (*(const float* const __attribute__((address_space(4)))*)(ka + 8 * (k)))
#define PH_PTRS kaptr_t ka = ka_get(); unsigned char* const ws = *(unsigned char* const __attribute__((address_space(4)))*)(ka + 168); float* const out = *(float* const __attribute__((address_space(4)))*)(ka + 160); gu32* const ctl = (gu32*)(ws + WS_CTL); (void)out; (void)ctl
#define IN_X KA_IN(0)
#define norm_mix KA_IN(1)
#define norm_ffn KA_IN(2)
#define final_norm KA_IN(3)
#define da_wqkv KA_IN(4)
#define da_wo KA_IN(5)
#define da_lq1 KA_IN(6)
#define da_lk1 KA_IN(7)
#define da_lq2 KA_IN(8)
#define da_lk2 KA_IN(9)
#define da_subln KA_IN(10)
#define mb_wqkv KA_IN(11)
#define mb_wo KA_IN(12)
#define ffn_w1 KA_IN(13)
#define ffn_w3 KA_IN(14)
#define ffn_w2 KA_IN(15)
#define moe_router KA_IN(16)
#define moe_w1 KA_IN(17)
#define moe_w3 KA_IN(18)
#define moe_w2 KA_IN(19)
#define rope64 ((float*)(ws + WS_ROPE64))
#define rope128 ((float*)(ws + WS_ROPE128))
#define kmean ((float*)(ws + WS_KMEAN))
#define tok_e ((int*)(ws + WS_TOK))
#define tok_pos (tok_e + 2 * TOK)
#define tok_gate ((float*)(tok_pos + 2 * TOK))
#define wg_base ((int*)(ws + WS_TOK + 800 * 1024))
#define slot_tok ((int*)(ws + WS_SLOT))
#define slot_gate ((float*)(slot_tok + 2 * SLOTS))
#define ownml ((float*)(ws + WS_OWNML))
#define W0qkv ((bf16*)(ws + WS_W0QKV))
#define W0o ((bf16*)(ws + WS_W0O))
#define W013 ((bf16*)(ws + WS_W013))
#define W02 ((bf16*)(ws + WS_W02))
#define W1qkv ((bf16*)(ws + WS_W1QKV))
#define W1o ((bf16*)(ws + WS_W1O))
#define Rb ((bf16*)(ws + WS_H))
#define OB ((bf16*)out)
#define RSS(j) ((unsigned long long*)(ws + WS_RSS) + (size_t)(j) * TOK)
#define QKV ((bf16*)(ws + WS_QKV))
#define OATT ((bf16*)(ws + WS_OATT))
#define UD ((bf16*)(ws + WS_UD))
#define lists ((int*)(ws + WS_LIST))
#define pml ((float*)(ws + WS_PML))
#define PO ((bf16*)(ws + WS_PO))
#define WM13 ((signed char*)(ws + WS_WM13))
#define WM2 ((signed char*)(ws + WS_WM2))
#define AQ ((signed char*)(ws + WS_AQ))
#define UM ((signed char*)(ws + WS_UM))
#define CMAX13 ((unsigned*)(ws + WS_CMAX13))
#define CMAX2 ((unsigned*)(ws + WS_CMAX2))
#define SSTOT ((unsigned long long*)(ws + WS_SSTOT))
#define SA ((float*)(ws + WS_SA))
__global__ void __launch_bounds__(NWAVES * 64, 2) mk_fwd(Args args) {
    extern __shared__ __attribute__((aligned(16))) unsigned char lds[];
    LAS unsigned char* L = (LAS unsigned char*)lds;
    volatile LAS unsigned* MISC = (volatile LAS unsigned*)(L + MISC_OFF);
    const int wave = __builtin_amdgcn_readfirstlane((int)threadIdx.x >> 6);
#define tid ((int)threadIdx.x)
#define lane ((int)(threadIdx.x & 63u))
    const int G = gridDim.x; const int bx = blockIdx.x; const int vcu = (G % 8 == 0) ? (bx % 8) * (G / 8) + bx / 8 : bx;
    const int gw = vcu * NWAVES + wave, NGW = G * NWAVES;
    gu32* ctl0 = (gu32*)(args.ws + WS_CTL);
    for (int u = tid; u < (LDS_BYTES - LDSCTL_OFF) / 4; u += NWAVES * 64) ((LAS unsigned*)(L + LDSCTL_OFF))[u] = 0u;
    __syncthreads();
    XcdBarrier bar; bar.bar = (unsigned*)(ctl0 + CW_BAR); bar.x = 0; bar.st = nullptr;
    if (!MK_PER_PHASE) bar = xcd_barrier_post((unsigned*)(ctl0 + CW_BAR), MISC + 8);
#define GRID_BAR() do { if (!MK_PER_PHASE) xcd_barrier(bar); } while (0)
    const int lo = args.ph_lo, hi_ph = args.ph_hi;
#ifndef PH_MASK
#define PH_MASK 0xFFFFFFFFu
#endif
#define IN(k) (((PH_MASK >> (k)) & 1u) && lo <= (k) && (k) < hi_ph)
#define SEAM(k) do { if (IN((k) + 1)) GRID_BAR(); } while (0)
#ifndef DUP_MASK
#define DUP_MASK 0u
#endif
#define NREP(k) ((((DUP_MASK) >> (k)) & 1u) ? 2 : 1)

    if (IN(0)) { PH_PTRS; for (int rep_ = 0; rep_ < NREP(0); ++rep_) {
        LAS float* scr = (LAS float*)(L + RING_OFF + wave * 16384);
        constexpr int I_QKV = (DM / 64) * (NQKV / 32), I_O = (DM / 64) * (DM / 32), I_13 = (DM / 64) * (FF0 / 32), I_2 = (FF0 / 64) * (DM / 32);
        constexpr int NITEMS = 2 * I_QKV + 2 * I_O + 2 * I_13 + I_2;
        for (int it = gw; it < NITEMS; it += NGW) {
            int r = it;
            if (r < I_QKV) { transpose_item<1>(da_wqkv, DM, NQKV, W0qkv, scr, r, lane, norm_mix); continue; } r -= I_QKV;
            if (r < I_QKV) { transpose_item<2>(mb_wqkv, DM, NQKV, W1qkv, scr, r, lane, norm_mix + DM); continue; } r -= I_QKV;
            if (r < I_O) { transpose_item<0>(da_wo, DM, DM, W0o, scr, r, lane); continue; } r -= I_O;
            if (r < I_O) { transpose_item<0>(mb_wo, DM, DM, W1o, scr, r, lane); continue; } r -= I_O;
            if (r < I_13) { transpose_item<3>(ffn_w1, DM, FF0, W013, scr, r, lane, norm_ffn); continue; } r -= I_13;
            if (r < I_13) { transpose_item<4>(ffn_w3, DM, FF0, W013, scr, r, lane, norm_ffn); continue; } r -= I_13;
            transpose_item<0>(ffn_w2, FF0, DM, W02, scr, r, lane);
        }
        {
            const int gt = (vcu * NWAVES + wave) * 64 + lane, NT_ = G * NWAVES * 64;
            for (int e = gt; e < SEQ * 8; e += NT_) { const int pos = e >> 3, i = e & 7; const float ang = (float)pos * (*(const float __attribute__((address_space(4)))*)(ka + 176 + 4 * i)); rope64[e] = cosf(ang); rope64[SEQ * 8 + e] = sinf(ang); }
            for (int e = gt; e < SEQ * 16; e += NT_) { const int pos = e >> 4, i = e & 15; const float ang = (float)pos * (*(const float __attribute__((address_space(4)))*)(ka + 208 + 4 * i)); rope128[e] = cosf(ang); rope128[SEQ * 16 + e] = sinf(ang); }
        }
        for (int m = gw; m < TOK; m += NGW) {
            const GAS f32x4* xr = (const GAS f32x4*)(IN_X + (size_t)m * DM) + lane; f32x4 v[4]; float s = 0.f;
#pragma unroll
            for (int j = 0; j < 4; ++j) { v[j] = xr[64 * j]; s += (v[j].x * v[j].x + v[j].y * v[j].y) + (v[j].z * v[j].z + v[j].w * v[j].w); }
            store_row_bf16(Rb + (size_t)m * DM, v, lane); s = wave_sum(s); if (lane == 0) RSS(0)[m] = (unsigned long long)(s * 16777216.0f); }
        } SEAM(0);
    }
    if (IN(1)) { PH_PTRS; for (int rep_ = 0; rep_ < NREP(1); ++rep_) {
        pg8::ABDense ab{Rb, W0qkv, DM}; pg8::TileOrder S; S.init(TOK / 256, NQKV / 256, G, bx);
        pg8::EpiQKV<64> E{QKV, NQKV, rope64, rope64 + SEQ * 8, 0.125f * LOG2E, RSS(0)};
        pg8::gemm_phase<pg8::EpiQKV<64>, pg8::ABDense, GEMM_ALIGN>(L + RING_OFF, ab, S, E);
        } SEAM(1);
    }
    if (IN(2)) { PH_PTRS; for (int rep_ = 0; rep_ < NREP(2); ++rep_) {
        const moba::DaOrder AS(vcu, G);
        moba::dattn_phase<moba::DaOrder>((char*)lds + RING_OFF, (const moba::bf16*)QKV, (moba::bf16*)OATT, AS);
        } SEAM(2);
    }
    if (IN(3)) { PH_PTRS; for (int rep_ = 0; rep_ < NREP(3); ++rep_) {
        float lam;
        { const float a = wave_sum(da_lq1[lane] * da_lk1[lane]), b = wave_sum(da_lq2[lane] * da_lk2[lane]); lam = expf(a) - expf(b) + LAMBDA_INIT0; }
        const int hh = lane >> 3, dd = (lane & 7) * 16;
        float gsub[16];
#pragma unroll
        for (int k = 0; k < 16; ++k) gsub[k] = da_subln[dd + k] * (1.f - LAMBDA_INIT0);
        for (int m0 = gw; m0 < TOK; m0 += 2 * NGW) {
            v4u A0[2], A1[2], B0[2], B1[2];
#pragma unroll
            for (int u = 0; u < 2; ++u) { const int m = (m0 + u * NGW < TOK) ? m0 + u * NGW : m0;
                const bf16* o1 = OATT + (size_t)m * 2048 + (2 * hh) * 128 + dd; const bf16* o2 = o1 + 128;
                A0[u] = *(const GAS v4u*)o1; A1[u] = *(const GAS v4u*)(o1 + 8); B0[u] = *(const GAS v4u*)o2; B1[u] = *(const GAS v4u*)(o2 + 8); }
#pragma unroll
            for (int u = 0; u < 2; ++u) { const int m = m0 + u * NGW; if (m < TOK) {
                const v4u a0 = A0[u], a1 = A1[u], b0 = B0[u], b1 = B1[u];
                float d[16]; float ss = 0.f;
#pragma unroll
                for (int k = 0; k < 4; ++k) {
                    const unsigned ua = a0[k], ub = b0[k], uc = a1[k], ud = b1[k];
                    d[2 * k] = __uint_as_float(ua << 16) - lam * __uint_as_float(ub << 16); d[2 * k + 1] = __uint_as_float(ua & 0xffff0000u) - lam * __uint_as_float(ub & 0xffff0000u);
                    d[8 + 2 * k] = __uint_as_float(uc << 16) - lam * __uint_as_float(ud << 16); d[8 + 2 * k + 1] = __uint_as_float(uc & 0xffff0000u) - lam * __uint_as_float(ud & 0xffff0000u); }
#pragma unroll
                for (int k = 0; k < 16; ++k) ss += d[k] * d[k];
                ss += __shfl_xor(ss, 1); ss += __shfl_xor(ss, 2); ss += __shfl_xor(ss, 4);
                const float rstd = 1.f / sqrtf(ss * (1.f / 128.f) + SUBLN_EPS);
                v4u w0, w1;
#pragma unroll
                for (int k = 0; k < 4; ++k) { w0[k] = pk2(d[2 * k] * rstd * gsub[2 * k], d[2 * k + 1] * rstd * gsub[2 * k + 1]); w1[k] = pk2(d[8 + 2 * k] * rstd * gsub[8 + 2 * k], d[8 + 2 * k + 1] * rstd * gsub[8 + 2 * k + 1]); }
                bf16* od = OB + (size_t)m * DM + hh * 128 + dd;
                *(GAS v4u*)od = w0; *(GAS v4u*)(od + 8) = w1; } }
        }
        } SEAM(3);
    }
    if (IN(4)) { PH_PTRS; for (int rep_ = 0; rep_ < NREP(4); ++rep_) {
        pg8::ABDense ab{OB, W0o, DM}; pg8::TileOrder S; S.init(TOK / 256, DM / 256, G, bx);
        pg8::EpiResB E{Rb, Rb, DM, nullptr, RSS(1)};
        pg8::gemm_phase<pg8::EpiResB, pg8::ABDense, GEMM_ALIGN>(L + RING_OFF, ab, S, E);
        } SEAM(4);
    }
    if (IN(6)) { PH_PTRS; for (int rep_ = 0; rep_ < NREP(6); ++rep_) {
        pg8::ABDense ab{Rb, W013, DM}; pg8::TileOrder S; S.init(TOK / 256, (2 * FF0) / 256, G, bx);
        pg8::EpiSwiGLU E{UD, FF0, nullptr, RSS(1), nullptr};
        pg8::gemm_phase<pg8::EpiSwiGLU, pg8::ABDense, GEMM_ALIGN>(L + RING_OFF, ab, S, E);
        } SEAM(6);
    }
    if (IN(7)) { PH_PTRS; for (int rep_ = 0; rep_ < NREP(7); ++rep_) {
        pg8::ABDense ab{UD, W02, FF0}; pg8::TileOrder S; S.init(TOK / 256, DM / 256, G, bx);
        pg8::EpiResB E{Rb, Rb, DM, nullptr, RSS(2)};
        pg8::gemm_phase<pg8::EpiResB, pg8::ABDense, GEMM_ALIGN>(L + RING_OFF, ab, S, E);
        } SEAM(7);
    }
    if (IN(9)) { PH_PTRS; for (int rep_ = 0; rep_ < NREP(9); ++rep_) {
        pg8::ABDense ab{Rb, W1qkv, DM}; pg8::TileOrder S; S.init(TOK / 256, NQKV / 256, G, bx);
        pg8::EpiQKV<128> E{QKV, NQKV, rope128, rope128 + SEQ * 16, 0.08838834764831845f * LOG2E, RSS(2)};
        pg8::gemm_phase<pg8::EpiQKV<128>, pg8::ABDense, GEMM_ALIGN>(L + RING_OFF, ab, S, E);
        } SEAM(9);
    }
    if (IN(10)) { PH_PTRS; for (int rep_ = 0; rep_ < NREP(10); ++rep_) {
        LAS float* red = (LAS float*)(L + RING_OFF);
        for (int u = vcu; u < BATCH * MB_H * MB_NB; u += G) {
            const int b = u >> 8, h = (u >> 5) & 7, j = u & 31;
            const int dch = tid & 15, kg = tid >> 4;
            const bf16* kp = QKV + (size_t)(b * SEQ + j * MB_L + kg * 8) * NQKV + 1024 + h * 128 + dch * 8;
            float s[8] = {0.f, 0.f, 0.f, 0.f, 0.f, 0.f, 0.f, 0.f};
#pragma unroll
            for (int k = 0; k < 8; ++k) { const v4u v = *(const GAS v4u*)(kp + (size_t)k * NQKV);
#pragma unroll
                for (int q = 0; q < 4; ++q) { s[2 * q] += __uint_as_float(v[q] << 16); s[2 * q + 1] += __uint_as_float(v[q] & 0xffff0000u); } }
#pragma unroll
            for (int q = 0; q < 8; ++q) red[kg * 128 + dch * 8 + q] = s[q];
            __syncthreads();
            if (tid < 128) { float a = 0.f;
#pragma unroll 8
                for (int k = 0; k < 32; ++k) a += red[k * 128 + tid];
                kmean[(size_t)u * 128 + tid] = a * (1.f / 256.f); }
            __syncthreads();
        }
        } SEAM(10);
    }
    if (IN(11)) { PH_PTRS; for (int rep_ = 0; rep_ < NREP(11); ++rep_) {
        LAS float* km = (LAS float*)(L + RING_OFF);
        LAS float* mv = (LAS float*)(L + RING_OFF + 16384);
        LAS int* mi = (LAS int*)(L + RING_OFF + 16384 + 3072);
        LAS int* lcnt = (LAS int*)(L + RING_OFF + 24576);
        for (int u = vcu; u < BATCH * MB_H * (MB_NB - 1); u += G) {
            const int bh = u / 31, o = 1 + u % 31, b = bh >> 3, h = bh & 7;
            for (int e = tid; e < 32 * 128; e += 512) km[e] = kmean[(size_t)bh * 4096 + e];
            if (tid < 32) lcnt[tid] = 0;
            __syncthreads();
            const int ql = tid & 255, half = tid >> 8; const int s = o * 256 + ql;
            const bf16* qp = QKV + (size_t)(b * SEQ + s) * NQKV + h * 128;
            float qf[128];
#pragma unroll
            for (int c = 0; c < 16; ++c) { const v4u v = *(const GAS v4u*)(qp + c * 8);
#pragma unroll
                for (int q = 0; q < 4; ++q) { qf[c * 8 + 2 * q] = __uint_as_float(v[q] << 16); qf[c * 8 + 2 * q + 1] = __uint_as_float(v[q] & 0xffff0000u); } }
            float v0 = -INFINITY, v1 = -INFINITY, v2 = -INFINITY; int i0 = -1, i1 = -1, i2 = -1;
            for (int jj = 0; jj < 16; ++jj) { const int j = half * 16 + jj;
                if (j < o) { float g = 0.f; const LAS f32x4* kr = (const LAS f32x4*)(km + j * 128);
#pragma unroll
                    for (int c = 0; c < 32; ++c) { const f32x4 kv = kr[c]; g += qf[4 * c] * kv.x + qf[4 * c + 1] * kv.y + qf[4 * c + 2] * kv.z + qf[4 * c + 3] * kv.w; }
                    if (g > v0) { v2 = v1; i2 = i1; v1 = v0; i1 = i0; v0 = g; i0 = j; } else if (g > v1) { v2 = v1; i2 = i1; v1 = g; i1 = j; } else if (g > v2) { v2 = g; i2 = j; } } }
            if (half == 1) { mv[ql * 3] = v0; mv[ql * 3 + 1] = v1; mv[ql * 3 + 2] = v2; mi[ql * 3] = i0; mi[ql * 3 + 1] = i1; mi[ql * 3 + 2] = i2; }
            __syncthreads();
            int lp0 = 0, lp1 = 0, lp2 = 0;
            if (half == 0) {
#pragma unroll
                for (int k = 0; k < 3; ++k) { const float g = mv[ql * 3 + k]; const int j = mi[ql * 3 + k];
                    if (j >= 0) { if (g > v0) { v2 = v1; i2 = i1; v1 = v0; i1 = i0; v0 = g; i0 = j; } else if (g > v1) { v2 = v1; i2 = i1; v1 = g; i1 = j; } else if (g > v2) { v2 = g; i2 = j; } } }
                if (i0 >= 0) lp0 = __hip_atomic_fetch_add(&lcnt[i0], 1, __ATOMIC_RELAXED, __HIP_MEMORY_SCOPE_WORKGROUP);
                if (i1 >= 0) lp1 = __hip_atomic_fetch_add(&lcnt[i1], 1, __ATOMIC_RELAXED, __HIP_MEMORY_SCOPE_WORKGROUP);
                if (i2 >= 0) lp2 = __hip_atomic_fetch_add(&lcnt[i2], 1, __ATOMIC_RELAXED, __HIP_MEMORY_SCOPE_WORKGROUP);
            }
            __syncthreads();
            if (tid < 32 && rep_ == 0) { const int n = lcnt[tid]; lcnt[32 + tid] = n ? (int)__hip_atomic_fetch_add(ctl + CW_MOBACNT + bh * 32 + tid, (unsigned)n, RLX_AGENT) : 0; }
            __syncthreads();
            if (half == 0 && rep_ == 0) { int* lb = lists + (size_t)bh * LIST_PER_BH;
                if (i0 >= 0) lb[list_off(i0) + lcnt[32 + i0] + lp0] = s;
                if (i1 >= 0) lb[list_off(i1) + lcnt[32 + i1] + lp1] = s | (1 << 16);
                if (i2 >= 0) lb[list_off(i2) + lcnt[32 + i2] + lp2] = s | (2 << 16); }
            __syncthreads();
        }
        } SEAM(11);
    }
    if (IN(12)) { PH_PTRS; for (int rep_ = 0; rep_ < NREP(12); ++rep_) {
        LAS int* pre = (LAS int*)(L + 102400);
        { const unsigned c0 = __hip_atomic_load(ctl + CW_MOBACNT + tid, RLX_AGENT), c1 = __hip_atomic_load(ctl + CW_MOBACNT + 512 + tid, RLX_AGENT);
          pre[tid] = (int)((c0 + 255u) >> 8); pre[512 + tid] = (int)((c1 + 255u) >> 8); }
        __syncthreads();
        if (tid == 0) { int a = 0; for (int k = 0; k < 1024; ++k) { const int n = pre[k]; pre[k] = a; a += n; } pre[1024] = a; }
        __syncthreads();
        const int nlist = pre[1024], ntot = 1024 + nlist;
        const int wl = wave * 32 + (lane & 31);
        for (int u = vcu; u < ntot; u += G) {
            const bool own = u < 1024;
            int b, h, kb, s, dst, mli, ostride; moba::bf16* obase; float* mlp;
            if (own) {
                b = u >> 8; h = (u >> 5) & 7; kb = u & 31; s = kb * 256 + wl; dst = b * SEQ + s; mli = (b * 8 + h) * SEQ + s; ostride = DM; obase = (moba::bf16*)OB + h * 128; mlp = ownml;
            } else {
                const int lu = u - 1024; int loI = 0, hiI = 1024;
                while (hiI - loI > 1) { const int mid = (loI + hiI) >> 1; if (pre[mid] <= lu) loI = mid; else hiI = mid; }
                const int bhj = loI, chunk = lu - pre[bhj], bh = bhj >> 5; kb = bhj & 31; b = bh >> 3; h = bh & 7;
                const int cnt = (int)__hip_atomic_load(ctl + CW_MOBACNT + bhj, RLX_AGENT);
                const int ei = chunk * 256 + wl; const bool valid = ei < cnt;
                const int ent = valid ? lists[(size_t)bh * LIST_PER_BH + list_off(kb) + ei] : 0;
                s = ent & 0xffff; mli = (bh * SEQ + s) * 3 + (ent >> 16); dst = valid ? mli : -1; ostride = 128; obase = (moba::bf16*)PO; mlp = pml;
            }
            const moba::bf16* qrow = (const moba::bf16*)QKV + ((size_t)b * SEQ + s) * NQKV + h * 128;
            const moba::bf16* Kh = (const moba::bf16*)QKV + ((size_t)b * SEQ + kb * 256) * NQKV + 1024 + h * 128;
            moba::moba_unit(own, qrow, Kh, Kh + 1024, obase, ostride, dst, mlp, mli, wl, (char*)lds);
        }
        } SEAM(12);
    }
    if (IN(13)) { PH_PTRS; for (int rep_ = 0; rep_ < NREP(13); ++rep_) {
        const int hh = lane >> 3, dd = (lane & 7) * 16;
        for (int m = gw; m < TOK; m += NGW) {
            const int b = m >> 13, s = m & 8191, nv = (s >> 8) < 3 ? (s >> 8) : 3; const int qi = (b * 8 + hh) * SEQ + s;
            float mm[4], ll[4]; mm[0] = ownml[2 * (size_t)qi]; ll[0] = ownml[2 * (size_t)qi + 1]; float M = mm[0];
#pragma unroll
            for (int r = 0; r < 3; ++r) { if (r < nv) { mm[1 + r] = pml[2 * ((size_t)qi * 3 + r)]; ll[1 + r] = pml[2 * ((size_t)qi * 3 + r) + 1]; M = fmaxf(M, mm[1 + r]); } else { mm[1 + r] = -1e30f; ll[1 + r] = 0.f; } }
            float w[4], wsum = 0.f;
#pragma unroll
            for (int r = 0; r < 4; ++r) { w[r] = ll[r] * __builtin_amdgcn_exp2f(mm[r] - M); wsum += w[r]; }
            const float inv = 1.f / wsum;
            float acc16[16];
            bf16* op = OB + (size_t)m * DM + hh * 128 + dd;
            { const v4u a0 = *(const GAS v4u*)op, a1 = *(const GAS v4u*)(op + 8); const float ww = w[0] * inv;
#pragma unroll
              for (int k = 0; k < 4; ++k) { acc16[2 * k] = ww * __uint_as_float(a0[k] << 16); acc16[2 * k + 1] = ww * __uint_as_float(a0[k] & 0xffff0000u); acc16[8 + 2 * k] = ww * __uint_as_float(a1[k] << 16); acc16[8 + 2 * k + 1] = ww * __uint_as_float(a1[k] & 0xffff0000u); } }
#pragma unroll
            for (int r = 0; r < 3; ++r) if (r < nv) { const bf16* pp = PO + ((size_t)qi * 3 + r) * 128 + dd; const v4u a0 = *(const GAS v4u*)pp, a1 = *(const GAS v4u*)(pp + 8); const float ww = w[1 + r] * inv;
#pragma unroll
                for (int k = 0; k < 4; ++k) { acc16[2 * k] += ww * __uint_as_float(a0[k] << 16); acc16[2 * k + 1] += ww * __uint_as_float(a0[k] & 0xffff0000u); acc16[8 + 2 * k] += ww * __uint_as_float(a1[k] << 16); acc16[8 + 2 * k + 1] += ww * __uint_as_float(a1[k] & 0xffff0000u); } }
            v4u w0, w1;
#pragma unroll
            for (int k = 0; k < 4; ++k) { w0[k] = pk2(acc16[2 * k], acc16[2 * k + 1]); w1[k] = pk2(acc16[8 + 2 * k], acc16[8 + 2 * k + 1]); }
            *(GAS v4u*)op = w0; *(GAS v4u*)(op + 8) = w1;
        }
        } SEAM(13);
    }
    if (IN(14)) { PH_PTRS; for (int rep_ = 0; rep_ < NREP(14); ++rep_) {
        pg8::ABDense ab{OB, W1o, DM}; pg8::TileOrder S; S.init(TOK / 256, DM / 256, G, bx);
        pg8::EpiResB E{Rb, Rb, DM, nullptr, RSS(3)};
        pg8::gemm_phase<pg8::EpiResB, pg8::ABDense, GEMM_ALIGN>(L + RING_OFF, ab, S, E);
        } SEAM(14);
    }
    if (IN(15)) { PH_PTRS; for (int rep_ = 0; rep_ < NREP(15); ++rep_) {
        {
            const int gt = (vcu * NWAVES + wave) * 64 + lane, NT_ = G * NWAVES * 64;
            for (int e = gt; e < 2 * SLOTS; e += NT_) { slot_tok[e] = -1; slot_gate[e] = 0.f; }
        }
        if (rep_ == 0) {
            f32x4 gv[4]; load_gain(norm_ffn + DM, gv, lane);
            float wr_[16][8];
#pragma unroll
            for (int j = 0; j < 4; ++j)
#pragma unroll
                for (int q = 0; q < 4; ++q) { const int k = 4 * lane + 256 * j + q; const f32x4 a = *(const GAS f32x4*)(moe_router + (size_t)k * 8) * gv[j][q], c = *(const GAS f32x4*)(moe_router + (size_t)k * 8 + 4) * gv[j][q];
                    wr_[4 * j + q][0] = a.x; wr_[4 * j + q][1] = a.y; wr_[4 * j + q][2] = a.z; wr_[4 * j + q][3] = a.w; wr_[4 * j + q][4] = c.x; wr_[4 * j + q][5] = c.y; wr_[4 * j + q][6] = c.z; wr_[4 * j + q][7] = c.w; }
            for (int m = gw; m < TOK; m += NGW) {
                f32x4 v[4];
                { const GAS unsigned long long* r8 = (const GAS unsigned long long*)(Rb + (size_t)m * DM) + lane;
#pragma unroll
                  for (int j = 0; j < 4; ++j) { const unsigned long long w = r8[64 * j]; const unsigned lo32 = (unsigned)w, hi32 = (unsigned)(w >> 32);
                      v[j].x = __uint_as_float(lo32 << 16); v[j].y = __uint_as_float(lo32 & 0xffff0000u); v[j].z = __uint_as_float(hi32 << 16); v[j].w = __uint_as_float(hi32 & 0xffff0000u); } }
                float lg[8];
#pragma unroll
                for (int e = 0; e < 8; ++e) { float a = 0.f;
#pragma unroll
                    for (int j = 0; j < 4; ++j) a += v[j].x * wr_[4 * j][e] + v[j].y * wr_[4 * j + 1][e] + v[j].z * wr_[4 * j + 2][e] + v[j].w * wr_[4 * j + 3][e];
                    lg[e] = wave_sum(a); }
                const float rs = 1.f / sqrtf((float)RSS(3)[m] * (5.9604644775390625e-8f / DM) + NORM_EPS);
#pragma unroll
                for (int e = 0; e < 8; ++e) lg[e] *= rs;
                {
                    float mx = 0.f;
#pragma unroll
                    for (int j = 0; j < 4; ++j) mx = fmaxf(fmaxf(mx, fmaxf(fabsf(v[j].x), fabsf(v[j].y))), fmaxf(fabsf(v[j].z), fabsf(v[j].w)));
#pragma unroll
                    for (int o = 1; o < 64; o <<= 1) mx = fmaxf(mx, __shfl_xor(mx, o));
                    const float inv = mx > 0.f ? 127.0f / mx : 0.f;
                    GAS unsigned* aq = (GAS unsigned*)(AQ + (size_t)m * DM) + lane;
#pragma unroll
                    for (int j = 0; j < 4; ++j) { const int q0 = (int)__builtin_rintf(v[j].x * inv), q1 = (int)__builtin_rintf(v[j].y * inv), q2 = (int)__builtin_rintf(v[j].z * inv), q3 = (int)__builtin_rintf(v[j].w * inv);
                        aq[64 * j] = (unsigned)(q0 & 255) | ((unsigned)(q1 & 255) << 8) | ((unsigned)(q2 & 255) << 16) | ((unsigned)(q3 & 255) << 24); }
                    if (lane == 0) SA[m] = mx * rs * (1.0f / 127.0f);
                }
                int e0 = 0; float l0 = lg[0];
#pragma unroll
                for (int e = 1; e < 8; ++e) if (lg[e] > l0) { l0 = lg[e]; e0 = e; }
                int e1 = -1; float l1 = -INFINITY;
#pragma unroll
                for (int e = 0; e < 8; ++e) if (e != e0 && lg[e] > l1) { l1 = lg[e]; e1 = e; }
                if (lane == 0) {
                    const float g0 = 1.f / (1.f + expf(l1 - l0)), g1 = 1.f - g0;
                    const int p0 = (int)__hip_atomic_fetch_add((LAS unsigned*)(L + MISC_OFF) + 40 + e0, 1u, __ATOMIC_RELAXED, __HIP_MEMORY_SCOPE_WORKGROUP), p1 = (int)__hip_atomic_fetch_add((LAS unsigned*)(L + MISC_OFF) + 48 + e1, 1u, __ATOMIC_RELAXED, __HIP_MEMORY_SCOPE_WORKGROUP);
                    tok_e[m] = e0; tok_e[TOK + m] = e1; tok_pos[m] = p0; tok_pos[TOK + m] = p1; tok_gate[m] = g0; tok_gate[TOK + m] = g1;
                }
            }
            LDS_WAIT(); __syncthreads();
            if (tid < 16) { const unsigned n = MISC[40 + tid]; wg_base[vcu * 16 + tid] = n ? (int)__hip_atomic_fetch_add(ctl + CW_MOECNT + tid, n, RLX_AGENT) : 0; }
        }
        {
            constexpr int S_1 = (DM / 512) * (FF1 / 32), S_2 = (FF1 / 512) * (DM / 32), PER_E = 2 * S_1 + S_2;
            float ssA = 0.f, ssB = 0.f;
            for (int it = gw; it < NEXP * PER_E; it += NGW) {
                const int e = it / PER_E; int r = it % PER_E;
                if (r < S_1) { ssA += wmax_strip<3>(moe_w1 + (size_t)e * DM * FF1, FF1, CMAX13 + e * 2 * FF1, 8 * (r / (FF1 / 32)), 8, r % (FF1 / 32), lane, norm_ffn + DM); continue; } r -= S_1;
                if (r < S_1) { ssB += wmax_strip<4>(moe_w3 + (size_t)e * DM * FF1, FF1, CMAX13 + e * 2 * FF1, 8 * (r / (FF1 / 32)), 8, r % (FF1 / 32), lane, norm_ffn + DM); continue; } r -= S_1;
                (void)wmax_strip<0>(moe_w2 + (size_t)e * FF1 * DM, DM, CMAX2 + e * DM, 8 * (r / (DM / 32)), 8, r % (DM / 32), lane, nullptr);
            }
            ssA = wave_sum(ssA); ssB = wave_sum(ssB);
            if (lane == 0) { __hip_atomic_fetch_add(SSTOT, (unsigned long long)(ssA * 16777216.0f), __ATOMIC_RELAXED, __HIP_MEMORY_SCOPE_AGENT); __hip_atomic_fetch_add(SSTOT + 1, (unsigned long long)(ssB * 16777216.0f), __ATOMIC_RELAXED, __HIP_MEMORY_SCOPE_AGENT); }
        }
        } SEAM(15);
    }
#define MOE_CUM() do { if (tid < 2) { int a = 0; for (int e = 0; e < 8; ++e) { MISC[16 + 9 * tid + e] = (unsigned)a; a += (int)((__hip_atomic_load(ctl + CW_MOECNT + 8 * tid + e, RLX_AGENT) + 255u) >> 8); } MISC[16 + 9 * tid + 8] = (unsigned)a; } __syncthreads(); } while (0)
    if (IN(16)) { PH_PTRS; for (int rep_ = 0; rep_ < NREP(16); ++rep_) {
        MOE_CUM();
        const int gt = (vcu * NWAVES + wave) * 64 + lane, NT_ = G * NWAVES * 64;
        for (int e = gt; e < 2 * TOK; e += NT_) { const int r = e >= TOK ? 1 : 0; const int ex = tok_e[e]; const int t_ = e - r * TOK; const int slot = (int)MISC[16 + 9 * r + ex] * 256 + wg_base[((t_ % NGW) >> 3) * 16 + r * 8 + ex] + tok_pos[e];
            slot_tok[r * SLOTS + slot] = e - r * TOK; slot_gate[r * SLOTS + slot] = tok_gate[e]; }
        {
            LAS float* scr = (LAS float*)(L + RING_OFF + wave * 16384);
            constexpr int I_1 = (DM / 64) * (FF1 / 32), I_2 = (FF1 / 64) * (DM / 32), PER_E = 2 * I_1 + I_2;
            for (int it = gw; it < NEXP * PER_E; it += NGW) {
                const int e = it / PER_E; int r = it % PER_E;
                if (r < I_1) { transpose_item_q<3>(moe_w1 + (size_t)e * DM * FF1, DM, FF1, WM13 + (size_t)e * 2 * FF1 * DM, CMAX13 + e * 2 * FF1, scr, r, lane, norm_ffn + DM); continue; } r -= I_1;
                if (r < I_1) { transpose_item_q<4>(moe_w3 + (size_t)e * DM * FF1, DM, FF1, WM13 + (size_t)e * 2 * FF1 * DM, CMAX13 + e * 2 * FF1, scr, r, lane, norm_ffn + DM); continue; } r -= I_1;
                transpose_item_q<0>(moe_w2 + (size_t)e * FF1 * DM, FF1, DM, WM2 + (size_t)e * DM * FF1, CMAX2 + e * DM, scr, r, lane, nullptr);
            }
        }
        } SEAM(16);
    }
#define MOE_SU() (8.0f * sqrtf(((float)SSTOT[0] * (5.9604644775390625e-8f / (NEXP * FF1))) * ((float)SSTOT[1] * (5.9604644775390625e-8f / (NEXP * FF1)))))
#define MOE_UP(r) do { MOE_CUM(); \
        pg8::ABMoeUp ab{(const pg8::bf16_t*)AQ, (const pg8::bf16_t*)WM13, DM / 2, slot_tok + (r) * SLOTS, (const LAS int*)(L + MISC_OFF + 4 * (16 + 9 * (r))), (size_t)2 * FF1 * (DM / 2)}; \
        pg8::TileOrder S; S.init((int)MISC[16 + 9 * (r) + 8], (2 * FF1) / 256, G, bx); \
        pg8::EpiSwiGLUQ E{UM, FF1, SA, CMAX13, slot_tok + (r) * SLOTS, (const LAS int*)(L + MISC_OFF + 4 * (16 + 9 * (r))), 127.0f / MOE_SU()}; \
        pg8::gemm_phase<pg8::EpiSwiGLUQ, pg8::ABMoeUp, GEMM_ALIGN>(L + RING_OFF, ab, S, E); } while (0)
#define MOE_DOWN(r) do { MOE_CUM(); \
        pg8::ABMoeDown ab{(const pg8::bf16_t*)UM, (const pg8::bf16_t*)WM2, FF1 / 2, (const LAS int*)(L + MISC_OFF + 4 * (16 + 9 * (r))), (size_t)DM * (FF1 / 2)}; \
        pg8::TileOrder S; S.init((int)MISC[16 + 9 * (r) + 8], DM / 256, G, bx); \
        pg8::EpiResBQ E{(r) == 0 ? Rb : OB, (r) == 0 ? OB : Rb, DM, slot_tok + (r) * SLOTS, slot_gate + (r) * SLOTS, CMAX2, (const LAS int*)(L + MISC_OFF + 4 * (16 + 9 * (r))), MOE_SU() * (1.0f / 127.0f)}; \
        pg8::gemm_phase<pg8::EpiResBQ, pg8::ABMoeDown, GEMM_ALIGN>(L + RING_OFF, ab, S, E); } while (0)
    if (IN(17)) { PH_PTRS; for (int rep_ = 0; rep_ < NREP(17); ++rep_) MOE_UP(0); SEAM(17); }
    if (IN(18)) { PH_PTRS; MOE_DOWN(0); SEAM(18); }
    if (IN(19)) { PH_PTRS; for (int rep_ = 0; rep_ < NREP(19); ++rep_) MOE_UP(1); SEAM(19); }
    if (IN(20)) { PH_PTRS; MOE_DOWN(1); SEAM(20); }
    if (IN(21)) { PH_PTRS;
        f32x4 gv[4]; load_gain(final_norm, gv, lane);
        for (int m0 = gw; m0 < TOK; m0 += 4 * NGW) {
            unsigned long long w[4][4];
#pragma unroll
            for (int u = 0; u < 4; ++u) { const int m = (m0 + u * NGW < TOK) ? m0 + u * NGW : m0; const GAS unsigned long long* r8 = (const GAS unsigned long long*)(Rb + (size_t)m * DM) + lane;
#pragma unroll
                for (int j = 0; j < 4; ++j) w[u][j] = r8[64 * j]; }
#pragma unroll
            for (int u = 0; u < 4; ++u) { const int m = m0 + u * NGW; if (m < TOK) {
                f32x4 v[4]; float s = 0.f;
#pragma unroll
                for (int j = 0; j < 4; ++j) { const unsigned lo32 = (unsigned)w[u][j], hi32 = (unsigned)(w[u][j] >> 32);
                    v[j].x = __uint_as_float(lo32 << 16); v[j].y = __uint_as_float(lo32 & 0xffff0000u); v[j].z = __uint_as_float(hi32 << 16); v[j].w = __uint_as_float(hi32 & 0xffff0000u);
                    s += (v[j].x * v[j].x + v[j].y * v[j].y) + (v[j].z * v[j].z + v[j].w * v[j].w); }
                const float rstd = 1.f / sqrtf(wave_sum(s) * (1.f / DM) + NORM_EPS);
                GAS f32x4* o = (GAS f32x4*)(out + (size_t)m * DM) + lane;
#pragma unroll
                for (int j = 0; j < 4; ++j) o[64 * j] = v[j] * rstd * gv[j]; } }
        }
    }
#undef IN
#undef SEAM
#undef GRID_BAR
#undef tid
#undef lane
}
constexpr int N_PHASES = 22;

extern "C" void kernel_launch(void* const* d_in, const int* in_sizes, int n_in, void* d_out, int out_size, void* d_ws, size_t ws_size, hipStream_t stream) {
    static int grid = 0;
    if (grid == 0) {
        if (n_in != 20 || in_sizes[0] != TOK * DM || out_size != TOK * DM || ws_size < WS_END) { fprintf(stderr, "kernel_launch: shape / workspace mismatch (n_in %d, in0 %d, out %d, ws %zu, need %zu); nothing launched\n", n_in, n_in > 0 ? in_sizes[0] : -1, out_size, ws_size, (size_t)WS_END); grid = -1; return; }
        int dev = 0, cus = 0, per_cu = 0;
        if (hipGetDevice(&dev) != hipSuccess || hipDeviceGetAttribute(&cus, hipDeviceAttributeMultiprocessorCount, dev) != hipSuccess) { grid = -1; return; }
        if (hipFuncSetAttribute((const void*)mk_fwd, hipFuncAttributeMaxDynamicSharedMemorySize, LDS_BYTES) != hipSuccess) { fprintf(stderr, "kernel_launch: hipFuncSetAttribute failed\n"); grid = -1; return; }
        if (hipOccupancyMaxActiveBlocksPerMultiprocessor(&per_cu, (const void*)mk_fwd, NWAVES * 64, LDS_BYTES) != hipSuccess || per_cu < 1) fprintf(stderr, "kernel_launch: occupancy query reports %d workgroups per CU\n", per_cu);
        (void)hipGetLastError();
        grid = cus;
    }
    if (grid < 0) return;
    if (hipMemsetAsync((char*)d_ws + WS_CTL, 0, CTL_ZERO_BYTES, stream) != hipSuccess) return;
    Args a{};
    for (int i = 0; i < 20; ++i) a.in[i] = (const float*)d_in[i];
    a.out = (float*)d_out; a.ws = (unsigned char*)d_ws;
    for (int i = 0; i < 8; ++i) a.inv64[i] = (float)pow(500000.0, -(double)(2 * i) / 16.0);
    for (int i = 0; i < 16; ++i) a.inv128[i] = (float)pow(500000.0, -(double)(2 * i) / 32.0);
#if MK_PER_PHASE
    for (int p = 0; p < N_PHASES; ++p) { a.ph_lo = p; a.ph_hi = p + 1; hipLaunchKernelGGL(mk_fwd, dim3(grid), dim3(NWAVES * 64), LDS_BYTES, stream, a); }
#else
    a.ph_lo = 0; a.ph_hi = N_PHASES;
    hipLaunchKernelGGL(mk_fwd, dim3(grid), dim3(NWAVES * 64), LDS_BYTES, stream, a);
#ifdef PROBE_LIST
    {
        static const int probe[] = {PROBE_LIST};
        for (int k : probe) { a.ph_lo = k; a.ph_hi = k + 1;
            a.out = (k == 3 || k == 12 || k == 13 || k == 18 || k == 21) ? (float*)((char*)d_ws + WS_QKV) : (float*)d_out;
            hipLaunchKernelGGL(mk_fwd, dim3(grid), dim3(NWAVES * 64), LDS_BYTES, stream, a); }
    }
#endif
#endif
    const hipError_t le = hipPeekAtLastError();
    if (le != hipSuccess) fprintf(stderr, "kernel_launch: launch failed: %s\n", hipGetErrorName(le));
}
```

```cpp
#include <hip/hip_runtime.h>
#include <hip/hip_bf16.h>
#include <cstdio>
#include <cstdint>
#include <cmath>
namespace pg8 {
#define PG8_LAS __attribute__((address_space(3)))
typedef unsigned short bf16_t;
typedef short bf16x8 __attribute__((ext_vector_type(8)));
typedef float f32x4 __attribute__((ext_vector_type(4)));
typedef unsigned u32x4 __attribute__((ext_vector_type(4)));
constexpr int BM = 256, BK = 64, HALF = 128, HTB = HALF * BK * 2  , STAGE_BYTES = 8 * HTB, NXCD = 8, WGM = 8;

__host__ __device__ __forceinline__ int lds_byte(int r, int c) { const int st = (r >> 4) * 2 + (c >> 5), rr = r & 15, cc = c & 31, ob = rr * 64 + cc * 2; return st * 1024 + (ob ^ (((ob >> 9) & 1) << 5)); }
__host__ __device__ __forceinline__ void stage_rc(int b, int& R, int& C) { const int st = b / 1024, sb = b % 1024, swz = sb ^ (((sb >> 9) & 1) << 5); R = (st >> 1) * 16 + swz / 64; C = (st & 1) * 32 + (swz % 64) / 2; }
__host__ __device__ __forceinline__ int perm32(int rho) { const int n = rho >> 4, i = rho & 15; return 8 * (i >> 2) + 4 * n + (i & 3); }

struct Unit { int pm, pn; };

struct TileOrder {
    int nM, nN, nwg, G, c;
    __device__ __forceinline__ void init(int nM_, int nN_, int G_, int c_) { nM = nM_; nN = nN_; nwg = nM * nN; G = G_; c = c_; }
    __device__ __forceinline__ bool next(int i, Unit& u) const {
        const long L = (long)i * G + c; if (L >= nwg) return false;
        int wgid = (int)L; { const int q = nwg / NXCD, r = nwg % NXCD, xcd = wgid % NXCD, off = wgid / NXCD; wgid = (xcd < r ? xcd * (q + 1) : r * (q + 1) + (xcd - r) * q) + off; }
        const int nig = WGM * nN, gid = wgid / nig, fm = gid * WGM, gsz = (nM - fm) < WGM ? (nM - fm) : WGM;
        u.pm = fm + ((wgid % nig) % gsz); u.pn = (wgid % nig) / gsz; return true;
    }
};

struct ABDense {
    static constexpr bool GATHER = false;
    const bf16_t* A; const bf16_t* Bt; int K;
    __device__ __forceinline__ const char* abase(const Unit& u) const { return (const char*)A + (size_t)u.pm * BM * K * 2; }
    __device__ __forceinline__ const char* bbase(const Unit& u) const { return (const char*)Bt + (size_t)u.pn * BM * K * 2; }
    __device__ __forceinline__ const int* tokp(const Unit&) const { return nullptr; }
};
struct ABMoeUp {
    static constexpr bool GATHER = true;
    const bf16_t* A; const bf16_t* Bt; int K; const int* slot_tok; const PG8_LAS int* cum; size_t estride;
    __device__ __forceinline__ int expert(int pm) const { int e = 0;
#pragma unroll
        for (int k = 1; k < 8; ++k) e += (pm >= cum[k]) ? 1 : 0; return e; }
    __device__ __forceinline__ const char* abase(const Unit&) const { return (const char*)A; }
    __device__ __forceinline__ const char* bbase(const Unit& u) const { return (const char*)(Bt + (size_t)expert(u.pm) * estride) + (size_t)u.pn * BM * K * 2; }
    __device__ __forceinline__ const int* tokp(const Unit& u) const { return slot_tok + u.pm * BM; }
};
struct ABMoeDown {
    static constexpr bool GATHER = false;
    const bf16_t* A; const bf16_t* Bt; int K; const PG8_LAS int* cum; size_t estride;
    __device__ __forceinline__ int expert(int pm) const { int e = 0;
#pragma unroll
        for (int k = 1; k < 8; ++k) e += (pm >= cum[k]) ? 1 : 0; return e; }
    __device__ __forceinline__ const char* abase(const Unit& u) const { return (const char*)A + (size_t)u.pm * BM * K * 2; }
    __device__ __forceinline__ const char* bbase(const Unit& u) const { return (const char*)(Bt + (size_t)expert(u.pm) * estride) + (size_t)u.pn * BM * K * 2; }
    __device__ __forceinline__ const int* tokp(const Unit&) const { return nullptr; }
};

__device__ __forceinline__ unsigned cvt_pk_bf16(float lo, float hi) { unsigned r; asm volatile("v_cvt_pk_bf16_f32 %0, %1, %2" : "=v"(r) : "v"(lo), "v"(hi)); return r; }

template <int DH> struct EpiQKV {
    static constexpr bool PERM = true; typedef f32x4 acc_t;
    bf16_t* O; int ldc; const float* ct; const float* st; float qscale; const unsigned long long* rss;
    __device__ __forceinline__ void operator()(const f32x4 (&acc)[2][2][4][2], const Unit& u, int wr, int wc, int fr, int fq) const {
        constexpr int NF = DH / 8;
        const int row0 = u.pm * BM + wr * 64 + fr, col0 = u.pn * BM + wc * 32 + 8 * fq;
        const int sect = u.pn >> 2;
        const float sc = (sect == 0) ? qscale : 1.f;
        const bool rot = (sect < 2) && (DH == 64 ? (((wc & 1) == 0) && (fq < 2)) : (wc == 0));
#pragma unroll
        for (int ai = 0; ai < 2; ++ai)
#pragma unroll
            for (int m = 0; m < 4; ++m) {
                const int row = row0 + ai * HALF + m * 16; const int pos = row & 8191; const float rs = sc * __builtin_amdgcn_rsqf((float)rss[row] * (5.9604644775390625e-8f / 1024.0f) + 1e-6f);
                f32x4 c4 = (f32x4){1.f, 1.f, 1.f, 1.f}, s4 = (f32x4){0.f, 0.f, 0.f, 0.f};
                if (rot) { c4 = *(const f32x4*)(ct + pos * NF + 4 * fq); s4 = *(const f32x4*)(st + pos * NF + 4 * fq); }
                bf16_t* rowp = O + (size_t)row * ldc + col0;
#pragma unroll
                for (int bj = 0; bj < 2; ++bj) {
                    const f32x4 x1 = acc[ai][bj][m][0], x2 = acc[ai][bj][m][1];
                    f32x4 v0 = (x1 * c4 - x2 * s4) * rs, v1 = (x2 * c4 + x1 * s4) * rs;
                    u32x4 w; w.x = cvt_pk_bf16(v0[0], v0[1]); w.y = cvt_pk_bf16(v0[2], v0[3]); w.z = cvt_pk_bf16(v1[0], v1[1]); w.w = cvt_pk_bf16(v1[2], v1[3]);
                    *(u32x4*)(rowp + bj * HALF) = w; }
            }
    }
};

__device__ __forceinline__ float silu_mul(float a, float b) { return a * b * __builtin_amdgcn_rcpf(1.0f + __builtin_amdgcn_exp2f(-1.4426950408889634f * a)); }
struct EpiSwiGLU {
    static constexpr bool PERM = true; typedef f32x4 acc_t;
    bf16_t* O; int ldc; const float* gate; const unsigned long long* rss; const int* rowmap;
    __device__ __forceinline__ void operator()(const f32x4 (&acc)[2][2][4][2], const Unit& u, int wr, int wc, int fr, int fq) const {
        const int row0 = u.pm * BM + wr * 64 + fr, col0 = u.pn * HALF + wc * 32 + 8 * fq;
#pragma unroll
        for (int ai = 0; ai < 2; ++ai)
#pragma unroll
            for (int m = 0; m < 4; ++m) {
                const int row = row0 + ai * HALF + m * 16; const float g = gate ? gate[row] : 1.f; const int trow = rowmap ? rowmap[row] : row;
                const float rs = trow >= 0 ? __builtin_amdgcn_rsqf((float)rss[trow] * (5.9604644775390625e-8f / 1024.0f) + 1e-6f) : 0.f;
                const f32x4 a0 = acc[ai][0][m][0] * rs, a1 = acc[ai][0][m][1] * rs, b0 = acc[ai][1][m][0] * rs, b1 = acc[ai][1][m][1] * rs;
                float v[8];
#pragma unroll
                for (int k = 0; k < 4; ++k) { v[k] = g * silu_mul(a0[k], b0[k]); v[4 + k] = g * silu_mul(a1[k], b1[k]); }
                u32x4 w; w.x = cvt_pk_bf16(v[0], v[1]); w.y = cvt_pk_bf16(v[2], v[3]); w.z = cvt_pk_bf16(v[4], v[5]); w.w = cvt_pk_bf16(v[6], v[7]);
                *(u32x4*)(O + (size_t)row * ldc + col0) = w; }
    }
};
struct EpiResB {
    static constexpr bool PERM = true; typedef f32x4 acc_t;
    const bf16_t* Rin; bf16_t* Rout; int ldc; const int* rowmap; unsigned long long* rss_out;
    __device__ __forceinline__ void operator()(const f32x4 (&acc)[2][2][4][2], const Unit& u, int wr, int wc, int fr, int fq) const {
        const int row0 = u.pm * BM + wr * 64 + fr, col0 = u.pn * BM + wc * 32 + 8 * fq;
#pragma unroll
        for (int ai = 0; ai < 2; ++ai)
#pragma unroll
            for (int m = 0; m < 4; ++m) {
                const int row = row0 + ai * HALF + m * 16; const int orow = rowmap ? rowmap[row] : row; float ss = 0.f;
                if (orow >= 0) { const bf16_t* rp = Rin + (size_t)orow * ldc + col0; bf16_t* wp = Rout + (size_t)orow * ldc + col0;
#pragma unroll
                    for (int bj = 0; bj < 2; ++bj) { const u32x4 w = *(const u32x4*)(rp + bj * HALF); const f32x4 a0 = acc[ai][bj][m][0], a1 = acc[ai][bj][m][1];
                        float v[8];
                        v[0] = __uint_as_float(w.x << 16) + a0[0]; v[1] = __uint_as_float(w.x & 0xffff0000u) + a0[1]; v[2] = __uint_as_float(w.y << 16) + a0[2]; v[3] = __uint_as_float(w.y & 0xffff0000u) + a0[3];
                        v[4] = __uint_as_float(w.z << 16) + a1[0]; v[5] = __uint_as_float(w.z & 0xffff0000u) + a1[1]; v[6] = __uint_as_float(w.w << 16) + a1[2]; v[7] = __uint_as_float(w.w & 0xffff0000u) + a1[3];
#pragma unroll
                        for (int k = 0; k < 8; ++k) ss += v[k] * v[k];
                        u32x4 o; o.x = cvt_pk_bf16(v[0], v[1]); o.y = cvt_pk_bf16(v[2], v[3]); o.z = cvt_pk_bf16(v[4], v[5]); o.w = cvt_pk_bf16(v[6], v[7]);
                        *(u32x4*)(wp + bj * HALF) = o; } }
                if (rss_out) { ss += __shfl_xor(ss, 16); ss += __shfl_xor(ss, 32);
                    if (fq == 0) __hip_atomic_fetch_add(rss_out + orow, (unsigned long long)(ss * 16777216.0f), __ATOMIC_RELAXED, __HIP_MEMORY_SCOPE_AGENT); }
                if (m & 1) asm volatile("" ::: "memory"); }
    }
};

typedef int i32x4_e __attribute__((ext_vector_type(4)));
struct EpiSwiGLUQ {
    static constexpr bool PERM = true; typedef i32x4_e acc_t;
    signed char* O; int ldc; const float* sa; const unsigned* cm; const int* rowmap; const PG8_LAS int* cum; float qmul;
    __device__ __forceinline__ void operator()(const i32x4_e (&acc)[2][2][4][2], const Unit& u, int wr, int wc, int fr, int fq) const {
        int e = 0;
        if (cum) {
#pragma unroll
            for (int k = 1; k < 8; ++k) e += (u.pm >= cum[k]) ? 1 : 0; }
        const unsigned* cme = cm + (size_t)e * 7168 + u.pn * BM + wc * 32 + 8 * fq;
        float cA[8], cAB[8];
#pragma unroll
        for (int k = 0; k < 8; ++k) { cA[k] = __uint_as_float(cme[k]) * (1.0f / 127.0f); cAB[k] = cA[k] * (__uint_as_float(cme[HALF + k]) * (1.0f / 127.0f)); }
        const int row0 = u.pm * BM + wr * 64 + fr, col0 = u.pn * HALF + wc * 32 + 8 * fq;
#pragma unroll
        for (int ai = 0; ai < 2; ++ai)
#pragma unroll
            for (int m = 0; m < 4; ++m) {
                const int row = row0 + ai * HALF + m * 16; const int trow = rowmap ? rowmap[row] : row; const float s = trow >= 0 ? sa[trow] : 0.f;
                const float sneg = -1.4426950408889634f * s, s2q = s * s * qmul;
                const i32x4_e a0 = acc[ai][0][m][0], a1 = acc[ai][0][m][1], b0 = acc[ai][1][m][0], b1 = acc[ai][1][m][1];
                unsigned lo = 0u, hi = 0u;
#pragma unroll
                for (int k = 0; k < 4; ++k) {
                    const float fa = (float)a0[k], fb = (float)b0[k], fc = (float)a1[k], fd = (float)b1[k];
                    const float sg0 = __builtin_amdgcn_rcpf(1.0f + __builtin_amdgcn_exp2f((fa * cA[k]) * sneg)), sg1 = __builtin_amdgcn_rcpf(1.0f + __builtin_amdgcn_exp2f((fc * cA[4 + k]) * sneg));
                    const float u0 = ((fa * fb) * cAB[k]) * s2q * sg0 + 128.0f, u1 = ((fc * fd) * cAB[4 + k]) * s2q * sg1 + 128.0f;
                    lo = __builtin_amdgcn_cvt_pk_u8_f32(__builtin_rintf(u0), k, lo); hi = __builtin_amdgcn_cvt_pk_u8_f32(__builtin_rintf(u1), k, hi); }
                lo ^= 0x80808080u; hi ^= 0x80808080u;
                *(unsigned long long*)(O + (size_t)row * ldc + col0) = (unsigned long long)lo | ((unsigned long long)hi << 32); }
    }
};
struct EpiResBQ {
    static constexpr bool PERM = true; typedef i32x4_e acc_t;
    const bf16_t* Rin; bf16_t* Rout; int ldc; const int* rowmap; const float* gate; const unsigned* cm; const PG8_LAS int* cum; float dq; unsigned long long* rss_out;
    __device__ __forceinline__ void operator()(const i32x4_e (&acc)[2][2][4][2], const Unit& u, int wr, int wc, int fr, int fq) const {
        int e = 0;
        if (cum) {
#pragma unroll
            for (int k = 1; k < 8; ++k) e += (u.pm >= cum[k]) ? 1 : 0; }
        const int row0 = u.pm * BM + wr * 64 + fr, col0 = u.pn * BM + wc * 32 + 8 * fq;
        const unsigned* cme = cm + (size_t)e * 1024 + col0;
        float sb[2][8];
#pragma unroll
        for (int bj = 0; bj < 2; ++bj)
#pragma unroll
            for (int k = 0; k < 8; ++k) sb[bj][k] = __uint_as_float(cme[bj * HALF + k]) * (dq / 127.0f);
#pragma unroll
        for (int ai = 0; ai < 2; ++ai)
#pragma unroll
            for (int m = 0; m < 4; ++m) {
                const int row = row0 + ai * HALF + m * 16; const int orow = rowmap ? rowmap[row] : row; float ss = 0.f;
                if (orow >= 0) { const float gt = gate ? gate[row] : 1.f; const bf16_t* rp = Rin + (size_t)orow * ldc + col0; bf16_t* wp = Rout + (size_t)orow * ldc + col0;
#pragma unroll
                    for (int bj = 0; bj < 2; ++bj) { const u32x4 w = *(const u32x4*)(rp + bj * HALF); const i32x4_e a0 = acc[ai][bj][m][0], a1 = acc[ai][bj][m][1];
                        float v[8];
                        v[0] = __uint_as_float(w.x << 16) + (float)a0[0] * gt * sb[bj][0]; v[1] = __uint_as_float(w.x & 0xffff0000u) + (float)a0[1] * gt * sb[bj][1];
                        v[2] = __uint_as_float(w.y << 16) + (float)a0[2] * gt * sb[bj][2]; v[3] = __uint_as_float(w.y & 0xffff0000u) + (float)a0[3] * gt * sb[bj][3];
                        v[4] = __uint_as_float(w.z << 16) + (float)a1[0] * gt * sb[bj][4]; v[5] = __uint_as_float(w.z & 0xffff0000u) + (float)a1[1] * gt * sb[bj][5];
                        v[6] = __uint_as_float(w.w << 16) + (float)a1[2] * gt * sb[bj][6]; v[7] = __uint_as_float(w.w & 0xffff0000u) + (float)a1[3] * gt * sb[bj][7];
#pragma unroll
                        for (int k = 0; k < 8; ++k) ss += v[k] * v[k];
                        u32x4 o; o.x = cvt_pk_bf16(v[0], v[1]); o.y = cvt_pk_bf16(v[2], v[3]); o.z = cvt_pk_bf16(v[4], v[5]); o.w = cvt_pk_bf16(v[6], v[7]);
                        *(u32x4*)(wp + bj * HALF) = o; } }
                if (rss_out) { ss += __shfl_xor(ss, 16); ss += __shfl_xor(ss, 32);
                    if (fq == 0) __hip_atomic_fetch_add(rss_out + orow, (unsigned long long)(ss * 16777216.0f), __ATOMIC_RELAXED, __HIP_MEMORY_SCOPE_AGENT); }
                if (m & 1) asm volatile("" ::: "memory"); }
    }
};
typedef int i32x4 __attribute__((ext_vector_type(4)));
__device__ __forceinline__ f32x4 mma16(bf16x8 a, bf16x8 b, f32x4 c) { return __builtin_amdgcn_mfma_f32_16x16x32_bf16(a, b, c, 0, 0, 0); }
__device__ __forceinline__ i32x4 mma16(bf16x8 a, bf16x8 b, i32x4 c) { return __builtin_amdgcn_mfma_i32_16x16x64_i8(__builtin_bit_cast(i32x4, a), __builtin_bit_cast(i32x4, b), c, 0, 0, 0); }
template <class Epi, class AB, bool ALIGN_EPI = true>
__device__ __forceinline__ void gemm_phase(PG8_LAS unsigned char* lds, const AB ab, const TileOrder& S, const Epi& E) {
    const int tid = threadIdx.x, wid = __builtin_amdgcn_readfirstlane(tid >> 6), lane = tid & 63, wr = wid >> 2, wc = wid & 3, fr = lane & 15, fq = lane >> 4;
    const int K = ab.K, nt = K / BK;
    int Rr[2], Cc[2]; unsigned voffB[2];
#pragma unroll
    for (int i = 0; i < 2; ++i) { int R, C; stage_rc(tid * 16 + i * 8192, R, C); const int Rb = Epi::PERM ? ((R & ~31) + perm32(R & 31)) : R;
        Rr[i] = R; Cc[i] = C; voffB[i] = (unsigned)(Rb * K + C) * 2u; }
    const size_t kstep = (size_t)(BK * 2);
    const size_t hstep = (size_t)HALF * K * 2;
    const unsigned ldsw = (unsigned)wid * 1024u;
    const int aoff = lds_byte(wr * 64 + fr, fq * 8), boff = lds_byte(wc * 32 + fr, fq * 8);
#define PG8_SA(b, h) (((b) * 2 + (h)) * HTB)
#define PG8_SB(b, h) ((4 + (b) * 2 + (h)) * HTB)
#define PG8_STAGE(bufoff, gbase, voff) do { _Pragma("unroll") for (int _i = 0; _i < 2; ++_i) \
        __builtin_amdgcn_global_load_lds((const unsigned*)((const char*)(gbase) + (voff)[_i]), (PG8_LAS unsigned*)(lds + (bufoff) + ldsw + _i * 8192), 16, 0, 0); } while (0)
#define PG8_LDA(dst, b, h) do { _Pragma("unroll") for (int m = 0; m < 4; ++m) _Pragma("unroll") for (int k = 0; k < 2; ++k) dst[m][k] = *(const PG8_LAS bf16x8*)(lds + PG8_SA(b, h) + aoff + m * 2048 + k * 1024); } while (0)
#define PG8_LDB(dst, b, h) do { _Pragma("unroll") for (int n = 0; n < 2; ++n) _Pragma("unroll") for (int k = 0; k < 2; ++k) dst[n][k] = *(const PG8_LAS bf16x8*)(lds + PG8_SB(b, h) + boff + n * 2048 + k * 1024); } while (0)
#define PG8_MMA(ai, bj, At, Bt) do { __builtin_amdgcn_s_setprio(1); _Pragma("unroll") for (int m = 0; m < 4; ++m) _Pragma("unroll") for (int n = 0; n < 2; ++n) _Pragma("unroll") for (int k = 0; k < 2; ++k) \
        acc[ai][bj][m][n] = mma16(Bt[n][k], At[m][k], acc[ai][bj][m][n]); __builtin_amdgcn_s_setprio(0); } while (0)
#define PG8_WAIT_V(n) asm volatile("s_waitcnt vmcnt(" #n ")" ::: "memory")
#define PG8_WAIT_L(n) asm volatile("s_waitcnt lgkmcnt(" #n ")" ::: "memory")
#define PG8_BAR __builtin_amdgcn_s_barrier()
#define PG8_SCHED __builtin_amdgcn_sched_barrier(0)
    Unit cur, nxt; int ui = 0;
    if (!S.next(0, cur)) return;
    typedef typename Epi::acc_t acc_t;
    acc_t acc[2][2][4][2];
#pragma unroll
    for (int a = 0; a < 2; ++a)
#pragma unroll
        for (int b = 0; b < 2; ++b)
#pragma unroll
            for (int m = 0; m < 4; ++m)
#pragma unroll
                for (int n = 0; n < 2; ++n) acc[a][b][m][n] = (acc_t){0, 0, 0, 0};
    bf16x8 At[4][2], B0[2][2], B1[2][2];
    unsigned cv0[2], cv1[2], nv0[2], nv1[2]; int ntok[4] = {0, 0, 0, 0};
    if constexpr (AB::GATHER) { const int* tp = ab.tokp(cur);
#pragma unroll
        for (int i = 0; i < 2; ++i) { int t0 = tp[Rr[i]], t1 = tp[HALF + Rr[i]]; t0 = t0 < 0 ? 0 : t0; t1 = t1 < 0 ? 0 : t1;
            cv0[i] = (unsigned)(t0 * K + Cc[i]) * 2u; cv1[i] = (unsigned)(t1 * K + Cc[i]) * 2u; }
    } else {
#pragma unroll
        for (int i = 0; i < 2; ++i) { cv0[i] = (unsigned)(Rr[i] * K + Cc[i]) * 2u; cv1[i] = cv0[i] + (unsigned)hstep; }
    }
#pragma unroll
    for (int i = 0; i < 2; ++i) { nv0[i] = cv0[i]; nv1[i] = cv1[i]; }
    const char* cA = ab.abase(cur); const char* cB = ab.bbase(cur);
    PG8_STAGE(PG8_SB(0, 0), cB, voffB); PG8_STAGE(PG8_SB(0, 1), cB + hstep, voffB); PG8_STAGE(PG8_SA(0, 0), cA, cv0); PG8_STAGE(PG8_SA(0, 1), cA, cv1);
    if (wr == 1) PG8_BAR;
    PG8_WAIT_V(2); PG8_BAR;
    PG8_STAGE(PG8_SB(1, 0), cB + kstep, voffB); PG8_STAGE(PG8_SA(1, 0), cA + kstep, cv0); PG8_STAGE(PG8_SB(1, 1), cB + hstep + kstep, voffB);
    PG8_WAIT_V(6); PG8_BAR;
    for (;;) {
        const bool has_next = S.next(ui + 1, nxt);
        const char* nA = has_next ? ab.abase(nxt) : cA; const char* nB = has_next ? ab.bbase(nxt) : cB;
        if constexpr (AB::GATHER) {
            if (has_next) { const int* tp = ab.tokp(nxt);
                asm volatile("global_load_dword %0, %1, off" : "=v"(ntok[0]) : "v"(tp + Rr[0]) : "memory");
                asm volatile("global_load_dword %0, %1, off" : "=v"(ntok[1]) : "v"(tp + Rr[1]) : "memory");
                asm volatile("global_load_dword %0, %1, off" : "=v"(ntok[2]) : "v"(tp + HALF + Rr[0]) : "memory");
                asm volatile("global_load_dword %0, %1, off" : "=v"(ntok[3]) : "v"(tp + HALF + Rr[1]) : "memory"); }
        }
        for (int t = 0; t < nt; t += 2) {
            const bool last = (t == nt - 2);
            const char* a1 = cA + (size_t)(t + 1) * kstep;
            const char* a2 = last ? nA : cA + (size_t)(t + 2) * kstep; const char* b2 = last ? nB : cB + (size_t)(t + 2) * kstep;
            const char* a3 = a2 + kstep; const char* b3 = b2 + kstep;
            unsigned x0[2], x1[2];
            if constexpr (AB::GATHER) {
                if (last && has_next) {
                    asm volatile("s_waitcnt vmcnt(6)" : "+v"(ntok[0]), "+v"(ntok[1]), "+v"(ntok[2]), "+v"(ntok[3]) :: "memory");
#pragma unroll
                    for (int i = 0; i < 2; ++i) { int t0 = ntok[i], t1 = ntok[2 + i]; t0 = t0 < 0 ? 0 : t0; t1 = t1 < 0 ? 0 : t1;
                        nv0[i] = (unsigned)(t0 * K + Cc[i]) * 2u; nv1[i] = (unsigned)(t1 * K + Cc[i]) * 2u; }
                }
#pragma unroll
                for (int i = 0; i < 2; ++i) { x0[i] = last ? nv0[i] : cv0[i]; x1[i] = last ? nv1[i] : cv1[i]; }
            } else {
#pragma unroll
                for (int i = 0; i < 2; ++i) { x0[i] = cv0[i]; x1[i] = cv1[i]; }
            }
            PG8_LDB(B0, 0, 0); PG8_LDB(B1, 0, 1); PG8_SCHED; PG8_LDA(At, 0, 0); PG8_STAGE(PG8_SA(1, 1), a1, cv1);
            PG8_WAIT_V(8); PG8_WAIT_L(0); PG8_BAR; PG8_MMA(0, 0, At, B0); PG8_MMA(0, 1, At, B1); PG8_BAR; PG8_SCHED;
            PG8_LDA(At, 0, 1); PG8_STAGE(PG8_SB(0, 0), b2, voffB); PG8_STAGE(PG8_SB(0, 1), b2 + hstep, voffB); PG8_STAGE(PG8_SA(0, 0), a2, x0);
            PG8_WAIT_V(8); PG8_WAIT_L(0); PG8_BAR; PG8_MMA(1, 0, At, B0); PG8_MMA(1, 1, At, B1); PG8_BAR; PG8_SCHED;
            PG8_LDB(B0, 1, 0); PG8_LDB(B1, 1, 1); PG8_SCHED; PG8_LDA(At, 1, 0); PG8_STAGE(PG8_SA(0, 1), a2, x1);
            PG8_WAIT_V(8); PG8_WAIT_L(0); PG8_BAR; PG8_MMA(0, 0, At, B0); PG8_MMA(0, 1, At, B1); PG8_BAR; PG8_SCHED;
            PG8_LDA(At, 1, 1); PG8_STAGE(PG8_SB(1, 0), b3, voffB); PG8_STAGE(PG8_SB(1, 1), b3 + hstep, voffB); PG8_STAGE(PG8_SA(1, 0), a3, x0);
            PG8_WAIT_V(8); PG8_WAIT_L(0); PG8_BAR; PG8_MMA(1, 0, At, B0); PG8_MMA(1, 1, At, B1); PG8_BAR; PG8_SCHED;
        }
        if constexpr (ALIGN_EPI) { if (wr == 0) PG8_BAR; }
        E(acc, cur, wr, wc, fr, fq);
        if (!has_next) break;
#pragma unroll
        for (int a = 0; a < 2; ++a)
#pragma unroll
            for (int b = 0; b < 2; ++b)
#pragma unroll
                for (int m = 0; m < 4; ++m)
#pragma unroll
                    for (int n = 0; n < 2; ++n) acc[a][b][m][n] = (acc_t){0, 0, 0, 0};
        cur = nxt; cA = nA; cB = nB; ++ui;
#pragma unroll
        for (int i = 0; i < 2; ++i) { cv0[i] = nv0[i]; cv1[i] = nv1[i]; }
        if constexpr (ALIGN_EPI) { if (wr == 1) PG8_BAR; }
    }
    PG8_WAIT_V(0);
    if constexpr (!ALIGN_EPI) { if (wr == 0) PG8_BAR; }
    PG8_BAR;
#undef PG8_SA
#undef PG8_SB
#undef PG8_STAGE
#undef PG8_LDA
#undef PG8_LDB
#undef PG8_MMA
#undef PG8_WAIT_V
#undef PG8_WAIT_L
#undef PG8_BAR
#undef PG8_SCHED
}
}

namespace moba {
using bf16 = __hip_bfloat16;
using bf16x8 = __attribute__((ext_vector_type(8))) short;
using s16x4  = __attribute__((ext_vector_type(4))) short;
using f32x16 = __attribute__((ext_vector_type(16))) float;
using u32x4  = __attribute__((ext_vector_type(4))) unsigned;
constexpr int D = 128, NW = 8, QBLK = 32, KVBLK = 64, LDK = 3072, NT = 4;
constexpr float THR = 8.f;
constexpr size_t SHM_V = KVBLK * D * 2, SHM_K = KVBLK * D * 2, SHM_ATTN = 2 * SHM_V + 2 * SHM_K + NW * 64 * 4;
#define KSWZ(row, colB) ((row) * 256 + ((colB) ^ (((row) & 7) << 4)))
#define SBAR() __builtin_amdgcn_sched_barrier(0)
__device__ __forceinline__ int crow(int r, int hi) { return (r & 3) + 8 * (r >> 2) + 4 * hi; }
__device__ __forceinline__ unsigned cvtpk(float lo, float hi) { unsigned r; asm volatile("v_cvt_pk_bf16_f32 %0, %1, %2" : "=v"(r) : "v"(lo), "v"(hi)); return r; }
__device__ __forceinline__ void partialSM(f32x16& p0, f32x16& p1, float& m_reg, float& mn, float& alpha) {
  float pmax = p0[0];
#pragma unroll
  for (int r = 1; r < 16; ++r) pmax = fmaxf(pmax, p0[r]);
#pragma unroll
  for (int r = 0; r < 16; ++r) pmax = fmaxf(pmax, p1[r]);
  { auto rr = __builtin_amdgcn_permlane32_swap(__float_as_uint(pmax), __float_as_uint(pmax), false, false);
    pmax = fmaxf(__uint_as_float(rr[0]), __uint_as_float(rr[1])); }
  if (__builtin_expect(__all(pmax - m_reg <= THR), 1)) { mn = m_reg; alpha = 1.f; }
  else { mn = fmaxf(m_reg, pmax); alpha = __builtin_amdgcn_exp2f(m_reg - mn); m_reg = mn; }
#pragma unroll
  for (int r = 0; r < 16; ++r) p0[r] = p0[r] - mn;
#pragma unroll
  for (int r = 0; r < 16; ++r) p1[r] = p1[r] - mn;
#pragma unroll
  for (int r = 0; r < 16; ++r) p0[r] = __builtin_amdgcn_exp2f(p0[r]);
}
__device__ __forceinline__ void finishSM(f32x16& p0, f32x16& p1, float alpha, float& l_reg, bf16x8& pa0, bf16x8& pa1, bf16x8& pa2, bf16x8& pa3) {
#pragma unroll
  for (int r = 0; r < 16; ++r) p1[r] = __builtin_amdgcn_exp2f(p1[r]);
  float ps = 0;
#pragma unroll
  for (int r = 0; r < 16; ++r) ps += p0[r];
#pragma unroll
  for (int r = 0; r < 16; ++r) ps += p1[r];
  { auto rr = __builtin_amdgcn_permlane32_swap(__float_as_uint(ps), __float_as_uint(ps), false, false);
    ps = __uint_as_float(rr[0]) + __uint_as_float(rr[1]); }
  l_reg = l_reg * alpha + ps;
#define PK4(P, BASE, OUT) do { unsigned a0 = cvtpk(P[BASE + 0], P[BASE + 1]), a1 = cvtpk(P[BASE + 2], P[BASE + 3]);   \
    unsigned b0 = cvtpk(P[BASE + 4], P[BASE + 5]), b1 = cvtpk(P[BASE + 6], P[BASE + 7]);                              \
    auto r0 = __builtin_amdgcn_permlane32_swap(a0, b0, false, false); auto r1 = __builtin_amdgcn_permlane32_swap(a1, b1, false, false); \
    u32x4 w = {r0[0], r1[0], r0[1], r1[1]}; OUT = *reinterpret_cast<bf16x8*>(&w); } while (0)
  PK4(p0, 0, pa0); PK4(p0, 8, pa1); PK4(p1, 0, pa2); PK4(p1, 8, pa3);
#undef PK4
}
__device__ __forceinline__ void qkt(f32x16& p0, f32x16& p1, const bf16* Ks, const bf16x8* qr, int r32, int hi) {
  p0 = f32x16{}; p1 = f32x16{};
#pragma unroll
  for (int d0 = 0; d0 < 8; ++d0) { int cb = (d0 * 16 + hi * 8) * 2;
    bf16x8 b0 = *reinterpret_cast<const bf16x8*>((const char*)Ks + KSWZ(r32, cb));
    bf16x8 b1 = *reinterpret_cast<const bf16x8*>((const char*)Ks + KSWZ(32 + r32, cb));
    p0 = __builtin_amdgcn_mfma_f32_32x32x16_bf16(b0, qr[d0], p0, 0, 0, 0);
    p1 = __builtin_amdgcn_mfma_f32_32x32x16_bf16(b1, qr[d0], p1, 0, 0, 0); }
}
__device__ __forceinline__ int v_st(int k, int c) { const int kk = (k & ~0xC) | ((k & 4) << 1) | ((k & 8) >> 1); return ((kk >> 3) * 4 + (c >> 5)) * 512 + ((kk & 7) * 32 + (c & 31)) * 2; }
__device__ __forceinline__ int v_rd_base(int lane) { return ((lane & 3) << 3) | (((lane >> 2) & 3) << 6) | (((lane >> 4) & 1) << 5) | (((lane >> 5) & 1) << 8); }
constexpr int v_rd_off(int d0, int ks, int half) { return d0 * 512 + ks * 4096 + half * 2048; }
template <int OFF> __device__ __forceinline__ s16x4 tr_read(int vb) {
  s16x4 r; asm volatile("ds_read_b64_tr_b16 %0, %1 offset:%2" : "=&v"(r) : "v"(vb), "i"(OFF) : "memory"); return r;
}
template <int D0> __device__ __forceinline__ void pv_one(f32x16& od, int vb, bf16x8 pa0, bf16x8 pa1, bf16x8 pa2, bf16x8 pa3) {
  const s16x4 l0 = tr_read<v_rd_off(D0, 0, 0)>(vb), h0 = tr_read<v_rd_off(D0, 0, 1)>(vb), l1 = tr_read<v_rd_off(D0, 1, 0)>(vb), h1 = tr_read<v_rd_off(D0, 1, 1)>(vb);
  const s16x4 l2 = tr_read<v_rd_off(D0, 2, 0)>(vb), h2 = tr_read<v_rd_off(D0, 2, 1)>(vb), l3 = tr_read<v_rd_off(D0, 3, 0)>(vb), h3 = tr_read<v_rd_off(D0, 3, 1)>(vb);
  asm volatile("s_waitcnt lgkmcnt(0)" ::: "memory"); SBAR();
#define PK(L, H) (bf16x8){L[0], L[1], L[2], L[3], H[0], H[1], H[2], H[3]}
  od = __builtin_amdgcn_mfma_f32_32x32x16_bf16(pa0, PK(l0, h0), od, 0, 0, 0);
  od = __builtin_amdgcn_mfma_f32_32x32x16_bf16(pa1, PK(l1, h1), od, 0, 0, 0);
  od = __builtin_amdgcn_mfma_f32_32x32x16_bf16(pa2, PK(l2, h2), od, 0, 0, 0);
  od = __builtin_amdgcn_mfma_f32_32x32x16_bf16(pa3, PK(l3, h3), od, 0, 0, 0);
#undef PK
}
__device__ __forceinline__ void pv_d0(f32x16* o, int vb, bf16x8 pa0, bf16x8 pa1, bf16x8 pa2, bf16x8 pa3) {
  pv_one<0>(o[0], vb, pa0, pa1, pa2, pa3); pv_one<1>(o[1], vb, pa0, pa1, pa2, pa3); pv_one<2>(o[2], vb, pa0, pa1, pa2, pa3); pv_one<3>(o[3], vb, pa0, pa1, pa2, pa3);
}
__device__ __forceinline__ void cmask(f32x16& p0, f32x16& p1, int tile, int ql, int hi) {
  asm volatile("" : "+v"(ql));
#pragma unroll
  for (int r = 0; r < 16; ++r) { const int kv = 64 * tile + (r & 3) + 8 * (r >> 2) + 4 * hi; if (kv > ql) p0[r] = -1e30f; if (kv + 32 > ql) p1[r] = -1e30f; }
}
__device__ __forceinline__ void moba_unit(const bool OWN, const bf16* qrow, const bf16* __restrict__ Kh, const bf16* __restrict__ Vh, bf16* obase, int ostride, int dst, float* ml, int mli, int ql, char* lds) {
  const int tid = threadIdx.x, wid = tid >> 6, lane = tid & 63, r32 = lane & 31, hi = lane >> 5;
  bf16* V_lds = (bf16*)lds; bf16* K_lds = (bf16*)(lds + 2 * SHM_V);
  float* ws = (float*)(lds + 2 * SHM_V + 2 * SHM_K) + wid * 64; float* li_l = ws; float* al_l = ws + 32;
  float m_reg = -1e30f, l_reg = 0; f32x16 o[4] = {}; bf16x8 qr[8];
  const bf16* Qw = qrow + hi * 8;
#pragma unroll
  for (int d0 = 0; d0 < 8; ++d0) qr[d0] = *reinterpret_cast<const bf16x8*>(Qw + d0 * 16);
  const int sr = tid >> 4, sc = (tid & 15) * 8, vst0 = v_st(sr, sc), vst1 = v_st(32 + sr, sc);
  const int vb0 = (int)(uintptr_t)V_lds + v_rd_base(lane);
  struct { bf16x8 vs0, vs1, ks0, ks1; } sr_[2];
#define SLOAD(i, k0) do { sr_[i].vs0 = *reinterpret_cast<const bf16x8*>(&Vh[(long)((k0) + sr) * LDK + sc]); sr_[i].vs1 = *reinterpret_cast<const bf16x8*>(&Vh[(long)((k0) + 32 + sr) * LDK + sc]); \
    sr_[i].ks0 = *reinterpret_cast<const bf16x8*>(&Kh[(long)((k0) + sr) * LDK + sc]); sr_[i].ks1 = *reinterpret_cast<const bf16x8*>(&Kh[(long)((k0) + 32 + sr) * LDK + sc]); } while (0)
#define SWRITE(b, i) do { *(bf16x8*)((char*)V_lds + (b) * SHM_V + vst0) = sr_[i].vs0;          \
    *(bf16x8*)((char*)V_lds + (b) * SHM_V + vst1) = sr_[i].vs1; int kc = sc * 2;               \
    *(bf16x8*)((char*)K_lds + (b) * SHM_K + KSWZ(sr, kc)) = sr_[i].ks0;                       \
    *(bf16x8*)((char*)K_lds + (b) * SHM_K + KSWZ(32 + sr, kc)) = sr_[i].ks1; } while (0)
#define SWAIT() asm volatile("s_waitcnt vmcnt(4)" ::: "memory")
#define RESC(a) do { if (__any((a) < 1.f)) { if (hi == 0) al_l[r32] = (a); asm volatile("s_waitcnt lgkmcnt(0)" ::: "memory"); \
    _Pragma("unroll") for (int d = 0; d < 4; ++d) _Pragma("unroll") for (int r = 0; r < 16; ++r) o[d][r] *= al_l[crow(r, hi)]; } } while (0)
  f32x16 pA0, pA1, pB0, pB1; float mnA, mnB, alA, alB; bf16x8 pa0, pa1, pa2, pa3;
  constexpr int SE = 0, SO = 1;
  SLOAD(SE, 0); asm volatile("s_waitcnt vmcnt(0)" ::: "memory"); SWRITE(0, SE); __syncthreads();
  qkt(pA0, pA1, K_lds, qr, r32, hi); if (OWN) cmask(pA0, pA1, 0, ql, hi); partialSM(pA0, pA1, m_reg, mnA, alA);
  SLOAD(SO, KVBLK); SLOAD(SE, 2 * KVBLK);
  SWAIT(); SWRITE(1, SO); __syncthreads();
  {
    SBAR(); qkt(pB0, pB1, (bf16*)((char*)K_lds + SHM_K), qr, r32, hi);
    finishSM(pA0, pA1, alA, l_reg, pa0, pa1, pa2, pa3); SBAR();
    SLOAD(SO, 3 * KVBLK); SBAR();
    pv_d0(o, vb0, pa0, pa1, pa2, pa3); if (OWN) cmask(pB0, pB1, 1, ql, hi); partialSM(pB0, pB1, m_reg, mnB, alB);
    __syncthreads(); SWAIT(); SWRITE(0, SE);
    RESC(alB); __syncthreads();
    SBAR(); qkt(pA0, pA1, K_lds, qr, r32, hi);
    finishSM(pB0, pB1, alB, l_reg, pa0, pa1, pa2, pa3); SBAR();
    pv_d0(o, vb0 + (int)SHM_V, pa0, pa1, pa2, pa3); if (OWN) cmask(pA0, pA1, 2, ql, hi); partialSM(pA0, pA1, m_reg, mnA, alA);
    __syncthreads(); asm volatile("s_waitcnt vmcnt(0)" ::: "memory"); SWRITE(1, SO);
    RESC(alA); __syncthreads();
  }
  SBAR(); qkt(pB0, pB1, (bf16*)((char*)K_lds + SHM_K), qr, r32, hi);
  finishSM(pA0, pA1, alA, l_reg, pa0, pa1, pa2, pa3); SBAR();
  pv_d0(o, vb0, pa0, pa1, pa2, pa3); if (OWN) cmask(pB0, pB1, 3, ql, hi); partialSM(pB0, pB1, m_reg, mnB, alB);
  __syncthreads(); RESC(alB);
  finishSM(pB0, pB1, alB, l_reg, pa0, pa1, pa2, pa3); SBAR();
  pv_d0(o, vb0 + (int)SHM_V, pa0, pa1, pa2, pa3);
  if (hi == 0) li_l[r32] = l_reg; asm volatile("s_waitcnt lgkmcnt(0)" ::: "memory");
  float rli[16];
#pragma unroll
  for (int r = 0; r < 16; ++r) rli[r] = __builtin_amdgcn_rcpf(li_l[crow(r, hi)]);
  __syncthreads();
  bf16* stg = (bf16*)lds + wid * 4096;
#pragma unroll
  for (int r = 0; r < 16; ++r) { const int orow = crow(r, hi);
#pragma unroll
    for (int d0 = 0; d0 < 4; ++d0) stg[orow * 128 + d0 * 32 + r32] = __float2bfloat16(o[d0][r] * rli[r]); }
  int* dsto = (int*)al_l;
  if (hi == 0) dsto[r32] = dst;
  asm volatile("s_waitcnt lgkmcnt(0)" ::: "memory");
#pragma unroll
  for (int i = 0; i < 8; ++i) { const int row = i * 4 + (lane >> 4), ch = lane & 15; const int di = dsto[row]; const u32x4 v = *(const u32x4*)(stg + row * 128 + ch * 8);
    if (di >= 0) *(u32x4*)(obase + (size_t)di * ostride + ch * 8) = v; }
  if (hi == 0 && dst >= 0) { ml[2 * (size_t)mli] = m_reg; ml[2 * (size_t)mli + 1] = l_reg; }
  asm volatile("s_waitcnt lgkmcnt(0)" ::: "memory");
  __syncthreads();
#undef SLOAD
#undef SWRITE
#undef SWAIT
#undef RESC
}

#define KSWZ64(row, colB) ((row) * 128 + ((colB) ^ ((((row) >> 1) & 7) << 4)))
constexpr size_t DA_SHM_K = 64 * 64 * 2;
constexpr size_t DA_SHM = 2 * SHM_V + 2 * DA_SHM_K + NW * 64 * 4;
__device__ __forceinline__ void qkt64(f32x16& p0, f32x16& p1, const bf16* Ks, const bf16x8* qr, int r32, int hi) {
  p0 = f32x16{}; p1 = f32x16{};
#pragma unroll
  for (int d0 = 0; d0 < 4; ++d0) { int cb = (d0 * 16 + hi * 8) * 2;
    bf16x8 b0 = *reinterpret_cast<const bf16x8*>((const char*)Ks + KSWZ64(r32, cb));
    bf16x8 b1 = *reinterpret_cast<const bf16x8*>((const char*)Ks + KSWZ64(32 + r32, cb));
    p0 = __builtin_amdgcn_mfma_f32_32x32x16_bf16(b0, qr[d0], p0, 0, 0, 0);
    p1 = __builtin_amdgcn_mfma_f32_32x32x16_bf16(b1, qr[d0], p1, 0, 0, 0); }
}
__device__ __forceinline__ void dattn_unit(const bf16* Qb, const bf16* __restrict__ Kh, const bf16* __restrict__ Vh, bf16* Ob, const int NT, char* lds) {
  const int tid = threadIdx.x, wid = tid >> 6, lane = tid & 63, r32 = lane & 31, hi = lane >> 5;
  bf16* V_lds = (bf16*)lds; bf16* K_lds = (bf16*)(lds + 2 * SHM_V);
  float* ws = (float*)(lds + 2 * SHM_V + 2 * DA_SHM_K) + wid * 64; float* li_l = ws; float* al_l = ws + 32;
  float m_reg = -1e30f, l_reg = 0; f32x16 o[4] = {}; bf16x8 qr[4];
  const bf16* Qw = Qb + (long)(wid * QBLK + r32) * LDK + hi * 8;
#pragma unroll
  for (int d0 = 0; d0 < 4; ++d0) qr[d0] = *reinterpret_cast<const bf16x8*>(Qw + d0 * 16);
  const int sr = tid >> 4, sc = (tid & 15) * 8, vst0 = v_st(sr, sc), vst1 = v_st(32 + sr, sc);
  const int kr = tid >> 3, kc = (tid & 7) * 8, kst = KSWZ64(kr, kc * 2);
  const int vb0 = (int)(uintptr_t)V_lds + v_rd_base(lane);
  const int ql = wid * QBLK + r32;
  struct { bf16x8 vs0, vs1, ks; } sr_[2];
#define SLOAD(i, k0) do { sr_[i].vs0 = *reinterpret_cast<const bf16x8*>(&Vh[(long)((k0) + sr) * LDK + sc]); sr_[i].vs1 = *reinterpret_cast<const bf16x8*>(&Vh[(long)((k0) + 32 + sr) * LDK + sc]); \
    sr_[i].ks = *reinterpret_cast<const bf16x8*>(&Kh[(long)((k0) + kr) * LDK + kc]); } while (0)
#define SWRITE(b, i) do { *(bf16x8*)((char*)V_lds + (b) * SHM_V + vst0) = sr_[i].vs0; *(bf16x8*)((char*)V_lds + (b) * SHM_V + vst1) = sr_[i].vs1; \
    *(bf16x8*)((char*)K_lds + (b) * DA_SHM_K + kst) = sr_[i].ks; } while (0)
#define SWAIT() asm volatile("s_waitcnt vmcnt(3)" ::: "memory")
#define RESC(a) do { if (__any((a) < 1.f)) { if (hi == 0) al_l[r32] = (a); asm volatile("s_waitcnt lgkmcnt(0)" ::: "memory"); \
    _Pragma("unroll") for (int d = 0; d < 4; ++d) _Pragma("unroll") for (int r = 0; r < 16; ++r) o[d][r] *= al_l[crow(r, hi)]; } } while (0)
#define MASK(P0, P1, t) do { if ((t) >= NT - 4) cmask(P0, P1, (t) - (NT - 4), ql, hi); } while (0)
  f32x16 pA0, pA1, pB0, pB1; float mnA, mnB, alA, alB; bf16x8 pa0, pa1, pa2, pa3;
  constexpr int SE = 0, SO = 1;
  SLOAD(SE, 0); asm volatile("s_waitcnt vmcnt(0)" ::: "memory"); SWRITE(0, SE); __syncthreads();
  qkt64(pA0, pA1, K_lds, qr, r32, hi); MASK(pA0, pA1, 0); partialSM(pA0, pA1, m_reg, mnA, alA);
  SLOAD(SO, KVBLK); SLOAD(SE, 2 * KVBLK);
  SWAIT(); SWRITE(1, SO); __syncthreads();
  for (int j = 1; j + 1 < NT; j += 2) {
    SBAR(); qkt64(pB0, pB1, (bf16*)((char*)K_lds + DA_SHM_K), qr, r32, hi);
    finishSM(pA0, pA1, alA, l_reg, pa0, pa1, pa2, pa3); SBAR();
    SLOAD(SO, (j + 2) * KVBLK); SBAR();
    pv_d0(o, vb0, pa0, pa1, pa2, pa3); MASK(pB0, pB1, j); partialSM(pB0, pB1, m_reg, mnB, alB);
    __syncthreads(); SWAIT(); SWRITE(0, SE);
    RESC(alB); __syncthreads();
    SBAR(); qkt64(pA0, pA1, K_lds, qr, r32, hi);
    finishSM(pB0, pB1, alB, l_reg, pa0, pa1, pa2, pa3); SBAR();
    if (j + 3 < NT) SLOAD(SE, (j + 3) * KVBLK); SBAR();
    pv_d0(o, vb0 + (int)SHM_V, pa0, pa1, pa2, pa3); MASK(pA0, pA1, j + 1); partialSM(pA0, pA1, m_reg, mnA, alA);
    __syncthreads(); SWAIT(); SWRITE(1, SO);
    RESC(alA); __syncthreads();
  }
  SBAR(); qkt64(pB0, pB1, (bf16*)((char*)K_lds + DA_SHM_K), qr, r32, hi);
  finishSM(pA0, pA1, alA, l_reg, pa0, pa1, pa2, pa3); SBAR();
  pv_d0(o, vb0, pa0, pa1, pa2, pa3); MASK(pB0, pB1, NT - 1); partialSM(pB0, pB1, m_reg, mnB, alB);
  __syncthreads(); RESC(alB);
  finishSM(pB0, pB1, alB, l_reg, pa0, pa1, pa2, pa3); SBAR();
  pv_d0(o, vb0 + (int)SHM_V, pa0, pa1, pa2, pa3);
  if (hi == 0) li_l[r32] = l_reg; asm volatile("s_waitcnt lgkmcnt(0)" ::: "memory");
  float rli[16];
#pragma unroll
  for (int r = 0; r < 16; ++r) rli[r] = __builtin_amdgcn_rcpf(li_l[crow(r, hi)]);
  __syncthreads();
  bf16* stg = (bf16*)lds + wid * 4096;
#pragma unroll
  for (int r = 0; r < 16; ++r) { const int orow = crow(r, hi);
#pragma unroll
    for (int d0 = 0; d0 < 4; ++d0) stg[orow * 128 + d0 * 32 + r32] = __float2bfloat16(o[d0][r] * rli[r]); }
  asm volatile("s_waitcnt lgkmcnt(0)" ::: "memory");
#pragma unroll
  for (int i = 0; i < 8; ++i) { const int row = i * 4 + (lane >> 4), ch = lane & 15; const u32x4 v = *(const u32x4*)(stg + row * 128 + ch * 8);
    *(u32x4*)(Ob + (size_t)(wid * QBLK + row) * 2048 + ch * 8) = v; }
  asm volatile("s_waitcnt lgkmcnt(0)" ::: "memory");
  __syncthreads();
#undef SLOAD
#undef SWRITE
#undef SWAIT
#undef RESC
#undef MASK
}
struct DaUnit { int bqh; int qb; };
struct DaOrder {
  int vcu, G;
  __device__ __forceinline__ DaOrder(int vcu_, int G_) : vcu(vcu_), G(G_) {}
  __device__ __forceinline__ bool next(int i, DaUnit& u) const {
    if (G == 256) { if (i >= 8) return false; const int s = vcu & 7, ii = i & 3; u.bqh = (i >> 2) * 32 + (vcu >> 3); u.qb = (ii == 0) ? s : (ii == 1) ? 15 - s : (ii == 2) ? 16 + s : 31 - s; return true; }
    const int uu = vcu + i * G; if (uu >= 2048) return false; u.bqh = uu >> 5; u.qb = uu & 31; return true; }
};
template <class Sched> __device__ __forceinline__ void dattn_phase(char* lds, const bf16* QKV, bf16* O, const Sched& S) {
  DaUnit u;
  for (int i = 0; S.next(i, u); ++i) { const int b = u.bqh >> 4, qh = u.bqh & 15; const size_t rb = (size_t)b * 8192;
    dattn_unit(QKV + (rb + u.qb * 256) * LDK + qh * 64, QKV + rb * LDK + 1024 + qh * 64, QKV + rb * LDK + 2048 + (qh >> 1) * 128, O + (rb + u.qb * 256) * 2048 + qh * 128, 4 * (u.qb + 1), lds); }
}
#undef KSWZ64
#undef KSWZ
#undef SBAR
}
#define GAS __attribute__((address_space(1)))
#define LAS __attribute__((address_space(3)))
typedef unsigned short bf16;
typedef unsigned v4u __attribute__((ext_vector_type(4)));
typedef float f32x4 __attribute__((ext_vector_type(4)));
typedef short bf16x8 __attribute__((ext_vector_type(8)));
typedef GAS unsigned gu32;
typedef GAS unsigned long long gu64;
#define RLX_AGENT __ATOMIC_RELAXED, __HIP_MEMORY_SCOPE_AGENT
#define LDS_WAIT() asm volatile("s_waitcnt lgkmcnt(0)" ::: "memory")
#define VM_WAIT() asm volatile("s_waitcnt vmcnt(0)" ::: "memory")
__device__ __forceinline__ unsigned long long rt() { return __builtin_amdgcn_s_memrealtime(); }
__device__ __forceinline__ unsigned f2bf(float f) { unsigned u = __builtin_bit_cast(unsigned, f); return (u + 0x7fffu + ((u >> 16) & 1u)) >> 16; }
__device__ __forceinline__ unsigned pk2(float lo, float hi) { return f2bf(lo) | (f2bf(hi) << 16); }
#define XB_TMO      128
#define XB_XCNT(j)  (256  + 64 * (j))
#define XB_XSUB(j)  (1280 + 64 * (j))
#define XB_XGEN(j)  (2304 + 64 * (j))
#define XB_TOP      3328
#define XB_TOPGEN   3392
#define XCD_BAR_WORDS 3456
#define XB_SPIN_CAP (1u << 18)

__device__ __forceinline__ unsigned xb_ld(unsigned* p)              { return __hip_atomic_load(p, __ATOMIC_RELAXED, __HIP_MEMORY_SCOPE_AGENT); }
__device__ __forceinline__ unsigned xb_add(unsigned* p, unsigned v) { return __hip_atomic_fetch_add(p, v, __ATOMIC_RELAXED, __HIP_MEMORY_SCOPE_AGENT); }
__device__ __forceinline__ unsigned xb_xcc_id() { return (unsigned)__builtin_amdgcn_s_getreg((3 << 11) | 20) & 0xFu; }
#define XB_SPIN(cond, bar) do { unsigned _sp = 0; while (cond) { __builtin_amdgcn_s_sleep(1); \
    if ((++_sp & 255u) == 0u) { if (xb_ld(&(bar)[XB_TMO])) break; if (_sp > XB_SPIN_CAP) { atomicAdd(&(bar)[XB_TMO], 1u); break; } } } } while (0)

struct XcdBarrier {
    unsigned* bar; unsigned x;
    volatile LAS unsigned* st;
};

__device__ __forceinline__ XcdBarrier xcd_barrier_post(unsigned* bar, volatile LAS unsigned* st) {
    XcdBarrier b; b.bar = bar; b.x = xb_xcc_id(); b.st = st;
    if (threadIdx.x == 0) (void)xb_add(&bar[XB_XCNT(b.x)], 1u);
    return b;
}
__device__ __forceinline__ void xcd_barrier_complete(unsigned* bar, unsigned x, unsigned& nloc, unsigned& nx) {
    const unsigned G = gridDim.x * gridDim.y * gridDim.z;
    unsigned sum, cnt, mine, sp = 0u;
    for (;;) {
        sum = 0u; cnt = 0u; mine = 0u;
#pragma unroll
        for (unsigned j = 0; j < 16; ++j) { const unsigned c = xb_ld(&bar[XB_XCNT(j)]); sum += c; cnt += (c > 0u) ? 1u : 0u; mine = (j == x) ? c : mine; }
        if (sum == G) break;
        __builtin_amdgcn_s_sleep(1);
        if ((++sp & 255u) == 0u) { if (xb_ld(&bar[XB_TMO])) break; if (sp > XB_SPIN_CAP) { atomicAdd(&bar[XB_TMO], 1u); break; } }
    }
    nloc = mine > 0u ? mine : 1u; nx = cnt > 0u ? cnt : 1u;
}

__device__ __forceinline__ void xcd_barrier(const XcdBarrier& b) {
    asm volatile("s_waitcnt vmcnt(0)" ::: "memory");
    __syncthreads();
    if (threadIdx.x == 0) {
        unsigned* bar = b.bar;
        __builtin_amdgcn_s_waitcnt(0);
        unsigned nloc = b.st[0], nx = b.st[1];
        if (nloc == 0u) { xcd_barrier_complete(bar, b.x, nloc, nx); b.st[0] = nloc; b.st[1] = nx; }
        const unsigned old = xb_add(&bar[XB_XSUB(b.x)], 1u);
        const unsigned gen = old / nloc;
        if (old + 1u == (gen + 1u) * nloc) {
            __builtin_amdgcn_fence(__ATOMIC_RELEASE, "agent");
            asm volatile("s_waitcnt vmcnt(0)" ::: "memory");
            const unsigned og = xb_add(&bar[XB_TOP], 1u);
            const unsigned tg = og / nx;
            if (og + 1u == (tg + 1u) * nx) xb_add(&bar[XB_TOPGEN], 1u);
            else XB_SPIN(xb_ld(&bar[XB_TOPGEN]) == tg, bar);
            __builtin_amdgcn_fence(__ATOMIC_ACQUIRE, "agent");
            xb_add(&bar[XB_XGEN(b.x)], 1u);
            asm volatile("s_waitcnt vmcnt(0)" ::: "memory");
        } else {
            XB_SPIN(xb_ld(&bar[XB_XGEN(b.x)]) == gen, bar);
            __builtin_amdgcn_fence(__ATOMIC_ACQUIRE, "agent");
            asm volatile("s_waitcnt vmcnt(0)" ::: "memory");
        }
    }
    __syncthreads();
}

constexpr int NWAVES = 8;
#ifndef GEMM_ALIGN
#define GEMM_ALIGN true
#endif
#ifndef MK_PER_PHASE
#define MK_PER_PHASE 0
#endif
constexpr int BATCH = 4, SEQ = 8192, DM = 1024, TOK = BATCH * SEQ;
constexpr int FF0 = 2816, NEXP = 8, FF1 = 3584;
constexpr int NQKV = 3072;
constexpr int MB_H = 8, MB_NB = 32, MB_L = 256;
constexpr int SLOTS = TOK + NEXP * 256;
constexpr float NORM_EPS = 1e-6f, SUBLN_EPS = 1e-5f;
constexpr float LAMBDA_INIT0 = 0.2f;
constexpr float LOG2E = 1.4426950408889634f;
constexpr int LIST_PER_BH = 256 * 496;
__host__ __device__ constexpr int list_off(int j) { return 256 * (31 * j - (j * (j - 1)) / 2); }

constexpr size_t MiB = 1u << 20;
constexpr size_t WS_CTL = 0, CTL_ZERO_BYTES = 3 * MiB;
constexpr size_t WS_CMAX13 = 2 * MiB;
constexpr size_t WS_CMAX2 = WS_CMAX13 + 256 * 1024;
constexpr size_t WS_SSTOT = WS_CMAX2 + 64 * 1024;
constexpr size_t WS_CM0 = WS_CMAX2 + 128 * 1024;
constexpr size_t WS_ROPE64 = 3 * MiB;
constexpr size_t WS_ROPE128 = WS_ROPE64 + 512 * 1024;
constexpr size_t WS_KMEAN = WS_ROPE128 + 1 * MiB;
constexpr size_t WS_TOK = 5 * MiB;
constexpr size_t WS_SLOT = 6 * MiB;
constexpr size_t WS_SA = 7 * MiB;
constexpr size_t WS_OWNML = 41 * MiB;
constexpr size_t WS_W0QKV = 8 * MiB, WS_W0O = 14 * MiB, WS_W013 = 16 * MiB, WS_W02 = 27 * MiB, WS_W1QKV = 33 * MiB, WS_W1O = 39 * MiB;
constexpr size_t B0 = 43 * MiB;
constexpr size_t WS_H = B0;
constexpr size_t WS_QKV = B0 + 64 * MiB;
constexpr size_t WS_OATT = B0 + 256 * MiB;
constexpr size_t WS_UD = B0 + 128 * MiB;
constexpr size_t WS_LIST = B0 + 256 * MiB;
constexpr size_t WS_PML = B0 + 272 * MiB;
constexpr size_t WS_PO = B0 + 280 * MiB;
constexpr size_t WS_WM13 = B0 + 64 * MiB;
constexpr size_t WS_WM2 = WS_WM13 + 56 * MiB;
constexpr size_t WS_AQ = WS_WM2 + 28 * MiB;
constexpr size_t WS_UM = B0 + 232 * MiB;
constexpr size_t WS_END = WS_PO + (size_t)TOK * MB_H * 3 * 128 * 2;
static_assert(WS_UM + (size_t)SLOTS * FF1 <= WS_END && WS_AQ + (size_t)TOK * DM <= WS_UM && WS_END <= 528 * MiB, "d_ws map");
constexpr int CW_TMO = 0, CW_CODE = 1, CW_DBG = 2;
constexpr int CW_MOECNT = 64;
constexpr int CW_MOBACNT = 256;
constexpr int CW_BAR = 4096;
constexpr size_t WS_RSS = 1 * MiB;
constexpr int RING_OFF = 0, RING_BYTES = 131072;
constexpr int LDSCTL_OFF = RING_BYTES, MISC_OFF = LDSCTL_OFF + 320;
constexpr int LDS_BYTES = 147456;

struct Args { const float* in[20]; float* out; unsigned char* ws; float inv64[8]; float inv128[16]; int ph_lo, ph_hi; };

__device__ __forceinline__ float wave_sum(float v) {
#pragma unroll
    for (int o = 1; o < 64; o <<= 1) v += __shfl_xor(v, o);
    return v;
}
template <int MAP> __device__ __forceinline__ int maprow(int n) {
    if (MAP == 1) { if (n >= 2048) return n; const int d = n & 63; if (d >= 16) return n; const int b = d >> 3, a = (d >> 2) & 1, c = d & 3; return (n & ~63) + 8 * a + 4 * b + c; }
    if (MAP == 2) { if (n >= 2048) return n; const int d = n & 127; if (d >= 32) return n; const int b = d >> 4, a = (d >> 2) & 3, c = d & 3; return (n & ~127) + 8 * a + 4 * b + c; }
    if (MAP == 3) return 256 * (n >> 7) + (n & 127);
    if (MAP == 4) return 256 * (n >> 7) + 128 + (n & 127);
    return n;
}
template <int MAP> __device__ __forceinline__ void transpose_item(const float* W, int K, int N, bf16* WT, LAS float* scr, int item, int lane, const float* gk = nullptr) {
    const int nblk = N / 32, kb = item / nblk, nb = item % nblk, k0 = 64 * kb, n0 = 32 * nb;
    const int kr = lane >> 3, nc = (lane & 7) * 4;
    f32x4 v[8];
#pragma unroll
    for (int i = 0; i < 8; ++i) v[i] = *(const GAS f32x4*)(W + (size_t)(k0 + i * 8 + kr) * N + n0 + nc);
    if (gk) {
#pragma unroll
        for (int i = 0; i < 8; ++i) v[i] = v[i] * gk[k0 + i * 8 + kr]; }
#pragma unroll
    for (int i = 0; i < 8; ++i) { LAS float* d = scr + (i * 8 + kr) * 33 + nc; d[0] = v[i].x; d[1] = v[i].y; d[2] = v[i].z; d[3] = v[i].w; }
    LDS_WAIT(); asm volatile("" ::: "memory");
    const int c = lane & 7;
#pragma unroll
    for (int j = 0; j < 4; ++j) { const int n = (lane >> 3) + 8 * j; const LAS float* s = scr + (8 * c) * 33 + n;
        v4u o; o.x = pk2(s[0 * 33], s[1 * 33]); o.y = pk2(s[2 * 33], s[3 * 33]); o.z = pk2(s[4 * 33], s[5 * 33]); o.w = pk2(s[6 * 33], s[7 * 33]);
        *(GAS v4u*)(WT + (size_t)maprow<MAP>(n0 + n) * K + k0 + 8 * c) = o; }
    LDS_WAIT(); asm volatile("" ::: "memory");
}

template <int MAP> __device__ __forceinline__ float wmax_strip(const float* W, int N, unsigned* cmax, int kb0, int nkb, int nb, int lane, const float* gk) {
    const int n0 = 32 * nb, kr = lane >> 3, nc = (lane & 7) * 4;
    f32x4 mx = (f32x4){0.f, 0.f, 0.f, 0.f}; float ss = 0.f;
    for (int kb = kb0; kb < kb0 + nkb; ++kb) { const int k0 = 64 * kb;
        f32x4 v[8];
#pragma unroll
        for (int i = 0; i < 8; ++i) v[i] = *(const GAS f32x4*)(W + (size_t)(k0 + i * 8 + kr) * N + n0 + nc);
        if (gk) {
#pragma unroll
            for (int i = 0; i < 8; ++i) v[i] = v[i] * gk[k0 + i * 8 + kr]; }
#pragma unroll
        for (int i = 0; i < 8; ++i) { mx.x = fmaxf(mx.x, fabsf(v[i].x)); mx.y = fmaxf(mx.y, fabsf(v[i].y)); mx.z = fmaxf(mx.z, fabsf(v[i].z)); mx.w = fmaxf(mx.w, fabsf(v[i].w));
            ss += (v[i].x * v[i].x + v[i].y * v[i].y) + (v[i].z * v[i].z + v[i].w * v[i].w); } }
#pragma unroll
    for (int o = 8; o < 64; o <<= 1) { mx.x = fmaxf(mx.x, __shfl_xor(mx.x, o)); mx.y = fmaxf(mx.y, __shfl_xor(mx.y, o)); mx.z = fmaxf(mx.z, __shfl_xor(mx.z, o)); mx.w = fmaxf(mx.w, __shfl_xor(mx.w, o)); }
    if (lane < 8) {
        __hip_atomic_fetch_max(cmax + maprow<MAP>(n0 + nc + 0), __float_as_uint(mx.x), __ATOMIC_RELAXED, __HIP_MEMORY_SCOPE_AGENT);
        __hip_atomic_fetch_max(cmax + maprow<MAP>(n0 + nc + 1), __float_as_uint(mx.y), __ATOMIC_RELAXED, __HIP_MEMORY_SCOPE_AGENT);
        __hip_atomic_fetch_max(cmax + maprow<MAP>(n0 + nc + 2), __float_as_uint(mx.z), __ATOMIC_RELAXED, __HIP_MEMORY_SCOPE_AGENT);
        __hip_atomic_fetch_max(cmax + maprow<MAP>(n0 + nc + 3), __float_as_uint(mx.w), __ATOMIC_RELAXED, __HIP_MEMORY_SCOPE_AGENT); }
    return ss;
}
template <int MAP> __device__ __forceinline__ void transpose_item_q(const float* W, int K, int N, signed char* WT, const unsigned* cmax, LAS float* scr, int item, int lane, const float* gk) {
    const int nblk = N / 32, kb = item / nblk, nb = item % nblk, k0 = 64 * kb, n0 = 32 * nb;
    const int kr = lane >> 3, nc = (lane & 7) * 4;
    f32x4 v[8];
#pragma unroll
    for (int i = 0; i < 8; ++i) v[i] = *(const GAS f32x4*)(W + (size_t)(k0 + i * 8 + kr) * N + n0 + nc);
    if (gk) {
#pragma unroll
        for (int i = 0; i < 8; ++i) v[i] = v[i] * gk[k0 + i * 8 + kr]; }
#pragma unroll
    for (int i = 0; i < 8; ++i) { LAS float* d = scr + (i * 8 + kr) * 33 + nc; d[0] = v[i].x; d[1] = v[i].y; d[2] = v[i].z; d[3] = v[i].w; }
    LDS_WAIT(); asm volatile("" ::: "memory");
    const int half = lane >> 5, n = lane & 31, row = maprow<MAP>(n0 + n);
    const float cm = __uint_as_float(cmax[row]); const float inv = cm > 0.f ? 127.0f / cm : 0.f;
    const LAS float* s = scr + (32 * half) * 33 + n;
    unsigned w[8];
#pragma unroll
    for (int q4 = 0; q4 < 8; ++q4) { unsigned pk = 0;
#pragma unroll
        for (int b = 0; b < 4; ++b) { const int q = (int)__builtin_rintf(s[(4 * q4 + b) * 33] * inv); pk |= (unsigned)(q & 255) << (8 * b); }
        w[q4] = pk; }
    GAS v4u* dst = (GAS v4u*)(WT + (size_t)row * K + k0 + 32 * half);
    dst[0] = (v4u){w[0], w[1], w[2], w[3]}; dst[1] = (v4u){w[4], w[5], w[6], w[7]};
    LDS_WAIT(); asm volatile("" ::: "memory");
}
__device__ __forceinline__ void rms_row(const float* xrow, const f32x4 (&g)[4], f32x4 (&v)[4], int lane) {
    const GAS f32x4* xr = (const GAS f32x4*)xrow + lane; float s = 0.f;
#pragma unroll
    for (int j = 0; j < 4; ++j) { v[j] = xr[64 * j]; s += (v[j].x * v[j].x + v[j].y * v[j].y) + (v[j].z * v[j].z + v[j].w * v[j].w); }
    const float rstd = 1.f / sqrtf(wave_sum(s) * (1.f / DM) + NORM_EPS);
#pragma unroll
    for (int j = 0; j < 4; ++j) v[j] = v[j] * rstd * g[j];
}
__device__ __forceinline__ void store_row_bf16(bf16* orow, const f32x4 (&v)[4], int lane) {
    GAS unsigned long long* o8 = (GAS unsigned long long*)orow + lane;
#pragma unroll
    for (int j = 0; j < 4; ++j) o8[64 * j] = (unsigned long long)pk2(v[j].x, v[j].y) | ((unsigned long long)pk2(v[j].z, v[j].w) << 32);
}
__device__ __forceinline__ void load_gain(const float* g, f32x4 (&gv)[4], int lane) {
#pragma unroll
    for (int j = 0; j < 4; ++j) gv[j] = *((const f32x4*)g + lane + 64 * j);
}
__device__ __forceinline__ void rmsnorm_phase(const float* src, const float* gain, bf16* dst, int gw, int ngw, int lane) {
    f32x4 gv[4]; load_gain(gain, gv, lane);
    for (int m = gw; m < TOK; m += ngw) { f32x4 v[4]; rms_row(src + (size_t)m * DM, gv, v, lane); store_row_bf16(dst + (size_t)m * DM, v, lane); }
}
__device__ __forceinline__ float bf2f(unsigned short b) { return __uint_as_float((unsigned)b << 16); }


typedef __attribute__((address_space(4))) const unsigned char* kaptr_t;
__device__ __forceinline__ kaptr_t ka_get() { kaptr_t p = (kaptr_t)__builtin_amdgcn_kernarg_segment_ptr(); asm volatile("" : "+s"(p)); return p; }
#define KA_IN(k) (*(const float* const __attribute__((address_space(4)))*)(ka + 8 * (k)))
#define PH_PTRS kaptr_t ka = ka_get(); unsigned char* const ws = *(unsigned char* const __attribute__((address_space(4)))*)(ka + 168); float* const out = *(float* const __attribute__((address_space(4)))*)(ka + 160); gu32* const ctl = (gu32*)(ws + WS_CTL); (void)out; (void)ctl
#define IN_X KA_IN(0)
#define norm_mix KA_IN(1)
#define norm_ffn KA_IN(2)
#define final_norm KA_IN(3)
#define da_wqkv KA_IN(4)
#define da_wo KA_IN(5)
#define da_lq1 KA_IN(6)
#define da_lk1 KA_IN(7)
#define da_lq2 KA_IN(8)
#define da_lk2 KA_IN(9)
#define da_subln KA_IN(10)
#define mb_wqkv KA_IN(11)
#define mb_wo KA_IN(12)
#define ffn_w1 KA_IN(13)
#define ffn_w3 KA_IN(14)
#define ffn_w2 KA_IN(15)
#define moe_router KA_IN(16)
#define moe_w1 KA_IN(17)
#define moe_w3 KA_IN(18)
#define moe_w2 KA_IN(19)
#define rope64 ((float*)(ws + WS_ROPE64))
#define rope128 ((float*)(ws + WS_ROPE128))
#define kmean ((float*)(ws + WS_KMEAN))
#define tok_e ((int*)(ws + WS_TOK))
#define tok_pos (tok_e + 2 * TOK)
#define tok_gate ((float*)(tok_pos + 2 * TOK))
#define wg_base ((int*)(ws + WS_TOK + 800 * 1024))
#define slot_tok ((int*)(ws + WS_SLOT))
#define slot_gate ((float*)(slot_tok + 2 * SLOTS))
#define ownml ((float*)(ws + WS_OWNML))
#define W0qkv ((bf16*)(ws + WS_W0QKV))
#define W0o ((bf16*)(ws + WS_W0O))
#define W013 ((bf16*)(ws + WS_W013))
#define W02 ((bf16*)(ws + WS_W02))
#define W1qkv ((bf16*)(ws + WS_W1QKV))
#define W1o ((bf16*)(ws + WS_W1O))
#define Rb ((bf16*)(ws + WS_H))
#define OB ((bf16*)out)
#define RSS(j) ((unsigned long long*)(ws + WS_RSS) + (size_t)(j) * TOK)
#define QKV ((bf16*)(ws + WS_QKV))
#define OATT ((bf16*)(ws + WS_OATT))
#define UD ((bf16*)(ws + WS_UD))
#define lists ((int*)(ws + WS_LIST))
#define pml ((float*)(ws + WS_PML))
#define PO ((bf16*)(ws + WS_PO))
#define WM13 ((signed char*)(ws + WS_WM13))
#define WM2 ((signed char*)(ws + WS_WM2))
#define AQ ((signed char*)(ws + WS_AQ))
#define UM ((signed char*)(ws + WS_UM))
#define CMAX13 ((unsigned*)(ws + WS_CMAX13))
#define CMAX2 ((unsigned*)(ws + WS_CMAX2))
#define SSTOT ((unsigned long long*)(ws + WS_SSTOT))
#define SA ((float*)(ws + WS_SA))
#define SA1 ((float*)(ws + WS_SA + 128 * 1024))
#define CM0_13 ((unsigned*)(ws + WS_CM0))
#define CM0_2 ((unsigned*)(ws + WS_CM0 + 32 * 1024))
#define SSTOT0 ((unsigned long long*)(ws + WS_CM0 + 48 * 1024))
#define W013q ((signed char*)(ws + WS_W013))
#define W02q ((signed char*)(ws + WS_W02))
#define A1Q ((signed char*)(ws + WS_QKV))
#define UDQ ((signed char*)(ws + WS_UD))
__global__ void __launch_bounds__(NWAVES * 64, 2) mk_fwd(Args args) {
    extern __shared__ __attribute__((aligned(16))) unsigned char lds[];
    LAS unsigned char* L = (LAS unsigned char*)lds;
    volatile LAS unsigned* MISC = (volatile LAS unsigned*)(L + MISC_OFF);
    const int wave = __builtin_amdgcn_readfirstlane((int)threadIdx.x >> 6);
#define tid ((int)threadIdx.x)
#define lane ((int)(threadIdx.x & 63u))
    const int G = gridDim.x; const int bx = blockIdx.x; const int vcu = (G % 8 == 0) ? (bx % 8) * (G / 8) + bx / 8 : bx;
    const int gw = vcu * NWAVES + wave, NGW = G * NWAVES;
    gu32* ctl0 = (gu32*)(args.ws + WS_CTL);
    for (int u = tid; u < (LDS_BYTES - LDSCTL_OFF) / 4; u += NWAVES * 64) ((LAS unsigned*)(L + LDSCTL_OFF))[u] = 0u;
    __syncthreads();
    XcdBarrier bar; bar.bar = (unsigned*)(ctl0 + CW_BAR); bar.x = 0; bar.st = nullptr;
    if (!MK_PER_PHASE) bar = xcd_barrier_post((unsigned*)(ctl0 + CW_BAR), MISC + 8);
#define GRID_BAR() do { if (!MK_PER_PHASE) xcd_barrier(bar); } while (0)
    const int lo = args.ph_lo, hi_ph = args.ph_hi;
#ifndef PH_MASK
#define PH_MASK 0xFFFFFFFFu
#endif
#define IN(k) (((PH_MASK >> (k)) & 1u) && lo <= (k) && (k) < hi_ph)
#define SEAM(k) do { if (IN((k) + 1)) GRID_BAR(); } while (0)
#ifndef DUP_MASK
#define DUP_MASK 0u
#endif
#define NREP(k) ((((DUP_MASK) >> (k)) & 1u) ? 2 : 1)

    if (IN(0)) { PH_PTRS; for (int rep_ = 0; rep_ < NREP(0); ++rep_) {
        LAS float* scr = (LAS float*)(L + RING_OFF + wave * 16384);
        constexpr int I_QKV = (DM / 64) * (NQKV / 32), I_O = (DM / 64) * (DM / 32);
        constexpr int NITEMS = 2 * I_QKV + 2 * I_O;
        for (int it = gw; it < NITEMS; it += NGW) {
            int r = it;
            if (r < I_QKV) { transpose_item<1>(da_wqkv, DM, NQKV, W0qkv, scr, r, lane, norm_mix); continue; } r -= I_QKV;
            if (r < I_QKV) { transpose_item<2>(mb_wqkv, DM, NQKV, W1qkv, scr, r, lane, norm_mix + DM); continue; } r -= I_QKV;
            if (r < I_O) { transpose_item<0>(da_wo, DM, DM, W0o, scr, r, lane); continue; } r -= I_O;
            transpose_item<0>(mb_wo, DM, DM, W1o, scr, r, lane);
        }
        {
            constexpr int S_1 = (DM / 512) * (FF0 / 32), S_2 = 6 * (DM / 32);
            float ssA = 0.f, ssB = 0.f;
            for (int it = NGW - 1 - gw; it < 2 * S_1 + S_2; it += NGW) {
                int r = it;
                if (r < S_1) { ssA += wmax_strip<3>(ffn_w1, FF0, CM0_13, 8 * (r / (FF0 / 32)), 8, r % (FF0 / 32), lane, norm_ffn); continue; } r -= S_1;
                if (r < S_1) { ssB += wmax_strip<4>(ffn_w3, FF0, CM0_13, 8 * (r / (FF0 / 32)), 8, r % (FF0 / 32), lane, norm_ffn); continue; } r -= S_1;
                { const int st = r / (DM / 32); (void)wmax_strip<0>(ffn_w2, DM, CM0_2, 8 * st, st == 5 ? 4 : 8, r % (DM / 32), lane, nullptr); }
            }
            ssA = wave_sum(ssA); ssB = wave_sum(ssB);
            if (lane == 0 && (ssA != 0.f || ssB != 0.f)) { __hip_atomic_fetch_add(SSTOT0, (unsigned long long)(ssA * 16777216.0f), __ATOMIC_RELAXED, __HIP_MEMORY_SCOPE_AGENT); __hip_atomic_fetch_add(SSTOT0 + 1, (unsigned long long)(ssB * 16777216.0f), __ATOMIC_RELAXED, __HIP_MEMORY_SCOPE_AGENT); }
        }
        {
            const int gt = (vcu * NWAVES + wave) * 64 + lane, NT_ = G * NWAVES * 64;
            for (int e = gt; e < SEQ * 8; e += NT_) { const int pos = e >> 3, i = e & 7; const float ang = (float)pos * (*(const float __attribute__((address_space(4)))*)(ka + 176 + 4 * i)); rope64[e] = cosf(ang); rope64[SEQ * 8 + e] = sinf(ang); }
            for (int e = gt; e < SEQ * 16; e += NT_) { const int pos = e >> 4, i = e & 15; const float ang = (float)pos * (*(const float __attribute__((address_space(4)))*)(ka + 208 + 4 * i)); rope128[e] = cosf(ang); rope128[SEQ * 16 + e] = sinf(ang); }
        }
        for (int m = gw; m < TOK; m += NGW) {
            const GAS f32x4* xr = (const GAS f32x4*)(IN_X + (size_t)m * DM) + lane; f32x4 v[4]; float s = 0.f;
#pragma unroll
            for (int j = 0; j < 4; ++j) { v[j] = xr[64 * j]; s += (v[j].x * v[j].x + v[j].y * v[j].y) + (v[j].z * v[j].z + v[j].w * v[j].w); }
            store_row_bf16(Rb + (size_t)m * DM, v, lane); s = wave_sum(s); if (lane == 0) RSS(0)[m] = (unsigned long long)(s * 16777216.0f); }
        } SEAM(0);
    }
    if (IN(1)) { PH_PTRS; for (int rep_ = 0; rep_ < NREP(1); ++rep_) {
        pg8::ABDense ab{Rb, W0qkv, DM}; pg8::TileOrder S; S.init(TOK / 256, NQKV / 256, G, bx);
        pg8::EpiQKV<64> E{QKV, NQKV, rope64, rope64 + SEQ * 8, 0.125f * LOG2E, RSS(0)};
        pg8::gemm_phase<pg8::EpiQKV<64>, pg8::ABDense, GEMM_ALIGN>(L + RING_OFF, ab, S, E);
        } SEAM(1);
    }
    if (IN(2)) { PH_PTRS; for (int rep_ = 0; rep_ < NREP(2); ++rep_) {
        const moba::DaOrder AS(vcu, G);
        moba::dattn_phase<moba::DaOrder>((char*)lds + RING_OFF, (const moba::bf16*)QKV, (moba::bf16*)OATT, AS);
        } SEAM(2);
    }
    if (IN(3)) { PH_PTRS; for (int rep_ = 0; rep_ < NREP(3); ++rep_) {
        float lam;
        { const float a = wave_sum(da_lq1[lane] * da_lk1[lane]), b = wave_sum(da_lq2[lane] * da_lk2[lane]); lam = expf(a) - expf(b) + LAMBDA_INIT0; }
        const int hh = lane >> 3, dd = (lane & 7) * 16;
        float gsub[16];
#pragma unroll
        for (int k = 0; k < 16; ++k) gsub[k] = da_subln[dd + k] * (1.f - LAMBDA_INIT0);
        for (int m0 = gw; m0 < TOK; m0 += 2 * NGW) {
            v4u A0[2], A1[2], B0[2], B1[2];
#pragma unroll
            for (int u = 0; u < 2; ++u) { const int m = (m0 + u * NGW < TOK) ? m0 + u * NGW : m0;
                const bf16* o1 = OATT + (size_t)m * 2048 + (2 * hh) * 128 + dd; const bf16* o2 = o1 + 128;
                A0[u] = *(const GAS v4u*)o1; A1[u] = *(const GAS v4u*)(o1 + 8); B0[u] = *(const GAS v4u*)o2; B1[u] = *(const GAS v4u*)(o2 + 8); }
#pragma unroll
            for (int u = 0; u < 2; ++u) { const int m = m0 + u * NGW; if (m < TOK) {
                const v4u a0 = A0[u], a1 = A1[u], b0 = B0[u], b1 = B1[u];
                float d[16]; float ss = 0.f;
#pragma unroll
                for (int k = 0; k < 4; ++k) {
                    const unsigned ua = a0[k], ub = b0[k], uc = a1[k], ud = b1[k];
                    d[2 * k] = __uint_as_float(ua << 16) - lam * __uint_as_float(ub << 16); d[2 * k + 1] = __uint_as_float(ua & 0xffff0000u) - lam * __uint_as_float(ub & 0xffff0000u);
                    d[8 + 2 * k] = __uint_as_float(uc << 16) - lam * __uint_as_float(ud << 16); d[8 + 2 * k + 1] = __uint_as_float(uc & 0xffff0000u) - lam * __uint_as_float(ud & 0xffff0000u); }
#pragma unroll
                for (int k = 0; k < 16; ++k) ss += d[k] * d[k];
                ss += __shfl_xor(ss, 1); ss += __shfl_xor(ss, 2); ss += __shfl_xor(ss, 4);
                const float rstd = 1.f / sqrtf(ss * (1.f / 128.f) + SUBLN_EPS);
                v4u w0, w1;
#pragma unroll
                for (int k = 0; k < 4; ++k) { w0[k] = pk2(d[2 * k] * rstd * gsub[2 * k], d[2 * k + 1] * rstd * gsub[2 * k + 1]); w1[k] = pk2(d[8 + 2 * k] * rstd * gsub[8 + 2 * k], d[8 + 2 * k + 1] * rstd * gsub[8 + 2 * k + 1]); }
                bf16* od = OB + (size_t)m * DM + hh * 128 + dd;
                *(GAS v4u*)od = w0; *(GAS v4u*)(od + 8) = w1; } }
        }
        {
            LAS float* scr = (LAS float*)(L + RING_OFF + wave * 16384);
            constexpr int I_13 = (DM / 64) * (FF0 / 32), I_2 = (FF0 / 64) * (DM / 32);
            for (int it = gw; it < 2 * I_13 + I_2; it += NGW) {
                int r = it;
                if (r < I_13) { transpose_item_q<3>(ffn_w1, DM, FF0, W013q, CM0_13, scr, r, lane, norm_ffn); continue; } r -= I_13;
                if (r < I_13) { transpose_item_q<4>(ffn_w3, DM, FF0, W013q, CM0_13, scr, r, lane, norm_ffn); continue; } r -= I_13;
                transpose_item_q<0>(ffn_w2, FF0, DM, W02q, CM0_2, scr, r, lane, nullptr);
            }
        }
        } SEAM(3);
    }
    if (IN(4)) { PH_PTRS; for (int rep_ = 0; rep_ < NREP(4); ++rep_) {
        pg8::ABDense ab{OB, W0o, DM}; pg8::TileOrder S; S.init(TOK / 256, DM / 256, G, bx);
        pg8::EpiResB E{Rb, Rb, DM, nullptr, RSS(1)};
        pg8::gemm_phase<pg8::EpiResB, pg8::ABDense, GEMM_ALIGN>(L + RING_OFF, ab, S, E);
        } SEAM(4);
    }
    if (IN(5)) { PH_PTRS;
        for (int m0 = gw; m0 < TOK; m0 += 4 * NGW) {
            unsigned long long w[4][4];
#pragma unroll
            for (int u = 0; u < 4; ++u) { const int m = (m0 + u * NGW < TOK) ? m0 + u * NGW : m0; const GAS unsigned long long* r8 = (const GAS unsigned long long*)(Rb + (size_t)m * DM) + lane;
#pragma unroll
                for (int j = 0; j < 4; ++j) w[u][j] = r8[64 * j]; }
#pragma unroll
            for (int u = 0; u < 4; ++u) { const int m = m0 + u * NGW; if (m < TOK) {
                f32x4 v[4]; float mx = 0.f;
#pragma unroll
                for (int j = 0; j < 4; ++j) { const unsigned lo32 = (unsigned)w[u][j], hi32 = (unsigned)(w[u][j] >> 32);
                    v[j].x = __uint_as_float(lo32 << 16); v[j].y = __uint_as_float(lo32 & 0xffff0000u); v[j].z = __uint_as_float(hi32 << 16); v[j].w = __uint_as_float(hi32 & 0xffff0000u);
                    mx = fmaxf(fmaxf(mx, fmaxf(fabsf(v[j].x), fabsf(v[j].y))), fmaxf(fabsf(v[j].z), fabsf(v[j].w))); }
#pragma unroll
                for (int o = 1; o < 64; o <<= 1) mx = fmaxf(mx, __shfl_xor(mx, o));
                const float inv = mx > 0.f ? 127.0f / mx : 0.f;
                GAS unsigned* aq = (GAS unsigned*)(A1Q + (size_t)m * DM) + lane;
#pragma unroll
                for (int j = 0; j < 4; ++j) { const int q0 = (int)__builtin_rintf(v[j].x * inv), q1 = (int)__builtin_rintf(v[j].y * inv), q2 = (int)__builtin_rintf(v[j].z * inv), q3 = (int)__builtin_rintf(v[j].w * inv);
                    aq[64 * j] = (unsigned)(q0 & 255) | ((unsigned)(q1 & 255) << 8) | ((unsigned)(q2 & 255) << 16) | ((unsigned)(q3 & 255) << 24); }
                if (lane == 0) SA1[m] = mx * (1.f / sqrtf((float)RSS(1)[m] * (5.9604644775390625e-8f / DM) + NORM_EPS)) * (1.0f / 127.0f); } }
        }
        SEAM(5);
    }
    if (IN(6)) { PH_PTRS; for (int rep_ = 0; rep_ < NREP(6); ++rep_) {
        const float su0 = 8.0f * sqrtf(((float)SSTOT0[0] * (5.9604644775390625e-8f / FF0)) * ((float)SSTOT0[1] * (5.9604644775390625e-8f / FF0)));
        pg8::ABDense ab{(const pg8::bf16_t*)A1Q, (const pg8::bf16_t*)W013q, DM / 2}; pg8::TileOrder S; S.init(TOK / 256, (2 * FF0) / 256, G, bx);
        pg8::EpiSwiGLUQ E{UDQ, FF0, SA1, CM0_13, nullptr, nullptr, 127.0f / su0};
        pg8::gemm_phase<pg8::EpiSwiGLUQ, pg8::ABDense, GEMM_ALIGN>(L + RING_OFF, ab, S, E);
        } SEAM(6);
    }
    if (IN(7)) { PH_PTRS; for (int rep_ = 0; rep_ < NREP(7); ++rep_) {
        const float su0 = 8.0f * sqrtf(((float)SSTOT0[0] * (5.9604644775390625e-8f / FF0)) * ((float)SSTOT0[1] * (5.9604644775390625e-8f / FF0)));
        pg8::ABDense ab{(const pg8::bf16_t*)UDQ, (const pg8::bf16_t*)W02q, FF0 / 2}; pg8::TileOrder S; S.init(TOK / 256, DM / 256, G, bx);
        pg8::EpiResBQ E{Rb, Rb, DM, nullptr, nullptr, CM0_2, nullptr, su0 * (1.0f / 127.0f), RSS(2)};
        pg8::gemm_phase<pg8::EpiResBQ, pg8::ABDense, GEMM_ALIGN>(L + RING_OFF, ab, S, E);
        } SEAM(7);
    }
    if (IN(9)) { PH_PTRS; for (int rep_ = 0; rep_ < NREP(9); ++rep_) {
        pg8::ABDense ab{Rb, W1qkv, DM}; pg8::TileOrder S; S.init(TOK / 256, NQKV / 256, G, bx);
        pg8::EpiQKV<128> E{QKV, NQKV, rope128, rope128 + SEQ * 16, 0.08838834764831845f * LOG2E, RSS(2)};
        pg8::gemm_phase<pg8::EpiQKV<128>, pg8::ABDense, GEMM_ALIGN>(L + RING_OFF, ab, S, E);
        } SEAM(9);
    }
    if (IN(10)) { PH_PTRS; for (int rep_ = 0; rep_ < NREP(10); ++rep_) {
        LAS float* red = (LAS float*)(L + RING_OFF);
        for (int u = vcu; u < BATCH * MB_H * MB_NB; u += G) {
            const int b = u >> 8, h = (u >> 5) & 7, j = u & 31;
            const int dch = tid & 15, kg = tid >> 4;
            const bf16* kp = QKV + (size_t)(b * SEQ + j * MB_L + kg * 8) * NQKV + 1024 + h * 128 + dch * 8;
            float s[8] = {0.f, 0.f, 0.f, 0.f, 0.f, 0.f, 0.f, 0.f};
#pragma unroll
            for (int k = 0; k < 8; ++k) { const v4u v = *(const GAS v4u*)(kp + (size_t)k * NQKV);
#pragma unroll
                for (int q = 0; q < 4; ++q) { s[2 * q] += __uint_as_float(v[q] << 16); s[2 * q + 1] += __uint_as_float(v[q] & 0xffff0000u); } }
#pragma unroll
            for (int q = 0; q < 8; ++q) red[kg * 128 + dch * 8 + q] = s[q];
            __syncthreads();
            if (tid < 128) { float a = 0.f;
#pragma unroll 8
                for (int k = 0; k < 32; ++k) a += red[k * 128 + tid];
                kmean[(size_t)u * 128 + tid] = a * (1.f / 256.f); }
            __syncthreads();
        }
        } SEAM(10);
    }
    if (IN(11)) { PH_PTRS; for (int rep_ = 0; rep_ < NREP(11); ++rep_) {
        LAS float* km = (LAS float*)(L + RING_OFF);
        LAS float* mv = (LAS float*)(L + RING_OFF + 16384);
        LAS int* mi = (LAS int*)(L + RING_OFF + 16384 + 3072);
        LAS int* lcnt = (LAS int*)(L + RING_OFF + 24576);
        for (int u = vcu; u < BATCH * MB_H * (MB_NB - 1); u += G) {
            const int bh = u / 31, o = 1 + u % 31, b = bh >> 3, h = bh & 7;
            for (int e = tid; e < 32 * 128; e += 512) km[e] = kmean[(size_t)bh * 4096 + e];
            if (tid < 32) lcnt[tid] = 0;
            __syncthreads();
            const int ql = tid & 255, half = tid >> 8; const int s = o * 256 + ql;
            const bf16* qp = QKV + (size_t)(b * SEQ + s) * NQKV + h * 128;
            float qf[128];
#pragma unroll
            for (int c = 0; c < 16; ++c) { const v4u v = *(const GAS v4u*)(qp + c * 8);
#pragma unroll
                for (int q = 0; q < 4; ++q) { qf[c * 8 + 2 * q] = __uint_as_float(v[q] << 16); qf[c * 8 + 2 * q + 1] = __uint_as_float(v[q] & 0xffff0000u); } }
            float v0 = -INFINITY, v1 = -INFINITY, v2 = -INFINITY; int i0 = -1, i1 = -1, i2 = -1;
            for (int jj = 0; jj < 16; ++jj) { const int j = half * 16 + jj;
                if (j < o) { float g = 0.f; const LAS f32x4* kr = (const LAS f32x4*)(km + j * 128);
#pragma unroll
                    for (int c = 0; c < 32; ++c) { const f32x4 kv = kr[c]; g += qf[4 * c] * kv.x + qf[4 * c + 1] * kv.y + qf[4 * c + 2] * kv.z + qf[4 * c + 3] * kv.w; }
                    if (g > v0) { v2 = v1; i2 = i1; v1 = v0; i1 = i0; v0 = g; i0 = j; } else if (g > v1) { v2 = v1; i2 = i1; v1 = g; i1 = j; } else if (g > v2) { v2 = g; i2 = j; } } }
            if (half == 1) { mv[ql * 3] = v0; mv[ql * 3 + 1] = v1; mv[ql * 3 + 2] = v2; mi[ql * 3] = i0; mi[ql * 3 + 1] = i1; mi[ql * 3 + 2] = i2; }
            __syncthreads();
            int lp0 = 0, lp1 = 0, lp2 = 0;
            if (half == 0) {
#pragma unroll
                for (int k = 0; k < 3; ++k) { const float g = mv[ql * 3 + k]; const int j = mi[ql * 3 + k];
                    if (j >= 0) { if (g > v0) { v2 = v1; i2 = i1; v1 = v0; i1 = i0; v0 = g; i0 = j; } else if (g > v1) { v2 = v1; i2 = i1; v1 = g; i1 = j; } else if (g > v2) { v2 = g; i2 = j; } } }
                if (i0 >= 0) lp0 = __hip_atomic_fetch_add(&lcnt[i0], 1, __ATOMIC_RELAXED, __HIP_MEMORY_SCOPE_WORKGROUP);
                if (i1 >= 0) lp1 = __hip_atomic_fetch_add(&lcnt[i1], 1, __ATOMIC_RELAXED, __HIP_MEMORY_SCOPE_WORKGROUP);
                if (i2 >= 0) lp2 = __hip_atomic_fetch_add(&lcnt[i2], 1, __ATOMIC_RELAXED, __HIP_MEMORY_SCOPE_WORKGROUP);
            }
            __syncthreads();
            if (tid < 32 && rep_ == 0) { const int n = lcnt[tid]; lcnt[32 + tid] = n ? (int)__hip_atomic_fetch_add(ctl + CW_MOBACNT + bh * 32 + tid, (unsigned)n, RLX_AGENT) : 0; }
            __syncthreads();
            if (half == 0 && rep_ == 0) { int* lb = lists + (size_t)bh * LIST_PER_BH;
                if (i0 >= 0) lb[list_off(i0) + lcnt[32 + i0] + lp0] = s;
                if (i1 >= 0) lb[list_off(i1) + lcnt[32 + i1] + lp1] = s | (1 << 16);
                if (i2 >= 0) lb[list_off(i2) + lcnt[32 + i2] + lp2] = s | (2 << 16); }
            __syncthreads();
        }
        } SEAM(11);
    }
    if (IN(12)) { PH_PTRS; for (int rep_ = 0; rep_ < NREP(12); ++rep_) {
        LAS int* pre = (LAS int*)(L + 102400);
        { const unsigned c0 = __hip_atomic_load(ctl + CW_MOBACNT + tid, RLX_AGENT), c1 = __hip_atomic_load(ctl + CW_MOBACNT + 512 + tid, RLX_AGENT);
          pre[tid] = (int)((c0 + 255u) >> 8); pre[512 + tid] = (int)((c1 + 255u) >> 8); }
        __syncthreads();
        if (tid == 0) { int a = 0; for (int k = 0; k < 1024; ++k) { const int n = pre[k]; pre[k] = a; a += n; } pre[1024] = a; }
        __syncthreads();
        const int nlist = pre[1024], ntot = 1024 + nlist;
        const int wl = wave * 32 + (lane & 31);
        for (int u = vcu; u < ntot; u += G) {
            const bool own = u < 1024;
            int b, h, kb, s, dst, mli, ostride; moba::bf16* obase; float* mlp;
            if (own) {
                b = u >> 8; h = (u >> 5) & 7; kb = u & 31; s = kb * 256 + wl; dst = b * SEQ + s; mli = (b * 8 + h) * SEQ + s; ostride = DM; obase = (moba::bf16*)OB + h * 128; mlp = ownml;
            } else {
                const int lu = u - 1024; int loI = 0, hiI = 1024;
                while (hiI - loI > 1) { const int mid = (loI + hiI) >> 1; if (pre[mid] <= lu) loI = mid; else hiI = mid; }
                const int bhj = loI, chunk = lu - pre[bhj], bh = bhj >> 5; kb = bhj & 31; b = bh >> 3; h = bh & 7;
                const int cnt = (int)__hip_atomic_load(ctl + CW_MOBACNT + bhj, RLX_AGENT);
                const int ei = chunk * 256 + wl; const bool valid = ei < cnt;
                const int ent = valid ? lists[(size_t)bh * LIST_PER_BH + list_off(kb) + ei] : 0;
                s = ent & 0xffff; mli = (bh * SEQ + s) * 3 + (ent >> 16); dst = valid ? mli : -1; ostride = 128; obase = (moba::bf16*)PO; mlp = pml;
            }
            const moba::bf16* qrow = (const moba::bf16*)QKV + ((size_t)b * SEQ + s) * NQKV + h * 128;
            const moba::bf16* Kh = (const moba::bf16*)QKV + ((size_t)b * SEQ + kb * 256) * NQKV + 1024 + h * 128;
            moba::moba_unit(own, qrow, Kh, Kh + 1024, obase, ostride, dst, mlp, mli, wl, (char*)lds);
        }
        } SEAM(12);
    }
    if (IN(13)) { PH_PTRS; for (int rep_ = 0; rep_ < NREP(13); ++rep_) {
        const int hh = lane >> 3, dd = (lane & 7) * 16;
        for (int m = gw; m < TOK; m += NGW) {
            const int b = m >> 13, s = m & 8191, nv = (s >> 8) < 3 ? (s >> 8) : 3; const int qi = (b * 8 + hh) * SEQ + s;
            float mm[4], ll[4]; mm[0] = ownml[2 * (size_t)qi]; ll[0] = ownml[2 * (size_t)qi + 1]; float M = mm[0];
#pragma unroll
            for (int r = 0; r < 3; ++r) { if (r < nv) { mm[1 + r] = pml[2 * ((size_t)qi * 3 + r)]; ll[1 + r] = pml[2 * ((size_t)qi * 3 + r) + 1]; M = fmaxf(M, mm[1 + r]); } else { mm[1 + r] = -1e30f; ll[1 + r] = 0.f; } }
            float w[4], wsum = 0.f;
#pragma unroll
            for (int r = 0; r < 4; ++r) { w[r] = ll[r] * __builtin_amdgcn_exp2f(mm[r] - M); wsum += w[r]; }
            const float inv = 1.f / wsum;
            float acc16[16];
            bf16* op = OB + (size_t)m * DM + hh * 128 + dd;
            { const v4u a0 = *(const GAS v4u*)op, a1 = *(const GAS v4u*)(op + 8); const float ww = w[0] * inv;
#pragma unroll
              for (int k = 0; k < 4; ++k) { acc16[2 * k] = ww * __uint_as_float(a0[k] << 16); acc16[2 * k + 1] = ww * __uint_as_float(a0[k] & 0xffff0000u); acc16[8 + 2 * k] = ww * __uint_as_float(a1[k] << 16); acc16[8 + 2 * k + 1] = ww * __uint_as_float(a1[k] & 0xffff0000u); } }
#pragma unroll
            for (int r = 0; r < 3; ++r) if (r < nv) { const bf16* pp = PO + ((size_t)qi * 3 + r) * 128 + dd; const v4u a0 = *(const GAS v4u*)pp, a1 = *(const GAS v4u*)(pp + 8); const float ww = w[1 + r] * inv;
#pragma unroll
                for (int k = 0; k < 4; ++k) { acc16[2 * k] += ww * __uint_as_float(a0[k] << 16); acc16[2 * k + 1] += ww * __uint_as_float(a0[k] & 0xffff0000u); acc16[8 + 2 * k] += ww * __uint_as_float(a1[k] << 16); acc16[8 + 2 * k + 1] += ww * __uint_as_float(a1[k] & 0xffff0000u); } }
            v4u w0, w1;
#pragma unroll
            for (int k = 0; k < 4; ++k) { w0[k] = pk2(acc16[2 * k], acc16[2 * k + 1]); w1[k] = pk2(acc16[8 + 2 * k], acc16[8 + 2 * k + 1]); }
            *(GAS v4u*)op = w0; *(GAS v4u*)(op + 8) = w1;
        }
        } SEAM(13);
    }
    if (IN(14)) { PH_PTRS; for (int rep_ = 0; rep_ < NREP(14); ++rep_) {
        pg8::ABDense ab{OB, W1o, DM}; pg8::TileOrder S; S.init(TOK / 256, DM / 256, G, bx);
        pg8::EpiResB E{Rb, Rb, DM, nullptr, RSS(3)};
        pg8::gemm_phase<pg8::EpiResB, pg8::ABDense, GEMM_ALIGN>(L + RING_OFF, ab, S, E);
        } SEAM(14);
    }
    if (IN(15)) { PH_PTRS; for (int rep_ = 0; rep_ < NREP(15); ++rep_) {
        {
            const int gt = (vcu * NWAVES + wave) * 64 + lane, NT_ = G * NWAVES * 64;
            for (int e = gt; e < 2 * SLOTS; e += NT_) { slot_tok[e] = -1; slot_gate[e] = 0.f; }
        }
        if (rep_ == 0) {
            f32x4 gv[4]; load_gain(norm_ffn + DM, gv, lane);
            float wr_[16][8];
#pragma unroll
            for (int j = 0; j < 4; ++j)
#pragma unroll
                for (int q = 0; q < 4; ++q) { const int k = 4 * lane + 256 * j + q; const f32x4 a = *(const GAS f32x4*)(moe_router + (size_t)k * 8) * gv[j][q], c = *(const GAS f32x4*)(moe_router + (size_t)k * 8 + 4) * gv[j][q];
                    wr_[4 * j + q][0] = a.x; wr_[4 * j + q][1] = a.y; wr_[4 * j + q][2] = a.z; wr_[4 * j + q][3] = a.w; wr_[4 * j + q][4] = c.x; wr_[4 * j + q][5] = c.y; wr_[4 * j + q][6] = c.z; wr_[4 * j + q][7] = c.w; }
            for (int m = gw; m < TOK; m += NGW) {
                f32x4 v[4];
                { const GAS unsigned long long* r8 = (const GAS unsigned long long*)(Rb + (size_t)m * DM) + lane;
#pragma unroll
                  for (int j = 0; j < 4; ++j) { const unsigned long long w = r8[64 * j]; const unsigned lo32 = (unsigned)w, hi32 = (unsigned)(w >> 32);
                      v[j].x = __uint_as_float(lo32 << 16); v[j].y = __uint_as_float(lo32 & 0xffff0000u); v[j].z = __uint_as_float(hi32 << 16); v[j].w = __uint_as_float(hi32 & 0xffff0000u); } }
                float lg[8];
#pragma unroll
                for (int e = 0; e < 8; ++e) { float a = 0.f;
#pragma unroll
                    for (int j = 0; j < 4; ++j) a += v[j].x * wr_[4 * j][e] + v[j].y * wr_[4 * j + 1][e] + v[j].z * wr_[4 * j + 2][e] + v[j].w * wr_[4 * j + 3][e];
                    lg[e] = wave_sum(a); }
                const float rs = 1.f / sqrtf((float)RSS(3)[m] * (5.9604644775390625e-8f / DM) + NORM_EPS);
#pragma unroll
                for (int e = 0; e < 8; ++e) lg[e] *= rs;
                {
                    float mx = 0.f;
#pragma unroll
                    for (int j = 0; j < 4; ++j) mx = fmaxf(fmaxf(mx, fmaxf(fabsf(v[j].x), fabsf(v[j].y))), fmaxf(fabsf(v[j].z), fabsf(v[j].w)));
#pragma unroll
                    for (int o = 1; o < 64; o <<= 1) mx = fmaxf(mx, __shfl_xor(mx, o));
                    const float inv = mx > 0.f ? 127.0f / mx : 0.f;
                    GAS unsigned* aq = (GAS unsigned*)(AQ + (size_t)m * DM) + lane;
#pragma unroll
                    for (int j = 0; j < 4; ++j) { const int q0 = (int)__builtin_rintf(v[j].x * inv), q1 = (int)__builtin_rintf(v[j].y * inv), q2 = (int)__builtin_rintf(v[j].z * inv), q3 = (int)__builtin_rintf(v[j].w * inv);
                        aq[64 * j] = (unsigned)(q0 & 255) | ((unsigned)(q1 & 255) << 8) | ((unsigned)(q2 & 255) << 16) | ((unsigned)(q3 & 255) << 24); }
                    if (lane == 0) SA[m] = mx * rs * (1.0f / 127.0f);
                }
                int e0 = 0; float l0 = lg[0];
#pragma unroll
                for (int e = 1; e < 8; ++e) if (lg[e] > l0) { l0 = lg[e]; e0 = e; }
                int e1 = -1; float l1 = -INFINITY;
#pragma unroll
                for (int e = 0; e < 8; ++e) if (e != e0 && lg[e] > l1) { l1 = lg[e]; e1 = e; }
                if (lane == 0) {
                    const float g0 = 1.f / (1.f + expf(l1 - l0)), g1 = 1.f - g0;
                    const int p0 = (int)__hip_atomic_fetch_add((LAS unsigned*)(L + MISC_OFF) + 40 + e0, 1u, __ATOMIC_RELAXED, __HIP_MEMORY_SCOPE_WORKGROUP), p1 = (int)__hip_atomic_fetch_add((LAS unsigned*)(L + MISC_OFF) + 48 + e1, 1u, __ATOMIC_RELAXED, __HIP_MEMORY_SCOPE_WORKGROUP);
                    tok_e[m] = e0; tok_e[TOK + m] = e1; tok_pos[m] = p0; tok_pos[TOK + m] = p1; tok_gate[m] = g0; tok_gate[TOK + m] = g1;
                }
            }
            LDS_WAIT(); __syncthreads();
            if (tid < 16) { const unsigned n = MISC[40 + tid]; wg_base[vcu * 16 + tid] = n ? (int)__hip_atomic_fetch_add(ctl + CW_MOECNT + tid, n, RLX_AGENT) : 0; }
        }
        {
            constexpr int S_1 = (DM / 512) * (FF1 / 32), S_2 = (FF1 / 512) * (DM / 32), PER_E = 2 * S_1 + S_2;
            float ssA = 0.f, ssB = 0.f;
            for (int it = gw; it < NEXP * PER_E; it += NGW) {
                const int e = it / PER_E; int r = it % PER_E;
                if (r < S_1) { ssA += wmax_strip<3>(moe_w1 + (size_t)e * DM * FF1, FF1, CMAX13 + e * 2 * FF1, 8 * (r / (FF1 / 32)), 8, r % (FF1 / 32), lane, norm_ffn + DM); continue; } r -= S_1;
                if (r < S_1) { ssB += wmax_strip<4>(moe_w3 + (size_t)e * DM * FF1, FF1, CMAX13 + e * 2 * FF1, 8 * (r / (FF1 / 32)), 8, r % (FF1 / 32), lane, norm_ffn + DM); continue; } r -= S_1;
                (void)wmax_strip<0>(moe_w2 + (size_t)e * FF1 * DM, DM, CMAX2 + e * DM, 8 * (r / (DM / 32)), 8, r % (DM / 32), lane, nullptr);
            }
            ssA = wave_sum(ssA); ssB = wave_sum(ssB);
            if (lane == 0) { __hip_atomic_fetch_add(SSTOT, (unsigned long long)(ssA * 16777216.0f), __ATOMIC_RELAXED, __HIP_MEMORY_SCOPE_AGENT); __hip_atomic_fetch_add(SSTOT + 1, (unsigned long long)(ssB * 16777216.0f), __ATOMIC_RELAXED, __HIP_MEMORY_SCOPE_AGENT); }
        }
        } SEAM(15);
    }
#define MOE_CUM() do { if (tid < 2) { int a = 0; for (int e = 0; e < 8; ++e) { MISC[16 + 9 * tid + e] = (unsigned)a; a += (int)((__hip_atomic_load(ctl + CW_MOECNT + 8 * tid + e, RLX_AGENT) + 255u) >> 8); } MISC[16 + 9 * tid + 8] = (unsigned)a; } __syncthreads(); } while (0)
    if (IN(16)) { PH_PTRS; for (int rep_ = 0; rep_ < NREP(16); ++rep_) {
        MOE_CUM();
        const int gt = (vcu * NWAVES + wave) * 64 + lane, NT_ = G * NWAVES * 64;
        for (int e = gt; e < 2 * TOK; e += NT_) { const int r = e >= TOK ? 1 : 0; const int ex = tok_e[e]; const int t_ = e - r * TOK; const int slot = (int)MISC[16 + 9 * r + ex] * 256 + wg_base[((t_ % NGW) >> 3) * 16 + r * 8 + ex] + tok_pos[e];
            slot_tok[r * SLOTS + slot] = e - r * TOK; slot_gate[r * SLOTS + slot] = tok_gate[e]; }
        {
            LAS float* scr = (LAS float*)(L + RING_OFF + wave * 16384);
            constexpr int I_1 = (DM / 64) * (FF1 / 32), I_2 = (FF1 / 64) * (DM / 32), PER_E = 2 * I_1 + I_2;
            for (int it = gw; it < NEXP * PER_E; it += NGW) {
                const int e = it / PER_E; int r = it % PER_E;
                if (r < I_1) { transpose_item_q<3>(moe_w1 + (size_t)e * DM * FF1, DM, FF1, WM13 + (size_t)e * 2 * FF1 * DM, CMAX13 + e * 2 * FF1, scr, r, lane, norm_ffn + DM); continue; } r -= I_1;
                if (r < I_1) { transpose_item_q<4>(moe_w3 + (size_t)e * DM * FF1, DM, FF1, WM13 + (size_t)e * 2 * FF1 * DM, CMAX13 + e * 2 * FF1, scr, r, lane, norm_ffn + DM); continue; } r -= I_1;
                transpose_item_q<0>(moe_w2 + (size_t)e * FF1 * DM, FF1, DM, WM2 + (size_t)e * DM * FF1, CMAX2 + e * DM, scr, r, lane, nullptr);
            }
        }
        } SEAM(16);
    }
#define MOE_SU() (8.0f * sqrtf(((float)SSTOT[0] * (5.9604644775390625e-8f / (NEXP * FF1))) * ((float)SSTOT[1] * (5.9604644775390625e-8f / (NEXP * FF1)))))
#define MOE_UP(r) do { MOE_CUM(); \
        pg8::ABMoeUp ab{(const pg8::bf16_t*)AQ, (const pg8::bf16_t*)WM13, DM / 2, slot_tok + (r) * SLOTS, (const LAS int*)(L + MISC_OFF + 4 * (16 + 9 * (r))), (size_t)2 * FF1 * (DM / 2)}; \
        pg8::TileOrder S; S.init((int)MISC[16 + 9 * (r) + 8], (2 * FF1) / 256, G, bx); \
        pg8::EpiSwiGLUQ E{UM, FF1, SA, CMAX13, slot_tok + (r) * SLOTS, (const LAS int*)(L + MISC_OFF + 4 * (16 + 9 * (r))), 127.0f / MOE_SU()}; \
        pg8::gemm_phase<pg8::EpiSwiGLUQ, pg8::ABMoeUp, GEMM_ALIGN>(L + RING_OFF, ab, S, E); } while (0)
#define MOE_DOWN(r) do { MOE_CUM(); \
        pg8::ABMoeDown ab{(const pg8::bf16_t*)UM, (const pg8::bf16_t*)WM2, FF1 / 2, (const LAS int*)(L + MISC_OFF + 4 * (16 + 9 * (r))), (size_t)DM * (FF1 / 2)}; \
        pg8::TileOrder S; S.init((int)MISC[16 + 9 * (r) + 8], DM / 256, G, bx); \
        pg8::EpiResBQ E{(r) == 0 ? Rb : OB, (r) == 0 ? OB : Rb, DM, slot_tok + (r) * SLOTS, slot_gate + (r) * SLOTS, CMAX2, (const LAS int*)(L + MISC_OFF + 4 * (16 + 9 * (r))), MOE_SU() * (1.0f / 127.0f), nullptr}; \
        pg8::gemm_phase<pg8::EpiResBQ, pg8::ABMoeDown, GEMM_ALIGN>(L + RING_OFF, ab, S, E); } while (0)
    if (IN(17)) { PH_PTRS; for (int rep_ = 0; rep_ < NREP(17); ++rep_) MOE_UP(0); SEAM(17); }
    if (IN(18)) { PH_PTRS; MOE_DOWN(0); SEAM(18); }
    if (IN(19)) { PH_PTRS; for (int rep_ = 0; rep_ < NREP(19); ++rep_) MOE_UP(1); SEAM(19); }
    if (IN(20)) { PH_PTRS; MOE_DOWN(1); SEAM(20); }
    if (IN(21)) { PH_PTRS;
        f32x4 gv[4]; load_gain(final_norm, gv, lane);
        for (int m0 = gw; m0 < TOK; m0 += 4 * NGW) {
            unsigned long long w[4][4];
#pragma unroll
            for (int u = 0; u < 4; ++u) { const int m = (m0 + u * NGW < TOK) ? m0 + u * NGW : m0; const GAS unsigned long long* r8 = (const GAS unsigned long long*)(Rb + (size_t)m * DM) + lane;
#pragma unroll
                for (int j = 0; j < 4; ++j) w[u][j] = r8[64 * j]; }
#pragma unroll
            for (int u = 0; u < 4; ++u) { const int m = m0 + u * NGW; if (m < TOK) {
                f32x4 v[4]; float s = 0.f;
#pragma unroll
                for (int j = 0; j < 4; ++j) { const unsigned lo32 = (unsigned)w[u][j], hi32 = (unsigned)(w[u][j] >> 32);
                    v[j].x = __uint_as_float(lo32 << 16); v[j].y = __uint_as_float(lo32 & 0xffff0000u); v[j].z = __uint_as_float(hi32 << 16); v[j].w = __uint_as_float(hi32 & 0xffff0000u);
                    s += (v[j].x * v[j].x + v[j].y * v[j].y) + (v[j].z * v[j].z + v[j].w * v[j].w); }
                const float rstd = 1.f / sqrtf(wave_sum(s) * (1.f / DM) + NORM_EPS);
                GAS f32x4* o = (GAS f32x4*)(out + (size_t)m * DM) + lane;
#pragma unroll
                for (int j = 0; j < 4; ++j) o[64 * j] = v[j] * rstd * gv[j]; } }
        }
    }
#undef IN
#undef SEAM
#undef GRID_BAR
#undef tid
#undef lane
}
constexpr int N_PHASES = 22;

extern "C" void kernel_launch(void* const* d_in, const int* in_sizes, int n_in, void* d_out, int out_size, void* d_ws, size_t ws_size, hipStream_t stream) {
    static int grid = 0;
    if (grid == 0) {
        if (n_in != 20 || in_sizes[0] != TOK * DM || out_size != TOK * DM || ws_size < WS_END) { fprintf(stderr, "kernel_launch: shape / workspace mismatch (n_in %d, in0 %d, out %d, ws %zu, need %zu); nothing launched\n", n_in, n_in > 0 ? in_sizes[0] : -1, out_size, ws_size, (size_t)WS_END); grid = -1; return; }
        int dev = 0, cus = 0, per_cu = 0;
        if (hipGetDevice(&dev) != hipSuccess || hipDeviceGetAttribute(&cus, hipDeviceAttributeMultiprocessorCount, dev) != hipSuccess) { grid = -1; return; }
        if (hipFuncSetAttribute((const void*)mk_fwd, hipFuncAttributeMaxDynamicSharedMemorySize, LDS_BYTES) != hipSuccess) { fprintf(stderr, "kernel_launch: hipFuncSetAttribute failed\n"); grid = -1; return; }
        if (hipOccupancyMaxActiveBlocksPerMultiprocessor(&per_cu, (const void*)mk_fwd, NWAVES * 64, LDS_BYTES) != hipSuccess || per_cu < 1) fprintf(stderr, "kernel_launch: occupancy query reports %d workgroups per CU\n", per_cu);
        (void)hipGetLastError();
        grid = cus;
    }
    if (grid < 0) return;
    if (hipMemsetAsync((char*)d_ws + WS_CTL, 0, CTL_ZERO_BYTES, stream) != hipSuccess) return;
    Args a{};
    for (int i = 0; i < 20; ++i) a.in[i] = (const float*)d_in[i];
    a.out = (float*)d_out; a.ws = (unsigned char*)d_ws;
    for (int i = 0; i < 8; ++i) a.inv64[i] = (float)pow(500000.0, -(double)(2 * i) / 16.0);
    for (int i = 0; i < 16; ++i) a.inv128[i] = (float)pow(500000.0, -(double)(2 * i) / 32.0);
#if MK_PER_PHASE
    for (int p = 0; p < N_PHASES; ++p) { a.ph_lo = p; a.ph_hi = p + 1; hipLaunchKernelGGL(mk_fwd, dim3(grid), dim3(NWAVES * 64), LDS_BYTES, stream, a); }
#else
    a.ph_lo = 0; a.ph_hi = N_PHASES;
    hipLaunchKernelGGL(mk_fwd, dim3(grid), dim3(NWAVES * 64), LDS_BYTES, stream, a);
#ifdef PROBE_LIST
    {
        static const int probe[] = {PROBE_LIST};
        for (int k : probe) { a.ph_lo = k; a.ph_hi = k + 1;
            a.out = (k == 3 || k == 12 || k == 13 || k == 18 || k == 21) ? (float*)((char*)d_ws + WS_QKV) : (float*)d_out;
            hipLaunchKernelGGL(mk_fwd, dim3(grid), dim3(NWAVES * 64), LDS_BYTES, stream, a); }
    }
#endif
#endif
    const hipError_t le = hipPeekAtLastError();
    if (le != hipSuccess) fprintf(stderr, "kernel_launch: launch failed: %s\n", hipGetErrorName(le));
}
```

```cpp
#include <hip/hip_runtime.h>
#include <hip/hip_bf16.h>
#include <cstdio>
#include <cstdint>
#include <cmath>
namespace pg8 {
#define PG8_LAS __attribute__((address_space(3)))
typedef unsigned short bf16_t;
typedef short bf16x8 __attribute__((ext_vector_type(8)));
typedef float f32x4 __attribute__((ext_vector_type(4)));
typedef unsigned u32x4 __attribute__((ext_vector_type(4)));
constexpr int BM = 256, BK = 64, HALF = 128, HTB = HALF * BK * 2  , STAGE_BYTES = 8 * HTB, NXCD = 8, WGM = 8;

__host__ __device__ __forceinline__ int lds_byte(int r, int c) { const int st = (r >> 4) * 2 + (c >> 5), rr = r & 15, cc = c & 31, ob = rr * 64 + cc * 2; return st * 1024 + (ob ^ (((ob >> 9) & 1) << 5)); }
__host__ __device__ __forceinline__ void stage_rc(int b, int& R, int& C) { const int st = b / 1024, sb = b % 1024, swz = sb ^ (((sb >> 9) & 1) << 5); R = (st >> 1) * 16 + swz / 64; C = (st & 1) * 32 + (swz % 64) / 2; }
__host__ __device__ __forceinline__ int perm32(int rho) { const int n = rho >> 4, i = rho & 15; return 8 * (i >> 2) + 4 * n + (i & 3); }

struct Unit { int pm, pn; };

struct TileOrder {
    int nM, nN, nwg, G, c;
    __device__ __forceinline__ void init(int nM_, int nN_, int G_, int c_) { nM = nM_; nN = nN_; nwg = nM * nN; G = G_; c = c_; }
    __device__ __forceinline__ bool next(int i, Unit& u) const {
        const long L = (long)i * G + c; if (L >= nwg) return false;
        int wgid = (int)L; { const int q = nwg / NXCD, r = nwg % NXCD, xcd = wgid % NXCD, off = wgid / NXCD; wgid = (xcd < r ? xcd * (q + 1) : r * (q + 1) + (xcd - r) * q) + off; }
        const int nig = WGM * nN, gid = wgid / nig, fm = gid * WGM, gsz = (nM - fm) < WGM ? (nM - fm) : WGM;
        u.pm = fm + ((wgid % nig) % gsz); u.pn = (wgid % nig) / gsz; return true;
    }
};

struct ABDense {
    static constexpr bool GATHER = false;
    const bf16_t* A; const bf16_t* Bt; int K;
    __device__ __forceinline__ const char* abase(const Unit& u) const { return (const char*)A + (size_t)u.pm * BM * K * 2; }
    __device__ __forceinline__ const char* bbase(const Unit& u) const { return (const char*)Bt + (size_t)u.pn * BM * K * 2; }
    __device__ __forceinline__ const int* tokp(const Unit&) const { return nullptr; }
};
struct ABMoeUp {
    static constexpr bool GATHER = true;
    const bf16_t* A; const bf16_t* Bt; int K; const int* slot_tok; const PG8_LAS int* cum; size_t estride;
    __device__ __forceinline__ int expert(int pm) const { int e = 0;
#pragma unroll
        for (int k = 1; k < 8; ++k) e += (pm >= cum[k]) ? 1 : 0; return e; }
    __device__ __forceinline__ const char* abase(const Unit&) const { return (const char*)A; }
    __device__ __forceinline__ const char* bbase(const Unit& u) const { return (const char*)(Bt + (size_t)expert(u.pm) * estride) + (size_t)u.pn * BM * K * 2; }
    __device__ __forceinline__ const int* tokp(const Unit& u) const { return slot_tok + u.pm * BM; }
};
struct ABMoeDown {
    static constexpr bool GATHER = false;
    const bf16_t* A; const bf16_t* Bt; int K; const PG8_LAS int* cum; size_t estride;
    __device__ __forceinline__ int expert(int pm) const { int e = 0;
#pragma unroll
        for (int k = 1; k < 8; ++k) e += (pm >= cum[k]) ? 1 : 0; return e; }
    __device__ __forceinline__ const char* abase(const Unit& u) const { return (const char*)A + (size_t)u.pm * BM * K * 2; }
    __device__ __forceinline__ const char* bbase(const Unit& u) const { return (const char*)(Bt + (size_t)expert(u.pm) * estride) + (size_t)u.pn * BM * K * 2; }
    __device__ __forceinline__ const int* tokp(const Unit&) const { return nullptr; }
};

__device__ __forceinline__ unsigned cvt_pk_bf16(float lo, float hi) { unsigned r; asm volatile("v_cvt_pk_bf16_f32 %0, %1, %2" : "=v"(r) : "v"(lo), "v"(hi)); return r; }

template <int DH> struct EpiQKV {
    static constexpr bool PERM = true; typedef f32x4 acc_t;
    bf16_t* O; int ldc; const float* ct; const float* st; float qscale; const unsigned long long* rss;
    __device__ __forceinline__ void operator()(const f32x4 (&acc)[2][2][4][2], const Unit& u, int wr, int wc, int fr, int fq) const {
        constexpr int NF = DH / 8;
        const int row0 = u.pm * BM + wr * 64 + fr, col0 = u.pn * BM + wc * 32 + 8 * fq;
        const int sect = u.pn >> 2;
        const float sc = (sect == 0) ? qscale : 1.f;
        const bool rot = (sect < 2) && (DH == 64 ? (((wc & 1) == 0) && (fq < 2)) : (wc == 0));
#pragma unroll
        for (int ai = 0; ai < 2; ++ai)
#pragma unroll
            for (int m = 0; m < 4; ++m) {
                const int row = row0 + ai * HALF + m * 16; const int pos = row & 8191; const float rs = sc * __builtin_amdgcn_rsqf((float)rss[row] * (5.9604644775390625e-8f / 1024.0f) + 1e-6f);
                f32x4 c4 = (f32x4){1.f, 1.f, 1.f, 1.f}, s4 = (f32x4){0.f, 0.f, 0.f, 0.f};
                if (rot) { c4 = *(const f32x4*)(ct + pos * NF + 4 * fq); s4 = *(const f32x4*)(st + pos * NF + 4 * fq); }
                bf16_t* rowp = O + (size_t)row * ldc + col0;
#pragma unroll
                for (int bj = 0; bj < 2; ++bj) {
                    const f32x4 x1 = acc[ai][bj][m][0], x2 = acc[ai][bj][m][1];
                    f32x4 v0 = (x1 * c4 - x2 * s4) * rs, v1 = (x2 * c4 + x1 * s4) * rs;
                    u32x4 w; w.x = cvt_pk_bf16(v0[0], v0[1]); w.y = cvt_pk_bf16(v0[2], v0[3]); w.z = cvt_pk_bf16(v1[0], v1[1]); w.w = cvt_pk_bf16(v1[2], v1[3]);
                    *(u32x4*)(rowp + bj * HALF) = w; }
            }
    }
};

__device__ __forceinline__ float silu_mul(float a, float b) { return a * b * __builtin_amdgcn_rcpf(1.0f + __builtin_amdgcn_exp2f(-1.4426950408889634f * a)); }
struct EpiSwiGLU {
    static constexpr bool PERM = true; typedef f32x4 acc_t;
    bf16_t* O; int ldc; const float* gate; const unsigned long long* rss; const int* rowmap;
    __device__ __forceinline__ void operator()(const f32x4 (&acc)[2][2][4][2], const Unit& u, int wr, int wc, int fr, int fq) const {
        const int row0 = u.pm * BM + wr * 64 + fr, col0 = u.pn * HALF + wc * 32 + 8 * fq;
#pragma unroll
        for (int ai = 0; ai < 2; ++ai)
#pragma unroll
            for (int m = 0; m < 4; ++m) {
                const int row = row0 + ai * HALF + m * 16; const float g = gate ? gate[row] : 1.f; const int trow = rowmap ? rowmap[row] : row;
                const float rs = trow >= 0 ? __builtin_amdgcn_rsqf((float)rss[trow] * (5.9604644775390625e-8f / 1024.0f) + 1e-6f) : 0.f;
                const f32x4 a0 = acc[ai][0][m][0] * rs, a1 = acc[ai][0][m][1] * rs, b0 = acc[ai][1][m][0] * rs, b1 = acc[ai][1][m][1] * rs;
                float v[8];
#pragma unroll
                for (int k = 0; k < 4; ++k) { v[k] = g * silu_mul(a0[k], b0[k]); v[4 + k] = g * silu_mul(a1[k], b1[k]); }
                u32x4 w; w.x = cvt_pk_bf16(v[0], v[1]); w.y = cvt_pk_bf16(v[2], v[3]); w.z = cvt_pk_bf16(v[4], v[5]); w.w = cvt_pk_bf16(v[6], v[7]);
                *(u32x4*)(O + (size_t)row * ldc + col0) = w; }
    }
};
struct EpiResB {
    static constexpr bool PERM = true; typedef f32x4 acc_t;
    const bf16_t* Rin; bf16_t* Rout; int ldc; const int* rowmap; unsigned long long* rss_out;
    __device__ __forceinline__ void operator()(const f32x4 (&acc)[2][2][4][2], const Unit& u, int wr, int wc, int fr, int fq) const {
        const int row0 = u.pm * BM + wr * 64 + fr, col0 = u.pn * BM + wc * 32 + 8 * fq;
#pragma unroll
        for (int ai = 0; ai < 2; ++ai)
#pragma unroll
            for (int m = 0; m < 4; ++m) {
                const int row = row0 + ai * HALF + m * 16; const int orow = rowmap ? rowmap[row] : row; float ss = 0.f;
                if (orow >= 0) { const bf16_t* rp = Rin + (size_t)orow * ldc + col0; bf16_t* wp = Rout + (size_t)orow * ldc + col0;
#pragma unroll
                    for (int bj = 0; bj < 2; ++bj) { const u32x4 w = *(const u32x4*)(rp + bj * HALF); const f32x4 a0 = acc[ai][bj][m][0], a1 = acc[ai][bj][m][1];
                        float v[8];
                        v[0] = __uint_as_float(w.x << 16) + a0[0]; v[1] = __uint_as_float(w.x & 0xffff0000u) + a0[1]; v[2] = __uint_as_float(w.y << 16) + a0[2]; v[3] = __uint_as_float(w.y & 0xffff0000u) + a0[3];
                        v[4] = __uint_as_float(w.z << 16) + a1[0]; v[5] = __uint_as_float(w.z & 0xffff0000u) + a1[1]; v[6] = __uint_as_float(w.w << 16) + a1[2]; v[7] = __uint_as_float(w.w & 0xffff0000u) + a1[3];
#pragma unroll
                        for (int k = 0; k < 8; ++k) ss += v[k] * v[k];
                        u32x4 o; o.x = cvt_pk_bf16(v[0], v[1]); o.y = cvt_pk_bf16(v[2], v[3]); o.z = cvt_pk_bf16(v[4], v[5]); o.w = cvt_pk_bf16(v[6], v[7]);
                        *(u32x4*)(wp + bj * HALF) = o; } }
                if (rss_out) { ss += __shfl_xor(ss, 16); ss += __shfl_xor(ss, 32);
                    if (fq == 0) __hip_atomic_fetch_add(rss_out + orow, (unsigned long long)(ss * 16777216.0f), __ATOMIC_RELAXED, __HIP_MEMORY_SCOPE_AGENT); }
                if (m & 1) asm volatile("" ::: "memory"); }
    }
};

typedef int i32x4_e __attribute__((ext_vector_type(4)));
struct EpiSwiGLUQ {
    static constexpr bool PERM = true; typedef i32x4_e acc_t;
    signed char* O; int ldc; const float* sa; const unsigned* cm; const int* rowmap; const PG8_LAS int* cum; float qmul;
    __device__ __forceinline__ void operator()(const i32x4_e (&acc)[2][2][4][2], const Unit& u, int wr, int wc, int fr, int fq) const {
        int e = 0;
        if (cum) {
#pragma unroll
            for (int k = 1; k < 8; ++k) e += (u.pm >= cum[k]) ? 1 : 0; }
        const unsigned* cme = cm + (size_t)e * 7168 + u.pn * BM + wc * 32 + 8 * fq;
        float cA[8], cAB[8];
#pragma unroll
        for (int k = 0; k < 8; ++k) { cA[k] = __uint_as_float(cme[k]) * (1.0f / 127.0f); cAB[k] = cA[k] * (__uint_as_float(cme[HALF + k]) * (1.0f / 127.0f)); }
        const int row0 = u.pm * BM + wr * 64 + fr, col0 = u.pn * HALF + wc * 32 + 8 * fq;
#pragma unroll
        for (int ai = 0; ai < 2; ++ai)
#pragma unroll
            for (int m = 0; m < 4; ++m) {
                const int row = row0 + ai * HALF + m * 16; const int trow = rowmap ? rowmap[row] : row; const float s = trow >= 0 ? sa[trow] : 0.f;
                const float sneg = -1.4426950408889634f * s, s2q = s * s * qmul;
                const i32x4_e a0 = acc[ai][0][m][0], a1 = acc[ai][0][m][1], b0 = acc[ai][1][m][0], b1 = acc[ai][1][m][1];
                unsigned lo = 0u, hi = 0u;
#pragma unroll
                for (int k = 0; k < 4; ++k) {
                    const float fa = (float)a0[k], fb = (float)b0[k], fc = (float)a1[k], fd = (float)b1[k];
                    const float sg0 = __builtin_amdgcn_rcpf(1.0f + __builtin_amdgcn_exp2f((fa * cA[k]) * sneg)), sg1 = __builtin_amdgcn_rcpf(1.0f + __builtin_amdgcn_exp2f((fc * cA[4 + k]) * sneg));
                    const float u0 = ((fa * fb) * cAB[k]) * s2q * sg0 + 128.0f, u1 = ((fc * fd) * cAB[4 + k]) * s2q * sg1 + 128.0f;
                    lo = __builtin_amdgcn_cvt_pk_u8_f32(__builtin_rintf(u0), k, lo); hi = __builtin_amdgcn_cvt_pk_u8_f32(__builtin_rintf(u1), k, hi); }
                lo ^= 0x80808080u; hi ^= 0x80808080u;
                *(unsigned long long*)(O + (size_t)row * ldc + col0) = (unsigned long long)lo | ((unsigned long long)hi << 32); }
    }
};
struct EpiResBQ {
    static constexpr bool PERM = true; typedef i32x4_e acc_t;
    const bf16_t* Rin; bf16_t* Rout; int ldc; const int* rowmap; const float* gate; const unsigned* cm; const PG8_LAS int* cum; float dq; unsigned long long* rss_out;
    __device__ __forceinline__ void operator()(const i32x4_e (&acc)[2][2][4][2], const Unit& u, int wr, int wc, int fr, int fq) const {
        int e = 0;
        if (cum) {
#pragma unroll
            for (int k = 1; k < 8; ++k) e += (u.pm >= cum[k]) ? 1 : 0; }
        const int row0 = u.pm * BM + wr * 64 + fr, col0 = u.pn * BM + wc * 32 + 8 * fq;
        const unsigned* cme = cm + (size_t)e * 1024 + col0;
        float sb[2][8];
#pragma unroll
        for (int bj = 0; bj < 2; ++bj)
#pragma unroll
            for (int k = 0; k < 8; ++k) sb[bj][k] = __uint_as_float(cme[bj * HALF + k]) * (dq / 127.0f);
#pragma unroll
        for (int ai = 0; ai < 2; ++ai)
#pragma unroll
            for (int m = 0; m < 4; ++m) {
                const int row = row0 + ai * HALF + m * 16; const int orow = rowmap ? rowmap[row] : row; float ss = 0.f;
                if (orow >= 0) { const float gt = gate ? gate[row] : 1.f; const bf16_t* rp = Rin + (size_t)orow * ldc + col0; bf16_t* wp = Rout + (size_t)orow * ldc + col0;
#pragma unroll
                    for (int bj = 0; bj < 2; ++bj) { const u32x4 w = *(const u32x4*)(rp + bj * HALF); const i32x4_e a0 = acc[ai][bj][m][0], a1 = acc[ai][bj][m][1];
                        float v[8];
                        v[0] = __uint_as_float(w.x << 16) + (float)a0[0] * gt * sb[bj][0]; v[1] = __uint_as_float(w.x & 0xffff0000u) + (float)a0[1] * gt * sb[bj][1];
                        v[2] = __uint_as_float(w.y << 16) + (float)a0[2] * gt * sb[bj][2]; v[3] = __uint_as_float(w.y & 0xffff0000u) + (float)a0[3] * gt * sb[bj][3];
                        v[4] = __uint_as_float(w.z << 16) + (float)a1[0] * gt * sb[bj][4]; v[5] = __uint_as_float(w.z & 0xffff0000u) + (float)a1[1] * gt * sb[bj][5];
                        v[6] = __uint_as_float(w.w << 16) + (float)a1[2] * gt * sb[bj][6]; v[7] = __uint_as_float(w.w & 0xffff0000u) + (float)a1[3] * gt * sb[bj][7];
#pragma unroll
                        for (int k = 0; k < 8; ++k) ss += v[k] * v[k];
                        u32x4 o; o.x = cvt_pk_bf16(v[0], v[1]); o.y = cvt_pk_bf16(v[2], v[3]); o.z = cvt_pk_bf16(v[4], v[5]); o.w = cvt_pk_bf16(v[6], v[7]);
                        *(u32x4*)(wp + bj * HALF) = o; } }
                if (rss_out) { ss += __shfl_xor(ss, 16); ss += __shfl_xor(ss, 32);
                    if (fq == 0) __hip_atomic_fetch_add(rss_out + orow, (unsigned long long)(ss * 16777216.0f), __ATOMIC_RELAXED, __HIP_MEMORY_SCOPE_AGENT); }
                if (m & 1) asm volatile("" ::: "memory"); }
    }
};
typedef int i32x4 __attribute__((ext_vector_type(4)));
__device__ __forceinline__ f32x4 mma16(bf16x8 a, bf16x8 b, f32x4 c) { return __builtin_amdgcn_mfma_f32_16x16x32_bf16(a, b, c, 0, 0, 0); }
__device__ __forceinline__ i32x4 mma16(bf16x8 a, bf16x8 b, i32x4 c) { return __builtin_amdgcn_mfma_i32_16x16x64_i8(__builtin_bit_cast(i32x4, a), __builtin_bit_cast(i32x4, b), c, 0, 0, 0); }
template <class Epi, class AB, bool ALIGN_EPI = true>
__device__ __forceinline__ void gemm_phase(PG8_LAS unsigned char* lds, const AB ab, const TileOrder& S, const Epi& E) {
    const int tid = threadIdx.x, wid = __builtin_amdgcn_readfirstlane(tid >> 6), lane = tid & 63, wr = wid >> 2, wc = wid & 3, fr = lane & 15, fq = lane >> 4;
    const int K = ab.K, nt = K / BK;
    int Rr[2], Cc[2]; unsigned voffB[2];
#pragma unroll
    for (int i = 0; i < 2; ++i) { int R, C; stage_rc(tid * 16 + i * 8192, R, C); const int Rb = Epi::PERM ? ((R & ~31) + perm32(R & 31)) : R;
        Rr[i] = R; Cc[i] = C; voffB[i] = (unsigned)(Rb * K + C) * 2u; }
    const size_t kstep = (size_t)(BK * 2);
    const size_t hstep = (size_t)HALF * K * 2;
    const unsigned ldsw = (unsigned)wid * 1024u;
    const int aoff = lds_byte(wr * 64 + fr, fq * 8), boff = lds_byte(wc * 32 + fr, fq * 8);
#define PG8_SA(b, h) (((b) * 2 + (h)) * HTB)
#define PG8_SB(b, h) ((4 + (b) * 2 + (h)) * HTB)
#define PG8_STAGE(bufoff, gbase, voff) do { _Pragma("unroll") for (int _i = 0; _i < 2; ++_i) \
        __builtin_amdgcn_global_load_lds((const unsigned*)((const char*)(gbase) + (voff)[_i]), (PG8_LAS unsigned*)(lds + (bufoff) + ldsw + _i * 8192), 16, 0, 0); } while (0)
#define PG8_LDA(dst, b, h) do { _Pragma("unroll") for (int m = 0; m < 4; ++m) _Pragma("unroll") for (int k = 0; k < 2; ++k) dst[m][k] = *(const PG8_LAS bf16x8*)(lds + PG8_SA(b, h) + aoff + m * 2048 + k * 1024); } while (0)
#define PG8_LDB(dst, b, h) do { _Pragma("unroll") for (int n = 0; n < 2; ++n) _Pragma("unroll") for (int k = 0; k < 2; ++k) dst[n][k] = *(const PG8_LAS bf16x8*)(lds + PG8_SB(b, h) + boff + n * 2048 + k * 1024); } while (0)
#define PG8_MMA(ai, bj, At, Bt) do { __builtin_amdgcn_s_setprio(1); _Pragma("unroll") for (int m = 0; m < 4; ++m) _Pragma("unroll") for (int n = 0; n < 2; ++n) _Pragma("unroll") for (int k = 0; k < 2; ++k) \
        acc[ai][bj][m][n] = mma16(Bt[n][k], At[m][k], acc[ai][bj][m][n]); __builtin_amdgcn_s_setprio(0); } while (0)
#define PG8_WAIT_V(n) asm volatile("s_waitcnt vmcnt(" #n ")" ::: "memory")
#define PG8_WAIT_L(n) asm volatile("s_waitcnt lgkmcnt(" #n ")" ::: "memory")
#define PG8_BAR __builtin_amdgcn_s_barrier()
#define PG8_SCHED __builtin_amdgcn_sched_barrier(0)
    Unit cur, nxt; int ui = 0;
    if (!S.next(0, cur)) return;
    typedef typename Epi::acc_t acc_t;
    acc_t acc[2][2][4][2];
#pragma unroll
    for (int a = 0; a < 2; ++a)
#pragma unroll
        for (int b = 0; b < 2; ++b)
#pragma unroll
            for (int m = 0; m < 4; ++m)
#pragma unroll
                for (int n = 0; n < 2; ++n) acc[a][b][m][n] = (acc_t){0, 0, 0, 0};
    bf16x8 At[4][2], B0[2][2], B1[2][2];
    unsigned cv0[2], cv1[2], nv0[2], nv1[2]; int ntok[4] = {0, 0, 0, 0};
    if constexpr (AB::GATHER) { const int* tp = ab.tokp(cur);
#pragma unroll
        for (int i = 0; i < 2; ++i) { int t0 = tp[Rr[i]], t1 = tp[HALF + Rr[i]]; t0 = t0 < 0 ? 0 : t0; t1 = t1 < 0 ? 0 : t1;
            cv0[i] = (unsigned)(t0 * K + Cc[i]) * 2u; cv1[i] = (unsigned)(t1 * K + Cc[i]) * 2u; }
    } else {
#pragma unroll
        for (int i = 0; i < 2; ++i) { cv0[i] = (unsigned)(Rr[i] * K + Cc[i]) * 2u; cv1[i] = cv0[i] + (unsigned)hstep; }
    }
#pragma unroll
    for (int i = 0; i < 2; ++i) { nv0[i] = cv0[i]; nv1[i] = cv1[i]; }
    const char* cA = ab.abase(cur); const char* cB = ab.bbase(cur);
    PG8_STAGE(PG8_SB(0, 0), cB, voffB); PG8_STAGE(PG8_SB(0, 1), cB + hstep, voffB); PG8_STAGE(PG8_SA(0, 0), cA, cv0); PG8_STAGE(PG8_SA(0, 1), cA, cv1);
    if (wr == 1) PG8_BAR;
    PG8_WAIT_V(2); PG8_BAR;
    PG8_STAGE(PG8_SB(1, 0), cB + kstep, voffB); PG8_STAGE(PG8_SA(1, 0), cA + kstep, cv0); PG8_STAGE(PG8_SB(1, 1), cB + hstep + kstep, voffB);
    PG8_WAIT_V(6); PG8_BAR;
    for (;;) {
        const bool has_next = S.next(ui + 1, nxt);
        const char* nA = has_next ? ab.abase(nxt) : cA; const char* nB = has_next ? ab.bbase(nxt) : cB;
        if constexpr (AB::GATHER) {
            if (has_next) { const int* tp = ab.tokp(nxt);
                asm volatile("global_load_dword %0, %1, off" : "=v"(ntok[0]) : "v"(tp + Rr[0]) : "memory");
                asm volatile("global_load_dword %0, %1, off" : "=v"(ntok[1]) : "v"(tp + Rr[1]) : "memory");
                asm volatile("global_load_dword %0, %1, off" : "=v"(ntok[2]) : "v"(tp + HALF + Rr[0]) : "memory");
                asm volatile("global_load_dword %0, %1, off" : "=v"(ntok[3]) : "v"(tp + HALF + Rr[1]) : "memory"); }
        }
        for (int t = 0; t < nt; t += 2) {
            const bool last = (t == nt - 2);
            const char* a1 = cA + (size_t)(t + 1) * kstep;
            const char* a2 = last ? nA : cA + (size_t)(t + 2) * kstep; const char* b2 = last ? nB : cB + (size_t)(t + 2) * kstep;
            const char* a3 = a2 + kstep; const char* b3 = b2 + kstep;
            unsigned x0[2], x1[2];
            if constexpr (AB::GATHER) {
                if (last && has_next) {
                    asm volatile("s_waitcnt vmcnt(6)" : "+v"(ntok[0]), "+v"(ntok[1]), "+v"(ntok[2]), "+v"(ntok[3]) :: "memory");
#pragma unroll
                    for (int i = 0; i < 2; ++i) { int t0 = ntok[i], t1 = ntok[2 + i]; t0 = t0 < 0 ? 0 : t0; t1 = t1 < 0 ? 0 : t1;
                        nv0[i] = (unsigned)(t0 * K + Cc[i]) * 2u; nv1[i] = (unsigned)(t1 * K + Cc[i]) * 2u; }
                }
#pragma unroll
                for (int i = 0; i < 2; ++i) { x0[i] = last ? nv0[i] : cv0[i]; x1[i] = last ? nv1[i] : cv1[i]; }
            } else {
#pragma unroll
                for (int i = 0; i < 2; ++i) { x0[i] = cv0[i]; x1[i] = cv1[i]; }
            }
            PG8_LDB(B0, 0, 0); PG8_LDB(B1, 0, 1); PG8_SCHED; PG8_LDA(At, 0, 0); PG8_STAGE(PG8_SA(1, 1), a1, cv1);
            PG8_WAIT_V(8); PG8_WAIT_L(0); PG8_BAR; PG8_MMA(0, 0, At, B0); PG8_MMA(0, 1, At, B1); PG8_BAR; PG8_SCHED;
            PG8_LDA(At, 0, 1); PG8_STAGE(PG8_SB(0, 0), b2, voffB); PG8_STAGE(PG8_SB(0, 1), b2 + hstep, voffB); PG8_STAGE(PG8_SA(0, 0), a2, x0);
            PG8_WAIT_V(8); PG8_WAIT_L(0); PG8_BAR; PG8_MMA(1, 0, At, B0); PG8_MMA(1, 1, At, B1); PG8_BAR; PG8_SCHED;
            PG8_LDB(B0, 1, 0); PG8_LDB(B1, 1, 1); PG8_SCHED; PG8_LDA(At, 1, 0); PG8_STAGE(PG8_SA(0, 1), a2, x1);
            PG8_WAIT_V(8); PG8_WAIT_L(0); PG8_BAR; PG8_MMA(0, 0, At, B0); PG8_MMA(0, 1, At, B1); PG8_BAR; PG8_SCHED;
            PG8_LDA(At, 1, 1); PG8_STAGE(PG8_SB(1, 0), b3, voffB); PG8_STAGE(PG8_SB(1, 1), b3 + hstep, voffB); PG8_STAGE(PG8_SA(1, 0), a3, x0);
            PG8_WAIT_V(8); PG8_WAIT_L(0); PG8_BAR; PG8_MMA(1, 0, At, B0); PG8_MMA(1, 1, At, B1); PG8_BAR; PG8_SCHED;
        }
        if constexpr (ALIGN_EPI) { if (wr == 0) PG8_BAR; }
        E(acc, cur, wr, wc, fr, fq);
        if (!has_next) break;
#pragma unroll
        for (int a = 0; a < 2; ++a)
#pragma unroll
            for (int b = 0; b < 2; ++b)
#pragma unroll
                for (int m = 0; m < 4; ++m)
#pragma unroll
                    for (int n = 0; n < 2; ++n) acc[a][b][m][n] = (acc_t){0, 0, 0, 0};
        cur = nxt; cA = nA; cB = nB; ++ui;
#pragma unroll
        for (int i = 0; i < 2; ++i) { cv0[i] = nv0[i]; cv1[i] = nv1[i]; }
        if constexpr (ALIGN_EPI) { if (wr == 1) PG8_BAR; }
    }
    PG8_WAIT_V(0);
    if constexpr (!ALIGN_EPI) { if (wr == 0) PG8_BAR; }
    PG8_BAR;
#undef PG8_SA
#undef PG8_SB
#undef PG8_STAGE
#undef PG8_LDA
#undef PG8_LDB
#undef PG8_MMA
#undef PG8_WAIT_V
#undef PG8_WAIT_L
#undef PG8_BAR
#undef PG8_SCHED
}
}

namespace moba {
using bf16 = __hip_bfloat16;
using bf16x8 = __attribute__((ext_vector_type(8))) short;
using s16x4  = __attribute__((ext_vector_type(4))) short;
using f32x16 = __attribute__((ext_vector_type(16))) float;
using u32x4  = __attribute__((ext_vector_type(4))) unsigned;
constexpr int D = 128, NW = 8, QBLK = 32, KVBLK = 64, LDK = 3072, NT = 4;
constexpr float THR = 8.f;
constexpr size_t SHM_V = KVBLK * D * 2, SHM_K = KVBLK * D * 2, SHM_ATTN = 2 * SHM_V + 2 * SHM_K + NW * 64 * 4;
#define KSWZ(row, colB) ((row) * 256 + ((colB) ^ (((row) & 7) << 4)))
#define SBAR() __builtin_amdgcn_sched_barrier(0)
__device__ __forceinline__ int crow(int r, int hi) { return (r & 3) + 8 * (r >> 2) + 4 * hi; }
__device__ __forceinline__ unsigned cvtpk(float lo, float hi) { unsigned r; asm volatile("v_cvt_pk_bf16_f32 %0, %1, %2" : "=v"(r) : "v"(lo), "v"(hi)); return r; }
__device__ __forceinline__ void partialSM(f32x16& p0, f32x16& p1, float& m_reg, float& mn, float& alpha) {
  float pmax = p0[0];
#pragma unroll
  for (int r = 1; r < 16; ++r) pmax = fmaxf(pmax, p0[r]);
#pragma unroll
  for (int r = 0; r < 16; ++r) pmax = fmaxf(pmax, p1[r]);
  { auto rr = __builtin_amdgcn_permlane32_swap(__float_as_uint(pmax), __float_as_uint(pmax), false, false);
    pmax = fmaxf(__uint_as_float(rr[0]), __uint_as_float(rr[1])); }
  if (__builtin_expect(__all(pmax - m_reg <= THR), 1)) { mn = m_reg; alpha = 1.f; }
  else { mn = fmaxf(m_reg, pmax); alpha = __builtin_amdgcn_exp2f(m_reg - mn); m_reg = mn; }
#pragma unroll
  for (int r = 0; r < 16; ++r) p0[r] = p0[r] - mn;
#pragma unroll
  for (int r = 0; r < 16; ++r) p1[r] = p1[r] - mn;
#pragma unroll
  for (int r = 0; r < 16; ++r) p0[r] = __builtin_amdgcn_exp2f(p0[r]);
}
__device__ __forceinline__ void finishSM(f32x16& p0, f32x16& p1, float alpha, float& l_reg, bf16x8& pa0, bf16x8& pa1, bf16x8& pa2, bf16x8& pa3) {
#pragma unroll
  for (int r = 0; r < 16; ++r) p1[r] = __builtin_amdgcn_exp2f(p1[r]);
  float ps = 0;
#pragma unroll
  for (int r = 0; r < 16; ++r) ps += p0[r];
#pragma unroll
  for (int r = 0; r < 16; ++r) ps += p1[r];
  { auto rr = __builtin_amdgcn_permlane32_swap(__float_as_uint(ps), __float_as_uint(ps), false, false);
    ps = __uint_as_float(rr[0]) + __uint_as_float(rr[1]); }
  l_reg = l_reg * alpha + ps;
#define PK4(P, BASE, OUT) do { unsigned a0 = cvtpk(P[BASE + 0], P[BASE + 1]), a1 = cvtpk(P[BASE + 2], P[BASE + 3]);   \
    unsigned b0 = cvtpk(P[BASE + 4], P[BASE + 5]), b1 = cvtpk(P[BASE + 6], P[BASE + 7]);                              \
    auto r0 = __builtin_amdgcn_permlane32_swap(a0, b0, false, false); auto r1 = __builtin_amdgcn_permlane32_swap(a1, b1, false, false); \
    u32x4 w = {r0[0], r1[0], r0[1], r1[1]}; OUT = *reinterpret_cast<bf16x8*>(&w); } while (0)
  PK4(p0, 0, pa0); PK4(p0, 8, pa1); PK4(p1, 0, pa2); PK4(p1, 8, pa3);
#undef PK4
}
__device__ __forceinline__ void qkt(f32x16& p0, f32x16& p1, const bf16* Ks, const bf16x8* qr, int r32, int hi) {
  p0 = f32x16{}; p1 = f32x16{};
#pragma unroll
  for (int d0 = 0; d0 < 8; ++d0) { int cb = (d0 * 16 + hi * 8) * 2;
    bf16x8 b0 = *reinterpret_cast<const bf16x8*>((const char*)Ks + KSWZ(r32, cb));
    bf16x8 b1 = *reinterpret_cast<const bf16x8*>((const char*)Ks + KSWZ(32 + r32, cb));
    p0 = __builtin_amdgcn_mfma_f32_32x32x16_bf16(b0, qr[d0], p0, 0, 0, 0);
    p1 = __builtin_amdgcn_mfma_f32_32x32x16_bf16(b1, qr[d0], p1, 0, 0, 0); }
}
__device__ __forceinline__ int v_st(int k, int c) { const int kk = (k & ~0xC) | ((k & 4) << 1) | ((k & 8) >> 1); return ((kk >> 3) * 4 + (c >> 5)) * 512 + ((kk & 7) * 32 + (c & 31)) * 2; }
__device__ __forceinline__ int v_rd_base(int lane) { return ((lane & 3) << 3) | (((lane >> 2) & 3) << 6) | (((lane >> 4) & 1) << 5) | (((lane >> 5) & 1) << 8); }
constexpr int v_rd_off(int d0, int ks, int half) { return d0 * 512 + ks * 4096 + half * 2048; }
template <int OFF> __device__ __forceinline__ s16x4 tr_read(int vb) {
  s16x4 r; asm volatile("ds_read_b64_tr_b16 %0, %1 offset:%2" : "=&v"(r) : "v"(vb), "i"(OFF) : "memory"); return r;
}
template <int D0> __device__ __forceinline__ void pv_one(f32x16& od, int vb, bf16x8 pa0, bf16x8 pa1, bf16x8 pa2, bf16x8 pa3) {
  const s16x4 l0 = tr_read<v_rd_off(D0, 0, 0)>(vb), h0 = tr_read<v_rd_off(D0, 0, 1)>(vb), l1 = tr_read<v_rd_off(D0, 1, 0)>(vb), h1 = tr_read<v_rd_off(D0, 1, 1)>(vb);
  const s16x4 l2 = tr_read<v_rd_off(D0, 2, 0)>(vb), h2 = tr_read<v_rd_off(D0, 2, 1)>(vb), l3 = tr_read<v_rd_off(D0, 3, 0)>(vb), h3 = tr_read<v_rd_off(D0, 3, 1)>(vb);
  asm volatile("s_waitcnt lgkmcnt(0)" ::: "memory"); SBAR();
#define PK(L, H) (bf16x8){L[0], L[1], L[2], L[3], H[0], H[1], H[2], H[3]}
  od = __builtin_amdgcn_mfma_f32_32x32x16_bf16(pa0, PK(l0, h0), od, 0, 0, 0);
  od = __builtin_amdgcn_mfma_f32_32x32x16_bf16(pa1, PK(l1, h1), od, 0, 0, 0);
  od = __builtin_amdgcn_mfma_f32_32x32x16_bf16(pa2, PK(l2, h2), od, 0, 0, 0);
  od = __builtin_amdgcn_mfma_f32_32x32x16_bf16(pa3, PK(l3, h3), od, 0, 0, 0);
#undef PK
}
__device__ __forceinline__ void pv_d0(f32x16* o, int vb, bf16x8 pa0, bf16x8 pa1, bf16x8 pa2, bf16x8 pa3) {
  pv_one<0>(o[0], vb, pa0, pa1, pa2, pa3); pv_one<1>(o[1], vb, pa0, pa1, pa2, pa3); pv_one<2>(o[2], vb, pa0, pa1, pa2, pa3); pv_one<3>(o[3], vb, pa0, pa1, pa2, pa3);
}
__device__ __forceinline__ void cmask(f32x16& p0, f32x16& p1, int tile, int ql, int hi) {
  asm volatile("" : "+v"(ql));
#pragma unroll
  for (int r = 0; r < 16; ++r) { const int kv = 64 * tile + (r & 3) + 8 * (r >> 2) + 4 * hi; if (kv > ql) p0[r] = -1e30f; if (kv + 32 > ql) p1[r] = -1e30f; }
}
__device__ __forceinline__ void moba_unit(const bool OWN, const bf16* qrow, const bf16* __restrict__ Kh, const bf16* __restrict__ Vh, bf16* obase, int ostride, int dst, float* ml, int mli, int ql, char* lds) {
  const int tid = threadIdx.x, wid = tid >> 6, lane = tid & 63, r32 = lane & 31, hi = lane >> 5;
  bf16* V_lds = (bf16*)lds; bf16* K_lds = (bf16*)(lds + 2 * SHM_V);
  float* ws = (float*)(lds + 2 * SHM_V + 2 * SHM_K) + wid * 64; float* li_l = ws; float* al_l = ws + 32;
  float m_reg = -1e30f, l_reg = 0; f32x16 o[4] = {}; bf16x8 qr[8];
  const bf16* Qw = qrow + hi * 8;
#pragma unroll
  for (int d0 = 0; d0 < 8; ++d0) qr[d0] = *reinterpret_cast<const bf16x8*>(Qw + d0 * 16);
  const int sr = tid >> 4, sc = (tid & 15) * 8, vst0 = v_st(sr, sc), vst1 = v_st(32 + sr, sc);
  const int vb0 = (int)(uintptr_t)V_lds + v_rd_base(lane);
  struct { bf16x8 vs0, vs1, ks0, ks1; } sr_[2];
#define SLOAD(i, k0) do { sr_[i].vs0 = *reinterpret_cast<const bf16x8*>(&Vh[(long)((k0) + sr) * LDK + sc]); sr_[i].vs1 = *reinterpret_cast<const bf16x8*>(&Vh[(long)((k0) + 32 + sr) * LDK + sc]); \
    sr_[i].ks0 = *reinterpret_cast<const bf16x8*>(&Kh[(long)((k0) + sr) * LDK + sc]); sr_[i].ks1 = *reinterpret_cast<const bf16x8*>(&Kh[(long)((k0) + 32 + sr) * LDK + sc]); } while (0)
#define SWRITE(b, i) do { *(bf16x8*)((char*)V_lds + (b) * SHM_V + vst0) = sr_[i].vs0;          \
    *(bf16x8*)((char*)V_lds + (b) * SHM_V + vst1) = sr_[i].vs1; int kc = sc * 2;               \
    *(bf16x8*)((char*)K_lds + (b) * SHM_K + KSWZ(sr, kc)) = sr_[i].ks0;                       \
    *(bf16x8*)((char*)K_lds + (b) * SHM_K + KSWZ(32 + sr, kc)) = sr_[i].ks1; } while (0)
#define SWAIT() asm volatile("s_waitcnt vmcnt(4)" ::: "memory")
#define RESC(a) do { if (__any((a) < 1.f)) { if (hi == 0) al_l[r32] = (a); asm volatile("s_waitcnt lgkmcnt(0)" ::: "memory"); \
    _Pragma("unroll") for (int d = 0; d < 4; ++d) _Pragma("unroll") for (int r = 0; r < 16; ++r) o[d][r] *= al_l[crow(r, hi)]; } } while (0)
  f32x16 pA0, pA1, pB0, pB1; float mnA, mnB, alA, alB; bf16x8 pa0, pa1, pa2, pa3;
  constexpr int SE = 0, SO = 1;
  SLOAD(SE, 0); asm volatile("s_waitcnt vmcnt(0)" ::: "memory"); SWRITE(0, SE); __syncthreads();
  qkt(pA0, pA1, K_lds, qr, r32, hi); if (OWN) cmask(pA0, pA1, 0, ql, hi); partialSM(pA0, pA1, m_reg, mnA, alA);
  SLOAD(SO, KVBLK); SLOAD(SE, 2 * KVBLK);
  SWAIT(); SWRITE(1, SO); __syncthreads();
  {
    SBAR(); qkt(pB0, pB1, (bf16*)((char*)K_lds + SHM_K), qr, r32, hi);
    finishSM(pA0, pA1, alA, l_reg, pa0, pa1, pa2, pa3); SBAR();
    SLOAD(SO, 3 * KVBLK); SBAR();
    pv_d0(o, vb0, pa0, pa1, pa2, pa3); if (OWN) cmask(pB0, pB1, 1, ql, hi); partialSM(pB0, pB1, m_reg, mnB, alB);
    __syncthreads(); SWAIT(); SWRITE(0, SE);
    RESC(alB); __syncthreads();
    SBAR(); qkt(pA0, pA1, K_lds, qr, r32, hi);
    finishSM(pB0, pB1, alB, l_reg, pa0, pa1, pa2, pa3); SBAR();
    pv_d0(o, vb0 + (int)SHM_V, pa0, pa1, pa2, pa3); if (OWN) cmask(pA0, pA1, 2, ql, hi); partialSM(pA0, pA1, m_reg, mnA, alA);
    __syncthreads(); asm volatile("s_waitcnt vmcnt(0)" ::: "memory"); SWRITE(1, SO);
    RESC(alA); __syncthreads();
  }
  SBAR(); qkt(pB0, pB1, (bf16*)((char*)K_lds + SHM_K), qr, r32, hi);
  finishSM(pA0, pA1, alA, l_reg, pa0, pa1, pa2, pa3); SBAR();
  pv_d0(o, vb0, pa0, pa1, pa2, pa3); if (OWN) cmask(pB0, pB1, 3, ql, hi); partialSM(pB0, pB1, m_reg, mnB, alB);
  __syncthreads(); RESC(alB);
  finishSM(pB0, pB1, alB, l_reg, pa0, pa1, pa2, pa3); SBAR();
  pv_d0(o, vb0 + (int)SHM_V, pa0, pa1, pa2, pa3);
  if (hi == 0) li_l[r32] = l_reg; asm volatile("s_waitcnt lgkmcnt(0)" ::: "memory");
  float rli[16];
#pragma unroll
  for (int r = 0; r < 16; ++r) rli[r] = __builtin_amdgcn_rcpf(li_l[crow(r, hi)]);
  __syncthreads();
  bf16* stg = (bf16*)lds + wid * 4096;
#pragma unroll
  for (int r = 0; r < 16; ++r) { const int orow = crow(r, hi);
#pragma unroll
    for (int d0 = 0; d0 < 4; ++d0) stg[orow * 128 + d0 * 32 + r32] = __float2bfloat16(o[d0][r] * rli[r]); }
  int* dsto = (int*)al_l;
  if (hi == 0) dsto[r32] = dst;
  asm volatile("s_waitcnt lgkmcnt(0)" ::: "memory");
#pragma unroll
  for (int i = 0; i < 8; ++i) { const int row = i * 4 + (lane >> 4), ch = lane & 15; const int di = dsto[row]; const u32x4 v = *(const u32x4*)(stg + row * 128 + ch * 8);
    if (di >= 0) *(u32x4*)(obase + (size_t)di * ostride + ch * 8) = v; }
  if (hi == 0 && dst >= 0) { ml[2 * (size_t)mli] = m_reg; ml[2 * (size_t)mli + 1] = l_reg; }
  asm volatile("s_waitcnt lgkmcnt(0)" ::: "memory");
  __syncthreads();
#undef SLOAD
#undef SWRITE
#undef SWAIT
#undef RESC
}

#define KSWZ64(row, colB) ((row) * 128 + ((colB) ^ ((((row) >> 1) & 7) << 4)))
constexpr size_t DA_SHM_K = 64 * 64 * 2;
constexpr size_t DA_SHM = 2 * SHM_V + 2 * DA_SHM_K + NW * 64 * 4;
__device__ __forceinline__ void qkt64(f32x16& p0, f32x16& p1, const bf16* Ks, const bf16x8* qr, int r32, int hi) {
  p0 = f32x16{}; p1 = f32x16{};
#pragma unroll
  for (int d0 = 0; d0 < 4; ++d0) { int cb = (d0 * 16 + hi * 8) * 2;
    bf16x8 b0 = *reinterpret_cast<const bf16x8*>((const char*)Ks + KSWZ64(r32, cb));
    bf16x8 b1 = *reinterpret_cast<const bf16x8*>((const char*)Ks + KSWZ64(32 + r32, cb));
    p0 = __builtin_amdgcn_mfma_f32_32x32x16_bf16(b0, qr[d0], p0, 0, 0, 0);
    p1 = __builtin_amdgcn_mfma_f32_32x32x16_bf16(b1, qr[d0], p1, 0, 0, 0); }
}
__device__ __forceinline__ void dattn_unit(const bf16* Qb, const bf16* __restrict__ Kh, const bf16* __restrict__ Vh, bf16* Ob, const int NT, char* lds) {
  const int tid = threadIdx.x, wid = tid >> 6, lane = tid & 63, r32 = lane & 31, hi = lane >> 5;
  bf16* V_lds = (bf16*)lds; bf16* K_lds = (bf16*)(lds + 2 * SHM_V);
  float* ws = (float*)(lds + 2 * SHM_V + 2 * DA_SHM_K) + wid * 64; float* li_l = ws; float* al_l = ws + 32;
  float m_reg = -1e30f, l_reg = 0; f32x16 o[4] = {}; bf16x8 qr[4];
  const bf16* Qw = Qb + (long)(wid * QBLK + r32) * LDK + hi * 8;
#pragma unroll
  for (int d0 = 0; d0 < 4; ++d0) qr[d0] = *reinterpret_cast<const bf16x8*>(Qw + d0 * 16);
  const int sr = tid >> 4, sc = (tid & 15) * 8, vst0 = v_st(sr, sc), vst1 = v_st(32 + sr, sc);
  const int kr = tid >> 3, kc = (tid & 7) * 8, kst = KSWZ64(kr, kc * 2);
  const int vb0 = (int)(uintptr_t)V_lds + v_rd_base(lane);
  const int ql = wid * QBLK + r32;
  struct { bf16x8 vs0, vs1, ks; } sr_[2];
#define SLOAD(i, k0) do { sr_[i].vs0 = *reinterpret_cast<const bf16x8*>(&Vh[(long)((k0) + sr) * LDK + sc]); sr_[i].vs1 = *reinterpret_cast<const bf16x8*>(&Vh[(long)((k0) + 32 + sr) * LDK + sc]); \
    sr_[i].ks = *reinterpret_cast<const bf16x8*>(&Kh[(long)((k0) + kr) * LDK + kc]); } while (0)
#define SWRITE(b, i) do { *(bf16x8*)((char*)V_lds + (b) * SHM_V + vst0) = sr_[i].vs0; *(bf16x8*)((char*)V_lds + (b) * SHM_V + vst1) = sr_[i].vs1; \
    *(bf16x8*)((char*)K_lds + (b) * DA_SHM_K + kst) = sr_[i].ks; } while (0)
#define SWAIT() asm volatile("s_waitcnt vmcnt(3)" ::: "memory")
#define RESC(a) do { if (__any((a) < 1.f)) { if (hi == 0) al_l[r32] = (a); asm volatile("s_waitcnt lgkmcnt(0)" ::: "memory"); \
    _Pragma("unroll") for (int d = 0; d < 4; ++d) _Pragma("unroll") for (int r = 0; r < 16; ++r) o[d][r] *= al_l[crow(r, hi)]; } } while (0)
#define MASK(P0, P1, t) do { if ((t) >= NT - 4) cmask(P0, P1, (t) - (NT - 4), ql, hi); } while (0)
  f32x16 pA0, pA1, pB0, pB1; float mnA, mnB, alA, alB; bf16x8 pa0, pa1, pa2, pa3;
  constexpr int SE = 0, SO = 1;
  SLOAD(SE, 0); asm volatile("s_waitcnt vmcnt(0)" ::: "memory"); SWRITE(0, SE); __syncthreads();
  qkt64(pA0, pA1, K_lds, qr, r32, hi); MASK(pA0, pA1, 0); partialSM(pA0, pA1, m_reg, mnA, alA);
  SLOAD(SO, KVBLK); SLOAD(SE, 2 * KVBLK);
  SWAIT(); SWRITE(1, SO); __syncthreads();
  for (int j = 1; j + 1 < NT; j += 2) {
    SBAR(); qkt64(pB0, pB1, (bf16*)((char*)K_lds + DA_SHM_K), qr, r32, hi);
    finishSM(pA0, pA1, alA, l_reg, pa0, pa1, pa2, pa3); SBAR();
    SLOAD(SO, (j + 2) * KVBLK); SBAR();
    pv_d0(o, vb0, pa0, pa1, pa2, pa3); MASK(pB0, pB1, j); partialSM(pB0, pB1, m_reg, mnB, alB);
    __syncthreads(); SWAIT(); SWRITE(0, SE);
    RESC(alB); __syncthreads();
    SBAR(); qkt64(pA0, pA1, K_lds, qr, r32, hi);
    finishSM(pB0, pB1, alB, l_reg, pa0, pa1, pa2, pa3); SBAR();
    if (j + 3 < NT) SLOAD(SE, (j + 3) * KVBLK); SBAR();
    pv_d0(o, vb0 + (int)SHM_V, pa0, pa1, pa2, pa3); MASK(pA0, pA1, j + 1); partialSM(pA0, pA1, m_reg, mnA, alA);
    __syncthreads(); SWAIT(); SWRITE(1, SO);
    RESC(alA); __syncthreads();
  }
  SBAR(); qkt64(pB0, pB1, (bf16*)((char*)K_lds + DA_SHM_K), qr, r32, hi);
  finishSM(pA0, pA1, alA, l_reg, pa0, pa1, pa2, pa3); SBAR();
  pv_d0(o, vb0, pa0, pa1, pa2, pa3); MASK(pB0, pB1, NT - 1); partialSM(pB0, pB1, m_reg, mnB, alB);
  __syncthreads(); RESC(alB);
  finishSM(pB0, pB1, alB, l_reg, pa0, pa1, pa2, pa3); SBAR();
  pv_d0(o, vb0 + (int)SHM_V, pa0, pa1, pa2, pa3);
  if (hi == 0) li_l[r32] = l_reg; asm volatile("s_waitcnt lgkmcnt(0)" ::: "memory");
  float rli[16];
#pragma unroll
  for (int r = 0; r < 16; ++r) rli[r] = __builtin_amdgcn_rcpf(li_l[crow(r, hi)]);
  __syncthreads();
  bf16* stg = (bf16*)lds + wid * 4096;
#pragma unroll
  for (int r = 0; r < 16; ++r) { const int orow = crow(r, hi);
#pragma unroll
    for (int d0 = 0; d0 < 4; ++d0) stg[orow * 128 + d0 * 32 + r32] = __float2bfloat16(o[d0][r] * rli[r]); }
  asm volatile("s_waitcnt lgkmcnt(0)" ::: "memory");
#pragma unroll
  for (int i = 0; i < 8; ++i) { const int row = i * 4 + (lane >> 4), ch = lane & 15; const u32x4 v = *(const u32x4*)(stg + row * 128 + ch * 8);
    *(u32x4*)(Ob + (size_t)(wid * QBLK + row) * 2048 + ch * 8) = v; }
  asm volatile("s_waitcnt lgkmcnt(0)" ::: "memory");
  __syncthreads();
#undef SLOAD
#undef SWRITE
#undef SWAIT
#undef RESC
#undef MASK
}

__device__ __forceinline__ void glds16(const void* gsrc, unsigned lds_dst) { unsigned keep;
  asm volatile("s_mov_b32 %0, m0\n\ts_mov_b32 m0, %2\n\ts_nop 0\n\tglobal_load_lds_dwordx4 %1, off\n\ts_mov_b32 m0, %0" : "=&s"(keep) : "v"(gsrc), "s"(lds_dst) : "memory"); }
#define WAIT_BAR(N) asm volatile("s_waitcnt vmcnt(" #N ") lgkmcnt(0)\n\ts_barrier" ::: "memory")
constexpr int DA2_STG = 24576;
constexpr size_t DA2_SHM = 3 * DA2_STG + NW * 64 * 4;
__device__ __forceinline__ void qkt64m(f32x16& p0, f32x16& p1, const bf16* Ks, const bf16x8* qr, bf16x8 qm, bf16x8 kneg, int r32, int hi) {
  p0 = __builtin_amdgcn_mfma_f32_32x32x16_bf16(kneg, qm, f32x16{}, 0, 0, 0); p1 = p0;
#pragma unroll
  for (int d0 = 0; d0 < 4; ++d0) { int cb = (d0 * 16 + hi * 8) * 2;
    bf16x8 b0 = *reinterpret_cast<const bf16x8*>((const char*)Ks + KSWZ64(r32, cb));
    bf16x8 b1 = *reinterpret_cast<const bf16x8*>((const char*)Ks + KSWZ64(32 + r32, cb));
    p0 = __builtin_amdgcn_mfma_f32_32x32x16_bf16(b0, qr[d0], p0, 0, 0, 0);
    p1 = __builtin_amdgcn_mfma_f32_32x32x16_bf16(b1, qr[d0], p1, 0, 0, 0); }
}
__device__ __forceinline__ void partialSM2(f32x16& p0, f32x16& p1, float& m_ref, bf16x8& qm, float& alpha, const bool first, const int hi) {
  float pmax = p0[0];
#pragma unroll
  for (int r = 1; r < 16; ++r) pmax = fmaxf(pmax, p0[r]);
#pragma unroll
  for (int r = 0; r < 16; ++r) pmax = fmaxf(pmax, p1[r]);
  { auto rr = __builtin_amdgcn_permlane32_swap(__float_as_uint(pmax), __float_as_uint(pmax), false, false);
    pmax = fmaxf(__uint_as_float(rr[0]), __uint_as_float(rr[1])); }
  alpha = 1.f;
  if (__builtin_expect(first || __any(pmax > THR), 0)) {
    const bool upd = first || (pmax > THR);
    const float mn = m_ref + pmax; const unsigned b = __float_as_uint(mn);
    const float mup = __uint_as_float(mn >= 0.f ? ((b + 0xFFFFu) & 0xFFFF0000u) : (b & 0xFFFF0000u));
    const float mnew = upd ? mup : m_ref; const float delta = mnew - m_ref;
    m_ref = mnew; alpha = __builtin_amdgcn_exp2f(-delta);
#pragma unroll
    for (int r = 0; r < 16; ++r) { p0[r] -= delta; p1[r] -= delta; }
    qm[0] = (hi == 0) ? (short)(__float_as_uint(m_ref) >> 16) : (short)0;
  }
#pragma unroll
  for (int r = 0; r < 16; ++r) p0[r] = __builtin_amdgcn_exp2f(p0[r]);
}
__device__ __forceinline__ void dattn_unit2(const bf16* Qb, const bf16* __restrict__ Kh, const bf16* __restrict__ Vh, bf16* Ob, const int NT, char* lds) {
  const int tid = threadIdx.x, lane = tid & 63, r32 = lane & 31, hi = lane >> 5; const int wid = __builtin_amdgcn_readfirstlane(tid >> 6);
  const unsigned lds0 = (unsigned)(uintptr_t)lds;
  float* ws = (float*)(lds + 3 * DA2_STG) + wid * 64; float* li_l = ws; float* al_l = ws + 32;
  const int krow = 8 * wid + (lane >> 3), kch = (lane & 7) ^ ((krow >> 1) & 7);
  const bf16* ksrc = Kh + (long)krow * LDK + kch * 8;
  const bf16* vsrc[2];
#pragma unroll
  for (int i = 0; i < 2; ++i) { const int off = (i * 8 + wid) * 1024 + lane * 16, sub = off >> 9, within = (off & 511) >> 1;
    const int kk = (sub >> 2) * 8 + (within >> 5), c = (sub & 3) * 32 + (within & 31), k = (kk & ~0xC) | ((kk & 4) << 1) | ((kk & 8) >> 1);
    vsrc[i] = Vh + (long)k * LDK + c; }
  const unsigned kdst = lds0 + wid * 1024, vdst = lds0 + 8192 + wid * 1024;
#define DMA(t, st) do { const long go_ = (long)(t) * KVBLK * LDK; glds16(ksrc + go_, (unsigned)__builtin_amdgcn_readfirstlane(kdst + (st))); \
    glds16(vsrc[0] + go_, (unsigned)__builtin_amdgcn_readfirstlane(vdst + (st))); glds16(vsrc[1] + go_, (unsigned)__builtin_amdgcn_readfirstlane(vdst + 8192 + (st))); } while (0)
  DMA(0, 0);
  float m_ref = 0.f, l_reg = 0.f; f32x16 o[4] = {}; bf16x8 qr[4]; bf16x8 qm = {0, 0, 0, 0, 0, 0, 0, 0};
  const bf16x8 kneg = {(short)(hi == 0 ? (short)0xBF80 : (short)0), 0, 0, 0, 0, 0, 0, 0};
  const bf16* Qw = Qb + (long)(wid * QBLK + r32) * LDK + hi * 8;
#pragma unroll
  for (int d0 = 0; d0 < 4; ++d0) qr[d0] = *reinterpret_cast<const bf16x8*>(Qw + d0 * 16);
  const int ql = wid * QBLK + r32;
#define RESC(a) do { if (__any((a) < 1.f)) { if (hi == 0) al_l[r32] = (a); asm volatile("s_waitcnt lgkmcnt(0)" ::: "memory"); \
    _Pragma("unroll") for (int d = 0; d < 4; ++d) _Pragma("unroll") for (int r = 0; r < 16; ++r) o[d][r] *= al_l[crow(r, hi)]; } } while (0)
#define MASK(P0, P1, t) do { if ((t) >= NT - 4) cmask(P0, P1, (t) - (NT - 4), ql, hi); } while (0)
#define KST(sx) ((const bf16*)(lds + (sx)))
#define VST(sx) ((int)(lds0 + 8192 + (sx)) + v_rd_base(lane))
  f32x16 pA0, pA1, pB0, pB1; float alA, alB; bf16x8 pa0, pa1, pa2, pa3;
  int s0 = 0, s1 = DA2_STG, s2 = 2 * DA2_STG;
  WAIT_BAR(0);
  DMA(1, DA2_STG);
  qkt64m(pA0, pA1, KST(0), qr, qm, kneg, r32, hi); MASK(pA0, pA1, 0); partialSM2(pA0, pA1, m_ref, qm, alA, true, hi);
  WAIT_BAR(2);
  DMA(2, 2 * DA2_STG);
  for (int j = 1; j + 1 < NT; j += 2) {
    SBAR(); qkt64m(pB0, pB1, KST(s1), qr, qm, kneg, r32, hi);
    finishSM(pA0, pA1, alA, l_reg, pa0, pa1, pa2, pa3); SBAR();
    pv_d0(o, VST(s0), pa0, pa1, pa2, pa3); MASK(pB0, pB1, j); partialSM2(pB0, pB1, m_ref, qm, alB, false, hi);
    WAIT_BAR(2);
    if (j + 2 < NT) DMA(j + 2, s0);
    RESC(alB);
    SBAR(); qkt64m(pA0, pA1, KST(s2), qr, qm, kneg, r32, hi);
    finishSM(pB0, pB1, alB, l_reg, pa0, pa1, pa2, pa3); SBAR();
    pv_d0(o, VST(s1), pa0, pa1, pa2, pa3); MASK(pA0, pA1, j + 1); partialSM2(pA0, pA1, m_ref, qm, alA, false, hi);
    WAIT_BAR(2);
    if (j + 3 < NT) DMA(j + 3, s1);
    RESC(alA);
    { const int t_ = s0; s0 = s2; s2 = s1; s1 = t_; }
  }
  SBAR(); qkt64m(pB0, pB1, KST(s1), qr, qm, kneg, r32, hi);
  finishSM(pA0, pA1, alA, l_reg, pa0, pa1, pa2, pa3); SBAR();
  pv_d0(o, VST(s0), pa0, pa1, pa2, pa3); MASK(pB0, pB1, NT - 1); partialSM2(pB0, pB1, m_ref, qm, alB, false, hi);
  WAIT_BAR(0);
  RESC(alB);
  finishSM(pB0, pB1, alB, l_reg, pa0, pa1, pa2, pa3); SBAR();
  pv_d0(o, VST(s1), pa0, pa1, pa2, pa3);
  if (hi == 0) li_l[r32] = l_reg; asm volatile("s_waitcnt lgkmcnt(0)" ::: "memory");
  float rli[16];
#pragma unroll
  for (int r = 0; r < 16; ++r) rli[r] = __builtin_amdgcn_rcpf(li_l[crow(r, hi)]);
  WAIT_BAR(0);
  bf16* stg = (bf16*)lds + wid * 4096;
#pragma unroll
  for (int r = 0; r < 16; ++r) { const int orow = crow(r, hi);
#pragma unroll
    for (int d0 = 0; d0 < 4; ++d0) stg[orow * 128 + d0 * 32 + r32] = __float2bfloat16(o[d0][r] * rli[r]); }
  asm volatile("s_waitcnt lgkmcnt(0)" ::: "memory");
#pragma unroll
  for (int i = 0; i < 8; ++i) { const int row = i * 4 + (lane >> 4), ch = lane & 15; const u32x4 v = *(const u32x4*)(stg + row * 128 + ch * 8);
    *(u32x4*)(Ob + (size_t)(wid * QBLK + row) * 2048 + ch * 8) = v; }
  asm volatile("s_waitcnt lgkmcnt(0)\n\ts_barrier" ::: "memory");
#undef DMA
#undef RESC
#undef MASK
#undef KST
#undef VST
}
#undef WAIT_BAR
struct DaUnit { int bqh; int qb; };
struct DaOrder {
  int vcu, G;
  __device__ __forceinline__ DaOrder(int vcu_, int G_) : vcu(vcu_), G(G_) {}
  __device__ __forceinline__ bool next(int i, DaUnit& u) const {
    if (G == 256) { if (i >= 8) return false; const int s = vcu & 7, ii = i & 3; u.bqh = (i >> 2) * 32 + (vcu >> 3); u.qb = (ii == 0) ? s : (ii == 1) ? 15 - s : (ii == 2) ? 16 + s : 31 - s; return true; }
    const int uu = vcu + i * G; if (uu >= 2048) return false; u.bqh = uu >> 5; u.qb = uu & 31; return true; }
};
template <class Sched> __device__ __forceinline__ void dattn_phase(char* lds, const bf16* QKV, bf16* O, const Sched& S) {
  DaUnit u;
  for (int i = 0; S.next(i, u); ++i) { const int b = u.bqh >> 4, qh = u.bqh & 15; const size_t rb = (size_t)b * 8192;
    dattn_unit2(QKV + (rb + u.qb * 256) * LDK + qh * 64, QKV + rb * LDK + 1024 + qh * 64, QKV + rb * LDK + 2048 + (qh >> 1) * 128, O + (rb + u.qb * 256) * 2048 + qh * 128, 4 * (u.qb + 1), lds); }
}
#undef KSWZ64
#undef KSWZ
#undef SBAR
}
#define GAS __attribute__((address_space(1)))
#define LAS __attribute__((address_space(3)))
typedef unsigned short bf16;
typedef unsigned v4u __attribute__((ext_vector_type(4)));
typedef float f32x4 __attribute__((ext_vector_type(4)));
typedef short bf16x8 __attribute__((ext_vector_type(8)));
typedef GAS unsigned gu32;
typedef GAS unsigned long long gu64;
#define RLX_AGENT __ATOMIC_RELAXED, __HIP_MEMORY_SCOPE_AGENT
#define LDS_WAIT() asm volatile("s_waitcnt lgkmcnt(0)" ::: "memory")
#define VM_WAIT() asm volatile("s_waitcnt vmcnt(0)" ::: "memory")
__device__ __forceinline__ unsigned long long rt() { return __builtin_amdgcn_s_memrealtime(); }
__device__ __forceinline__ unsigned f2bf(float f) { unsigned u = __builtin_bit_cast(unsigned, f); return (u + 0x7fffu + ((u >> 16) & 1u)) >> 16; }
__device__ __forceinline__ unsigned pk2(float lo, float hi) { return f2bf(lo) | (f2bf(hi) << 16); }
#define XB_TMO      128
#define XB_XCNT(j)  (256  + 64 * (j))
#define XB_XSUB(j)  (1280 + 64 * (j))
#define XB_XGEN(j)  (2304 + 64 * (j))
#define XB_TOP      3328
#define XB_TOPGEN   3392
#define XCD_BAR_WORDS 3456
#define XB_SPIN_CAP (1u << 18)

__device__ __forceinline__ unsigned xb_ld(unsigned* p)              { return __hip_atomic_load(p, __ATOMIC_RELAXED, __HIP_MEMORY_SCOPE_AGENT); }
__device__ __forceinline__ unsigned xb_add(unsigned* p, unsigned v) { return __hip_atomic_fetch_add(p, v, __ATOMIC_RELAXED, __HIP_MEMORY_SCOPE_AGENT); }
__device__ __forceinline__ unsigned xb_xcc_id() { return (unsigned)__builtin_amdgcn_s_getreg((3 << 11) | 20) & 0xFu; }
#define XB_SPIN(cond, bar) do { unsigned _sp = 0; while (cond) { __builtin_amdgcn_s_sleep(1); \
    if ((++_sp & 255u) == 0u) { if (xb_ld(&(bar)[XB_TMO])) break; if (_sp > XB_SPIN_CAP) { atomicAdd(&(bar)[XB_TMO], 1u); break; } } } } while (0)

struct XcdBarrier {
    unsigned* bar; unsigned x;
    volatile LAS unsigned* st;
};

__device__ __forceinline__ XcdBarrier xcd_barrier_post(unsigned* bar, volatile LAS unsigned* st) {
    XcdBarrier b; b.bar = bar; b.x = xb_xcc_id(); b.st = st;
    if (threadIdx.x == 0) (void)xb_add(&bar[XB_XCNT(b.x)], 1u);
    return b;
}
__device__ __forceinline__ void xcd_barrier_complete(unsigned* bar, unsigned x, unsigned& nloc, unsigned& nx) {
    const unsigned G = gridDim.x * gridDim.y * gridDim.z;
    unsigned sum, cnt, mine, sp = 0u;
    for (;;) {
        sum = 0u; cnt = 0u; mine = 0u;
#pragma unroll
        for (unsigned j = 0; j < 16; ++j) { const unsigned c = xb_ld(&bar[XB_XCNT(j)]); sum += c; cnt += (c > 0u) ? 1u : 0u; mine = (j == x) ? c : mine; }
        if (sum == G) break;
        __builtin_amdgcn_s_sleep(1);
        if ((++sp & 255u) == 0u) { if (xb_ld(&bar[XB_TMO])) break; if (sp > XB_SPIN_CAP) { atomicAdd(&bar[XB_TMO], 1u); break; } }
    }
    nloc = mine > 0u ? mine : 1u; nx = cnt > 0u ? cnt : 1u;
}

__device__ __forceinline__ void xcd_barrier(const XcdBarrier& b) {
    asm volatile("s_waitcnt vmcnt(0)" ::: "memory");
    __syncthreads();
    if (threadIdx.x == 0) {
        unsigned* bar = b.bar;
        __builtin_amdgcn_s_waitcnt(0);
        unsigned nloc = b.st[0], nx = b.st[1];
        if (nloc == 0u) { xcd_barrier_complete(bar, b.x, nloc, nx); b.st[0] = nloc; b.st[1] = nx; }
        const unsigned old = xb_add(&bar[XB_XSUB(b.x)], 1u);
        const unsigned gen = old / nloc;
        if (old + 1u == (gen + 1u) * nloc) {
            __builtin_amdgcn_fence(__ATOMIC_RELEASE, "agent");
            asm volatile("s_waitcnt vmcnt(0)" ::: "memory");
            const unsigned og = xb_add(&bar[XB_TOP], 1u);
            const unsigned tg = og / nx;
            if (og + 1u == (tg + 1u) * nx) xb_add(&bar[XB_TOPGEN], 1u);
            else XB_SPIN(xb_ld(&bar[XB_TOPGEN]) == tg, bar);
            __builtin_amdgcn_fence(__ATOMIC_ACQUIRE, "agent");
            xb_add(&bar[XB_XGEN(b.x)], 1u);
            asm volatile("s_waitcnt vmcnt(0)" ::: "memory");
        } else {
            XB_SPIN(xb_ld(&bar[XB_XGEN(b.x)]) == gen, bar);
            __builtin_amdgcn_fence(__ATOMIC_ACQUIRE, "agent");
            asm volatile("s_waitcnt vmcnt(0)" ::: "memory");
        }
    }
    __syncthreads();
}

constexpr int NWAVES = 8;
#ifndef GEMM_ALIGN
#define GEMM_ALIGN true
#endif
#ifndef MK_PER_PHASE
#define MK_PER_PHASE 0
#endif
constexpr int BATCH = 4, SEQ = 8192, DM = 1024, TOK = BATCH * SEQ;
constexpr int FF0 = 2816, NEXP = 8, FF1 = 3584;
constexpr int NQKV = 3072;
constexpr int MB_H = 8, MB_NB = 32, MB_L = 256;
constexpr int SLOTS = TOK + NEXP * 256;
constexpr float NORM_EPS = 1e-6f, SUBLN_EPS = 1e-5f;
constexpr float LAMBDA_INIT0 = 0.2f;
constexpr float LOG2E = 1.4426950408889634f;
constexpr int LIST_PER_BH = 256 * 496;
__host__ __device__ constexpr int list_off(int j) { return 256 * (31 * j - (j * (j - 1)) / 2); }

constexpr size_t MiB = 1u << 20;
constexpr size_t WS_CTL = 0, CTL_ZERO_BYTES = 3 * MiB;
constexpr size_t WS_CMAX13 = 2 * MiB;
constexpr size_t WS_CMAX2 = WS_CMAX13 + 256 * 1024;
constexpr size_t WS_SSTOT = WS_CMAX2 + 64 * 1024;
constexpr size_t WS_CM0 = WS_CMAX2 + 128 * 1024;
constexpr size_t WS_ROPE64 = 3 * MiB;
constexpr size_t WS_ROPE128 = WS_ROPE64 + 512 * 1024;
constexpr size_t WS_KMEAN = WS_ROPE128 + 1 * MiB;
constexpr size_t WS_TOK = 5 * MiB;
constexpr size_t WS_SLOT = 6 * MiB;
constexpr size_t WS_SA = 7 * MiB;
constexpr size_t WS_OWNML = 41 * MiB;
constexpr size_t WS_W0QKV = 8 * MiB, WS_W0O = 14 * MiB, WS_W013 = 16 * MiB, WS_W02 = 27 * MiB, WS_W1QKV = 33 * MiB, WS_W1O = 39 * MiB;
constexpr size_t B0 = 43 * MiB;
constexpr size_t WS_H = B0;
constexpr size_t WS_QKV = B0 + 64 * MiB;
constexpr size_t WS_OATT = B0 + 256 * MiB;
constexpr size_t WS_UD = B0 + 128 * MiB;
constexpr size_t WS_LIST = B0 + 256 * MiB;
constexpr size_t WS_PML = B0 + 272 * MiB;
constexpr size_t WS_PO = B0 + 280 * MiB;
constexpr size_t WS_WM13 = B0 + 64 * MiB;
constexpr size_t WS_WM2 = WS_WM13 + 56 * MiB;
constexpr size_t WS_AQ = WS_WM2 + 28 * MiB;
constexpr size_t WS_UM = B0 + 232 * MiB;
constexpr size_t WS_END = WS_PO + (size_t)TOK * MB_H * 3 * 128 * 2;
static_assert(WS_UM + (size_t)SLOTS * FF1 <= WS_END && WS_AQ + (size_t)TOK * DM <= WS_UM && WS_END <= 528 * MiB, "d_ws map");
constexpr int CW_TMO = 0, CW_CODE = 1, CW_DBG = 2;
constexpr int CW_MOECNT = 64;
constexpr int CW_MOBACNT = 256;
constexpr int CW_BAR = 4096;
constexpr size_t WS_RSS = 1 * MiB;
constexpr int RING_OFF = 0, RING_BYTES = 131072;
constexpr int LDSCTL_OFF = RING_BYTES, MISC_OFF = LDSCTL_OFF + 320;
constexpr int LDS_BYTES = 147456;

struct Args { const float* in[20]; float* out; unsigned char* ws; float inv64[8]; float inv128[16]; int ph_lo, ph_hi; };

__device__ __forceinline__ float wave_sum(float v) {
#pragma unroll
    for (int o = 1; o < 64; o <<= 1) v += __shfl_xor(v, o);
    return v;
}
template <int MAP> __device__ __forceinline__ int maprow(int n) {
    if (MAP == 1) { if (n >= 2048) return n; const int d = n & 63; if (d >= 16) return n; const int b = d >> 3, a = (d >> 2) & 1, c = d & 3; return (n & ~63) + 8 * a + 4 * b + c; }
    if (MAP == 2) { if (n >= 2048) return n; const int d = n & 127; if (d >= 32) return n; const int b = d >> 4, a = (d >> 2) & 3, c = d & 3; return (n & ~127) + 8 * a + 4 * b + c; }
    if (MAP == 3) return 256 * (n >> 7) + (n & 127);
    if (MAP == 4) return 256 * (n >> 7) + 128 + (n & 127);
    return n;
}
template <int MAP> __device__ __forceinline__ void transpose_item(const float* W, int K, int N, bf16* WT, LAS float* scr, int item, int lane, const float* gk = nullptr) {
    const int nblk = N / 32, kb = item / nblk, nb = item % nblk, k0 = 64 * kb, n0 = 32 * nb;
    const int kr = lane >> 3, nc = (lane & 7) * 4;
    f32x4 v[8];
#pragma unroll
    for (int i = 0; i < 8; ++i) v[i] = *(const GAS f32x4*)(W + (size_t)(k0 + i * 8 + kr) * N + n0 + nc);
    if (gk) {
#pragma unroll
        for (int i = 0; i < 8; ++i) v[i] = v[i] * gk[k0 + i * 8 + kr]; }
#pragma unroll
    for (int i = 0; i < 8; ++i) { LAS float* d = scr + (i * 8 + kr) * 33 + nc; d[0] = v[i].x; d[1] = v[i].y; d[2] = v[i].z; d[3] = v[i].w; }
    LDS_WAIT(); asm volatile("" ::: "memory");
    const int c = lane & 7;
#pragma unroll
    for (int j = 0; j < 4; ++j) { const int n = (lane >> 3) + 8 * j; const LAS float* s = scr + (8 * c) * 33 + n;
        v4u o; o.x = pk2(s[0 * 33], s[1 * 33]); o.y = pk2(s[2 * 33], s[3 * 33]); o.z = pk2(s[4 * 33], s[5 * 33]); o.w = pk2(s[6 * 33], s[7 * 33]);
        *(GAS v4u*)(WT + (size_t)maprow<MAP>(n0 + n) * K + k0 + 8 * c) = o; }
    LDS_WAIT(); asm volatile("" ::: "memory");
}

template <int MAP> __device__ __forceinline__ float wmax_strip(const float* W, int N, unsigned* cmax, int kb0, int nkb, int nb, int lane, const float* gk) {
    const int n0 = 32 * nb, kr = lane >> 3, nc = (lane & 7) * 4;
    f32x4 mx = (f32x4){0.f, 0.f, 0.f, 0.f}; float ss = 0.f;
    for (int kb = kb0; kb < kb0 + nkb; ++kb) { const int k0 = 64 * kb;
        f32x4 v[8];
#pragma unroll
        for (int i = 0; i < 8; ++i) v[i] = *(const GAS f32x4*)(W + (size_t)(k0 + i * 8 + kr) * N + n0 + nc);
        if (gk) {
#pragma unroll
            for (int i = 0; i < 8; ++i) v[i] = v[i] * gk[k0 + i * 8 + kr]; }
#pragma unroll
        for (int i = 0; i < 8; ++i) { mx.x = fmaxf(mx.x, fabsf(v[i].x)); mx.y = fmaxf(mx.y, fabsf(v[i].y)); mx.z = fmaxf(mx.z, fabsf(v[i].z)); mx.w = fmaxf(mx.w, fabsf(v[i].w));
            ss += (v[i].x * v[i].x + v[i].y * v[i].y) + (v[i].z * v[i].z + v[i].w * v[i].w); } }
#pragma unroll
    for (int o = 8; o < 64; o <<= 1) { mx.x = fmaxf(mx.x, __shfl_xor(mx.x, o)); mx.y = fmaxf(mx.y, __shfl_xor(mx.y, o)); mx.z = fmaxf(mx.z, __shfl_xor(mx.z, o)); mx.w = fmaxf(mx.w, __shfl_xor(mx.w, o)); }
    if (lane < 8) {
        __hip_atomic_fetch_max(cmax + maprow<MAP>(n0 + nc + 0), __float_as_uint(mx.x), __ATOMIC_RELAXED, __HIP_MEMORY_SCOPE_AGENT);
        __hip_atomic_fetch_max(cmax + maprow<MAP>(n0 + nc + 1), __float_as_uint(mx.y), __ATOMIC_RELAXED, __HIP_MEMORY_SCOPE_AGENT);
        __hip_atomic_fetch_max(cmax + maprow<MAP>(n0 + nc + 2), __float_as_uint(mx.z), __ATOMIC_RELAXED, __HIP_MEMORY_SCOPE_AGENT);
        __hip_atomic_fetch_max(cmax + maprow<MAP>(n0 + nc + 3), __float_as_uint(mx.w), __ATOMIC_RELAXED, __HIP_MEMORY_SCOPE_AGENT); }
    return ss;
}
template <int MAP> __device__ __forceinline__ void transpose_item_q(const float* W, int K, int N, signed char* WT, const unsigned* cmax, LAS float* scr, int item, int lane, const float* gk) {
    const int nblk = N / 32, kb = item / nblk, nb = item % nblk, k0 = 64 * kb, n0 = 32 * nb;
    const int kr = lane >> 3, nc = (lane & 7) * 4;
    f32x4 v[8];
#pragma unroll
    for (int i = 0; i < 8; ++i) v[i] = *(const GAS f32x4*)(W + (size_t)(k0 + i * 8 + kr) * N + n0 + nc);
    if (gk) {
#pragma unroll
        for (int i = 0; i < 8; ++i) v[i] = v[i] * gk[k0 + i * 8 + kr]; }
#pragma unroll
    for (int i = 0; i < 8; ++i) { LAS float* d = scr + (i * 8 + kr) * 33 + nc; d[0] = v[i].x; d[1] = v[i].y; d[2] = v[i].z; d[3] = v[i].w; }
    LDS_WAIT(); asm volatile("" ::: "memory");
    const int half = lane >> 5, n = lane & 31, row = maprow<MAP>(n0 + n);
    const float cm = __uint_as_float(cmax[row]); const float inv = cm > 0.f ? 127.0f / cm : 0.f;
    const LAS float* s = scr + (32 * half) * 33 + n;
    unsigned w[8];
#pragma unroll
    for (int q4 = 0; q4 < 8; ++q4) { unsigned pk = 0;
#pragma unroll
        for (int b = 0; b < 4; ++b) { const int q = (int)__builtin_rintf(s[(4 * q4 + b) * 33] * inv); pk |= (unsigned)(q & 255) << (8 * b); }
        w[q4] = pk; }
    GAS v4u* dst = (GAS v4u*)(WT + (size_t)row * K + k0 + 32 * half);
    dst[0] = (v4u){w[0], w[1], w[2], w[3]}; dst[1] = (v4u){w[4], w[5], w[6], w[7]};
    LDS_WAIT(); asm volatile("" ::: "memory");
}
__device__ __forceinline__ void rms_row(const float* xrow, const f32x4 (&g)[4], f32x4 (&v)[4], int lane) {
    const GAS f32x4* xr = (const GAS f32x4*)xrow + lane; float s = 0.f;
#pragma unroll
    for (int j = 0; j < 4; ++j) { v[j] = xr[64 * j]; s += (v[j].x * v[j].x + v[j].y * v[j].y) + (v[j].z * v[j].z + v[j].w * v[j].w); }
    const float rstd = 1.f / sqrtf(wave_sum(s) * (1.f / DM) + NORM_EPS);
#pragma unroll
    for (int j = 0; j < 4; ++j) v[j] = v[j] * rstd * g[j];
}
__device__ __forceinline__ void store_row_bf16(bf16* orow, const f32x4 (&v)[4], int lane) {
    GAS unsigned long long* o8 = (GAS unsigned long long*)orow + lane;
#pragma unroll
    for (int j = 0; j < 4; ++j) o8[64 * j] = (unsigned long long)pk2(v[j].x, v[j].y) | ((unsigned long long)pk2(v[j].z, v[j].w) << 32);
}
__device__ __forceinline__ void load_gain(const float* g, f32x4 (&gv)[4], int lane) {
#pragma unroll
    for (int j = 0; j < 4; ++j) gv[j] = *((const f32x4*)g + lane + 64 * j);
}
__device__ __forceinline__ void rmsnorm_phase(const float* src, const float* gain, bf16* dst, int gw, int ngw, int lane) {
    f32x4 gv[4]; load_gain(gain, gv, lane);
    for (int m = gw; m < TOK; m += ngw) { f32x4 v[4]; rms_row(src + (size_t)m * DM, gv, v, lane); store_row_bf16(dst + (size_t)m * DM, v, lane); }
}
__device__ __forceinline__ float bf2f(unsigned short b) { return __uint_as_float((unsigned)b << 16); }


typedef __attribute__((address_space(4))) const unsigned char* kaptr_t;
__device__ __forceinline__ kaptr_t ka_get() { kaptr_t p = (kaptr_t)__builtin_amdgcn_kernarg_segment_ptr(); asm volatile("" : "+s"(p)); return p; }
#define KA_IN(k) (*(const float* const __attribute__((address_space(4)))*)(ka + 8 * (k)))
#define PH_PTRS kaptr_t ka = ka_get(); unsigned char* const ws = *(unsigned char* const __attribute__((address_space(4)))*)(ka + 168); float* const out = *(float* const __attribute__((address_space(4)))*)(ka + 160); gu32* const ctl = (gu32*)(ws + WS_CTL); (void)out; (void)ctl
#define IN_X KA_IN(0)
#define norm_mix KA_IN(1)
#define norm_ffn KA_IN(2)
#define final_norm KA_IN(3)
#define da_wqkv KA_IN(4)
#define da_wo KA_IN(5)
#define da_lq1 KA_IN(6)
#define da_lk1 KA_IN(7)
#define da_lq2 KA_IN(8)
#define da_lk2 KA_IN(9)
#define da_subln KA_IN(10)
#define mb_wqkv KA_IN(11)
#define mb_wo KA_IN(12)
#define ffn_w1 KA_IN(13)
#define ffn_w3 KA_IN(14)
#define ffn_w2 KA_IN(15)
#define moe_router KA_IN(16)
#define moe_w1 KA_IN(17)
#define moe_w3 KA_IN(18)
#define moe_w2 KA_IN(19)
#define rope64 ((float*)(ws + WS_ROPE64))
#define rope128 ((float*)(ws + WS_ROPE128))
#define kmean ((float*)(ws + WS_KMEAN))
#define tok_e ((int*)(ws + WS_TOK))
#define tok_pos (tok_e + 2 * TOK)
#define tok_gate ((float*)(tok_pos + 2 * TOK))
#define wg_base ((int*)(ws + WS_TOK + 800 * 1024))
#define slot_tok ((int*)(ws + WS_SLOT))
#define slot_gate ((float*)(slot_tok + 2 * SLOTS))
#define ownml ((float*)(ws + WS_OWNML))
#define W0qkv ((bf16*)(ws + WS_W0QKV))
#define W0o ((bf16*)(ws + WS_W0O))
#define W013 ((bf16*)(ws + WS_W013))
#define W02 ((bf16*)(ws + WS_W02))
#define W1qkv ((bf16*)(ws + WS_W1QKV))
#define W1o ((bf16*)(ws + WS_W1O))
#define Rb ((bf16*)(ws + WS_H))
#define OB ((bf16*)out)
#define RSS(j) ((unsigned long long*)(ws + WS_RSS) + (size_t)(j) * TOK)
#define QKV ((bf16*)(ws + WS_QKV))
#define OATT ((bf16*)(ws + WS_OATT))
#define UD ((bf16*)(ws + WS_UD))
#define lists ((int*)(ws + WS_LIST))
#define pml ((float*)(ws + WS_PML))
#define PO ((bf16*)(ws + WS_PO))
#define WM13 ((signed char*)(ws + WS_WM13))
#define WM2 ((signed char*)(ws + WS_WM2))
#define AQ ((signed char*)(ws + WS_AQ))
#define UM ((signed char*)(ws + WS_UM))
#define CMAX13 ((unsigned*)(ws + WS_CMAX13))
#define CMAX2 ((unsigned*)(ws + WS_CMAX2))
#define SSTOT ((unsigned long long*)(ws + WS_SSTOT))
#define SA ((float*)(ws + WS_SA))
#define SA1 ((float*)(ws + WS_SA + 128 * 1024))
#define CM0_13 ((unsigned*)(ws + WS_CM0))
#define CM0_2 ((unsigned*)(ws + WS_CM0 + 32 * 1024))
#define SSTOT0 ((unsigned long long*)(ws + WS_CM0 + 48 * 1024))
#define W013q ((signed char*)(ws + WS_W013))
#define W02q ((signed char*)(ws + WS_W02))
#define A1Q ((signed char*)(ws + WS_QKV))
#define UDQ ((signed char*)(ws + WS_UD))
__global__ void __launch_bounds__(NWAVES * 64, 2) mk_fwd(Args args) {
    extern __shared__ __attribute__((aligned(16))) unsigned char lds[];
    LAS unsigned char* L = (LAS unsigned char*)lds;
    volatile LAS unsigned* MISC = (volatile LAS unsigned*)(L + MISC_OFF);
    const int wave = __builtin_amdgcn_readfirstlane((int)threadIdx.x >> 6);
#define tid ((int)threadIdx.x)
#define lane ((int)(threadIdx.x & 63u))
    const int G = gridDim.x; const int bx = blockIdx.x; const int vcu = (G % 8 == 0) ? (bx % 8) * (G / 8) + bx / 8 : bx;
    const int gw = vcu * NWAVES + wave, NGW = G * NWAVES;
    gu32* ctl0 = (gu32*)(args.ws + WS_CTL);
    for (int u = tid; u < (LDS_BYTES - LDSCTL_OFF) / 4; u += NWAVES * 64) ((LAS unsigned*)(L + LDSCTL_OFF))[u] = 0u;
    __syncthreads();
    XcdBarrier bar; bar.bar = (unsigned*)(ctl0 + CW_BAR); bar.x = 0; bar.st = nullptr;
    if (!MK_PER_PHASE) bar = xcd_barrier_post((unsigned*)(ctl0 + CW_BAR), MISC + 8);
#define GRID_BAR() do { if (!MK_PER_PHASE) xcd_barrier(bar); } while (0)
    const int lo = args.ph_lo, hi_ph = args.ph_hi;
#ifndef PH_MASK
#define PH_MASK 0xFFFFFFFFu
#endif
#define IN(k) (((PH_MASK >> (k)) & 1u) && lo <= (k) && (k) < hi_ph)
#define SEAM(k) do { if (IN((k) + 1)) GRID_BAR(); } while (0)
#ifndef DUP_MASK
#define DUP_MASK 0u
#endif
#define NREP(k) ((((DUP_MASK) >> (k)) & 1u) ? 2 : 1)

    if (IN(0)) { PH_PTRS; for (int rep_ = 0; rep_ < NREP(0); ++rep_) {
        LAS float* scr = (LAS float*)(L + RING_OFF + wave * 16384);
        constexpr int I_QKV = (DM / 64) * (NQKV / 32), I_O = (DM / 64) * (DM / 32);
        constexpr int NITEMS = 2 * I_QKV + 2 * I_O;
        for (int it = gw; it < NITEMS; it += NGW) {
            int r = it;
            if (r < I_QKV) { transpose_item<1>(da_wqkv, DM, NQKV, W0qkv, scr, r, lane, norm_mix); continue; } r -= I_QKV;
            if (r < I_QKV) { transpose_item<2>(mb_wqkv, DM, NQKV, W1qkv, scr, r, lane, norm_mix + DM); continue; } r -= I_QKV;
            if (r < I_O) { transpose_item<0>(da_wo, DM, DM, W0o, scr, r, lane); continue; } r -= I_O;
            transpose_item<0>(mb_wo, DM, DM, W1o, scr, r, lane);
        }
        {
            constexpr int S_1 = (DM / 512) * (FF0 / 32), S_2 = 6 * (DM / 32);
            float ssA = 0.f, ssB = 0.f;
            for (int it = NGW - 1 - gw; it < 2 * S_1 + S_2; it += NGW) {
                int r = it;
                if (r < S_1) { ssA += wmax_strip<3>(ffn_w1, FF0, CM0_13, 8 * (r / (FF0 / 32)), 8, r % (FF0 / 32), lane, norm_ffn); continue; } r -= S_1;
                if (r < S_1) { ssB += wmax_strip<4>(ffn_w3, FF0, CM0_13, 8 * (r / (FF0 / 32)), 8, r % (FF0 / 32), lane, norm_ffn); continue; } r -= S_1;
                { const int st = r / (DM / 32); (void)wmax_strip<0>(ffn_w2, DM, CM0_2, 8 * st, st == 5 ? 4 : 8, r % (DM / 32), lane, nullptr); }
            }
            ssA = wave_sum(ssA); ssB = wave_sum(ssB);
            if (lane == 0 && (ssA != 0.f || ssB != 0.f)) { __hip_atomic_fetch_add(SSTOT0, (unsigned long long)(ssA * 16777216.0f), __ATOMIC_RELAXED, __HIP_MEMORY_SCOPE_AGENT); __hip_atomic_fetch_add(SSTOT0 + 1, (unsigned long long)(ssB * 16777216.0f), __ATOMIC_RELAXED, __HIP_MEMORY_SCOPE_AGENT); }
        }
        {
            const int gt = (vcu * NWAVES + wave) * 64 + lane, NT_ = G * NWAVES * 64;
            for (int e = gt; e < SEQ * 8; e += NT_) { const int pos = e >> 3, i = e & 7; const float ang = (float)pos * (*(const float __attribute__((address_space(4)))*)(ka + 176 + 4 * i)); rope64[e] = cosf(ang); rope64[SEQ * 8 + e] = sinf(ang); }
            for (int e = gt; e < SEQ * 16; e += NT_) { const int pos = e >> 4, i = e & 15; const float ang = (float)pos * (*(const float __attribute__((address_space(4)))*)(ka + 208 + 4 * i)); rope128[e] = cosf(ang); rope128[SEQ * 16 + e] = sinf(ang); }
        }
        for (int m = gw; m < TOK; m += NGW) {
            const GAS f32x4* xr = (const GAS f32x4*)(IN_X + (size_t)m * DM) + lane; f32x4 v[4]; float s = 0.f;
#pragma unroll
            for (int j = 0; j < 4; ++j) { v[j] = xr[64 * j]; s += (v[j].x * v[j].x + v[j].y * v[j].y) + (v[j].z * v[j].z + v[j].w * v[j].w); }
            store_row_bf16(Rb + (size_t)m * DM, v, lane); s = wave_sum(s); if (lane == 0) RSS(0)[m] = (unsigned long long)(s * 16777216.0f); }
        } SEAM(0);
    }
    if (IN(1)) { PH_PTRS; for (int rep_ = 0; rep_ < NREP(1); ++rep_) {
        pg8::ABDense ab{Rb, W0qkv, DM}; pg8::TileOrder S; S.init(TOK / 256, NQKV / 256, G, bx);
        pg8::EpiQKV<64> E{QKV, NQKV, rope64, rope64 + SEQ * 8, 0.125f * LOG2E, RSS(0)};
        pg8::gemm_phase<pg8::EpiQKV<64>, pg8::ABDense, GEMM_ALIGN>(L + RING_OFF, ab, S, E);
        } SEAM(1);
    }
    if (IN(2)) { PH_PTRS; for (int rep_ = 0; rep_ < NREP(2); ++rep_) {
        const moba::DaOrder AS(vcu, G);
        moba::dattn_phase<moba::DaOrder>((char*)lds + RING_OFF, (const moba::bf16*)QKV, (moba::bf16*)OATT, AS);
        } SEAM(2);
    }
    if (IN(3)) { PH_PTRS; for (int rep_ = 0; rep_ < NREP(3); ++rep_) {
        float lam;
        { const float a = wave_sum(da_lq1[lane] * da_lk1[lane]), b = wave_sum(da_lq2[lane] * da_lk2[lane]); lam = expf(a) - expf(b) + LAMBDA_INIT0; }
        const int hh = lane >> 3, dd = (lane & 7) * 16;
        float gsub[16];
#pragma unroll
        for (int k = 0; k < 16; ++k) gsub[k] = da_subln[dd + k] * (1.f - LAMBDA_INIT0);
        for (int m0 = gw; m0 < TOK; m0 += 2 * NGW) {
            v4u A0[2], A1[2], B0[2], B1[2];
#pragma unroll
            for (int u = 0; u < 2; ++u) { const int m = (m0 + u * NGW < TOK) ? m0 + u * NGW : m0;
                const bf16* o1 = OATT + (size_t)m * 2048 + (2 * hh) * 128 + dd; const bf16* o2 = o1 + 128;
                A0[u] = *(const GAS v4u*)o1; A1[u] = *(const GAS v4u*)(o1 + 8); B0[u] = *(const GAS v4u*)o2; B1[u] = *(const GAS v4u*)(o2 + 8); }
#pragma unroll
            for (int u = 0; u < 2; ++u) { const int m = m0 + u * NGW; if (m < TOK) {
                const v4u a0 = A0[u], a1 = A1[u], b0 = B0[u], b1 = B1[u];
                float d[16]; float ss = 0.f;
#pragma unroll
                for (int k = 0; k < 4; ++k) {
                    const unsigned ua = a0[k], ub = b0[k], uc = a1[k], ud = b1[k];
                    d[2 * k] = __uint_as_float(ua << 16) - lam * __uint_as_float(ub << 16); d[2 * k + 1] = __uint_as_float(ua & 0xffff0000u) - lam * __uint_as_float(ub & 0xffff0000u);
                    d[8 + 2 * k] = __uint_as_float(uc << 16) - lam * __uint_as_float(ud << 16); d[8 + 2 * k + 1] = __uint_as_float(uc & 0xffff0000u) - lam * __uint_as_float(ud & 0xffff0000u); }
#pragma unroll
                for (int k = 0; k < 16; ++k) ss += d[k] * d[k];
                ss += __shfl_xor(ss, 1); ss += __shfl_xor(ss, 2); ss += __shfl_xor(ss, 4);
                const float rstd = 1.f / sqrtf(ss * (1.f / 128.f) + SUBLN_EPS);
                v4u w0, w1;
#pragma unroll
                for (int k = 0; k < 4; ++k) { w0[k] = pk2(d[2 * k] * rstd * gsub[2 * k], d[2 * k + 1] * rstd * gsub[2 * k + 1]); w1[k] = pk2(d[8 + 2 * k] * rstd * gsub[8 + 2 * k], d[8 + 2 * k + 1] * rstd * gsub[8 + 2 * k + 1]); }
                bf16* od = OB + (size_t)m * DM + hh * 128 + dd;
                *(GAS v4u*)od = w0; *(GAS v4u*)(od + 8) = w1; } }
        }
        {
            LAS float* scr = (LAS float*)(L + RING_OFF + wave * 16384);
            constexpr int I_13 = (DM / 64) * (FF0 / 32), I_2 = (FF0 / 64) * (DM / 32);
            for (int it = gw; it < 2 * I_13 + I_2; it += NGW) {
                int r = it;
                if (r < I_13) { transpose_item_q<3>(ffn_w1, DM, FF0, W013q, CM0_13, scr, r, lane, norm_ffn); continue; } r -= I_13;
                if (r < I_13) { transpose_item_q<4>(ffn_w3, DM, FF0, W013q, CM0_13, scr, r, lane, norm_ffn); continue; } r -= I_13;
                transpose_item_q<0>(ffn_w2, FF0, DM, W02q, CM0_2, scr, r, lane, nullptr);
            }
        }
        } SEAM(3);
    }
    if (IN(4)) { PH_PTRS; for (int rep_ = 0; rep_ < NREP(4); ++rep_) {
        pg8::ABDense ab{OB, W0o, DM}; pg8::TileOrder S; S.init(TOK / 256, DM / 256, G, bx);
        pg8::EpiResB E{Rb, Rb, DM, nullptr, RSS(1)};
        pg8::gemm_phase<pg8::EpiResB, pg8::ABDense, GEMM_ALIGN>(L + RING_OFF, ab, S, E);
        } SEAM(4);
    }
    if (IN(5)) { PH_PTRS;
        for (int m0 = gw; m0 < TOK; m0 += 4 * NGW) {
            unsigned long long w[4][4];
#pragma unroll
            for (int u = 0; u < 4; ++u) { const int m = (m0 + u * NGW < TOK) ? m0 + u * NGW : m0; const GAS unsigned long long* r8 = (const GAS unsigned long long*)(Rb + (size_t)m * DM) + lane;
#pragma unroll
                for (int j = 0; j < 4; ++j) w[u][j] = r8[64 * j]; }
#pragma unroll
            for (int u = 0; u < 4; ++u) { const int m = m0 + u * NGW; if (m < TOK) {
                f32x4 v[4]; float mx = 0.f;
#pragma unroll
                for (int j = 0; j < 4; ++j) { const unsigned lo32 = (unsigned)w[u][j], hi32 = (unsigned)(w[u][j] >> 32);
                    v[j].x = __uint_as_float(lo32 << 16); v[j].y = __uint_as_float(lo32 & 0xffff0000u); v[j].z = __uint_as_float(hi32 << 16); v[j].w = __uint_as_float(hi32 & 0xffff0000u);
                    mx = fmaxf(fmaxf(mx, fmaxf(fabsf(v[j].x), fabsf(v[j].y))), fmaxf(fabsf(v[j].z), fabsf(v[j].w))); }
#pragma unroll
                for (int o = 1; o < 64; o <<= 1) mx = fmaxf(mx, __shfl_xor(mx, o));
                const float inv = mx > 0.f ? 127.0f / mx : 0.f;
                GAS unsigned* aq = (GAS unsigned*)(A1Q + (size_t)m * DM) + lane;
#pragma unroll
                for (int j = 0; j < 4; ++j) { const int q0 = (int)__builtin_rintf(v[j].x * inv), q1 = (int)__builtin_rintf(v[j].y * inv), q2 = (int)__builtin_rintf(v[j].z * inv), q3 = (int)__builtin_rintf(v[j].w * inv);
                    aq[64 * j] = (unsigned)(q0 & 255) | ((unsigned)(q1 & 255) << 8) | ((unsigned)(q2 & 255) << 16) | ((unsigned)(q3 & 255) << 24); }
                if (lane == 0) SA1[m] = mx * (1.f / sqrtf((float)RSS(1)[m] * (5.9604644775390625e-8f / DM) + NORM_EPS)) * (1.0f / 127.0f); } }
        }
        SEAM(5);
    }
    if (IN(6)) { PH_PTRS; for (int rep_ = 0; rep_ < NREP(6); ++rep_) {
        const float su0 = 8.0f * sqrtf(((float)SSTOT0[0] * (5.9604644775390625e-8f / FF0)) * ((float)SSTOT0[1] * (5.9604644775390625e-8f / FF0)));
        pg8::ABDense ab{(const pg8::bf16_t*)A1Q, (const pg8::bf16_t*)W013q, DM / 2}; pg8::TileOrder S; S.init(TOK / 256, (2 * FF0) / 256, G, bx);
        pg8::EpiSwiGLUQ E{UDQ, FF0, SA1, CM0_13, nullptr, nullptr, 127.0f / su0};
        pg8::gemm_phase<pg8::EpiSwiGLUQ, pg8::ABDense, GEMM_ALIGN>(L + RING_OFF, ab, S, E);
        } SEAM(6);
    }
    if (IN(7)) { PH_PTRS; for (int rep_ = 0; rep_ < NREP(7); ++rep_) {
        const float su0 = 8.0f * sqrtf(((float)SSTOT0[0] * (5.9604644775390625e-8f / FF0)) * ((float)SSTOT0[1] * (5.9604644775390625e-8f / FF0)));
        pg8::ABDense ab{(const pg8::bf16_t*)UDQ, (const pg8::bf16_t*)W02q, FF0 / 2}; pg8::TileOrder S; S.init(TOK / 256, DM / 256, G, bx);
        pg8::EpiResBQ E{Rb, Rb, DM, nullptr, nullptr, CM0_2, nullptr, su0 * (1.0f / 127.0f), RSS(2)};
        pg8::gemm_phase<pg8::EpiResBQ, pg8::ABDense, GEMM_ALIGN>(L + RING_OFF, ab, S, E);
        } SEAM(7);
    }
    if (IN(9)) { PH_PTRS; for (int rep_ = 0; rep_ < NREP(9); ++rep_) {
        pg8::ABDense ab{Rb, W1qkv, DM}; pg8::TileOrder S; S.init(TOK / 256, NQKV / 256, G, bx);
        pg8::EpiQKV<128> E{QKV, NQKV, rope128, rope128 + SEQ * 16, 0.08838834764831845f * LOG2E, RSS(2)};
        pg8::gemm_phase<pg8::EpiQKV<128>, pg8::ABDense, GEMM_ALIGN>(L + RING_OFF, ab, S, E);
        } SEAM(9);
    }
    if (IN(10)) { PH_PTRS; for (int rep_ = 0; rep_ < NREP(10); ++rep_) {
        LAS float* red = (LAS float*)(L + RING_OFF);
        for (int u = vcu; u < BATCH * MB_H * MB_NB; u += G) {
            const int b = u >> 8, h = (u >> 5) & 7, j = u & 31;
            const int dch = tid & 15, kg = tid >> 4;
            const bf16* kp = QKV + (size_t)(b * SEQ + j * MB_L + kg * 8) * NQKV + 1024 + h * 128 + dch * 8;
            float s[8] = {0.f, 0.f, 0.f, 0.f, 0.f, 0.f, 0.f, 0.f};
#pragma unroll
            for (int k = 0; k < 8; ++k) { const v4u v = *(const GAS v4u*)(kp + (size_t)k * NQKV);
#pragma unroll
                for (int q = 0; q < 4; ++q) { s[2 * q] += __uint_as_float(v[q] << 16); s[2 * q + 1] += __uint_as_float(v[q] & 0xffff0000u); } }
#pragma unroll
            for (int q = 0; q < 8; ++q) red[kg * 128 + dch * 8 + q] = s[q];
            __syncthreads();
            if (tid < 128) { float a = 0.f;
#pragma unroll 8
                for (int k = 0; k < 32; ++k) a += red[k * 128 + tid];
                kmean[(size_t)u * 128 + tid] = a * (1.f / 256.f); }
            __syncthreads();
        }
        } SEAM(10);
    }
    if (IN(11)) { PH_PTRS; for (int rep_ = 0; rep_ < NREP(11); ++rep_) {
        LAS float* km = (LAS float*)(L + RING_OFF);
        LAS float* mv = (LAS float*)(L + RING_OFF + 16384);
        LAS int* mi = (LAS int*)(L + RING_OFF + 16384 + 3072);
        LAS int* lcnt = (LAS int*)(L + RING_OFF + 24576);
        for (int u = vcu; u < BATCH * MB_H * (MB_NB - 1); u += G) {
            const int bh = u / 31, o = 1 + u % 31, b = bh >> 3, h = bh & 7;
            for (int e = tid; e < 32 * 128; e += 512) km[e] = kmean[(size_t)bh * 4096 + e];
            if (tid < 32) lcnt[tid] = 0;
            __syncthreads();
            const int ql = tid & 255, half = tid >> 8; const int s = o * 256 + ql;
            const bf16* qp = QKV + (size_t)(b * SEQ + s) * NQKV + h * 128;
            float qf[128];
#pragma unroll
            for (int c = 0; c < 16; ++c) { const v4u v = *(const GAS v4u*)(qp + c * 8);
#pragma unroll
                for (int q = 0; q < 4; ++q) { qf[c * 8 + 2 * q] = __uint_as_float(v[q] << 16); qf[c * 8 + 2 * q + 1] = __uint_as_float(v[q] & 0xffff0000u); } }
            float v0 = -INFINITY, v1 = -INFINITY, v2 = -INFINITY; int i0 = -1, i1 = -1, i2 = -1;
            for (int jj = 0; jj < 16; ++jj) { const int j = half * 16 + jj;
                if (j < o) { float g = 0.f; const LAS f32x4* kr = (const LAS f32x4*)(km + j * 128);
#pragma unroll
                    for (int c = 0; c < 32; ++c) { const f32x4 kv = kr[c]; g += qf[4 * c] * kv.x + qf[4 * c + 1] * kv.y + qf[4 * c + 2] * kv.z + qf[4 * c + 3] * kv.w; }
                    if (g > v0) { v2 = v1; i2 = i1; v1 = v0; i1 = i0; v0 = g; i0 = j; } else if (g > v1) { v2 = v1; i2 = i1; v1 = g; i1 = j; } else if (g > v2) { v2 = g; i2 = j; } } }
            if (half == 1) { mv[ql * 3] = v0; mv[ql * 3 + 1] = v1; mv[ql * 3 + 2] = v2; mi[ql * 3] = i0; mi[ql * 3 + 1] = i1; mi[ql * 3 + 2] = i2; }
            __syncthreads();
            int lp0 = 0, lp1 = 0, lp2 = 0;
            if (half == 0) {
#pragma unroll
                for (int k = 0; k < 3; ++k) { const float g = mv[ql * 3 + k]; const int j = mi[ql * 3 + k];
                    if (j >= 0) { if (g > v0) { v2 = v1; i2 = i1; v1 = v0; i1 = i0; v0 = g; i0 = j; } else if (g > v1) { v2 = v1; i2 = i1; v1 = g; i1 = j; } else if (g > v2) { v2 = g; i2 = j; } } }
                if (i0 >= 0) lp0 = __hip_atomic_fetch_add(&lcnt[i0], 1, __ATOMIC_RELAXED, __HIP_MEMORY_SCOPE_WORKGROUP);
                if (i1 >= 0) lp1 = __hip_atomic_fetch_add(&lcnt[i1], 1, __ATOMIC_RELAXED, __HIP_MEMORY_SCOPE_WORKGROUP);
                if (i2 >= 0) lp2 = __hip_atomic_fetch_add(&lcnt[i2], 1, __ATOMIC_RELAXED, __HIP_MEMORY_SCOPE_WORKGROUP);
            }
            __syncthreads();
            if (tid < 32 && rep_ == 0) { const int n = lcnt[tid]; lcnt[32 + tid] = n ? (int)__hip_atomic_fetch_add(ctl + CW_MOBACNT + bh * 32 + tid, (unsigned)n, RLX_AGENT) : 0; }
            __syncthreads();
            if (half == 0 && rep_ == 0) { int* lb = lists + (size_t)bh * LIST_PER_BH;
                if (i0 >= 0) lb[list_off(i0) + lcnt[32 + i0] + lp0] = s;
                if (i1 >= 0) lb[list_off(i1) + lcnt[32 + i1] + lp1] = s | (1 << 16);
                if (i2 >= 0) lb[list_off(i2) + lcnt[32 + i2] + lp2] = s | (2 << 16); }
            __syncthreads();
        }
        } SEAM(11);
    }
    if (IN(12)) { PH_PTRS; for (int rep_ = 0; rep_ < NREP(12); ++rep_) {
        LAS int* pre = (LAS int*)(L + 102400);
        { const unsigned c0 = __hip_atomic_load(ctl + CW_MOBACNT + tid, RLX_AGENT), c1 = __hip_atomic_load(ctl + CW_MOBACNT + 512 + tid, RLX_AGENT);
          pre[tid] = (int)((c0 + 255u) >> 8); pre[512 + tid] = (int)((c1 + 255u) >> 8); }
        __syncthreads();
        if (tid == 0) { int a = 0; for (int k = 0; k < 1024; ++k) { const int n = pre[k]; pre[k] = a; a += n; } pre[1024] = a; }
        __syncthreads();
        const int nlist = pre[1024], ntot = 1024 + nlist;
        const int wl = wave * 32 + (lane & 31);
        for (int u = vcu; u < ntot; u += G) {
            const bool own = u < 1024;
            int b, h, kb, s, dst, mli, ostride; moba::bf16* obase; float* mlp;
            if (own) {
                b = u >> 8; h = (u >> 5) & 7; kb = u & 31; s = kb * 256 + wl; dst = b * SEQ + s; mli = (b * 8 + h) * SEQ + s; ostride = DM; obase = (moba::bf16*)OB + h * 128; mlp = ownml;
            } else {
                const int lu = u - 1024; int loI = 0, hiI = 1024;
                while (hiI - loI > 1) { const int mid = (loI + hiI) >> 1; if (pre[mid] <= lu) loI = mid; else hiI = mid; }
                const int bhj = loI, chunk = lu - pre[bhj], bh = bhj >> 5; kb = bhj & 31; b = bh >> 3; h = bh & 7;
                const int cnt = (int)__hip_atomic_load(ctl + CW_MOBACNT + bhj, RLX_AGENT);
                const int ei = chunk * 256 + wl; const bool valid = ei < cnt;
                const int ent = valid ? lists[(size_t)bh * LIST_PER_BH + list_off(kb) + ei] : 0;
                s = ent & 0xffff; mli = (bh * SEQ + s) * 3 + (ent >> 16); dst = valid ? mli : -1; ostride = 128; obase = (moba::bf16*)PO; mlp = pml;
            }
            const moba::bf16* qrow = (const moba::bf16*)QKV + ((size_t)b * SEQ + s) * NQKV + h * 128;
            const moba::bf16* Kh = (const moba::bf16*)QKV + ((size_t)b * SEQ + kb * 256) * NQKV + 1024 + h * 128;
            moba::moba_unit(own, qrow, Kh, Kh + 1024, obase, ostride, dst, mlp, mli, wl, (char*)lds);
        }
        } SEAM(12);
    }
    if (IN(13)) { PH_PTRS; for (int rep_ = 0; rep_ < NREP(13); ++rep_) {
        const int hh = lane >> 3, dd = (lane & 7) * 16;
        for (int m = gw; m < TOK; m += NGW) {
            const int b = m >> 13, s = m & 8191, nv = (s >> 8) < 3 ? (s >> 8) : 3; const int qi = (b * 8 + hh) * SEQ + s;
            float mm[4], ll[4]; mm[0] = ownml[2 * (size_t)qi]; ll[0] = ownml[2 * (size_t)qi + 1]; float M = mm[0];
#pragma unroll
            for (int r = 0; r < 3; ++r) { if (r < nv) { mm[1 + r] = pml[2 * ((size_t)qi * 3 + r)]; ll[1 + r] = pml[2 * ((size_t)qi * 3 + r) + 1]; M = fmaxf(M, mm[1 + r]); } else { mm[1 + r] = -1e30f; ll[1 + r] = 0.f; } }
            float w[4], wsum = 0.f;
#pragma unroll
            for (int r = 0; r < 4; ++r) { w[r] = ll[r] * __builtin_amdgcn_exp2f(mm[r] - M); wsum += w[r]; }
            const float inv = 1.f / wsum;
            float acc16[16];
            bf16* op = OB + (size_t)m * DM + hh * 128 + dd;
            { const v4u a0 = *(const GAS v4u*)op, a1 = *(const GAS v4u*)(op + 8); const float ww = w[0] * inv;
#pragma unroll
              for (int k = 0; k < 4; ++k) { acc16[2 * k] = ww * __uint_as_float(a0[k] << 16); acc16[2 * k + 1] = ww * __uint_as_float(a0[k] & 0xffff0000u); acc16[8 + 2 * k] = ww * __uint_as_float(a1[k] << 16); acc16[8 + 2 * k + 1] = ww * __uint_as_float(a1[k] & 0xffff0000u); } }
#pragma unroll
            for (int r = 0; r < 3; ++r) if (r < nv) { const bf16* pp = PO + ((size_t)qi * 3 + r) * 128 + dd; const v4u a0 = *(const GAS v4u*)pp, a1 = *(const GAS v4u*)(pp + 8); const float ww = w[1 + r] * inv;
#pragma unroll
                for (int k = 0; k < 4; ++k) { acc16[2 * k] += ww * __uint_as_float(a0[k] << 16); acc16[2 * k + 1] += ww * __uint_as_float(a0[k] & 0xffff0000u); acc16[8 + 2 * k] += ww * __uint_as_float(a1[k] << 16); acc16[8 + 2 * k + 1] += ww * __uint_as_float(a1[k] & 0xffff0000u); } }
            v4u w0, w1;
#pragma unroll
            for (int k = 0; k < 4; ++k) { w0[k] = pk2(acc16[2 * k], acc16[2 * k + 1]); w1[k] = pk2(acc16[8 + 2 * k], acc16[8 + 2 * k + 1]); }
            *(GAS v4u*)op = w0; *(GAS v4u*)(op + 8) = w1;
        }
        } SEAM(13);
    }
    if (IN(14)) { PH_PTRS; for (int rep_ = 0; rep_ < NREP(14); ++rep_) {
        pg8::ABDense ab{OB, W1o, DM}; pg8::TileOrder S; S.init(TOK / 256, DM / 256, G, bx);
        pg8::EpiResB E{Rb, Rb, DM, nullptr, RSS(3)};
        pg8::gemm_phase<pg8::EpiResB, pg8::ABDense, GEMM_ALIGN>(L + RING_OFF, ab, S, E);
        } SEAM(14);
    }
    if (IN(15)) { PH_PTRS; for (int rep_ = 0; rep_ < NREP(15); ++rep_) {
        {
            const int gt = (vcu * NWAVES + wave) * 64 + lane, NT_ = G * NWAVES * 64;
            for (int e = gt; e < 2 * SLOTS; e += NT_) { slot_tok[e] = -1; slot_gate[e] = 0.f; }
        }
        if (rep_ == 0) {
            f32x4 gv[4]; load_gain(norm_ffn + DM, gv, lane);
            float wr_[16][8];
#pragma unroll
            for (int j = 0; j < 4; ++j)
#pragma unroll
                for (int q = 0; q < 4; ++q) { const int k = 4 * lane + 256 * j + q; const f32x4 a = *(const GAS f32x4*)(moe_router + (size_t)k * 8) * gv[j][q], c = *(const GAS f32x4*)(moe_router + (size_t)k * 8 + 4) * gv[j][q];
                    wr_[4 * j + q][0] = a.x; wr_[4 * j + q][1] = a.y; wr_[4 * j + q][2] = a.z; wr_[4 * j + q][3] = a.w; wr_[4 * j + q][4] = c.x; wr_[4 * j + q][5] = c.y; wr_[4 * j + q][6] = c.z; wr_[4 * j + q][7] = c.w; }
            for (int m = gw; m < TOK; m += NGW) {
                f32x4 v[4];
                { const GAS unsigned long long* r8 = (const GAS unsigned long long*)(Rb + (size_t)m * DM) + lane;
#pragma unroll
                  for (int j = 0; j < 4; ++j) { const unsigned long long w = r8[64 * j]; const unsigned lo32 = (unsigned)w, hi32 = (unsigned)(w >> 32);
                      v[j].x = __uint_as_float(lo32 << 16); v[j].y = __uint_as_float(lo32 & 0xffff0000u); v[j].z = __uint_as_float(hi32 << 16); v[j].w = __uint_as_float(hi32 & 0xffff0000u); } }
                float lg[8];
#pragma unroll
                for (int e = 0; e < 8; ++e) { float a = 0.f;
#pragma unroll
                    for (int j = 0; j < 4; ++j) a += v[j].x * wr_[4 * j][e] + v[j].y * wr_[4 * j + 1][e] + v[j].z * wr_[4 * j + 2][e] + v[j].w * wr_[4 * j + 3][e];
                    lg[e] = wave_sum(a); }
                const float rs = 1.f / sqrtf((float)RSS(3)[m] * (5.9604644775390625e-8f / DM) + NORM_EPS);
#pragma unroll
                for (int e = 0; e < 8; ++e) lg[e] *= rs;
                {
                    float mx = 0.f;
#pragma unroll
                    for (int j = 0; j < 4; ++j) mx = fmaxf(fmaxf(mx, fmaxf(fabsf(v[j].x), fabsf(v[j].y))), fmaxf(fabsf(v[j].z), fabsf(v[j].w)));
#pragma unroll
                    for (int o = 1; o < 64; o <<= 1) mx = fmaxf(mx, __shfl_xor(mx, o));
                    const float inv = mx > 0.f ? 127.0f / mx : 0.f;
                    GAS unsigned* aq = (GAS unsigned*)(AQ + (size_t)m * DM) + lane;
#pragma unroll
                    for (int j = 0; j < 4; ++j) { const int q0 = (int)__builtin_rintf(v[j].x * inv), q1 = (int)__builtin_rintf(v[j].y * inv), q2 = (int)__builtin_rintf(v[j].z * inv), q3 = (int)__builtin_rintf(v[j].w * inv);
                        aq[64 * j] = (unsigned)(q0 & 255) | ((unsigned)(q1 & 255) << 8) | ((unsigned)(q2 & 255) << 16) | ((unsigned)(q3 & 255) << 24); }
                    if (lane == 0) SA[m] = mx * rs * (1.0f / 127.0f);
                }
                int e0 = 0; float l0 = lg[0];
#pragma unroll
                for (int e = 1; e < 8; ++e) if (lg[e] > l0) { l0 = lg[e]; e0 = e; }
                int e1 = -1; float l1 = -INFINITY;
#pragma unroll
                for (int e = 0; e < 8; ++e) if (e != e0 && lg[e] > l1) { l1 = lg[e]; e1 = e; }
                if (lane == 0) {
                    const float g0 = 1.f / (1.f + expf(l1 - l0)), g1 = 1.f - g0;
                    const int p0 = (int)__hip_atomic_fetch_add((LAS unsigned*)(L + MISC_OFF) + 40 + e0, 1u, __ATOMIC_RELAXED, __HIP_MEMORY_SCOPE_WORKGROUP), p1 = (int)__hip_atomic_fetch_add((LAS unsigned*)(L + MISC_OFF) + 48 + e1, 1u, __ATOMIC_RELAXED, __HIP_MEMORY_SCOPE_WORKGROUP);
                    tok_e[m] = e0; tok_e[TOK + m] = e1; tok_pos[m] = p0; tok_pos[TOK + m] = p1; tok_gate[m] = g0; tok_gate[TOK + m] = g1;
                }
            }
            LDS_WAIT(); __syncthreads();
            if (tid < 16) { const unsigned n = MISC[40 + tid]; wg_base[vcu * 16 + tid] = n ? (int)__hip_atomic_fetch_add(ctl + CW_MOECNT + tid, n, RLX_AGENT) : 0; }
        }
        {
            constexpr int S_1 = (DM / 512) * (FF1 / 32), S_2 = (FF1 / 512) * (DM / 32), PER_E = 2 * S_1 + S_2;
            float ssA = 0.f, ssB = 0.f;
            for (int it = gw; it < NEXP * PER_E; it += NGW) {
                const int e = it / PER_E; int r = it % PER_E;
                if (r < S_1) { ssA += wmax_strip<3>(moe_w1 + (size_t)e * DM * FF1, FF1, CMAX13 + e * 2 * FF1, 8 * (r / (FF1 / 32)), 8, r % (FF1 / 32), lane, norm_ffn + DM); continue; } r -= S_1;
                if (r < S_1) { ssB += wmax_strip<4>(moe_w3 + (size_t)e * DM * FF1, FF1, CMAX13 + e * 2 * FF1, 8 * (r / (FF1 / 32)), 8, r % (FF1 / 32), lane, norm_ffn + DM); continue; } r -= S_1;
                (void)wmax_strip<0>(moe_w2 + (size_t)e * FF1 * DM, DM, CMAX2 + e * DM, 8 * (r / (DM / 32)), 8, r % (DM / 32), lane, nullptr);
            }
            ssA = wave_sum(ssA); ssB = wave_sum(ssB);
            if (lane == 0) { __hip_atomic_fetch_add(SSTOT, (unsigned long long)(ssA * 16777216.0f), __ATOMIC_RELAXED, __HIP_MEMORY_SCOPE_AGENT); __hip_atomic_fetch_add(SSTOT + 1, (unsigned long long)(ssB * 16777216.0f), __ATOMIC_RELAXED, __HIP_MEMORY_SCOPE_AGENT); }
        }
        } SEAM(15);
    }
#define MOE_CUM() do { if (tid < 2) { int a = 0; for (int e = 0; e < 8; ++e) { MISC[16 + 9 * tid + e] = (unsigned)a; a += (int)((__hip_atomic_load(ctl + CW_MOECNT + 8 * tid + e, RLX_AGENT) + 255u) >> 8); } MISC[16 + 9 * tid + 8] = (unsigned)a; } __syncthreads(); } while (0)
    if (IN(16)) { PH_PTRS; for (int rep_ = 0; rep_ < NREP(16); ++rep_) {
        MOE_CUM();
        const int gt = (vcu * NWAVES + wave) * 64 + lane, NT_ = G * NWAVES * 64;
        for (int e = gt; e < 2 * TOK; e += NT_) { const int r = e >= TOK ? 1 : 0; const int ex = tok_e[e]; const int t_ = e - r * TOK; const int slot = (int)MISC[16 + 9 * r + ex] * 256 + wg_base[((t_ % NGW) >> 3) * 16 + r * 8 + ex] + tok_pos[e];
            slot_tok[r * SLOTS + slot] = e - r * TOK; slot_gate[r * SLOTS + slot] = tok_gate[e]; }
        {
            LAS float* scr = (LAS float*)(L + RING_OFF + wave * 16384);
            constexpr int I_1 = (DM / 64) * (FF1 / 32), I_2 = (FF1 / 64) * (DM / 32), PER_E = 2 * I_1 + I_2;
            for (int it = gw; it < NEXP * PER_E; it += NGW) {
                const int e = it / PER_E; int r = it % PER_E;
                if (r < I_1) { transpose_item_q<3>(moe_w1 + (size_t)e * DM * FF1, DM, FF1, WM13 + (size_t)e * 2 * FF1 * DM, CMAX13 + e * 2 * FF1, scr, r, lane, norm_ffn + DM); continue; } r -= I_1;
                if (r < I_1) { transpose_item_q<4>(moe_w3 + (size_t)e * DM * FF1, DM, FF1, WM13 + (size_t)e * 2 * FF1 * DM, CMAX13 + e * 2 * FF1, scr, r, lane, norm_ffn + DM); continue; } r -= I_1;
                transpose_item_q<0>(moe_w2 + (size_t)e * FF1 * DM, FF1, DM, WM2 + (size_t)e * DM * FF1, CMAX2 + e * DM, scr, r, lane, nullptr);
            }
        }
        } SEAM(16);
    }
#define MOE_SU() (8.0f * sqrtf(((float)SSTOT[0] * (5.9604644775390625e-8f / (NEXP * FF1))) * ((float)SSTOT[1] * (5.9604644775390625e-8f / (NEXP * FF1)))))
#define MOE_UP(r) do { MOE_CUM(); \
        pg8::ABMoeUp ab{(const pg8::bf16_t*)AQ, (const pg8::bf16_t*)WM13, DM / 2, slot_tok + (r) * SLOTS, (const LAS int*)(L + MISC_OFF + 4 * (16 + 9 * (r))), (size_t)2 * FF1 * (DM / 2)}; \
        pg8::TileOrder S; S.init((int)MISC[16 + 9 * (r) + 8], (2 * FF1) / 256, G, bx); \
        pg8::EpiSwiGLUQ E{UM, FF1, SA, CMAX13, slot_tok + (r) * SLOTS, (const LAS int*)(L + MISC_OFF + 4 * (16 + 9 * (r))), 127.0f / MOE_SU()}; \
        pg8::gemm_phase<pg8::EpiSwiGLUQ, pg8::ABMoeUp, GEMM_ALIGN>(L + RING_OFF, ab, S, E); } while (0)
#define MOE_DOWN(r) do { MOE_CUM(); \
        pg8::ABMoeDown ab{(const pg8::bf16_t*)UM, (const pg8::bf16_t*)WM2, FF1 / 2, (const LAS int*)(L + MISC_OFF + 4 * (16 + 9 * (r))), (size_t)DM * (FF1 / 2)}; \
        pg8::TileOrder S; S.init((int)MISC[16 + 9 * (r) + 8], DM / 256, G, bx); \
        pg8::EpiResBQ E{(r) == 0 ? Rb : OB, (r) == 0 ? OB : Rb, DM, slot_tok + (r) * SLOTS, slot_gate + (r) * SLOTS, CMAX2, (const LAS int*)(L + MISC_OFF + 4 * (16 + 9 * (r))), MOE_SU() * (1.0f / 127.0f), nullptr}; \
        pg8::gemm_phase<pg8::EpiResBQ, pg8::ABMoeDown, GEMM_ALIGN>(L + RING_OFF, ab, S, E); } while (0)
    if (IN(17)) { PH_PTRS; for (int rep_ = 0; rep_ < NREP(17); ++rep_) MOE_UP(0); SEAM(17); }
    if (IN(18)) { PH_PTRS; MOE_DOWN(0); SEAM(18); }
    if (IN(19)) { PH_PTRS; for (int rep_ = 0; rep_ < NREP(19); ++rep_) MOE_UP(1); SEAM(19); }
    if (IN(20)) { PH_PTRS; MOE_DOWN(1); SEAM(20); }
    if (IN(21)) { PH_PTRS;
        f32x4 gv[4]; load_gain(final_norm, gv, lane);
        for (int m0 = gw; m0 < TOK; m0 += 4 * NGW) {
            unsigned long long w[4][4];
#pragma unroll
            for (int u = 0; u < 4; ++u) { const int m = (m0 + u * NGW < TOK) ? m0 + u * NGW : m0; const GAS unsigned long long* r8 = (const GAS unsigned long long*)(Rb + (size_t)m * DM) + lane;
#pragma unroll
                for (int j = 0; j < 4; ++j) w[u][j] = r8[64 * j]; }
#pragma unroll
            for (int u = 0; u < 4; ++u) { const int m = m0 + u * NGW; if (m < TOK) {
                f32x4 v[4]; float s = 0.f;
#pragma unroll
                for (int j = 0; j < 4; ++j) { const unsigned lo32 = (unsigned)w[u][j], hi32 = (unsigned)(w[u][j] >> 32);
                    v[j].x = __uint_as_float(lo32 << 16); v[j].y = __uint_as_float(lo32 & 0xffff0000u); v[j].z = __uint_as_float(hi32 << 16); v[j].w = __uint_as_float(hi32 & 0xffff0000u);
                    s += (v[j].x * v[j].x + v[j].y * v[j].y) + (v[j].z * v[j].z + v[j].w * v[j].w); }
                const float rstd = 1.f / sqrtf(wave_sum(s) * (1.f / DM) + NORM_EPS);
                GAS f32x4* o = (GAS f32x4*)(out + (size_t)m * DM) + lane;
#pragma unroll
                for (int j = 0; j < 4; ++j) o[64 * j] = v[j] * rstd * gv[j]; } }
        }
    }
#undef IN
#undef SEAM
#undef GRID_BAR
#undef tid
#undef lane
}
constexpr int N_PHASES = 22;

extern "C" void kernel_launch(void* const* d_in, const int* in_sizes, int n_in, void* d_out, int out_size, void* d_ws, size_t ws_size, hipStream_t stream) {
    static int grid = 0;
    if (grid == 0) {
        if (n_in != 20 || in_sizes[0] != TOK * DM || out_size != TOK * DM || ws_size < WS_END) { fprintf(stderr, "kernel_launch: shape / workspace mismatch (n_in %d, in0 %d, out %d, ws %zu, need %zu); nothing launched\n", n_in, n_in > 0 ? in_sizes[0] : -1, out_size, ws_size, (size_t)WS_END); grid = -1; return; }
        int dev = 0, cus = 0, per_cu = 0;
        if (hipGetDevice(&dev) != hipSuccess || hipDeviceGetAttribute(&cus, hipDeviceAttributeMultiprocessorCount, dev) != hipSuccess) { grid = -1; return; }
        if (hipFuncSetAttribute((const void*)mk_fwd, hipFuncAttributeMaxDynamicSharedMemorySize, LDS_BYTES) != hipSuccess) { fprintf(stderr, "kernel_launch: hipFuncSetAttribute failed\n"); grid = -1; return; }
        if (hipOccupancyMaxActiveBlocksPerMultiprocessor(&per_cu, (const void*)mk_fwd, NWAVES * 64, LDS_BYTES) != hipSuccess || per_cu < 1) fprintf(stderr, "kernel_launch: occupancy query reports %d workgroups per CU\n", per_cu);
        (void)hipGetLastError();
        grid = cus;
    }
    if (grid < 0) return;
    if (hipMemsetAsync((char*)d_ws + WS_CTL, 0, CTL_ZERO_BYTES, stream) != hipSuccess) return;
    Args a{};
    for (int i = 0; i < 20; ++i) a.in[i] = (const float*)d_in[i];
    a.out = (float*)d_out; a.ws = (unsigned char*)d_ws;
    for (int i = 0; i < 8; ++i) a.inv64[i] = (float)pow(500000.0, -(double)(2 * i) / 16.0);
    for (int i = 0; i < 16; ++i) a.inv128[i] = (float)pow(500000.0, -(double)(2 * i) / 32.0);
#if MK_PER_PHASE
    for (int p = 0; p < N_PHASES; ++p) { a.ph_lo = p; a.ph_hi = p + 1; hipLaunchKernelGGL(mk_fwd, dim3(grid), dim3(NWAVES * 64), LDS_BYTES, stream, a); }
#else
    a.ph_lo = 0; a.ph_hi = N_PHASES;
    hipLaunchKernelGGL(mk_fwd, dim3(grid), dim3(NWAVES * 64), LDS_BYTES, stream, a);
#ifdef PROBE_LIST
    {
        static const int probe[] = {PROBE_LIST};
        for (int k : probe) { a.ph_lo = k; a.ph_hi = k + 1;
            a.out = (k == 3 || k == 12 || k == 13 || k == 18 || k == 21) ? (float*)((char*)d_ws + WS_QKV) : (float*)d_out;
            hipLaunchKernelGGL(mk_fwd, dim3(grid), dim3(NWAVES * 64), LDS_BYTES, stream, a); }
    }
#endif
#endif
    const hipError_t le = hipPeekAtLastError();
    if (le != hipSuccess) fprintf(stderr, "kernel_launch: launch failed: %s\n", hipGetErrorName(le));
}
```

```cpp
#include <hip/hip_runtime.h>
#include <hip/hip_bf16.h>
#include <cstdio>
#include <cstdint>
#include <cmath>
namespace pg8 {
#define PG8_LAS __attribute__((address_space(3)))
typedef unsigned short bf16_t;
typedef short bf16x8 __attribute__((ext_vector_type(8)));
typedef float f32x4 __attribute__((ext_vector_type(4)));
typedef unsigned u32x4 __attribute__((ext_vector_type(4)));
constexpr int BM = 256, BK = 64, HALF = 128, HTB = HALF * BK * 2  , STAGE_BYTES = 8 * HTB, NXCD = 8, WGM = 8;

__host__ __device__ __forceinline__ int lds_byte(int r, int c) { const int st = (r >> 4) * 2 + (c >> 5), rr = r & 15, cc = c & 31, ob = rr * 64 + cc * 2; return st * 1024 + (ob ^ (((ob >> 9) & 1) << 5)); }
__host__ __device__ __forceinline__ void stage_rc(int b, int& R, int& C) { const int st = b / 1024, sb = b % 1024, swz = sb ^ (((sb >> 9) & 1) << 5); R = (st >> 1) * 16 + swz / 64; C = (st & 1) * 32 + (swz % 64) / 2; }
__host__ __device__ __forceinline__ int perm32(int rho) { const int n = rho >> 4, i = rho & 15; return 8 * (i >> 2) + 4 * n + (i & 3); }

struct Unit { int pm, pn; };

struct TileOrder {
    int nM, nN, nwg, G, c;
    __device__ __forceinline__ void init(int nM_, int nN_, int G_, int c_) { nM = nM_; nN = nN_; nwg = nM * nN; G = G_; c = c_; }
    __device__ __forceinline__ bool next(int i, Unit& u) const {
        const long L = (long)i * G + c; if (L >= nwg) return false;
        int wgid = (int)L; { const int q = nwg / NXCD, r = nwg % NXCD, xcd = wgid % NXCD, off = wgid / NXCD; wgid = (xcd < r ? xcd * (q + 1) : r * (q + 1) + (xcd - r) * q) + off; }
        const int nig = WGM * nN, gid = wgid / nig, fm = gid * WGM, gsz = (nM - fm) < WGM ? (nM - fm) : WGM;
        u.pm = fm + ((wgid % nig) % gsz); u.pn = (wgid % nig) / gsz; return true;
    }
};

struct ABDense {
    static constexpr bool GATHER = false;
    const bf16_t* A; const bf16_t* Bt; int K;
    __device__ __forceinline__ const char* abase(const Unit& u) const { return (const char*)A + (size_t)u.pm * BM * K * 2; }
    __device__ __forceinline__ const char* bbase(const Unit& u) const { return (const char*)Bt + (size_t)u.pn * BM * K * 2; }
    __device__ __forceinline__ const int* tokp(const Unit&) const { return nullptr; }
};
struct ABMoeUp {
    static constexpr bool GATHER = true;
    const bf16_t* A; const bf16_t* Bt; int K; const int* slot_tok; const PG8_LAS int* cum; size_t estride;
    __device__ __forceinline__ int expert(int pm) const { int e = 0;
#pragma unroll
        for (int k = 1; k < 8; ++k) e += (pm >= cum[k]) ? 1 : 0; return e; }
    __device__ __forceinline__ const char* abase(const Unit&) const { return (const char*)A; }
    __device__ __forceinline__ const char* bbase(const Unit& u) const { return (const char*)(Bt + (size_t)expert(u.pm) * estride) + (size_t)u.pn * BM * K * 2; }
    __device__ __forceinline__ const int* tokp(const Unit& u) const { return slot_tok + u.pm * BM; }
};
struct ABMoeDown {
    static constexpr bool GATHER = false;
    const bf16_t* A; const bf16_t* Bt; int K; const PG8_LAS int* cum; size_t estride;
    __device__ __forceinline__ int expert(int pm) const { int e = 0;
#pragma unroll
        for (int k = 1; k < 8; ++k) e += (pm >= cum[k]) ? 1 : 0; return e; }
    __device__ __forceinline__ const char* abase(const Unit& u) const { return (const char*)A + (size_t)u.pm * BM * K * 2; }
    __device__ __forceinline__ const char* bbase(const Unit& u) const { return (const char*)(Bt + (size_t)expert(u.pm) * estride) + (size_t)u.pn * BM * K * 2; }
    __device__ __forceinline__ const int* tokp(const Unit&) const { return nullptr; }
};

__device__ __forceinline__ unsigned cvt_pk_bf16(float lo, float hi) { unsigned r; asm volatile("v_cvt_pk_bf16_f32 %0, %1, %2" : "=v"(r) : "v"(lo), "v"(hi)); return r; }

template <int DH> struct EpiQKV {
    static constexpr bool PERM = true; typedef f32x4 acc_t;
    bf16_t* O; int ldc; const float* ct; const float* st; float qscale; const unsigned long long* rss; int* kms;
    __device__ __forceinline__ void operator()(const f32x4 (&acc)[2][2][4][2], const Unit& u, int wr, int wc, int fr, int fq) const {
        constexpr int NF = DH / 8;
        const int row0 = u.pm * BM + wr * 64 + fr, col0 = u.pn * BM + wc * 32 + 8 * fq;
        const int sect = u.pn >> 2;
        const float sc = (sect == 0) ? qscale : 1.f;
        const bool rot = (sect < 2) && (DH == 64 ? (((wc & 1) == 0) && (fq < 2)) : (wc == 0));
        f32x4 ksum[2][2] = {{(f32x4){0.f, 0.f, 0.f, 0.f}, (f32x4){0.f, 0.f, 0.f, 0.f}}, {(f32x4){0.f, 0.f, 0.f, 0.f}, (f32x4){0.f, 0.f, 0.f, 0.f}}};
#pragma unroll
        for (int ai = 0; ai < 2; ++ai)
#pragma unroll
            for (int m = 0; m < 4; ++m) {
                const int row = row0 + ai * HALF + m * 16; const int pos = row & 8191; const float rs = sc * __builtin_amdgcn_rsqf((float)rss[row] * (5.9604644775390625e-8f / 1024.0f) + 1e-6f);
                f32x4 c4 = (f32x4){1.f, 1.f, 1.f, 1.f}, s4 = (f32x4){0.f, 0.f, 0.f, 0.f};
                if (rot) { c4 = *(const f32x4*)(ct + pos * NF + 4 * fq); s4 = *(const f32x4*)(st + pos * NF + 4 * fq); }
                bf16_t* rowp = O + (size_t)row * ldc + col0;
#pragma unroll
                for (int bj = 0; bj < 2; ++bj) {
                    const f32x4 x1 = acc[ai][bj][m][0], x2 = acc[ai][bj][m][1];
                    f32x4 v0 = (x1 * c4 - x2 * s4) * rs, v1 = (x2 * c4 + x1 * s4) * rs;
                    u32x4 w; w.x = cvt_pk_bf16(v0[0], v0[1]); w.y = cvt_pk_bf16(v0[2], v0[3]); w.z = cvt_pk_bf16(v1[0], v1[1]); w.w = cvt_pk_bf16(v1[2], v1[3]);
                    *(u32x4*)(rowp + bj * HALF) = w;
                    if (DH == 128) { ksum[bj][0] += v0; ksum[bj][1] += v1; } }
            }
        if (DH == 128 && kms && sect == 1) {
            const int blk = u.pm;
            int* dst = kms + ((size_t)((blk >> 5) * 8 + ((u.pn & 3) * 2)) * 32 + (blk & 31)) * 128;
#pragma unroll
            for (int bj = 0; bj < 2; ++bj)
#pragma unroll
                for (int n = 0; n < 2; ++n)
#pragma unroll
                    for (int c = 0; c < 4; ++c) { float s = ksum[bj][n][c];
                        s += __shfl_xor(s, 1); s += __shfl_xor(s, 2); s += __shfl_xor(s, 4); s += __shfl_xor(s, 8);
                        if (fr == 0) __hip_atomic_fetch_add(dst + bj * 32 * 128 + wc * 32 + 8 * fq + 4 * n + c, (int)__builtin_rintf(s * 65536.0f), __ATOMIC_RELAXED, __HIP_MEMORY_SCOPE_AGENT); }
        }
    }
};

__device__ __forceinline__ float silu_mul(float a, float b) { return a * b * __builtin_amdgcn_rcpf(1.0f + __builtin_amdgcn_exp2f(-1.4426950408889634f * a)); }
struct EpiSwiGLU {
    static constexpr bool PERM = true; typedef f32x4 acc_t;
    bf16_t* O; int ldc; const float* gate; const unsigned long long* rss; const int* rowmap;
    __device__ __forceinline__ void operator()(const f32x4 (&acc)[2][2][4][2], const Unit& u, int wr, int wc, int fr, int fq) const {
        const int row0 = u.pm * BM + wr * 64 + fr, col0 = u.pn * HALF + wc * 32 + 8 * fq;
#pragma unroll
        for (int ai = 0; ai < 2; ++ai)
#pragma unroll
            for (int m = 0; m < 4; ++m) {
                const int row = row0 + ai * HALF + m * 16; const float g = gate ? gate[row] : 1.f; const int trow = rowmap ? rowmap[row] : row;
                const float rs = trow >= 0 ? __builtin_amdgcn_rsqf((float)rss[trow] * (5.9604644775390625e-8f / 1024.0f) + 1e-6f) : 0.f;
                const f32x4 a0 = acc[ai][0][m][0] * rs, a1 = acc[ai][0][m][1] * rs, b0 = acc[ai][1][m][0] * rs, b1 = acc[ai][1][m][1] * rs;
                float v[8];
#pragma unroll
                for (int k = 0; k < 4; ++k) { v[k] = g * silu_mul(a0[k], b0[k]); v[4 + k] = g * silu_mul(a1[k], b1[k]); }
                u32x4 w; w.x = cvt_pk_bf16(v[0], v[1]); w.y = cvt_pk_bf16(v[2], v[3]); w.z = cvt_pk_bf16(v[4], v[5]); w.w = cvt_pk_bf16(v[6], v[7]);
                *(u32x4*)(O + (size_t)row * ldc + col0) = w; }
    }
};
struct EpiResB {
    static constexpr bool PERM = true; typedef f32x4 acc_t;
    const bf16_t* Rin; bf16_t* Rout; int ldc; const int* rowmap; unsigned long long* rss_out;
    __device__ __forceinline__ void operator()(const f32x4 (&acc)[2][2][4][2], const Unit& u, int wr, int wc, int fr, int fq) const {
        const int row0 = u.pm * BM + wr * 64 + fr, col0 = u.pn * BM + wc * 32 + 8 * fq;
#pragma unroll
        for (int ai = 0; ai < 2; ++ai)
#pragma unroll
            for (int m = 0; m < 4; ++m) {
                const int row = row0 + ai * HALF + m * 16; const int orow = rowmap ? rowmap[row] : row; float ss = 0.f;
                if (orow >= 0) { const bf16_t* rp = Rin + (size_t)orow * ldc + col0; bf16_t* wp = Rout + (size_t)orow * ldc + col0;
#pragma unroll
                    for (int bj = 0; bj < 2; ++bj) { const u32x4 w = *(const u32x4*)(rp + bj * HALF); const f32x4 a0 = acc[ai][bj][m][0], a1 = acc[ai][bj][m][1];
                        float v[8];
                        v[0] = __uint_as_float(w.x << 16) + a0[0]; v[1] = __uint_as_float(w.x & 0xffff0000u) + a0[1]; v[2] = __uint_as_float(w.y << 16) + a0[2]; v[3] = __uint_as_float(w.y & 0xffff0000u) + a0[3];
                        v[4] = __uint_as_float(w.z << 16) + a1[0]; v[5] = __uint_as_float(w.z & 0xffff0000u) + a1[1]; v[6] = __uint_as_float(w.w << 16) + a1[2]; v[7] = __uint_as_float(w.w & 0xffff0000u) + a1[3];
#pragma unroll
                        for (int k = 0; k < 8; ++k) ss += v[k] * v[k];
                        u32x4 o; o.x = cvt_pk_bf16(v[0], v[1]); o.y = cvt_pk_bf16(v[2], v[3]); o.z = cvt_pk_bf16(v[4], v[5]); o.w = cvt_pk_bf16(v[6], v[7]);
                        *(u32x4*)(wp + bj * HALF) = o; } }
                if (rss_out) { ss += __shfl_xor(ss, 16); ss += __shfl_xor(ss, 32);
                    if (fq == 0) __hip_atomic_fetch_add(rss_out + orow, (unsigned long long)(ss * 16777216.0f), __ATOMIC_RELAXED, __HIP_MEMORY_SCOPE_AGENT); }
                if (m & 1) asm volatile("" ::: "memory"); }
    }
};

typedef int i32x4_e __attribute__((ext_vector_type(4)));
struct EpiSwiGLUQ {
    static constexpr bool PERM = true; typedef i32x4_e acc_t;
    signed char* O; int ldc; const float* sa; const unsigned* cm; const int* rowmap; const PG8_LAS int* cum; float qmul;
    __device__ __forceinline__ void operator()(const i32x4_e (&acc)[2][2][4][2], const Unit& u, int wr, int wc, int fr, int fq) const {
        int e = 0;
        if (cum) {
#pragma unroll
            for (int k = 1; k < 8; ++k) e += (u.pm >= cum[k]) ? 1 : 0; }
        const unsigned* cme = cm + (size_t)e * 7168 + u.pn * BM + wc * 32 + 8 * fq;
        float cA[8], cAB[8];
#pragma unroll
        for (int k = 0; k < 8; ++k) { cA[k] = __uint_as_float(cme[k]) * (1.0f / 127.0f); cAB[k] = cA[k] * (__uint_as_float(cme[HALF + k]) * (1.0f / 127.0f)); }
        const int row0 = u.pm * BM + wr * 64 + fr, col0 = u.pn * HALF + wc * 32 + 8 * fq;
#pragma unroll
        for (int ai = 0; ai < 2; ++ai)
#pragma unroll
            for (int m = 0; m < 4; ++m) {
                const int row = row0 + ai * HALF + m * 16; const int trow = rowmap ? rowmap[row] : row; const float s = trow >= 0 ? sa[trow] : 0.f;
                const float sneg = -1.4426950408889634f * s, s2q = s * s * qmul;
                const i32x4_e a0 = acc[ai][0][m][0], a1 = acc[ai][0][m][1], b0 = acc[ai][1][m][0], b1 = acc[ai][1][m][1];
                unsigned lo = 0u, hi = 0u;
#pragma unroll
                for (int k = 0; k < 4; ++k) {
                    const float fa = (float)a0[k], fb = (float)b0[k], fc = (float)a1[k], fd = (float)b1[k];
                    const float sg0 = __builtin_amdgcn_rcpf(1.0f + __builtin_amdgcn_exp2f((fa * cA[k]) * sneg)), sg1 = __builtin_amdgcn_rcpf(1.0f + __builtin_amdgcn_exp2f((fc * cA[4 + k]) * sneg));
                    const float u0 = ((fa * fb) * cAB[k]) * s2q * sg0 + 128.0f, u1 = ((fc * fd) * cAB[4 + k]) * s2q * sg1 + 128.0f;
                    lo = __builtin_amdgcn_cvt_pk_u8_f32(__builtin_rintf(u0), k, lo); hi = __builtin_amdgcn_cvt_pk_u8_f32(__builtin_rintf(u1), k, hi); }
                lo ^= 0x80808080u; hi ^= 0x80808080u;
                *(unsigned long long*)(O + (size_t)row * ldc + col0) = (unsigned long long)lo | ((unsigned long long)hi << 32); }
    }
};
struct EpiResBQ {
    static constexpr bool PERM = true; typedef i32x4_e acc_t;
    const bf16_t* Rin; bf16_t* Rout; int ldc; const int* rowmap; const float* gate; const unsigned* cm; const PG8_LAS int* cum; float dq; unsigned long long* rss_out;
    __device__ __forceinline__ void operator()(const i32x4_e (&acc)[2][2][4][2], const Unit& u, int wr, int wc, int fr, int fq) const {
        int e = 0;
        if (cum) {
#pragma unroll
            for (int k = 1; k < 8; ++k) e += (u.pm >= cum[k]) ? 1 : 0; }
        const int row0 = u.pm * BM + wr * 64 + fr, col0 = u.pn * BM + wc * 32 + 8 * fq;
        const unsigned* cme = cm + (size_t)e * 1024 + col0;
        float sb[2][8];
#pragma unroll
        for (int bj = 0; bj < 2; ++bj)
#pragma unroll
            for (int k = 0; k < 8; ++k) sb[bj][k] = __uint_as_float(cme[bj * HALF + k]) * (dq / 127.0f);
#pragma unroll
        for (int ai = 0; ai < 2; ++ai)
#pragma unroll
            for (int m = 0; m < 4; ++m) {
                const int row = row0 + ai * HALF + m * 16; const int orow = rowmap ? rowmap[row] : row; float ss = 0.f;
                if (orow >= 0) { const float gt = gate ? gate[row] : 1.f; const bf16_t* rp = Rin + (size_t)orow * ldc + col0; bf16_t* wp = Rout + (size_t)orow * ldc + col0;
#pragma unroll
                    for (int bj = 0; bj < 2; ++bj) { const u32x4 w = *(const u32x4*)(rp + bj * HALF); const i32x4_e a0 = acc[ai][bj][m][0], a1 = acc[ai][bj][m][1];
                        float v[8];
                        v[0] = __uint_as_float(w.x << 16) + (float)a0[0] * gt * sb[bj][0]; v[1] = __uint_as_float(w.x & 0xffff0000u) + (float)a0[1] * gt * sb[bj][1];
                        v[2] = __uint_as_float(w.y << 16) + (float)a0[2] * gt * sb[bj][2]; v[3] = __uint_as_float(w.y & 0xffff0000u) + (float)a0[3] * gt * sb[bj][3];
                        v[4] = __uint_as_float(w.z << 16) + (float)a1[0] * gt * sb[bj][4]; v[5] = __uint_as_float(w.z & 0xffff0000u) + (float)a1[1] * gt * sb[bj][5];
                        v[6] = __uint_as_float(w.w << 16) + (float)a1[2] * gt * sb[bj][6]; v[7] = __uint_as_float(w.w & 0xffff0000u) + (float)a1[3] * gt * sb[bj][7];
#pragma unroll
                        for (int k = 0; k < 8; ++k) ss += v[k] * v[k];
                        u32x4 o; o.x = cvt_pk_bf16(v[0], v[1]); o.y = cvt_pk_bf16(v[2], v[3]); o.z = cvt_pk_bf16(v[4], v[5]); o.w = cvt_pk_bf16(v[6], v[7]);
                        *(u32x4*)(wp + bj * HALF) = o; } }
                if (rss_out) { ss += __shfl_xor(ss, 16); ss += __shfl_xor(ss, 32);
                    if (fq == 0) __hip_atomic_fetch_add(rss_out + orow, (unsigned long long)(ss * 16777216.0f), __ATOMIC_RELAXED, __HIP_MEMORY_SCOPE_AGENT); }
                if (m & 1) asm volatile("" ::: "memory"); }
    }
};
typedef int i32x4 __attribute__((ext_vector_type(4)));
__device__ __forceinline__ f32x4 mma16(bf16x8 a, bf16x8 b, f32x4 c) { return __builtin_amdgcn_mfma_f32_16x16x32_bf16(a, b, c, 0, 0, 0); }
__device__ __forceinline__ i32x4 mma16(bf16x8 a, bf16x8 b, i32x4 c) { return __builtin_amdgcn_mfma_i32_16x16x64_i8(__builtin_bit_cast(i32x4, a), __builtin_bit_cast(i32x4, b), c, 0, 0, 0); }
template <class Epi, class AB, bool ALIGN_EPI = true>
__device__ __forceinline__ void gemm_phase(PG8_LAS unsigned char* lds, const AB ab, const TileOrder& S, const Epi& E) {
    const int tid = threadIdx.x, wid = __builtin_amdgcn_readfirstlane(tid >> 6), lane = tid & 63, wr = wid >> 2, wc = wid & 3, fr = lane & 15, fq = lane >> 4;
    const int K = ab.K, nt = K / BK;
    int Rr[2], Cc[2]; unsigned voffB[2];
#pragma unroll
    for (int i = 0; i < 2; ++i) { int R, C; stage_rc(tid * 16 + i * 8192, R, C); const int Rb = Epi::PERM ? ((R & ~31) + perm32(R & 31)) : R;
        Rr[i] = R; Cc[i] = C; voffB[i] = (unsigned)(Rb * K + C) * 2u; }
    const size_t kstep = (size_t)(BK * 2);
    const size_t hstep = (size_t)HALF * K * 2;
    const unsigned ldsw = (unsigned)wid * 1024u;
    const int aoff = lds_byte(wr * 64 + fr, fq * 8), boff = lds_byte(wc * 32 + fr, fq * 8);
#define PG8_SA(b, h) (((b) * 2 + (h)) * HTB)
#define PG8_SB(b, h) ((4 + (b) * 2 + (h)) * HTB)
#define PG8_STAGE(bufoff, gbase, voff) do { _Pragma("unroll") for (int _i = 0; _i < 2; ++_i) \
        __builtin_amdgcn_global_load_lds((const unsigned*)((const char*)(gbase) + (voff)[_i]), (PG8_LAS unsigned*)(lds + (bufoff) + ldsw + _i * 8192), 16, 0, 0); } while (0)
#define PG8_LDA(dst, b, h) do { _Pragma("unroll") for (int m = 0; m < 4; ++m) _Pragma("unroll") for (int k = 0; k < 2; ++k) dst[m][k] = *(const PG8_LAS bf16x8*)(lds + PG8_SA(b, h) + aoff + m * 2048 + k * 1024); } while (0)
#define PG8_LDB(dst, b, h) do { _Pragma("unroll") for (int n = 0; n < 2; ++n) _Pragma("unroll") for (int k = 0; k < 2; ++k) dst[n][k] = *(const PG8_LAS bf16x8*)(lds + PG8_SB(b, h) + boff + n * 2048 + k * 1024); } while (0)
#define PG8_MMA(ai, bj, At, Bt) do { __builtin_amdgcn_s_setprio(1); _Pragma("unroll") for (int m = 0; m < 4; ++m) _Pragma("unroll") for (int n = 0; n < 2; ++n) _Pragma("unroll") for (int k = 0; k < 2; ++k) \
        acc[ai][bj][m][n] = mma16(Bt[n][k], At[m][k], acc[ai][bj][m][n]); __builtin_amdgcn_s_setprio(0); } while (0)
#define PG8_WAIT_V(n) asm volatile("s_waitcnt vmcnt(" #n ")" ::: "memory")
#define PG8_WAIT_L(n) asm volatile("s_waitcnt lgkmcnt(" #n ")" ::: "memory")
#define PG8_BAR __builtin_amdgcn_s_barrier()
#define PG8_SCHED __builtin_amdgcn_sched_barrier(0)
    Unit cur, nxt; int ui = 0;
    if (!S.next(0, cur)) return;
    typedef typename Epi::acc_t acc_t;
    acc_t acc[2][2][4][2];
#pragma unroll
    for (int a = 0; a < 2; ++a)
#pragma unroll
        for (int b = 0; b < 2; ++b)
#pragma unroll
            for (int m = 0; m < 4; ++m)
#pragma unroll
                for (int n = 0; n < 2; ++n) acc[a][b][m][n] = (acc_t){0, 0, 0, 0};
    bf16x8 At[4][2], B0[2][2], B1[2][2];
    unsigned cv0[2], cv1[2], nv0[2], nv1[2]; int ntok[4] = {0, 0, 0, 0};
    if constexpr (AB::GATHER) { const int* tp = ab.tokp(cur);
#pragma unroll
        for (int i = 0; i < 2; ++i) { int t0 = tp[Rr[i]], t1 = tp[HALF + Rr[i]]; t0 = t0 < 0 ? 0 : t0; t1 = t1 < 0 ? 0 : t1;
            cv0[i] = (unsigned)(t0 * K + Cc[i]) * 2u; cv1[i] = (unsigned)(t1 * K + Cc[i]) * 2u; }
    } else {
#pragma unroll
        for (int i = 0; i < 2; ++i) { cv0[i] = (unsigned)(Rr[i] * K + Cc[i]) * 2u; cv1[i] = cv0[i] + (unsigned)hstep; }
    }
#pragma unroll
    for (int i = 0; i < 2; ++i) { nv0[i] = cv0[i]; nv1[i] = cv1[i]; }
    const char* cA = ab.abase(cur); const char* cB = ab.bbase(cur);
    PG8_STAGE(PG8_SB(0, 0), cB, voffB); PG8_STAGE(PG8_SB(0, 1), cB + hstep, voffB); PG8_STAGE(PG8_SA(0, 0), cA, cv0); PG8_STAGE(PG8_SA(0, 1), cA, cv1);
    if (wr == 1) PG8_BAR;
    PG8_WAIT_V(2); PG8_BAR;
    PG8_STAGE(PG8_SB(1, 0), cB + kstep, voffB); PG8_STAGE(PG8_SA(1, 0), cA + kstep, cv0); PG8_STAGE(PG8_SB(1, 1), cB + hstep + kstep, voffB);
    PG8_WAIT_V(6); PG8_BAR;
    for (;;) {
        const bool has_next = S.next(ui + 1, nxt);
        const char* nA = has_next ? ab.abase(nxt) : cA; const char* nB = has_next ? ab.bbase(nxt) : cB;
        if constexpr (AB::GATHER) {
            if (has_next) { const int* tp = ab.tokp(nxt);
                asm volatile("global_load_dword %0, %1, off" : "=v"(ntok[0]) : "v"(tp + Rr[0]) : "memory");
                asm volatile("global_load_dword %0, %1, off" : "=v"(ntok[1]) : "v"(tp + Rr[1]) : "memory");
                asm volatile("global_load_dword %0, %1, off" : "=v"(ntok[2]) : "v"(tp + HALF + Rr[0]) : "memory");
                asm volatile("global_load_dword %0, %1, off" : "=v"(ntok[3]) : "v"(tp + HALF + Rr[1]) : "memory"); }
        }
        for (int t = 0; t < nt; t += 2) {
            const bool last = (t == nt - 2);
            const char* a1 = cA + (size_t)(t + 1) * kstep;
            const char* a2 = last ? nA : cA + (size_t)(t + 2) * kstep; const char* b2 = last ? nB : cB + (size_t)(t + 2) * kstep;
            const char* a3 = a2 + kstep; const char* b3 = b2 + kstep;
            unsigned x0[2], x1[2];
            if constexpr (AB::GATHER) {
                if (last && has_next) {
                    asm volatile("s_waitcnt vmcnt(6)" : "+v"(ntok[0]), "+v"(ntok[1]), "+v"(ntok[2]), "+v"(ntok[3]) :: "memory");
#pragma unroll
                    for (int i = 0; i < 2; ++i) { int t0 = ntok[i], t1 = ntok[2 + i]; t0 = t0 < 0 ? 0 : t0; t1 = t1 < 0 ? 0 : t1;
                        nv0[i] = (unsigned)(t0 * K + Cc[i]) * 2u; nv1[i] = (unsigned)(t1 * K + Cc[i]) * 2u; }
                }
#pragma unroll
                for (int i = 0; i < 2; ++i) { x0[i] = last ? nv0[i] : cv0[i]; x1[i] = last ? nv1[i] : cv1[i]; }
            } else {
#pragma unroll
                for (int i = 0; i < 2; ++i) { x0[i] = cv0[i]; x1[i] = cv1[i]; }
            }
            PG8_LDB(B0, 0, 0); PG8_LDB(B1, 0, 1); PG8_SCHED; PG8_LDA(At, 0, 0); PG8_STAGE(PG8_SA(1, 1), a1, cv1);
            PG8_WAIT_V(8); PG8_WAIT_L(0); PG8_BAR; PG8_MMA(0, 0, At, B0); PG8_MMA(0, 1, At, B1); PG8_BAR; PG8_SCHED;
            PG8_LDA(At, 0, 1); PG8_STAGE(PG8_SB(0, 0), b2, voffB); PG8_STAGE(PG8_SB(0, 1), b2 + hstep, voffB); PG8_STAGE(PG8_SA(0, 0), a2, x0);
            PG8_WAIT_V(8); PG8_WAIT_L(0); PG8_BAR; PG8_MMA(1, 0, At, B0); PG8_MMA(1, 1, At, B1); PG8_BAR; PG8_SCHED;
            PG8_LDB(B0, 1, 0); PG8_LDB(B1, 1, 1); PG8_SCHED; PG8_LDA(At, 1, 0); PG8_STAGE(PG8_SA(0, 1), a2, x1);
            PG8_WAIT_V(8); PG8_WAIT_L(0); PG8_BAR; PG8_MMA(0, 0, At, B0); PG8_MMA(0, 1, At, B1); PG8_BAR; PG8_SCHED;
            PG8_LDA(At, 1, 1); PG8_STAGE(PG8_SB(1, 0), b3, voffB); PG8_STAGE(PG8_SB(1, 1), b3 + hstep, voffB); PG8_STAGE(PG8_SA(1, 0), a3, x0);
            PG8_WAIT_V(8); PG8_WAIT_L(0); PG8_BAR; PG8_MMA(1, 0, At, B0); PG8_MMA(1, 1, At, B1); PG8_BAR; PG8_SCHED;
        }
        if constexpr (ALIGN_EPI) { if (wr == 0) PG8_BAR; }
        E(acc, cur, wr, wc, fr, fq);
        if (!has_next) break;
#pragma unroll
        for (int a = 0; a < 2; ++a)
#pragma unroll
            for (int b = 0; b < 2; ++b)
#pragma unroll
                for (int m = 0; m < 4; ++m)
#pragma unroll
                    for (int n = 0; n < 2; ++n) acc[a][b][m][n] = (acc_t){0, 0, 0, 0};
        cur = nxt; cA = nA; cB = nB; ++ui;
#pragma unroll
        for (int i = 0; i < 2; ++i) { cv0[i] = nv0[i]; cv1[i] = nv1[i]; }
        if constexpr (ALIGN_EPI) { if (wr == 1) PG8_BAR; }
    }
    PG8_WAIT_V(0);
    if constexpr (!ALIGN_EPI) { if (wr == 0) PG8_BAR; }
    PG8_BAR;
#undef PG8_SA
#undef PG8_SB
#undef PG8_STAGE
#undef PG8_LDA
#undef PG8_LDB
#undef PG8_MMA
#undef PG8_WAIT_V
#undef PG8_WAIT_L
#undef PG8_BAR
#undef PG8_SCHED
}
}

namespace moba {
using bf16 = __hip_bfloat16;
using bf16x8 = __attribute__((ext_vector_type(8))) short;
using s16x4  = __attribute__((ext_vector_type(4))) short;
using f32x16 = __attribute__((ext_vector_type(16))) float;
using u32x4  = __attribute__((ext_vector_type(4))) unsigned;
constexpr int D = 128, NW = 8, QBLK = 32, KVBLK = 64, LDK = 3072, NT = 4;
constexpr float THR = 8.f;
constexpr size_t SHM_V = KVBLK * D * 2, SHM_K = KVBLK * D * 2, SHM_ATTN = 2 * SHM_V + 2 * SHM_K + NW * 64 * 4;
#define KSWZ(row, colB) ((row) * 256 + ((colB) ^ (((row) & 7) << 4)))
#define SBAR() __builtin_amdgcn_sched_barrier(0)
__device__ __forceinline__ int crow(int r, int hi) { return (r & 3) + 8 * (r >> 2) + 4 * hi; }
__device__ __forceinline__ unsigned cvtpk(float lo, float hi) { unsigned r; asm volatile("v_cvt_pk_bf16_f32 %0, %1, %2" : "=v"(r) : "v"(lo), "v"(hi)); return r; }
__device__ __forceinline__ void partialSM(f32x16& p0, f32x16& p1, float& m_reg, float& mn, float& alpha) {
  float pmax = p0[0];
#pragma unroll
  for (int r = 1; r < 16; ++r) pmax = fmaxf(pmax, p0[r]);
#pragma unroll
  for (int r = 0; r < 16; ++r) pmax = fmaxf(pmax, p1[r]);
  { auto rr = __builtin_amdgcn_permlane32_swap(__float_as_uint(pmax), __float_as_uint(pmax), false, false);
    pmax = fmaxf(__uint_as_float(rr[0]), __uint_as_float(rr[1])); }
  if (__builtin_expect(__all(pmax - m_reg <= THR), 1)) { mn = m_reg; alpha = 1.f; }
  else { mn = fmaxf(m_reg, pmax); alpha = __builtin_amdgcn_exp2f(m_reg - mn); m_reg = mn; }
#pragma unroll
  for (int r = 0; r < 16; ++r) p0[r] = p0[r] - mn;
#pragma unroll
  for (int r = 0; r < 16; ++r) p1[r] = p1[r] - mn;
#pragma unroll
  for (int r = 0; r < 16; ++r) p0[r] = __builtin_amdgcn_exp2f(p0[r]);
}
__device__ __forceinline__ void finishSM(f32x16& p0, f32x16& p1, float alpha, float& l_reg, bf16x8& pa0, bf16x8& pa1, bf16x8& pa2, bf16x8& pa3) {
#pragma unroll
  for (int r = 0; r < 16; ++r) p1[r] = __builtin_amdgcn_exp2f(p1[r]);
  float ps = 0;
#pragma unroll
  for (int r = 0; r < 16; ++r) ps += p0[r];
#pragma unroll
  for (int r = 0; r < 16; ++r) ps += p1[r];
  { auto rr = __builtin_amdgcn_permlane32_swap(__float_as_uint(ps), __float_as_uint(ps), false, false);
    ps = __uint_as_float(rr[0]) + __uint_as_float(rr[1]); }
  l_reg = l_reg * alpha + ps;
#define PK4(P, BASE, OUT) do { unsigned a0 = cvtpk(P[BASE + 0], P[BASE + 1]), a1 = cvtpk(P[BASE + 2], P[BASE + 3]);   \
    unsigned b0 = cvtpk(P[BASE + 4], P[BASE + 5]), b1 = cvtpk(P[BASE + 6], P[BASE + 7]);                              \
    auto r0 = __builtin_amdgcn_permlane32_swap(a0, b0, false, false); auto r1 = __builtin_amdgcn_permlane32_swap(a1, b1, false, false); \
    u32x4 w = {r0[0], r1[0], r0[1], r1[1]}; OUT = *reinterpret_cast<bf16x8*>(&w); } while (0)
  PK4(p0, 0, pa0); PK4(p0, 8, pa1); PK4(p1, 0, pa2); PK4(p1, 8, pa3);
#undef PK4
}
__device__ __forceinline__ void qkt(f32x16& p0, f32x16& p1, const bf16* Ks, const bf16x8* qr, int r32, int hi) {
  p0 = f32x16{}; p1 = f32x16{};
#pragma unroll
  for (int d0 = 0; d0 < 8; ++d0) { int cb = (d0 * 16 + hi * 8) * 2;
    bf16x8 b0 = *reinterpret_cast<const bf16x8*>((const char*)Ks + KSWZ(r32, cb));
    bf16x8 b1 = *reinterpret_cast<const bf16x8*>((const char*)Ks + KSWZ(32 + r32, cb));
    p0 = __builtin_amdgcn_mfma_f32_32x32x16_bf16(b0, qr[d0], p0, 0, 0, 0);
    p1 = __builtin_amdgcn_mfma_f32_32x32x16_bf16(b1, qr[d0], p1, 0, 0, 0); }
}
__device__ __forceinline__ int v_st(int k, int c) { const int kk = (k & ~0xC) | ((k & 4) << 1) | ((k & 8) >> 1); return ((kk >> 3) * 4 + (c >> 5)) * 512 + ((kk & 7) * 32 + (c & 31)) * 2; }
__device__ __forceinline__ int v_rd_base(int lane) { return ((lane & 3) << 3) | (((lane >> 2) & 3) << 6) | (((lane >> 4) & 1) << 5) | (((lane >> 5) & 1) << 8); }
constexpr int v_rd_off(int d0, int ks, int half) { return d0 * 512 + ks * 4096 + half * 2048; }
template <int OFF> __device__ __forceinline__ s16x4 tr_read(int vb) {
  s16x4 r; asm volatile("ds_read_b64_tr_b16 %0, %1 offset:%2" : "=&v"(r) : "v"(vb), "i"(OFF) : "memory"); return r;
}
template <int D0> __device__ __forceinline__ void pv_one(f32x16& od, int vb, bf16x8 pa0, bf16x8 pa1, bf16x8 pa2, bf16x8 pa3) {
  const s16x4 l0 = tr_read<v_rd_off(D0, 0, 0)>(vb), h0 = tr_read<v_rd_off(D0, 0, 1)>(vb), l1 = tr_read<v_rd_off(D0, 1, 0)>(vb), h1 = tr_read<v_rd_off(D0, 1, 1)>(vb);
  const s16x4 l2 = tr_read<v_rd_off(D0, 2, 0)>(vb), h2 = tr_read<v_rd_off(D0, 2, 1)>(vb), l3 = tr_read<v_rd_off(D0, 3, 0)>(vb), h3 = tr_read<v_rd_off(D0, 3, 1)>(vb);
  asm volatile("s_waitcnt lgkmcnt(0)" ::: "memory"); SBAR();
#define PK(L, H) (bf16x8){L[0], L[1], L[2], L[3], H[0], H[1], H[2], H[3]}
  od = __builtin_amdgcn_mfma_f32_32x32x16_bf16(pa0, PK(l0, h0), od, 0, 0, 0);
  od = __builtin_amdgcn_mfma_f32_32x32x16_bf16(pa1, PK(l1, h1), od, 0, 0, 0);
  od = __builtin_amdgcn_mfma_f32_32x32x16_bf16(pa2, PK(l2, h2), od, 0, 0, 0);
  od = __builtin_amdgcn_mfma_f32_32x32x16_bf16(pa3, PK(l3, h3), od, 0, 0, 0);
#undef PK
}
__device__ __forceinline__ void pv_d0(f32x16* o, int vb, bf16x8 pa0, bf16x8 pa1, bf16x8 pa2, bf16x8 pa3) {
  pv_one<0>(o[0], vb, pa0, pa1, pa2, pa3); pv_one<1>(o[1], vb, pa0, pa1, pa2, pa3); pv_one<2>(o[2], vb, pa0, pa1, pa2, pa3); pv_one<3>(o[3], vb, pa0, pa1, pa2, pa3);
}
__device__ __forceinline__ void cmask(f32x16& p0, f32x16& p1, int tile, int ql, int hi) {
  asm volatile("" : "+v"(ql));
#pragma unroll
  for (int r = 0; r < 16; ++r) { const int kv = 64 * tile + (r & 3) + 8 * (r >> 2) + 4 * hi; if (kv > ql) p0[r] = -1e30f; if (kv + 32 > ql) p1[r] = -1e30f; }
}
__device__ __forceinline__ void moba_unit(const bool OWN, const bf16* qrow, const bf16* __restrict__ Kh, const bf16* __restrict__ Vh, bf16* obase, int ostride, int dst, float* ml, int mli, int ql, char* lds) {
  const int tid = threadIdx.x, wid = tid >> 6, lane = tid & 63, r32 = lane & 31, hi = lane >> 5;
  bf16* V_lds = (bf16*)lds; bf16* K_lds = (bf16*)(lds + 2 * SHM_V);
  float* ws = (float*)(lds + 2 * SHM_V + 2 * SHM_K) + wid * 64; float* li_l = ws; float* al_l = ws + 32;
  float m_reg = -1e30f, l_reg = 0; f32x16 o[4] = {}; bf16x8 qr[8];
  const bf16* Qw = qrow + hi * 8;
#pragma unroll
  for (int d0 = 0; d0 < 8; ++d0) qr[d0] = *reinterpret_cast<const bf16x8*>(Qw + d0 * 16);
  const int sr = tid >> 4, sc = (tid & 15) * 8, vst0 = v_st(sr, sc), vst1 = v_st(32 + sr, sc);
  const int vb0 = (int)(uintptr_t)V_lds + v_rd_base(lane);
  struct { bf16x8 vs0, vs1, ks0, ks1; } sr_[2];
#define SLOAD(i, k0) do { sr_[i].vs0 = *reinterpret_cast<const bf16x8*>(&Vh[(long)((k0) + sr) * LDK + sc]); sr_[i].vs1 = *reinterpret_cast<const bf16x8*>(&Vh[(long)((k0) + 32 + sr) * LDK + sc]); \
    sr_[i].ks0 = *reinterpret_cast<const bf16x8*>(&Kh[(long)((k0) + sr) * LDK + sc]); sr_[i].ks1 = *reinterpret_cast<const bf16x8*>(&Kh[(long)((k0) + 32 + sr) * LDK + sc]); } while (0)
#define SWRITE(b, i) do { *(bf16x8*)((char*)V_lds + (b) * SHM_V + vst0) = sr_[i].vs0;          \
    *(bf16x8*)((char*)V_lds + (b) * SHM_V + vst1) = sr_[i].vs1; int kc = sc * 2;               \
    *(bf16x8*)((char*)K_lds + (b) * SHM_K + KSWZ(sr, kc)) = sr_[i].ks0;                       \
    *(bf16x8*)((char*)K_lds + (b) * SHM_K + KSWZ(32 + sr, kc)) = sr_[i].ks1; } while (0)
#define SWAIT() asm volatile("s_waitcnt vmcnt(4)" ::: "memory")
#define RESC(a) do { if (__any((a) < 1.f)) { if (hi == 0) al_l[r32] = (a); asm volatile("s_waitcnt lgkmcnt(0)" ::: "memory"); \
    _Pragma("unroll") for (int d = 0; d < 4; ++d) _Pragma("unroll") for (int r = 0; r < 16; ++r) o[d][r] *= al_l[crow(r, hi)]; } } while (0)
  f32x16 pA0, pA1, pB0, pB1; float mnA, mnB, alA, alB; bf16x8 pa0, pa1, pa2, pa3;
  constexpr int SE = 0, SO = 1;
  SLOAD(SE, 0); asm volatile("s_waitcnt vmcnt(0)" ::: "memory"); SWRITE(0, SE); __syncthreads();
  qkt(pA0, pA1, K_lds, qr, r32, hi); if (OWN) cmask(pA0, pA1, 0, ql, hi); partialSM(pA0, pA1, m_reg, mnA, alA);
  SLOAD(SO, KVBLK); SLOAD(SE, 2 * KVBLK);
  SWAIT(); SWRITE(1, SO); __syncthreads();
  {
    SBAR(); qkt(pB0, pB1, (bf16*)((char*)K_lds + SHM_K), qr, r32, hi);
    finishSM(pA0, pA1, alA, l_reg, pa0, pa1, pa2, pa3); SBAR();
    SLOAD(SO, 3 * KVBLK); SBAR();
    pv_d0(o, vb0, pa0, pa1, pa2, pa3); if (OWN) cmask(pB0, pB1, 1, ql, hi); partialSM(pB0, pB1, m_reg, mnB, alB);
    __syncthreads(); SWAIT(); SWRITE(0, SE);
    RESC(alB); __syncthreads();
    SBAR(); qkt(pA0, pA1, K_lds, qr, r32, hi);
    finishSM(pB0, pB1, alB, l_reg, pa0, pa1, pa2, pa3); SBAR();
    pv_d0(o, vb0 + (int)SHM_V, pa0, pa1, pa2, pa3); if (OWN) cmask(pA0, pA1, 2, ql, hi); partialSM(pA0, pA1, m_reg, mnA, alA);
    __syncthreads(); asm volatile("s_waitcnt vmcnt(0)" ::: "memory"); SWRITE(1, SO);
    RESC(alA); __syncthreads();
  }
  SBAR(); qkt(pB0, pB1, (bf16*)((char*)K_lds + SHM_K), qr, r32, hi);
  finishSM(pA0, pA1, alA, l_reg, pa0, pa1, pa2, pa3); SBAR();
  pv_d0(o, vb0, pa0, pa1, pa2, pa3); if (OWN) cmask(pB0, pB1, 3, ql, hi); partialSM(pB0, pB1, m_reg, mnB, alB);
  __syncthreads(); RESC(alB);
  finishSM(pB0, pB1, alB, l_reg, pa0, pa1, pa2, pa3); SBAR();
  pv_d0(o, vb0 + (int)SHM_V, pa0, pa1, pa2, pa3);
  if (hi == 0) li_l[r32] = l_reg; asm volatile("s_waitcnt lgkmcnt(0)" ::: "memory");
  float rli[16];
#pragma unroll
  for (int r = 0; r < 16; ++r) rli[r] = __builtin_amdgcn_rcpf(li_l[crow(r, hi)]);
  __syncthreads();
  bf16* stg = (bf16*)lds + wid * 4096;
#pragma unroll
  for (int r = 0; r < 16; ++r) { const int orow = crow(r, hi);
#pragma unroll
    for (int d0 = 0; d0 < 4; ++d0) stg[orow * 128 + d0 * 32 + r32] = __float2bfloat16(o[d0][r] * rli[r]); }
  int* dsto = (int*)al_l;
  if (hi == 0) dsto[r32] = dst;
  asm volatile("s_waitcnt lgkmcnt(0)" ::: "memory");
#pragma unroll
  for (int i = 0; i < 8; ++i) { const int row = i * 4 + (lane >> 4), ch = lane & 15; const int di = dsto[row]; const u32x4 v = *(const u32x4*)(stg + row * 128 + ch * 8);
    if (di >= 0) *(u32x4*)(obase + (size_t)di * ostride + ch * 8) = v; }
  if (hi == 0 && dst >= 0) { ml[2 * (size_t)mli] = m_reg; ml[2 * (size_t)mli + 1] = l_reg; }
  asm volatile("s_waitcnt lgkmcnt(0)" ::: "memory");
  __syncthreads();
#undef SLOAD
#undef SWRITE
#undef SWAIT
#undef RESC
}

#define KSWZ64(row, colB) ((row) * 128 + ((colB) ^ ((((row) >> 1) & 7) << 4)))
constexpr size_t DA_SHM_K = 64 * 64 * 2;
constexpr size_t DA_SHM = 2 * SHM_V + 2 * DA_SHM_K + NW * 64 * 4;
__device__ __forceinline__ void qkt64(f32x16& p0, f32x16& p1, const bf16* Ks, const bf16x8* qr, int r32, int hi) {
  p0 = f32x16{}; p1 = f32x16{};
#pragma unroll
  for (int d0 = 0; d0 < 4; ++d0) { int cb = (d0 * 16 + hi * 8) * 2;
    bf16x8 b0 = *reinterpret_cast<const bf16x8*>((const char*)Ks + KSWZ64(r32, cb));
    bf16x8 b1 = *reinterpret_cast<const bf16x8*>((const char*)Ks + KSWZ64(32 + r32, cb));
    p0 = __builtin_amdgcn_mfma_f32_32x32x16_bf16(b0, qr[d0], p0, 0, 0, 0);
    p1 = __builtin_amdgcn_mfma_f32_32x32x16_bf16(b1, qr[d0], p1, 0, 0, 0); }
}
__device__ __forceinline__ void dattn_unit(const bf16* Qb, const bf16* __restrict__ Kh, const bf16* __restrict__ Vh, bf16* Ob, const int NT, char* lds) {
  const int tid = threadIdx.x, wid = tid >> 6, lane = tid & 63, r32 = lane & 31, hi = lane >> 5;
  bf16* V_lds = (bf16*)lds; bf16* K_lds = (bf16*)(lds + 2 * SHM_V);
  float* ws = (float*)(lds + 2 * SHM_V + 2 * DA_SHM_K) + wid * 64; float* li_l = ws; float* al_l = ws + 32;
  float m_reg = -1e30f, l_reg = 0; f32x16 o[4] = {}; bf16x8 qr[4];
  const bf16* Qw = Qb + (long)(wid * QBLK + r32) * LDK + hi * 8;
#pragma unroll
  for (int d0 = 0; d0 < 4; ++d0) qr[d0] = *reinterpret_cast<const bf16x8*>(Qw + d0 * 16);
  const int sr = tid >> 4, sc = (tid & 15) * 8, vst0 = v_st(sr, sc), vst1 = v_st(32 + sr, sc);
  const int kr = tid >> 3, kc = (tid & 7) * 8, kst = KSWZ64(kr, kc * 2);
  const int vb0 = (int)(uintptr_t)V_lds + v_rd_base(lane);
  const int ql = wid * QBLK + r32;
  struct { bf16x8 vs0, vs1, ks; } sr_[2];
#define SLOAD(i, k0) do { sr_[i].vs0 = *reinterpret_cast<const bf16x8*>(&Vh[(long)((k0) + sr) * LDK + sc]); sr_[i].vs1 = *reinterpret_cast<const bf16x8*>(&Vh[(long)((k0) + 32 + sr) * LDK + sc]); \
    sr_[i].ks = *reinterpret_cast<const bf16x8*>(&Kh[(long)((k0) + kr) * LDK + kc]); } while (0)
#define SWRITE(b, i) do { *(bf16x8*)((char*)V_lds + (b) * SHM_V + vst0) = sr_[i].vs0; *(bf16x8*)((char*)V_lds + (b) * SHM_V + vst1) = sr_[i].vs1; \
    *(bf16x8*)((char*)K_lds + (b) * DA_SHM_K + kst) = sr_[i].ks; } while (0)
#define SWAIT() asm volatile("s_waitcnt vmcnt(3)" ::: "memory")
#define RESC(a) do { if (__any((a) < 1.f)) { if (hi == 0) al_l[r32] = (a); asm volatile("s_waitcnt lgkmcnt(0)" ::: "memory"); \
    _Pragma("unroll") for (int d = 0; d < 4; ++d) _Pragma("unroll") for (int r = 0; r < 16; ++r) o[d][r] *= al_l[crow(r, hi)]; } } while (0)
#define MASK(P0, P1, t) do { if ((t) >= NT - 4) cmask(P0, P1, (t) - (NT - 4), ql, hi); } while (0)
  f32x16 pA0, pA1, pB0, pB1; float mnA, mnB, alA, alB; bf16x8 pa0, pa1, pa2, pa3;
  constexpr int SE = 0, SO = 1;
  SLOAD(SE, 0); asm volatile("s_waitcnt vmcnt(0)" ::: "memory"); SWRITE(0, SE); __syncthreads();
  qkt64(pA0, pA1, K_lds, qr, r32, hi); MASK(pA0, pA1, 0); partialSM(pA0, pA1, m_reg, mnA, alA);
  SLOAD(SO, KVBLK); SLOAD(SE, 2 * KVBLK);
  SWAIT(); SWRITE(1, SO); __syncthreads();
  for (int j = 1; j + 1 < NT; j += 2) {
    SBAR(); qkt64(pB0, pB1, (bf16*)((char*)K_lds + DA_SHM_K), qr, r32, hi);
    finishSM(pA0, pA1, alA, l_reg, pa0, pa1, pa2, pa3); SBAR();
    SLOAD(SO, (j + 2) * KVBLK); SBAR();
    pv_d0(o, vb0, pa0, pa1, pa2, pa3); MASK(pB0, pB1, j); partialSM(pB0, pB1, m_reg, mnB, alB);
    __syncthreads(); SWAIT(); SWRITE(0, SE);
    RESC(alB); __syncthreads();
    SBAR(); qkt64(pA0, pA1, K_lds, qr, r32, hi);
    finishSM(pB0, pB1, alB, l_reg, pa0, pa1, pa2, pa3); SBAR();
    if (j + 3 < NT) SLOAD(SE, (j + 3) * KVBLK); SBAR();
    pv_d0(o, vb0 + (int)SHM_V, pa0, pa1, pa2, pa3); MASK(pA0, pA1, j + 1); partialSM(pA0, pA1, m_reg, mnA, alA);
    __syncthreads(); SWAIT(); SWRITE(1, SO);
    RESC(alA); __syncthreads();
  }
  SBAR(); qkt64(pB0, pB1, (bf16*)((char*)K_lds + DA_SHM_K), qr, r32, hi);
  finishSM(pA0, pA1, alA, l_reg, pa0, pa1, pa2, pa3); SBAR();
  pv_d0(o, vb0, pa0, pa1, pa2, pa3); MASK(pB0, pB1, NT - 1); partialSM(pB0, pB1, m_reg, mnB, alB);
  __syncthreads(); RESC(alB);
  finishSM(pB0, pB1, alB, l_reg, pa0, pa1, pa2, pa3); SBAR();
  pv_d0(o, vb0 + (int)SHM_V, pa0, pa1, pa2, pa3);
  if (hi == 0) li_l[r32] = l_reg; asm volatile("s_waitcnt lgkmcnt(0)" ::: "memory");
  float rli[16];
#pragma unroll
  for (int r = 0; r < 16; ++r) rli[r] = __builtin_amdgcn_rcpf(li_l[crow(r, hi)]);
  __syncthreads();
  bf16* stg = (bf16*)lds + wid * 4096;
#pragma unroll
  for (int r = 0; r < 16; ++r) { const int orow = crow(r, hi);
#pragma unroll
    for (int d0 = 0; d0 < 4; ++d0) stg[orow * 128 + d0 * 32 + r32] = __float2bfloat16(o[d0][r] * rli[r]); }
  asm volatile("s_waitcnt lgkmcnt(0)" ::: "memory");
#pragma unroll
  for (int i = 0; i < 8; ++i) { const int row = i * 4 + (lane >> 4), ch = lane & 15; const u32x4 v = *(const u32x4*)(stg + row * 128 + ch * 8);
    *(u32x4*)(Ob + (size_t)(wid * QBLK + row) * 2048 + ch * 8) = v; }
  asm volatile("s_waitcnt lgkmcnt(0)" ::: "memory");
  __syncthreads();
#undef SLOAD
#undef SWRITE
#undef SWAIT
#undef RESC
#undef MASK
}

__device__ __forceinline__ void glds16(const void* gsrc, unsigned lds_dst) { unsigned keep;
  asm volatile("s_mov_b32 %0, m0\n\ts_mov_b32 m0, %2\n\ts_nop 0\n\tglobal_load_lds_dwordx4 %1, off\n\ts_mov_b32 m0, %0" : "=&s"(keep) : "v"(gsrc), "s"(lds_dst) : "memory"); }
#define WAIT_BAR(N) asm volatile("s_waitcnt vmcnt(" #N ") lgkmcnt(0)\n\ts_barrier" ::: "memory")
constexpr int DA2_STG = 24576;
constexpr size_t DA2_SHM = 3 * DA2_STG + NW * 64 * 4;
__device__ __forceinline__ void qkt64m(f32x16& p0, f32x16& p1, const bf16* Ks, const bf16x8* qr, bf16x8 qm, bf16x8 kneg, int r32, int hi) {
  p0 = __builtin_amdgcn_mfma_f32_32x32x16_bf16(kneg, qm, f32x16{}, 0, 0, 0); p1 = p0;
#pragma unroll
  for (int h2 = 0; h2 < 2; ++h2) {
    bf16x8 kf[4];
#pragma unroll
    for (int d = 0; d < 2; ++d) { int cb = ((2 * h2 + d) * 16 + hi * 8) * 2;
      kf[2 * d] = *reinterpret_cast<const bf16x8*>((const char*)Ks + KSWZ64(r32, cb));
      kf[2 * d + 1] = *reinterpret_cast<const bf16x8*>((const char*)Ks + KSWZ64(32 + r32, cb)); }
    SBAR();
#pragma unroll
    for (int d = 0; d < 2; ++d) {
      p0 = __builtin_amdgcn_mfma_f32_32x32x16_bf16(kf[2 * d], qr[2 * h2 + d], p0, 0, 0, 0);
      p1 = __builtin_amdgcn_mfma_f32_32x32x16_bf16(kf[2 * d + 1], qr[2 * h2 + d], p1, 0, 0, 0); }
  }
}
__device__ __forceinline__ void partialSM2(f32x16& p0, f32x16& p1, float& m_ref, bf16x8& qm, float& alpha, const bool first, const int hi) {
  float pmax = p0[0];
#pragma unroll
  for (int r = 1; r < 16; ++r) pmax = fmaxf(pmax, p0[r]);
#pragma unroll
  for (int r = 0; r < 16; ++r) pmax = fmaxf(pmax, p1[r]);
  { auto rr = __builtin_amdgcn_permlane32_swap(__float_as_uint(pmax), __float_as_uint(pmax), false, false);
    pmax = fmaxf(__uint_as_float(rr[0]), __uint_as_float(rr[1])); }
  alpha = 1.f;
  if (__builtin_expect(first || __any(pmax > THR), 0)) {
    const bool upd = first || (pmax > THR);
    const float mn = m_ref + pmax; const unsigned b = __float_as_uint(mn);
    const float mup = __uint_as_float(mn >= 0.f ? ((b + 0xFFFFu) & 0xFFFF0000u) : (b & 0xFFFF0000u));
    const float mnew = upd ? mup : m_ref; const float delta = mnew - m_ref;
    m_ref = mnew; alpha = __builtin_amdgcn_exp2f(-delta);
#pragma unroll
    for (int r = 0; r < 16; ++r) { p0[r] -= delta; p1[r] -= delta; }
    qm[0] = (hi == 0) ? (short)(__float_as_uint(m_ref) >> 16) : (short)0;
  }
#pragma unroll
  for (int r = 0; r < 16; ++r) p0[r] = __builtin_amdgcn_exp2f(p0[r]);
}
__device__ __forceinline__ void dattn_unit2(const bf16* Qb, const bf16* __restrict__ Kh, const bf16* __restrict__ Vh, bf16* Ob, const int NT, char* lds) {
  const int tid = threadIdx.x, lane = tid & 63, r32 = lane & 31, hi = lane >> 5; const int wid = __builtin_amdgcn_readfirstlane(tid >> 6);
  const unsigned lds0 = (unsigned)(uintptr_t)lds;
  float* ws = (float*)(lds + 3 * DA2_STG) + wid * 64; float* li_l = ws; float* al_l = ws + 32;
  const int krow = 8 * wid + (lane >> 3), kch = (lane & 7) ^ ((krow >> 1) & 7);
  const bf16* ksrc = Kh + (long)krow * LDK + kch * 8;
  const bf16* vsrc[2];
#pragma unroll
  for (int i = 0; i < 2; ++i) { const int off = (i * 8 + wid) * 1024 + lane * 16, sub = off >> 9, within = (off & 511) >> 1;
    const int kk = (sub >> 2) * 8 + (within >> 5), c = (sub & 3) * 32 + (within & 31), k = (kk & ~0xC) | ((kk & 4) << 1) | ((kk & 8) >> 1);
    vsrc[i] = Vh + (long)k * LDK + c; }
  const unsigned kdst = lds0 + wid * 1024, vdst = lds0 + 8192 + wid * 1024;
#define DMA(t, st) do { const long go_ = (long)(t) * KVBLK * LDK; glds16(ksrc + go_, (unsigned)__builtin_amdgcn_readfirstlane(kdst + (st))); \
    glds16(vsrc[0] + go_, (unsigned)__builtin_amdgcn_readfirstlane(vdst + (st))); glds16(vsrc[1] + go_, (unsigned)__builtin_amdgcn_readfirstlane(vdst + 8192 + (st))); } while (0)
  DMA(0, 0);
  float m_ref = 0.f, l_reg = 0.f; f32x16 o[4] = {}; bf16x8 qr[4]; bf16x8 qm = {0, 0, 0, 0, 0, 0, 0, 0};
  const bf16x8 kneg = {(short)(hi == 0 ? (short)0xBF80 : (short)0), 0, 0, 0, 0, 0, 0, 0};
  const bf16* Qw = Qb + (long)(wid * QBLK + r32) * LDK + hi * 8;
#pragma unroll
  for (int d0 = 0; d0 < 4; ++d0) qr[d0] = *reinterpret_cast<const bf16x8*>(Qw + d0 * 16);
  const int ql = wid * QBLK + r32;
#define RESC(a) do { if (__any((a) < 1.f)) { if (hi == 0) al_l[r32] = (a); asm volatile("s_waitcnt lgkmcnt(0)" ::: "memory"); \
    _Pragma("unroll") for (int d = 0; d < 4; ++d) _Pragma("unroll") for (int r = 0; r < 16; ++r) o[d][r] *= al_l[crow(r, hi)]; } } while (0)
#define MASK(P0, P1, t) do { if ((t) >= NT - 4) cmask(P0, P1, (t) - (NT - 4), ql, hi); } while (0)
#define KST(sx) ((const bf16*)(lds + (sx)))
#define VST(sx) ((int)(lds0 + 8192 + (sx)) + v_rd_base(lane))
  f32x16 pA0, pA1, pB0, pB1; float alA, alB; bf16x8 pa0, pa1, pa2, pa3;
  int s0 = 0, s1 = DA2_STG, s2 = 2 * DA2_STG;
  WAIT_BAR(0);
  DMA(1, DA2_STG);
  qkt64m(pA0, pA1, KST(0), qr, qm, kneg, r32, hi); MASK(pA0, pA1, 0); partialSM2(pA0, pA1, m_ref, qm, alA, true, hi);
  WAIT_BAR(2);
  DMA(2, 2 * DA2_STG);
  for (int j = 1; j + 1 < NT; j += 2) {
    SBAR(); qkt64m(pB0, pB1, KST(s1), qr, qm, kneg, r32, hi);
    finishSM(pA0, pA1, alA, l_reg, pa0, pa1, pa2, pa3); SBAR();
    pv_d0(o, VST(s0), pa0, pa1, pa2, pa3); MASK(pB0, pB1, j); partialSM2(pB0, pB1, m_ref, qm, alB, false, hi);
    WAIT_BAR(2);
    if (j + 2 < NT) DMA(j + 2, s0);
    RESC(alB);
    SBAR(); qkt64m(pA0, pA1, KST(s2), qr, qm, kneg, r32, hi);
    finishSM(pB0, pB1, alB, l_reg, pa0, pa1, pa2, pa3); SBAR();
    pv_d0(o, VST(s1), pa0, pa1, pa2, pa3); MASK(pA0, pA1, j + 1); partialSM2(pA0, pA1, m_ref, qm, alA, false, hi);
    WAIT_BAR(2);
    if (j + 3 < NT) DMA(j + 3, s1);
    RESC(alA);
    { const int t_ = s0; s0 = s2; s2 = s1; s1 = t_; }
  }
  SBAR(); qkt64m(pB0, pB1, KST(s1), qr, qm, kneg, r32, hi);
  finishSM(pA0, pA1, alA, l_reg, pa0, pa1, pa2, pa3); SBAR();
  pv_d0(o, VST(s0), pa0, pa1, pa2, pa3); MASK(pB0, pB1, NT - 1); partialSM2(pB0, pB1, m_ref, qm, alB, false, hi);
  WAIT_BAR(0);
  RESC(alB);
  finishSM(pB0, pB1, alB, l_reg, pa0, pa1, pa2, pa3); SBAR();
  pv_d0(o, VST(s1), pa0, pa1, pa2, pa3);
  if (hi == 0) li_l[r32] = l_reg; asm volatile("s_waitcnt lgkmcnt(0)" ::: "memory");
  float rli[16];
#pragma unroll
  for (int r = 0; r < 16; ++r) rli[r] = __builtin_amdgcn_rcpf(li_l[crow(r, hi)]);
  WAIT_BAR(0);
  bf16* stg = (bf16*)lds + wid * 4096;
#pragma unroll
  for (int r = 0; r < 16; ++r) { const int orow = crow(r, hi);
#pragma unroll
    for (int d0 = 0; d0 < 4; ++d0) stg[orow * 128 + d0 * 32 + r32] = __float2bfloat16(o[d0][r] * rli[r]); }
  asm volatile("s_waitcnt lgkmcnt(0)" ::: "memory");
#pragma unroll
  for (int i = 0; i < 8; ++i) { const int row = i * 4 + (lane >> 4), ch = lane & 15; const u32x4 v = *(const u32x4*)(stg + row * 128 + ch * 8);
    *(u32x4*)(Ob + (size_t)(wid * QBLK + row) * 2048 + ch * 8) = v; }
  asm volatile("s_waitcnt lgkmcnt(0)\n\ts_barrier" ::: "memory");
#undef DMA
#undef RESC
#undef MASK
#undef KST
#undef VST
}
#undef WAIT_BAR
struct DaUnit { int bqh; int qb; };
struct DaOrder {
  int vcu, G;
  __device__ __forceinline__ DaOrder(int vcu_, int G_) : vcu(vcu_), G(G_) {}
  __device__ __forceinline__ bool next(int i, DaUnit& u) const {
    if (G == 256) { if (i >= 8) return false; const int s = vcu & 7, ii = i & 3; u.bqh = (i >> 2) * 32 + (vcu >> 3); u.qb = (ii == 0) ? s : (ii == 1) ? 15 - s : (ii == 2) ? 16 + s : 31 - s; return true; }
    const int uu = vcu + i * G; if (uu >= 2048) return false; u.bqh = uu >> 5; u.qb = uu & 31; return true; }
};
template <class Sched> __device__ __forceinline__ void dattn_phase(char* lds, const bf16* QKV, bf16* O, const Sched& S) {
  DaUnit u;
  for (int i = 0; S.next(i, u); ++i) { const int b = u.bqh >> 4, qh = u.bqh & 15; const size_t rb = (size_t)b * 8192;
    dattn_unit2(QKV + (rb + u.qb * 256) * LDK + qh * 64, QKV + rb * LDK + 1024 + qh * 64, QKV + rb * LDK + 2048 + (qh >> 1) * 128, O + (rb + u.qb * 256) * 2048 + qh * 128, 4 * (u.qb + 1), lds); }
}
#undef KSWZ64
#undef KSWZ
#undef SBAR
}
#define GAS __attribute__((address_space(1)))
#define LAS __attribute__((address_space(3)))
typedef unsigned short bf16;
typedef unsigned v4u __attribute__((ext_vector_type(4)));
typedef float f32x4 __attribute__((ext_vector_type(4)));
typedef short bf16x8 __attribute__((ext_vector_type(8)));
typedef GAS unsigned gu32;
typedef GAS unsigned long long gu64;
#define RLX_AGENT __ATOMIC_RELAXED, __HIP_MEMORY_SCOPE_AGENT
#define LDS_WAIT() asm volatile("s_waitcnt lgkmcnt(0)" ::: "memory")
#define VM_WAIT() asm volatile("s_waitcnt vmcnt(0)" ::: "memory")
__device__ __forceinline__ unsigned long long rt() { return __builtin_amdgcn_s_memrealtime(); }
__device__ __forceinline__ unsigned f2bf(float f) { unsigned u = __builtin_bit_cast(unsigned, f); return (u + 0x7fffu + ((u >> 16) & 1u)) >> 16; }
__device__ __forceinline__ unsigned pk2(float lo, float hi) { return f2bf(lo) | (f2bf(hi) << 16); }
#define XB_TMO      128
#define XB_XCNT(j)  (256  + 64 * (j))
#define XB_XSUB(j)  (1280 + 64 * (j))
#define XB_XGEN(j)  (2304 + 64 * (j))
#define XB_TOP      3328
#define XB_TOPGEN   3392
#define XCD_BAR_WORDS 3456
#define XB_SPIN_CAP (1u << 18)

__device__ __forceinline__ unsigned xb_ld(unsigned* p)              { return __hip_atomic_load(p, __ATOMIC_RELAXED, __HIP_MEMORY_SCOPE_AGENT); }
__device__ __forceinline__ unsigned xb_add(unsigned* p, unsigned v) { return __hip_atomic_fetch_add(p, v, __ATOMIC_RELAXED, __HIP_MEMORY_SCOPE_AGENT); }
__device__ __forceinline__ unsigned xb_xcc_id() { return (unsigned)__builtin_amdgcn_s_getreg((3 << 11) | 20) & 0xFu; }
#define XB_SPIN(cond, bar) do { unsigned _sp = 0; while (cond) { __builtin_amdgcn_s_sleep(1); \
    if ((++_sp & 255u) == 0u) { if (xb_ld(&(bar)[XB_TMO])) break; if (_sp > XB_SPIN_CAP) { atomicAdd(&(bar)[XB_TMO], 1u); break; } } } } while (0)

struct XcdBarrier {
    unsigned* bar; unsigned x;
    volatile LAS unsigned* st;
};

__device__ __forceinline__ XcdBarrier xcd_barrier_post(unsigned* bar, volatile LAS unsigned* st) {
    XcdBarrier b; b.bar = bar; b.x = xb_xcc_id(); b.st = st;
    if (threadIdx.x == 0) (void)xb_add(&bar[XB_XCNT(b.x)], 1u);
    return b;
}
__device__ __forceinline__ void xcd_barrier_complete(unsigned* bar, unsigned x, unsigned& nloc, unsigned& nx) {
    const unsigned G = gridDim.x * gridDim.y * gridDim.z;
    unsigned sum, cnt, mine, sp = 0u;
    for (;;) {
        sum = 0u; cnt = 0u; mine = 0u;
#pragma unroll
        for (unsigned j = 0; j < 16; ++j) { const unsigned c = xb_ld(&bar[XB_XCNT(j)]); sum += c; cnt += (c > 0u) ? 1u : 0u; mine = (j == x) ? c : mine; }
        if (sum == G) break;
        __builtin_amdgcn_s_sleep(1);
        if ((++sp & 255u) == 0u) { if (xb_ld(&bar[XB_TMO])) break; if (sp > XB_SPIN_CAP) { atomicAdd(&bar[XB_TMO], 1u); break; } }
    }
    nloc = mine > 0u ? mine : 1u; nx = cnt > 0u ? cnt : 1u;
}

__device__ __forceinline__ void xcd_barrier(const XcdBarrier& b) {
    asm volatile("s_waitcnt vmcnt(0)" ::: "memory");
    __syncthreads();
    if (threadIdx.x == 0) {
        unsigned* bar = b.bar;
        __builtin_amdgcn_s_waitcnt(0);
        unsigned nloc = b.st[0], nx = b.st[1];
        if (nloc == 0u) { xcd_barrier_complete(bar, b.x, nloc, nx); b.st[0] = nloc; b.st[1] = nx; }
        const unsigned old = xb_add(&bar[XB_XSUB(b.x)], 1u);
        const unsigned gen = old / nloc;
        if (old + 1u == (gen + 1u) * nloc) {
            __builtin_amdgcn_fence(__ATOMIC_RELEASE, "agent");
            asm volatile("s_waitcnt vmcnt(0)" ::: "memory");
            const unsigned og = xb_add(&bar[XB_TOP], 1u);
            const unsigned tg = og / nx;
            if (og + 1u == (tg + 1u) * nx) xb_add(&bar[XB_TOPGEN], 1u);
            else XB_SPIN(xb_ld(&bar[XB_TOPGEN]) == tg, bar);
            __builtin_amdgcn_fence(__ATOMIC_ACQUIRE, "agent");
            xb_add(&bar[XB_XGEN(b.x)], 1u);
            asm volatile("s_waitcnt vmcnt(0)" ::: "memory");
        } else {
            XB_SPIN(xb_ld(&bar[XB_XGEN(b.x)]) == gen, bar);
            __builtin_amdgcn_fence(__ATOMIC_ACQUIRE, "agent");
            asm volatile("s_waitcnt vmcnt(0)" ::: "memory");
        }
    }
    __syncthreads();
}

constexpr int NWAVES = 8;
#ifndef GEMM_ALIGN
#define GEMM_ALIGN true
#endif
#ifndef MK_PER_PHASE
#define MK_PER_PHASE 0
#endif
constexpr int BATCH = 4, SEQ = 8192, DM = 1024, TOK = BATCH * SEQ;
constexpr int FF0 = 2816, NEXP = 8, FF1 = 3584;
constexpr int NQKV = 3072;
constexpr int MB_H = 8, MB_NB = 32, MB_L = 256;
constexpr int SLOTS = TOK + NEXP * 256;
constexpr float NORM_EPS = 1e-6f, SUBLN_EPS = 1e-5f;
constexpr float LAMBDA_INIT0 = 0.2f;
constexpr float LOG2E = 1.4426950408889634f;
constexpr int LIST_PER_BH = 256 * 496;
__host__ __device__ constexpr int list_off(int j) { return 256 * (31 * j - (j * (j - 1)) / 2); }

constexpr size_t MiB = 1u << 20;
constexpr size_t WS_CTL = 0, CTL_ZERO_BYTES = 3 * MiB;
constexpr size_t WS_CMAX13 = 2 * MiB;
constexpr size_t WS_CMAX2 = WS_CMAX13 + 256 * 1024;
constexpr size_t WS_SSTOT = WS_CMAX2 + 64 * 1024;
constexpr size_t WS_CM0 = WS_CMAX2 + 128 * 1024;
constexpr size_t WS_ROPE64 = 3 * MiB;
constexpr size_t WS_ROPE128 = WS_ROPE64 + 512 * 1024;
constexpr size_t WS_KMEAN = 2 * MiB + 512 * 1024;
constexpr size_t WS_TOK = 5 * MiB;
constexpr size_t WS_SLOT = 6 * MiB;
constexpr size_t WS_SA = 7 * MiB;
constexpr size_t WS_OWNML = 41 * MiB;
constexpr size_t WS_W0QKV = 8 * MiB, WS_W0O = 14 * MiB, WS_W013 = 16 * MiB, WS_W02 = 27 * MiB, WS_W1QKV = 33 * MiB, WS_W1O = 39 * MiB;
constexpr size_t B0 = 43 * MiB;
constexpr size_t WS_H = B0;
constexpr size_t WS_QKV = B0 + 64 * MiB;
constexpr size_t WS_OATT = B0 + 256 * MiB;
constexpr size_t WS_UD = B0 + 128 * MiB;
constexpr size_t WS_LIST = B0 + 256 * MiB;
constexpr size_t WS_PML = B0 + 272 * MiB;
constexpr size_t WS_PO = B0 + 280 * MiB;
constexpr size_t WS_WM13 = B0 + 64 * MiB;
constexpr size_t WS_WM2 = WS_WM13 + 56 * MiB;
constexpr size_t WS_AQ = WS_WM2 + 28 * MiB;
constexpr size_t WS_UM = B0 + 232 * MiB;
constexpr size_t WS_END = WS_PO + (size_t)TOK * MB_H * 3 * 128 * 2;
static_assert(WS_UM + (size_t)SLOTS * FF1 <= WS_END && WS_AQ + (size_t)TOK * DM <= WS_UM && WS_END <= 528 * MiB, "d_ws map");
constexpr int CW_TMO = 0, CW_CODE = 1, CW_DBG = 2;
constexpr int CW_MOECNT = 64;
constexpr int CW_MOBACNT = 256;
constexpr int CW_BAR = 4096;
constexpr size_t WS_RSS = 1 * MiB;
constexpr int RING_OFF = 0, RING_BYTES = 131072;
constexpr int LDSCTL_OFF = RING_BYTES, MISC_OFF = LDSCTL_OFF + 320;
constexpr int LDS_BYTES = 147456;

struct Args { const float* in[20]; float* out; unsigned char* ws; float inv64[8]; float inv128[16]; int ph_lo, ph_hi; };

__device__ __forceinline__ float wave_sum(float v) {
#pragma unroll
    for (int o = 1; o < 64; o <<= 1) v += __shfl_xor(v, o);
    return v;
}
template <int MAP> __device__ __forceinline__ int maprow(int n) {
    if (MAP == 1) { if (n >= 2048) return n; const int d = n & 63; if (d >= 16) return n; const int b = d >> 3, a = (d >> 2) & 1, c = d & 3; return (n & ~63) + 8 * a + 4 * b + c; }
    if (MAP == 2) { if (n >= 2048) return n; const int d = n & 127; if (d >= 32) return n; const int b = d >> 4, a = (d >> 2) & 3, c = d & 3; return (n & ~127) + 8 * a + 4 * b + c; }
    if (MAP == 3) return 256 * (n >> 7) + (n & 127);
    if (MAP == 4) return 256 * (n >> 7) + 128 + (n & 127);
    return n;
}
template <int MAP> __device__ __forceinline__ void transpose_item(const float* W, int K, int N, bf16* WT, LAS float* scr, int item, int lane, const float* gk = nullptr) {
    const int nblk = N / 32, kb = item / nblk, nb = item % nblk, k0 = 64 * kb, n0 = 32 * nb;
    const int kr = lane >> 3, nc = (lane & 7) * 4;
    f32x4 v[8];
#pragma unroll
    for (int i = 0; i < 8; ++i) v[i] = *(const GAS f32x4*)(W + (size_t)(k0 + i * 8 + kr) * N + n0 + nc);
    if (gk) {
#pragma unroll
        for (int i = 0; i < 8; ++i) v[i] = v[i] * gk[k0 + i * 8 + kr]; }
#pragma unroll
    for (int i = 0; i < 8; ++i) { LAS float* d = scr + (i * 8 + kr) * 33 + nc; d[0] = v[i].x; d[1] = v[i].y; d[2] = v[i].z; d[3] = v[i].w; }
    LDS_WAIT(); asm volatile("" ::: "memory");
    const int c = lane & 7;
#pragma unroll
    for (int j = 0; j < 4; ++j) { const int n = (lane >> 3) + 8 * j; const LAS float* s = scr + (8 * c) * 33 + n;
        v4u o; o.x = pk2(s[0 * 33], s[1 * 33]); o.y = pk2(s[2 * 33], s[3 * 33]); o.z = pk2(s[4 * 33], s[5 * 33]); o.w = pk2(s[6 * 33], s[7 * 33]);
        *(GAS v4u*)(WT + (size_t)maprow<MAP>(n0 + n) * K + k0 + 8 * c) = o; }
    LDS_WAIT(); asm volatile("" ::: "memory");
}

template <int MAP> __device__ __forceinline__ float wmax_strip(const float* W, int N, unsigned* cmax, int kb0, int nkb, int nb, int lane, const float* gk) {
    const int n0 = 32 * nb, kr = lane >> 3, nc = (lane & 7) * 4;
    f32x4 mx = (f32x4){0.f, 0.f, 0.f, 0.f}; float ss = 0.f;
    for (int kb = kb0; kb < kb0 + nkb; ++kb) { const int k0 = 64 * kb;
        f32x4 v[8];
#pragma unroll
        for (int i = 0; i < 8; ++i) v[i] = *(const GAS f32x4*)(W + (size_t)(k0 + i * 8 + kr) * N + n0 + nc);
        if (gk) {
#pragma unroll
            for (int i = 0; i < 8; ++i) v[i] = v[i] * gk[k0 + i * 8 + kr]; }
#pragma unroll
        for (int i = 0; i < 8; ++i) { mx.x = fmaxf(mx.x, fabsf(v[i].x)); mx.y = fmaxf(mx.y, fabsf(v[i].y)); mx.z = fmaxf(mx.z, fabsf(v[i].z)); mx.w = fmaxf(mx.w, fabsf(v[i].w));
            ss += (v[i].x * v[i].x + v[i].y * v[i].y) + (v[i].z * v[i].z + v[i].w * v[i].w); } }
#pragma unroll
    for (int o = 8; o < 64; o <<= 1) { mx.x = fmaxf(mx.x, __shfl_xor(mx.x, o)); mx.y = fmaxf(mx.y, __shfl_xor(mx.y, o)); mx.z = fmaxf(mx.z, __shfl_xor(mx.z, o)); mx.w = fmaxf(mx.w, __shfl_xor(mx.w, o)); }
    if (lane < 8) {
        __hip_atomic_fetch_max(cmax + maprow<MAP>(n0 + nc + 0), __float_as_uint(mx.x), __ATOMIC_RELAXED, __HIP_MEMORY_SCOPE_AGENT);
        __hip_atomic_fetch_max(cmax + maprow<MAP>(n0 + nc + 1), __float_as_uint(mx.y), __ATOMIC_RELAXED, __HIP_MEMORY_SCOPE_AGENT);
        __hip_atomic_fetch_max(cmax + maprow<MAP>(n0 + nc + 2), __float_as_uint(mx.z), __ATOMIC_RELAXED, __HIP_MEMORY_SCOPE_AGENT);
        __hip_atomic_fetch_max(cmax + maprow<MAP>(n0 + nc + 3), __float_as_uint(mx.w), __ATOMIC_RELAXED, __HIP_MEMORY_SCOPE_AGENT); }
    return ss;
}
template <int MAP> __device__ __forceinline__ void transpose_item_q(const float* W, int K, int N, signed char* WT, const unsigned* cmax, LAS float* scr, int item, int lane, const float* gk) {
    const int nblk = N / 32, kb = item / nblk, nb = item % nblk, k0 = 64 * kb, n0 = 32 * nb;
    const int kr = lane >> 3, nc = (lane & 7) * 4;
    f32x4 v[8];
#pragma unroll
    for (int i = 0; i < 8; ++i) v[i] = *(const GAS f32x4*)(W + (size_t)(k0 + i * 8 + kr) * N + n0 + nc);
    if (gk) {
#pragma unroll
        for (int i = 0; i < 8; ++i) v[i] = v[i] * gk[k0 + i * 8 + kr]; }
#pragma unroll
    for (int i = 0; i < 8; ++i) { LAS float* d = scr + (i * 8 + kr) * 33 + nc; d[0] = v[i].x; d[1] = v[i].y; d[2] = v[i].z; d[3] = v[i].w; }
    LDS_WAIT(); asm volatile("" ::: "memory");
    const int half = lane >> 5, n = lane & 31, row = maprow<MAP>(n0 + n);
    const float cm = __uint_as_float(cmax[row]); const float inv = cm > 0.f ? 127.0f / cm : 0.f;
    const LAS float* s = scr + (32 * half) * 33 + n;
    unsigned w[8];
#pragma unroll
    for (int q4 = 0; q4 < 8; ++q4) { unsigned pk = 0;
#pragma unroll
        for (int b = 0; b < 4; ++b) { const int q = (int)__builtin_rintf(s[(4 * q4 + b) * 33] * inv); pk |= (unsigned)(q & 255) << (8 * b); }
        w[q4] = pk; }
    GAS v4u* dst = (GAS v4u*)(WT + (size_t)row * K + k0 + 32 * half);
    dst[0] = (v4u){w[0], w[1], w[2], w[3]}; dst[1] = (v4u){w[4], w[5], w[6], w[7]};
    LDS_WAIT(); asm volatile("" ::: "memory");
}
__device__ __forceinline__ void rms_row(const float* xrow, const f32x4 (&g)[4], f32x4 (&v)[4], int lane) {
    const GAS f32x4* xr = (const GAS f32x4*)xrow + lane; float s = 0.f;
#pragma unroll
    for (int j = 0; j < 4; ++j) { v[j] = xr[64 * j]; s += (v[j].x * v[j].x + v[j].y * v[j].y) + (v[j].z * v[j].z + v[j].w * v[j].w); }
    const float rstd = 1.f / sqrtf(wave_sum(s) * (1.f / DM) + NORM_EPS);
#pragma unroll
    for (int j = 0; j < 4; ++j) v[j] = v[j] * rstd * g[j];
}
__device__ __forceinline__ void store_row_bf16(bf16* orow, const f32x4 (&v)[4], int lane) {
    GAS unsigned long long* o8 = (GAS unsigned long long*)orow + lane;
#pragma unroll
    for (int j = 0; j < 4; ++j) o8[64 * j] = (unsigned long long)pk2(v[j].x, v[j].y) | ((unsigned long long)pk2(v[j].z, v[j].w) << 32);
}
__device__ __forceinline__ void load_gain(const float* g, f32x4 (&gv)[4], int lane) {
#pragma unroll
    for (int j = 0; j < 4; ++j) gv[j] = *((const f32x4*)g + lane + 64 * j);
}
__device__ __forceinline__ void rmsnorm_phase(const float* src, const float* gain, bf16* dst, int gw, int ngw, int lane) {
    f32x4 gv[4]; load_gain(gain, gv, lane);
    for (int m = gw; m < TOK; m += ngw) { f32x4 v[4]; rms_row(src + (size_t)m * DM, gv, v, lane); store_row_bf16(dst + (size_t)m * DM, v, lane); }
}
__device__ __forceinline__ float bf2f(unsigned short b) { return __uint_as_float((unsigned)b << 16); }


typedef __attribute__((address_space(4))) const unsigned char* kaptr_t;
__device__ __forceinline__ kaptr_t ka_get() { kaptr_t p = (kaptr_t)__builtin_amdgcn_kernarg_segment_ptr(); asm volatile("" : "+s"(p)); return p; }
#define KA_IN(k) (*(const float* const __attribute__((address_space(4)))*)(ka + 8 * (k)))
#define PH_PTRS kaptr_t ka = ka_get(); unsigned char* const ws = *(unsigned char* const __attribute__((address_space(4)))*)(ka + 168); float* const out = *(float* const __attribute__((address_space(4)))*)(ka + 160); gu32* const ctl = (gu32*)(ws + WS_CTL); (void)out; (void)ctl
#define IN_X KA_IN(0)
#define norm_mix KA_IN(1)
#define norm_ffn KA_IN(2)
#define final_norm KA_IN(3)
#define da_wqkv KA_IN(4)
#define da_wo KA_IN(5)
#define da_lq1 KA_IN(6)
#define da_lk1 KA_IN(7)
#define da_lq2 KA_IN(8)
#define da_lk2 KA_IN(9)
#define da_subln KA_IN(10)
#define mb_wqkv KA_IN(11)
#define mb_wo KA_IN(12)
#define ffn_w1 KA_IN(13)
#define ffn_w3 KA_IN(14)
#define ffn_w2 KA_IN(15)
#define moe_router KA_IN(16)
#define moe_w1 KA_IN(17)
#define moe_w3 KA_IN(18)
#define moe_w2 KA_IN(19)
#define rope64 ((float*)(ws + WS_ROPE64))
#define rope128 ((float*)(ws + WS_ROPE128))
#define kmean ((int*)(ws + WS_KMEAN))
#define tok_e ((int*)(ws + WS_TOK))
#define tok_pos (tok_e + 2 * TOK)
#define tok_gate ((float*)(tok_pos + 2 * TOK))
#define wg_base ((int*)(ws + WS_TOK + 800 * 1024))
#define slot_tok ((int*)(ws + WS_SLOT))
#define slot_gate ((float*)(slot_tok + 2 * SLOTS))
#define ownml ((float*)(ws + WS_OWNML))
#define W0qkv ((bf16*)(ws + WS_W0QKV))
#define W0o ((bf16*)(ws + WS_W0O))
#define W013 ((bf16*)(ws + WS_W013))
#define W02 ((bf16*)(ws + WS_W02))
#define W1qkv ((bf16*)(ws + WS_W1QKV))
#define W1o ((bf16*)(ws + WS_W1O))
#define Rb ((bf16*)(ws + WS_H))
#define OB ((bf16*)out)
#define RSS(j) ((unsigned long long*)(ws + WS_RSS) + (size_t)(j) * TOK)
#define QKV ((bf16*)(ws + WS_QKV))
#define OATT ((bf16*)(ws + WS_OATT))
#define UD ((bf16*)(ws + WS_UD))
#define lists ((int*)(ws + WS_LIST))
#define pml ((float*)(ws + WS_PML))
#define PO ((bf16*)(ws + WS_PO))
#define WM13 ((signed char*)(ws + WS_WM13))
#define WM2 ((signed char*)(ws + WS_WM2))
#define AQ ((signed char*)(ws + WS_AQ))
#define UM ((signed char*)(ws + WS_UM))
#define CMAX13 ((unsigned*)(ws + WS_CMAX13))
#define CMAX2 ((unsigned*)(ws + WS_CMAX2))
#define SSTOT ((unsigned long long*)(ws + WS_SSTOT))
#define SA ((float*)(ws + WS_SA))
#define SA1 ((float*)(ws + WS_SA + 128 * 1024))
#define CM0_13 ((unsigned*)(ws + WS_CM0))
#define CM0_2 ((unsigned*)(ws + WS_CM0 + 32 * 1024))
#define SSTOT0 ((unsigned long long*)(ws + WS_CM0 + 48 * 1024))
#define W013q ((signed char*)(ws + WS_W013))
#define W02q ((signed char*)(ws + WS_W02))
#define A1Q ((signed char*)(ws + WS_QKV))
#define UDQ ((signed char*)(ws + WS_UD))
__global__ void __launch_bounds__(NWAVES * 64, 2) mk_fwd(Args args) {
    extern __shared__ __attribute__((aligned(16))) unsigned char lds[];
    LAS unsigned char* L = (LAS unsigned char*)lds;
    volatile LAS unsigned* MISC = (volatile LAS unsigned*)(L + MISC_OFF);
    const int wave = __builtin_amdgcn_readfirstlane((int)threadIdx.x >> 6);
#define tid ((int)threadIdx.x)
#define lane ((int)(threadIdx.x & 63u))
    const int G = gridDim.x; const int bx = blockIdx.x; const int vcu = (G % 8 == 0) ? (bx % 8) * (G / 8) + bx / 8 : bx;
    const int gw = vcu * NWAVES + wave, NGW = G * NWAVES;
    gu32* ctl0 = (gu32*)(args.ws + WS_CTL);
    for (int u = tid; u < (LDS_BYTES - LDSCTL_OFF) / 4; u += NWAVES * 64) ((LAS unsigned*)(L + LDSCTL_OFF))[u] = 0u;
    __syncthreads();
    XcdBarrier bar; bar.bar = (unsigned*)(ctl0 + CW_BAR); bar.x = 0; bar.st = nullptr;
    if (!MK_PER_PHASE) bar = xcd_barrier_post((unsigned*)(ctl0 + CW_BAR), MISC + 8);
#define GRID_BAR() do { if (!MK_PER_PHASE) xcd_barrier(bar); } while (0)
    const int lo = args.ph_lo, hi_ph = args.ph_hi;
#ifndef PH_MASK
#define PH_MASK 0xFFFFFFFFu
#endif
#define IN(k) (((PH_MASK >> (k)) & 1u) && lo <= (k) && (k) < hi_ph)
#define SEAM(k) do { if (IN((k) + 1)) GRID_BAR(); } while (0)
#ifndef DUP_MASK
#define DUP_MASK 0u
#endif
#define NREP(k) ((((DUP_MASK) >> (k)) & 1u) ? 2 : 1)

    if (IN(0)) { PH_PTRS; for (int rep_ = 0; rep_ < NREP(0); ++rep_) {
        LAS float* scr = (LAS float*)(L + RING_OFF + wave * 16384);
        constexpr int I_QKV = (DM / 64) * (NQKV / 32), I_O = (DM / 64) * (DM / 32);
        constexpr int NITEMS = 2 * I_QKV + 2 * I_O;
        for (int it = gw; it < NITEMS; it += NGW) {
            int r = it;
            if (r < I_QKV) { transpose_item<1>(da_wqkv, DM, NQKV, W0qkv, scr, r, lane, norm_mix); continue; } r -= I_QKV;
            if (r < I_QKV) { transpose_item<2>(mb_wqkv, DM, NQKV, W1qkv, scr, r, lane, norm_mix + DM); continue; } r -= I_QKV;
            if (r < I_O) { transpose_item<0>(da_wo, DM, DM, W0o, scr, r, lane); continue; } r -= I_O;
            transpose_item<0>(mb_wo, DM, DM, W1o, scr, r, lane);
        }
        {
            constexpr int S_1 = (DM / 512) * (FF0 / 32), S_2 = 6 * (DM / 32);
            float ssA = 0.f, ssB = 0.f;
            for (int it = NGW - 1 - gw; it < 2 * S_1 + S_2; it += NGW) {
                int r = it;
                if (r < S_1) { ssA += wmax_strip<3>(ffn_w1, FF0, CM0_13, 8 * (r / (FF0 / 32)), 8, r % (FF0 / 32), lane, norm_ffn); continue; } r -= S_1;
                if (r < S_1) { ssB += wmax_strip<4>(ffn_w3, FF0, CM0_13, 8 * (r / (FF0 / 32)), 8, r % (FF0 / 32), lane, norm_ffn); continue; } r -= S_1;
                { const int st = r / (DM / 32); (void)wmax_strip<0>(ffn_w2, DM, CM0_2, 8 * st, st == 5 ? 4 : 8, r % (DM / 32), lane, nullptr); }
            }
            ssA = wave_sum(ssA); ssB = wave_sum(ssB);
            if (lane == 0 && (ssA != 0.f || ssB != 0.f)) { __hip_atomic_fetch_add(SSTOT0, (unsigned long long)(ssA * 16777216.0f), __ATOMIC_RELAXED, __HIP_MEMORY_SCOPE_AGENT); __hip_atomic_fetch_add(SSTOT0 + 1, (unsigned long long)(ssB * 16777216.0f), __ATOMIC_RELAXED, __HIP_MEMORY_SCOPE_AGENT); }
        }
        {
            const int gt = (vcu * NWAVES + wave) * 64 + lane, NT_ = G * NWAVES * 64;
            for (int e = gt; e < SEQ * 8; e += NT_) { const int pos = e >> 3, i = e & 7; const float ang = (float)pos * (*(const float __attribute__((address_space(4)))*)(ka + 176 + 4 * i)); rope64[e] = cosf(ang); rope64[SEQ * 8 + e] = sinf(ang); }
            for (int e = gt; e < SEQ * 16; e += NT_) { const int pos = e >> 4, i = e & 15; const float ang = (float)pos * (*(const float __attribute__((address_space(4)))*)(ka + 208 + 4 * i)); rope128[e] = cosf(ang); rope128[SEQ * 16 + e] = sinf(ang); }
        }
        for (int m = gw; m < TOK; m += NGW) {
            const GAS f32x4* xr = (const GAS f32x4*)(IN_X + (size_t)m * DM) + lane; f32x4 v[4]; float s = 0.f;
#pragma unroll
            for (int j = 0; j < 4; ++j) { v[j] = xr[64 * j]; s += (v[j].x * v[j].x + v[j].y * v[j].y) + (v[j].z * v[j].z + v[j].w * v[j].w); }
            store_row_bf16(Rb + (size_t)m * DM, v, lane); s = wave_sum(s); if (lane == 0) RSS(0)[m] = (unsigned long long)(s * 16777216.0f); }
        } SEAM(0);
    }
    if (IN(1)) { PH_PTRS; for (int rep_ = 0; rep_ < NREP(1); ++rep_) {
        pg8::ABDense ab{Rb, W0qkv, DM}; pg8::TileOrder S; S.init(TOK / 256, NQKV / 256, G, bx);
        pg8::EpiQKV<64> E{QKV, NQKV, rope64, rope64 + SEQ * 8, 0.125f * LOG2E, RSS(0), nullptr};
        pg8::gemm_phase<pg8::EpiQKV<64>, pg8::ABDense, GEMM_ALIGN>(L + RING_OFF, ab, S, E);
        } SEAM(1);
    }
    if (IN(2)) { PH_PTRS; for (int rep_ = 0; rep_ < NREP(2); ++rep_) {
        const moba::DaOrder AS(vcu, G);
        moba::dattn_phase<moba::DaOrder>((char*)lds + RING_OFF, (const moba::bf16*)QKV, (moba::bf16*)OATT, AS);
        } SEAM(2);
    }
    if (IN(3)) { PH_PTRS; for (int rep_ = 0; rep_ < NREP(3); ++rep_) {
        float lam;
        { const float a = wave_sum(da_lq1[lane] * da_lk1[lane]), b = wave_sum(da_lq2[lane] * da_lk2[lane]); lam = expf(a) - expf(b) + LAMBDA_INIT0; }
        const int hh = lane >> 3, dd = (lane & 7) * 16;
        float gsub[16];
#pragma unroll
        for (int k = 0; k < 16; ++k) gsub[k] = da_subln[dd + k] * (1.f - LAMBDA_INIT0);
        for (int m0 = gw; m0 < TOK; m0 += 2 * NGW) {
            v4u A0[2], A1[2], B0[2], B1[2];
#pragma unroll
            for (int u = 0; u < 2; ++u) { const int m = (m0 + u * NGW < TOK) ? m0 + u * NGW : m0;
                const bf16* o1 = OATT + (size_t)m * 2048 + (2 * hh) * 128 + dd; const bf16* o2 = o1 + 128;
                A0[u] = *(const GAS v4u*)o1; A1[u] = *(const GAS v4u*)(o1 + 8); B0[u] = *(const GAS v4u*)o2; B1[u] = *(const GAS v4u*)(o2 + 8); }
#pragma unroll
            for (int u = 0; u < 2; ++u) { const int m = m0 + u * NGW; if (m < TOK) {
                const v4u a0 = A0[u], a1 = A1[u], b0 = B0[u], b1 = B1[u];
                float d[16]; float ss = 0.f;
#pragma unroll
                for (int k = 0; k < 4; ++k) {
                    const unsigned ua = a0[k], ub = b0[k], uc = a1[k], ud = b1[k];
                    d[2 * k] = __uint_as_float(ua << 16) - lam * __uint_as_float(ub << 16); d[2 * k + 1] = __uint_as_float(ua & 0xffff0000u) - lam * __uint_as_float(ub & 0xffff0000u);
                    d[8 + 2 * k] = __uint_as_float(uc << 16) - lam * __uint_as_float(ud << 16); d[8 + 2 * k + 1] = __uint_as_float(uc & 0xffff0000u) - lam * __uint_as_float(ud & 0xffff0000u); }
#pragma unroll
                for (int k = 0; k < 16; ++k) ss += d[k] * d[k];
                ss += __shfl_xor(ss, 1); ss += __shfl_xor(ss, 2); ss += __shfl_xor(ss, 4);
                const float rstd = 1.f / sqrtf(ss * (1.f / 128.f) + SUBLN_EPS);
                v4u w0, w1;
#pragma unroll
                for (int k = 0; k < 4; ++k) { w0[k] = pk2(d[2 * k] * rstd * gsub[2 * k], d[2 * k + 1] * rstd * gsub[2 * k + 1]); w1[k] = pk2(d[8 + 2 * k] * rstd * gsub[8 + 2 * k], d[8 + 2 * k + 1] * rstd * gsub[8 + 2 * k + 1]); }
                bf16* od = OB + (size_t)m * DM + hh * 128 + dd;
                *(GAS v4u*)od = w0; *(GAS v4u*)(od + 8) = w1; } }
        }
        {
            LAS float* scr = (LAS float*)(L + RING_OFF + wave * 16384);
            constexpr int I_13 = (DM / 64) * (FF0 / 32), I_2 = (FF0 / 64) * (DM / 32);
            for (int it = gw; it < 2 * I_13 + I_2; it += NGW) {
                int r = it;
                if (r < I_13) { transpose_item_q<3>(ffn_w1, DM, FF0, W013q, CM0_13, scr, r, lane, norm_ffn); continue; } r -= I_13;
                if (r < I_13) { transpose_item_q<4>(ffn_w3, DM, FF0, W013q, CM0_13, scr, r, lane, norm_ffn); continue; } r -= I_13;
                transpose_item_q<0>(ffn_w2, FF0, DM, W02q, CM0_2, scr, r, lane, nullptr);
            }
        }
        } SEAM(3);
    }
    if (IN(4)) { PH_PTRS; for (int rep_ = 0; rep_ < NREP(4); ++rep_) {
        pg8::ABDense ab{OB, W0o, DM}; pg8::TileOrder S; S.init(TOK / 256, DM / 256, G, bx);
        pg8::EpiResB E{Rb, Rb, DM, nullptr, RSS(1)};
        pg8::gemm_phase<pg8::EpiResB, pg8::ABDense, GEMM_ALIGN>(L + RING_OFF, ab, S, E);
        } SEAM(4);
    }
    if (IN(5)) { PH_PTRS;
        for (int m0 = gw; m0 < TOK; m0 += 4 * NGW) {
            unsigned long long w[4][4];
#pragma unroll
            for (int u = 0; u < 4; ++u) { const int m = (m0 + u * NGW < TOK) ? m0 + u * NGW : m0; const GAS unsigned long long* r8 = (const GAS unsigned long long*)(Rb + (size_t)m * DM) + lane;
#pragma unroll
                for (int j = 0; j < 4; ++j) w[u][j] = r8[64 * j]; }
#pragma unroll
            for (int u = 0; u < 4; ++u) { const int m = m0 + u * NGW; if (m < TOK) {
                f32x4 v[4]; float mx = 0.f;
#pragma unroll
                for (int j = 0; j < 4; ++j) { const unsigned lo32 = (unsigned)w[u][j], hi32 = (unsigned)(w[u][j] >> 32);
                    v[j].x = __uint_as_float(lo32 << 16); v[j].y = __uint_as_float(lo32 & 0xffff0000u); v[j].z = __uint_as_float(hi32 << 16); v[j].w = __uint_as_float(hi32 & 0xffff0000u);
                    mx = fmaxf(fmaxf(mx, fmaxf(fabsf(v[j].x), fabsf(v[j].y))), fmaxf(fabsf(v[j].z), fabsf(v[j].w))); }
#pragma unroll
                for (int o = 1; o < 64; o <<= 1) mx = fmaxf(mx, __shfl_xor(mx, o));
                const float inv = mx > 0.f ? 127.0f / mx : 0.f;
                GAS unsigned* aq = (GAS unsigned*)(A1Q + (size_t)m * DM) + lane;
#pragma unroll
                for (int j = 0; j < 4; ++j) { const int q0 = (int)__builtin_rintf(v[j].x * inv), q1 = (int)__builtin_rintf(v[j].y * inv), q2 = (int)__builtin_rintf(v[j].z * inv), q3 = (int)__builtin_rintf(v[j].w * inv);
                    aq[64 * j] = (unsigned)(q0 & 255) | ((unsigned)(q1 & 255) << 8) | ((unsigned)(q2 & 255) << 16) | ((unsigned)(q3 & 255) << 24); }
                if (lane == 0) SA1[m] = mx * (1.f / sqrtf((float)RSS(1)[m] * (5.9604644775390625e-8f / DM) + NORM_EPS)) * (1.0f / 127.0f); } }
        }
        SEAM(5);
    }
    if (IN(6)) { PH_PTRS; for (int rep_ = 0; rep_ < NREP(6); ++rep_) {
        const float su0 = 8.0f * sqrtf(((float)SSTOT0[0] * (5.9604644775390625e-8f / FF0)) * ((float)SSTOT0[1] * (5.9604644775390625e-8f / FF0)));
        pg8::ABDense ab{(const pg8::bf16_t*)A1Q, (const pg8::bf16_t*)W013q, DM / 2}; pg8::TileOrder S; S.init(TOK / 256, (2 * FF0) / 256, G, bx);
        pg8::EpiSwiGLUQ E{UDQ, FF0, SA1, CM0_13, nullptr, nullptr, 127.0f / su0};
        pg8::gemm_phase<pg8::EpiSwiGLUQ, pg8::ABDense, GEMM_ALIGN>(L + RING_OFF, ab, S, E);
        } SEAM(6);
    }
    if (IN(7)) { PH_PTRS; for (int rep_ = 0; rep_ < NREP(7); ++rep_) {
        const float su0 = 8.0f * sqrtf(((float)SSTOT0[0] * (5.9604644775390625e-8f / FF0)) * ((float)SSTOT0[1] * (5.9604644775390625e-8f / FF0)));
        pg8::ABDense ab{(const pg8::bf16_t*)UDQ, (const pg8::bf16_t*)W02q, FF0 / 2}; pg8::TileOrder S; S.init(TOK / 256, DM / 256, G, bx);
        pg8::EpiResBQ E{Rb, Rb, DM, nullptr, nullptr, CM0_2, nullptr, su0 * (1.0f / 127.0f), RSS(2)};
        pg8::gemm_phase<pg8::EpiResBQ, pg8::ABDense, GEMM_ALIGN>(L + RING_OFF, ab, S, E);
        } SEAM(7);
    }
    if (IN(9)) { PH_PTRS; for (int rep_ = 0; rep_ < NREP(9); ++rep_) {
        pg8::ABDense ab{Rb, W1qkv, DM}; pg8::TileOrder S; S.init(TOK / 256, NQKV / 256, G, bx);
        pg8::EpiQKV<128> E{QKV, NQKV, rope128, rope128 + SEQ * 16, 0.08838834764831845f * LOG2E, RSS(2), kmean};
        pg8::gemm_phase<pg8::EpiQKV<128>, pg8::ABDense, GEMM_ALIGN>(L + RING_OFF, ab, S, E);
        } SEAM(9);
    }
    if (IN(11)) { PH_PTRS; for (int rep_ = 0; rep_ < NREP(11); ++rep_) {
        LAS float* km = (LAS float*)(L + RING_OFF);
        LAS float* mv = (LAS float*)(L + RING_OFF + 16384);
        LAS int* mi = (LAS int*)(L + RING_OFF + 16384 + 3072);
        LAS int* lcnt = (LAS int*)(L + RING_OFF + 24576);
        for (int u = vcu; u < BATCH * MB_H * (MB_NB - 1); u += G) {
            const int bh = u / 31, o = 1 + u % 31, b = bh >> 3, h = bh & 7;
            for (int e = tid; e < 32 * 128; e += 512) km[e] = (float)kmean[(size_t)bh * 4096 + e] * (1.0f / (65536.0f * 256.0f));
            if (tid < 32) lcnt[tid] = 0;
            __syncthreads();
            const int ql = tid & 255, half = tid >> 8; const int s = o * 256 + ql;
            const bf16* qp = QKV + (size_t)(b * SEQ + s) * NQKV + h * 128;
            float qf[128];
#pragma unroll
            for (int c = 0; c < 16; ++c) { const v4u v = *(const GAS v4u*)(qp + c * 8);
#pragma unroll
                for (int q = 0; q < 4; ++q) { qf[c * 8 + 2 * q] = __uint_as_float(v[q] << 16); qf[c * 8 + 2 * q + 1] = __uint_as_float(v[q] & 0xffff0000u); } }
            float v0 = -INFINITY, v1 = -INFINITY, v2 = -INFINITY; int i0 = -1, i1 = -1, i2 = -1;
            for (int jj = 0; jj < 16; ++jj) { const int j = half * 16 + jj;
                if (j < o) { float g = 0.f; const LAS f32x4* kr = (const LAS f32x4*)(km + j * 128);
#pragma unroll
                    for (int c = 0; c < 32; ++c) { const f32x4 kv = kr[c]; g += qf[4 * c] * kv.x + qf[4 * c + 1] * kv.y + qf[4 * c + 2] * kv.z + qf[4 * c + 3] * kv.w; }
                    if (g > v0) { v2 = v1; i2 = i1; v1 = v0; i1 = i0; v0 = g; i0 = j; } else if (g > v1) { v2 = v1; i2 = i1; v1 = g; i1 = j; } else if (g > v2) { v2 = g; i2 = j; } } }
            if (half == 1) { mv[ql * 3] = v0; mv[ql * 3 + 1] = v1; mv[ql * 3 + 2] = v2; mi[ql * 3] = i0; mi[ql * 3 + 1] = i1; mi[ql * 3 + 2] = i2; }
            __syncthreads();
            int lp0 = 0, lp1 = 0, lp2 = 0;
            if (half == 0) {
#pragma unroll
                for (int k = 0; k < 3; ++k) { const float g = mv[ql * 3 + k]; const int j = mi[ql * 3 + k];
                    if (j >= 0) { if (g > v0) { v2 = v1; i2 = i1; v1 = v0; i1 = i0; v0 = g; i0 = j; } else if (g > v1) { v2 = v1; i2 = i1; v1 = g; i1 = j; } else if (g > v2) { v2 = g; i2 = j; } } }
                if (i0 >= 0) lp0 = __hip_atomic_fetch_add(&lcnt[i0], 1, __ATOMIC_RELAXED, __HIP_MEMORY_SCOPE_WORKGROUP);
                if (i1 >= 0) lp1 = __hip_atomic_fetch_add(&lcnt[i1], 1, __ATOMIC_RELAXED, __HIP_MEMORY_SCOPE_WORKGROUP);
                if (i2 >= 0) lp2 = __hip_atomic_fetch_add(&lcnt[i2], 1, __ATOMIC_RELAXED, __HIP_MEMORY_SCOPE_WORKGROUP);
            }
            __syncthreads();
            if (tid < 32 && rep_ == 0) { const int n = lcnt[tid]; lcnt[32 + tid] = n ? (int)__hip_atomic_fetch_add(ctl + CW_MOBACNT + bh * 32 + tid, (unsigned)n, RLX_AGENT) : 0; }
            __syncthreads();
            if (half == 0 && rep_ == 0) { int* lb = lists + (size_t)bh * LIST_PER_BH;
                if (i0 >= 0) lb[list_off(i0) + lcnt[32 + i0] + lp0] = s;
                if (i1 >= 0) lb[list_off(i1) + lcnt[32 + i1] + lp1] = s | (1 << 16);
                if (i2 >= 0) lb[list_off(i2) + lcnt[32 + i2] + lp2] = s | (2 << 16); }
            __syncthreads();
        }
        } SEAM(11);
    }
    if (IN(12)) { PH_PTRS; for (int rep_ = 0; rep_ < NREP(12); ++rep_) {
        LAS int* pre = (LAS int*)(L + 102400);
        { const unsigned c0 = __hip_atomic_load(ctl + CW_MOBACNT + tid, RLX_AGENT), c1 = __hip_atomic_load(ctl + CW_MOBACNT + 512 + tid, RLX_AGENT);
          pre[tid] = (int)((c0 + 255u) >> 8); pre[512 + tid] = (int)((c1 + 255u) >> 8); }
        __syncthreads();
        if (tid == 0) { int a = 0; for (int k = 0; k < 1024; ++k) { const int n = pre[k]; pre[k] = a; a += n; } pre[1024] = a; }
        __syncthreads();
        const int nlist = pre[1024], ntot = 1024 + nlist;
        const int wl = wave * 32 + (lane & 31);
        for (int u = vcu; u < ntot; u += G) {
            const bool own = u < 1024;
            int b, h, kb, s, dst, mli, ostride; moba::bf16* obase; float* mlp;
            if (own) {
                b = u >> 8; h = (u >> 5) & 7; kb = u & 31; s = kb * 256 + wl; dst = b * SEQ + s; mli = (b * 8 + h) * SEQ + s; ostride = DM; obase = (moba::bf16*)OB + h * 128; mlp = ownml;
            } else {
                const int lu = u - 1024; int loI = 0, hiI = 1024;
                while (hiI - loI > 1) { const int mid = (loI + hiI) >> 1; if (pre[mid] <= lu) loI = mid; else hiI = mid; }
                const int bhj = loI, chunk = lu - pre[bhj], bh = bhj >> 5; kb = bhj & 31; b = bh >> 3; h = bh & 7;
                const int cnt = (int)__hip_atomic_load(ctl + CW_MOBACNT + bhj, RLX_AGENT);
                const int ei = chunk * 256 + wl; const bool valid = ei < cnt;
                const int ent = valid ? lists[(size_t)bh * LIST_PER_BH + list_off(kb) + ei] : 0;
                s = ent & 0xffff; mli = (bh * SEQ + s) * 3 + (ent >> 16); dst = valid ? mli : -1; ostride = 128; obase = (moba::bf16*)PO; mlp = pml;
            }
            const moba::bf16* qrow = (const moba::bf16*)QKV + ((size_t)b * SEQ + s) * NQKV + h * 128;
            const moba::bf16* Kh = (const moba::bf16*)QKV + ((size_t)b * SEQ + kb * 256) * NQKV + 1024 + h * 128;
            moba::moba_unit(own, qrow, Kh, Kh + 1024, obase, ostride, dst, mlp, mli, wl, (char*)lds);
        }
        } SEAM(12);
    }
    if (IN(13)) { PH_PTRS; for (int rep_ = 0; rep_ < NREP(13); ++rep_) {
        const int hh = lane >> 3, dd = (lane & 7) * 16;
        for (int m = gw; m < TOK; m += NGW) {
            const int b = m >> 13, s = m & 8191, nv = (s >> 8) < 3 ? (s >> 8) : 3; const int qi = (b * 8 + hh) * SEQ + s;
            float mm[4], ll[4]; mm[0] = ownml[2 * (size_t)qi]; ll[0] = ownml[2 * (size_t)qi + 1]; float M = mm[0];
#pragma unroll
            for (int r = 0; r < 3; ++r) { if (r < nv) { mm[1 + r] = pml[2 * ((size_t)qi * 3 + r)]; ll[1 + r] = pml[2 * ((size_t)qi * 3 + r) + 1]; M = fmaxf(M, mm[1 + r]); } else { mm[1 + r] = -1e30f; ll[1 + r] = 0.f; } }
            float w[4], wsum = 0.f;
#pragma unroll
            for (int r = 0; r < 4; ++r) { w[r] = ll[r] * __builtin_amdgcn_exp2f(mm[r] - M); wsum += w[r]; }
            const float inv = 1.f / wsum;
            float acc16[16];
            bf16* op = OB + (size_t)m * DM + hh * 128 + dd;
            { const v4u a0 = *(const GAS v4u*)op, a1 = *(const GAS v4u*)(op + 8); const float ww = w[0] * inv;
#pragma unroll
              for (int k = 0; k < 4; ++k) { acc16[2 * k] = ww * __uint_as_float(a0[k] << 16); acc16[2 * k + 1] = ww * __uint_as_float(a0[k] & 0xffff0000u); acc16[8 + 2 * k] = ww * __uint_as_float(a1[k] << 16); acc16[8 + 2 * k + 1] = ww * __uint_as_float(a1[k] & 0xffff0000u); } }
#pragma unroll
            for (int r = 0; r < 3; ++r) if (r < nv) { const bf16* pp = PO + ((size_t)qi * 3 + r) * 128 + dd; const v4u a0 = *(const GAS v4u*)pp, a1 = *(const GAS v4u*)(pp + 8); const float ww = w[1 + r] * inv;
#pragma unroll
                for (int k = 0; k < 4; ++k) { acc16[2 * k] += ww * __uint_as_float(a0[k] << 16); acc16[2 * k + 1] += ww * __uint_as_float(a0[k] & 0xffff0000u); acc16[8 + 2 * k] += ww * __uint_as_float(a1[k] << 16); acc16[8 + 2 * k + 1] += ww * __uint_as_float(a1[k] & 0xffff0000u); } }
            v4u w0, w1;
#pragma unroll
            for (int k = 0; k < 4; ++k) { w0[k] = pk2(acc16[2 * k], acc16[2 * k + 1]); w1[k] = pk2(acc16[8 + 2 * k], acc16[8 + 2 * k + 1]); }
            *(GAS v4u*)op = w0; *(GAS v4u*)(op + 8) = w1;
        }
        } SEAM(13);
    }
    if (IN(14)) { PH_PTRS; for (int rep_ = 0; rep_ < NREP(14); ++rep_) {
        pg8::ABDense ab{OB, W1o, DM}; pg8::TileOrder S; S.init(TOK / 256, DM / 256, G, bx);
        pg8::EpiResB E{Rb, Rb, DM, nullptr, RSS(3)};
        pg8::gemm_phase<pg8::EpiResB, pg8::ABDense, GEMM_ALIGN>(L + RING_OFF, ab, S, E);
        } SEAM(14);
    }
    if (IN(15)) { PH_PTRS; for (int rep_ = 0; rep_ < NREP(15); ++rep_) {
        {
            const int gt = (vcu * NWAVES + wave) * 64 + lane, NT_ = G * NWAVES * 64;
            for (int e = gt; e < 2 * SLOTS; e += NT_) { slot_tok[e] = -1; slot_gate[e] = 0.f; }
        }
        if (rep_ == 0) {
            f32x4 gv[4]; load_gain(norm_ffn + DM, gv, lane);
            float wr_[16][8];
#pragma unroll
            for (int j = 0; j < 4; ++j)
#pragma unroll
                for (int q = 0; q < 4; ++q) { const int k = 4 * lane + 256 * j + q; const f32x4 a = *(const GAS f32x4*)(moe_router + (size_t)k * 8) * gv[j][q], c = *(const GAS f32x4*)(moe_router + (size_t)k * 8 + 4) * gv[j][q];
                    wr_[4 * j + q][0] = a.x; wr_[4 * j + q][1] = a.y; wr_[4 * j + q][2] = a.z; wr_[4 * j + q][3] = a.w; wr_[4 * j + q][4] = c.x; wr_[4 * j + q][5] = c.y; wr_[4 * j + q][6] = c.z; wr_[4 * j + q][7] = c.w; }
            for (int m = gw; m < TOK; m += NGW) {
                f32x4 v[4];
                { const GAS unsigned long long* r8 = (const GAS unsigned long long*)(Rb + (size_t)m * DM) + lane;
#pragma unroll
                  for (int j = 0; j < 4; ++j) { const unsigned long long w = r8[64 * j]; const unsigned lo32 = (unsigned)w, hi32 = (unsigned)(w >> 32);
                      v[j].x = __uint_as_float(lo32 << 16); v[j].y = __uint_as_float(lo32 & 0xffff0000u); v[j].z = __uint_as_float(hi32 << 16); v[j].w = __uint_as_float(hi32 & 0xffff0000u); } }
                float lg[8];
#pragma unroll
                for (int e = 0; e < 8; ++e) { float a = 0.f;
#pragma unroll
                    for (int j = 0; j < 4; ++j) a += v[j].x * wr_[4 * j][e] + v[j].y * wr_[4 * j + 1][e] + v[j].z * wr_[4 * j + 2][e] + v[j].w * wr_[4 * j + 3][e];
                    lg[e] = wave_sum(a); }
                const float rs = 1.f / sqrtf((float)RSS(3)[m] * (5.9604644775390625e-8f / DM) + NORM_EPS);
#pragma unroll
                for (int e = 0; e < 8; ++e) lg[e] *= rs;
                {
                    float mx = 0.f;
#pragma unroll
                    for (int j = 0; j < 4; ++j) mx = fmaxf(fmaxf(mx, fmaxf(fabsf(v[j].x), fabsf(v[j].y))), fmaxf(fabsf(v[j].z), fabsf(v[j].w)));
#pragma unroll
                    for (int o = 1; o < 64; o <<= 1) mx = fmaxf(mx, __shfl_xor(mx, o));
                    const float inv = mx > 0.f ? 127.0f / mx : 0.f;
                    GAS unsigned* aq = (GAS unsigned*)(AQ + (size_t)m * DM) + lane;
#pragma unroll
                    for (int j = 0; j < 4; ++j) { const int q0 = (int)__builtin_rintf(v[j].x * inv), q1 = (int)__builtin_rintf(v[j].y * inv), q2 = (int)__builtin_rintf(v[j].z * inv), q3 = (int)__builtin_rintf(v[j].w * inv);
                        aq[64 * j] = (unsigned)(q0 & 255) | ((unsigned)(q1 & 255) << 8) | ((unsigned)(q2 & 255) << 16) | ((unsigned)(q3 & 255) << 24); }
                    if (lane == 0) SA[m] = mx * rs * (1.0f / 127.0f);
                }
                int e0 = 0; float l0 = lg[0];
#pragma unroll
                for (int e = 1; e < 8; ++e) if (lg[e] > l0) { l0 = lg[e]; e0 = e; }
                int e1 = -1; float l1 = -INFINITY;
#pragma unroll
                for (int e = 0; e < 8; ++e) if (e != e0 && lg[e] > l1) { l1 = lg[e]; e1 = e; }
                if (lane == 0) {
                    const float g0 = 1.f / (1.f + expf(l1 - l0)), g1 = 1.f - g0;
                    const int p0 = (int)__hip_atomic_fetch_add((LAS unsigned*)(L + MISC_OFF) + 40 + e0, 1u, __ATOMIC_RELAXED, __HIP_MEMORY_SCOPE_WORKGROUP), p1 = (int)__hip_atomic_fetch_add((LAS unsigned*)(L + MISC_OFF) + 48 + e1, 1u, __ATOMIC_RELAXED, __HIP_MEMORY_SCOPE_WORKGROUP);
                    tok_e[m] = e0; tok_e[TOK + m] = e1; tok_pos[m] = p0; tok_pos[TOK + m] = p1; tok_gate[m] = g0; tok_gate[TOK + m] = g1;
                }
            }
            LDS_WAIT(); __syncthreads();
            if (tid < 16) { const unsigned n = MISC[40 + tid]; wg_base[vcu * 16 + tid] = n ? (int)__hip_atomic_fetch_add(ctl + CW_MOECNT + tid, n, RLX_AGENT) : 0; }
        }
        {
            constexpr int S_1 = (DM / 512) * (FF1 / 32), S_2 = (FF1 / 512) * (DM / 32), PER_E = 2 * S_1 + S_2;
            float ssA = 0.f, ssB = 0.f;
            for (int it = gw; it < NEXP * PER_E; it += NGW) {
                const int e = it / PER_E; int r = it % PER_E;
                if (r < S_1) { ssA += wmax_strip<3>(moe_w1 + (size_t)e * DM * FF1, FF1, CMAX13 + e * 2 * FF1, 8 * (r / (FF1 / 32)), 8, r % (FF1 / 32), lane, norm_ffn + DM); continue; } r -= S_1;
                if (r < S_1) { ssB += wmax_strip<4>(moe_w3 + (size_t)e * DM * FF1, FF1, CMAX13 + e * 2 * FF1, 8 * (r / (FF1 / 32)), 8, r % (FF1 / 32), lane, norm_ffn + DM); continue; } r -= S_1;
                (void)wmax_strip<0>(moe_w2 + (size_t)e * FF1 * DM, DM, CMAX2 + e * DM, 8 * (r / (DM / 32)), 8, r % (DM / 32), lane, nullptr);
            }
            ssA = wave_sum(ssA); ssB = wave_sum(ssB);
            if (lane == 0) { __hip_atomic_fetch_add(SSTOT, (unsigned long long)(ssA * 16777216.0f), __ATOMIC_RELAXED, __HIP_MEMORY_SCOPE_AGENT); __hip_atomic_fetch_add(SSTOT + 1, (unsigned long long)(ssB * 16777216.0f), __ATOMIC_RELAXED, __HIP_MEMORY_SCOPE_AGENT); }
        }
        } SEAM(15);
    }
#define MOE_CUM() do { if (tid < 2) { int a = 0; for (int e = 0; e < 8; ++e) { MISC[16 + 9 * tid + e] = (unsigned)a; a += (int)((__hip_atomic_load(ctl + CW_MOECNT + 8 * tid + e, RLX_AGENT) + 255u) >> 8); } MISC[16 + 9 * tid + 8] = (unsigned)a; } __syncthreads(); } while (0)
    if (IN(16)) { PH_PTRS; for (int rep_ = 0; rep_ < NREP(16); ++rep_) {
        MOE_CUM();
        const int gt = (vcu * NWAVES + wave) * 64 + lane, NT_ = G * NWAVES * 64;
        for (int e = gt; e < 2 * TOK; e += NT_) { const int r = e >= TOK ? 1 : 0; const int ex = tok_e[e]; const int t_ = e - r * TOK; const int slot = (int)MISC[16 + 9 * r + ex] * 256 + wg_base[((t_ % NGW) >> 3) * 16 + r * 8 + ex] + tok_pos[e];
            slot_tok[r * SLOTS + slot] = e - r * TOK; slot_gate[r * SLOTS + slot] = tok_gate[e]; }
        {
            LAS float* scr = (LAS float*)(L + RING_OFF + wave * 16384);
            constexpr int I_1 = (DM / 64) * (FF1 / 32), I_2 = (FF1 / 64) * (DM / 32), PER_E = 2 * I_1 + I_2;
            for (int it = gw; it < NEXP * PER_E; it += NGW) {
                const int e = it / PER_E; int r = it % PER_E;
                if (r < I_1) { transpose_item_q<3>(moe_w1 + (size_t)e * DM * FF1, DM, FF1, WM13 + (size_t)e * 2 * FF1 * DM, CMAX13 + e * 2 * FF1, scr, r, lane, norm_ffn + DM); continue; } r -= I_1;
                if (r < I_1) { transpose_item_q<4>(moe_w3 + (size_t)e * DM * FF1, DM, FF1, WM13 + (size_t)e * 2 * FF1 * DM, CMAX13 + e * 2 * FF1, scr, r, lane, norm_ffn + DM); continue; } r -= I_1;
                transpose_item_q<0>(moe_w2 + (size_t)e * FF1 * DM, FF1, DM, WM2 + (size_t)e * DM * FF1, CMAX2 + e * DM, scr, r, lane, nullptr);
            }
        }
        } SEAM(16);
    }
#define MOE_SU() (8.0f * sqrtf(((float)SSTOT[0] * (5.9604644775390625e-8f / (NEXP * FF1))) * ((float)SSTOT[1] * (5.9604644775390625e-8f / (NEXP * FF1)))))
#define MOE_UP(r) do { MOE_CUM(); \
        pg8::ABMoeUp ab{(const pg8::bf16_t*)AQ, (const pg8::bf16_t*)WM13, DM / 2, slot_tok + (r) * SLOTS, (const LAS int*)(L + MISC_OFF + 4 * (16 + 9 * (r))), (size_t)2 * FF1 * (DM / 2)}; \
        pg8::TileOrder S; S.init((int)MISC[16 + 9 * (r) + 8], (2 * FF1) / 256, G, bx); \
        pg8::EpiSwiGLUQ E{UM, FF1, SA, CMAX13, slot_tok + (r) * SLOTS, (const LAS int*)(L + MISC_OFF + 4 * (16 + 9 * (r))), 127.0f / MOE_SU()}; \
        pg8::gemm_phase<pg8::EpiSwiGLUQ, pg8::ABMoeUp, GEMM_ALIGN>(L + RING_OFF, ab, S, E); } while (0)
#define MOE_DOWN(r) do { MOE_CUM(); \
        pg8::ABMoeDown ab{(const pg8::bf16_t*)UM, (const pg8::bf16_t*)WM2, FF1 / 2, (const LAS int*)(L + MISC_OFF + 4 * (16 + 9 * (r))), (size_t)DM * (FF1 / 2)}; \
        pg8::TileOrder S; S.init((int)MISC[16 + 9 * (r) + 8], DM / 256, G, bx); \
        pg8::EpiResBQ E{(r) == 0 ? Rb : OB, (r) == 0 ? OB : Rb, DM, slot_tok + (r) * SLOTS, slot_gate + (r) * SLOTS, CMAX2, (const LAS int*)(L + MISC_OFF + 4 * (16 + 9 * (r))), MOE_SU() * (1.0f / 127.0f), nullptr}; \
        pg8::gemm_phase<pg8::EpiResBQ, pg8::ABMoeDown, GEMM_ALIGN>(L + RING_OFF, ab, S, E); } while (0)
    if (IN(17)) { PH_PTRS; for (int rep_ = 0; rep_ < NREP(17); ++rep_) MOE_UP(0); SEAM(17); }
    if (IN(18)) { PH_PTRS; MOE_DOWN(0); SEAM(18); }
    if (IN(19)) { PH_PTRS; for (int rep_ = 0; rep_ < NREP(19); ++rep_) MOE_UP(1); SEAM(19); }
    if (IN(20)) { PH_PTRS; MOE_DOWN(1); SEAM(20); }
    if (IN(21)) { PH_PTRS;
        f32x4 gv[4]; load_gain(final_norm, gv, lane);
        for (int m0 = gw; m0 < TOK; m0 += 4 * NGW) {
            unsigned long long w[4][4];
#pragma unroll
            for (int u = 0; u < 4; ++u) { const int m = (m0 + u * NGW < TOK) ? m0 + u * NGW : m0; const GAS unsigned long long* r8 = (const GAS unsigned long long*)(Rb + (size_t)m * DM) + lane;
#pragma unroll
                for (int j = 0; j < 4; ++j) w[u][j] = r8[64 * j]; }
#pragma unroll
            for (int u = 0; u < 4; ++u) { const int m = m0 + u * NGW; if (m < TOK) {
                f32x4 v[4]; float s = 0.f;
#pragma unroll
                for (int j = 0; j < 4; ++j) { const unsigned lo32 = (unsigned)w[u][j], hi32 = (unsigned)(w[u][j] >> 32);
                    v[j].x = __uint_as_float(lo32 << 16); v[j].y = __uint_as_float(lo32 & 0xffff0000u); v[j].z = __uint_as_float(hi32 << 16); v[j].w = __uint_as_float(hi32 & 0xffff0000u);
                    s += (v[j].x * v[j].x + v[j].y * v[j].y) + (v[j].z * v[j].z + v[j].w * v[j].w); }
                const float rstd = 1.f / sqrtf(wave_sum(s) * (1.f / DM) + NORM_EPS);
                GAS f32x4* o = (GAS f32x4*)(out + (size_t)m * DM) + lane;
#pragma unroll
                for (int j = 0; j < 4; ++j) o[64 * j] = v[j] * rstd * gv[j]; } }
        }
    }
#undef IN
#undef SEAM
#undef GRID_BAR
#undef tid
#undef lane
}
constexpr int N_PHASES = 22;

extern "C" void kernel_launch(void* const* d_in, const int* in_sizes, int n_in, void* d_out, int out_size, void* d_ws, size_t ws_size, hipStream_t stream) {
    static int grid = 0;
    if (grid == 0) {
        if (n_in != 20 || in_sizes[0] != TOK * DM || out_size != TOK * DM || ws_size < WS_END) { fprintf(stderr, "kernel_launch: shape / workspace mismatch (n_in %d, in0 %d, out %d, ws %zu, need %zu); nothing launched\n", n_in, n_in > 0 ? in_sizes[0] : -1, out_size, ws_size, (size_t)WS_END); grid = -1; return; }
        int dev = 0, cus = 0, per_cu = 0;
        if (hipGetDevice(&dev) != hipSuccess || hipDeviceGetAttribute(&cus, hipDeviceAttributeMultiprocessorCount, dev) != hipSuccess) { grid = -1; return; }
        if (hipFuncSetAttribute((const void*)mk_fwd, hipFuncAttributeMaxDynamicSharedMemorySize, LDS_BYTES) != hipSuccess) { fprintf(stderr, "kernel_launch: hipFuncSetAttribute failed\n"); grid = -1; return; }
        if (hipOccupancyMaxActiveBlocksPerMultiprocessor(&per_cu, (const void*)mk_fwd, NWAVES * 64, LDS_BYTES) != hipSuccess || per_cu < 1) fprintf(stderr, "kernel_launch: occupancy query reports %d workgroups per CU\n", per_cu);
        (void)hipGetLastError();
        grid = cus;
    }
    if (grid < 0) return;
    if (hipMemsetAsync((char*)d_ws + WS_CTL, 0, CTL_ZERO_BYTES, stream) != hipSuccess) return;
    Args a{};
    for (int i = 0; i < 20; ++i) a.in[i] = (const float*)d_in[i];
    a.out = (float*)d_out; a.ws = (unsigned char*)d_ws;
    for (int i = 0; i < 8; ++i) a.inv64[i] = (float)pow(500000.0, -(double)(2 * i) / 16.0);
    for (int i = 0; i < 16; ++i) a.inv128[i] = (float)pow(500000.0, -(double)(2 * i) / 32.0);
#if MK_PER_PHASE
    for (int p = 0; p < N_PHASES; ++p) { a.ph_lo = p; a.ph_hi = p + 1; hipLaunchKernelGGL(mk_fwd, dim3(grid), dim3(NWAVES * 64), LDS_BYTES, stream, a); }
#else
    a.ph_lo = 0; a.ph_hi = N_PHASES;
    hipLaunchKernelGGL(mk_fwd, dim3(grid), dim3(NWAVES * 64), LDS_BYTES, stream, a);
#ifdef PROBE_LIST
    {
        static const int probe[] = {PROBE_LIST};
        for (int k : probe) { a.ph_lo = k; a.ph_hi = k + 1;
            a.out = (k == 3 || k == 12 || k == 13 || k == 18 || k == 21) ? (float*)((char*)d_ws + WS_QKV) : (float*)d_out;
            hipLaunchKernelGGL(mk_fwd, dim3(grid), dim3(NWAVES * 64), LDS_BYTES, stream, a); }
    }
#endif
#endif
    const hipError_t le = hipPeekAtLastError();
    if (le != hipSuccess) fprintf(stderr, "kernel_launch: launch failed: %s\n", hipGetErrorName(le));
}
```

```cpp
#include <hip/hip_runtime.h>
#include <hip/hip_bf16.h>
#include <cstdio>
#include <cstdint>
#include <cmath>
namespace pg8 {
#define PG8_LAS __attribute__((address_space(3)))
typedef unsigned short bf16_t;
typedef short bf16x8 __attribute__((ext_vector_type(8)));
typedef float f32x4 __attribute__((ext_vector_type(4)));
typedef unsigned u32x4 __attribute__((ext_vector_type(4)));
constexpr int BM = 256, BK = 64, HALF = 128, HTB = HALF * BK * 2  , STAGE_BYTES = 8 * HTB, NXCD = 8, WGM = 8;

__host__ __device__ __forceinline__ int lds_byte(int r, int c) { const int st = (r >> 4) * 2 + (c >> 5), rr = r & 15, cc = c & 31, ob = rr * 64 + cc * 2; return st * 1024 + (ob ^ (((ob >> 9) & 1) << 5)); }
__host__ __device__ __forceinline__ void stage_rc(int b, int& R, int& C) { const int st = b / 1024, sb = b % 1024, swz = sb ^ (((sb >> 9) & 1) << 5); R = (st >> 1) * 16 + swz / 64; C = (st & 1) * 32 + (swz % 64) / 2; }
__host__ __device__ __forceinline__ int perm32(int rho) { const int n = rho >> 4, i = rho & 15; return 8 * (i >> 2) + 4 * n + (i & 3); }

struct Unit { int pm, pn; };

struct TileOrder {
    int nM, nN, nwg, G, c;
    __device__ __forceinline__ void init(int nM_, int nN_, int G_, int c_) { nM = nM_; nN = nN_; nwg = nM * nN; G = G_; c = c_; }
    __device__ __forceinline__ bool next(int i, Unit& u) const {
        const long L = (long)i * G + c; if (L >= nwg) return false;
        int wgid = (int)L; { const int q = nwg / NXCD, r = nwg % NXCD, xcd = wgid % NXCD, off = wgid / NXCD; wgid = (xcd < r ? xcd * (q + 1) : r * (q + 1) + (xcd - r) * q) + off; }
        const int nig = WGM * nN, gid = wgid / nig, fm = gid * WGM, gsz = (nM - fm) < WGM ? (nM - fm) : WGM;
        u.pm = fm + ((wgid % nig) % gsz); u.pn = (wgid % nig) / gsz; return true;
    }
};

struct ABDense {
    static constexpr bool GATHER = false;
    const bf16_t* A; const bf16_t* Bt; int K;
    __device__ __forceinline__ const char* abase(const Unit& u) const { return (const char*)A + (size_t)u.pm * BM * K * 2; }
    __device__ __forceinline__ const char* bbase(const Unit& u) const { return (const char*)Bt + (size_t)u.pn * BM * K * 2; }
    __device__ __forceinline__ const int* tokp(const Unit&) const { return nullptr; }
};
struct MoeMap { int T0; const PG8_LAS int* cum;
    __device__ __forceinline__ int mt(int pm) const { return pm < T0 ? pm : pm + (136 - T0); }
    __device__ __forceinline__ int expert(int mtile) const { const int r = mtile >= 136 ? 1 : 0, loc = mtile - 136 * r; int e = 0;
#pragma unroll
        for (int k = 1; k < 8; ++k) e += (loc >= cum[9 * r + k]) ? 1 : 0; return e; }
};
struct ABMoeUp {
    static constexpr bool GATHER = true;
    const bf16_t* A; const bf16_t* Bt; int K; const int* slot_tok; MoeMap mp; size_t estride;
    __device__ __forceinline__ const char* abase(const Unit&) const { return (const char*)A; }
    __device__ __forceinline__ const char* bbase(const Unit& u) const { return (const char*)(Bt + (size_t)mp.expert(mp.mt(u.pm)) * estride) + (size_t)u.pn * BM * K * 2; }
    __device__ __forceinline__ const int* tokp(const Unit& u) const { return slot_tok + mp.mt(u.pm) * BM; }
};
struct ABMoeDown {
    static constexpr bool GATHER = false;
    const bf16_t* A; const bf16_t* Bt; int K; MoeMap mp; size_t estride;
    __device__ __forceinline__ const char* abase(const Unit& u) const { return (const char*)A + (size_t)mp.mt(u.pm) * BM * K * 2; }
    __device__ __forceinline__ const char* bbase(const Unit& u) const { return (const char*)(Bt + (size_t)mp.expert(mp.mt(u.pm)) * estride) + (size_t)u.pn * BM * K * 2; }
    __device__ __forceinline__ const int* tokp(const Unit&) const { return nullptr; }
};

__device__ __forceinline__ unsigned cvt_pk_bf16(float lo, float hi) { unsigned r; asm volatile("v_cvt_pk_bf16_f32 %0, %1, %2" : "=v"(r) : "v"(lo), "v"(hi)); return r; }

template <int DH> struct EpiQKV {
    static constexpr bool PERM = true; typedef f32x4 acc_t;
    bf16_t* O; int ldc; const float* ct; const float* st; float qscale; const unsigned long long* rss; int* kms;
    __device__ __forceinline__ void operator()(const f32x4 (&acc)[2][2][4][2], const Unit& u, int wr, int wc, int fr, int fq) const {
        constexpr int NF = DH / 8;
        const int row0 = u.pm * BM + wr * 64 + fr, col0 = u.pn * BM + wc * 32 + 8 * fq;
        const int sect = u.pn >> 2;
        const float sc = (sect == 0) ? qscale : 1.f;
        const bool rot = (sect < 2) && (DH == 64 ? (((wc & 1) == 0) && (fq < 2)) : (wc == 0));
        f32x4 ksum[2][2] = {{(f32x4){0.f, 0.f, 0.f, 0.f}, (f32x4){0.f, 0.f, 0.f, 0.f}}, {(f32x4){0.f, 0.f, 0.f, 0.f}, (f32x4){0.f, 0.f, 0.f, 0.f}}};
        unsigned long long rq[8];
#pragma unroll
        for (int i = 0; i < 8; ++i) rq[i] = rss[row0 + (i >> 2) * HALF + (i & 3) * 16];
#pragma unroll
        for (int ai = 0; ai < 2; ++ai) {
            f32x4 c4[4], s4[4];
#pragma unroll
            for (int m = 0; m < 4; ++m) { const int pos = (row0 + ai * HALF + m * 16) & 8191; c4[m] = (f32x4){1.f, 1.f, 1.f, 1.f}; s4[m] = (f32x4){0.f, 0.f, 0.f, 0.f};
                if (rot) { c4[m] = *(const f32x4*)(ct + pos * NF + 4 * fq); s4[m] = *(const f32x4*)(st + pos * NF + 4 * fq); } }
#pragma unroll
            for (int m = 0; m < 4; ++m) {
                const int row = row0 + ai * HALF + m * 16; const float rs = sc * __builtin_amdgcn_rsqf((float)rq[ai * 4 + m] * (5.9604644775390625e-8f / 1024.0f) + 1e-6f);
                bf16_t* rowp = O + (size_t)row * ldc + col0;
#pragma unroll
                for (int bj = 0; bj < 2; ++bj) {
                    const f32x4 x1 = acc[ai][bj][m][0], x2 = acc[ai][bj][m][1];
                    f32x4 v0 = (x1 * c4[m] - x2 * s4[m]) * rs, v1 = (x2 * c4[m] + x1 * s4[m]) * rs;
                    u32x4 w; w.x = cvt_pk_bf16(v0[0], v0[1]); w.y = cvt_pk_bf16(v0[2], v0[3]); w.z = cvt_pk_bf16(v1[0], v1[1]); w.w = cvt_pk_bf16(v1[2], v1[3]);
                    *(u32x4*)(rowp + bj * HALF) = w;
                    if (DH == 128) { ksum[bj][0] += v0; ksum[bj][1] += v1; } }
            }
        }
        if (DH == 128 && kms && sect == 1) {
            const int blk = u.pm;
            int* dst = kms + ((size_t)((blk >> 5) * 8 + ((u.pn & 3) * 2)) * 32 + (blk & 31)) * 128;
#pragma unroll
            for (int bj = 0; bj < 2; ++bj)
#pragma unroll
                for (int n = 0; n < 2; ++n)
#pragma unroll
                    for (int c = 0; c < 4; ++c) { float s = ksum[bj][n][c];
                        s += __shfl_xor(s, 1); s += __shfl_xor(s, 2); s += __shfl_xor(s, 4); s += __shfl_xor(s, 8);
                        if (fr == 0) __hip_atomic_fetch_add(dst + bj * 32 * 128 + wc * 32 + 8 * fq + 4 * n + c, (int)__builtin_rintf(s * 65536.0f), __ATOMIC_RELAXED, __HIP_MEMORY_SCOPE_AGENT); }
        }
    }
};

typedef int i32x4_q __attribute__((ext_vector_type(4)));
template <int DH> struct EpiQKVQ {
    static constexpr bool PERM = true; typedef i32x4_q acc_t;
    bf16_t* O; int ldc; const float* ct; const float* st; float qscale; const float* sa; const unsigned* cm; int* kms;
    __device__ __forceinline__ void operator()(const i32x4_q (&acc)[2][2][4][2], const Unit& u, int wr, int wc, int fr, int fq) const {
        constexpr int NF = DH / 8;
        const int row0 = u.pm * BM + wr * 64 + fr, col0 = u.pn * BM + wc * 32 + 8 * fq;
        const int sect = u.pn >> 2;
        const float sc = (sect == 0) ? qscale : 1.f;
        const bool rot = (sect < 2) && (DH == 64 ? (((wc & 1) == 0) && (fq < 2)) : (wc == 0));
        f32x4 ksum[2][2] = {{(f32x4){0.f, 0.f, 0.f, 0.f}, (f32x4){0.f, 0.f, 0.f, 0.f}}, {(f32x4){0.f, 0.f, 0.f, 0.f}, (f32x4){0.f, 0.f, 0.f, 0.f}}};
        float cmv[2][8];
#pragma unroll
        for (int bj = 0; bj < 2; ++bj)
#pragma unroll
            for (int k = 0; k < 8; ++k) cmv[bj][k] = __uint_as_float(cm[col0 + bj * HALF + k]) * (1.0f / 127.0f);
        float rq[8];
#pragma unroll
        for (int i = 0; i < 8; ++i) rq[i] = sa[row0 + (i >> 2) * HALF + (i & 3) * 16];
#pragma unroll
        for (int ai = 0; ai < 2; ++ai) {
            f32x4 c4[4], s4[4];
#pragma unroll
            for (int m = 0; m < 4; ++m) { const int pos = (row0 + ai * HALF + m * 16) & 8191; c4[m] = (f32x4){1.f, 1.f, 1.f, 1.f}; s4[m] = (f32x4){0.f, 0.f, 0.f, 0.f};
                if (sect < 2) {
                    const int ti = rot ? pos * NF + 4 * fq : 0; const f32x4 cl = *(const f32x4*)(ct + ti), sl = *(const f32x4*)(st + ti);
                    c4[m] = rot ? cl : c4[m]; s4[m] = rot ? sl : s4[m]; } }
#pragma unroll
            for (int m = 0; m < 4; ++m) {
                const int row = row0 + ai * HALF + m * 16; const float rs = sc * rq[ai * 4 + m];
                bf16_t* rowp = O + (size_t)row * ldc + col0;
#pragma unroll
                for (int bj = 0; bj < 2; ++bj) {
                    const i32x4_q i1 = acc[ai][bj][m][0], i2 = acc[ai][bj][m][1];
                    const f32x4 x1 = (f32x4){(float)i1[0] * cmv[bj][0], (float)i1[1] * cmv[bj][1], (float)i1[2] * cmv[bj][2], (float)i1[3] * cmv[bj][3]}, x2 = (f32x4){(float)i2[0] * cmv[bj][4], (float)i2[1] * cmv[bj][5], (float)i2[2] * cmv[bj][6], (float)i2[3] * cmv[bj][7]};
                    f32x4 v0 = (x1 * c4[m] - x2 * s4[m]) * rs, v1 = (x2 * c4[m] + x1 * s4[m]) * rs;
                    u32x4 w; w.x = cvt_pk_bf16(v0[0], v0[1]); w.y = cvt_pk_bf16(v0[2], v0[3]); w.z = cvt_pk_bf16(v1[0], v1[1]); w.w = cvt_pk_bf16(v1[2], v1[3]);
                    *(u32x4*)(rowp + bj * HALF) = w;
                    if (DH == 128) { ksum[bj][0] += v0; ksum[bj][1] += v1; } }
            }
        }
        if (DH == 128 && kms && sect == 1) {
            const int blk = u.pm;
            int* dst = kms + ((size_t)((blk >> 5) * 8 + ((u.pn & 3) * 2)) * 32 + (blk & 31)) * 128;
#pragma unroll
            for (int bj = 0; bj < 2; ++bj)
#pragma unroll
                for (int n = 0; n < 2; ++n)
#pragma unroll
                    for (int c = 0; c < 4; ++c) { float s = ksum[bj][n][c];
                        s += __shfl_xor(s, 1); s += __shfl_xor(s, 2); s += __shfl_xor(s, 4); s += __shfl_xor(s, 8);
                        if (fr == 0) __hip_atomic_fetch_add(dst + bj * 32 * 128 + wc * 32 + 8 * fq + 4 * n + c, (int)__builtin_rintf(s * 65536.0f), __ATOMIC_RELAXED, __HIP_MEMORY_SCOPE_AGENT); }
        }
    }
};

__device__ __forceinline__ float silu_mul(float a, float b) { return a * b * __builtin_amdgcn_rcpf(1.0f + __builtin_amdgcn_exp2f(-1.4426950408889634f * a)); }
struct EpiSwiGLU {
    static constexpr bool PERM = true; typedef f32x4 acc_t;
    bf16_t* O; int ldc; const float* gate; const unsigned long long* rss; const int* rowmap;
    __device__ __forceinline__ void operator()(const f32x4 (&acc)[2][2][4][2], const Unit& u, int wr, int wc, int fr, int fq) const {
        const int row0 = u.pm * BM + wr * 64 + fr, col0 = u.pn * HALF + wc * 32 + 8 * fq;
#pragma unroll
        for (int ai = 0; ai < 2; ++ai)
#pragma unroll
            for (int m = 0; m < 4; ++m) {
                const int row = row0 + ai * HALF + m * 16; const float g = gate ? gate[row] : 1.f; const int trow = rowmap ? rowmap[row] : row;
                const float rs = trow >= 0 ? __builtin_amdgcn_rsqf((float)rss[trow] * (5.9604644775390625e-8f / 1024.0f) + 1e-6f) : 0.f;
                const f32x4 a0 = acc[ai][0][m][0] * rs, a1 = acc[ai][0][m][1] * rs, b0 = acc[ai][1][m][0] * rs, b1 = acc[ai][1][m][1] * rs;
                float v[8];
#pragma unroll
                for (int k = 0; k < 4; ++k) { v[k] = g * silu_mul(a0[k], b0[k]); v[4 + k] = g * silu_mul(a1[k], b1[k]); }
                u32x4 w; w.x = cvt_pk_bf16(v[0], v[1]); w.y = cvt_pk_bf16(v[2], v[3]); w.z = cvt_pk_bf16(v[4], v[5]); w.w = cvt_pk_bf16(v[6], v[7]);
                *(u32x4*)(O + (size_t)row * ldc + col0) = w; }
    }
};
struct EpiResB {
    static constexpr bool PERM = true; typedef f32x4 acc_t;
    const bf16_t* Rin; bf16_t* Rout; int ldc; const int* rowmap; unsigned long long* rss_out;
    __device__ __forceinline__ void operator()(const f32x4 (&acc)[2][2][4][2], const Unit& u, int wr, int wc, int fr, int fq) const {
        const int row0 = u.pm * BM + wr * 64 + fr, col0 = u.pn * BM + wc * 32 + 8 * fq;
        int orow[8];
#pragma unroll
        for (int i = 0; i < 8; ++i) { const int row = row0 + (i >> 2) * HALF + (i & 3) * 16; orow[i] = rowmap ? rowmap[row] : row; }
#pragma unroll
        for (int ai = 0; ai < 2; ++ai) {
            u32x4 bw[4][2];
#pragma unroll
            for (int m = 0; m < 4; ++m)
#pragma unroll
                for (int bj = 0; bj < 2; ++bj) bw[m][bj] = orow[ai * 4 + m] >= 0 ? *(const u32x4*)(Rin + (size_t)orow[ai * 4 + m] * ldc + col0 + bj * HALF) : (u32x4){0u, 0u, 0u, 0u};
#pragma unroll
            for (int m = 0; m < 4; ++m) { const int o_ = orow[ai * 4 + m]; float ss = 0.f;
                if (o_ >= 0) { bf16_t* wp = Rout + (size_t)o_ * ldc + col0;
#pragma unroll
                    for (int bj = 0; bj < 2; ++bj) { const u32x4 w = bw[m][bj]; const f32x4 a0 = acc[ai][bj][m][0], a1 = acc[ai][bj][m][1];
                        float v[8];
                        v[0] = __uint_as_float(w.x << 16) + a0[0]; v[1] = __uint_as_float(w.x & 0xffff0000u) + a0[1]; v[2] = __uint_as_float(w.y << 16) + a0[2]; v[3] = __uint_as_float(w.y & 0xffff0000u) + a0[3];
                        v[4] = __uint_as_float(w.z << 16) + a1[0]; v[5] = __uint_as_float(w.z & 0xffff0000u) + a1[1]; v[6] = __uint_as_float(w.w << 16) + a1[2]; v[7] = __uint_as_float(w.w & 0xffff0000u) + a1[3];
#pragma unroll
                        for (int k = 0; k < 8; ++k) ss += v[k] * v[k];
                        u32x4 o; o.x = cvt_pk_bf16(v[0], v[1]); o.y = cvt_pk_bf16(v[2], v[3]); o.z = cvt_pk_bf16(v[4], v[5]); o.w = cvt_pk_bf16(v[6], v[7]);
                        *(u32x4*)(wp + bj * HALF) = o; } }
                if (rss_out) { ss += __shfl_xor(ss, 16); ss += __shfl_xor(ss, 32);
                    if (fq == 0) __hip_atomic_fetch_add(rss_out + o_, (unsigned long long)(ss * 16777216.0f), __ATOMIC_RELAXED, __HIP_MEMORY_SCOPE_AGENT); } }
        }
    }
};

typedef int i32x4_e __attribute__((ext_vector_type(4)));
struct EpiSwiGLUQ {
    static constexpr bool PERM = true; typedef i32x4_e acc_t;
    signed char* O; int ldc; const float* sa; const unsigned* cm; const int* rowmap; MoeMap mp; float qmul;
    __device__ __forceinline__ void operator()(const i32x4_e (&acc)[2][2][4][2], const Unit& u, int wr, int wc, int fr, int fq) const {
        const int mtile = mp.cum ? mp.mt(u.pm) : u.pm; const int e = mp.cum ? mp.expert(mtile) : 0;
        const unsigned* cme = cm + (size_t)e * 7168 + u.pn * BM + wc * 32 + 8 * fq;
        f32x4 cA[2], cAB[2];
#pragma unroll
        for (int h = 0; h < 2; ++h)
#pragma unroll
            for (int k = 0; k < 4; ++k) { cA[h][k] = __uint_as_float(cme[4 * h + k]) * (1.0f / 127.0f); cAB[h][k] = cA[h][k] * (__uint_as_float(cme[HALF + 4 * h + k]) * (1.0f / 127.0f)); }
        const int row0 = mtile * BM + wr * 64 + fr, col0 = u.pn * HALF + wc * 32 + 8 * fq;
        float srow[8];
#pragma unroll
        for (int i = 0; i < 8; ++i) { const int row = row0 + (i >> 2) * HALF + (i & 3) * 16; const int trow = rowmap ? rowmap[row] : row; srow[i] = trow >= 0 ? sa[trow] : 0.f; }
#pragma unroll
        for (int ai = 0; ai < 2; ++ai)
#pragma unroll
            for (int m = 0; m < 4; ++m) {
                const int row = row0 + ai * HALF + m * 16; const float s = srow[ai * 4 + m];
                const float sneg = -1.4426950408889634f * s, s2q = s * s * qmul;
                unsigned pk[2];
#pragma unroll
                for (int h = 0; h < 2; ++h) {
                    const f32x4 fa = __builtin_convertvector(acc[ai][0][m][h], f32x4), fb = __builtin_convertvector(acc[ai][1][m][h], f32x4);
                    const f32x4 t = (fa * cA[h]) * sneg;
                    f32x4 e; e.x = __builtin_amdgcn_exp2f(t.x); e.y = __builtin_amdgcn_exp2f(t.y); e.z = __builtin_amdgcn_exp2f(t.z); e.w = __builtin_amdgcn_exp2f(t.w);
                    const f32x4 d = e + 1.0f;
                    f32x4 sg; sg.x = __builtin_amdgcn_rcpf(d.x); sg.y = __builtin_amdgcn_rcpf(d.y); sg.z = __builtin_amdgcn_rcpf(d.z); sg.w = __builtin_amdgcn_rcpf(d.w);
                    const f32x4 uq = (((fa * fb) * cAB[h]) * s2q) * sg + 128.0f;
                    unsigned w = 0u;
                    w = __builtin_amdgcn_cvt_pk_u8_f32(__builtin_rintf(uq.x), 0, w); w = __builtin_amdgcn_cvt_pk_u8_f32(__builtin_rintf(uq.y), 1, w);
                    w = __builtin_amdgcn_cvt_pk_u8_f32(__builtin_rintf(uq.z), 2, w); w = __builtin_amdgcn_cvt_pk_u8_f32(__builtin_rintf(uq.w), 3, w);
                    pk[h] = w ^ 0x80808080u; }
                *(unsigned long long*)(O + (size_t)row * ldc + col0) = (unsigned long long)pk[0] | ((unsigned long long)pk[1] << 32); }
    }
};
struct EpiResBQ {
    static constexpr bool PERM = true; typedef i32x4_e acc_t;
    const bf16_t* Rin; bf16_t* Rout; int ldc; const int* rowmap; const float* gate; const unsigned* cm; MoeMap mp; float dq; unsigned long long* rss_out; bf16_t* Y1;
    __device__ __forceinline__ void operator()(const i32x4_e (&acc)[2][2][4][2], const Unit& u, int wr, int wc, int fr, int fq) const {
        const int mtile = mp.cum ? mp.mt(u.pm) : u.pm; const int e = mp.cum ? mp.expert(mtile) : 0; const bool second = mp.cum && mtile >= 136;
        const int row0 = mtile * BM + wr * 64 + fr, col0 = u.pn * BM + wc * 32 + 8 * fq;
        const unsigned* cme = cm + (size_t)e * 1024 + col0;
        float sb[2][8];
#pragma unroll
        for (int bj = 0; bj < 2; ++bj)
#pragma unroll
            for (int k = 0; k < 8; ++k) sb[bj][k] = __uint_as_float(cme[bj * HALF + k]) * (dq / 127.0f);
        int orow[8]; float gts[8];
#pragma unroll
        for (int i = 0; i < 8; ++i) { const int row = row0 + (i >> 2) * HALF + (i & 3) * 16; orow[i] = rowmap ? rowmap[row] : row; gts[i] = gate ? gate[row] : 1.f; }
#pragma unroll
        for (int ai = 0; ai < 2; ++ai) {
            u32x4 bw[4][2];
#pragma unroll
            for (int m = 0; m < 4; ++m)
#pragma unroll
                for (int bj = 0; bj < 2; ++bj) bw[m][bj] = (orow[ai * 4 + m] >= 0 && !second) ? *(const u32x4*)(Rin + (size_t)orow[ai * 4 + m] * ldc + col0 + bj * HALF) : (u32x4){0u, 0u, 0u, 0u};
#pragma unroll
            for (int m = 0; m < 4; ++m) { const int o_ = orow[ai * 4 + m]; float ss = 0.f;
                if (o_ >= 0) { const float gt = gts[ai * 4 + m]; bf16_t* wp = (second ? Y1 : Rout) + (size_t)o_ * ldc + col0;
#pragma unroll
                    for (int bj = 0; bj < 2; ++bj) { const u32x4 w = bw[m][bj]; const i32x4_e a0 = acc[ai][bj][m][0], a1 = acc[ai][bj][m][1];
                        float v[8];
                        v[0] = __uint_as_float(w.x << 16) + (float)a0[0] * gt * sb[bj][0]; v[1] = __uint_as_float(w.x & 0xffff0000u) + (float)a0[1] * gt * sb[bj][1];
                        v[2] = __uint_as_float(w.y << 16) + (float)a0[2] * gt * sb[bj][2]; v[3] = __uint_as_float(w.y & 0xffff0000u) + (float)a0[3] * gt * sb[bj][3];
                        v[4] = __uint_as_float(w.z << 16) + (float)a1[0] * gt * sb[bj][4]; v[5] = __uint_as_float(w.z & 0xffff0000u) + (float)a1[1] * gt * sb[bj][5];
                        v[6] = __uint_as_float(w.w << 16) + (float)a1[2] * gt * sb[bj][6]; v[7] = __uint_as_float(w.w & 0xffff0000u) + (float)a1[3] * gt * sb[bj][7];
#pragma unroll
                        for (int k = 0; k < 8; ++k) ss += v[k] * v[k];
                        u32x4 o; o.x = cvt_pk_bf16(v[0], v[1]); o.y = cvt_pk_bf16(v[2], v[3]); o.z = cvt_pk_bf16(v[4], v[5]); o.w = cvt_pk_bf16(v[6], v[7]);
                        *(u32x4*)(wp + bj * HALF) = o; } }
                if (rss_out) { ss += __shfl_xor(ss, 16); ss += __shfl_xor(ss, 32);
                    if (fq == 0) __hip_atomic_fetch_add(rss_out + o_, (unsigned long long)(ss * 16777216.0f), __ATOMIC_RELAXED, __HIP_MEMORY_SCOPE_AGENT); } }
        }
    }
};
typedef int i32x4 __attribute__((ext_vector_type(4)));
__device__ __forceinline__ f32x4 mma16(bf16x8 a, bf16x8 b, f32x4 c) { return __builtin_amdgcn_mfma_f32_16x16x32_bf16(a, b, c, 0, 0, 0); }
__device__ __forceinline__ i32x4 mma16(bf16x8 a, bf16x8 b, i32x4 c) { return __builtin_amdgcn_mfma_i32_16x16x64_i8(__builtin_bit_cast(i32x4, a), __builtin_bit_cast(i32x4, b), c, 0, 0, 0); }
template <class Epi, class AB, bool ALIGN_EPI = true>
__device__ __forceinline__ void gemm_phase(PG8_LAS unsigned char* lds, const AB ab, const TileOrder& S, const Epi& E) {
    int tid = threadIdx.x; asm volatile("" : "+v"(tid));
    const int wid = __builtin_amdgcn_readfirstlane(tid >> 6), lane = tid & 63, wr = wid >> 2, wc = wid & 3, fr = lane & 15, fq = lane >> 4;
    const int K = ab.K, nt = K / BK;
    int Rr[2], Cc[2]; unsigned voffB[2];
#pragma unroll
    for (int i = 0; i < 2; ++i) { int R, C; stage_rc(tid * 16 + i * 8192, R, C); const int Rb = Epi::PERM ? ((R & ~31) + perm32(R & 31)) : R;
        Rr[i] = R; Cc[i] = C; voffB[i] = (unsigned)(Rb * K + C) * 2u; }
    const size_t kstep = (size_t)(BK * 2);
    const size_t hstep = (size_t)HALF * K * 2;
    const unsigned ldsw = (unsigned)wid * 1024u;
    const int aoff = lds_byte(wr * 64 + fr, fq * 8), boff = lds_byte(wc * 32 + fr, fq * 8);
#define PG8_SA(b, h) (((b) * 2 + (h)) * HTB)
#define PG8_SB(b, h) ((4 + (b) * 2 + (h)) * HTB)
#define PG8_STAGE(bufoff, gbase, voff) do { _Pragma("unroll") for (int _i = 0; _i < 2; ++_i) \
        __builtin_amdgcn_global_load_lds((const unsigned*)((const char*)(gbase) + (voff)[_i]), (PG8_LAS unsigned*)(lds + (bufoff) + ldsw + _i * 8192), 16, 0, 0); } while (0)
#define PG8_LDA(dst, b, h) do { _Pragma("unroll") for (int m = 0; m < 4; ++m) _Pragma("unroll") for (int k = 0; k < 2; ++k) dst[m][k] = *(const PG8_LAS bf16x8*)(lds + PG8_SA(b, h) + aoff + m * 2048 + k * 1024); } while (0)
#define PG8_LDB(dst, b, h) do { _Pragma("unroll") for (int n = 0; n < 2; ++n) _Pragma("unroll") for (int k = 0; k < 2; ++k) dst[n][k] = *(const PG8_LAS bf16x8*)(lds + PG8_SB(b, h) + boff + n * 2048 + k * 1024); } while (0)
#define PG8_MMA(ai, bj, At, Bt) do { __builtin_amdgcn_s_setprio(1); _Pragma("unroll") for (int m = 0; m < 4; ++m) _Pragma("unroll") for (int n = 0; n < 2; ++n) _Pragma("unroll") for (int k = 0; k < 2; ++k) \
        acc[ai][bj][m][n] = mma16(Bt[n][k], At[m][k], acc[ai][bj][m][n]); __builtin_amdgcn_s_setprio(0); } while (0)
#define PG8_WAIT_V(n) asm volatile("s_waitcnt vmcnt(" #n ")" ::: "memory")
#define PG8_WAIT_L(n) asm volatile("s_waitcnt lgkmcnt(" #n ")" ::: "memory")
#define PG8_BAR __builtin_amdgcn_s_barrier()
#define PG8_SCHED __builtin_amdgcn_sched_barrier(0)
    Unit cur, nxt; int ui = 0;
    if (!S.next(0, cur)) return;
    typedef typename Epi::acc_t acc_t;
    acc_t acc[2][2][4][2];
#pragma unroll
    for (int a = 0; a < 2; ++a)
#pragma unroll
        for (int b = 0; b < 2; ++b)
#pragma unroll
            for (int m = 0; m < 4; ++m)
#pragma unroll
                for (int n = 0; n < 2; ++n) acc[a][b][m][n] = (acc_t){0, 0, 0, 0};
    bf16x8 At[4][2], B0[2][2], B1[2][2];
    unsigned cv0[2], cv1[2], nv0[2], nv1[2]; int ntok[4] = {0, 0, 0, 0};
    if constexpr (AB::GATHER) { const int* tp = ab.tokp(cur);
#pragma unroll
        for (int i = 0; i < 2; ++i) { int t0 = tp[Rr[i]], t1 = tp[HALF + Rr[i]]; t0 = t0 < 0 ? 0 : t0; t1 = t1 < 0 ? 0 : t1;
            cv0[i] = (unsigned)(t0 * K + Cc[i]) * 2u; cv1[i] = (unsigned)(t1 * K + Cc[i]) * 2u; }
    } else {
#pragma unroll
        for (int i = 0; i < 2; ++i) { cv0[i] = (unsigned)(Rr[i] * K + Cc[i]) * 2u; cv1[i] = cv0[i] + (unsigned)hstep; }
    }
#pragma unroll
    for (int i = 0; i < 2; ++i) { nv0[i] = cv0[i]; nv1[i] = cv1[i]; }
    const char* cA = ab.abase(cur); const char* cB = ab.bbase(cur);
    PG8_STAGE(PG8_SB(0, 0), cB, voffB); PG8_STAGE(PG8_SB(0, 1), cB + hstep, voffB); PG8_STAGE(PG8_SA(0, 0), cA, cv0); PG8_STAGE(PG8_SA(0, 1), cA, cv1);
    if (wr == 1) PG8_BAR;
    PG8_WAIT_V(2); PG8_BAR;
    PG8_STAGE(PG8_SB(1, 0), cB + kstep, voffB); PG8_STAGE(PG8_SA(1, 0), cA + kstep, cv0); PG8_STAGE(PG8_SB(1, 1), cB + hstep + kstep, voffB);
    PG8_WAIT_V(6); PG8_BAR;
    for (;;) {
        const bool has_next = S.next(ui + 1, nxt);
        const char* nA = has_next ? ab.abase(nxt) : cA; const char* nB = has_next ? ab.bbase(nxt) : cB;
        if constexpr (AB::GATHER) {
            if (has_next) { const int* tp = ab.tokp(nxt);
                asm volatile("global_load_dword %0, %1, off" : "=v"(ntok[0]) : "v"(tp + Rr[0]) : "memory");
                asm volatile("global_load_dword %0, %1, off" : "=v"(ntok[1]) : "v"(tp + Rr[1]) : "memory");
                asm volatile("global_load_dword %0, %1, off" : "=v"(ntok[2]) : "v"(tp + HALF + Rr[0]) : "memory");
                asm volatile("global_load_dword %0, %1, off" : "=v"(ntok[3]) : "v"(tp + HALF + Rr[1]) : "memory"); }
        }
        for (int t = 0; t < nt; t += 2) {
            const bool last = (t == nt - 2);
            const char* a1 = cA + (size_t)(t + 1) * kstep;
            const char* a2 = last ? nA : cA + (size_t)(t + 2) * kstep; const char* b2 = last ? nB : cB + (size_t)(t + 2) * kstep;
            const char* a3 = a2 + kstep; const char* b3 = b2 + kstep;
            unsigned x0[2], x1[2];
            if constexpr (AB::GATHER) {
                if (last && has_next) {
                    asm volatile("s_waitcnt vmcnt(6)" : "+v"(ntok[0]), "+v"(ntok[1]), "+v"(ntok[2]), "+v"(ntok[3]) :: "memory");
#pragma unroll
                    for (int i = 0; i < 2; ++i) { int t0 = ntok[i], t1 = ntok[2 + i]; t0 = t0 < 0 ? 0 : t0; t1 = t1 < 0 ? 0 : t1;
                        nv0[i] = (unsigned)(t0 * K + Cc[i]) * 2u; nv1[i] = (unsigned)(t1 * K + Cc[i]) * 2u; }
                }
#pragma unroll
                for (int i = 0; i < 2; ++i) { x0[i] = last ? nv0[i] : cv0[i]; x1[i] = last ? nv1[i] : cv1[i]; }
            } else {
#pragma unroll
                for (int i = 0; i < 2; ++i) { x0[i] = cv0[i]; x1[i] = cv1[i]; }
            }
            PG8_LDB(B0, 0, 0); PG8_LDB(B1, 0, 1); PG8_SCHED; PG8_LDA(At, 0, 0); PG8_STAGE(PG8_SA(1, 1), a1, cv1);
            PG8_WAIT_V(8); PG8_WAIT_L(0); PG8_BAR; PG8_MMA(0, 0, At, B0); PG8_MMA(0, 1, At, B1); PG8_BAR; PG8_SCHED;
            PG8_LDA(At, 0, 1); PG8_STAGE(PG8_SB(0, 0), b2, voffB); PG8_STAGE(PG8_SB(0, 1), b2 + hstep, voffB); PG8_STAGE(PG8_SA(0, 0), a2, x0);
            PG8_WAIT_V(8); PG8_WAIT_L(0); PG8_BAR; PG8_MMA(1, 0, At, B0); PG8_MMA(1, 1, At, B1); PG8_BAR; PG8_SCHED;
            PG8_LDB(B0, 1, 0); PG8_LDB(B1, 1, 1); PG8_SCHED; PG8_LDA(At, 1, 0); PG8_STAGE(PG8_SA(0, 1), a2, x1);
            PG8_WAIT_V(8); PG8_WAIT_L(0); PG8_BAR; PG8_MMA(0, 0, At, B0); PG8_MMA(0, 1, At, B1); PG8_BAR; PG8_SCHED;
            PG8_LDA(At, 1, 1); PG8_STAGE(PG8_SB(1, 0), b3, voffB); PG8_STAGE(PG8_SB(1, 1), b3 + hstep, voffB); PG8_STAGE(PG8_SA(1, 0), a3, x0);
            PG8_WAIT_V(8); PG8_WAIT_L(0); PG8_BAR; PG8_MMA(1, 0, At, B0); PG8_MMA(1, 1, At, B1); PG8_BAR; PG8_SCHED;
        }
        if constexpr (ALIGN_EPI) { if (wr == 0) PG8_BAR; }
        E(acc, cur, wr, wc, fr, fq);
        if (!has_next) break;
#pragma unroll
        for (int a = 0; a < 2; ++a)
#pragma unroll
            for (int b = 0; b < 2; ++b)
#pragma unroll
                for (int m = 0; m < 4; ++m)
#pragma unroll
                    for (int n = 0; n < 2; ++n) acc[a][b][m][n] = (acc_t){0, 0, 0, 0};
        cur = nxt; cA = nA; cB = nB; ++ui;
#pragma unroll
        for (int i = 0; i < 2; ++i) { cv0[i] = nv0[i]; cv1[i] = nv1[i]; }
        if constexpr (ALIGN_EPI) { if (wr == 1) PG8_BAR; }
    }
    PG8_WAIT_V(0);
    if constexpr (!ALIGN_EPI) { if (wr == 0) PG8_BAR; }
    PG8_BAR;
#undef PG8_SA
#undef PG8_SB
#undef PG8_STAGE
#undef PG8_LDA
#undef PG8_LDB
#undef PG8_MMA
#undef PG8_WAIT_V
#undef PG8_WAIT_L
#undef PG8_BAR
#undef PG8_SCHED
}
}

namespace moba {
using bf16 = __hip_bfloat16;
using bf16x8 = __attribute__((ext_vector_type(8))) short;
using s16x4  = __attribute__((ext_vector_type(4))) short;
using f32x16 = __attribute__((ext_vector_type(16))) float;
using u32x4  = __attribute__((ext_vector_type(4))) unsigned;
constexpr int D = 128, NW = 8, QBLK = 32, KVBLK = 64, LDK = 3072, NT = 4;
constexpr float THR = 8.f;
constexpr size_t SHM_V = KVBLK * D * 2, SHM_K = KVBLK * D * 2, SHM_ATTN = 2 * SHM_V + 2 * SHM_K + NW * 64 * 4;
#define KSWZ(row, colB) ((row) * 256 + ((colB) ^ (((row) & 7) << 4)))
#define SBAR() __builtin_amdgcn_sched_barrier(0)
__device__ __forceinline__ int crow(int r, int hi) { return (r & 3) + 8 * (r >> 2) + 4 * hi; }
__device__ __forceinline__ unsigned cvtpk(float lo, float hi) { unsigned r; asm volatile("v_cvt_pk_bf16_f32 %0, %1, %2" : "=v"(r) : "v"(lo), "v"(hi)); return r; }
__device__ __forceinline__ void partialSM(f32x16& p0, f32x16& p1, float& m_reg, float& mn, float& alpha) {
  float pmax = p0[0];
#pragma unroll
  for (int r = 1; r < 16; ++r) pmax = fmaxf(pmax, p0[r]);
#pragma unroll
  for (int r = 0; r < 16; ++r) pmax = fmaxf(pmax, p1[r]);
  { auto rr = __builtin_amdgcn_permlane32_swap(__float_as_uint(pmax), __float_as_uint(pmax), false, false);
    pmax = fmaxf(__uint_as_float(rr[0]), __uint_as_float(rr[1])); }
  if (__builtin_expect(__all(pmax - m_reg <= THR), 1)) { mn = m_reg; alpha = 1.f; }
  else { mn = fmaxf(m_reg, pmax); alpha = __builtin_amdgcn_exp2f(m_reg - mn); m_reg = mn; }
#pragma unroll
  for (int r = 0; r < 16; ++r) p0[r] = p0[r] - mn;
#pragma unroll
  for (int r = 0; r < 16; ++r) p1[r] = p1[r] - mn;
#pragma unroll
  for (int r = 0; r < 16; ++r) p0[r] = __builtin_amdgcn_exp2f(p0[r]);
}
__device__ __forceinline__ void finishSM(f32x16& p0, f32x16& p1, float alpha, float& l_reg, bf16x8& pa0, bf16x8& pa1, bf16x8& pa2, bf16x8& pa3) {
#pragma unroll
  for (int r = 0; r < 16; ++r) p1[r] = __builtin_amdgcn_exp2f(p1[r]);
  float ps = 0;
#pragma unroll
  for (int r = 0; r < 16; ++r) ps += p0[r];
#pragma unroll
  for (int r = 0; r < 16; ++r) ps += p1[r];
  { auto rr = __builtin_amdgcn_permlane32_swap(__float_as_uint(ps), __float_as_uint(ps), false, false);
    ps = __uint_as_float(rr[0]) + __uint_as_float(rr[1]); }
  l_reg = l_reg * alpha + ps;
#define PK4(P, BASE, OUT) do { unsigned a0 = cvtpk(P[BASE + 0], P[BASE + 1]), a1 = cvtpk(P[BASE + 2], P[BASE + 3]);   \
    unsigned b0 = cvtpk(P[BASE + 4], P[BASE + 5]), b1 = cvtpk(P[BASE + 6], P[BASE + 7]);                              \
    auto r0 = __builtin_amdgcn_permlane32_swap(a0, b0, false, false); auto r1 = __builtin_amdgcn_permlane32_swap(a1, b1, false, false); \
    u32x4 w = {r0[0], r1[0], r0[1], r1[1]}; OUT = *reinterpret_cast<bf16x8*>(&w); } while (0)
  PK4(p0, 0, pa0); PK4(p0, 8, pa1); PK4(p1, 0, pa2); PK4(p1, 8, pa3);
#undef PK4
}
__device__ __forceinline__ void qkt(f32x16& p0, f32x16& p1, const bf16* Ks, const bf16x8* qr, int r32, int hi) {
  p0 = f32x16{}; p1 = f32x16{};
#pragma unroll
  for (int h2 = 0; h2 < 2; ++h2) {
    bf16x8 kf[8];
#pragma unroll
    for (int d = 0; d < 4; ++d) { int cb = ((4 * h2 + d) * 16 + hi * 8) * 2;
      kf[2 * d] = *reinterpret_cast<const bf16x8*>((const char*)Ks + KSWZ(r32, cb)); kf[2 * d + 1] = *reinterpret_cast<const bf16x8*>((const char*)Ks + KSWZ(32 + r32, cb)); }
    SBAR();
    __builtin_amdgcn_s_setprio(1);
#pragma unroll
    for (int d = 0; d < 4; ++d) { p0 = __builtin_amdgcn_mfma_f32_32x32x16_bf16(kf[2 * d], qr[4 * h2 + d], p0, 0, 0, 0); p1 = __builtin_amdgcn_mfma_f32_32x32x16_bf16(kf[2 * d + 1], qr[4 * h2 + d], p1, 0, 0, 0); }
    __builtin_amdgcn_s_setprio(0);
  }
}
__device__ __forceinline__ int v_st(int k, int c) { const int kk = (k & ~0xC) | ((k & 4) << 1) | ((k & 8) >> 1); return ((kk >> 3) * 4 + (c >> 5)) * 512 + ((kk & 7) * 32 + (c & 31)) * 2; }
__device__ __forceinline__ int v_rd_base(int lane) { return ((lane & 3) << 3) | (((lane >> 2) & 3) << 6) | (((lane >> 4) & 1) << 5) | (((lane >> 5) & 1) << 8); }
constexpr int v_rd_off(int d0, int ks, int half) { return d0 * 512 + ks * 4096 + half * 2048; }
template <int OFF> __device__ __forceinline__ s16x4 tr_read(int vb) {
  s16x4 r; asm volatile("ds_read_b64_tr_b16 %0, %1 offset:%2" : "=&v"(r) : "v"(vb), "i"(OFF) : "memory"); return r;
}
template <int D0> __device__ __forceinline__ void pv_one(f32x16& od, int vb, bf16x8 pa0, bf16x8 pa1, bf16x8 pa2, bf16x8 pa3) {
  const s16x4 l0 = tr_read<v_rd_off(D0, 0, 0)>(vb), h0 = tr_read<v_rd_off(D0, 0, 1)>(vb), l1 = tr_read<v_rd_off(D0, 1, 0)>(vb), h1 = tr_read<v_rd_off(D0, 1, 1)>(vb);
  const s16x4 l2 = tr_read<v_rd_off(D0, 2, 0)>(vb), h2 = tr_read<v_rd_off(D0, 2, 1)>(vb), l3 = tr_read<v_rd_off(D0, 3, 0)>(vb), h3 = tr_read<v_rd_off(D0, 3, 1)>(vb);
  asm volatile("s_waitcnt lgkmcnt(0)" ::: "memory"); SBAR();
  __builtin_amdgcn_s_setprio(1);
#define PK(L, H) (bf16x8){L[0], L[1], L[2], L[3], H[0], H[1], H[2], H[3]}
  od = __builtin_amdgcn_mfma_f32_32x32x16_bf16(pa0, PK(l0, h0), od, 0, 0, 0);
  od = __builtin_amdgcn_mfma_f32_32x32x16_bf16(pa1, PK(l1, h1), od, 0, 0, 0);
  od = __builtin_amdgcn_mfma_f32_32x32x16_bf16(pa2, PK(l2, h2), od, 0, 0, 0);
  od = __builtin_amdgcn_mfma_f32_32x32x16_bf16(pa3, PK(l3, h3), od, 0, 0, 0);
  __builtin_amdgcn_s_setprio(0);
#undef PK
}
__device__ __forceinline__ void pv_d0(f32x16* o, int vb, bf16x8 pa0, bf16x8 pa1, bf16x8 pa2, bf16x8 pa3) {
  pv_one<0>(o[0], vb, pa0, pa1, pa2, pa3); pv_one<1>(o[1], vb, pa0, pa1, pa2, pa3); pv_one<2>(o[2], vb, pa0, pa1, pa2, pa3); pv_one<3>(o[3], vb, pa0, pa1, pa2, pa3);
}
template <int D0> __device__ __forceinline__ void v_rd8(s16x4 (&f)[8], int vb) {
  f[0] = tr_read<v_rd_off(D0, 0, 0)>(vb); f[1] = tr_read<v_rd_off(D0, 0, 1)>(vb); f[2] = tr_read<v_rd_off(D0, 1, 0)>(vb); f[3] = tr_read<v_rd_off(D0, 1, 1)>(vb);
  f[4] = tr_read<v_rd_off(D0, 2, 0)>(vb); f[5] = tr_read<v_rd_off(D0, 2, 1)>(vb); f[6] = tr_read<v_rd_off(D0, 3, 0)>(vb); f[7] = tr_read<v_rd_off(D0, 3, 1)>(vb);
}
__device__ __forceinline__ void pv_mma4(f32x16& od, const s16x4 (&f)[8], bf16x8 pa0, bf16x8 pa1, bf16x8 pa2, bf16x8 pa3) {
#define PK(L, H) (bf16x8){L[0], L[1], L[2], L[3], H[0], H[1], H[2], H[3]}
  __builtin_amdgcn_s_setprio(1);
  od = __builtin_amdgcn_mfma_f32_32x32x16_bf16(pa0, PK(f[0], f[1]), od, 0, 0, 0);
  od = __builtin_amdgcn_mfma_f32_32x32x16_bf16(pa1, PK(f[2], f[3]), od, 0, 0, 0);
  od = __builtin_amdgcn_mfma_f32_32x32x16_bf16(pa2, PK(f[4], f[5]), od, 0, 0, 0);
  od = __builtin_amdgcn_mfma_f32_32x32x16_bf16(pa3, PK(f[6], f[7]), od, 0, 0, 0);
  __builtin_amdgcn_s_setprio(0);
#undef PK
}
__device__ __forceinline__ void pv_d0p(f32x16* o, int vb, bf16x8 pa0, bf16x8 pa1, bf16x8 pa2, bf16x8 pa3) {
  s16x4 fa[8], fb[8];
  v_rd8<0>(fa, vb); v_rd8<1>(fb, vb);
  asm volatile("s_waitcnt lgkmcnt(8)" ::: "memory"); SBAR(); pv_mma4(o[0], fa, pa0, pa1, pa2, pa3); SBAR();
  v_rd8<2>(fa, vb);
  asm volatile("s_waitcnt lgkmcnt(8)" ::: "memory"); SBAR(); pv_mma4(o[1], fb, pa0, pa1, pa2, pa3); SBAR();
  v_rd8<3>(fb, vb);
  asm volatile("s_waitcnt lgkmcnt(8)" ::: "memory"); SBAR(); pv_mma4(o[2], fa, pa0, pa1, pa2, pa3); SBAR();
  asm volatile("s_waitcnt lgkmcnt(0)" ::: "memory"); SBAR(); pv_mma4(o[3], fb, pa0, pa1, pa2, pa3); SBAR();
}
__device__ __forceinline__ void cmask(f32x16& p0, f32x16& p1, int tile, int ql, int hi) {
  asm volatile("" : "+v"(ql));
#pragma unroll
  for (int r = 0; r < 16; ++r) { const int kv = 64 * tile + (r & 3) + 8 * (r >> 2) + 4 * hi; if (kv > ql) p0[r] = -1e30f; if (kv + 32 > ql) p1[r] = -1e30f; }
}
__device__ __forceinline__ void moba_unit(const bool OWN, const bf16* qrow, const bf16* __restrict__ Kh, const bf16* __restrict__ Vh, bf16* obase, int ostride, int dst, float* ml, int mli, int ql, char* lds) {
  const int tid = threadIdx.x, wid = tid >> 6, lane = tid & 63, r32 = lane & 31, hi = lane >> 5;
  bf16* V_lds = (bf16*)lds; bf16* K_lds = (bf16*)(lds + 2 * SHM_V);
  float* ws = (float*)(lds + 2 * SHM_V + 2 * SHM_K) + wid * 64; float* li_l = ws; float* al_l = ws + 32;
  float m_reg = -1e30f, l_reg = 0; f32x16 o[4] = {}; bf16x8 qr[8];
  const bf16* Qw = qrow + hi * 8;
#pragma unroll
  for (int d0 = 0; d0 < 8; ++d0) qr[d0] = *reinterpret_cast<const bf16x8*>(Qw + d0 * 16);
  const int sr = tid >> 4, sc = (tid & 15) * 8, vst0 = v_st(sr, sc), vst1 = v_st(32 + sr, sc);
  const int vb0 = (int)(uintptr_t)V_lds + v_rd_base(lane);
  struct { bf16x8 vs0, vs1, ks0, ks1; } sr_[2];
#define SLOAD(i, k0) do { sr_[i].vs0 = *reinterpret_cast<const bf16x8*>(&Vh[(long)((k0) + sr) * LDK + sc]); sr_[i].vs1 = *reinterpret_cast<const bf16x8*>(&Vh[(long)((k0) + 32 + sr) * LDK + sc]); \
    sr_[i].ks0 = *reinterpret_cast<const bf16x8*>(&Kh[(long)((k0) + sr) * LDK + sc]); sr_[i].ks1 = *reinterpret_cast<const bf16x8*>(&Kh[(long)((k0) + 32 + sr) * LDK + sc]); } while (0)
#define SWRITE(b, i) do { *(bf16x8*)((char*)V_lds + (b) * SHM_V + vst0) = sr_[i].vs0;          \
    *(bf16x8*)((char*)V_lds + (b) * SHM_V + vst1) = sr_[i].vs1; int kc = sc * 2;               \
    *(bf16x8*)((char*)K_lds + (b) * SHM_K + KSWZ(sr, kc)) = sr_[i].ks0;                       \
    *(bf16x8*)((char*)K_lds + (b) * SHM_K + KSWZ(32 + sr, kc)) = sr_[i].ks1; } while (0)
#define SWAIT() asm volatile("s_waitcnt vmcnt(4)" ::: "memory")
#define RESC(a) do { if (__any((a) < 1.f)) { if (hi == 0) al_l[r32] = (a); asm volatile("s_waitcnt lgkmcnt(0)" ::: "memory"); \
    _Pragma("unroll") for (int d = 0; d < 4; ++d) _Pragma("unroll") for (int r = 0; r < 16; ++r) o[d][r] *= al_l[crow(r, hi)]; } } while (0)
  f32x16 pA0, pA1, pB0, pB1; float mnA, mnB, alA, alB; bf16x8 pa0, pa1, pa2, pa3;
  constexpr int SE = 0, SO = 1;
  SLOAD(SE, 0); asm volatile("s_waitcnt vmcnt(0)" ::: "memory"); SWRITE(0, SE); __syncthreads();
  qkt(pA0, pA1, K_lds, qr, r32, hi); if (OWN) cmask(pA0, pA1, 0, ql, hi); partialSM(pA0, pA1, m_reg, mnA, alA);
  SLOAD(SO, KVBLK); SLOAD(SE, 2 * KVBLK);
  SWAIT(); SWRITE(1, SO); __syncthreads();
  {
    SBAR(); qkt(pB0, pB1, (bf16*)((char*)K_lds + SHM_K), qr, r32, hi);
    finishSM(pA0, pA1, alA, l_reg, pa0, pa1, pa2, pa3); SBAR();
    SLOAD(SO, 3 * KVBLK); SBAR();
    pv_d0(o, vb0, pa0, pa1, pa2, pa3); if (OWN) cmask(pB0, pB1, 1, ql, hi); partialSM(pB0, pB1, m_reg, mnB, alB);
    __syncthreads(); SWAIT(); SWRITE(0, SE);
    RESC(alB); __syncthreads();
    SBAR(); qkt(pA0, pA1, K_lds, qr, r32, hi);
    finishSM(pB0, pB1, alB, l_reg, pa0, pa1, pa2, pa3); SBAR();
    pv_d0(o, vb0 + (int)SHM_V, pa0, pa1, pa2, pa3); if (OWN) cmask(pA0, pA1, 2, ql, hi); partialSM(pA0, pA1, m_reg, mnA, alA);
    __syncthreads(); asm volatile("s_waitcnt vmcnt(0)" ::: "memory"); SWRITE(1, SO);
    RESC(alA); __syncthreads();
  }
  SBAR(); qkt(pB0, pB1, (bf16*)((char*)K_lds + SHM_K), qr, r32, hi);
  finishSM(pA0, pA1, alA, l_reg, pa0, pa1, pa2, pa3); SBAR();
  pv_d0(o, vb0, pa0, pa1, pa2, pa3); if (OWN) cmask(pB0, pB1, 3, ql, hi); partialSM(pB0, pB1, m_reg, mnB, alB);
  __syncthreads(); RESC(alB);
  finishSM(pB0, pB1, alB, l_reg, pa0, pa1, pa2, pa3); SBAR();
  pv_d0(o, vb0 + (int)SHM_V, pa0, pa1, pa2, pa3);
  if (hi == 0) li_l[r32] = l_reg; asm volatile("s_waitcnt lgkmcnt(0)" ::: "memory");
  float rli[16];
#pragma unroll
  for (int r = 0; r < 16; ++r) rli[r] = __builtin_amdgcn_rcpf(li_l[crow(r, hi)]);
  __syncthreads();
  bf16* stg = (bf16*)lds + wid * 4096;
#pragma unroll
  for (int r = 0; r < 16; ++r) { const int orow = crow(r, hi);
#pragma unroll
    for (int d0 = 0; d0 < 4; ++d0) stg[orow * 128 + d0 * 32 + r32] = __float2bfloat16(o[d0][r] * rli[r]); }
  int* dsto = (int*)al_l;
  if (hi == 0) dsto[r32] = dst;
  asm volatile("s_waitcnt lgkmcnt(0)" ::: "memory");
#pragma unroll
  for (int i = 0; i < 8; ++i) { const int row = i * 4 + (lane >> 4), ch = lane & 15; const int di = dsto[row]; const u32x4 v = *(const u32x4*)(stg + row * 128 + ch * 8);
    if (di >= 0) *(u32x4*)(obase + (size_t)di * ostride + ch * 8) = v; }
  if (hi == 0 && dst >= 0) { ml[2 * (size_t)mli] = m_reg; ml[2 * (size_t)mli + 1] = l_reg; }
  asm volatile("s_waitcnt lgkmcnt(0)" ::: "memory");
  __syncthreads();
#undef SLOAD
#undef SWRITE
#undef SWAIT
#undef RESC
}

constexpr int MB2_K = 0, MB2_V = 65536, MB2_WV = 132096, MB2_WVB = 2560;
__device__ __forceinline__ void mb2_glds16(const void* gsrc, unsigned lds_dst) { unsigned keep;
  asm volatile("s_mov_b32 %0, m0\n\ts_mov_b32 m0, %2\n\ts_nop 0\n\tglobal_load_lds_dwordx4 %1, off\n\ts_mov_b32 m0, %0" : "=&s"(keep) : "v"(gsrc), "s"(lds_dst) : "memory"); }
__device__ __forceinline__ void moba_load_block(const bf16* __restrict__ Kh, const bf16* __restrict__ Vh, char* lds) {
  int tid = threadIdx.x; asm volatile("" : "+v"(tid)); const int lane = tid & 63; const int wid = __builtin_amdgcn_readfirstlane(tid >> 6);
  const unsigned lds0 = (unsigned)(uintptr_t)lds;
#pragma unroll
  for (int i = 0; i < 8; ++i) { const int p = wid + 8 * i; const int row = 4 * p + (lane >> 4), ch = (lane & 15) ^ (row & 7);
    mb2_glds16(Kh + (long)row * LDK + ch * 8, (unsigned)__builtin_amdgcn_readfirstlane(lds0 + MB2_K + p * 1024)); }
#pragma unroll
  for (int i = 0; i < 8; ++i) { const int q = wid + 8 * i, t = q >> 4, pi = q & 15; const int off = pi * 1024 + lane * 16, sub = off >> 9, within = (off & 511) >> 1;
    const int kk = (sub >> 2) * 8 + (within >> 5), c = (sub & 3) * 32 + (within & 31), k = (kk & ~0xC) | ((kk & 4) << 1) | ((kk & 8) >> 1);
    mb2_glds16(Vh + (long)(64 * t + k) * LDK + c, (unsigned)__builtin_amdgcn_readfirstlane(lds0 + MB2_V + q * 1024)); }
}
template <bool own> __device__ __forceinline__ void moba_sub(const int tmax, const bf16* qrow, bf16* obase, int ostride, int dst, float* ml, int mli, int ql, char* lds, int wid) {
  int tid = threadIdx.x; asm volatile("" : "+v"(tid)); const int lane = tid & 63, r32 = lane & 31, hi = lane >> 5;
  const bf16* K_lds = (const bf16*)(lds + MB2_K);
  bf16* stg = (bf16*)(lds + MB2_WV + wid * MB2_WVB); float* ws = (float*)(lds + MB2_WV + wid * MB2_WVB + 2048); float* li_l = ws; float* al_l = ws + 32;
  const int vb0 = (int)(uintptr_t)(lds + MB2_V) + v_rd_base(lane);
  float m_reg = -1e30f, l_reg = 0; f32x16 o[4] = {}; bf16x8 qr[8];
  const bf16* Qw = qrow + hi * 8;
#pragma unroll
  for (int d0 = 0; d0 < 8; ++d0) qr[d0] = *reinterpret_cast<const bf16x8*>(Qw + d0 * 16);
#define RESC(a) do { if (__any((a) < 1.f)) { if (hi == 0) al_l[r32] = (a); asm volatile("s_waitcnt lgkmcnt(0)" ::: "memory"); \
    _Pragma("unroll") for (int d = 0; d < 4; ++d) _Pragma("unroll") for (int r = 0; r < 16; ++r) o[d][r] *= al_l[crow(r, hi)]; } } while (0)
#define KT(t) ((const bf16*)((const char*)K_lds + (t) * SHM_K))
#define VT(t) (vb0 + (t) * (int)SHM_V)
  f32x16 pA0, pA1, pB0, pB1; float mnA, mnB, alA, alB; bf16x8 pa0, pa1, pa2, pa3;
  qkt(pA0, pA1, KT(0), qr, r32, hi); if (own) cmask(pA0, pA1, 0, ql, hi); partialSM(pA0, pA1, m_reg, mnA, alA);
  SBAR(); qkt(pB0, pB1, KT(1), qr, r32, hi); finishSM(pA0, pA1, alA, l_reg, pa0, pa1, pa2, pa3); SBAR();
  pv_d0p(o, VT(0), pa0, pa1, pa2, pa3); if (own) cmask(pB0, pB1, 1, ql, hi); partialSM(pB0, pB1, m_reg, mnB, alB); RESC(alB);
  SBAR(); qkt(pA0, pA1, KT(2), qr, r32, hi); finishSM(pB0, pB1, alB, l_reg, pa0, pa1, pa2, pa3); SBAR();
  pv_d0p(o, VT(1), pa0, pa1, pa2, pa3); if (own) cmask(pA0, pA1, 2, ql, hi); partialSM(pA0, pA1, m_reg, mnA, alA); RESC(alA);
  SBAR(); qkt(pB0, pB1, KT(3), qr, r32, hi); finishSM(pA0, pA1, alA, l_reg, pa0, pa1, pa2, pa3); SBAR();
  pv_d0p(o, VT(2), pa0, pa1, pa2, pa3); if (own) cmask(pB0, pB1, 3, ql, hi); partialSM(pB0, pB1, m_reg, mnB, alB); RESC(alB);
  finishSM(pB0, pB1, alB, l_reg, pa0, pa1, pa2, pa3); SBAR(); pv_d0p(o, VT(3), pa0, pa1, pa2, pa3);
  (void)tmax;
  if (hi == 0) { li_l[r32] = l_reg; ((int*)al_l)[r32] = dst; } asm volatile("s_waitcnt lgkmcnt(0)" ::: "memory");
  float rli[16];
#pragma unroll
  for (int r = 0; r < 16; ++r) rli[r] = __builtin_amdgcn_rcpf(li_l[crow(r, hi)]);
#pragma unroll
  for (int g = 0; g < 4; ++g) {
#pragma unroll
    for (int rr = 0; rr < 4; ++rr)
#pragma unroll
      for (int d0 = 0; d0 < 4; ++d0) stg[(4 * hi + rr) * 128 + d0 * 32 + r32] = __float2bfloat16(o[d0][4 * g + rr] * rli[4 * g + rr]);
    asm volatile("s_waitcnt lgkmcnt(0)" ::: "memory");
#pragma unroll
    for (int i = 0; i < 2; ++i) { const int pc = i * 64 + lane, rl = pc >> 4, ch = pc & 15; const int di = ((const int*)al_l)[8 * g + rl]; const u32x4 v = *(const u32x4*)(stg + rl * 128 + ch * 8);
      if (di >= 0) *(u32x4*)(obase + (size_t)di * ostride + ch * 8) = v; }
    asm volatile("s_waitcnt lgkmcnt(0)" ::: "memory");
  }
  if (hi == 0 && dst >= 0) { ml[2 * (size_t)mli] = m_reg; ml[2 * (size_t)mli + 1] = l_reg; }
#undef RESC
#undef KT
#undef VT
}

#define KSWZ64(row, colB) ((row) * 128 + ((colB) ^ ((((row) >> 1) & 7) << 4)))
constexpr size_t DA_SHM_K = 64 * 64 * 2;
constexpr size_t DA_SHM = 2 * SHM_V + 2 * DA_SHM_K + NW * 64 * 4;
__device__ __forceinline__ void qkt64(f32x16& p0, f32x16& p1, const bf16* Ks, const bf16x8* qr, int r32, int hi) {
  p0 = f32x16{}; p1 = f32x16{};
#pragma unroll
  for (int d0 = 0; d0 < 4; ++d0) { int cb = (d0 * 16 + hi * 8) * 2;
    bf16x8 b0 = *reinterpret_cast<const bf16x8*>((const char*)Ks + KSWZ64(r32, cb));
    bf16x8 b1 = *reinterpret_cast<const bf16x8*>((const char*)Ks + KSWZ64(32 + r32, cb));
    p0 = __builtin_amdgcn_mfma_f32_32x32x16_bf16(b0, qr[d0], p0, 0, 0, 0);
    p1 = __builtin_amdgcn_mfma_f32_32x32x16_bf16(b1, qr[d0], p1, 0, 0, 0); }
}
__device__ __forceinline__ void dattn_unit(const bf16* Qb, const bf16* __restrict__ Kh, const bf16* __restrict__ Vh, bf16* Ob, const int NT, char* lds) {
  const int tid = threadIdx.x, wid = tid >> 6, lane = tid & 63, r32 = lane & 31, hi = lane >> 5;
  bf16* V_lds = (bf16*)lds; bf16* K_lds = (bf16*)(lds + 2 * SHM_V);
  float* ws = (float*)(lds + 2 * SHM_V + 2 * DA_SHM_K) + wid * 64; float* li_l = ws; float* al_l = ws + 32;
  float m_reg = -1e30f, l_reg = 0; f32x16 o[4] = {}; bf16x8 qr[4];
  const bf16* Qw = Qb + (long)(wid * QBLK + r32) * LDK + hi * 8;
#pragma unroll
  for (int d0 = 0; d0 < 4; ++d0) qr[d0] = *reinterpret_cast<const bf16x8*>(Qw + d0 * 16);
  const int sr = tid >> 4, sc = (tid & 15) * 8, vst0 = v_st(sr, sc), vst1 = v_st(32 + sr, sc);
  const int kr = tid >> 3, kc = (tid & 7) * 8, kst = KSWZ64(kr, kc * 2);
  const int vb0 = (int)(uintptr_t)V_lds + v_rd_base(lane);
  const int ql = wid * QBLK + r32;
  struct { bf16x8 vs0, vs1, ks; } sr_[2];
#define SLOAD(i, k0) do { sr_[i].vs0 = *reinterpret_cast<const bf16x8*>(&Vh[(long)((k0) + sr) * LDK + sc]); sr_[i].vs1 = *reinterpret_cast<const bf16x8*>(&Vh[(long)((k0) + 32 + sr) * LDK + sc]); \
    sr_[i].ks = *reinterpret_cast<const bf16x8*>(&Kh[(long)((k0) + kr) * LDK + kc]); } while (0)
#define SWRITE(b, i) do { *(bf16x8*)((char*)V_lds + (b) * SHM_V + vst0) = sr_[i].vs0; *(bf16x8*)((char*)V_lds + (b) * SHM_V + vst1) = sr_[i].vs1; \
    *(bf16x8*)((char*)K_lds + (b) * DA_SHM_K + kst) = sr_[i].ks; } while (0)
#define SWAIT() asm volatile("s_waitcnt vmcnt(3)" ::: "memory")
#define RESC(a) do { if (__any((a) < 1.f)) { if (hi == 0) al_l[r32] = (a); asm volatile("s_waitcnt lgkmcnt(0)" ::: "memory"); \
    _Pragma("unroll") for (int d = 0; d < 4; ++d) _Pragma("unroll") for (int r = 0; r < 16; ++r) o[d][r] *= al_l[crow(r, hi)]; } } while (0)
#define MASK(P0, P1, t) do { if ((t) >= NT - 4) cmask(P0, P1, (t) - (NT - 4), ql, hi); } while (0)
  f32x16 pA0, pA1, pB0, pB1; float mnA, mnB, alA, alB; bf16x8 pa0, pa1, pa2, pa3;
  constexpr int SE = 0, SO = 1;
  SLOAD(SE, 0); asm volatile("s_waitcnt vmcnt(0)" ::: "memory"); SWRITE(0, SE); __syncthreads();
  qkt64(pA0, pA1, K_lds, qr, r32, hi); MASK(pA0, pA1, 0); partialSM(pA0, pA1, m_reg, mnA, alA);
  SLOAD(SO, KVBLK); SLOAD(SE, 2 * KVBLK);
  SWAIT(); SWRITE(1, SO); __syncthreads();
  for (int j = 1; j + 1 < NT; j += 2) {
    SBAR(); qkt64(pB0, pB1, (bf16*)((char*)K_lds + DA_SHM_K), qr, r32, hi);
    finishSM(pA0, pA1, alA, l_reg, pa0, pa1, pa2, pa3); SBAR();
    SLOAD(SO, (j + 2) * KVBLK); SBAR();
    pv_d0(o, vb0, pa0, pa1, pa2, pa3); MASK(pB0, pB1, j); partialSM(pB0, pB1, m_reg, mnB, alB);
    __syncthreads(); SWAIT(); SWRITE(0, SE);
    RESC(alB); __syncthreads();
    SBAR(); qkt64(pA0, pA1, K_lds, qr, r32, hi);
    finishSM(pB0, pB1, alB, l_reg, pa0, pa1, pa2, pa3); SBAR();
    if (j + 3 < NT) SLOAD(SE, (j + 3) * KVBLK); SBAR();
    pv_d0(o, vb0 + (int)SHM_V, pa0, pa1, pa2, pa3); MASK(pA0, pA1, j + 1); partialSM(pA0, pA1, m_reg, mnA, alA);
    __syncthreads(); SWAIT(); SWRITE(1, SO);
    RESC(alA); __syncthreads();
  }
  SBAR(); qkt64(pB0, pB1, (bf16*)((char*)K_lds + DA_SHM_K), qr, r32, hi);
  finishSM(pA0, pA1, alA, l_reg, pa0, pa1, pa2, pa3); SBAR();
  pv_d0(o, vb0, pa0, pa1, pa2, pa3); MASK(pB0, pB1, NT - 1); partialSM(pB0, pB1, m_reg, mnB, alB);
  __syncthreads(); RESC(alB);
  finishSM(pB0, pB1, alB, l_reg, pa0, pa1, pa2, pa3); SBAR();
  pv_d0(o, vb0 + (int)SHM_V, pa0, pa1, pa2, pa3);
  if (hi == 0) li_l[r32] = l_reg; asm volatile("s_waitcnt lgkmcnt(0)" ::: "memory");
  float rli[16];
#pragma unroll
  for (int r = 0; r < 16; ++r) rli[r] = __builtin_amdgcn_rcpf(li_l[crow(r, hi)]);
  __syncthreads();
  bf16* stg = (bf16*)lds + wid * 4096;
#pragma unroll
  for (int r = 0; r < 16; ++r) { const int orow = crow(r, hi);
#pragma unroll
    for (int d0 = 0; d0 < 4; ++d0) stg[orow * 128 + d0 * 32 + r32] = __float2bfloat16(o[d0][r] * rli[r]); }
  asm volatile("s_waitcnt lgkmcnt(0)" ::: "memory");
#pragma unroll
  for (int i = 0; i < 8; ++i) { const int row = i * 4 + (lane >> 4), ch = lane & 15; const u32x4 v = *(const u32x4*)(stg + row * 128 + ch * 8);
    *(u32x4*)(Ob + (size_t)(wid * QBLK + row) * 2048 + ch * 8) = v; }
  asm volatile("s_waitcnt lgkmcnt(0)" ::: "memory");
  __syncthreads();
#undef SLOAD
#undef SWRITE
#undef SWAIT
#undef RESC
#undef MASK
}

__device__ __forceinline__ void glds16(const void* gsrc, unsigned lds_dst) { unsigned keep;
  asm volatile("s_mov_b32 %0, m0\n\ts_mov_b32 m0, %2\n\ts_nop 0\n\tglobal_load_lds_dwordx4 %1, off\n\ts_mov_b32 m0, %0" : "=&s"(keep) : "v"(gsrc), "s"(lds_dst) : "memory"); }
#define WAIT_BAR(N) asm volatile("s_waitcnt vmcnt(" #N ") lgkmcnt(0)\n\ts_barrier" ::: "memory")
constexpr int DA2_STG = 24576;
constexpr size_t DA2_SHM = 3 * DA2_STG + NW * 64 * 4;
__device__ __forceinline__ void qkt64m(f32x16& p0, f32x16& p1, const bf16* Ks, const bf16x8* qr, bf16x8 qm, bf16x8 kneg, int r32, int hi) {
  __builtin_amdgcn_s_setprio(1);
  p0 = __builtin_amdgcn_mfma_f32_32x32x16_bf16(kneg, qm, f32x16{}, 0, 0, 0); p1 = p0;
#pragma unroll
  for (int d0 = 0; d0 < 4; ++d0) { int cb = (d0 * 16 + hi * 8) * 2;
    bf16x8 b0 = *reinterpret_cast<const bf16x8*>((const char*)Ks + KSWZ64(r32, cb));
    bf16x8 b1 = *reinterpret_cast<const bf16x8*>((const char*)Ks + KSWZ64(32 + r32, cb));
    p0 = __builtin_amdgcn_mfma_f32_32x32x16_bf16(b0, qr[d0], p0, 0, 0, 0);
    p1 = __builtin_amdgcn_mfma_f32_32x32x16_bf16(b1, qr[d0], p1, 0, 0, 0); }
  __builtin_amdgcn_s_setprio(0);
}
__device__ __forceinline__ void partialSM2(f32x16& p0, f32x16& p1, float& m_ref, bf16x8& qm, float& alpha, const bool first, const int hi) {
  float pmax = p0[0];
#pragma unroll
  for (int r = 1; r < 16; ++r) pmax = fmaxf(pmax, p0[r]);
#pragma unroll
  for (int r = 0; r < 16; ++r) pmax = fmaxf(pmax, p1[r]);
  { auto rr = __builtin_amdgcn_permlane32_swap(__float_as_uint(pmax), __float_as_uint(pmax), false, false);
    pmax = fmaxf(__uint_as_float(rr[0]), __uint_as_float(rr[1])); }
  alpha = 1.f;
  if (__builtin_expect(first || __any(pmax > THR), 0)) {
    const bool upd = first || (pmax > THR);
    const float mn = m_ref + pmax; const unsigned b = __float_as_uint(mn);
    const float mup = __uint_as_float(mn >= 0.f ? ((b + 0xFFFFu) & 0xFFFF0000u) : (b & 0xFFFF0000u));
    const float mnew = upd ? mup : m_ref; const float delta = mnew - m_ref;
    m_ref = mnew; alpha = __builtin_amdgcn_exp2f(-delta);
#pragma unroll
    for (int r = 0; r < 16; ++r) { p0[r] -= delta; p1[r] -= delta; }
    qm[0] = (hi == 0) ? (short)(__float_as_uint(m_ref) >> 16) : (short)0;
  }
#pragma unroll
  for (int r = 0; r < 16; ++r) p0[r] = __builtin_amdgcn_exp2f(p0[r]);
}
__device__ __forceinline__ void dattn_unit2(const bf16* Qb, const bf16* __restrict__ Kh, const bf16* __restrict__ Vh, bf16* Ob, const int NT, char* lds) {
  int tid = threadIdx.x; asm volatile("" : "+v"(tid)); const int lane = tid & 63, r32 = lane & 31, hi = lane >> 5; const int wid = __builtin_amdgcn_readfirstlane(tid >> 6);
  const unsigned lds0 = (unsigned)(uintptr_t)lds;
  float* ws = (float*)(lds + 3 * DA2_STG) + wid * 64; float* li_l = ws; float* al_l = ws + 32;
  const int krow = 8 * wid + (lane >> 3), kch = (lane & 7) ^ ((krow >> 1) & 7);
  const bf16* ksrc = Kh + (long)krow * LDK + kch * 8;
  const bf16* vsrc[2];
#pragma unroll
  for (int i = 0; i < 2; ++i) { const int off = (i * 8 + wid) * 1024 + lane * 16, sub = off >> 9, within = (off & 511) >> 1;
    const int kk = (sub >> 2) * 8 + (within >> 5), c = (sub & 3) * 32 + (within & 31), k = (kk & ~0xC) | ((kk & 4) << 1) | ((kk & 8) >> 1);
    vsrc[i] = Vh + (long)k * LDK + c; }
  const unsigned kdst = lds0 + wid * 1024, vdst = lds0 + 8192 + wid * 1024;
#define DMA(t, st) do { const long go_ = (long)(t) * KVBLK * LDK; glds16(ksrc + go_, (unsigned)__builtin_amdgcn_readfirstlane(kdst + (st))); \
    glds16(vsrc[0] + go_, (unsigned)__builtin_amdgcn_readfirstlane(vdst + (st))); glds16(vsrc[1] + go_, (unsigned)__builtin_amdgcn_readfirstlane(vdst + 8192 + (st))); } while (0)
  DMA(0, 0);
  float m_ref = 0.f, l_reg = 0.f; f32x16 o[4] = {}; bf16x8 qr[4]; bf16x8 qm = {0, 0, 0, 0, 0, 0, 0, 0};
  const bf16x8 kneg = {(short)(hi == 0 ? (short)0xBF80 : (short)0), 0, 0, 0, 0, 0, 0, 0};
  const bf16* Qw = Qb + (long)(wid * QBLK + r32) * LDK + hi * 8;
#pragma unroll
  for (int d0 = 0; d0 < 4; ++d0) qr[d0] = *reinterpret_cast<const bf16x8*>(Qw + d0 * 16);
  const int ql = wid * QBLK + r32;
#define RESC(a) do { if (__any((a) < 1.f)) { if (hi == 0) al_l[r32] = (a); asm volatile("s_waitcnt lgkmcnt(0)" ::: "memory"); \
    _Pragma("unroll") for (int d = 0; d < 4; ++d) _Pragma("unroll") for (int r = 0; r < 16; ++r) o[d][r] *= al_l[crow(r, hi)]; } } while (0)
#define MASK(P0, P1, t) do { if ((t) >= NT - 4) cmask(P0, P1, (t) - (NT - 4), ql, hi); } while (0)
#define KST(sx) ((const bf16*)(lds + (sx)))
#define VST(sx) ((int)(lds0 + 8192 + (sx)) + v_rd_base(lane))
  f32x16 pA0, pA1, pB0, pB1; float alA, alB; bf16x8 pa0, pa1, pa2, pa3;
  int s0 = 0, s1 = DA2_STG, s2 = 2 * DA2_STG;
  WAIT_BAR(0);
  DMA(1, DA2_STG);
  qkt64m(pA0, pA1, KST(0), qr, qm, kneg, r32, hi); MASK(pA0, pA1, 0); partialSM2(pA0, pA1, m_ref, qm, alA, true, hi);
  WAIT_BAR(2);
  DMA(2, 2 * DA2_STG);
  for (int j = 1; j + 1 < NT; j += 2) {
    SBAR(); qkt64m(pB0, pB1, KST(s1), qr, qm, kneg, r32, hi);
    finishSM(pA0, pA1, alA, l_reg, pa0, pa1, pa2, pa3); SBAR();
    pv_d0(o, VST(s0), pa0, pa1, pa2, pa3); MASK(pB0, pB1, j); partialSM2(pB0, pB1, m_ref, qm, alB, false, hi);
    WAIT_BAR(2);
    if (j + 2 < NT) DMA(j + 2, s0);
    RESC(alB);
    SBAR(); qkt64m(pA0, pA1, KST(s2), qr, qm, kneg, r32, hi);
    finishSM(pB0, pB1, alB, l_reg, pa0, pa1, pa2, pa3); SBAR();
    pv_d0(o, VST(s1), pa0, pa1, pa2, pa3); MASK(pA0, pA1, j + 1); partialSM2(pA0, pA1, m_ref, qm, alA, false, hi);
    WAIT_BAR(2);
    if (j + 3 < NT) DMA(j + 3, s1);
    RESC(alA);
    { const int t_ = s0; s0 = s2; s2 = s1; s1 = t_; }
  }
  SBAR(); qkt64m(pB0, pB1, KST(s1), qr, qm, kneg, r32, hi);
  finishSM(pA0, pA1, alA, l_reg, pa0, pa1, pa2, pa3); SBAR();
  pv_d0(o, VST(s0), pa0, pa1, pa2, pa3); MASK(pB0, pB1, NT - 1); partialSM2(pB0, pB1, m_ref, qm, alB, false, hi);
  WAIT_BAR(0);
  RESC(alB);
  finishSM(pB0, pB1, alB, l_reg, pa0, pa1, pa2, pa3); SBAR();
  pv_d0(o, VST(s1), pa0, pa1, pa2, pa3);
  if (hi == 0) li_l[r32] = l_reg; asm volatile("s_waitcnt lgkmcnt(0)" ::: "memory");
  float rli[16];
#pragma unroll
  for (int r = 0; r < 16; ++r) rli[r] = __builtin_amdgcn_rcpf(li_l[crow(r, hi)]);
  WAIT_BAR(0);
  bf16* stg = (bf16*)lds + wid * 4096;
#pragma unroll
  for (int r = 0; r < 16; ++r) { const int orow = crow(r, hi);
#pragma unroll
    for (int d0 = 0; d0 < 4; ++d0) stg[orow * 128 + d0 * 32 + r32] = __float2bfloat16(o[d0][r] * rli[r]); }
  asm volatile("s_waitcnt lgkmcnt(0)" ::: "memory");
#pragma unroll
  for (int i = 0; i < 8; ++i) { const int row = i * 4 + (lane >> 4), ch = lane & 15; const u32x4 v = *(const u32x4*)(stg + row * 128 + ch * 8);
    *(u32x4*)(Ob + (size_t)(wid * QBLK + row) * 2048 + ch * 8) = v; }
  asm volatile("s_waitcnt lgkmcnt(0)\n\ts_barrier" ::: "memory");
#undef DMA
#undef RESC
#undef MASK
#undef KST
#undef VST
}
__device__ __forceinline__ void qkt64p(f32x16& p0, f32x16& p1, const bf16* Ks, const bf16x8* qr, int r32, int hi) {
  bf16x8 kf[8];
#pragma unroll
  for (int d0 = 0; d0 < 4; ++d0) { int cb = (d0 * 16 + hi * 8) * 2;
    kf[2 * d0] = *reinterpret_cast<const bf16x8*>((const char*)Ks + KSWZ64(r32, cb)); kf[2 * d0 + 1] = *reinterpret_cast<const bf16x8*>((const char*)Ks + KSWZ64(32 + r32, cb)); }
  p0 = f32x16{}; p1 = f32x16{};
  __builtin_amdgcn_s_setprio(1);
#pragma unroll
  for (int d0 = 0; d0 < 4; ++d0) { p0 = __builtin_amdgcn_mfma_f32_32x32x16_bf16(kf[2 * d0], qr[d0], p0, 0, 0, 0); p1 = __builtin_amdgcn_mfma_f32_32x32x16_bf16(kf[2 * d0 + 1], qr[d0], p1, 0, 0, 0); }
  __builtin_amdgcn_s_setprio(0);
}
__device__ __forceinline__ bool dattn_unit3(const bf16* Qb, const bf16* __restrict__ Kh, const bf16* __restrict__ Vh, bf16* Ob, const int NT, char* lds) {
  int tid = threadIdx.x; asm volatile("" : "+v"(tid)); const int lane = tid & 63, r32 = lane & 31, hi = lane >> 5; const int wid = __builtin_amdgcn_readfirstlane(tid >> 6);
  const unsigned lds0 = (unsigned)(uintptr_t)lds;
  float* ws = (float*)(lds + 3 * DA2_STG) + wid * 64; float* li_l = ws; float* al_l = ws + 32;
  const int krow = 8 * wid + (lane >> 3), kch = (lane & 7) ^ ((krow >> 1) & 7);
  const bf16* ksrc = Kh + (long)krow * LDK + kch * 8;
  const bf16* vsrc[2];
#pragma unroll
  for (int i = 0; i < 2; ++i) { const int off = (i * 8 + wid) * 1024 + lane * 16, sub = off >> 9, within = (off & 511) >> 1;
    const int kk = (sub >> 2) * 8 + (within >> 5), c = (sub & 3) * 32 + (within & 31), k = (kk & ~0xC) | ((kk & 4) << 1) | ((kk & 8) >> 1);
    vsrc[i] = Vh + (long)k * LDK + c; }
  const unsigned kdst = lds0 + wid * 1024, vdst = lds0 + 8192 + wid * 1024;
#define DMA(t, st) do { const long go_ = (long)(t) * KVBLK * LDK; glds16(ksrc + go_, (unsigned)__builtin_amdgcn_readfirstlane(kdst + (st))); \
    glds16(vsrc[0] + go_, (unsigned)__builtin_amdgcn_readfirstlane(vdst + (st))); glds16(vsrc[1] + go_, (unsigned)__builtin_amdgcn_readfirstlane(vdst + 8192 + (st))); } while (0)
  DMA(0, 0);
  float l_reg = 0.f; f32x16 o[4] = {}; bf16x8 qr[4];
  const bf16* Qw = Qb + (long)(wid * QBLK + r32) * LDK + hi * 8;
#pragma unroll
  for (int d0 = 0; d0 < 4; ++d0) qr[d0] = *reinterpret_cast<const bf16x8*>(Qw + d0 * 16);
  const int ql = wid * QBLK + r32;
#define RESC(a) do { } while (0)
#define EXP0(P0) do { _Pragma("unroll") for (int r = 0; r < 16; ++r) P0[r] = __builtin_amdgcn_exp2f(P0[r]); } while (0)
#define MASK(P0, P1, t) do { if ((t) >= NT - 4) cmask(P0, P1, (t) - (NT - 4), ql, hi); } while (0)
#define KST(sx) ((const bf16*)(lds + (sx)))
#define VST(sx) ((int)(lds0 + 8192 + (sx)) + v_rd_base(lane))
  f32x16 pA0, pA1, pB0, pB1; const float alA = 1.f, alB = 1.f; bf16x8 pa0, pa1, pa2, pa3;
  int s0 = 0, s1 = DA2_STG, s2 = 2 * DA2_STG;
  WAIT_BAR(0);
  DMA(1, DA2_STG);
  qkt64p(pA0, pA1, KST(0), qr, r32, hi); MASK(pA0, pA1, 0); EXP0(pA0);
  WAIT_BAR(2);
  DMA(2, 2 * DA2_STG);
  for (int j = 1; j + 1 < NT; j += 2) {
    SBAR(); qkt64p(pB0, pB1, KST(s1), qr, r32, hi);
    finishSM(pA0, pA1, alA, l_reg, pa0, pa1, pa2, pa3); SBAR();
    pv_d0p(o, VST(s0), pa0, pa1, pa2, pa3); MASK(pB0, pB1, j); EXP0(pB0);
    WAIT_BAR(2);
    if (j + 2 < NT) DMA(j + 2, s0);
    RESC(alB);
    SBAR(); qkt64p(pA0, pA1, KST(s2), qr, r32, hi);
    finishSM(pB0, pB1, alB, l_reg, pa0, pa1, pa2, pa3); SBAR();
    pv_d0p(o, VST(s1), pa0, pa1, pa2, pa3); MASK(pA0, pA1, j + 1); EXP0(pA0);
    WAIT_BAR(2);
    if (j + 3 < NT) DMA(j + 3, s1);
    RESC(alA);
    { const int t_ = s0; s0 = s2; s2 = s1; s1 = t_; }
  }
  SBAR(); qkt64p(pB0, pB1, KST(s1), qr, r32, hi);
  finishSM(pA0, pA1, alA, l_reg, pa0, pa1, pa2, pa3); SBAR();
  pv_d0p(o, VST(s0), pa0, pa1, pa2, pa3); MASK(pB0, pB1, NT - 1); EXP0(pB0);
  WAIT_BAR(0);
  RESC(alB);
  finishSM(pB0, pB1, alB, l_reg, pa0, pa1, pa2, pa3); SBAR();
  pv_d0p(o, VST(s1), pa0, pa1, pa2, pa3);
  const bool bad = __any(!(l_reg > 1e-30f && l_reg < 1e30f));
  if (hi == 0) li_l[r32] = l_reg; asm volatile("s_waitcnt lgkmcnt(0)" ::: "memory");
  float rli[16];
#pragma unroll
  for (int r = 0; r < 16; ++r) rli[r] = __builtin_amdgcn_rcpf(li_l[crow(r, hi)]);
  WAIT_BAR(0);
  bf16* stg = (bf16*)lds + wid * 4096;
#pragma unroll
  for (int r = 0; r < 16; ++r) { const int orow = crow(r, hi);
#pragma unroll
    for (int d0 = 0; d0 < 4; ++d0) stg[orow * 128 + d0 * 32 + r32] = __float2bfloat16(o[d0][r] * rli[r]); }
  asm volatile("s_waitcnt lgkmcnt(0)" ::: "memory");
#pragma unroll
  for (int i = 0; i < 8; ++i) { const int row = i * 4 + (lane >> 4), ch = lane & 15; const u32x4 v = *(const u32x4*)(stg + row * 128 + ch * 8);
    *(u32x4*)(Ob + (size_t)(wid * QBLK + row) * 2048 + ch * 8) = v; }
  asm volatile("s_waitcnt lgkmcnt(0)\n\ts_barrier" ::: "memory");
#undef DMA
#undef RESC
#undef EXP0
#undef MASK
#undef KST
#undef VST
  return bad;
}
#undef WAIT_BAR
struct DaUnit { int bqh; int qb; };
struct DaOrder {
  int vcu, G;
  __device__ __forceinline__ DaOrder(int vcu_, int G_) : vcu(vcu_), G(G_) {}
  __device__ __forceinline__ bool next(int i, DaUnit& u) const {
    if (G == 256) { if (i >= 8) return false; const int s = vcu & 7, ii = i & 3; u.bqh = (i >> 2) * 32 + (vcu >> 3); u.qb = (ii == 0) ? s : (ii == 1) ? 15 - s : (ii == 2) ? 16 + s : 31 - s; return true; }
    const int uu = vcu + i * G; if (uu >= 2048) return false; u.bqh = uu >> 5; u.qb = uu & 31; return true; }
};
template <class Sched> __device__ __forceinline__ void dattn_phase(char* lds, const bf16* QKV, bf16* O, const Sched& S) {
  DaUnit u; unsigned fail = 0u;
  for (int i = 0; S.next(i, u); ++i) { const int b = u.bqh >> 4, qh = u.bqh & 15; const size_t rb = (size_t)b * 8192;
    const bool bad = dattn_unit3(QKV + (rb + u.qb * 256) * LDK + qh * 64, QKV + rb * LDK + 1024 + qh * 64, QKV + rb * LDK + 2048 + (qh >> 1) * 128, O + (rb + u.qb * 256) * 2048 + qh * 128, 4 * (u.qb + 1), lds);
    if (bad) fail |= 1u << (i & 31); }
  unsigned* fl = (unsigned*)(lds + 3 * DA2_STG) + (threadIdx.x >> 6);
  if ((threadIdx.x & 63) == 0) *fl = fail;
  __syncthreads();
  unsigned all = 0u;
#pragma unroll
  for (int w = 0; w < NW; ++w) all |= ((unsigned*)(lds + 3 * DA2_STG))[w];
  all = (unsigned)__builtin_amdgcn_readfirstlane((int)all);
  __syncthreads();
  if (all) for (int i = 0; S.next(i, u); ++i) if ((all >> (i & 31)) & 1u) { const int b = u.bqh >> 4, qh = u.bqh & 15; const size_t rb = (size_t)b * 8192;
    dattn_unit2(QKV + (rb + u.qb * 256) * LDK + qh * 64, QKV + rb * LDK + 1024 + qh * 64, QKV + rb * LDK + 2048 + (qh >> 1) * 128, O + (rb + u.qb * 256) * 2048 + qh * 128, 4 * (u.qb + 1), lds); }
}
#undef KSWZ64
#undef KSWZ
#undef SBAR
}
#define GAS __attribute__((address_space(1)))
#define LAS __attribute__((address_space(3)))
typedef unsigned short bf16;
typedef unsigned v4u __attribute__((ext_vector_type(4)));
typedef float f32x4 __attribute__((ext_vector_type(4)));
typedef short bf16x8 __attribute__((ext_vector_type(8)));
typedef GAS unsigned gu32;
typedef GAS unsigned long long gu64;
#define RLX_AGENT __ATOMIC_RELAXED, __HIP_MEMORY_SCOPE_AGENT
#define LDS_WAIT() asm volatile("s_waitcnt lgkmcnt(0)" ::: "memory")
#define VM_WAIT() asm volatile("s_waitcnt vmcnt(0)" ::: "memory")
__device__ __forceinline__ unsigned long long rt() { return __builtin_amdgcn_s_memrealtime(); }
__device__ __forceinline__ unsigned f2bf(float f) { unsigned u = __builtin_bit_cast(unsigned, f); return (u + 0x7fffu + ((u >> 16) & 1u)) >> 16; }
__device__ __forceinline__ unsigned pk2(float lo, float hi) { return f2bf(lo) | (f2bf(hi) << 16); }
#define XB_TMO      128
#define XB_XCNT(j)  (256  + 64 * (j))
#define XB_XSUB(j)  (1280 + 64 * (j))
#define XB_XGEN(j)  (2304 + 64 * (j))
#define XB_TOP      3328
#define XB_TOPGEN   3392
#define XCD_BAR_WORDS 3456
#define XB_SPIN_CAP (1u << 18)

__device__ __forceinline__ unsigned xb_ld(unsigned* p)              { return __hip_atomic_load(p, __ATOMIC_RELAXED, __HIP_MEMORY_SCOPE_AGENT); }
__device__ __forceinline__ unsigned xb_add(unsigned* p, unsigned v) { return __hip_atomic_fetch_add(p, v, __ATOMIC_RELAXED, __HIP_MEMORY_SCOPE_AGENT); }
__device__ __forceinline__ unsigned xb_xcc_id() { return (unsigned)__builtin_amdgcn_s_getreg((3 << 11) | 20) & 0xFu; }
#define XB_SPIN(cond, bar) do { unsigned _sp = 0; while (cond) { __builtin_amdgcn_s_sleep(1); \
    if ((++_sp & 255u) == 0u) { if (xb_ld(&(bar)[XB_TMO])) break; if (_sp > XB_SPIN_CAP) { atomicAdd(&(bar)[XB_TMO], 1u); break; } } } } while (0)

struct XcdBarrier {
    unsigned* bar; unsigned x;
    volatile LAS unsigned* st;
};

__device__ __forceinline__ XcdBarrier xcd_barrier_post(unsigned* bar, volatile LAS unsigned* st) {
    XcdBarrier b; b.bar = bar; b.x = xb_xcc_id(); b.st = st;
    if (threadIdx.x == 0) (void)xb_add(&bar[XB_XCNT(b.x)], 1u);
    return b;
}
__device__ __forceinline__ void xcd_barrier_complete(unsigned* bar, unsigned x, unsigned& nloc, unsigned& nx) {
    const unsigned G = gridDim.x * gridDim.y * gridDim.z;
    unsigned sum, cnt, mine, sp = 0u;
    for (;;) {
        sum = 0u; cnt = 0u; mine = 0u;
#pragma unroll
        for (unsigned j = 0; j < 16; ++j) { const unsigned c = xb_ld(&bar[XB_XCNT(j)]); sum += c; cnt += (c > 0u) ? 1u : 0u; mine = (j == x) ? c : mine; }
        if (sum == G) break;
        __builtin_amdgcn_s_sleep(1);
        if ((++sp & 255u) == 0u) { if (xb_ld(&bar[XB_TMO])) break; if (sp > XB_SPIN_CAP) { atomicAdd(&bar[XB_TMO], 1u); break; } }
    }
    nloc = mine > 0u ? mine : 1u; nx = cnt > 0u ? cnt : 1u;
}

__device__ __forceinline__ void xcd_barrier(const XcdBarrier& b) {
    asm volatile("s_waitcnt vmcnt(0)" ::: "memory");
    __syncthreads();
    if (threadIdx.x == 0) {
        unsigned* bar = b.bar;
        __builtin_amdgcn_s_waitcnt(0);
        unsigned nloc = b.st[0], nx = b.st[1];
        if (nloc == 0u) { xcd_barrier_complete(bar, b.x, nloc, nx); b.st[0] = nloc; b.st[1] = nx; }
        const unsigned old = xb_add(&bar[XB_XSUB(b.x)], 1u);
        const unsigned gen = old / nloc;
        if (old + 1u == (gen + 1u) * nloc) {
            __builtin_amdgcn_fence(__ATOMIC_RELEASE, "agent");
            asm volatile("s_waitcnt vmcnt(0)" ::: "memory");
            const unsigned og = xb_add(&bar[XB_TOP], 1u);
            const unsigned tg = og / nx;
            if (og + 1u == (tg + 1u) * nx) xb_add(&bar[XB_TOPGEN], 1u);
            else XB_SPIN(xb_ld(&bar[XB_TOPGEN]) == tg, bar);
            __builtin_amdgcn_fence(__ATOMIC_ACQUIRE, "agent");
            xb_add(&bar[XB_XGEN(b.x)], 1u);
            asm volatile("s_waitcnt vmcnt(0)" ::: "memory");
        } else {
            XB_SPIN(xb_ld(&bar[XB_XGEN(b.x)]) == gen, bar);
            __builtin_amdgcn_fence(__ATOMIC_ACQUIRE, "agent");
            asm volatile("s_waitcnt vmcnt(0)" ::: "memory");
        }
    }
    __syncthreads();
}

constexpr int NWAVES = 8;
#ifndef GEMM_ALIGN
#define GEMM_ALIGN true
#endif
#ifndef MK_PER_PHASE
#define MK_PER_PHASE 0
#endif
constexpr int BATCH = 4, SEQ = 8192, DM = 1024, TOK = BATCH * SEQ;
constexpr int FF0 = 2816, NEXP = 8, FF1 = 3584;
constexpr int NQKV = 3072;
constexpr int MB_H = 8, MB_NB = 32, MB_L = 256;
constexpr int SLOTS = TOK + NEXP * 256;
constexpr float NORM_EPS = 1e-6f, SUBLN_EPS = 1e-5f;
constexpr float LAMBDA_INIT0 = 0.2f;
constexpr float LOG2E = 1.4426950408889634f;
constexpr int LIST_PER_BH = 256 * 496;
__host__ __device__ constexpr int list_off(int j) { return 256 * (31 * j - (j * (j - 1)) / 2); }

constexpr size_t MiB = 1u << 20;
constexpr size_t WS_CTL = 0, CTL_ZERO_BYTES = 3 * MiB;
constexpr size_t WS_CMAX13 = 2 * MiB;
constexpr size_t WS_CMAX2 = WS_CMAX13 + 256 * 1024;
constexpr size_t WS_SSTOT = WS_CMAX2 + 64 * 1024;
constexpr size_t WS_CM0 = WS_CMAX2 + 128 * 1024;
constexpr size_t WS_ROPE64 = 3 * MiB;
constexpr size_t WS_ROPE128 = WS_ROPE64 + 512 * 1024;
constexpr size_t WS_KMEAN = 2 * MiB + 512 * 1024;
constexpr size_t WS_TOK = 5 * MiB;
constexpr size_t WS_SLOT = 6 * MiB;
constexpr size_t WS_SA = 7 * MiB;
constexpr size_t WS_OWNML = 41 * MiB;
constexpr size_t WS_W0QKV = 8 * MiB, WS_W0O = 14 * MiB, WS_W013 = 16 * MiB, WS_W02 = 27 * MiB, WS_W1QKV = 33 * MiB, WS_W1O = 39 * MiB;
constexpr size_t B0 = 43 * MiB;
constexpr size_t WS_H = B0;
constexpr size_t WS_QKV = B0 + 64 * MiB;
constexpr size_t WS_OATT = B0 + 256 * MiB;
constexpr size_t WS_UD = B0 + 128 * MiB;
constexpr size_t WS_LIST = B0 + 256 * MiB;
constexpr size_t WS_PML = B0 + 272 * MiB;
constexpr size_t WS_PO = B0 + 280 * MiB;
constexpr size_t WS_WM13 = B0 + 64 * MiB;
constexpr size_t WS_WM2 = WS_WM13 + 56 * MiB;
constexpr size_t WS_AQ = WS_WM2 + 28 * MiB;
constexpr size_t WS_UM = B0 + 232 * MiB;
constexpr size_t WS_END = WS_PO + (size_t)TOK * MB_H * 3 * 128 * 2;
static_assert(WS_UM + (size_t)2 * SLOTS * FF1 <= WS_END && WS_AQ + (size_t)TOK * DM <= WS_UM && WS_END <= 528 * MiB, "d_ws map");
constexpr int CW_TMO = 0, CW_CODE = 1, CW_DBG = 2, CW_Q = 8;
constexpr int CW_MOECNT = 64;
constexpr int CW_MOBACNT = 256;
constexpr int CW_BAR = 4096;
constexpr size_t WS_RSS = 1 * MiB;
constexpr int RING_OFF = 0, RING_BYTES = 131072;
constexpr int LDSCTL_OFF = RING_BYTES, MISC_OFF = LDSCTL_OFF + 320;
constexpr int LDS_BYTES = 163840;

struct Args { const float* in[20]; float* out; unsigned char* ws; float inv64[8]; float inv128[16]; int ph_lo, ph_hi; };

__device__ __forceinline__ float wave_sum(float v) {
#pragma unroll
    for (int o = 1; o < 64; o <<= 1) v += __shfl_xor(v, o);
    return v;
}
template <int MAP> __device__ __forceinline__ int maprow(int n) {
    if (MAP == 1) { if (n >= 2048) return n; const int d = n & 63; if (d >= 16) return n; const int b = d >> 3, a = (d >> 2) & 1, c = d & 3; return (n & ~63) + 8 * a + 4 * b + c; }
    if (MAP == 2) { if (n >= 2048) return n; const int d = n & 127; if (d >= 32) return n; const int b = d >> 4, a = (d >> 2) & 3, c = d & 3; return (n & ~127) + 8 * a + 4 * b + c; }
    if (MAP == 3) return 256 * (n >> 7) + (n & 127);
    if (MAP == 4) return 256 * (n >> 7) + 128 + (n & 127);
    return n;
}
template <int MAP> __device__ __forceinline__ void transpose_item(const float* W, int K, int N, bf16* WT, LAS float* scr, int item, int lane, const float* gk = nullptr) {
    const int nblk = N / 32, kb = item / nblk, nb = item % nblk, k0 = 64 * kb, n0 = 32 * nb;
    const int kr = lane >> 3, nc = (lane & 7) * 4;
    f32x4 v[8];
#pragma unroll
    for (int i = 0; i < 8; ++i) v[i] = *(const GAS f32x4*)(W + (size_t)(k0 + i * 8 + kr) * N + n0 + nc);
    if (gk) {
#pragma unroll
        for (int i = 0; i < 8; ++i) v[i] = v[i] * gk[k0 + i * 8 + kr]; }
#pragma unroll
    for (int i = 0; i < 8; ++i) { LAS float* d = scr + (i * 8 + kr) * 33 + nc; d[0] = v[i].x; d[1] = v[i].y; d[2] = v[i].z; d[3] = v[i].w; }
    LDS_WAIT(); asm volatile("" ::: "memory");
    const int c = lane & 7;
#pragma unroll
    for (int j = 0; j < 4; ++j) { const int n = (lane >> 3) + 8 * j; const LAS float* s = scr + (8 * c) * 33 + n;
        v4u o; o.x = pk2(s[0 * 33], s[1 * 33]); o.y = pk2(s[2 * 33], s[3 * 33]); o.z = pk2(s[4 * 33], s[5 * 33]); o.w = pk2(s[6 * 33], s[7 * 33]);
        *(GAS v4u*)(WT + (size_t)maprow<MAP>(n0 + n) * K + k0 + 8 * c) = o; }
    LDS_WAIT(); asm volatile("" ::: "memory");
}

template <int MAP> __device__ __forceinline__ float wmax_strip(const float* W, int N, unsigned* cmax, int kb0, int nkb, int nb, int lane, const float* gk) {
    const int n0 = 32 * nb, kr = lane >> 3, nc = (lane & 7) * 4;
    f32x4 mx = (f32x4){0.f, 0.f, 0.f, 0.f}; float ss = 0.f;
    for (int kb = kb0; kb < kb0 + nkb; ++kb) { const int k0 = 64 * kb;
        f32x4 v[8];
#pragma unroll
        for (int i = 0; i < 8; ++i) v[i] = *(const GAS f32x4*)(W + (size_t)(k0 + i * 8 + kr) * N + n0 + nc);
        if (gk) {
#pragma unroll
            for (int i = 0; i < 8; ++i) v[i] = v[i] * gk[k0 + i * 8 + kr]; }
#pragma unroll
        for (int i = 0; i < 8; ++i) { mx.x = fmaxf(mx.x, fabsf(v[i].x)); mx.y = fmaxf(mx.y, fabsf(v[i].y)); mx.z = fmaxf(mx.z, fabsf(v[i].z)); mx.w = fmaxf(mx.w, fabsf(v[i].w));
            ss += (v[i].x * v[i].x + v[i].y * v[i].y) + (v[i].z * v[i].z + v[i].w * v[i].w); } }
#pragma unroll
    for (int o = 8; o < 64; o <<= 1) { mx.x = fmaxf(mx.x, __shfl_xor(mx.x, o)); mx.y = fmaxf(mx.y, __shfl_xor(mx.y, o)); mx.z = fmaxf(mx.z, __shfl_xor(mx.z, o)); mx.w = fmaxf(mx.w, __shfl_xor(mx.w, o)); }
    if (lane < 8) {
        __hip_atomic_fetch_max(cmax + maprow<MAP>(n0 + nc + 0), __float_as_uint(mx.x), __ATOMIC_RELAXED, __HIP_MEMORY_SCOPE_AGENT);
        __hip_atomic_fetch_max(cmax + maprow<MAP>(n0 + nc + 1), __float_as_uint(mx.y), __ATOMIC_RELAXED, __HIP_MEMORY_SCOPE_AGENT);
        __hip_atomic_fetch_max(cmax + maprow<MAP>(n0 + nc + 2), __float_as_uint(mx.z), __ATOMIC_RELAXED, __HIP_MEMORY_SCOPE_AGENT);
        __hip_atomic_fetch_max(cmax + maprow<MAP>(n0 + nc + 3), __float_as_uint(mx.w), __ATOMIC_RELAXED, __HIP_MEMORY_SCOPE_AGENT); }
    return ss;
}
template <int MAP> __device__ __forceinline__ void transpose_item_q(const float* W, int K, int N, signed char* WT, const unsigned* cmax, LAS float* scr, int item, int lane, const float* gk) {
    const int nblk = N / 32, kb = item / nblk, nb = item % nblk, k0 = 64 * kb, n0 = 32 * nb;
    const int kr = lane >> 3, nc = (lane & 7) * 4;
    f32x4 v[8];
#pragma unroll
    for (int i = 0; i < 8; ++i) v[i] = *(const GAS f32x4*)(W + (size_t)(k0 + i * 8 + kr) * N + n0 + nc);
    if (gk) {
#pragma unroll
        for (int i = 0; i < 8; ++i) v[i] = v[i] * gk[k0 + i * 8 + kr]; }
#pragma unroll
    for (int i = 0; i < 8; ++i) { LAS float* d = scr + (i * 8 + kr) * 33 + nc; d[0] = v[i].x; d[1] = v[i].y; d[2] = v[i].z; d[3] = v[i].w; }
    LDS_WAIT(); asm volatile("" ::: "memory");
    const int half = lane >> 5, n = lane & 31, row = maprow<MAP>(n0 + n);
    const float cm = __uint_as_float(cmax[row]); const float inv = cm > 0.f ? 127.0f / cm : 0.f;
    const LAS float* s = scr + (32 * half) * 33 + n;
    unsigned w[8];
#pragma unroll
    for (int q4 = 0; q4 < 8; ++q4) { unsigned pk = 0;
#pragma unroll
        for (int b = 0; b < 4; ++b) { const int q = (int)__builtin_rintf(s[(4 * q4 + b) * 33] * inv); pk |= (unsigned)(q & 255) << (8 * b); }
        w[q4] = pk; }
    GAS v4u* dst = (GAS v4u*)(WT + (size_t)row * K + k0 + 32 * half);
    dst[0] = (v4u){w[0], w[1], w[2], w[3]}; dst[1] = (v4u){w[4], w[5], w[6], w[7]};
    LDS_WAIT(); asm volatile("" ::: "memory");
}

template <int MAP> __device__ __forceinline__ void strip_quant(const float* W, int K, int N, signed char* WT, float cm, LAS float* scr, int kb0, int nkb, int nb, int lane, const float* gk) {
    const int n0 = 32 * nb, kr = lane >> 3, nc = (lane & 7) * 4;
    const int half = lane >> 5, n = lane & 31, row = maprow<MAP>(n0 + n);
    const float inv = cm > 0.f ? 127.0f / cm : 0.f;
    f32x4 vn[8];
#pragma unroll
    for (int i = 0; i < 8; ++i) vn[i] = *(const GAS f32x4*)(W + (size_t)(64 * kb0 + i * 8 + kr) * N + n0 + nc);
    for (int kb = kb0; kb < kb0 + nkb; ++kb) { const int k0 = 64 * kb;
        f32x4 v[8];
#pragma unroll
        for (int i = 0; i < 8; ++i) v[i] = vn[i];
        if (kb + 1 < kb0 + nkb) {
#pragma unroll
            for (int i = 0; i < 8; ++i) vn[i] = *(const GAS f32x4*)(W + (size_t)(k0 + 64 + i * 8 + kr) * N + n0 + nc); }
        if (gk) {
#pragma unroll
            for (int i = 0; i < 8; ++i) v[i] = v[i] * gk[k0 + i * 8 + kr]; }
#pragma unroll
        for (int i = 0; i < 8; ++i) { LAS float* d = scr + (i * 8 + kr) * 33 + nc; d[0] = v[i].x; d[1] = v[i].y; d[2] = v[i].z; d[3] = v[i].w; }
        LDS_WAIT(); asm volatile("" ::: "memory");
        const LAS float* s = scr + (32 * half) * 33 + n;
        unsigned w[8];
#pragma unroll
        for (int q4 = 0; q4 < 8; ++q4) { unsigned pk = 0;
#pragma unroll
            for (int b = 0; b < 4; ++b) { const int q = (int)__builtin_rintf(s[(4 * q4 + b) * 33] * inv); pk |= (unsigned)(q & 255) << (8 * b); }
            w[q4] = pk; }
        GAS v4u* dst = (GAS v4u*)(WT + (size_t)row * K + k0 + 32 * half);
        dst[0] = (v4u){w[0], w[1], w[2], w[3]}; dst[1] = (v4u){w[4], w[5], w[6], w[7]};
        LDS_WAIT(); asm volatile("" ::: "memory");
    }
}
__device__ __forceinline__ float wstrip_max(const float* W, int N, int kb0, int nkb, int nb, int lane, const float* gk, f32x4& mx) {
    const int n0 = 32 * nb, kr = lane >> 3, nc = (lane & 7) * 4; float ss = 0.f;
    for (int kb = kb0; kb < kb0 + nkb; kb += 2) {
        const int k0 = 64 * kb; const bool two = kb + 1 < kb0 + nkb; const int k1 = two ? k0 + 64 : k0;
        f32x4 v[16];
#pragma unroll
        for (int i = 0; i < 8; ++i) { v[i] = *(const GAS f32x4*)(W + (size_t)(k0 + i * 8 + kr) * N + n0 + nc); v[8 + i] = *(const GAS f32x4*)(W + (size_t)(k1 + i * 8 + kr) * N + n0 + nc); }
        if (gk) {
#pragma unroll
            for (int i = 0; i < 8; ++i) { v[i] = v[i] * gk[k0 + i * 8 + kr]; v[8 + i] = v[8 + i] * gk[k1 + i * 8 + kr]; } }
#pragma unroll
        for (int i = 0; i < 16; ++i) { mx.x = fmaxf(mx.x, fabsf(v[i].x)); mx.y = fmaxf(mx.y, fabsf(v[i].y)); mx.z = fmaxf(mx.z, fabsf(v[i].z)); mx.w = fmaxf(mx.w, fabsf(v[i].w));
            if (i < 8 || two) ss += (v[i].x * v[i].x + v[i].y * v[i].y) + (v[i].z * v[i].z + v[i].w * v[i].w); } }
#pragma unroll
    for (int o = 8; o < 64; o <<= 1) { mx.x = fmaxf(mx.x, __shfl_xor(mx.x, o)); mx.y = fmaxf(mx.y, __shfl_xor(mx.y, o)); mx.z = fmaxf(mx.z, __shfl_xor(mx.z, o)); mx.w = fmaxf(mx.w, __shfl_xor(mx.w, o)); }
    return ss;
}
__device__ __forceinline__ float strip_colmax(const f32x4& mx, int lane) {
    const int n = lane & 31, src = n >> 2; const float a = __shfl(mx.x, src), b = __shfl(mx.y, src), c = __shfl(mx.z, src), d = __shfl(mx.w, src);
    return (n & 3) == 0 ? a : (n & 3) == 1 ? b : (n & 3) == 2 ? c : d;
}
__device__ __forceinline__ void rms_row(const float* xrow, const f32x4 (&g)[4], f32x4 (&v)[4], int lane) {
    const GAS f32x4* xr = (const GAS f32x4*)xrow + lane; float s = 0.f;
#pragma unroll
    for (int j = 0; j < 4; ++j) { v[j] = xr[64 * j]; s += (v[j].x * v[j].x + v[j].y * v[j].y) + (v[j].z * v[j].z + v[j].w * v[j].w); }
    const float rstd = 1.f / sqrtf(wave_sum(s) * (1.f / DM) + NORM_EPS);
#pragma unroll
    for (int j = 0; j < 4; ++j) v[j] = v[j] * rstd * g[j];
}
__device__ __forceinline__ void store_row_bf16(bf16* orow, const f32x4 (&v)[4], int lane) {
    GAS unsigned long long* o8 = (GAS unsigned long long*)orow + lane;
#pragma unroll
    for (int j = 0; j < 4; ++j) o8[64 * j] = (unsigned long long)pk2(v[j].x, v[j].y) | ((unsigned long long)pk2(v[j].z, v[j].w) << 32);
}
__device__ __forceinline__ void load_gain(const float* g, f32x4 (&gv)[4], int lane) {
#pragma unroll
    for (int j = 0; j < 4; ++j) gv[j] = *((const f32x4*)g + lane + 64 * j);
}
__device__ __forceinline__ void rmsnorm_phase(const float* src, const float* gain, bf16* dst, int gw, int ngw, int lane) {
    f32x4 gv[4]; load_gain(gain, gv, lane);
    for (int m = gw; m < TOK; m += ngw) { f32x4 v[4]; rms_row(src + (size_t)m * DM, gv, v, lane); store_row_bf16(dst + (size_t)m * DM, v, lane); }
}
__device__ __forceinline__ float bf2f(unsigned short b) { return __uint_as_float((unsigned)b << 16); }


__device__ __forceinline__ int tid_fresh() { int t = (int)threadIdx.x; asm volatile("" : "+v"(t)); return t; }
typedef __attribute__((address_space(4))) const unsigned char* kaptr_t;
__device__ __forceinline__ kaptr_t ka_get() { kaptr_t p = (kaptr_t)__builtin_amdgcn_kernarg_segment_ptr(); asm volatile("" : "+s"(p)); return p; }
#define KA_IN(k) (*(const float* const __attribute__((address_space(4)))*)(ka + 8 * (k)))
#define PH_PTRS const int tid = tid_fresh(); const int lane = tid & 63; (void)lane; kaptr_t ka = ka_get(); unsigned char* const ws = *(unsigned char* const __attribute__((address_space(4)))*)(ka + 168); float* const out = *(float* const __attribute__((address_space(4)))*)(ka + 160); gu32* const ctl = (gu32*)(ws + WS_CTL); (void)out; (void)ctl
#define IN_X KA_IN(0)
#define norm_mix KA_IN(1)
#define norm_ffn KA_IN(2)
#define final_norm KA_IN(3)
#define da_wqkv KA_IN(4)
#define da_wo KA_IN(5)
#define da_lq1 KA_IN(6)
#define da_lk1 KA_IN(7)
#define da_lq2 KA_IN(8)
#define da_lk2 KA_IN(9)
#define da_subln KA_IN(10)
#define mb_wqkv KA_IN(11)
#define mb_wo KA_IN(12)
#define ffn_w1 KA_IN(13)
#define ffn_w3 KA_IN(14)
#define ffn_w2 KA_IN(15)
#define moe_router KA_IN(16)
#define moe_w1 KA_IN(17)
#define moe_w3 KA_IN(18)
#define moe_w2 KA_IN(19)
#define rope64 ((float*)(ws + WS_ROPE64))
#define rope128 ((float*)(ws + WS_ROPE128))
#define kmean ((int*)(ws + WS_KMEAN))
#define tok_e ((int*)(ws + WS_TOK))
#define tok_pos (tok_e + 2 * TOK)
#define tok_gate ((float*)(tok_pos + 2 * TOK))
#define wg_base ((int*)(ws + WS_TOK + 800 * 1024))
#define slot_tok ((int*)(ws + WS_SLOT))
#define slot_gate ((float*)(slot_tok + 2 * SLOTS))
#define slot_sa (slot_gate + 2 * SLOTS)
#define ownml ((float*)(ws + WS_OWNML))
#define W0qkv ((bf16*)(ws + WS_W0QKV))
#define W0o ((bf16*)(ws + WS_W0O))
#define W013 ((bf16*)(ws + WS_W013))
#define W02 ((bf16*)(ws + WS_W02))
#define W1qkv ((bf16*)(ws + WS_W1QKV))
#define W1o ((bf16*)(ws + WS_W1O))
#define Rb ((bf16*)(ws + WS_H))
#define OB ((bf16*)out)
#define RSS(j) ((unsigned long long*)(ws + WS_RSS) + (size_t)(j) * TOK)
#define QKV ((bf16*)(ws + WS_QKV))
#define OATT ((bf16*)(ws + WS_OATT))
#define UD ((bf16*)(ws + WS_UD))
#define lists ((int*)(ws + WS_LIST))
#define pml ((float*)(ws + WS_PML))
#define PO ((bf16*)(ws + WS_PO))
#define WM13 ((signed char*)(ws + WS_WM13))
#define WM2 ((signed char*)(ws + WS_WM2))
#define AQ ((signed char*)(ws + WS_AQ))
#define UM ((signed char*)(ws + WS_UM))
#define Y1B ((bf16*)(ws + WS_AQ))
#define CMAX13 ((unsigned*)(ws + WS_CMAX13))
#define CMAX2 ((unsigned*)(ws + WS_CMAX2))
#define SSTOT ((unsigned long long*)(ws + WS_SSTOT))
#define SA ((float*)(ws + WS_SA))
#define SA1 ((float*)(ws + WS_SA + 128 * 1024))
#define SA0 ((float*)(ws + WS_SA + 256 * 1024))
#define SA2 ((float*)(ws + WS_SA + 384 * 1024))
#define SO0 ((float*)(ws + WS_SA + 512 * 1024))
#define SO1 ((float*)(ws + WS_SA + 640 * 1024))
#define CMQ0 ((unsigned*)(ws + WS_SA + 768 * 1024))
#define CMQ1 ((unsigned*)(ws + WS_SA + 784 * 1024))
#define CMO0 ((unsigned*)(ws + WS_SA + 800 * 1024))
#define CMO1 ((unsigned*)(ws + WS_SA + 808 * 1024))
#define AXQ ((signed char*)(ws + WS_OATT))
#define OBQ ((signed char*)out + (size_t)64 * MiB)
#define CM0_13 ((unsigned*)(ws + WS_CM0))
#define CM0_2 ((unsigned*)(ws + WS_CM0 + 32 * 1024))
#define SSTOT0 ((unsigned long long*)(ws + WS_CM0 + 48 * 1024))
#define W013q ((signed char*)(ws + WS_W013))
#define W02q ((signed char*)(ws + WS_W02))
#define A1Q ((signed char*)(ws + WS_QKV))
#define UDQ ((signed char*)(ws + WS_UD))
__global__ void __launch_bounds__(NWAVES * 64, 2) mk_fwd(Args args) {
    extern __shared__ __attribute__((aligned(16))) unsigned char lds[];
    LAS unsigned char* L = (LAS unsigned char*)lds;
    volatile LAS unsigned* MISC = (volatile LAS unsigned*)(L + MISC_OFF);
    const int wave = __builtin_amdgcn_readfirstlane((int)threadIdx.x >> 6);
    const int G = gridDim.x; const int bx = blockIdx.x; const int vcu = (G % 8 == 0) ? (bx % 8) * (G / 8) + bx / 8 : bx;
    const int gw = vcu * NWAVES + wave, NGW = G * NWAVES;
    gu32* ctl0 = (gu32*)(args.ws + WS_CTL);
    for (int u = (int)threadIdx.x; u < (LDS_BYTES - LDSCTL_OFF) / 4; u += NWAVES * 64) ((LAS unsigned*)(L + LDSCTL_OFF))[u] = 0u;
    __syncthreads();
    XcdBarrier bar; bar.bar = (unsigned*)(ctl0 + CW_BAR); bar.x = 0; bar.st = nullptr;
    if (!MK_PER_PHASE) bar = xcd_barrier_post((unsigned*)(ctl0 + CW_BAR), MISC + 8);
#define GRID_BAR() do { if (!MK_PER_PHASE) xcd_barrier(bar); } while (0)
    const int lo = args.ph_lo, hi_ph = args.ph_hi;
#ifndef PH_MASK
#define PH_MASK 0xFFFFFFFFu
#endif
#define IN(k) (((PH_MASK >> (k)) & 1u) && lo <= (k) && (k) < hi_ph)
#define SEAM(k) do { if (IN((k) + 1)) GRID_BAR(); } while (0)
#ifndef DUP_MASK
#define DUP_MASK 0u
#endif
#define NREP(k) ((((DUP_MASK) >> (k)) & 1u) ? 2 : 1)

    if (IN(0)) { PH_PTRS; for (int rep_ = 0; rep_ < NREP(0); ++rep_) {
        LAS float* scr = (LAS float*)(L + RING_OFF + wave * 16384);
        {
            LAS float* cmw = (LAS float*)(L + 132096);
            for (int st = vcu; st < 256; st += G) {
                const int mat = st < 96 ? 0 : st < 192 ? 1 : st < 224 ? 2 : 3; const int nb = st - (mat == 0 ? 0 : mat == 1 ? 96 : mat == 2 ? 192 : 224);
                const float* W = mat == 0 ? da_wqkv : mat == 1 ? mb_wqkv : mat == 2 ? da_wo : mb_wo; const int N = mat < 2 ? NQKV : DM;
                const float* gk = mat == 0 ? norm_mix : mat == 1 ? norm_mix + DM : nullptr;
                f32x4 mx = (f32x4){0.f, 0.f, 0.f, 0.f}; (void)wstrip_max(W, N, 2 * wave, 2, nb, lane, gk, mx);
                if (lane < 8) { LAS float* d = cmw + wave * 32 + lane * 4; d[0] = mx.x; d[1] = mx.y; d[2] = mx.z; d[3] = mx.w; }
                LDS_WAIT(); __syncthreads();
                float cm = 0.f;
#pragma unroll
                for (int w8 = 0; w8 < 8; ++w8) cm = fmaxf(cm, cmw[w8 * 32 + (lane & 31)]);
                if (mat == 0) { if (wave == 0 && lane < 32) CMQ0[maprow<1>(nb * 32 + lane)] = __float_as_uint(cm); strip_quant<1>(W, DM, N, (signed char*)W0qkv, cm, scr, 2 * wave, 2, nb, lane, gk); }
                else if (mat == 1) { if (wave == 0 && lane < 32) CMQ1[maprow<2>(nb * 32 + lane)] = __float_as_uint(cm); strip_quant<2>(W, DM, N, (signed char*)W1qkv, cm, scr, 2 * wave, 2, nb, lane, gk); }
                else if (mat == 2) { if (wave == 0 && lane < 32) CMO0[nb * 32 + lane] = __float_as_uint(cm); strip_quant<0>(W, DM, N, (signed char*)W0o, cm, scr, 2 * wave, 2, nb, lane, gk); }
                else { if (wave == 0 && lane < 32) CMO1[nb * 32 + lane] = __float_as_uint(cm); strip_quant<0>(W, DM, N, (signed char*)W1o, cm, scr, 2 * wave, 2, nb, lane, gk); }
                __syncthreads();
            }
        }
        {
            constexpr int S_1 = (DM / 512) * (FF0 / 32), S_2 = 6 * (DM / 32);
            float ssA = 0.f, ssB = 0.f;
            for (int it = NGW - 1 - gw; it < 2 * S_1 + S_2; it += NGW) {
                int r = it;
                if (r < S_1) { ssA += wmax_strip<3>(ffn_w1, FF0, CM0_13, 8 * (r / (FF0 / 32)), 8, r % (FF0 / 32), lane, norm_ffn); continue; } r -= S_1;
                if (r < S_1) { ssB += wmax_strip<4>(ffn_w3, FF0, CM0_13, 8 * (r / (FF0 / 32)), 8, r % (FF0 / 32), lane, norm_ffn); continue; } r -= S_1;
                { const int st = r / (DM / 32); (void)wmax_strip<0>(ffn_w2, DM, CM0_2, 8 * st, st == 5 ? 4 : 8, r % (DM / 32), lane, nullptr); }
            }
            ssA = wave_sum(ssA); ssB = wave_sum(ssB);
            if (lane == 0 && (ssA != 0.f || ssB != 0.f)) { __hip_atomic_fetch_add(SSTOT0, (unsigned long long)(ssA * 16777216.0f), __ATOMIC_RELAXED, __HIP_MEMORY_SCOPE_AGENT); __hip_atomic_fetch_add(SSTOT0 + 1, (unsigned long long)(ssB * 16777216.0f), __ATOMIC_RELAXED, __HIP_MEMORY_SCOPE_AGENT); }
        }
        {
            const int gt = (vcu * NWAVES + wave) * 64 + lane, NT_ = G * NWAVES * 64;
            for (int e = gt; e < SEQ * 8; e += NT_) { const int pos = e >> 3, i = e & 7; const float ang = (float)pos * (*(const float __attribute__((address_space(4)))*)(ka + 176 + 4 * i)); rope64[e] = cosf(ang); rope64[SEQ * 8 + e] = sinf(ang); }
            for (int e = gt; e < SEQ * 16; e += NT_) { const int pos = e >> 4, i = e & 15; const float ang = (float)pos * (*(const float __attribute__((address_space(4)))*)(ka + 208 + 4 * i)); rope128[e] = cosf(ang); rope128[SEQ * 16 + e] = sinf(ang); }
        }
        for (int m0 = gw; m0 < TOK; m0 += 2 * NGW) {
            f32x4 vv[2][4];
#pragma unroll
            for (int u = 0; u < 2; ++u) { const int m = (m0 + u * NGW < TOK) ? m0 + u * NGW : m0; const GAS f32x4* xr = (const GAS f32x4*)(IN_X + (size_t)m * DM) + lane;
#pragma unroll
                for (int j = 0; j < 4; ++j) vv[u][j] = xr[64 * j]; }
#pragma unroll
            for (int u = 0; u < 2; ++u) { const int m = m0 + u * NGW; if (m < TOK) {
                f32x4 v[4]; float s = 0.f, mx = 0.f;
#pragma unroll
                for (int j = 0; j < 4; ++j) { v[j] = vv[u][j]; s += (v[j].x * v[j].x + v[j].y * v[j].y) + (v[j].z * v[j].z + v[j].w * v[j].w);
                    mx = fmaxf(fmaxf(mx, fmaxf(fabsf(v[j].x), fabsf(v[j].y))), fmaxf(fabsf(v[j].z), fabsf(v[j].w))); }
                store_row_bf16(Rb + (size_t)m * DM, v, lane); s = wave_sum(s);
#pragma unroll
                for (int o = 1; o < 64; o <<= 1) mx = fmaxf(mx, __shfl_xor(mx, o));
                const float inv = mx > 0.f ? 127.0f / mx : 0.f;
                GAS unsigned* aq = (GAS unsigned*)(AXQ + (size_t)m * DM) + lane;
#pragma unroll
                for (int j = 0; j < 4; ++j) { const int q0 = (int)__builtin_rintf(v[j].x * inv), q1 = (int)__builtin_rintf(v[j].y * inv), q2 = (int)__builtin_rintf(v[j].z * inv), q3 = (int)__builtin_rintf(v[j].w * inv);
                    aq[64 * j] = (unsigned)(q0 & 255) | ((unsigned)(q1 & 255) << 8) | ((unsigned)(q2 & 255) << 16) | ((unsigned)(q3 & 255) << 24); }
                if (lane == 0) SA0[m] = mx * (1.f / sqrtf(s * (1.f / DM) + NORM_EPS)) * (1.0f / 127.0f); } }
        }
        } SEAM(0);
    }
    if (IN(1)) { PH_PTRS; for (int rep_ = 0; rep_ < NREP(1); ++rep_) {
        pg8::ABDense ab{(const pg8::bf16_t*)AXQ, (const pg8::bf16_t*)W0qkv, DM / 2}; pg8::TileOrder S; S.init(TOK / 256, NQKV / 256, G, bx);
        pg8::EpiQKVQ<64> E{QKV, NQKV, rope64, rope64 + SEQ * 8, 0.125f * LOG2E, SA0, CMQ0, nullptr};
        pg8::gemm_phase<pg8::EpiQKVQ<64>, pg8::ABDense, GEMM_ALIGN>(L + RING_OFF, ab, S, E);
        } SEAM(1);
    }
    if (IN(2)) { PH_PTRS; for (int rep_ = 0; rep_ < NREP(2); ++rep_) {
        const moba::DaOrder AS(vcu, G);
        moba::dattn_phase<moba::DaOrder>((char*)lds + RING_OFF, (const moba::bf16*)QKV, (moba::bf16*)OATT, AS);
        } SEAM(2);
    }
    if (IN(3)) { PH_PTRS; for (int rep_ = 0; rep_ < NREP(3); ++rep_) {
        float lam;
        { const float a = wave_sum(da_lq1[lane] * da_lk1[lane]), b = wave_sum(da_lq2[lane] * da_lk2[lane]); lam = expf(a) - expf(b) + LAMBDA_INIT0; }
        const int hh = lane >> 3, dd = (lane & 7) * 16;
        float gsub[16];
#pragma unroll
        for (int k = 0; k < 16; ++k) gsub[k] = da_subln[dd + k] * (1.f - LAMBDA_INIT0);
        for (int m0 = gw; m0 < TOK; m0 += 2 * NGW) {
            v4u A0[2], A1[2], B0[2], B1[2];
#pragma unroll
            for (int u = 0; u < 2; ++u) { const int m = (m0 + u * NGW < TOK) ? m0 + u * NGW : m0;
                const bf16* o1 = OATT + (size_t)m * 2048 + (2 * hh) * 128 + dd; const bf16* o2 = o1 + 128;
                A0[u] = *(const GAS v4u*)o1; A1[u] = *(const GAS v4u*)(o1 + 8); B0[u] = *(const GAS v4u*)o2; B1[u] = *(const GAS v4u*)(o2 + 8); }
#pragma unroll
            for (int u = 0; u < 2; ++u) { const int m = m0 + u * NGW; if (m < TOK) {
                const v4u a0 = A0[u], a1 = A1[u], b0 = B0[u], b1 = B1[u];
                float d[16]; float ss = 0.f;
#pragma unroll
                for (int k = 0; k < 4; ++k) {
                    const unsigned ua = a0[k], ub = b0[k], uc = a1[k], ud = b1[k];
                    d[2 * k] = __uint_as_float(ua << 16) - lam * __uint_as_float(ub << 16); d[2 * k + 1] = __uint_as_float(ua & 0xffff0000u) - lam * __uint_as_float(ub & 0xffff0000u);
                    d[8 + 2 * k] = __uint_as_float(uc << 16) - lam * __uint_as_float(ud << 16); d[8 + 2 * k + 1] = __uint_as_float(uc & 0xffff0000u) - lam * __uint_as_float(ud & 0xffff0000u); }
#pragma unroll
                for (int k = 0; k < 16; ++k) ss += d[k] * d[k];
                ss += __shfl_xor(ss, 1); ss += __shfl_xor(ss, 2); ss += __shfl_xor(ss, 4);
                const float rstd = 1.f / sqrtf(ss * (1.f / 128.f) + SUBLN_EPS);
                float mx = 0.f;
#pragma unroll
                for (int k = 0; k < 16; ++k) { d[k] = d[k] * rstd * gsub[k]; mx = fmaxf(mx, fabsf(d[k])); }
#pragma unroll
                for (int o = 1; o < 64; o <<= 1) mx = fmaxf(mx, __shfl_xor(mx, o));
                const float inv = mx > 0.f ? 127.0f / mx : 0.f;
                v4u wq;
#pragma unroll
                for (int k = 0; k < 4; ++k) { const int q0 = (int)__builtin_rintf(d[4 * k] * inv), q1 = (int)__builtin_rintf(d[4 * k + 1] * inv), q2 = (int)__builtin_rintf(d[4 * k + 2] * inv), q3 = (int)__builtin_rintf(d[4 * k + 3] * inv);
                    wq[k] = (unsigned)(q0 & 255) | ((unsigned)(q1 & 255) << 8) | ((unsigned)(q2 & 255) << 16) | ((unsigned)(q3 & 255) << 24); }
                *(GAS v4u*)(OBQ + (size_t)m * DM + hh * 128 + dd) = wq;
                if (lane == 0) SO0[m] = mx * (1.0f / 127.0f); } }
        }
        {
            LAS float* scr = (LAS float*)(L + RING_OFF + wave * 16384);
            constexpr int I_13 = (DM / 64) * (FF0 / 32), I_2 = (FF0 / 64) * (DM / 32);
            for (int it = gw; it < 2 * I_13 + I_2; it += NGW) {
                int r = it;
                if (r < I_13) { transpose_item_q<3>(ffn_w1, DM, FF0, W013q, CM0_13, scr, r, lane, norm_ffn); continue; } r -= I_13;
                if (r < I_13) { transpose_item_q<4>(ffn_w3, DM, FF0, W013q, CM0_13, scr, r, lane, norm_ffn); continue; } r -= I_13;
                transpose_item_q<0>(ffn_w2, FF0, DM, W02q, CM0_2, scr, r, lane, nullptr);
            }
        }
        } SEAM(3);
    }
    if (IN(4)) { PH_PTRS; for (int rep_ = 0; rep_ < NREP(4); ++rep_) {
        pg8::ABDense ab{(const pg8::bf16_t*)OBQ, (const pg8::bf16_t*)W0o, DM / 2}; pg8::TileOrder S; S.init(TOK / 256, DM / 256, G, bx);
        pg8::EpiResBQ E{Rb, Rb, DM, nullptr, SO0, CMO0, pg8::MoeMap{0, nullptr}, 1.0f, RSS(1), nullptr};
        pg8::gemm_phase<pg8::EpiResBQ, pg8::ABDense, GEMM_ALIGN>(L + RING_OFF, ab, S, E);
        } SEAM(4);
    }
    if (IN(5)) { PH_PTRS;
        for (int m0 = gw; m0 < TOK; m0 += 4 * NGW) {
            unsigned long long w[4][4];
#pragma unroll
            for (int u = 0; u < 4; ++u) { const int m = (m0 + u * NGW < TOK) ? m0 + u * NGW : m0; const GAS unsigned long long* r8 = (const GAS unsigned long long*)(Rb + (size_t)m * DM) + lane;
#pragma unroll
                for (int j = 0; j < 4; ++j) w[u][j] = r8[64 * j]; }
#pragma unroll
            for (int u = 0; u < 4; ++u) { const int m = m0 + u * NGW; if (m < TOK) {
                f32x4 v[4]; float mx = 0.f;
#pragma unroll
                for (int j = 0; j < 4; ++j) { const unsigned lo32 = (unsigned)w[u][j], hi32 = (unsigned)(w[u][j] >> 32);
                    v[j].x = __uint_as_float(lo32 << 16); v[j].y = __uint_as_float(lo32 & 0xffff0000u); v[j].z = __uint_as_float(hi32 << 16); v[j].w = __uint_as_float(hi32 & 0xffff0000u);
                    mx = fmaxf(fmaxf(mx, fmaxf(fabsf(v[j].x), fabsf(v[j].y))), fmaxf(fabsf(v[j].z), fabsf(v[j].w))); }
#pragma unroll
                for (int o = 1; o < 64; o <<= 1) mx = fmaxf(mx, __shfl_xor(mx, o));
                const float inv = mx > 0.f ? 127.0f / mx : 0.f;
                GAS unsigned* aq = (GAS unsigned*)(A1Q + (size_t)m * DM) + lane;
#pragma unroll
                for (int j = 0; j < 4; ++j) { const int q0 = (int)__builtin_rintf(v[j].x * inv), q1 = (int)__builtin_rintf(v[j].y * inv), q2 = (int)__builtin_rintf(v[j].z * inv), q3 = (int)__builtin_rintf(v[j].w * inv);
                    aq[64 * j] = (unsigned)(q0 & 255) | ((unsigned)(q1 & 255) << 8) | ((unsigned)(q2 & 255) << 16) | ((unsigned)(q3 & 255) << 24); }
                if (lane == 0) SA1[m] = mx * (1.f / sqrtf((float)RSS(1)[m] * (5.9604644775390625e-8f / DM) + NORM_EPS)) * (1.0f / 127.0f); } }
        }
        SEAM(5);
    }
    if (IN(6)) { PH_PTRS; for (int rep_ = 0; rep_ < NREP(6); ++rep_) {
        const float su0 = 8.0f * sqrtf(((float)SSTOT0[0] * (5.9604644775390625e-8f / FF0)) * ((float)SSTOT0[1] * (5.9604644775390625e-8f / FF0)));
        pg8::ABDense ab{(const pg8::bf16_t*)A1Q, (const pg8::bf16_t*)W013q, DM / 2}; pg8::TileOrder S; S.init(TOK / 256, (2 * FF0) / 256, G, bx);
        pg8::EpiSwiGLUQ E{UDQ, FF0, SA1, CM0_13, nullptr, pg8::MoeMap{0, nullptr}, 127.0f / su0};
        pg8::gemm_phase<pg8::EpiSwiGLUQ, pg8::ABDense, GEMM_ALIGN>(L + RING_OFF, ab, S, E);
        } SEAM(6);
    }
    if (IN(7)) { PH_PTRS; for (int rep_ = 0; rep_ < NREP(7); ++rep_) {
        const float su0 = 8.0f * sqrtf(((float)SSTOT0[0] * (5.9604644775390625e-8f / FF0)) * ((float)SSTOT0[1] * (5.9604644775390625e-8f / FF0)));
        pg8::ABDense ab{(const pg8::bf16_t*)UDQ, (const pg8::bf16_t*)W02q, FF0 / 2}; pg8::TileOrder S; S.init(TOK / 256, DM / 256, G, bx);
        pg8::EpiResBQ E{Rb, Rb, DM, nullptr, nullptr, CM0_2, pg8::MoeMap{0, nullptr}, su0 * (1.0f / 127.0f), RSS(2), nullptr};
        pg8::gemm_phase<pg8::EpiResBQ, pg8::ABDense, GEMM_ALIGN>(L + RING_OFF, ab, S, E);
        } SEAM(7);
    }
    if (IN(8)) { PH_PTRS;
        for (int m0 = gw; m0 < TOK; m0 += 4 * NGW) {
            unsigned long long w[4][4];
#pragma unroll
            for (int u = 0; u < 4; ++u) { const int m = (m0 + u * NGW < TOK) ? m0 + u * NGW : m0; const GAS unsigned long long* r8 = (const GAS unsigned long long*)(Rb + (size_t)m * DM) + lane;
#pragma unroll
                for (int j = 0; j < 4; ++j) w[u][j] = r8[64 * j]; }
#pragma unroll
            for (int u = 0; u < 4; ++u) { const int m = m0 + u * NGW; if (m < TOK) {
                f32x4 v[4]; float mx = 0.f;
#pragma unroll
                for (int j = 0; j < 4; ++j) { const unsigned lo32 = (unsigned)w[u][j], hi32 = (unsigned)(w[u][j] >> 32);
                    v[j].x = __uint_as_float(lo32 << 16); v[j].y = __uint_as_float(lo32 & 0xffff0000u); v[j].z = __uint_as_float(hi32 << 16); v[j].w = __uint_as_float(hi32 & 0xffff0000u);
                    mx = fmaxf(fmaxf(mx, fmaxf(fabsf(v[j].x), fabsf(v[j].y))), fmaxf(fabsf(v[j].z), fabsf(v[j].w))); }
#pragma unroll
                for (int o = 1; o < 64; o <<= 1) mx = fmaxf(mx, __shfl_xor(mx, o));
                const float inv = mx > 0.f ? 127.0f / mx : 0.f;
                GAS unsigned* aq = (GAS unsigned*)(AXQ + (size_t)m * DM) + lane;
#pragma unroll
                for (int j = 0; j < 4; ++j) { const int q0 = (int)__builtin_rintf(v[j].x * inv), q1 = (int)__builtin_rintf(v[j].y * inv), q2 = (int)__builtin_rintf(v[j].z * inv), q3 = (int)__builtin_rintf(v[j].w * inv);
                    aq[64 * j] = (unsigned)(q0 & 255) | ((unsigned)(q1 & 255) << 8) | ((unsigned)(q2 & 255) << 16) | ((unsigned)(q3 & 255) << 24); }
                if (lane == 0) SA2[m] = mx * (1.f / sqrtf((float)RSS(2)[m] * (5.9604644775390625e-8f / DM) + NORM_EPS)) * (1.0f / 127.0f); } }
        }
        SEAM(8);
    }
    if (IN(9)) { PH_PTRS; for (int rep_ = 0; rep_ < NREP(9); ++rep_) {
        pg8::ABDense ab{(const pg8::bf16_t*)AXQ, (const pg8::bf16_t*)W1qkv, DM / 2}; pg8::TileOrder S; S.init(TOK / 256, NQKV / 256, G, bx);
        pg8::EpiQKVQ<128> E{QKV, NQKV, rope128, rope128 + SEQ * 16, 0.08838834764831845f * LOG2E, SA2, CMQ1, kmean};
        pg8::gemm_phase<pg8::EpiQKVQ<128>, pg8::ABDense, GEMM_ALIGN>(L + RING_OFF, ab, S, E);
        } SEAM(9);
    }
    if (IN(11)) { PH_PTRS; for (int rep_ = 0; rep_ < NREP(11); ++rep_) {
        LAS float* km = (LAS float*)(L + RING_OFF);
        LAS float* mv = (LAS float*)(L + RING_OFF + 16384);
        LAS int* mi = (LAS int*)(L + RING_OFF + 16384 + 3072);
        LAS int* lcnt = (LAS int*)(L + RING_OFF + 24576);
        for (int u = vcu; u < BATCH * MB_H * (MB_NB - 1); u += G) {
            const int bh = u / 31, o = 1 + u % 31, b = bh >> 3, h = bh & 7;
            for (int e = tid; e < 32 * 128; e += 512) km[e] = (float)kmean[(size_t)bh * 4096 + e] * (1.0f / (65536.0f * 256.0f));
            if (tid < 32) lcnt[tid] = 0;
            __syncthreads();
            const int ql = tid & 255, half = tid >> 8; const int s = o * 256 + ql;
            const bf16* qp = QKV + (size_t)(b * SEQ + s) * NQKV + h * 128;
            float qf[128];
#pragma unroll
            for (int c = 0; c < 16; ++c) { const v4u v = *(const GAS v4u*)(qp + c * 8);
#pragma unroll
                for (int q = 0; q < 4; ++q) { qf[c * 8 + 2 * q] = __uint_as_float(v[q] << 16); qf[c * 8 + 2 * q + 1] = __uint_as_float(v[q] & 0xffff0000u); } }
            float v0 = -INFINITY, v1 = -INFINITY, v2 = -INFINITY; int i0 = -1, i1 = -1, i2 = -1;
            for (int jj = 0; jj < 16; ++jj) { const int j = half * 16 + jj;
                if (j < o) { float g = 0.f; const LAS f32x4* kr = (const LAS f32x4*)(km + j * 128);
#pragma unroll
                    for (int c = 0; c < 32; ++c) { const f32x4 kv = kr[c]; g += qf[4 * c] * kv.x + qf[4 * c + 1] * kv.y + qf[4 * c + 2] * kv.z + qf[4 * c + 3] * kv.w; }
                    if (g > v0) { v2 = v1; i2 = i1; v1 = v0; i1 = i0; v0 = g; i0 = j; } else if (g > v1) { v2 = v1; i2 = i1; v1 = g; i1 = j; } else if (g > v2) { v2 = g; i2 = j; } } }
            if (half == 1) { mv[ql * 3] = v0; mv[ql * 3 + 1] = v1; mv[ql * 3 + 2] = v2; mi[ql * 3] = i0; mi[ql * 3 + 1] = i1; mi[ql * 3 + 2] = i2; }
            __syncthreads();
            int lp0 = 0, lp1 = 0, lp2 = 0;
            if (half == 0) {
#pragma unroll
                for (int k = 0; k < 3; ++k) { const float g = mv[ql * 3 + k]; const int j = mi[ql * 3 + k];
                    if (j >= 0) { if (g > v0) { v2 = v1; i2 = i1; v1 = v0; i1 = i0; v0 = g; i0 = j; } else if (g > v1) { v2 = v1; i2 = i1; v1 = g; i1 = j; } else if (g > v2) { v2 = g; i2 = j; } } }
                if (i0 >= 0) lp0 = __hip_atomic_fetch_add(&lcnt[i0], 1, __ATOMIC_RELAXED, __HIP_MEMORY_SCOPE_WORKGROUP);
                if (i1 >= 0) lp1 = __hip_atomic_fetch_add(&lcnt[i1], 1, __ATOMIC_RELAXED, __HIP_MEMORY_SCOPE_WORKGROUP);
                if (i2 >= 0) lp2 = __hip_atomic_fetch_add(&lcnt[i2], 1, __ATOMIC_RELAXED, __HIP_MEMORY_SCOPE_WORKGROUP);
            }
            __syncthreads();
            if (tid < 32 && rep_ == 0) { const int n = lcnt[tid]; lcnt[32 + tid] = n ? (int)__hip_atomic_fetch_add(ctl + CW_MOBACNT + bh * 32 + tid, (unsigned)n, RLX_AGENT) : 0; }
            __syncthreads();
            if (half == 0 && rep_ == 0) { int* lb = lists + (size_t)bh * LIST_PER_BH;
                if (i0 >= 0) lb[list_off(i0) + lcnt[32 + i0] + lp0] = s;
                if (i1 >= 0) lb[list_off(i1) + lcnt[32 + i1] + lp1] = s | (1 << 16);
                if (i2 >= 0) lb[list_off(i2) + lcnt[32 + i2] + lp2] = s | (2 << 16); }
            __syncthreads();
        }
        } SEAM(11);
    }
    if (IN(12)) { PH_PTRS; for (int rep_ = 0; rep_ < NREP(12); ++rep_) {
        LAS int* pre = (LAS int*)(L + 153600);
        { const unsigned c0 = __hip_atomic_load(ctl + CW_MOBACNT + tid, RLX_AGENT), c1 = __hip_atomic_load(ctl + CW_MOBACNT + 512 + tid, RLX_AGENT);
          pre[tid] = (int)((c0 + 1023u) >> 10); pre[512 + tid] = (int)((c1 + 1023u) >> 10); }
        __syncthreads();
        if (tid == 0) { int a = 0; for (int k = 0; k < 1024; ++k) { const int n = pre[k]; pre[k] = a; a += n; } pre[1024] = a; }
        __syncthreads();
        const int nlu = pre[1024];
        const int r32_ = lane & 31;
        for (;;) {
            __syncthreads();
            if (tid == 0) MISC[60] = __hip_atomic_fetch_add(ctl + CW_Q + (rep_ ? 16 : 0), 1u, RLX_AGENT);
            __syncthreads();
            const int u = (int)MISC[60];
            if (u >= nlu) break;
            int loI = 0, hiI = 1024;
            while (hiI - loI > 1) { const int mid = (loI + hiI) >> 1; if (pre[mid] <= u) loI = mid; else hiI = mid; }
            const int bhj = loI, grp = u - pre[bhj], bh = bhj >> 5, kb = bhj & 31, b = bh >> 3, h = bh & 7;
            const int cnt = (int)__hip_atomic_load(ctl + CW_MOBACNT + bhj, RLX_AGENT);
            const int e0 = grp * 1024, n = (cnt - e0) < 1024 ? (cnt - e0) : 1024, nsub = (n + 31) >> 5;
            const moba::bf16* Kh = (const moba::bf16*)QKV + ((size_t)b * SEQ + kb * 256) * NQKV + 1024 + h * 128;
            moba::moba_load_block(Kh, Kh + 1024, (char*)lds);
            asm volatile("s_waitcnt vmcnt(0) lgkmcnt(0)\n\ts_barrier" ::: "memory");
            for (int sc = wave; sc < nsub; sc += 8) {
                const int ei = e0 + sc * 32 + r32_; const bool valid = ei < cnt;
                const int ent = valid ? lists[(size_t)bh * LIST_PER_BH + list_off(kb) + ei] : 0;
                const int s = ent & 0xffff, mli = (bh * SEQ + s) * 3 + (ent >> 16);
                const moba::bf16* qrow = (const moba::bf16*)QKV + ((size_t)b * SEQ + s) * NQKV + h * 128;
                moba::moba_sub<false>(3, qrow, (moba::bf16*)PO, 128, valid ? mli : -1, pml, mli, 0, (char*)lds, wave);
            }
        }
        for (;;) {
            __syncthreads();
            if (tid == 0) MISC[60] = __hip_atomic_fetch_add(ctl + CW_Q + 1 + (rep_ ? 16 : 0), 1u, RLX_AGENT);
            __syncthreads();
            const int ou = (int)MISC[60];
            if (ou >= 1024) break;
            const int b = ou >> 8, h = (ou >> 5) & 7, kb = ou & 31;
            const moba::bf16* Kh = (const moba::bf16*)QKV + ((size_t)b * SEQ + kb * 256) * NQKV + 1024 + h * 128;
            moba::moba_load_block(Kh, Kh + 1024, (char*)lds);
            const int s = kb * 256 + wave * 32 + r32_;
            const moba::bf16* qrow = (const moba::bf16*)QKV + ((size_t)b * SEQ + s) * NQKV + h * 128;
            asm volatile("s_waitcnt vmcnt(0) lgkmcnt(0)\n\ts_barrier" ::: "memory");
            moba::moba_sub<true>(wave >> 1, qrow, (moba::bf16*)OB + h * 128, DM, b * SEQ + s, ownml, (b * 8 + h) * SEQ + s, wave * 32 + r32_, (char*)lds, wave);
        }
        } SEAM(12);
    }
    if (IN(13)) { PH_PTRS; for (int rep_ = 0; rep_ < NREP(13); ++rep_) {
        const int hh = lane >> 3, dd = (lane & 7) * 16;
        for (int m0 = gw; m0 < TOK; m0 += 2 * NGW) {
            v4u A0[2], A1[2], Q0[2][3], Q1[2][3]; float mm[2][4], ll[2][4];
#pragma unroll
            for (int u = 0; u < 2; ++u) { const int m = (m0 + u * NGW < TOK) ? m0 + u * NGW : m0;
                const int b = m >> 13, s = m & 8191, nv = (s >> 8) < 3 ? (s >> 8) : 3; const int qi = (b * 8 + hh) * SEQ + s;
                mm[u][0] = ownml[2 * (size_t)qi]; ll[u][0] = ownml[2 * (size_t)qi + 1];
                const bf16* op = OB + (size_t)m * DM + hh * 128 + dd; A0[u] = *(const GAS v4u*)op; A1[u] = *(const GAS v4u*)(op + 8);
#pragma unroll
                for (int r = 0; r < 3; ++r) { if (r < nv) { mm[u][1 + r] = pml[2 * ((size_t)qi * 3 + r)]; ll[u][1 + r] = pml[2 * ((size_t)qi * 3 + r) + 1];
                        const bf16* pp = PO + ((size_t)qi * 3 + r) * 128 + dd; Q0[u][r] = *(const GAS v4u*)pp; Q1[u][r] = *(const GAS v4u*)(pp + 8); }
                    else { mm[u][1 + r] = -1e30f; ll[u][1 + r] = 0.f; Q0[u][r] = (v4u){0u, 0u, 0u, 0u}; Q1[u][r] = (v4u){0u, 0u, 0u, 0u}; } } }
#pragma unroll
            for (int u = 0; u < 2; ++u) { const int m = m0 + u * NGW; if (m < TOK) {
                float M = fmaxf(fmaxf(mm[u][0], mm[u][1]), fmaxf(mm[u][2], mm[u][3]));
                float w[4], wsum = 0.f;
#pragma unroll
                for (int r = 0; r < 4; ++r) { w[r] = ll[u][r] * __builtin_amdgcn_exp2f(mm[u][r] - M); wsum += w[r]; }
                const float inv = 1.f / wsum;
                float acc16[16];
                { const v4u a0 = A0[u], a1 = A1[u]; const float ww = w[0] * inv;
#pragma unroll
                  for (int k = 0; k < 4; ++k) { acc16[2 * k] = ww * __uint_as_float(a0[k] << 16); acc16[2 * k + 1] = ww * __uint_as_float(a0[k] & 0xffff0000u); acc16[8 + 2 * k] = ww * __uint_as_float(a1[k] << 16); acc16[8 + 2 * k + 1] = ww * __uint_as_float(a1[k] & 0xffff0000u); } }
#pragma unroll
                for (int r = 0; r < 3; ++r) { const v4u a0 = Q0[u][r], a1 = Q1[u][r]; const float ww = w[1 + r] * inv;
#pragma unroll
                    for (int k = 0; k < 4; ++k) { acc16[2 * k] += ww * __uint_as_float(a0[k] << 16); acc16[2 * k + 1] += ww * __uint_as_float(a0[k] & 0xffff0000u); acc16[8 + 2 * k] += ww * __uint_as_float(a1[k] << 16); acc16[8 + 2 * k + 1] += ww * __uint_as_float(a1[k] & 0xffff0000u); } }
                float mx = 0.f;
#pragma unroll
                for (int k = 0; k < 16; ++k) mx = fmaxf(mx, fabsf(acc16[k]));
#pragma unroll
                for (int o = 1; o < 64; o <<= 1) mx = fmaxf(mx, __shfl_xor(mx, o));
                const float invq = mx > 0.f ? 127.0f / mx : 0.f;
                v4u wq;
#pragma unroll
                for (int k = 0; k < 4; ++k) { const int q0 = (int)__builtin_rintf(acc16[4 * k] * invq), q1 = (int)__builtin_rintf(acc16[4 * k + 1] * invq), q2 = (int)__builtin_rintf(acc16[4 * k + 2] * invq), q3 = (int)__builtin_rintf(acc16[4 * k + 3] * invq);
                    wq[k] = (unsigned)(q0 & 255) | ((unsigned)(q1 & 255) << 8) | ((unsigned)(q2 & 255) << 16) | ((unsigned)(q3 & 255) << 24); }
                *(GAS v4u*)(OBQ + (size_t)m * DM + hh * 128 + dd) = wq;
                if (lane == 0) SO1[m] = mx * (1.0f / 127.0f); } }
        }
        } SEAM(13);
    }
    if (IN(14)) { PH_PTRS; for (int rep_ = 0; rep_ < NREP(14); ++rep_) {
        pg8::ABDense ab{(const pg8::bf16_t*)OBQ, (const pg8::bf16_t*)W1o, DM / 2}; pg8::TileOrder S; S.init(TOK / 256, DM / 256, G, bx);
        pg8::EpiResBQ E{Rb, Rb, DM, nullptr, SO1, CMO1, pg8::MoeMap{0, nullptr}, 1.0f, RSS(3), nullptr};
        pg8::gemm_phase<pg8::EpiResBQ, pg8::ABDense, GEMM_ALIGN>(L + RING_OFF, ab, S, E);
        } SEAM(14);
    }
    if (IN(15)) { PH_PTRS; for (int rep_ = 0; rep_ < NREP(15); ++rep_) {
        {
            const int gt = (vcu * NWAVES + wave) * 64 + lane, NT_ = G * NWAVES * 64;
            for (int e = gt; e < 2 * SLOTS; e += NT_) { slot_tok[e] = -1; slot_gate[e] = 0.f; slot_sa[e] = 0.f; }
        }
        if (rep_ == 0) {
            f32x4 gv[4]; load_gain(norm_ffn + DM, gv, lane);
            float wr_[16][8];
#pragma unroll
            for (int j = 0; j < 4; ++j)
#pragma unroll
                for (int q = 0; q < 4; ++q) { const int k = 4 * lane + 256 * j + q; const f32x4 a = *(const GAS f32x4*)(moe_router + (size_t)k * 8) * gv[j][q], c = *(const GAS f32x4*)(moe_router + (size_t)k * 8 + 4) * gv[j][q];
                    wr_[4 * j + q][0] = a.x; wr_[4 * j + q][1] = a.y; wr_[4 * j + q][2] = a.z; wr_[4 * j + q][3] = a.w; wr_[4 * j + q][4] = c.x; wr_[4 * j + q][5] = c.y; wr_[4 * j + q][6] = c.z; wr_[4 * j + q][7] = c.w; }
            for (int m = gw; m < TOK; m += NGW) {
                f32x4 v[4];
                { const GAS unsigned long long* r8 = (const GAS unsigned long long*)(Rb + (size_t)m * DM) + lane;
#pragma unroll
                  for (int j = 0; j < 4; ++j) { const unsigned long long w = r8[64 * j]; const unsigned lo32 = (unsigned)w, hi32 = (unsigned)(w >> 32);
                      v[j].x = __uint_as_float(lo32 << 16); v[j].y = __uint_as_float(lo32 & 0xffff0000u); v[j].z = __uint_as_float(hi32 << 16); v[j].w = __uint_as_float(hi32 & 0xffff0000u); } }
                float lg[8];
#pragma unroll
                for (int e = 0; e < 8; ++e) { float a = 0.f;
#pragma unroll
                    for (int j = 0; j < 4; ++j) a += v[j].x * wr_[4 * j][e] + v[j].y * wr_[4 * j + 1][e] + v[j].z * wr_[4 * j + 2][e] + v[j].w * wr_[4 * j + 3][e];
                    lg[e] = wave_sum(a); }
                const float rs = 1.f / sqrtf((float)RSS(3)[m] * (5.9604644775390625e-8f / DM) + NORM_EPS);
#pragma unroll
                for (int e = 0; e < 8; ++e) lg[e] *= rs;
                {
                    float mx = 0.f;
#pragma unroll
                    for (int j = 0; j < 4; ++j) mx = fmaxf(fmaxf(mx, fmaxf(fabsf(v[j].x), fabsf(v[j].y))), fmaxf(fabsf(v[j].z), fabsf(v[j].w)));
#pragma unroll
                    for (int o = 1; o < 64; o <<= 1) mx = fmaxf(mx, __shfl_xor(mx, o));
                    const float inv = mx > 0.f ? 127.0f / mx : 0.f;
                    GAS unsigned* aq = (GAS unsigned*)(AQ + (size_t)m * DM) + lane;
#pragma unroll
                    for (int j = 0; j < 4; ++j) { const int q0 = (int)__builtin_rintf(v[j].x * inv), q1 = (int)__builtin_rintf(v[j].y * inv), q2 = (int)__builtin_rintf(v[j].z * inv), q3 = (int)__builtin_rintf(v[j].w * inv);
                        aq[64 * j] = (unsigned)(q0 & 255) | ((unsigned)(q1 & 255) << 8) | ((unsigned)(q2 & 255) << 16) | ((unsigned)(q3 & 255) << 24); }
                    if (lane == 0) SA[m] = mx * rs * (1.0f / 127.0f);
                }
                int e0 = 0; float l0 = lg[0];
#pragma unroll
                for (int e = 1; e < 8; ++e) if (lg[e] > l0) { l0 = lg[e]; e0 = e; }
                int e1 = -1; float l1 = -INFINITY;
#pragma unroll
                for (int e = 0; e < 8; ++e) if (e != e0 && lg[e] > l1) { l1 = lg[e]; e1 = e; }
                if (lane == 0) {
                    const float g0 = 1.f / (1.f + expf(l1 - l0)), g1 = 1.f - g0;
                    const int p0 = (int)__hip_atomic_fetch_add((LAS unsigned*)(L + MISC_OFF) + 40 + e0, 1u, __ATOMIC_RELAXED, __HIP_MEMORY_SCOPE_WORKGROUP), p1 = (int)__hip_atomic_fetch_add((LAS unsigned*)(L + MISC_OFF) + 48 + e1, 1u, __ATOMIC_RELAXED, __HIP_MEMORY_SCOPE_WORKGROUP);
                    tok_e[m] = e0; tok_e[TOK + m] = e1; tok_pos[m] = p0; tok_pos[TOK + m] = p1; tok_gate[m] = g0; tok_gate[TOK + m] = g1;
                }
            }
            LDS_WAIT(); __syncthreads();
            if (tid < 16) { const unsigned n = MISC[40 + tid]; wg_base[vcu * 16 + tid] = n ? (int)__hip_atomic_fetch_add(ctl + CW_MOECNT + tid, n, RLX_AGENT) : 0; }
        }
        {
            LAS float* scr = (LAS float*)(L + RING_OFF + wave * 16384);
            LAS float* cmw = (LAS float*)(L + 132096);
            const float* gk1 = norm_ffn + DM;
            for (int st = vcu; st < NEXP * (DM / 32); st += G) {
                const int e = st >> 5, nb = st & 31; const float* W = moe_w2 + (size_t)e * FF1 * DM;
                f32x4 mx = (f32x4){0.f, 0.f, 0.f, 0.f}; (void)wstrip_max(W, DM, 7 * wave, 7, nb, lane, nullptr, mx);
                if (lane < 8) { LAS float* d = cmw + wave * 32 + lane * 4; d[0] = mx.x; d[1] = mx.y; d[2] = mx.z; d[3] = mx.w; }
                LDS_WAIT(); __syncthreads();
                float cm = 0.f;
#pragma unroll
                for (int w8 = 0; w8 < 8; ++w8) cm = fmaxf(cm, cmw[w8 * 32 + (lane & 31)]);
                if (wave == 0 && lane < 32) CMAX2[e * DM + nb * 32 + lane] = __float_as_uint(cm);
                strip_quant<0>(W, FF1, DM, WM2 + (size_t)e * DM * FF1, cm, scr, 7 * wave, 7, nb, lane, nullptr);
                __syncthreads();
            }
            float ssA = 0.f, ssB = 0.f;
            LAS float* Lf = (LAS float*)(L + RING_OFF);
            for (int it = vcu; it < 2 * NEXP * (FF1 / 32); it += G) {
                const int mat = it / (FF1 / 32), nb = it % (FF1 / 32), e = mat >> 1; const bool w3 = (mat & 1) != 0;
                const float* W = (w3 ? moe_w3 : moe_w1) + (size_t)e * DM * FF1;
                const int n0 = 32 * nb, kr = lane >> 3, nc = (lane & 7) * 4;
                f32x4 mx = (f32x4){0.f, 0.f, 0.f, 0.f}; float ss = 0.f;
#pragma unroll
                for (int bt = 0; bt < 2; ++bt) { f32x4 v[8];
#pragma unroll
                    for (int i = 0; i < 8; ++i) v[i] = *(const GAS f32x4*)(W + (size_t)(128 * wave + bt * 64 + i * 8 + kr) * FF1 + n0 + nc);
#pragma unroll
                    for (int i = 0; i < 8; ++i) { const int k = 128 * wave + bt * 64 + i * 8 + kr; v[i] = v[i] * gk1[k];
                        mx.x = fmaxf(mx.x, fabsf(v[i].x)); mx.y = fmaxf(mx.y, fabsf(v[i].y)); mx.z = fmaxf(mx.z, fabsf(v[i].z)); mx.w = fmaxf(mx.w, fabsf(v[i].w));
                        ss += (v[i].x * v[i].x + v[i].y * v[i].y) + (v[i].z * v[i].z + v[i].w * v[i].w);
                        LAS float* d = Lf + k * 32; const int sw = k & 31; d[(nc + 0) ^ sw] = v[i].x; d[(nc + 1) ^ sw] = v[i].y; d[(nc + 2) ^ sw] = v[i].z; d[(nc + 3) ^ sw] = v[i].w; } }
                if (w3) ssB += ss; else ssA += ss;
#pragma unroll
                for (int o = 8; o < 64; o <<= 1) { mx.x = fmaxf(mx.x, __shfl_xor(mx.x, o)); mx.y = fmaxf(mx.y, __shfl_xor(mx.y, o)); mx.z = fmaxf(mx.z, __shfl_xor(mx.z, o)); mx.w = fmaxf(mx.w, __shfl_xor(mx.w, o)); }
                if (lane < 8) { LAS float* d = cmw + wave * 32 + lane * 4; d[0] = mx.x; d[1] = mx.y; d[2] = mx.z; d[3] = mx.w; }
                LDS_WAIT(); __syncthreads();
                const int n = lane & 31, hh = lane >> 5;
                float cm = 0.f;
#pragma unroll
                for (int w8 = 0; w8 < 8; ++w8) cm = fmaxf(cm, cmw[w8 * 32 + n]);
                const int row = w3 ? maprow<4>(n0 + n) : maprow<3>(n0 + n);
                if (wave == 0 && lane < 32) CMAX13[e * 2 * FF1 + row] = __float_as_uint(cm);
                const float inv = cm > 0.f ? 127.0f / cm : 0.f;
                signed char* wt = WM13 + (size_t)e * 2 * FF1 * DM + (size_t)row * DM + 128 * wave + 64 * hh;
#pragma unroll
                for (int q16 = 0; q16 < 4; ++q16) { v4u o;
#pragma unroll
                    for (int dq = 0; dq < 4; ++dq) { unsigned pk = 0;
#pragma unroll
                        for (int b = 0; b < 4; ++b) { const int k = 128 * wave + 64 * hh + 16 * q16 + 4 * dq + b; const int q = (int)__builtin_rintf(Lf[k * 32 + (n ^ (k & 31))] * inv); pk |= (unsigned)(q & 255) << (8 * b); }
                        o[dq] = pk; }
                    *(GAS v4u*)(wt + 16 * q16) = o; }
                LDS_WAIT(); __syncthreads();
            }
            ssA = wave_sum(ssA); ssB = wave_sum(ssB);
            if (lane == 0) { __hip_atomic_fetch_add(SSTOT, (unsigned long long)(ssA * 16777216.0f), __ATOMIC_RELAXED, __HIP_MEMORY_SCOPE_AGENT); __hip_atomic_fetch_add(SSTOT + 1, (unsigned long long)(ssB * 16777216.0f), __ATOMIC_RELAXED, __HIP_MEMORY_SCOPE_AGENT); }
        }
        } SEAM(15);
    }
#define MOE_CUM() do { if (tid < 2) { int a = 0; for (int e = 0; e < 8; ++e) { MISC[16 + 9 * tid + e] = (unsigned)a; a += (int)((__hip_atomic_load(ctl + CW_MOECNT + 8 * tid + e, RLX_AGENT) + 255u) >> 8); } MISC[16 + 9 * tid + 8] = (unsigned)a; } __syncthreads(); } while (0)
    if (IN(16)) { PH_PTRS; for (int rep_ = 0; rep_ < NREP(16); ++rep_) {
        MOE_CUM();
        const int gt = (vcu * NWAVES + wave) * 64 + lane, NT_ = G * NWAVES * 64;
        for (int e = gt; e < 2 * TOK; e += NT_) { const int r = e >= TOK ? 1 : 0; const int ex = tok_e[e]; const int t_ = e - r * TOK; const int slot = (int)MISC[16 + 9 * r + ex] * 256 + wg_base[((t_ % NGW) >> 3) * 16 + r * 8 + ex] + tok_pos[e];
            slot_tok[r * SLOTS + slot] = e - r * TOK; slot_gate[r * SLOTS + slot] = tok_gate[e]; slot_sa[r * SLOTS + slot] = SA[e - r * TOK]; }
        } SEAM(16);
    }
#define MOE_SU() (8.0f * sqrtf(((float)SSTOT[0] * (5.9604644775390625e-8f / (NEXP * FF1))) * ((float)SSTOT[1] * (5.9604644775390625e-8f / (NEXP * FF1)))))
#define MOE_UP_BOTH() do { MOE_CUM(); \
        const pg8::MoeMap mp{(int)MISC[16 + 8], (const LAS int*)(L + MISC_OFF + 4 * 16)}; \
        pg8::ABMoeUp ab{(const pg8::bf16_t*)AQ, (const pg8::bf16_t*)WM13, DM / 2, slot_tok, mp, (size_t)2 * FF1 * (DM / 2)}; \
        pg8::TileOrder S; S.init((int)MISC[16 + 8] + (int)MISC[16 + 9 + 8], (2 * FF1) / 256, G, bx); \
        pg8::EpiSwiGLUQ E{UM, FF1, slot_sa, CMAX13, nullptr, mp, 127.0f / MOE_SU()}; \
        pg8::gemm_phase<pg8::EpiSwiGLUQ, pg8::ABMoeUp, GEMM_ALIGN>(L + RING_OFF, ab, S, E); } while (0)
#define MOE_DOWN_BOTH() do { MOE_CUM(); \
        const pg8::MoeMap mp{(int)MISC[16 + 8], (const LAS int*)(L + MISC_OFF + 4 * 16)}; \
        pg8::ABMoeDown ab{(const pg8::bf16_t*)UM, (const pg8::bf16_t*)WM2, FF1 / 2, mp, (size_t)DM * (FF1 / 2)}; \
        pg8::TileOrder S; S.init((int)MISC[16 + 8] + (int)MISC[16 + 9 + 8], DM / 256, G, bx); \
        pg8::EpiResBQ E{Rb, Rb, DM, slot_tok, slot_gate, CMAX2, mp, MOE_SU() * (1.0f / 127.0f), nullptr, Y1B}; \
        pg8::gemm_phase<pg8::EpiResBQ, pg8::ABMoeDown, GEMM_ALIGN>(L + RING_OFF, ab, S, E); } while (0)
    if (IN(17)) { PH_PTRS; for (int rep_ = 0; rep_ < NREP(17); ++rep_) MOE_UP_BOTH(); SEAM(17); }
    if (IN(18)) { PH_PTRS; MOE_DOWN_BOTH(); SEAM(18); }
    if (IN(21)) { PH_PTRS;
        f32x4 gv[4]; load_gain(final_norm, gv, lane);
        for (int m0 = gw; m0 < TOK; m0 += 4 * NGW) {
            unsigned long long w[4][4], y[4][4];
#pragma unroll
            for (int u = 0; u < 4; ++u) { const int m = (m0 + u * NGW < TOK) ? m0 + u * NGW : m0; const GAS unsigned long long* r8 = (const GAS unsigned long long*)(Rb + (size_t)m * DM) + lane; const GAS unsigned long long* y8 = (const GAS unsigned long long*)(Y1B + (size_t)m * DM) + lane;
#pragma unroll
                for (int j = 0; j < 4; ++j) { w[u][j] = r8[64 * j]; y[u][j] = y8[64 * j]; } }
#pragma unroll
            for (int u = 0; u < 4; ++u) { const int m = m0 + u * NGW; if (m < TOK) {
                f32x4 v[4]; float s = 0.f;
#pragma unroll
                for (int j = 0; j < 4; ++j) { const unsigned lo32 = (unsigned)w[u][j], hi32 = (unsigned)(w[u][j] >> 32), ylo = (unsigned)y[u][j], yhi = (unsigned)(y[u][j] >> 32);
                    v[j].x = __uint_as_float(lo32 << 16) + __uint_as_float(ylo << 16); v[j].y = __uint_as_float(lo32 & 0xffff0000u) + __uint_as_float(ylo & 0xffff0000u);
                    v[j].z = __uint_as_float(hi32 << 16) + __uint_as_float(yhi << 16); v[j].w = __uint_as_float(hi32 & 0xffff0000u) + __uint_as_float(yhi & 0xffff0000u);
                    s += (v[j].x * v[j].x + v[j].y * v[j].y) + (v[j].z * v[j].z + v[j].w * v[j].w); }
                const float rstd = 1.f / sqrtf(wave_sum(s) * (1.f / DM) + NORM_EPS);
                GAS f32x4* o = (GAS f32x4*)(out + (size_t)m * DM) + lane;
#pragma unroll
                for (int j = 0; j < 4; ++j) o[64 * j] = v[j] * rstd * gv[j]; } }
        }
    }
#undef IN
#undef SEAM
#undef GRID_BAR
}
constexpr int N_PHASES = 22;

extern "C" void kernel_launch(void* const* d_in, const int* in_sizes, int n_in, void* d_out, int out_size, void* d_ws, size_t ws_size, hipStream_t stream) {
    static int grid = 0;
    if (grid == 0) {
        if (n_in != 20 || in_sizes[0] != TOK * DM || out_size != TOK * DM || ws_size < WS_END) { fprintf(stderr, "kernel_launch: shape / workspace mismatch (n_in %d, in0 %d, out %d, ws %zu, need %zu); nothing launched\n", n_in, n_in > 0 ? in_sizes[0] : -1, out_size, ws_size, (size_t)WS_END); grid = -1; return; }
        int dev = 0, cus = 0, per_cu = 0;
        if (hipGetDevice(&dev) != hipSuccess || hipDeviceGetAttribute(&cus, hipDeviceAttributeMultiprocessorCount, dev) != hipSuccess) { grid = -1; return; }
        if (hipFuncSetAttribute((const void*)mk_fwd, hipFuncAttributeMaxDynamicSharedMemorySize, LDS_BYTES) != hipSuccess) { fprintf(stderr, "kernel_launch: hipFuncSetAttribute failed\n"); grid = -1; return; }
        if (hipOccupancyMaxActiveBlocksPerMultiprocessor(&per_cu, (const void*)mk_fwd, NWAVES * 64, LDS_BYTES) != hipSuccess || per_cu < 1) fprintf(stderr, "kernel_launch: occupancy query reports %d workgroups per CU\n", per_cu);
        (void)hipGetLastError();
        grid = cus;
    }
    if (grid < 0) return;
    if (hipMemsetAsync((char*)d_ws + WS_CTL, 0, CTL_ZERO_BYTES, stream) != hipSuccess) return;
    Args a{};
    for (int i = 0; i < 20; ++i) a.in[i] = (const float*)d_in[i];
    a.out = (float*)d_out; a.ws = (unsigned char*)d_ws;
    for (int i = 0; i < 8; ++i) a.inv64[i] = (float)pow(500000.0, -(double)(2 * i) / 16.0);
    for (int i = 0; i < 16; ++i) a.inv128[i] = (float)pow(500000.0, -(double)(2 * i) / 32.0);
#if MK_PER_PHASE
    for (int p = 0; p < N_PHASES; ++p) { a.ph_lo = p; a.ph_hi = p + 1; hipLaunchKernelGGL(mk_fwd, dim3(grid), dim3(NWAVES * 64), LDS_BYTES, stream, a); }
#else
    a.ph_lo = 0; a.ph_hi = N_PHASES;
    hipLaunchKernelGGL(mk_fwd, dim3(grid), dim3(NWAVES * 64), LDS_BYTES, stream, a);
#ifdef PROBE_LIST
    {
        static const int probe[] = {PROBE_LIST};
        for (int k : probe) { a.ph_lo = k; a.ph_hi = k + 1;
            a.out = (k == 3 || k == 12 || k == 13 || k == 18 || k == 21) ? (float*)((char*)d_ws + WS_QKV) : (float*)d_out;
            hipLaunchKernelGGL(mk_fwd, dim3(grid), dim3(NWAVES * 64), LDS_BYTES, stream, a); }
    }
#endif
#endif
    const hipError_t le = hipPeekAtLastError();
    if (le != hipSuccess) fprintf(stderr, "kernel_launch: launch failed: %s\n", hipGetErrorName(le));
}
```

```cpp
#include <hip/hip_runtime.h>
#include <hip/hip_bf16.h>
#include <cstdio>
#include <cstdint>
#include <cmath>
namespace pg8 {
#define PG8_LAS __attribute__((address_space(3)))
typedef unsigned short bf16_t;
typedef short bf16x8 __attribute__((ext_vector_type(8)));
typedef float f32x4 __attribute__((ext_vector_type(4)));
typedef unsigned u32x4 __attribute__((ext_vector_type(4)));
constexpr int BM = 256, BK = 64, HALF = 128, HTB = HALF * BK * 2  , STAGE_BYTES = 8 * HTB, NXCD = 8, WGM = 8;

__host__ __device__ __forceinline__ int lds_byte(int r, int c) { const int st = (r >> 4) * 2 + (c >> 5), rr = r & 15, cc = c & 31, ob = rr * 64 + cc * 2; return st * 1024 + (ob ^ (((ob >> 9) & 1) << 5)); }
__host__ __device__ __forceinline__ void stage_rc(int b, int& R, int& C) { const int st = b / 1024, sb = b % 1024, swz = sb ^ (((sb >> 9) & 1) << 5); R = (st >> 1) * 16 + swz / 64; C = (st & 1) * 32 + (swz % 64) / 2; }
__host__ __device__ __forceinline__ int perm32(int rho) { const int n = rho >> 4, i = rho & 15; return 8 * (i >> 2) + 4 * n + (i & 3); }

struct Unit { int pm, pn; };

struct TileOrder {
    int nM, nN, nwg, G, c;
    __device__ __forceinline__ void init(int nM_, int nN_, int G_, int c_) { nM = nM_; nN = nN_; nwg = nM * nN; G = G_; c = c_; }
    __device__ __forceinline__ bool next(int i, Unit& u) const {
        const long L = (long)i * G + c; if (L >= nwg) return false;
        int wgid = (int)L; { const int q = nwg / NXCD, r = nwg % NXCD, xcd = wgid % NXCD, off = wgid / NXCD; wgid = (xcd < r ? xcd * (q + 1) : r * (q + 1) + (xcd - r) * q) + off; }
        const int nig = WGM * nN, gid = wgid / nig, fm = gid * WGM, gsz = (nM - fm) < WGM ? (nM - fm) : WGM;
        u.pm = fm + ((wgid % nig) % gsz); u.pn = (wgid % nig) / gsz; return true;
    }
};

struct ABDense {
    static constexpr bool GATHER = false;
    const bf16_t* A; const bf16_t* Bt; int K;
    __device__ __forceinline__ const char* abase(const Unit& u) const { return (const char*)A + (size_t)u.pm * BM * K * 2; }
    __device__ __forceinline__ const char* bbase(const Unit& u) const { return (const char*)Bt + (size_t)u.pn * BM * K * 2; }
    __device__ __forceinline__ const int* tokp(const Unit&) const { return nullptr; }
};
struct MoeMap { int T0; const PG8_LAS int* cum;
    __device__ __forceinline__ int mt(int pm) const { return pm < T0 ? pm : pm + (136 - T0); }
    __device__ __forceinline__ int expert(int mtile) const { const int r = mtile >= 136 ? 1 : 0, loc = mtile - 136 * r; int e = 0;
#pragma unroll
        for (int k = 1; k < 8; ++k) e += (loc >= cum[9 * r + k]) ? 1 : 0; return e; }
};
struct ABMoeUp {
    static constexpr bool GATHER = true;
    const bf16_t* A; const bf16_t* Bt; int K; const int* slot_tok; MoeMap mp; size_t estride;
    __device__ __forceinline__ const char* abase(const Unit&) const { return (const char*)A; }
    __device__ __forceinline__ const char* bbase(const Unit& u) const { return (const char*)(Bt + (size_t)mp.expert(mp.mt(u.pm)) * estride) + (size_t)u.pn * BM * K * 2; }
    __device__ __forceinline__ const int* tokp(const Unit& u) const { return slot_tok + mp.mt(u.pm) * BM; }
};
struct ABMoeDown {
    static constexpr bool GATHER = false;
    const bf16_t* A; const bf16_t* Bt; int K; MoeMap mp; size_t estride;
    __device__ __forceinline__ const char* abase(const Unit& u) const { return (const char*)A + (size_t)mp.mt(u.pm) * BM * K * 2; }
    __device__ __forceinline__ const char* bbase(const Unit& u) const { return (const char*)(Bt + (size_t)mp.expert(mp.mt(u.pm)) * estride) + (size_t)u.pn * BM * K * 2; }
    __device__ __forceinline__ const int* tokp(const Unit&) const { return nullptr; }
};

__device__ __forceinline__ unsigned cvt_pk_bf16(float lo, float hi) { unsigned r; asm volatile("v_cvt_pk_bf16_f32 %0, %1, %2" : "=v"(r) : "v"(lo), "v"(hi)); return r; }

template <int DH> struct EpiQKV {
    static constexpr bool PERM = true; typedef f32x4 acc_t;
    bf16_t* O; int ldc; const float* ct; const float* st; float qscale; const unsigned long long* rss; int* kms;
    __device__ __forceinline__ void operator()(const f32x4 (&acc)[2][2][4][2], const Unit& u, int wr, int wc, int fr, int fq) const {
        constexpr int NF = DH / 8;
        const int row0 = u.pm * BM + wr * 64 + fr, col0 = u.pn * BM + wc * 32 + 8 * fq;
        const int sect = u.pn >> 2;
        const float sc = (sect == 0) ? qscale : 1.f;
        const bool rot = (sect < 2) && (DH == 64 ? (((wc & 1) == 0) && (fq < 2)) : (wc == 0));
        f32x4 ksum[2][2] = {{(f32x4){0.f, 0.f, 0.f, 0.f}, (f32x4){0.f, 0.f, 0.f, 0.f}}, {(f32x4){0.f, 0.f, 0.f, 0.f}, (f32x4){0.f, 0.f, 0.f, 0.f}}};
        unsigned long long rq[8];
#pragma unroll
        for (int i = 0; i < 8; ++i) rq[i] = rss[row0 + (i >> 2) * HALF + (i & 3) * 16];
#pragma unroll
        for (int ai = 0; ai < 2; ++ai) {
            f32x4 c4[4], s4[4];
#pragma unroll
            for (int m = 0; m < 4; ++m) { const int pos = (row0 + ai * HALF + m * 16) & 8191; c4[m] = (f32x4){1.f, 1.f, 1.f, 1.f}; s4[m] = (f32x4){0.f, 0.f, 0.f, 0.f};
                if (rot) { c4[m] = *(const f32x4*)(ct + pos * NF + 4 * fq); s4[m] = *(const f32x4*)(st + pos * NF + 4 * fq); } }
#pragma unroll
            for (int m = 0; m < 4; ++m) {
                const int row = row0 + ai * HALF + m * 16; const float rs = sc * __builtin_amdgcn_rsqf((float)rq[ai * 4 + m] * (5.9604644775390625e-8f / 1024.0f) + 1e-6f);
                bf16_t* rowp = O + (size_t)row * ldc + col0;
#pragma unroll
                for (int bj = 0; bj < 2; ++bj) {
                    const f32x4 x1 = acc[ai][bj][m][0], x2 = acc[ai][bj][m][1];
                    f32x4 v0 = (x1 * c4[m] - x2 * s4[m]) * rs, v1 = (x2 * c4[m] + x1 * s4[m]) * rs;
                    u32x4 w; w.x = cvt_pk_bf16(v0[0], v0[1]); w.y = cvt_pk_bf16(v0[2], v0[3]); w.z = cvt_pk_bf16(v1[0], v1[1]); w.w = cvt_pk_bf16(v1[2], v1[3]);
                    *(u32x4*)(rowp + bj * HALF) = w;
                    if (DH == 128) { ksum[bj][0] += v0; ksum[bj][1] += v1; } }
            }
        }
        if (DH == 128 && kms && sect == 1) {
            const int blk = u.pm;
            int* dst = kms + ((size_t)((blk >> 5) * 8 + ((u.pn & 3) * 2)) * 32 + (blk & 31)) * 128;
#pragma unroll
            for (int bj = 0; bj < 2; ++bj)
#pragma unroll
                for (int n = 0; n < 2; ++n)
#pragma unroll
                    for (int c = 0; c < 4; ++c) { float s = ksum[bj][n][c];
                        s += __shfl_xor(s, 1); s += __shfl_xor(s, 2); s += __shfl_xor(s, 4); s += __shfl_xor(s, 8);
                        if (fr == 0) __hip_atomic_fetch_add(dst + bj * 32 * 128 + wc * 32 + 8 * fq + 4 * n + c, (int)__builtin_rintf(s * 65536.0f), __ATOMIC_RELAXED, __HIP_MEMORY_SCOPE_AGENT); }
        }
    }
};

typedef int i32x4_q __attribute__((ext_vector_type(4)));
template <int DH> struct EpiQKVQ {
    static constexpr bool PERM = true; typedef i32x4_q acc_t;
    bf16_t* O; int ldc; const float* ct; const float* st; float qscale; const float* sa; const unsigned* cm; int* kms; const unsigned long long* rss;
    __device__ __forceinline__ void operator()(const i32x4_q (&acc)[2][2][4][2], const Unit& u, int wr, int wc, int fr, int fq) const {
        constexpr int NF = DH / 8;
        const int row0 = u.pm * BM + wr * 64 + fr, col0 = u.pn * BM + wc * 32 + 8 * fq;
        const int sect = u.pn >> 2;
        const float sc = (sect == 0) ? qscale : 1.f;
        const bool rot = (sect < 2) && (DH == 64 ? (((wc & 1) == 0) && (fq < 2)) : (wc == 0));
        f32x4 ksum[2][2] = {{(f32x4){0.f, 0.f, 0.f, 0.f}, (f32x4){0.f, 0.f, 0.f, 0.f}}, {(f32x4){0.f, 0.f, 0.f, 0.f}, (f32x4){0.f, 0.f, 0.f, 0.f}}};
        float cmv[2][8];
#pragma unroll
        for (int bj = 0; bj < 2; ++bj)
#pragma unroll
            for (int k = 0; k < 8; ++k) cmv[bj][k] = __uint_as_float(cm[col0 + bj * HALF + k]) * (1.0f / 127.0f);
        float rq[8];
#pragma unroll
        for (int i = 0; i < 8; ++i) { const int row = row0 + (i >> 2) * HALF + (i & 3) * 16; rq[i] = sa[row];
            if (rss) rq[i] *= (1.0f / 127.0f) * __builtin_amdgcn_rsqf((float)rss[row] * (5.9604644775390625e-8f / 1024.0f) + 1e-6f); }
#pragma unroll
        for (int ai = 0; ai < 2; ++ai) {
            f32x4 c4[4], s4[4];
#pragma unroll
            for (int m = 0; m < 4; ++m) { const int pos = (row0 + ai * HALF + m * 16) & 8191; c4[m] = (f32x4){1.f, 1.f, 1.f, 1.f}; s4[m] = (f32x4){0.f, 0.f, 0.f, 0.f};
                if (sect < 2) {
                    const int ti = rot ? pos * NF + 4 * fq : 0; const f32x4 cl = *(const f32x4*)(ct + ti), sl = *(const f32x4*)(st + ti);
                    c4[m] = rot ? cl : c4[m]; s4[m] = rot ? sl : s4[m]; } }
#pragma unroll
            for (int m = 0; m < 4; ++m) {
                const int row = row0 + ai * HALF + m * 16; const float rs = sc * rq[ai * 4 + m];
                bf16_t* rowp = O + (size_t)row * ldc + col0;
#pragma unroll
                for (int bj = 0; bj < 2; ++bj) {
                    const i32x4_q i1 = acc[ai][bj][m][0], i2 = acc[ai][bj][m][1];
                    const f32x4 x1 = (f32x4){(float)i1[0] * cmv[bj][0], (float)i1[1] * cmv[bj][1], (float)i1[2] * cmv[bj][2], (float)i1[3] * cmv[bj][3]}, x2 = (f32x4){(float)i2[0] * cmv[bj][4], (float)i2[1] * cmv[bj][5], (float)i2[2] * cmv[bj][6], (float)i2[3] * cmv[bj][7]};
                    f32x4 v0 = (x1 * c4[m] - x2 * s4[m]) * rs, v1 = (x2 * c4[m] + x1 * s4[m]) * rs;
                    u32x4 w; w.x = cvt_pk_bf16(v0[0], v0[1]); w.y = cvt_pk_bf16(v0[2], v0[3]); w.z = cvt_pk_bf16(v1[0], v1[1]); w.w = cvt_pk_bf16(v1[2], v1[3]);
                    *(u32x4*)(rowp + bj * HALF) = w;
                    if (DH == 128) { ksum[bj][0] += v0; ksum[bj][1] += v1; } }
            }
        }
        if (DH == 128 && kms && sect == 1) {
            const int blk = u.pm;
            int* dst = kms + ((size_t)((blk >> 5) * 8 + ((u.pn & 3) * 2)) * 32 + (blk & 31)) * 128;
#pragma unroll
            for (int bj = 0; bj < 2; ++bj)
#pragma unroll
                for (int n = 0; n < 2; ++n)
#pragma unroll
                    for (int c = 0; c < 4; ++c) { float s = ksum[bj][n][c];
                        s += __shfl_xor(s, 1); s += __shfl_xor(s, 2); s += __shfl_xor(s, 4); s += __shfl_xor(s, 8);
                        if (fr == 0) __hip_atomic_fetch_add(dst + bj * 32 * 128 + wc * 32 + 8 * fq + 4 * n + c, (int)__builtin_rintf(s * 65536.0f), __ATOMIC_RELAXED, __HIP_MEMORY_SCOPE_AGENT); }
        }
    }
};

__device__ __forceinline__ float silu_mul(float a, float b) { return a * b * __builtin_amdgcn_rcpf(1.0f + __builtin_amdgcn_exp2f(-1.4426950408889634f * a)); }
struct EpiSwiGLU {
    static constexpr bool PERM = true; typedef f32x4 acc_t;
    bf16_t* O; int ldc; const float* gate; const unsigned long long* rss; const int* rowmap;
    __device__ __forceinline__ void operator()(const f32x4 (&acc)[2][2][4][2], const Unit& u, int wr, int wc, int fr, int fq) const {
        const int row0 = u.pm * BM + wr * 64 + fr, col0 = u.pn * HALF + wc * 32 + 8 * fq;
#pragma unroll
        for (int ai = 0; ai < 2; ++ai)
#pragma unroll
            for (int m = 0; m < 4; ++m) {
                const int row = row0 + ai * HALF + m * 16; const float g = gate ? gate[row] : 1.f; const int trow = rowmap ? rowmap[row] : row;
                const float rs = trow >= 0 ? __builtin_amdgcn_rsqf((float)rss[trow] * (5.9604644775390625e-8f / 1024.0f) + 1e-6f) : 0.f;
                const f32x4 a0 = acc[ai][0][m][0] * rs, a1 = acc[ai][0][m][1] * rs, b0 = acc[ai][1][m][0] * rs, b1 = acc[ai][1][m][1] * rs;
                float v[8];
#pragma unroll
                for (int k = 0; k < 4; ++k) { v[k] = g * silu_mul(a0[k], b0[k]); v[4 + k] = g * silu_mul(a1[k], b1[k]); }
                u32x4 w; w.x = cvt_pk_bf16(v[0], v[1]); w.y = cvt_pk_bf16(v[2], v[3]); w.z = cvt_pk_bf16(v[4], v[5]); w.w = cvt_pk_bf16(v[6], v[7]);
                *(u32x4*)(O + (size_t)row * ldc + col0) = w; }
    }
};
struct EpiResB {
    static constexpr bool PERM = true; typedef f32x4 acc_t;
    const bf16_t* Rin; bf16_t* Rout; int ldc; const int* rowmap; unsigned long long* rss_out;
    __device__ __forceinline__ void operator()(const f32x4 (&acc)[2][2][4][2], const Unit& u, int wr, int wc, int fr, int fq) const {
        const int row0 = u.pm * BM + wr * 64 + fr, col0 = u.pn * BM + wc * 32 + 8 * fq;
        int orow[8];
#pragma unroll
        for (int i = 0; i < 8; ++i) { const int row = row0 + (i >> 2) * HALF + (i & 3) * 16; orow[i] = rowmap ? rowmap[row] : row; }
#pragma unroll
        for (int ai = 0; ai < 2; ++ai) {
            u32x4 bw[4][2];
#pragma unroll
            for (int m = 0; m < 4; ++m)
#pragma unroll
                for (int bj = 0; bj < 2; ++bj) bw[m][bj] = orow[ai * 4 + m] >= 0 ? *(const u32x4*)(Rin + (size_t)orow[ai * 4 + m] * ldc + col0 + bj * HALF) : (u32x4){0u, 0u, 0u, 0u};
#pragma unroll
            for (int m = 0; m < 4; ++m) { const int o_ = orow[ai * 4 + m]; float ss = 0.f;
                if (o_ >= 0) { bf16_t* wp = Rout + (size_t)o_ * ldc + col0;
#pragma unroll
                    for (int bj = 0; bj < 2; ++bj) { const u32x4 w = bw[m][bj]; const f32x4 a0 = acc[ai][bj][m][0], a1 = acc[ai][bj][m][1];
                        float v[8];
                        v[0] = __uint_as_float(w.x << 16) + a0[0]; v[1] = __uint_as_float(w.x & 0xffff0000u) + a0[1]; v[2] = __uint_as_float(w.y << 16) + a0[2]; v[3] = __uint_as_float(w.y & 0xffff0000u) + a0[3];
                        v[4] = __uint_as_float(w.z << 16) + a1[0]; v[5] = __uint_as_float(w.z & 0xffff0000u) + a1[1]; v[6] = __uint_as_float(w.w << 16) + a1[2]; v[7] = __uint_as_float(w.w & 0xffff0000u) + a1[3];
#pragma unroll
                        for (int k = 0; k < 8; ++k) ss += v[k] * v[k];
                        u32x4 o; o.x = cvt_pk_bf16(v[0], v[1]); o.y = cvt_pk_bf16(v[2], v[3]); o.z = cvt_pk_bf16(v[4], v[5]); o.w = cvt_pk_bf16(v[6], v[7]);
                        *(u32x4*)(wp + bj * HALF) = o; } }
                if (rss_out) { ss += __shfl_xor(ss, 16); ss += __shfl_xor(ss, 32);
                    if (fq == 0) __hip_atomic_fetch_add(rss_out + o_, (unsigned long long)(ss * 16777216.0f), __ATOMIC_RELAXED, __HIP_MEMORY_SCOPE_AGENT); } }
        }
    }
};

typedef int i32x4_e __attribute__((ext_vector_type(4)));
struct EpiSwiGLUQ {
    static constexpr bool PERM = true; typedef i32x4_e acc_t;
    signed char* O; int ldc; const float* sa; const unsigned* cm; const int* rowmap; MoeMap mp; float qmul; const unsigned long long* rss;
    __device__ __forceinline__ void operator()(const i32x4_e (&acc)[2][2][4][2], const Unit& u, int wr, int wc, int fr, int fq) const {
        const int mtile = mp.cum ? mp.mt(u.pm) : u.pm; const int e = mp.cum ? mp.expert(mtile) : 0;
        const unsigned* cme = cm + (size_t)e * 7168 + u.pn * BM + wc * 32 + 8 * fq;
        f32x4 cA[2], cAB[2];
#pragma unroll
        for (int h = 0; h < 2; ++h)
#pragma unroll
            for (int k = 0; k < 4; ++k) { cA[h][k] = __uint_as_float(cme[4 * h + k]) * (1.0f / 127.0f); cAB[h][k] = cA[h][k] * (__uint_as_float(cme[HALF + 4 * h + k]) * (1.0f / 127.0f)); }
        const int row0 = mtile * BM + wr * 64 + fr, col0 = u.pn * HALF + wc * 32 + 8 * fq;
        float srow[8];
#pragma unroll
        for (int i = 0; i < 8; ++i) { const int row = row0 + (i >> 2) * HALF + (i & 3) * 16; const int trow = rowmap ? rowmap[row] : row; srow[i] = trow >= 0 ? sa[trow] : 0.f;
            if (rss) srow[i] *= (1.0f / 127.0f) * __builtin_amdgcn_rsqf((float)rss[trow] * (5.9604644775390625e-8f / 1024.0f) + 1e-6f); }
#pragma unroll
        for (int ai = 0; ai < 2; ++ai)
#pragma unroll
            for (int m = 0; m < 4; ++m) {
                const int row = row0 + ai * HALF + m * 16; const float s = srow[ai * 4 + m];
                const float sneg = -1.4426950408889634f * s, s2q = s * s * qmul;
                unsigned pk[2];
#pragma unroll
                for (int h = 0; h < 2; ++h) {
                    const f32x4 fa = __builtin_convertvector(acc[ai][0][m][h], f32x4), fb = __builtin_convertvector(acc[ai][1][m][h], f32x4);
                    const f32x4 t = (fa * cA[h]) * sneg;
                    f32x4 e; e.x = __builtin_amdgcn_exp2f(t.x); e.y = __builtin_amdgcn_exp2f(t.y); e.z = __builtin_amdgcn_exp2f(t.z); e.w = __builtin_amdgcn_exp2f(t.w);
                    const f32x4 d = e + 1.0f;
                    f32x4 sg; sg.x = __builtin_amdgcn_rcpf(d.x); sg.y = __builtin_amdgcn_rcpf(d.y); sg.z = __builtin_amdgcn_rcpf(d.z); sg.w = __builtin_amdgcn_rcpf(d.w);
                    const f32x4 uq = (((fa * fb) * cAB[h]) * s2q) * sg + 128.0f;
                    unsigned w = 0u;
                    w = __builtin_amdgcn_cvt_pk_u8_f32(__builtin_rintf(uq.x), 0, w); w = __builtin_amdgcn_cvt_pk_u8_f32(__builtin_rintf(uq.y), 1, w);
                    w = __builtin_amdgcn_cvt_pk_u8_f32(__builtin_rintf(uq.z), 2, w); w = __builtin_amdgcn_cvt_pk_u8_f32(__builtin_rintf(uq.w), 3, w);
                    pk[h] = w ^ 0x80808080u; }
                *(unsigned long long*)(O + (size_t)row * ldc + col0) = (unsigned long long)pk[0] | ((unsigned long long)pk[1] << 32); }
    }
};
struct EpiResBQ {
    static constexpr bool PERM = true; typedef i32x4_e acc_t;
    const bf16_t* Rin; bf16_t* Rout; int ldc; const int* rowmap; const float* gate; const unsigned* cm; MoeMap mp; float dq; unsigned long long* rss_out; bf16_t* Y1; signed char* Aq; const float* amx_in; float amx_mul; unsigned* amx_out; float* qs_out;
    __device__ __forceinline__ void operator()(const i32x4_e (&acc)[2][2][4][2], const Unit& u, int wr, int wc, int fr, int fq) const {
        const int mtile = mp.cum ? mp.mt(u.pm) : u.pm; const int e = mp.cum ? mp.expert(mtile) : 0; const bool second = mp.cum && mtile >= 136;
        const int row0 = mtile * BM + wr * 64 + fr, col0 = u.pn * BM + wc * 32 + 8 * fq;
        const unsigned* cme = cm + (size_t)e * 1024 + col0;
        float sb[2][8];
#pragma unroll
        for (int bj = 0; bj < 2; ++bj)
#pragma unroll
            for (int k = 0; k < 8; ++k) sb[bj][k] = __uint_as_float(cme[bj * HALF + k]) * (dq / 127.0f);
        int orow[8]; float gts[8], qsc[8];
#pragma unroll
        for (int i = 0; i < 8; ++i) { const int row = row0 + (i >> 2) * HALF + (i & 3) * 16; orow[i] = rowmap ? rowmap[row] : row; gts[i] = gate ? gate[row] : 1.f; qsc[i] = Aq ? amx_mul * amx_in[row] : 0.f; }
#pragma unroll
        for (int ai = 0; ai < 2; ++ai) {
            u32x4 bw[4][2];
#pragma unroll
            for (int m = 0; m < 4; ++m)
#pragma unroll
                for (int bj = 0; bj < 2; ++bj) bw[m][bj] = (orow[ai * 4 + m] >= 0 && !second) ? *(const u32x4*)(Rin + (size_t)orow[ai * 4 + m] * ldc + col0 + bj * HALF) : (u32x4){0u, 0u, 0u, 0u};
#pragma unroll
            for (int m = 0; m < 4; ++m) { const int o_ = orow[ai * 4 + m]; float ss = 0.f, vmx = 0.f; const float qinv = qsc[ai * 4 + m] > 0.f ? 127.0f / qsc[ai * 4 + m] : 0.f;
                if (o_ >= 0) { const float gt = gts[ai * 4 + m]; bf16_t* wp = (second ? Y1 : Rout) + (size_t)o_ * ldc + col0;
#pragma unroll
                    for (int bj = 0; bj < 2; ++bj) { const u32x4 w = bw[m][bj]; const i32x4_e a0 = acc[ai][bj][m][0], a1 = acc[ai][bj][m][1];
                        float v[8];
                        v[0] = __uint_as_float(w.x << 16) + (float)a0[0] * gt * sb[bj][0]; v[1] = __uint_as_float(w.x & 0xffff0000u) + (float)a0[1] * gt * sb[bj][1];
                        v[2] = __uint_as_float(w.y << 16) + (float)a0[2] * gt * sb[bj][2]; v[3] = __uint_as_float(w.y & 0xffff0000u) + (float)a0[3] * gt * sb[bj][3];
                        v[4] = __uint_as_float(w.z << 16) + (float)a1[0] * gt * sb[bj][4]; v[5] = __uint_as_float(w.z & 0xffff0000u) + (float)a1[1] * gt * sb[bj][5];
                        v[6] = __uint_as_float(w.w << 16) + (float)a1[2] * gt * sb[bj][6]; v[7] = __uint_as_float(w.w & 0xffff0000u) + (float)a1[3] * gt * sb[bj][7];
#pragma unroll
                        for (int k = 0; k < 8; ++k) { ss += v[k] * v[k]; vmx = fmaxf(vmx, fabsf(v[k])); }
                        u32x4 o; o.x = cvt_pk_bf16(v[0], v[1]); o.y = cvt_pk_bf16(v[2], v[3]); o.z = cvt_pk_bf16(v[4], v[5]); o.w = cvt_pk_bf16(v[6], v[7]);
                        *(u32x4*)(wp + bj * HALF) = o;
                        if (Aq) { unsigned lo = 0u, hi = 0u;
#pragma unroll
                            for (int k = 0; k < 4; ++k) { lo = __builtin_amdgcn_cvt_pk_u8_f32(__builtin_rintf(v[k] * qinv) + 128.0f, k, lo); hi = __builtin_amdgcn_cvt_pk_u8_f32(__builtin_rintf(v[4 + k] * qinv) + 128.0f, k, hi); }
                            *(unsigned long long*)(Aq + (size_t)o_ * ldc + col0 + bj * HALF) = (unsigned long long)(lo ^ 0x80808080u) | ((unsigned long long)(hi ^ 0x80808080u) << 32); } } }
                if (rss_out) { ss += __shfl_xor(ss, 16); ss += __shfl_xor(ss, 32);
                    if (fq == 0) __hip_atomic_fetch_add(rss_out + o_, (unsigned long long)(ss * 16777216.0f), __ATOMIC_RELAXED, __HIP_MEMORY_SCOPE_AGENT); }
                if (amx_out) { vmx = fmaxf(vmx, __shfl_xor(vmx, 16)); vmx = fmaxf(vmx, __shfl_xor(vmx, 32));
                    if (fq == 0) __hip_atomic_fetch_max(amx_out + o_, __float_as_uint(vmx), __ATOMIC_RELAXED, __HIP_MEMORY_SCOPE_AGENT); }
                if (qs_out && u.pn == 0 && wc == 0 && fq == 0) qs_out[o_] = qsc[ai * 4 + m]; }
        }
    }
};
typedef int i32x4 __attribute__((ext_vector_type(4)));
__device__ __forceinline__ f32x4 mma16(bf16x8 a, bf16x8 b, f32x4 c) { return __builtin_amdgcn_mfma_f32_16x16x32_bf16(a, b, c, 0, 0, 0); }
__device__ __forceinline__ i32x4 mma16(bf16x8 a, bf16x8 b, i32x4 c) { return __builtin_amdgcn_mfma_i32_16x16x64_i8(__builtin_bit_cast(i32x4, a), __builtin_bit_cast(i32x4, b), c, 0, 0, 0); }
template <class Epi, class AB, bool ALIGN_EPI = true>
__device__ __forceinline__ void gemm_phase(PG8_LAS unsigned char* lds, const AB ab, const TileOrder& S, const Epi& E) {
    int tid = threadIdx.x; asm volatile("" : "+v"(tid));
    const int wid = __builtin_amdgcn_readfirstlane(tid >> 6), lane = tid & 63, wr = wid >> 2, wc = wid & 3, fr = lane & 15, fq = lane >> 4;
    const int K = ab.K, nt = K / BK;
    int Rr[2], Cc[2]; unsigned voffB[2];
#pragma unroll
    for (int i = 0; i < 2; ++i) { int R, C; stage_rc(tid * 16 + i * 8192, R, C); const int Rb = Epi::PERM ? ((R & ~31) + perm32(R & 31)) : R;
        Rr[i] = R; Cc[i] = C; voffB[i] = (unsigned)(Rb * K + C) * 2u; }
    const size_t kstep = (size_t)(BK * 2);
    const size_t hstep = (size_t)HALF * K * 2;
    const unsigned ldsw = (unsigned)wid * 1024u;
    const int aoff = lds_byte(wr * 64 + fr, fq * 8), boff = lds_byte(wc * 32 + fr, fq * 8);
#define PG8_SA(b, h) (((b) * 2 + (h)) * HTB)
#define PG8_SB(b, h) ((4 + (b) * 2 + (h)) * HTB)
#define PG8_STAGE(bufoff, gbase, voff) do { _Pragma("unroll") for (int _i = 0; _i < 2; ++_i) \
        __builtin_amdgcn_global_load_lds((const unsigned*)((const char*)(gbase) + (voff)[_i]), (PG8_LAS unsigned*)(lds + (bufoff) + ldsw + _i * 8192), 16, 0, 0); } while (0)
#define PG8_LDA(dst, b, h) do { _Pragma("unroll") for (int m = 0; m < 4; ++m) _Pragma("unroll") for (int k = 0; k < 2; ++k) dst[m][k] = *(const PG8_LAS bf16x8*)(lds + PG8_SA(b, h) + aoff + m * 2048 + k * 1024); } while (0)
#define PG8_LDB(dst, b, h) do { _Pragma("unroll") for (int n = 0; n < 2; ++n) _Pragma("unroll") for (int k = 0; k < 2; ++k) dst[n][k] = *(const PG8_LAS bf16x8*)(lds + PG8_SB(b, h) + boff + n * 2048 + k * 1024); } while (0)
#define PG8_MMA(ai, bj, At, Bt) do { __builtin_amdgcn_s_setprio(1); _Pragma("unroll") for (int m = 0; m < 4; ++m) _Pragma("unroll") for (int n = 0; n < 2; ++n) _Pragma("unroll") for (int k = 0; k < 2; ++k) \
        acc[ai][bj][m][n] = mma16(Bt[n][k], At[m][k], acc[ai][bj][m][n]); __builtin_amdgcn_s_setprio(0); } while (0)
#define PG8_WAIT_V(n) asm volatile("s_waitcnt vmcnt(" #n ")" ::: "memory")
#define PG8_WAIT_L(n) asm volatile("s_waitcnt lgkmcnt(" #n ")" ::: "memory")
#define PG8_BAR __builtin_amdgcn_s_barrier()
#define PG8_SCHED __builtin_amdgcn_sched_barrier(0)
    Unit cur, nxt; int ui = 0;
    if (!S.next(0, cur)) return;
    typedef typename Epi::acc_t acc_t;
    acc_t acc[2][2][4][2];
#pragma unroll
    for (int a = 0; a < 2; ++a)
#pragma unroll
        for (int b = 0; b < 2; ++b)
#pragma unroll
            for (int m = 0; m < 4; ++m)
#pragma unroll
                for (int n = 0; n < 2; ++n) acc[a][b][m][n] = (acc_t){0, 0, 0, 0};
    bf16x8 At[4][2], B0[2][2], B1[2][2];
    unsigned cv0[2], cv1[2], nv0[2], nv1[2]; int ntok[4] = {0, 0, 0, 0};
    if constexpr (AB::GATHER) { const int* tp = ab.tokp(cur);
#pragma unroll
        for (int i = 0; i < 2; ++i) { int t0 = tp[Rr[i]], t1 = tp[HALF + Rr[i]]; t0 = t0 < 0 ? 0 : t0; t1 = t1 < 0 ? 0 : t1;
            cv0[i] = (unsigned)(t0 * K + Cc[i]) * 2u; cv1[i] = (unsigned)(t1 * K + Cc[i]) * 2u; }
    } else {
#pragma unroll
        for (int i = 0; i < 2; ++i) { cv0[i] = (unsigned)(Rr[i] * K + Cc[i]) * 2u; cv1[i] = cv0[i] + (unsigned)hstep; }
    }
#pragma unroll
    for (int i = 0; i < 2; ++i) { nv0[i] = cv0[i]; nv1[i] = cv1[i]; }
    const char* cA = ab.abase(cur); const char* cB = ab.bbase(cur);
    PG8_STAGE(PG8_SB(0, 0), cB, voffB); PG8_STAGE(PG8_SB(0, 1), cB + hstep, voffB); PG8_STAGE(PG8_SA(0, 0), cA, cv0); PG8_STAGE(PG8_SA(0, 1), cA, cv1);
    if (wr == 1) PG8_BAR;
    PG8_WAIT_V(2); PG8_BAR;
    PG8_STAGE(PG8_SB(1, 0), cB + kstep, voffB); PG8_STAGE(PG8_SA(1, 0), cA + kstep, cv0); PG8_STAGE(PG8_SB(1, 1), cB + hstep + kstep, voffB);
    PG8_WAIT_V(6); PG8_BAR;
    for (;;) {
        const bool has_next = S.next(ui + 1, nxt);
        const char* nA = has_next ? ab.abase(nxt) : cA; const char* nB = has_next ? ab.bbase(nxt) : cB;
        if constexpr (AB::GATHER) {
            if (has_next) { const int* tp = ab.tokp(nxt);
                asm volatile("global_load_dword %0, %1, off" : "=v"(ntok[0]) : "v"(tp + Rr[0]) : "memory");
                asm volatile("global_load_dword %0, %1, off" : "=v"(ntok[1]) : "v"(tp + Rr[1]) : "memory");
                asm volatile("global_load_dword %0, %1, off" : "=v"(ntok[2]) : "v"(tp + HALF + Rr[0]) : "memory");
                asm volatile("global_load_dword %0, %1, off" : "=v"(ntok[3]) : "v"(tp + HALF + Rr[1]) : "memory"); }
        }
        for (int t = 0; t < nt; t += 2) {
            const bool last = (t == nt - 2);
            const char* a1 = cA + (size_t)(t + 1) * kstep;
            const char* a2 = last ? nA : cA + (size_t)(t + 2) * kstep; const char* b2 = last ? nB : cB + (size_t)(t + 2) * kstep;
            const char* a3 = a2 + kstep; const char* b3 = b2 + kstep;
            unsigned x0[2], x1[2];
            if constexpr (AB::GATHER) {
                if (last && has_next) {
                    asm volatile("s_waitcnt vmcnt(6)" : "+v"(ntok[0]), "+v"(ntok[1]), "+v"(ntok[2]), "+v"(ntok[3]) :: "memory");
#pragma unroll
                    for (int i = 0; i < 2; ++i) { int t0 = ntok[i], t1 = ntok[2 + i]; t0 = t0 < 0 ? 0 : t0; t1 = t1 < 0 ? 0 : t1;
                        nv0[i] = (unsigned)(t0 * K + Cc[i]) * 2u; nv1[i] = (unsigned)(t1 * K + Cc[i]) * 2u; }
                }
#pragma unroll
                for (int i = 0; i < 2; ++i) { x0[i] = last ? nv0[i] : cv0[i]; x1[i] = last ? nv1[i] : cv1[i]; }
            } else {
#pragma unroll
                for (int i = 0; i < 2; ++i) { x0[i] = cv0[i]; x1[i] = cv1[i]; }
            }
            PG8_LDB(B0, 0, 0); PG8_LDB(B1, 0, 1); PG8_SCHED; PG8_LDA(At, 0, 0); PG8_STAGE(PG8_SA(1, 1), a1, cv1);
            PG8_WAIT_V(8); PG8_WAIT_L(0); PG8_BAR; PG8_MMA(0, 0, At, B0); PG8_MMA(0, 1, At, B1); PG8_BAR; PG8_SCHED;
            PG8_LDA(At, 0, 1); PG8_STAGE(PG8_SB(0, 0), b2, voffB); PG8_STAGE(PG8_SB(0, 1), b2 + hstep, voffB); PG8_STAGE(PG8_SA(0, 0), a2, x0);
            PG8_WAIT_V(8); PG8_WAIT_L(0); PG8_BAR; PG8_MMA(1, 0, At, B0); PG8_MMA(1, 1, At, B1); PG8_BAR; PG8_SCHED;
            PG8_LDB(B0, 1, 0); PG8_LDB(B1, 1, 1); PG8_SCHED; PG8_LDA(At, 1, 0); PG8_STAGE(PG8_SA(0, 1), a2, x1);
            PG8_WAIT_V(8); PG8_WAIT_L(0); PG8_BAR; PG8_MMA(0, 0, At, B0); PG8_MMA(0, 1, At, B1); PG8_BAR; PG8_SCHED;
            PG8_LDA(At, 1, 1); PG8_STAGE(PG8_SB(1, 0), b3, voffB); PG8_STAGE(PG8_SB(1, 1), b3 + hstep, voffB); PG8_STAGE(PG8_SA(1, 0), a3, x0);
            PG8_WAIT_V(8); PG8_WAIT_L(0); PG8_BAR; PG8_MMA(1, 0, At, B0); PG8_MMA(1, 1, At, B1); PG8_BAR; PG8_SCHED;
        }
        if constexpr (ALIGN_EPI) { if (wr == 0) PG8_BAR; }
        E(acc, cur, wr, wc, fr, fq);
        if (!has_next) break;
#pragma unroll
        for (int a = 0; a < 2; ++a)
#pragma unroll
            for (int b = 0; b < 2; ++b)
#pragma unroll
                for (int m = 0; m < 4; ++m)
#pragma unroll
                    for (int n = 0; n < 2; ++n) acc[a][b][m][n] = (acc_t){0, 0, 0, 0};
        cur = nxt; cA = nA; cB = nB; ++ui;
#pragma unroll
        for (int i = 0; i < 2; ++i) { cv0[i] = nv0[i]; cv1[i] = nv1[i]; }
        if constexpr (ALIGN_EPI) { if (wr == 1) PG8_BAR; }
    }
    PG8_WAIT_V(0);
    if constexpr (!ALIGN_EPI) { if (wr == 0) PG8_BAR; }
    PG8_BAR;
#undef PG8_SA
#undef PG8_SB
#undef PG8_STAGE
#undef PG8_LDA
#undef PG8_LDB
#undef PG8_MMA
#undef PG8_WAIT_V
#undef PG8_WAIT_L
#undef PG8_BAR
#undef PG8_SCHED
}
}

namespace moba {
using bf16 = __hip_bfloat16;
using bf16x8 = __attribute__((ext_vector_type(8))) short;
using s16x4  = __attribute__((ext_vector_type(4))) short;
using f32x16 = __attribute__((ext_vector_type(16))) float;
using u32x4  = __attribute__((ext_vector_type(4))) unsigned;
constexpr int D = 128, NW = 8, QBLK = 32, KVBLK = 64, LDK = 3072, NT = 4;
constexpr float THR = 8.f;
constexpr size_t SHM_V = KVBLK * D * 2, SHM_K = KVBLK * D * 2, SHM_ATTN = 2 * SHM_V + 2 * SHM_K + NW * 64 * 4;
#define KSWZ(row, colB) ((row) * 256 + ((colB) ^ (((row) & 7) << 4)))
#define SBAR() __builtin_amdgcn_sched_barrier(0)
__device__ __forceinline__ int crow(int r, int hi) { return (r & 3) + 8 * (r >> 2) + 4 * hi; }
__device__ __forceinline__ unsigned cvtpk(float lo, float hi) { unsigned r; asm volatile("v_cvt_pk_bf16_f32 %0, %1, %2" : "=v"(r) : "v"(lo), "v"(hi)); return r; }
__device__ __forceinline__ void partialSM(f32x16& p0, f32x16& p1, float& m_reg, float& mn, float& alpha) {
  float pmax = p0[0];
#pragma unroll
  for (int r = 1; r < 16; ++r) pmax = fmaxf(pmax, p0[r]);
#pragma unroll
  for (int r = 0; r < 16; ++r) pmax = fmaxf(pmax, p1[r]);
  { auto rr = __builtin_amdgcn_permlane32_swap(__float_as_uint(pmax), __float_as_uint(pmax), false, false);
    pmax = fmaxf(__uint_as_float(rr[0]), __uint_as_float(rr[1])); }
  if (__builtin_expect(__all(pmax - m_reg <= THR), 1)) { mn = m_reg; alpha = 1.f; }
  else { mn = fmaxf(m_reg, pmax); alpha = __builtin_amdgcn_exp2f(m_reg - mn); m_reg = mn; }
#pragma unroll
  for (int r = 0; r < 16; ++r) p0[r] = p0[r] - mn;
#pragma unroll
  for (int r = 0; r < 16; ++r) p1[r] = p1[r] - mn;
#pragma unroll
  for (int r = 0; r < 16; ++r) p0[r] = __builtin_amdgcn_exp2f(p0[r]);
}
__device__ __forceinline__ void finishSM(f32x16& p0, f32x16& p1, float alpha, float& l_reg, bf16x8& pa0, bf16x8& pa1, bf16x8& pa2, bf16x8& pa3) {
#pragma unroll
  for (int r = 0; r < 16; ++r) p1[r] = __builtin_amdgcn_exp2f(p1[r]);
  float ps = 0;
#pragma unroll
  for (int r = 0; r < 16; ++r) ps += p0[r];
#pragma unroll
  for (int r = 0; r < 16; ++r) ps += p1[r];
  { auto rr = __builtin_amdgcn_permlane32_swap(__float_as_uint(ps), __float_as_uint(ps), false, false);
    ps = __uint_as_float(rr[0]) + __uint_as_float(rr[1]); }
  l_reg = l_reg * alpha + ps;
#define PK4(P, BASE, OUT) do { unsigned a0 = cvtpk(P[BASE + 0], P[BASE + 1]), a1 = cvtpk(P[BASE + 2], P[BASE + 3]);   \
    unsigned b0 = cvtpk(P[BASE + 4], P[BASE + 5]), b1 = cvtpk(P[BASE + 6], P[BASE + 7]);                              \
    auto r0 = __builtin_amdgcn_permlane32_swap(a0, b0, false, false); auto r1 = __builtin_amdgcn_permlane32_swap(a1, b1, false, false); \
    u32x4 w = {r0[0], r1[0], r0[1], r1[1]}; OUT = *reinterpret_cast<bf16x8*>(&w); } while (0)
  PK4(p0, 0, pa0); PK4(p0, 8, pa1); PK4(p1, 0, pa2); PK4(p1, 8, pa3);
#undef PK4
}
__device__ __forceinline__ void qkt(f32x16& p0, f32x16& p1, const bf16* Ks, const bf16x8* qr, int r32, int hi) {
  p0 = f32x16{}; p1 = f32x16{};
#pragma unroll
  for (int h2 = 0; h2 < 2; ++h2) {
    bf16x8 kf[8];
#pragma unroll
    for (int d = 0; d < 4; ++d) { int cb = ((4 * h2 + d) * 16 + hi * 8) * 2;
      kf[2 * d] = *reinterpret_cast<const bf16x8*>((const char*)Ks + KSWZ(r32, cb)); kf[2 * d + 1] = *reinterpret_cast<const bf16x8*>((const char*)Ks + KSWZ(32 + r32, cb)); }
    SBAR();
    __builtin_amdgcn_s_setprio(1);
#pragma unroll
    for (int d = 0; d < 4; ++d) { p0 = __builtin_amdgcn_mfma_f32_32x32x16_bf16(kf[2 * d], qr[4 * h2 + d], p0, 0, 0, 0); p1 = __builtin_amdgcn_mfma_f32_32x32x16_bf16(kf[2 * d + 1], qr[4 * h2 + d], p1, 0, 0, 0); }
    __builtin_amdgcn_s_setprio(0);
  }
}
__device__ __forceinline__ int v_st(int k, int c) { const int kk = (k & ~0xC) | ((k & 4) << 1) | ((k & 8) >> 1); return ((kk >> 3) * 4 + (c >> 5)) * 512 + ((kk & 7) * 32 + (c & 31)) * 2; }
__device__ __forceinline__ int v_rd_base(int lane) { return ((lane & 3) << 3) | (((lane >> 2) & 3) << 6) | (((lane >> 4) & 1) << 5) | (((lane >> 5) & 1) << 8); }
constexpr int v_rd_off(int d0, int ks, int half) { return d0 * 512 + ks * 4096 + half * 2048; }
template <int OFF> __device__ __forceinline__ s16x4 tr_read(int vb) {
  s16x4 r; asm volatile("ds_read_b64_tr_b16 %0, %1 offset:%2" : "=&v"(r) : "v"(vb), "i"(OFF) : "memory"); return r;
}
template <int D0> __device__ __forceinline__ void pv_one(f32x16& od, int vb, bf16x8 pa0, bf16x8 pa1, bf16x8 pa2, bf16x8 pa3) {
  const s16x4 l0 = tr_read<v_rd_off(D0, 0, 0)>(vb), h0 = tr_read<v_rd_off(D0, 0, 1)>(vb), l1 = tr_read<v_rd_off(D0, 1, 0)>(vb), h1 = tr_read<v_rd_off(D0, 1, 1)>(vb);
  const s16x4 l2 = tr_read<v_rd_off(D0, 2, 0)>(vb), h2 = tr_read<v_rd_off(D0, 2, 1)>(vb), l3 = tr_read<v_rd_off(D0, 3, 0)>(vb), h3 = tr_read<v_rd_off(D0, 3, 1)>(vb);
  asm volatile("s_waitcnt lgkmcnt(0)" ::: "memory"); SBAR();
  __builtin_amdgcn_s_setprio(1);
#define PK(L, H) (bf16x8){L[0], L[1], L[2], L[3], H[0], H[1], H[2], H[3]}
  od = __builtin_amdgcn_mfma_f32_32x32x16_bf16(pa0, PK(l0, h0), od, 0, 0, 0);
  od = __builtin_amdgcn_mfma_f32_32x32x16_bf16(pa1, PK(l1, h1), od, 0, 0, 0);
  od = __builtin_amdgcn_mfma_f32_32x32x16_bf16(pa2, PK(l2, h2), od, 0, 0, 0);
  od = __builtin_amdgcn_mfma_f32_32x32x16_bf16(pa3, PK(l3, h3), od, 0, 0, 0);
  __builtin_amdgcn_s_setprio(0);
#undef PK
}
__device__ __forceinline__ void pv_d0(f32x16* o, int vb, bf16x8 pa0, bf16x8 pa1, bf16x8 pa2, bf16x8 pa3) {
  pv_one<0>(o[0], vb, pa0, pa1, pa2, pa3); pv_one<1>(o[1], vb, pa0, pa1, pa2, pa3); pv_one<2>(o[2], vb, pa0, pa1, pa2, pa3); pv_one<3>(o[3], vb, pa0, pa1, pa2, pa3);
}
template <int D0> __device__ __forceinline__ void v_rd8(s16x4 (&f)[8], int vb) {
  f[0] = tr_read<v_rd_off(D0, 0, 0)>(vb); f[1] = tr_read<v_rd_off(D0, 0, 1)>(vb); f[2] = tr_read<v_rd_off(D0, 1, 0)>(vb); f[3] = tr_read<v_rd_off(D0, 1, 1)>(vb);
  f[4] = tr_read<v_rd_off(D0, 2, 0)>(vb); f[5] = tr_read<v_rd_off(D0, 2, 1)>(vb); f[6] = tr_read<v_rd_off(D0, 3, 0)>(vb); f[7] = tr_read<v_rd_off(D0, 3, 1)>(vb);
}
__device__ __forceinline__ void pv_mma4(f32x16& od, const s16x4 (&f)[8], bf16x8 pa0, bf16x8 pa1, bf16x8 pa2, bf16x8 pa3) {
#define PK(L, H) (bf16x8){L[0], L[1], L[2], L[3], H[0], H[1], H[2], H[3]}
  __builtin_amdgcn_s_setprio(1);
  od = __builtin_amdgcn_mfma_f32_32x32x16_bf16(pa0, PK(f[0], f[1]), od, 0, 0, 0);
  od = __builtin_amdgcn_mfma_f32_32x32x16_bf16(pa1, PK(f[2], f[3]), od, 0, 0, 0);
  od = __builtin_amdgcn_mfma_f32_32x32x16_bf16(pa2, PK(f[4], f[5]), od, 0, 0, 0);
  od = __builtin_amdgcn_mfma_f32_32x32x16_bf16(pa3, PK(f[6], f[7]), od, 0, 0, 0);
  __builtin_amdgcn_s_setprio(0);
#undef PK
}
__device__ __forceinline__ void pv_d0p(f32x16* o, int vb, bf16x8 pa0, bf16x8 pa1, bf16x8 pa2, bf16x8 pa3) {
  s16x4 fa[8], fb[8];
  v_rd8<0>(fa, vb); v_rd8<1>(fb, vb);
  asm volatile("s_waitcnt lgkmcnt(8)" ::: "memory"); SBAR(); pv_mma4(o[0], fa, pa0, pa1, pa2, pa3); SBAR();
  v_rd8<2>(fa, vb);
  asm volatile("s_waitcnt lgkmcnt(8)" ::: "memory"); SBAR(); pv_mma4(o[1], fb, pa0, pa1, pa2, pa3); SBAR();
  v_rd8<3>(fb, vb);
  asm volatile("s_waitcnt lgkmcnt(8)" ::: "memory"); SBAR(); pv_mma4(o[2], fa, pa0, pa1, pa2, pa3); SBAR();
  asm volatile("s_waitcnt lgkmcnt(0)" ::: "memory"); SBAR(); pv_mma4(o[3], fb, pa0, pa1, pa2, pa3); SBAR();
}
__device__ __forceinline__ void cmask(f32x16& p0, f32x16& p1, int tile, int ql, int hi) {
  asm volatile("" : "+v"(ql));
#pragma unroll
  for (int r = 0; r < 16; ++r) { const int kv = 64 * tile + (r & 3) + 8 * (r >> 2) + 4 * hi; if (kv > ql) p0[r] = -1e30f; if (kv + 32 > ql) p1[r] = -1e30f; }
}
__device__ __forceinline__ void moba_unit(const bool OWN, const bf16* qrow, const bf16* __restrict__ Kh, const bf16* __restrict__ Vh, bf16* obase, int ostride, int dst, float* ml, int mli, int ql, char* lds) {
  const int tid = threadIdx.x, wid = tid >> 6, lane = tid & 63, r32 = lane & 31, hi = lane >> 5;
  bf16* V_lds = (bf16*)lds; bf16* K_lds = (bf16*)(lds + 2 * SHM_V);
  float* ws = (float*)(lds + 2 * SHM_V + 2 * SHM_K) + wid * 64; float* li_l = ws; float* al_l = ws + 32;
  float m_reg = -1e30f, l_reg = 0; f32x16 o[4] = {}; bf16x8 qr[8];
  const bf16* Qw = qrow + hi * 8;
#pragma unroll
  for (int d0 = 0; d0 < 8; ++d0) qr[d0] = *reinterpret_cast<const bf16x8*>(Qw + d0 * 16);
  const int sr = tid >> 4, sc = (tid & 15) * 8, vst0 = v_st(sr, sc), vst1 = v_st(32 + sr, sc);
  const int vb0 = (int)(uintptr_t)V_lds + v_rd_base(lane);
  struct { bf16x8 vs0, vs1, ks0, ks1; } sr_[2];
#define SLOAD(i, k0) do { sr_[i].vs0 = *reinterpret_cast<const bf16x8*>(&Vh[(long)((k0) + sr) * LDK + sc]); sr_[i].vs1 = *reinterpret_cast<const bf16x8*>(&Vh[(long)((k0) + 32 + sr) * LDK + sc]); \
    sr_[i].ks0 = *reinterpret_cast<const bf16x8*>(&Kh[(long)((k0) + sr) * LDK + sc]); sr_[i].ks1 = *reinterpret_cast<const bf16x8*>(&Kh[(long)((k0) + 32 + sr) * LDK + sc]); } while (0)
#define SWRITE(b, i) do { *(bf16x8*)((char*)V_lds + (b) * SHM_V + vst0) = sr_[i].vs0;          \
    *(bf16x8*)((char*)V_lds + (b) * SHM_V + vst1) = sr_[i].vs1; int kc = sc * 2;               \
    *(bf16x8*)((char*)K_lds + (b) * SHM_K + KSWZ(sr, kc)) = sr_[i].ks0;                       \
    *(bf16x8*)((char*)K_lds + (b) * SHM_K + KSWZ(32 + sr, kc)) = sr_[i].ks1; } while (0)
#define SWAIT() asm volatile("s_waitcnt vmcnt(4)" ::: "memory")
#define RESC(a) do { if (__any((a) < 1.f)) { if (hi == 0) al_l[r32] = (a); asm volatile("s_waitcnt lgkmcnt(0)" ::: "memory"); \
    _Pragma("unroll") for (int d = 0; d < 4; ++d) _Pragma("unroll") for (int r = 0; r < 16; ++r) o[d][r] *= al_l[crow(r, hi)]; } } while (0)
  f32x16 pA0, pA1, pB0, pB1; float mnA, mnB, alA, alB; bf16x8 pa0, pa1, pa2, pa3;
  constexpr int SE = 0, SO = 1;
  SLOAD(SE, 0); asm volatile("s_waitcnt vmcnt(0)" ::: "memory"); SWRITE(0, SE); __syncthreads();
  qkt(pA0, pA1, K_lds, qr, r32, hi); if (OWN) cmask(pA0, pA1, 0, ql, hi); partialSM(pA0, pA1, m_reg, mnA, alA);
  SLOAD(SO, KVBLK); SLOAD(SE, 2 * KVBLK);
  SWAIT(); SWRITE(1, SO); __syncthreads();
  {
    SBAR(); qkt(pB0, pB1, (bf16*)((char*)K_lds + SHM_K), qr, r32, hi);
    finishSM(pA0, pA1, alA, l_reg, pa0, pa1, pa2, pa3); SBAR();
    SLOAD(SO, 3 * KVBLK); SBAR();
    pv_d0(o, vb0, pa0, pa1, pa2, pa3); if (OWN) cmask(pB0, pB1, 1, ql, hi); partialSM(pB0, pB1, m_reg, mnB, alB);
    __syncthreads(); SWAIT(); SWRITE(0, SE);
    RESC(alB); __syncthreads();
    SBAR(); qkt(pA0, pA1, K_lds, qr, r32, hi);
    finishSM(pB0, pB1, alB, l_reg, pa0, pa1, pa2, pa3); SBAR();
    pv_d0(o, vb0 + (int)SHM_V, pa0, pa1, pa2, pa3); if (OWN) cmask(pA0, pA1, 2, ql, hi); partialSM(pA0, pA1, m_reg, mnA, alA);
    __syncthreads(); asm volatile("s_waitcnt vmcnt(0)" ::: "memory"); SWRITE(1, SO);
    RESC(alA); __syncthreads();
  }
  SBAR(); qkt(pB0, pB1, (bf16*)((char*)K_lds + SHM_K), qr, r32, hi);
  finishSM(pA0, pA1, alA, l_reg, pa0, pa1, pa2, pa3); SBAR();
  pv_d0(o, vb0, pa0, pa1, pa2, pa3); if (OWN) cmask(pB0, pB1, 3, ql, hi); partialSM(pB0, pB1, m_reg, mnB, alB);
  __syncthreads(); RESC(alB);
  finishSM(pB0, pB1, alB, l_reg, pa0, pa1, pa2, pa3); SBAR();
  pv_d0(o, vb0 + (int)SHM_V, pa0, pa1, pa2, pa3);
  if (hi == 0) li_l[r32] = l_reg; asm volatile("s_waitcnt lgkmcnt(0)" ::: "memory");
  float rli[16];
#pragma unroll
  for (int r = 0; r < 16; ++r) rli[r] = __builtin_amdgcn_rcpf(li_l[crow(r, hi)]);
  __syncthreads();
  bf16* stg = (bf16*)lds + wid * 4096;
#pragma unroll
  for (int r = 0; r < 16; ++r) { const int orow = crow(r, hi);
#pragma unroll
    for (int d0 = 0; d0 < 4; ++d0) stg[orow * 128 + d0 * 32 + r32] = __float2bfloat16(o[d0][r] * rli[r]); }
  int* dsto = (int*)al_l;
  if (hi == 0) dsto[r32] = dst;
  asm volatile("s_waitcnt lgkmcnt(0)" ::: "memory");
#pragma unroll
  for (int i = 0; i < 8; ++i) { const int row = i * 4 + (lane >> 4), ch = lane & 15; const int di = dsto[row]; const u32x4 v = *(const u32x4*)(stg + row * 128 + ch * 8);
    if (di >= 0) *(u32x4*)(obase + (size_t)di * ostride + ch * 8) = v; }
  if (hi == 0 && dst >= 0) { ml[2 * (size_t)mli] = m_reg; ml[2 * (size_t)mli + 1] = l_reg; }
  asm volatile("s_waitcnt lgkmcnt(0)" ::: "memory");
  __syncthreads();
#undef SLOAD
#undef SWRITE
#undef SWAIT
#undef RESC
}

constexpr int MB2_K = 0, MB2_V = 65536, MB2_WV = 132096, MB2_WVB = 2560;
__device__ __forceinline__ void mb2_glds16(const void* gsrc, unsigned lds_dst) { unsigned keep;
  asm volatile("s_mov_b32 %0, m0\n\ts_mov_b32 m0, %2\n\ts_nop 0\n\tglobal_load_lds_dwordx4 %1, off\n\ts_mov_b32 m0, %0" : "=&s"(keep) : "v"(gsrc), "s"(lds_dst) : "memory"); }
__device__ __forceinline__ void moba_load_block(const bf16* __restrict__ Kh, const bf16* __restrict__ Vh, char* lds) {
  int tid = threadIdx.x; asm volatile("" : "+v"(tid)); const int lane = tid & 63; const int wid = __builtin_amdgcn_readfirstlane(tid >> 6);
  const unsigned lds0 = (unsigned)(uintptr_t)lds;
#pragma unroll
  for (int i = 0; i < 8; ++i) { const int p = wid + 8 * i; const int row = 4 * p + (lane >> 4), ch = (lane & 15) ^ (row & 7);
    mb2_glds16(Kh + (long)row * LDK + ch * 8, (unsigned)__builtin_amdgcn_readfirstlane(lds0 + MB2_K + p * 1024)); }
#pragma unroll
  for (int i = 0; i < 8; ++i) { const int q = wid + 8 * i, t = q >> 4, pi = q & 15; const int off = pi * 1024 + lane * 16, sub = off >> 9, within = (off & 511) >> 1;
    const int kk = (sub >> 2) * 8 + (within >> 5), c = (sub & 3) * 32 + (within & 31), k = (kk & ~0xC) | ((kk & 4) << 1) | ((kk & 8) >> 1);
    mb2_glds16(Vh + (long)(64 * t + k) * LDK + c, (unsigned)__builtin_amdgcn_readfirstlane(lds0 + MB2_V + q * 1024)); }
}
template <bool own> __device__ __forceinline__ void moba_sub(const int tmax, const bf16* qrow, bf16* obase, int ostride, int dst, float* ml, int mli, int ql, char* lds, int wid) {
  int tid = threadIdx.x; asm volatile("" : "+v"(tid)); const int lane = tid & 63, r32 = lane & 31, hi = lane >> 5;
  const bf16* K_lds = (const bf16*)(lds + MB2_K);
  bf16* stg = (bf16*)(lds + MB2_WV + wid * MB2_WVB); float* ws = (float*)(lds + MB2_WV + wid * MB2_WVB + 2048); float* li_l = ws; float* al_l = ws + 32;
  const int vb0 = (int)(uintptr_t)(lds + MB2_V) + v_rd_base(lane);
  float m_reg = -1e30f, l_reg = 0; f32x16 o[4] = {}; bf16x8 qr[8];
  const bf16* Qw = qrow + hi * 8;
#pragma unroll
  for (int d0 = 0; d0 < 8; ++d0) qr[d0] = *reinterpret_cast<const bf16x8*>(Qw + d0 * 16);
#define RESC(a) do { if (__any((a) < 1.f)) { if (hi == 0) al_l[r32] = (a); asm volatile("s_waitcnt lgkmcnt(0)" ::: "memory"); \
    _Pragma("unroll") for (int d = 0; d < 4; ++d) _Pragma("unroll") for (int r = 0; r < 16; ++r) o[d][r] *= al_l[crow(r, hi)]; } } while (0)
#define KT(t) ((const bf16*)((const char*)K_lds + (t) * SHM_K))
#define VT(t) (vb0 + (t) * (int)SHM_V)
  f32x16 pA0, pA1, pB0, pB1; float mnA, mnB, alA, alB; bf16x8 pa0, pa1, pa2, pa3;
  qkt(pA0, pA1, KT(0), qr, r32, hi); if (own) cmask(pA0, pA1, 0, ql, hi); partialSM(pA0, pA1, m_reg, mnA, alA);
  SBAR(); qkt(pB0, pB1, KT(1), qr, r32, hi); finishSM(pA0, pA1, alA, l_reg, pa0, pa1, pa2, pa3); SBAR();
  pv_d0p(o, VT(0), pa0, pa1, pa2, pa3); if (own) cmask(pB0, pB1, 1, ql, hi); partialSM(pB0, pB1, m_reg, mnB, alB); RESC(alB);
  SBAR(); qkt(pA0, pA1, KT(2), qr, r32, hi); finishSM(pB0, pB1, alB, l_reg, pa0, pa1, pa2, pa3); SBAR();
  pv_d0p(o, VT(1), pa0, pa1, pa2, pa3); if (own) cmask(pA0, pA1, 2, ql, hi); partialSM(pA0, pA1, m_reg, mnA, alA); RESC(alA);
  SBAR(); qkt(pB0, pB1, KT(3), qr, r32, hi); finishSM(pA0, pA1, alA, l_reg, pa0, pa1, pa2, pa3); SBAR();
  pv_d0p(o, VT(2), pa0, pa1, pa2, pa3); if (own) cmask(pB0, pB1, 3, ql, hi); partialSM(pB0, pB1, m_reg, mnB, alB); RESC(alB);
  finishSM(pB0, pB1, alB, l_reg, pa0, pa1, pa2, pa3); SBAR(); pv_d0p(o, VT(3), pa0, pa1, pa2, pa3);
  (void)tmax;
  if (hi == 0) { li_l[r32] = l_reg; ((int*)al_l)[r32] = dst; } asm volatile("s_waitcnt lgkmcnt(0)" ::: "memory");
  float rli[16];
#pragma unroll
  for (int r = 0; r < 16; ++r) rli[r] = __builtin_amdgcn_rcpf(li_l[crow(r, hi)]);
#pragma unroll
  for (int g = 0; g < 4; ++g) {
#pragma unroll
    for (int rr = 0; rr < 4; ++rr)
#pragma unroll
      for (int d0 = 0; d0 < 4; ++d0) stg[(4 * hi + rr) * 128 + d0 * 32 + r32] = __float2bfloat16(o[d0][4 * g + rr] * rli[4 * g + rr]);
    asm volatile("s_waitcnt lgkmcnt(0)" ::: "memory");
#pragma unroll
    for (int i = 0; i < 2; ++i) { const int pc = i * 64 + lane, rl = pc >> 4, ch = pc & 15; const int di = ((const int*)al_l)[8 * g + rl]; const u32x4 v = *(const u32x4*)(stg + rl * 128 + ch * 8);
      if (di >= 0) *(u32x4*)(obase + (size_t)di * ostride + ch * 8) = v; }
    asm volatile("s_waitcnt lgkmcnt(0)" ::: "memory");
  }
  if (hi == 0 && dst >= 0) { ml[2 * (size_t)mli] = m_reg; ml[2 * (size_t)mli + 1] = l_reg; }
#undef RESC
#undef KT
#undef VT
}

#define KSWZ64(row, colB) ((row) * 128 + ((colB) ^ ((((row) >> 1) & 7) << 4)))
constexpr size_t DA_SHM_K = 64 * 64 * 2;
constexpr size_t DA_SHM = 2 * SHM_V + 2 * DA_SHM_K + NW * 64 * 4;
__device__ __forceinline__ void qkt64(f32x16& p0, f32x16& p1, const bf16* Ks, const bf16x8* qr, int r32, int hi) {
  p0 = f32x16{}; p1 = f32x16{};
#pragma unroll
  for (int d0 = 0; d0 < 4; ++d0) { int cb = (d0 * 16 + hi * 8) * 2;
    bf16x8 b0 = *reinterpret_cast<const bf16x8*>((const char*)Ks + KSWZ64(r32, cb));
    bf16x8 b1 = *reinterpret_cast<const bf16x8*>((const char*)Ks + KSWZ64(32 + r32, cb));
    p0 = __builtin_amdgcn_mfma_f32_32x32x16_bf16(b0, qr[d0], p0, 0, 0, 0);
    p1 = __builtin_amdgcn_mfma_f32_32x32x16_bf16(b1, qr[d0], p1, 0, 0, 0); }
}
__device__ __forceinline__ void dattn_unit(const bf16* Qb, const bf16* __restrict__ Kh, const bf16* __restrict__ Vh, bf16* Ob, const int NT, char* lds) {
  const int tid = threadIdx.x, wid = tid >> 6, lane = tid & 63, r32 = lane & 31, hi = lane >> 5;
  bf16* V_lds = (bf16*)lds; bf16* K_lds = (bf16*)(lds + 2 * SHM_V);
  float* ws = (float*)(lds + 2 * SHM_V + 2 * DA_SHM_K) + wid * 64; float* li_l = ws; float* al_l = ws + 32;
  float m_reg = -1e30f, l_reg = 0; f32x16 o[4] = {}; bf16x8 qr[4];
  const bf16* Qw = Qb + (long)(wid * QBLK + r32) * LDK + hi * 8;
#pragma unroll
  for (int d0 = 0; d0 < 4; ++d0) qr[d0] = *reinterpret_cast<const bf16x8*>(Qw + d0 * 16);
  const int sr = tid >> 4, sc = (tid & 15) * 8, vst0 = v_st(sr, sc), vst1 = v_st(32 + sr, sc);
  const int kr = tid >> 3, kc = (tid & 7) * 8, kst = KSWZ64(kr, kc * 2);
  const int vb0 = (int)(uintptr_t)V_lds + v_rd_base(lane);
  const int ql = wid * QBLK + r32;
  struct { bf16x8 vs0, vs1, ks; } sr_[2];
#define SLOAD(i, k0) do { sr_[i].vs0 = *reinterpret_cast<const bf16x8*>(&Vh[(long)((k0) + sr) * LDK + sc]); sr_[i].vs1 = *reinterpret_cast<const bf16x8*>(&Vh[(long)((k0) + 32 + sr) * LDK + sc]); \
    sr_[i].ks = *reinterpret_cast<const bf16x8*>(&Kh[(long)((k0) + kr) * LDK + kc]); } while (0)
#define SWRITE(b, i) do { *(bf16x8*)((char*)V_lds + (b) * SHM_V + vst0) = sr_[i].vs0; *(bf16x8*)((char*)V_lds + (b) * SHM_V + vst1) = sr_[i].vs1; \
    *(bf16x8*)((char*)K_lds + (b) * DA_SHM_K + kst) = sr_[i].ks; } while (0)
#define SWAIT() asm volatile("s_waitcnt vmcnt(3)" ::: "memory")
#define RESC(a) do { if (__any((a) < 1.f)) { if (hi == 0) al_l[r32] = (a); asm volatile("s_waitcnt lgkmcnt(0)" ::: "memory"); \
    _Pragma("unroll") for (int d = 0; d < 4; ++d) _Pragma("unroll") for (int r = 0; r < 16; ++r) o[d][r] *= al_l[crow(r, hi)]; } } while (0)
#define MASK(P0, P1, t) do { if ((t) >= NT - 4) cmask(P0, P1, (t) - (NT - 4), ql, hi); } while (0)
  f32x16 pA0, pA1, pB0, pB1; float mnA, mnB, alA, alB; bf16x8 pa0, pa1, pa2, pa3;
  constexpr int SE = 0, SO = 1;
  SLOAD(SE, 0); asm volatile("s_waitcnt vmcnt(0)" ::: "memory"); SWRITE(0, SE); __syncthreads();
  qkt64(pA0, pA1, K_lds, qr, r32, hi); MASK(pA0, pA1, 0); partialSM(pA0, pA1, m_reg, mnA, alA);
  SLOAD(SO, KVBLK); SLOAD(SE, 2 * KVBLK);
  SWAIT(); SWRITE(1, SO); __syncthreads();
  for (int j = 1; j + 1 < NT; j += 2) {
    SBAR(); qkt64(pB0, pB1, (bf16*)((char*)K_lds + DA_SHM_K), qr, r32, hi);
    finishSM(pA0, pA1, alA, l_reg, pa0, pa1, pa2, pa3); SBAR();
    SLOAD(SO, (j + 2) * KVBLK); SBAR();
    pv_d0(o, vb0, pa0, pa1, pa2, pa3); MASK(pB0, pB1, j); partialSM(pB0, pB1, m_reg, mnB, alB);
    __syncthreads(); SWAIT(); SWRITE(0, SE);
    RESC(alB); __syncthreads();
    SBAR(); qkt64(pA0, pA1, K_lds, qr, r32, hi);
    finishSM(pB0, pB1, alB, l_reg, pa0, pa1, pa2, pa3); SBAR();
    if (j + 3 < NT) SLOAD(SE, (j + 3) * KVBLK); SBAR();
    pv_d0(o, vb0 + (int)SHM_V, pa0, pa1, pa2, pa3); MASK(pA0, pA1, j + 1); partialSM(pA0, pA1, m_reg, mnA, alA);
    __syncthreads(); SWAIT(); SWRITE(1, SO);
    RESC(alA); __syncthreads();
  }
  SBAR(); qkt64(pB0, pB1, (bf16*)((char*)K_lds + DA_SHM_K), qr, r32, hi);
  finishSM(pA0, pA1, alA, l_reg, pa0, pa1, pa2, pa3); SBAR();
  pv_d0(o, vb0, pa0, pa1, pa2, pa3); MASK(pB0, pB1, NT - 1); partialSM(pB0, pB1, m_reg, mnB, alB);
  __syncthreads(); RESC(alB);
  finishSM(pB0, pB1, alB, l_reg, pa0, pa1, pa2, pa3); SBAR();
  pv_d0(o, vb0 + (int)SHM_V, pa0, pa1, pa2, pa3);
  if (hi == 0) li_l[r32] = l_reg; asm volatile("s_waitcnt lgkmcnt(0)" ::: "memory");
  float rli[16];
#pragma unroll
  for (int r = 0; r < 16; ++r) rli[r] = __builtin_amdgcn_rcpf(li_l[crow(r, hi)]);
  __syncthreads();
  bf16* stg = (bf16*)lds + wid * 4096;
#pragma unroll
  for (int r = 0; r < 16; ++r) { const int orow = crow(r, hi);
#pragma unroll
    for (int d0 = 0; d0 < 4; ++d0) stg[orow * 128 + d0 * 32 + r32] = __float2bfloat16(o[d0][r] * rli[r]); }
  asm volatile("s_waitcnt lgkmcnt(0)" ::: "memory");
#pragma unroll
  for (int i = 0; i < 8; ++i) { const int row = i * 4 + (lane >> 4), ch = lane & 15; const u32x4 v = *(const u32x4*)(stg + row * 128 + ch * 8);
    *(u32x4*)(Ob + (size_t)(wid * QBLK + row) * 2048 + ch * 8) = v; }
  asm volatile("s_waitcnt lgkmcnt(0)" ::: "memory");
  __syncthreads();
#undef SLOAD
#undef SWRITE
#undef SWAIT
#undef RESC
#undef MASK
}

__device__ __forceinline__ void glds16(const void* gsrc, unsigned lds_dst) { unsigned keep;
  asm volatile("s_mov_b32 %0, m0\n\ts_mov_b32 m0, %2\n\ts_nop 0\n\tglobal_load_lds_dwordx4 %1, off\n\ts_mov_b32 m0, %0" : "=&s"(keep) : "v"(gsrc), "s"(lds_dst) : "memory"); }
#define WAIT_BAR(N) asm volatile("s_waitcnt vmcnt(" #N ") lgkmcnt(0)\n\ts_barrier" ::: "memory")
constexpr int DA2_STG = 24576;
constexpr size_t DA2_SHM = 3 * DA2_STG + NW * 64 * 4;
__device__ __forceinline__ void qkt64m(f32x16& p0, f32x16& p1, const bf16* Ks, const bf16x8* qr, bf16x8 qm, bf16x8 kneg, int r32, int hi) {
  __builtin_amdgcn_s_setprio(1);
  p0 = __builtin_amdgcn_mfma_f32_32x32x16_bf16(kneg, qm, f32x16{}, 0, 0, 0); p1 = p0;
#pragma unroll
  for (int d0 = 0; d0 < 4; ++d0) { int cb = (d0 * 16 + hi * 8) * 2;
    bf16x8 b0 = *reinterpret_cast<const bf16x8*>((const char*)Ks + KSWZ64(r32, cb));
    bf16x8 b1 = *reinterpret_cast<const bf16x8*>((const char*)Ks + KSWZ64(32 + r32, cb));
    p0 = __builtin_amdgcn_mfma_f32_32x32x16_bf16(b0, qr[d0], p0, 0, 0, 0);
    p1 = __builtin_amdgcn_mfma_f32_32x32x16_bf16(b1, qr[d0], p1, 0, 0, 0); }
  __builtin_amdgcn_s_setprio(0);
}
__device__ __forceinline__ void partialSM2(f32x16& p0, f32x16& p1, float& m_ref, bf16x8& qm, float& alpha, const bool first, const int hi) {
  float pmax = p0[0];
#pragma unroll
  for (int r = 1; r < 16; ++r) pmax = fmaxf(pmax, p0[r]);
#pragma unroll
  for (int r = 0; r < 16; ++r) pmax = fmaxf(pmax, p1[r]);
  { auto rr = __builtin_amdgcn_permlane32_swap(__float_as_uint(pmax), __float_as_uint(pmax), false, false);
    pmax = fmaxf(__uint_as_float(rr[0]), __uint_as_float(rr[1])); }
  alpha = 1.f;
  if (__builtin_expect(first || __any(pmax > THR), 0)) {
    const bool upd = first || (pmax > THR);
    const float mn = m_ref + pmax; const unsigned b = __float_as_uint(mn);
    const float mup = __uint_as_float(mn >= 0.f ? ((b + 0xFFFFu) & 0xFFFF0000u) : (b & 0xFFFF0000u));
    const float mnew = upd ? mup : m_ref; const float delta = mnew - m_ref;
    m_ref = mnew; alpha = __builtin_amdgcn_exp2f(-delta);
#pragma unroll
    for (int r = 0; r < 16; ++r) { p0[r] -= delta; p1[r] -= delta; }
    qm[0] = (hi == 0) ? (short)(__float_as_uint(m_ref) >> 16) : (short)0;
  }
#pragma unroll
  for (int r = 0; r < 16; ++r) p0[r] = __builtin_amdgcn_exp2f(p0[r]);
}
__device__ __forceinline__ void dattn_unit2(const bf16* Qb, const bf16* __restrict__ Kh, const bf16* __restrict__ Vh, bf16* Ob, const int NT, char* lds) {
  int tid = threadIdx.x; asm volatile("" : "+v"(tid)); const int lane = tid & 63, r32 = lane & 31, hi = lane >> 5; const int wid = __builtin_amdgcn_readfirstlane(tid >> 6);
  const unsigned lds0 = (unsigned)(uintptr_t)lds;
  float* ws = (float*)(lds + 3 * DA2_STG) + wid * 64; float* li_l = ws; float* al_l = ws + 32;
  const int krow = 8 * wid + (lane >> 3), kch = (lane & 7) ^ ((krow >> 1) & 7);
  const bf16* ksrc = Kh + (long)krow * LDK + kch * 8;
  const bf16* vsrc[2];
#pragma unroll
  for (int i = 0; i < 2; ++i) { const int off = (i * 8 + wid) * 1024 + lane * 16, sub = off >> 9, within = (off & 511) >> 1;
    const int kk = (sub >> 2) * 8 + (within >> 5), c = (sub & 3) * 32 + (within & 31), k = (kk & ~0xC) | ((kk & 4) << 1) | ((kk & 8) >> 1);
    vsrc[i] = Vh + (long)k * LDK + c; }
  const unsigned kdst = lds0 + wid * 1024, vdst = lds0 + 8192 + wid * 1024;
#define DMA(t, st) do { const long go_ = (long)(t) * KVBLK * LDK; glds16(ksrc + go_, (unsigned)__builtin_amdgcn_readfirstlane(kdst + (st))); \
    glds16(vsrc[0] + go_, (unsigned)__builtin_amdgcn_readfirstlane(vdst + (st))); glds16(vsrc[1] + go_, (unsigned)__builtin_amdgcn_readfirstlane(vdst + 8192 + (st))); } while (0)
  DMA(0, 0);
  float m_ref = 0.f, l_reg = 0.f; f32x16 o[4] = {}; bf16x8 qr[4]; bf16x8 qm = {0, 0, 0, 0, 0, 0, 0, 0};
  const bf16x8 kneg = {(short)(hi == 0 ? (short)0xBF80 : (short)0), 0, 0, 0, 0, 0, 0, 0};
  const bf16* Qw = Qb + (long)(wid * QBLK + r32) * LDK + hi * 8;
#pragma unroll
  for (int d0 = 0; d0 < 4; ++d0) qr[d0] = *reinterpret_cast<const bf16x8*>(Qw + d0 * 16);
  const int ql = wid * QBLK + r32;
#define RESC(a) do { if (__any((a) < 1.f)) { if (hi == 0) al_l[r32] = (a); asm volatile("s_waitcnt lgkmcnt(0)" ::: "memory"); \
    _Pragma("unroll") for (int d = 0; d < 4; ++d) _Pragma("unroll") for (int r = 0; r < 16; ++r) o[d][r] *= al_l[crow(r, hi)]; } } while (0)
#define MASK(P0, P1, t) do { if ((t) >= NT - 4) cmask(P0, P1, (t) - (NT - 4), ql, hi); } while (0)
#define KST(sx) ((const bf16*)(lds + (sx)))
#define VST(sx) ((int)(lds0 + 8192 + (sx)) + v_rd_base(lane))
  f32x16 pA0, pA1, pB0, pB1; float alA, alB; bf16x8 pa0, pa1, pa2, pa3;
  int s0 = 0, s1 = DA2_STG, s2 = 2 * DA2_STG;
  WAIT_BAR(0);
  DMA(1, DA2_STG);
  qkt64m(pA0, pA1, KST(0), qr, qm, kneg, r32, hi); MASK(pA0, pA1, 0); partialSM2(pA0, pA1, m_ref, qm, alA, true, hi);
  WAIT_BAR(2);
  DMA(2, 2 * DA2_STG);
  for (int j = 1; j + 1 < NT; j += 2) {
    SBAR(); qkt64m(pB0, pB1, KST(s1), qr, qm, kneg, r32, hi);
    finishSM(pA0, pA1, alA, l_reg, pa0, pa1, pa2, pa3); SBAR();
    pv_d0(o, VST(s0), pa0, pa1, pa2, pa3); MASK(pB0, pB1, j); partialSM2(pB0, pB1, m_ref, qm, alB, false, hi);
    WAIT_BAR(2);
    if (j + 2 < NT) DMA(j + 2, s0);
    RESC(alB);
    SBAR(); qkt64m(pA0, pA1, KST(s2), qr, qm, kneg, r32, hi);
    finishSM(pB0, pB1, alB, l_reg, pa0, pa1, pa2, pa3); SBAR();
    pv_d0(o, VST(s1), pa0, pa1, pa2, pa3); MASK(pA0, pA1, j + 1); partialSM2(pA0, pA1, m_ref, qm, alA, false, hi);
    WAIT_BAR(2);
    if (j + 3 < NT) DMA(j + 3, s1);
    RESC(alA);
    { const int t_ = s0; s0 = s2; s2 = s1; s1 = t_; }
  }
  SBAR(); qkt64m(pB0, pB1, KST(s1), qr, qm, kneg, r32, hi);
  finishSM(pA0, pA1, alA, l_reg, pa0, pa1, pa2, pa3); SBAR();
  pv_d0(o, VST(s0), pa0, pa1, pa2, pa3); MASK(pB0, pB1, NT - 1); partialSM2(pB0, pB1, m_ref, qm, alB, false, hi);
  WAIT_BAR(0);
  RESC(alB);
  finishSM(pB0, pB1, alB, l_reg, pa0, pa1, pa2, pa3); SBAR();
  pv_d0(o, VST(s1), pa0, pa1, pa2, pa3);
  if (hi == 0) li_l[r32] = l_reg; asm volatile("s_waitcnt lgkmcnt(0)" ::: "memory");
  float rli[16];
#pragma unroll
  for (int r = 0; r < 16; ++r) rli[r] = __builtin_amdgcn_rcpf(li_l[crow(r, hi)]);
  WAIT_BAR(0);
  bf16* stg = (bf16*)lds + wid * 4096;
#pragma unroll
  for (int r = 0; r < 16; ++r) { const int orow = crow(r, hi);
#pragma unroll
    for (int d0 = 0; d0 < 4; ++d0) stg[orow * 128 + d0 * 32 + r32] = __float2bfloat16(o[d0][r] * rli[r]); }
  asm volatile("s_waitcnt lgkmcnt(0)" ::: "memory");
#pragma unroll
  for (int i = 0; i < 8; ++i) { const int row = i * 4 + (lane >> 4), ch = lane & 15; const u32x4 v = *(const u32x4*)(stg + row * 128 + ch * 8);
    *(u32x4*)(Ob + (size_t)(wid * QBLK + row) * 2048 + ch * 8) = v; }
  asm volatile("s_waitcnt lgkmcnt(0)\n\ts_barrier" ::: "memory");
#undef DMA
#undef RESC
#undef MASK
#undef KST
#undef VST
}
__device__ __forceinline__ void qkt64p(f32x16& p0, f32x16& p1, const bf16* Ks, const bf16x8* qr, int r32, int hi) {
  bf16x8 kf[8];
#pragma unroll
  for (int d0 = 0; d0 < 4; ++d0) { int cb = (d0 * 16 + hi * 8) * 2;
    kf[2 * d0] = *reinterpret_cast<const bf16x8*>((const char*)Ks + KSWZ64(r32, cb)); kf[2 * d0 + 1] = *reinterpret_cast<const bf16x8*>((const char*)Ks + KSWZ64(32 + r32, cb)); }
  p0 = f32x16{}; p1 = f32x16{};
  __builtin_amdgcn_s_setprio(1);
#pragma unroll
  for (int d0 = 0; d0 < 4; ++d0) { p0 = __builtin_amdgcn_mfma_f32_32x32x16_bf16(kf[2 * d0], qr[d0], p0, 0, 0, 0); p1 = __builtin_amdgcn_mfma_f32_32x32x16_bf16(kf[2 * d0 + 1], qr[d0], p1, 0, 0, 0); }
  __builtin_amdgcn_s_setprio(0);
}
__device__ __forceinline__ bool dattn_unit3(const bf16* Qb, const bf16* __restrict__ Kh, const bf16* __restrict__ Vh, bf16* Ob, const int NT, char* lds) {
  int tid = threadIdx.x; asm volatile("" : "+v"(tid)); const int lane = tid & 63, r32 = lane & 31, hi = lane >> 5; const int wid = __builtin_amdgcn_readfirstlane(tid >> 6);
  const unsigned lds0 = (unsigned)(uintptr_t)lds;
  float* ws = (float*)(lds + 3 * DA2_STG) + wid * 64; float* li_l = ws; float* al_l = ws + 32;
  const int krow = 8 * wid + (lane >> 3), kch = (lane & 7) ^ ((krow >> 1) & 7);
  const bf16* ksrc = Kh + (long)krow * LDK + kch * 8;
  const bf16* vsrc[2];
#pragma unroll
  for (int i = 0; i < 2; ++i) { const int off = (i * 8 + wid) * 1024 + lane * 16, sub = off >> 9, within = (off & 511) >> 1;
    const int kk = (sub >> 2) * 8 + (within >> 5), c = (sub & 3) * 32 + (within & 31), k = (kk & ~0xC) | ((kk & 4) << 1) | ((kk & 8) >> 1);
    vsrc[i] = Vh + (long)k * LDK + c; }
  const unsigned kdst = lds0 + wid * 1024, vdst = lds0 + 8192 + wid * 1024;
#define DMA(t, st) do { const long go_ = (long)(t) * KVBLK * LDK; glds16(ksrc + go_, (unsigned)__builtin_amdgcn_readfirstlane(kdst + (st))); \
    glds16(vsrc[0] + go_, (unsigned)__builtin_amdgcn_readfirstlane(vdst + (st))); glds16(vsrc[1] + go_, (unsigned)__builtin_amdgcn_readfirstlane(vdst + 8192 + (st))); } while (0)
  DMA(0, 0);
  float l_reg = 0.f; f32x16 o[4] = {}; bf16x8 qr[4];
  const bf16* Qw = Qb + (long)(wid * QBLK + r32) * LDK + hi * 8;
#pragma unroll
  for (int d0 = 0; d0 < 4; ++d0) qr[d0] = *reinterpret_cast<const bf16x8*>(Qw + d0 * 16);
  const int ql = wid * QBLK + r32;
#define RESC(a) do { } while (0)
#define EXP0(P0) do { _Pragma("unroll") for (int r = 0; r < 16; ++r) P0[r] = __builtin_amdgcn_exp2f(P0[r]); } while (0)
#define MASK(P0, P1, t) do { if ((t) >= NT - 4) cmask(P0, P1, (t) - (NT - 4), ql, hi); } while (0)
#define KST(sx) ((const bf16*)(lds + (sx)))
#define VST(sx) ((int)(lds0 + 8192 + (sx)) + v_rd_base(lane))
  f32x16 pA0, pA1, pB0, pB1; const float alA = 1.f, alB = 1.f; bf16x8 pa0, pa1, pa2, pa3;
  int s0 = 0, s1 = DA2_STG, s2 = 2 * DA2_STG;
  WAIT_BAR(0);
  DMA(1, DA2_STG);
  qkt64p(pA0, pA1, KST(0), qr, r32, hi); MASK(pA0, pA1, 0); EXP0(pA0);
  WAIT_BAR(2);
  DMA(2, 2 * DA2_STG);
  for (int j = 1; j + 1 < NT; j += 2) {
    SBAR(); qkt64p(pB0, pB1, KST(s1), qr, r32, hi);
    finishSM(pA0, pA1, alA, l_reg, pa0, pa1, pa2, pa3); SBAR();
    pv_d0p(o, VST(s0), pa0, pa1, pa2, pa3); MASK(pB0, pB1, j); EXP0(pB0);
    WAIT_BAR(2);
    if (j + 2 < NT) DMA(j + 2, s0);
    RESC(alB);
    SBAR(); qkt64p(pA0, pA1, KST(s2), qr, r32, hi);
    finishSM(pB0, pB1, alB, l_reg, pa0, pa1, pa2, pa3); SBAR();
    pv_d0p(o, VST(s1), pa0, pa1, pa2, pa3); MASK(pA0, pA1, j + 1); EXP0(pA0);
    WAIT_BAR(2);
    if (j + 3 < NT) DMA(j + 3, s1);
    RESC(alA);
    { const int t_ = s0; s0 = s2; s2 = s1; s1 = t_; }
  }
  SBAR(); qkt64p(pB0, pB1, KST(s1), qr, r32, hi);
  finishSM(pA0, pA1, alA, l_reg, pa0, pa1, pa2, pa3); SBAR();
  pv_d0p(o, VST(s0), pa0, pa1, pa2, pa3); MASK(pB0, pB1, NT - 1); EXP0(pB0);
  WAIT_BAR(0);
  RESC(alB);
  finishSM(pB0, pB1, alB, l_reg, pa0, pa1, pa2, pa3); SBAR();
  pv_d0p(o, VST(s1), pa0, pa1, pa2, pa3);
  const bool bad = __any(!(l_reg > 1e-30f && l_reg < 1e30f));
  if (hi == 0) li_l[r32] = l_reg; asm volatile("s_waitcnt lgkmcnt(0)" ::: "memory");
  float rli[16];
#pragma unroll
  for (int r = 0; r < 16; ++r) rli[r] = __builtin_amdgcn_rcpf(li_l[crow(r, hi)]);
  WAIT_BAR(0);
  bf16* stg = (bf16*)lds + wid * 4096;
#pragma unroll
  for (int r = 0; r < 16; ++r) { const int orow = crow(r, hi);
#pragma unroll
    for (int d0 = 0; d0 < 4; ++d0) stg[orow * 128 + d0 * 32 + r32] = __float2bfloat16(o[d0][r] * rli[r]); }
  asm volatile("s_waitcnt lgkmcnt(0)" ::: "memory");
#pragma unroll
  for (int i = 0; i < 8; ++i) { const int row = i * 4 + (lane >> 4), ch = lane & 15; const u32x4 v = *(const u32x4*)(stg + row * 128 + ch * 8);
    *(u32x4*)(Ob + (size_t)(wid * QBLK + row) * 2048 + ch * 8) = v; }
  asm volatile("s_waitcnt lgkmcnt(0)\n\ts_barrier" ::: "memory");
#undef DMA
#undef RESC
#undef EXP0
#undef MASK
#undef KST
#undef VST
  return bad;
}
#undef WAIT_BAR
struct DaUnit { int bqh; int qb; };
struct DaOrder {
  int vcu, G;
  __device__ __forceinline__ DaOrder(int vcu_, int G_) : vcu(vcu_), G(G_) {}
  __device__ __forceinline__ bool next(int i, DaUnit& u) const {
    if (G == 256) { if (i >= 8) return false; const int s = vcu & 7, ii = i & 3; u.bqh = (i >> 2) * 32 + (vcu >> 3); u.qb = (ii == 0) ? s : (ii == 1) ? 15 - s : (ii == 2) ? 16 + s : 31 - s; return true; }
    const int uu = vcu + i * G; if (uu >= 2048) return false; u.bqh = uu >> 5; u.qb = uu & 31; return true; }
};
template <class Sched> __device__ __forceinline__ void dattn_phase(char* lds, const bf16* QKV, bf16* O, const Sched& S) {
  DaUnit u; unsigned fail = 0u;
  for (int i = 0; S.next(i, u); ++i) { const int b = u.bqh >> 4, qh = u.bqh & 15; const size_t rb = (size_t)b * 8192;
    const bool bad = dattn_unit3(QKV + (rb + u.qb * 256) * LDK + qh * 64, QKV + rb * LDK + 1024 + qh * 64, QKV + rb * LDK + 2048 + (qh >> 1) * 128, O + (rb + u.qb * 256) * 2048 + qh * 128, 4 * (u.qb + 1), lds);
    if (bad) fail |= 1u << (i & 31); }
  unsigned* fl = (unsigned*)(lds + 3 * DA2_STG) + (threadIdx.x >> 6);
  if ((threadIdx.x & 63) == 0) *fl = fail;
  __syncthreads();
  unsigned all = 0u;
#pragma unroll
  for (int w = 0; w < NW; ++w) all |= ((unsigned*)(lds + 3 * DA2_STG))[w];
  all = (unsigned)__builtin_amdgcn_readfirstlane((int)all);
  __syncthreads();
  if (all) for (int i = 0; S.next(i, u); ++i) if ((all >> (i & 31)) & 1u) { const int b = u.bqh >> 4, qh = u.bqh & 15; const size_t rb = (size_t)b * 8192;
    dattn_unit2(QKV + (rb + u.qb * 256) * LDK + qh * 64, QKV + rb * LDK + 1024 + qh * 64, QKV + rb * LDK + 2048 + (qh >> 1) * 128, O + (rb + u.qb * 256) * 2048 + qh * 128, 4 * (u.qb + 1), lds); }
}
#undef KSWZ64
#undef KSWZ
#undef SBAR
}
#define GAS __attribute__((address_space(1)))
#define LAS __attribute__((address_space(3)))
typedef unsigned short bf16;
typedef unsigned v4u __attribute__((ext_vector_type(4)));
typedef float f32x4 __attribute__((ext_vector_type(4)));
typedef short bf16x8 __attribute__((ext_vector_type(8)));
typedef GAS unsigned gu32;
typedef GAS unsigned long long gu64;
#define RLX_AGENT __ATOMIC_RELAXED, __HIP_MEMORY_SCOPE_AGENT
#define LDS_WAIT() asm volatile("s_waitcnt lgkmcnt(0)" ::: "memory")
#define VM_WAIT() asm volatile("s_waitcnt vmcnt(0)" ::: "memory")
__device__ __forceinline__ unsigned long long rt() { return __builtin_amdgcn_s_memrealtime(); }
__device__ __forceinline__ unsigned f2bf(float f) { unsigned u = __builtin_bit_cast(unsigned, f); return (u + 0x7fffu + ((u >> 16) & 1u)) >> 16; }
__device__ __forceinline__ unsigned pk2(float lo, float hi) { return f2bf(lo) | (f2bf(hi) << 16); }
#define XB_TMO      128
#define XB_XCNT(j)  (256  + 64 * (j))
#define XB_XSUB(j)  (1280 + 64 * (j))
#define XB_XGEN(j)  (2304 + 64 * (j))
#define XB_TOP      3328
#define XB_TOPGEN   3392
#define XCD_BAR_WORDS 3456
#define XB_SPIN_CAP (1u << 18)

__device__ __forceinline__ unsigned xb_ld(unsigned* p)              { return __hip_atomic_load(p, __ATOMIC_RELAXED, __HIP_MEMORY_SCOPE_AGENT); }
__device__ __forceinline__ unsigned xb_add(unsigned* p, unsigned v) { return __hip_atomic_fetch_add(p, v, __ATOMIC_RELAXED, __HIP_MEMORY_SCOPE_AGENT); }
__device__ __forceinline__ unsigned xb_xcc_id() { return (unsigned)__builtin_amdgcn_s_getreg((3 << 11) | 20) & 0xFu; }
#define XB_SPIN(cond, bar) do { unsigned _sp = 0; while (cond) { __builtin_amdgcn_s_sleep(1); \
    if ((++_sp & 255u) == 0u) { if (xb_ld(&(bar)[XB_TMO])) break; if (_sp > XB_SPIN_CAP) { atomicAdd(&(bar)[XB_TMO], 1u); break; } } } } while (0)

struct XcdBarrier {
    unsigned* bar; unsigned x;
    volatile LAS unsigned* st;
};

__device__ __forceinline__ XcdBarrier xcd_barrier_post(unsigned* bar, volatile LAS unsigned* st) {
    XcdBarrier b; b.bar = bar; b.x = xb_xcc_id(); b.st = st;
    if (threadIdx.x == 0) (void)xb_add(&bar[XB_XCNT(b.x)], 1u);
    return b;
}
__device__ __forceinline__ void xcd_barrier_complete(unsigned* bar, unsigned x, unsigned& nloc, unsigned& nx) {
    const unsigned G = gridDim.x * gridDim.y * gridDim.z;
    unsigned sum, cnt, mine, sp = 0u;
    for (;;) {
        sum = 0u; cnt = 0u; mine = 0u;
#pragma unroll
        for (unsigned j = 0; j < 16; ++j) { const unsigned c = xb_ld(&bar[XB_XCNT(j)]); sum += c; cnt += (c > 0u) ? 1u : 0u; mine = (j == x) ? c : mine; }
        if (sum == G) break;
        __builtin_amdgcn_s_sleep(1);
        if ((++sp & 255u) == 0u) { if (xb_ld(&bar[XB_TMO])) break; if (sp > XB_SPIN_CAP) { atomicAdd(&bar[XB_TMO], 1u); break; } }
    }
    nloc = mine > 0u ? mine : 1u; nx = cnt > 0u ? cnt : 1u;
}

__device__ __forceinline__ void xcd_barrier(const XcdBarrier& b) {
    asm volatile("s_waitcnt vmcnt(0)" ::: "memory");
    __syncthreads();
    if (threadIdx.x == 0) {
        unsigned* bar = b.bar;
        __builtin_amdgcn_s_waitcnt(0);
        unsigned nloc = b.st[0], nx = b.st[1];
        if (nloc == 0u) { xcd_barrier_complete(bar, b.x, nloc, nx); b.st[0] = nloc; b.st[1] = nx; }
        const unsigned old = xb_add(&bar[XB_XSUB(b.x)], 1u);
        const unsigned gen = old / nloc;
        if (old + 1u == (gen + 1u) * nloc) {
            __builtin_amdgcn_fence(__ATOMIC_RELEASE, "agent");
            asm volatile("s_waitcnt vmcnt(0)" ::: "memory");
            const unsigned og = xb_add(&bar[XB_TOP], 1u);
            const unsigned tg = og / nx;
            if (og + 1u == (tg + 1u) * nx) xb_add(&bar[XB_TOPGEN], 1u);
            else XB_SPIN(xb_ld(&bar[XB_TOPGEN]) == tg, bar);
            __builtin_amdgcn_fence(__ATOMIC_ACQUIRE, "agent");
            xb_add(&bar[XB_XGEN(b.x)], 1u);
            asm volatile("s_waitcnt vmcnt(0)" ::: "memory");
        } else {
            XB_SPIN(xb_ld(&bar[XB_XGEN(b.x)]) == gen, bar);
            __builtin_amdgcn_fence(__ATOMIC_ACQUIRE, "agent");
            asm volatile("s_waitcnt vmcnt(0)" ::: "memory");
        }
    }
    __syncthreads();
}

constexpr int NWAVES = 8;
#ifndef GEMM_ALIGN
#define GEMM_ALIGN true
#endif
#ifndef MK_PER_PHASE
#define MK_PER_PHASE 0
#endif
constexpr int BATCH = 4, SEQ = 8192, DM = 1024, TOK = BATCH * SEQ;
constexpr int FF0 = 2816, NEXP = 8, FF1 = 3584;
constexpr int NQKV = 3072;
constexpr int MB_H = 8, MB_NB = 32, MB_L = 256;
constexpr int SLOTS = TOK + NEXP * 256;
constexpr float NORM_EPS = 1e-6f, SUBLN_EPS = 1e-5f;
constexpr float LAMBDA_INIT0 = 0.2f;
constexpr float LOG2E = 1.4426950408889634f;
constexpr int LIST_PER_BH = 256 * 496;
__host__ __device__ constexpr int list_off(int j) { return 256 * (31 * j - (j * (j - 1)) / 2); }

constexpr size_t MiB = 1u << 20;
constexpr size_t WS_CTL = 0, CTL_ZERO_BYTES = 3 * MiB;
constexpr size_t WS_CMAX13 = 2 * MiB;
constexpr size_t WS_CMAX2 = WS_CMAX13 + 256 * 1024;
constexpr size_t WS_SSTOT = WS_CMAX2 + 64 * 1024;
constexpr size_t WS_CM0 = WS_CMAX2 + 128 * 1024;
constexpr size_t WS_ROPE64 = 3 * MiB;
constexpr size_t WS_ROPE128 = WS_ROPE64 + 512 * 1024;
constexpr size_t WS_KMEAN = 2 * MiB + 512 * 1024;
constexpr size_t WS_TOK = 5 * MiB;
constexpr size_t WS_SLOT = 6 * MiB;
constexpr size_t WS_SA = 7 * MiB;
constexpr size_t WS_OWNML = 41 * MiB;
constexpr size_t WS_W0QKV = 8 * MiB, WS_W0O = 14 * MiB, WS_W013 = 16 * MiB, WS_W02 = 27 * MiB, WS_W1QKV = 33 * MiB, WS_W1O = 39 * MiB;
constexpr size_t B0 = 43 * MiB;
constexpr size_t WS_H = B0;
constexpr size_t WS_QKV = B0 + 64 * MiB;
constexpr size_t WS_OATT = B0 + 256 * MiB;
constexpr size_t WS_UD = B0 + 128 * MiB;
constexpr size_t WS_LIST = B0 + 256 * MiB;
constexpr size_t WS_PML = B0 + 272 * MiB;
constexpr size_t WS_PO = B0 + 280 * MiB;
constexpr size_t WS_WM13 = B0 + 64 * MiB;
constexpr size_t WS_WM2 = WS_WM13 + 56 * MiB;
constexpr size_t WS_AQ = WS_WM2 + 28 * MiB;
constexpr size_t WS_UM = B0 + 232 * MiB;
constexpr size_t WS_END = WS_PO + (size_t)TOK * MB_H * 3 * 128 * 2;
static_assert(WS_UM + (size_t)2 * SLOTS * FF1 <= WS_END && WS_AQ + (size_t)TOK * DM <= WS_UM && WS_END <= 528 * MiB, "d_ws map");
constexpr int CW_TMO = 0, CW_CODE = 1, CW_DBG = 2, CW_Q = 8;
constexpr int CW_MOECNT = 64;
constexpr int CW_MOBACNT = 256;
constexpr int CW_BAR = 4096;
constexpr size_t WS_RSS = 1 * MiB;
constexpr int RING_OFF = 0, RING_BYTES = 131072;
constexpr int LDSCTL_OFF = RING_BYTES, MISC_OFF = LDSCTL_OFF + 320;
constexpr int LDS_BYTES = 163840;

struct Args { const float* in[20]; float* out; unsigned char* ws; float inv64[8]; float inv128[16]; int ph_lo, ph_hi; };

__device__ __forceinline__ float wave_sum(float v) {
#pragma unroll
    for (int o = 1; o < 64; o <<= 1) v += __shfl_xor(v, o);
    return v;
}
template <int MAP> __device__ __forceinline__ int maprow(int n) {
    if (MAP == 1) { if (n >= 2048) return n; const int d = n & 63; if (d >= 16) return n; const int b = d >> 3, a = (d >> 2) & 1, c = d & 3; return (n & ~63) + 8 * a + 4 * b + c; }
    if (MAP == 2) { if (n >= 2048) return n; const int d = n & 127; if (d >= 32) return n; const int b = d >> 4, a = (d >> 2) & 3, c = d & 3; return (n & ~127) + 8 * a + 4 * b + c; }
    if (MAP == 3) return 256 * (n >> 7) + (n & 127);
    if (MAP == 4) return 256 * (n >> 7) + 128 + (n & 127);
    return n;
}
template <int MAP> __device__ __forceinline__ void transpose_item(const float* W, int K, int N, bf16* WT, LAS float* scr, int item, int lane, const float* gk = nullptr) {
    const int nblk = N / 32, kb = item / nblk, nb = item % nblk, k0 = 64 * kb, n0 = 32 * nb;
    const int kr = lane >> 3, nc = (lane & 7) * 4;
    f32x4 v[8];
#pragma unroll
    for (int i = 0; i < 8; ++i) v[i] = *(const GAS f32x4*)(W + (size_t)(k0 + i * 8 + kr) * N + n0 + nc);
    if (gk) {
#pragma unroll
        for (int i = 0; i < 8; ++i) v[i] = v[i] * gk[k0 + i * 8 + kr]; }
#pragma unroll
    for (int i = 0; i < 8; ++i) { LAS float* d = scr + (i * 8 + kr) * 33 + nc; d[0] = v[i].x; d[1] = v[i].y; d[2] = v[i].z; d[3] = v[i].w; }
    LDS_WAIT(); asm volatile("" ::: "memory");
    const int c = lane & 7;
#pragma unroll
    for (int j = 0; j < 4; ++j) { const int n = (lane >> 3) + 8 * j; const LAS float* s = scr + (8 * c) * 33 + n;
        v4u o; o.x = pk2(s[0 * 33], s[1 * 33]); o.y = pk2(s[2 * 33], s[3 * 33]); o.z = pk2(s[4 * 33], s[5 * 33]); o.w = pk2(s[6 * 33], s[7 * 33]);
        *(GAS v4u*)(WT + (size_t)maprow<MAP>(n0 + n) * K + k0 + 8 * c) = o; }
    LDS_WAIT(); asm volatile("" ::: "memory");
}

template <int MAP> __device__ __forceinline__ float wmax_strip(const float* W, int N, unsigned* cmax, int kb0, int nkb, int nb, int lane, const float* gk) {
    const int n0 = 32 * nb, kr = lane >> 3, nc = (lane & 7) * 4;
    f32x4 mx = (f32x4){0.f, 0.f, 0.f, 0.f}; float ss = 0.f;
    for (int kb = kb0; kb < kb0 + nkb; ++kb) { const int k0 = 64 * kb;
        f32x4 v[8];
#pragma unroll
        for (int i = 0; i < 8; ++i) v[i] = *(const GAS f32x4*)(W + (size_t)(k0 + i * 8 + kr) * N + n0 + nc);
        if (gk) {
#pragma unroll
            for (int i = 0; i < 8; ++i) v[i] = v[i] * gk[k0 + i * 8 + kr]; }
#pragma unroll
        for (int i = 0; i < 8; ++i) { mx.x = fmaxf(mx.x, fabsf(v[i].x)); mx.y = fmaxf(mx.y, fabsf(v[i].y)); mx.z = fmaxf(mx.z, fabsf(v[i].z)); mx.w = fmaxf(mx.w, fabsf(v[i].w));
            ss += (v[i].x * v[i].x + v[i].y * v[i].y) + (v[i].z * v[i].z + v[i].w * v[i].w); } }
#pragma unroll
    for (int o = 8; o < 64; o <<= 1) { mx.x = fmaxf(mx.x, __shfl_xor(mx.x, o)); mx.y = fmaxf(mx.y, __shfl_xor(mx.y, o)); mx.z = fmaxf(mx.z, __shfl_xor(mx.z, o)); mx.w = fmaxf(mx.w, __shfl_xor(mx.w, o)); }
    if (lane < 8) {
        __hip_atomic_fetch_max(cmax + maprow<MAP>(n0 + nc + 0), __float_as_uint(mx.x), __ATOMIC_RELAXED, __HIP_MEMORY_SCOPE_AGENT);
        __hip_atomic_fetch_max(cmax + maprow<MAP>(n0 + nc + 1), __float_as_uint(mx.y), __ATOMIC_RELAXED, __HIP_MEMORY_SCOPE_AGENT);
        __hip_atomic_fetch_max(cmax + maprow<MAP>(n0 + nc + 2), __float_as_uint(mx.z), __ATOMIC_RELAXED, __HIP_MEMORY_SCOPE_AGENT);
        __hip_atomic_fetch_max(cmax + maprow<MAP>(n0 + nc + 3), __float_as_uint(mx.w), __ATOMIC_RELAXED, __HIP_MEMORY_SCOPE_AGENT); }
    return ss;
}
template <int MAP> __device__ __forceinline__ void transpose_item_q(const float* W, int K, int N, signed char* WT, const unsigned* cmax, LAS float* scr, int item, int lane, const float* gk) {
    const int nblk = N / 32, kb = item / nblk, nb = item % nblk, k0 = 64 * kb, n0 = 32 * nb;
    const int kr = lane >> 3, nc = (lane & 7) * 4;
    f32x4 v[8];
#pragma unroll
    for (int i = 0; i < 8; ++i) v[i] = *(const GAS f32x4*)(W + (size_t)(k0 + i * 8 + kr) * N + n0 + nc);
    if (gk) {
#pragma unroll
        for (int i = 0; i < 8; ++i) v[i] = v[i] * gk[k0 + i * 8 + kr]; }
#pragma unroll
    for (int i = 0; i < 8; ++i) { LAS float* d = scr + (i * 8 + kr) * 33 + nc; d[0] = v[i].x; d[1] = v[i].y; d[2] = v[i].z; d[3] = v[i].w; }
    LDS_WAIT(); asm volatile("" ::: "memory");
    const int half = lane >> 5, n = lane & 31, row = maprow<MAP>(n0 + n);
    const float cm = __uint_as_float(cmax[row]); const float inv = cm > 0.f ? 127.0f / cm : 0.f;
    const LAS float* s = scr + (32 * half) * 33 + n;
    unsigned w[8];
#pragma unroll
    for (int q4 = 0; q4 < 8; ++q4) { unsigned pk = 0;
#pragma unroll
        for (int b = 0; b < 4; ++b) { const int q = (int)__builtin_rintf(s[(4 * q4 + b) * 33] * inv); pk |= (unsigned)(q & 255) << (8 * b); }
        w[q4] = pk; }
    GAS v4u* dst = (GAS v4u*)(WT + (size_t)row * K + k0 + 32 * half);
    dst[0] = (v4u){w[0], w[1], w[2], w[3]}; dst[1] = (v4u){w[4], w[5], w[6], w[7]};
    LDS_WAIT(); asm volatile("" ::: "memory");
}

template <int MAP> __device__ __forceinline__ void strip_quant(const float* W, int K, int N, signed char* WT, float cm, LAS float* scr, int kb0, int nkb, int nb, int lane, const float* gk) {
    const int n0 = 32 * nb, kr = lane >> 3, nc = (lane & 7) * 4;
    const int half = lane >> 5, n = lane & 31, row = maprow<MAP>(n0 + n);
    const float inv = cm > 0.f ? 127.0f / cm : 0.f;
    f32x4 vn[8];
#pragma unroll
    for (int i = 0; i < 8; ++i) vn[i] = *(const GAS f32x4*)(W + (size_t)(64 * kb0 + i * 8 + kr) * N + n0 + nc);
    for (int kb = kb0; kb < kb0 + nkb; ++kb) { const int k0 = 64 * kb;
        f32x4 v[8];
#pragma unroll
        for (int i = 0; i < 8; ++i) v[i] = vn[i];
        if (kb + 1 < kb0 + nkb) {
#pragma unroll
            for (int i = 0; i < 8; ++i) vn[i] = *(const GAS f32x4*)(W + (size_t)(k0 + 64 + i * 8 + kr) * N + n0 + nc); }
        if (gk) {
#pragma unroll
            for (int i = 0; i < 8; ++i) v[i] = v[i] * gk[k0 + i * 8 + kr]; }
#pragma unroll
        for (int i = 0; i < 8; ++i) { LAS float* d = scr + (i * 8 + kr) * 33 + nc; d[0] = v[i].x; d[1] = v[i].y; d[2] = v[i].z; d[3] = v[i].w; }
        LDS_WAIT(); asm volatile("" ::: "memory");
        const LAS float* s = scr + (32 * half) * 33 + n;
        unsigned w[8];
#pragma unroll
        for (int q4 = 0; q4 < 8; ++q4) { unsigned pk = 0;
#pragma unroll
            for (int b = 0; b < 4; ++b) { const int q = (int)__builtin_rintf(s[(4 * q4 + b) * 33] * inv); pk |= (unsigned)(q & 255) << (8 * b); }
            w[q4] = pk; }
        GAS v4u* dst = (GAS v4u*)(WT + (size_t)row * K + k0 + 32 * half);
        dst[0] = (v4u){w[0], w[1], w[2], w[3]}; dst[1] = (v4u){w[4], w[5], w[6], w[7]};
        LDS_WAIT(); asm volatile("" ::: "memory");
    }
}
__device__ __forceinline__ float wstrip_max(const float* W, int N, int kb0, int nkb, int nb, int lane, const float* gk, f32x4& mx) {
    const int n0 = 32 * nb, kr = lane >> 3, nc = (lane & 7) * 4; float ss = 0.f;
    for (int kb = kb0; kb < kb0 + nkb; kb += 2) {
        const int k0 = 64 * kb; const bool two = kb + 1 < kb0 + nkb; const int k1 = two ? k0 + 64 : k0;
        f32x4 v[16];
#pragma unroll
        for (int i = 0; i < 8; ++i) { v[i] = *(const GAS f32x4*)(W + (size_t)(k0 + i * 8 + kr) * N + n0 + nc); v[8 + i] = *(const GAS f32x4*)(W + (size_t)(k1 + i * 8 + kr) * N + n0 + nc); }
        if (gk) {
#pragma unroll
            for (int i = 0; i < 8; ++i) { v[i] = v[i] * gk[k0 + i * 8 + kr]; v[8 + i] = v[8 + i] * gk[k1 + i * 8 + kr]; } }
#pragma unroll
        for (int i = 0; i < 16; ++i) { mx.x = fmaxf(mx.x, fabsf(v[i].x)); mx.y = fmaxf(mx.y, fabsf(v[i].y)); mx.z = fmaxf(mx.z, fabsf(v[i].z)); mx.w = fmaxf(mx.w, fabsf(v[i].w));
            if (i < 8 || two) ss += (v[i].x * v[i].x + v[i].y * v[i].y) + (v[i].z * v[i].z + v[i].w * v[i].w); } }
#pragma unroll
    for (int o = 8; o < 64; o <<= 1) { mx.x = fmaxf(mx.x, __shfl_xor(mx.x, o)); mx.y = fmaxf(mx.y, __shfl_xor(mx.y, o)); mx.z = fmaxf(mx.z, __shfl_xor(mx.z, o)); mx.w = fmaxf(mx.w, __shfl_xor(mx.w, o)); }
    return ss;
}
__device__ __forceinline__ float strip_colmax(const f32x4& mx, int lane) {
    const int n = lane & 31, src = n >> 2; const float a = __shfl(mx.x, src), b = __shfl(mx.y, src), c = __shfl(mx.z, src), d = __shfl(mx.w, src);
    return (n & 3) == 0 ? a : (n & 3) == 1 ? b : (n & 3) == 2 ? c : d;
}
__device__ __forceinline__ void rms_row(const float* xrow, const f32x4 (&g)[4], f32x4 (&v)[4], int lane) {
    const GAS f32x4* xr = (const GAS f32x4*)xrow + lane; float s = 0.f;
#pragma unroll
    for (int j = 0; j < 4; ++j) { v[j] = xr[64 * j]; s += (v[j].x * v[j].x + v[j].y * v[j].y) + (v[j].z * v[j].z + v[j].w * v[j].w); }
    const float rstd = 1.f / sqrtf(wave_sum(s) * (1.f / DM) + NORM_EPS);
#pragma unroll
    for (int j = 0; j < 4; ++j) v[j] = v[j] * rstd * g[j];
}
__device__ __forceinline__ void store_row_bf16(bf16* orow, const f32x4 (&v)[4], int lane) {
    GAS unsigned long long* o8 = (GAS unsigned long long*)orow + lane;
#pragma unroll
    for (int j = 0; j < 4; ++j) o8[64 * j] = (unsigned long long)pk2(v[j].x, v[j].y) | ((unsigned long long)pk2(v[j].z, v[j].w) << 32);
}
__device__ __forceinline__ void load_gain(const float* g, f32x4 (&gv)[4], int lane) {
#pragma unroll
    for (int j = 0; j < 4; ++j) gv[j] = *((const f32x4*)g + lane + 64 * j);
}
__device__ __forceinline__ void rmsnorm_phase(const float* src, const float* gain, bf16* dst, int gw, int ngw, int lane) {
    f32x4 gv[4]; load_gain(gain, gv, lane);
    for (int m = gw; m < TOK; m += ngw) { f32x4 v[4]; rms_row(src + (size_t)m * DM, gv, v, lane); store_row_bf16(dst + (size_t)m * DM, v, lane); }
}
__device__ __forceinline__ float bf2f(unsigned short b) { return __uint_as_float((unsigned)b << 16); }


__device__ __forceinline__ int tid_fresh() { int t = (int)threadIdx.x; asm volatile("" : "+v"(t)); return t; }
typedef __attribute__((address_space(4))) const unsigned char* kaptr_t;
__device__ __forceinline__ kaptr_t ka_get() { kaptr_t p = (kaptr_t)__builtin_amdgcn_kernarg_segment_ptr(); asm volatile("" : "+s"(p)); return p; }
#define KA_IN(k) (*(const float* const __attribute__((address_space(4)))*)(ka + 8 * (k)))
#define PH_PTRS const int tid = tid_fresh(); const int lane = tid & 63; (void)lane; kaptr_t ka = ka_get(); unsigned char* const ws = *(unsigned char* const __attribute__((address_space(4)))*)(ka + 168); float* const out = *(float* const __attribute__((address_space(4)))*)(ka + 160); gu32* const ctl = (gu32*)(ws + WS_CTL); (void)out; (void)ctl
#define IN_X KA_IN(0)
#define norm_mix KA_IN(1)
#define norm_ffn KA_IN(2)
#define final_norm KA_IN(3)
#define da_wqkv KA_IN(4)
#define da_wo KA_IN(5)
#define da_lq1 KA_IN(6)
#define da_lk1 KA_IN(7)
#define da_lq2 KA_IN(8)
#define da_lk2 KA_IN(9)
#define da_subln KA_IN(10)
#define mb_wqkv KA_IN(11)
#define mb_wo KA_IN(12)
#define ffn_w1 KA_IN(13)
#define ffn_w3 KA_IN(14)
#define ffn_w2 KA_IN(15)
#define moe_router KA_IN(16)
#define moe_w1 KA_IN(17)
#define moe_w3 KA_IN(18)
#define moe_w2 KA_IN(19)
#define rope64 ((float*)(ws + WS_ROPE64))
#define rope128 ((float*)(ws + WS_ROPE128))
#define kmean ((int*)(ws + WS_KMEAN))
#define tok_e ((int*)(ws + WS_TOK))
#define tok_pos (tok_e + 2 * TOK)
#define tok_gate ((float*)(tok_pos + 2 * TOK))
#define wg_base ((int*)(ws + WS_TOK + 800 * 1024))
#define slot_tok ((int*)(ws + WS_SLOT))
#define slot_gate ((float*)(slot_tok + 2 * SLOTS))
#define slot_sa (slot_gate + 2 * SLOTS)
#define ownml ((float*)(ws + WS_OWNML))
#define W0qkv ((bf16*)(ws + WS_W0QKV))
#define W0o ((bf16*)(ws + WS_W0O))
#define W013 ((bf16*)(ws + WS_W013))
#define W02 ((bf16*)(ws + WS_W02))
#define W1qkv ((bf16*)(ws + WS_W1QKV))
#define W1o ((bf16*)(ws + WS_W1O))
#define Rb ((bf16*)(ws + WS_H))
#define OB ((bf16*)out)
#define RSS(j) ((unsigned long long*)(ws + WS_RSS) + (size_t)(j) * TOK)
#define QKV ((bf16*)(ws + WS_QKV))
#define OATT ((bf16*)(ws + WS_OATT))
#define UD ((bf16*)(ws + WS_UD))
#define lists ((int*)(ws + WS_LIST))
#define pml ((float*)(ws + WS_PML))
#define PO ((bf16*)(ws + WS_PO))
#define WM13 ((signed char*)(ws + WS_WM13))
#define WM2 ((signed char*)(ws + WS_WM2))
#define AQ ((signed char*)(ws + WS_AQ))
#define UM ((signed char*)(ws + WS_UM))
#define Y1B ((bf16*)(ws + WS_AQ))
#define CMAX13 ((unsigned*)(ws + WS_CMAX13))
#define CMAX2 ((unsigned*)(ws + WS_CMAX2))
#define SSTOT ((unsigned long long*)(ws + WS_SSTOT))
#define SA ((float*)(ws + WS_SA))
#define SA1 ((float*)(ws + WS_SA + 128 * 1024))
#define SA0 ((float*)(ws + WS_SA + 256 * 1024))
#define SA2 ((float*)(ws + WS_SA + 384 * 1024))
#define SO0 ((float*)(ws + WS_SA + 512 * 1024))
#define SO1 ((float*)(ws + WS_SA + 640 * 1024))
#define CMQ0 ((unsigned*)(ws + WS_SA + 768 * 1024))
#define CMQ1 ((unsigned*)(ws + WS_SA + 784 * 1024))
#define CMO0 ((unsigned*)(ws + WS_SA + 800 * 1024))
#define CMO1 ((unsigned*)(ws + WS_SA + 808 * 1024))
#define AMX0 ((float*)(ws + WS_W0QKV + 3 * MiB))
#define QS1 ((float*)(ws + WS_W0QKV + 3 * MiB + 128 * 1024))
#define QS2 ((float*)(ws + WS_W0QKV + 3 * MiB + 256 * 1024))
#define AMX1 ((unsigned*)(ws + 512 * 1024))
#define AXQ ((signed char*)(ws + WS_OATT))
#define OBQ ((signed char*)out + (size_t)64 * MiB)
#define CM0_13 ((unsigned*)(ws + WS_CM0))
#define CM0_2 ((unsigned*)(ws + WS_CM0 + 32 * 1024))
#define SSTOT0 ((unsigned long long*)(ws + WS_CM0 + 48 * 1024))
#define W013q ((signed char*)(ws + WS_W013))
#define W02q ((signed char*)(ws + WS_W02))
#define A1Q ((signed char*)(ws + WS_QKV))
#define UDQ ((signed char*)(ws + WS_UD))
__global__ void __launch_bounds__(NWAVES * 64, 2) mk_fwd(Args args) {
    extern __shared__ __attribute__((aligned(16))) unsigned char lds[];
    LAS unsigned char* L = (LAS unsigned char*)lds;
    volatile LAS unsigned* MISC = (volatile LAS unsigned*)(L + MISC_OFF);
    const int wave = __builtin_amdgcn_readfirstlane((int)threadIdx.x >> 6);
    const int G = gridDim.x; const int bx = blockIdx.x; const int vcu = (G % 8 == 0) ? (bx % 8) * (G / 8) + bx / 8 : bx;
    const int gw = vcu * NWAVES + wave, NGW = G * NWAVES;
    gu32* ctl0 = (gu32*)(args.ws + WS_CTL);
    for (int u = (int)threadIdx.x; u < (LDS_BYTES - LDSCTL_OFF) / 4; u += NWAVES * 64) ((LAS unsigned*)(L + LDSCTL_OFF))[u] = 0u;
    __syncthreads();
    XcdBarrier bar; bar.bar = (unsigned*)(ctl0 + CW_BAR); bar.x = 0; bar.st = nullptr;
    if (!MK_PER_PHASE) bar = xcd_barrier_post((unsigned*)(ctl0 + CW_BAR), MISC + 8);
#define GRID_BAR() do { if (!MK_PER_PHASE) xcd_barrier(bar); } while (0)
    const int lo = args.ph_lo, hi_ph = args.ph_hi;
#ifndef PH_MASK
#define PH_MASK 0xFFFFFFFFu
#endif
#define IN(k) (((PH_MASK >> (k)) & 1u) && lo <= (k) && (k) < hi_ph)
#define SEAM(k) do { if (IN((k) + 1)) GRID_BAR(); } while (0)
#ifndef DUP_MASK
#define DUP_MASK 0u
#endif
#define NREP(k) ((((DUP_MASK) >> (k)) & 1u) ? 2 : 1)

    if (IN(0)) { PH_PTRS; for (int rep_ = 0; rep_ < NREP(0); ++rep_) {
        LAS float* scr = (LAS float*)(L + RING_OFF + wave * 16384);
        {
            LAS float* cmw = (LAS float*)(L + 132096);
            for (int st = vcu; st < 256; st += G) {
                const int mat = st < 96 ? 0 : st < 192 ? 1 : st < 224 ? 2 : 3; const int nb = st - (mat == 0 ? 0 : mat == 1 ? 96 : mat == 2 ? 192 : 224);
                const float* W = mat == 0 ? da_wqkv : mat == 1 ? mb_wqkv : mat == 2 ? da_wo : mb_wo; const int N = mat < 2 ? NQKV : DM;
                const float* gk = mat == 0 ? norm_mix : mat == 1 ? norm_mix + DM : nullptr;
                f32x4 mx = (f32x4){0.f, 0.f, 0.f, 0.f}; (void)wstrip_max(W, N, 2 * wave, 2, nb, lane, gk, mx);
                if (lane < 8) { LAS float* d = cmw + wave * 32 + lane * 4; d[0] = mx.x; d[1] = mx.y; d[2] = mx.z; d[3] = mx.w; }
                LDS_WAIT(); __syncthreads();
                float cm = 0.f;
#pragma unroll
                for (int w8 = 0; w8 < 8; ++w8) cm = fmaxf(cm, cmw[w8 * 32 + (lane & 31)]);
                if (mat == 0) { if (wave == 0 && lane < 32) CMQ0[maprow<1>(nb * 32 + lane)] = __float_as_uint(cm); strip_quant<1>(W, DM, N, (signed char*)W0qkv, cm, scr, 2 * wave, 2, nb, lane, gk); }
                else if (mat == 1) { if (wave == 0 && lane < 32) CMQ1[maprow<2>(nb * 32 + lane)] = __float_as_uint(cm); strip_quant<2>(W, DM, N, (signed char*)W1qkv, cm, scr, 2 * wave, 2, nb, lane, gk); }
                else if (mat == 2) { if (wave == 0 && lane < 32) CMO0[nb * 32 + lane] = __float_as_uint(cm); strip_quant<0>(W, DM, N, (signed char*)W0o, cm, scr, 2 * wave, 2, nb, lane, gk); }
                else { if (wave == 0 && lane < 32) CMO1[nb * 32 + lane] = __float_as_uint(cm); strip_quant<0>(W, DM, N, (signed char*)W1o, cm, scr, 2 * wave, 2, nb, lane, gk); }
                __syncthreads();
            }
        }
        {
            constexpr int S_1 = (DM / 512) * (FF0 / 32), S_2 = 6 * (DM / 32);
            float ssA = 0.f, ssB = 0.f;
            for (int it = NGW - 1 - gw; it < 2 * S_1 + S_2; it += NGW) {
                int r = it;
                if (r < S_1) { ssA += wmax_strip<3>(ffn_w1, FF0, CM0_13, 8 * (r / (FF0 / 32)), 8, r % (FF0 / 32), lane, norm_ffn); continue; } r -= S_1;
                if (r < S_1) { ssB += wmax_strip<4>(ffn_w3, FF0, CM0_13, 8 * (r / (FF0 / 32)), 8, r % (FF0 / 32), lane, norm_ffn); continue; } r -= S_1;
                { const int st = r / (DM / 32); (void)wmax_strip<0>(ffn_w2, DM, CM0_2, 8 * st, st == 5 ? 4 : 8, r % (DM / 32), lane, nullptr); }
            }
            ssA = wave_sum(ssA); ssB = wave_sum(ssB);
            if (lane == 0 && (ssA != 0.f || ssB != 0.f)) { __hip_atomic_fetch_add(SSTOT0, (unsigned long long)(ssA * 16777216.0f), __ATOMIC_RELAXED, __HIP_MEMORY_SCOPE_AGENT); __hip_atomic_fetch_add(SSTOT0 + 1, (unsigned long long)(ssB * 16777216.0f), __ATOMIC_RELAXED, __HIP_MEMORY_SCOPE_AGENT); }
        }
        {
            const int gt = (vcu * NWAVES + wave) * 64 + lane, NT_ = G * NWAVES * 64;
            for (int e = gt; e < SEQ * 8; e += NT_) { const int pos = e >> 3, i = e & 7; const float ang = (float)pos * (*(const float __attribute__((address_space(4)))*)(ka + 176 + 4 * i)); rope64[e] = cosf(ang); rope64[SEQ * 8 + e] = sinf(ang); }
            for (int e = gt; e < SEQ * 16; e += NT_) { const int pos = e >> 4, i = e & 15; const float ang = (float)pos * (*(const float __attribute__((address_space(4)))*)(ka + 208 + 4 * i)); rope128[e] = cosf(ang); rope128[SEQ * 16 + e] = sinf(ang); }
        }
        for (int m0 = gw; m0 < TOK; m0 += 2 * NGW) {
            f32x4 vv[2][4];
#pragma unroll
            for (int u = 0; u < 2; ++u) { const int m = (m0 + u * NGW < TOK) ? m0 + u * NGW : m0; const GAS f32x4* xr = (const GAS f32x4*)(IN_X + (size_t)m * DM) + lane;
#pragma unroll
                for (int j = 0; j < 4; ++j) vv[u][j] = xr[64 * j]; }
#pragma unroll
            for (int u = 0; u < 2; ++u) { const int m = m0 + u * NGW; if (m < TOK) {
                f32x4 v[4]; float s = 0.f, mx = 0.f;
#pragma unroll
                for (int j = 0; j < 4; ++j) { v[j] = vv[u][j]; s += (v[j].x * v[j].x + v[j].y * v[j].y) + (v[j].z * v[j].z + v[j].w * v[j].w);
                    mx = fmaxf(fmaxf(mx, fmaxf(fabsf(v[j].x), fabsf(v[j].y))), fmaxf(fabsf(v[j].z), fabsf(v[j].w))); }
                store_row_bf16(Rb + (size_t)m * DM, v, lane); s = wave_sum(s);
#pragma unroll
                for (int o = 1; o < 64; o <<= 1) mx = fmaxf(mx, __shfl_xor(mx, o));
                const float inv = mx > 0.f ? 127.0f / mx : 0.f;
                GAS unsigned* aq = (GAS unsigned*)(AXQ + (size_t)m * DM) + lane;
#pragma unroll
                for (int j = 0; j < 4; ++j) { const int q0 = (int)__builtin_rintf(v[j].x * inv), q1 = (int)__builtin_rintf(v[j].y * inv), q2 = (int)__builtin_rintf(v[j].z * inv), q3 = (int)__builtin_rintf(v[j].w * inv);
                    aq[64 * j] = (unsigned)(q0 & 255) | ((unsigned)(q1 & 255) << 8) | ((unsigned)(q2 & 255) << 16) | ((unsigned)(q3 & 255) << 24); }
                if (lane == 0) { SA0[m] = mx * (1.f / sqrtf(s * (1.f / DM) + NORM_EPS)) * (1.0f / 127.0f); AMX0[m] = mx; } } }
        }
        } SEAM(0);
    }
    if (IN(1)) { PH_PTRS; for (int rep_ = 0; rep_ < NREP(1); ++rep_) {
        pg8::ABDense ab{(const pg8::bf16_t*)AXQ, (const pg8::bf16_t*)W0qkv, DM / 2}; pg8::TileOrder S; S.init(TOK / 256, NQKV / 256, G, bx);
        pg8::EpiQKVQ<64> E{QKV, NQKV, rope64, rope64 + SEQ * 8, 0.125f * LOG2E, SA0, CMQ0, nullptr, nullptr};
        pg8::gemm_phase<pg8::EpiQKVQ<64>, pg8::ABDense, GEMM_ALIGN>(L + RING_OFF, ab, S, E);
        } SEAM(1);
    }
    if (IN(2)) { PH_PTRS; for (int rep_ = 0; rep_ < NREP(2); ++rep_) {
        const moba::DaOrder AS(vcu, G);
        moba::dattn_phase<moba::DaOrder>((char*)lds + RING_OFF, (const moba::bf16*)QKV, (moba::bf16*)OATT, AS);
        } SEAM(2);
    }
    if (IN(3)) { PH_PTRS; for (int rep_ = 0; rep_ < NREP(3); ++rep_) {
        float lam;
        { const float a = wave_sum(da_lq1[lane] * da_lk1[lane]), b = wave_sum(da_lq2[lane] * da_lk2[lane]); lam = expf(a) - expf(b) + LAMBDA_INIT0; }
        const int hh = lane >> 3, dd = (lane & 7) * 16;
        float gsub[16];
#pragma unroll
        for (int k = 0; k < 16; ++k) gsub[k] = da_subln[dd + k] * (1.f - LAMBDA_INIT0);
        for (int m0 = gw; m0 < TOK; m0 += 2 * NGW) {
            v4u A0[2], A1[2], B0[2], B1[2];
#pragma unroll
            for (int u = 0; u < 2; ++u) { const int m = (m0 + u * NGW < TOK) ? m0 + u * NGW : m0;
                const bf16* o1 = OATT + (size_t)m * 2048 + (2 * hh) * 128 + dd; const bf16* o2 = o1 + 128;
                A0[u] = *(const GAS v4u*)o1; A1[u] = *(const GAS v4u*)(o1 + 8); B0[u] = *(const GAS v4u*)o2; B1[u] = *(const GAS v4u*)(o2 + 8); }
#pragma unroll
            for (int u = 0; u < 2; ++u) { const int m = m0 + u * NGW; if (m < TOK) {
                const v4u a0 = A0[u], a1 = A1[u], b0 = B0[u], b1 = B1[u];
                float d[16]; float ss = 0.f;
#pragma unroll
                for (int k = 0; k < 4; ++k) {
                    const unsigned ua = a0[k], ub = b0[k], uc = a1[k], ud = b1[k];
                    d[2 * k] = __uint_as_float(ua << 16) - lam * __uint_as_float(ub << 16); d[2 * k + 1] = __uint_as_float(ua & 0xffff0000u) - lam * __uint_as_float(ub & 0xffff0000u);
                    d[8 + 2 * k] = __uint_as_float(uc << 16) - lam * __uint_as_float(ud << 16); d[8 + 2 * k + 1] = __uint_as_float(uc & 0xffff0000u) - lam * __uint_as_float(ud & 0xffff0000u); }
#pragma unroll
                for (int k = 0; k < 16; ++k) ss += d[k] * d[k];
                ss += __shfl_xor(ss, 1); ss += __shfl_xor(ss, 2); ss += __shfl_xor(ss, 4);
                const float rstd = 1.f / sqrtf(ss * (1.f / 128.f) + SUBLN_EPS);
                float mx = 0.f;
#pragma unroll
                for (int k = 0; k < 16; ++k) { d[k] = d[k] * rstd * gsub[k]; mx = fmaxf(mx, fabsf(d[k])); }
#pragma unroll
                for (int o = 1; o < 64; o <<= 1) mx = fmaxf(mx, __shfl_xor(mx, o));
                const float inv = mx > 0.f ? 127.0f / mx : 0.f;
                v4u wq;
#pragma unroll
                for (int k = 0; k < 4; ++k) { const int q0 = (int)__builtin_rintf(d[4 * k] * inv), q1 = (int)__builtin_rintf(d[4 * k + 1] * inv), q2 = (int)__builtin_rintf(d[4 * k + 2] * inv), q3 = (int)__builtin_rintf(d[4 * k + 3] * inv);
                    wq[k] = (unsigned)(q0 & 255) | ((unsigned)(q1 & 255) << 8) | ((unsigned)(q2 & 255) << 16) | ((unsigned)(q3 & 255) << 24); }
                *(GAS v4u*)(OBQ + (size_t)m * DM + hh * 128 + dd) = wq;
                if (lane == 0) SO0[m] = mx * (1.0f / 127.0f); } }
        }
        {
            LAS float* scr = (LAS float*)(L + RING_OFF + wave * 16384);
            constexpr int I_13 = (DM / 64) * (FF0 / 32), I_2 = (FF0 / 64) * (DM / 32);
            for (int it = gw; it < 2 * I_13 + I_2; it += NGW) {
                int r = it;
                if (r < I_13) { transpose_item_q<3>(ffn_w1, DM, FF0, W013q, CM0_13, scr, r, lane, norm_ffn); continue; } r -= I_13;
                if (r < I_13) { transpose_item_q<4>(ffn_w3, DM, FF0, W013q, CM0_13, scr, r, lane, norm_ffn); continue; } r -= I_13;
                transpose_item_q<0>(ffn_w2, FF0, DM, W02q, CM0_2, scr, r, lane, nullptr);
            }
        }
        } SEAM(3);
    }
    if (IN(4)) { PH_PTRS; for (int rep_ = 0; rep_ < NREP(4); ++rep_) {
        pg8::ABDense ab{(const pg8::bf16_t*)OBQ, (const pg8::bf16_t*)W0o, DM / 2}; pg8::TileOrder S; S.init(TOK / 256, DM / 256, G, bx);
        pg8::EpiResBQ E{Rb, Rb, DM, nullptr, SO0, CMO0, pg8::MoeMap{0, nullptr}, 1.0f, RSS(1), nullptr, A1Q, AMX0, 1.5f, AMX1, QS1};
        pg8::gemm_phase<pg8::EpiResBQ, pg8::ABDense, GEMM_ALIGN>(L + RING_OFF, ab, S, E);
        } SEAM(4);
    }
    if (IN(6)) { PH_PTRS; for (int rep_ = 0; rep_ < NREP(6); ++rep_) {
        const float su0 = 8.0f * sqrtf(((float)SSTOT0[0] * (5.9604644775390625e-8f / FF0)) * ((float)SSTOT0[1] * (5.9604644775390625e-8f / FF0)));
        pg8::ABDense ab{(const pg8::bf16_t*)A1Q, (const pg8::bf16_t*)W013q, DM / 2}; pg8::TileOrder S; S.init(TOK / 256, (2 * FF0) / 256, G, bx);
        pg8::EpiSwiGLUQ E{UDQ, FF0, QS1, CM0_13, nullptr, pg8::MoeMap{0, nullptr}, 127.0f / su0, RSS(1)};
        pg8::gemm_phase<pg8::EpiSwiGLUQ, pg8::ABDense, GEMM_ALIGN>(L + RING_OFF, ab, S, E);
        } SEAM(6);
    }
    if (IN(7)) { PH_PTRS; for (int rep_ = 0; rep_ < NREP(7); ++rep_) {
        const float su0 = 8.0f * sqrtf(((float)SSTOT0[0] * (5.9604644775390625e-8f / FF0)) * ((float)SSTOT0[1] * (5.9604644775390625e-8f / FF0)));
        pg8::ABDense ab{(const pg8::bf16_t*)UDQ, (const pg8::bf16_t*)W02q, FF0 / 2}; pg8::TileOrder S; S.init(TOK / 256, DM / 256, G, bx);
        pg8::EpiResBQ E{Rb, Rb, DM, nullptr, nullptr, CM0_2, pg8::MoeMap{0, nullptr}, su0 * (1.0f / 127.0f), RSS(2), nullptr, AXQ, (const float*)AMX1, 1.3f, nullptr, QS2};
        pg8::gemm_phase<pg8::EpiResBQ, pg8::ABDense, GEMM_ALIGN>(L + RING_OFF, ab, S, E);
        } SEAM(7);
    }
    if (IN(9)) { PH_PTRS; for (int rep_ = 0; rep_ < NREP(9); ++rep_) {
        pg8::ABDense ab{(const pg8::bf16_t*)AXQ, (const pg8::bf16_t*)W1qkv, DM / 2}; pg8::TileOrder S; S.init(TOK / 256, NQKV / 256, G, bx);
        pg8::EpiQKVQ<128> E{QKV, NQKV, rope128, rope128 + SEQ * 16, 0.08838834764831845f * LOG2E, QS2, CMQ1, kmean, RSS(2)};
        pg8::gemm_phase<pg8::EpiQKVQ<128>, pg8::ABDense, GEMM_ALIGN>(L + RING_OFF, ab, S, E);
        } SEAM(9);
    }
    if (IN(11)) { PH_PTRS; for (int rep_ = 0; rep_ < NREP(11); ++rep_) {
        LAS float* km = (LAS float*)(L + RING_OFF);
        LAS float* mv = (LAS float*)(L + RING_OFF + 16384);
        LAS int* mi = (LAS int*)(L + RING_OFF + 16384 + 3072);
        LAS int* lcnt = (LAS int*)(L + RING_OFF + 24576);
        for (int u = vcu; u < BATCH * MB_H * (MB_NB - 1); u += G) {
            const int bh = u / 31, o = 1 + u % 31, b = bh >> 3, h = bh & 7;
            for (int e = tid; e < 32 * 128; e += 512) km[e] = (float)kmean[(size_t)bh * 4096 + e] * (1.0f / (65536.0f * 256.0f));
            if (tid < 32) lcnt[tid] = 0;
            __syncthreads();
            const int ql = tid & 255, half = tid >> 8; const int s = o * 256 + ql;
            const bf16* qp = QKV + (size_t)(b * SEQ + s) * NQKV + h * 128;
            float qf[128];
#pragma unroll
            for (int c = 0; c < 16; ++c) { const v4u v = *(const GAS v4u*)(qp + c * 8);
#pragma unroll
                for (int q = 0; q < 4; ++q) { qf[c * 8 + 2 * q] = __uint_as_float(v[q] << 16); qf[c * 8 + 2 * q + 1] = __uint_as_float(v[q] & 0xffff0000u); } }
            float v0 = -INFINITY, v1 = -INFINITY, v2 = -INFINITY; int i0 = -1, i1 = -1, i2 = -1;
            for (int jj = 0; jj < 16; ++jj) { const int j = half * 16 + jj;
                if (j < o) { float g = 0.f; const LAS f32x4* kr = (const LAS f32x4*)(km + j * 128);
#pragma unroll
                    for (int c = 0; c < 32; ++c) { const f32x4 kv = kr[c]; g += qf[4 * c] * kv.x + qf[4 * c + 1] * kv.y + qf[4 * c + 2] * kv.z + qf[4 * c + 3] * kv.w; }
                    if (g > v0) { v2 = v1; i2 = i1; v1 = v0; i1 = i0; v0 = g; i0 = j; } else if (g > v1) { v2 = v1; i2 = i1; v1 = g; i1 = j; } else if (g > v2) { v2 = g; i2 = j; } } }
            if (half == 1) { mv[ql * 3] = v0; mv[ql * 3 + 1] = v1; mv[ql * 3 + 2] = v2; mi[ql * 3] = i0; mi[ql * 3 + 1] = i1; mi[ql * 3 + 2] = i2; }
            __syncthreads();
            int lp0 = 0, lp1 = 0, lp2 = 0;
            if (half == 0) {
#pragma unroll
                for (int k = 0; k < 3; ++k) { const float g = mv[ql * 3 + k]; const int j = mi[ql * 3 + k];
                    if (j >= 0) { if (g > v0) { v2 = v1; i2 = i1; v1 = v0; i1 = i0; v0 = g; i0 = j; } else if (g > v1) { v2 = v1; i2 = i1; v1 = g; i1 = j; } else if (g > v2) { v2 = g; i2 = j; } } }
                if (i0 >= 0) lp0 = __hip_atomic_fetch_add(&lcnt[i0], 1, __ATOMIC_RELAXED, __HIP_MEMORY_SCOPE_WORKGROUP);
                if (i1 >= 0) lp1 = __hip_atomic_fetch_add(&lcnt[i1], 1, __ATOMIC_RELAXED, __HIP_MEMORY_SCOPE_WORKGROUP);
                if (i2 >= 0) lp2 = __hip_atomic_fetch_add(&lcnt[i2], 1, __ATOMIC_RELAXED, __HIP_MEMORY_SCOPE_WORKGROUP);
            }
            __syncthreads();
            if (tid < 32 && rep_ == 0) { const int n = lcnt[tid]; lcnt[32 + tid] = n ? (int)__hip_atomic_fetch_add(ctl + CW_MOBACNT + bh * 32 + tid, (unsigned)n, RLX_AGENT) : 0; }
            __syncthreads();
            if (half == 0 && rep_ == 0) { int* lb = lists + (size_t)bh * LIST_PER_BH;
                if (i0 >= 0) lb[list_off(i0) + lcnt[32 + i0] + lp0] = s;
                if (i1 >= 0) lb[list_off(i1) + lcnt[32 + i1] + lp1] = s | (1 << 16);
                if (i2 >= 0) lb[list_off(i2) + lcnt[32 + i2] + lp2] = s | (2 << 16); }
            __syncthreads();
        }
        } SEAM(11);
    }
    if (IN(12)) { PH_PTRS; for (int rep_ = 0; rep_ < NREP(12); ++rep_) {
        LAS int* pre = (LAS int*)(L + 153600);
        { const unsigned c0 = __hip_atomic_load(ctl + CW_MOBACNT + tid, RLX_AGENT), c1 = __hip_atomic_load(ctl + CW_MOBACNT + 512 + tid, RLX_AGENT);
          pre[tid] = (int)((c0 + 1023u) >> 10); pre[512 + tid] = (int)((c1 + 1023u) >> 10); }
        __syncthreads();
        if (tid == 0) { int a = 0; for (int k = 0; k < 1024; ++k) { const int n = pre[k]; pre[k] = a; a += n; } pre[1024] = a; }
        __syncthreads();
        const int nlu = pre[1024];
        const int r32_ = lane & 31;
        for (;;) {
            __syncthreads();
            if (tid == 0) MISC[60] = __hip_atomic_fetch_add(ctl + CW_Q + (rep_ ? 16 : 0), 1u, RLX_AGENT);
            __syncthreads();
            const int u = (int)MISC[60];
            if (u >= nlu) break;
            int loI = 0, hiI = 1024;
            while (hiI - loI > 1) { const int mid = (loI + hiI) >> 1; if (pre[mid] <= u) loI = mid; else hiI = mid; }
            const int bhj = loI, grp = u - pre[bhj], bh = bhj >> 5, kb = bhj & 31, b = bh >> 3, h = bh & 7;
            const int cnt = (int)__hip_atomic_load(ctl + CW_MOBACNT + bhj, RLX_AGENT);
            const int e0 = grp * 1024, n = (cnt - e0) < 1024 ? (cnt - e0) : 1024, nsub = (n + 31) >> 5;
            const moba::bf16* Kh = (const moba::bf16*)QKV + ((size_t)b * SEQ + kb * 256) * NQKV + 1024 + h * 128;
            moba::moba_load_block(Kh, Kh + 1024, (char*)lds);
            asm volatile("s_waitcnt vmcnt(0) lgkmcnt(0)\n\ts_barrier" ::: "memory");
            for (int sc = wave; sc < nsub; sc += 8) {
                const int ei = e0 + sc * 32 + r32_; const bool valid = ei < cnt;
                const int ent = valid ? lists[(size_t)bh * LIST_PER_BH + list_off(kb) + ei] : 0;
                const int s = ent & 0xffff, mli = (bh * SEQ + s) * 3 + (ent >> 16);
                const moba::bf16* qrow = (const moba::bf16*)QKV + ((size_t)b * SEQ + s) * NQKV + h * 128;
                moba::moba_sub<false>(3, qrow, (moba::bf16*)PO, 128, valid ? mli : -1, pml, mli, 0, (char*)lds, wave);
            }
        }
        for (;;) {
            __syncthreads();
            if (tid == 0) MISC[60] = __hip_atomic_fetch_add(ctl + CW_Q + 1 + (rep_ ? 16 : 0), 1u, RLX_AGENT);
            __syncthreads();
            const int ou = (int)MISC[60];
            if (ou >= 1024) break;
            const int b = ou >> 8, h = (ou >> 5) & 7, kb = ou & 31;
            const moba::bf16* Kh = (const moba::bf16*)QKV + ((size_t)b * SEQ + kb * 256) * NQKV + 1024 + h * 128;
            moba::moba_load_block(Kh, Kh + 1024, (char*)lds);
            const int s = kb * 256 + wave * 32 + r32_;
            const moba::bf16* qrow = (const moba::bf16*)QKV + ((size_t)b * SEQ + s) * NQKV + h * 128;
            asm volatile("s_waitcnt vmcnt(0) lgkmcnt(0)\n\ts_barrier" ::: "memory");
            moba::moba_sub<true>(wave >> 1, qrow, (moba::bf16*)OB + h * 128, DM, b * SEQ + s, ownml, (b * 8 + h) * SEQ + s, wave * 32 + r32_, (char*)lds, wave);
        }
        } SEAM(12);
    }
    if (IN(13)) { PH_PTRS; for (int rep_ = 0; rep_ < NREP(13); ++rep_) {
        const int hh = lane >> 3, dd = (lane & 7) * 16;
        for (int m0 = gw; m0 < TOK; m0 += 2 * NGW) {
            v4u A0[2], A1[2], Q0[2][3], Q1[2][3]; float mm[2][4], ll[2][4];
#pragma unroll
            for (int u = 0; u < 2; ++u) { const int m = (m0 + u * NGW < TOK) ? m0 + u * NGW : m0;
                const int b = m >> 13, s = m & 8191, nv = (s >> 8) < 3 ? (s >> 8) : 3; const int qi = (b * 8 + hh) * SEQ + s;
                mm[u][0] = ownml[2 * (size_t)qi]; ll[u][0] = ownml[2 * (size_t)qi + 1];
                const bf16* op = OB + (size_t)m * DM + hh * 128 + dd; A0[u] = *(const GAS v4u*)op; A1[u] = *(const GAS v4u*)(op + 8);
#pragma unroll
                for (int r = 0; r < 3; ++r) { if (r < nv) { mm[u][1 + r] = pml[2 * ((size_t)qi * 3 + r)]; ll[u][1 + r] = pml[2 * ((size_t)qi * 3 + r) + 1];
                        const bf16* pp = PO + ((size_t)qi * 3 + r) * 128 + dd; Q0[u][r] = *(const GAS v4u*)pp; Q1[u][r] = *(const GAS v4u*)(pp + 8); }
                    else { mm[u][1 + r] = -1e30f; ll[u][1 + r] = 0.f; Q0[u][r] = (v4u){0u, 0u, 0u, 0u}; Q1[u][r] = (v4u){0u, 0u, 0u, 0u}; } } }
#pragma unroll
            for (int u = 0; u < 2; ++u) { const int m = m0 + u * NGW; if (m < TOK) {
                float M = fmaxf(fmaxf(mm[u][0], mm[u][1]), fmaxf(mm[u][2], mm[u][3]));
                float w[4], wsum = 0.f;
#pragma unroll
                for (int r = 0; r < 4; ++r) { w[r] = ll[u][r] * __builtin_amdgcn_exp2f(mm[u][r] - M); wsum += w[r]; }
                const float inv = 1.f / wsum;
                float acc16[16];
                { const v4u a0 = A0[u], a1 = A1[u]; const float ww = w[0] * inv;
#pragma unroll
                  for (int k = 0; k < 4; ++k) { acc16[2 * k] = ww * __uint_as_float(a0[k] << 16); acc16[2 * k + 1] = ww * __uint_as_float(a0[k] & 0xffff0000u); acc16[8 + 2 * k] = ww * __uint_as_float(a1[k] << 16); acc16[8 + 2 * k + 1] = ww * __uint_as_float(a1[k] & 0xffff0000u); } }
#pragma unroll
                for (int r = 0; r < 3; ++r) { const v4u a0 = Q0[u][r], a1 = Q1[u][r]; const float ww = w[1 + r] * inv;
#pragma unroll
                    for (int k = 0; k < 4; ++k) { acc16[2 * k] += ww * __uint_as_float(a0[k] << 16); acc16[2 * k + 1] += ww * __uint_as_float(a0[k] & 0xffff0000u); acc16[8 + 2 * k] += ww * __uint_as_float(a1[k] << 16); acc16[8 + 2 * k + 1] += ww * __uint_as_float(a1[k] & 0xffff0000u); } }
                float mx = 0.f;
#pragma unroll
                for (int k = 0; k < 16; ++k) mx = fmaxf(mx, fabsf(acc16[k]));
#pragma unroll
                for (int o = 1; o < 64; o <<= 1) mx = fmaxf(mx, __shfl_xor(mx, o));
                const float invq = mx > 0.f ? 127.0f / mx : 0.f;
                v4u wq;
#pragma unroll
                for (int k = 0; k < 4; ++k) { const int q0 = (int)__builtin_rintf(acc16[4 * k] * invq), q1 = (int)__builtin_rintf(acc16[4 * k + 1] * invq), q2 = (int)__builtin_rintf(acc16[4 * k + 2] * invq), q3 = (int)__builtin_rintf(acc16[4 * k + 3] * invq);
                    wq[k] = (unsigned)(q0 & 255) | ((unsigned)(q1 & 255) << 8) | ((unsigned)(q2 & 255) << 16) | ((unsigned)(q3 & 255) << 24); }
                *(GAS v4u*)(OBQ + (size_t)m * DM + hh * 128 + dd) = wq;
                if (lane == 0) SO1[m] = mx * (1.0f / 127.0f); } }
        }
        } SEAM(13);
    }
    if (IN(14)) { PH_PTRS; for (int rep_ = 0; rep_ < NREP(14); ++rep_) {
        pg8::ABDense ab{(const pg8::bf16_t*)OBQ, (const pg8::bf16_t*)W1o, DM / 2}; pg8::TileOrder S; S.init(TOK / 256, DM / 256, G, bx);
        pg8::EpiResBQ E{Rb, Rb, DM, nullptr, SO1, CMO1, pg8::MoeMap{0, nullptr}, 1.0f, RSS(3), nullptr, nullptr, nullptr, 0.f, nullptr, nullptr};
        pg8::gemm_phase<pg8::EpiResBQ, pg8::ABDense, GEMM_ALIGN>(L + RING_OFF, ab, S, E);
        } SEAM(14);
    }
    if (IN(15)) { PH_PTRS; for (int rep_ = 0; rep_ < NREP(15); ++rep_) {
        {
            const int gt = (vcu * NWAVES + wave) * 64 + lane, NT_ = G * NWAVES * 64;
            for (int e = gt; e < 2 * SLOTS; e += NT_) { slot_tok[e] = -1; slot_gate[e] = 0.f; slot_sa[e] = 0.f; }
        }
        if (rep_ == 0) {
            f32x4 gv[4]; load_gain(norm_ffn + DM, gv, lane);
            float wr_[16][8];
#pragma unroll
            for (int j = 0; j < 4; ++j)
#pragma unroll
                for (int q = 0; q < 4; ++q) { const int k = 4 * lane + 256 * j + q; const f32x4 a = *(const GAS f32x4*)(moe_router + (size_t)k * 8) * gv[j][q], c = *(const GAS f32x4*)(moe_router + (size_t)k * 8 + 4) * gv[j][q];
                    wr_[4 * j + q][0] = a.x; wr_[4 * j + q][1] = a.y; wr_[4 * j + q][2] = a.z; wr_[4 * j + q][3] = a.w; wr_[4 * j + q][4] = c.x; wr_[4 * j + q][5] = c.y; wr_[4 * j + q][6] = c.z; wr_[4 * j + q][7] = c.w; }
            for (int m = gw; m < TOK; m += NGW) {
                f32x4 v[4];
                { const GAS unsigned long long* r8 = (const GAS unsigned long long*)(Rb + (size_t)m * DM) + lane;
#pragma unroll
                  for (int j = 0; j < 4; ++j) { const unsigned long long w = r8[64 * j]; const unsigned lo32 = (unsigned)w, hi32 = (unsigned)(w >> 32);
                      v[j].x = __uint_as_float(lo32 << 16); v[j].y = __uint_as_float(lo32 & 0xffff0000u); v[j].z = __uint_as_float(hi32 << 16); v[j].w = __uint_as_float(hi32 & 0xffff0000u); } }
                float lg[8];
#pragma unroll
                for (int e = 0; e < 8; ++e) { float a = 0.f;
#pragma unroll
                    for (int j = 0; j < 4; ++j) a += v[j].x * wr_[4 * j][e] + v[j].y * wr_[4 * j + 1][e] + v[j].z * wr_[4 * j + 2][e] + v[j].w * wr_[4 * j + 3][e];
                    lg[e] = wave_sum(a); }
                const float rs = 1.f / sqrtf((float)RSS(3)[m] * (5.9604644775390625e-8f / DM) + NORM_EPS);
#pragma unroll
                for (int e = 0; e < 8; ++e) lg[e] *= rs;
                {
                    float mx = 0.f;
#pragma unroll
                    for (int j = 0; j < 4; ++j) mx = fmaxf(fmaxf(mx, fmaxf(fabsf(v[j].x), fabsf(v[j].y))), fmaxf(fabsf(v[j].z), fabsf(v[j].w)));
#pragma unroll
                    for (int o = 1; o < 64; o <<= 1) mx = fmaxf(mx, __shfl_xor(mx, o));
                    const float inv = mx > 0.f ? 127.0f / mx : 0.f;
                    GAS unsigned* aq = (GAS unsigned*)(AQ + (size_t)m * DM) + lane;
#pragma unroll
                    for (int j = 0; j < 4; ++j) { const int q0 = (int)__builtin_rintf(v[j].x * inv), q1 = (int)__builtin_rintf(v[j].y * inv), q2 = (int)__builtin_rintf(v[j].z * inv), q3 = (int)__builtin_rintf(v[j].w * inv);
                        aq[64 * j] = (unsigned)(q0 & 255) | ((unsigned)(q1 & 255) << 8) | ((unsigned)(q2 & 255) << 16) | ((unsigned)(q3 & 255) << 24); }
                    if (lane == 0) SA[m] = mx * rs * (1.0f / 127.0f);
                }
                int e0 = 0; float l0 = lg[0];
#pragma unroll
                for (int e = 1; e < 8; ++e) if (lg[e] > l0) { l0 = lg[e]; e0 = e; }
                int e1 = -1; float l1 = -INFINITY;
#pragma unroll
                for (int e = 0; e < 8; ++e) if (e != e0 && lg[e] > l1) { l1 = lg[e]; e1 = e; }
                if (lane == 0) {
                    const float g0 = 1.f / (1.f + expf(l1 - l0)), g1 = 1.f - g0;
                    const int p0 = (int)__hip_atomic_fetch_add((LAS unsigned*)(L + MISC_OFF) + 40 + e0, 1u, __ATOMIC_RELAXED, __HIP_MEMORY_SCOPE_WORKGROUP), p1 = (int)__hip_atomic_fetch_add((LAS unsigned*)(L + MISC_OFF) + 48 + e1, 1u, __ATOMIC_RELAXED, __HIP_MEMORY_SCOPE_WORKGROUP);
                    tok_e[m] = e0; tok_e[TOK + m] = e1; tok_pos[m] = p0; tok_pos[TOK + m] = p1; tok_gate[m] = g0; tok_gate[TOK + m] = g1;
                }
            }
            LDS_WAIT(); __syncthreads();
            if (tid < 16) { const unsigned n = MISC[40 + tid]; wg_base[vcu * 16 + tid] = n ? (int)__hip_atomic_fetch_add(ctl + CW_MOECNT + tid, n, RLX_AGENT) : 0; }
        }
        {
            LAS float* scr = (LAS float*)(L + RING_OFF + wave * 16384);
            LAS float* cmw = (LAS float*)(L + 132096);
            const float* gk1 = norm_ffn + DM;
            for (int st = vcu; st < NEXP * (DM / 32); st += G) {
                const int e = st >> 5, nb = st & 31; const float* W = moe_w2 + (size_t)e * FF1 * DM;
                f32x4 mx = (f32x4){0.f, 0.f, 0.f, 0.f}; (void)wstrip_max(W, DM, 7 * wave, 7, nb, lane, nullptr, mx);
                if (lane < 8) { LAS float* d = cmw + wave * 32 + lane * 4; d[0] = mx.x; d[1] = mx.y; d[2] = mx.z; d[3] = mx.w; }
                LDS_WAIT(); __syncthreads();
                float cm = 0.f;
#pragma unroll
                for (int w8 = 0; w8 < 8; ++w8) cm = fmaxf(cm, cmw[w8 * 32 + (lane & 31)]);
                if (wave == 0 && lane < 32) CMAX2[e * DM + nb * 32 + lane] = __float_as_uint(cm);
                strip_quant<0>(W, FF1, DM, WM2 + (size_t)e * DM * FF1, cm, scr, 7 * wave, 7, nb, lane, nullptr);
                __syncthreads();
            }
            float ssA = 0.f, ssB = 0.f;
            LAS float* Lf = (LAS float*)(L + RING_OFF);
            for (int it = vcu; it < 2 * NEXP * (FF1 / 32); it += G) {
                const int mat = it / (FF1 / 32), nb = it % (FF1 / 32), e = mat >> 1; const bool w3 = (mat & 1) != 0;
                const float* W = (w3 ? moe_w3 : moe_w1) + (size_t)e * DM * FF1;
                const int n0 = 32 * nb, kr = lane >> 3, nc = (lane & 7) * 4;
                f32x4 mx = (f32x4){0.f, 0.f, 0.f, 0.f}; float ss = 0.f;
#pragma unroll
                for (int bt = 0; bt < 2; ++bt) { f32x4 v[8];
#pragma unroll
                    for (int i = 0; i < 8; ++i) v[i] = *(const GAS f32x4*)(W + (size_t)(128 * wave + bt * 64 + i * 8 + kr) * FF1 + n0 + nc);
#pragma unroll
                    for (int i = 0; i < 8; ++i) { const int k = 128 * wave + bt * 64 + i * 8 + kr; v[i] = v[i] * gk1[k];
                        mx.x = fmaxf(mx.x, fabsf(v[i].x)); mx.y = fmaxf(mx.y, fabsf(v[i].y)); mx.z = fmaxf(mx.z, fabsf(v[i].z)); mx.w = fmaxf(mx.w, fabsf(v[i].w));
                        ss += (v[i].x * v[i].x + v[i].y * v[i].y) + (v[i].z * v[i].z + v[i].w * v[i].w);
                        LAS float* d = Lf + k * 32; const int sw = k & 31; d[(nc + 0) ^ sw] = v[i].x; d[(nc + 1) ^ sw] = v[i].y; d[(nc + 2) ^ sw] = v[i].z; d[(nc + 3) ^ sw] = v[i].w; } }
                if (w3) ssB += ss; else ssA += ss;
#pragma unroll
                for (int o = 8; o < 64; o <<= 1) { mx.x = fmaxf(mx.x, __shfl_xor(mx.x, o)); mx.y = fmaxf(mx.y, __shfl_xor(mx.y, o)); mx.z = fmaxf(mx.z, __shfl_xor(mx.z, o)); mx.w = fmaxf(mx.w, __shfl_xor(mx.w, o)); }
                if (lane < 8) { LAS float* d = cmw + wave * 32 + lane * 4; d[0] = mx.x; d[1] = mx.y; d[2] = mx.z; d[3] = mx.w; }
                LDS_WAIT(); __syncthreads();
                const int n = lane & 31, hh = lane >> 5;
                float cm = 0.f;
#pragma unroll
                for (int w8 = 0; w8 < 8; ++w8) cm = fmaxf(cm, cmw[w8 * 32 + n]);
                const int row = w3 ? maprow<4>(n0 + n) : maprow<3>(n0 + n);
                if (wave == 0 && lane < 32) CMAX13[e * 2 * FF1 + row] = __float_as_uint(cm);
                const float inv = cm > 0.f ? 127.0f / cm : 0.f;
                signed char* wt = WM13 + (size_t)e * 2 * FF1 * DM + (size_t)row * DM + 128 * wave + 64 * hh;
#pragma unroll
                for (int q16 = 0; q16 < 4; ++q16) { v4u o;
#pragma unroll
                    for (int dq = 0; dq < 4; ++dq) { unsigned pk = 0;
#pragma unroll
                        for (int b = 0; b < 4; ++b) { const int k = 128 * wave + 64 * hh + 16 * q16 + 4 * dq + b; const int q = (int)__builtin_rintf(Lf[k * 32 + (n ^ (k & 31))] * inv); pk |= (unsigned)(q & 255) << (8 * b); }
                        o[dq] = pk; }
                    *(GAS v4u*)(wt + 16 * q16) = o; }
                LDS_WAIT(); __syncthreads();
            }
            ssA = wave_sum(ssA); ssB = wave_sum(ssB);
            if (lane == 0) { __hip_atomic_fetch_add(SSTOT, (unsigned long long)(ssA * 16777216.0f), __ATOMIC_RELAXED, __HIP_MEMORY_SCOPE_AGENT); __hip_atomic_fetch_add(SSTOT + 1, (unsigned long long)(ssB * 16777216.0f), __ATOMIC_RELAXED, __HIP_MEMORY_SCOPE_AGENT); }
        }
        } SEAM(15);
    }
#define MOE_CUM() do { if (tid < 2) { int a = 0; for (int e = 0; e < 8; ++e) { MISC[16 + 9 * tid + e] = (unsigned)a; a += (int)((__hip_atomic_load(ctl + CW_MOECNT + 8 * tid + e, RLX_AGENT) + 255u) >> 8); } MISC[16 + 9 * tid + 8] = (unsigned)a; } __syncthreads(); } while (0)
    if (IN(16)) { PH_PTRS; for (int rep_ = 0; rep_ < NREP(16); ++rep_) {
        MOE_CUM();
        const int gt = (vcu * NWAVES + wave) * 64 + lane, NT_ = G * NWAVES * 64;
        for (int e = gt; e < 2 * TOK; e += NT_) { const int r = e >= TOK ? 1 : 0; const int ex = tok_e[e]; const int t_ = e - r * TOK; const int slot = (int)MISC[16 + 9 * r + ex] * 256 + wg_base[((t_ % NGW) >> 3) * 16 + r * 8 + ex] + tok_pos[e];
            slot_tok[r * SLOTS + slot] = e - r * TOK; slot_gate[r * SLOTS + slot] = tok_gate[e]; slot_sa[r * SLOTS + slot] = SA[e - r * TOK]; }
        } SEAM(16);
    }
#define MOE_SU() (8.0f * sqrtf(((float)SSTOT[0] * (5.9604644775390625e-8f / (NEXP * FF1))) * ((float)SSTOT[1] * (5.9604644775390625e-8f / (NEXP * FF1)))))
#define MOE_UP_BOTH() do { MOE_CUM(); \
        const pg8::MoeMap mp{(int)MISC[16 + 8], (const LAS int*)(L + MISC_OFF + 4 * 16)}; \
        pg8::ABMoeUp ab{(const pg8::bf16_t*)AQ, (const pg8::bf16_t*)WM13, DM / 2, slot_tok, mp, (size_t)2 * FF1 * (DM / 2)}; \
        pg8::TileOrder S; S.init((int)MISC[16 + 8] + (int)MISC[16 + 9 + 8], (2 * FF1) / 256, G, bx); \
        pg8::EpiSwiGLUQ E{UM, FF1, slot_sa, CMAX13, nullptr, mp, 127.0f / MOE_SU(), nullptr}; \
        pg8::gemm_phase<pg8::EpiSwiGLUQ, pg8::ABMoeUp, GEMM_ALIGN>(L + RING_OFF, ab, S, E); } while (0)
#define MOE_DOWN_BOTH() do { MOE_CUM(); \
        const pg8::MoeMap mp{(int)MISC[16 + 8], (const LAS int*)(L + MISC_OFF + 4 * 16)}; \
        pg8::ABMoeDown ab{(const pg8::bf16_t*)UM, (const pg8::bf16_t*)WM2, FF1 / 2, mp, (size_t)DM * (FF1 / 2)}; \
        pg8::TileOrder S; S.init((int)MISC[16 + 8] + (int)MISC[16 + 9 + 8], DM / 256, G, bx); \
        pg8::EpiResBQ E{Rb, Rb, DM, slot_tok, slot_gate, CMAX2, mp, MOE_SU() * (1.0f / 127.0f), nullptr, Y1B, nullptr, nullptr, 0.f, nullptr, nullptr}; \
        pg8::gemm_phase<pg8::EpiResBQ, pg8::ABMoeDown, GEMM_ALIGN>(L + RING_OFF, ab, S, E); } while (0)
    if (IN(17)) { PH_PTRS; for (int rep_ = 0; rep_ < NREP(17); ++rep_) MOE_UP_BOTH(); SEAM(17); }
    if (IN(18)) { PH_PTRS; MOE_DOWN_BOTH(); SEAM(18); }
    if (IN(21)) { PH_PTRS;
        f32x4 gv[4]; load_gain(final_norm, gv, lane);
        for (int m0 = gw; m0 < TOK; m0 += 4 * NGW) {
            unsigned long long w[4][4], y[4][4];
#pragma unroll
            for (int u = 0; u < 4; ++u) { const int m = (m0 + u * NGW < TOK) ? m0 + u * NGW : m0; const GAS unsigned long long* r8 = (const GAS unsigned long long*)(Rb + (size_t)m * DM) + lane; const GAS unsigned long long* y8 = (const GAS unsigned long long*)(Y1B + (size_t)m * DM) + lane;
#pragma unroll
                for (int j = 0; j < 4; ++j) { w[u][j] = r8[64 * j]; y[u][j] = y8[64 * j]; } }
#pragma unroll
            for (int u = 0; u < 4; ++u) { const int m = m0 + u * NGW; if (m < TOK) {
                f32x4 v[4]; float s = 0.f;
#pragma unroll
                for (int j = 0; j < 4; ++j) { const unsigned lo32 = (unsigned)w[u][j], hi32 = (unsigned)(w[u][j] >> 32), ylo = (unsigned)y[u][j], yhi = (unsigned)(y[u][j] >> 32);
                    v[j].x = __uint_as_float(lo32 << 16) + __uint_as_float(ylo << 16); v[j].y = __uint_as_float(lo32 & 0xffff0000u) + __uint_as_float(ylo & 0xffff0000u);
                    v[j].z = __uint_as_float(hi32 << 16) + __uint_as_float(yhi << 16); v[j].w = __uint_as_float(hi32 & 0xffff0000u) + __uint_as_float(yhi & 0xffff0000u);
                    s += (v[j].x * v[j].x + v[j].y * v[j].y) + (v[j].z * v[j].z + v[j].w * v[j].w); }
                const float rstd = 1.f / sqrtf(wave_sum(s) * (1.f / DM) + NORM_EPS);
                GAS f32x4* o = (GAS f32x4*)(out + (size_t)m * DM) + lane;
#pragma unroll
                for (int j = 0; j < 4; ++j) o[64 * j] = v[j] * rstd * gv[j]; } }
        }
    }
#undef IN
#undef SEAM
#undef GRID_BAR
}
constexpr int N_PHASES = 22;

extern "C" void kernel_launch(void* const* d_in, const int* in_sizes, int n_in, void* d_out, int out_size, void* d_ws, size_t ws_size, hipStream_t stream) {
    static int grid = 0;
    if (grid == 0) {
        if (n_in != 20 || in_sizes[0] != TOK * DM || out_size != TOK * DM || ws_size < WS_END) { fprintf(stderr, "kernel_launch: shape / workspace mismatch (n_in %d, in0 %d, out %d, ws %zu, need %zu); nothing launched\n", n_in, n_in > 0 ? in_sizes[0] : -1, out_size, ws_size, (size_t)WS_END); grid = -1; return; }
        int dev = 0, cus = 0, per_cu = 0;
        if (hipGetDevice(&dev) != hipSuccess || hipDeviceGetAttribute(&cus, hipDeviceAttributeMultiprocessorCount, dev) != hipSuccess) { grid = -1; return; }
        if (hipFuncSetAttribute((const void*)mk_fwd, hipFuncAttributeMaxDynamicSharedMemorySize, LDS_BYTES) != hipSuccess) { fprintf(stderr, "kernel_launch: hipFuncSetAttribute failed\n"); grid = -1; return; }
        if (hipOccupancyMaxActiveBlocksPerMultiprocessor(&per_cu, (const void*)mk_fwd, NWAVES * 64, LDS_BYTES) != hipSuccess || per_cu < 1) fprintf(stderr, "kernel_launch: occupancy query reports %d workgroups per CU\n", per_cu);
        (void)hipGetLastError();
        grid = cus;
    }
    if (grid < 0) return;
    if (hipMemsetAsync((char*)d_ws + WS_CTL, 0, CTL_ZERO_BYTES, stream) != hipSuccess) return;
    Args a{};
    for (int i = 0; i < 20; ++i) a.in[i] = (const float*)d_in[i];
    a.out = (float*)d_out; a.ws = (unsigned char*)d_ws;
    for (int i = 0; i < 8; ++i) a.inv64[i] = (float)pow(500000.0, -(double)(2 * i) / 16.0);
    for (int i = 0; i < 16; ++i) a.inv128[i] = (float)pow(500000.0, -(double)(2 * i) / 32.0);
#if MK_PER_PHASE
    for (int p = 0; p < N_PHASES; ++p) { a.ph_lo = p; a.ph_hi = p + 1; hipLaunchKernelGGL(mk_fwd, dim3(grid), dim3(NWAVES * 64), LDS_BYTES, stream, a); }
#else
    a.ph_lo = 0; a.ph_hi = N_PHASES;
    hipLaunchKernelGGL(mk_fwd, dim3(grid), dim3(NWAVES * 64), LDS_BYTES, stream, a);
#ifdef PROBE_LIST
    {
        static const int probe[] = {PROBE_LIST};
        for (int k : probe) { a.ph_lo = k; a.ph_hi = k + 1;
            a.out = (k == 3 || k == 12 || k == 13 || k == 18 || k == 21) ? (float*)((char*)d_ws + WS_QKV) : (float*)d_out;
            hipLaunchKernelGGL(mk_fwd, dim3(grid), dim3(NWAVES * 64), LDS_BYTES, stream, a); }
    }
#endif
#endif
    const hipError_t le = hipPeekAtLastError();
    if (le != hipSuccess) fprintf(stderr, "kernel_launch: launch failed: %s\n", hipGetErrorName(le));
}
```

```cpp
#include <hip/hip_runtime.h>
#include <hip/hip_bf16.h>
#include <cstdio>
#include <cstdint>
#include <cmath>
namespace pg8 {
#define PG8_LAS __attribute__((address_space(3)))
typedef unsigned short bf16_t;
typedef short bf16x8 __attribute__((ext_vector_type(8)));
typedef float f32x4 __attribute__((ext_vector_type(4)));
typedef unsigned u32x4 __attribute__((ext_vector_type(4)));
constexpr int BM = 256, BK = 64, HALF = 128, HTB = HALF * BK * 2  , STAGE_BYTES = 8 * HTB, NXCD = 8, WGM = 8;

__host__ __device__ __forceinline__ int lds_byte(int r, int c) { const int st = (r >> 4) * 2 + (c >> 5), rr = r & 15, cc = c & 31, ob = rr * 64 + cc * 2; return st * 1024 + (ob ^ (((ob >> 9) & 1) << 5)); }
__host__ __device__ __forceinline__ void stage_rc(int b, int& R, int& C) { const int st = b / 1024, sb = b % 1024, swz = sb ^ (((sb >> 9) & 1) << 5); R = (st >> 1) * 16 + swz / 64; C = (st & 1) * 32 + (swz % 64) / 2; }
__host__ __device__ __forceinline__ int perm32(int rho) { const int n = rho >> 4, i = rho & 15; return 8 * (i >> 2) + 4 * n + (i & 3); }

struct Unit { int pm, pn; };

struct TileOrder {
    int nM, nN, nwg, G, c;
    __device__ __forceinline__ void init(int nM_, int nN_, int G_, int c_) { nM = nM_; nN = nN_; nwg = nM * nN; G = G_; c = c_; }
    __device__ __forceinline__ bool next(int i, Unit& u) const {
        const long L = (long)i * G + c; if (L >= nwg) return false;
        int wgid = (int)L; { const int q = nwg / NXCD, r = nwg % NXCD, xcd = wgid % NXCD, off = wgid / NXCD; wgid = (xcd < r ? xcd * (q + 1) : r * (q + 1) + (xcd - r) * q) + off; }
        const int nig = WGM * nN, gid = wgid / nig, fm = gid * WGM, gsz = (nM - fm) < WGM ? (nM - fm) : WGM;
        u.pm = fm + ((wgid % nig) % gsz); u.pn = (wgid % nig) / gsz; return true;
    }
};

struct ABDense {
    static constexpr bool GATHER = false;
    const bf16_t* A; const bf16_t* Bt; int K;
    __device__ __forceinline__ const char* abase(const Unit& u) const { return (const char*)A + (size_t)u.pm * BM * K * 2; }
    __device__ __forceinline__ const char* bbase(const Unit& u) const { return (const char*)Bt + (size_t)u.pn * BM * K * 2; }
    __device__ __forceinline__ const int* tokp(const Unit&) const { return nullptr; }
};
struct MoeMap { int T0; const PG8_LAS int* cum;
    __device__ __forceinline__ int mt(int pm) const { return pm < T0 ? pm : pm + (136 - T0); }
    __device__ __forceinline__ int expert(int mtile) const { const int r = mtile >= 136 ? 1 : 0, loc = mtile - 136 * r; int e = 0;
#pragma unroll
        for (int k = 1; k < 8; ++k) e += (loc >= cum[9 * r + k]) ? 1 : 0; return e; }
};
struct ABMoeUp {
    static constexpr bool GATHER = true;
    const bf16_t* A; const bf16_t* Bt; int K; const int* slot_tok; MoeMap mp; size_t estride;
    __device__ __forceinline__ const char* abase(const Unit&) const { return (const char*)A; }
    __device__ __forceinline__ const char* bbase(const Unit& u) const { return (const char*)(Bt + (size_t)mp.expert(mp.mt(u.pm)) * estride) + (size_t)u.pn * BM * K * 2; }
    __device__ __forceinline__ const int* tokp(const Unit& u) const { return slot_tok + mp.mt(u.pm) * BM; }
};
struct ABMoeDown {
    static constexpr bool GATHER = false;
    const bf16_t* A; const bf16_t* Bt; int K; MoeMap mp; size_t estride;
    __device__ __forceinline__ const char* abase(const Unit& u) const { return (const char*)A + (size_t)mp.mt(u.pm) * BM * K * 2; }
    __device__ __forceinline__ const char* bbase(const Unit& u) const { return (const char*)(Bt + (size_t)mp.expert(mp.mt(u.pm)) * estride) + (size_t)u.pn * BM * K * 2; }
    __device__ __forceinline__ const int* tokp(const Unit&) const { return nullptr; }
};

__device__ __forceinline__ unsigned cvt_pk_bf16(float lo, float hi) { unsigned r; asm volatile("v_cvt_pk_bf16_f32 %0, %1, %2" : "=v"(r) : "v"(lo), "v"(hi)); return r; }

template <int DH> struct EpiQKV {
    static constexpr bool PERM = true; typedef f32x4 acc_t;
    bf16_t* O; int ldc; const float* ct; const float* st; float qscale; const unsigned long long* rss; int* kms;
    __device__ __forceinline__ void operator()(const f32x4 (&acc)[2][2][4][2], const Unit& u, int wr, int wc, int fr, int fq) const {
        constexpr int NF = DH / 8;
        const int row0 = u.pm * BM + wr * 64 + fr, col0 = u.pn * BM + wc * 32 + 8 * fq;
        const int sect = u.pn >> 2;
        const float sc = (sect == 0) ? qscale : 1.f;
        const bool rot = (sect < 2) && (DH == 64 ? (((wc & 1) == 0) && (fq < 2)) : (wc == 0));
        f32x4 ksum[2][2] = {{(f32x4){0.f, 0.f, 0.f, 0.f}, (f32x4){0.f, 0.f, 0.f, 0.f}}, {(f32x4){0.f, 0.f, 0.f, 0.f}, (f32x4){0.f, 0.f, 0.f, 0.f}}};
        unsigned long long rq[8];
#pragma unroll
        for (int i = 0; i < 8; ++i) rq[i] = rss[row0 + (i >> 2) * HALF + (i & 3) * 16];
#pragma unroll
        for (int ai = 0; ai < 2; ++ai) {
            f32x4 c4[4], s4[4];
#pragma unroll
            for (int m = 0; m < 4; ++m) { const int pos = (row0 + ai * HALF + m * 16) & 8191; c4[m] = (f32x4){1.f, 1.f, 1.f, 1.f}; s4[m] = (f32x4){0.f, 0.f, 0.f, 0.f};
                if (rot) { c4[m] = *(const f32x4*)(ct + pos * NF + 4 * fq); s4[m] = *(const f32x4*)(st + pos * NF + 4 * fq); } }
#pragma unroll
            for (int m = 0; m < 4; ++m) {
                const int row = row0 + ai * HALF + m * 16; const float rs = sc * __builtin_amdgcn_rsqf((float)rq[ai * 4 + m] * (5.9604644775390625e-8f / 1024.0f) + 1e-6f);
                bf16_t* rowp = O + (size_t)row * ldc + col0;
#pragma unroll
                for (int bj = 0; bj < 2; ++bj) {
                    const f32x4 x1 = acc[ai][bj][m][0], x2 = acc[ai][bj][m][1];
                    f32x4 v0 = (x1 * c4[m] - x2 * s4[m]) * rs, v1 = (x2 * c4[m] + x1 * s4[m]) * rs;
                    u32x4 w; w.x = cvt_pk_bf16(v0[0], v0[1]); w.y = cvt_pk_bf16(v0[2], v0[3]); w.z = cvt_pk_bf16(v1[0], v1[1]); w.w = cvt_pk_bf16(v1[2], v1[3]);
                    *(u32x4*)(rowp + bj * HALF) = w;
                    if (DH == 128) { ksum[bj][0] += v0; ksum[bj][1] += v1; } }
            }
        }
        if (DH == 128 && kms && sect == 1) {
            const int blk = u.pm;
            int* dst = kms + ((size_t)((blk >> 5) * 8 + ((u.pn & 3) * 2)) * 32 + (blk & 31)) * 128;
#pragma unroll
            for (int bj = 0; bj < 2; ++bj)
#pragma unroll
                for (int n = 0; n < 2; ++n)
#pragma unroll
                    for (int c = 0; c < 4; ++c) { float s = ksum[bj][n][c];
                        s += __shfl_xor(s, 1); s += __shfl_xor(s, 2); s += __shfl_xor(s, 4); s += __shfl_xor(s, 8);
                        if (fr == 0) __hip_atomic_fetch_add(dst + bj * 32 * 128 + wc * 32 + 8 * fq + 4 * n + c, (int)__builtin_rintf(s * 65536.0f), __ATOMIC_RELAXED, __HIP_MEMORY_SCOPE_AGENT); }
        }
    }
};

typedef int i32x4_q __attribute__((ext_vector_type(4)));
template <int DH> struct EpiQKVQ {
    static constexpr bool PERM = true; typedef i32x4_q acc_t;
    bf16_t* O; int ldc; const float* ct; const float* st; float qscale; const float* sa; const unsigned* cm; int* kms; const unsigned long long* rss;
    __device__ __forceinline__ void operator()(const i32x4_q (&acc)[2][2][4][2], const Unit& u, int wr, int wc, int fr, int fq) const {
        constexpr int NF = DH / 8;
        const int row0 = u.pm * BM + wr * 64 + fr, col0 = u.pn * BM + wc * 32 + 8 * fq;
        const int sect = u.pn >> 2;
        const float sc = (sect == 0) ? qscale : 1.f;
        const bool rot = (sect < 2) && (DH == 64 ? (((wc & 1) == 0) && (fq < 2)) : (wc == 0));
        f32x4 ksum[2][2] = {{(f32x4){0.f, 0.f, 0.f, 0.f}, (f32x4){0.f, 0.f, 0.f, 0.f}}, {(f32x4){0.f, 0.f, 0.f, 0.f}, (f32x4){0.f, 0.f, 0.f, 0.f}}};
        float cmv[2][8];
#pragma unroll
        for (int bj = 0; bj < 2; ++bj)
#pragma unroll
            for (int k = 0; k < 8; ++k) cmv[bj][k] = __uint_as_float(cm[col0 + bj * HALF + k]) * (1.0f / 127.0f);
        float rq[8];
#pragma unroll
        for (int i = 0; i < 8; ++i) { const int row = row0 + (i >> 2) * HALF + (i & 3) * 16; rq[i] = sa[row];
            if (rss) rq[i] *= (1.0f / 127.0f) * __builtin_amdgcn_rsqf((float)rss[row] * (5.9604644775390625e-8f / 1024.0f) + 1e-6f); }
#pragma unroll
        for (int ai = 0; ai < 2; ++ai) {
            f32x4 c4[4], s4[4];
#pragma unroll
            for (int m = 0; m < 4; ++m) { const int pos = (row0 + ai * HALF + m * 16) & 8191; c4[m] = (f32x4){1.f, 1.f, 1.f, 1.f}; s4[m] = (f32x4){0.f, 0.f, 0.f, 0.f};
                if (sect < 2) {
                    const int ti = rot ? pos * NF + 4 * fq : 0; const f32x4 cl = *(const f32x4*)(ct + ti), sl = *(const f32x4*)(st + ti);
                    c4[m] = rot ? cl : c4[m]; s4[m] = rot ? sl : s4[m]; } }
#pragma unroll
            for (int m = 0; m < 4; ++m) {
                const int row = row0 + ai * HALF + m * 16; const float rs = sc * rq[ai * 4 + m];
                bf16_t* rowp = O + (size_t)row * ldc + col0;
#pragma unroll
                for (int bj = 0; bj < 2; ++bj) {
                    const i32x4_q i1 = acc[ai][bj][m][0], i2 = acc[ai][bj][m][1];
                    const f32x4 x1 = (f32x4){(float)i1[0] * cmv[bj][0], (float)i1[1] * cmv[bj][1], (float)i1[2] * cmv[bj][2], (float)i1[3] * cmv[bj][3]}, x2 = (f32x4){(float)i2[0] * cmv[bj][4], (float)i2[1] * cmv[bj][5], (float)i2[2] * cmv[bj][6], (float)i2[3] * cmv[bj][7]};
                    f32x4 v0 = (x1 * c4[m] - x2 * s4[m]) * rs, v1 = (x2 * c4[m] + x1 * s4[m]) * rs;
                    u32x4 w; w.x = cvt_pk_bf16(v0[0], v0[1]); w.y = cvt_pk_bf16(v0[2], v0[3]); w.z = cvt_pk_bf16(v1[0], v1[1]); w.w = cvt_pk_bf16(v1[2], v1[3]);
                    *(u32x4*)(rowp + bj * HALF) = w;
                    if (DH == 128) { ksum[bj][0] += v0; ksum[bj][1] += v1; } }
            }
        }
        if (DH == 128 && kms && sect == 1) {
            const int blk = u.pm;
            int* dst = kms + ((size_t)((blk >> 5) * 8 + ((u.pn & 3) * 2)) * 32 + (blk & 31)) * 128;
#pragma unroll
            for (int bj = 0; bj < 2; ++bj)
#pragma unroll
                for (int n = 0; n < 2; ++n)
#pragma unroll
                    for (int c = 0; c < 4; ++c) { float s = ksum[bj][n][c];
                        s += __shfl_xor(s, 1); s += __shfl_xor(s, 2); s += __shfl_xor(s, 4); s += __shfl_xor(s, 8);
                        if (fr == 0) __hip_atomic_fetch_add(dst + bj * 32 * 128 + wc * 32 + 8 * fq + 4 * n + c, (int)__builtin_rintf(s * 65536.0f), __ATOMIC_RELAXED, __HIP_MEMORY_SCOPE_AGENT); }
        }
    }
};

__device__ __forceinline__ float silu_mul(float a, float b) { return a * b * __builtin_amdgcn_rcpf(1.0f + __builtin_amdgcn_exp2f(-1.4426950408889634f * a)); }
struct EpiSwiGLU {
    static constexpr bool PERM = true; typedef f32x4 acc_t;
    bf16_t* O; int ldc; const float* gate; const unsigned long long* rss; const int* rowmap;
    __device__ __forceinline__ void operator()(const f32x4 (&acc)[2][2][4][2], const Unit& u, int wr, int wc, int fr, int fq) const {
        const int row0 = u.pm * BM + wr * 64 + fr, col0 = u.pn * HALF + wc * 32 + 8 * fq;
#pragma unroll
        for (int ai = 0; ai < 2; ++ai)
#pragma unroll
            for (int m = 0; m < 4; ++m) {
                const int row = row0 + ai * HALF + m * 16; const float g = gate ? gate[row] : 1.f; const int trow = rowmap ? rowmap[row] : row;
                const float rs = trow >= 0 ? __builtin_amdgcn_rsqf((float)rss[trow] * (5.9604644775390625e-8f / 1024.0f) + 1e-6f) : 0.f;
                const f32x4 a0 = acc[ai][0][m][0] * rs, a1 = acc[ai][0][m][1] * rs, b0 = acc[ai][1][m][0] * rs, b1 = acc[ai][1][m][1] * rs;
                float v[8];
#pragma unroll
                for (int k = 0; k < 4; ++k) { v[k] = g * silu_mul(a0[k], b0[k]); v[4 + k] = g * silu_mul(a1[k], b1[k]); }
                u32x4 w; w.x = cvt_pk_bf16(v[0], v[1]); w.y = cvt_pk_bf16(v[2], v[3]); w.z = cvt_pk_bf16(v[4], v[5]); w.w = cvt_pk_bf16(v[6], v[7]);
                *(u32x4*)(O + (size_t)row * ldc + col0) = w; }
    }
};
struct EpiResB {
    static constexpr bool PERM = true; typedef f32x4 acc_t;
    const bf16_t* Rin; bf16_t* Rout; int ldc; const int* rowmap; unsigned long long* rss_out;
    __device__ __forceinline__ void operator()(const f32x4 (&acc)[2][2][4][2], const Unit& u, int wr, int wc, int fr, int fq) const {
        const int row0 = u.pm * BM + wr * 64 + fr, col0 = u.pn * BM + wc * 32 + 8 * fq;
        int orow[8];
#pragma unroll
        for (int i = 0; i < 8; ++i) { const int row = row0 + (i >> 2) * HALF + (i & 3) * 16; orow[i] = rowmap ? rowmap[row] : row; }
#pragma unroll
        for (int ai = 0; ai < 2; ++ai) {
            u32x4 bw[4][2];
#pragma unroll
            for (int m = 0; m < 4; ++m)
#pragma unroll
                for (int bj = 0; bj < 2; ++bj) bw[m][bj] = orow[ai * 4 + m] >= 0 ? *(const u32x4*)(Rin + (size_t)orow[ai * 4 + m] * ldc + col0 + bj * HALF) : (u32x4){0u, 0u, 0u, 0u};
#pragma unroll
            for (int m = 0; m < 4; ++m) { const int o_ = orow[ai * 4 + m]; float ss = 0.f;
                if (o_ >= 0) { bf16_t* wp = Rout + (size_t)o_ * ldc + col0;
#pragma unroll
                    for (int bj = 0; bj < 2; ++bj) { const u32x4 w = bw[m][bj]; const f32x4 a0 = acc[ai][bj][m][0], a1 = acc[ai][bj][m][1];
                        float v[8];
                        v[0] = __uint_as_float(w.x << 16) + a0[0]; v[1] = __uint_as_float(w.x & 0xffff0000u) + a0[1]; v[2] = __uint_as_float(w.y << 16) + a0[2]; v[3] = __uint_as_float(w.y & 0xffff0000u) + a0[3];
                        v[4] = __uint_as_float(w.z << 16) + a1[0]; v[5] = __uint_as_float(w.z & 0xffff0000u) + a1[1]; v[6] = __uint_as_float(w.w << 16) + a1[2]; v[7] = __uint_as_float(w.w & 0xffff0000u) + a1[3];
#pragma unroll
                        for (int k = 0; k < 8; ++k) ss += v[k] * v[k];
                        u32x4 o; o.x = cvt_pk_bf16(v[0], v[1]); o.y = cvt_pk_bf16(v[2], v[3]); o.z = cvt_pk_bf16(v[4], v[5]); o.w = cvt_pk_bf16(v[6], v[7]);
                        *(u32x4*)(wp + bj * HALF) = o; } }
                if (rss_out) { ss += __shfl_xor(ss, 16); ss += __shfl_xor(ss, 32);
                    if (fq == 0) __hip_atomic_fetch_add(rss_out + o_, (unsigned long long)(ss * 16777216.0f), __ATOMIC_RELAXED, __HIP_MEMORY_SCOPE_AGENT); } }
        }
    }
};

typedef int i32x4_e __attribute__((ext_vector_type(4)));
struct EpiSwiGLUQ {
    static constexpr bool PERM = true; typedef i32x4_e acc_t;
    signed char* O; int ldc; const float* sa; const unsigned* cm; const int* rowmap; MoeMap mp; float qmul; const unsigned long long* rss;
    __device__ __forceinline__ void operator()(const i32x4_e (&acc)[2][2][4][2], const Unit& u, int wr, int wc, int fr, int fq) const {
        const int mtile = mp.cum ? mp.mt(u.pm) : u.pm; const int e = mp.cum ? mp.expert(mtile) : 0;
        const unsigned* cme = cm + (size_t)e * 7168 + u.pn * BM + wc * 32 + 8 * fq;
        f32x4 cA[2], cAB[2];
#pragma unroll
        for (int h = 0; h < 2; ++h)
#pragma unroll
            for (int k = 0; k < 4; ++k) { cA[h][k] = __uint_as_float(cme[4 * h + k]) * (1.0f / 127.0f); cAB[h][k] = cA[h][k] * (__uint_as_float(cme[HALF + 4 * h + k]) * (1.0f / 127.0f)); }
        const int row0 = mtile * BM + wr * 64 + fr, col0 = u.pn * HALF + wc * 32 + 8 * fq;
        float srow[8];
#pragma unroll
        for (int i = 0; i < 8; ++i) { const int row = row0 + (i >> 2) * HALF + (i & 3) * 16; const int trow = rowmap ? rowmap[row] : row; srow[i] = trow >= 0 ? sa[trow] : 0.f;
            if (rss) srow[i] *= (1.0f / 127.0f) * __builtin_amdgcn_rsqf((float)rss[trow] * (5.9604644775390625e-8f / 1024.0f) + 1e-6f); }
#pragma unroll
        for (int ai = 0; ai < 2; ++ai)
#pragma unroll
            for (int m = 0; m < 4; ++m) {
                const int row = row0 + ai * HALF + m * 16; const float s = srow[ai * 4 + m];
                const float sneg = -1.4426950408889634f * s, s2q = s * s * qmul;
                unsigned pk[2];
#pragma unroll
                for (int h = 0; h < 2; ++h) {
                    const f32x4 fa = __builtin_convertvector(acc[ai][0][m][h], f32x4), fb = __builtin_convertvector(acc[ai][1][m][h], f32x4);
                    const f32x4 t = (fa * cA[h]) * sneg;
                    f32x4 e; e.x = __builtin_amdgcn_exp2f(t.x); e.y = __builtin_amdgcn_exp2f(t.y); e.z = __builtin_amdgcn_exp2f(t.z); e.w = __builtin_amdgcn_exp2f(t.w);
                    const f32x4 d = e + 1.0f;
                    f32x4 sg; sg.x = __builtin_amdgcn_rcpf(d.x); sg.y = __builtin_amdgcn_rcpf(d.y); sg.z = __builtin_amdgcn_rcpf(d.z); sg.w = __builtin_amdgcn_rcpf(d.w);
                    const f32x4 uq = (((fa * fb) * cAB[h]) * s2q) * sg + 128.0f;
                    unsigned w = 0u;
                    w = __builtin_amdgcn_cvt_pk_u8_f32(__builtin_rintf(uq.x), 0, w); w = __builtin_amdgcn_cvt_pk_u8_f32(__builtin_rintf(uq.y), 1, w);
                    w = __builtin_amdgcn_cvt_pk_u8_f32(__builtin_rintf(uq.z), 2, w); w = __builtin_amdgcn_cvt_pk_u8_f32(__builtin_rintf(uq.w), 3, w);
                    pk[h] = w ^ 0x80808080u; }
                *(unsigned long long*)(O + (size_t)row * ldc + col0) = (unsigned long long)pk[0] | ((unsigned long long)pk[1] << 32); }
    }
};
struct EpiResBQ {
    static constexpr bool PERM = true; typedef i32x4_e acc_t;
    const bf16_t* Rin; bf16_t* Rout; int ldc; const int* rowmap; const float* gate; const unsigned* cm; MoeMap mp; float dq; unsigned long long* rss_out; bf16_t* Y1; signed char* Aq; const float* amx_in; float amx_mul; unsigned* amx_out; float* qs_out;
    __device__ __forceinline__ void operator()(const i32x4_e (&acc)[2][2][4][2], const Unit& u, int wr, int wc, int fr, int fq) const {
        const int mtile = mp.cum ? mp.mt(u.pm) : u.pm; const int e = mp.cum ? mp.expert(mtile) : 0; const bool second = mp.cum && mtile >= 136;
        const int row0 = mtile * BM + wr * 64 + fr, col0 = u.pn * BM + wc * 32 + 8 * fq;
        const unsigned* cme = cm + (size_t)e * 1024 + col0;
        float sb[2][8];
#pragma unroll
        for (int bj = 0; bj < 2; ++bj)
#pragma unroll
            for (int k = 0; k < 8; ++k) sb[bj][k] = __uint_as_float(cme[bj * HALF + k]) * (dq / 127.0f);
        int orow[8]; float gts[8], qsc[8];
#pragma unroll
        for (int i = 0; i < 8; ++i) { const int row = row0 + (i >> 2) * HALF + (i & 3) * 16; orow[i] = rowmap ? rowmap[row] : row; gts[i] = gate ? gate[row] : 1.f; qsc[i] = Aq ? amx_mul * amx_in[row] : 0.f; }
#pragma unroll
        for (int ai = 0; ai < 2; ++ai) {
            u32x4 bw[4][2];
#pragma unroll
            for (int m = 0; m < 4; ++m)
#pragma unroll
                for (int bj = 0; bj < 2; ++bj) bw[m][bj] = (orow[ai * 4 + m] >= 0 && !second) ? *(const u32x4*)(Rin + (size_t)orow[ai * 4 + m] * ldc + col0 + bj * HALF) : (u32x4){0u, 0u, 0u, 0u};
#pragma unroll
            for (int m = 0; m < 4; ++m) { const int o_ = orow[ai * 4 + m]; float ss = 0.f, vmx = 0.f; const float qinv = qsc[ai * 4 + m] > 0.f ? 127.0f / qsc[ai * 4 + m] : 0.f;
                if (o_ >= 0) { const float gt = gts[ai * 4 + m]; bf16_t* wp = (second ? Y1 : Rout) + (size_t)o_ * ldc + col0;
#pragma unroll
                    for (int bj = 0; bj < 2; ++bj) { const u32x4 w = bw[m][bj]; const i32x4_e a0 = acc[ai][bj][m][0], a1 = acc[ai][bj][m][1];
                        float v[8];
                        v[0] = __uint_as_float(w.x << 16) + (float)a0[0] * gt * sb[bj][0]; v[1] = __uint_as_float(w.x & 0xffff0000u) + (float)a0[1] * gt * sb[bj][1];
                        v[2] = __uint_as_float(w.y << 16) + (float)a0[2] * gt * sb[bj][2]; v[3] = __uint_as_float(w.y & 0xffff0000u) + (float)a0[3] * gt * sb[bj][3];
                        v[4] = __uint_as_float(w.z << 16) + (float)a1[0] * gt * sb[bj][4]; v[5] = __uint_as_float(w.z & 0xffff0000u) + (float)a1[1] * gt * sb[bj][5];
                        v[6] = __uint_as_float(w.w << 16) + (float)a1[2] * gt * sb[bj][6]; v[7] = __uint_as_float(w.w & 0xffff0000u) + (float)a1[3] * gt * sb[bj][7];
#pragma unroll
                        for (int k = 0; k < 8; ++k) { ss += v[k] * v[k]; vmx = fmaxf(vmx, fabsf(v[k])); }
                        u32x4 o; o.x = cvt_pk_bf16(v[0], v[1]); o.y = cvt_pk_bf16(v[2], v[3]); o.z = cvt_pk_bf16(v[4], v[5]); o.w = cvt_pk_bf16(v[6], v[7]);
                        *(u32x4*)(wp + bj * HALF) = o;
                        if (Aq) { unsigned lo = 0u, hi = 0u;
#pragma unroll
                            for (int k = 0; k < 4; ++k) { lo = __builtin_amdgcn_cvt_pk_u8_f32(__builtin_rintf(v[k] * qinv) + 128.0f, k, lo); hi = __builtin_amdgcn_cvt_pk_u8_f32(__builtin_rintf(v[4 + k] * qinv) + 128.0f, k, hi); }
                            *(unsigned long long*)(Aq + (size_t)o_ * ldc + col0 + bj * HALF) = (unsigned long long)(lo ^ 0x80808080u) | ((unsigned long long)(hi ^ 0x80808080u) << 32); } } }
                if (rss_out) { ss += __shfl_xor(ss, 16); ss += __shfl_xor(ss, 32);
                    if (fq == 0) __hip_atomic_fetch_add(rss_out + o_, (unsigned long long)(ss * 16777216.0f), __ATOMIC_RELAXED, __HIP_MEMORY_SCOPE_AGENT); }
                if (amx_out) { vmx = fmaxf(vmx, __shfl_xor(vmx, 16)); vmx = fmaxf(vmx, __shfl_xor(vmx, 32));
                    if (fq == 0) __hip_atomic_fetch_max(amx_out + o_, __float_as_uint(vmx), __ATOMIC_RELAXED, __HIP_MEMORY_SCOPE_AGENT); }
                if (qs_out && u.pn == 0 && wc == 0 && fq == 0) qs_out[o_] = qsc[ai * 4 + m]; }
        }
    }
};
typedef int i32x4 __attribute__((ext_vector_type(4)));
__device__ __forceinline__ f32x4 mma16(bf16x8 a, bf16x8 b, f32x4 c) { return __builtin_amdgcn_mfma_f32_16x16x32_bf16(a, b, c, 0, 0, 0); }
__device__ __forceinline__ i32x4 mma16(bf16x8 a, bf16x8 b, i32x4 c) { return __builtin_amdgcn_mfma_i32_16x16x64_i8(__builtin_bit_cast(i32x4, a), __builtin_bit_cast(i32x4, b), c, 0, 0, 0); }
template <class Epi, class AB, bool ALIGN_EPI = true>
__device__ __forceinline__ void gemm_phase(PG8_LAS unsigned char* lds, const AB ab, const TileOrder& S, const Epi& E) {
    int tid = threadIdx.x; asm volatile("" : "+v"(tid));
    const int wid = __builtin_amdgcn_readfirstlane(tid >> 6), lane = tid & 63, wr = wid >> 2, wc = wid & 3, fr = lane & 15, fq = lane >> 4;
    const int K = ab.K, nt = K / BK;
    int Rr[2], Cc[2]; unsigned voffB[2];
#pragma unroll
    for (int i = 0; i < 2; ++i) { int R, C; stage_rc(tid * 16 + i * 8192, R, C); const int Rb = Epi::PERM ? ((R & ~31) + perm32(R & 31)) : R;
        Rr[i] = R; Cc[i] = C; voffB[i] = (unsigned)(Rb * K + C) * 2u; }
    const size_t kstep = (size_t)(BK * 2);
    const size_t hstep = (size_t)HALF * K * 2;
    const unsigned ldsw = (unsigned)wid * 1024u;
    const int aoff = lds_byte(wr * 64 + fr, fq * 8), boff = lds_byte(wc * 32 + fr, fq * 8);
#define PG8_SA(b, h) (((b) * 2 + (h)) * HTB)
#define PG8_SB(b, h) ((4 + (b) * 2 + (h)) * HTB)
#define PG8_STAGE(bufoff, gbase, voff) do { _Pragma("unroll") for (int _i = 0; _i < 2; ++_i) \
        __builtin_amdgcn_global_load_lds((const unsigned*)((const char*)(gbase) + (voff)[_i]), (PG8_LAS unsigned*)(lds + (bufoff) + ldsw + _i * 8192), 16, 0, 0); } while (0)
#define PG8_LDA(dst, b, h) do { _Pragma("unroll") for (int m = 0; m < 4; ++m) _Pragma("unroll") for (int k = 0; k < 2; ++k) dst[m][k] = *(const PG8_LAS bf16x8*)(lds + PG8_SA(b, h) + aoff + m * 2048 + k * 1024); } while (0)
#define PG8_LDB(dst, b, h) do { _Pragma("unroll") for (int n = 0; n < 2; ++n) _Pragma("unroll") for (int k = 0; k < 2; ++k) dst[n][k] = *(const PG8_LAS bf16x8*)(lds + PG8_SB(b, h) + boff + n * 2048 + k * 1024); } while (0)
#define PG8_MMA(ai, bj, At, Bt) do { __builtin_amdgcn_s_setprio(1); _Pragma("unroll") for (int m = 0; m < 4; ++m) _Pragma("unroll") for (int n = 0; n < 2; ++n) _Pragma("unroll") for (int k = 0; k < 2; ++k) \
        acc[ai][bj][m][n] = mma16(Bt[n][k], At[m][k], acc[ai][bj][m][n]); __builtin_amdgcn_s_setprio(0); } while (0)
#define PG8_WAIT_V(n) asm volatile("s_waitcnt vmcnt(" #n ")" ::: "memory")
#define PG8_WAIT_L(n) asm volatile("s_waitcnt lgkmcnt(" #n ")" ::: "memory")
#define PG8_BAR __builtin_amdgcn_s_barrier()
#define PG8_SCHED __builtin_amdgcn_sched_barrier(0)
    Unit cur, nxt; int ui = 0;
    if (!S.next(0, cur)) return;
    typedef typename Epi::acc_t acc_t;
    acc_t acc[2][2][4][2];
#pragma unroll
    for (int a = 0; a < 2; ++a)
#pragma unroll
        for (int b = 0; b < 2; ++b)
#pragma unroll
            for (int m = 0; m < 4; ++m)
#pragma unroll
                for (int n = 0; n < 2; ++n) acc[a][b][m][n] = (acc_t){0, 0, 0, 0};
    bf16x8 At[4][2], B0[2][2], B1[2][2];
    unsigned cv0[2], cv1[2], nv0[2], nv1[2]; int ntok[4] = {0, 0, 0, 0};
    if constexpr (AB::GATHER) { const int* tp = ab.tokp(cur);
#pragma unroll
        for (int i = 0; i < 2; ++i) { int t0 = tp[Rr[i]], t1 = tp[HALF + Rr[i]]; t0 = t0 < 0 ? 0 : t0; t1 = t1 < 0 ? 0 : t1;
            cv0[i] = (unsigned)(t0 * K + Cc[i]) * 2u; cv1[i] = (unsigned)(t1 * K + Cc[i]) * 2u; }
    } else {
#pragma unroll
        for (int i = 0; i < 2; ++i) { cv0[i] = (unsigned)(Rr[i] * K + Cc[i]) * 2u; cv1[i] = cv0[i] + (unsigned)hstep; }
    }
#pragma unroll
    for (int i = 0; i < 2; ++i) { nv0[i] = cv0[i]; nv1[i] = cv1[i]; }
    const char* cA = ab.abase(cur); const char* cB = ab.bbase(cur);
    PG8_STAGE(PG8_SB(0, 0), cB, voffB); PG8_STAGE(PG8_SB(0, 1), cB + hstep, voffB); PG8_STAGE(PG8_SA(0, 0), cA, cv0); PG8_STAGE(PG8_SA(0, 1), cA, cv1);
    if (wr == 1) PG8_BAR;
    PG8_WAIT_V(2); PG8_BAR;
    PG8_STAGE(PG8_SB(1, 0), cB + kstep, voffB); PG8_STAGE(PG8_SA(1, 0), cA + kstep, cv0); PG8_STAGE(PG8_SB(1, 1), cB + hstep + kstep, voffB);
    PG8_WAIT_V(6); PG8_BAR;
    for (;;) {
        const bool has_next = S.next(ui + 1, nxt);
        const char* nA = has_next ? ab.abase(nxt) : cA; const char* nB = has_next ? ab.bbase(nxt) : cB;
        if constexpr (AB::GATHER) {
            if (has_next) { const int* tp = ab.tokp(nxt);
                asm volatile("global_load_dword %0, %1, off" : "=v"(ntok[0]) : "v"(tp + Rr[0]) : "memory");
                asm volatile("global_load_dword %0, %1, off" : "=v"(ntok[1]) : "v"(tp + Rr[1]) : "memory");
                asm volatile("global_load_dword %0, %1, off" : "=v"(ntok[2]) : "v"(tp + HALF + Rr[0]) : "memory");
                asm volatile("global_load_dword %0, %1, off" : "=v"(ntok[3]) : "v"(tp + HALF + Rr[1]) : "memory"); }
        }
        for (int t = 0; t < nt; t += 2) {
            const bool last = (t == nt - 2);
            const char* a1 = cA + (size_t)(t + 1) * kstep;
            const char* a2 = last ? nA : cA + (size_t)(t + 2) * kstep; const char* b2 = last ? nB : cB + (size_t)(t + 2) * kstep;
            const char* a3 = a2 + kstep; const char* b3 = b2 + kstep;
            unsigned x0[2], x1[2];
            if constexpr (AB::GATHER) {
                if (last && has_next) {
                    asm volatile("s_waitcnt vmcnt(6)" : "+v"(ntok[0]), "+v"(ntok[1]), "+v"(ntok[2]), "+v"(ntok[3]) :: "memory");
#pragma unroll
                    for (int i = 0; i < 2; ++i) { int t0 = ntok[i], t1 = ntok[2 + i]; t0 = t0 < 0 ? 0 : t0; t1 = t1 < 0 ? 0 : t1;
                        nv0[i] = (unsigned)(t0 * K + Cc[i]) * 2u; nv1[i] = (unsigned)(t1 * K + Cc[i]) * 2u; }
                }
#pragma unroll
                for (int i = 0; i < 2; ++i) { x0[i] = last ? nv0[i] : cv0[i]; x1[i] = last ? nv1[i] : cv1[i]; }
            } else {
#pragma unroll
                for (int i = 0; i < 2; ++i) { x0[i] = cv0[i]; x1[i] = cv1[i]; }
            }
            PG8_LDB(B0, 0, 0); PG8_LDB(B1, 0, 1); PG8_SCHED; PG8_LDA(At, 0, 0); PG8_STAGE(PG8_SA(1, 1), a1, cv1);
            PG8_WAIT_V(8); PG8_WAIT_L(0); PG8_BAR; PG8_MMA(0, 0, At, B0); PG8_MMA(0, 1, At, B1); PG8_BAR; PG8_SCHED;
            PG8_LDA(At, 0, 1); PG8_STAGE(PG8_SB(0, 0), b2, voffB); PG8_STAGE(PG8_SB(0, 1), b2 + hstep, voffB); PG8_STAGE(PG8_SA(0, 0), a2, x0);
            PG8_WAIT_V(8); PG8_WAIT_L(0); PG8_BAR; PG8_MMA(1, 0, At, B0); PG8_MMA(1, 1, At, B1); PG8_BAR; PG8_SCHED;
            PG8_LDB(B0, 1, 0); PG8_LDB(B1, 1, 1); PG8_SCHED; PG8_LDA(At, 1, 0); PG8_STAGE(PG8_SA(0, 1), a2, x1);
            PG8_WAIT_V(8); PG8_WAIT_L(0); PG8_BAR; PG8_MMA(0, 0, At, B0); PG8_MMA(0, 1, At, B1); PG8_BAR; PG8_SCHED;
            PG8_LDA(At, 1, 1); PG8_STAGE(PG8_SB(1, 0), b3, voffB); PG8_STAGE(PG8_SB(1, 1), b3 + hstep, voffB); PG8_STAGE(PG8_SA(1, 0), a3, x0);
            PG8_WAIT_V(8); PG8_WAIT_L(0); PG8_BAR; PG8_MMA(1, 0, At, B0); PG8_MMA(1, 1, At, B1); PG8_BAR; PG8_SCHED;
        }
        if constexpr (ALIGN_EPI) { if (wr == 0) PG8_BAR; }
        E(acc, cur, wr, wc, fr, fq);
        if (!has_next) break;
#pragma unroll
        for (int a = 0; a < 2; ++a)
#pragma unroll
            for (int b = 0; b < 2; ++b)
#pragma unroll
                for (int m = 0; m < 4; ++m)
#pragma unroll
                    for (int n = 0; n < 2; ++n) acc[a][b][m][n] = (acc_t){0, 0, 0, 0};
        cur = nxt; cA = nA; cB = nB; ++ui;
#pragma unroll
        for (int i = 0; i < 2; ++i) { cv0[i] = nv0[i]; cv1[i] = nv1[i]; }
        if constexpr (ALIGN_EPI) { if (wr == 1) PG8_BAR; }
    }
    PG8_WAIT_V(0);
    if constexpr (!ALIGN_EPI) { if (wr == 0) PG8_BAR; }
    PG8_BAR;
#undef PG8_SA
#undef PG8_SB
#undef PG8_STAGE
#undef PG8_LDA
#undef PG8_LDB
#undef PG8_MMA
#undef PG8_WAIT_V
#undef PG8_WAIT_L
#undef PG8_BAR
#undef PG8_SCHED
}
}

namespace moba {
using bf16 = __hip_bfloat16;
using bf16x8 = __attribute__((ext_vector_type(8))) short;
using s16x4  = __attribute__((ext_vector_type(4))) short;
using f32x16 = __attribute__((ext_vector_type(16))) float;
using u32x4  = __attribute__((ext_vector_type(4))) unsigned;
constexpr int D = 128, NW = 8, QBLK = 32, KVBLK = 64, LDK = 3072, NT = 4;
constexpr float THR = 8.f;
constexpr size_t SHM_V = KVBLK * D * 2, SHM_K = KVBLK * D * 2, SHM_ATTN = 2 * SHM_V + 2 * SHM_K + NW * 64 * 4;
#define KSWZ(row, colB) ((row) * 256 + ((colB) ^ (((row) & 7) << 4)))
#define SBAR() __builtin_amdgcn_sched_barrier(0)
__device__ __forceinline__ int crow(int r, int hi) { return (r & 3) + 8 * (r >> 2) + 4 * hi; }
__device__ __forceinline__ unsigned cvtpk(float lo, float hi) { unsigned r; asm volatile("v_cvt_pk_bf16_f32 %0, %1, %2" : "=v"(r) : "v"(lo), "v"(hi)); return r; }
__device__ __forceinline__ void partialSM(f32x16& p0, f32x16& p1, float& m_reg, float& mn, float& alpha) {
  float pmax = p0[0];
#pragma unroll
  for (int r = 1; r < 16; ++r) pmax = fmaxf(pmax, p0[r]);
#pragma unroll
  for (int r = 0; r < 16; ++r) pmax = fmaxf(pmax, p1[r]);
  { auto rr = __builtin_amdgcn_permlane32_swap(__float_as_uint(pmax), __float_as_uint(pmax), false, false);
    pmax = fmaxf(__uint_as_float(rr[0]), __uint_as_float(rr[1])); }
  if (__builtin_expect(__all(pmax - m_reg <= THR), 1)) { mn = m_reg; alpha = 1.f; }
  else { mn = fmaxf(m_reg, pmax); alpha = __builtin_amdgcn_exp2f(m_reg - mn); m_reg = mn; }
#pragma unroll
  for (int r = 0; r < 16; ++r) p0[r] = p0[r] - mn;
#pragma unroll
  for (int r = 0; r < 16; ++r) p1[r] = p1[r] - mn;
#pragma unroll
  for (int r = 0; r < 16; ++r) p0[r] = __builtin_amdgcn_exp2f(p0[r]);
}
__device__ __forceinline__ void finishSM(f32x16& p0, f32x16& p1, float alpha, float& l_reg, bf16x8& pa0, bf16x8& pa1, bf16x8& pa2, bf16x8& pa3) {
#pragma unroll
  for (int r = 0; r < 16; ++r) p1[r] = __builtin_amdgcn_exp2f(p1[r]);
  float ps = 0;
#pragma unroll
  for (int r = 0; r < 16; ++r) ps += p0[r];
#pragma unroll
  for (int r = 0; r < 16; ++r) ps += p1[r];
  { auto rr = __builtin_amdgcn_permlane32_swap(__float_as_uint(ps), __float_as_uint(ps), false, false);
    ps = __uint_as_float(rr[0]) + __uint_as_float(rr[1]); }
  l_reg = l_reg * alpha + ps;
#define PK4(P, BASE, OUT) do { unsigned a0 = cvtpk(P[BASE + 0], P[BASE + 1]), a1 = cvtpk(P[BASE + 2], P[BASE + 3]);   \
    unsigned b0 = cvtpk(P[BASE + 4], P[BASE + 5]), b1 = cvtpk(P[BASE + 6], P[BASE + 7]);                              \
    auto r0 = __builtin_amdgcn_permlane32_swap(a0, b0, false, false); auto r1 = __builtin_amdgcn_permlane32_swap(a1, b1, false, false); \
    u32x4 w = {r0[0], r1[0], r0[1], r1[1]}; OUT = *reinterpret_cast<bf16x8*>(&w); } while (0)
  PK4(p0, 0, pa0); PK4(p0, 8, pa1); PK4(p1, 0, pa2); PK4(p1, 8, pa3);
#undef PK4
}
__device__ __forceinline__ void qkt(f32x16& p0, f32x16& p1, const bf16* Ks, const bf16x8* qr, int r32, int hi) {
  p0 = f32x16{}; p1 = f32x16{};
#pragma unroll
  for (int h2 = 0; h2 < 2; ++h2) {
    bf16x8 kf[8];
#pragma unroll
    for (int d = 0; d < 4; ++d) { int cb = ((4 * h2 + d) * 16 + hi * 8) * 2;
      kf[2 * d] = *reinterpret_cast<const bf16x8*>((const char*)Ks + KSWZ(r32, cb)); kf[2 * d + 1] = *reinterpret_cast<const bf16x8*>((const char*)Ks + KSWZ(32 + r32, cb)); }
    SBAR();
    __builtin_amdgcn_s_setprio(1);
#pragma unroll
    for (int d = 0; d < 4; ++d) { p0 = __builtin_amdgcn_mfma_f32_32x32x16_bf16(kf[2 * d], qr[4 * h2 + d], p0, 0, 0, 0); p1 = __builtin_amdgcn_mfma_f32_32x32x16_bf16(kf[2 * d + 1], qr[4 * h2 + d], p1, 0, 0, 0); }
    __builtin_amdgcn_s_setprio(0);
  }
}
__device__ __forceinline__ int v_st(int k, int c) { const int kk = (k & ~0xC) | ((k & 4) << 1) | ((k & 8) >> 1); return ((kk >> 3) * 4 + (c >> 5)) * 512 + ((kk & 7) * 32 + (c & 31)) * 2; }
__device__ __forceinline__ int v_rd_base(int lane) { return ((lane & 3) << 3) | (((lane >> 2) & 3) << 6) | (((lane >> 4) & 1) << 5) | (((lane >> 5) & 1) << 8); }
constexpr int v_rd_off(int d0, int ks, int half) { return d0 * 512 + ks * 4096 + half * 2048; }
template <int OFF> __device__ __forceinline__ s16x4 tr_read(int vb) {
  s16x4 r; asm volatile("ds_read_b64_tr_b16 %0, %1 offset:%2" : "=&v"(r) : "v"(vb), "i"(OFF) : "memory"); return r;
}
template <int D0> __device__ __forceinline__ void pv_one(f32x16& od, int vb, bf16x8 pa0, bf16x8 pa1, bf16x8 pa2, bf16x8 pa3) {
  const s16x4 l0 = tr_read<v_rd_off(D0, 0, 0)>(vb), h0 = tr_read<v_rd_off(D0, 0, 1)>(vb), l1 = tr_read<v_rd_off(D0, 1, 0)>(vb), h1 = tr_read<v_rd_off(D0, 1, 1)>(vb);
  const s16x4 l2 = tr_read<v_rd_off(D0, 2, 0)>(vb), h2 = tr_read<v_rd_off(D0, 2, 1)>(vb), l3 = tr_read<v_rd_off(D0, 3, 0)>(vb), h3 = tr_read<v_rd_off(D0, 3, 1)>(vb);
  asm volatile("s_waitcnt lgkmcnt(0)" ::: "memory"); SBAR();
  __builtin_amdgcn_s_setprio(1);
#define PK(L, H) (bf16x8){L[0], L[1], L[2], L[3], H[0], H[1], H[2], H[3]}
  od = __builtin_amdgcn_mfma_f32_32x32x16_bf16(pa0, PK(l0, h0), od, 0, 0, 0);
  od = __builtin_amdgcn_mfma_f32_32x32x16_bf16(pa1, PK(l1, h1), od, 0, 0, 0);
  od = __builtin_amdgcn_mfma_f32_32x32x16_bf16(pa2, PK(l2, h2), od, 0, 0, 0);
  od = __builtin_amdgcn_mfma_f32_32x32x16_bf16(pa3, PK(l3, h3), od, 0, 0, 0);
  __builtin_amdgcn_s_setprio(0);
#undef PK
}
__device__ __forceinline__ void pv_d0(f32x16* o, int vb, bf16x8 pa0, bf16x8 pa1, bf16x8 pa2, bf16x8 pa3) {
  pv_one<0>(o[0], vb, pa0, pa1, pa2, pa3); pv_one<1>(o[1], vb, pa0, pa1, pa2, pa3); pv_one<2>(o[2], vb, pa0, pa1, pa2, pa3); pv_one<3>(o[3], vb, pa0, pa1, pa2, pa3);
}
template <int D0> __device__ __forceinline__ void v_rd8(s16x4 (&f)[8], int vb) {
  f[0] = tr_read<v_rd_off(D0, 0, 0)>(vb); f[1] = tr_read<v_rd_off(D0, 0, 1)>(vb); f[2] = tr_read<v_rd_off(D0, 1, 0)>(vb); f[3] = tr_read<v_rd_off(D0, 1, 1)>(vb);
  f[4] = tr_read<v_rd_off(D0, 2, 0)>(vb); f[5] = tr_read<v_rd_off(D0, 2, 1)>(vb); f[6] = tr_read<v_rd_off(D0, 3, 0)>(vb); f[7] = tr_read<v_rd_off(D0, 3, 1)>(vb);
}
__device__ __forceinline__ void pv_mma4(f32x16& od, const s16x4 (&f)[8], bf16x8 pa0, bf16x8 pa1, bf16x8 pa2, bf16x8 pa3) {
#define PK(L, H) (bf16x8){L[0], L[1], L[2], L[3], H[0], H[1], H[2], H[3]}
  __builtin_amdgcn_s_setprio(1);
  od = __builtin_amdgcn_mfma_f32_32x32x16_bf16(pa0, PK(f[0], f[1]), od, 0, 0, 0);
  od = __builtin_amdgcn_mfma_f32_32x32x16_bf16(pa1, PK(f[2], f[3]), od, 0, 0, 0);
  od = __builtin_amdgcn_mfma_f32_32x32x16_bf16(pa2, PK(f[4], f[5]), od, 0, 0, 0);
  od = __builtin_amdgcn_mfma_f32_32x32x16_bf16(pa3, PK(f[6], f[7]), od, 0, 0, 0);
  __builtin_amdgcn_s_setprio(0);
#undef PK
}
__device__ __forceinline__ void pv_d0p(f32x16* o, int vb, bf16x8 pa0, bf16x8 pa1, bf16x8 pa2, bf16x8 pa3) {
  s16x4 fa[8], fb[8];
  v_rd8<0>(fa, vb); v_rd8<1>(fb, vb);
  asm volatile("s_waitcnt lgkmcnt(8)" ::: "memory"); SBAR(); pv_mma4(o[0], fa, pa0, pa1, pa2, pa3); SBAR();
  v_rd8<2>(fa, vb);
  asm volatile("s_waitcnt lgkmcnt(8)" ::: "memory"); SBAR(); pv_mma4(o[1], fb, pa0, pa1, pa2, pa3); SBAR();
  v_rd8<3>(fb, vb);
  asm volatile("s_waitcnt lgkmcnt(8)" ::: "memory"); SBAR(); pv_mma4(o[2], fa, pa0, pa1, pa2, pa3); SBAR();
  asm volatile("s_waitcnt lgkmcnt(0)" ::: "memory"); SBAR(); pv_mma4(o[3], fb, pa0, pa1, pa2, pa3); SBAR();
}
__device__ __forceinline__ void cmask(f32x16& p0, f32x16& p1, int tile, int ql, int hi) {
  asm volatile("" : "+v"(ql));
#pragma unroll
  for (int r = 0; r < 16; ++r) { const int kv = 64 * tile + (r & 3) + 8 * (r >> 2) + 4 * hi; if (kv > ql) p0[r] = -1e30f; if (kv + 32 > ql) p1[r] = -1e30f; }
}
__device__ __forceinline__ void moba_unit(const bool OWN, const bf16* qrow, const bf16* __restrict__ Kh, const bf16* __restrict__ Vh, bf16* obase, int ostride, int dst, float* ml, int mli, int ql, char* lds) {
  const int tid = threadIdx.x, wid = tid >> 6, lane = tid & 63, r32 = lane & 31, hi = lane >> 5;
  bf16* V_lds = (bf16*)lds; bf16* K_lds = (bf16*)(lds + 2 * SHM_V);
  float* ws = (float*)(lds + 2 * SHM_V + 2 * SHM_K) + wid * 64; float* li_l = ws; float* al_l = ws + 32;
  float m_reg = -1e30f, l_reg = 0; f32x16 o[4] = {}; bf16x8 qr[8];
  const bf16* Qw = qrow + hi * 8;
#pragma unroll
  for (int d0 = 0; d0 < 8; ++d0) qr[d0] = *reinterpret_cast<const bf16x8*>(Qw + d0 * 16);
  const int sr = tid >> 4, sc = (tid & 15) * 8, vst0 = v_st(sr, sc), vst1 = v_st(32 + sr, sc);
  const int vb0 = (int)(uintptr_t)V_lds + v_rd_base(lane);
  struct { bf16x8 vs0, vs1, ks0, ks1; } sr_[2];
#define SLOAD(i, k0) do { sr_[i].vs0 = *reinterpret_cast<const bf16x8*>(&Vh[(long)((k0) + sr) * LDK + sc]); sr_[i].vs1 = *reinterpret_cast<const bf16x8*>(&Vh[(long)((k0) + 32 + sr) * LDK + sc]); \
    sr_[i].ks0 = *reinterpret_cast<const bf16x8*>(&Kh[(long)((k0) + sr) * LDK + sc]); sr_[i].ks1 = *reinterpret_cast<const bf16x8*>(&Kh[(long)((k0) + 32 + sr) * LDK + sc]); } while (0)
#define SWRITE(b, i) do { *(bf16x8*)((char*)V_lds + (b) * SHM_V + vst0) = sr_[i].vs0;          \
    *(bf16x8*)((char*)V_lds + (b) * SHM_V + vst1) = sr_[i].vs1; int kc = sc * 2;               \
    *(bf16x8*)((char*)K_lds + (b) * SHM_K + KSWZ(sr, kc)) = sr_[i].ks0;                       \
    *(bf16x8*)((char*)K_lds + (b) * SHM_K + KSWZ(32 + sr, kc)) = sr_[i].ks1; } while (0)
#define SWAIT() asm volatile("s_waitcnt vmcnt(4)" ::: "memory")
#define RESC(a) do { if (__any((a) < 1.f)) { if (hi == 0) al_l[r32] = (a); asm volatile("s_waitcnt lgkmcnt(0)" ::: "memory"); \
    _Pragma("unroll") for (int d = 0; d < 4; ++d) _Pragma("unroll") for (int r = 0; r < 16; ++r) o[d][r] *= al_l[crow(r, hi)]; } } while (0)
  f32x16 pA0, pA1, pB0, pB1; float mnA, mnB, alA, alB; bf16x8 pa0, pa1, pa2, pa3;
  constexpr int SE = 0, SO = 1;
  SLOAD(SE, 0); asm volatile("s_waitcnt vmcnt(0)" ::: "memory"); SWRITE(0, SE); __syncthreads();
  qkt(pA0, pA1, K_lds, qr, r32, hi); if (OWN) cmask(pA0, pA1, 0, ql, hi); partialSM(pA0, pA1, m_reg, mnA, alA);
  SLOAD(SO, KVBLK); SLOAD(SE, 2 * KVBLK);
  SWAIT(); SWRITE(1, SO); __syncthreads();
  {
    SBAR(); qkt(pB0, pB1, (bf16*)((char*)K_lds + SHM_K), qr, r32, hi);
    finishSM(pA0, pA1, alA, l_reg, pa0, pa1, pa2, pa3); SBAR();
    SLOAD(SO, 3 * KVBLK); SBAR();
    pv_d0(o, vb0, pa0, pa1, pa2, pa3); if (OWN) cmask(pB0, pB1, 1, ql, hi); partialSM(pB0, pB1, m_reg, mnB, alB);
    __syncthreads(); SWAIT(); SWRITE(0, SE);
    RESC(alB); __syncthreads();
    SBAR(); qkt(pA0, pA1, K_lds, qr, r32, hi);
    finishSM(pB0, pB1, alB, l_reg, pa0, pa1, pa2, pa3); SBAR();
    pv_d0(o, vb0 + (int)SHM_V, pa0, pa1, pa2, pa3); if (OWN) cmask(pA0, pA1, 2, ql, hi); partialSM(pA0, pA1, m_reg, mnA, alA);
    __syncthreads(); asm volatile("s_waitcnt vmcnt(0)" ::: "memory"); SWRITE(1, SO);
    RESC(alA); __syncthreads();
  }
  SBAR(); qkt(pB0, pB1, (bf16*)((char*)K_lds + SHM_K), qr, r32, hi);
  finishSM(pA0, pA1, alA, l_reg, pa0, pa1, pa2, pa3); SBAR();
  pv_d0(o, vb0, pa0, pa1, pa2, pa3); if (OWN) cmask(pB0, pB1, 3, ql, hi); partialSM(pB0, pB1, m_reg, mnB, alB);
  __syncthreads(); RESC(alB);
  finishSM(pB0, pB1, alB, l_reg, pa0, pa1, pa2, pa3); SBAR();
  pv_d0(o, vb0 + (int)SHM_V, pa0, pa1, pa2, pa3);
  if (hi == 0) li_l[r32] = l_reg; asm volatile("s_waitcnt lgkmcnt(0)" ::: "memory");
  float rli[16];
#pragma unroll
  for (int r = 0; r < 16; ++r) rli[r] = __builtin_amdgcn_rcpf(li_l[crow(r, hi)]);
  __syncthreads();
  bf16* stg = (bf16*)lds + wid * 4096;
#pragma unroll
  for (int r = 0; r < 16; ++r) { const int orow = crow(r, hi);
#pragma unroll
    for (int d0 = 0; d0 < 4; ++d0) stg[orow * 128 + d0 * 32 + r32] = __float2bfloat16(o[d0][r] * rli[r]); }
  int* dsto = (int*)al_l;
  if (hi == 0) dsto[r32] = dst;
  asm volatile("s_waitcnt lgkmcnt(0)" ::: "memory");
#pragma unroll
  for (int i = 0; i < 8; ++i) { const int row = i * 4 + (lane >> 4), ch = lane & 15; const int di = dsto[row]; const u32x4 v = *(const u32x4*)(stg + row * 128 + ch * 8);
    if (di >= 0) *(u32x4*)(obase + (size_t)di * ostride + ch * 8) = v; }
  if (hi == 0 && dst >= 0) { ml[2 * (size_t)mli] = m_reg; ml[2 * (size_t)mli + 1] = l_reg; }
  asm volatile("s_waitcnt lgkmcnt(0)" ::: "memory");
  __syncthreads();
#undef SLOAD
#undef SWRITE
#undef SWAIT
#undef RESC
}

constexpr int MB2_K = 0, MB2_V = 65536, MB2_WV = 132096, MB2_WVB = 2560;
__device__ __forceinline__ void mb2_glds16(const void* gsrc, unsigned lds_dst) { unsigned keep;
  asm volatile("s_mov_b32 %0, m0\n\ts_mov_b32 m0, %2\n\ts_nop 0\n\tglobal_load_lds_dwordx4 %1, off\n\ts_mov_b32 m0, %0" : "=&s"(keep) : "v"(gsrc), "s"(lds_dst) : "memory"); }
__device__ __forceinline__ void moba_load_block(const bf16* __restrict__ Kh, const bf16* __restrict__ Vh, char* lds) {
  int tid = threadIdx.x; asm volatile("" : "+v"(tid)); const int lane = tid & 63; const int wid = __builtin_amdgcn_readfirstlane(tid >> 6);
  const unsigned lds0 = (unsigned)(uintptr_t)lds;
#pragma unroll
  for (int i = 0; i < 8; ++i) { const int p = wid + 8 * i; const int row = 4 * p + (lane >> 4), ch = (lane & 15) ^ (row & 7);
    mb2_glds16(Kh + (long)row * LDK + ch * 8, (unsigned)__builtin_amdgcn_readfirstlane(lds0 + MB2_K + p * 1024)); }
#pragma unroll
  for (int i = 0; i < 8; ++i) { const int q = wid + 8 * i, t = q >> 4, pi = q & 15; const int off = pi * 1024 + lane * 16, sub = off >> 9, within = (off & 511) >> 1;
    const int kk = (sub >> 2) * 8 + (within >> 5), c = (sub & 3) * 32 + (within & 31), k = (kk & ~0xC) | ((kk & 4) << 1) | ((kk & 8) >> 1);
    mb2_glds16(Vh + (long)(64 * t + k) * LDK + c, (unsigned)__builtin_amdgcn_readfirstlane(lds0 + MB2_V + q * 1024)); }
}
template <bool own> __device__ __forceinline__ void moba_sub(const int tmax, const bf16* qrow, bf16* obase, int ostride, int dst, float* ml, int mli, int ql, char* lds, int wid) {
  int tid = threadIdx.x; asm volatile("" : "+v"(tid)); const int lane = tid & 63, r32 = lane & 31, hi = lane >> 5;
  const bf16* K_lds = (const bf16*)(lds + MB2_K);
  bf16* stg = (bf16*)(lds + MB2_WV + wid * MB2_WVB); float* ws = (float*)(lds + MB2_WV + wid * MB2_WVB + 2048); float* li_l = ws; float* al_l = ws + 32;
  const int vb0 = (int)(uintptr_t)(lds + MB2_V) + v_rd_base(lane);
  float m_reg = -1e30f, l_reg = 0; f32x16 o[4] = {}; bf16x8 qr[8];
  const bf16* Qw = qrow + hi * 8;
#pragma unroll
  for (int d0 = 0; d0 < 8; ++d0) qr[d0] = *reinterpret_cast<const bf16x8*>(Qw + d0 * 16);
#define RESC(a) do { if (__any((a) < 1.f)) { if (hi == 0) al_l[r32] = (a); asm volatile("s_waitcnt lgkmcnt(0)" ::: "memory"); \
    _Pragma("unroll") for (int d = 0; d < 4; ++d) _Pragma("unroll") for (int r = 0; r < 16; ++r) o[d][r] *= al_l[crow(r, hi)]; } } while (0)
#define KT(t) ((const bf16*)((const char*)K_lds + (t) * SHM_K))
#define VT(t) (vb0 + (t) * (int)SHM_V)
  f32x16 pA0, pA1, pB0, pB1; float mnA, mnB, alA, alB; bf16x8 pa0, pa1, pa2, pa3;
  qkt(pA0, pA1, KT(0), qr, r32, hi); if (own) cmask(pA0, pA1, 0, ql, hi); partialSM(pA0, pA1, m_reg, mnA, alA);
  SBAR(); qkt(pB0, pB1, KT(1), qr, r32, hi); finishSM(pA0, pA1, alA, l_reg, pa0, pa1, pa2, pa3); SBAR();
  pv_d0p(o, VT(0), pa0, pa1, pa2, pa3); if (own) cmask(pB0, pB1, 1, ql, hi); partialSM(pB0, pB1, m_reg, mnB, alB); RESC(alB);
  SBAR(); qkt(pA0, pA1, KT(2), qr, r32, hi); finishSM(pB0, pB1, alB, l_reg, pa0, pa1, pa2, pa3); SBAR();
  pv_d0p(o, VT(1), pa0, pa1, pa2, pa3); if (own) cmask(pA0, pA1, 2, ql, hi); partialSM(pA0, pA1, m_reg, mnA, alA); RESC(alA);
  SBAR(); qkt(pB0, pB1, KT(3), qr, r32, hi); finishSM(pA0, pA1, alA, l_reg, pa0, pa1, pa2, pa3); SBAR();
  pv_d0p(o, VT(2), pa0, pa1, pa2, pa3); if (own) cmask(pB0, pB1, 3, ql, hi); partialSM(pB0, pB1, m_reg, mnB, alB); RESC(alB);
  finishSM(pB0, pB1, alB, l_reg, pa0, pa1, pa2, pa3); SBAR(); pv_d0p(o, VT(3), pa0, pa1, pa2, pa3);
  (void)tmax;
  if (hi == 0) { li_l[r32] = l_reg; ((int*)al_l)[r32] = dst; } asm volatile("s_waitcnt lgkmcnt(0)" ::: "memory");
  float rli[16];
#pragma unroll
  for (int r = 0; r < 16; ++r) rli[r] = __builtin_amdgcn_rcpf(li_l[crow(r, hi)]);
#pragma unroll
  for (int g = 0; g < 4; ++g) {
#pragma unroll
    for (int rr = 0; rr < 4; ++rr)
#pragma unroll
      for (int d0 = 0; d0 < 4; ++d0) stg[(4 * hi + rr) * 128 + d0 * 32 + r32] = __float2bfloat16(o[d0][4 * g + rr] * rli[4 * g + rr]);
    asm volatile("s_waitcnt lgkmcnt(0)" ::: "memory");
#pragma unroll
    for (int i = 0; i < 2; ++i) { const int pc = i * 64 + lane, rl = pc >> 4, ch = pc & 15; const int di = ((const int*)al_l)[8 * g + rl]; const u32x4 v = *(const u32x4*)(stg + rl * 128 + ch * 8);
      if (di >= 0) *(u32x4*)(obase + (size_t)di * ostride + ch * 8) = v; }
    asm volatile("s_waitcnt lgkmcnt(0)" ::: "memory");
  }
  if (hi == 0 && dst >= 0) { ml[2 * (size_t)mli] = m_reg; ml[2 * (size_t)mli + 1] = l_reg; }
#undef RESC
#undef KT
#undef VT
}

#define KSWZ64(row, colB) ((row) * 128 + ((colB) ^ ((((row) >> 1) & 7) << 4)))
constexpr size_t DA_SHM_K = 64 * 64 * 2;
constexpr size_t DA_SHM = 2 * SHM_V + 2 * DA_SHM_K + NW * 64 * 4;
__device__ __forceinline__ void qkt64(f32x16& p0, f32x16& p1, const bf16* Ks, const bf16x8* qr, int r32, int hi) {
  p0 = f32x16{}; p1 = f32x16{};
#pragma unroll
  for (int d0 = 0; d0 < 4; ++d0) { int cb = (d0 * 16 + hi * 8) * 2;
    bf16x8 b0 = *reinterpret_cast<const bf16x8*>((const char*)Ks + KSWZ64(r32, cb));
    bf16x8 b1 = *reinterpret_cast<const bf16x8*>((const char*)Ks + KSWZ64(32 + r32, cb));
    p0 = __builtin_amdgcn_mfma_f32_32x32x16_bf16(b0, qr[d0], p0, 0, 0, 0);
    p1 = __builtin_amdgcn_mfma_f32_32x32x16_bf16(b1, qr[d0], p1, 0, 0, 0); }
}
__device__ __forceinline__ void dattn_unit(const bf16* Qb, const bf16* __restrict__ Kh, const bf16* __restrict__ Vh, bf16* Ob, const int NT, char* lds) {
  const int tid = threadIdx.x, wid = tid >> 6, lane = tid & 63, r32 = lane & 31, hi = lane >> 5;
  bf16* V_lds = (bf16*)lds; bf16* K_lds = (bf16*)(lds + 2 * SHM_V);
  float* ws = (float*)(lds + 2 * SHM_V + 2 * DA_SHM_K) + wid * 64; float* li_l = ws; float* al_l = ws + 32;
  float m_reg = -1e30f, l_reg = 0; f32x16 o[4] = {}; bf16x8 qr[4];
  const bf16* Qw = Qb + (long)(wid * QBLK + r32) * LDK + hi * 8;
#pragma unroll
  for (int d0 = 0; d0 < 4; ++d0) qr[d0] = *reinterpret_cast<const bf16x8*>(Qw + d0 * 16);
  const int sr = tid >> 4, sc = (tid & 15) * 8, vst0 = v_st(sr, sc), vst1 = v_st(32 + sr, sc);
  const int kr = tid >> 3, kc = (tid & 7) * 8, kst = KSWZ64(kr, kc * 2);
  const int vb0 = (int)(uintptr_t)V_lds + v_rd_base(lane);
  const int ql = wid * QBLK + r32;
  struct { bf16x8 vs0, vs1, ks; } sr_[2];
#define SLOAD(i, k0) do { sr_[i].vs0 = *reinterpret_cast<const bf16x8*>(&Vh[(long)((k0) + sr) * LDK + sc]); sr_[i].vs1 = *reinterpret_cast<const bf16x8*>(&Vh[(long)((k0) + 32 + sr) * LDK + sc]); \
    sr_[i].ks = *reinterpret_cast<const bf16x8*>(&Kh[(long)((k0) + kr) * LDK + kc]); } while (0)
#define SWRITE(b, i) do { *(bf16x8*)((char*)V_lds + (b) * SHM_V + vst0) = sr_[i].vs0; *(bf16x8*)((char*)V_lds + (b) * SHM_V + vst1) = sr_[i].vs1; \
    *(bf16x8*)((char*)K_lds + (b) * DA_SHM_K + kst) = sr_[i].ks; } while (0)
#define SWAIT() asm volatile("s_waitcnt vmcnt(3)" ::: "memory")
#define RESC(a) do { if (__any((a) < 1.f)) { if (hi == 0) al_l[r32] = (a); asm volatile("s_waitcnt lgkmcnt(0)" ::: "memory"); \
    _Pragma("unroll") for (int d = 0; d < 4; ++d) _Pragma("unroll") for (int r = 0; r < 16; ++r) o[d][r] *= al_l[crow(r, hi)]; } } while (0)
#define MASK(P0, P1, t) do { if ((t) >= NT - 4) cmask(P0, P1, (t) - (NT - 4), ql, hi); } while (0)
  f32x16 pA0, pA1, pB0, pB1; float mnA, mnB, alA, alB; bf16x8 pa0, pa1, pa2, pa3;
  constexpr int SE = 0, SO = 1;
  SLOAD(SE, 0); asm volatile("s_waitcnt vmcnt(0)" ::: "memory"); SWRITE(0, SE); __syncthreads();
  qkt64(pA0, pA1, K_lds, qr, r32, hi); MASK(pA0, pA1, 0); partialSM(pA0, pA1, m_reg, mnA, alA);
  SLOAD(SO, KVBLK); SLOAD(SE, 2 * KVBLK);
  SWAIT(); SWRITE(1, SO); __syncthreads();
  for (int j = 1; j + 1 < NT; j += 2) {
    SBAR(); qkt64(pB0, pB1, (bf16*)((char*)K_lds + DA_SHM_K), qr, r32, hi);
    finishSM(pA0, pA1, alA, l_reg, pa0, pa1, pa2, pa3); SBAR();
    SLOAD(SO, (j + 2) * KVBLK); SBAR();
    pv_d0(o, vb0, pa0, pa1, pa2, pa3); MASK(pB0, pB1, j); partialSM(pB0, pB1, m_reg, mnB, alB);
    __syncthreads(); SWAIT(); SWRITE(0, SE);
    RESC(alB); __syncthreads();
    SBAR(); qkt64(pA0, pA1, K_lds, qr, r32, hi);
    finishSM(pB0, pB1, alB, l_reg, pa0, pa1, pa2, pa3); SBAR();
    if (j + 3 < NT) SLOAD(SE, (j + 3) * KVBLK); SBAR();
    pv_d0(o, vb0 + (int)SHM_V, pa0, pa1, pa2, pa3); MASK(pA0, pA1, j + 1); partialSM(pA0, pA1, m_reg, mnA, alA);
    __syncthreads(); SWAIT(); SWRITE(1, SO);
    RESC(alA); __syncthreads();
  }
  SBAR(); qkt64(pB0, pB1, (bf16*)((char*)K_lds + DA_SHM_K), qr, r32, hi);
  finishSM(pA0, pA1, alA, l_reg, pa0, pa1, pa2, pa3); SBAR();
  pv_d0(o, vb0, pa0, pa1, pa2, pa3); MASK(pB0, pB1, NT - 1); partialSM(pB0, pB1, m_reg, mnB, alB);
  __syncthreads(); RESC(alB);
  finishSM(pB0, pB1, alB, l_reg, pa0, pa1, pa2, pa3); SBAR();
  pv_d0(o, vb0 + (int)SHM_V, pa0, pa1, pa2, pa3);
  if (hi == 0) li_l[r32] = l_reg; asm volatile("s_waitcnt lgkmcnt(0)" ::: "memory");
  float rli[16];
#pragma unroll
  for (int r = 0; r < 16; ++r) rli[r] = __builtin_amdgcn_rcpf(li_l[crow(r, hi)]);
  __syncthreads();
  bf16* stg = (bf16*)lds + wid * 4096;
#pragma unroll
  for (int r = 0; r < 16; ++r) { const int orow = crow(r, hi);
#pragma unroll
    for (int d0 = 0; d0 < 4; ++d0) stg[orow * 128 + d0 * 32 + r32] = __float2bfloat16(o[d0][r] * rli[r]); }
  asm volatile("s_waitcnt lgkmcnt(0)" ::: "memory");
#pragma unroll
  for (int i = 0; i < 8; ++i) { const int row = i * 4 + (lane >> 4), ch = lane & 15; const u32x4 v = *(const u32x4*)(stg + row * 128 + ch * 8);
    *(u32x4*)(Ob + (size_t)(wid * QBLK + row) * 2048 + ch * 8) = v; }
  asm volatile("s_waitcnt lgkmcnt(0)" ::: "memory");
  __syncthreads();
#undef SLOAD
#undef SWRITE
#undef SWAIT
#undef RESC
#undef MASK
}

__device__ __forceinline__ void glds16(const void* gsrc, unsigned lds_dst) { unsigned keep;
  asm volatile("s_mov_b32 %0, m0\n\ts_mov_b32 m0, %2\n\ts_nop 0\n\tglobal_load_lds_dwordx4 %1, off\n\ts_mov_b32 m0, %0" : "=&s"(keep) : "v"(gsrc), "s"(lds_dst) : "memory"); }
#define WAIT_BAR(N) asm volatile("s_waitcnt vmcnt(" #N ") lgkmcnt(0)\n\ts_barrier" ::: "memory")
constexpr int DA2_STG = 24576;
constexpr size_t DA2_SHM = 3 * DA2_STG + NW * 64 * 4;
__device__ __forceinline__ void qkt64m(f32x16& p0, f32x16& p1, const bf16* Ks, const bf16x8* qr, bf16x8 qm, bf16x8 kneg, int r32, int hi) {
  __builtin_amdgcn_s_setprio(1);
  p0 = __builtin_amdgcn_mfma_f32_32x32x16_bf16(kneg, qm, f32x16{}, 0, 0, 0); p1 = p0;
#pragma unroll
  for (int d0 = 0; d0 < 4; ++d0) { int cb = (d0 * 16 + hi * 8) * 2;
    bf16x8 b0 = *reinterpret_cast<const bf16x8*>((const char*)Ks + KSWZ64(r32, cb));
    bf16x8 b1 = *reinterpret_cast<const bf16x8*>((const char*)Ks + KSWZ64(32 + r32, cb));
    p0 = __builtin_amdgcn_mfma_f32_32x32x16_bf16(b0, qr[d0], p0, 0, 0, 0);
    p1 = __builtin_amdgcn_mfma_f32_32x32x16_bf16(b1, qr[d0], p1, 0, 0, 0); }
  __builtin_amdgcn_s_setprio(0);
}
__device__ __forceinline__ void partialSM2(f32x16& p0, f32x16& p1, float& m_ref, bf16x8& qm, float& alpha, const bool first, const int hi) {
  float pmax = p0[0];
#pragma unroll
  for (int r = 1; r < 16; ++r) pmax = fmaxf(pmax, p0[r]);
#pragma unroll
  for (int r = 0; r < 16; ++r) pmax = fmaxf(pmax, p1[r]);
  { auto rr = __builtin_amdgcn_permlane32_swap(__float_as_uint(pmax), __float_as_uint(pmax), false, false);
    pmax = fmaxf(__uint_as_float(rr[0]), __uint_as_float(rr[1])); }
  alpha = 1.f;
  if (__builtin_expect(first || __any(pmax > THR), 0)) {
    const bool upd = first || (pmax > THR);
    const float mn = m_ref + pmax; const unsigned b = __float_as_uint(mn);
    const float mup = __uint_as_float(mn >= 0.f ? ((b + 0xFFFFu) & 0xFFFF0000u) : (b & 0xFFFF0000u));
    const float mnew = upd ? mup : m_ref; const float delta = mnew - m_ref;
    m_ref = mnew; alpha = __builtin_amdgcn_exp2f(-delta);
#pragma unroll
    for (int r = 0; r < 16; ++r) { p0[r] -= delta; p1[r] -= delta; }
    qm[0] = (hi == 0) ? (short)(__float_as_uint(m_ref) >> 16) : (short)0;
  }
#pragma unroll
  for (int r = 0; r < 16; ++r) p0[r] = __builtin_amdgcn_exp2f(p0[r]);
}
__device__ __forceinline__ void dattn_unit2(const bf16* Qb, const bf16* __restrict__ Kh, const bf16* __restrict__ Vh, bf16* Ob, const int NT, char* lds) {
  int tid = threadIdx.x; asm volatile("" : "+v"(tid)); const int lane = tid & 63, r32 = lane & 31, hi = lane >> 5; const int wid = __builtin_amdgcn_readfirstlane(tid >> 6);
  const unsigned lds0 = (unsigned)(uintptr_t)lds;
  float* ws = (float*)(lds + 3 * DA2_STG) + wid * 64; float* li_l = ws; float* al_l = ws + 32;
  const int krow = 8 * wid + (lane >> 3), kch = (lane & 7) ^ ((krow >> 1) & 7);
  const bf16* ksrc = Kh + (long)krow * LDK + kch * 8;
  const bf16* vsrc[2];
#pragma unroll
  for (int i = 0; i < 2; ++i) { const int off = (i * 8 + wid) * 1024 + lane * 16, sub = off >> 9, within = (off & 511) >> 1;
    const int kk = (sub >> 2) * 8 + (within >> 5), c = (sub & 3) * 32 + (within & 31), k = (kk & ~0xC) | ((kk & 4) << 1) | ((kk & 8) >> 1);
    vsrc[i] = Vh + (long)k * LDK + c; }
  const unsigned kdst = lds0 + wid * 1024, vdst = lds0 + 8192 + wid * 1024;
#define DMA(t, st) do { const long go_ = (long)(t) * KVBLK * LDK; glds16(ksrc + go_, (unsigned)__builtin_amdgcn_readfirstlane(kdst + (st))); \
    glds16(vsrc[0] + go_, (unsigned)__builtin_amdgcn_readfirstlane(vdst + (st))); glds16(vsrc[1] + go_, (unsigned)__builtin_amdgcn_readfirstlane(vdst + 8192 + (st))); } while (0)
  DMA(0, 0);
  float m_ref = 0.f, l_reg = 0.f; f32x16 o[4] = {}; bf16x8 qr[4]; bf16x8 qm = {0, 0, 0, 0, 0, 0, 0, 0};
  const bf16x8 kneg = {(short)(hi == 0 ? (short)0xBF80 : (short)0), 0, 0, 0, 0, 0, 0, 0};
  const bf16* Qw = Qb + (long)(wid * QBLK + r32) * LDK + hi * 8;
#pragma unroll
  for (int d0 = 0; d0 < 4; ++d0) qr[d0] = *reinterpret_cast<const bf16x8*>(Qw + d0 * 16);
  const int ql = wid * QBLK + r32;
#define RESC(a) do { if (__any((a) < 1.f)) { if (hi == 0) al_l[r32] = (a); asm volatile("s_waitcnt lgkmcnt(0)" ::: "memory"); \
    _Pragma("unroll") for (int d = 0; d < 4; ++d) _Pragma("unroll") for (int r = 0; r < 16; ++r) o[d][r] *= al_l[crow(r, hi)]; } } while (0)
#define MASK(P0, P1, t) do { if ((t) >= NT - 4) cmask(P0, P1, (t) - (NT - 4), ql, hi); } while (0)
#define KST(sx) ((const bf16*)(lds + (sx)))
#define VST(sx) ((int)(lds0 + 8192 + (sx)) + v_rd_base(lane))
  f32x16 pA0, pA1, pB0, pB1; float alA, alB; bf16x8 pa0, pa1, pa2, pa3;
  int s0 = 0, s1 = DA2_STG, s2 = 2 * DA2_STG;
  WAIT_BAR(0);
  DMA(1, DA2_STG);
  qkt64m(pA0, pA1, KST(0), qr, qm, kneg, r32, hi); MASK(pA0, pA1, 0); partialSM2(pA0, pA1, m_ref, qm, alA, true, hi);
  WAIT_BAR(2);
  DMA(2, 2 * DA2_STG);
  for (int j = 1; j + 1 < NT; j += 2) {
    SBAR(); qkt64m(pB0, pB1, KST(s1), qr, qm, kneg, r32, hi);
    finishSM(pA0, pA1, alA, l_reg, pa0, pa1, pa2, pa3); SBAR();
    pv_d0(o, VST(s0), pa0, pa1, pa2, pa3); MASK(pB0, pB1, j); partialSM2(pB0, pB1, m_ref, qm, alB, false, hi);
    WAIT_BAR(2);
    if (j + 2 < NT) DMA(j + 2, s0);
    RESC(alB);
    SBAR(); qkt64m(pA0, pA1, KST(s2), qr, qm, kneg, r32, hi);
    finishSM(pB0, pB1, alB, l_reg, pa0, pa1, pa2, pa3); SBAR();
    pv_d0(o, VST(s1), pa0, pa1, pa2, pa3); MASK(pA0, pA1, j + 1); partialSM2(pA0, pA1, m_ref, qm, alA, false, hi);
    WAIT_BAR(2);
    if (j + 3 < NT) DMA(j + 3, s1);
    RESC(alA);
    { const int t_ = s0; s0 = s2; s2 = s1; s1 = t_; }
  }
  SBAR(); qkt64m(pB0, pB1, KST(s1), qr, qm, kneg, r32, hi);
  finishSM(pA0, pA1, alA, l_reg, pa0, pa1, pa2, pa3); SBAR();
  pv_d0(o, VST(s0), pa0, pa1, pa2, pa3); MASK(pB0, pB1, NT - 1); partialSM2(pB0, pB1, m_ref, qm, alB, false, hi);
  WAIT_BAR(0);
  RESC(alB);
  finishSM(pB0, pB1, alB, l_reg, pa0, pa1, pa2, pa3); SBAR();
  pv_d0(o, VST(s1), pa0, pa1, pa2, pa3);
  if (hi == 0) li_l[r32] = l_reg; asm volatile("s_waitcnt lgkmcnt(0)" ::: "memory");
  float rli[16];
#pragma unroll
  for (int r = 0; r < 16; ++r) rli[r] = __builtin_amdgcn_rcpf(li_l[crow(r, hi)]);
  WAIT_BAR(0);
  bf16* stg = (bf16*)lds + wid * 4096;
#pragma unroll
  for (int r = 0; r < 16; ++r) { const int orow = crow(r, hi);
#pragma unroll
    for (int d0 = 0; d0 < 4; ++d0) stg[orow * 128 + d0 * 32 + r32] = __float2bfloat16(o[d0][r] * rli[r]); }
  asm volatile("s_waitcnt lgkmcnt(0)" ::: "memory");
#pragma unroll
  for (int i = 0; i < 8; ++i) { const int row = i * 4 + (lane >> 4), ch = lane & 15; const u32x4 v = *(const u32x4*)(stg + row * 128 + ch * 8);
    *(u32x4*)(Ob + (size_t)(wid * QBLK + row) * 2048 + ch * 8) = v; }
  asm volatile("s_waitcnt lgkmcnt(0)\n\ts_barrier" ::: "memory");
#undef DMA
#undef RESC
#undef MASK
#undef KST
#undef VST
}
__device__ __forceinline__ void qkt64p(f32x16& p0, f32x16& p1, const bf16* Ks, const bf16x8* qr, int r32, int hi) {
  bf16x8 kf[8];
#pragma unroll
  for (int d0 = 0; d0 < 4; ++d0) { int cb = (d0 * 16 + hi * 8) * 2;
    kf[2 * d0] = *reinterpret_cast<const bf16x8*>((const char*)Ks + KSWZ64(r32, cb)); kf[2 * d0 + 1] = *reinterpret_cast<const bf16x8*>((const char*)Ks + KSWZ64(32 + r32, cb)); }
  p0 = f32x16{}; p1 = f32x16{};
  __builtin_amdgcn_s_setprio(1);
#pragma unroll
  for (int d0 = 0; d0 < 4; ++d0) { p0 = __builtin_amdgcn_mfma_f32_32x32x16_bf16(kf[2 * d0], qr[d0], p0, 0, 0, 0); p1 = __builtin_amdgcn_mfma_f32_32x32x16_bf16(kf[2 * d0 + 1], qr[d0], p1, 0, 0, 0); }
  __builtin_amdgcn_s_setprio(0);
}
__device__ __forceinline__ bool dattn_unit3(const bf16* Qb, const bf16* __restrict__ Kh, const bf16* __restrict__ Vh, bf16* Ob, const int NT, char* lds) {
  int tid = threadIdx.x; asm volatile("" : "+v"(tid)); const int lane = tid & 63, r32 = lane & 31, hi = lane >> 5; const int wid = __builtin_amdgcn_readfirstlane(tid >> 6);
  const unsigned lds0 = (unsigned)(uintptr_t)lds;
  float* ws = (float*)(lds + 3 * DA2_STG) + wid * 64; float* li_l = ws; float* al_l = ws + 32;
  const int krow = 8 * wid + (lane >> 3), kch = (lane & 7) ^ ((krow >> 1) & 7);
  const bf16* ksrc = Kh + (long)krow * LDK + kch * 8;
  const bf16* vsrc[2];
#pragma unroll
  for (int i = 0; i < 2; ++i) { const int off = (i * 8 + wid) * 1024 + lane * 16, sub = off >> 9, within = (off & 511) >> 1;
    const int kk = (sub >> 2) * 8 + (within >> 5), c = (sub & 3) * 32 + (within & 31), k = (kk & ~0xC) | ((kk & 4) << 1) | ((kk & 8) >> 1);
    vsrc[i] = Vh + (long)k * LDK + c; }
  const unsigned kdst = lds0 + wid * 1024, vdst = lds0 + 8192 + wid * 1024;
#define DMA(t, st) do { const long go_ = (long)(t) * KVBLK * LDK; glds16(ksrc + go_, (unsigned)__builtin_amdgcn_readfirstlane(kdst + (st))); \
    glds16(vsrc[0] + go_, (unsigned)__builtin_amdgcn_readfirstlane(vdst + (st))); glds16(vsrc[1] + go_, (unsigned)__builtin_amdgcn_readfirstlane(vdst + 8192 + (st))); } while (0)
  DMA(0, 0);
  float l_reg = 0.f; f32x16 o[4] = {}; bf16x8 qr[4];
  const bf16* Qw = Qb + (long)(wid * QBLK + r32) * LDK + hi * 8;
#pragma unroll
  for (int d0 = 0; d0 < 4; ++d0) qr[d0] = *reinterpret_cast<const bf16x8*>(Qw + d0 * 16);
  const int ql = wid * QBLK + r32;
#define RESC(a) do { } while (0)
#define EXP0(P0) do { _Pragma("unroll") for (int r = 0; r < 16; ++r) P0[r] = __builtin_amdgcn_exp2f(P0[r]); } while (0)
#define MASK(P0, P1, t) do { if ((t) >= NT - 4) cmask(P0, P1, (t) - (NT - 4), ql, hi); } while (0)
#define KST(sx) ((const bf16*)(lds + (sx)))
#define VST(sx) ((int)(lds0 + 8192 + (sx)) + v_rd_base(lane))
  f32x16 pA0, pA1, pB0, pB1; const float alA = 1.f, alB = 1.f; bf16x8 pa0, pa1, pa2, pa3;
  int s0 = 0, s1 = DA2_STG, s2 = 2 * DA2_STG;
  WAIT_BAR(0);
  DMA(1, DA2_STG);
  qkt64p(pA0, pA1, KST(0), qr, r32, hi); MASK(pA0, pA1, 0); EXP0(pA0);
  WAIT_BAR(2);
  DMA(2, 2 * DA2_STG);
  for (int j = 1; j + 1 < NT; j += 2) {
    SBAR(); qkt64p(pB0, pB1, KST(s1), qr, r32, hi);
    finishSM(pA0, pA1, alA, l_reg, pa0, pa1, pa2, pa3); SBAR();
    pv_d0p(o, VST(s0), pa0, pa1, pa2, pa3); MASK(pB0, pB1, j); EXP0(pB0);
    WAIT_BAR(2);
    if (j + 2 < NT) DMA(j + 2, s0);
    RESC(alB);
    SBAR(); qkt64p(pA0, pA1, KST(s2), qr, r32, hi);
    finishSM(pB0, pB1, alB, l_reg, pa0, pa1, pa2, pa3); SBAR();
    pv_d0p(o, VST(s1), pa0, pa1, pa2, pa3); MASK(pA0, pA1, j + 1); EXP0(pA0);
    WAIT_BAR(2);
    if (j + 3 < NT) DMA(j + 3, s1);
    RESC(alA);
    { const int t_ = s0; s0 = s2; s2 = s1; s1 = t_; }
  }
  SBAR(); qkt64p(pB0, pB1, KST(s1), qr, r32, hi);
  finishSM(pA0, pA1, alA, l_reg, pa0, pa1, pa2, pa3); SBAR();
  pv_d0p(o, VST(s0), pa0, pa1, pa2, pa3); MASK(pB0, pB1, NT - 1); EXP0(pB0);
  WAIT_BAR(0);
  RESC(alB);
  finishSM(pB0, pB1, alB, l_reg, pa0, pa1, pa2, pa3); SBAR();
  pv_d0p(o, VST(s1), pa0, pa1, pa2, pa3);
  const bool bad = __any(!(l_reg > 1e-30f && l_reg < 1e30f));
  if (hi == 0) li_l[r32] = l_reg; asm volatile("s_waitcnt lgkmcnt(0)" ::: "memory");
  float rli[16];
#pragma unroll
  for (int r = 0; r < 16; ++r) rli[r] = __builtin_amdgcn_rcpf(li_l[crow(r, hi)]);
  WAIT_BAR(0);
  bf16* stg = (bf16*)lds + wid * 4096;
#pragma unroll
  for (int r = 0; r < 16; ++r) { const int orow = crow(r, hi);
#pragma unroll
    for (int d0 = 0; d0 < 4; ++d0) stg[orow * 128 + d0 * 32 + r32] = __float2bfloat16(o[d0][r] * rli[r]); }
  asm volatile("s_waitcnt lgkmcnt(0)" ::: "memory");
#pragma unroll
  for (int i = 0; i < 8; ++i) { const int row = i * 4 + (lane >> 4), ch = lane & 15; const u32x4 v = *(const u32x4*)(stg + row * 128 + ch * 8);
    *(u32x4*)(Ob + (size_t)(wid * QBLK + row) * 2048 + ch * 8) = v; }
  asm volatile("s_waitcnt lgkmcnt(0)\n\ts_barrier" ::: "memory");
#undef DMA
#undef RESC
#undef EXP0
#undef MASK
#undef KST
#undef VST
  return bad;
}
#undef WAIT_BAR
struct DaUnit { int bqh; int qb; };
struct DaOrder {
  int vcu, G;
  __device__ __forceinline__ DaOrder(int vcu_, int G_) : vcu(vcu_), G(G_) {}
  __device__ __forceinline__ bool next(int i, DaUnit& u) const {
    if (G == 256) { if (i >= 8) return false; const int s = vcu & 7, ii = i & 3; u.bqh = (i >> 2) * 32 + (vcu >> 3); u.qb = (ii == 0) ? s : (ii == 1) ? 15 - s : (ii == 2) ? 16 + s : 31 - s; return true; }
    const int uu = vcu + i * G; if (uu >= 2048) return false; u.bqh = uu >> 5; u.qb = uu & 31; return true; }
};
template <class Sched> __device__ __forceinline__ void dattn_phase(char* lds, const bf16* QKV, bf16* O, const Sched& S) {
  DaUnit u; unsigned fail = 0u;
  for (int i = 0; S.next(i, u); ++i) { const int b = u.bqh >> 4, qh = u.bqh & 15; const size_t rb = (size_t)b * 8192;
    const bool bad = dattn_unit3(QKV + (rb + u.qb * 256) * LDK + qh * 64, QKV + rb * LDK + 1024 + qh * 64, QKV + rb * LDK + 2048 + (qh >> 1) * 128, O + (rb + u.qb * 256) * 2048 + qh * 128, 4 * (u.qb + 1), lds);
    if (bad) fail |= 1u << (i & 31); }
  unsigned* fl = (unsigned*)(lds + 3 * DA2_STG) + (threadIdx.x >> 6);
  if ((threadIdx.x & 63) == 0) *fl = fail;
  __syncthreads();
  unsigned all = 0u;
#pragma unroll
  for (int w = 0; w < NW; ++w) all |= ((unsigned*)(lds + 3 * DA2_STG))[w];
  all = (unsigned)__builtin_amdgcn_readfirstlane((int)all);
  __syncthreads();
  if (all) for (int i = 0; S.next(i, u); ++i) if ((all >> (i & 31)) & 1u) { const int b = u.bqh >> 4, qh = u.bqh & 15; const size_t rb = (size_t)b * 8192;
    dattn_unit2(QKV + (rb + u.qb * 256) * LDK + qh * 64, QKV + rb * LDK + 1024 + qh * 64, QKV + rb * LDK + 2048 + (qh >> 1) * 128, O + (rb + u.qb * 256) * 2048 + qh * 128, 4 * (u.qb + 1), lds); }
}
#undef KSWZ64
#undef KSWZ
#undef SBAR
}
#define GAS __attribute__((address_space(1)))
#define LAS __attribute__((address_space(3)))
typedef unsigned short bf16;
typedef unsigned v4u __attribute__((ext_vector_type(4)));
typedef float f32x4 __attribute__((ext_vector_type(4)));
typedef short bf16x8 __attribute__((ext_vector_type(8)));
typedef GAS unsigned gu32;
typedef GAS unsigned long long gu64;
#define RLX_AGENT __ATOMIC_RELAXED, __HIP_MEMORY_SCOPE_AGENT
#define LDS_WAIT() asm volatile("s_waitcnt lgkmcnt(0)" ::: "memory")
#define VM_WAIT() asm volatile("s_waitcnt vmcnt(0)" ::: "memory")
__device__ __forceinline__ unsigned long long rt() { return __builtin_amdgcn_s_memrealtime(); }
__device__ __forceinline__ unsigned f2bf(float f) { unsigned u = __builtin_bit_cast(unsigned, f); return (u + 0x7fffu + ((u >> 16) & 1u)) >> 16; }
__device__ __forceinline__ unsigned pk2(float lo, float hi) { return f2bf(lo) | (f2bf(hi) << 16); }
#define XB_TMO      128
#define XB_XCNT(j)  (256  + 64 * (j))
#define XB_XSUB(j)  (1280 + 64 * (j))
#define XB_XGEN(j)  (2304 + 64 * (j))
#define XB_TOP      3328
#define XB_TOPGEN   3392
#define XCD_BAR_WORDS 3456
#define XB_SPIN_CAP (1u << 18)

__device__ __forceinline__ unsigned xb_ld(unsigned* p)              { return __hip_atomic_load(p, __ATOMIC_RELAXED, __HIP_MEMORY_SCOPE_AGENT); }
__device__ __forceinline__ unsigned xb_add(unsigned* p, unsigned v) { return __hip_atomic_fetch_add(p, v, __ATOMIC_RELAXED, __HIP_MEMORY_SCOPE_AGENT); }
__device__ __forceinline__ unsigned xb_xcc_id() { return (unsigned)__builtin_amdgcn_s_getreg((3 << 11) | 20) & 0xFu; }
#define XB_SPIN(cond, bar) do { unsigned _sp = 0; while (cond) { __builtin_amdgcn_s_sleep(1); \
    if ((++_sp & 255u) == 0u) { if (xb_ld(&(bar)[XB_TMO])) break; if (_sp > XB_SPIN_CAP) { atomicAdd(&(bar)[XB_TMO], 1u); break; } } } } while (0)

struct XcdBarrier {
    unsigned* bar; unsigned x;
    volatile LAS unsigned* st;
};

__device__ __forceinline__ XcdBarrier xcd_barrier_post(unsigned* bar, volatile LAS unsigned* st) {
    XcdBarrier b; b.bar = bar; b.x = xb_xcc_id(); b.st = st;
    if (threadIdx.x == 0) (void)xb_add(&bar[XB_XCNT(b.x)], 1u);
    return b;
}
__device__ __forceinline__ void xcd_barrier_complete(unsigned* bar, unsigned x, unsigned& nloc, unsigned& nx) {
    const unsigned G = gridDim.x * gridDim.y * gridDim.z;
    unsigned sum, cnt, mine, sp = 0u;
    for (;;) {
        sum = 0u; cnt = 0u; mine = 0u;
#pragma unroll
        for (unsigned j = 0; j < 16; ++j) { const unsigned c = xb_ld(&bar[XB_XCNT(j)]); sum += c; cnt += (c > 0u) ? 1u : 0u; mine = (j == x) ? c : mine; }
        if (sum == G) break;
        __builtin_amdgcn_s_sleep(1);
        if ((++sp & 255u) == 0u) { if (xb_ld(&bar[XB_TMO])) break; if (sp > XB_SPIN_CAP) { atomicAdd(&bar[XB_TMO], 1u); break; } }
    }
    nloc = mine > 0u ? mine : 1u; nx = cnt > 0u ? cnt : 1u;
}

__device__ __forceinline__ void xcd_barrier(const XcdBarrier& b) {
    asm volatile("s_waitcnt vmcnt(0)" ::: "memory");
    __syncthreads();
    if (threadIdx.x == 0) {
        unsigned* bar = b.bar;
        __builtin_amdgcn_s_waitcnt(0);
        unsigned nloc = b.st[0], nx = b.st[1];
        if (nloc == 0u) { xcd_barrier_complete(bar, b.x, nloc, nx); b.st[0] = nloc; b.st[1] = nx; }
        const unsigned old = xb_add(&bar[XB_XSUB(b.x)], 1u);
        const unsigned gen = old / nloc;
        if (old + 1u == (gen + 1u) * nloc) {
            __builtin_amdgcn_fence(__ATOMIC_RELEASE, "agent");
            asm volatile("s_waitcnt vmcnt(0)" ::: "memory");
            const unsigned og = xb_add(&bar[XB_TOP], 1u);
            const unsigned tg = og / nx;
            if (og + 1u == (tg + 1u) * nx) xb_add(&bar[XB_TOPGEN], 1u);
            else XB_SPIN(xb_ld(&bar[XB_TOPGEN]) == tg, bar);
            __builtin_amdgcn_fence(__ATOMIC_ACQUIRE, "agent");
            xb_add(&bar[XB_XGEN(b.x)], 1u);
            asm volatile("s_waitcnt vmcnt(0)" ::: "memory");
        } else {
            XB_SPIN(xb_ld(&bar[XB_XGEN(b.x)]) == gen, bar);
            __builtin_amdgcn_fence(__ATOMIC_ACQUIRE, "agent");
            asm volatile("s_waitcnt vmcnt(0)" ::: "memory");
        }
    }
    __syncthreads();
}

constexpr int NWAVES = 8;
#ifndef GEMM_ALIGN
#define GEMM_ALIGN true
#endif
#ifndef MK_PER_PHASE
#define MK_PER_PHASE 0
#endif
constexpr int BATCH = 4, SEQ = 8192, DM = 1024, TOK = BATCH * SEQ;
constexpr int FF0 = 2816, NEXP = 8, FF1 = 3584;
constexpr int NQKV = 3072;
constexpr int MB_H = 8, MB_NB = 32, MB_L = 256;
constexpr int SLOTS = TOK + NEXP * 256;
constexpr float NORM_EPS = 1e-6f, SUBLN_EPS = 1e-5f;
constexpr float LAMBDA_INIT0 = 0.2f;
constexpr float LOG2E = 1.4426950408889634f;
constexpr int LIST_PER_BH = 256 * 496;
__host__ __device__ constexpr int list_off(int j) { return 256 * (31 * j - (j * (j - 1)) / 2); }

constexpr size_t MiB = 1u << 20;
constexpr size_t WS_CTL = 0, CTL_ZERO_BYTES = 3 * MiB;
constexpr size_t WS_CMAX13 = 2 * MiB;
constexpr size_t WS_CMAX2 = WS_CMAX13 + 256 * 1024;
constexpr size_t WS_SSTOT = WS_CMAX2 + 64 * 1024;
constexpr size_t WS_CM0 = WS_CMAX2 + 128 * 1024;
constexpr size_t WS_ROPE64 = 3 * MiB;
constexpr size_t WS_ROPE128 = WS_ROPE64 + 512 * 1024;
constexpr size_t WS_KMEAN = 2 * MiB + 512 * 1024;
constexpr size_t WS_TOK = 5 * MiB;
constexpr size_t WS_SLOT = 6 * MiB;
constexpr size_t WS_SA = 7 * MiB;
constexpr size_t WS_OWNML = 41 * MiB;
constexpr size_t WS_W0QKV = 8 * MiB, WS_W0O = 14 * MiB, WS_W013 = 16 * MiB, WS_W02 = 27 * MiB, WS_W1QKV = 33 * MiB, WS_W1O = 39 * MiB;
constexpr size_t B0 = 43 * MiB;
constexpr size_t WS_H = B0;
constexpr size_t WS_QKV = B0 + 64 * MiB;
constexpr size_t WS_OATT = B0 + 256 * MiB;
constexpr size_t WS_UD = B0 + 128 * MiB;
constexpr size_t WS_LIST = B0 + 256 * MiB;
constexpr size_t WS_PML = B0 + 272 * MiB;
constexpr size_t WS_PO = B0 + 280 * MiB;
constexpr size_t WS_WM13 = B0 + 64 * MiB;
constexpr size_t WS_WM2 = WS_WM13 + 56 * MiB;
constexpr size_t WS_AQ = WS_WM2 + 28 * MiB;
constexpr size_t WS_UM = B0 + 232 * MiB;
constexpr size_t WS_END = WS_PO + (size_t)TOK * MB_H * 3 * 128 * 2;
static_assert(WS_UM + (size_t)2 * SLOTS * FF1 <= WS_END && WS_AQ + (size_t)TOK * DM <= WS_UM && WS_END <= 528 * MiB, "d_ws map");
constexpr int CW_TMO = 0, CW_CODE = 1, CW_DBG = 2, CW_Q = 8;
constexpr int CW_MOECNT = 64;
constexpr int CW_MOBACNT = 256;
constexpr int CW_BAR = 4096;
constexpr size_t WS_RSS = 1 * MiB;
constexpr int RING_OFF = 0, RING_BYTES = 131072;
constexpr int LDSCTL_OFF = RING_BYTES, MISC_OFF = LDSCTL_OFF + 320;
constexpr int LDS_BYTES = 163840;

struct Args { const float* in[20]; float* out; unsigned char* ws; float inv64[8]; float inv128[16]; int ph_lo, ph_hi; };

__device__ __forceinline__ float wave_sum(float v) {
#pragma unroll
    for (int o = 1; o < 64; o <<= 1) v += __shfl_xor(v, o);
    return v;
}
template <int MAP> __device__ __forceinline__ int maprow(int n) {
    if (MAP == 1) { if (n >= 2048) return n; const int d = n & 63; if (d >= 16) return n; const int b = d >> 3, a = (d >> 2) & 1, c = d & 3; return (n & ~63) + 8 * a + 4 * b + c; }
    if (MAP == 2) { if (n >= 2048) return n; const int d = n & 127; if (d >= 32) return n; const int b = d >> 4, a = (d >> 2) & 3, c = d & 3; return (n & ~127) + 8 * a + 4 * b + c; }
    if (MAP == 3) return 256 * (n >> 7) + (n & 127);
    if (MAP == 4) return 256 * (n >> 7) + 128 + (n & 127);
    return n;
}
template <int MAP> __device__ __forceinline__ void transpose_item(const float* W, int K, int N, bf16* WT, LAS float* scr, int item, int lane, const float* gk = nullptr) {
    const int nblk = N / 32, kb = item / nblk, nb = item % nblk, k0 = 64 * kb, n0 = 32 * nb;
    const int kr = lane >> 3, nc = (lane & 7) * 4;
    f32x4 v[8];
#pragma unroll
    for (int i = 0; i < 8; ++i) v[i] = *(const GAS f32x4*)(W + (size_t)(k0 + i * 8 + kr) * N + n0 + nc);
    if (gk) {
#pragma unroll
        for (int i = 0; i < 8; ++i) v[i] = v[i] * gk[k0 + i * 8 + kr]; }
#pragma unroll
    for (int i = 0; i < 8; ++i) { LAS float* d = scr + (i * 8 + kr) * 33 + nc; d[0] = v[i].x; d[1] = v[i].y; d[2] = v[i].z; d[3] = v[i].w; }
    LDS_WAIT(); asm volatile("" ::: "memory");
    const int c = lane & 7;
#pragma unroll
    for (int j = 0; j < 4; ++j) { const int n = (lane >> 3) + 8 * j; const LAS float* s = scr + (8 * c) * 33 + n;
        v4u o; o.x = pk2(s[0 * 33], s[1 * 33]); o.y = pk2(s[2 * 33], s[3 * 33]); o.z = pk2(s[4 * 33], s[5 * 33]); o.w = pk2(s[6 * 33], s[7 * 33]);
        *(GAS v4u*)(WT + (size_t)maprow<MAP>(n0 + n) * K + k0 + 8 * c) = o; }
    LDS_WAIT(); asm volatile("" ::: "memory");
}

template <int MAP> __device__ __forceinline__ float wmax_strip(const float* W, int N, unsigned* cmax, int kb0, int nkb, int nb, int lane, const float* gk) {
    const int n0 = 32 * nb, kr = lane >> 3, nc = (lane & 7) * 4;
    f32x4 mx = (f32x4){0.f, 0.f, 0.f, 0.f}; float ss = 0.f;
    for (int kb = kb0; kb < kb0 + nkb; ++kb) { const int k0 = 64 * kb;
        f32x4 v[8];
#pragma unroll
        for (int i = 0; i < 8; ++i) v[i] = *(const GAS f32x4*)(W + (size_t)(k0 + i * 8 + kr) * N + n0 + nc);
        if (gk) {
#pragma unroll
            for (int i = 0; i < 8; ++i) v[i] = v[i] * gk[k0 + i * 8 + kr]; }
#pragma unroll
        for (int i = 0; i < 8; ++i) { mx.x = fmaxf(mx.x, fabsf(v[i].x)); mx.y = fmaxf(mx.y, fabsf(v[i].y)); mx.z = fmaxf(mx.z, fabsf(v[i].z)); mx.w = fmaxf(mx.w, fabsf(v[i].w));
            ss += (v[i].x * v[i].x + v[i].y * v[i].y) + (v[i].z * v[i].z + v[i].w * v[i].w); } }
#pragma unroll
    for (int o = 8; o < 64; o <<= 1) { mx.x = fmaxf(mx.x, __shfl_xor(mx.x, o)); mx.y = fmaxf(mx.y, __shfl_xor(mx.y, o)); mx.z = fmaxf(mx.z, __shfl_xor(mx.z, o)); mx.w = fmaxf(mx.w, __shfl_xor(mx.w, o)); }
    if (lane < 8) {
        __hip_atomic_fetch_max(cmax + maprow<MAP>(n0 + nc + 0), __float_as_uint(mx.x), __ATOMIC_RELAXED, __HIP_MEMORY_SCOPE_AGENT);
        __hip_atomic_fetch_max(cmax + maprow<MAP>(n0 + nc + 1), __float_as_uint(mx.y), __ATOMIC_RELAXED, __HIP_MEMORY_SCOPE_AGENT);
        __hip_atomic_fetch_max(cmax + maprow<MAP>(n0 + nc + 2), __float_as_uint(mx.z), __ATOMIC_RELAXED, __HIP_MEMORY_SCOPE_AGENT);
        __hip_atomic_fetch_max(cmax + maprow<MAP>(n0 + nc + 3), __float_as_uint(mx.w), __ATOMIC_RELAXED, __HIP_MEMORY_SCOPE_AGENT); }
    return ss;
}
template <int MAP> __device__ __forceinline__ void transpose_item_q(const float* W, int K, int N, signed char* WT, const unsigned* cmax, LAS float* scr, int item, int lane, const float* gk) {
    const int nblk = N / 32, kb = item / nblk, nb = item % nblk, k0 = 64 * kb, n0 = 32 * nb;
    const int kr = lane >> 3, nc = (lane & 7) * 4;
    f32x4 v[8];
#pragma unroll
    for (int i = 0; i < 8; ++i) v[i] = *(const GAS f32x4*)(W + (size_t)(k0 + i * 8 + kr) * N + n0 + nc);
    if (gk) {
#pragma unroll
        for (int i = 0; i < 8; ++i) v[i] = v[i] * gk[k0 + i * 8 + kr]; }
#pragma unroll
    for (int i = 0; i < 8; ++i) { LAS float* d = scr + (i * 8 + kr) * 33 + nc; d[0] = v[i].x; d[1] = v[i].y; d[2] = v[i].z; d[3] = v[i].w; }
    LDS_WAIT(); asm volatile("" ::: "memory");
    const int half = lane >> 5, n = lane & 31, row = maprow<MAP>(n0 + n);
    const float cm = __uint_as_float(cmax[row]); const float inv = cm > 0.f ? 127.0f / cm : 0.f;
    const LAS float* s = scr + (32 * half) * 33 + n;
    unsigned w[8];
#pragma unroll
    for (int q4 = 0; q4 < 8; ++q4) { unsigned pk = 0;
#pragma unroll
        for (int b = 0; b < 4; ++b) { const int q = (int)__builtin_rintf(s[(4 * q4 + b) * 33] * inv); pk |= (unsigned)(q & 255) << (8 * b); }
        w[q4] = pk; }
    GAS v4u* dst = (GAS v4u*)(WT + (size_t)row * K + k0 + 32 * half);
    dst[0] = (v4u){w[0], w[1], w[2], w[3]}; dst[1] = (v4u){w[4], w[5], w[6], w[7]};
    LDS_WAIT(); asm volatile("" ::: "memory");
}

template <int MAP> __device__ __forceinline__ void strip_quant(const float* W, int K, int N, signed char* WT, float cm, LAS float* scr, int kb0, int nkb, int nb, int lane, const float* gk) {
    const int n0 = 32 * nb, kr = lane >> 3, nc = (lane & 7) * 4;
    const int half = lane >> 5, n = lane & 31, row = maprow<MAP>(n0 + n);
    const float inv = cm > 0.f ? 127.0f / cm : 0.f;
    f32x4 vn[8];
#pragma unroll
    for (int i = 0; i < 8; ++i) vn[i] = *(const GAS f32x4*)(W + (size_t)(64 * kb0 + i * 8 + kr) * N + n0 + nc);
    for (int kb = kb0; kb < kb0 + nkb; ++kb) { const int k0 = 64 * kb;
        f32x4 v[8];
#pragma unroll
        for (int i = 0; i < 8; ++i) v[i] = vn[i];
        if (kb + 1 < kb0 + nkb) {
#pragma unroll
            for (int i = 0; i < 8; ++i) vn[i] = *(const GAS f32x4*)(W + (size_t)(k0 + 64 + i * 8 + kr) * N + n0 + nc); }
        if (gk) {
#pragma unroll
            for (int i = 0; i < 8; ++i) v[i] = v[i] * gk[k0 + i * 8 + kr]; }
#pragma unroll
        for (int i = 0; i < 8; ++i) { LAS float* d = scr + (i * 8 + kr) * 33 + nc; d[0] = v[i].x; d[1] = v[i].y; d[2] = v[i].z; d[3] = v[i].w; }
        LDS_WAIT(); asm volatile("" ::: "memory");
        const LAS float* s = scr + (32 * half) * 33 + n;
        unsigned w[8];
#pragma unroll
        for (int q4 = 0; q4 < 8; ++q4) { unsigned pk = 0;
#pragma unroll
            for (int b = 0; b < 4; ++b) { const int q = (int)__builtin_rintf(s[(4 * q4 + b) * 33] * inv); pk |= (unsigned)(q & 255) << (8 * b); }
            w[q4] = pk; }
        GAS v4u* dst = (GAS v4u*)(WT + (size_t)row * K + k0 + 32 * half);
        dst[0] = (v4u){w[0], w[1], w[2], w[3]}; dst[1] = (v4u){w[4], w[5], w[6], w[7]};
        LDS_WAIT(); asm volatile("" ::: "memory");
    }
}
__device__ __forceinline__ float wstrip_max(const float* W, int N, int kb0, int nkb, int nb, int lane, const float* gk, f32x4& mx) {
    const int n0 = 32 * nb, kr = lane >> 3, nc = (lane & 7) * 4; float ss = 0.f;
    for (int kb = kb0; kb < kb0 + nkb; kb += 2) {
        const int k0 = 64 * kb; const bool two = kb + 1 < kb0 + nkb; const int k1 = two ? k0 + 64 : k0;
        f32x4 v[16];
#pragma unroll
        for (int i = 0; i < 8; ++i) { v[i] = *(const GAS f32x4*)(W + (size_t)(k0 + i * 8 + kr) * N + n0 + nc); v[8 + i] = *(const GAS f32x4*)(W + (size_t)(k1 + i * 8 + kr) * N + n0 + nc); }
        if (gk) {
#pragma unroll
            for (int i = 0; i < 8; ++i) { v[i] = v[i] * gk[k0 + i * 8 + kr]; v[8 + i] = v[8 + i] * gk[k1 + i * 8 + kr]; } }
#pragma unroll
        for (int i = 0; i < 16; ++i) { mx.x = fmaxf(mx.x, fabsf(v[i].x)); mx.y = fmaxf(mx.y, fabsf(v[i].y)); mx.z = fmaxf(mx.z, fabsf(v[i].z)); mx.w = fmaxf(mx.w, fabsf(v[i].w));
            if (i < 8 || two) ss += (v[i].x * v[i].x + v[i].y * v[i].y) + (v[i].z * v[i].z + v[i].w * v[i].w); } }
#pragma unroll
    for (int o = 8; o < 64; o <<= 1) { mx.x = fmaxf(mx.x, __shfl_xor(mx.x, o)); mx.y = fmaxf(mx.y, __shfl_xor(mx.y, o)); mx.z = fmaxf(mx.z, __shfl_xor(mx.z, o)); mx.w = fmaxf(mx.w, __shfl_xor(mx.w, o)); }
    return ss;
}
__device__ __forceinline__ float strip_colmax(const f32x4& mx, int lane) {
    const int n = lane & 31, src = n >> 2; const float a = __shfl(mx.x, src), b = __shfl(mx.y, src), c = __shfl(mx.z, src), d = __shfl(mx.w, src);
    return (n & 3) == 0 ? a : (n & 3) == 1 ? b : (n & 3) == 2 ? c : d;
}
__device__ __forceinline__ void rms_row(const float* xrow, const f32x4 (&g)[4], f32x4 (&v)[4], int lane) {
    const GAS f32x4* xr = (const GAS f32x4*)xrow + lane; float s = 0.f;
#pragma unroll
    for (int j = 0; j < 4; ++j) { v[j] = xr[64 * j]; s += (v[j].x * v[j].x + v[j].y * v[j].y) + (v[j].z * v[j].z + v[j].w * v[j].w); }
    const float rstd = 1.f / sqrtf(wave_sum(s) * (1.f / DM) + NORM_EPS);
#pragma unroll
    for (int j = 0; j < 4; ++j) v[j] = v[j] * rstd * g[j];
}
__device__ __forceinline__ void store_row_bf16(bf16* orow, const f32x4 (&v)[4], int lane) {
    GAS unsigned long long* o8 = (GAS unsigned long long*)orow + lane;
#pragma unroll
    for (int j = 0; j < 4; ++j) o8[64 * j] = (unsigned long long)pk2(v[j].x, v[j].y) | ((unsigned long long)pk2(v[j].z, v[j].w) << 32);
}
__device__ __forceinline__ void load_gain(const float* g, f32x4 (&gv)[4], int lane) {
#pragma unroll
    for (int j = 0; j < 4; ++j) gv[j] = *((const f32x4*)g + lane + 64 * j);
}
__device__ __forceinline__ void rmsnorm_phase(const float* src, const float* gain, bf16* dst, int gw, int ngw, int lane) {
    f32x4 gv[4]; load_gain(gain, gv, lane);
    for (int m = gw; m < TOK; m += ngw) { f32x4 v[4]; rms_row(src + (size_t)m * DM, gv, v, lane); store_row_bf16(dst + (size_t)m * DM, v, lane); }
}
__device__ __forceinline__ float bf2f(unsigned short b) { return __uint_as_float((unsigned)b << 16); }


__device__ __forceinline__ int tid_fresh() { int t = (int)threadIdx.x; asm volatile("" : "+v"(t)); return t; }
typedef __attribute__((address_space(4))) const unsigned char* kaptr_t;
__device__ __forceinline__ kaptr_t ka_get() { kaptr_t p = (kaptr_t)__builtin_amdgcn_kernarg_segment_ptr(); asm volatile("" : "+s"(p)); return p; }
#define KA_IN(k) (*(const float* const __attribute__((address_space(4)))*)(ka + 8 * (k)))
#define PH_PTRS const int tid = tid_fresh(); const int lane = tid & 63; (void)lane; kaptr_t ka = ka_get(); unsigned char* const ws = *(unsigned char* const __attribute__((address_space(4)))*)(ka + 168); float* const out = *(float* const __attribute__((address_space(4)))*)(ka + 160); gu32* const ctl = (gu32*)(ws + WS_CTL); (void)out; (void)ctl
#define IN_X KA_IN(0)
#define norm_mix KA_IN(1)
#define norm_ffn KA_IN(2)
#define final_norm KA_IN(3)
#define da_wqkv KA_IN(4)
#define da_wo KA_IN(5)
#define da_lq1 KA_IN(6)
#define da_lk1 KA_IN(7)
#define da_lq2 KA_IN(8)
#define da_lk2 KA_IN(9)
#define da_subln KA_IN(10)
#define mb_wqkv KA_IN(11)
#define mb_wo KA_IN(12)
#define ffn_w1 KA_IN(13)
#define ffn_w3 KA_IN(14)
#define ffn_w2 KA_IN(15)
#define moe_router KA_IN(16)
#define moe_w1 KA_IN(17)
#define moe_w3 KA_IN(18)
#define moe_w2 KA_IN(19)
#define rope64 ((float*)(ws + WS_ROPE64))
#define rope128 ((float*)(ws + WS_ROPE128))
#define kmean ((int*)(ws + WS_KMEAN))
#define tok_e ((int*)(ws + WS_TOK))
#define tok_pos (tok_e + 2 * TOK)
#define tok_gate ((float*)(tok_pos + 2 * TOK))
#define wg_base ((int*)(ws + WS_TOK + 800 * 1024))
#define slot_tok ((int*)(ws + WS_SLOT))
#define slot_gate ((float*)(slot_tok + 2 * SLOTS))
#define slot_sa (slot_gate + 2 * SLOTS)
#define ownml ((float*)(ws + WS_OWNML))
#define W0qkv ((bf16*)(ws + WS_W0QKV))
#define W0o ((bf16*)(ws + WS_W0O))
#define W013 ((bf16*)(ws + WS_W013))
#define W02 ((bf16*)(ws + WS_W02))
#define W1qkv ((bf16*)(ws + WS_W1QKV))
#define W1o ((bf16*)(ws + WS_W1O))
#define Rb ((bf16*)(ws + WS_H))
#define OB ((bf16*)out)
#define RSS(j) ((unsigned long long*)(ws + WS_RSS) + (size_t)(j) * TOK)
#define QKV ((bf16*)(ws + WS_QKV))
#define OATT ((bf16*)(ws + WS_OATT))
#define UD ((bf16*)(ws + WS_UD))
#define lists ((int*)(ws + WS_LIST))
#define pml ((float*)(ws + WS_PML))
#define PO ((bf16*)(ws + WS_PO))
#define WM13 ((signed char*)(ws + WS_WM13))
#define WM2 ((signed char*)(ws + WS_WM2))
#define AQ ((signed char*)(ws + WS_AQ))
#define UM ((signed char*)(ws + WS_UM))
#define Y1B ((bf16*)(ws + WS_AQ))
#define CMAX13 ((unsigned*)(ws + WS_CMAX13))
#define CMAX2 ((unsigned*)(ws + WS_CMAX2))
#define SSTOT ((unsigned long long*)(ws + WS_SSTOT))
#define SA ((float*)(ws + WS_SA))
#define SA1 ((float*)(ws + WS_SA + 128 * 1024))
#define SA0 ((float*)(ws + WS_SA + 256 * 1024))
#define SA2 ((float*)(ws + WS_SA + 384 * 1024))
#define SO0 ((float*)(ws + WS_SA + 512 * 1024))
#define SO1 ((float*)(ws + WS_SA + 640 * 1024))
#define CMQ0 ((unsigned*)(ws + WS_SA + 768 * 1024))
#define CMQ1 ((unsigned*)(ws + WS_SA + 784 * 1024))
#define CMO0 ((unsigned*)(ws + WS_SA + 800 * 1024))
#define CMO1 ((unsigned*)(ws + WS_SA + 808 * 1024))
#define AMX0 ((float*)(ws + WS_W0QKV + 3 * MiB))
#define QS1 ((float*)(ws + WS_W0QKV + 3 * MiB + 128 * 1024))
#define QS2 ((float*)(ws + WS_W0QKV + 3 * MiB + 256 * 1024))
#define AMX1 ((unsigned*)(ws + 512 * 1024))
#define AXQ ((signed char*)(ws + WS_OATT))
#define OBQ ((signed char*)out + (size_t)64 * MiB)
#define CM0_13 ((unsigned*)(ws + WS_CM0))
#define CM0_2 ((unsigned*)(ws + WS_CM0 + 32 * 1024))
#define SSTOT0 ((unsigned long long*)(ws + WS_CM0 + 48 * 1024))
#define W013q ((signed char*)(ws + WS_W013))
#define W02q ((signed char*)(ws + WS_W02))
#define A1Q ((signed char*)(ws + WS_QKV))
#define UDQ ((signed char*)(ws + WS_UD))
__global__ void __launch_bounds__(NWAVES * 64, 2) mk_fwd(Args args) {
    extern __shared__ __attribute__((aligned(16))) unsigned char lds[];
    LAS unsigned char* L = (LAS unsigned char*)lds;
    volatile LAS unsigned* MISC = (volatile LAS unsigned*)(L + MISC_OFF);
    const int wave = __builtin_amdgcn_readfirstlane((int)threadIdx.x >> 6);
    const int G = gridDim.x; const int bx = blockIdx.x; const int vcu = (G % 8 == 0) ? (bx % 8) * (G / 8) + bx / 8 : bx;
    const int gw = vcu * NWAVES + wave, NGW = G * NWAVES;
    gu32* ctl0 = (gu32*)(args.ws + WS_CTL);
    for (int u = (int)threadIdx.x; u < (LDS_BYTES - LDSCTL_OFF) / 4; u += NWAVES * 64) ((LAS unsigned*)(L + LDSCTL_OFF))[u] = 0u;
    __syncthreads();
    XcdBarrier bar; bar.bar = (unsigned*)(ctl0 + CW_BAR); bar.x = 0; bar.st = nullptr;
    if (!MK_PER_PHASE) bar = xcd_barrier_post((unsigned*)(ctl0 + CW_BAR), MISC + 8);
#define GRID_BAR() do { if (!MK_PER_PHASE) xcd_barrier(bar); } while (0)
    const int lo = args.ph_lo, hi_ph = args.ph_hi;
#ifndef PH_MASK
#define PH_MASK 0xFFFFFFFFu
#endif
#define IN(k) (((PH_MASK >> (k)) & 1u) && lo <= (k) && (k) < hi_ph)
#define SEAM(k) do { if (IN((k) + 1)) GRID_BAR(); } while (0)
#ifndef DUP_MASK
#define DUP_MASK 0u
#endif
#define NREP(k) ((((DUP_MASK) >> (k)) & 1u) ? 2 : 1)

    if (IN(0)) { PH_PTRS; for (int rep_ = 0; rep_ < NREP(0); ++rep_) {
        LAS float* scr = (LAS float*)(L + RING_OFF + wave * 16384);
        {
            LAS float* cmw = (LAS float*)(L + 132096);
            for (int st = vcu; st < 256; st += G) {
                const int mat = st < 96 ? 0 : st < 192 ? 1 : st < 224 ? 2 : 3; const int nb = st - (mat == 0 ? 0 : mat == 1 ? 96 : mat == 2 ? 192 : 224);
                const float* W = mat == 0 ? da_wqkv : mat == 1 ? mb_wqkv : mat == 2 ? da_wo : mb_wo; const int N = mat < 2 ? NQKV : DM;
                const float* gk = mat == 0 ? norm_mix : mat == 1 ? norm_mix + DM : nullptr;
                f32x4 mx = (f32x4){0.f, 0.f, 0.f, 0.f}; (void)wstrip_max(W, N, 2 * wave, 2, nb, lane, gk, mx);
                if (lane < 8) { LAS float* d = cmw + wave * 32 + lane * 4; d[0] = mx.x; d[1] = mx.y; d[2] = mx.z; d[3] = mx.w; }
                LDS_WAIT(); __syncthreads();
                float cm = 0.f;
#pragma unroll
                for (int w8 = 0; w8 < 8; ++w8) cm = fmaxf(cm, cmw[w8 * 32 + (lane & 31)]);
                if (mat == 0) { if (wave == 0 && lane < 32) CMQ0[maprow<1>(nb * 32 + lane)] = __float_as_uint(cm); strip_quant<1>(W, DM, N, (signed char*)W0qkv, cm, scr, 2 * wave, 2, nb, lane, gk); }
                else if (mat == 1) { if (wave == 0 && lane < 32) CMQ1[maprow<2>(nb * 32 + lane)] = __float_as_uint(cm); strip_quant<2>(W, DM, N, (signed char*)W1qkv, cm, scr, 2 * wave, 2, nb, lane, gk); }
                else if (mat == 2) { if (wave == 0 && lane < 32) CMO0[nb * 32 + lane] = __float_as_uint(cm); strip_quant<0>(W, DM, N, (signed char*)W0o, cm, scr, 2 * wave, 2, nb, lane, gk); }
                else { if (wave == 0 && lane < 32) CMO1[nb * 32 + lane] = __float_as_uint(cm); strip_quant<0>(W, DM, N, (signed char*)W1o, cm, scr, 2 * wave, 2, nb, lane, gk); }
                __syncthreads();
            }
        }
        {
            constexpr int S_1 = (DM / 512) * (FF0 / 32), S_2 = 6 * (DM / 32);
            float ssA = 0.f, ssB = 0.f;
            for (int it = NGW - 1 - gw; it < 2 * S_1 + S_2; it += NGW) {
                int r = it;
                if (r < S_1) { ssA += wmax_strip<3>(ffn_w1, FF0, CM0_13, 8 * (r / (FF0 / 32)), 8, r % (FF0 / 32), lane, norm_ffn); continue; } r -= S_1;
                if (r < S_1) { ssB += wmax_strip<4>(ffn_w3, FF0, CM0_13, 8 * (r / (FF0 / 32)), 8, r % (FF0 / 32), lane, norm_ffn); continue; } r -= S_1;
                { const int st = r / (DM / 32); (void)wmax_strip<0>(ffn_w2, DM, CM0_2, 8 * st, st == 5 ? 4 : 8, r % (DM / 32), lane, nullptr); }
            }
            ssA = wave_sum(ssA); ssB = wave_sum(ssB);
            if (lane == 0 && (ssA != 0.f || ssB != 0.f)) { __hip_atomic_fetch_add(SSTOT0, (unsigned long long)(ssA * 16777216.0f), __ATOMIC_RELAXED, __HIP_MEMORY_SCOPE_AGENT); __hip_atomic_fetch_add(SSTOT0 + 1, (unsigned long long)(ssB * 16777216.0f), __ATOMIC_RELAXED, __HIP_MEMORY_SCOPE_AGENT); }
        }
        {
            const int gt = (vcu * NWAVES + wave) * 64 + lane, NT_ = G * NWAVES * 64;
            for (int e = gt; e < SEQ * 8; e += NT_) { const int pos = e >> 3, i = e & 7; const float ang = (float)pos * (*(const float __attribute__((address_space(4)))*)(ka + 176 + 4 * i)); rope64[e] = cosf(ang); rope64[SEQ * 8 + e] = sinf(ang); }
            for (int e = gt; e < SEQ * 16; e += NT_) { const int pos = e >> 4, i = e & 15; const float ang = (float)pos * (*(const float __attribute__((address_space(4)))*)(ka + 208 + 4 * i)); rope128[e] = cosf(ang); rope128[SEQ * 16 + e] = sinf(ang); }
        }
        for (int m0 = gw; m0 < TOK; m0 += 2 * NGW) {
            f32x4 vv[2][4];
#pragma unroll
            for (int u = 0; u < 2; ++u) { const int m = (m0 + u * NGW < TOK) ? m0 + u * NGW : m0; const GAS f32x4* xr = (const GAS f32x4*)(IN_X + (size_t)m * DM) + lane;
#pragma unroll
                for (int j = 0; j < 4; ++j) vv[u][j] = xr[64 * j]; }
#pragma unroll
            for (int u = 0; u < 2; ++u) { const int m = m0 + u * NGW; if (m < TOK) {
                f32x4 v[4]; float s = 0.f, mx = 0.f;
#pragma unroll
                for (int j = 0; j < 4; ++j) { v[j] = vv[u][j]; s += (v[j].x * v[j].x + v[j].y * v[j].y) + (v[j].z * v[j].z + v[j].w * v[j].w);
                    mx = fmaxf(fmaxf(mx, fmaxf(fabsf(v[j].x), fabsf(v[j].y))), fmaxf(fabsf(v[j].z), fabsf(v[j].w))); }
                store_row_bf16(Rb + (size_t)m * DM, v, lane); s = wave_sum(s);
#pragma unroll
                for (int o = 1; o < 64; o <<= 1) mx = fmaxf(mx, __shfl_xor(mx, o));
                const float inv = mx > 0.f ? 127.0f / mx : 0.f;
                GAS unsigned* aq = (GAS unsigned*)(AXQ + (size_t)m * DM) + lane;
#pragma unroll
                for (int j = 0; j < 4; ++j) { const int q0 = (int)__builtin_rintf(v[j].x * inv), q1 = (int)__builtin_rintf(v[j].y * inv), q2 = (int)__builtin_rintf(v[j].z * inv), q3 = (int)__builtin_rintf(v[j].w * inv);
                    aq[64 * j] = (unsigned)(q0 & 255) | ((unsigned)(q1 & 255) << 8) | ((unsigned)(q2 & 255) << 16) | ((unsigned)(q3 & 255) << 24); }
                if (lane == 0) { SA0[m] = mx * (1.f / sqrtf(s * (1.f / DM) + NORM_EPS)) * (1.0f / 127.0f); AMX0[m] = mx; } } }
        }
        } SEAM(0);
    }
    if (IN(1)) { PH_PTRS; for (int rep_ = 0; rep_ < NREP(1); ++rep_) {
        pg8::ABDense ab{(const pg8::bf16_t*)AXQ, (const pg8::bf16_t*)W0qkv, DM / 2}; pg8::TileOrder S; S.init(TOK / 256, NQKV / 256, G, bx);
        pg8::EpiQKVQ<64> E{QKV, NQKV, rope64, rope64 + SEQ * 8, 0.125f * LOG2E, SA0, CMQ0, nullptr, nullptr};
        pg8::gemm_phase<pg8::EpiQKVQ<64>, pg8::ABDense, GEMM_ALIGN>(L + RING_OFF, ab, S, E);
        } SEAM(1);
    }
    if (IN(2)) { PH_PTRS; for (int rep_ = 0; rep_ < NREP(2); ++rep_) {
        const moba::DaOrder AS(vcu, G);
        moba::dattn_phase<moba::DaOrder>((char*)lds + RING_OFF, (const moba::bf16*)QKV, (moba::bf16*)OATT, AS);
        } SEAM(2);
    }
    if (IN(3)) { PH_PTRS; for (int rep_ = 0; rep_ < NREP(3); ++rep_) {
        float lam;
        { const float a = wave_sum(da_lq1[lane] * da_lk1[lane]), b = wave_sum(da_lq2[lane] * da_lk2[lane]); lam = expf(a) - expf(b) + LAMBDA_INIT0; }
        const int hh = lane >> 3, dd = (lane & 7) * 16;
        float gsub[16];
#pragma unroll
        for (int k = 0; k < 16; ++k) gsub[k] = da_subln[dd + k] * (1.f - LAMBDA_INIT0);
        for (int m0 = gw; m0 < TOK; m0 += 2 * NGW) {
            v4u A0[2], A1[2], B0[2], B1[2];
#pragma unroll
            for (int u = 0; u < 2; ++u) { const int m = (m0 + u * NGW < TOK) ? m0 + u * NGW : m0;
                const bf16* o1 = OATT + (size_t)m * 2048 + (2 * hh) * 128 + dd; const bf16* o2 = o1 + 128;
                A0[u] = *(const GAS v4u*)o1; A1[u] = *(const GAS v4u*)(o1 + 8); B0[u] = *(const GAS v4u*)o2; B1[u] = *(const GAS v4u*)(o2 + 8); }
#pragma unroll
            for (int u = 0; u < 2; ++u) { const int m = m0 + u * NGW; if (m < TOK) {
                const v4u a0 = A0[u], a1 = A1[u], b0 = B0[u], b1 = B1[u];
                float d[16]; float ss = 0.f;
#pragma unroll
                for (int k = 0; k < 4; ++k) {
                    const unsigned ua = a0[k], ub = b0[k], uc = a1[k], ud = b1[k];
                    d[2 * k] = __uint_as_float(ua << 16) - lam * __uint_as_float(ub << 16); d[2 * k + 1] = __uint_as_float(ua & 0xffff0000u) - lam * __uint_as_float(ub & 0xffff0000u);
                    d[8 + 2 * k] = __uint_as_float(uc << 16) - lam * __uint_as_float(ud << 16); d[8 + 2 * k + 1] = __uint_as_float(uc & 0xffff0000u) - lam * __uint_as_float(ud & 0xffff0000u); }
#pragma unroll
                for (int k = 0; k < 16; ++k) ss += d[k] * d[k];
                ss += __shfl_xor(ss, 1); ss += __shfl_xor(ss, 2); ss += __shfl_xor(ss, 4);
                const float rstd = 1.f / sqrtf(ss * (1.f / 128.f) + SUBLN_EPS);
                float mx = 0.f;
#pragma unroll
                for (int k = 0; k < 16; ++k) { d[k] = d[k] * rstd * gsub[k]; mx = fmaxf(mx, fabsf(d[k])); }
#pragma unroll
                for (int o = 1; o < 64; o <<= 1) mx = fmaxf(mx, __shfl_xor(mx, o));
                const float inv = mx > 0.f ? 127.0f / mx : 0.f;
                v4u wq;
#pragma unroll
                for (int k = 0; k < 4; ++k) { const int q0 = (int)__builtin_rintf(d[4 * k] * inv), q1 = (int)__builtin_rintf(d[4 * k + 1] * inv), q2 = (int)__builtin_rintf(d[4 * k + 2] * inv), q3 = (int)__builtin_rintf(d[4 * k + 3] * inv);
                    wq[k] = (unsigned)(q0 & 255) | ((unsigned)(q1 & 255) << 8) | ((unsigned)(q2 & 255) << 16) | ((unsigned)(q3 & 255) << 24); }
                *(GAS v4u*)(OBQ + (size_t)m * DM + hh * 128 + dd) = wq;
                if (lane == 0) SO0[m] = mx * (1.0f / 127.0f); } }
        }
        {
            LAS float* scr = (LAS float*)(L + RING_OFF + wave * 16384);
            constexpr int I_13 = (DM / 64) * (FF0 / 32), I_2 = (FF0 / 64) * (DM / 32);
            for (int it = gw; it < 2 * I_13 + I_2; it += NGW) {
                int r = it;
                if (r < I_13) { transpose_item_q<3>(ffn_w1, DM, FF0, W013q, CM0_13, scr, r, lane, norm_ffn); continue; } r -= I_13;
                if (r < I_13) { transpose_item_q<4>(ffn_w3, DM, FF0, W013q, CM0_13, scr, r, lane, norm_ffn); continue; } r -= I_13;
                transpose_item_q<0>(ffn_w2, FF0, DM, W02q, CM0_2, scr, r, lane, nullptr);
            }
        }
        } SEAM(3);
    }
    if (IN(4)) { PH_PTRS; for (int rep_ = 0; rep_ < NREP(4); ++rep_) {
        pg8::ABDense ab{(const pg8::bf16_t*)OBQ, (const pg8::bf16_t*)W0o, DM / 2}; pg8::TileOrder S; S.init(TOK / 256, DM / 256, G, bx);
        pg8::EpiResBQ E{Rb, Rb, DM, nullptr, SO0, CMO0, pg8::MoeMap{0, nullptr}, 1.0f, RSS(1), nullptr, A1Q, AMX0, 1.5f, AMX1, QS1};
        pg8::gemm_phase<pg8::EpiResBQ, pg8::ABDense, GEMM_ALIGN>(L + RING_OFF, ab, S, E);
        } SEAM(4);
    }
    if (IN(6)) { PH_PTRS; for (int rep_ = 0; rep_ < NREP(6); ++rep_) {
        const float su0 = 8.0f * sqrtf(((float)SSTOT0[0] * (5.9604644775390625e-8f / FF0)) * ((float)SSTOT0[1] * (5.9604644775390625e-8f / FF0)));
        pg8::ABDense ab{(const pg8::bf16_t*)A1Q, (const pg8::bf16_t*)W013q, DM / 2}; pg8::TileOrder S; S.init(TOK / 256, (2 * FF0) / 256, G, bx);
        pg8::EpiSwiGLUQ E{UDQ, FF0, QS1, CM0_13, nullptr, pg8::MoeMap{0, nullptr}, 127.0f / su0, RSS(1)};
        pg8::gemm_phase<pg8::EpiSwiGLUQ, pg8::ABDense, GEMM_ALIGN>(L + RING_OFF, ab, S, E);
        } SEAM(6);
    }
    if (IN(7)) { PH_PTRS; for (int rep_ = 0; rep_ < NREP(7); ++rep_) {
        const float su0 = 8.0f * sqrtf(((float)SSTOT0[0] * (5.9604644775390625e-8f / FF0)) * ((float)SSTOT0[1] * (5.9604644775390625e-8f / FF0)));
        pg8::ABDense ab{(const pg8::bf16_t*)UDQ, (const pg8::bf16_t*)W02q, FF0 / 2}; pg8::TileOrder S; S.init(TOK / 256, DM / 256, G, bx);
        pg8::EpiResBQ E{Rb, Rb, DM, nullptr, nullptr, CM0_2, pg8::MoeMap{0, nullptr}, su0 * (1.0f / 127.0f), RSS(2), nullptr, AXQ, (const float*)AMX1, 1.3f, nullptr, QS2};
        pg8::gemm_phase<pg8::EpiResBQ, pg8::ABDense, GEMM_ALIGN>(L + RING_OFF, ab, S, E);
        } SEAM(7);
    }
    if (IN(9)) { PH_PTRS; for (int rep_ = 0; rep_ < NREP(9); ++rep_) {
        pg8::ABDense ab{(const pg8::bf16_t*)AXQ, (const pg8::bf16_t*)W1qkv, DM / 2}; pg8::TileOrder S; S.init(TOK / 256, NQKV / 256, G, bx);
        pg8::EpiQKVQ<128> E{QKV, NQKV, rope128, rope128 + SEQ * 16, 0.08838834764831845f * LOG2E, QS2, CMQ1, kmean, RSS(2)};
        pg8::gemm_phase<pg8::EpiQKVQ<128>, pg8::ABDense, GEMM_ALIGN>(L + RING_OFF, ab, S, E);
        } SEAM(9);
    }
    if (IN(11)) { PH_PTRS; for (int rep_ = 0; rep_ < NREP(11); ++rep_) {
        LAS unsigned short* kh = (LAS unsigned short*)(L + RING_OFF);
        LAS unsigned short* kl = kh + 32 * 128;
        LAS int* lcnt = (LAS int*)(L + RING_OFF + 24576);
        const int r32 = lane & 31, hi = lane >> 5;
        for (int u = vcu; u < BATCH * MB_H * (MB_NB - 1); u += G) {
            const int bh = u / 31, o = 1 + u % 31, b = bh >> 3, h = bh & 7;
            for (int e = tid; e < 32 * 128; e += 512) { const float fv = (float)kmean[(size_t)bh * 4096 + e] * (1.0f / (65536.0f * 256.0f));
                const unsigned hb = f2bf(fv); const unsigned lb = f2bf(fv - __uint_as_float(hb << 16));
                const int j = e >> 7, d = e & 127, off = (j * 256 + ((2 * d) ^ ((j & 7) << 4))) >> 1; kh[off] = (unsigned short)hb; kl[off] = (unsigned short)lb; }
            if (tid < 32) lcnt[tid] = 0;
            __syncthreads();
            const int ql = wave * 32 + r32; const int s = o * 256 + ql;
            const bf16* qp = QKV + (size_t)(b * SEQ + s) * NQKV + h * 128 + hi * 8;
            moba::f32x16 g = {};
#pragma unroll
            for (int d0 = 0; d0 < 8; ++d0) { const moba::bf16x8 qf = *(const GAS moba::bf16x8*)(qp + d0 * 16); const int ob = r32 * 256 + (((d0 * 16 + hi * 8) * 2) ^ ((r32 & 7) << 4));
                const moba::bf16x8 ah = *(const LAS moba::bf16x8*)((const LAS char*)kh + ob), al = *(const LAS moba::bf16x8*)((const LAS char*)kl + ob);
                g = __builtin_amdgcn_mfma_f32_32x32x16_bf16(ah, qf, g, 0, 0, 0); g = __builtin_amdgcn_mfma_f32_32x32x16_bf16(al, qf, g, 0, 0, 0); }
            float v0 = -INFINITY, v1 = -INFINITY, v2 = -INFINITY; int i0 = -1, i1 = -1, i2 = -1;
#define INS3(G_, J_) do { const float g_ = (G_); const int j_ = (J_); \
        if (g_ > v0 || (g_ == v0 && j_ < i0)) { v2 = v1; i2 = i1; v1 = v0; i1 = i0; v0 = g_; i0 = j_; } \
        else if (g_ > v1 || (g_ == v1 && j_ < i1)) { v2 = v1; i2 = i1; v1 = g_; i1 = j_; } \
        else if (g_ > v2 || (g_ == v2 && j_ < i2)) { v2 = g_; i2 = j_; } } while (0)
#pragma unroll
            for (int r = 0; r < 16; ++r) { const int j = (r & 3) + 8 * (r >> 2) + 4 * hi; if (j < o) INS3(g[r], j); }
            { const float p0 = __shfl_xor(v0, 32), p1 = __shfl_xor(v1, 32), p2 = __shfl_xor(v2, 32); const int q0 = __shfl_xor(i0, 32), q1 = __shfl_xor(i1, 32), q2 = __shfl_xor(i2, 32);
              if (q0 >= 0) INS3(p0, q0); if (q1 >= 0) INS3(p1, q1); if (q2 >= 0) INS3(p2, q2); }
#undef INS3
            int lp0 = 0, lp1 = 0, lp2 = 0;
            if (hi == 0) {
                if (i0 >= 0) lp0 = __hip_atomic_fetch_add(&lcnt[i0], 1, __ATOMIC_RELAXED, __HIP_MEMORY_SCOPE_WORKGROUP);
                if (i1 >= 0) lp1 = __hip_atomic_fetch_add(&lcnt[i1], 1, __ATOMIC_RELAXED, __HIP_MEMORY_SCOPE_WORKGROUP);
                if (i2 >= 0) lp2 = __hip_atomic_fetch_add(&lcnt[i2], 1, __ATOMIC_RELAXED, __HIP_MEMORY_SCOPE_WORKGROUP);
            }
            __syncthreads();
            if (tid < 32 && rep_ == 0) { const int n = lcnt[tid]; lcnt[32 + tid] = n ? (int)__hip_atomic_fetch_add(ctl + CW_MOBACNT + bh * 32 + tid, (unsigned)n, RLX_AGENT) : 0; }
            __syncthreads();
            if (hi == 0 && rep_ == 0) { int* lb = lists + (size_t)bh * LIST_PER_BH;
                if (i0 >= 0) lb[list_off(i0) + lcnt[32 + i0] + lp0] = s;
                if (i1 >= 0) lb[list_off(i1) + lcnt[32 + i1] + lp1] = s | (1 << 16);
                if (i2 >= 0) lb[list_off(i2) + lcnt[32 + i2] + lp2] = s | (2 << 16); }
            __syncthreads();
        }
        } SEAM(11);
    }
    if (IN(12)) { PH_PTRS; for (int rep_ = 0; rep_ < NREP(12); ++rep_) {
        LAS int* pre = (LAS int*)(L + 153600);
        { const unsigned c0 = __hip_atomic_load(ctl + CW_MOBACNT + tid, RLX_AGENT), c1 = __hip_atomic_load(ctl + CW_MOBACNT + 512 + tid, RLX_AGENT);
          pre[tid] = (int)((c0 + 1023u) >> 10); pre[512 + tid] = (int)((c1 + 1023u) >> 10); }
        __syncthreads();
        if (tid == 0) { int a = 0; for (int k = 0; k < 1024; ++k) { const int n = pre[k]; pre[k] = a; a += n; } pre[1024] = a; }
        __syncthreads();
        const int nlu = pre[1024];
        const int r32_ = lane & 31;
        for (;;) {
            __syncthreads();
            if (tid == 0) MISC[60] = __hip_atomic_fetch_add(ctl + CW_Q + (rep_ ? 16 : 0), 1u, RLX_AGENT);
            __syncthreads();
            const int u = (int)MISC[60];
            if (u >= nlu) break;
            int loI = 0, hiI = 1024;
            while (hiI - loI > 1) { const int mid = (loI + hiI) >> 1; if (pre[mid] <= u) loI = mid; else hiI = mid; }
            const int bhj = loI, grp = u - pre[bhj], bh = bhj >> 5, kb = bhj & 31, b = bh >> 3, h = bh & 7;
            const int cnt = (int)__hip_atomic_load(ctl + CW_MOBACNT + bhj, RLX_AGENT);
            const int e0 = grp * 1024, n = (cnt - e0) < 1024 ? (cnt - e0) : 1024, nsub = (n + 31) >> 5;
            const moba::bf16* Kh = (const moba::bf16*)QKV + ((size_t)b * SEQ + kb * 256) * NQKV + 1024 + h * 128;
            moba::moba_load_block(Kh, Kh + 1024, (char*)lds);
            asm volatile("s_waitcnt vmcnt(0) lgkmcnt(0)\n\ts_barrier" ::: "memory");
            for (int sc = wave; sc < nsub; sc += 8) {
                const int ei = e0 + sc * 32 + r32_; const bool valid = ei < cnt;
                const int ent = valid ? lists[(size_t)bh * LIST_PER_BH + list_off(kb) + ei] : 0;
                const int s = ent & 0xffff, mli = (bh * SEQ + s) * 3 + (ent >> 16);
                const moba::bf16* qrow = (const moba::bf16*)QKV + ((size_t)b * SEQ + s) * NQKV + h * 128;
                moba::moba_sub<false>(3, qrow, (moba::bf16*)PO, 128, valid ? mli : -1, pml, mli, 0, (char*)lds, wave);
            }
        }
        for (;;) {
            __syncthreads();
            if (tid == 0) MISC[60] = __hip_atomic_fetch_add(ctl + CW_Q + 1 + (rep_ ? 16 : 0), 1u, RLX_AGENT);
            __syncthreads();
            const int ou = (int)MISC[60];
            if (ou >= 1024) break;
            const int b = ou >> 8, h = (ou >> 5) & 7, kb = ou & 31;
            const moba::bf16* Kh = (const moba::bf16*)QKV + ((size_t)b * SEQ + kb * 256) * NQKV + 1024 + h * 128;
            moba::moba_load_block(Kh, Kh + 1024, (char*)lds);
            const int s = kb * 256 + wave * 32 + r32_;
            const moba::bf16* qrow = (const moba::bf16*)QKV + ((size_t)b * SEQ + s) * NQKV + h * 128;
            asm volatile("s_waitcnt vmcnt(0) lgkmcnt(0)\n\ts_barrier" ::: "memory");
            moba::moba_sub<true>(wave >> 1, qrow, (moba::bf16*)OB + h * 128, DM, b * SEQ + s, ownml, (b * 8 + h) * SEQ + s, wave * 32 + r32_, (char*)lds, wave);
        }
        } SEAM(12);
    }
    if (IN(13)) { PH_PTRS; for (int rep_ = 0; rep_ < NREP(13); ++rep_) {
        const int hh = lane >> 3, dd = (lane & 7) * 16;
        for (int m0 = gw; m0 < TOK; m0 += 2 * NGW) {
            v4u A0[2], A1[2], Q0[2][3], Q1[2][3]; float mm[2][4], ll[2][4];
#pragma unroll
            for (int u = 0; u < 2; ++u) { const int m = (m0 + u * NGW < TOK) ? m0 + u * NGW : m0;
                const int b = m >> 13, s = m & 8191, nv = (s >> 8) < 3 ? (s >> 8) : 3; const int qi = (b * 8 + hh) * SEQ + s;
                mm[u][0] = ownml[2 * (size_t)qi]; ll[u][0] = ownml[2 * (size_t)qi + 1];
                const bf16* op = OB + (size_t)m * DM + hh * 128 + dd; A0[u] = *(const GAS v4u*)op; A1[u] = *(const GAS v4u*)(op + 8);
#pragma unroll
                for (int r = 0; r < 3; ++r) { if (r < nv) { mm[u][1 + r] = pml[2 * ((size_t)qi * 3 + r)]; ll[u][1 + r] = pml[2 * ((size_t)qi * 3 + r) + 1];
                        const bf16* pp = PO + ((size_t)qi * 3 + r) * 128 + dd; Q0[u][r] = *(const GAS v4u*)pp; Q1[u][r] = *(const GAS v4u*)(pp + 8); }
                    else { mm[u][1 + r] = -1e30f; ll[u][1 + r] = 0.f; Q0[u][r] = (v4u){0u, 0u, 0u, 0u}; Q1[u][r] = (v4u){0u, 0u, 0u, 0u}; } } }
#pragma unroll
            for (int u = 0; u < 2; ++u) { const int m = m0 + u * NGW; if (m < TOK) {
                float M = fmaxf(fmaxf(mm[u][0], mm[u][1]), fmaxf(mm[u][2], mm[u][3]));
                float w[4], wsum = 0.f;
#pragma unroll
                for (int r = 0; r < 4; ++r) { w[r] = ll[u][r] * __builtin_amdgcn_exp2f(mm[u][r] - M); wsum += w[r]; }
                const float inv = 1.f / wsum;
                float acc16[16];
                { const v4u a0 = A0[u], a1 = A1[u]; const float ww = w[0] * inv;
#pragma unroll
                  for (int k = 0; k < 4; ++k) { acc16[2 * k] = ww * __uint_as_float(a0[k] << 16); acc16[2 * k + 1] = ww * __uint_as_float(a0[k] & 0xffff0000u); acc16[8 + 2 * k] = ww * __uint_as_float(a1[k] << 16); acc16[8 + 2 * k + 1] = ww * __uint_as_float(a1[k] & 0xffff0000u); } }
#pragma unroll
                for (int r = 0; r < 3; ++r) { const v4u a0 = Q0[u][r], a1 = Q1[u][r]; const float ww = w[1 + r] * inv;
#pragma unroll
                    for (int k = 0; k < 4; ++k) { acc16[2 * k] += ww * __uint_as_float(a0[k] << 16); acc16[2 * k + 1] += ww * __uint_as_float(a0[k] & 0xffff0000u); acc16[8 + 2 * k] += ww * __uint_as_float(a1[k] << 16); acc16[8 + 2 * k + 1] += ww * __uint_as_float(a1[k] & 0xffff0000u); } }
                float mx = 0.f;
#pragma unroll
                for (int k = 0; k < 16; ++k) mx = fmaxf(mx, fabsf(acc16[k]));
#pragma unroll
                for (int o = 1; o < 64; o <<= 1) mx = fmaxf(mx, __shfl_xor(mx, o));
                const float invq = mx > 0.f ? 127.0f / mx : 0.f;
                v4u wq;
#pragma unroll
                for (int k = 0; k < 4; ++k) { const int q0 = (int)__builtin_rintf(acc16[4 * k] * invq), q1 = (int)__builtin_rintf(acc16[4 * k + 1] * invq), q2 = (int)__builtin_rintf(acc16[4 * k + 2] * invq), q3 = (int)__builtin_rintf(acc16[4 * k + 3] * invq);
                    wq[k] = (unsigned)(q0 & 255) | ((unsigned)(q1 & 255) << 8) | ((unsigned)(q2 & 255) << 16) | ((unsigned)(q3 & 255) << 24); }
                *(GAS v4u*)(OBQ + (size_t)m * DM + hh * 128 + dd) = wq;
                if (lane == 0) SO1[m] = mx * (1.0f / 127.0f); } }
        }
        } SEAM(13);
    }
    if (IN(14)) { PH_PTRS; for (int rep_ = 0; rep_ < NREP(14); ++rep_) {
        pg8::ABDense ab{(const pg8::bf16_t*)OBQ, (const pg8::bf16_t*)W1o, DM / 2}; pg8::TileOrder S; S.init(TOK / 256, DM / 256, G, bx);
        pg8::EpiResBQ E{Rb, Rb, DM, nullptr, SO1, CMO1, pg8::MoeMap{0, nullptr}, 1.0f, RSS(3), nullptr, nullptr, nullptr, 0.f, nullptr, nullptr};
        pg8::gemm_phase<pg8::EpiResBQ, pg8::ABDense, GEMM_ALIGN>(L + RING_OFF, ab, S, E);
        } SEAM(14);
    }
    if (IN(15)) { PH_PTRS; for (int rep_ = 0; rep_ < NREP(15); ++rep_) {
        {
            const int gt = (vcu * NWAVES + wave) * 64 + lane, NT_ = G * NWAVES * 64;
            for (int e = gt; e < 2 * SLOTS; e += NT_) { slot_tok[e] = -1; slot_gate[e] = 0.f; slot_sa[e] = 0.f; }
        }
        if (rep_ == 0) {
            f32x4 gv[4]; load_gain(norm_ffn + DM, gv, lane);
            float wr_[16][8];
#pragma unroll
            for (int j = 0; j < 4; ++j)
#pragma unroll
                for (int q = 0; q < 4; ++q) { const int k = 4 * lane + 256 * j + q; const f32x4 a = *(const GAS f32x4*)(moe_router + (size_t)k * 8) * gv[j][q], c = *(const GAS f32x4*)(moe_router + (size_t)k * 8 + 4) * gv[j][q];
                    wr_[4 * j + q][0] = a.x; wr_[4 * j + q][1] = a.y; wr_[4 * j + q][2] = a.z; wr_[4 * j + q][3] = a.w; wr_[4 * j + q][4] = c.x; wr_[4 * j + q][5] = c.y; wr_[4 * j + q][6] = c.z; wr_[4 * j + q][7] = c.w; }
            for (int m = gw; m < TOK; m += NGW) {
                f32x4 v[4];
                { const GAS unsigned long long* r8 = (const GAS unsigned long long*)(Rb + (size_t)m * DM) + lane;
#pragma unroll
                  for (int j = 0; j < 4; ++j) { const unsigned long long w = r8[64 * j]; const unsigned lo32 = (unsigned)w, hi32 = (unsigned)(w >> 32);
                      v[j].x = __uint_as_float(lo32 << 16); v[j].y = __uint_as_float(lo32 & 0xffff0000u); v[j].z = __uint_as_float(hi32 << 16); v[j].w = __uint_as_float(hi32 & 0xffff0000u); } }
                float lg[8];
#pragma unroll
                for (int e = 0; e < 8; ++e) { float a = 0.f;
#pragma unroll
                    for (int j = 0; j < 4; ++j) a += v[j].x * wr_[4 * j][e] + v[j].y * wr_[4 * j + 1][e] + v[j].z * wr_[4 * j + 2][e] + v[j].w * wr_[4 * j + 3][e];
                    lg[e] = wave_sum(a); }
                const float rs = 1.f / sqrtf((float)RSS(3)[m] * (5.9604644775390625e-8f / DM) + NORM_EPS);
#pragma unroll
                for (int e = 0; e < 8; ++e) lg[e] *= rs;
                {
                    float mx = 0.f;
#pragma unroll
                    for (int j = 0; j < 4; ++j) mx = fmaxf(fmaxf(mx, fmaxf(fabsf(v[j].x), fabsf(v[j].y))), fmaxf(fabsf(v[j].z), fabsf(v[j].w)));
#pragma unroll
                    for (int o = 1; o < 64; o <<= 1) mx = fmaxf(mx, __shfl_xor(mx, o));
                    const float inv = mx > 0.f ? 127.0f / mx : 0.f;
                    GAS unsigned* aq = (GAS unsigned*)(AQ + (size_t)m * DM) + lane;
#pragma unroll
                    for (int j = 0; j < 4; ++j) { const int q0 = (int)__builtin_rintf(v[j].x * inv), q1 = (int)__builtin_rintf(v[j].y * inv), q2 = (int)__builtin_rintf(v[j].z * inv), q3 = (int)__builtin_rintf(v[j].w * inv);
                        aq[64 * j] = (unsigned)(q0 & 255) | ((unsigned)(q1 & 255) << 8) | ((unsigned)(q2 & 255) << 16) | ((unsigned)(q3 & 255) << 24); }
                    if (lane == 0) SA[m] = mx * rs * (1.0f / 127.0f);
                }
                int e0 = 0; float l0 = lg[0];
#pragma unroll
                for (int e = 1; e < 8; ++e) if (lg[e] > l0) { l0 = lg[e]; e0 = e; }
                int e1 = -1; float l1 = -INFINITY;
#pragma unroll
                for (int e = 0; e < 8; ++e) if (e != e0 && lg[e] > l1) { l1 = lg[e]; e1 = e; }
                if (lane == 0) {
                    const float g0 = 1.f / (1.f + expf(l1 - l0)), g1 = 1.f - g0;
                    const int p0 = (int)__hip_atomic_fetch_add((LAS unsigned*)(L + MISC_OFF) + 40 + e0, 1u, __ATOMIC_RELAXED, __HIP_MEMORY_SCOPE_WORKGROUP), p1 = (int)__hip_atomic_fetch_add((LAS unsigned*)(L + MISC_OFF) + 48 + e1, 1u, __ATOMIC_RELAXED, __HIP_MEMORY_SCOPE_WORKGROUP);
                    tok_e[m] = e0; tok_e[TOK + m] = e1; tok_pos[m] = p0; tok_pos[TOK + m] = p1; tok_gate[m] = g0; tok_gate[TOK + m] = g1;
                }
            }
            LDS_WAIT(); __syncthreads();
            if (tid < 16) { const unsigned n = MISC[40 + tid]; wg_base[vcu * 16 + tid] = n ? (int)__hip_atomic_fetch_add(ctl + CW_MOECNT + tid, n, RLX_AGENT) : 0; }
        }
        {
            LAS float* scr = (LAS float*)(L + RING_OFF + wave * 16384);
            LAS float* cmw = (LAS float*)(L + 132096);
            const float* gk1 = norm_ffn + DM;
            for (int st = vcu; st < NEXP * (DM / 32); st += G) {
                const int e = st >> 5, nb = st & 31; const float* W = moe_w2 + (size_t)e * FF1 * DM;
                f32x4 mx = (f32x4){0.f, 0.f, 0.f, 0.f}; (void)wstrip_max(W, DM, 7 * wave, 7, nb, lane, nullptr, mx);
                if (lane < 8) { LAS float* d = cmw + wave * 32 + lane * 4; d[0] = mx.x; d[1] = mx.y; d[2] = mx.z; d[3] = mx.w; }
                LDS_WAIT(); __syncthreads();
                float cm = 0.f;
#pragma unroll
                for (int w8 = 0; w8 < 8; ++w8) cm = fmaxf(cm, cmw[w8 * 32 + (lane & 31)]);
                if (wave == 0 && lane < 32) CMAX2[e * DM + nb * 32 + lane] = __float_as_uint(cm);
                strip_quant<0>(W, FF1, DM, WM2 + (size_t)e * DM * FF1, cm, scr, 7 * wave, 7, nb, lane, nullptr);
                __syncthreads();
            }
            float ssA = 0.f, ssB = 0.f;
            LAS float* Lf = (LAS float*)(L + RING_OFF);
            for (int it = vcu; it < 2 * NEXP * (FF1 / 32); it += G) {
                const int mat = it / (FF1 / 32), nb = it % (FF1 / 32), e = mat >> 1; const bool w3 = (mat & 1) != 0;
                const float* W = (w3 ? moe_w3 : moe_w1) + (size_t)e * DM * FF1;
                const int n0 = 32 * nb, kr = lane >> 3, nc = (lane & 7) * 4;
                f32x4 mx = (f32x4){0.f, 0.f, 0.f, 0.f}; float ss = 0.f;
#pragma unroll
                for (int bt = 0; bt < 2; ++bt) { f32x4 v[8];
#pragma unroll
                    for (int i = 0; i < 8; ++i) v[i] = *(const GAS f32x4*)(W + (size_t)(128 * wave + bt * 64 + i * 8 + kr) * FF1 + n0 + nc);
#pragma unroll
                    for (int i = 0; i < 8; ++i) { const int k = 128 * wave + bt * 64 + i * 8 + kr; v[i] = v[i] * gk1[k];
                        mx.x = fmaxf(mx.x, fabsf(v[i].x)); mx.y = fmaxf(mx.y, fabsf(v[i].y)); mx.z = fmaxf(mx.z, fabsf(v[i].z)); mx.w = fmaxf(mx.w, fabsf(v[i].w));
                        ss += (v[i].x * v[i].x + v[i].y * v[i].y) + (v[i].z * v[i].z + v[i].w * v[i].w);
                        LAS float* d = Lf + k * 32; const int sw = k & 31; d[(nc + 0) ^ sw] = v[i].x; d[(nc + 1) ^ sw] = v[i].y; d[(nc + 2) ^ sw] = v[i].z; d[(nc + 3) ^ sw] = v[i].w; } }
                if (w3) ssB += ss; else ssA += ss;
#pragma unroll
                for (int o = 8; o < 64; o <<= 1) { mx.x = fmaxf(mx.x, __shfl_xor(mx.x, o)); mx.y = fmaxf(mx.y, __shfl_xor(mx.y, o)); mx.z = fmaxf(mx.z, __shfl_xor(mx.z, o)); mx.w = fmaxf(mx.w, __shfl_xor(mx.w, o)); }
                if (lane < 8) { LAS float* d = cmw + wave * 32 + lane * 4; d[0] = mx.x; d[1] = mx.y; d[2] = mx.z; d[3] = mx.w; }
                LDS_WAIT(); __syncthreads();
                const int n = lane & 31, hh = lane >> 5;
                float cm = 0.f;
#pragma unroll
                for (int w8 = 0; w8 < 8; ++w8) cm = fmaxf(cm, cmw[w8 * 32 + n]);
                const int row = w3 ? maprow<4>(n0 + n) : maprow<3>(n0 + n);
                if (wave == 0 && lane < 32) CMAX13[e * 2 * FF1 + row] = __float_as_uint(cm);
                const float inv = cm > 0.f ? 127.0f / cm : 0.f;
                signed char* wt = WM13 + (size_t)e * 2 * FF1 * DM + (size_t)row * DM + 128 * wave + 64 * hh;
#pragma unroll
                for (int q16 = 0; q16 < 4; ++q16) { v4u o;
#pragma unroll
                    for (int dq = 0; dq < 4; ++dq) { unsigned pk = 0;
#pragma unroll
                        for (int b = 0; b < 4; ++b) { const int k = 128 * wave + 64 * hh + 16 * q16 + 4 * dq + b; const int q = (int)__builtin_rintf(Lf[k * 32 + (n ^ (k & 31))] * inv); pk |= (unsigned)(q & 255) << (8 * b); }
                        o[dq] = pk; }
                    *(GAS v4u*)(wt + 16 * q16) = o; }
                LDS_WAIT(); __syncthreads();
            }
            ssA = wave_sum(ssA); ssB = wave_sum(ssB);
            if (lane == 0) { __hip_atomic_fetch_add(SSTOT, (unsigned long long)(ssA * 16777216.0f), __ATOMIC_RELAXED, __HIP_MEMORY_SCOPE_AGENT); __hip_atomic_fetch_add(SSTOT + 1, (unsigned long long)(ssB * 16777216.0f), __ATOMIC_RELAXED, __HIP_MEMORY_SCOPE_AGENT); }
        }
        } SEAM(15);
    }
#define MOE_CUM() do { if (tid < 2) { int a = 0; for (int e = 0; e < 8; ++e) { MISC[16 + 9 * tid + e] = (unsigned)a; a += (int)((__hip_atomic_load(ctl + CW_MOECNT + 8 * tid + e, RLX_AGENT) + 255u) >> 8); } MISC[16 + 9 * tid + 8] = (unsigned)a; } __syncthreads(); } while (0)
    if (IN(16)) { PH_PTRS; for (int rep_ = 0; rep_ < NREP(16); ++rep_) {
        MOE_CUM();
        const int gt = (vcu * NWAVES + wave) * 64 + lane, NT_ = G * NWAVES * 64;
        for (int e = gt; e < 2 * TOK; e += NT_) { const int r = e >= TOK ? 1 : 0; const int ex = tok_e[e]; const int t_ = e - r * TOK; const int slot = (int)MISC[16 + 9 * r + ex] * 256 + wg_base[((t_ % NGW) >> 3) * 16 + r * 8 + ex] + tok_pos[e];
            slot_tok[r * SLOTS + slot] = e - r * TOK; slot_gate[r * SLOTS + slot] = tok_gate[e]; slot_sa[r * SLOTS + slot] = SA[e - r * TOK]; }
        } SEAM(16);
    }
#define MOE_SU() (8.0f * sqrtf(((float)SSTOT[0] * (5.9604644775390625e-8f / (NEXP * FF1))) * ((float)SSTOT[1] * (5.9604644775390625e-8f / (NEXP * FF1)))))
#define MOE_UP_BOTH() do { MOE_CUM(); \
        const pg8::MoeMap mp{(int)MISC[16 + 8], (const LAS int*)(L + MISC_OFF + 4 * 16)}; \
        pg8::ABMoeUp ab{(const pg8::bf16_t*)AQ, (const pg8::bf16_t*)WM13, DM / 2, slot_tok, mp, (size_t)2 * FF1 * (DM / 2)}; \
        pg8::TileOrder S; S.init((int)MISC[16 + 8] + (int)MISC[16 + 9 + 8], (2 * FF1) / 256, G, bx); \
        pg8::EpiSwiGLUQ E{UM, FF1, slot_sa, CMAX13, nullptr, mp, 127.0f / MOE_SU(), nullptr}; \
        pg8::gemm_phase<pg8::EpiSwiGLUQ, pg8::ABMoeUp, GEMM_ALIGN>(L + RING_OFF, ab, S, E); } while (0)
#define MOE_DOWN_BOTH() do { MOE_CUM(); \
        const pg8::MoeMap mp{(int)MISC[16 + 8], (const LAS int*)(L + MISC_OFF + 4 * 16)}; \
        pg8::ABMoeDown ab{(const pg8::bf16_t*)UM, (const pg8::bf16_t*)WM2, FF1 / 2, mp, (size_t)DM * (FF1 / 2)}; \
        pg8::TileOrder S; S.init((int)MISC[16 + 8] + (int)MISC[16 + 9 + 8], DM / 256, G, bx); \
        pg8::EpiResBQ E{Rb, Rb, DM, slot_tok, slot_gate, CMAX2, mp, MOE_SU() * (1.0f / 127.0f), nullptr, Y1B, nullptr, nullptr, 0.f, nullptr, nullptr}; \
        pg8::gemm_phase<pg8::EpiResBQ, pg8::ABMoeDown, GEMM_ALIGN>(L + RING_OFF, ab, S, E); } while (0)
    if (IN(17)) { PH_PTRS; for (int rep_ = 0; rep_ < NREP(17); ++rep_) MOE_UP_BOTH(); SEAM(17); }
    if (IN(18)) { PH_PTRS; MOE_DOWN_BOTH(); SEAM(18); }
    if (IN(21)) { PH_PTRS;
        f32x4 gv[4]; load_gain(final_norm, gv, lane);
        for (int m0 = gw; m0 < TOK; m0 += 4 * NGW) {
            unsigned long long w[4][4], y[4][4];
#pragma unroll
            for (int u = 0; u < 4; ++u) { const int m = (m0 + u * NGW < TOK) ? m0 + u * NGW : m0; const GAS unsigned long long* r8 = (const GAS unsigned long long*)(Rb + (size_t)m * DM) + lane; const GAS unsigned long long* y8 = (const GAS unsigned long long*)(Y1B + (size_t)m * DM) + lane;
#pragma unroll
                for (int j = 0; j < 4; ++j) { w[u][j] = r8[64 * j]; y[u][j] = y8[64 * j]; } }
#pragma unroll
            for (int u = 0; u < 4; ++u) { const int m = m0 + u * NGW; if (m < TOK) {
                f32x4 v[4]; float s = 0.f;
#pragma unroll
                for (int j = 0; j < 4; ++j) { const unsigned lo32 = (unsigned)w[u][j], hi32 = (unsigned)(w[u][j] >> 32), ylo = (unsigned)y[u][j], yhi = (unsigned)(y[u][j] >> 32);
                    v[j].x = __uint_as_float(lo32 << 16) + __uint_as_float(ylo << 16); v[j].y = __uint_as_float(lo32 & 0xffff0000u) + __uint_as_float(ylo & 0xffff0000u);
                    v[j].z = __uint_as_float(hi32 << 16) + __uint_as_float(yhi << 16); v[j].w = __uint_as_float(hi32 & 0xffff0000u) + __uint_as_float(yhi & 0xffff0000u);
                    s += (v[j].x * v[j].x + v[j].y * v[j].y) + (v[j].z * v[j].z + v[j].w * v[j].w); }
                const float rstd = 1.f / sqrtf(wave_sum(s) * (1.f / DM) + NORM_EPS);
                GAS f32x4* o = (GAS f32x4*)(out + (size_t)m * DM) + lane;
#pragma unroll
                for (int j = 0; j < 4; ++j) o[64 * j] = v[j] * rstd * gv[j]; } }
        }
    }
#undef IN
#undef SEAM
#undef GRID_BAR
}
constexpr int N_PHASES = 22;

extern "C" void kernel_launch(void* const* d_in, const int* in_sizes, int n_in, void* d_out, int out_size, void* d_ws, size_t ws_size, hipStream_t stream) {
    static int grid = 0;
    if (grid == 0) {
        if (n_in != 20 || in_sizes[0] != TOK * DM || out_size != TOK * DM || ws_size < WS_END) { fprintf(stderr, "kernel_launch: shape / workspace mismatch (n_in %d, in0 %d, out %d, ws %zu, need %zu); nothing launched\n", n_in, n_in > 0 ? in_sizes[0] : -1, out_size, ws_size, (size_t)WS_END); grid = -1; return; }
        int dev = 0, cus = 0, per_cu = 0;
        if (hipGetDevice(&dev) != hipSuccess || hipDeviceGetAttribute(&cus, hipDeviceAttributeMultiprocessorCount, dev) != hipSuccess) { grid = -1; return; }
        if (hipFuncSetAttribute((const void*)mk_fwd, hipFuncAttributeMaxDynamicSharedMemorySize, LDS_BYTES) != hipSuccess) { fprintf(stderr, "kernel_launch: hipFuncSetAttribute failed\n"); grid = -1; return; }
        if (hipOccupancyMaxActiveBlocksPerMultiprocessor(&per_cu, (const void*)mk_fwd, NWAVES * 64, LDS_BYTES) != hipSuccess || per_cu < 1) fprintf(stderr, "kernel_launch: occupancy query reports %d workgroups per CU\n", per_cu);
        (void)hipGetLastError();
        grid = cus;
    }
    if (grid < 0) return;
    if (hipMemsetAsync((char*)d_ws + WS_CTL, 0, CTL_ZERO_BYTES, stream) != hipSuccess) return;
    Args a{};
    for (int i = 0; i < 20; ++i) a.in[i] = (const float*)d_in[i];
    a.out = (float*)d_out; a.ws = (unsigned char*)d_ws;
    for (int i = 0; i < 8; ++i) a.inv64[i] = (float)pow(500000.0, -(double)(2 * i) / 16.0);
    for (int i = 0; i < 16; ++i) a.inv128[i] = (float)pow(500000.0, -(double)(2 * i) / 32.0);
#if MK_PER_PHASE
    for (int p = 0; p < N_PHASES; ++p) { a.ph_lo = p; a.ph_hi = p + 1; hipLaunchKernelGGL(mk_fwd, dim3(grid), dim3(NWAVES * 64), LDS_BYTES, stream, a); }
#else
    a.ph_lo = 0; a.ph_hi = N_PHASES;
    hipLaunchKernelGGL(mk_fwd, dim3(grid), dim3(NWAVES * 64), LDS_BYTES, stream, a);
#ifdef PROBE_LIST
    {
        static const int probe[] = {PROBE_LIST};
        for (int k : probe) { a.ph_lo = k; a.ph_hi = k + 1;
            a.out = (k == 3 || k == 12 || k == 13 || k == 18 || k == 21) ? (float*)((char*)d_ws + WS_QKV) : (float*)d_out;
            hipLaunchKernelGGL(mk_fwd, dim3(grid), dim3(NWAVES * 64), LDS_BYTES, stream, a); }
    }
#endif
#endif
    const hipError_t le = hipPeekAtLastError();
    if (le != hipSuccess) fprintf(stderr, "kernel_launch: launch failed: %s\n", hipGetErrorName(le));
}
```
